# Optimizing an MI355X kernel written in HIP

```python
import math
import jax, jax.numpy as jnp
from jax import lax
import numpy as np

D_MODEL = 1024
BATCH = 2
SEQ = 8192
DEPTH = 4

N_MIXERS = 3
MIXER_ORDER = ('gla', 'diff', 'sgu')
EPS = 1e-6
NEG_INF = -1e30
D_FF = 4 * D_MODEL

GLA_HEADS = 4
GLA_DK = D_MODEL // 2
GLA_DV = D_MODEL
GLA_HK = GLA_DK // GLA_HEADS
GLA_HV = GLA_DV // GLA_HEADS
GLA_RANK = 16
GLA_GATE_NORM = 16.0
GLA_CHUNK = 64
GLA_IN = 2 * GLA_DK + 2 * GLA_DV

DIFF_HEAD_DIM = 64
DIFF_HEADS = D_MODEL // (2 * DIFF_HEAD_DIM)
DIFF_QBLOCK = 128
DIFF_IN = 4 * DIFF_HEADS * DIFF_HEAD_DIM + 2 * DIFF_HEADS * DIFF_HEAD_DIM

SGU_CHUNK = 128
SGU_WIDTH = D_MODEL
SGU_GROUPS = 8
SGU_GROUP_DIM = SGU_WIDTH // SGU_GROUPS

kernel_name = 'hybrid_gla_diffattn_sgu_trunk'


def rmsnorm(x, g):
    xf = x.astype(jnp.float32)
    y = xf * lax.rsqrt(jnp.mean(xf * xf, axis=-1, keepdims=True) + EPS)
    return (y * g.astype(jnp.float32)).astype(x.dtype)


def head_rms(o):
    return o * lax.rsqrt(jnp.mean(o * o, axis=-1, keepdims=True) + EPS)


def alibi_slopes(n_heads):
    return 2.0 ** (-8.0 * jnp.arange(1, n_heads + 1, dtype=jnp.float32) / n_heads)


def gla_mixer(h, w_in, gate_w1, gate_w2, gate_b, head_norm, w_out):
    B, T, _ = h.shape
    C = GLA_CHUNK
    nC = T // C
    f32 = jnp.float32
    proj = h @ w_in
    q, k, v, g = jnp.split(proj, [GLA_DK, 2 * GLA_DK, 2 * GLA_DK + GLA_DV], axis=-1)
    log_a = jax.nn.log_sigmoid(((h @ gate_w1) @ gate_w2 + gate_b).astype(f32)) / GLA_GATE_NORM

    def chunked(t, d):
        return t.reshape(B, nC, C, GLA_HEADS, d).transpose(0, 3, 1, 2, 4).astype(f32)

    q = chunked(q, GLA_HK) * (GLA_HK ** -0.5)
    k = chunked(k, GLA_HK)
    v = chunked(v, GLA_HV)
    b = jnp.cumsum(chunked(log_a, GLA_HK), axis=3)
    b_last = b[:, :, :, -1:, :]
    q_dec = q * jnp.exp(b)
    k_inv = k * jnp.exp(-b)
    k_to_end = k * jnp.exp(b_last - b)
    causal = jnp.tril(jnp.ones((C, C), dtype=bool))
    att = jnp.where(causal, jnp.einsum('bhncd,bhnsd->bhncs', q_dec, k_inv), 0.0)
    o_intra = jnp.einsum('bhncs,bhnsv->bhncv', att, v)
    kv = jnp.einsum('bhncd,bhncv->bhndv', k_to_end, v)
    decay = jnp.exp(b_last[:, :, :, 0, :])

    def step(S, inp):
        kv_n, dec_n = inp
        return dec_n[..., None] * S + kv_n, S

    S0 = jnp.zeros((B, GLA_HEADS, GLA_HK, GLA_HV), f32)
    _, S_prev = lax.scan(step, S0, (kv.transpose(2, 0, 1, 3, 4), decay.transpose(2, 0, 1, 3)))
    S_prev = S_prev.transpose(1, 2, 0, 3, 4)
    o = o_intra + jnp.einsum('bhncd,bhndv->bhncv', q_dec, S_prev)
    o = head_rms(o) * head_norm.astype(f32)
    o = o.transpose(0, 2, 3, 1, 4).reshape(B, T, GLA_DV)
    o = o * jax.nn.silu(g.astype(f32))
    return o.astype(h.dtype) @ w_out


def diff_mixer(h, w_in, lq1, lk1, lq2, lk2, head_norm, w_out, layer_idx):
    B, T, _ = h.shape
    H, Dh, QB = DIFF_HEADS, DIFF_HEAD_DIM, DIFF_QBLOCK
    nQ = T // QB
    f32 = jnp.float32
    lambda_init = 0.8 - 0.6 * math.exp(-0.3 * layer_idx)
    lam = (jnp.exp(jnp.sum(lq1.astype(f32) * lk1.astype(f32)))
           - jnp.exp(jnp.sum(lq2.astype(f32) * lk2.astype(f32))) + lambda_init)
    proj = h @ w_in
    q, k, v = jnp.split(proj, [2 * H * Dh, 4 * H * Dh], axis=-1)
    q = q.reshape(B, T, H, 2, Dh) * (Dh ** -0.5)
    k = k.reshape(B, T, H, 2, Dh)
    v = v.reshape(B, T, H, 2 * Dh)
    slopes = alibi_slopes(H)[:, None, None, None]
    pos_k = jnp.arange(T)
    q_blocks = jnp.moveaxis(q.reshape(B, nQ, QB, H, 2, Dh), 1, 0)

    def attend_block(args):
        q_blk, blk = args
        pos_q = blk * QB + jnp.arange(QB)
        dist = pos_q[:, None] - pos_k[None, :]
        s = jnp.einsum('bqhrd,bkhrd->bhrqk', q_blk, k).astype(f32)
        s = jnp.where(dist >= 0, s - slopes * dist.astype(f32), NEG_INF)
        p = jax.nn.softmax(s, axis=-1)
        p = p[:, :, 0] - lam * p[:, :, 1]
        return jnp.einsum('bhqk,bkhv->bqhv', p.astype(v.dtype), v)

    o = lax.map(attend_block, (q_blocks, jnp.arange(nQ)))
    o = jnp.moveaxis(o, 0, 1).reshape(B, T, H, 2 * Dh).astype(f32)
    o = head_rms(o) * head_norm.astype(f32) * (1.0 - lambda_init)
    return o.reshape(B, T, H * 2 * Dh).astype(h.dtype) @ w_out


def sgu_mixer(h, w_in, b_in, v_norm, w_s, b_s, w_out):
    B, T, _ = h.shape
    C = SGU_CHUNK
    nC = T // C
    uv = jax.nn.gelu(h @ w_in + b_in)
    u, v = jnp.split(uv, 2, axis=-1)
    v = rmsnorm(v, v_norm)
    vc = v.reshape(B, nC, C, SGU_GROUPS, SGU_GROUP_DIM)
    w = w_s * jnp.tril(jnp.ones((C, C), w_s.dtype))
    s = jnp.einsum('gts,bnsgd->bntgd', w, vc) + b_s.T[:, :, None]
    return (u * s.reshape(B, T, SGU_WIDTH)) @ w_out


def sq_relu_mlp(h, w1, w2):
    a = jax.nn.relu(h @ w1)
    return (a * a) @ w2


def setup_inputs(seed: int = 0) -> dict:
    key = jax.random.key(seed)
    keys = iter(jax.random.split(key, 64))

    def nrm(shape, scale):
        return scale * jax.random.normal(next(keys), shape, jnp.float32)

    def gain(n):
        return 1.0 + 0.05 * jax.random.normal(next(keys), (n,), jnp.float32)

    inp = {'x': jax.random.normal(next(keys), (BATCH, SEQ, D_MODEL), jnp.float32)}
    for i in range(DEPTH):
        p = 'l%d_' % i
        kind = MIXER_ORDER[i % N_MIXERS]
        inp[p + 'norm1'] = gain(D_MODEL)
        if kind == 'gla':
            inp[p + 'w_in'] = nrm((D_MODEL, GLA_IN), D_MODEL ** -0.5)
            inp[p + 'gate_w1'] = nrm((D_MODEL, GLA_RANK), D_MODEL ** -0.5)
            inp[p + 'gate_w2'] = nrm((GLA_RANK, GLA_DK), GLA_RANK ** -0.5)
            inp[p + 'gate_b'] = nrm((GLA_DK,), 0.1)
            inp[p + 'head_norm'] = gain(GLA_HV)
            inp[p + 'w_out'] = nrm((GLA_DV, D_MODEL), GLA_DV ** -0.5)
        elif kind == 'diff':
            inp[p + 'w_in'] = nrm((D_MODEL, DIFF_IN), D_MODEL ** -0.5)
            for nm in ('lambda_q1', 'lambda_k1', 'lambda_q2', 'lambda_k2'):
                inp[p + nm] = nrm((DIFF_HEAD_DIM,), 0.1)
            inp[p + 'head_norm'] = gain(2 * DIFF_HEAD_DIM)
            inp[p + 'w_out'] = nrm((2 * DIFF_HEADS * DIFF_HEAD_DIM, D_MODEL), D_MODEL ** -0.5)
        else:
            inp[p + 'w_in'] = nrm((D_MODEL, 2 * SGU_WIDTH), D_MODEL ** -0.5)
            inp[p + 'b_in'] = nrm((2 * SGU_WIDTH,), 0.02)
            inp[p + 'v_norm'] = gain(SGU_WIDTH)
            inp[p + 'w_s'] = nrm((SGU_GROUPS, SGU_CHUNK, SGU_CHUNK), 0.5 * SGU_CHUNK ** -0.5)
            inp[p + 'b_s'] = 1.0 + nrm((SGU_GROUPS, SGU_CHUNK), 0.05)
            inp[p + 'w_out'] = nrm((SGU_WIDTH, D_MODEL), SGU_WIDTH ** -0.5)
        inp[p + 'norm2'] = gain(D_MODEL)
        inp[p + 'mlp_w1'] = nrm((D_MODEL, D_FF), D_MODEL ** -0.5)
        inp[p + 'mlp_w2'] = nrm((D_FF, D_MODEL), D_FF ** -0.5)
    inp['final_norm'] = gain(D_MODEL)
    return inp


def reference(x,
              l0_norm1, l0_w_in, l0_gate_w1, l0_gate_w2, l0_gate_b, l0_head_norm, l0_w_out,
              l0_norm2, l0_mlp_w1, l0_mlp_w2,
              l1_norm1, l1_w_in, l1_lambda_q1, l1_lambda_k1, l1_lambda_q2, l1_lambda_k2,
              l1_head_norm, l1_w_out, l1_norm2, l1_mlp_w1, l1_mlp_w2,
              l2_norm1, l2_w_in, l2_b_in, l2_v_norm, l2_w_s, l2_b_s, l2_w_out,
              l2_norm2, l2_mlp_w1, l2_mlp_w2,
              l3_norm1, l3_w_in, l3_gate_w1, l3_gate_w2, l3_gate_b, l3_head_norm, l3_w_out,
              l3_norm2, l3_mlp_w1, l3_mlp_w2,
              final_norm):
    layers = (
        (l0_norm1, lambda h: gla_mixer(h, l0_w_in, l0_gate_w1, l0_gate_w2, l0_gate_b, l0_head_norm, l0_w_out),
         l0_norm2, l0_mlp_w1, l0_mlp_w2),
        (l1_norm1, lambda h: diff_mixer(h, l1_w_in, l1_lambda_q1, l1_lambda_k1, l1_lambda_q2, l1_lambda_k2,
                                        l1_head_norm, l1_w_out, 1),
         l1_norm2, l1_mlp_w1, l1_mlp_w2),
        (l2_norm1, lambda h: sgu_mixer(h, l2_w_in, l2_b_in, l2_v_norm, l2_w_s, l2_b_s, l2_w_out),
         l2_norm2, l2_mlp_w1, l2_mlp_w2),
        (l3_norm1, lambda h: gla_mixer(h, l3_w_in, l3_gate_w1, l3_gate_w2, l3_gate_b, l3_head_norm, l3_w_out),
         l3_norm2, l3_mlp_w1, l3_mlp_w2),
    )
    for i in range(DEPTH):
        norm1, mixer, norm2, w1, w2 = layers[i]
        x = x + mixer(rmsnorm(x, norm1))
        x = x + sq_relu_mlp(rmsnorm(x, norm2), w1, w2)
    return rmsnorm(x, final_norm)
```

```cpp
#include <hip/hip_runtime.h>
#include <hip/hip_cooperative_groups.h>
#include <cstdio>
#include <cstdint>
namespace cg = cooperative_groups;

#ifndef MK_ONE_LAUNCH
#define MK_ONE_LAUNCH 1
#endif

#define GAS __attribute__((address_space(1)))
#define LAS __attribute__((address_space(3)))
typedef unsigned short bf16;
typedef unsigned v4u __attribute__((ext_vector_type(4)));
typedef unsigned v2u __attribute__((ext_vector_type(2)));
typedef float f32x4 __attribute__((ext_vector_type(4)));

constexpr int NB = 2, T = 8192, D = 1024, NTOK = NB * T, FF = 4096;
constexpr float EPS = 1e-6f;
constexpr float LOG2E = 1.4426950408889634f;
constexpr int NWAVES = 8, NTHR = 512;
constexpr int K_GLA = 0, K_DIFF = 1, K_SGU = 2;
constexpr int GLA_H = 4, GLA_HK = 128, GLA_HV = 256, GLA_C = 64, GLA_NC = T / GLA_C;
constexpr int GLA_PITCH = 3584;
constexpr int DIFF_H = 8, DIFF_PITCH = 3072;
constexpr float LAMBDA_INIT = 0.35551069f;
constexpr int SGU_PITCH = 2048, SGU_C = 128, SGU_G = 8;

constexpr size_t MiB = 1u << 20;
constexpr size_t WS_CTL = 0, CTL_ZERO_BYTES = 1 * MiB;
constexpr size_t WS_SSQ = 1 * MiB;
constexpr size_t WS_VSSQ = 2 * MiB;
constexpr size_t WS_DEC = 3 * MiB;
constexpr size_t WS_W = 4 * MiB;
constexpr size_t WS_XB = 29 * MiB;
constexpr size_t WS_STATE = 61 * MiB;
constexpr size_t WS_H = 125 * MiB;
constexpr size_t WS_END = 253 * MiB;
constexpr size_t WOFF_IN = 0, WOFF_OUT = (size_t)3584 * 1024, WOFF_1 = WOFF_OUT + (size_t)1024 * 1024, WOFF_2 = WOFF_1 + (size_t)4096 * 1024;

constexpr int RING_BYTES = 131072, LDSCTL_OFF = RING_BYTES, MISC_OFF = LDSCTL_OFF + 320, LDS_BYTES = 147456;

#define RLX_AGENT __ATOMIC_RELAXED, __HIP_MEMORY_SCOPE_AGENT
#define LDS_WAIT() asm volatile("s_waitcnt lgkmcnt(0)" ::: "memory")
__device__ __forceinline__ unsigned f2bf(float f) { unsigned u = __builtin_bit_cast(unsigned, f); return (u + 0x7fffu + ((u >> 16) & 1u)) >> 16; }
__device__ __forceinline__ unsigned pk2(float lo, float hi) { return f2bf(lo) | (f2bf(hi) << 16); }
__device__ __forceinline__ float bf2f(unsigned b) { return __builtin_bit_cast(float, b << 16); }
__device__ __forceinline__ float bflo(unsigned w) { return __builtin_bit_cast(float, w << 16); }
__device__ __forceinline__ float bfhi(unsigned w) { return __builtin_bit_cast(float, w & 0xffff0000u); }
__device__ __forceinline__ int otid() { int t = threadIdx.x; asm volatile("" : "+v"(t)); return t; }
__device__ __forceinline__ float wave_sum(float v) {
#pragma unroll
    for (int o = 1; o < 64; o <<= 1) v += __shfl_xor(v, o);
    return v;
}
__device__ __forceinline__ float wave_max(float v) {
#pragma unroll
    for (int o = 1; o < 64; o <<= 1) v = fmaxf(v, __shfl_xor(v, o));
    return v;
}
__device__ __forceinline__ float gelu_tanh(float x) {
    const float u = 0.7978845608028654f * (x + 0.044715f * x * x * x);
    const float e = __expf(2.f * u);
    const float t = 1.f - 2.f / (e + 1.f);
    return 0.5f * x * (1.f + t);
}
__device__ __forceinline__ float log_sigmoid(float z) { return fminf(z, 0.f) - log1pf(__expf(-fabsf(z))); }

#define XB_TMO      128
#define XB_XCNT(j)  (256  + 64 * (j))
#define XB_XSUB(j)  (1280 + 64 * (j))
#define XB_XGEN(j)  (2304 + 64 * (j))
#define XB_TOP      3328
#define XB_TOPGEN   3392
#define XCD_BAR_WORDS 3456
#define XB_SPIN_CAP (1u << 22)
__device__ __forceinline__ unsigned xb_ld(unsigned* p)              { return __hip_atomic_load(p, __ATOMIC_RELAXED, __HIP_MEMORY_SCOPE_AGENT); }
__device__ __forceinline__ unsigned xb_add(unsigned* p, unsigned v) { return __hip_atomic_fetch_add(p, v, __ATOMIC_RELAXED, __HIP_MEMORY_SCOPE_AGENT); }
__device__ __forceinline__ unsigned xb_xcc_id() { return (unsigned)__builtin_amdgcn_s_getreg((3 << 11) | 20) & 0xFu; }
#define XB_SPIN(cond, bar) do { unsigned _sp = 0; while (cond) { __builtin_amdgcn_s_sleep(1); \
    if ((++_sp & 255u) == 0u) { if (xb_ld(&(bar)[XB_TMO])) break; if (_sp > XB_SPIN_CAP) { atomicAdd(&(bar)[XB_TMO], 1u); break; } } } } while (0)
struct XcdBarrier { unsigned* bar; unsigned x; volatile LAS unsigned* st; };
__device__ __forceinline__ XcdBarrier xcd_barrier_post(unsigned* bar, volatile LAS unsigned* st) {
    XcdBarrier b; b.bar = bar; b.x = xb_xcc_id(); b.st = st;
    if (threadIdx.x == 0) (void)xb_add(&bar[XB_XCNT(b.x)], 1u);
    return b;
}
__device__ __forceinline__ void xcd_barrier_complete(unsigned* bar, unsigned x, unsigned& nloc, unsigned& nx) {
    const unsigned G = gridDim.x * gridDim.y * gridDim.z;
    unsigned sum, cnt, mine, sp = 0u;
    for (;;) {
        sum = 0u; cnt = 0u; mine = 0u;
#pragma unroll
        for (unsigned j = 0; j < 16; ++j) { const unsigned c = xb_ld(&bar[XB_XCNT(j)]); sum += c; cnt += (c > 0u) ? 1u : 0u; mine = (j == x) ? c : mine; }
        if (sum == G) break;
        __builtin_amdgcn_s_sleep(1);
        if ((++sp & 255u) == 0u) { if (xb_ld(&bar[XB_TMO])) break; if (sp > XB_SPIN_CAP) { atomicAdd(&bar[XB_TMO], 1u); break; } }
    }
    nloc = mine > 0u ? mine : 1u; nx = cnt > 0u ? cnt : 1u;
}
__device__ __forceinline__ void xcd_barrier(const XcdBarrier& b) {
    asm volatile("s_waitcnt vmcnt(0)" ::: "memory");
    __syncthreads();
    if (threadIdx.x == 0) {
        unsigned* bar = b.bar;
        __builtin_amdgcn_s_waitcnt(0);
        unsigned nloc = b.st[0], nx = b.st[1];
        if (nloc == 0u) { xcd_barrier_complete(bar, b.x, nloc, nx); b.st[0] = nloc; b.st[1] = nx; }
        const unsigned old = xb_add(&bar[XB_XSUB(b.x)], 1u);
        const unsigned gen = old / nloc;
        if (old + 1u == (gen + 1u) * nloc) {
            __builtin_amdgcn_fence(__ATOMIC_RELEASE, "agent");
            asm volatile("s_waitcnt vmcnt(0)" ::: "memory");
            const unsigned og = xb_add(&bar[XB_TOP], 1u);
            const unsigned tg = og / nx;
            if (og + 1u == (tg + 1u) * nx) xb_add(&bar[XB_TOPGEN], 1u);
            else XB_SPIN(xb_ld(&bar[XB_TOPGEN]) == tg, bar);
            __builtin_amdgcn_fence(__ATOMIC_ACQUIRE, "agent");
            xb_add(&bar[XB_XGEN(b.x)], 1u);
            asm volatile("s_waitcnt vmcnt(0)" ::: "memory");
        } else {
            XB_SPIN(xb_ld(&bar[XB_XGEN(b.x)]) == gen, bar);
            __builtin_amdgcn_fence(__ATOMIC_ACQUIRE, "agent");
            asm volatile("s_waitcnt vmcnt(0)" ::: "memory");
        }
    }
    __syncthreads();
}

struct Args { const float* in[43]; float* out; unsigned char* ws; int ph_lo, ph_hi; };
struct LayerP {
    int kind;
    const float *norm1, *w_in, *w_out, *norm2, *w1, *w2;
    const float *e0, *e1, *e2, *e3, *e4;
    int nin;
    int mixoff;
};
typedef const float* cfptr;
#define CAS __attribute__((address_space(4)))
__device__ __forceinline__ LayerP layer_params(int L) {
    const CAS cfptr* in = (const CAS cfptr*)__builtin_amdgcn_kernarg_segment_ptr();
    LayerP p;
    const int base = (L == 0) ? 1 : (L == 1) ? 11 : (L == 2) ? 22 : 32;
    p.kind = (L == 1) ? K_DIFF : (L == 2) ? K_SGU : K_GLA;
    const int sh = (p.kind == K_DIFF) ? 1 : 0;
    p.norm1 = in[base]; p.w_in = in[base + 1];
    p.e0 = in[base + 2]; p.e1 = in[base + 3]; p.e2 = in[base + 4]; p.e3 = in[base + 5]; p.e4 = in[base + 6];
    p.w_out = in[base + 6 + sh]; p.norm2 = in[base + 7 + sh]; p.w1 = in[base + 8 + sh]; p.w2 = in[base + 9 + sh];
    p.nin = (p.kind == K_GLA) ? GLA_PITCH : (p.kind == K_DIFF) ? DIFF_PITCH : SGU_PITCH;
    p.mixoff = (p.kind == K_GLA) ? 1024 : 0;
    return p;
}

__device__ __forceinline__ float row_rstd(const float* ssq, int row) {
    const f32x4* p = (const f32x4*)(ssq + (size_t)row * 16);
    const f32x4 a = p[0], b = p[1], c = p[2], d = p[3];
    const float s = ((a.x + a.y) + (a.z + a.w)) + ((b.x + b.y) + (b.z + b.w)) + ((c.x + c.y) + (c.z + c.w)) + ((d.x + d.y) + (d.z + d.w));
    return 1.0f / sqrtf(s * (1.0f / D) + EPS);
}

struct EpiIn {
    int kind; bf16* proj; const float* ssq; const float* bias;
    float* vssq;
    __device__ __forceinline__ float rowscale(int row) const { return row_rstd(ssq, row); }
    __device__ __forceinline__ float apply8(int row, int col0, const float (&v)[8], float rs) const {
        float o[8]; float part = 0.f; int pitch;
        if (kind == K_GLA) { pitch = GLA_PITCH;
            if (col0 < 3072) {
#pragma unroll
                for (int j = 0; j < 8; ++j) o[j] = v[j] * rs;
            } else {
#pragma unroll
                for (int j = 0; j < 8; ++j) o[j] = log_sigmoid(v[j] * rs + bias[col0 - 3072 + j]) * (1.0f / 16.0f);
            }
        } else if (kind == K_DIFF) { pitch = DIFF_PITCH;
            const float sc = (col0 < 1024) ? rs * (0.125f * LOG2E) : rs;
#pragma unroll
            for (int j = 0; j < 8; ++j) o[j] = v[j] * sc;
        } else { pitch = SGU_PITCH;
#pragma unroll
            for (int j = 0; j < 8; ++j) { o[j] = gelu_tanh(v[j] * rs + bias[col0 + j]); }
            if (col0 >= 1024) {
#pragma unroll
                for (int j = 0; j < 8; ++j) part += o[j] * o[j];
            }
        }
        v4u w; w.x = pk2(o[0], o[1]); w.y = pk2(o[2], o[3]); w.z = pk2(o[4], o[5]); w.w = pk2(o[6], o[7]);
        *(v4u*)(proj + (size_t)row * pitch + col0) = w;
        return part;
    }
    __device__ __forceinline__ void store_part(int row, int col0, int idx, float part) const {
        if (kind == K_SGU && col0 >= 1024) vssq[(size_t)row * 16 + idx] = part;
    }
};
struct EpiHid {
    bf16* h; const float* ssq;
    __device__ __forceinline__ float rowscale(int row) const { return row_rstd(ssq, row); }
    __device__ __forceinline__ float apply8(int row, int col0, const float (&v)[8], float rs) const {
        float o[8];
#pragma unroll
        for (int j = 0; j < 8; ++j) { const float a = fmaxf(v[j] * rs, 0.f); o[j] = a * a; }
        v4u w; w.x = pk2(o[0], o[1]); w.y = pk2(o[2], o[3]); w.z = pk2(o[4], o[5]); w.w = pk2(o[6], o[7]);
        *(v4u*)(h + (size_t)row * FF + col0) = w;
        return 0.f;
    }
    __device__ __forceinline__ void store_part(int, int, int, float) const {}
};
struct EpiRes {
    const float* base; float* x; bf16* xb; float* ssq;
    __device__ __forceinline__ float rowscale(int) const { return 1.f; }
    __device__ __forceinline__ float apply8(int row, int col0, const float (&v)[8], float) const {
        const size_t off = (size_t)row * D + col0;
        const f32x4 b0 = *(const f32x4*)(base + off), b1 = *(const f32x4*)(base + off + 4);
        float o[8] = {b0.x + v[0], b0.y + v[1], b0.z + v[2], b0.w + v[3], b1.x + v[4], b1.y + v[5], b1.z + v[6], b1.w + v[7]};
        *(f32x4*)(x + off) = (f32x4){o[0], o[1], o[2], o[3]}; *(f32x4*)(x + off + 4) = (f32x4){o[4], o[5], o[6], o[7]};
        v4u w; w.x = pk2(o[0], o[1]); w.y = pk2(o[2], o[3]); w.z = pk2(o[4], o[5]); w.w = pk2(o[6], o[7]);
        *(v4u*)(xb + off) = w;
        float part = 0.f;
#pragma unroll
        for (int j = 0; j < 8; ++j) part += o[j] * o[j];
        return part;
    }
    __device__ __forceinline__ void store_part(int row, int, int idx, float part) const { ssq[(size_t)row * 16 + idx] = part; }
};

template <class Epi>
__device__ __forceinline__ void gemm_naive(LAS unsigned char* lds, const bf16* A, int lda, const bf16* Bt, int M, int N, int K, const Epi& E, int vcu, int G) {
    LAS float* As = (LAS float*)lds;
    LAS float* Bs = As + 64 * 33;
    const int tid = otid();
    const int nM = M / 64, nN = N / 64;
    const int r = tid >> 3, cgp = tid & 7;
    for (int u = vcu; u < nM * nN; u += G) {
        const int pm = u / nN, pn = u % nN;
        float acc[8];
#pragma unroll
        for (int j = 0; j < 8; ++j) acc[j] = 0.f;
        for (int k0 = 0; k0 < K; k0 += 32) {
            { const int lr = tid >> 3, lc = (tid & 7) * 4;
              const v2u av = *(const v2u*)(A + (size_t)(pm * 64 + lr) * lda + k0 + lc);
              const v2u bv = *(const v2u*)(Bt + (size_t)(pn * 64 + lr) * K + k0 + lc);
              As[lr * 33 + lc + 0] = bflo(av.x); As[lr * 33 + lc + 1] = bfhi(av.x); As[lr * 33 + lc + 2] = bflo(av.y); As[lr * 33 + lc + 3] = bfhi(av.y);
              Bs[lr * 33 + lc + 0] = bflo(bv.x); Bs[lr * 33 + lc + 1] = bfhi(bv.x); Bs[lr * 33 + lc + 2] = bflo(bv.y); Bs[lr * 33 + lc + 3] = bfhi(bv.y); }
            __syncthreads();
#pragma unroll 8
            for (int kk = 0; kk < 32; ++kk) { const float a = As[r * 33 + kk];
#pragma unroll
                for (int j = 0; j < 8; ++j) acc[j] += a * Bs[(cgp * 8 + j) * 33 + kk]; }
            __syncthreads();
        }
        const int row = pm * 64 + r, col0 = pn * 64 + cgp * 8;
        const float rs = E.rowscale(row);
        float part = E.apply8(row, col0, acc, rs);
        part += __shfl_xor(part, 1); part += __shfl_xor(part, 2); part += __shfl_xor(part, 4);
        if (cgp == 0) E.store_part(row, col0, pn & 15, part);
    }
}

__device__ __forceinline__ void transpose_item(const float* W, const float* gain, int K, int N, bf16* WT, int row_off, LAS float* scr, int item, int lane) {
    const int nblk = N / 32, kb = item / nblk, nb = item % nblk, k0 = 64 * kb, n0 = 32 * nb;
#pragma unroll 8
    for (int i = 0; i < 32; ++i) { const int kk = 2 * i + (lane >> 5); const float g = gain ? gain[k0 + kk] : 1.f; scr[kk * 33 + (lane & 31)] = g * W[(size_t)(k0 + kk) * N + n0 + (lane & 31)]; }
    LDS_WAIT(); asm volatile("" ::: "memory");
    const int c = lane & 7;
#pragma unroll
    for (int j = 0; j < 4; ++j) { const int n = (lane >> 3) + 8 * j; const LAS float* s = scr + (8 * c) * 33 + n;
        v4u o; o.x = pk2(s[0 * 33], s[1 * 33]); o.y = pk2(s[2 * 33], s[3 * 33]); o.z = pk2(s[4 * 33], s[5 * 33]); o.w = pk2(s[6 * 33], s[7 * 33]);
        *(GAS v4u*)(WT + (size_t)(row_off + n0 + n) * K + k0 + 8 * c) = o; }
    LDS_WAIT(); asm volatile("" ::: "memory");
}

__device__ __forceinline__ void phase_conv(LAS unsigned char* lds, const Args& a, const LayerP& P, int L, int vcu, int G) {
    const int tid = otid(), lane = tid & 63, wave = __builtin_amdgcn_readfirstlane(tid >> 6);
    LAS float* scr = (LAS float*)(lds + wave * 16384);
    bf16* Wb = (bf16*)(a.ws + WS_W);
    const int gw = vcu * NWAVES + wave, NGW = G * NWAVES;
    const int nin_w = (P.kind == K_SGU) ? 2048 : 3072;
    const int I_IN = (D / 64) * (nin_w / 32), I_OUT = (D / 64) * (D / 32), I_1 = (D / 64) * (FF / 32), I_2 = (FF / 64) * (D / 32);
    const int NITEMS = I_IN + I_OUT + I_1 + I_2;
    for (int it = gw; it < NITEMS; it += NGW) {
        int r = it;
        if (r < I_IN) { transpose_item(P.w_in, P.norm1, D, nin_w, Wb + WOFF_IN, 0, scr, r, lane); continue; } r -= I_IN;
        if (r < I_OUT) { transpose_item(P.w_out, nullptr, D, D, Wb + WOFF_OUT, 0, scr, r, lane); continue; } r -= I_OUT;
        if (r < I_1) { transpose_item(P.w1, P.norm2, D, FF, Wb + WOFF_1, 0, scr, r, lane); continue; } r -= I_1;
        transpose_item(P.w2, nullptr, FF, D, Wb + WOFF_2, 0, scr, r, lane);
    }
    if (P.kind == K_GLA) {
        const float* W1 = P.e0; const float* W2 = P.e1;
        for (int e = vcu * NTHR + tid; e < 512 * 1024; e += G * NTHR) {
            const int n = e >> 10, k = e & 1023;
            float s = 0.f;
#pragma unroll
            for (int r = 0; r < 16; ++r) s += W1[k * 16 + r] * W2[r * 512 + n];
            Wb[WOFF_IN + (size_t)(3072 + n) * 1024 + k] = (bf16)f2bf(s * P.norm1[k]);
        }
    }
    if (L == 0) {
        const float* x = a.in[0]; bf16* xb = (bf16*)(a.ws + WS_XB); float* ssq = (float*)(a.ws + WS_SSQ);
        for (int m = gw; m < NTOK; m += NGW) {
            const f32x4* xr = (const f32x4*)(x + (size_t)m * D) + lane;
            f32x4 v[4]; float s = 0.f;
#pragma unroll
            for (int j = 0; j < 4; ++j) { v[j] = xr[64 * j]; s += (v[j].x * v[j].x + v[j].y * v[j].y) + (v[j].z * v[j].z + v[j].w * v[j].w); }
            s = wave_sum(s);
            v2u* o8 = (v2u*)(xb + (size_t)m * D) + lane;
#pragma unroll
            for (int j = 0; j < 4; ++j) { v2u w; w.x = pk2(v[j].x, v[j].y); w.y = pk2(v[j].z, v[j].w); o8[64 * j] = w; }
            if (lane < 16) ssq[(size_t)m * 16 + lane] = (lane == 0) ? s : 0.f;
        }
    }
}

__device__ __forceinline__ void phase_final(const Args& a, int vcu, int G) {
    const int tid = otid(), lane = tid & 63, wave = tid >> 6;
    const int gw = vcu * NWAVES + wave, NGW = G * NWAVES;
    const float* ssq = (const float*)(a.ws + WS_SSQ); const float* g = a.in[42];
    for (int m = gw; m < NTOK; m += NGW) {
        const float rs = row_rstd(ssq, m);
        f32x4* xr = (f32x4*)(a.out + (size_t)m * D) + lane; const f32x4* gr = (const f32x4*)g + lane;
#pragma unroll
        for (int j = 0; j < 4; ++j) { f32x4 v = xr[64 * j]; const f32x4 gg = gr[64 * j]; v.x *= rs * gg.x; v.y *= rs * gg.y; v.z *= rs * gg.z; v.w *= rs * gg.w; xr[64 * j] = v; }
    }
}

struct GlaCum { float b0[8], b1[8], tot0, tot1; };
__device__ __forceinline__ void gla_cumsum(GlaCum& c, const bf16* proj, int row0, int h, LAS float* TOT, int tid) {
    const int cp = tid & 63, part = tid >> 6;
#pragma unroll
    for (int i = 0; i < 8; ++i) { const unsigned w = *(const unsigned*)(proj + (size_t)(row0 + 8 * part + i) * GLA_PITCH + 3072 + h * 128 + 2 * cp); c.b0[i] = bflo(w); c.b1[i] = bfhi(w); }
#pragma unroll
    for (int i = 1; i < 8; ++i) { c.b0[i] += c.b0[i - 1]; c.b1[i] += c.b1[i - 1]; }
    TOT[part * 128 + 2 * cp] = c.b0[7]; TOT[part * 128 + 2 * cp + 1] = c.b1[7];
    __syncthreads();
    float o0 = 0.f, o1 = 0.f, t0 = 0.f, t1 = 0.f;
#pragma unroll
    for (int p = 0; p < 8; ++p) { const float x0 = TOT[p * 128 + 2 * cp], x1 = TOT[p * 128 + 2 * cp + 1]; if (p < part) { o0 += x0; o1 += x1; } t0 += x0; t1 += x1; }
#pragma unroll
    for (int i = 0; i < 8; ++i) { c.b0[i] += o0; c.b1[i] += o1; }
    c.tot0 = t0; c.tot1 = t1;
}
__device__ __forceinline__ void phase_gla_kv(LAS unsigned char* lds, const Args& a, int vcu, int G) {
    const int tid = otid();
    const bf16* proj = (const bf16*)(a.ws + WS_H); bf16* state = (bf16*)(a.ws + WS_STATE); float* dec = (float*)(a.ws + WS_DEC);
    LAS float* KE = (LAS float*)lds;
    LAS float* V = KE + 64 * 128;
    LAS float* TOT = V + 64 * 256;
    for (int u = vcu; u < NB * GLA_H * GLA_NC; u += G) {
        const int n = u % GLA_NC, bh = u / GLA_NC, h = bh % GLA_H, b = bh / GLA_H;
        const int row0 = b * T + n * GLA_C;
        GlaCum c; gla_cumsum(c, proj, row0, h, TOT, tid);
        const int cp = tid & 63, part = tid >> 6;
#pragma unroll
        for (int i = 0; i < 8; ++i) { const int t = 8 * part + i; const unsigned w = *(const unsigned*)(proj + (size_t)(row0 + t) * GLA_PITCH + 512 + h * 128 + 2 * cp);
            KE[t * 128 + 2 * cp] = bflo(w) * __expf(c.tot0 - c.b0[i]); KE[t * 128 + 2 * cp + 1] = bfhi(w) * __expf(c.tot1 - c.b1[i]); }
        if (part == 0) { dec[(size_t)u * 128 + 2 * cp] = __expf(c.tot0); dec[(size_t)u * 128 + 2 * cp + 1] = __expf(c.tot1); }
        { const int vp = tid & 127, rp = tid >> 7;
#pragma unroll
          for (int i = 0; i < 16; ++i) { const int t = 16 * rp + i; const unsigned w = *(const unsigned*)(proj + (size_t)(row0 + t) * GLA_PITCH + 1024 + h * 256 + 2 * vp);
              V[t * 256 + 2 * vp] = bflo(w); V[t * 256 + 2 * vp + 1] = bfhi(w); } }
        __syncthreads();
        const int vd = tid & 255, kh = tid >> 8;
        float acc[64];
#pragma unroll
        for (int j = 0; j < 64; ++j) acc[j] = 0.f;
        for (int t = 0; t < 64; ++t) { const float v = V[t * 256 + vd];
#pragma unroll
            for (int j = 0; j < 64; ++j) acc[j] += KE[t * 128 + kh * 64 + j] * v; }
        bf16* sp = state + ((size_t)u * 256 + vd) * 128 + kh * 64;
#pragma unroll
        for (int j = 0; j < 64; j += 8) { v4u w; w.x = pk2(acc[j], acc[j + 1]); w.y = pk2(acc[j + 2], acc[j + 3]); w.z = pk2(acc[j + 4], acc[j + 5]); w.w = pk2(acc[j + 6], acc[j + 7]); *(v4u*)(sp + j) = w; }
        __syncthreads();
    }
}
__device__ __forceinline__ void phase_gla_scan(const Args& a, int vcu, int G) {
    unsigned* state = (unsigned*)(a.ws + WS_STATE); const float* dec = (const float*)(a.ws + WS_DEC);
    for (int gid = vcu * NTHR + otid(); gid < NB * GLA_H * 16384; gid += G * NTHR) {
        const int bh = gid >> 14, e = gid & 16383, kp = e & 63;
        unsigned* sp = state + (size_t)bh * GLA_NC * 16384 + e;
        const float* dp = dec + (size_t)bh * GLA_NC * 128 + 2 * kp;
        float s0 = 0.f, s1 = 0.f;
        for (int n0 = 0; n0 < GLA_NC; n0 += 8) {
            unsigned w[8]; float d0[8], d1[8];
#pragma unroll
            for (int i = 0; i < 8; ++i) { w[i] = sp[(size_t)(n0 + i) * 16384]; d0[i] = dp[(n0 + i) * 128]; d1[i] = dp[(n0 + i) * 128 + 1]; }
#pragma unroll
            for (int i = 0; i < 8; ++i) { sp[(size_t)(n0 + i) * 16384] = pk2(s0, s1); s0 = d0[i] * s0 + bflo(w[i]); s1 = d1[i] * s1 + bfhi(w[i]); }
        }
    }
}
__device__ __forceinline__ void phase_gla_out(LAS unsigned char* lds, const Args& a, const LayerP& P, int vcu, int G) {
    const int tid = otid(), lane = tid & 63, wave = tid >> 6;
    bf16* proj = (bf16*)(a.ws + WS_H); const bf16* state = (const bf16*)(a.ws + WS_STATE);
    LAS float* QD = (LAS float*)lds;
    LAS float* KI = QD + 64 * 128;
    LAS float* ATT = KI + 64 * 128;
    LAS unsigned* Vb = (LAS unsigned*)(ATT + 64 * 64);
    LAS float* TOT = (LAS float*)(Vb + 64 * 128);
    LAS float* RSS = TOT + 8 * 128;
    for (int u = vcu; u < NB * GLA_H * GLA_NC; u += G) {
        const int n = u % GLA_NC, bh = u / GLA_NC, h = bh % GLA_H, b = bh / GLA_H;
        const int row0 = b * T + n * GLA_C;
        GlaCum c; gla_cumsum(c, proj, row0, h, TOT, tid);
        const int cp = tid & 63, part = tid >> 6;
#pragma unroll
        for (int i = 0; i < 8; ++i) { const int t = 8 * part + i;
            const unsigned wq = *(const unsigned*)(proj + (size_t)(row0 + t) * GLA_PITCH + h * 128 + 2 * cp);
            const unsigned wk = *(const unsigned*)(proj + (size_t)(row0 + t) * GLA_PITCH + 512 + h * 128 + 2 * cp);
            const float e0 = __expf(c.b0[i]), e1 = __expf(c.b1[i]);
            QD[t * 128 + 2 * cp] = bflo(wq) * 0.08838834764831845f * e0; QD[t * 128 + 2 * cp + 1] = bfhi(wq) * 0.08838834764831845f * e1;
            KI[t * 128 + 2 * cp] = bflo(wk) / e0; KI[t * 128 + 2 * cp + 1] = bfhi(wk) / e1; }
        { const int vp = tid & 127, rp = tid >> 7;
#pragma unroll
          for (int i = 0; i < 16; ++i) { const int t = 16 * rp + i; Vb[t * 128 + vp] = *(const unsigned*)(proj + (size_t)(row0 + t) * GLA_PITCH + 1024 + h * 256 + 2 * vp); } }
        __syncthreads();
        { const int cc = tid >> 3, s0 = (tid & 7) * 8; float acc[8];
#pragma unroll
          for (int j = 0; j < 8; ++j) acc[j] = 0.f;
          for (int d = 0; d < 128; ++d) { const float q = QD[cc * 128 + d];
#pragma unroll
              for (int j = 0; j < 8; ++j) acc[j] += q * KI[(s0 + j) * 128 + d]; }
#pragma unroll
          for (int j = 0; j < 8; ++j) ATT[cc * 64 + s0 + j] = (s0 + j <= cc) ? acc[j] : 0.f; }
        __syncthreads();
        const int vd = tid & 255, ch = tid >> 8;
        float acc[32];
#pragma unroll
        for (int j = 0; j < 32; ++j) acc[j] = 0.f;
        for (int s = 0; s < 64; ++s) { const unsigned w = Vb[s * 128 + (vd >> 1)]; const float v = (vd & 1) ? bfhi(w) : bflo(w);
#pragma unroll
            for (int j = 0; j < 32; ++j) acc[j] += ATT[(ch * 32 + j) * 64 + s] * v; }
        { const bf16* sp = state + ((size_t)u * 256 + vd) * 128;
          for (int d0 = 0; d0 < 128; d0 += 8) { const v4u w = *(const v4u*)(sp + d0);
              const float st[8] = {bflo(w.x), bfhi(w.x), bflo(w.y), bfhi(w.y), bflo(w.z), bfhi(w.z), bflo(w.w), bfhi(w.w)};
#pragma unroll
              for (int dd = 0; dd < 8; ++dd) {
#pragma unroll
                  for (int j = 0; j < 32; ++j) acc[j] += QD[(ch * 32 + j) * 128 + d0 + dd] * st[dd]; } } }
#pragma unroll
        for (int j = 0; j < 32; ++j) { const float s = wave_sum(acc[j] * acc[j]); if (lane == 0) RSS[wave * 32 + j] = s; }
        __syncthreads();
        const float hn = P.e3[vd];
#pragma unroll
        for (int j = 0; j < 32; ++j) { const int cc = ch * 32 + j;
            const float ss = (RSS[(ch * 4 + 0) * 32 + j] + RSS[(ch * 4 + 1) * 32 + j]) + (RSS[(ch * 4 + 2) * 32 + j] + RSS[(ch * 4 + 3) * 32 + j]);
            const float rs = 1.0f / sqrtf(ss * (1.0f / 256.0f) + EPS);
            const float g = bf2f(proj[(size_t)(row0 + cc) * GLA_PITCH + 2048 + h * 256 + vd]);
            const float o = acc[j] * rs * hn * (g / (1.f + __expf(-g)));
            proj[(size_t)(row0 + cc) * GLA_PITCH + 1024 + h * 256 + vd] = (bf16)f2bf(o); }
        __syncthreads();
    }
}

__device__ __forceinline__ void phase_sgu(LAS unsigned char* lds, const Args& a, const LayerP& P, int vcu, int G) {
    const int tid = otid();
    bf16* proj = (bf16*)(a.ws + WS_H); const float* vssq = (const float*)(a.ws + WS_VSSQ);
    const float* v_norm = P.e1; const float* w_s = P.e2; const float* b_s = P.e3;
    LAS float* W = (LAS float*)lds;
    LAS float* V = W + 128 * 128;
    for (int u = vcu; u < NB * (T / SGU_C) * SGU_G; u += G) {
        const int g = u % SGU_G, bc = u / SGU_G;
        const int row0 = bc * SGU_C;
        for (int e = tid; e < 128 * 128; e += NTHR) { const int t = e >> 7, s = e & 127;
            const float rs = row_rstd(vssq, row0 + s);
            W[e] = (s <= t) ? w_s[(size_t)g * 16384 + e] * rs : 0.f;
            V[e] = bf2f(proj[(size_t)(row0 + t) * SGU_PITCH + 1024 + g * 128 + s]); }
        __syncthreads();
        const int d = tid & 127, tq = tid >> 7;
        float acc[32];
#pragma unroll
        for (int j = 0; j < 32; ++j) acc[j] = 0.f;
        for (int s = 0; s < 128; ++s) { const float v = V[s * 128 + d];
#pragma unroll
            for (int j = 0; j < 32; ++j) acc[j] += W[(tq + 4 * j) * 128 + s] * v; }
        const float vn = v_norm[g * 128 + d];
#pragma unroll
        for (int j = 0; j < 32; ++j) { const int t = tq + 4 * j;
            const float sv = vn * acc[j] + b_s[g * 128 + t];
            bf16* up = proj + (size_t)(row0 + t) * SGU_PITCH + g * 128 + d;
            *up = (bf16)f2bf(bf2f(*up) * sv); }
        __syncthreads();
    }
}

__device__ __forceinline__ void phase_diff(LAS unsigned char* lds, const Args& a, const LayerP& P, int vcu, int G) {
    const int tid = otid(), lane = tid & 63, wave = tid >> 6;
    bf16* proj = (bf16*)(a.ws + WS_H);
    LAS float* Ks = (LAS float*)lds;
    LAS float* Vs = Ks + 64 * 132;
    LAS float* Qs = Vs + 64 * 128;
    LAS float* Ps = Qs + 32 * 128;
    float lam;
    { float s1 = 0.f, s2 = 0.f;
      for (int i = 0; i < 64; ++i) { s1 += P.e0[i] * P.e1[i]; s2 += P.e2[i] * P.e3[i]; }
      lam = __expf(s1) - __expf(s2) + LAMBDA_INIT; }
    const float* head_norm = P.e4;
    const int NU = NB * DIFF_H * (T / 32);
    for (int u = vcu; u < NU; u += G) {
        const int qb = (T / 32 - 1) - (u / (NB * DIFF_H)), bh = u % (NB * DIFF_H), h = bh % DIFF_H, b = bh / DIFF_H;
        const int q0 = qb * 32; const size_t rowbase = (size_t)b * T;
        const float slope2 = exp2f(-(float)(h + 1)) * LOG2E;
        __syncthreads();
        for (int e = tid; e < 32 * 64; e += NTHR) { const int r = e >> 6, c2 = e & 63;
            const unsigned w = *(const unsigned*)(proj + (rowbase + q0 + r) * DIFF_PITCH + h * 128 + 2 * c2);
            Qs[r * 128 + 2 * c2] = bflo(w); Qs[r * 128 + 2 * c2 + 1] = bfhi(w); }
        float m1[4], l1[4], m2[4], l2[4], oa1[4], ob1[4], oa2[4], ob2[4];
#pragma unroll
        for (int i = 0; i < 4; ++i) { m1[i] = -1e30f; m2[i] = -1e30f; l1[i] = 0.f; l2[i] = 0.f; oa1[i] = 0.f; ob1[i] = 0.f; oa2[i] = 0.f; ob2[i] = 0.f; }
        const int ntile = (q0 + 31) / 64 + 1;
        for (int kt = 0; kt < ntile; ++kt) {
            __syncthreads();
            for (int e = tid; e < 64 * 64; e += NTHR) { const int r = e >> 6, c2 = e & 63;
                const unsigned wk = *(const unsigned*)(proj + (rowbase + kt * 64 + r) * DIFF_PITCH + 1024 + h * 128 + 2 * c2);
                const unsigned wv = *(const unsigned*)(proj + (rowbase + kt * 64 + r) * DIFF_PITCH + 2048 + h * 128 + 2 * c2);
                Ks[r * 132 + 2 * c2] = bflo(wk); Ks[r * 132 + 2 * c2 + 1] = bfhi(wk);
                Vs[r * 128 + 2 * c2] = bflo(wv); Vs[r * 128 + 2 * c2 + 1] = bfhi(wv); }
            __syncthreads();
            const int kpos = kt * 64 + lane;
#pragma unroll
            for (int i = 0; i < 4; ++i) {
                const int r = wave + 8 * i, qpos = q0 + r;
                if (kt * 64 > qpos) continue;
                float s1 = 0.f, s2 = 0.f;
                const LAS f32x4* qp = (const LAS f32x4*)(Qs + r * 128); const LAS f32x4* kp = (const LAS f32x4*)(Ks + lane * 132);
#pragma unroll
                for (int d = 0; d < 16; ++d) { const f32x4 q = qp[d], k = kp[d]; s1 += (q.x * k.x + q.y * k.y) + (q.z * k.z + q.w * k.w); }
#pragma unroll
                for (int d = 16; d < 32; ++d) { const f32x4 q = qp[d], k = kp[d]; s2 += (q.x * k.x + q.y * k.y) + (q.z * k.z + q.w * k.w); }
                const float bias = slope2 * (float)(qpos - kpos);
                const bool ok = kpos <= qpos;
                s1 = ok ? s1 - bias : -1e30f; s2 = ok ? s2 - bias : -1e30f;
                const float mn1 = fmaxf(m1[i], wave_max(s1)), mn2 = fmaxf(m2[i], wave_max(s2));
                const float p1 = ok ? exp2f(s1 - mn1) : 0.f, p2 = ok ? exp2f(s2 - mn2) : 0.f;
                const float a1 = exp2f(m1[i] - mn1), a2 = exp2f(m2[i] - mn2);
                l1[i] = l1[i] * a1 + wave_sum(p1); l2[i] = l2[i] * a2 + wave_sum(p2); m1[i] = mn1; m2[i] = mn2;
                Ps[wave * 128 + lane] = p1; Ps[wave * 128 + 64 + lane] = p2;
                LDS_WAIT();
                float x1 = 0.f, y1 = 0.f, x2 = 0.f, y2 = 0.f;
                for (int j = 0; j < 64; ++j) { const float pa = Ps[wave * 128 + j], pb = Ps[wave * 128 + 64 + j]; const float va = Vs[j * 128 + lane], vb = Vs[j * 128 + 64 + lane];
                    x1 += pa * va; y1 += pa * vb; x2 += pb * va; y2 += pb * vb; }
                oa1[i] = oa1[i] * a1 + x1; ob1[i] = ob1[i] * a1 + y1; oa2[i] = oa2[i] * a2 + x2; ob2[i] = ob2[i] * a2 + y2;
                LDS_WAIT();
            }
        }
#pragma unroll
        for (int i = 0; i < 4; ++i) {
            const int r = wave + 8 * i;
            const float oa = oa1[i] / l1[i] - lam * (oa2[i] / l2[i]), ob = ob1[i] / l1[i] - lam * (ob2[i] / l2[i]);
            const float ss = wave_sum(oa * oa + ob * ob);
            const float rs = (1.0f / sqrtf(ss * (1.0f / 128.0f) + EPS)) * (1.0f - LAMBDA_INIT);
            bf16* op = proj + (rowbase + q0 + r) * DIFF_PITCH + h * 128;
            op[lane] = (bf16)f2bf(oa * rs * head_norm[lane]); op[64 + lane] = (bf16)f2bf(ob * rs * head_norm[64 + lane]);
        }
    }
}

constexpr int PH_PER_LAYER = 8, NPHASE = 4 * PH_PER_LAYER + 1;
__host__ __device__ inline bool phase_is_noop(int ph) {
    if (ph >= 4 * PH_PER_LAYER) return false;
    const int L = ph / PH_PER_LAYER, s = ph % PH_PER_LAYER;
    const bool gla = (L == 0 || L == 3);
    return (s == 3 || s == 4) && !gla;
}

__global__ void __launch_bounds__(NTHR, 2) trunk_fwd(Args args) {
    extern __shared__ __attribute__((aligned(16))) unsigned char lds_raw[];
    LAS unsigned char* lds = (LAS unsigned char*)lds_raw;
    const int tid = threadIdx.x;
    const int G0 = gridDim.x; const int bx = blockIdx.x;
    const int vcu0 = (G0 % 8 == 0) ? (bx % 8) * (G0 / 8) + bx / 8 : bx;
    for (int u = tid; u < (LDS_BYTES - LDSCTL_OFF) / 4; u += NTHR) ((LAS unsigned*)(lds + LDSCTL_OFF))[u] = 0u;
    __syncthreads();
    unsigned* ctl = (unsigned*)(args.ws + WS_CTL);
    XcdBarrier bar; bar.bar = ctl + 4096; bar.x = 0; bar.st = nullptr;
    const bool multi = (args.ph_hi - args.ph_lo) > 1;
    if (multi) bar = xcd_barrier_post(ctl + 4096, (volatile LAS unsigned*)(lds + MISC_OFF) + 8);
    bf16* Wb = (bf16*)(args.ws + WS_W); bf16* XB = (bf16*)(args.ws + WS_XB); bf16* HB = (bf16*)(args.ws + WS_H);
    float* SSQ = (float*)(args.ws + WS_SSQ); float* VSSQ = (float*)(args.ws + WS_VSSQ);
    bool first_seam = true;
    for (int ph = args.ph_lo; ph < args.ph_hi; ++ph) {
        if (phase_is_noop(ph)) continue;
        int vcu = vcu0, G = G0; asm volatile("" : "+s"(vcu), "+s"(G));
        if (ph == 4 * PH_PER_LAYER) { phase_final(args, vcu, G); }
        else {
            const int L = ph / PH_PER_LAYER, s = ph % PH_PER_LAYER;
            const LayerP P = layer_params(L);
            if (s == 0) phase_conv(lds, args, P, L, vcu, G);
            else if (s == 1) { EpiIn E{P.kind, HB, SSQ, (P.kind == K_GLA) ? P.e2 : P.e0, VSSQ}; gemm_naive(lds, XB, D, Wb + WOFF_IN, NTOK, P.nin, D, E, vcu, G); }
            else if (s == 2) { if (P.kind == K_GLA) phase_gla_kv(lds, args, vcu, G); else if (P.kind == K_DIFF) phase_diff(lds, args, P, vcu, G); else phase_sgu(lds, args, P, vcu, G); }
            else if (s == 3) phase_gla_scan(args, vcu, G);
            else if (s == 4) phase_gla_out(lds, args, P, vcu, G);
            else if (s == 5) { EpiRes E{(L == 0) ? args.in[0] : args.out, args.out, XB, SSQ}; gemm_naive(lds, HB + P.mixoff, P.nin, Wb + WOFF_OUT, NTOK, D, D, E, vcu, G); }
            else if (s == 6) { EpiHid E{HB, SSQ}; gemm_naive(lds, XB, D, Wb + WOFF_1, NTOK, FF, D, E, vcu, G); }
            else { EpiRes E{args.out, args.out, XB, SSQ}; gemm_naive(lds, HB, FF, Wb + WOFF_2, NTOK, D, FF, E, vcu, G); }
        }
        if (ph + 1 < args.ph_hi) {
            if (first_seam) { cg::this_grid().sync(); first_seam = false; }
            else xcd_barrier(bar);
        }
    }
}

extern "C" void kernel_launch(void* const* d_in, const int* in_sizes, int n_in, void* d_out, int out_size, void* d_ws, size_t ws_size, hipStream_t stream) {
    static int grid = 0;
    if (grid == 0) {
        if (n_in != 43 || in_sizes[0] != NTOK * D || out_size != NTOK * D || ws_size < WS_END) {
            fprintf(stderr, "kernel_launch: unexpected problem (n_in %d, in0 %d, out %d, ws %zu); nothing launched\n", n_in, n_in > 0 ? in_sizes[0] : -1, out_size, ws_size); grid = -1; return; }
        int dev = 0, cus = 0, per_cu = 0;
        if (hipGetDevice(&dev) != hipSuccess || hipDeviceGetAttribute(&cus, hipDeviceAttributeMultiprocessorCount, dev) != hipSuccess) { grid = -1; return; }
        if (hipFuncSetAttribute((const void*)trunk_fwd, hipFuncAttributeMaxDynamicSharedMemorySize, LDS_BYTES) != hipSuccess) { fprintf(stderr, "kernel_launch: hipFuncSetAttribute failed\n"); grid = -1; return; }
        if (hipOccupancyMaxActiveBlocksPerMultiprocessor(&per_cu, (const void*)trunk_fwd, NTHR, LDS_BYTES) != hipSuccess || per_cu < 1) { fprintf(stderr, "kernel_launch: occupancy query says %d blocks/CU\n", per_cu); per_cu = 1; }
        (void)hipGetLastError();
        grid = cus;
    }
    if (grid < 0) return;
    (void)hipMemsetAsync((char*)d_ws + WS_CTL, 0, CTL_ZERO_BYTES, stream);
    Args a{};
    for (int i = 0; i < 43; ++i) a.in[i] = (const float*)d_in[i];
    a.out = (float*)d_out; a.ws = (unsigned char*)d_ws;
#if MK_ONE_LAUNCH
    a.ph_lo = 0; a.ph_hi = NPHASE;
    void* kargs[] = {&a};
    hipError_t e = hipLaunchCooperativeKernel((const void*)trunk_fwd, dim3(grid), dim3(NTHR), kargs, LDS_BYTES, stream);
    if (e != hipSuccess) fprintf(stderr, "kernel_launch: cooperative launch failed: %s (grid %d)\n", hipGetErrorString(e), grid);
#else
    for (int ph = 0; ph < NPHASE; ++ph) {
        if (phase_is_noop(ph)) continue;
        a.ph_lo = ph; a.ph_hi = ph + 1;
        hipLaunchKernelGGL(trunk_fwd, dim3(grid), dim3(NTHR), LDS_BYTES, stream, a);
    }
#endif
}
```

```cpp
#include <hip/hip_runtime.h>
#include <hip/hip_cooperative_groups.h>
#include <cstdio>
#include <cstdint>
namespace cg = cooperative_groups;

#ifndef MK_ONE_LAUNCH
#define MK_ONE_LAUNCH 1
#endif

#define GAS __attribute__((address_space(1)))
#define LAS __attribute__((address_space(3)))
typedef unsigned short bf16;
typedef unsigned v4u __attribute__((ext_vector_type(4)));
typedef unsigned v2u __attribute__((ext_vector_type(2)));
typedef float f32x4 __attribute__((ext_vector_type(4)));

constexpr int NB = 2, T = 8192, D = 1024, NTOK = NB * T, FF = 4096;
constexpr float EPS = 1e-6f;
constexpr float LOG2E = 1.4426950408889634f;
constexpr int NWAVES = 8, NTHR = 512;
constexpr int K_GLA = 0, K_DIFF = 1, K_SGU = 2;
constexpr int GLA_H = 4, GLA_HK = 128, GLA_HV = 256, GLA_C = 64, GLA_NC = T / GLA_C;
constexpr int GLA_PITCH = 3584;
constexpr int DIFF_H = 8, DIFF_PITCH = 3072;
constexpr float LAMBDA_INIT = 0.35551069f;
constexpr int SGU_PITCH = 2048, SGU_C = 128, SGU_G = 8;

constexpr size_t MiB = 1u << 20;
constexpr size_t WS_CTL = 0, CTL_ZERO_BYTES = 1 * MiB;
constexpr size_t WS_SSQ = 1 * MiB;
constexpr size_t WS_VSSQ = 2 * MiB;
constexpr size_t WS_DEC = 3 * MiB;
constexpr size_t WS_W = 4 * MiB;
constexpr size_t WS_XB = 29 * MiB;
constexpr size_t WS_STATE = 61 * MiB;
constexpr size_t WS_H = 125 * MiB;
constexpr size_t WS_END = 253 * MiB;
constexpr size_t WOFF_IN = 0, WOFF_OUT = (size_t)3584 * 1024, WOFF_1 = WOFF_OUT + (size_t)1024 * 1024, WOFF_2 = WOFF_1 + (size_t)4096 * 1024;

constexpr int RING_BYTES = 131072, LDSCTL_OFF = RING_BYTES, MISC_OFF = LDSCTL_OFF + 320, LDS_BYTES = 147456;

#define RLX_AGENT __ATOMIC_RELAXED, __HIP_MEMORY_SCOPE_AGENT
#define LDS_WAIT() asm volatile("s_waitcnt lgkmcnt(0)" ::: "memory")
__device__ __forceinline__ unsigned f2bf(float f) { unsigned u = __builtin_bit_cast(unsigned, f); return (u + 0x7fffu + ((u >> 16) & 1u)) >> 16; }
__device__ __forceinline__ unsigned pk2(float lo, float hi) { return f2bf(lo) | (f2bf(hi) << 16); }
__device__ __forceinline__ float bf2f(unsigned b) { return __builtin_bit_cast(float, b << 16); }
__device__ __forceinline__ float bflo(unsigned w) { return __builtin_bit_cast(float, w << 16); }
__device__ __forceinline__ float bfhi(unsigned w) { return __builtin_bit_cast(float, w & 0xffff0000u); }
__device__ __forceinline__ int otid() { int t = threadIdx.x; asm volatile("" : "+v"(t)); return t; }
__device__ __forceinline__ float wave_sum(float v) {
#pragma unroll
    for (int o = 1; o < 64; o <<= 1) v += __shfl_xor(v, o);
    return v;
}
__device__ __forceinline__ float wave_max(float v) {
#pragma unroll
    for (int o = 1; o < 64; o <<= 1) v = fmaxf(v, __shfl_xor(v, o));
    return v;
}
__device__ __forceinline__ float gelu_tanh(float x) {
    const float u = 0.7978845608028654f * (x + 0.044715f * x * x * x);
    const float e = __expf(2.f * u);
    const float t = 1.f - 2.f / (e + 1.f);
    return 0.5f * x * (1.f + t);
}
__device__ __forceinline__ float log_sigmoid(float z) { return fminf(z, 0.f) - log1pf(__expf(-fabsf(z))); }

#define XB_TMO      128
#define XB_XCNT(j)  (256  + 64 * (j))
#define XB_XSUB(j)  (1280 + 64 * (j))
#define XB_XGEN(j)  (2304 + 64 * (j))
#define XB_TOP      3328
#define XB_TOPGEN   3392
#define XCD_BAR_WORDS 3456
#define XB_SPIN_CAP (1u << 22)
__device__ __forceinline__ unsigned xb_ld(unsigned* p)              { return __hip_atomic_load(p, __ATOMIC_RELAXED, __HIP_MEMORY_SCOPE_AGENT); }
__device__ __forceinline__ unsigned xb_add(unsigned* p, unsigned v) { return __hip_atomic_fetch_add(p, v, __ATOMIC_RELAXED, __HIP_MEMORY_SCOPE_AGENT); }
__device__ __forceinline__ unsigned xb_xcc_id() { return (unsigned)__builtin_amdgcn_s_getreg((3 << 11) | 20) & 0xFu; }
#define XB_SPIN(cond, bar) do { unsigned _sp = 0; while (cond) { __builtin_amdgcn_s_sleep(1); \
    if ((++_sp & 255u) == 0u) { if (xb_ld(&(bar)[XB_TMO])) break; if (_sp > XB_SPIN_CAP) { atomicAdd(&(bar)[XB_TMO], 1u); break; } } } } while (0)
struct XcdBarrier { unsigned* bar; unsigned x; volatile LAS unsigned* st; };
__device__ __forceinline__ XcdBarrier xcd_barrier_post(unsigned* bar, volatile LAS unsigned* st) {
    XcdBarrier b; b.bar = bar; b.x = xb_xcc_id(); b.st = st;
    if (threadIdx.x == 0) (void)xb_add(&bar[XB_XCNT(b.x)], 1u);
    return b;
}
__device__ __forceinline__ void xcd_barrier_complete(unsigned* bar, unsigned x, unsigned& nloc, unsigned& nx) {
    const unsigned G = gridDim.x * gridDim.y * gridDim.z;
    unsigned sum, cnt, mine, sp = 0u;
    for (;;) {
        sum = 0u; cnt = 0u; mine = 0u;
#pragma unroll
        for (unsigned j = 0; j < 16; ++j) { const unsigned c = xb_ld(&bar[XB_XCNT(j)]); sum += c; cnt += (c > 0u) ? 1u : 0u; mine = (j == x) ? c : mine; }
        if (sum == G) break;
        __builtin_amdgcn_s_sleep(1);
        if ((++sp & 255u) == 0u) { if (xb_ld(&bar[XB_TMO])) break; if (sp > XB_SPIN_CAP) { atomicAdd(&bar[XB_TMO], 1u); break; } }
    }
    nloc = mine > 0u ? mine : 1u; nx = cnt > 0u ? cnt : 1u;
}
__device__ __forceinline__ void xcd_barrier(const XcdBarrier& b) {
    asm volatile("s_waitcnt vmcnt(0)" ::: "memory");
    __syncthreads();
    if (threadIdx.x == 0) {
        unsigned* bar = b.bar;
        __builtin_amdgcn_s_waitcnt(0);
        unsigned nloc = b.st[0], nx = b.st[1];
        if (nloc == 0u) { xcd_barrier_complete(bar, b.x, nloc, nx); b.st[0] = nloc; b.st[1] = nx; }
        const unsigned old = xb_add(&bar[XB_XSUB(b.x)], 1u);
        const unsigned gen = old / nloc;
        if (old + 1u == (gen + 1u) * nloc) {
            __builtin_amdgcn_fence(__ATOMIC_RELEASE, "agent");
            asm volatile("s_waitcnt vmcnt(0)" ::: "memory");
            const unsigned og = xb_add(&bar[XB_TOP], 1u);
            const unsigned tg = og / nx;
            if (og + 1u == (tg + 1u) * nx) xb_add(&bar[XB_TOPGEN], 1u);
            else XB_SPIN(xb_ld(&bar[XB_TOPGEN]) == tg, bar);
            __builtin_amdgcn_fence(__ATOMIC_ACQUIRE, "agent");
            xb_add(&bar[XB_XGEN(b.x)], 1u);
            asm volatile("s_waitcnt vmcnt(0)" ::: "memory");
        } else {
            XB_SPIN(xb_ld(&bar[XB_XGEN(b.x)]) == gen, bar);
            __builtin_amdgcn_fence(__ATOMIC_ACQUIRE, "agent");
            asm volatile("s_waitcnt vmcnt(0)" ::: "memory");
        }
    }
    __syncthreads();
}

struct Args { const float* in[43]; float* out; unsigned char* ws; int ph_lo, ph_hi; };
struct Ctx { const float* in0; const float* in42; float* out; unsigned char* ws; };
struct LayerP {
    int kind;
    const float *norm1, *w_in, *w_out, *norm2, *w1, *w2;
    const float *e0, *e1, *e2, *e3, *e4;
    int nin;
    int mixoff;
};
typedef const float* cfptr;
#define CAS __attribute__((address_space(4)))
__device__ __forceinline__ LayerP layer_params(const CAS cfptr* in, int L) {
    LayerP p;
    const int base = (L == 0) ? 1 : (L == 1) ? 11 : (L == 2) ? 22 : 32;
    p.kind = (L == 1) ? K_DIFF : (L == 2) ? K_SGU : K_GLA;
    const int sh = (p.kind == K_DIFF) ? 1 : 0;
    p.norm1 = in[base]; p.w_in = in[base + 1];
    p.e0 = in[base + 2]; p.e1 = in[base + 3]; p.e2 = in[base + 4]; p.e3 = in[base + 5]; p.e4 = in[base + 6];
    p.w_out = in[base + 6 + sh]; p.norm2 = in[base + 7 + sh]; p.w1 = in[base + 8 + sh]; p.w2 = in[base + 9 + sh];
    p.nin = (p.kind == K_GLA) ? GLA_PITCH : (p.kind == K_DIFF) ? DIFF_PITCH : SGU_PITCH;
    p.mixoff = (p.kind == K_GLA) ? 1024 : 0;
    return p;
}

__device__ __forceinline__ float row_rstd(const float* ssq, int row) {
    const f32x4* p = (const f32x4*)(ssq + (size_t)row * 16);
    const f32x4 a = p[0], b = p[1], c = p[2], d = p[3];
    const float s = ((a.x + a.y) + (a.z + a.w)) + ((b.x + b.y) + (b.z + b.w)) + ((c.x + c.y) + (c.z + c.w)) + ((d.x + d.y) + (d.z + d.w));
    return 1.0f / sqrtf(s * (1.0f / D) + EPS);
}

struct EpiIn {
    int kind; bf16* proj; const float* ssq; const float* bias;
    float* vssq;
    __device__ __forceinline__ float rowscale(int row) const { return row_rstd(ssq, row); }
    __device__ __forceinline__ float apply8(int row, int col0, const float (&v)[8], float rs) const {
        float o[8]; float part = 0.f; int pitch;
        if (kind == K_GLA) { pitch = GLA_PITCH;
            if (col0 < 3072) {
#pragma unroll
                for (int j = 0; j < 8; ++j) o[j] = v[j] * rs;
            } else {
#pragma unroll
                for (int j = 0; j < 8; ++j) o[j] = log_sigmoid(v[j] * rs + bias[col0 - 3072 + j]) * (1.0f / 16.0f);
            }
        } else if (kind == K_DIFF) { pitch = DIFF_PITCH;
            const float sc = (col0 < 1024) ? rs * (0.125f * LOG2E) : rs;
#pragma unroll
            for (int j = 0; j < 8; ++j) o[j] = v[j] * sc;
        } else { pitch = SGU_PITCH;
#pragma unroll
            for (int j = 0; j < 8; ++j) { o[j] = gelu_tanh(v[j] * rs + bias[col0 + j]); }
            if (col0 >= 1024) {
#pragma unroll
                for (int j = 0; j < 8; ++j) part += o[j] * o[j];
            }
        }
        v4u w; w.x = pk2(o[0], o[1]); w.y = pk2(o[2], o[3]); w.z = pk2(o[4], o[5]); w.w = pk2(o[6], o[7]);
        *(v4u*)(proj + (size_t)row * pitch + col0) = w;
        return part;
    }
    __device__ __forceinline__ void store_part(int row, int col0, int idx, float part) const {
        if (kind == K_SGU && col0 >= 1024) vssq[(size_t)row * 16 + idx] = part;
    }
};
struct EpiHid {
    bf16* h; const float* ssq;
    __device__ __forceinline__ float rowscale(int row) const { return row_rstd(ssq, row); }
    __device__ __forceinline__ float apply8(int row, int col0, const float (&v)[8], float rs) const {
        float o[8];
#pragma unroll
        for (int j = 0; j < 8; ++j) { const float a = fmaxf(v[j] * rs, 0.f); o[j] = a * a; }
        v4u w; w.x = pk2(o[0], o[1]); w.y = pk2(o[2], o[3]); w.z = pk2(o[4], o[5]); w.w = pk2(o[6], o[7]);
        *(v4u*)(h + (size_t)row * FF + col0) = w;
        return 0.f;
    }
    __device__ __forceinline__ void store_part(int, int, int, float) const {}
};
struct EpiRes {
    const float* base; float* x; bf16* xb; float* ssq;
    __device__ __forceinline__ float rowscale(int) const { return 1.f; }
    __device__ __forceinline__ float apply8(int row, int col0, const float (&v)[8], float) const {
        const size_t off = (size_t)row * D + col0;
        const f32x4 b0 = *(const f32x4*)(base + off), b1 = *(const f32x4*)(base + off + 4);
        float o[8] = {b0.x + v[0], b0.y + v[1], b0.z + v[2], b0.w + v[3], b1.x + v[4], b1.y + v[5], b1.z + v[6], b1.w + v[7]};
        *(f32x4*)(x + off) = (f32x4){o[0], o[1], o[2], o[3]}; *(f32x4*)(x + off + 4) = (f32x4){o[4], o[5], o[6], o[7]};
        v4u w; w.x = pk2(o[0], o[1]); w.y = pk2(o[2], o[3]); w.z = pk2(o[4], o[5]); w.w = pk2(o[6], o[7]);
        *(v4u*)(xb + off) = w;
        float part = 0.f;
#pragma unroll
        for (int j = 0; j < 8; ++j) part += o[j] * o[j];
        return part;
    }
    __device__ __forceinline__ void store_part(int row, int, int idx, float part) const { ssq[(size_t)row * 16 + idx] = part; }
};

template <class Epi>
__device__ __forceinline__ void gemm_naive(LAS unsigned char* lds, const bf16* A, int lda, const bf16* Bt, int M, int N, int K, const Epi& E, int vcu, int G) {
    LAS float* As = (LAS float*)lds;
    LAS float* Bs = As + 64 * 33;
    const int tid = otid();
    const int nM = M / 64, nN = N / 64;
    const int r = tid >> 3, cgp = tid & 7;
    for (int u = vcu; u < nM * nN; u += G) {
        const int pm = u / nN, pn = u % nN;
        float acc[8];
#pragma unroll
        for (int j = 0; j < 8; ++j) acc[j] = 0.f;
        for (int k0 = 0; k0 < K; k0 += 32) {
            { const int lr = tid >> 3, lc = (tid & 7) * 4;
              const v2u av = *(const v2u*)(A + (size_t)(pm * 64 + lr) * lda + k0 + lc);
              const v2u bv = *(const v2u*)(Bt + (size_t)(pn * 64 + lr) * K + k0 + lc);
              As[lr * 33 + lc + 0] = bflo(av.x); As[lr * 33 + lc + 1] = bfhi(av.x); As[lr * 33 + lc + 2] = bflo(av.y); As[lr * 33 + lc + 3] = bfhi(av.y);
              Bs[lr * 33 + lc + 0] = bflo(bv.x); Bs[lr * 33 + lc + 1] = bfhi(bv.x); Bs[lr * 33 + lc + 2] = bflo(bv.y); Bs[lr * 33 + lc + 3] = bfhi(bv.y); }
            __syncthreads();
#pragma unroll 8
            for (int kk = 0; kk < 32; ++kk) { const float a = As[r * 33 + kk];
#pragma unroll
                for (int j = 0; j < 8; ++j) acc[j] += a * Bs[(cgp * 8 + j) * 33 + kk]; }
            __syncthreads();
        }
        const int row = pm * 64 + r, col0 = pn * 64 + cgp * 8;
        const float rs = E.rowscale(row);
        float part = E.apply8(row, col0, acc, rs);
        part += __shfl_xor(part, 1); part += __shfl_xor(part, 2); part += __shfl_xor(part, 4);
        if (cgp == 0) E.store_part(row, col0, pn & 15, part);
    }
}

__device__ __forceinline__ void transpose_item(const float* W, const float* gain, int K, int N, bf16* WT, int row_off, LAS float* scr, int item, int lane) {
    const int nblk = N / 32, kb = item / nblk, nb = item % nblk, k0 = 64 * kb, n0 = 32 * nb;
#pragma unroll 8
    for (int i = 0; i < 32; ++i) { const int kk = 2 * i + (lane >> 5); const float g = gain ? gain[k0 + kk] : 1.f; scr[kk * 33 + (lane & 31)] = g * W[(size_t)(k0 + kk) * N + n0 + (lane & 31)]; }
    LDS_WAIT(); asm volatile("" ::: "memory");
    const int c = lane & 7;
#pragma unroll
    for (int j = 0; j < 4; ++j) { const int n = (lane >> 3) + 8 * j; const LAS float* s = scr + (8 * c) * 33 + n;
        v4u o; o.x = pk2(s[0 * 33], s[1 * 33]); o.y = pk2(s[2 * 33], s[3 * 33]); o.z = pk2(s[4 * 33], s[5 * 33]); o.w = pk2(s[6 * 33], s[7 * 33]);
        *(GAS v4u*)(WT + (size_t)(row_off + n0 + n) * K + k0 + 8 * c) = o; }
    LDS_WAIT(); asm volatile("" ::: "memory");
}

__device__ __forceinline__ void phase_conv(LAS unsigned char* lds, const Ctx& a, const LayerP& P, int L, int vcu, int G) {
    const int tid = otid(), lane = tid & 63, wave = __builtin_amdgcn_readfirstlane(tid >> 6);
    LAS float* scr = (LAS float*)(lds + wave * 16384);
    bf16* Wb = (bf16*)(a.ws + WS_W);
    const int gw = vcu * NWAVES + wave, NGW = G * NWAVES;
    const int nin_w = (P.kind == K_SGU) ? 2048 : 3072;
    const int I_IN = (D / 64) * (nin_w / 32), I_OUT = (D / 64) * (D / 32), I_1 = (D / 64) * (FF / 32), I_2 = (FF / 64) * (D / 32);
    const int NITEMS = I_IN + I_OUT + I_1 + I_2;
    for (int it = gw; it < NITEMS; it += NGW) {
        int r = it;
        if (r < I_IN) { transpose_item(P.w_in, P.norm1, D, nin_w, Wb + WOFF_IN, 0, scr, r, lane); continue; } r -= I_IN;
        if (r < I_OUT) { transpose_item(P.w_out, nullptr, D, D, Wb + WOFF_OUT, 0, scr, r, lane); continue; } r -= I_OUT;
        if (r < I_1) { transpose_item(P.w1, P.norm2, D, FF, Wb + WOFF_1, 0, scr, r, lane); continue; } r -= I_1;
        transpose_item(P.w2, nullptr, FF, D, Wb + WOFF_2, 0, scr, r, lane);
    }
    if (P.kind == K_GLA) {
        const float* W1 = P.e0; const float* W2 = P.e1;
        for (int e = vcu * NTHR + tid; e < 512 * 1024; e += G * NTHR) {
            const int n = e >> 10, k = e & 1023;
            float s = 0.f;
#pragma unroll
            for (int r = 0; r < 16; ++r) s += W1[k * 16 + r] * W2[r * 512 + n];
            Wb[WOFF_IN + (size_t)(3072 + n) * 1024 + k] = (bf16)f2bf(s * P.norm1[k]);
        }
    }
    if (L == 0) {
        const float* x = a.in0; bf16* xb = (bf16*)(a.ws + WS_XB); float* ssq = (float*)(a.ws + WS_SSQ);
        for (int m = gw; m < NTOK; m += NGW) {
            const f32x4* xr = (const f32x4*)(x + (size_t)m * D) + lane;
            f32x4 v[4]; float s = 0.f;
#pragma unroll
            for (int j = 0; j < 4; ++j) { v[j] = xr[64 * j]; s += (v[j].x * v[j].x + v[j].y * v[j].y) + (v[j].z * v[j].z + v[j].w * v[j].w); }
            s = wave_sum(s);
            v2u* o8 = (v2u*)(xb + (size_t)m * D) + lane;
#pragma unroll
            for (int j = 0; j < 4; ++j) { v2u w; w.x = pk2(v[j].x, v[j].y); w.y = pk2(v[j].z, v[j].w); o8[64 * j] = w; }
            if (lane < 16) ssq[(size_t)m * 16 + lane] = (lane == 0) ? s : 0.f;
        }
    }
}

__device__ __forceinline__ void phase_final(const Ctx& a, int vcu, int G) {
    const int tid = otid(), lane = tid & 63, wave = tid >> 6;
    const int gw = vcu * NWAVES + wave, NGW = G * NWAVES;
    const float* ssq = (const float*)(a.ws + WS_SSQ); const float* g = a.in42;
    for (int m = gw; m < NTOK; m += NGW) {
        const float rs = row_rstd(ssq, m);
        f32x4* xr = (f32x4*)(a.out + (size_t)m * D) + lane; const f32x4* gr = (const f32x4*)g + lane;
#pragma unroll
        for (int j = 0; j < 4; ++j) { f32x4 v = xr[64 * j]; const f32x4 gg = gr[64 * j]; v.x *= rs * gg.x; v.y *= rs * gg.y; v.z *= rs * gg.z; v.w *= rs * gg.w; xr[64 * j] = v; }
    }
}

struct GlaCum { float b0[8], b1[8], tot0, tot1; };
__device__ __forceinline__ void gla_cumsum(GlaCum& c, const bf16* proj, int row0, int h, LAS float* TOT, int tid) {
    const int cp = tid & 63, part = tid >> 6;
#pragma unroll
    for (int i = 0; i < 8; ++i) { const unsigned w = *(const unsigned*)(proj + (size_t)(row0 + 8 * part + i) * GLA_PITCH + 3072 + h * 128 + 2 * cp); c.b0[i] = bflo(w); c.b1[i] = bfhi(w); }
#pragma unroll
    for (int i = 1; i < 8; ++i) { c.b0[i] += c.b0[i - 1]; c.b1[i] += c.b1[i - 1]; }
    TOT[part * 128 + 2 * cp] = c.b0[7]; TOT[part * 128 + 2 * cp + 1] = c.b1[7];
    __syncthreads();
    float o0 = 0.f, o1 = 0.f, t0 = 0.f, t1 = 0.f;
#pragma unroll
    for (int p = 0; p < 8; ++p) { const float x0 = TOT[p * 128 + 2 * cp], x1 = TOT[p * 128 + 2 * cp + 1]; if (p < part) { o0 += x0; o1 += x1; } t0 += x0; t1 += x1; }
#pragma unroll
    for (int i = 0; i < 8; ++i) { c.b0[i] += o0; c.b1[i] += o1; }
    c.tot0 = t0; c.tot1 = t1;
}
__device__ __forceinline__ void phase_gla_kv(LAS unsigned char* lds, const Ctx& a, int vcu, int G) {
    const int tid = otid();
    const bf16* proj = (const bf16*)(a.ws + WS_H); bf16* state = (bf16*)(a.ws + WS_STATE); float* dec = (float*)(a.ws + WS_DEC);
    LAS float* KE = (LAS float*)lds;
    LAS float* V = KE + 64 * 128;
    LAS float* TOT = V + 64 * 256;
    for (int u = vcu; u < NB * GLA_H * GLA_NC; u += G) {
        const int n = u % GLA_NC, bh = u / GLA_NC, h = bh % GLA_H, b = bh / GLA_H;
        const int row0 = b * T + n * GLA_C;
        GlaCum c; gla_cumsum(c, proj, row0, h, TOT, tid);
        const int cp = tid & 63, part = tid >> 6;
#pragma unroll
        for (int i = 0; i < 8; ++i) { const int t = 8 * part + i; const unsigned w = *(const unsigned*)(proj + (size_t)(row0 + t) * GLA_PITCH + 512 + h * 128 + 2 * cp);
            KE[t * 128 + 2 * cp] = bflo(w) * __expf(c.tot0 - c.b0[i]); KE[t * 128 + 2 * cp + 1] = bfhi(w) * __expf(c.tot1 - c.b1[i]); }
        if (part == 0) { dec[(size_t)u * 128 + 2 * cp] = __expf(c.tot0); dec[(size_t)u * 128 + 2 * cp + 1] = __expf(c.tot1); }
        { const int vp = tid & 127, rp = tid >> 7;
#pragma unroll
          for (int i = 0; i < 16; ++i) { const int t = 16 * rp + i; const unsigned w = *(const unsigned*)(proj + (size_t)(row0 + t) * GLA_PITCH + 1024 + h * 256 + 2 * vp);
              V[t * 256 + 2 * vp] = bflo(w); V[t * 256 + 2 * vp + 1] = bfhi(w); } }
        __syncthreads();
        const int vd = tid & 255, kh = tid >> 8;
        float acc[64];
#pragma unroll
        for (int j = 0; j < 64; ++j) acc[j] = 0.f;
        for (int t = 0; t < 64; ++t) { const float v = V[t * 256 + vd];
#pragma unroll
            for (int j = 0; j < 64; ++j) acc[j] += KE[t * 128 + kh * 64 + j] * v; }
        bf16* sp = state + ((size_t)u * 256 + vd) * 128 + kh * 64;
#pragma unroll
        for (int j = 0; j < 64; j += 8) { v4u w; w.x = pk2(acc[j], acc[j + 1]); w.y = pk2(acc[j + 2], acc[j + 3]); w.z = pk2(acc[j + 4], acc[j + 5]); w.w = pk2(acc[j + 6], acc[j + 7]); *(v4u*)(sp + j) = w; }
        __syncthreads();
    }
}
__device__ __forceinline__ void phase_gla_scan(const Ctx& a, int vcu, int G) {
    unsigned* state = (unsigned*)(a.ws + WS_STATE); const float* dec = (const float*)(a.ws + WS_DEC);
    for (int gid = vcu * NTHR + otid(); gid < NB * GLA_H * 16384; gid += G * NTHR) {
        const int bh = gid >> 14, e = gid & 16383, kp = e & 63;
        unsigned* sp = state + (size_t)bh * GLA_NC * 16384 + e;
        const float* dp = dec + (size_t)bh * GLA_NC * 128 + 2 * kp;
        float s0 = 0.f, s1 = 0.f;
        for (int n0 = 0; n0 < GLA_NC; n0 += 8) {
            unsigned w[8]; float d0[8], d1[8];
#pragma unroll
            for (int i = 0; i < 8; ++i) { w[i] = sp[(size_t)(n0 + i) * 16384]; d0[i] = dp[(n0 + i) * 128]; d1[i] = dp[(n0 + i) * 128 + 1]; }
#pragma unroll
            for (int i = 0; i < 8; ++i) { sp[(size_t)(n0 + i) * 16384] = pk2(s0, s1); s0 = d0[i] * s0 + bflo(w[i]); s1 = d1[i] * s1 + bfhi(w[i]); }
        }
    }
}
__device__ __forceinline__ void phase_gla_out(LAS unsigned char* lds, const Ctx& a, const LayerP& P, int vcu, int G) {
    const int tid = otid(), lane = tid & 63, wave = tid >> 6;
    bf16* proj = (bf16*)(a.ws + WS_H); const bf16* state = (const bf16*)(a.ws + WS_STATE);
    LAS float* QD = (LAS float*)lds;
    LAS float* KI = QD + 64 * 128;
    LAS float* ATT = KI + 64 * 128;
    LAS unsigned* Vb = (LAS unsigned*)(ATT + 64 * 64);
    LAS float* TOT = (LAS float*)(Vb + 64 * 128);
    LAS float* RSS = TOT + 8 * 128;
    for (int u = vcu; u < NB * GLA_H * GLA_NC; u += G) {
        const int n = u % GLA_NC, bh = u / GLA_NC, h = bh % GLA_H, b = bh / GLA_H;
        const int row0 = b * T + n * GLA_C;
        GlaCum c; gla_cumsum(c, proj, row0, h, TOT, tid);
        const int cp = tid & 63, part = tid >> 6;
#pragma unroll
        for (int i = 0; i < 8; ++i) { const int t = 8 * part + i;
            const unsigned wq = *(const unsigned*)(proj + (size_t)(row0 + t) * GLA_PITCH + h * 128 + 2 * cp);
            const unsigned wk = *(const unsigned*)(proj + (size_t)(row0 + t) * GLA_PITCH + 512 + h * 128 + 2 * cp);
            const float e0 = __expf(c.b0[i]), e1 = __expf(c.b1[i]);
            QD[t * 128 + 2 * cp] = bflo(wq) * 0.08838834764831845f * e0; QD[t * 128 + 2 * cp + 1] = bfhi(wq) * 0.08838834764831845f * e1;
            KI[t * 128 + 2 * cp] = bflo(wk) / e0; KI[t * 128 + 2 * cp + 1] = bfhi(wk) / e1; }
        { const int vp = tid & 127, rp = tid >> 7;
#pragma unroll
          for (int i = 0; i < 16; ++i) { const int t = 16 * rp + i; Vb[t * 128 + vp] = *(const unsigned*)(proj + (size_t)(row0 + t) * GLA_PITCH + 1024 + h * 256 + 2 * vp); } }
        __syncthreads();
        { const int cc = tid >> 3, s0 = (tid & 7) * 8; float acc[8];
#pragma unroll
          for (int j = 0; j < 8; ++j) acc[j] = 0.f;
          for (int d = 0; d < 128; ++d) { const float q = QD[cc * 128 + d];
#pragma unroll
              for (int j = 0; j < 8; ++j) acc[j] += q * KI[(s0 + j) * 128 + d]; }
#pragma unroll
          for (int j = 0; j < 8; ++j) ATT[cc * 64 + s0 + j] = (s0 + j <= cc) ? acc[j] : 0.f; }
        __syncthreads();
        const int vd = tid & 255, ch = tid >> 8;
        float acc[32];
#pragma unroll
        for (int j = 0; j < 32; ++j) acc[j] = 0.f;
        for (int s = 0; s < 64; ++s) { const unsigned w = Vb[s * 128 + (vd >> 1)]; const float v = (vd & 1) ? bfhi(w) : bflo(w);
#pragma unroll
            for (int j = 0; j < 32; ++j) acc[j] += ATT[(ch * 32 + j) * 64 + s] * v; }
        { const bf16* sp = state + ((size_t)u * 256 + vd) * 128;
          for (int d0 = 0; d0 < 128; d0 += 8) { const v4u w = *(const v4u*)(sp + d0);
              const float st[8] = {bflo(w.x), bfhi(w.x), bflo(w.y), bfhi(w.y), bflo(w.z), bfhi(w.z), bflo(w.w), bfhi(w.w)};
#pragma unroll
              for (int dd = 0; dd < 8; ++dd) {
#pragma unroll
                  for (int j = 0; j < 32; ++j) acc[j] += QD[(ch * 32 + j) * 128 + d0 + dd] * st[dd]; } } }
#pragma unroll
        for (int j = 0; j < 32; ++j) { const float s = wave_sum(acc[j] * acc[j]); if (lane == 0) RSS[wave * 32 + j] = s; }
        __syncthreads();
        const float hn = P.e3[vd];
#pragma unroll
        for (int j = 0; j < 32; ++j) { const int cc = ch * 32 + j;
            const float ss = (RSS[(ch * 4 + 0) * 32 + j] + RSS[(ch * 4 + 1) * 32 + j]) + (RSS[(ch * 4 + 2) * 32 + j] + RSS[(ch * 4 + 3) * 32 + j]);
            const float rs = 1.0f / sqrtf(ss * (1.0f / 256.0f) + EPS);
            const float g = bf2f(proj[(size_t)(row0 + cc) * GLA_PITCH + 2048 + h * 256 + vd]);
            const float o = acc[j] * rs * hn * (g / (1.f + __expf(-g)));
            proj[(size_t)(row0 + cc) * GLA_PITCH + 1024 + h * 256 + vd] = (bf16)f2bf(o); }
        __syncthreads();
    }
}

__device__ __forceinline__ void phase_sgu(LAS unsigned char* lds, const Ctx& a, const LayerP& P, int vcu, int G) {
    const int tid = otid();
    bf16* proj = (bf16*)(a.ws + WS_H); const float* vssq = (const float*)(a.ws + WS_VSSQ);
    const float* v_norm = P.e1; const float* w_s = P.e2; const float* b_s = P.e3;
    LAS float* W = (LAS float*)lds;
    LAS float* V = W + 128 * 128;
    for (int u = vcu; u < NB * (T / SGU_C) * SGU_G; u += G) {
        const int g = u % SGU_G, bc = u / SGU_G;
        const int row0 = bc * SGU_C;
        for (int e = tid; e < 128 * 128; e += NTHR) { const int t = e >> 7, s = e & 127;
            const float rs = row_rstd(vssq, row0 + s);
            W[e] = (s <= t) ? w_s[(size_t)g * 16384 + e] * rs : 0.f;
            V[e] = bf2f(proj[(size_t)(row0 + t) * SGU_PITCH + 1024 + g * 128 + s]); }
        __syncthreads();
        const int d = tid & 127, tq = tid >> 7;
        float acc[32];
#pragma unroll
        for (int j = 0; j < 32; ++j) acc[j] = 0.f;
        for (int s = 0; s < 128; ++s) { const float v = V[s * 128 + d];
#pragma unroll
            for (int j = 0; j < 32; ++j) acc[j] += W[(tq + 4 * j) * 128 + s] * v; }
        const float vn = v_norm[g * 128 + d];
#pragma unroll
        for (int j = 0; j < 32; ++j) { const int t = tq + 4 * j;
            const float sv = vn * acc[j] + b_s[g * 128 + t];
            bf16* up = proj + (size_t)(row0 + t) * SGU_PITCH + g * 128 + d;
            *up = (bf16)f2bf(bf2f(*up) * sv); }
        __syncthreads();
    }
}

__device__ __forceinline__ void phase_diff(LAS unsigned char* lds, const Ctx& a, const LayerP& P, int vcu, int G) {
    const int tid = otid(), lane = tid & 63, wave = tid >> 6;
    bf16* proj = (bf16*)(a.ws + WS_H);
    LAS float* Ks = (LAS float*)lds;
    LAS float* Vs = Ks + 64 * 132;
    LAS float* Qs = Vs + 64 * 128;
    LAS float* Ps = Qs + 32 * 128;
    float lam;
    { float s1 = 0.f, s2 = 0.f;
      for (int i = 0; i < 64; ++i) { s1 += P.e0[i] * P.e1[i]; s2 += P.e2[i] * P.e3[i]; }
      lam = __expf(s1) - __expf(s2) + LAMBDA_INIT; }
    const float* head_norm = P.e4;
    const int NU = NB * DIFF_H * (T / 32);
    for (int u = vcu; u < NU; u += G) {
        const int qb = (T / 32 - 1) - (u / (NB * DIFF_H)), bh = u % (NB * DIFF_H), h = bh % DIFF_H, b = bh / DIFF_H;
        const int q0 = qb * 32; const size_t rowbase = (size_t)b * T;
        const float slope2 = exp2f(-(float)(h + 1)) * LOG2E;
        __syncthreads();
        for (int e = tid; e < 32 * 64; e += NTHR) { const int r = e >> 6, c2 = e & 63;
            const unsigned w = *(const unsigned*)(proj + (rowbase + q0 + r) * DIFF_PITCH + h * 128 + 2 * c2);
            Qs[r * 128 + 2 * c2] = bflo(w); Qs[r * 128 + 2 * c2 + 1] = bfhi(w); }
        float m1[4], l1[4], m2[4], l2[4], oa1[4], ob1[4], oa2[4], ob2[4];
#pragma unroll
        for (int i = 0; i < 4; ++i) { m1[i] = -1e30f; m2[i] = -1e30f; l1[i] = 0.f; l2[i] = 0.f; oa1[i] = 0.f; ob1[i] = 0.f; oa2[i] = 0.f; ob2[i] = 0.f; }
        const int ntile = (q0 + 31) / 64 + 1;
        for (int kt = 0; kt < ntile; ++kt) {
            __syncthreads();
            for (int e = tid; e < 64 * 64; e += NTHR) { const int r = e >> 6, c2 = e & 63;
                const unsigned wk = *(const unsigned*)(proj + (rowbase + kt * 64 + r) * DIFF_PITCH + 1024 + h * 128 + 2 * c2);
                const unsigned wv = *(const unsigned*)(proj + (rowbase + kt * 64 + r) * DIFF_PITCH + 2048 + h * 128 + 2 * c2);
                Ks[r * 132 + 2 * c2] = bflo(wk); Ks[r * 132 + 2 * c2 + 1] = bfhi(wk);
                Vs[r * 128 + 2 * c2] = bflo(wv); Vs[r * 128 + 2 * c2 + 1] = bfhi(wv); }
            __syncthreads();
            const int kpos = kt * 64 + lane;
#pragma unroll
            for (int i = 0; i < 4; ++i) {
                const int r = wave + 8 * i, qpos = q0 + r;
                if (kt * 64 > qpos) continue;
                float s1 = 0.f, s2 = 0.f;
                const LAS f32x4* qp = (const LAS f32x4*)(Qs + r * 128); const LAS f32x4* kp = (const LAS f32x4*)(Ks + lane * 132);
#pragma unroll
                for (int d = 0; d < 16; ++d) { const f32x4 q = qp[d], k = kp[d]; s1 += (q.x * k.x + q.y * k.y) + (q.z * k.z + q.w * k.w); }
#pragma unroll
                for (int d = 16; d < 32; ++d) { const f32x4 q = qp[d], k = kp[d]; s2 += (q.x * k.x + q.y * k.y) + (q.z * k.z + q.w * k.w); }
                const float bias = slope2 * (float)(qpos - kpos);
                const bool ok = kpos <= qpos;
                s1 = ok ? s1 - bias : -1e30f; s2 = ok ? s2 - bias : -1e30f;
                const float mn1 = fmaxf(m1[i], wave_max(s1)), mn2 = fmaxf(m2[i], wave_max(s2));
                const float p1 = ok ? exp2f(s1 - mn1) : 0.f, p2 = ok ? exp2f(s2 - mn2) : 0.f;
                const float a1 = exp2f(m1[i] - mn1), a2 = exp2f(m2[i] - mn2);
                l1[i] = l1[i] * a1 + wave_sum(p1); l2[i] = l2[i] * a2 + wave_sum(p2); m1[i] = mn1; m2[i] = mn2;
                Ps[wave * 128 + lane] = p1; Ps[wave * 128 + 64 + lane] = p2;
                LDS_WAIT();
                float x1 = 0.f, y1 = 0.f, x2 = 0.f, y2 = 0.f;
                for (int j = 0; j < 64; ++j) { const float pa = Ps[wave * 128 + j], pb = Ps[wave * 128 + 64 + j]; const float va = Vs[j * 128 + lane], vb = Vs[j * 128 + 64 + lane];
                    x1 += pa * va; y1 += pa * vb; x2 += pb * va; y2 += pb * vb; }
                oa1[i] = oa1[i] * a1 + x1; ob1[i] = ob1[i] * a1 + y1; oa2[i] = oa2[i] * a2 + x2; ob2[i] = ob2[i] * a2 + y2;
                LDS_WAIT();
            }
        }
#pragma unroll
        for (int i = 0; i < 4; ++i) {
            const int r = wave + 8 * i;
            const float oa = oa1[i] / l1[i] - lam * (oa2[i] / l2[i]), ob = ob1[i] / l1[i] - lam * (ob2[i] / l2[i]);
            const float ss = wave_sum(oa * oa + ob * ob);
            const float rs = (1.0f / sqrtf(ss * (1.0f / 128.0f) + EPS)) * (1.0f - LAMBDA_INIT);
            bf16* op = proj + (rowbase + q0 + r) * DIFF_PITCH + h * 128;
            op[lane] = (bf16)f2bf(oa * rs * head_norm[lane]); op[64 + lane] = (bf16)f2bf(ob * rs * head_norm[64 + lane]);
        }
    }
}

namespace pg8 {
#define PG8_LAS __attribute__((address_space(3)))
typedef unsigned short bf16_t;
typedef short bf16x8 __attribute__((ext_vector_type(8)));
typedef float f32x4 __attribute__((ext_vector_type(4)));
typedef unsigned u32x4 __attribute__((ext_vector_type(4)));
constexpr int BM = 256, BK = 64, HALF = 128, HTB = HALF * BK * 2  , STAGE_BYTES = 8 * HTB, NXCD = 8, WGM = 8;

__host__ __device__ __forceinline__ int lds_byte(int r, int c) { const int st = (r >> 4) * 2 + (c >> 5), rr = r & 15, cc = c & 31, ob = rr * 64 + cc * 2; return st * 1024 + (ob ^ (((ob >> 9) & 1) << 5)); }
__host__ __device__ __forceinline__ void stage_rc(int b, int& R, int& C) { const int st = b / 1024, sb = b % 1024, swz = sb ^ (((sb >> 9) & 1) << 5); R = (st >> 1) * 16 + swz / 64; C = (st & 1) * 32 + (swz % 64) / 2; }
__host__ __device__ __forceinline__ int perm32(int rho) { const int n = rho >> 4, i = rho & 15; return 8 * (i >> 2) + 4 * n + (i & 3); }

struct Unit { int pm, pn; };
struct Gemm { const bf16_t* A; int lda; const bf16_t* Bt; int M, N, K; };

struct StaticOrder {
    int nM, nN, nwg, G, c;
    __host__ __device__ void init(int M, int N, int G_, int c_) { nM = M / BM; nN = N / BM; nwg = nM * nN; G = G_; c = c_; }
    __host__ __device__ bool next(int i, Unit& u) const {
        const long L = (long)i * G + c; if (L >= nwg) return false;
        int wgid = (int)L; { const int q = nwg / NXCD, r = nwg % NXCD, xcd = wgid % NXCD, off = wgid / NXCD; wgid = (xcd < r ? xcd * (q + 1) : r * (q + 1) + (xcd - r) * q) + off; }
        const int nig = WGM * nN, gid = wgid / nig, fm = gid * WGM, gsz = (nM - fm) < WGM ? (nM - fm) : WGM;
        u.pm = fm + ((wgid % nig) % gsz); u.pn = (wgid % nig) / gsz; return true;
    }
    __device__ __forceinline__ void a_ready(const Unit&) const {}
    __device__ __forceinline__ void done(const Unit&) const {}
};

template <class Epi, class Sched, bool ALIGN_EPI = false, bool SP2 = false>
__device__ __forceinline__ void gemm_phase(PG8_LAS unsigned char* lds, const Gemm g, const Sched& S, const Epi& E) {
    const int tid = otid(), wid = __builtin_amdgcn_readfirstlane(tid >> 6), lane = tid & 63, wr = wid >> 2, wc = wid & 3, fr = lane & 15, fq = lane >> 4;
    const int K = g.K, nt = K / BK, lda = g.lda;
    unsigned voffA[2], voffB[2];
#pragma unroll
    for (int i = 0; i < 2; ++i) { int R, C; stage_rc(tid * 16 + i * 8192, R, C); const int Rb = Epi::PERM ? ((R & ~31) + perm32(R & 31)) : R;
        voffA[i] = (unsigned)(R * lda + C) * 2u; voffB[i] = (unsigned)(Rb * K + C) * 2u; }
    const size_t kstep = (size_t)(BK * 2);
    const size_t hstepA = (size_t)HALF * lda * 2, hstepB = (size_t)HALF * K * 2;
    const size_t tstepA = 2 * hstepA, tstepB = 2 * hstepB;
    const unsigned ldsw = (unsigned)wid * 1024u;
    const int aoff = lds_byte(wr * 64 + fr, fq * 8), boff = lds_byte(wc * 32 + fr, fq * 8);
#define PG8_SA(b, h) (((b) * 2 + (h)) * HTB)
#define PG8_SB(b, h) ((4 + (b) * 2 + (h)) * HTB)
#define PG8_STAGE(bufoff, gbase, voff) do { _Pragma("unroll") for (int _i = 0; _i < 2; ++_i) \
        __builtin_amdgcn_global_load_lds((const unsigned*)((const char*)(gbase) + (voff)[_i]), (PG8_LAS unsigned*)(lds + (bufoff) + ldsw + _i * 8192), 16, 0, 0); } while (0)
#define PG8_LDA(dst, b, h) do { _Pragma("unroll") for (int m = 0; m < 4; ++m) _Pragma("unroll") for (int k = 0; k < 2; ++k) dst[m][k] = *(const PG8_LAS bf16x8*)(lds + PG8_SA(b, h) + aoff + m * 2048 + k * 1024); } while (0)
#define PG8_LDB(dst, b, h) do { _Pragma("unroll") for (int n = 0; n < 2; ++n) _Pragma("unroll") for (int k = 0; k < 2; ++k) dst[n][k] = *(const PG8_LAS bf16x8*)(lds + PG8_SB(b, h) + boff + n * 2048 + k * 1024); } while (0)
#define PG8_MMA(ai, bj, At, Bt) do { __builtin_amdgcn_s_setprio(1); _Pragma("unroll") for (int m = 0; m < 4; ++m) _Pragma("unroll") for (int n = 0; n < 2; ++n) _Pragma("unroll") for (int k = 0; k < 2; ++k) \
        acc[ai][bj][m][n] = __builtin_amdgcn_mfma_f32_16x16x32_bf16(Bt[n][k], At[m][k], acc[ai][bj][m][n], 0, 0, 0); __builtin_amdgcn_s_setprio(0); } while (0)
#define PG8_WAIT_V(n) asm volatile("s_waitcnt vmcnt(" #n ")" ::: "memory")
#define PG8_WAIT_L(n) asm volatile("s_waitcnt lgkmcnt(" #n ")" ::: "memory")
#define PG8_BAR __builtin_amdgcn_s_barrier()
#define PG8_SCHED __builtin_amdgcn_sched_barrier(0)
    Unit cur, nxt; int ui = 0;
    if (!S.next(0, cur)) return;
    f32x4 acc[2][2][4][2];
#pragma unroll
    for (int a = 0; a < 2; ++a)
#pragma unroll
        for (int b = 0; b < 2; ++b)
#pragma unroll
            for (int m = 0; m < 4; ++m)
#pragma unroll
                for (int n = 0; n < 2; ++n) acc[a][b][m][n] = (f32x4){0.f, 0.f, 0.f, 0.f};
    bf16x8 At[4][2], B0[2][2], B1[2][2];
    const char* cA = (const char*)g.A + (size_t)cur.pm * tstepA; const char* cB = (const char*)g.Bt + (size_t)cur.pn * tstepB;
    S.a_ready(cur);
    if constexpr (SP2) {
        PG8_STAGE(PG8_SB(0, 0), cB, voffB); PG8_STAGE(PG8_SB(0, 1), cB + hstepB, voffB); PG8_STAGE(PG8_SA(0, 0), cA, voffA); PG8_STAGE(PG8_SA(0, 1), cA + hstepA, voffA);
        if (wr == 1) PG8_BAR;
        PG8_WAIT_V(2); PG8_BAR;
        PG8_STAGE(PG8_SB(1, 0), cB + kstep, voffB); PG8_STAGE(PG8_SA(1, 0), cA + kstep, voffA); PG8_STAGE(PG8_SB(1, 1), cB + hstepB + kstep, voffB);
        PG8_WAIT_V(6); PG8_BAR;
    } else {
        PG8_STAGE(PG8_SB(0, 0), cB, voffB); PG8_STAGE(PG8_SA(0, 0), cA, voffA); PG8_STAGE(PG8_SB(0, 1), cB + hstepB, voffB); PG8_STAGE(PG8_SA(0, 1), cA + hstepA, voffA);
        if (wr == 1) PG8_BAR;
        PG8_WAIT_V(4); PG8_BAR;
        PG8_STAGE(PG8_SB(1, 0), cB + kstep, voffB); PG8_STAGE(PG8_SA(1, 0), cA + kstep, voffA); PG8_STAGE(PG8_SB(1, 1), cB + hstepB + kstep, voffB);
        PG8_WAIT_V(6); PG8_BAR;
    }
    for (;;) {
        const bool has_next = S.next(ui + 1, nxt);
        const char* nA = has_next ? (const char*)g.A + (size_t)nxt.pm * tstepA : cA; const char* nB = has_next ? (const char*)g.Bt + (size_t)nxt.pn * tstepB : cB;
        for (int t = 0; t < nt; t += 2) {
            const bool last = (t == nt - 2);
            const char* a1 = cA + (size_t)(t + 1) * kstep;
            const char* a2 = last ? nA : cA + (size_t)(t + 2) * kstep; const char* b2 = last ? nB : cB + (size_t)(t + 2) * kstep;
            const char* a3 = a2 + kstep; const char* b3 = b2 + kstep;
            if (last && has_next) S.a_ready(nxt);
            if constexpr (SP2) {
            PG8_LDB(B0, 0, 0); PG8_LDB(B1, 0, 1); PG8_SCHED; PG8_LDA(At, 0, 0); PG8_STAGE(PG8_SA(1, 1), a1 + hstepA, voffA);
            PG8_WAIT_V(8); PG8_WAIT_L(0); PG8_BAR; PG8_MMA(0, 0, At, B0); PG8_MMA(0, 1, At, B1); PG8_BAR; PG8_SCHED;
            PG8_LDA(At, 0, 1); PG8_STAGE(PG8_SB(0, 0), b2, voffB); PG8_STAGE(PG8_SB(0, 1), b2 + hstepB, voffB); PG8_STAGE(PG8_SA(0, 0), a2, voffA);
            PG8_WAIT_V(8); PG8_WAIT_L(0); PG8_BAR; PG8_MMA(1, 0, At, B0); PG8_MMA(1, 1, At, B1); PG8_BAR; PG8_SCHED;
            PG8_LDB(B0, 1, 0); PG8_LDB(B1, 1, 1); PG8_SCHED; PG8_LDA(At, 1, 0); PG8_STAGE(PG8_SA(0, 1), a2 + hstepA, voffA);
            PG8_WAIT_V(8); PG8_WAIT_L(0); PG8_BAR; PG8_MMA(0, 0, At, B0); PG8_MMA(0, 1, At, B1); PG8_BAR; PG8_SCHED;
            PG8_LDA(At, 1, 1); PG8_STAGE(PG8_SB(1, 0), b3, voffB); PG8_STAGE(PG8_SB(1, 1), b3 + hstepB, voffB); PG8_STAGE(PG8_SA(1, 0), a3, voffA);
            PG8_WAIT_V(8); PG8_WAIT_L(0); PG8_BAR; PG8_MMA(1, 0, At, B0); PG8_MMA(1, 1, At, B1); PG8_BAR; PG8_SCHED;
            } else {
            PG8_LDB(B0, 0, 0); PG8_SCHED; PG8_LDA(At, 0, 0); PG8_STAGE(PG8_SA(1, 1), a1 + hstepA, voffA);
            PG8_WAIT_L(8); PG8_BAR; PG8_WAIT_L(0); PG8_MMA(0, 0, At, B0); PG8_BAR; PG8_SCHED;
            PG8_LDB(B1, 0, 1); PG8_STAGE(PG8_SB(0, 0), b2, voffB);
            PG8_BAR; PG8_WAIT_L(0); PG8_MMA(0, 1, At, B1); PG8_BAR;
            PG8_LDA(At, 0, 1); PG8_STAGE(PG8_SA(0, 0), a2, voffA);
            PG8_BAR; PG8_WAIT_L(0); PG8_MMA(1, 0, At, B0); PG8_BAR; PG8_SCHED;
            PG8_STAGE(PG8_SB(0, 1), b2 + hstepB, voffB);
            PG8_WAIT_V(6); PG8_BAR; PG8_MMA(1, 1, At, B1); PG8_BAR;
            PG8_LDB(B0, 1, 0); PG8_SCHED; PG8_LDA(At, 1, 0); PG8_STAGE(PG8_SA(0, 1), a2 + hstepA, voffA);
            PG8_WAIT_L(8); PG8_BAR; PG8_WAIT_L(0); PG8_MMA(0, 0, At, B0); PG8_BAR; PG8_SCHED;
            PG8_LDB(B1, 1, 1); PG8_STAGE(PG8_SB(1, 0), b3, voffB);
            PG8_BAR; PG8_WAIT_L(0); PG8_MMA(0, 1, At, B1); PG8_BAR;
            PG8_LDA(At, 1, 1); PG8_STAGE(PG8_SA(1, 0), a3, voffA);
            PG8_BAR; PG8_WAIT_L(0); PG8_MMA(1, 0, At, B0); PG8_BAR; PG8_SCHED;
            PG8_STAGE(PG8_SB(1, 1), b3 + hstepB, voffB);
            PG8_WAIT_V(6); PG8_BAR; PG8_MMA(1, 1, At, B1); PG8_BAR;
            }
        }
        if constexpr (ALIGN_EPI) { if (wr == 0) PG8_BAR; }
        if constexpr (!Epi::AFTER_DRAIN) { E(acc, cur, wr, wc, fr, fq); S.done(cur); }
        if (!has_next) break;
#pragma unroll
        for (int a = 0; a < 2; ++a)
#pragma unroll
            for (int b = 0; b < 2; ++b)
#pragma unroll
                for (int m = 0; m < 4; ++m)
#pragma unroll
                    for (int n = 0; n < 2; ++n) acc[a][b][m][n] = (f32x4){0.f, 0.f, 0.f, 0.f};
        cur = nxt; cA = nA; cB = nB; ++ui;
        if constexpr (ALIGN_EPI) { if (wr == 1) PG8_BAR; }
    }
    PG8_WAIT_V(0);
    if constexpr (!ALIGN_EPI) { if (wr == 0) PG8_BAR; }
    PG8_BAR;
    if constexpr (Epi::AFTER_DRAIN) { E.fused(acc, cur, wr, wc, fr, fq, lds, wid, lane); S.done(cur); }
#undef PG8_SA
#undef PG8_SB
#undef PG8_STAGE
#undef PG8_LDA
#undef PG8_LDB
#undef PG8_MMA
#undef PG8_WAIT_V
#undef PG8_WAIT_L
#undef PG8_BAR
#undef PG8_SCHED
}
}

template <class Core> struct EpiMfma {
    static constexpr bool PERM = true, AFTER_DRAIN = false;
    Core c;
    __device__ __forceinline__ void operator()(const pg8::f32x4 (&acc)[2][2][4][2], const pg8::Unit& u, int wr, int wc, int fr, int fq) const {
#pragma unroll
        for (int ai = 0; ai < 2; ++ai)
#pragma unroll
            for (int m = 0; m < 4; ++m) {
                const int row = u.pm * 256 + ai * 128 + wr * 64 + m * 16 + fr;
                const float rs = c.rowscale(row);
                float part = 0.f;
#pragma unroll
                for (int bj = 0; bj < 2; ++bj) {
                    const int col0 = u.pn * 256 + bj * 128 + wc * 32 + 8 * fq;
                    const float v[8] = {acc[ai][bj][m][0][0], acc[ai][bj][m][0][1], acc[ai][bj][m][0][2], acc[ai][bj][m][0][3],
                                        acc[ai][bj][m][1][0], acc[ai][bj][m][1][1], acc[ai][bj][m][1][2], acc[ai][bj][m][1][3]};
                    part += c.apply8(row, col0, v, rs);
                }
                part += __shfl_xor(part, 16); part += __shfl_xor(part, 32);
                if (fq == 0) c.store_part(row, u.pn * 256, (u.pn & 3) * 4 + wc, part);
            }
    }
};
#ifndef USE_MFMA_GEMM
#define USE_MFMA_GEMM 1
#endif
template <class Core>
__device__ __forceinline__ void run_gemm(LAS unsigned char* lds, const bf16* A, int lda, const bf16* Bt, int M, int N, int K, const Core& c, int vcu, int G) {
#if USE_MFMA_GEMM
    pg8::Gemm g{A, lda, Bt, M, N, K}; pg8::StaticOrder S; S.init(M, N, G, (int)blockIdx.x);
    EpiMfma<Core> E{c};
    pg8::gemm_phase<EpiMfma<Core>, pg8::StaticOrder, true, true>(lds, g, S, E);
#else
    gemm_naive(lds, A, lda, Bt, M, N, K, c, vcu, G);
#endif
}

#include <hip/hip_bf16.h>
#include <cmath>
namespace attn_body {
using bf16=__hip_bfloat16;
using bf16x8=__attribute__((ext_vector_type(8)))short;
using s16x4=__attribute__((ext_vector_type(4)))short;
using f32x16=__attribute__((ext_vector_type(16)))float;
using u32x4=__attribute__((ext_vector_type(4)))unsigned;
constexpr int SEQ=8192,D=64,PQ=3072,PO=2048;
constexpr int NW=8,QBLK=32,QB=QBLK*NW,KVBLK=64,NQB=SEQ/QB;
__device__ __forceinline__ int crow(int r,int hi){return (r&3)+8*(r>>2)+4*hi;}
#define SBAR() __builtin_amdgcn_sched_barrier(0)
__device__ __forceinline__ void cmask(f32x16&p0,f32x16&p1,int jb,int qrel,int hi){
  const float NEG=-INFINITY; int kb=64*jb+4*hi;
  #pragma unroll
  for(int r=0;r<16;++r){int kv=kb+(r&3)+8*(r>>2); if(kv>qrel)p0[r]=NEG; if(kv+32>qrel)p1[r]=NEG;}
}

constexpr int NSLOT=3, SLOTB=8192;
constexpr int LDS_K=0, LDS_V=NSLOT*SLOTB, LDS_WS=2*NSLOT*SLOTB, LDS_OST=LDS_WS+NW*64*4, LDS_BYTES=LDS_OST+NW*4096;
constexpr float C2=0.125f*1.4426950408889634f;
__device__ __forceinline__ void glds16(const void*gsrc,unsigned lds_dst){unsigned keep;
  asm volatile("s_mov_b32 %0, m0\n\ts_mov_b32 m0, %2\n\ts_nop 0\n\tglobal_load_lds_dwordx4 %1, off\n\ts_mov_b32 m0, %0":"=&s"(keep):"v"(gsrc),"s"(lds_dst):"memory");}
__device__ __forceinline__ float max3f(float a,float b,float c){float r;asm("v_max3_f32 %0, %1, %2, %3":"=v"(r):"v"(a),"v"(b),"v"(c));return r;}
__device__ __forceinline__ float max2f(float a,float b){float r;asm("v_max_f32_e32 %0, %1, %2":"=v"(r):"v"(a),"v"(b));return r;}
__device__ __forceinline__ float fadd_s(float a,float b){float r;asm("v_add_f32_e32 %0, %1, %2":"=v"(r):"v"(a),"v"(b));return r;}
__device__ __forceinline__ float fsub_s(float a,float b){float r;asm("v_sub_f32_e32 %0, %1, %2":"=v"(r):"v"(a),"v"(b));return r;}
typedef float f32x2_t __attribute__((ext_vector_type(2))); typedef __bf16 bf16x2_t __attribute__((ext_vector_type(2)));
__device__ __forceinline__ unsigned cvtpk_s(float lo,float hi){f32x2_t v={lo,hi};bf16x2_t b=__builtin_convertvector(v,bf16x2_t);return __builtin_bit_cast(unsigned,b);}
#define WAIT_BAR(N) asm volatile("s_waitcnt vmcnt(" #N ") lgkmcnt(0)\n\ts_barrier":::"memory")

__device__ __forceinline__ void qkt(f32x16&p0,f32x16&p1,const char*Kslot,const bf16x8*qr,const f32x16&negm,int r32,int hi){
  const char*kb=Kslot+hi*1024+r32*16;
  #pragma unroll
  for(int d0=0;d0<4;++d0){
    const bf16x8 b0=*reinterpret_cast<const bf16x8*>(kb+d0*2048);
    const bf16x8 b1=*reinterpret_cast<const bf16x8*>(kb+d0*2048+512);
    if(d0==0){p0=__builtin_amdgcn_mfma_f32_32x32x16_bf16(b0,qr[0],negm,0,0,0);p1=__builtin_amdgcn_mfma_f32_32x32x16_bf16(b1,qr[0],negm,0,0,0);}
    else{p0=__builtin_amdgcn_mfma_f32_32x32x16_bf16(b0,qr[d0],p0,0,0,0);p1=__builtin_amdgcn_mfma_f32_32x32x16_bf16(b1,qr[d0],p1,0,0,0);}}
}
typedef __attribute__((address_space(3))) const char* lds_cptr;
typedef short v4i16_t __attribute__((ext_vector_type(4)));
__device__ __forceinline__ void kload8(bf16x8*kf,lds_cptr kp){
  kf[0]=*(const __attribute__((address_space(3))) bf16x8*)(kp);      kf[1]=*(const __attribute__((address_space(3))) bf16x8*)(kp+512);
  kf[2]=*(const __attribute__((address_space(3))) bf16x8*)(kp+2048); kf[3]=*(const __attribute__((address_space(3))) bf16x8*)(kp+2560);
  kf[4]=*(const __attribute__((address_space(3))) bf16x8*)(kp+4096); kf[5]=*(const __attribute__((address_space(3))) bf16x8*)(kp+4608);
  kf[6]=*(const __attribute__((address_space(3))) bf16x8*)(kp+6144); kf[7]=*(const __attribute__((address_space(3))) bf16x8*)(kp+6656);
}
__device__ __forceinline__ void kload2(bf16x8*kf,lds_cptr kp,int j){ kf[2*j]=*(const __attribute__((address_space(3))) bf16x8*)(kp+j*2048); kf[2*j+1]=*(const __attribute__((address_space(3))) bf16x8*)(kp+j*2048+512); }
__device__ __forceinline__ s16x4 vtr(lds_cptr p){ return __builtin_bit_cast(s16x4,__builtin_amdgcn_ds_read_tr16_b64_v4i16((__attribute__((address_space(3))) v4i16_t*)p)); }
__device__ __forceinline__ float rowmax(const f32x16&p0,const f32x16&p1){
  float a=max3f(p0[0],p0[1],p1[0]),b=max3f(p0[2],p0[3],p1[1]);a=max3f(a,p1[2],p1[3]);
  #pragma unroll
  for(int r=4;r<16;r+=4){a=max3f(a,p0[r],p0[r+1]);b=max3f(b,p0[r+2],p0[r+3]);a=max3f(a,p1[r],p1[r+1]);b=max3f(b,p1[r+2],p1[r+3]);}
  const float m=max2f(a,b);
  auto rr=__builtin_amdgcn_permlane32_swap(__float_as_uint(m),__float_as_uint(m),false,false);
  return max2f(__uint_as_float(rr[0]),__uint_as_float(rr[1]));
}
__device__ __forceinline__ void pv(f32x16*o,int vb,bf16x8 pa0,bf16x8 pa1,bf16x8 pa2,bf16x8 pa3){
  #pragma unroll
  for(int d0=0;d0<2;++d0){s16x4 lo[4],hi[4];
    #pragma unroll
    for(int ks=0;ks<4;++ks){
      asm volatile("ds_read_b64_tr_b16 %0,%1 offset:%c2":"=&v"(lo[ks]):"v"(vb),"i"(d0*4096+ks*1024):"memory");
      asm volatile("ds_read_b64_tr_b16 %0,%1 offset:%c2":"=&v"(hi[ks]):"v"(vb),"i"(d0*4096+ks*1024+512):"memory");}
    asm volatile("s_waitcnt lgkmcnt(0)":::"memory");SBAR();
    #define PK(k) (bf16x8){lo[k][0],lo[k][1],lo[k][2],lo[k][3],hi[k][0],hi[k][1],hi[k][2],hi[k][3]}
    o[d0]=__builtin_amdgcn_mfma_f32_32x32x16_bf16(pa0,PK(0),o[d0],0,0,0);
    o[d0]=__builtin_amdgcn_mfma_f32_32x32x16_bf16(pa1,PK(1),o[d0],0,0,0);
    o[d0]=__builtin_amdgcn_mfma_f32_32x32x16_bf16(pa2,PK(2),o[d0],0,0,0);
    o[d0]=__builtin_amdgcn_mfma_f32_32x32x16_bf16(pa3,PK(3),o[d0],0,0,0);
    #undef PK
  }
}

#ifndef ATTN_STORE16
#define ATTN_STORE16(p,v) (*(u32x4*)(p)=(v))
#endif
template<int THRL> __device__ __forceinline__ void attn_unit(int b,int qb,const bf16*Q,const bf16*K,const bf16*V,bf16*O,float slope2,char*shm){
  const int tid=otid(),lane=tid&63,r32=lane&31,hi=lane>>5; const int wid=__builtin_amdgcn_readfirstlane(tid>>6);
  const long rowbase=(long)b*SEQ; const int q0=qb*QB;
  const bf16*Qw=Q+(rowbase+q0+wid*QBLK)*PQ;
  const bf16*Kh=K+rowbase*PQ,*Vh=V+rowbase*PQ;
  const unsigned lds0=(unsigned)(uintptr_t)shm;
  float*wsf=(float*)(shm+LDS_WS)+wid*64;
  const bf16*ksrc=Kh+(long)lane*PQ+wid*8;
  const bf16*vsrc=Vh+(long)(16*(wid&3)+(lane>>2))*PQ+(wid>>2)*32+(lane&3)*8;
  const unsigned kdst=lds0+LDS_K+wid*1024, vdst=lds0+LDS_V+wid*1024;
  #define DMA_K(t,slot) glds16(ksrc+(long)(t)*KVBLK*PQ,(unsigned)__builtin_amdgcn_readfirstlane(kdst+(slot)))
  #define DMA_V(t,slot) glds16(vsrc+(long)(t)*KVBLK*PQ,(unsigned)__builtin_amdgcn_readfirstlane(vdst+(slot)))
  const int vb0=(int)(lds0+LDS_V)+((lane>>4)&1)*32+(lane&3)*8+(4*hi+((lane&15)>>2))*64;
  const char*Kbase=shm+LDS_K; bf16x8 kf[8];
  const lds_cptr shm3=(lds_cptr)shm; const lds_cptr kp0=shm3+LDS_K+hi*1024+r32*16; const lds_cptr vp0=shm3+LDS_V+((lane>>4)&1)*32+(lane&3)*8+(4*hi+((lane&15)>>2))*64;
  const int NT=(q0+QB)/KVBLK;
  DMA_K(0,0);DMA_V(0,0);DMA_K(1,SLOTB);
  bf16x8 qr[4];
  #pragma unroll
  for(int d0=0;d0<4;++d0)qr[d0]=*reinterpret_cast<const bf16x8*>(&Qw[(long)r32*PQ+d0*16+hi*8]);
  float l_reg=0.f;f32x16 o[2];o[0]=f32x16{};o[1]=f32x16{};f32x16 negm;
  _Pragma("unroll") for(int r=0;r<16;++r)negm[r]=slope2*(float)crow(r,hi);
  asm volatile("":"+v"(negm)); const float b32=32.f*slope2, step64=64.f*slope2;
  const int qrel=wid*QBLK+r32;
  #define CMASK(P0,P1,t) do{int jb_=(t)-(NT-4); if(jb_>=0)cmask(P0,P1,jb_,qrel,hi);}while(0)
  bool resc=false;
  #define START(P0,P1) do{ const float rm=rowmax(P0,P1); resc=false; \
    { const float dl=rm; \
      _Pragma("unroll") for(int r=0;r<16;++r){P0[r]=fsub_s(P0[r],dl);P1[r]=fsub_s(P1[r],dl);} \
      const float adj_=step64-dl; _Pragma("unroll") for(int r=0;r<16;++r)negm[r]+=adj_; asm volatile("":"+v"(negm)); } \
    _Pragma("unroll") for(int r=0;r<16;++r)P0[r]=__builtin_amdgcn_exp2f(P0[r]); }while(0)
  #define RESC() do{ if(resc){ asm volatile("s_waitcnt lgkmcnt(0)":::"memory"); \
      _Pragma("unroll") for(int d_=0;d_<2;++d_) _Pragma("unroll") for(int r=0;r<16;++r)o[d_][r]*=wsf[crow(r,hi)]; } }while(0)
  f32x16 pA0,pA1,pB0,pB1;
  int sl_prev=0,sl_cur=0,sl_next=SLOTB;
  #define ROT() do{sl_prev=sl_cur;sl_cur=sl_next;sl_next=(sl_next==(NSLOT-1)*SLOTB)?0:sl_next+SLOTB;}while(0)
  DMA_K(2,2*SLOTB);
  WAIT_BAR(3);
  qkt(pA0,pA1,Kbase,qr,negm,r32,hi);asm volatile("s_nop 15\n\ts_nop 7":"+v"(pA0),"+v"(pA1));
  _Pragma("unroll") for(int r=0;r<16;++r)pA1[r]+=b32;
  CMASK(pA0,pA1,0);
  START(pA0,pA1);
  _Pragma("unroll") for(int r=0;r<16;++r)pA1[r]=__builtin_amdgcn_exp2f(pA1[r]);
  WAIT_BAR(0);
  DMA_K(3,0);DMA_V(1,SLOTB);
  ROT();
  kload8(kf,kp0+sl_cur);
  WAIT_BAR(2);
  s16x4 vlo[8],vhi[8]; u32x4 pw0,pw1,pw2,pw3;
  #define PKW(P,B) cvtpk_s(P[B],P[B+1])
  #define PAF(k) __builtin_bit_cast(bf16x8,pw##k)
  #define VFR(i) (bf16x8){vlo[i][0],vlo[i][1],vlo[i][2],vlo[i][3],vhi[i][0],vhi[i][1],vhi[i][2],vhi[i][3]}
  #define PIN(x) asm volatile("":"+v"(x))
  #define MX3(a,b,c) __builtin_fmaxf(__builtin_fmaxf((a),(b)),(c))
  #define GAPA(MF,A0,A1,A2,A3,W0,W1,PW) do{ MF; sacc+=A0; sacc+=A1; sacc+=A2; sacc+=A3; PIN(sacc); W0; W1; PIN(PW); SBAR(); }while(0)
  #define EX(v) __builtin_amdgcn_exp2f(v)
  #define GAPB(MF,X,B) do{ MF; X[B]=EX(X[B]); X[B+1]=EX(X[B+1]); X[B+2]=EX(X[B+2]); X[B+3]=EX(X[B+3]); PIN(X); SBAR(); }while(0)
  #define VRD(i) do{ vlo[i]=vtr(vp_+(((i)>>2)*4096+((i)&3)*1024)); vhi[i]=vtr(vp_+(((i)>>2)*4096+((i)&3)*1024+512)); }while(0)
  #define KRD(G,j) do{ if(G){ kload2(kf,kp0+sl_next,j); SBAR(); } }while(0)
  #define STEP(C0,C1,P0,P1,t,GK,GV,GL) do{ SBAR(); \
    const lds_cptr vp_=vp0+sl_prev; \
    VRD(0); SBAR(); float sacc=(P0[0]+P0[1]); \
    GAPA(C0=__builtin_amdgcn_mfma_f32_32x32x16_bf16(kf[0],qr[0],negm,0,0,0), P0[2],P0[3],P0[4],P0[5],     pw0[0]=PKW(P0,0), pw0[1]=PKW(P0,2), pw0); \
    VRD(4); SBAR(); GAPA(C1=__builtin_amdgcn_mfma_f32_32x32x16_bf16(kf[1],qr[0],negm,0,0,0), P0[6],P0[7],P0[8],P0[9],     pw0[2]=PKW(P0,4), pw0[3]=PKW(P0,6), pw0); \
    VRD(1); SBAR(); GAPA(C0=__builtin_amdgcn_mfma_f32_32x32x16_bf16(kf[2],qr[1],C0,0,0,0),   P0[10],P0[11],P0[12],P0[13], pw1[0]=PKW(P0,8), pw1[1]=PKW(P0,10), pw1); \
    VRD(5); SBAR(); GAPA(C1=__builtin_amdgcn_mfma_f32_32x32x16_bf16(kf[3],qr[1],C1,0,0,0),   P0[14],P0[15],P1[0],P1[1],   pw1[2]=PKW(P0,12),pw1[3]=PKW(P0,14), pw1); \
    VRD(2); SBAR(); GAPA(C0=__builtin_amdgcn_mfma_f32_32x32x16_bf16(kf[4],qr[2],C0,0,0,0),   P1[2],P1[3],P1[4],P1[5],     pw2[0]=PKW(P1,0), pw2[1]=PKW(P1,2), pw2); \
    VRD(6); SBAR(); GAPA(C1=__builtin_amdgcn_mfma_f32_32x32x16_bf16(kf[5],qr[2],C1,0,0,0),   P1[6],P1[7],P1[8],P1[9],     pw2[2]=PKW(P1,4), pw2[3]=PKW(P1,6), pw2); \
    VRD(3); SBAR(); GAPA(C0=__builtin_amdgcn_mfma_f32_32x32x16_bf16(kf[6],qr[3],C0,0,0,0),   P1[10],P1[11],P1[12],P1[13], pw3[0]=PKW(P1,8), pw3[1]=PKW(P1,10), pw3); \
    VRD(7); SBAR(); GAPA(C1=__builtin_amdgcn_mfma_f32_32x32x16_bf16(kf[7],qr[3],C1,0,0,0),   P1[14],P1[15],0.f,0.f,       pw3[2]=PKW(P1,12),pw3[3]=PKW(P1,14), pw3); \
    l_reg+=sacc; \
    if(GK){DMA_K((t)+3,sl_cur);} if(GV){DMA_V((t)+1,sl_next);} \
    _Pragma("unroll") for(int r=0;r<16;++r)C1[r]+=b32; \
    CMASK(C0,C1,t); \
    { float a=MX3(C0[0],C0[1],C1[0]),b=MX3(C0[2],C0[3],C1[1]); a=MX3(a,C1[2],C1[3]); \
      _Pragma("unroll") for(int r=4;r<16;r+=4){a=MX3(a,C0[r],C0[r+1]);b=MX3(b,C0[r+2],C0[r+3]);a=MX3(a,C1[r],C1[r+1]);b=MX3(b,C1[r+2],C1[r+3]);} \
      float rm=__builtin_fmaxf(a,b); { auto rr=__builtin_amdgcn_permlane32_swap(__float_as_uint(rm),__float_as_uint(rm),false,false); rm=__builtin_fmaxf(__uint_as_float(rr[0]),__uint_as_float(rr[1])); } \
      resc=false; float adj_=step64; \
      if(__any(rm>(float)THRL)){ const float dl=__builtin_fmaxf(rm,0.f); adj_-=dl; \
        _Pragma("unroll") for(int r=0;r<16;++r){C0[r]-=dl;C1[r]-=dl;} \
        const float f=__builtin_amdgcn_exp2f(-dl); l_reg*=f; if(hi==0)wsf[r32]=f; resc=true; } \
      _Pragma("unroll") for(int r=0;r<16;++r)negm[r]+=adj_; asm volatile("":"+v"(negm)); } \
    SBAR(); \
    GAPB(o[0]=__builtin_amdgcn_mfma_f32_32x32x16_bf16(PAF(0),VFR(0),o[0],0,0,0), C0,0); \
    GAPB(o[1]=__builtin_amdgcn_mfma_f32_32x32x16_bf16(PAF(0),VFR(4),o[1],0,0,0), C0,4); \
    KRD(GL,0); GAPB(o[0]=__builtin_amdgcn_mfma_f32_32x32x16_bf16(PAF(1),VFR(1),o[0],0,0,0), C0,8); \
    KRD(GL,1); GAPB(o[1]=__builtin_amdgcn_mfma_f32_32x32x16_bf16(PAF(1),VFR(5),o[1],0,0,0), C0,12); \
    KRD(GL,2); GAPB(o[0]=__builtin_amdgcn_mfma_f32_32x32x16_bf16(PAF(2),VFR(2),o[0],0,0,0), C1,0); \
    KRD(GL,3); GAPB(o[1]=__builtin_amdgcn_mfma_f32_32x32x16_bf16(PAF(2),VFR(6),o[1],0,0,0), C1,4); \
    GAPB(o[0]=__builtin_amdgcn_mfma_f32_32x32x16_bf16(PAF(3),VFR(3),o[0],0,0,0), C1,8); \
    GAPB(o[1]=__builtin_amdgcn_mfma_f32_32x32x16_bf16(PAF(3),VFR(7),o[1],0,0,0), C1,12); \
    }while(0)
  int t=1;
  #undef CMASK
  #define CMASK(P0,P1,t) do{}while(0)
  for(;t+5<NT;t+=2){
    STEP(pB0,pB1,pA0,pA1,t,true,true,true);     WAIT_BAR(2); RESC(); ROT();
    STEP(pA0,pA1,pB0,pB1,t+1,true,true,true);   WAIT_BAR(2); RESC(); ROT();
  }
  #undef CMASK
  #define CMASK(P0,P1,t) do{int jb_=(t)-(NT-4); if(jb_>=0)cmask(P0,P1,jb_,qrel,hi);}while(0)
  #define ENDW(tt) do{ if((tt)+3<NT){WAIT_BAR(2);} else if((tt)+2<NT){WAIT_BAR(1);} else {WAIT_BAR(0);} }while(0)
  for(;t+1<NT;t+=2){
    STEP(pB0,pB1,pA0,pA1,t,(t+3<NT),(t+1<NT),(t+1<NT));       ENDW(t);   RESC(); ROT();
    STEP(pA0,pA1,pB0,pB1,t+1,(t+4<NT),(t+2<NT),(t+2<NT));     ENDW(t+1); RESC(); ROT();
  }
  STEP(pB0,pB1,pA0,pA1,NT-1,false,false,false); RESC();
  { float sacc=pB0[0]+pB0[1]; _Pragma("unroll") for(int r=2;r<16;++r)sacc+=pB0[r]; _Pragma("unroll") for(int r=0;r<16;++r)sacc+=pB1[r]; l_reg+=sacc;
    pw0=(u32x4){PKW(pB0,0),PKW(pB0,2),PKW(pB0,4),PKW(pB0,6)};pw1=(u32x4){PKW(pB0,8),PKW(pB0,10),PKW(pB0,12),PKW(pB0,14)};pw2=(u32x4){PKW(pB1,0),PKW(pB1,2),PKW(pB1,4),PKW(pB1,6)};pw3=(u32x4){PKW(pB1,8),PKW(pB1,10),PKW(pB1,12),PKW(pB1,14)};
    SBAR(); pv(o,vb0+sl_cur,PAF(0),PAF(1),PAF(2),PAF(3)); }
  #undef PKW
  #undef PAF
  #undef VFR
  #undef PIN
  #undef MX3
  #undef GAPA
  #undef GAPB
  #undef EX
  #undef VRD
  #undef KRD
  #undef STEP
  #undef ENDW
  {auto rr=__builtin_amdgcn_permlane32_swap(__float_as_uint(l_reg),__float_as_uint(l_reg),false,false);l_reg=__uint_as_float(rr[0])+__uint_as_float(rr[1]);}
  if(hi==0)wsf[32+r32]=l_reg;asm volatile("s_waitcnt lgkmcnt(0)":::"memory");
  float rli[16];
  #pragma unroll
  for(int r=0;r<16;++r)rli[r]=__builtin_amdgcn_rcpf(wsf[32+crow(r,hi)]);
  bf16*Ow=O+(rowbase+q0+wid*QBLK)*PO;
  { bf16*stg=(bf16*)(shm+LDS_OST)+wid*2048;
    #pragma unroll
    for(int r=0;r<16;++r){const int orow=crow(r,hi);
      #pragma unroll
      for(int d0=0;d0<2;++d0)stg[orow*64+d0*32+r32]=__float2bfloat16(o[d0][r]*rli[r]);}
    asm volatile("s_waitcnt lgkmcnt(0)":::"memory");
    #pragma unroll
    for(int i=0;i<4;++i){const int row=i*8+(lane>>3),ch=lane&7; const u32x4 v=*(const u32x4*)(stg+row*64+ch*8); ATTN_STORE16(Ow+(long)row*PO+ch*8,v);} }
  asm volatile("s_waitcnt lgkmcnt(0)\n\ts_barrier":::"memory");
  #undef DMA_K
  #undef DMA_V
  #undef CMASK
  #undef START
  #undef RESC
  #undef ROT
}
constexpr int ATTN_LDS_BYTES=LDS_BYTES;
#undef SBAR
#undef WAIT_BAR
}

#ifndef USE_MFMA_ATTN
#define USE_MFMA_ATTN 1
#endif
__device__ __forceinline__ void phase_diff_mfma(char* shm, const Ctx& a, const LayerP& P, int vcu, int G) {
    bf16* proj = (bf16*)(a.ws + WS_H); bf16* o12 = (bf16*)(a.ws + WS_STATE);
    float lam;
    { float s1 = 0.f, s2 = 0.f;
      for (int i = 0; i < 64; ++i) { s1 += P.e0[i] * P.e1[i]; s2 += P.e2[i] * P.e3[i]; }
      lam = __expf(s1) - __expf(s2) + LAMBDA_INIT; }
    const float* head_norm = P.e4;
    for (int j = vcu; j < NB * DIFF_H * 32; j += G) {
        const int jj = j & 255, pass = j >> 8, bh = jj >> 4, s = jj & 15;
        const int qb = pass ? 31 - s : s, h = bh & 7, b = bh >> 3;
        const float slope2 = exp2f(-(float)(h + 1)) * LOG2E;
#pragma nounroll
        for (int sp = 0; sp < 4; ++sp) {
            const int r = sp >> 1, vh = sp & 1;
            attn_body::attn_unit<8>(b, qb, (const attn_body::bf16*)(proj + h * 128 + r * 64), (const attn_body::bf16*)(proj + 1024 + h * 128 + r * 64),
                                    (const attn_body::bf16*)(proj + 2048 + h * 128 + vh * 64), (attn_body::bf16*)(o12 + r * 1024 + h * 128 + vh * 64), slope2, shm);
        }
        asm volatile("s_waitcnt vmcnt(0)" ::: "memory"); __syncthreads();
        const int tid2 = otid(), lane = tid2 & 63, wave = tid2 >> 6;
        const size_t row0 = (size_t)b * T + (size_t)qb * 256 + wave * 32;
        const float hn0 = head_norm[2 * lane], hn1 = head_norm[2 * lane + 1];
        for (int i4 = 0; i4 < 32; i4 += 4) {
            unsigned w1[4], w2[4];
#pragma unroll
            for (int k = 0; k < 4; ++k) { w1[k] = *(const unsigned*)(o12 + (row0 + i4 + k) * 2048 + h * 128 + 2 * lane); w2[k] = *(const unsigned*)(o12 + (row0 + i4 + k) * 2048 + 1024 + h * 128 + 2 * lane); }
#pragma unroll
            for (int k = 0; k < 4; ++k) { const float oa = bflo(w1[k]) - lam * bflo(w2[k]), ob = bfhi(w1[k]) - lam * bfhi(w2[k]);
                const float ss = wave_sum(oa * oa + ob * ob);
                const float rs = (1.0f / sqrtf(ss * (1.0f / 128.0f) + EPS)) * (1.0f - LAMBDA_INIT);
                *(unsigned*)(proj + (row0 + i4 + k) * DIFF_PITCH + h * 128 + 2 * lane) = pk2(oa * rs * hn0, ob * rs * hn1); }
        }
    }
}

constexpr int PH_PER_LAYER = 8, NPHASE = 4 * PH_PER_LAYER + 1;
__host__ __device__ inline bool phase_is_noop(int ph) {
    if (ph >= 4 * PH_PER_LAYER) return false;
    const int L = ph / PH_PER_LAYER, s = ph % PH_PER_LAYER;
    const bool gla = (L == 0 || L == 3);
    return (s == 3 || s == 4) && !gla;
}

__global__ void __launch_bounds__(NTHR, 2) trunk_fwd(Args kargs) {
    extern __shared__ __attribute__((aligned(16))) unsigned char lds_raw[];
    LAS unsigned char* lds = (LAS unsigned char*)lds_raw;
    const int tid = threadIdx.x;
    const int G0 = gridDim.x; const int bx = blockIdx.x;
    const int vcu0 = (G0 % 8 == 0) ? (bx % 8) * (G0 / 8) + bx / 8 : bx;
    for (int u = tid; u < (LDS_BYTES - LDSCTL_OFF) / 4; u += NTHR) ((LAS unsigned*)(lds + LDSCTL_OFF))[u] = 0u;
    __syncthreads();
    unsigned* ctl = (unsigned*)(kargs.ws + WS_CTL);
    const int ph_lo = kargs.ph_lo, ph_hi = kargs.ph_hi; const bool multi = (ph_hi - ph_lo) > 1;
    if (multi) (void)xcd_barrier_post(ctl + 4096, (volatile LAS unsigned*)(lds + MISC_OFF) + 8);
    bool first_seam = true;
    for (int ph = ph_lo; ph < ph_hi; ++ph) {
        if (phase_is_noop(ph)) continue;
        int vcu = vcu0, G = G0; asm volatile("" : "+s"(vcu), "+s"(G));
        const CAS Args* ap = (const CAS Args*)__builtin_amdgcn_kernarg_segment_ptr(); asm volatile("" : "+s"(ap));
        Ctx args; args.in0 = ap->in[0]; args.in42 = ap->in[42]; args.out = ap->out; args.ws = ap->ws;
        bf16* Wb = (bf16*)(args.ws + WS_W); bf16* XB = (bf16*)(args.ws + WS_XB); bf16* HB = (bf16*)(args.ws + WS_H);
        float* SSQ = (float*)(args.ws + WS_SSQ); float* VSSQ = (float*)(args.ws + WS_VSSQ);
        if (ph == 4 * PH_PER_LAYER) { phase_final(args, vcu, G); }
        else {
            const int L = ph / PH_PER_LAYER, s = ph % PH_PER_LAYER;
            const LayerP P = layer_params((const CAS cfptr*)ap, L);
            if (s == 0) phase_conv(lds, args, P, L, vcu, G);
            else if (s == 1) { EpiIn E{P.kind, HB, SSQ, (P.kind == K_GLA) ? P.e2 : P.e0, VSSQ}; run_gemm(lds, XB, D, Wb + WOFF_IN, NTOK, P.nin, D, E, vcu, G); }
            else if (s == 2) { if (P.kind == K_GLA) phase_gla_kv(lds, args, vcu, G); else if (P.kind == K_DIFF) {
#if USE_MFMA_ATTN
                    phase_diff_mfma((char*)lds_raw, args, P, vcu, G);
#else
                    phase_diff(lds, args, P, vcu, G);
#endif
                } else phase_sgu(lds, args, P, vcu, G); }
            else if (s == 3) phase_gla_scan(args, vcu, G);
            else if (s == 4) phase_gla_out(lds, args, P, vcu, G);
            else if (s == 5) { EpiRes E{(L == 0) ? args.in0 : args.out, args.out, XB, SSQ}; run_gemm(lds, HB + P.mixoff, P.nin, Wb + WOFF_OUT, NTOK, D, D, E, vcu, G); }
            else if (s == 6) { EpiHid E{HB, SSQ}; run_gemm(lds, XB, D, Wb + WOFF_1, NTOK, FF, D, E, vcu, G); }
            else { EpiRes E{args.out, args.out, XB, SSQ}; run_gemm(lds, HB, FF, Wb + WOFF_2, NTOK, D, FF, E, vcu, G); }
        }
        if (ph + 1 < ph_hi) {
            if (first_seam) { cg::this_grid().sync(); first_seam = false; }
            else { XcdBarrier bb; bb.bar = (unsigned*)(ap->ws + WS_CTL) + 4096; bb.x = xb_xcc_id(); bb.st = (volatile LAS unsigned*)(lds + MISC_OFF) + 8; xcd_barrier(bb); }
        }
    }
}

extern "C" void kernel_launch(void* const* d_in, const int* in_sizes, int n_in, void* d_out, int out_size, void* d_ws, size_t ws_size, hipStream_t stream) {
    static int grid = 0;
    if (grid == 0) {
        if (n_in != 43 || in_sizes[0] != NTOK * D || out_size != NTOK * D || ws_size < WS_END) {
            fprintf(stderr, "kernel_launch: unexpected problem (n_in %d, in0 %d, out %d, ws %zu); nothing launched\n", n_in, n_in > 0 ? in_sizes[0] : -1, out_size, ws_size); grid = -1; return; }
        int dev = 0, cus = 0, per_cu = 0;
        if (hipGetDevice(&dev) != hipSuccess || hipDeviceGetAttribute(&cus, hipDeviceAttributeMultiprocessorCount, dev) != hipSuccess) { grid = -1; return; }
        if (hipFuncSetAttribute((const void*)trunk_fwd, hipFuncAttributeMaxDynamicSharedMemorySize, LDS_BYTES) != hipSuccess) { fprintf(stderr, "kernel_launch: hipFuncSetAttribute failed\n"); grid = -1; return; }
        if (hipOccupancyMaxActiveBlocksPerMultiprocessor(&per_cu, (const void*)trunk_fwd, NTHR, LDS_BYTES) != hipSuccess || per_cu < 1) { fprintf(stderr, "kernel_launch: occupancy query says %d blocks/CU\n", per_cu); per_cu = 1; }
        (void)hipGetLastError();
        grid = cus;
    }
    if (grid < 0) return;
    (void)hipMemsetAsync((char*)d_ws + WS_CTL, 0, CTL_ZERO_BYTES, stream);
    Args a{};
    for (int i = 0; i < 43; ++i) a.in[i] = (const float*)d_in[i];
    a.out = (float*)d_out; a.ws = (unsigned char*)d_ws;
#if MK_ONE_LAUNCH
    a.ph_lo = 0; a.ph_hi = NPHASE;
    void* kargs[] = {&a};
    hipError_t e = hipLaunchCooperativeKernel((const void*)trunk_fwd, dim3(grid), dim3(NTHR), kargs, LDS_BYTES, stream);
    if (e != hipSuccess) fprintf(stderr, "kernel_launch: cooperative launch failed: %s (grid %d)\n", hipGetErrorString(e), grid);
#else
    for (int ph = 0; ph < NPHASE; ++ph) {
        if (phase_is_noop(ph)) continue;
        a.ph_lo = ph; a.ph_hi = ph + 1;
        hipLaunchKernelGGL(trunk_fwd, dim3(grid), dim3(NTHR), LDS_BYTES, stream, a);
    }
#endif
}
```

```cpp
#include <hip/hip_runtime.h>
#include <hip/hip_cooperative_groups.h>
#include <cstdio>
#include <cstdint>
namespace cg = cooperative_groups;

#ifndef MK_ONE_LAUNCH
#define MK_ONE_LAUNCH 1
#endif

#define GAS __attribute__((address_space(1)))
#define LAS __attribute__((address_space(3)))
typedef unsigned short bf16;
typedef unsigned v4u __attribute__((ext_vector_type(4)));
typedef unsigned v2u __attribute__((ext_vector_type(2)));
typedef float f32x4 __attribute__((ext_vector_type(4)));

constexpr int NB = 2, T = 8192, D = 1024, NTOK = NB * T, FF = 4096;
constexpr float EPS = 1e-6f;
constexpr float LOG2E = 1.4426950408889634f;
constexpr int NWAVES = 8, NTHR = 512;
constexpr int K_GLA = 0, K_DIFF = 1, K_SGU = 2;
constexpr int GLA_H = 4, GLA_HK = 128, GLA_HV = 256, GLA_C = 64, GLA_NC = T / GLA_C;
constexpr int GLA_PITCH = 3584;
constexpr int DIFF_H = 8, DIFF_PITCH = 3072;
constexpr float LAMBDA_INIT = 0.35551069f;
constexpr int SGU_PITCH = 2048, SGU_C = 128, SGU_G = 8;

constexpr size_t MiB = 1u << 20;
constexpr size_t WS_CTL = 0, CTL_ZERO_BYTES = 1 * MiB;
constexpr size_t WS_SSQ = 1 * MiB;
constexpr size_t WS_VSSQ = 2 * MiB;
constexpr size_t WS_DEC = 3 * MiB;
constexpr size_t WS_W = 4 * MiB;
constexpr size_t WS_XB = 29 * MiB;
constexpr size_t WS_STATE = 61 * MiB;
constexpr size_t WS_H = 125 * MiB;
constexpr size_t WS_END = 253 * MiB;
constexpr size_t WOFF_IN = 0, WOFF_OUT = (size_t)3584 * 1024, WOFF_1 = WOFF_OUT + (size_t)1024 * 1024, WOFF_2 = WOFF_1 + (size_t)4096 * 1024;

constexpr int RING_BYTES = 131072, LDSCTL_OFF = RING_BYTES, MISC_OFF = LDSCTL_OFF + 320, LDS_BYTES = 147456;

#define RLX_AGENT __ATOMIC_RELAXED, __HIP_MEMORY_SCOPE_AGENT
#define LDS_WAIT() asm volatile("s_waitcnt lgkmcnt(0)" ::: "memory")
__device__ __forceinline__ unsigned f2bf(float f) { unsigned u = __builtin_bit_cast(unsigned, f); return (u + 0x7fffu + ((u >> 16) & 1u)) >> 16; }
__device__ __forceinline__ unsigned pk2(float lo, float hi) { return f2bf(lo) | (f2bf(hi) << 16); }
__device__ __forceinline__ float bf2f(unsigned b) { return __builtin_bit_cast(float, b << 16); }
__device__ __forceinline__ float bflo(unsigned w) { return __builtin_bit_cast(float, w << 16); }
__device__ __forceinline__ float bfhi(unsigned w) { return __builtin_bit_cast(float, w & 0xffff0000u); }
__device__ __forceinline__ int otid() { int t = threadIdx.x; asm volatile("" : "+v"(t)); return t; }
__device__ __forceinline__ float wave_sum(float v) {
#pragma unroll
    for (int o = 1; o < 64; o <<= 1) v += __shfl_xor(v, o);
    return v;
}
__device__ __forceinline__ float wave_max(float v) {
#pragma unroll
    for (int o = 1; o < 64; o <<= 1) v = fmaxf(v, __shfl_xor(v, o));
    return v;
}
__device__ __forceinline__ float gelu_tanh(float x) {
    const float u = 0.7978845608028654f * (x + 0.044715f * x * x * x);
    const float e = __expf(2.f * u);
    const float t = 1.f - 2.f / (e + 1.f);
    return 0.5f * x * (1.f + t);
}
__device__ __forceinline__ float log_sigmoid(float z) { return fminf(z, 0.f) - log1pf(__expf(-fabsf(z))); }

#define XB_TMO      128
#define XB_XCNT(j)  (256  + 64 * (j))
#define XB_XSUB(j)  (1280 + 64 * (j))
#define XB_XGEN(j)  (2304 + 64 * (j))
#define XB_TOP      3328
#define XB_TOPGEN   3392
#define XCD_BAR_WORDS 3456
#define XB_SPIN_CAP (1u << 22)
__device__ __forceinline__ unsigned xb_ld(unsigned* p)              { return __hip_atomic_load(p, __ATOMIC_RELAXED, __HIP_MEMORY_SCOPE_AGENT); }
__device__ __forceinline__ unsigned xb_add(unsigned* p, unsigned v) { return __hip_atomic_fetch_add(p, v, __ATOMIC_RELAXED, __HIP_MEMORY_SCOPE_AGENT); }
__device__ __forceinline__ unsigned xb_xcc_id() { return (unsigned)__builtin_amdgcn_s_getreg((3 << 11) | 20) & 0xFu; }
#define XB_SPIN(cond, bar) do { unsigned _sp = 0; while (cond) { __builtin_amdgcn_s_sleep(1); \
    if ((++_sp & 255u) == 0u) { if (xb_ld(&(bar)[XB_TMO])) break; if (_sp > XB_SPIN_CAP) { atomicAdd(&(bar)[XB_TMO], 1u); break; } } } } while (0)
struct XcdBarrier { unsigned* bar; unsigned x; volatile LAS unsigned* st; };
__device__ __forceinline__ XcdBarrier xcd_barrier_post(unsigned* bar, volatile LAS unsigned* st) {
    XcdBarrier b; b.bar = bar; b.x = xb_xcc_id(); b.st = st;
    if (threadIdx.x == 0) (void)xb_add(&bar[XB_XCNT(b.x)], 1u);
    return b;
}
__device__ __forceinline__ void xcd_barrier_complete(unsigned* bar, unsigned x, unsigned& nloc, unsigned& nx) {
    const unsigned G = gridDim.x * gridDim.y * gridDim.z;
    unsigned sum, cnt, mine, sp = 0u;
    for (;;) {
        sum = 0u; cnt = 0u; mine = 0u;
#pragma unroll
        for (unsigned j = 0; j < 16; ++j) { const unsigned c = xb_ld(&bar[XB_XCNT(j)]); sum += c; cnt += (c > 0u) ? 1u : 0u; mine = (j == x) ? c : mine; }
        if (sum == G) break;
        __builtin_amdgcn_s_sleep(1);
        if ((++sp & 255u) == 0u) { if (xb_ld(&bar[XB_TMO])) break; if (sp > XB_SPIN_CAP) { atomicAdd(&bar[XB_TMO], 1u); break; } }
    }
    nloc = mine > 0u ? mine : 1u; nx = cnt > 0u ? cnt : 1u;
}
__device__ __forceinline__ void xcd_barrier(const XcdBarrier& b) {
    asm volatile("s_waitcnt vmcnt(0)" ::: "memory");
    __syncthreads();
    if (threadIdx.x == 0) {
        unsigned* bar = b.bar;
        __builtin_amdgcn_s_waitcnt(0);
        unsigned nloc = b.st[0], nx = b.st[1];
        if (nloc == 0u) { xcd_barrier_complete(bar, b.x, nloc, nx); b.st[0] = nloc; b.st[1] = nx; }
        const unsigned old = xb_add(&bar[XB_XSUB(b.x)], 1u);
        const unsigned gen = old / nloc;
        if (old + 1u == (gen + 1u) * nloc) {
            __builtin_amdgcn_fence(__ATOMIC_RELEASE, "agent");
            asm volatile("s_waitcnt vmcnt(0)" ::: "memory");
            const unsigned og = xb_add(&bar[XB_TOP], 1u);
            const unsigned tg = og / nx;
            if (og + 1u == (tg + 1u) * nx) xb_add(&bar[XB_TOPGEN], 1u);
            else XB_SPIN(xb_ld(&bar[XB_TOPGEN]) == tg, bar);
            __builtin_amdgcn_fence(__ATOMIC_ACQUIRE, "agent");
            xb_add(&bar[XB_XGEN(b.x)], 1u);
            asm volatile("s_waitcnt vmcnt(0)" ::: "memory");
        } else {
            XB_SPIN(xb_ld(&bar[XB_XGEN(b.x)]) == gen, bar);
            __builtin_amdgcn_fence(__ATOMIC_ACQUIRE, "agent");
            asm volatile("s_waitcnt vmcnt(0)" ::: "memory");
        }
    }
    __syncthreads();
}

struct Args { const float* in[43]; float* out; unsigned char* ws; int ph_lo, ph_hi; };
struct Ctx { const float* in0; const float* in42; float* out; unsigned char* ws; };
struct LayerP {
    int kind;
    const float *norm1, *w_in, *w_out, *norm2, *w1, *w2;
    const float *e0, *e1, *e2, *e3, *e4;
    int nin;
    int mixoff;
};
typedef const float* cfptr;
#define CAS __attribute__((address_space(4)))
__device__ __forceinline__ LayerP layer_params(const CAS cfptr* in, int L) {
    LayerP p;
    const int base = (L == 0) ? 1 : (L == 1) ? 11 : (L == 2) ? 22 : 32;
    p.kind = (L == 1) ? K_DIFF : (L == 2) ? K_SGU : K_GLA;
    const int sh = (p.kind == K_DIFF) ? 1 : 0;
    p.norm1 = in[base]; p.w_in = in[base + 1];
    p.e0 = in[base + 2]; p.e1 = in[base + 3]; p.e2 = in[base + 4]; p.e3 = in[base + 5]; p.e4 = in[base + 6];
    p.w_out = in[base + 6 + sh]; p.norm2 = in[base + 7 + sh]; p.w1 = in[base + 8 + sh]; p.w2 = in[base + 9 + sh];
    p.nin = (p.kind == K_GLA) ? GLA_PITCH : (p.kind == K_DIFF) ? DIFF_PITCH : SGU_PITCH;
    p.mixoff = (p.kind == K_GLA) ? 1024 : 0;
    return p;
}

__device__ __forceinline__ float row_rstd(const float* ssq, int row) {
    const f32x4* p = (const f32x4*)(ssq + (size_t)row * 16);
    const f32x4 a = p[0], b = p[1], c = p[2], d = p[3];
    const float s = ((a.x + a.y) + (a.z + a.w)) + ((b.x + b.y) + (b.z + b.w)) + ((c.x + c.y) + (c.z + c.w)) + ((d.x + d.y) + (d.z + d.w));
    return 1.0f / sqrtf(s * (1.0f / D) + EPS);
}

struct EpiIn {
    int kind; bf16* proj; const float* ssq; const float* bias;
    float* vssq;
    __device__ __forceinline__ float rowscale(int row) const { return row_rstd(ssq, row); }
    __device__ __forceinline__ float apply8(int row, int col0, const float (&v)[8], float rs) const {
        float o[8]; float part = 0.f; int pitch;
        if (kind == K_GLA) { pitch = GLA_PITCH;
            if (col0 < 3072) {
#pragma unroll
                for (int j = 0; j < 8; ++j) o[j] = v[j] * rs;
            } else {
#pragma unroll
                for (int j = 0; j < 8; ++j) o[j] = log_sigmoid(v[j] * rs + bias[col0 - 3072 + j]) * (1.0f / 16.0f);
            }
        } else if (kind == K_DIFF) { pitch = DIFF_PITCH;
            const float sc = (col0 < 1024) ? rs * (0.125f * LOG2E) : rs;
#pragma unroll
            for (int j = 0; j < 8; ++j) o[j] = v[j] * sc;
        } else { pitch = SGU_PITCH;
#pragma unroll
            for (int j = 0; j < 8; ++j) { o[j] = gelu_tanh(v[j] * rs + bias[col0 + j]); }
            if (col0 >= 1024) {
#pragma unroll
                for (int j = 0; j < 8; ++j) part += o[j] * o[j];
            }
        }
        v4u w; w.x = pk2(o[0], o[1]); w.y = pk2(o[2], o[3]); w.z = pk2(o[4], o[5]); w.w = pk2(o[6], o[7]);
        *(v4u*)(proj + (size_t)row * pitch + col0) = w;
        return part;
    }
    __device__ __forceinline__ void store_part(int row, int col0, int idx, float part) const {
        if (kind == K_SGU && col0 >= 1024) vssq[(size_t)row * 16 + idx] = part;
    }
};
struct EpiHid {
    bf16* h; const float* ssq;
    __device__ __forceinline__ float rowscale(int row) const { return row_rstd(ssq, row); }
    __device__ __forceinline__ float apply8(int row, int col0, const float (&v)[8], float rs) const {
        float o[8];
#pragma unroll
        for (int j = 0; j < 8; ++j) { const float a = fmaxf(v[j] * rs, 0.f); o[j] = a * a; }
        v4u w; w.x = pk2(o[0], o[1]); w.y = pk2(o[2], o[3]); w.z = pk2(o[4], o[5]); w.w = pk2(o[6], o[7]);
        *(v4u*)(h + (size_t)row * FF + col0) = w;
        return 0.f;
    }
    __device__ __forceinline__ void store_part(int, int, int, float) const {}
};
struct EpiRes {
    const float* base; float* x; bf16* xb; float* ssq;
    __device__ __forceinline__ float rowscale(int) const { return 1.f; }
    __device__ __forceinline__ float apply8(int row, int col0, const float (&v)[8], float) const {
        const size_t off = (size_t)row * D + col0;
        const f32x4 b0 = *(const f32x4*)(base + off), b1 = *(const f32x4*)(base + off + 4);
        float o[8] = {b0.x + v[0], b0.y + v[1], b0.z + v[2], b0.w + v[3], b1.x + v[4], b1.y + v[5], b1.z + v[6], b1.w + v[7]};
        *(f32x4*)(x + off) = (f32x4){o[0], o[1], o[2], o[3]}; *(f32x4*)(x + off + 4) = (f32x4){o[4], o[5], o[6], o[7]};
        v4u w; w.x = pk2(o[0], o[1]); w.y = pk2(o[2], o[3]); w.z = pk2(o[4], o[5]); w.w = pk2(o[6], o[7]);
        *(v4u*)(xb + off) = w;
        float part = 0.f;
#pragma unroll
        for (int j = 0; j < 8; ++j) part += o[j] * o[j];
        return part;
    }
    __device__ __forceinline__ void store_part(int row, int, int idx, float part) const { ssq[(size_t)row * 16 + idx] = part; }
};

template <class Epi>
__device__ __forceinline__ void gemm_naive(LAS unsigned char* lds, const bf16* A, int lda, const bf16* Bt, int M, int N, int K, const Epi& E, int vcu, int G) {
    LAS float* As = (LAS float*)lds;
    LAS float* Bs = As + 64 * 33;
    const int tid = otid();
    const int nM = M / 64, nN = N / 64;
    const int r = tid >> 3, cgp = tid & 7;
    for (int u = vcu; u < nM * nN; u += G) {
        const int pm = u / nN, pn = u % nN;
        float acc[8];
#pragma unroll
        for (int j = 0; j < 8; ++j) acc[j] = 0.f;
        for (int k0 = 0; k0 < K; k0 += 32) {
            { const int lr = tid >> 3, lc = (tid & 7) * 4;
              const v2u av = *(const v2u*)(A + (size_t)(pm * 64 + lr) * lda + k0 + lc);
              const v2u bv = *(const v2u*)(Bt + (size_t)(pn * 64 + lr) * K + k0 + lc);
              As[lr * 33 + lc + 0] = bflo(av.x); As[lr * 33 + lc + 1] = bfhi(av.x); As[lr * 33 + lc + 2] = bflo(av.y); As[lr * 33 + lc + 3] = bfhi(av.y);
              Bs[lr * 33 + lc + 0] = bflo(bv.x); Bs[lr * 33 + lc + 1] = bfhi(bv.x); Bs[lr * 33 + lc + 2] = bflo(bv.y); Bs[lr * 33 + lc + 3] = bfhi(bv.y); }
            __syncthreads();
#pragma unroll 8
            for (int kk = 0; kk < 32; ++kk) { const float a = As[r * 33 + kk];
#pragma unroll
                for (int j = 0; j < 8; ++j) acc[j] += a * Bs[(cgp * 8 + j) * 33 + kk]; }
            __syncthreads();
        }
        const int row = pm * 64 + r, col0 = pn * 64 + cgp * 8;
        const float rs = E.rowscale(row);
        float part = E.apply8(row, col0, acc, rs);
        part += __shfl_xor(part, 1); part += __shfl_xor(part, 2); part += __shfl_xor(part, 4);
        if (cgp == 0) E.store_part(row, col0, pn & 15, part);
    }
}

__device__ __forceinline__ void transpose_item(const float* W, const float* gain, int K, int N, bf16* WT, int row_off, LAS float* scr, int item, int lane) {
    const int nblk = N / 32, kb = item / nblk, nb = item % nblk, k0 = 64 * kb, n0 = 32 * nb;
#pragma unroll 8
    for (int i = 0; i < 32; ++i) { const int kk = 2 * i + (lane >> 5); const float g = gain ? gain[k0 + kk] : 1.f; scr[kk * 33 + (lane & 31)] = g * W[(size_t)(k0 + kk) * N + n0 + (lane & 31)]; }
    LDS_WAIT(); asm volatile("" ::: "memory");
    const int c = lane & 7;
#pragma unroll
    for (int j = 0; j < 4; ++j) { const int n = (lane >> 3) + 8 * j; const LAS float* s = scr + (8 * c) * 33 + n;
        v4u o; o.x = pk2(s[0 * 33], s[1 * 33]); o.y = pk2(s[2 * 33], s[3 * 33]); o.z = pk2(s[4 * 33], s[5 * 33]); o.w = pk2(s[6 * 33], s[7 * 33]);
        *(GAS v4u*)(WT + (size_t)(row_off + n0 + n) * K + k0 + 8 * c) = o; }
    LDS_WAIT(); asm volatile("" ::: "memory");
}

__device__ __forceinline__ void phase_conv(LAS unsigned char* lds, const Ctx& a, const LayerP& P, int L, int vcu, int G) {
    const int tid = otid(), lane = tid & 63, wave = __builtin_amdgcn_readfirstlane(tid >> 6);
    LAS float* scr = (LAS float*)(lds + wave * 16384);
    bf16* Wb = (bf16*)(a.ws + WS_W);
    const int gw = vcu * NWAVES + wave, NGW = G * NWAVES;
    const int nin_w = (P.kind == K_SGU) ? 2048 : 3072;
    const int I_IN = (D / 64) * (nin_w / 32), I_OUT = (D / 64) * (D / 32), I_1 = (D / 64) * (FF / 32), I_2 = (FF / 64) * (D / 32);
    const int NITEMS = I_IN + I_OUT + I_1 + I_2;
    for (int it = gw; it < NITEMS; it += NGW) {
        int r = it;
        if (r < I_IN) { transpose_item(P.w_in, P.norm1, D, nin_w, Wb + WOFF_IN, 0, scr, r, lane); continue; } r -= I_IN;
        if (r < I_OUT) { transpose_item(P.w_out, nullptr, D, D, Wb + WOFF_OUT, 0, scr, r, lane); continue; } r -= I_OUT;
        if (r < I_1) { transpose_item(P.w1, P.norm2, D, FF, Wb + WOFF_1, 0, scr, r, lane); continue; } r -= I_1;
        transpose_item(P.w2, nullptr, FF, D, Wb + WOFF_2, 0, scr, r, lane);
    }
    if (P.kind == K_GLA) {
        const float* W1 = P.e0; const float* W2 = P.e1;
        for (int e = vcu * NTHR + tid; e < 512 * 1024; e += G * NTHR) {
            const int n = e >> 10, k = e & 1023;
            float s = 0.f;
#pragma unroll
            for (int r = 0; r < 16; ++r) s += W1[k * 16 + r] * W2[r * 512 + n];
            Wb[WOFF_IN + (size_t)(3072 + n) * 1024 + k] = (bf16)f2bf(s * P.norm1[k]);
        }
    }
    if (L == 0) {
        const float* x = a.in0; bf16* xb = (bf16*)(a.ws + WS_XB); float* ssq = (float*)(a.ws + WS_SSQ);
        for (int m = gw; m < NTOK; m += NGW) {
            const f32x4* xr = (const f32x4*)(x + (size_t)m * D) + lane;
            f32x4 v[4]; float s = 0.f;
#pragma unroll
            for (int j = 0; j < 4; ++j) { v[j] = xr[64 * j]; s += (v[j].x * v[j].x + v[j].y * v[j].y) + (v[j].z * v[j].z + v[j].w * v[j].w); }
            s = wave_sum(s);
            v2u* o8 = (v2u*)(xb + (size_t)m * D) + lane;
#pragma unroll
            for (int j = 0; j < 4; ++j) { v2u w; w.x = pk2(v[j].x, v[j].y); w.y = pk2(v[j].z, v[j].w); o8[64 * j] = w; }
            if (lane < 16) ssq[(size_t)m * 16 + lane] = (lane == 0) ? s : 0.f;
        }
    }
}

__device__ __forceinline__ void phase_final(const Ctx& a, int vcu, int G) {
    const int tid = otid(), lane = tid & 63, wave = tid >> 6;
    const int gw = vcu * NWAVES + wave, NGW = G * NWAVES;
    const float* ssq = (const float*)(a.ws + WS_SSQ); const float* g = a.in42;
    for (int m = gw; m < NTOK; m += NGW) {
        const float rs = row_rstd(ssq, m);
        f32x4* xr = (f32x4*)(a.out + (size_t)m * D) + lane; const f32x4* gr = (const f32x4*)g + lane;
#pragma unroll
        for (int j = 0; j < 4; ++j) { f32x4 v = xr[64 * j]; const f32x4 gg = gr[64 * j]; v.x *= rs * gg.x; v.y *= rs * gg.y; v.z *= rs * gg.z; v.w *= rs * gg.w; xr[64 * j] = v; }
    }
}

struct GlaCum { float b0[8], b1[8], tot0, tot1; };
__device__ __forceinline__ void gla_cumsum(GlaCum& c, const bf16* proj, int row0, int h, LAS float* TOT, int tid) {
    const int cp = tid & 63, part = tid >> 6;
#pragma unroll
    for (int i = 0; i < 8; ++i) { const unsigned w = *(const unsigned*)(proj + (size_t)(row0 + 8 * part + i) * GLA_PITCH + 3072 + h * 128 + 2 * cp); c.b0[i] = bflo(w); c.b1[i] = bfhi(w); }
#pragma unroll
    for (int i = 1; i < 8; ++i) { c.b0[i] += c.b0[i - 1]; c.b1[i] += c.b1[i - 1]; }
    TOT[part * 128 + 2 * cp] = c.b0[7]; TOT[part * 128 + 2 * cp + 1] = c.b1[7];
    __syncthreads();
    float o0 = 0.f, o1 = 0.f, t0 = 0.f, t1 = 0.f;
#pragma unroll
    for (int p = 0; p < 8; ++p) { const float x0 = TOT[p * 128 + 2 * cp], x1 = TOT[p * 128 + 2 * cp + 1]; if (p < part) { o0 += x0; o1 += x1; } t0 += x0; t1 += x1; }
#pragma unroll
    for (int i = 0; i < 8; ++i) { c.b0[i] += o0; c.b1[i] += o1; }
    c.tot0 = t0; c.tot1 = t1;
}
__device__ __forceinline__ void phase_gla_kv(LAS unsigned char* lds, const Ctx& a, int vcu, int G) {
    const int tid = otid();
    const bf16* proj = (const bf16*)(a.ws + WS_H); bf16* state = (bf16*)(a.ws + WS_STATE); float* dec = (float*)(a.ws + WS_DEC);
    LAS float* KE = (LAS float*)lds;
    LAS float* V = KE + 64 * 128;
    LAS float* TOT = V + 64 * 256;
    for (int u = vcu; u < NB * GLA_H * GLA_NC; u += G) {
        const int n = u % GLA_NC, bh = u / GLA_NC, h = bh % GLA_H, b = bh / GLA_H;
        const int row0 = b * T + n * GLA_C;
        GlaCum c; gla_cumsum(c, proj, row0, h, TOT, tid);
        const int cp = tid & 63, part = tid >> 6;
#pragma unroll
        for (int i = 0; i < 8; ++i) { const int t = 8 * part + i; const unsigned w = *(const unsigned*)(proj + (size_t)(row0 + t) * GLA_PITCH + 512 + h * 128 + 2 * cp);
            KE[t * 128 + 2 * cp] = bflo(w) * __expf(c.tot0 - c.b0[i]); KE[t * 128 + 2 * cp + 1] = bfhi(w) * __expf(c.tot1 - c.b1[i]); }
        if (part == 0) { dec[(size_t)u * 128 + 2 * cp] = __expf(c.tot0); dec[(size_t)u * 128 + 2 * cp + 1] = __expf(c.tot1); }
        { const int vp = tid & 127, rp = tid >> 7;
#pragma unroll
          for (int i = 0; i < 16; ++i) { const int t = 16 * rp + i; const unsigned w = *(const unsigned*)(proj + (size_t)(row0 + t) * GLA_PITCH + 1024 + h * 256 + 2 * vp);
              V[t * 256 + 2 * vp] = bflo(w); V[t * 256 + 2 * vp + 1] = bfhi(w); } }
        __syncthreads();
        const int vd = tid & 255, kh = tid >> 8;
        float acc[64];
#pragma unroll
        for (int j = 0; j < 64; ++j) acc[j] = 0.f;
        for (int t = 0; t < 64; ++t) { const float v = V[t * 256 + vd];
#pragma unroll
            for (int j = 0; j < 64; ++j) acc[j] += KE[t * 128 + kh * 64 + j] * v; }
        bf16* sp = state + ((size_t)u * 256 + vd) * 128 + kh * 64;
#pragma unroll
        for (int j = 0; j < 64; j += 8) { v4u w; w.x = pk2(acc[j], acc[j + 1]); w.y = pk2(acc[j + 2], acc[j + 3]); w.z = pk2(acc[j + 4], acc[j + 5]); w.w = pk2(acc[j + 6], acc[j + 7]); *(v4u*)(sp + j) = w; }
        __syncthreads();
    }
}
__device__ __forceinline__ void phase_gla_scan(const Ctx& a, int vcu, int G) {
    unsigned* state = (unsigned*)(a.ws + WS_STATE); const float* dec = (const float*)(a.ws + WS_DEC);
    for (int gid = vcu * NTHR + otid(); gid < NB * GLA_H * 16384; gid += G * NTHR) {
        const int bh = gid >> 14, e = gid & 16383, kp = e & 63;
        unsigned* sp = state + (size_t)bh * GLA_NC * 16384 + e;
        const float* dp = dec + (size_t)bh * GLA_NC * 128 + 2 * kp;
        float s0 = 0.f, s1 = 0.f;
        for (int n0 = 0; n0 < GLA_NC; n0 += 8) {
            unsigned w[8]; float d0[8], d1[8];
#pragma unroll
            for (int i = 0; i < 8; ++i) { w[i] = sp[(size_t)(n0 + i) * 16384]; d0[i] = dp[(n0 + i) * 128]; d1[i] = dp[(n0 + i) * 128 + 1]; }
#pragma unroll
            for (int i = 0; i < 8; ++i) { sp[(size_t)(n0 + i) * 16384] = pk2(s0, s1); s0 = d0[i] * s0 + bflo(w[i]); s1 = d1[i] * s1 + bfhi(w[i]); }
        }
    }
}
__device__ __forceinline__ void phase_gla_out(LAS unsigned char* lds, const Ctx& a, const LayerP& P, int vcu, int G) {
    const int tid = otid(), lane = tid & 63, wave = tid >> 6;
    bf16* proj = (bf16*)(a.ws + WS_H); const bf16* state = (const bf16*)(a.ws + WS_STATE);
    LAS float* QD = (LAS float*)lds;
    LAS float* KI = QD + 64 * 128;
    LAS float* ATT = KI + 64 * 128;
    LAS unsigned* Vb = (LAS unsigned*)(ATT + 64 * 64);
    LAS float* TOT = (LAS float*)(Vb + 64 * 128);
    LAS float* RSS = TOT + 8 * 128;
    for (int u = vcu; u < NB * GLA_H * GLA_NC; u += G) {
        const int n = u % GLA_NC, bh = u / GLA_NC, h = bh % GLA_H, b = bh / GLA_H;
        const int row0 = b * T + n * GLA_C;
        GlaCum c; gla_cumsum(c, proj, row0, h, TOT, tid);
        const int cp = tid & 63, part = tid >> 6;
#pragma unroll
        for (int i = 0; i < 8; ++i) { const int t = 8 * part + i;
            const unsigned wq = *(const unsigned*)(proj + (size_t)(row0 + t) * GLA_PITCH + h * 128 + 2 * cp);
            const unsigned wk = *(const unsigned*)(proj + (size_t)(row0 + t) * GLA_PITCH + 512 + h * 128 + 2 * cp);
            const float e0 = __expf(c.b0[i]), e1 = __expf(c.b1[i]);
            QD[t * 128 + 2 * cp] = bflo(wq) * 0.08838834764831845f * e0; QD[t * 128 + 2 * cp + 1] = bfhi(wq) * 0.08838834764831845f * e1;
            KI[t * 128 + 2 * cp] = bflo(wk) / e0; KI[t * 128 + 2 * cp + 1] = bfhi(wk) / e1; }
        { const int vp = tid & 127, rp = tid >> 7;
#pragma unroll
          for (int i = 0; i < 16; ++i) { const int t = 16 * rp + i; Vb[t * 128 + vp] = *(const unsigned*)(proj + (size_t)(row0 + t) * GLA_PITCH + 1024 + h * 256 + 2 * vp); } }
        __syncthreads();
        { const int cc = tid >> 3, s0 = (tid & 7) * 8; float acc[8];
#pragma unroll
          for (int j = 0; j < 8; ++j) acc[j] = 0.f;
          for (int d = 0; d < 128; ++d) { const float q = QD[cc * 128 + d];
#pragma unroll
              for (int j = 0; j < 8; ++j) acc[j] += q * KI[(s0 + j) * 128 + d]; }
#pragma unroll
          for (int j = 0; j < 8; ++j) ATT[cc * 64 + s0 + j] = (s0 + j <= cc) ? acc[j] : 0.f; }
        __syncthreads();
        const int vd = tid & 255, ch = tid >> 8;
        float acc[32];
#pragma unroll
        for (int j = 0; j < 32; ++j) acc[j] = 0.f;
        for (int s = 0; s < 64; ++s) { const unsigned w = Vb[s * 128 + (vd >> 1)]; const float v = (vd & 1) ? bfhi(w) : bflo(w);
#pragma unroll
            for (int j = 0; j < 32; ++j) acc[j] += ATT[(ch * 32 + j) * 64 + s] * v; }
        { const bf16* sp = state + ((size_t)u * 256 + vd) * 128;
          for (int d0 = 0; d0 < 128; d0 += 8) { const v4u w = *(const v4u*)(sp + d0);
              const float st[8] = {bflo(w.x), bfhi(w.x), bflo(w.y), bfhi(w.y), bflo(w.z), bfhi(w.z), bflo(w.w), bfhi(w.w)};
#pragma unroll
              for (int dd = 0; dd < 8; ++dd) {
#pragma unroll
                  for (int j = 0; j < 32; ++j) acc[j] += QD[(ch * 32 + j) * 128 + d0 + dd] * st[dd]; } } }
#pragma unroll
        for (int j = 0; j < 32; ++j) { const float s = wave_sum(acc[j] * acc[j]); if (lane == 0) RSS[wave * 32 + j] = s; }
        __syncthreads();
        const float hn = P.e3[vd];
#pragma unroll
        for (int j = 0; j < 32; ++j) { const int cc = ch * 32 + j;
            const float ss = (RSS[(ch * 4 + 0) * 32 + j] + RSS[(ch * 4 + 1) * 32 + j]) + (RSS[(ch * 4 + 2) * 32 + j] + RSS[(ch * 4 + 3) * 32 + j]);
            const float rs = 1.0f / sqrtf(ss * (1.0f / 256.0f) + EPS);
            const float g = bf2f(proj[(size_t)(row0 + cc) * GLA_PITCH + 2048 + h * 256 + vd]);
            const float o = acc[j] * rs * hn * (g / (1.f + __expf(-g)));
            proj[(size_t)(row0 + cc) * GLA_PITCH + 1024 + h * 256 + vd] = (bf16)f2bf(o); }
        __syncthreads();
    }
}

__device__ __forceinline__ void phase_sgu(LAS unsigned char* lds, const Ctx& a, const LayerP& P, int vcu, int G) {
    const int tid = otid();
    bf16* proj = (bf16*)(a.ws + WS_H); const float* vssq = (const float*)(a.ws + WS_VSSQ);
    const float* v_norm = P.e1; const float* w_s = P.e2; const float* b_s = P.e3;
    LAS float* W = (LAS float*)lds;
    LAS float* V = W + 128 * 128;
    for (int u = vcu; u < NB * (T / SGU_C) * SGU_G; u += G) {
        const int g = u % SGU_G, bc = u / SGU_G;
        const int row0 = bc * SGU_C;
        for (int e = tid; e < 128 * 128; e += NTHR) { const int t = e >> 7, s = e & 127;
            const float rs = row_rstd(vssq, row0 + s);
            W[e] = (s <= t) ? w_s[(size_t)g * 16384 + e] * rs : 0.f;
            V[e] = bf2f(proj[(size_t)(row0 + t) * SGU_PITCH + 1024 + g * 128 + s]); }
        __syncthreads();
        const int d = tid & 127, tq = tid >> 7;
        float acc[32];
#pragma unroll
        for (int j = 0; j < 32; ++j) acc[j] = 0.f;
        for (int s = 0; s < 128; ++s) { const float v = V[s * 128 + d];
#pragma unroll
            for (int j = 0; j < 32; ++j) acc[j] += W[(tq + 4 * j) * 128 + s] * v; }
        const float vn = v_norm[g * 128 + d];
#pragma unroll
        for (int j = 0; j < 32; ++j) { const int t = tq + 4 * j;
            const float sv = vn * acc[j] + b_s[g * 128 + t];
            bf16* up = proj + (size_t)(row0 + t) * SGU_PITCH + g * 128 + d;
            *up = (bf16)f2bf(bf2f(*up) * sv); }
        __syncthreads();
    }
}

__device__ __forceinline__ void phase_diff(LAS unsigned char* lds, const Ctx& a, const LayerP& P, int vcu, int G) {
    const int tid = otid(), lane = tid & 63, wave = tid >> 6;
    bf16* proj = (bf16*)(a.ws + WS_H);
    LAS float* Ks = (LAS float*)lds;
    LAS float* Vs = Ks + 64 * 132;
    LAS float* Qs = Vs + 64 * 128;
    LAS float* Ps = Qs + 32 * 128;
    float lam;
    { float s1 = 0.f, s2 = 0.f;
      for (int i = 0; i < 64; ++i) { s1 += P.e0[i] * P.e1[i]; s2 += P.e2[i] * P.e3[i]; }
      lam = __expf(s1) - __expf(s2) + LAMBDA_INIT; }
    const float* head_norm = P.e4;
    const int NU = NB * DIFF_H * (T / 32);
    for (int u = vcu; u < NU; u += G) {
        const int qb = (T / 32 - 1) - (u / (NB * DIFF_H)), bh = u % (NB * DIFF_H), h = bh % DIFF_H, b = bh / DIFF_H;
        const int q0 = qb * 32; const size_t rowbase = (size_t)b * T;
        const float slope2 = exp2f(-(float)(h + 1)) * LOG2E;
        __syncthreads();
        for (int e = tid; e < 32 * 64; e += NTHR) { const int r = e >> 6, c2 = e & 63;
            const unsigned w = *(const unsigned*)(proj + (rowbase + q0 + r) * DIFF_PITCH + h * 128 + 2 * c2);
            Qs[r * 128 + 2 * c2] = bflo(w); Qs[r * 128 + 2 * c2 + 1] = bfhi(w); }
        float m1[4], l1[4], m2[4], l2[4], oa1[4], ob1[4], oa2[4], ob2[4];
#pragma unroll
        for (int i = 0; i < 4; ++i) { m1[i] = -1e30f; m2[i] = -1e30f; l1[i] = 0.f; l2[i] = 0.f; oa1[i] = 0.f; ob1[i] = 0.f; oa2[i] = 0.f; ob2[i] = 0.f; }
        const int ntile = (q0 + 31) / 64 + 1;
        for (int kt = 0; kt < ntile; ++kt) {
            __syncthreads();
            for (int e = tid; e < 64 * 64; e += NTHR) { const int r = e >> 6, c2 = e & 63;
                const unsigned wk = *(const unsigned*)(proj + (rowbase + kt * 64 + r) * DIFF_PITCH + 1024 + h * 128 + 2 * c2);
                const unsigned wv = *(const unsigned*)(proj + (rowbase + kt * 64 + r) * DIFF_PITCH + 2048 + h * 128 + 2 * c2);
                Ks[r * 132 + 2 * c2] = bflo(wk); Ks[r * 132 + 2 * c2 + 1] = bfhi(wk);
                Vs[r * 128 + 2 * c2] = bflo(wv); Vs[r * 128 + 2 * c2 + 1] = bfhi(wv); }
            __syncthreads();
            const int kpos = kt * 64 + lane;
#pragma unroll
            for (int i = 0; i < 4; ++i) {
                const int r = wave + 8 * i, qpos = q0 + r;
                if (kt * 64 > qpos) continue;
                float s1 = 0.f, s2 = 0.f;
                const LAS f32x4* qp = (const LAS f32x4*)(Qs + r * 128); const LAS f32x4* kp = (const LAS f32x4*)(Ks + lane * 132);
#pragma unroll
                for (int d = 0; d < 16; ++d) { const f32x4 q = qp[d], k = kp[d]; s1 += (q.x * k.x + q.y * k.y) + (q.z * k.z + q.w * k.w); }
#pragma unroll
                for (int d = 16; d < 32; ++d) { const f32x4 q = qp[d], k = kp[d]; s2 += (q.x * k.x + q.y * k.y) + (q.z * k.z + q.w * k.w); }
                const float bias = slope2 * (float)(qpos - kpos);
                const bool ok = kpos <= qpos;
                s1 = ok ? s1 - bias : -1e30f; s2 = ok ? s2 - bias : -1e30f;
                const float mn1 = fmaxf(m1[i], wave_max(s1)), mn2 = fmaxf(m2[i], wave_max(s2));
                const float p1 = ok ? exp2f(s1 - mn1) : 0.f, p2 = ok ? exp2f(s2 - mn2) : 0.f;
                const float a1 = exp2f(m1[i] - mn1), a2 = exp2f(m2[i] - mn2);
                l1[i] = l1[i] * a1 + wave_sum(p1); l2[i] = l2[i] * a2 + wave_sum(p2); m1[i] = mn1; m2[i] = mn2;
                Ps[wave * 128 + lane] = p1; Ps[wave * 128 + 64 + lane] = p2;
                LDS_WAIT();
                float x1 = 0.f, y1 = 0.f, x2 = 0.f, y2 = 0.f;
                for (int j = 0; j < 64; ++j) { const float pa = Ps[wave * 128 + j], pb = Ps[wave * 128 + 64 + j]; const float va = Vs[j * 128 + lane], vb = Vs[j * 128 + 64 + lane];
                    x1 += pa * va; y1 += pa * vb; x2 += pb * va; y2 += pb * vb; }
                oa1[i] = oa1[i] * a1 + x1; ob1[i] = ob1[i] * a1 + y1; oa2[i] = oa2[i] * a2 + x2; ob2[i] = ob2[i] * a2 + y2;
                LDS_WAIT();
            }
        }
#pragma unroll
        for (int i = 0; i < 4; ++i) {
            const int r = wave + 8 * i;
            const float oa = oa1[i] / l1[i] - lam * (oa2[i] / l2[i]), ob = ob1[i] / l1[i] - lam * (ob2[i] / l2[i]);
            const float ss = wave_sum(oa * oa + ob * ob);
            const float rs = (1.0f / sqrtf(ss * (1.0f / 128.0f) + EPS)) * (1.0f - LAMBDA_INIT);
            bf16* op = proj + (rowbase + q0 + r) * DIFF_PITCH + h * 128;
            op[lane] = (bf16)f2bf(oa * rs * head_norm[lane]); op[64 + lane] = (bf16)f2bf(ob * rs * head_norm[64 + lane]);
        }
    }
}

namespace pg8 {
#define PG8_LAS __attribute__((address_space(3)))
typedef unsigned short bf16_t;
typedef short bf16x8 __attribute__((ext_vector_type(8)));
typedef float f32x4 __attribute__((ext_vector_type(4)));
typedef unsigned u32x4 __attribute__((ext_vector_type(4)));
constexpr int BM = 256, BK = 64, HALF = 128, HTB = HALF * BK * 2  , STAGE_BYTES = 8 * HTB, NXCD = 8, WGM = 8;

__host__ __device__ __forceinline__ int lds_byte(int r, int c) { const int st = (r >> 4) * 2 + (c >> 5), rr = r & 15, cc = c & 31, ob = rr * 64 + cc * 2; return st * 1024 + (ob ^ (((ob >> 9) & 1) << 5)); }
__host__ __device__ __forceinline__ void stage_rc(int b, int& R, int& C) { const int st = b / 1024, sb = b % 1024, swz = sb ^ (((sb >> 9) & 1) << 5); R = (st >> 1) * 16 + swz / 64; C = (st & 1) * 32 + (swz % 64) / 2; }
__host__ __device__ __forceinline__ int perm32(int rho) { const int n = rho >> 4, i = rho & 15; return 8 * (i >> 2) + 4 * n + (i & 3); }

struct Unit { int pm, pn; };
struct Gemm { const bf16_t* A; int lda; const bf16_t* Bt; int M, N, K; };

struct StaticOrder {
    int nM, nN, nwg, G, c;
    __host__ __device__ void init(int M, int N, int G_, int c_) { nM = M / BM; nN = N / BM; nwg = nM * nN; G = G_; c = c_; }
    __host__ __device__ bool next(int i, Unit& u) const {
        const long L = (long)i * G + c; if (L >= nwg) return false;
        int wgid = (int)L; { const int q = nwg / NXCD, r = nwg % NXCD, xcd = wgid % NXCD, off = wgid / NXCD; wgid = (xcd < r ? xcd * (q + 1) : r * (q + 1) + (xcd - r) * q) + off; }
        const int nig = WGM * nN, gid = wgid / nig, fm = gid * WGM, gsz = (nM - fm) < WGM ? (nM - fm) : WGM;
        u.pm = fm + ((wgid % nig) % gsz); u.pn = (wgid % nig) / gsz; return true;
    }
    __device__ __forceinline__ void a_ready(const Unit&) const {}
    __device__ __forceinline__ void done(const Unit&) const {}
};

template <class Epi, class Sched, bool ALIGN_EPI = false, bool SP2 = false>
__device__ __forceinline__ void gemm_phase(PG8_LAS unsigned char* lds, const Gemm g, const Sched& S, const Epi& E) {
    const int tid = otid(), wid = __builtin_amdgcn_readfirstlane(tid >> 6), lane = tid & 63, wr = wid >> 2, wc = wid & 3, fr = lane & 15, fq = lane >> 4;
    const int K = g.K, nt = K / BK, lda = g.lda;
    unsigned voffA[2], voffB[2];
#pragma unroll
    for (int i = 0; i < 2; ++i) { int R, C; stage_rc(tid * 16 + i * 8192, R, C); const int Rb = Epi::PERM ? ((R & ~31) + perm32(R & 31)) : R;
        voffA[i] = (unsigned)(R * lda + C) * 2u; voffB[i] = (unsigned)(Rb * K + C) * 2u; }
    const size_t kstep = (size_t)(BK * 2);
    const size_t hstepA = (size_t)HALF * lda * 2, hstepB = (size_t)HALF * K * 2;
    const size_t tstepA = 2 * hstepA, tstepB = 2 * hstepB;
    const unsigned ldsw = (unsigned)wid * 1024u;
    const int aoff = lds_byte(wr * 64 + fr, fq * 8), boff = lds_byte(wc * 32 + fr, fq * 8);
#define PG8_SA(b, h) (((b) * 2 + (h)) * HTB)
#define PG8_SB(b, h) ((4 + (b) * 2 + (h)) * HTB)
#define PG8_STAGE(bufoff, gbase, voff) do { _Pragma("unroll") for (int _i = 0; _i < 2; ++_i) \
        __builtin_amdgcn_global_load_lds((const unsigned*)((const char*)(gbase) + (voff)[_i]), (PG8_LAS unsigned*)(lds + (bufoff) + ldsw + _i * 8192), 16, 0, 0); } while (0)
#define PG8_LDA(dst, b, h) do { _Pragma("unroll") for (int m = 0; m < 4; ++m) _Pragma("unroll") for (int k = 0; k < 2; ++k) dst[m][k] = *(const PG8_LAS bf16x8*)(lds + PG8_SA(b, h) + aoff + m * 2048 + k * 1024); } while (0)
#define PG8_LDB(dst, b, h) do { _Pragma("unroll") for (int n = 0; n < 2; ++n) _Pragma("unroll") for (int k = 0; k < 2; ++k) dst[n][k] = *(const PG8_LAS bf16x8*)(lds + PG8_SB(b, h) + boff + n * 2048 + k * 1024); } while (0)
#define PG8_MMA(ai, bj, At, Bt) do { __builtin_amdgcn_s_setprio(1); _Pragma("unroll") for (int m = 0; m < 4; ++m) _Pragma("unroll") for (int n = 0; n < 2; ++n) _Pragma("unroll") for (int k = 0; k < 2; ++k) \
        acc[ai][bj][m][n] = __builtin_amdgcn_mfma_f32_16x16x32_bf16(Bt[n][k], At[m][k], acc[ai][bj][m][n], 0, 0, 0); __builtin_amdgcn_s_setprio(0); } while (0)
#define PG8_WAIT_V(n) asm volatile("s_waitcnt vmcnt(" #n ")" ::: "memory")
#define PG8_WAIT_L(n) asm volatile("s_waitcnt lgkmcnt(" #n ")" ::: "memory")
#define PG8_BAR __builtin_amdgcn_s_barrier()
#define PG8_SCHED __builtin_amdgcn_sched_barrier(0)
    Unit cur, nxt; int ui = 0;
    if (!S.next(0, cur)) return;
    f32x4 acc[2][2][4][2];
#pragma unroll
    for (int a = 0; a < 2; ++a)
#pragma unroll
        for (int b = 0; b < 2; ++b)
#pragma unroll
            for (int m = 0; m < 4; ++m)
#pragma unroll
                for (int n = 0; n < 2; ++n) acc[a][b][m][n] = (f32x4){0.f, 0.f, 0.f, 0.f};
    bf16x8 At[4][2], B0[2][2], B1[2][2];
    const char* cA = (const char*)g.A + (size_t)cur.pm * tstepA; const char* cB = (const char*)g.Bt + (size_t)cur.pn * tstepB;
    S.a_ready(cur);
    if constexpr (SP2) {
        PG8_STAGE(PG8_SB(0, 0), cB, voffB); PG8_STAGE(PG8_SB(0, 1), cB + hstepB, voffB); PG8_STAGE(PG8_SA(0, 0), cA, voffA); PG8_STAGE(PG8_SA(0, 1), cA + hstepA, voffA);
        if (wr == 1) PG8_BAR;
        PG8_WAIT_V(2); PG8_BAR;
        PG8_STAGE(PG8_SB(1, 0), cB + kstep, voffB); PG8_STAGE(PG8_SA(1, 0), cA + kstep, voffA); PG8_STAGE(PG8_SB(1, 1), cB + hstepB + kstep, voffB);
        PG8_WAIT_V(6); PG8_BAR;
    } else {
        PG8_STAGE(PG8_SB(0, 0), cB, voffB); PG8_STAGE(PG8_SA(0, 0), cA, voffA); PG8_STAGE(PG8_SB(0, 1), cB + hstepB, voffB); PG8_STAGE(PG8_SA(0, 1), cA + hstepA, voffA);
        if (wr == 1) PG8_BAR;
        PG8_WAIT_V(4); PG8_BAR;
        PG8_STAGE(PG8_SB(1, 0), cB + kstep, voffB); PG8_STAGE(PG8_SA(1, 0), cA + kstep, voffA); PG8_STAGE(PG8_SB(1, 1), cB + hstepB + kstep, voffB);
        PG8_WAIT_V(6); PG8_BAR;
    }
    for (;;) {
        const bool has_next = S.next(ui + 1, nxt);
        const char* nA = has_next ? (const char*)g.A + (size_t)nxt.pm * tstepA : cA; const char* nB = has_next ? (const char*)g.Bt + (size_t)nxt.pn * tstepB : cB;
        for (int t = 0; t < nt; t += 2) {
            const bool last = (t == nt - 2);
            const char* a1 = cA + (size_t)(t + 1) * kstep;
            const char* a2 = last ? nA : cA + (size_t)(t + 2) * kstep; const char* b2 = last ? nB : cB + (size_t)(t + 2) * kstep;
            const char* a3 = a2 + kstep; const char* b3 = b2 + kstep;
            if (last && has_next) S.a_ready(nxt);
            if constexpr (SP2) {
            PG8_LDB(B0, 0, 0); PG8_LDB(B1, 0, 1); PG8_SCHED; PG8_LDA(At, 0, 0); PG8_STAGE(PG8_SA(1, 1), a1 + hstepA, voffA);
            PG8_WAIT_V(8); PG8_WAIT_L(0); PG8_BAR; PG8_MMA(0, 0, At, B0); PG8_MMA(0, 1, At, B1); PG8_BAR; PG8_SCHED;
            PG8_LDA(At, 0, 1); PG8_STAGE(PG8_SB(0, 0), b2, voffB); PG8_STAGE(PG8_SB(0, 1), b2 + hstepB, voffB); PG8_STAGE(PG8_SA(0, 0), a2, voffA);
            PG8_WAIT_V(8); PG8_WAIT_L(0); PG8_BAR; PG8_MMA(1, 0, At, B0); PG8_MMA(1, 1, At, B1); PG8_BAR; PG8_SCHED;
            PG8_LDB(B0, 1, 0); PG8_LDB(B1, 1, 1); PG8_SCHED; PG8_LDA(At, 1, 0); PG8_STAGE(PG8_SA(0, 1), a2 + hstepA, voffA);
            PG8_WAIT_V(8); PG8_WAIT_L(0); PG8_BAR; PG8_MMA(0, 0, At, B0); PG8_MMA(0, 1, At, B1); PG8_BAR; PG8_SCHED;
            PG8_LDA(At, 1, 1); PG8_STAGE(PG8_SB(1, 0), b3, voffB); PG8_STAGE(PG8_SB(1, 1), b3 + hstepB, voffB); PG8_STAGE(PG8_SA(1, 0), a3, voffA);
            PG8_WAIT_V(8); PG8_WAIT_L(0); PG8_BAR; PG8_MMA(1, 0, At, B0); PG8_MMA(1, 1, At, B1); PG8_BAR; PG8_SCHED;
            } else {
            PG8_LDB(B0, 0, 0); PG8_SCHED; PG8_LDA(At, 0, 0); PG8_STAGE(PG8_SA(1, 1), a1 + hstepA, voffA);
            PG8_WAIT_L(8); PG8_BAR; PG8_WAIT_L(0); PG8_MMA(0, 0, At, B0); PG8_BAR; PG8_SCHED;
            PG8_LDB(B1, 0, 1); PG8_STAGE(PG8_SB(0, 0), b2, voffB);
            PG8_BAR; PG8_WAIT_L(0); PG8_MMA(0, 1, At, B1); PG8_BAR;
            PG8_LDA(At, 0, 1); PG8_STAGE(PG8_SA(0, 0), a2, voffA);
            PG8_BAR; PG8_WAIT_L(0); PG8_MMA(1, 0, At, B0); PG8_BAR; PG8_SCHED;
            PG8_STAGE(PG8_SB(0, 1), b2 + hstepB, voffB);
            PG8_WAIT_V(6); PG8_BAR; PG8_MMA(1, 1, At, B1); PG8_BAR;
            PG8_LDB(B0, 1, 0); PG8_SCHED; PG8_LDA(At, 1, 0); PG8_STAGE(PG8_SA(0, 1), a2 + hstepA, voffA);
            PG8_WAIT_L(8); PG8_BAR; PG8_WAIT_L(0); PG8_MMA(0, 0, At, B0); PG8_BAR; PG8_SCHED;
            PG8_LDB(B1, 1, 1); PG8_STAGE(PG8_SB(1, 0), b3, voffB);
            PG8_BAR; PG8_WAIT_L(0); PG8_MMA(0, 1, At, B1); PG8_BAR;
            PG8_LDA(At, 1, 1); PG8_STAGE(PG8_SA(1, 0), a3, voffA);
            PG8_BAR; PG8_WAIT_L(0); PG8_MMA(1, 0, At, B0); PG8_BAR; PG8_SCHED;
            PG8_STAGE(PG8_SB(1, 1), b3 + hstepB, voffB);
            PG8_WAIT_V(6); PG8_BAR; PG8_MMA(1, 1, At, B1); PG8_BAR;
            }
        }
        if constexpr (ALIGN_EPI) { if (wr == 0) PG8_BAR; }
        if constexpr (!Epi::AFTER_DRAIN) { E(acc, cur, wr, wc, fr, fq); S.done(cur); }
        if (!has_next) break;
#pragma unroll
        for (int a = 0; a < 2; ++a)
#pragma unroll
            for (int b = 0; b < 2; ++b)
#pragma unroll
                for (int m = 0; m < 4; ++m)
#pragma unroll
                    for (int n = 0; n < 2; ++n) acc[a][b][m][n] = (f32x4){0.f, 0.f, 0.f, 0.f};
        cur = nxt; cA = nA; cB = nB; ++ui;
        if constexpr (ALIGN_EPI) { if (wr == 1) PG8_BAR; }
    }
    PG8_WAIT_V(0);
    if constexpr (!ALIGN_EPI) { if (wr == 0) PG8_BAR; }
    PG8_BAR;
    if constexpr (Epi::AFTER_DRAIN) { E.fused(acc, cur, wr, wc, fr, fq, lds, wid, lane); S.done(cur); }
#undef PG8_SA
#undef PG8_SB
#undef PG8_STAGE
#undef PG8_LDA
#undef PG8_LDB
#undef PG8_MMA
#undef PG8_WAIT_V
#undef PG8_WAIT_L
#undef PG8_BAR
#undef PG8_SCHED
}
}

template <class Core> struct EpiMfma {
    static constexpr bool PERM = true, AFTER_DRAIN = false;
    Core c;
    __device__ __forceinline__ void operator()(const pg8::f32x4 (&acc)[2][2][4][2], const pg8::Unit& u, int wr, int wc, int fr, int fq) const {
#pragma unroll
        for (int ai = 0; ai < 2; ++ai)
#pragma unroll
            for (int m = 0; m < 4; ++m) {
                const int row = u.pm * 256 + ai * 128 + wr * 64 + m * 16 + fr;
                const float rs = c.rowscale(row);
                float part = 0.f;
#pragma unroll
                for (int bj = 0; bj < 2; ++bj) {
                    const int col0 = u.pn * 256 + bj * 128 + wc * 32 + 8 * fq;
                    const float v[8] = {acc[ai][bj][m][0][0], acc[ai][bj][m][0][1], acc[ai][bj][m][0][2], acc[ai][bj][m][0][3],
                                        acc[ai][bj][m][1][0], acc[ai][bj][m][1][1], acc[ai][bj][m][1][2], acc[ai][bj][m][1][3]};
                    part += c.apply8(row, col0, v, rs);
                }
                part += __shfl_xor(part, 16); part += __shfl_xor(part, 32);
                if (fq == 0) c.store_part(row, u.pn * 256, (u.pn & 3) * 4 + wc, part);
            }
    }
};
#ifndef USE_MFMA_GEMM
#define USE_MFMA_GEMM 1
#endif
template <class Core>
__device__ __forceinline__ void run_gemm(LAS unsigned char* lds, const bf16* A, int lda, const bf16* Bt, int M, int N, int K, const Core& c, int vcu, int G) {
#if USE_MFMA_GEMM
    pg8::Gemm g{A, lda, Bt, M, N, K}; pg8::StaticOrder S; S.init(M, N, G, (int)blockIdx.x);
    EpiMfma<Core> E{c};
    pg8::gemm_phase<EpiMfma<Core>, pg8::StaticOrder, true, true>(lds, g, S, E);
#else
    gemm_naive(lds, A, lda, Bt, M, N, K, c, vcu, G);
#endif
}

#include <hip/hip_bf16.h>
#include <cmath>
namespace attn_body {
using bf16=__hip_bfloat16;
using bf16x8=__attribute__((ext_vector_type(8)))short;
using s16x4=__attribute__((ext_vector_type(4)))short;
using f32x16=__attribute__((ext_vector_type(16)))float;
using u32x4=__attribute__((ext_vector_type(4)))unsigned;
constexpr int SEQ=8192,D=64,PQ=3072,PO=2048;
constexpr int NW=8,QBLK=32,QB=QBLK*NW,KVBLK=64,NQB=SEQ/QB;
__device__ __forceinline__ int crow(int r,int hi){return (r&3)+8*(r>>2)+4*hi;}
#define SBAR() __builtin_amdgcn_sched_barrier(0)
__device__ __forceinline__ void cmask(f32x16&p0,f32x16&p1,int jb,int qrel,int hi){
  const float NEG=-INFINITY; int kb=64*jb+4*hi;
  #pragma unroll
  for(int r=0;r<16;++r){int kv=kb+(r&3)+8*(r>>2); if(kv>qrel)p0[r]=NEG; if(kv+32>qrel)p1[r]=NEG;}
}

constexpr int NSLOT=3, SLOTB=8192;
constexpr int LDS_K=0, LDS_V=NSLOT*SLOTB, LDS_WS=2*NSLOT*SLOTB, LDS_OST=LDS_WS+NW*64*4, LDS_BYTES=LDS_OST+NW*4096;
constexpr float C2=0.125f*1.4426950408889634f;
__device__ __forceinline__ void glds16(const void*gsrc,unsigned lds_dst){unsigned keep;
  asm volatile("s_mov_b32 %0, m0\n\ts_mov_b32 m0, %2\n\ts_nop 0\n\tglobal_load_lds_dwordx4 %1, off\n\ts_mov_b32 m0, %0":"=&s"(keep):"v"(gsrc),"s"(lds_dst):"memory");}
__device__ __forceinline__ float max3f(float a,float b,float c){float r;asm("v_max3_f32 %0, %1, %2, %3":"=v"(r):"v"(a),"v"(b),"v"(c));return r;}
__device__ __forceinline__ float max2f(float a,float b){float r;asm("v_max_f32_e32 %0, %1, %2":"=v"(r):"v"(a),"v"(b));return r;}
__device__ __forceinline__ float fadd_s(float a,float b){float r;asm("v_add_f32_e32 %0, %1, %2":"=v"(r):"v"(a),"v"(b));return r;}
__device__ __forceinline__ float fsub_s(float a,float b){float r;asm("v_sub_f32_e32 %0, %1, %2":"=v"(r):"v"(a),"v"(b));return r;}
typedef float f32x2_t __attribute__((ext_vector_type(2))); typedef __bf16 bf16x2_t __attribute__((ext_vector_type(2)));
__device__ __forceinline__ unsigned cvtpk_s(float lo,float hi){f32x2_t v={lo,hi};bf16x2_t b=__builtin_convertvector(v,bf16x2_t);return __builtin_bit_cast(unsigned,b);}
#define WAIT_BAR(N) asm volatile("s_waitcnt vmcnt(" #N ") lgkmcnt(0)\n\ts_barrier":::"memory")

__device__ __forceinline__ void qkt(f32x16&p0,f32x16&p1,const char*Kslot,const bf16x8*qr,const f32x16&negm,int r32,int hi){
  const char*kb=Kslot+hi*1024+r32*16;
  #pragma unroll
  for(int d0=0;d0<4;++d0){
    const bf16x8 b0=*reinterpret_cast<const bf16x8*>(kb+d0*2048);
    const bf16x8 b1=*reinterpret_cast<const bf16x8*>(kb+d0*2048+512);
    if(d0==0){p0=__builtin_amdgcn_mfma_f32_32x32x16_bf16(b0,qr[0],negm,0,0,0);p1=__builtin_amdgcn_mfma_f32_32x32x16_bf16(b1,qr[0],negm,0,0,0);}
    else{p0=__builtin_amdgcn_mfma_f32_32x32x16_bf16(b0,qr[d0],p0,0,0,0);p1=__builtin_amdgcn_mfma_f32_32x32x16_bf16(b1,qr[d0],p1,0,0,0);}}
}
typedef __attribute__((address_space(3))) const char* lds_cptr;
typedef short v4i16_t __attribute__((ext_vector_type(4)));
__device__ __forceinline__ void kload8(bf16x8*kf,lds_cptr kp){
  kf[0]=*(const __attribute__((address_space(3))) bf16x8*)(kp);      kf[1]=*(const __attribute__((address_space(3))) bf16x8*)(kp+512);
  kf[2]=*(const __attribute__((address_space(3))) bf16x8*)(kp+2048); kf[3]=*(const __attribute__((address_space(3))) bf16x8*)(kp+2560);
  kf[4]=*(const __attribute__((address_space(3))) bf16x8*)(kp+4096); kf[5]=*(const __attribute__((address_space(3))) bf16x8*)(kp+4608);
  kf[6]=*(const __attribute__((address_space(3))) bf16x8*)(kp+6144); kf[7]=*(const __attribute__((address_space(3))) bf16x8*)(kp+6656);
}
__device__ __forceinline__ void kload2(bf16x8*kf,lds_cptr kp,int j){ kf[2*j]=*(const __attribute__((address_space(3))) bf16x8*)(kp+j*2048); kf[2*j+1]=*(const __attribute__((address_space(3))) bf16x8*)(kp+j*2048+512); }
__device__ __forceinline__ s16x4 vtr(lds_cptr p){ return __builtin_bit_cast(s16x4,__builtin_amdgcn_ds_read_tr16_b64_v4i16((__attribute__((address_space(3))) v4i16_t*)p)); }
__device__ __forceinline__ float rowmax(const f32x16&p0,const f32x16&p1){
  float a=max3f(p0[0],p0[1],p1[0]),b=max3f(p0[2],p0[3],p1[1]);a=max3f(a,p1[2],p1[3]);
  #pragma unroll
  for(int r=4;r<16;r+=4){a=max3f(a,p0[r],p0[r+1]);b=max3f(b,p0[r+2],p0[r+3]);a=max3f(a,p1[r],p1[r+1]);b=max3f(b,p1[r+2],p1[r+3]);}
  const float m=max2f(a,b);
  auto rr=__builtin_amdgcn_permlane32_swap(__float_as_uint(m),__float_as_uint(m),false,false);
  return max2f(__uint_as_float(rr[0]),__uint_as_float(rr[1]));
}
__device__ __forceinline__ void pv(f32x16*o,int vb,bf16x8 pa0,bf16x8 pa1,bf16x8 pa2,bf16x8 pa3){
  #pragma unroll
  for(int d0=0;d0<2;++d0){s16x4 lo[4],hi[4];
    #pragma unroll
    for(int ks=0;ks<4;++ks){
      asm volatile("ds_read_b64_tr_b16 %0,%1 offset:%c2":"=&v"(lo[ks]):"v"(vb),"i"(d0*4096+ks*1024):"memory");
      asm volatile("ds_read_b64_tr_b16 %0,%1 offset:%c2":"=&v"(hi[ks]):"v"(vb),"i"(d0*4096+ks*1024+512):"memory");}
    asm volatile("s_waitcnt lgkmcnt(0)":::"memory");SBAR();
    #define PK(k) (bf16x8){lo[k][0],lo[k][1],lo[k][2],lo[k][3],hi[k][0],hi[k][1],hi[k][2],hi[k][3]}
    o[d0]=__builtin_amdgcn_mfma_f32_32x32x16_bf16(pa0,PK(0),o[d0],0,0,0);
    o[d0]=__builtin_amdgcn_mfma_f32_32x32x16_bf16(pa1,PK(1),o[d0],0,0,0);
    o[d0]=__builtin_amdgcn_mfma_f32_32x32x16_bf16(pa2,PK(2),o[d0],0,0,0);
    o[d0]=__builtin_amdgcn_mfma_f32_32x32x16_bf16(pa3,PK(3),o[d0],0,0,0);
    #undef PK
  }
}

#ifndef ATTN_STORE16
#define ATTN_STORE16(p,v) (*(u32x4*)(p)=(v))
#endif
template<int THRL> __device__ __forceinline__ void attn_unit(int b,int qb,const bf16*Q,const bf16*K,const bf16*V,bf16*O,float slope2,char*shm){
  const int tid=otid(),lane=tid&63,r32=lane&31,hi=lane>>5; const int wid=__builtin_amdgcn_readfirstlane(tid>>6);
  const long rowbase=(long)b*SEQ; const int q0=qb*QB;
  const bf16*Qw=Q+(rowbase+q0+wid*QBLK)*PQ;
  const bf16*Kh=K+rowbase*PQ,*Vh=V+rowbase*PQ;
  const unsigned lds0=(unsigned)(uintptr_t)shm;
  float*wsf=(float*)(shm+LDS_WS)+wid*64;
  const bf16*ksrc=Kh+(long)lane*PQ+wid*8;
  const bf16*vsrc=Vh+(long)(16*(wid&3)+(lane>>2))*PQ+(wid>>2)*32+(lane&3)*8;
  const unsigned kdst=lds0+LDS_K+wid*1024, vdst=lds0+LDS_V+wid*1024;
  #define DMA_K(t,slot) glds16(ksrc+(long)(t)*KVBLK*PQ,(unsigned)__builtin_amdgcn_readfirstlane(kdst+(slot)))
  #define DMA_V(t,slot) glds16(vsrc+(long)(t)*KVBLK*PQ,(unsigned)__builtin_amdgcn_readfirstlane(vdst+(slot)))
  const int vb0=(int)(lds0+LDS_V)+((lane>>4)&1)*32+(lane&3)*8+(4*hi+((lane&15)>>2))*64;
  const char*Kbase=shm+LDS_K; bf16x8 kf[8];
  const lds_cptr shm3=(lds_cptr)shm; const lds_cptr kp0=shm3+LDS_K+hi*1024+r32*16; const lds_cptr vp0=shm3+LDS_V+((lane>>4)&1)*32+(lane&3)*8+(4*hi+((lane&15)>>2))*64;
  const int NT=(q0+QB)/KVBLK;
  DMA_K(0,0);DMA_V(0,0);DMA_K(1,SLOTB);
  bf16x8 qr[4];
  #pragma unroll
  for(int d0=0;d0<4;++d0)qr[d0]=*reinterpret_cast<const bf16x8*>(&Qw[(long)r32*PQ+d0*16+hi*8]);
  float l_reg=0.f;f32x16 o[2];o[0]=f32x16{};o[1]=f32x16{};f32x16 negm;
  _Pragma("unroll") for(int r=0;r<16;++r)negm[r]=slope2*(float)crow(r,hi);
  asm volatile("":"+v"(negm)); const float b32=32.f*slope2, step64=64.f*slope2;
  const int qrel=wid*QBLK+r32;
  #define CMASK(P0,P1,t) do{int jb_=(t)-(NT-4); if(jb_>=0)cmask(P0,P1,jb_,qrel,hi);}while(0)
  bool resc=false;
  #define START(P0,P1) do{ const float rm=rowmax(P0,P1); resc=false; \
    { const float dl=rm; \
      _Pragma("unroll") for(int r=0;r<16;++r){P0[r]=fsub_s(P0[r],dl);P1[r]=fsub_s(P1[r],dl);} \
      const float adj_=step64-dl; _Pragma("unroll") for(int r=0;r<16;++r)negm[r]+=adj_; asm volatile("":"+v"(negm)); } \
    _Pragma("unroll") for(int r=0;r<16;++r)P0[r]=__builtin_amdgcn_exp2f(P0[r]); }while(0)
  #define RESC() do{ if(resc){ asm volatile("s_waitcnt lgkmcnt(0)":::"memory"); \
      _Pragma("unroll") for(int d_=0;d_<2;++d_) _Pragma("unroll") for(int r=0;r<16;++r)o[d_][r]*=wsf[crow(r,hi)]; } }while(0)
  f32x16 pA0,pA1,pB0,pB1;
  int sl_prev=0,sl_cur=0,sl_next=SLOTB;
  #define ROT() do{sl_prev=sl_cur;sl_cur=sl_next;sl_next=(sl_next==(NSLOT-1)*SLOTB)?0:sl_next+SLOTB;}while(0)
  DMA_K(2,2*SLOTB);
  WAIT_BAR(3);
  qkt(pA0,pA1,Kbase,qr,negm,r32,hi);asm volatile("s_nop 15\n\ts_nop 7":"+v"(pA0),"+v"(pA1));
  _Pragma("unroll") for(int r=0;r<16;++r)pA1[r]+=b32;
  CMASK(pA0,pA1,0);
  START(pA0,pA1);
  _Pragma("unroll") for(int r=0;r<16;++r)pA1[r]=__builtin_amdgcn_exp2f(pA1[r]);
  WAIT_BAR(0);
  DMA_K(3,0);DMA_V(1,SLOTB);
  ROT();
  kload8(kf,kp0+sl_cur);
  WAIT_BAR(2);
  s16x4 vlo[8],vhi[8]; u32x4 pw0,pw1,pw2,pw3;
  #define PKW(P,B) cvtpk_s(P[B],P[B+1])
  #define PAF(k) __builtin_bit_cast(bf16x8,pw##k)
  #define VFR(i) (bf16x8){vlo[i][0],vlo[i][1],vlo[i][2],vlo[i][3],vhi[i][0],vhi[i][1],vhi[i][2],vhi[i][3]}
  #define PIN(x) asm volatile("":"+v"(x))
  #define MX3(a,b,c) __builtin_fmaxf(__builtin_fmaxf((a),(b)),(c))
  #define GAPA(MF,A0,A1,A2,A3,W0,W1,PW) do{ MF; sacc+=A0; sacc+=A1; sacc+=A2; sacc+=A3; PIN(sacc); W0; W1; PIN(PW); SBAR(); }while(0)
  #define EX(v) __builtin_amdgcn_exp2f(v)
  #define GAPB(MF,X,B) do{ MF; X[B]=EX(X[B]); X[B+1]=EX(X[B+1]); X[B+2]=EX(X[B+2]); X[B+3]=EX(X[B+3]); PIN(X); SBAR(); }while(0)
  #define VRD(i) do{ vlo[i]=vtr(vp_+(((i)>>2)*4096+((i)&3)*1024)); vhi[i]=vtr(vp_+(((i)>>2)*4096+((i)&3)*1024+512)); }while(0)
  #define KRD(G,j) do{ if(G){ kload2(kf,kp0+sl_next,j); SBAR(); } }while(0)
  #define STEP(C0,C1,P0,P1,t,GK,GV,GL) do{ SBAR(); \
    const lds_cptr vp_=vp0+sl_prev; \
    VRD(0); SBAR(); float sacc=(P0[0]+P0[1]); \
    GAPA(C0=__builtin_amdgcn_mfma_f32_32x32x16_bf16(kf[0],qr[0],negm,0,0,0), P0[2],P0[3],P0[4],P0[5],     pw0[0]=PKW(P0,0), pw0[1]=PKW(P0,2), pw0); \
    VRD(4); SBAR(); GAPA(C1=__builtin_amdgcn_mfma_f32_32x32x16_bf16(kf[1],qr[0],negm,0,0,0), P0[6],P0[7],P0[8],P0[9],     pw0[2]=PKW(P0,4), pw0[3]=PKW(P0,6), pw0); \
    VRD(1); SBAR(); GAPA(C0=__builtin_amdgcn_mfma_f32_32x32x16_bf16(kf[2],qr[1],C0,0,0,0),   P0[10],P0[11],P0[12],P0[13], pw1[0]=PKW(P0,8), pw1[1]=PKW(P0,10), pw1); \
    VRD(5); SBAR(); GAPA(C1=__builtin_amdgcn_mfma_f32_32x32x16_bf16(kf[3],qr[1],C1,0,0,0),   P0[14],P0[15],P1[0],P1[1],   pw1[2]=PKW(P0,12),pw1[3]=PKW(P0,14), pw1); \
    VRD(2); SBAR(); GAPA(C0=__builtin_amdgcn_mfma_f32_32x32x16_bf16(kf[4],qr[2],C0,0,0,0),   P1[2],P1[3],P1[4],P1[5],     pw2[0]=PKW(P1,0), pw2[1]=PKW(P1,2), pw2); \
    VRD(6); SBAR(); GAPA(C1=__builtin_amdgcn_mfma_f32_32x32x16_bf16(kf[5],qr[2],C1,0,0,0),   P1[6],P1[7],P1[8],P1[9],     pw2[2]=PKW(P1,4), pw2[3]=PKW(P1,6), pw2); \
    VRD(3); SBAR(); GAPA(C0=__builtin_amdgcn_mfma_f32_32x32x16_bf16(kf[6],qr[3],C0,0,0,0),   P1[10],P1[11],P1[12],P1[13], pw3[0]=PKW(P1,8), pw3[1]=PKW(P1,10), pw3); \
    VRD(7); SBAR(); GAPA(C1=__builtin_amdgcn_mfma_f32_32x32x16_bf16(kf[7],qr[3],C1,0,0,0),   P1[14],P1[15],0.f,0.f,       pw3[2]=PKW(P1,12),pw3[3]=PKW(P1,14), pw3); \
    l_reg+=sacc; \
    if(GK){DMA_K((t)+3,sl_cur);} if(GV){DMA_V((t)+1,sl_next);} \
    _Pragma("unroll") for(int r=0;r<16;++r)C1[r]+=b32; \
    CMASK(C0,C1,t); \
    { float a=MX3(C0[0],C0[1],C1[0]),b=MX3(C0[2],C0[3],C1[1]); a=MX3(a,C1[2],C1[3]); \
      _Pragma("unroll") for(int r=4;r<16;r+=4){a=MX3(a,C0[r],C0[r+1]);b=MX3(b,C0[r+2],C0[r+3]);a=MX3(a,C1[r],C1[r+1]);b=MX3(b,C1[r+2],C1[r+3]);} \
      float rm=__builtin_fmaxf(a,b); { auto rr=__builtin_amdgcn_permlane32_swap(__float_as_uint(rm),__float_as_uint(rm),false,false); rm=__builtin_fmaxf(__uint_as_float(rr[0]),__uint_as_float(rr[1])); } \
      resc=false; float adj_=step64; \
      if(__any(rm>(float)THRL)){ const float dl=__builtin_fmaxf(rm,0.f); adj_-=dl; \
        _Pragma("unroll") for(int r=0;r<16;++r){C0[r]-=dl;C1[r]-=dl;} \
        const float f=__builtin_amdgcn_exp2f(-dl); l_reg*=f; if(hi==0)wsf[r32]=f; resc=true; } \
      _Pragma("unroll") for(int r=0;r<16;++r)negm[r]+=adj_; asm volatile("":"+v"(negm)); } \
    SBAR(); \
    GAPB(o[0]=__builtin_amdgcn_mfma_f32_32x32x16_bf16(PAF(0),VFR(0),o[0],0,0,0), C0,0); \
    GAPB(o[1]=__builtin_amdgcn_mfma_f32_32x32x16_bf16(PAF(0),VFR(4),o[1],0,0,0), C0,4); \
    KRD(GL,0); GAPB(o[0]=__builtin_amdgcn_mfma_f32_32x32x16_bf16(PAF(1),VFR(1),o[0],0,0,0), C0,8); \
    KRD(GL,1); GAPB(o[1]=__builtin_amdgcn_mfma_f32_32x32x16_bf16(PAF(1),VFR(5),o[1],0,0,0), C0,12); \
    KRD(GL,2); GAPB(o[0]=__builtin_amdgcn_mfma_f32_32x32x16_bf16(PAF(2),VFR(2),o[0],0,0,0), C1,0); \
    KRD(GL,3); GAPB(o[1]=__builtin_amdgcn_mfma_f32_32x32x16_bf16(PAF(2),VFR(6),o[1],0,0,0), C1,4); \
    GAPB(o[0]=__builtin_amdgcn_mfma_f32_32x32x16_bf16(PAF(3),VFR(3),o[0],0,0,0), C1,8); \
    GAPB(o[1]=__builtin_amdgcn_mfma_f32_32x32x16_bf16(PAF(3),VFR(7),o[1],0,0,0), C1,12); \
    }while(0)
  int t=1;
  #undef CMASK
  #define CMASK(P0,P1,t) do{}while(0)
  for(;t+5<NT;t+=2){
    STEP(pB0,pB1,pA0,pA1,t,true,true,true);     WAIT_BAR(2); RESC(); ROT();
    STEP(pA0,pA1,pB0,pB1,t+1,true,true,true);   WAIT_BAR(2); RESC(); ROT();
  }
  #undef CMASK
  #define CMASK(P0,P1,t) do{int jb_=(t)-(NT-4); if(jb_>=0)cmask(P0,P1,jb_,qrel,hi);}while(0)
  #define ENDW(tt) do{ if((tt)+3<NT){WAIT_BAR(2);} else if((tt)+2<NT){WAIT_BAR(1);} else {WAIT_BAR(0);} }while(0)
  for(;t+1<NT;t+=2){
    STEP(pB0,pB1,pA0,pA1,t,(t+3<NT),(t+1<NT),(t+1<NT));       ENDW(t);   RESC(); ROT();
    STEP(pA0,pA1,pB0,pB1,t+1,(t+4<NT),(t+2<NT),(t+2<NT));     ENDW(t+1); RESC(); ROT();
  }
  STEP(pB0,pB1,pA0,pA1,NT-1,false,false,false); RESC();
  { float sacc=pB0[0]+pB0[1]; _Pragma("unroll") for(int r=2;r<16;++r)sacc+=pB0[r]; _Pragma("unroll") for(int r=0;r<16;++r)sacc+=pB1[r]; l_reg+=sacc;
    pw0=(u32x4){PKW(pB0,0),PKW(pB0,2),PKW(pB0,4),PKW(pB0,6)};pw1=(u32x4){PKW(pB0,8),PKW(pB0,10),PKW(pB0,12),PKW(pB0,14)};pw2=(u32x4){PKW(pB1,0),PKW(pB1,2),PKW(pB1,4),PKW(pB1,6)};pw3=(u32x4){PKW(pB1,8),PKW(pB1,10),PKW(pB1,12),PKW(pB1,14)};
    SBAR(); pv(o,vb0+sl_cur,PAF(0),PAF(1),PAF(2),PAF(3)); }
  #undef PKW
  #undef PAF
  #undef VFR
  #undef PIN
  #undef MX3
  #undef GAPA
  #undef GAPB
  #undef EX
  #undef VRD
  #undef KRD
  #undef STEP
  #undef ENDW
  {auto rr=__builtin_amdgcn_permlane32_swap(__float_as_uint(l_reg),__float_as_uint(l_reg),false,false);l_reg=__uint_as_float(rr[0])+__uint_as_float(rr[1]);}
  if(hi==0)wsf[32+r32]=l_reg;asm volatile("s_waitcnt lgkmcnt(0)":::"memory");
  float rli[16];
  #pragma unroll
  for(int r=0;r<16;++r)rli[r]=__builtin_amdgcn_rcpf(wsf[32+crow(r,hi)]);
  bf16*Ow=O+(rowbase+q0+wid*QBLK)*PO;
  { bf16*stg=(bf16*)(shm+LDS_OST)+wid*2048;
    #pragma unroll
    for(int r=0;r<16;++r){const int orow=crow(r,hi);
      #pragma unroll
      for(int d0=0;d0<2;++d0)stg[orow*64+d0*32+r32]=__float2bfloat16(o[d0][r]*rli[r]);}
    asm volatile("s_waitcnt lgkmcnt(0)":::"memory");
    #pragma unroll
    for(int i=0;i<4;++i){const int row=i*8+(lane>>3),ch=lane&7; const u32x4 v=*(const u32x4*)(stg+row*64+ch*8); ATTN_STORE16(Ow+(long)row*PO+ch*8,v);} }
  asm volatile("s_waitcnt lgkmcnt(0)\n\ts_barrier":::"memory");
  #undef DMA_K
  #undef DMA_V
  #undef CMASK
  #undef START
  #undef RESC
  #undef ROT
}
constexpr int ATTN_LDS_BYTES=LDS_BYTES;
#undef SBAR
#undef WAIT_BAR
}

#ifndef USE_MFMA_ATTN
#define USE_MFMA_ATTN 1
#endif
__device__ __forceinline__ void phase_diff_mfma(char* shm, const Ctx& a, const LayerP& P, int vcu, int G) {
    bf16* proj = (bf16*)(a.ws + WS_H); bf16* o12 = (bf16*)(a.ws + WS_STATE);
    float lam;
    { float s1 = 0.f, s2 = 0.f;
      for (int i = 0; i < 64; ++i) { s1 += P.e0[i] * P.e1[i]; s2 += P.e2[i] * P.e3[i]; }
      lam = __expf(s1) - __expf(s2) + LAMBDA_INIT; }
    const float* head_norm = P.e4;
    for (int j = vcu; j < NB * DIFF_H * 32; j += G) {
        const int jj = j & 255, pass = j >> 8, bh = jj >> 4, s = jj & 15;
        const int qb = pass ? 31 - s : s, h = bh & 7, b = bh >> 3;
        const float slope2 = exp2f(-(float)(h + 1)) * LOG2E;
#pragma nounroll
        for (int sp = 0; sp < 4; ++sp) {
            const int r = sp >> 1, vh = sp & 1;
            attn_body::attn_unit<8>(b, qb, (const attn_body::bf16*)(proj + h * 128 + r * 64), (const attn_body::bf16*)(proj + 1024 + h * 128 + r * 64),
                                    (const attn_body::bf16*)(proj + 2048 + h * 128 + vh * 64), (attn_body::bf16*)(o12 + r * 1024 + h * 128 + vh * 64), slope2, shm);
        }
        asm volatile("s_waitcnt vmcnt(0)" ::: "memory"); __syncthreads();
        const int tid2 = otid(), lane = tid2 & 63, wave = tid2 >> 6;
        const size_t row0 = (size_t)b * T + (size_t)qb * 256 + wave * 32;
        const float hn0 = head_norm[2 * lane], hn1 = head_norm[2 * lane + 1];
        for (int i4 = 0; i4 < 32; i4 += 4) {
            unsigned w1[4], w2[4];
#pragma unroll
            for (int k = 0; k < 4; ++k) { w1[k] = *(const unsigned*)(o12 + (row0 + i4 + k) * 2048 + h * 128 + 2 * lane); w2[k] = *(const unsigned*)(o12 + (row0 + i4 + k) * 2048 + 1024 + h * 128 + 2 * lane); }
#pragma unroll
            for (int k = 0; k < 4; ++k) { const float oa = bflo(w1[k]) - lam * bflo(w2[k]), ob = bfhi(w1[k]) - lam * bfhi(w2[k]);
                const float ss = wave_sum(oa * oa + ob * ob);
                const float rs = (1.0f / sqrtf(ss * (1.0f / 128.0f) + EPS)) * (1.0f - LAMBDA_INIT);
                *(unsigned*)(proj + (row0 + i4 + k) * DIFF_PITCH + h * 128 + 2 * lane) = pk2(oa * rs * hn0, ob * rs * hn1); }
        }
    }
}


typedef short mbf16x8 __attribute__((ext_vector_type(8)));
typedef short ms16x4 __attribute__((ext_vector_type(4)));
typedef float mf32x16 __attribute__((ext_vector_type(16)));
#define MFMA32(a, b, c) __builtin_amdgcn_mfma_f32_32x32x16_bf16(a, b, c, 0, 0, 0)
__device__ __forceinline__ int crow32(int r, int hi) { return (r & 3) + 8 * (r >> 2) + 4 * hi; }
__device__ __forceinline__ mbf16x8 frag_rk(const LAS unsigned char* base, int stride, int row0, int k0, int lane) {
    return *(const LAS mbf16x8*)(base + (row0 + (lane & 31)) * stride + (k0 + 8 * (lane >> 5)) * 2);
}
__device__ __forceinline__ mbf16x8 frag_kn(const LAS unsigned char* base, int stride, int k0, int n0, int lane) {
    const int i = lane & 15, g = lane >> 4;
    const LAS unsigned char* p = base + (k0 + 8 * (g >> 1) + (i >> 2)) * stride + (n0 + 16 * (g & 1) + 4 * (i & 3)) * 2;
    const ms16x4 lo = __builtin_bit_cast(ms16x4, __builtin_amdgcn_ds_read_tr16_b64_v4i16((LAS ms16x4*)p));
    const ms16x4 hi = __builtin_bit_cast(ms16x4, __builtin_amdgcn_ds_read_tr16_b64_v4i16((LAS ms16x4*)(p + 4 * stride)));
    return (mbf16x8){lo[0], lo[1], lo[2], lo[3], hi[0], hi[1], hi[2], hi[3]};
}
__device__ __forceinline__ mf32x16 zero16() { mf32x16 z;
#pragma unroll
    for (int r = 0; r < 16; ++r) z[r] = 0.f; return z; }

__device__ __forceinline__ void phase_sgu_mfma(LAS unsigned char* lds, const Ctx& a, const LayerP& P, int vcu, int G) {
    const int tid = otid(), lane = tid & 63, wave = __builtin_amdgcn_readfirstlane(tid >> 6);
    bf16* proj = (bf16*)(a.ws + WS_H); const float* vssq = (const float*)(a.ws + WS_VSSQ);
    const float* v_norm = P.e1; const float* w_s = P.e2; const float* b_s = P.e3;
    constexpr int SA = 272, SV = 320, SO = 132;
    LAS unsigned char* WA = lds;
    LAS unsigned char* VV = lds + 128 * SA;
    LAS float* RS = (LAS float*)(lds + 128 * SA + 128 * SV);
    LAS float* OS = (LAS float*)lds;
    const int tm = wave & 3, nh = wave >> 2, hi = lane >> 5;
    for (int u = vcu; u < NB * (T / SGU_C) * SGU_G; u += G) {
        const int g = u % SGU_G, bc = u / SGU_G;
        const int row0 = bc * SGU_C;
        if (tid < 128) RS[tid] = row_rstd(vssq, row0 + tid);
#pragma unroll
        for (int i = 0; i < 4; ++i) { const int ch = tid + NTHR * i, r = ch >> 4, c16 = ch & 15;
            const v4u w = *(const v4u*)(proj + (size_t)(row0 + r) * SGU_PITCH + 1024 + g * 128 + c16 * 8);
            *(LAS v4u*)(VV + r * SV + c16 * 16) = w; }
        __syncthreads();
#pragma unroll
        for (int i = 0; i < 8; ++i) { const int idx = tid + NTHR * i, t = idx >> 5, s4 = (idx & 31) * 4;
            const f32x4 w = *(const f32x4*)(w_s + (size_t)g * 16384 + t * 128 + s4);
            const float x0 = (s4 + 0 <= t) ? w.x * RS[s4 + 0] : 0.f, x1 = (s4 + 1 <= t) ? w.y * RS[s4 + 1] : 0.f, x2 = (s4 + 2 <= t) ? w.z * RS[s4 + 2] : 0.f, x3 = (s4 + 3 <= t) ? w.w * RS[s4 + 3] : 0.f;
            v2u o; o.x = pk2(x0, x1); o.y = pk2(x2, x3); *(LAS v2u*)(WA + t * SA + s4 * 2) = o; }
        __syncthreads();
        mf32x16 acc0 = zero16(), acc1 = zero16();
        for (int ks = 0; ks < 2 * (tm + 1); ++ks) {
            const mbf16x8 af = frag_rk(WA, SA, 32 * tm, 16 * ks, lane);
            const mbf16x8 b0 = frag_kn(VV, SV, 16 * ks, 64 * nh, lane), b1 = frag_kn(VV, SV, 16 * ks, 64 * nh + 32, lane);
            acc0 = MFMA32(af, b0, acc0); acc1 = MFMA32(af, b1, acc1);
        }
        __syncthreads();
#pragma unroll
        for (int r = 0; r < 16; ++r) { const int row = 32 * tm + crow32(r, hi);
            OS[row * SO + 64 * nh + (lane & 31)] = acc0[r]; OS[row * SO + 64 * nh + 32 + (lane & 31)] = acc1[r]; }
        __syncthreads();
#pragma unroll
        for (int i = 0; i < 4; ++i) { const int ch = tid + NTHR * i, t = ch >> 4, c8 = (ch & 15) * 8;
            const f32x4 s0 = *(const LAS f32x4*)(OS + t * SO + c8), s1 = *(const LAS f32x4*)(OS + t * SO + c8 + 4);
            const f32x4 n0 = *(const f32x4*)(v_norm + g * 128 + c8), n1 = *(const f32x4*)(v_norm + g * 128 + c8 + 4);
            const float bs = b_s[g * 128 + t];
            bf16* up = proj + (size_t)(row0 + t) * SGU_PITCH + g * 128 + c8;
            const v4u uw = *(const v4u*)up;
            v4u o;
            o.x = pk2(bflo(uw.x) * (n0.x * s0.x + bs), bfhi(uw.x) * (n0.y * s0.y + bs)); o.y = pk2(bflo(uw.y) * (n0.z * s0.z + bs), bfhi(uw.y) * (n0.w * s0.w + bs));
            o.z = pk2(bflo(uw.z) * (n1.x * s1.x + bs), bfhi(uw.z) * (n1.y * s1.y + bs)); o.w = pk2(bflo(uw.w) * (n1.z * s1.z + bs), bfhi(uw.w) * (n1.w * s1.w + bs));
            *(v4u*)up = o; }
        __syncthreads();
    }
}

__device__ __forceinline__ void phase_gla_kv_mfma(LAS unsigned char* lds, const Ctx& a, int vcu, int G) {
    const int tid = otid(), lane = tid & 63, wave = __builtin_amdgcn_readfirstlane(tid >> 6), hi = lane >> 5;
    const bf16* proj = (const bf16*)(a.ws + WS_H); bf16* state = (bf16*)(a.ws + WS_STATE); float* dec = (float*)(a.ws + WS_DEC);
    constexpr int SV = 576, SK = 320, SS = 272;
    LAS unsigned char* VV = lds;
    LAS unsigned char* KE = lds + 64 * SV;
    LAS unsigned char* ST = lds;
    LAS float* TOT = (LAS float*)(lds + 256 * SS);
    for (int u = vcu; u < NB * GLA_H * GLA_NC; u += G) {
        const int n = u % GLA_NC, bh = u / GLA_NC, h = bh % GLA_H, b = bh / GLA_H;
        const int row0 = b * T + n * GLA_C;
        GlaCum c; gla_cumsum(c, proj, row0, h, TOT, tid);
        const int cp = tid & 63, part = tid >> 6;
#pragma unroll
        for (int i = 0; i < 8; ++i) { const int t = 8 * part + i; const unsigned w = *(const unsigned*)(proj + (size_t)(row0 + t) * GLA_PITCH + 512 + h * 128 + 2 * cp);
            *(LAS unsigned*)(KE + t * SK + 4 * cp) = pk2(bflo(w) * __expf(c.tot0 - c.b0[i]), bfhi(w) * __expf(c.tot1 - c.b1[i])); }
        if (part == 0) { dec[(size_t)u * 128 + 2 * cp] = __expf(c.tot0); dec[(size_t)u * 128 + 2 * cp + 1] = __expf(c.tot1); }
#pragma unroll
        for (int i = 0; i < 4; ++i) { const int ch = tid + NTHR * i, r = ch >> 5, c16 = ch & 31;
            *(LAS v4u*)(VV + r * SV + c16 * 16) = *(const v4u*)(proj + (size_t)(row0 + r) * GLA_PITCH + 1024 + h * 256 + c16 * 8); }
        __syncthreads();
        mf32x16 acc[4];
#pragma unroll
        for (int nt = 0; nt < 4; ++nt) acc[nt] = zero16();
#pragma unroll
        for (int ks = 0; ks < 4; ++ks) { const mbf16x8 af = frag_kn(VV, SV, 16 * ks, 32 * wave, lane);
#pragma unroll
            for (int nt = 0; nt < 4; ++nt) { const mbf16x8 bfr = frag_kn(KE, SK, 16 * ks, 32 * nt, lane); acc[nt] = MFMA32(af, bfr, acc[nt]); } }
        __syncthreads();
#pragma unroll
        for (int nt = 0; nt < 4; ++nt)
#pragma unroll
            for (int r = 0; r < 16; ++r) *(LAS bf16*)(ST + (32 * wave + crow32(r, hi)) * SS + (32 * nt + (lane & 31)) * 2) = (bf16)f2bf(acc[nt][r]);
        __syncthreads();
#pragma unroll
        for (int i = 0; i < 8; ++i) { const int ch = tid + NTHR * i, vd = ch >> 4, c16 = ch & 15;
            *(v4u*)(state + ((size_t)u * 256 + vd) * 128 + c16 * 8) = *(const LAS v4u*)(ST + vd * SS + c16 * 16); }
        __syncthreads();
    }
}
__device__ __forceinline__ void phase_gla_out_mfma(LAS unsigned char* lds, const Ctx& a, const LayerP& P, int vcu, int G) {
    const int tid = otid(), lane = tid & 63, wave = __builtin_amdgcn_readfirstlane(tid >> 6), hi = lane >> 5;
    bf16* proj = (bf16*)(a.ws + WS_H); const bf16* state = (const bf16*)(a.ws + WS_STATE);
    const float* head_norm = P.e3;
    constexpr int SQ = 272, SA = 144, SV = 576, SO = 260;
    LAS unsigned char* QD = lds;
    LAS unsigned char* KI = lds + 64 * SQ;
    LAS unsigned char* AT = lds + 2 * 64 * SQ;
    LAS unsigned char* VV = lds + 2 * 64 * SQ + 64 * SA;
    LAS float* TOT = (LAS float*)(lds + 80896);
    LAS float* OS = (LAS float*)lds;
    for (int u = vcu; u < NB * GLA_H * GLA_NC; u += G) {
        const int n = u % GLA_NC, bh = u / GLA_NC, h = bh % GLA_H, b = bh / GLA_H;
        const int row0 = b * T + n * GLA_C;
        mbf16x8 sfr[8];
        { const bf16* sp = state + ((size_t)u * 256 + 32 * wave + (lane & 31)) * 128 + 8 * hi;
#pragma unroll
          for (int ks = 0; ks < 8; ++ks) sfr[ks] = *(const mbf16x8*)(sp + 16 * ks); }
        GlaCum c; gla_cumsum(c, proj, row0, h, TOT, tid);
        const int cp = tid & 63, part = tid >> 6;
#pragma unroll
        for (int i = 0; i < 8; ++i) { const int t = 8 * part + i;
            const unsigned wq = *(const unsigned*)(proj + (size_t)(row0 + t) * GLA_PITCH + h * 128 + 2 * cp);
            const unsigned wk = *(const unsigned*)(proj + (size_t)(row0 + t) * GLA_PITCH + 512 + h * 128 + 2 * cp);
            const float e0 = __expf(c.b0[i]), e1 = __expf(c.b1[i]);
            *(LAS unsigned*)(QD + t * SQ + 4 * cp) = pk2(bflo(wq) * 0.08838834764831845f * e0, bfhi(wq) * 0.08838834764831845f * e1);
            *(LAS unsigned*)(KI + t * SQ + 4 * cp) = pk2(bflo(wk) / e0, bfhi(wk) / e1); }
#pragma unroll
        for (int i = 0; i < 4; ++i) { const int ch = tid + NTHR * i, r = ch >> 5, c16 = ch & 31;
            *(LAS v4u*)(VV + r * SV + c16 * 16) = *(const v4u*)(proj + (size_t)(row0 + r) * GLA_PITCH + 1024 + h * 256 + c16 * 8); }
        __syncthreads();
        if (wave < 4) {
            const int mi = wave >> 1, ni = wave & 1;
            mf32x16 at = zero16();
            if (!(mi == 0 && ni == 1)) {
#pragma unroll
                for (int ks = 0; ks < 8; ++ks) at = MFMA32(frag_rk(QD, SQ, 32 * mi, 16 * ks, lane), frag_rk(KI, SQ, 32 * ni, 16 * ks, lane), at);
            }
#pragma unroll
            for (int r = 0; r < 16; ++r) { const int cc = 32 * mi + crow32(r, hi), ss = 32 * ni + (lane & 31);
                *(LAS bf16*)(AT + cc * SA + ss * 2) = (bf16)f2bf((ss <= cc) ? at[r] : 0.f); }
        }
        __syncthreads();
        mf32x16 acc[2]; acc[0] = zero16(); acc[1] = zero16();
#pragma unroll
        for (int ks = 0; ks < 4; ++ks) { const mbf16x8 bfr = frag_kn(VV, SV, 16 * ks, 32 * wave, lane);
            if (ks < 2) acc[0] = MFMA32(frag_rk(AT, SA, 0, 16 * ks, lane), bfr, acc[0]);
            acc[1] = MFMA32(frag_rk(AT, SA, 32, 16 * ks, lane), bfr, acc[1]); }
#pragma unroll
        for (int ks = 0; ks < 8; ++ks) { acc[0] = MFMA32(frag_rk(QD, SQ, 0, 16 * ks, lane), sfr[ks], acc[0]); acc[1] = MFMA32(frag_rk(QD, SQ, 32, 16 * ks, lane), sfr[ks], acc[1]); }
        __syncthreads();
#pragma unroll
        for (int mi = 0; mi < 2; ++mi)
#pragma unroll
            for (int r = 0; r < 16; ++r) OS[(32 * mi + crow32(r, hi)) * SO + 32 * wave + (lane & 31)] = acc[mi][r];
        __syncthreads();
#pragma unroll
        for (int p = 0; p < 4; ++p) { const int cc = p * 16 + wave * 2 + hi, c8 = (lane & 31) * 8;
            const f32x4 s0 = *(const LAS f32x4*)(OS + cc * SO + c8), s1 = *(const LAS f32x4*)(OS + cc * SO + c8 + 4);
            float ss = (s0.x * s0.x + s0.y * s0.y) + (s0.z * s0.z + s0.w * s0.w) + (s1.x * s1.x + s1.y * s1.y) + (s1.z * s1.z + s1.w * s1.w);
            ss += __shfl_xor(ss, 1); ss += __shfl_xor(ss, 2); ss += __shfl_xor(ss, 4); ss += __shfl_xor(ss, 8); ss += __shfl_xor(ss, 16);
            const float rs = 1.0f / sqrtf(ss * (1.0f / 256.0f) + EPS);
            const f32x4 n0 = *(const f32x4*)(head_norm + c8), n1 = *(const f32x4*)(head_norm + c8 + 4);
            const v4u gw = *(const v4u*)(proj + (size_t)(row0 + cc) * GLA_PITCH + 2048 + h * 256 + c8);
            const float gg[8] = {bflo(gw.x), bfhi(gw.x), bflo(gw.y), bfhi(gw.y), bflo(gw.z), bfhi(gw.z), bflo(gw.w), bfhi(gw.w)};
            const float ov[8] = {s0.x * n0.x, s0.y * n0.y, s0.z * n0.z, s0.w * n0.w, s1.x * n1.x, s1.y * n1.y, s1.z * n1.z, s1.w * n1.w};
            float o[8];
#pragma unroll
            for (int j = 0; j < 8; ++j) o[j] = ov[j] * rs * (gg[j] / (1.f + __expf(-gg[j])));
            v4u w; w.x = pk2(o[0], o[1]); w.y = pk2(o[2], o[3]); w.z = pk2(o[4], o[5]); w.w = pk2(o[6], o[7]);
            *(v4u*)(proj + (size_t)(row0 + cc) * GLA_PITCH + 1024 + h * 256 + c8) = w; }
        __syncthreads();
    }
}
#ifndef USE_MFMA_SGU
#define USE_MFMA_SGU 1
#endif
#ifndef USE_MFMA_GLA
#define USE_MFMA_GLA 1
#endif

constexpr int PH_PER_LAYER = 8, NPHASE = 4 * PH_PER_LAYER + 1;
__host__ __device__ inline bool phase_is_noop(int ph) {
    if (ph >= 4 * PH_PER_LAYER) return false;
    const int L = ph / PH_PER_LAYER, s = ph % PH_PER_LAYER;
    const bool gla = (L == 0 || L == 3);
    return (s == 3 || s == 4) && !gla;
}

__global__ void __launch_bounds__(NTHR, 2) trunk_fwd(Args kargs) {
    extern __shared__ __attribute__((aligned(16))) unsigned char lds_raw[];
    LAS unsigned char* lds = (LAS unsigned char*)lds_raw;
    const int tid = threadIdx.x;
    const int G0 = gridDim.x; const int bx = blockIdx.x;
    const int vcu0 = (G0 % 8 == 0) ? (bx % 8) * (G0 / 8) + bx / 8 : bx;
    for (int u = tid; u < (LDS_BYTES - LDSCTL_OFF) / 4; u += NTHR) ((LAS unsigned*)(lds + LDSCTL_OFF))[u] = 0u;
    __syncthreads();
    unsigned* ctl = (unsigned*)(kargs.ws + WS_CTL);
    const int ph_lo = kargs.ph_lo, ph_hi = kargs.ph_hi; const bool multi = (ph_hi - ph_lo) > 1;
    if (multi) (void)xcd_barrier_post(ctl + 4096, (volatile LAS unsigned*)(lds + MISC_OFF) + 8);
    bool first_seam = true;
    for (int ph = ph_lo; ph < ph_hi; ++ph) {
        if (phase_is_noop(ph)) continue;
        int vcu = vcu0, G = G0; asm volatile("" : "+s"(vcu), "+s"(G));
        const CAS Args* ap = (const CAS Args*)__builtin_amdgcn_kernarg_segment_ptr(); asm volatile("" : "+s"(ap));
        Ctx args; args.in0 = ap->in[0]; args.in42 = ap->in[42]; args.out = ap->out; args.ws = ap->ws;
        bf16* Wb = (bf16*)(args.ws + WS_W); bf16* XB = (bf16*)(args.ws + WS_XB); bf16* HB = (bf16*)(args.ws + WS_H);
        float* SSQ = (float*)(args.ws + WS_SSQ); float* VSSQ = (float*)(args.ws + WS_VSSQ);
        if (ph == 4 * PH_PER_LAYER) { phase_final(args, vcu, G); }
        else {
            const int L = ph / PH_PER_LAYER, s = ph % PH_PER_LAYER;
            const LayerP P = layer_params((const CAS cfptr*)ap, L);
            if (s == 0) phase_conv(lds, args, P, L, vcu, G);
            else if (s == 1) { EpiIn E{P.kind, HB, SSQ, (P.kind == K_GLA) ? P.e2 : P.e0, VSSQ}; run_gemm(lds, XB, D, Wb + WOFF_IN, NTOK, P.nin, D, E, vcu, G); }
            else if (s == 2) { if (P.kind == K_GLA) {
#if USE_MFMA_GLA
                    phase_gla_kv_mfma(lds, args, vcu, G);
#else
                    phase_gla_kv(lds, args, vcu, G);
#endif
                } else if (P.kind == K_DIFF) {
#if USE_MFMA_ATTN
                    phase_diff_mfma((char*)lds_raw, args, P, vcu, G);
#else
                    phase_diff(lds, args, P, vcu, G);
#endif
                } else {
#if USE_MFMA_SGU
                    phase_sgu_mfma(lds, args, P, vcu, G);
#else
                    phase_sgu(lds, args, P, vcu, G);
#endif
                } }
            else if (s == 3) phase_gla_scan(args, vcu, G);
            else if (s == 4) {
#if USE_MFMA_GLA
                phase_gla_out_mfma(lds, args, P, vcu, G);
#else
                phase_gla_out(lds, args, P, vcu, G);
#endif
            }
            else if (s == 5) { EpiRes E{(L == 0) ? args.in0 : args.out, args.out, XB, SSQ}; run_gemm(lds, HB + P.mixoff, P.nin, Wb + WOFF_OUT, NTOK, D, D, E, vcu, G); }
            else if (s == 6) { EpiHid E{HB, SSQ}; run_gemm(lds, XB, D, Wb + WOFF_1, NTOK, FF, D, E, vcu, G); }
            else { EpiRes E{args.out, args.out, XB, SSQ}; run_gemm(lds, HB, FF, Wb + WOFF_2, NTOK, D, FF, E, vcu, G); }
        }
        if (ph + 1 < ph_hi) {
            if (first_seam) { cg::this_grid().sync(); first_seam = false; }
            else { XcdBarrier bb; bb.bar = (unsigned*)(ap->ws + WS_CTL) + 4096; bb.x = xb_xcc_id(); bb.st = (volatile LAS unsigned*)(lds + MISC_OFF) + 8; xcd_barrier(bb); }
        }
    }
}

extern "C" void kernel_launch(void* const* d_in, const int* in_sizes, int n_in, void* d_out, int out_size, void* d_ws, size_t ws_size, hipStream_t stream) {
    static int grid = 0;
    if (grid == 0) {
        if (n_in != 43 || in_sizes[0] != NTOK * D || out_size != NTOK * D || ws_size < WS_END) {
            fprintf(stderr, "kernel_launch: unexpected problem (n_in %d, in0 %d, out %d, ws %zu); nothing launched\n", n_in, n_in > 0 ? in_sizes[0] : -1, out_size, ws_size); grid = -1; return; }
        int dev = 0, cus = 0, per_cu = 0;
        if (hipGetDevice(&dev) != hipSuccess || hipDeviceGetAttribute(&cus, hipDeviceAttributeMultiprocessorCount, dev) != hipSuccess) { grid = -1; return; }
        if (hipFuncSetAttribute((const void*)trunk_fwd, hipFuncAttributeMaxDynamicSharedMemorySize, LDS_BYTES) != hipSuccess) { fprintf(stderr, "kernel_launch: hipFuncSetAttribute failed\n"); grid = -1; return; }
        if (hipOccupancyMaxActiveBlocksPerMultiprocessor(&per_cu, (const void*)trunk_fwd, NTHR, LDS_BYTES) != hipSuccess || per_cu < 1) { fprintf(stderr, "kernel_launch: occupancy query says %d blocks/CU\n", per_cu); per_cu = 1; }
        (void)hipGetLastError();
        grid = cus;
    }
    if (grid < 0) return;
    (void)hipMemsetAsync((char*)d_ws + WS_CTL, 0, CTL_ZERO_BYTES, stream);
    Args a{};
    for (int i = 0; i < 43; ++i) a.in[i] = (const float*)d_in[i];
    a.out = (float*)d_out; a.ws = (unsigned char*)d_ws;
#if MK_ONE_LAUNCH
    a.ph_lo = 0; a.ph_hi = NPHASE;
    void* kargs[] = {&a};
    hipError_t e = hipLaunchCooperativeKernel((const void*)trunk_fwd, dim3(grid), dim3(NTHR), kargs, LDS_BYTES, stream);
    if (e != hipSuccess) fprintf(stderr, "kernel_launch: cooperative launch failed: %s (grid %d)\n", hipGetErrorString(e), grid);
#else
    for (int ph = 0; ph < NPHASE; ++ph) {
        if (phase_is_noop(ph)) continue;
        a.ph_lo = ph; a.ph_hi = ph + 1;
        hipLaunchKernelGGL(trunk_fwd, dim3(grid), dim3(NTHR), LDS_BYTES, stream, a);
    }
#endif
}
```

```cpp
#include <hip/hip_runtime.h>
#include <hip/hip_cooperative_groups.h>
#include <cstdio>
#include <cstdint>
namespace cg = cooperative_groups;

#ifndef MK_ONE_LAUNCH
#define MK_ONE_LAUNCH 1
#endif

#define GAS __attribute__((address_space(1)))
#define LAS __attribute__((address_space(3)))
typedef unsigned short bf16;
typedef unsigned v4u __attribute__((ext_vector_type(4)));
typedef unsigned v2u __attribute__((ext_vector_type(2)));
typedef float f32x4 __attribute__((ext_vector_type(4)));

constexpr int NB = 2, T = 8192, D = 1024, NTOK = NB * T, FF = 4096;
constexpr float EPS = 1e-6f;
constexpr float LOG2E = 1.4426950408889634f;
constexpr int NWAVES = 8, NTHR = 512;
constexpr int K_GLA = 0, K_DIFF = 1, K_SGU = 2;
constexpr int GLA_H = 4, GLA_HK = 128, GLA_HV = 256, GLA_C = 64, GLA_NC = T / GLA_C;
constexpr int GLA_PITCH = 3584;
constexpr int DIFF_H = 8, DIFF_PITCH = 3072;
constexpr float LAMBDA_INIT = 0.35551069f;
constexpr int SGU_PITCH = 2048, SGU_C = 128, SGU_G = 8;

constexpr size_t MiB = 1u << 20;
constexpr size_t WS_CTL = 0, CTL_ZERO_BYTES = 1 * MiB;
constexpr size_t WS_SSQ = 1 * MiB;
constexpr size_t WS_VSSQ = 2 * MiB;
constexpr size_t WS_DEC = 3 * MiB;
constexpr size_t WS_W = 4 * MiB;
constexpr size_t WS_XB = 29 * MiB;
constexpr size_t WS_STATE = 61 * MiB;
constexpr size_t WS_H = 125 * MiB;
constexpr size_t WS_END = 253 * MiB;
constexpr int CW_QKMAX = 8192;
constexpr int CW_QUEUE = 8448;
constexpr size_t WOFF_IN = 0, WOFF_OUT = (size_t)3584 * 1024, WOFF_1 = WOFF_OUT + (size_t)1024 * 1024, WOFF_2 = WOFF_1 + (size_t)4096 * 1024;

constexpr int RING_BYTES = 131072, LDSCTL_OFF = RING_BYTES, MISC_OFF = LDSCTL_OFF + 320, LDS_BYTES = 147456;

#define RLX_AGENT __ATOMIC_RELAXED, __HIP_MEMORY_SCOPE_AGENT
#define LDS_WAIT() asm volatile("s_waitcnt lgkmcnt(0)" ::: "memory")
__device__ __forceinline__ unsigned f2bf(float f) { unsigned u = __builtin_bit_cast(unsigned, f); return (u + 0x7fffu + ((u >> 16) & 1u)) >> 16; }
__device__ __forceinline__ unsigned pk2(float lo, float hi) { return f2bf(lo) | (f2bf(hi) << 16); }
__device__ __forceinline__ float bf2f(unsigned b) { return __builtin_bit_cast(float, b << 16); }
__device__ __forceinline__ float bflo(unsigned w) { return __builtin_bit_cast(float, w << 16); }
__device__ __forceinline__ float bfhi(unsigned w) { return __builtin_bit_cast(float, w & 0xffff0000u); }
extern __shared__ __attribute__((aligned(16))) unsigned char lds_raw[];
constexpr int TIDTAB_OFF = 131072;
__device__ __forceinline__ unsigned hw_slot() { return (unsigned)__builtin_amdgcn_s_getreg((5 << 11) | 4) & 63u; }
__device__ __forceinline__ int otid() {
    const int wv = (int)((volatile __attribute__((address_space(3))) unsigned*)((__attribute__((address_space(3))) unsigned char*)lds_raw + TIDTAB_OFF))[hw_slot()];
    int t = wv * 64 + (int)__builtin_amdgcn_mbcnt_hi(~0u, __builtin_amdgcn_mbcnt_lo(~0u, 0u));
    asm volatile("" : "+v"(t)); return t; }
__device__ __forceinline__ float wave_sum(float v) {
#pragma unroll
    for (int o = 1; o < 64; o <<= 1) v += __shfl_xor(v, o);
    return v;
}
__device__ __forceinline__ float wave_max(float v) {
#pragma unroll
    for (int o = 1; o < 64; o <<= 1) v = fmaxf(v, __shfl_xor(v, o));
    return v;
}
__device__ __forceinline__ float gelu_tanh(float x) {
    const float u = 0.7978845608028654f * (x + 0.044715f * x * x * x);
    const float e = __expf(2.f * u);
    const float t = 1.f - 2.f / (e + 1.f);
    return 0.5f * x * (1.f + t);
}
__device__ __forceinline__ float log_sigmoid(float z) { return fminf(z, 0.f) - log1pf(__expf(-fabsf(z))); }

#define XB_TMO      128
#define XB_XCNT(j)  (256  + 64 * (j))
#define XB_XSUB(j)  (1280 + 64 * (j))
#define XB_XGEN(j)  (2304 + 64 * (j))
#define XB_TOP      3328
#define XB_TOPGEN   3392
#define XCD_BAR_WORDS 3456
#define XB_SPIN_CAP (1u << 22)
__device__ __forceinline__ unsigned xb_ld(unsigned* p)              { return __hip_atomic_load(p, __ATOMIC_RELAXED, __HIP_MEMORY_SCOPE_AGENT); }
__device__ __forceinline__ unsigned xb_add(unsigned* p, unsigned v) { return __hip_atomic_fetch_add(p, v, __ATOMIC_RELAXED, __HIP_MEMORY_SCOPE_AGENT); }
__device__ __forceinline__ unsigned xb_xcc_id() { return (unsigned)__builtin_amdgcn_s_getreg((3 << 11) | 20) & 0xFu; }
#define XB_SPIN(cond, bar) do { unsigned _sp = 0; while (cond) { __builtin_amdgcn_s_sleep(1); \
    if ((++_sp & 255u) == 0u) { if (xb_ld(&(bar)[XB_TMO])) break; if (_sp > XB_SPIN_CAP) { atomicAdd(&(bar)[XB_TMO], 1u); break; } } } } while (0)
struct XcdBarrier { unsigned* bar; unsigned x; volatile LAS unsigned* st; };
__device__ __forceinline__ XcdBarrier xcd_barrier_post(unsigned* bar, volatile LAS unsigned* st) {
    XcdBarrier b; b.bar = bar; b.x = xb_xcc_id(); b.st = st;
    if (threadIdx.x == 0) (void)xb_add(&bar[XB_XCNT(b.x)], 1u);
    return b;
}
__device__ __forceinline__ void xcd_barrier_complete(unsigned* bar, unsigned x, unsigned& nloc, unsigned& nx) {
    const unsigned G = gridDim.x * gridDim.y * gridDim.z;
    unsigned sum, cnt, mine, sp = 0u;
    for (;;) {
        sum = 0u; cnt = 0u; mine = 0u;
#pragma unroll
        for (unsigned j = 0; j < 16; ++j) { const unsigned c = xb_ld(&bar[XB_XCNT(j)]); sum += c; cnt += (c > 0u) ? 1u : 0u; mine = (j == x) ? c : mine; }
        if (sum == G) break;
        __builtin_amdgcn_s_sleep(1);
        if ((++sp & 255u) == 0u) { if (xb_ld(&bar[XB_TMO])) break; if (sp > XB_SPIN_CAP) { atomicAdd(&bar[XB_TMO], 1u); break; } }
    }
    nloc = mine > 0u ? mine : 1u; nx = cnt > 0u ? cnt : 1u;
}
__device__ __forceinline__ void xcd_barrier(const XcdBarrier& b) {
    asm volatile("s_waitcnt vmcnt(0)" ::: "memory");
    __syncthreads();
    if (threadIdx.x == 0) {
        unsigned* bar = b.bar;
        __builtin_amdgcn_s_waitcnt(0);
        unsigned nloc = b.st[0], nx = b.st[1];
        if (nloc == 0u) { xcd_barrier_complete(bar, b.x, nloc, nx); b.st[0] = nloc; b.st[1] = nx; }
        const unsigned old = xb_add(&bar[XB_XSUB(b.x)], 1u);
        const unsigned gen = old / nloc;
        if (old + 1u == (gen + 1u) * nloc) {
            __builtin_amdgcn_fence(__ATOMIC_RELEASE, "agent");
            asm volatile("s_waitcnt vmcnt(0)" ::: "memory");
            const unsigned og = xb_add(&bar[XB_TOP], 1u);
            const unsigned tg = og / nx;
            if (og + 1u == (tg + 1u) * nx) xb_add(&bar[XB_TOPGEN], 1u);
            else XB_SPIN(xb_ld(&bar[XB_TOPGEN]) == tg, bar);
            __builtin_amdgcn_fence(__ATOMIC_ACQUIRE, "agent");
            xb_add(&bar[XB_XGEN(b.x)], 1u);
            asm volatile("s_waitcnt vmcnt(0)" ::: "memory");
        } else {
            XB_SPIN(xb_ld(&bar[XB_XGEN(b.x)]) == gen, bar);
            __builtin_amdgcn_fence(__ATOMIC_ACQUIRE, "agent");
            asm volatile("s_waitcnt vmcnt(0)" ::: "memory");
        }
    }
    __syncthreads();
}

struct Args { const float* in[43]; float* out; unsigned char* ws; int ph_lo, ph_hi; };
struct Ctx { const float* in0; const float* in42; float* out; unsigned char* ws; };
struct LayerP {
    int kind;
    const float *norm1, *w_in, *w_out, *norm2, *w1, *w2;
    const float *e0, *e1, *e2, *e3, *e4;
    int nin;
    int mixoff;
};
typedef const float* cfptr;
#define CAS __attribute__((address_space(4)))
__device__ __forceinline__ LayerP layer_params(const CAS cfptr* in, int L) {
    LayerP p;
    const int base = (L == 0) ? 1 : (L == 1) ? 11 : (L == 2) ? 22 : 32;
    p.kind = (L == 1) ? K_DIFF : (L == 2) ? K_SGU : K_GLA;
    const int sh = (p.kind == K_DIFF) ? 1 : 0;
    p.norm1 = in[base]; p.w_in = in[base + 1];
    p.e0 = in[base + 2]; p.e1 = in[base + 3]; p.e2 = in[base + 4]; p.e3 = in[base + 5]; p.e4 = in[base + 6];
    p.w_out = in[base + 6 + sh]; p.norm2 = in[base + 7 + sh]; p.w1 = in[base + 8 + sh]; p.w2 = in[base + 9 + sh];
    p.nin = (p.kind == K_GLA) ? GLA_PITCH : (p.kind == K_DIFF) ? DIFF_PITCH : SGU_PITCH;
    p.mixoff = (p.kind == K_GLA) ? 1024 : 0;
    return p;
}

__device__ __forceinline__ float row_rstd(const float* ssq, int row) {
    const f32x4* p = (const f32x4*)(ssq + (size_t)row * 16);
    const f32x4 a = p[0], b = p[1], c = p[2], d = p[3];
    const float s = ((a.x + a.y) + (a.z + a.w)) + ((b.x + b.y) + (b.z + b.w)) + ((c.x + c.y) + (c.z + c.w)) + ((d.x + d.y) + (d.z + d.w));
    return 1.0f / sqrtf(s * (1.0f / D) + EPS);
}

struct EpiIn {
    int kind; bf16* proj; const float* ssq; const float* bias;
    float* vssq;
    __device__ __forceinline__ float rowscale(int row) const { return row_rstd(ssq, row); }
    __device__ __forceinline__ float apply8(int row, int col0, const float (&v)[8], float rs) const {
        float o[8]; float part = 0.f; int pitch;
        if (kind == K_GLA) { pitch = GLA_PITCH;
            if (col0 < 3072) {
#pragma unroll
                for (int j = 0; j < 8; ++j) o[j] = v[j] * rs;
            } else {
#pragma unroll
                for (int j = 0; j < 8; ++j) o[j] = log_sigmoid(v[j] * rs + bias[col0 - 3072 + j]) * (1.0f / 16.0f);
            }
        } else if (kind == K_DIFF) { pitch = DIFF_PITCH;
            const float sc = (col0 < 1024) ? rs * (0.125f * LOG2E) : rs;
#pragma unroll
            for (int j = 0; j < 8; ++j) o[j] = v[j] * sc;
            if (col0 < 2048) {
#pragma unroll
                for (int j = 0; j < 8; ++j) part += o[j] * o[j];
            }
        } else { pitch = SGU_PITCH;
#pragma unroll
            for (int j = 0; j < 8; ++j) { o[j] = gelu_tanh(v[j] * rs + bias[col0 + j]); }
            if (col0 >= 1024) {
#pragma unroll
                for (int j = 0; j < 8; ++j) part += o[j] * o[j];
            }
        }
        v4u w; w.x = pk2(o[0], o[1]); w.y = pk2(o[2], o[3]); w.z = pk2(o[4], o[5]); w.w = pk2(o[6], o[7]);
        *(v4u*)(proj + (size_t)row * pitch + col0) = w;
        return part;
    }
    __device__ __forceinline__ void store_part(int row, int col0, int idx, float part) const {
        if (kind == K_SGU && col0 >= 1024) vssq[(size_t)row * 16 + idx] = part;
    }
    static constexpr bool GROUPMAX = true;
    unsigned* qkmax;
    __device__ __forceinline__ bool want_groupmax(int col0) const { return kind == K_DIFF && col0 < 2048; }
    __device__ __forceinline__ void store_groupmax(int row, int col0, float m) const {
        atomicMax(qkmax + (row >> 13) * 64 + (col0 >> 5), __float_as_uint(m * 1.01f));
    }
};
struct EpiHid {
    bf16* h; const float* ssq;
    __device__ __forceinline__ float rowscale(int row) const { return row_rstd(ssq, row); }
    __device__ __forceinline__ float apply8(int row, int col0, const float (&v)[8], float rs) const {
        float o[8];
#pragma unroll
        for (int j = 0; j < 8; ++j) { const float a = fmaxf(v[j] * rs, 0.f); o[j] = a * a; }
        v4u w; w.x = pk2(o[0], o[1]); w.y = pk2(o[2], o[3]); w.z = pk2(o[4], o[5]); w.w = pk2(o[6], o[7]);
        *(v4u*)(h + (size_t)row * FF + col0) = w;
        return 0.f;
    }
    __device__ __forceinline__ void store_part(int, int, int, float) const {}
    static constexpr bool GROUPMAX = false;
    __device__ __forceinline__ bool want_groupmax(int) const { return false; }
    __device__ __forceinline__ void store_groupmax(int, int, float) const {}
};
struct EpiRes {
    const float* base; float* x; bf16* xb; float* ssq;
    __device__ __forceinline__ float rowscale(int) const { return 1.f; }
    __device__ __forceinline__ float apply8(int row, int col0, const float (&v)[8], float) const {
        const size_t off = (size_t)row * D + col0;
        const f32x4 b0 = *(const f32x4*)(base + off), b1 = *(const f32x4*)(base + off + 4);
        float o[8] = {b0.x + v[0], b0.y + v[1], b0.z + v[2], b0.w + v[3], b1.x + v[4], b1.y + v[5], b1.z + v[6], b1.w + v[7]};
        *(f32x4*)(x + off) = (f32x4){o[0], o[1], o[2], o[3]}; *(f32x4*)(x + off + 4) = (f32x4){o[4], o[5], o[6], o[7]};
        v4u w; w.x = pk2(o[0], o[1]); w.y = pk2(o[2], o[3]); w.z = pk2(o[4], o[5]); w.w = pk2(o[6], o[7]);
        *(v4u*)(xb + off) = w;
        float part = 0.f;
#pragma unroll
        for (int j = 0; j < 8; ++j) part += o[j] * o[j];
        return part;
    }
    __device__ __forceinline__ void store_part(int row, int, int idx, float part) const { ssq[(size_t)row * 16 + idx] = part; }
    static constexpr bool GROUPMAX = false;
    __device__ __forceinline__ bool want_groupmax(int) const { return false; }
    __device__ __forceinline__ void store_groupmax(int, int, float) const {}
};

template <class Epi>
__device__ __forceinline__ void gemm_naive(LAS unsigned char* lds, const bf16* A, int lda, const bf16* Bt, int M, int N, int K, const Epi& E, int vcu, int G) {
    LAS float* As = (LAS float*)lds;
    LAS float* Bs = As + 64 * 33;
    const int tid = otid();
    const int nM = M / 64, nN = N / 64;
    const int r = tid >> 3, cgp = tid & 7;
    for (int u = vcu; u < nM * nN; u += G) {
        const int pm = u / nN, pn = u % nN;
        float acc[8];
#pragma unroll
        for (int j = 0; j < 8; ++j) acc[j] = 0.f;
        for (int k0 = 0; k0 < K; k0 += 32) {
            { const int lr = tid >> 3, lc = (tid & 7) * 4;
              const v2u av = *(const v2u*)(A + (size_t)(pm * 64 + lr) * lda + k0 + lc);
              const v2u bv = *(const v2u*)(Bt + (size_t)(pn * 64 + lr) * K + k0 + lc);
              As[lr * 33 + lc + 0] = bflo(av.x); As[lr * 33 + lc + 1] = bfhi(av.x); As[lr * 33 + lc + 2] = bflo(av.y); As[lr * 33 + lc + 3] = bfhi(av.y);
              Bs[lr * 33 + lc + 0] = bflo(bv.x); Bs[lr * 33 + lc + 1] = bfhi(bv.x); Bs[lr * 33 + lc + 2] = bflo(bv.y); Bs[lr * 33 + lc + 3] = bfhi(bv.y); }
            __syncthreads();
#pragma unroll 8
            for (int kk = 0; kk < 32; ++kk) { const float a = As[r * 33 + kk];
#pragma unroll
                for (int j = 0; j < 8; ++j) acc[j] += a * Bs[(cgp * 8 + j) * 33 + kk]; }
            __syncthreads();
        }
        const int row = pm * 64 + r, col0 = pn * 64 + cgp * 8;
        const float rs = E.rowscale(row);
        float part = E.apply8(row, col0, acc, rs);
        part += __shfl_xor(part, 1); part += __shfl_xor(part, 2); part += __shfl_xor(part, 4);
        if (cgp == 0) E.store_part(row, col0, pn & 15, part);
    }
}

__device__ __forceinline__ void transpose_item(const float* W, const float* gain, int K, int N, bf16* WT, int row_off, LAS float* scr, int item, int lane) {
    const int nblk = N / 32, kb = item / nblk, nb = item % nblk, k0 = 64 * kb, n0 = 32 * nb;
#pragma unroll 8
    for (int i = 0; i < 32; ++i) { const int kk = 2 * i + (lane >> 5); const float g = gain ? gain[k0 + kk] : 1.f; scr[kk * 33 + (lane & 31)] = g * W[(size_t)(k0 + kk) * N + n0 + (lane & 31)]; }
    LDS_WAIT(); asm volatile("" ::: "memory");
    const int c = lane & 7;
#pragma unroll
    for (int j = 0; j < 4; ++j) { const int n = (lane >> 3) + 8 * j; const LAS float* s = scr + (8 * c) * 33 + n;
        v4u o; o.x = pk2(s[0 * 33], s[1 * 33]); o.y = pk2(s[2 * 33], s[3 * 33]); o.z = pk2(s[4 * 33], s[5 * 33]); o.w = pk2(s[6 * 33], s[7 * 33]);
        *(GAS v4u*)(WT + (size_t)(row_off + n0 + n) * K + k0 + 8 * c) = o; }
    LDS_WAIT(); asm volatile("" ::: "memory");
}

__device__ __forceinline__ void phase_conv(LAS unsigned char* lds, const Ctx& a, const LayerP& P, int L, int vcu, int G) {
    const int tid = otid(), lane = tid & 63, wave = __builtin_amdgcn_readfirstlane(tid >> 6);
    LAS float* scr = (LAS float*)(lds + wave * 16384);
    bf16* Wb = (bf16*)(a.ws + WS_W);
    const int gw = vcu * NWAVES + wave, NGW = G * NWAVES;
    const int nin_w = (P.kind == K_SGU) ? 2048 : 3072;
    const int I_IN = (D / 64) * (nin_w / 32), I_OUT = (D / 64) * (D / 32), I_1 = (D / 64) * (FF / 32), I_2 = (FF / 64) * (D / 32);
    const int NITEMS = I_IN + I_OUT + I_1 + I_2;
    for (int it = gw; it < NITEMS; it += NGW) {
        int r = it;
        if (r < I_IN) { transpose_item(P.w_in, P.norm1, D, nin_w, Wb + WOFF_IN, 0, scr, r, lane); continue; } r -= I_IN;
        if (r < I_OUT) { transpose_item(P.w_out, nullptr, D, D, Wb + WOFF_OUT, 0, scr, r, lane); continue; } r -= I_OUT;
        if (r < I_1) { transpose_item(P.w1, P.norm2, D, FF, Wb + WOFF_1, 0, scr, r, lane); continue; } r -= I_1;
        transpose_item(P.w2, nullptr, FF, D, Wb + WOFF_2, 0, scr, r, lane);
    }
    if (P.kind == K_GLA) {
        const float* W1 = P.e0; const float* W2 = P.e1;
        for (int e = vcu * NTHR + tid; e < 512 * 1024; e += G * NTHR) {
            const int n = e >> 10, k = e & 1023;
            float s = 0.f;
#pragma unroll
            for (int r = 0; r < 16; ++r) s += W1[k * 16 + r] * W2[r * 512 + n];
            Wb[WOFF_IN + (size_t)(3072 + n) * 1024 + k] = (bf16)f2bf(s * P.norm1[k]);
        }
    }
    if (L == 0) {
        const float* x = a.in0; bf16* xb = (bf16*)(a.ws + WS_XB); float* ssq = (float*)(a.ws + WS_SSQ);
        for (int m = gw; m < NTOK; m += NGW) {
            const f32x4* xr = (const f32x4*)(x + (size_t)m * D) + lane;
            f32x4 v[4]; float s = 0.f;
#pragma unroll
            for (int j = 0; j < 4; ++j) { v[j] = xr[64 * j]; s += (v[j].x * v[j].x + v[j].y * v[j].y) + (v[j].z * v[j].z + v[j].w * v[j].w); }
            s = wave_sum(s);
            v2u* o8 = (v2u*)(xb + (size_t)m * D) + lane;
#pragma unroll
            for (int j = 0; j < 4; ++j) { v2u w; w.x = pk2(v[j].x, v[j].y); w.y = pk2(v[j].z, v[j].w); o8[64 * j] = w; }
            if (lane < 16) ssq[(size_t)m * 16 + lane] = (lane == 0) ? s : 0.f;
        }
    }
}

__device__ __forceinline__ void phase_final(const Ctx& a, int vcu, int G) {
    const int tid = otid(), lane = tid & 63, wave = tid >> 6;
    const int gw = vcu * NWAVES + wave, NGW = G * NWAVES;
    const float* ssq = (const float*)(a.ws + WS_SSQ); const float* g = a.in42;
    for (int m = gw; m < NTOK; m += NGW) {
        const float rs = row_rstd(ssq, m);
        f32x4* xr = (f32x4*)(a.out + (size_t)m * D) + lane; const f32x4* gr = (const f32x4*)g + lane;
#pragma unroll
        for (int j = 0; j < 4; ++j) { f32x4 v = xr[64 * j]; const f32x4 gg = gr[64 * j]; v.x *= rs * gg.x; v.y *= rs * gg.y; v.z *= rs * gg.z; v.w *= rs * gg.w; xr[64 * j] = v; }
    }
}

struct GlaCum { float b0[8], b1[8], tot0, tot1; };
__device__ __forceinline__ void gla_cumsum(GlaCum& c, const bf16* proj, int row0, int h, LAS float* TOT, int tid) {
    const int cp = tid & 63, part = tid >> 6;
#pragma unroll
    for (int i = 0; i < 8; ++i) { const unsigned w = *(const unsigned*)(proj + (size_t)(row0 + 8 * part + i) * GLA_PITCH + 3072 + h * 128 + 2 * cp); c.b0[i] = bflo(w); c.b1[i] = bfhi(w); }
#pragma unroll
    for (int i = 1; i < 8; ++i) { c.b0[i] += c.b0[i - 1]; c.b1[i] += c.b1[i - 1]; }
    TOT[part * 128 + 2 * cp] = c.b0[7]; TOT[part * 128 + 2 * cp + 1] = c.b1[7];
    __syncthreads();
    float o0 = 0.f, o1 = 0.f, t0 = 0.f, t1 = 0.f;
#pragma unroll
    for (int p = 0; p < 8; ++p) { const float x0 = TOT[p * 128 + 2 * cp], x1 = TOT[p * 128 + 2 * cp + 1]; if (p < part) { o0 += x0; o1 += x1; } t0 += x0; t1 += x1; }
#pragma unroll
    for (int i = 0; i < 8; ++i) { c.b0[i] += o0; c.b1[i] += o1; }
    c.tot0 = t0; c.tot1 = t1;
}
__device__ __forceinline__ void phase_gla_kv(LAS unsigned char* lds, const Ctx& a, int vcu, int G) {
    const int tid = otid();
    const bf16* proj = (const bf16*)(a.ws + WS_H); bf16* state = (bf16*)(a.ws + WS_STATE); float* dec = (float*)(a.ws + WS_DEC);
    LAS float* KE = (LAS float*)lds;
    LAS float* V = KE + 64 * 128;
    LAS float* TOT = V + 64 * 256;
    for (int u = vcu; u < NB * GLA_H * GLA_NC; u += G) {
        const int n = u % GLA_NC, bh = u / GLA_NC, h = bh % GLA_H, b = bh / GLA_H;
        const int row0 = b * T + n * GLA_C;
        GlaCum c; gla_cumsum(c, proj, row0, h, TOT, tid);
        const int cp = tid & 63, part = tid >> 6;
#pragma unroll
        for (int i = 0; i < 8; ++i) { const int t = 8 * part + i; const unsigned w = *(const unsigned*)(proj + (size_t)(row0 + t) * GLA_PITCH + 512 + h * 128 + 2 * cp);
            KE[t * 128 + 2 * cp] = bflo(w) * __expf(c.tot0 - c.b0[i]); KE[t * 128 + 2 * cp + 1] = bfhi(w) * __expf(c.tot1 - c.b1[i]); }
        if (part == 0) { dec[(size_t)u * 128 + 2 * cp] = __expf(c.tot0); dec[(size_t)u * 128 + 2 * cp + 1] = __expf(c.tot1); }
        { const int vp = tid & 127, rp = tid >> 7;
#pragma unroll
          for (int i = 0; i < 16; ++i) { const int t = 16 * rp + i; const unsigned w = *(const unsigned*)(proj + (size_t)(row0 + t) * GLA_PITCH + 1024 + h * 256 + 2 * vp);
              V[t * 256 + 2 * vp] = bflo(w); V[t * 256 + 2 * vp + 1] = bfhi(w); } }
        __syncthreads();
        const int vd = tid & 255, kh = tid >> 8;
        float acc[64];
#pragma unroll
        for (int j = 0; j < 64; ++j) acc[j] = 0.f;
        for (int t = 0; t < 64; ++t) { const float v = V[t * 256 + vd];
#pragma unroll
            for (int j = 0; j < 64; ++j) acc[j] += KE[t * 128 + kh * 64 + j] * v; }
        bf16* sp = state + ((size_t)u * 256 + vd) * 128 + kh * 64;
#pragma unroll
        for (int j = 0; j < 64; j += 8) { v4u w; w.x = pk2(acc[j], acc[j + 1]); w.y = pk2(acc[j + 2], acc[j + 3]); w.z = pk2(acc[j + 4], acc[j + 5]); w.w = pk2(acc[j + 6], acc[j + 7]); *(v4u*)(sp + j) = w; }
        __syncthreads();
    }
}
__device__ __forceinline__ void phase_gla_scan(const Ctx& a, int vcu, int G) {
    unsigned* state = (unsigned*)(a.ws + WS_STATE); const float* dec = (const float*)(a.ws + WS_DEC);
    for (int gid = vcu * NTHR + otid(); gid < NB * GLA_H * 16384; gid += G * NTHR) {
        const int bh = gid >> 14, e = gid & 16383, kp = e & 63;
        unsigned* sp = state + (size_t)bh * GLA_NC * 16384 + e;
        const float* dp = dec + (size_t)bh * GLA_NC * 128 + 2 * kp;
        float s0 = 0.f, s1 = 0.f;
        for (int n0 = 0; n0 < GLA_NC; n0 += 8) {
            unsigned w[8]; float d0[8], d1[8];
#pragma unroll
            for (int i = 0; i < 8; ++i) { w[i] = sp[(size_t)(n0 + i) * 16384]; d0[i] = dp[(n0 + i) * 128]; d1[i] = dp[(n0 + i) * 128 + 1]; }
#pragma unroll
            for (int i = 0; i < 8; ++i) { sp[(size_t)(n0 + i) * 16384] = pk2(s0, s1); s0 = d0[i] * s0 + bflo(w[i]); s1 = d1[i] * s1 + bfhi(w[i]); }
        }
    }
}
__device__ __forceinline__ void phase_gla_out(LAS unsigned char* lds, const Ctx& a, const LayerP& P, int vcu, int G) {
    const int tid = otid(), lane = tid & 63, wave = tid >> 6;
    bf16* proj = (bf16*)(a.ws + WS_H); const bf16* state = (const bf16*)(a.ws + WS_STATE);
    LAS float* QD = (LAS float*)lds;
    LAS float* KI = QD + 64 * 128;
    LAS float* ATT = KI + 64 * 128;
    LAS unsigned* Vb = (LAS unsigned*)(ATT + 64 * 64);
    LAS float* TOT = (LAS float*)(Vb + 64 * 128);
    LAS float* RSS = TOT + 8 * 128;
    for (int u = vcu; u < NB * GLA_H * GLA_NC; u += G) {
        const int n = u % GLA_NC, bh = u / GLA_NC, h = bh % GLA_H, b = bh / GLA_H;
        const int row0 = b * T + n * GLA_C;
        GlaCum c; gla_cumsum(c, proj, row0, h, TOT, tid);
        const int cp = tid & 63, part = tid >> 6;
#pragma unroll
        for (int i = 0; i < 8; ++i) { const int t = 8 * part + i;
            const unsigned wq = *(const unsigned*)(proj + (size_t)(row0 + t) * GLA_PITCH + h * 128 + 2 * cp);
            const unsigned wk = *(const unsigned*)(proj + (size_t)(row0 + t) * GLA_PITCH + 512 + h * 128 + 2 * cp);
            const float e0 = __expf(c.b0[i]), e1 = __expf(c.b1[i]);
            QD[t * 128 + 2 * cp] = bflo(wq) * 0.08838834764831845f * e0; QD[t * 128 + 2 * cp + 1] = bfhi(wq) * 0.08838834764831845f * e1;
            KI[t * 128 + 2 * cp] = bflo(wk) / e0; KI[t * 128 + 2 * cp + 1] = bfhi(wk) / e1; }
        { const int vp = tid & 127, rp = tid >> 7;
#pragma unroll
          for (int i = 0; i < 16; ++i) { const int t = 16 * rp + i; Vb[t * 128 + vp] = *(const unsigned*)(proj + (size_t)(row0 + t) * GLA_PITCH + 1024 + h * 256 + 2 * vp); } }
        __syncthreads();
        { const int cc = tid >> 3, s0 = (tid & 7) * 8; float acc[8];
#pragma unroll
          for (int j = 0; j < 8; ++j) acc[j] = 0.f;
          for (int d = 0; d < 128; ++d) { const float q = QD[cc * 128 + d];
#pragma unroll
              for (int j = 0; j < 8; ++j) acc[j] += q * KI[(s0 + j) * 128 + d]; }
#pragma unroll
          for (int j = 0; j < 8; ++j) ATT[cc * 64 + s0 + j] = (s0 + j <= cc) ? acc[j] : 0.f; }
        __syncthreads();
        const int vd = tid & 255, ch = tid >> 8;
        float acc[32];
#pragma unroll
        for (int j = 0; j < 32; ++j) acc[j] = 0.f;
        for (int s = 0; s < 64; ++s) { const unsigned w = Vb[s * 128 + (vd >> 1)]; const float v = (vd & 1) ? bfhi(w) : bflo(w);
#pragma unroll
            for (int j = 0; j < 32; ++j) acc[j] += ATT[(ch * 32 + j) * 64 + s] * v; }
        { const bf16* sp = state + ((size_t)u * 256 + vd) * 128;
          for (int d0 = 0; d0 < 128; d0 += 8) { const v4u w = *(const v4u*)(sp + d0);
              const float st[8] = {bflo(w.x), bfhi(w.x), bflo(w.y), bfhi(w.y), bflo(w.z), bfhi(w.z), bflo(w.w), bfhi(w.w)};
#pragma unroll
              for (int dd = 0; dd < 8; ++dd) {
#pragma unroll
                  for (int j = 0; j < 32; ++j) acc[j] += QD[(ch * 32 + j) * 128 + d0 + dd] * st[dd]; } } }
#pragma unroll
        for (int j = 0; j < 32; ++j) { const float s = wave_sum(acc[j] * acc[j]); if (lane == 0) RSS[wave * 32 + j] = s; }
        __syncthreads();
        const float hn = P.e3[vd];
#pragma unroll
        for (int j = 0; j < 32; ++j) { const int cc = ch * 32 + j;
            const float ss = (RSS[(ch * 4 + 0) * 32 + j] + RSS[(ch * 4 + 1) * 32 + j]) + (RSS[(ch * 4 + 2) * 32 + j] + RSS[(ch * 4 + 3) * 32 + j]);
            const float rs = 1.0f / sqrtf(ss * (1.0f / 256.0f) + EPS);
            const float g = bf2f(proj[(size_t)(row0 + cc) * GLA_PITCH + 2048 + h * 256 + vd]);
            const float o = acc[j] * rs * hn * (g / (1.f + __expf(-g)));
            proj[(size_t)(row0 + cc) * GLA_PITCH + 1024 + h * 256 + vd] = (bf16)f2bf(o); }
        __syncthreads();
    }
}

__device__ __forceinline__ void phase_sgu(LAS unsigned char* lds, const Ctx& a, const LayerP& P, int vcu, int G) {
    const int tid = otid();
    bf16* proj = (bf16*)(a.ws + WS_H); const float* vssq = (const float*)(a.ws + WS_VSSQ);
    const float* v_norm = P.e1; const float* w_s = P.e2; const float* b_s = P.e3;
    LAS float* W = (LAS float*)lds;
    LAS float* V = W + 128 * 128;
    for (int u = vcu; u < NB * (T / SGU_C) * SGU_G; u += G) {
        const int g = u % SGU_G, bc = u / SGU_G;
        const int row0 = bc * SGU_C;
        for (int e = tid; e < 128 * 128; e += NTHR) { const int t = e >> 7, s = e & 127;
            const float rs = row_rstd(vssq, row0 + s);
            W[e] = (s <= t) ? w_s[(size_t)g * 16384 + e] * rs : 0.f;
            V[e] = bf2f(proj[(size_t)(row0 + t) * SGU_PITCH + 1024 + g * 128 + s]); }
        __syncthreads();
        const int d = tid & 127, tq = tid >> 7;
        float acc[32];
#pragma unroll
        for (int j = 0; j < 32; ++j) acc[j] = 0.f;
        for (int s = 0; s < 128; ++s) { const float v = V[s * 128 + d];
#pragma unroll
            for (int j = 0; j < 32; ++j) acc[j] += W[(tq + 4 * j) * 128 + s] * v; }
        const float vn = v_norm[g * 128 + d];
#pragma unroll
        for (int j = 0; j < 32; ++j) { const int t = tq + 4 * j;
            const float sv = vn * acc[j] + b_s[g * 128 + t];
            bf16* up = proj + (size_t)(row0 + t) * SGU_PITCH + g * 128 + d;
            *up = (bf16)f2bf(bf2f(*up) * sv); }
        __syncthreads();
    }
}

__device__ __forceinline__ void phase_diff(LAS unsigned char* lds, const Ctx& a, const LayerP& P, int vcu, int G) {
    const int tid = otid(), lane = tid & 63, wave = tid >> 6;
    bf16* proj = (bf16*)(a.ws + WS_H);
    LAS float* Ks = (LAS float*)lds;
    LAS float* Vs = Ks + 64 * 132;
    LAS float* Qs = Vs + 64 * 128;
    LAS float* Ps = Qs + 32 * 128;
    float lam;
    { float s1 = 0.f, s2 = 0.f;
      for (int i = 0; i < 64; ++i) { s1 += P.e0[i] * P.e1[i]; s2 += P.e2[i] * P.e3[i]; }
      lam = __expf(s1) - __expf(s2) + LAMBDA_INIT; }
    const float* head_norm = P.e4;
    const int NU = NB * DIFF_H * (T / 32);
    for (int u = vcu; u < NU; u += G) {
        const int qb = (T / 32 - 1) - (u / (NB * DIFF_H)), bh = u % (NB * DIFF_H), h = bh % DIFF_H, b = bh / DIFF_H;
        const int q0 = qb * 32; const size_t rowbase = (size_t)b * T;
        const float slope2 = exp2f(-(float)(h + 1)) * LOG2E;
        __syncthreads();
        for (int e = tid; e < 32 * 64; e += NTHR) { const int r = e >> 6, c2 = e & 63;
            const unsigned w = *(const unsigned*)(proj + (rowbase + q0 + r) * DIFF_PITCH + h * 128 + 2 * c2);
            Qs[r * 128 + 2 * c2] = bflo(w); Qs[r * 128 + 2 * c2 + 1] = bfhi(w); }
        float m1[4], l1[4], m2[4], l2[4], oa1[4], ob1[4], oa2[4], ob2[4];
#pragma unroll
        for (int i = 0; i < 4; ++i) { m1[i] = -1e30f; m2[i] = -1e30f; l1[i] = 0.f; l2[i] = 0.f; oa1[i] = 0.f; ob1[i] = 0.f; oa2[i] = 0.f; ob2[i] = 0.f; }
        const int ntile = (q0 + 31) / 64 + 1;
        for (int kt = 0; kt < ntile; ++kt) {
            __syncthreads();
            for (int e = tid; e < 64 * 64; e += NTHR) { const int r = e >> 6, c2 = e & 63;
                const unsigned wk = *(const unsigned*)(proj + (rowbase + kt * 64 + r) * DIFF_PITCH + 1024 + h * 128 + 2 * c2);
                const unsigned wv = *(const unsigned*)(proj + (rowbase + kt * 64 + r) * DIFF_PITCH + 2048 + h * 128 + 2 * c2);
                Ks[r * 132 + 2 * c2] = bflo(wk); Ks[r * 132 + 2 * c2 + 1] = bfhi(wk);
                Vs[r * 128 + 2 * c2] = bflo(wv); Vs[r * 128 + 2 * c2 + 1] = bfhi(wv); }
            __syncthreads();
            const int kpos = kt * 64 + lane;
#pragma unroll
            for (int i = 0; i < 4; ++i) {
                const int r = wave + 8 * i, qpos = q0 + r;
                if (kt * 64 > qpos) continue;
                float s1 = 0.f, s2 = 0.f;
                const LAS f32x4* qp = (const LAS f32x4*)(Qs + r * 128); const LAS f32x4* kp = (const LAS f32x4*)(Ks + lane * 132);
#pragma unroll
                for (int d = 0; d < 16; ++d) { const f32x4 q = qp[d], k = kp[d]; s1 += (q.x * k.x + q.y * k.y) + (q.z * k.z + q.w * k.w); }
#pragma unroll
                for (int d = 16; d < 32; ++d) { const f32x4 q = qp[d], k = kp[d]; s2 += (q.x * k.x + q.y * k.y) + (q.z * k.z + q.w * k.w); }
                const float bias = slope2 * (float)(qpos - kpos);
                const bool ok = kpos <= qpos;
                s1 = ok ? s1 - bias : -1e30f; s2 = ok ? s2 - bias : -1e30f;
                const float mn1 = fmaxf(m1[i], wave_max(s1)), mn2 = fmaxf(m2[i], wave_max(s2));
                const float p1 = ok ? exp2f(s1 - mn1) : 0.f, p2 = ok ? exp2f(s2 - mn2) : 0.f;
                const float a1 = exp2f(m1[i] - mn1), a2 = exp2f(m2[i] - mn2);
                l1[i] = l1[i] * a1 + wave_sum(p1); l2[i] = l2[i] * a2 + wave_sum(p2); m1[i] = mn1; m2[i] = mn2;
                Ps[wave * 128 + lane] = p1; Ps[wave * 128 + 64 + lane] = p2;
                LDS_WAIT();
                float x1 = 0.f, y1 = 0.f, x2 = 0.f, y2 = 0.f;
                for (int j = 0; j < 64; ++j) { const float pa = Ps[wave * 128 + j], pb = Ps[wave * 128 + 64 + j]; const float va = Vs[j * 128 + lane], vb = Vs[j * 128 + 64 + lane];
                    x1 += pa * va; y1 += pa * vb; x2 += pb * va; y2 += pb * vb; }
                oa1[i] = oa1[i] * a1 + x1; ob1[i] = ob1[i] * a1 + y1; oa2[i] = oa2[i] * a2 + x2; ob2[i] = ob2[i] * a2 + y2;
                LDS_WAIT();
            }
        }
#pragma unroll
        for (int i = 0; i < 4; ++i) {
            const int r = wave + 8 * i;
            const float oa = oa1[i] / l1[i] - lam * (oa2[i] / l2[i]), ob = ob1[i] / l1[i] - lam * (ob2[i] / l2[i]);
            const float ss = wave_sum(oa * oa + ob * ob);
            const float rs = (1.0f / sqrtf(ss * (1.0f / 128.0f) + EPS)) * (1.0f - LAMBDA_INIT);
            bf16* op = proj + (rowbase + q0 + r) * DIFF_PITCH + h * 128;
            op[lane] = (bf16)f2bf(oa * rs * head_norm[lane]); op[64 + lane] = (bf16)f2bf(ob * rs * head_norm[64 + lane]);
        }
    }
}

namespace pg8 {
#define PG8_LAS __attribute__((address_space(3)))
typedef unsigned short bf16_t;
typedef short bf16x8 __attribute__((ext_vector_type(8)));
typedef float f32x4 __attribute__((ext_vector_type(4)));
typedef unsigned u32x4 __attribute__((ext_vector_type(4)));
constexpr int BM = 256, BK = 64, HALF = 128, HTB = HALF * BK * 2  , STAGE_BYTES = 8 * HTB, NXCD = 8, WGM = 8;

__host__ __device__ __forceinline__ int lds_byte(int r, int c) { const int st = (r >> 4) * 2 + (c >> 5), rr = r & 15, cc = c & 31, ob = rr * 64 + cc * 2; return st * 1024 + (ob ^ (((ob >> 9) & 1) << 5)); }
__host__ __device__ __forceinline__ void stage_rc(int b, int& R, int& C) { const int st = b / 1024, sb = b % 1024, swz = sb ^ (((sb >> 9) & 1) << 5); R = (st >> 1) * 16 + swz / 64; C = (st & 1) * 32 + (swz % 64) / 2; }
__host__ __device__ __forceinline__ int perm32(int rho) { const int n = rho >> 4, i = rho & 15; return 8 * (i >> 2) + 4 * n + (i & 3); }

struct Unit { int pm, pn; };
struct Gemm { const bf16_t* A; int lda; const bf16_t* Bt; int M, N, K; };

struct StaticOrder {
    int nM, nN, nwg, G, c;
    __host__ __device__ void init(int M, int N, int G_, int c_) { nM = M / BM; nN = N / BM; nwg = nM * nN; G = G_; c = c_; }
    __host__ __device__ bool next(int i, Unit& u) const {
        const long L = (long)i * G + c; if (L >= nwg) return false;
        int wgid = (int)L; { const int q = nwg / NXCD, r = nwg % NXCD, xcd = wgid % NXCD, off = wgid / NXCD; wgid = (xcd < r ? xcd * (q + 1) : r * (q + 1) + (xcd - r) * q) + off; }
        const int nig = WGM * nN, gid = wgid / nig, fm = gid * WGM, gsz = (nM - fm) < WGM ? (nM - fm) : WGM;
        u.pm = fm + ((wgid % nig) % gsz); u.pn = (wgid % nig) / gsz; return true;
    }
    __device__ __forceinline__ void a_ready(const Unit&) const {}
    __device__ __forceinline__ void done(const Unit&) const {}
};

template <class Epi, class Sched, bool ALIGN_EPI = false, bool SP2 = false>
__device__ __forceinline__ void gemm_phase(PG8_LAS unsigned char* lds, const Gemm g, const Sched& S, const Epi& E) {
    const int tid = otid(), wid = __builtin_amdgcn_readfirstlane(tid >> 6), lane = tid & 63, wr = wid >> 2, wc = wid & 3, fr = lane & 15, fq = lane >> 4;
    const int K = g.K, nt = K / BK, lda = g.lda;
    unsigned voffA[2], voffB[2];
#pragma unroll
    for (int i = 0; i < 2; ++i) { int R, C; stage_rc(tid * 16 + i * 8192, R, C); const int Rb = Epi::PERM ? ((R & ~31) + perm32(R & 31)) : R;
        voffA[i] = (unsigned)(R * lda + C) * 2u; voffB[i] = (unsigned)(Rb * K + C) * 2u; }
    const size_t kstep = (size_t)(BK * 2);
    const size_t hstepA = (size_t)HALF * lda * 2, hstepB = (size_t)HALF * K * 2;
    const size_t tstepA = 2 * hstepA, tstepB = 2 * hstepB;
    const unsigned ldsw = (unsigned)wid * 1024u;
    const int aoff = lds_byte(wr * 64 + fr, fq * 8), boff = lds_byte(wc * 32 + fr, fq * 8);
#define PG8_SA(b, h) (((b) * 2 + (h)) * HTB)
#define PG8_SB(b, h) ((4 + (b) * 2 + (h)) * HTB)
#define PG8_STAGE(bufoff, gbase, voff) do { _Pragma("unroll") for (int _i = 0; _i < 2; ++_i) \
        __builtin_amdgcn_global_load_lds((const unsigned*)((const char*)(gbase) + (voff)[_i]), (PG8_LAS unsigned*)(lds + (bufoff) + ldsw + _i * 8192), 16, 0, 0); } while (0)
#define PG8_LDA(dst, b, h) do { _Pragma("unroll") for (int m = 0; m < 4; ++m) _Pragma("unroll") for (int k = 0; k < 2; ++k) dst[m][k] = *(const PG8_LAS bf16x8*)(lds + PG8_SA(b, h) + aoff + m * 2048 + k * 1024); } while (0)
#define PG8_LDB(dst, b, h) do { _Pragma("unroll") for (int n = 0; n < 2; ++n) _Pragma("unroll") for (int k = 0; k < 2; ++k) dst[n][k] = *(const PG8_LAS bf16x8*)(lds + PG8_SB(b, h) + boff + n * 2048 + k * 1024); } while (0)
#define PG8_MMA(ai, bj, At, Bt) do { __builtin_amdgcn_s_setprio(1); _Pragma("unroll") for (int m = 0; m < 4; ++m) _Pragma("unroll") for (int n = 0; n < 2; ++n) _Pragma("unroll") for (int k = 0; k < 2; ++k) \
        acc[ai][bj][m][n] = __builtin_amdgcn_mfma_f32_16x16x32_bf16(Bt[n][k], At[m][k], acc[ai][bj][m][n], 0, 0, 0); __builtin_amdgcn_s_setprio(0); } while (0)
#define PG8_WAIT_V(n) asm volatile("s_waitcnt vmcnt(" #n ")" ::: "memory")
#define PG8_WAIT_L(n) asm volatile("s_waitcnt lgkmcnt(" #n ")" ::: "memory")
#define PG8_BAR __builtin_amdgcn_s_barrier()
#define PG8_SCHED __builtin_amdgcn_sched_barrier(0)
    Unit cur, nxt; int ui = 0;
    if (!S.next(0, cur)) return;
    f32x4 acc[2][2][4][2];
#pragma unroll
    for (int a = 0; a < 2; ++a)
#pragma unroll
        for (int b = 0; b < 2; ++b)
#pragma unroll
            for (int m = 0; m < 4; ++m)
#pragma unroll
                for (int n = 0; n < 2; ++n) acc[a][b][m][n] = (f32x4){0.f, 0.f, 0.f, 0.f};
    bf16x8 At[4][2], B0[2][2], B1[2][2];
    const char* cA = (const char*)g.A + (size_t)cur.pm * tstepA; const char* cB = (const char*)g.Bt + (size_t)cur.pn * tstepB;
    S.a_ready(cur);
    if constexpr (SP2) {
        PG8_STAGE(PG8_SB(0, 0), cB, voffB); PG8_STAGE(PG8_SB(0, 1), cB + hstepB, voffB); PG8_STAGE(PG8_SA(0, 0), cA, voffA); PG8_STAGE(PG8_SA(0, 1), cA + hstepA, voffA);
        if (wr == 1) PG8_BAR;
        PG8_WAIT_V(2); PG8_BAR;
        PG8_STAGE(PG8_SB(1, 0), cB + kstep, voffB); PG8_STAGE(PG8_SA(1, 0), cA + kstep, voffA); PG8_STAGE(PG8_SB(1, 1), cB + hstepB + kstep, voffB);
        PG8_WAIT_V(6); PG8_BAR;
    } else {
        PG8_STAGE(PG8_SB(0, 0), cB, voffB); PG8_STAGE(PG8_SA(0, 0), cA, voffA); PG8_STAGE(PG8_SB(0, 1), cB + hstepB, voffB); PG8_STAGE(PG8_SA(0, 1), cA + hstepA, voffA);
        if (wr == 1) PG8_BAR;
        PG8_WAIT_V(4); PG8_BAR;
        PG8_STAGE(PG8_SB(1, 0), cB + kstep, voffB); PG8_STAGE(PG8_SA(1, 0), cA + kstep, voffA); PG8_STAGE(PG8_SB(1, 1), cB + hstepB + kstep, voffB);
        PG8_WAIT_V(6); PG8_BAR;
    }
    for (;;) {
        const bool has_next = S.next(ui + 1, nxt);
        const char* nA = has_next ? (const char*)g.A + (size_t)nxt.pm * tstepA : cA; const char* nB = has_next ? (const char*)g.Bt + (size_t)nxt.pn * tstepB : cB;
        for (int t = 0; t < nt; t += 2) {
            const bool last = (t == nt - 2);
            const char* a1 = cA + (size_t)(t + 1) * kstep;
            const char* a2 = last ? nA : cA + (size_t)(t + 2) * kstep; const char* b2 = last ? nB : cB + (size_t)(t + 2) * kstep;
            const char* a3 = a2 + kstep; const char* b3 = b2 + kstep;
            if (last && has_next) S.a_ready(nxt);
            if constexpr (SP2) {
            PG8_LDB(B0, 0, 0); PG8_LDB(B1, 0, 1); PG8_SCHED; PG8_LDA(At, 0, 0); PG8_STAGE(PG8_SA(1, 1), a1 + hstepA, voffA);
            PG8_WAIT_V(8); PG8_WAIT_L(0); PG8_BAR; PG8_MMA(0, 0, At, B0); PG8_MMA(0, 1, At, B1); PG8_BAR; PG8_SCHED;
            PG8_LDA(At, 0, 1); PG8_STAGE(PG8_SB(0, 0), b2, voffB); PG8_STAGE(PG8_SB(0, 1), b2 + hstepB, voffB); PG8_STAGE(PG8_SA(0, 0), a2, voffA);
            PG8_WAIT_V(8); PG8_WAIT_L(0); PG8_BAR; PG8_MMA(1, 0, At, B0); PG8_MMA(1, 1, At, B1); PG8_BAR; PG8_SCHED;
            PG8_LDB(B0, 1, 0); PG8_LDB(B1, 1, 1); PG8_SCHED; PG8_LDA(At, 1, 0); PG8_STAGE(PG8_SA(0, 1), a2 + hstepA, voffA);
            PG8_WAIT_V(8); PG8_WAIT_L(0); PG8_BAR; PG8_MMA(0, 0, At, B0); PG8_MMA(0, 1, At, B1); PG8_BAR; PG8_SCHED;
            PG8_LDA(At, 1, 1); PG8_STAGE(PG8_SB(1, 0), b3, voffB); PG8_STAGE(PG8_SB(1, 1), b3 + hstepB, voffB); PG8_STAGE(PG8_SA(1, 0), a3, voffA);
            PG8_WAIT_V(8); PG8_WAIT_L(0); PG8_BAR; PG8_MMA(1, 0, At, B0); PG8_MMA(1, 1, At, B1); PG8_BAR; PG8_SCHED;
            } else {
            PG8_LDB(B0, 0, 0); PG8_SCHED; PG8_LDA(At, 0, 0); PG8_STAGE(PG8_SA(1, 1), a1 + hstepA, voffA);
            PG8_WAIT_L(8); PG8_BAR; PG8_WAIT_L(0); PG8_MMA(0, 0, At, B0); PG8_BAR; PG8_SCHED;
            PG8_LDB(B1, 0, 1); PG8_STAGE(PG8_SB(0, 0), b2, voffB);
            PG8_BAR; PG8_WAIT_L(0); PG8_MMA(0, 1, At, B1); PG8_BAR;
            PG8_LDA(At, 0, 1); PG8_STAGE(PG8_SA(0, 0), a2, voffA);
            PG8_BAR; PG8_WAIT_L(0); PG8_MMA(1, 0, At, B0); PG8_BAR; PG8_SCHED;
            PG8_STAGE(PG8_SB(0, 1), b2 + hstepB, voffB);
            PG8_WAIT_V(6); PG8_BAR; PG8_MMA(1, 1, At, B1); PG8_BAR;
            PG8_LDB(B0, 1, 0); PG8_SCHED; PG8_LDA(At, 1, 0); PG8_STAGE(PG8_SA(0, 1), a2 + hstepA, voffA);
            PG8_WAIT_L(8); PG8_BAR; PG8_WAIT_L(0); PG8_MMA(0, 0, At, B0); PG8_BAR; PG8_SCHED;
            PG8_LDB(B1, 1, 1); PG8_STAGE(PG8_SB(1, 0), b3, voffB);
            PG8_BAR; PG8_WAIT_L(0); PG8_MMA(0, 1, At, B1); PG8_BAR;
            PG8_LDA(At, 1, 1); PG8_STAGE(PG8_SA(1, 0), a3, voffA);
            PG8_BAR; PG8_WAIT_L(0); PG8_MMA(1, 0, At, B0); PG8_BAR; PG8_SCHED;
            PG8_STAGE(PG8_SB(1, 1), b3 + hstepB, voffB);
            PG8_WAIT_V(6); PG8_BAR; PG8_MMA(1, 1, At, B1); PG8_BAR;
            }
        }
        if constexpr (ALIGN_EPI) { if (wr == 0) PG8_BAR; }
        if constexpr (!Epi::AFTER_DRAIN) { E(acc, cur, wr, wc, fr, fq); S.done(cur); }
        if (!has_next) break;
#pragma unroll
        for (int a = 0; a < 2; ++a)
#pragma unroll
            for (int b = 0; b < 2; ++b)
#pragma unroll
                for (int m = 0; m < 4; ++m)
#pragma unroll
                    for (int n = 0; n < 2; ++n) acc[a][b][m][n] = (f32x4){0.f, 0.f, 0.f, 0.f};
        cur = nxt; cA = nA; cB = nB; ++ui;
        if constexpr (ALIGN_EPI) { if (wr == 1) PG8_BAR; }
    }
    PG8_WAIT_V(0);
    if constexpr (!ALIGN_EPI) { if (wr == 0) PG8_BAR; }
    PG8_BAR;
    if constexpr (Epi::AFTER_DRAIN) { E.fused(acc, cur, wr, wc, fr, fq, lds, wid, lane); S.done(cur); }
#undef PG8_SA
#undef PG8_SB
#undef PG8_STAGE
#undef PG8_LDA
#undef PG8_LDB
#undef PG8_MMA
#undef PG8_WAIT_V
#undef PG8_WAIT_L
#undef PG8_BAR
#undef PG8_SCHED
}
}

template <class Core> struct EpiMfma {
    static constexpr bool PERM = true, AFTER_DRAIN = false;
    Core c;
    __device__ __forceinline__ void operator()(const pg8::f32x4 (&acc)[2][2][4][2], const pg8::Unit& u, int wr, int wc, int fr, int fq) const {
        float gmax[2] = {0.f, 0.f};
#pragma unroll
        for (int ai = 0; ai < 2; ++ai)
#pragma unroll
            for (int m = 0; m < 4; ++m) {
                const int row = u.pm * 256 + ai * 128 + wr * 64 + m * 16 + fr;
                const float rs = c.rowscale(row);
                float part = 0.f;
#pragma unroll
                for (int bj = 0; bj < 2; ++bj) {
                    const int col0 = u.pn * 256 + bj * 128 + wc * 32 + 8 * fq;
                    const float v[8] = {acc[ai][bj][m][0][0], acc[ai][bj][m][0][1], acc[ai][bj][m][0][2], acc[ai][bj][m][0][3],
                                        acc[ai][bj][m][1][0], acc[ai][bj][m][1][1], acc[ai][bj][m][1][2], acc[ai][bj][m][1][3]};
                    const float p = c.apply8(row, col0, v, rs);
                    part += p;
                    if (Core::GROUPMAX) { float q = p; q += __shfl_xor(q, 16); q += __shfl_xor(q, 32); gmax[bj] = fmaxf(gmax[bj], q); }
                }
                part += __shfl_xor(part, 16); part += __shfl_xor(part, 32);
                if (fq == 0) c.store_part(row, u.pn * 256, (u.pn & 3) * 4 + wc, part);
            }
        if (Core::GROUPMAX) {
#pragma unroll
            for (int bj = 0; bj < 2; ++bj) { const int colg = u.pn * 256 + bj * 128 + wc * 32;
                if (c.want_groupmax(colg)) { const float m = wave_max(gmax[bj]); if (fr == 0 && fq == 0) c.store_groupmax(u.pm * 256, colg, m); } }
        }
    }
};
#ifndef USE_MFMA_GEMM
#define USE_MFMA_GEMM 1
#endif
template <class Core>
__device__ __forceinline__ void run_gemm(LAS unsigned char* lds, const bf16* A, int lda, const bf16* Bt, int M, int N, int K, const Core& c, int vcu, int G) {
#if USE_MFMA_GEMM
    pg8::Gemm g{A, lda, Bt, M, N, K}; pg8::StaticOrder S; S.init(M, N, G, (int)blockIdx.x);
    EpiMfma<Core> E{c};
    pg8::gemm_phase<EpiMfma<Core>, pg8::StaticOrder, true, true>(lds, g, S, E);
#else
    gemm_naive(lds, A, lda, Bt, M, N, K, c, vcu, G);
#endif
}

#include <hip/hip_bf16.h>
#include <cmath>
namespace attn_body {
using bf16=__hip_bfloat16;
using bf16x8=__attribute__((ext_vector_type(8)))short;
using s16x4=__attribute__((ext_vector_type(4)))short;
using f32x16=__attribute__((ext_vector_type(16)))float;
using u32x4=__attribute__((ext_vector_type(4)))unsigned;
constexpr int SEQ=8192,D=64,PQ=3072,PO=2048;
constexpr int NW=8,QBLK=32,QB=QBLK*NW,KVBLK=64,NQB=SEQ/QB;
__device__ __forceinline__ int crow(int r,int hi){return (r&3)+8*(r>>2)+4*hi;}
#define SBAR() __builtin_amdgcn_sched_barrier(0)
__device__ __forceinline__ void cmask(f32x16&p0,f32x16&p1,int jb,int qrel,int hi){
  const float NEG=-INFINITY; int kb=64*jb+4*hi;
  #pragma unroll
  for(int r=0;r<16;++r){int kv=kb+(r&3)+8*(r>>2); if(kv>qrel)p0[r]=NEG; if(kv+32>qrel)p1[r]=NEG;}
}

constexpr int NSLOT=3, SLOTB=8192;
constexpr int LDS_K=0, LDS_V=NSLOT*SLOTB, LDS_WS=2*NSLOT*SLOTB, LDS_OST=LDS_WS+NW*64*4, LDS_BYTES=LDS_OST+NW*4096;
constexpr float C2=0.125f*1.4426950408889634f;
__device__ __forceinline__ void glds16(const void*gsrc,unsigned lds_dst){unsigned keep;
  asm volatile("s_mov_b32 %0, m0\n\ts_mov_b32 m0, %2\n\ts_nop 0\n\tglobal_load_lds_dwordx4 %1, off\n\ts_mov_b32 m0, %0":"=&s"(keep):"v"(gsrc),"s"(lds_dst):"memory");}
__device__ __forceinline__ float max3f(float a,float b,float c){float r;asm("v_max3_f32 %0, %1, %2, %3":"=v"(r):"v"(a),"v"(b),"v"(c));return r;}
__device__ __forceinline__ float max2f(float a,float b){float r;asm("v_max_f32_e32 %0, %1, %2":"=v"(r):"v"(a),"v"(b));return r;}
__device__ __forceinline__ float fadd_s(float a,float b){float r;asm("v_add_f32_e32 %0, %1, %2":"=v"(r):"v"(a),"v"(b));return r;}
__device__ __forceinline__ float fsub_s(float a,float b){float r;asm("v_sub_f32_e32 %0, %1, %2":"=v"(r):"v"(a),"v"(b));return r;}
typedef float f32x2_t __attribute__((ext_vector_type(2))); typedef __bf16 bf16x2_t __attribute__((ext_vector_type(2)));
__device__ __forceinline__ unsigned cvtpk_s(float lo,float hi){f32x2_t v={lo,hi};bf16x2_t b=__builtin_convertvector(v,bf16x2_t);return __builtin_bit_cast(unsigned,b);}
#define WAIT_BAR(N) asm volatile("s_waitcnt vmcnt(" #N ") lgkmcnt(0)\n\ts_barrier":::"memory")

__device__ __forceinline__ void qkt(f32x16&p0,f32x16&p1,const char*Kslot,const bf16x8*qr,const f32x16&negm,int r32,int hi){
  const char*kb=Kslot+hi*1024+r32*16;
  #pragma unroll
  for(int d0=0;d0<4;++d0){
    const bf16x8 b0=*reinterpret_cast<const bf16x8*>(kb+d0*2048);
    const bf16x8 b1=*reinterpret_cast<const bf16x8*>(kb+d0*2048+512);
    if(d0==0){p0=__builtin_amdgcn_mfma_f32_32x32x16_bf16(b0,qr[0],negm,0,0,0);p1=__builtin_amdgcn_mfma_f32_32x32x16_bf16(b1,qr[0],negm,0,0,0);}
    else{p0=__builtin_amdgcn_mfma_f32_32x32x16_bf16(b0,qr[d0],p0,0,0,0);p1=__builtin_amdgcn_mfma_f32_32x32x16_bf16(b1,qr[d0],p1,0,0,0);}}
}
typedef __attribute__((address_space(3))) const char* lds_cptr;
typedef short v4i16_t __attribute__((ext_vector_type(4)));
__device__ __forceinline__ void kload8(bf16x8*kf,lds_cptr kp){
  kf[0]=*(const __attribute__((address_space(3))) bf16x8*)(kp);      kf[1]=*(const __attribute__((address_space(3))) bf16x8*)(kp+512);
  kf[2]=*(const __attribute__((address_space(3))) bf16x8*)(kp+2048); kf[3]=*(const __attribute__((address_space(3))) bf16x8*)(kp+2560);
  kf[4]=*(const __attribute__((address_space(3))) bf16x8*)(kp+4096); kf[5]=*(const __attribute__((address_space(3))) bf16x8*)(kp+4608);
  kf[6]=*(const __attribute__((address_space(3))) bf16x8*)(kp+6144); kf[7]=*(const __attribute__((address_space(3))) bf16x8*)(kp+6656);
}
__device__ __forceinline__ void kload2(bf16x8*kf,lds_cptr kp,int j){ kf[2*j]=*(const __attribute__((address_space(3))) bf16x8*)(kp+j*2048); kf[2*j+1]=*(const __attribute__((address_space(3))) bf16x8*)(kp+j*2048+512); }
__device__ __forceinline__ s16x4 vtr(lds_cptr p){ return __builtin_bit_cast(s16x4,__builtin_amdgcn_ds_read_tr16_b64_v4i16((__attribute__((address_space(3))) v4i16_t*)p)); }
__device__ __forceinline__ float rowmax(const f32x16&p0,const f32x16&p1){
  float a=max3f(p0[0],p0[1],p1[0]),b=max3f(p0[2],p0[3],p1[1]);a=max3f(a,p1[2],p1[3]);
  #pragma unroll
  for(int r=4;r<16;r+=4){a=max3f(a,p0[r],p0[r+1]);b=max3f(b,p0[r+2],p0[r+3]);a=max3f(a,p1[r],p1[r+1]);b=max3f(b,p1[r+2],p1[r+3]);}
  const float m=max2f(a,b);
  auto rr=__builtin_amdgcn_permlane32_swap(__float_as_uint(m),__float_as_uint(m),false,false);
  return max2f(__uint_as_float(rr[0]),__uint_as_float(rr[1]));
}
__device__ __forceinline__ void pv(f32x16*o,int vb,bf16x8 pa0,bf16x8 pa1,bf16x8 pa2,bf16x8 pa3){
  #pragma unroll
  for(int d0=0;d0<2;++d0){s16x4 lo[4],hi[4];
    #pragma unroll
    for(int ks=0;ks<4;++ks){
      asm volatile("ds_read_b64_tr_b16 %0,%1 offset:%c2":"=&v"(lo[ks]):"v"(vb),"i"(d0*4096+ks*1024):"memory");
      asm volatile("ds_read_b64_tr_b16 %0,%1 offset:%c2":"=&v"(hi[ks]):"v"(vb),"i"(d0*4096+ks*1024+512):"memory");}
    asm volatile("s_waitcnt lgkmcnt(0)":::"memory");SBAR();
    #define PK(k) (bf16x8){lo[k][0],lo[k][1],lo[k][2],lo[k][3],hi[k][0],hi[k][1],hi[k][2],hi[k][3]}
    o[d0]=__builtin_amdgcn_mfma_f32_32x32x16_bf16(pa0,PK(0),o[d0],0,0,0);
    o[d0]=__builtin_amdgcn_mfma_f32_32x32x16_bf16(pa1,PK(1),o[d0],0,0,0);
    o[d0]=__builtin_amdgcn_mfma_f32_32x32x16_bf16(pa2,PK(2),o[d0],0,0,0);
    o[d0]=__builtin_amdgcn_mfma_f32_32x32x16_bf16(pa3,PK(3),o[d0],0,0,0);
    #undef PK
  }
}

#ifndef ATTN_STORE16
#define ATTN_STORE16(p,v) (*(u32x4*)(p)=(v))
#endif
template<int THRL> __device__ __forceinline__ void attn_unit(int b,int qb,int t0,const bf16*Q,const bf16*K,const bf16*V,bf16*O,float slope2,char*shm){
  const int tid=otid(),lane=tid&63,r32=lane&31,hi=lane>>5; const int wid=__builtin_amdgcn_readfirstlane(tid>>6);
  const long rowbase=(long)b*SEQ; const int q0=qb*QB;
  const bf16*Qw=Q+(rowbase+q0+wid*QBLK)*PQ;
  const bf16*Kh=K+(rowbase+(long)t0*KVBLK)*PQ,*Vh=V+(rowbase+(long)t0*KVBLK)*PQ;
  const unsigned lds0=(unsigned)(uintptr_t)shm;
  float*wsf=(float*)(shm+LDS_WS)+wid*64;
  const bf16*ksrc=Kh+(long)lane*PQ+wid*8;
  const bf16*vsrc=Vh+(long)(16*(wid&3)+(lane>>2))*PQ+(wid>>2)*32+(lane&3)*8;
  const unsigned kdst=lds0+LDS_K+wid*1024, vdst=lds0+LDS_V+wid*1024;
  #define DMA_K(t,slot) glds16(ksrc+(long)(t)*KVBLK*PQ,(unsigned)__builtin_amdgcn_readfirstlane(kdst+(slot)))
  #define DMA_V(t,slot) glds16(vsrc+(long)(t)*KVBLK*PQ,(unsigned)__builtin_amdgcn_readfirstlane(vdst+(slot)))
  const int vb0=(int)(lds0+LDS_V)+((lane>>4)&1)*32+(lane&3)*8+(4*hi+((lane&15)>>2))*64;
  const char*Kbase=shm+LDS_K; bf16x8 kf[8];
  const lds_cptr shm3=(lds_cptr)shm; const lds_cptr kp0=shm3+LDS_K+hi*1024+r32*16; const lds_cptr vp0=shm3+LDS_V+((lane>>4)&1)*32+(lane&3)*8+(4*hi+((lane&15)>>2))*64;
  const int NT=(q0+QB)/KVBLK-t0;
  DMA_K(0,0);DMA_V(0,0);DMA_K(1,SLOTB);
  bf16x8 qr[4];
  #pragma unroll
  for(int d0=0;d0<4;++d0)qr[d0]=*reinterpret_cast<const bf16x8*>(&Qw[(long)r32*PQ+d0*16+hi*8]);
  float l_reg=0.f;f32x16 o[2];o[0]=f32x16{};o[1]=f32x16{};f32x16 negm;
  _Pragma("unroll") for(int r=0;r<16;++r)negm[r]=slope2*(float)crow(r,hi);
  asm volatile("":"+v"(negm)); const float b32=32.f*slope2, step64=64.f*slope2;
  const int qrel=wid*QBLK+r32;
  #define CMASK(P0,P1,t) do{int jb_=(t)-(NT-4); if(jb_>=0)cmask(P0,P1,jb_,qrel,hi);}while(0)
  bool resc=false;
  #define START(P0,P1) do{ const float rm=rowmax(P0,P1); resc=false; \
    { const float dl=rm; \
      _Pragma("unroll") for(int r=0;r<16;++r){P0[r]=fsub_s(P0[r],dl);P1[r]=fsub_s(P1[r],dl);} \
      const float adj_=step64-dl; _Pragma("unroll") for(int r=0;r<16;++r)negm[r]+=adj_; asm volatile("":"+v"(negm)); } \
    _Pragma("unroll") for(int r=0;r<16;++r)P0[r]=__builtin_amdgcn_exp2f(P0[r]); }while(0)
  #define RESC() do{ if(resc){ asm volatile("s_waitcnt lgkmcnt(0)":::"memory"); \
      _Pragma("unroll") for(int d_=0;d_<2;++d_) _Pragma("unroll") for(int r=0;r<16;++r)o[d_][r]*=wsf[crow(r,hi)]; } }while(0)
  f32x16 pA0,pA1,pB0,pB1;
  int sl_prev=0,sl_cur=0,sl_next=SLOTB;
  #define ROT() do{sl_prev=sl_cur;sl_cur=sl_next;sl_next=(sl_next==(NSLOT-1)*SLOTB)?0:sl_next+SLOTB;}while(0)
  DMA_K(2,2*SLOTB);
  WAIT_BAR(3);
  qkt(pA0,pA1,Kbase,qr,negm,r32,hi);asm volatile("s_nop 15\n\ts_nop 7":"+v"(pA0),"+v"(pA1));
  _Pragma("unroll") for(int r=0;r<16;++r)pA1[r]+=b32;
  CMASK(pA0,pA1,0);
  START(pA0,pA1);
  _Pragma("unroll") for(int r=0;r<16;++r)pA1[r]=__builtin_amdgcn_exp2f(pA1[r]);
  WAIT_BAR(0);
  DMA_K(3,0);DMA_V(1,SLOTB);
  ROT();
  kload8(kf,kp0+sl_cur);
  WAIT_BAR(2);
  s16x4 vlo[8],vhi[8]; u32x4 pw0,pw1,pw2,pw3;
  #define PKW(P,B) cvtpk_s(P[B],P[B+1])
  #define PAF(k) __builtin_bit_cast(bf16x8,pw##k)
  #define VFR(i) (bf16x8){vlo[i][0],vlo[i][1],vlo[i][2],vlo[i][3],vhi[i][0],vhi[i][1],vhi[i][2],vhi[i][3]}
  #define PIN(x) asm volatile("":"+v"(x))
  #define MX3(a,b,c) __builtin_fmaxf(__builtin_fmaxf((a),(b)),(c))
  #define GAPA(MF,A0,A1,A2,A3,W0,W1,PW) do{ MF; sacc+=A0; sacc+=A1; sacc+=A2; sacc+=A3; PIN(sacc); W0; W1; PIN(PW); SBAR(); }while(0)
  #define EX(v) __builtin_amdgcn_exp2f(v)
  #define GAPB(MF,X,B) do{ MF; X[B]=EX(X[B]); X[B+1]=EX(X[B+1]); X[B+2]=EX(X[B+2]); X[B+3]=EX(X[B+3]); PIN(X); SBAR(); }while(0)
  #define VRD(i) do{ vlo[i]=vtr(vp_+(((i)>>2)*4096+((i)&3)*1024)); vhi[i]=vtr(vp_+(((i)>>2)*4096+((i)&3)*1024+512)); }while(0)
  #define KRD(G,j) do{ if(G){ kload2(kf,kp0+sl_next,j); SBAR(); } }while(0)
  #define STEP(C0,C1,P0,P1,t,GK,GV,GL) do{ SBAR(); \
    const lds_cptr vp_=vp0+sl_prev; \
    VRD(0); SBAR(); float sacc=(P0[0]+P0[1]); \
    GAPA(C0=__builtin_amdgcn_mfma_f32_32x32x16_bf16(kf[0],qr[0],negm,0,0,0), P0[2],P0[3],P0[4],P0[5],     pw0[0]=PKW(P0,0), pw0[1]=PKW(P0,2), pw0); \
    VRD(4); SBAR(); GAPA(C1=__builtin_amdgcn_mfma_f32_32x32x16_bf16(kf[1],qr[0],negm,0,0,0), P0[6],P0[7],P0[8],P0[9],     pw0[2]=PKW(P0,4), pw0[3]=PKW(P0,6), pw0); \
    VRD(1); SBAR(); GAPA(C0=__builtin_amdgcn_mfma_f32_32x32x16_bf16(kf[2],qr[1],C0,0,0,0),   P0[10],P0[11],P0[12],P0[13], pw1[0]=PKW(P0,8), pw1[1]=PKW(P0,10), pw1); \
    VRD(5); SBAR(); GAPA(C1=__builtin_amdgcn_mfma_f32_32x32x16_bf16(kf[3],qr[1],C1,0,0,0),   P0[14],P0[15],P1[0],P1[1],   pw1[2]=PKW(P0,12),pw1[3]=PKW(P0,14), pw1); \
    VRD(2); SBAR(); GAPA(C0=__builtin_amdgcn_mfma_f32_32x32x16_bf16(kf[4],qr[2],C0,0,0,0),   P1[2],P1[3],P1[4],P1[5],     pw2[0]=PKW(P1,0), pw2[1]=PKW(P1,2), pw2); \
    VRD(6); SBAR(); GAPA(C1=__builtin_amdgcn_mfma_f32_32x32x16_bf16(kf[5],qr[2],C1,0,0,0),   P1[6],P1[7],P1[8],P1[9],     pw2[2]=PKW(P1,4), pw2[3]=PKW(P1,6), pw2); \
    VRD(3); SBAR(); GAPA(C0=__builtin_amdgcn_mfma_f32_32x32x16_bf16(kf[6],qr[3],C0,0,0,0),   P1[10],P1[11],P1[12],P1[13], pw3[0]=PKW(P1,8), pw3[1]=PKW(P1,10), pw3); \
    VRD(7); SBAR(); GAPA(C1=__builtin_amdgcn_mfma_f32_32x32x16_bf16(kf[7],qr[3],C1,0,0,0),   P1[14],P1[15],0.f,0.f,       pw3[2]=PKW(P1,12),pw3[3]=PKW(P1,14), pw3); \
    l_reg+=sacc; \
    if(GK){DMA_K((t)+3,sl_cur);} if(GV){DMA_V((t)+1,sl_next);} \
    _Pragma("unroll") for(int r=0;r<16;++r)C1[r]+=b32; \
    CMASK(C0,C1,t); \
    { float a=MX3(C0[0],C0[1],C1[0]),b=MX3(C0[2],C0[3],C1[1]); a=MX3(a,C1[2],C1[3]); \
      _Pragma("unroll") for(int r=4;r<16;r+=4){a=MX3(a,C0[r],C0[r+1]);b=MX3(b,C0[r+2],C0[r+3]);a=MX3(a,C1[r],C1[r+1]);b=MX3(b,C1[r+2],C1[r+3]);} \
      float rm=__builtin_fmaxf(a,b); { auto rr=__builtin_amdgcn_permlane32_swap(__float_as_uint(rm),__float_as_uint(rm),false,false); rm=__builtin_fmaxf(__uint_as_float(rr[0]),__uint_as_float(rr[1])); } \
      resc=false; float adj_=step64; \
      if(__any(rm>(float)THRL)){ const float dl=__builtin_fmaxf(rm,0.f); adj_-=dl; \
        _Pragma("unroll") for(int r=0;r<16;++r){C0[r]-=dl;C1[r]-=dl;} \
        const float f=__builtin_amdgcn_exp2f(-dl); l_reg*=f; if(hi==0)wsf[r32]=f; resc=true; } \
      _Pragma("unroll") for(int r=0;r<16;++r)negm[r]+=adj_; asm volatile("":"+v"(negm)); } \
    SBAR(); \
    GAPB(o[0]=__builtin_amdgcn_mfma_f32_32x32x16_bf16(PAF(0),VFR(0),o[0],0,0,0), C0,0); \
    GAPB(o[1]=__builtin_amdgcn_mfma_f32_32x32x16_bf16(PAF(0),VFR(4),o[1],0,0,0), C0,4); \
    KRD(GL,0); GAPB(o[0]=__builtin_amdgcn_mfma_f32_32x32x16_bf16(PAF(1),VFR(1),o[0],0,0,0), C0,8); \
    KRD(GL,1); GAPB(o[1]=__builtin_amdgcn_mfma_f32_32x32x16_bf16(PAF(1),VFR(5),o[1],0,0,0), C0,12); \
    KRD(GL,2); GAPB(o[0]=__builtin_amdgcn_mfma_f32_32x32x16_bf16(PAF(2),VFR(2),o[0],0,0,0), C1,0); \
    KRD(GL,3); GAPB(o[1]=__builtin_amdgcn_mfma_f32_32x32x16_bf16(PAF(2),VFR(6),o[1],0,0,0), C1,4); \
    GAPB(o[0]=__builtin_amdgcn_mfma_f32_32x32x16_bf16(PAF(3),VFR(3),o[0],0,0,0), C1,8); \
    GAPB(o[1]=__builtin_amdgcn_mfma_f32_32x32x16_bf16(PAF(3),VFR(7),o[1],0,0,0), C1,12); \
    }while(0)
  int t=1;
  #undef CMASK
  #define CMASK(P0,P1,t) do{}while(0)
  for(;t+5<NT;t+=2){
    STEP(pB0,pB1,pA0,pA1,t,true,true,true);     WAIT_BAR(2); RESC(); ROT();
    STEP(pA0,pA1,pB0,pB1,t+1,true,true,true);   WAIT_BAR(2); RESC(); ROT();
  }
  #undef CMASK
  #define CMASK(P0,P1,t) do{int jb_=(t)-(NT-4); if(jb_>=0)cmask(P0,P1,jb_,qrel,hi);}while(0)
  #define ENDW(tt) do{ if((tt)+3<NT){WAIT_BAR(2);} else if((tt)+2<NT){WAIT_BAR(1);} else {WAIT_BAR(0);} }while(0)
  for(;t+1<NT;t+=2){
    STEP(pB0,pB1,pA0,pA1,t,(t+3<NT),(t+1<NT),(t+1<NT));       ENDW(t);   RESC(); ROT();
    STEP(pA0,pA1,pB0,pB1,t+1,(t+4<NT),(t+2<NT),(t+2<NT));     ENDW(t+1); RESC(); ROT();
  }
  STEP(pB0,pB1,pA0,pA1,NT-1,false,false,false); RESC();
  { float sacc=pB0[0]+pB0[1]; _Pragma("unroll") for(int r=2;r<16;++r)sacc+=pB0[r]; _Pragma("unroll") for(int r=0;r<16;++r)sacc+=pB1[r]; l_reg+=sacc;
    pw0=(u32x4){PKW(pB0,0),PKW(pB0,2),PKW(pB0,4),PKW(pB0,6)};pw1=(u32x4){PKW(pB0,8),PKW(pB0,10),PKW(pB0,12),PKW(pB0,14)};pw2=(u32x4){PKW(pB1,0),PKW(pB1,2),PKW(pB1,4),PKW(pB1,6)};pw3=(u32x4){PKW(pB1,8),PKW(pB1,10),PKW(pB1,12),PKW(pB1,14)};
    SBAR(); pv(o,vb0+sl_cur,PAF(0),PAF(1),PAF(2),PAF(3)); }
  #undef PKW
  #undef PAF
  #undef VFR
  #undef PIN
  #undef MX3
  #undef GAPA
  #undef GAPB
  #undef EX
  #undef VRD
  #undef KRD
  #undef STEP
  #undef ENDW
  {auto rr=__builtin_amdgcn_permlane32_swap(__float_as_uint(l_reg),__float_as_uint(l_reg),false,false);l_reg=__uint_as_float(rr[0])+__uint_as_float(rr[1]);}
  if(hi==0)wsf[32+r32]=l_reg;asm volatile("s_waitcnt lgkmcnt(0)":::"memory");
  float rli[16];
  #pragma unroll
  for(int r=0;r<16;++r)rli[r]=__builtin_amdgcn_rcpf(wsf[32+crow(r,hi)]);
  bf16*Ow=O+(rowbase+q0+wid*QBLK)*PO;
  { bf16*stg=(bf16*)(shm+LDS_OST)+wid*2048;
    #pragma unroll
    for(int r=0;r<16;++r){const int orow=crow(r,hi);
      #pragma unroll
      for(int d0=0;d0<2;++d0)stg[orow*64+d0*32+r32]=__float2bfloat16(o[d0][r]*rli[r]);}
    asm volatile("s_waitcnt lgkmcnt(0)":::"memory");
    #pragma unroll
    for(int i=0;i<4;++i){const int row=i*8+(lane>>3),ch=lane&7; const u32x4 v=*(const u32x4*)(stg+row*64+ch*8); ATTN_STORE16(Ow+(long)row*PO+ch*8,v);} }
  asm volatile("s_waitcnt lgkmcnt(0)\n\ts_barrier":::"memory");
  #undef DMA_K
  #undef DMA_V
  #undef CMASK
  #undef START
  #undef RESC
  #undef ROT
}
constexpr int ATTN_LDS_BYTES=LDS_BYTES;
#undef SBAR
#undef WAIT_BAR
}

#ifndef USE_MFMA_ATTN
#define USE_MFMA_ATTN 1
#endif
__device__ __forceinline__ void phase_diff_mfma(char* shm, LAS unsigned char* lds, const Ctx& a, int vcu, int G) {
    bf16* proj = (bf16*)(a.ws + WS_H); bf16* o12 = (bf16*)(a.ws + WS_STATE);
    unsigned* ctl = (unsigned*)(a.ws + WS_CTL);
    volatile LAS unsigned* qslot = (volatile LAS unsigned*)(lds + MISC_OFF) + 16;
    for (;;) {
        const int tid = otid();
        if (tid == 0) *qslot = atomicAdd(ctl + CW_QUEUE, 1u);
        __syncthreads();
        const unsigned idx = (unsigned)__builtin_amdgcn_readfirstlane((int)*qslot);
        __syncthreads();
        if (idx >= (unsigned)(NB * DIFF_H * 2 * 32)) break;
        const int qb = 31 - (int)(idx >> 5), rem = idx & 31, b = rem >> 4, h = (rem >> 1) & 7, r = rem & 1;
        const float slope2 = exp2f(-(float)(h + 1)) * LOG2E;
        int t0 = 0;
        { const unsigned* qm = ctl + CW_QKMAX + b * 64; const int g0 = (h * 128 + r * 64) >> 5;
          const float pq = __uint_as_float(qm[g0]) + __uint_as_float(qm[g0 + 1]), pk = __uint_as_float(qm[32 + g0]) + __uint_as_float(qm[32 + g0 + 1]);
          const float smax = sqrtf(pq * pk);
          const float d = (float)(qb * 256) - (152.0f + 2.1f * smax) / slope2;
          if (d > 0.f) t0 = ((int)d >> 6) & ~1;
          if (t0 > 4 * qb) t0 = 4 * qb; }
#pragma nounroll
        for (int vh = 0; vh < 2; ++vh)
            attn_body::attn_unit<8>(b, qb, t0, (const attn_body::bf16*)(proj + h * 128 + r * 64), (const attn_body::bf16*)(proj + 1024 + h * 128 + r * 64),
                                    (const attn_body::bf16*)(proj + 2048 + h * 128 + vh * 64), (attn_body::bf16*)(o12 + r * 1024 + h * 128 + vh * 64), slope2, shm);
    }
}
__device__ __forceinline__ void phase_diff_combine(const Ctx& a, const LayerP& P, int vcu, int G) {
    const int tid = otid(), lane = tid & 63, wave = tid >> 6;
    bf16* proj = (bf16*)(a.ws + WS_H); const bf16* o12 = (const bf16*)(a.ws + WS_STATE);
    float lam;
    { float s1 = 0.f, s2 = 0.f;
      for (int i = 0; i < 64; ++i) { s1 += P.e0[i] * P.e1[i]; s2 += P.e2[i] * P.e3[i]; }
      lam = __expf(s1) - __expf(s2) + LAMBDA_INIT; }
    const int h = lane >> 3, sub = lane & 7;
    float hn[16];
#pragma unroll
    for (int j = 0; j < 16; ++j) hn[j] = P.e4[sub * 16 + j] * (1.0f - LAMBDA_INIT);
    const int gw = vcu * NWAVES + wave, NGW = G * NWAVES;
    for (int row = gw; row < NTOK; row += NGW) {
        const bf16* p1 = o12 + (size_t)row * 2048 + h * 128 + sub * 16;
        const v4u a0 = *(const v4u*)p1, a1 = *(const v4u*)(p1 + 8), b0 = *(const v4u*)(p1 + 1024), b1 = *(const v4u*)(p1 + 1032);
        const unsigned aw[8] = {a0.x, a0.y, a0.z, a0.w, a1.x, a1.y, a1.z, a1.w}, bw[8] = {b0.x, b0.y, b0.z, b0.w, b1.x, b1.y, b1.z, b1.w};
        float o[16]; float ss = 0.f;
#pragma unroll
        for (int j = 0; j < 8; ++j) { o[2 * j] = bflo(aw[j]) - lam * bflo(bw[j]); o[2 * j + 1] = bfhi(aw[j]) - lam * bfhi(bw[j]); ss += o[2 * j] * o[2 * j] + o[2 * j + 1] * o[2 * j + 1]; }
        ss += __shfl_xor(ss, 1); ss += __shfl_xor(ss, 2); ss += __shfl_xor(ss, 4);
        const float rs = 1.0f / sqrtf(ss * (1.0f / 128.0f) + EPS);
        v4u w0, w1;
        w0.x = pk2(o[0] * rs * hn[0], o[1] * rs * hn[1]); w0.y = pk2(o[2] * rs * hn[2], o[3] * rs * hn[3]); w0.z = pk2(o[4] * rs * hn[4], o[5] * rs * hn[5]); w0.w = pk2(o[6] * rs * hn[6], o[7] * rs * hn[7]);
        w1.x = pk2(o[8] * rs * hn[8], o[9] * rs * hn[9]); w1.y = pk2(o[10] * rs * hn[10], o[11] * rs * hn[11]); w1.z = pk2(o[12] * rs * hn[12], o[13] * rs * hn[13]); w1.w = pk2(o[14] * rs * hn[14], o[15] * rs * hn[15]);
        bf16* op = proj + (size_t)row * DIFF_PITCH + h * 128 + sub * 16;
        *(v4u*)op = w0; *(v4u*)(op + 8) = w1;
    }
}

typedef short mbf16x8 __attribute__((ext_vector_type(8)));
typedef short ms16x4 __attribute__((ext_vector_type(4)));
typedef float mf32x16 __attribute__((ext_vector_type(16)));
#define MFMA32(a, b, c) __builtin_amdgcn_mfma_f32_32x32x16_bf16(a, b, c, 0, 0, 0)
__device__ __forceinline__ int crow32(int r, int hi) { return (r & 3) + 8 * (r >> 2) + 4 * hi; }
__device__ __forceinline__ mbf16x8 frag_rk(const LAS unsigned char* base, int stride, int row0, int k0, int lane) {
    return *(const LAS mbf16x8*)(base + (row0 + (lane & 31)) * stride + (k0 + 8 * (lane >> 5)) * 2);
}
__device__ __forceinline__ mbf16x8 frag_kn(const LAS unsigned char* base, int stride, int k0, int n0, int lane) {
    const int i = lane & 15, g = lane >> 4;
    const LAS unsigned char* p = base + (k0 + 8 * (g >> 1) + (i >> 2)) * stride + (n0 + 16 * (g & 1) + 4 * (i & 3)) * 2;
    const ms16x4 lo = __builtin_bit_cast(ms16x4, __builtin_amdgcn_ds_read_tr16_b64_v4i16((LAS ms16x4*)p));
    const ms16x4 hi = __builtin_bit_cast(ms16x4, __builtin_amdgcn_ds_read_tr16_b64_v4i16((LAS ms16x4*)(p + 4 * stride)));
    return (mbf16x8){lo[0], lo[1], lo[2], lo[3], hi[0], hi[1], hi[2], hi[3]};
}
__device__ __forceinline__ mf32x16 zero16() { mf32x16 z;
#pragma unroll
    for (int r = 0; r < 16; ++r) z[r] = 0.f; return z; }

__device__ __forceinline__ void phase_sgu_mfma(LAS unsigned char* lds, const Ctx& a, const LayerP& P, int vcu, int G) {
    const int tid = otid(), lane = tid & 63, wave = __builtin_amdgcn_readfirstlane(tid >> 6);
    bf16* proj = (bf16*)(a.ws + WS_H); const float* vssq = (const float*)(a.ws + WS_VSSQ);
    const float* v_norm = P.e1; const float* w_s = P.e2; const float* b_s = P.e3;
    constexpr int SA = 272, SV = 320, SO = 132;
    LAS unsigned char* WA = lds;
    LAS unsigned char* VV = lds + 128 * SA;
    LAS float* RS = (LAS float*)(lds + 128 * SA + 128 * SV);
    LAS float* OS = (LAS float*)lds;
    const int tm = wave & 3, nh = wave >> 2, hi = lane >> 5;
    for (int u = vcu; u < NB * (T / SGU_C) * SGU_G; u += G) {
        const int g = u % SGU_G, bc = u / SGU_G;
        const int row0 = bc * SGU_C;
        if (tid < 128) RS[tid] = row_rstd(vssq, row0 + tid);
#pragma unroll
        for (int i = 0; i < 4; ++i) { const int ch = tid + NTHR * i, r = ch >> 4, c16 = ch & 15;
            const v4u w = *(const v4u*)(proj + (size_t)(row0 + r) * SGU_PITCH + 1024 + g * 128 + c16 * 8);
            *(LAS v4u*)(VV + r * SV + c16 * 16) = w; }
        __syncthreads();
#pragma unroll
        for (int i = 0; i < 8; ++i) { const int idx = tid + NTHR * i, t = idx >> 5, s4 = (idx & 31) * 4;
            const f32x4 w = *(const f32x4*)(w_s + (size_t)g * 16384 + t * 128 + s4);
            const float x0 = (s4 + 0 <= t) ? w.x * RS[s4 + 0] : 0.f, x1 = (s4 + 1 <= t) ? w.y * RS[s4 + 1] : 0.f, x2 = (s4 + 2 <= t) ? w.z * RS[s4 + 2] : 0.f, x3 = (s4 + 3 <= t) ? w.w * RS[s4 + 3] : 0.f;
            v2u o; o.x = pk2(x0, x1); o.y = pk2(x2, x3); *(LAS v2u*)(WA + t * SA + s4 * 2) = o; }
        __syncthreads();
        mf32x16 acc0 = zero16(), acc1 = zero16();
        for (int ks = 0; ks < 2 * (tm + 1); ++ks) {
            const mbf16x8 af = frag_rk(WA, SA, 32 * tm, 16 * ks, lane);
            const mbf16x8 b0 = frag_kn(VV, SV, 16 * ks, 64 * nh, lane), b1 = frag_kn(VV, SV, 16 * ks, 64 * nh + 32, lane);
            acc0 = MFMA32(af, b0, acc0); acc1 = MFMA32(af, b1, acc1);
        }
        __syncthreads();
#pragma unroll
        for (int r = 0; r < 16; ++r) { const int row = 32 * tm + crow32(r, hi);
            OS[row * SO + 64 * nh + (lane & 31)] = acc0[r]; OS[row * SO + 64 * nh + 32 + (lane & 31)] = acc1[r]; }
        __syncthreads();
#pragma unroll
        for (int i = 0; i < 4; ++i) { const int ch = tid + NTHR * i, t = ch >> 4, c8 = (ch & 15) * 8;
            const f32x4 s0 = *(const LAS f32x4*)(OS + t * SO + c8), s1 = *(const LAS f32x4*)(OS + t * SO + c8 + 4);
            const f32x4 n0 = *(const f32x4*)(v_norm + g * 128 + c8), n1 = *(const f32x4*)(v_norm + g * 128 + c8 + 4);
            const float bs = b_s[g * 128 + t];
            bf16* up = proj + (size_t)(row0 + t) * SGU_PITCH + g * 128 + c8;
            const v4u uw = *(const v4u*)up;
            v4u o;
            o.x = pk2(bflo(uw.x) * (n0.x * s0.x + bs), bfhi(uw.x) * (n0.y * s0.y + bs)); o.y = pk2(bflo(uw.y) * (n0.z * s0.z + bs), bfhi(uw.y) * (n0.w * s0.w + bs));
            o.z = pk2(bflo(uw.z) * (n1.x * s1.x + bs), bfhi(uw.z) * (n1.y * s1.y + bs)); o.w = pk2(bflo(uw.w) * (n1.z * s1.z + bs), bfhi(uw.w) * (n1.w * s1.w + bs));
            *(v4u*)up = o; }
        __syncthreads();
    }
}

__device__ __forceinline__ void phase_gla_kv_mfma(LAS unsigned char* lds, const Ctx& a, int vcu, int G) {
    const int tid = otid(), lane = tid & 63, wave = __builtin_amdgcn_readfirstlane(tid >> 6), hi = lane >> 5;
    const bf16* proj = (const bf16*)(a.ws + WS_H); bf16* state = (bf16*)(a.ws + WS_STATE); float* dec = (float*)(a.ws + WS_DEC);
    constexpr int SV = 576, SK = 320, SS = 272;
    LAS unsigned char* VV = lds;
    LAS unsigned char* KE = lds + 64 * SV;
    LAS unsigned char* ST = lds;
    LAS float* TOT = (LAS float*)(lds + 256 * SS);
    for (int u = vcu; u < NB * GLA_H * GLA_NC; u += G) {
        const int n = u % GLA_NC, bh = u / GLA_NC, h = bh % GLA_H, b = bh / GLA_H;
        const int row0 = b * T + n * GLA_C;
        GlaCum c; gla_cumsum(c, proj, row0, h, TOT, tid);
        const int cp = tid & 63, part = tid >> 6;
#pragma unroll
        for (int i = 0; i < 8; ++i) { const int t = 8 * part + i; const unsigned w = *(const unsigned*)(proj + (size_t)(row0 + t) * GLA_PITCH + 512 + h * 128 + 2 * cp);
            *(LAS unsigned*)(KE + t * SK + 4 * cp) = pk2(bflo(w) * __expf(c.tot0 - c.b0[i]), bfhi(w) * __expf(c.tot1 - c.b1[i])); }
        if (part == 0) { dec[(size_t)u * 128 + 2 * cp] = __expf(c.tot0); dec[(size_t)u * 128 + 2 * cp + 1] = __expf(c.tot1); }
#pragma unroll
        for (int i = 0; i < 4; ++i) { const int ch = tid + NTHR * i, r = ch >> 5, c16 = ch & 31;
            *(LAS v4u*)(VV + r * SV + c16 * 16) = *(const v4u*)(proj + (size_t)(row0 + r) * GLA_PITCH + 1024 + h * 256 + c16 * 8); }
        __syncthreads();
        mf32x16 acc[4];
#pragma unroll
        for (int nt = 0; nt < 4; ++nt) acc[nt] = zero16();
#pragma unroll
        for (int ks = 0; ks < 4; ++ks) { const mbf16x8 af = frag_kn(VV, SV, 16 * ks, 32 * wave, lane);
#pragma unroll
            for (int nt = 0; nt < 4; ++nt) { const mbf16x8 bfr = frag_kn(KE, SK, 16 * ks, 32 * nt, lane); acc[nt] = MFMA32(af, bfr, acc[nt]); } }
        __syncthreads();
#pragma unroll
        for (int nt = 0; nt < 4; ++nt)
#pragma unroll
            for (int r = 0; r < 16; ++r) *(LAS bf16*)(ST + (32 * wave + crow32(r, hi)) * SS + (32 * nt + (lane & 31)) * 2) = (bf16)f2bf(acc[nt][r]);
        __syncthreads();
#pragma unroll
        for (int i = 0; i < 8; ++i) { const int ch = tid + NTHR * i, vd = ch >> 4, c16 = ch & 15;
            *(v4u*)(state + ((size_t)u * 256 + vd) * 128 + c16 * 8) = *(const LAS v4u*)(ST + vd * SS + c16 * 16); }
        __syncthreads();
    }
}
__device__ __forceinline__ void phase_gla_out_mfma(LAS unsigned char* lds, const Ctx& a, const LayerP& P, int vcu, int G) {
    const int tid = otid(), lane = tid & 63, wave = __builtin_amdgcn_readfirstlane(tid >> 6), hi = lane >> 5;
    bf16* proj = (bf16*)(a.ws + WS_H); const bf16* state = (const bf16*)(a.ws + WS_STATE);
    const float* head_norm = P.e3;
    constexpr int SQ = 272, SA = 144, SV = 576, SO = 260;
    LAS unsigned char* QD = lds;
    LAS unsigned char* KI = lds + 64 * SQ;
    LAS unsigned char* AT = lds + 2 * 64 * SQ;
    LAS unsigned char* VV = lds + 2 * 64 * SQ + 64 * SA;
    LAS float* TOT = (LAS float*)(lds + 80896);
    LAS float* OS = (LAS float*)lds;
    for (int u = vcu; u < NB * GLA_H * GLA_NC; u += G) {
        const int n = u % GLA_NC, bh = u / GLA_NC, h = bh % GLA_H, b = bh / GLA_H;
        const int row0 = b * T + n * GLA_C;
        mbf16x8 sfr[8];
        { const bf16* sp = state + ((size_t)u * 256 + 32 * wave + (lane & 31)) * 128 + 8 * hi;
#pragma unroll
          for (int ks = 0; ks < 8; ++ks) sfr[ks] = *(const mbf16x8*)(sp + 16 * ks); }
        GlaCum c; gla_cumsum(c, proj, row0, h, TOT, tid);
        const int cp = tid & 63, part = tid >> 6;
#pragma unroll
        for (int i = 0; i < 8; ++i) { const int t = 8 * part + i;
            const unsigned wq = *(const unsigned*)(proj + (size_t)(row0 + t) * GLA_PITCH + h * 128 + 2 * cp);
            const unsigned wk = *(const unsigned*)(proj + (size_t)(row0 + t) * GLA_PITCH + 512 + h * 128 + 2 * cp);
            const float e0 = __expf(c.b0[i]), e1 = __expf(c.b1[i]);
            *(LAS unsigned*)(QD + t * SQ + 4 * cp) = pk2(bflo(wq) * 0.08838834764831845f * e0, bfhi(wq) * 0.08838834764831845f * e1);
            *(LAS unsigned*)(KI + t * SQ + 4 * cp) = pk2(bflo(wk) / e0, bfhi(wk) / e1); }
#pragma unroll
        for (int i = 0; i < 4; ++i) { const int ch = tid + NTHR * i, r = ch >> 5, c16 = ch & 31;
            *(LAS v4u*)(VV + r * SV + c16 * 16) = *(const v4u*)(proj + (size_t)(row0 + r) * GLA_PITCH + 1024 + h * 256 + c16 * 8); }
        __syncthreads();
        if (wave < 4) {
            const int mi = wave >> 1, ni = wave & 1;
            mf32x16 at = zero16();
            if (!(mi == 0 && ni == 1)) {
#pragma unroll
                for (int ks = 0; ks < 8; ++ks) at = MFMA32(frag_rk(QD, SQ, 32 * mi, 16 * ks, lane), frag_rk(KI, SQ, 32 * ni, 16 * ks, lane), at);
            }
#pragma unroll
            for (int r = 0; r < 16; ++r) { const int cc = 32 * mi + crow32(r, hi), ss = 32 * ni + (lane & 31);
                *(LAS bf16*)(AT + cc * SA + ss * 2) = (bf16)f2bf((ss <= cc) ? at[r] : 0.f); }
        }
        __syncthreads();
        mf32x16 acc[2]; acc[0] = zero16(); acc[1] = zero16();
#pragma unroll
        for (int ks = 0; ks < 4; ++ks) { const mbf16x8 bfr = frag_kn(VV, SV, 16 * ks, 32 * wave, lane);
            if (ks < 2) acc[0] = MFMA32(frag_rk(AT, SA, 0, 16 * ks, lane), bfr, acc[0]);
            acc[1] = MFMA32(frag_rk(AT, SA, 32, 16 * ks, lane), bfr, acc[1]); }
#pragma unroll
        for (int ks = 0; ks < 8; ++ks) { acc[0] = MFMA32(frag_rk(QD, SQ, 0, 16 * ks, lane), sfr[ks], acc[0]); acc[1] = MFMA32(frag_rk(QD, SQ, 32, 16 * ks, lane), sfr[ks], acc[1]); }
        __syncthreads();
#pragma unroll
        for (int mi = 0; mi < 2; ++mi)
#pragma unroll
            for (int r = 0; r < 16; ++r) OS[(32 * mi + crow32(r, hi)) * SO + 32 * wave + (lane & 31)] = acc[mi][r];
        __syncthreads();
#pragma unroll
        for (int p = 0; p < 4; ++p) { const int cc = p * 16 + wave * 2 + hi, c8 = (lane & 31) * 8;
            const f32x4 s0 = *(const LAS f32x4*)(OS + cc * SO + c8), s1 = *(const LAS f32x4*)(OS + cc * SO + c8 + 4);
            float ss = (s0.x * s0.x + s0.y * s0.y) + (s0.z * s0.z + s0.w * s0.w) + (s1.x * s1.x + s1.y * s1.y) + (s1.z * s1.z + s1.w * s1.w);
            ss += __shfl_xor(ss, 1); ss += __shfl_xor(ss, 2); ss += __shfl_xor(ss, 4); ss += __shfl_xor(ss, 8); ss += __shfl_xor(ss, 16);
            const float rs = 1.0f / sqrtf(ss * (1.0f / 256.0f) + EPS);
            const f32x4 n0 = *(const f32x4*)(head_norm + c8), n1 = *(const f32x4*)(head_norm + c8 + 4);
            const v4u gw = *(const v4u*)(proj + (size_t)(row0 + cc) * GLA_PITCH + 2048 + h * 256 + c8);
            const float gg[8] = {bflo(gw.x), bfhi(gw.x), bflo(gw.y), bfhi(gw.y), bflo(gw.z), bfhi(gw.z), bflo(gw.w), bfhi(gw.w)};
            const float ov[8] = {s0.x * n0.x, s0.y * n0.y, s0.z * n0.z, s0.w * n0.w, s1.x * n1.x, s1.y * n1.y, s1.z * n1.z, s1.w * n1.w};
            float o[8];
#pragma unroll
            for (int j = 0; j < 8; ++j) o[j] = ov[j] * rs * (gg[j] / (1.f + __expf(-gg[j])));
            v4u w; w.x = pk2(o[0], o[1]); w.y = pk2(o[2], o[3]); w.z = pk2(o[4], o[5]); w.w = pk2(o[6], o[7]);
            *(v4u*)(proj + (size_t)(row0 + cc) * GLA_PITCH + 1024 + h * 256 + c8) = w; }
        __syncthreads();
    }
}
#ifndef USE_MFMA_SGU
#define USE_MFMA_SGU 1
#endif
#ifndef USE_MFMA_GLA
#define USE_MFMA_GLA 1
#endif

constexpr int PH_PER_LAYER = 8, NPHASE = 4 * PH_PER_LAYER + 1;
__host__ __device__ inline bool phase_is_noop(int ph) {
    if (ph >= 4 * PH_PER_LAYER) return false;
    const int L = ph / PH_PER_LAYER, s = ph % PH_PER_LAYER;
    const bool gla = (L == 0 || L == 3), diff = (L == 1);
    return (s == 3 && !gla && !diff) || (s == 4 && !gla);
}

__global__ void __launch_bounds__(NTHR, 2) trunk_fwd(Args kargs) {
    LAS unsigned char* lds = (LAS unsigned char*)lds_raw;
    const int tid = threadIdx.x;
    const int G0 = gridDim.x; const int bx = blockIdx.x;
    const int vcu0 = (G0 % 8 == 0) ? (bx % 8) * (G0 / 8) + bx / 8 : bx;
    for (int u = tid; u < (LDS_BYTES - LDSCTL_OFF) / 4; u += NTHR) ((LAS unsigned*)(lds + LDSCTL_OFF))[u] = 0u;
    __syncthreads();
    if ((tid & 63) == 0) ((LAS unsigned*)(lds + TIDTAB_OFF))[hw_slot()] = (unsigned)(tid >> 6);
    __syncthreads();
    unsigned* ctl = (unsigned*)(kargs.ws + WS_CTL);
    const int ph_lo = kargs.ph_lo, ph_hi = kargs.ph_hi; const bool multi = (ph_hi - ph_lo) > 1;
    if (multi) (void)xcd_barrier_post(ctl + 4096, (volatile LAS unsigned*)(lds + MISC_OFF) + 8);
    bool first_seam = true;
    for (int ph = ph_lo; ph < ph_hi; ++ph) {
        if (phase_is_noop(ph)) continue;
        int vcu = vcu0, G = G0; asm volatile("" : "+s"(vcu), "+s"(G));
        const CAS Args* ap = (const CAS Args*)__builtin_amdgcn_kernarg_segment_ptr(); asm volatile("" : "+s"(ap));
        Ctx args; args.in0 = ap->in[0]; args.in42 = ap->in[42]; args.out = ap->out; args.ws = ap->ws;
        bf16* Wb = (bf16*)(args.ws + WS_W); bf16* XB = (bf16*)(args.ws + WS_XB); bf16* HB = (bf16*)(args.ws + WS_H);
        float* SSQ = (float*)(args.ws + WS_SSQ); float* VSSQ = (float*)(args.ws + WS_VSSQ);
        if (ph == 4 * PH_PER_LAYER) { phase_final(args, vcu, G); }
        else {
            const int L = ph / PH_PER_LAYER, s = ph % PH_PER_LAYER;
            const LayerP P = layer_params((const CAS cfptr*)ap, L);
            if (s == 0) phase_conv(lds, args, P, L, vcu, G);
            else if (s == 1) { EpiIn E{P.kind, HB, SSQ, (P.kind == K_GLA) ? P.e2 : P.e0, VSSQ, (unsigned*)(args.ws + WS_CTL) + CW_QKMAX}; run_gemm(lds, XB, D, Wb + WOFF_IN, NTOK, P.nin, D, E, vcu, G); }
            else if (s == 2) { if (P.kind == K_GLA) {
#if USE_MFMA_GLA
                    phase_gla_kv_mfma(lds, args, vcu, G);
#else
                    phase_gla_kv(lds, args, vcu, G);
#endif
                } else if (P.kind == K_DIFF) {
#if USE_MFMA_ATTN
                    phase_diff_mfma((char*)lds_raw, lds, args, vcu, G);
#else
                    phase_diff(lds, args, P, vcu, G);
#endif
                } else {
#if USE_MFMA_SGU
                    phase_sgu_mfma(lds, args, P, vcu, G);
#else
                    phase_sgu(lds, args, P, vcu, G);
#endif
                } }
            else if (s == 3) { if (P.kind == K_GLA) phase_gla_scan(args, vcu, G); else phase_diff_combine(args, P, vcu, G); }
            else if (s == 4) {
#if USE_MFMA_GLA
                phase_gla_out_mfma(lds, args, P, vcu, G);
#else
                phase_gla_out(lds, args, P, vcu, G);
#endif
            }
            else if (s == 5) { EpiRes E{(L == 0) ? args.in0 : args.out, args.out, XB, SSQ}; run_gemm(lds, HB + P.mixoff, P.nin, Wb + WOFF_OUT, NTOK, D, D, E, vcu, G); }
            else if (s == 6) { EpiHid E{HB, SSQ}; run_gemm(lds, XB, D, Wb + WOFF_1, NTOK, FF, D, E, vcu, G); }
            else { EpiRes E{args.out, args.out, XB, SSQ}; run_gemm(lds, HB, FF, Wb + WOFF_2, NTOK, D, FF, E, vcu, G); }
        }
        if (ph + 1 < ph_hi) {
            if (first_seam) { cg::this_grid().sync(); first_seam = false; }
            else { XcdBarrier bb; bb.bar = (unsigned*)(ap->ws + WS_CTL) + 4096; bb.x = xb_xcc_id(); bb.st = (volatile LAS unsigned*)(lds + MISC_OFF) + 8; xcd_barrier(bb); }
        }
    }
}

extern "C" void kernel_launch(void* const* d_in, const int* in_sizes, int n_in, void* d_out, int out_size, void* d_ws, size_t ws_size, hipStream_t stream) {
    static int grid = 0;
    if (grid == 0) {
        if (n_in != 43 || in_sizes[0] != NTOK * D || out_size != NTOK * D || ws_size < WS_END) {
            fprintf(stderr, "kernel_launch: unexpected problem (n_in %d, in0 %d, out %d, ws %zu); nothing launched\n", n_in, n_in > 0 ? in_sizes[0] : -1, out_size, ws_size); grid = -1; return; }
        int dev = 0, cus = 0, per_cu = 0;
        if (hipGetDevice(&dev) != hipSuccess || hipDeviceGetAttribute(&cus, hipDeviceAttributeMultiprocessorCount, dev) != hipSuccess) { grid = -1; return; }
        if (hipFuncSetAttribute((const void*)trunk_fwd, hipFuncAttributeMaxDynamicSharedMemorySize, LDS_BYTES) != hipSuccess) { fprintf(stderr, "kernel_launch: hipFuncSetAttribute failed\n"); grid = -1; return; }
        if (hipOccupancyMaxActiveBlocksPerMultiprocessor(&per_cu, (const void*)trunk_fwd, NTHR, LDS_BYTES) != hipSuccess || per_cu < 1) { fprintf(stderr, "kernel_launch: occupancy query says %d blocks/CU\n", per_cu); per_cu = 1; }
        (void)hipGetLastError();
        grid = cus;
    }
    if (grid < 0) return;
    (void)hipMemsetAsync((char*)d_ws + WS_CTL, 0, CTL_ZERO_BYTES, stream);
    Args a{};
    for (int i = 0; i < 43; ++i) a.in[i] = (const float*)d_in[i];
    a.out = (float*)d_out; a.ws = (unsigned char*)d_ws;
#if MK_ONE_LAUNCH
    a.ph_lo = 0; a.ph_hi = NPHASE;
    void* kargs[] = {&a};
    hipError_t e = hipLaunchCooperativeKernel((const void*)trunk_fwd, dim3(grid), dim3(NTHR), kargs, LDS_BYTES, stream);
    if (e != hipSuccess) fprintf(stderr, "kernel_launch: cooperative launch failed: %s (grid %d)\n", hipGetErrorString(e), grid);
#else
    for (int ph = 0; ph < NPHASE; ++ph) {
        if (phase_is_noop(ph)) continue;
        a.ph_lo = ph; a.ph_hi = ph + 1;
        hipLaunchKernelGGL(trunk_fwd, dim3(grid), dim3(NTHR), LDS_BYTES, stream, a);
    }
#endif
}
```

```cpp
#include <hip/hip_runtime.h>
#include <hip/hip_cooperative_groups.h>
#include <cstdio>
#include <cstdint>
namespace cg = cooperative_groups;

#ifndef MK_ONE_LAUNCH
#define MK_ONE_LAUNCH 1
#endif

#define GAS __attribute__((address_space(1)))
#define LAS __attribute__((address_space(3)))
typedef unsigned short bf16;
typedef unsigned v4u __attribute__((ext_vector_type(4)));
typedef unsigned v2u __attribute__((ext_vector_type(2)));
typedef float f32x4 __attribute__((ext_vector_type(4)));

constexpr int NB = 2, T = 8192, D = 1024, NTOK = NB * T, FF = 4096;
constexpr float EPS = 1e-6f;
constexpr float LOG2E = 1.4426950408889634f;
constexpr int NWAVES = 8, NTHR = 512;
constexpr int K_GLA = 0, K_DIFF = 1, K_SGU = 2;
constexpr int GLA_H = 4, GLA_HK = 128, GLA_HV = 256, GLA_C = 64, GLA_NC = T / GLA_C;
constexpr int GLA_PITCH = 3584;
constexpr int DIFF_H = 8, DIFF_PITCH = 3072;
constexpr float LAMBDA_INIT = 0.35551069f;
constexpr int SGU_PITCH = 2048, SGU_C = 128, SGU_G = 8;

constexpr size_t MiB = 1u << 20;
constexpr size_t WS_CTL = 0, CTL_ZERO_BYTES = 1 * MiB;
constexpr size_t WS_SSQ = 1 * MiB;
constexpr size_t WS_VSSQ = 2 * MiB;
constexpr size_t WS_DEC = 3 * MiB;
constexpr size_t WS_W = 4 * MiB;
constexpr size_t WS_XB = 29 * MiB;
constexpr size_t WS_STATE = 61 * MiB;
constexpr size_t WS_H = 125 * MiB;
constexpr size_t WS_END = 253 * MiB;
constexpr int CW_QKMAX = 8192;
constexpr int CW_QUEUE = 8448;
constexpr size_t WOFF_IN = 0, WOFF_OUT = (size_t)3584 * 1024, WOFF_1 = WOFF_OUT + (size_t)1024 * 1024, WOFF_2 = WOFF_1 + (size_t)4096 * 1024;

constexpr int RING_BYTES = 131072, LDSCTL_OFF = RING_BYTES, MISC_OFF = LDSCTL_OFF + 320, LDS_BYTES = 147456;

#define RLX_AGENT __ATOMIC_RELAXED, __HIP_MEMORY_SCOPE_AGENT
#define LDS_WAIT() asm volatile("s_waitcnt lgkmcnt(0)" ::: "memory")
__device__ __forceinline__ unsigned f2bf(float f) { unsigned u = __builtin_bit_cast(unsigned, f); return (u + 0x7fffu + ((u >> 16) & 1u)) >> 16; }
__device__ __forceinline__ unsigned pk2(float lo, float hi) { return f2bf(lo) | (f2bf(hi) << 16); }
__device__ __forceinline__ float bf2f(unsigned b) { return __builtin_bit_cast(float, b << 16); }
__device__ __forceinline__ float bflo(unsigned w) { return __builtin_bit_cast(float, w << 16); }
__device__ __forceinline__ float bfhi(unsigned w) { return __builtin_bit_cast(float, w & 0xffff0000u); }
extern __shared__ __attribute__((aligned(16))) unsigned char lds_raw[];
constexpr int TIDTAB_OFF = 131072;
__device__ __forceinline__ unsigned hw_slot() { return (unsigned)__builtin_amdgcn_s_getreg((5 << 11) | 4) & 63u; }
__device__ __forceinline__ int otid() {
    const int wv = (int)((volatile __attribute__((address_space(3))) unsigned*)((__attribute__((address_space(3))) unsigned char*)lds_raw + TIDTAB_OFF))[hw_slot()];
    int ln; asm volatile("v_mbcnt_lo_u32_b32 %0, -1, 0\n\tv_mbcnt_hi_u32_b32 %0, -1, %0" : "=v"(ln));
    int t = wv * 64 + ln;
    asm volatile("" : "+v"(t)); return t; }
__device__ __forceinline__ float wave_sum(float v) {
#pragma unroll
    for (int o = 1; o < 64; o <<= 1) v += __shfl_xor(v, o);
    return v;
}
__device__ __forceinline__ float wave_max(float v) {
#pragma unroll
    for (int o = 1; o < 64; o <<= 1) v = fmaxf(v, __shfl_xor(v, o));
    return v;
}
__device__ __forceinline__ float gelu_tanh(float x) {
    const float u = 0.7978845608028654f * (x + 0.044715f * x * x * x);
    const float e = __expf(2.f * u);
    const float t = 1.f - 2.f / (e + 1.f);
    return 0.5f * x * (1.f + t);
}
__device__ __forceinline__ float log_sigmoid(float z) { return fminf(z, 0.f) - log1pf(__expf(-fabsf(z))); }

#define XB_TMO      128
#define XB_XCNT(j)  (256  + 64 * (j))
#define XB_XSUB(j)  (1280 + 64 * (j))
#define XB_XGEN(j)  (2304 + 64 * (j))
#define XB_TOP      3328
#define XB_TOPGEN   3392
#define XCD_BAR_WORDS 3456
#define XB_SPIN_CAP (1u << 22)
__device__ __forceinline__ unsigned xb_ld(unsigned* p)              { return __hip_atomic_load(p, __ATOMIC_RELAXED, __HIP_MEMORY_SCOPE_AGENT); }
__device__ __forceinline__ unsigned xb_add(unsigned* p, unsigned v) { return __hip_atomic_fetch_add(p, v, __ATOMIC_RELAXED, __HIP_MEMORY_SCOPE_AGENT); }
__device__ __forceinline__ unsigned xb_xcc_id() { return (unsigned)__builtin_amdgcn_s_getreg((3 << 11) | 20) & 0xFu; }
#define XB_SPIN(cond, bar) do { unsigned _sp = 0; while (cond) { __builtin_amdgcn_s_sleep(1); \
    if ((++_sp & 255u) == 0u) { if (xb_ld(&(bar)[XB_TMO])) break; if (_sp > XB_SPIN_CAP) { atomicAdd(&(bar)[XB_TMO], 1u); break; } } } } while (0)
struct XcdBarrier { unsigned* bar; unsigned x; volatile LAS unsigned* st; };
__device__ __forceinline__ XcdBarrier xcd_barrier_post(unsigned* bar, volatile LAS unsigned* st) {
    XcdBarrier b; b.bar = bar; b.x = xb_xcc_id(); b.st = st;
    if (threadIdx.x == 0) (void)xb_add(&bar[XB_XCNT(b.x)], 1u);
    return b;
}
__device__ __forceinline__ void xcd_barrier_complete(unsigned* bar, unsigned x, unsigned& nloc, unsigned& nx) {
    const unsigned G = gridDim.x * gridDim.y * gridDim.z;
    unsigned sum, cnt, mine, sp = 0u;
    for (;;) {
        sum = 0u; cnt = 0u; mine = 0u;
#pragma unroll
        for (unsigned j = 0; j < 16; ++j) { const unsigned c = xb_ld(&bar[XB_XCNT(j)]); sum += c; cnt += (c > 0u) ? 1u : 0u; mine = (j == x) ? c : mine; }
        if (sum == G) break;
        __builtin_amdgcn_s_sleep(1);
        if ((++sp & 255u) == 0u) { if (xb_ld(&bar[XB_TMO])) break; if (sp > XB_SPIN_CAP) { atomicAdd(&bar[XB_TMO], 1u); break; } }
    }
    nloc = mine > 0u ? mine : 1u; nx = cnt > 0u ? cnt : 1u;
}
__device__ __forceinline__ void xcd_barrier(const XcdBarrier& b) {
    asm volatile("s_waitcnt vmcnt(0)" ::: "memory");
    __syncthreads();
    if (otid() == 0) {
        unsigned* bar = b.bar;
        __builtin_amdgcn_s_waitcnt(0);
        unsigned nloc = b.st[0], nx = b.st[1];
        if (nloc == 0u) { xcd_barrier_complete(bar, b.x, nloc, nx); b.st[0] = nloc; b.st[1] = nx; }
        const unsigned old = xb_add(&bar[XB_XSUB(b.x)], 1u);
        const unsigned gen = old / nloc;
        if (old + 1u == (gen + 1u) * nloc) {
            __builtin_amdgcn_fence(__ATOMIC_RELEASE, "agent");
            asm volatile("s_waitcnt vmcnt(0)" ::: "memory");
            const unsigned og = xb_add(&bar[XB_TOP], 1u);
            const unsigned tg = og / nx;
            if (og + 1u == (tg + 1u) * nx) xb_add(&bar[XB_TOPGEN], 1u);
            else XB_SPIN(xb_ld(&bar[XB_TOPGEN]) == tg, bar);
            __builtin_amdgcn_fence(__ATOMIC_ACQUIRE, "agent");
            xb_add(&bar[XB_XGEN(b.x)], 1u);
            asm volatile("s_waitcnt vmcnt(0)" ::: "memory");
        } else {
            XB_SPIN(xb_ld(&bar[XB_XGEN(b.x)]) == gen, bar);
            __builtin_amdgcn_fence(__ATOMIC_ACQUIRE, "agent");
            asm volatile("s_waitcnt vmcnt(0)" ::: "memory");
        }
    }
    __syncthreads();
}

struct Args { const float* in[43]; float* out; unsigned char* ws; int ph_lo, ph_hi; };
struct Ctx { const float* in0; const float* in42; float* out; unsigned char* ws; };
struct LayerP {
    int kind;
    const float *norm1, *w_in, *w_out, *norm2, *w1, *w2;
    const float *e0, *e1, *e2, *e3, *e4;
    int nin;
    int mixoff;
};
typedef const float* cfptr;
#define CAS __attribute__((address_space(4)))
__device__ __forceinline__ LayerP layer_params(const CAS cfptr* in, int L) {
    LayerP p;
    const int base = (L == 0) ? 1 : (L == 1) ? 11 : (L == 2) ? 22 : 32;
    p.kind = (L == 1) ? K_DIFF : (L == 2) ? K_SGU : K_GLA;
    const int sh = (p.kind == K_DIFF) ? 1 : 0;
    p.norm1 = in[base]; p.w_in = in[base + 1];
    p.e0 = in[base + 2]; p.e1 = in[base + 3]; p.e2 = in[base + 4]; p.e3 = in[base + 5]; p.e4 = in[base + 6];
    p.w_out = in[base + 6 + sh]; p.norm2 = in[base + 7 + sh]; p.w1 = in[base + 8 + sh]; p.w2 = in[base + 9 + sh];
    p.nin = (p.kind == K_GLA) ? GLA_PITCH : (p.kind == K_DIFF) ? DIFF_PITCH : SGU_PITCH;
    p.mixoff = (p.kind == K_GLA) ? 1024 : 0;
    return p;
}

__device__ __forceinline__ float row_rstd(const float* ssq, int row) {
    const f32x4* p = (const f32x4*)(ssq + (size_t)row * 16);
    const f32x4 a = p[0], b = p[1], c = p[2], d = p[3];
    const float s = ((a.x + a.y) + (a.z + a.w)) + ((b.x + b.y) + (b.z + b.w)) + ((c.x + c.y) + (c.z + c.w)) + ((d.x + d.y) + (d.z + d.w));
    return 1.0f / sqrtf(s * (1.0f / D) + EPS);
}

struct EpiIn {
    int kind; bf16* proj; const float* ssq; const float* bias;
    float* vssq;
    __device__ __forceinline__ float rowscale(int row) const { return row_rstd(ssq, row); }
    __device__ __forceinline__ float apply8(int row, int col0, const float (&v)[8], float rs) const {
        float o[8]; float part = 0.f; int pitch;
        if (kind == K_GLA) { pitch = GLA_PITCH;
            if (col0 < 3072) {
#pragma unroll
                for (int j = 0; j < 8; ++j) o[j] = v[j] * rs;
            } else {
#pragma unroll
                for (int j = 0; j < 8; ++j) o[j] = log_sigmoid(v[j] * rs + bias[col0 - 3072 + j]) * (1.0f / 16.0f);
            }
        } else if (kind == K_DIFF) { pitch = DIFF_PITCH;
            const float sc = (col0 < 1024) ? rs * (0.125f * LOG2E) : rs;
#pragma unroll
            for (int j = 0; j < 8; ++j) o[j] = v[j] * sc;
            if (col0 < 2048) {
#pragma unroll
                for (int j = 0; j < 8; ++j) part += o[j] * o[j];
            }
        } else { pitch = SGU_PITCH;
#pragma unroll
            for (int j = 0; j < 8; ++j) { o[j] = gelu_tanh(v[j] * rs + bias[col0 + j]); }
            if (col0 >= 1024) {
#pragma unroll
                for (int j = 0; j < 8; ++j) part += o[j] * o[j];
            }
        }
        v4u w; w.x = pk2(o[0], o[1]); w.y = pk2(o[2], o[3]); w.z = pk2(o[4], o[5]); w.w = pk2(o[6], o[7]);
        *(v4u*)(proj + (size_t)row * pitch + col0) = w;
        return part;
    }
    __device__ __forceinline__ void store_part(int row, int col0, int idx, float part) const {
        if (kind == K_SGU && col0 >= 1024) vssq[(size_t)row * 16 + idx] = part;
    }
    static constexpr bool GROUPMAX = true;
    unsigned* qkmax;
    __device__ __forceinline__ bool want_groupmax(int col0) const { return kind == K_DIFF && col0 < 2048; }
    __device__ __forceinline__ void store_groupmax(int row, int col0, float m) const {
        atomicMax(qkmax + (row >> 13) * 64 + (col0 >> 5), __float_as_uint(m * 1.01f));
    }
};
struct EpiHid {
    bf16* h; const float* ssq;
    __device__ __forceinline__ float rowscale(int row) const { return row_rstd(ssq, row); }
    __device__ __forceinline__ float apply8(int row, int col0, const float (&v)[8], float rs) const {
        float o[8];
#pragma unroll
        for (int j = 0; j < 8; ++j) { const float a = fmaxf(v[j] * rs, 0.f); o[j] = a * a; }
        v4u w; w.x = pk2(o[0], o[1]); w.y = pk2(o[2], o[3]); w.z = pk2(o[4], o[5]); w.w = pk2(o[6], o[7]);
        *(v4u*)(h + (size_t)row * FF + col0) = w;
        return 0.f;
    }
    __device__ __forceinline__ void store_part(int, int, int, float) const {}
    static constexpr bool GROUPMAX = false;
    __device__ __forceinline__ bool want_groupmax(int) const { return false; }
    __device__ __forceinline__ void store_groupmax(int, int, float) const {}
};
struct EpiRes {
    const float* base; float* x; bf16* xb; float* ssq;
    __device__ __forceinline__ float rowscale(int) const { return 1.f; }
    __device__ __forceinline__ float apply8(int row, int col0, const float (&v)[8], float) const {
        const size_t off = (size_t)row * D + col0;
        const f32x4 b0 = *(const f32x4*)(base + off), b1 = *(const f32x4*)(base + off + 4);
        float o[8] = {b0.x + v[0], b0.y + v[1], b0.z + v[2], b0.w + v[3], b1.x + v[4], b1.y + v[5], b1.z + v[6], b1.w + v[7]};
        *(f32x4*)(x + off) = (f32x4){o[0], o[1], o[2], o[3]}; *(f32x4*)(x + off + 4) = (f32x4){o[4], o[5], o[6], o[7]};
        v4u w; w.x = pk2(o[0], o[1]); w.y = pk2(o[2], o[3]); w.z = pk2(o[4], o[5]); w.w = pk2(o[6], o[7]);
        *(v4u*)(xb + off) = w;
        float part = 0.f;
#pragma unroll
        for (int j = 0; j < 8; ++j) part += o[j] * o[j];
        return part;
    }
    __device__ __forceinline__ void store_part(int row, int, int idx, float part) const { ssq[(size_t)row * 16 + idx] = part; }
    static constexpr bool GROUPMAX = false;
    __device__ __forceinline__ bool want_groupmax(int) const { return false; }
    __device__ __forceinline__ void store_groupmax(int, int, float) const {}
};

template <class Epi>
__device__ __forceinline__ void gemm_naive(LAS unsigned char* lds, const bf16* A, int lda, const bf16* Bt, int M, int N, int K, const Epi& E, int vcu, int G) {
    LAS float* As = (LAS float*)lds;
    LAS float* Bs = As + 64 * 33;
    const int tid = otid();
    const int nM = M / 64, nN = N / 64;
    const int r = tid >> 3, cgp = tid & 7;
    for (int u = vcu; u < nM * nN; u += G) {
        const int pm = u / nN, pn = u % nN;
        float acc[8];
#pragma unroll
        for (int j = 0; j < 8; ++j) acc[j] = 0.f;
        for (int k0 = 0; k0 < K; k0 += 32) {
            { const int lr = tid >> 3, lc = (tid & 7) * 4;
              const v2u av = *(const v2u*)(A + (size_t)(pm * 64 + lr) * lda + k0 + lc);
              const v2u bv = *(const v2u*)(Bt + (size_t)(pn * 64 + lr) * K + k0 + lc);
              As[lr * 33 + lc + 0] = bflo(av.x); As[lr * 33 + lc + 1] = bfhi(av.x); As[lr * 33 + lc + 2] = bflo(av.y); As[lr * 33 + lc + 3] = bfhi(av.y);
              Bs[lr * 33 + lc + 0] = bflo(bv.x); Bs[lr * 33 + lc + 1] = bfhi(bv.x); Bs[lr * 33 + lc + 2] = bflo(bv.y); Bs[lr * 33 + lc + 3] = bfhi(bv.y); }
            __syncthreads();
#pragma unroll 8
            for (int kk = 0; kk < 32; ++kk) { const float a = As[r * 33 + kk];
#pragma unroll
                for (int j = 0; j < 8; ++j) acc[j] += a * Bs[(cgp * 8 + j) * 33 + kk]; }
            __syncthreads();
        }
        const int row = pm * 64 + r, col0 = pn * 64 + cgp * 8;
        const float rs = E.rowscale(row);
        float part = E.apply8(row, col0, acc, rs);
        part += __shfl_xor(part, 1); part += __shfl_xor(part, 2); part += __shfl_xor(part, 4);
        if (cgp == 0) E.store_part(row, col0, pn & 15, part);
    }
}

__device__ __forceinline__ void transpose_item(const float* W, const float* gain, int K, int N, bf16* WT, int row_off, LAS float* scr, int item, int lane) {
    const int nblk = N / 32, kb = item / nblk, nb = item % nblk, k0 = 64 * kb, n0 = 32 * nb;
#pragma unroll 8
    for (int i = 0; i < 32; ++i) { const int kk = 2 * i + (lane >> 5); const float g = gain ? gain[k0 + kk] : 1.f; scr[kk * 33 + (lane & 31)] = g * W[(size_t)(k0 + kk) * N + n0 + (lane & 31)]; }
    LDS_WAIT(); asm volatile("" ::: "memory");
    const int c = lane & 7;
#pragma unroll
    for (int j = 0; j < 4; ++j) { const int n = (lane >> 3) + 8 * j; const LAS float* s = scr + (8 * c) * 33 + n;
        v4u o; o.x = pk2(s[0 * 33], s[1 * 33]); o.y = pk2(s[2 * 33], s[3 * 33]); o.z = pk2(s[4 * 33], s[5 * 33]); o.w = pk2(s[6 * 33], s[7 * 33]);
        *(GAS v4u*)(WT + (size_t)(row_off + n0 + n) * K + k0 + 8 * c) = o; }
    LDS_WAIT(); asm volatile("" ::: "memory");
}

__device__ __forceinline__ void phase_conv(LAS unsigned char* lds, const Ctx& a, const LayerP& P, int L, int vcu, int G) {
    const int tid = otid(), lane = tid & 63, wave = __builtin_amdgcn_readfirstlane(tid >> 6);
    LAS float* scr = (LAS float*)(lds + wave * 16384);
    bf16* Wb = (bf16*)(a.ws + WS_W);
    const int gw = vcu * NWAVES + wave, NGW = G * NWAVES;
    const int nin_w = (P.kind == K_SGU) ? 2048 : 3072;
    const int I_IN = (D / 64) * (nin_w / 32), I_OUT = (D / 64) * (D / 32), I_1 = (D / 64) * (FF / 32), I_2 = (FF / 64) * (D / 32);
    const int NITEMS = I_IN + I_OUT + I_1 + I_2;
    for (int it = gw; it < NITEMS; it += NGW) {
        int r = it;
        if (r < I_IN) { transpose_item(P.w_in, P.norm1, D, nin_w, Wb + WOFF_IN, 0, scr, r, lane); continue; } r -= I_IN;
        if (r < I_OUT) { transpose_item(P.w_out, nullptr, D, D, Wb + WOFF_OUT, 0, scr, r, lane); continue; } r -= I_OUT;
        if (r < I_1) { transpose_item(P.w1, P.norm2, D, FF, Wb + WOFF_1, 0, scr, r, lane); continue; } r -= I_1;
        transpose_item(P.w2, nullptr, FF, D, Wb + WOFF_2, 0, scr, r, lane);
    }
    if (P.kind == K_GLA) {
        const float* W1 = P.e0; const float* W2 = P.e1;
        for (int e = vcu * NTHR + tid; e < 512 * 1024; e += G * NTHR) {
            const int n = e >> 10, k = e & 1023;
            float s = 0.f;
#pragma unroll
            for (int r = 0; r < 16; ++r) s += W1[k * 16 + r] * W2[r * 512 + n];
            Wb[WOFF_IN + (size_t)(3072 + n) * 1024 + k] = (bf16)f2bf(s * P.norm1[k]);
        }
    }
    if (L == 0) {
        const float* x = a.in0; bf16* xb = (bf16*)(a.ws + WS_XB); float* ssq = (float*)(a.ws + WS_SSQ);
        for (int m = gw; m < NTOK; m += NGW) {
            const f32x4* xr = (const f32x4*)(x + (size_t)m * D) + lane;
            f32x4 v[4]; float s = 0.f;
#pragma unroll
            for (int j = 0; j < 4; ++j) { v[j] = xr[64 * j]; s += (v[j].x * v[j].x + v[j].y * v[j].y) + (v[j].z * v[j].z + v[j].w * v[j].w); }
            s = wave_sum(s);
            v2u* o8 = (v2u*)(xb + (size_t)m * D) + lane;
#pragma unroll
            for (int j = 0; j < 4; ++j) { v2u w; w.x = pk2(v[j].x, v[j].y); w.y = pk2(v[j].z, v[j].w); o8[64 * j] = w; }
            if (lane < 16) ssq[(size_t)m * 16 + lane] = (lane == 0) ? s : 0.f;
        }
    }
}

__device__ __forceinline__ void phase_final(const Ctx& a, int vcu, int G) {
    const int tid = otid(), lane = tid & 63, wave = tid >> 6;
    const int gw = vcu * NWAVES + wave, NGW = G * NWAVES;
    const float* ssq = (const float*)(a.ws + WS_SSQ); const float* g = a.in42;
    for (int m = gw; m < NTOK; m += NGW) {
        const float rs = row_rstd(ssq, m);
        f32x4* xr = (f32x4*)(a.out + (size_t)m * D) + lane; const f32x4* gr = (const f32x4*)g + lane;
#pragma unroll
        for (int j = 0; j < 4; ++j) { f32x4 v = xr[64 * j]; const f32x4 gg = gr[64 * j]; v.x *= rs * gg.x; v.y *= rs * gg.y; v.z *= rs * gg.z; v.w *= rs * gg.w; xr[64 * j] = v; }
    }
}

struct GlaCum { float b0[8], b1[8], tot0, tot1; };
__device__ __forceinline__ void gla_cumsum(GlaCum& c, const bf16* proj, int row0, int h, LAS float* TOT, int tid) {
    const int cp = tid & 63, part = tid >> 6;
#pragma unroll
    for (int i = 0; i < 8; ++i) { const unsigned w = *(const unsigned*)(proj + (size_t)(row0 + 8 * part + i) * GLA_PITCH + 3072 + h * 128 + 2 * cp); c.b0[i] = bflo(w); c.b1[i] = bfhi(w); }
#pragma unroll
    for (int i = 1; i < 8; ++i) { c.b0[i] += c.b0[i - 1]; c.b1[i] += c.b1[i - 1]; }
    TOT[part * 128 + 2 * cp] = c.b0[7]; TOT[part * 128 + 2 * cp + 1] = c.b1[7];
    __syncthreads();
    float o0 = 0.f, o1 = 0.f, t0 = 0.f, t1 = 0.f;
#pragma unroll
    for (int p = 0; p < 8; ++p) { const float x0 = TOT[p * 128 + 2 * cp], x1 = TOT[p * 128 + 2 * cp + 1]; if (p < part) { o0 += x0; o1 += x1; } t0 += x0; t1 += x1; }
#pragma unroll
    for (int i = 0; i < 8; ++i) { c.b0[i] += o0; c.b1[i] += o1; }
    c.tot0 = t0; c.tot1 = t1;
}
__device__ __forceinline__ void phase_gla_kv(LAS unsigned char* lds, const Ctx& a, int vcu, int G) {
    const int tid = otid();
    const bf16* proj = (const bf16*)(a.ws + WS_H); bf16* state = (bf16*)(a.ws + WS_STATE); float* dec = (float*)(a.ws + WS_DEC);
    LAS float* KE = (LAS float*)lds;
    LAS float* V = KE + 64 * 128;
    LAS float* TOT = V + 64 * 256;
    for (int u = vcu; u < NB * GLA_H * GLA_NC; u += G) {
        const int n = u % GLA_NC, bh = u / GLA_NC, h = bh % GLA_H, b = bh / GLA_H;
        const int row0 = b * T + n * GLA_C;
        GlaCum c; gla_cumsum(c, proj, row0, h, TOT, tid);
        const int cp = tid & 63, part = tid >> 6;
#pragma unroll
        for (int i = 0; i < 8; ++i) { const int t = 8 * part + i; const unsigned w = *(const unsigned*)(proj + (size_t)(row0 + t) * GLA_PITCH + 512 + h * 128 + 2 * cp);
            KE[t * 128 + 2 * cp] = bflo(w) * __expf(c.tot0 - c.b0[i]); KE[t * 128 + 2 * cp + 1] = bfhi(w) * __expf(c.tot1 - c.b1[i]); }
        if (part == 0) { dec[(size_t)u * 128 + 2 * cp] = __expf(c.tot0); dec[(size_t)u * 128 + 2 * cp + 1] = __expf(c.tot1); }
        { const int vp = tid & 127, rp = tid >> 7;
#pragma unroll
          for (int i = 0; i < 16; ++i) { const int t = 16 * rp + i; const unsigned w = *(const unsigned*)(proj + (size_t)(row0 + t) * GLA_PITCH + 1024 + h * 256 + 2 * vp);
              V[t * 256 + 2 * vp] = bflo(w); V[t * 256 + 2 * vp + 1] = bfhi(w); } }
        __syncthreads();
        const int vd = tid & 255, kh = tid >> 8;
        float acc[64];
#pragma unroll
        for (int j = 0; j < 64; ++j) acc[j] = 0.f;
        for (int t = 0; t < 64; ++t) { const float v = V[t * 256 + vd];
#pragma unroll
            for (int j = 0; j < 64; ++j) acc[j] += KE[t * 128 + kh * 64 + j] * v; }
        bf16* sp = state + ((size_t)u * 256 + vd) * 128 + kh * 64;
#pragma unroll
        for (int j = 0; j < 64; j += 8) { v4u w; w.x = pk2(acc[j], acc[j + 1]); w.y = pk2(acc[j + 2], acc[j + 3]); w.z = pk2(acc[j + 4], acc[j + 5]); w.w = pk2(acc[j + 6], acc[j + 7]); *(v4u*)(sp + j) = w; }
        __syncthreads();
    }
}
__device__ __forceinline__ void phase_gla_scan(const Ctx& a, int vcu, int G) {
    unsigned* state = (unsigned*)(a.ws + WS_STATE); const float* dec = (const float*)(a.ws + WS_DEC);
    for (int gid = vcu * NTHR + otid(); gid < NB * GLA_H * 16384; gid += G * NTHR) {
        const int bh = gid >> 14, e = gid & 16383, kp = e & 63;
        unsigned* sp = state + (size_t)bh * GLA_NC * 16384 + e;
        const float* dp = dec + (size_t)bh * GLA_NC * 128 + 2 * kp;
        float s0 = 0.f, s1 = 0.f;
        for (int n0 = 0; n0 < GLA_NC; n0 += 8) {
            unsigned w[8]; float d0[8], d1[8];
#pragma unroll
            for (int i = 0; i < 8; ++i) { w[i] = sp[(size_t)(n0 + i) * 16384]; d0[i] = dp[(n0 + i) * 128]; d1[i] = dp[(n0 + i) * 128 + 1]; }
#pragma unroll
            for (int i = 0; i < 8; ++i) { sp[(size_t)(n0 + i) * 16384] = pk2(s0, s1); s0 = d0[i] * s0 + bflo(w[i]); s1 = d1[i] * s1 + bfhi(w[i]); }
        }
    }
}
__device__ __forceinline__ void phase_gla_out(LAS unsigned char* lds, const Ctx& a, const LayerP& P, int vcu, int G) {
    const int tid = otid(), lane = tid & 63, wave = tid >> 6;
    bf16* proj = (bf16*)(a.ws + WS_H); const bf16* state = (const bf16*)(a.ws + WS_STATE);
    LAS float* QD = (LAS float*)lds;
    LAS float* KI = QD + 64 * 128;
    LAS float* ATT = KI + 64 * 128;
    LAS unsigned* Vb = (LAS unsigned*)(ATT + 64 * 64);
    LAS float* TOT = (LAS float*)(Vb + 64 * 128);
    LAS float* RSS = TOT + 8 * 128;
    for (int u = vcu; u < NB * GLA_H * GLA_NC; u += G) {
        const int n = u % GLA_NC, bh = u / GLA_NC, h = bh % GLA_H, b = bh / GLA_H;
        const int row0 = b * T + n * GLA_C;
        GlaCum c; gla_cumsum(c, proj, row0, h, TOT, tid);
        const int cp = tid & 63, part = tid >> 6;
#pragma unroll
        for (int i = 0; i < 8; ++i) { const int t = 8 * part + i;
            const unsigned wq = *(const unsigned*)(proj + (size_t)(row0 + t) * GLA_PITCH + h * 128 + 2 * cp);
            const unsigned wk = *(const unsigned*)(proj + (size_t)(row0 + t) * GLA_PITCH + 512 + h * 128 + 2 * cp);
            const float e0 = __expf(c.b0[i]), e1 = __expf(c.b1[i]);
            QD[t * 128 + 2 * cp] = bflo(wq) * 0.08838834764831845f * e0; QD[t * 128 + 2 * cp + 1] = bfhi(wq) * 0.08838834764831845f * e1;
            KI[t * 128 + 2 * cp] = bflo(wk) / e0; KI[t * 128 + 2 * cp + 1] = bfhi(wk) / e1; }
        { const int vp = tid & 127, rp = tid >> 7;
#pragma unroll
          for (int i = 0; i < 16; ++i) { const int t = 16 * rp + i; Vb[t * 128 + vp] = *(const unsigned*)(proj + (size_t)(row0 + t) * GLA_PITCH + 1024 + h * 256 + 2 * vp); } }
        __syncthreads();
        { const int cc = tid >> 3, s0 = (tid & 7) * 8; float acc[8];
#pragma unroll
          for (int j = 0; j < 8; ++j) acc[j] = 0.f;
          for (int d = 0; d < 128; ++d) { const float q = QD[cc * 128 + d];
#pragma unroll
              for (int j = 0; j < 8; ++j) acc[j] += q * KI[(s0 + j) * 128 + d]; }
#pragma unroll
          for (int j = 0; j < 8; ++j) ATT[cc * 64 + s0 + j] = (s0 + j <= cc) ? acc[j] : 0.f; }
        __syncthreads();
        const int vd = tid & 255, ch = tid >> 8;
        float acc[32];
#pragma unroll
        for (int j = 0; j < 32; ++j) acc[j] = 0.f;
        for (int s = 0; s < 64; ++s) { const unsigned w = Vb[s * 128 + (vd >> 1)]; const float v = (vd & 1) ? bfhi(w) : bflo(w);
#pragma unroll
            for (int j = 0; j < 32; ++j) acc[j] += ATT[(ch * 32 + j) * 64 + s] * v; }
        { const bf16* sp = state + ((size_t)u * 256 + vd) * 128;
          for (int d0 = 0; d0 < 128; d0 += 8) { const v4u w = *(const v4u*)(sp + d0);
              const float st[8] = {bflo(w.x), bfhi(w.x), bflo(w.y), bfhi(w.y), bflo(w.z), bfhi(w.z), bflo(w.w), bfhi(w.w)};
#pragma unroll
              for (int dd = 0; dd < 8; ++dd) {
#pragma unroll
                  for (int j = 0; j < 32; ++j) acc[j] += QD[(ch * 32 + j) * 128 + d0 + dd] * st[dd]; } } }
#pragma unroll
        for (int j = 0; j < 32; ++j) { const float s = wave_sum(acc[j] * acc[j]); if (lane == 0) RSS[wave * 32 + j] = s; }
        __syncthreads();
        const float hn = P.e3[vd];
#pragma unroll
        for (int j = 0; j < 32; ++j) { const int cc = ch * 32 + j;
            const float ss = (RSS[(ch * 4 + 0) * 32 + j] + RSS[(ch * 4 + 1) * 32 + j]) + (RSS[(ch * 4 + 2) * 32 + j] + RSS[(ch * 4 + 3) * 32 + j]);
            const float rs = 1.0f / sqrtf(ss * (1.0f / 256.0f) + EPS);
            const float g = bf2f(proj[(size_t)(row0 + cc) * GLA_PITCH + 2048 + h * 256 + vd]);
            const float o = acc[j] * rs * hn * (g / (1.f + __expf(-g)));
            proj[(size_t)(row0 + cc) * GLA_PITCH + 1024 + h * 256 + vd] = (bf16)f2bf(o); }
        __syncthreads();
    }
}

__device__ __forceinline__ void phase_sgu(LAS unsigned char* lds, const Ctx& a, const LayerP& P, int vcu, int G) {
    const int tid = otid();
    bf16* proj = (bf16*)(a.ws + WS_H); const float* vssq = (const float*)(a.ws + WS_VSSQ);
    const float* v_norm = P.e1; const float* w_s = P.e2; const float* b_s = P.e3;
    LAS float* W = (LAS float*)lds;
    LAS float* V = W + 128 * 128;
    for (int u = vcu; u < NB * (T / SGU_C) * SGU_G; u += G) {
        const int g = u % SGU_G, bc = u / SGU_G;
        const int row0 = bc * SGU_C;
        for (int e = tid; e < 128 * 128; e += NTHR) { const int t = e >> 7, s = e & 127;
            const float rs = row_rstd(vssq, row0 + s);
            W[e] = (s <= t) ? w_s[(size_t)g * 16384 + e] * rs : 0.f;
            V[e] = bf2f(proj[(size_t)(row0 + t) * SGU_PITCH + 1024 + g * 128 + s]); }
        __syncthreads();
        const int d = tid & 127, tq = tid >> 7;
        float acc[32];
#pragma unroll
        for (int j = 0; j < 32; ++j) acc[j] = 0.f;
        for (int s = 0; s < 128; ++s) { const float v = V[s * 128 + d];
#pragma unroll
            for (int j = 0; j < 32; ++j) acc[j] += W[(tq + 4 * j) * 128 + s] * v; }
        const float vn = v_norm[g * 128 + d];
#pragma unroll
        for (int j = 0; j < 32; ++j) { const int t = tq + 4 * j;
            const float sv = vn * acc[j] + b_s[g * 128 + t];
            bf16* up = proj + (size_t)(row0 + t) * SGU_PITCH + g * 128 + d;
            *up = (bf16)f2bf(bf2f(*up) * sv); }
        __syncthreads();
    }
}

__device__ __forceinline__ void phase_diff(LAS unsigned char* lds, const Ctx& a, const LayerP& P, int vcu, int G) {
    const int tid = otid(), lane = tid & 63, wave = tid >> 6;
    bf16* proj = (bf16*)(a.ws + WS_H);
    LAS float* Ks = (LAS float*)lds;
    LAS float* Vs = Ks + 64 * 132;
    LAS float* Qs = Vs + 64 * 128;
    LAS float* Ps = Qs + 32 * 128;
    float lam;
    { float s1 = 0.f, s2 = 0.f;
      for (int i = 0; i < 64; ++i) { s1 += P.e0[i] * P.e1[i]; s2 += P.e2[i] * P.e3[i]; }
      lam = __expf(s1) - __expf(s2) + LAMBDA_INIT; }
    const float* head_norm = P.e4;
    const int NU = NB * DIFF_H * (T / 32);
    for (int u = vcu; u < NU; u += G) {
        const int qb = (T / 32 - 1) - (u / (NB * DIFF_H)), bh = u % (NB * DIFF_H), h = bh % DIFF_H, b = bh / DIFF_H;
        const int q0 = qb * 32; const size_t rowbase = (size_t)b * T;
        const float slope2 = exp2f(-(float)(h + 1)) * LOG2E;
        __syncthreads();
        for (int e = tid; e < 32 * 64; e += NTHR) { const int r = e >> 6, c2 = e & 63;
            const unsigned w = *(const unsigned*)(proj + (rowbase + q0 + r) * DIFF_PITCH + h * 128 + 2 * c2);
            Qs[r * 128 + 2 * c2] = bflo(w); Qs[r * 128 + 2 * c2 + 1] = bfhi(w); }
        float m1[4], l1[4], m2[4], l2[4], oa1[4], ob1[4], oa2[4], ob2[4];
#pragma unroll
        for (int i = 0; i < 4; ++i) { m1[i] = -1e30f; m2[i] = -1e30f; l1[i] = 0.f; l2[i] = 0.f; oa1[i] = 0.f; ob1[i] = 0.f; oa2[i] = 0.f; ob2[i] = 0.f; }
        const int ntile = (q0 + 31) / 64 + 1;
        for (int kt = 0; kt < ntile; ++kt) {
            __syncthreads();
            for (int e = tid; e < 64 * 64; e += NTHR) { const int r = e >> 6, c2 = e & 63;
                const unsigned wk = *(const unsigned*)(proj + (rowbase + kt * 64 + r) * DIFF_PITCH + 1024 + h * 128 + 2 * c2);
                const unsigned wv = *(const unsigned*)(proj + (rowbase + kt * 64 + r) * DIFF_PITCH + 2048 + h * 128 + 2 * c2);
                Ks[r * 132 + 2 * c2] = bflo(wk); Ks[r * 132 + 2 * c2 + 1] = bfhi(wk);
                Vs[r * 128 + 2 * c2] = bflo(wv); Vs[r * 128 + 2 * c2 + 1] = bfhi(wv); }
            __syncthreads();
            const int kpos = kt * 64 + lane;
#pragma unroll
            for (int i = 0; i < 4; ++i) {
                const int r = wave + 8 * i, qpos = q0 + r;
                if (kt * 64 > qpos) continue;
                float s1 = 0.f, s2 = 0.f;
                const LAS f32x4* qp = (const LAS f32x4*)(Qs + r * 128); const LAS f32x4* kp = (const LAS f32x4*)(Ks + lane * 132);
#pragma unroll
                for (int d = 0; d < 16; ++d) { const f32x4 q = qp[d], k = kp[d]; s1 += (q.x * k.x + q.y * k.y) + (q.z * k.z + q.w * k.w); }
#pragma unroll
                for (int d = 16; d < 32; ++d) { const f32x4 q = qp[d], k = kp[d]; s2 += (q.x * k.x + q.y * k.y) + (q.z * k.z + q.w * k.w); }
                const float bias = slope2 * (float)(qpos - kpos);
                const bool ok = kpos <= qpos;
                s1 = ok ? s1 - bias : -1e30f; s2 = ok ? s2 - bias : -1e30f;
                const float mn1 = fmaxf(m1[i], wave_max(s1)), mn2 = fmaxf(m2[i], wave_max(s2));
                const float p1 = ok ? exp2f(s1 - mn1) : 0.f, p2 = ok ? exp2f(s2 - mn2) : 0.f;
                const float a1 = exp2f(m1[i] - mn1), a2 = exp2f(m2[i] - mn2);
                l1[i] = l1[i] * a1 + wave_sum(p1); l2[i] = l2[i] * a2 + wave_sum(p2); m1[i] = mn1; m2[i] = mn2;
                Ps[wave * 128 + lane] = p1; Ps[wave * 128 + 64 + lane] = p2;
                LDS_WAIT();
                float x1 = 0.f, y1 = 0.f, x2 = 0.f, y2 = 0.f;
                for (int j = 0; j < 64; ++j) { const float pa = Ps[wave * 128 + j], pb = Ps[wave * 128 + 64 + j]; const float va = Vs[j * 128 + lane], vb = Vs[j * 128 + 64 + lane];
                    x1 += pa * va; y1 += pa * vb; x2 += pb * va; y2 += pb * vb; }
                oa1[i] = oa1[i] * a1 + x1; ob1[i] = ob1[i] * a1 + y1; oa2[i] = oa2[i] * a2 + x2; ob2[i] = ob2[i] * a2 + y2;
                LDS_WAIT();
            }
        }
#pragma unroll
        for (int i = 0; i < 4; ++i) {
            const int r = wave + 8 * i;
            const float oa = oa1[i] / l1[i] - lam * (oa2[i] / l2[i]), ob = ob1[i] / l1[i] - lam * (ob2[i] / l2[i]);
            const float ss = wave_sum(oa * oa + ob * ob);
            const float rs = (1.0f / sqrtf(ss * (1.0f / 128.0f) + EPS)) * (1.0f - LAMBDA_INIT);
            bf16* op = proj + (rowbase + q0 + r) * DIFF_PITCH + h * 128;
            op[lane] = (bf16)f2bf(oa * rs * head_norm[lane]); op[64 + lane] = (bf16)f2bf(ob * rs * head_norm[64 + lane]);
        }
    }
}

namespace pg8 {
#define PG8_LAS __attribute__((address_space(3)))
typedef unsigned short bf16_t;
typedef short bf16x8 __attribute__((ext_vector_type(8)));
typedef float f32x4 __attribute__((ext_vector_type(4)));
typedef unsigned u32x4 __attribute__((ext_vector_type(4)));
constexpr int BM = 256, BK = 64, HALF = 128, HTB = HALF * BK * 2  , STAGE_BYTES = 8 * HTB, NXCD = 8, WGM = 8;

__host__ __device__ __forceinline__ int lds_byte(int r, int c) { const int st = (r >> 4) * 2 + (c >> 5), rr = r & 15, cc = c & 31, ob = rr * 64 + cc * 2; return st * 1024 + (ob ^ (((ob >> 9) & 1) << 5)); }
__host__ __device__ __forceinline__ void stage_rc(int b, int& R, int& C) { const int st = b / 1024, sb = b % 1024, swz = sb ^ (((sb >> 9) & 1) << 5); R = (st >> 1) * 16 + swz / 64; C = (st & 1) * 32 + (swz % 64) / 2; }
__host__ __device__ __forceinline__ int perm32(int rho) { const int n = rho >> 4, i = rho & 15; return 8 * (i >> 2) + 4 * n + (i & 3); }

struct Unit { int pm, pn; };
struct Gemm { const bf16_t* A; int lda; const bf16_t* Bt; int M, N, K; };

struct StaticOrder {
    int nM, nN, nwg, G, c;
    __host__ __device__ void init(int M, int N, int G_, int c_) { nM = M / BM; nN = N / BM; nwg = nM * nN; G = G_; c = c_; }
    __host__ __device__ bool next(int i, Unit& u) const {
        const long L = (long)i * G + c; if (L >= nwg) return false;
        int wgid = (int)L; { const int q = nwg / NXCD, r = nwg % NXCD, xcd = wgid % NXCD, off = wgid / NXCD; wgid = (xcd < r ? xcd * (q + 1) : r * (q + 1) + (xcd - r) * q) + off; }
        const int nig = WGM * nN, gid = wgid / nig, fm = gid * WGM, gsz = (nM - fm) < WGM ? (nM - fm) : WGM;
        u.pm = fm + ((wgid % nig) % gsz); u.pn = (wgid % nig) / gsz; return true;
    }
    __device__ __forceinline__ void a_ready(const Unit&) const {}
    __device__ __forceinline__ void done(const Unit&) const {}
};

template <class Epi, class Sched, bool ALIGN_EPI = false, bool SP2 = false>
__device__ __forceinline__ void gemm_phase(PG8_LAS unsigned char* lds, const Gemm g, const Sched& S, const Epi& E) {
    const int tid = otid(), wid = __builtin_amdgcn_readfirstlane(tid >> 6), lane = tid & 63, wr = wid >> 2, wc = wid & 3, fr = lane & 15, fq = lane >> 4;
    const int K = g.K, nt = K / BK, lda = g.lda;
    unsigned voffA[2], voffB[2];
#pragma unroll
    for (int i = 0; i < 2; ++i) { int R, C; stage_rc(tid * 16 + i * 8192, R, C); const int Rb = Epi::PERM ? ((R & ~31) + perm32(R & 31)) : R;
        voffA[i] = (unsigned)(R * lda + C) * 2u; voffB[i] = (unsigned)(Rb * K + C) * 2u; }
    const size_t kstep = (size_t)(BK * 2);
    const size_t hstepA = (size_t)HALF * lda * 2, hstepB = (size_t)HALF * K * 2;
    const size_t tstepA = 2 * hstepA, tstepB = 2 * hstepB;
    const unsigned ldsw = (unsigned)wid * 1024u;
    const int aoff = lds_byte(wr * 64 + fr, fq * 8), boff = lds_byte(wc * 32 + fr, fq * 8);
#define PG8_SA(b, h) (((b) * 2 + (h)) * HTB)
#define PG8_SB(b, h) ((4 + (b) * 2 + (h)) * HTB)
#define PG8_STAGE(bufoff, gbase, voff) do { _Pragma("unroll") for (int _i = 0; _i < 2; ++_i) \
        __builtin_amdgcn_global_load_lds((const unsigned*)((const char*)(gbase) + (voff)[_i]), (PG8_LAS unsigned*)(lds + (bufoff) + ldsw + _i * 8192), 16, 0, 0); } while (0)
#define PG8_LDA(dst, b, h) do { _Pragma("unroll") for (int m = 0; m < 4; ++m) _Pragma("unroll") for (int k = 0; k < 2; ++k) dst[m][k] = *(const PG8_LAS bf16x8*)(lds + PG8_SA(b, h) + aoff + m * 2048 + k * 1024); } while (0)
#define PG8_LDB(dst, b, h) do { _Pragma("unroll") for (int n = 0; n < 2; ++n) _Pragma("unroll") for (int k = 0; k < 2; ++k) dst[n][k] = *(const PG8_LAS bf16x8*)(lds + PG8_SB(b, h) + boff + n * 2048 + k * 1024); } while (0)
#define PG8_MMA(ai, bj, At, Bt) do { __builtin_amdgcn_s_setprio(1); _Pragma("unroll") for (int m = 0; m < 4; ++m) _Pragma("unroll") for (int n = 0; n < 2; ++n) _Pragma("unroll") for (int k = 0; k < 2; ++k) \
        acc[ai][bj][m][n] = __builtin_amdgcn_mfma_f32_16x16x32_bf16(Bt[n][k], At[m][k], acc[ai][bj][m][n], 0, 0, 0); __builtin_amdgcn_s_setprio(0); } while (0)
#define PG8_WAIT_V(n) asm volatile("s_waitcnt vmcnt(" #n ")" ::: "memory")
#define PG8_WAIT_L(n) asm volatile("s_waitcnt lgkmcnt(" #n ")" ::: "memory")
#define PG8_BAR __builtin_amdgcn_s_barrier()
#define PG8_SCHED __builtin_amdgcn_sched_barrier(0)
    Unit cur, nxt; int ui = 0;
    if (!S.next(0, cur)) return;
    f32x4 acc[2][2][4][2];
#pragma unroll
    for (int a = 0; a < 2; ++a)
#pragma unroll
        for (int b = 0; b < 2; ++b)
#pragma unroll
            for (int m = 0; m < 4; ++m)
#pragma unroll
                for (int n = 0; n < 2; ++n) acc[a][b][m][n] = (f32x4){0.f, 0.f, 0.f, 0.f};
    bf16x8 At[4][2], B0[2][2], B1[2][2];
    const char* cA = (const char*)g.A + (size_t)cur.pm * tstepA; const char* cB = (const char*)g.Bt + (size_t)cur.pn * tstepB;
    S.a_ready(cur);
    if constexpr (SP2) {
        PG8_STAGE(PG8_SB(0, 0), cB, voffB); PG8_STAGE(PG8_SB(0, 1), cB + hstepB, voffB); PG8_STAGE(PG8_SA(0, 0), cA, voffA); PG8_STAGE(PG8_SA(0, 1), cA + hstepA, voffA);
        if (wr == 1) PG8_BAR;
        PG8_WAIT_V(2); PG8_BAR;
        PG8_STAGE(PG8_SB(1, 0), cB + kstep, voffB); PG8_STAGE(PG8_SA(1, 0), cA + kstep, voffA); PG8_STAGE(PG8_SB(1, 1), cB + hstepB + kstep, voffB);
        PG8_WAIT_V(6); PG8_BAR;
    } else {
        PG8_STAGE(PG8_SB(0, 0), cB, voffB); PG8_STAGE(PG8_SA(0, 0), cA, voffA); PG8_STAGE(PG8_SB(0, 1), cB + hstepB, voffB); PG8_STAGE(PG8_SA(0, 1), cA + hstepA, voffA);
        if (wr == 1) PG8_BAR;
        PG8_WAIT_V(4); PG8_BAR;
        PG8_STAGE(PG8_SB(1, 0), cB + kstep, voffB); PG8_STAGE(PG8_SA(1, 0), cA + kstep, voffA); PG8_STAGE(PG8_SB(1, 1), cB + hstepB + kstep, voffB);
        PG8_WAIT_V(6); PG8_BAR;
    }
    for (;;) {
        const bool has_next = S.next(ui + 1, nxt);
        const char* nA = has_next ? (const char*)g.A + (size_t)nxt.pm * tstepA : cA; const char* nB = has_next ? (const char*)g.Bt + (size_t)nxt.pn * tstepB : cB;
        for (int t = 0; t < nt; t += 2) {
            const bool last = (t == nt - 2);
            const char* a1 = cA + (size_t)(t + 1) * kstep;
            const char* a2 = last ? nA : cA + (size_t)(t + 2) * kstep; const char* b2 = last ? nB : cB + (size_t)(t + 2) * kstep;
            const char* a3 = a2 + kstep; const char* b3 = b2 + kstep;
            if (last && has_next) S.a_ready(nxt);
            if constexpr (SP2) {
            PG8_LDB(B0, 0, 0); PG8_LDB(B1, 0, 1); PG8_SCHED; PG8_LDA(At, 0, 0); PG8_STAGE(PG8_SA(1, 1), a1 + hstepA, voffA);
            PG8_WAIT_V(8); PG8_WAIT_L(0); PG8_BAR; PG8_MMA(0, 0, At, B0); PG8_MMA(0, 1, At, B1); PG8_BAR; PG8_SCHED;
            PG8_LDA(At, 0, 1); PG8_STAGE(PG8_SB(0, 0), b2, voffB); PG8_STAGE(PG8_SB(0, 1), b2 + hstepB, voffB); PG8_STAGE(PG8_SA(0, 0), a2, voffA);
            PG8_WAIT_V(8); PG8_WAIT_L(0); PG8_BAR; PG8_MMA(1, 0, At, B0); PG8_MMA(1, 1, At, B1); PG8_BAR; PG8_SCHED;
            PG8_LDB(B0, 1, 0); PG8_LDB(B1, 1, 1); PG8_SCHED; PG8_LDA(At, 1, 0); PG8_STAGE(PG8_SA(0, 1), a2 + hstepA, voffA);
            PG8_WAIT_V(8); PG8_WAIT_L(0); PG8_BAR; PG8_MMA(0, 0, At, B0); PG8_MMA(0, 1, At, B1); PG8_BAR; PG8_SCHED;
            PG8_LDA(At, 1, 1); PG8_STAGE(PG8_SB(1, 0), b3, voffB); PG8_STAGE(PG8_SB(1, 1), b3 + hstepB, voffB); PG8_STAGE(PG8_SA(1, 0), a3, voffA);
            PG8_WAIT_V(8); PG8_WAIT_L(0); PG8_BAR; PG8_MMA(1, 0, At, B0); PG8_MMA(1, 1, At, B1); PG8_BAR; PG8_SCHED;
            } else {
            PG8_LDB(B0, 0, 0); PG8_SCHED; PG8_LDA(At, 0, 0); PG8_STAGE(PG8_SA(1, 1), a1 + hstepA, voffA);
            PG8_WAIT_L(8); PG8_BAR; PG8_WAIT_L(0); PG8_MMA(0, 0, At, B0); PG8_BAR; PG8_SCHED;
            PG8_LDB(B1, 0, 1); PG8_STAGE(PG8_SB(0, 0), b2, voffB);
            PG8_BAR; PG8_WAIT_L(0); PG8_MMA(0, 1, At, B1); PG8_BAR;
            PG8_LDA(At, 0, 1); PG8_STAGE(PG8_SA(0, 0), a2, voffA);
            PG8_BAR; PG8_WAIT_L(0); PG8_MMA(1, 0, At, B0); PG8_BAR; PG8_SCHED;
            PG8_STAGE(PG8_SB(0, 1), b2 + hstepB, voffB);
            PG8_WAIT_V(6); PG8_BAR; PG8_MMA(1, 1, At, B1); PG8_BAR;
            PG8_LDB(B0, 1, 0); PG8_SCHED; PG8_LDA(At, 1, 0); PG8_STAGE(PG8_SA(0, 1), a2 + hstepA, voffA);
            PG8_WAIT_L(8); PG8_BAR; PG8_WAIT_L(0); PG8_MMA(0, 0, At, B0); PG8_BAR; PG8_SCHED;
            PG8_LDB(B1, 1, 1); PG8_STAGE(PG8_SB(1, 0), b3, voffB);
            PG8_BAR; PG8_WAIT_L(0); PG8_MMA(0, 1, At, B1); PG8_BAR;
            PG8_LDA(At, 1, 1); PG8_STAGE(PG8_SA(1, 0), a3, voffA);
            PG8_BAR; PG8_WAIT_L(0); PG8_MMA(1, 0, At, B0); PG8_BAR; PG8_SCHED;
            PG8_STAGE(PG8_SB(1, 1), b3 + hstepB, voffB);
            PG8_WAIT_V(6); PG8_BAR; PG8_MMA(1, 1, At, B1); PG8_BAR;
            }
        }
        if constexpr (ALIGN_EPI) { if (wr == 0) PG8_BAR; }
        if constexpr (!Epi::AFTER_DRAIN) { E(acc, cur, wr, wc, fr, fq); S.done(cur); }
        if (!has_next) break;
#pragma unroll
        for (int a = 0; a < 2; ++a)
#pragma unroll
            for (int b = 0; b < 2; ++b)
#pragma unroll
                for (int m = 0; m < 4; ++m)
#pragma unroll
                    for (int n = 0; n < 2; ++n) acc[a][b][m][n] = (f32x4){0.f, 0.f, 0.f, 0.f};
        cur = nxt; cA = nA; cB = nB; ++ui;
        if constexpr (ALIGN_EPI) { if (wr == 1) PG8_BAR; }
    }
    PG8_WAIT_V(0);
    if constexpr (!ALIGN_EPI) { if (wr == 0) PG8_BAR; }
    PG8_BAR;
    if constexpr (Epi::AFTER_DRAIN) { E.fused(acc, cur, wr, wc, fr, fq, lds, wid, lane); S.done(cur); }
#undef PG8_SA
#undef PG8_SB
#undef PG8_STAGE
#undef PG8_LDA
#undef PG8_LDB
#undef PG8_MMA
#undef PG8_WAIT_V
#undef PG8_WAIT_L
#undef PG8_BAR
#undef PG8_SCHED
}
}

template <class Core> struct EpiMfma {
    static constexpr bool PERM = true, AFTER_DRAIN = false;
    Core c;
    __device__ __forceinline__ void operator()(const pg8::f32x4 (&acc)[2][2][4][2], const pg8::Unit& u, int wr, int wc, int fr, int fq) const {
        float gmax[2] = {0.f, 0.f};
#pragma unroll
        for (int ai = 0; ai < 2; ++ai)
#pragma unroll
            for (int m = 0; m < 4; ++m) {
                const int row = u.pm * 256 + ai * 128 + wr * 64 + m * 16 + fr;
                const float rs = c.rowscale(row);
                float part = 0.f;
#pragma unroll
                for (int bj = 0; bj < 2; ++bj) {
                    const int col0 = u.pn * 256 + bj * 128 + wc * 32 + 8 * fq;
                    const float v[8] = {acc[ai][bj][m][0][0], acc[ai][bj][m][0][1], acc[ai][bj][m][0][2], acc[ai][bj][m][0][3],
                                        acc[ai][bj][m][1][0], acc[ai][bj][m][1][1], acc[ai][bj][m][1][2], acc[ai][bj][m][1][3]};
                    const float p = c.apply8(row, col0, v, rs);
                    part += p;
                    if (Core::GROUPMAX) { float q = p; q += __shfl_xor(q, 16); q += __shfl_xor(q, 32); gmax[bj] = fmaxf(gmax[bj], q); }
                }
                part += __shfl_xor(part, 16); part += __shfl_xor(part, 32);
                if (fq == 0) c.store_part(row, u.pn * 256, (u.pn & 3) * 4 + wc, part);
            }
        if (Core::GROUPMAX) {
#pragma unroll
            for (int bj = 0; bj < 2; ++bj) { const int colg = u.pn * 256 + bj * 128 + wc * 32;
                if (c.want_groupmax(colg)) { const float m = wave_max(gmax[bj]); if (fr == 0 && fq == 0) c.store_groupmax(u.pm * 256, colg, m); } }
        }
    }
};
#ifndef USE_MFMA_GEMM
#define USE_MFMA_GEMM 1
#endif
template <class Core>
__device__ __forceinline__ void run_gemm(LAS unsigned char* lds, const bf16* A, int lda, const bf16* Bt, int M, int N, int K, const Core& c, int vcu, int G) {
#if USE_MFMA_GEMM
    int bxo = (int)blockIdx.x; asm volatile("" : "+s"(bxo));
    pg8::Gemm g{A, lda, Bt, M, N, K}; pg8::StaticOrder S; S.init(M, N, G, bxo);
    EpiMfma<Core> E{c};
    pg8::gemm_phase<EpiMfma<Core>, pg8::StaticOrder, true, true>(lds, g, S, E);
#else
    gemm_naive(lds, A, lda, Bt, M, N, K, c, vcu, G);
#endif
}

#include <hip/hip_bf16.h>
#include <cmath>
namespace attn_body {
using bf16=__hip_bfloat16;
using bf16x8=__attribute__((ext_vector_type(8)))short;
using s16x4=__attribute__((ext_vector_type(4)))short;
using f32x16=__attribute__((ext_vector_type(16)))float;
using u32x4=__attribute__((ext_vector_type(4)))unsigned;
constexpr int SEQ=8192,D=64,PQ=3072,PO=2048;
constexpr int NW=8,QBLK=32,QB=QBLK*NW,KVBLK=64,NQB=SEQ/QB;
__device__ __forceinline__ int crow(int r,int hi){return (r&3)+8*(r>>2)+4*hi;}
#define SBAR() __builtin_amdgcn_sched_barrier(0)
__device__ __forceinline__ void cmask(f32x16&p0,f32x16&p1,int jb,int qrel,int hi){
  const float NEG=-INFINITY; int kb=64*jb+4*hi;
  #pragma unroll
  for(int r=0;r<16;++r){int kv=kb+(r&3)+8*(r>>2); if(kv>qrel)p0[r]=NEG; if(kv+32>qrel)p1[r]=NEG;}
}

constexpr int NSLOT=3, SLOTB=8192;
constexpr int LDS_K=0, LDS_V=NSLOT*SLOTB, LDS_WS=2*NSLOT*SLOTB, LDS_OST=LDS_WS+NW*64*4, LDS_BYTES=LDS_OST+NW*4096;
constexpr float C2=0.125f*1.4426950408889634f;
__device__ __forceinline__ void glds16(const void*gsrc,unsigned lds_dst){unsigned keep;
  asm volatile("s_mov_b32 %0, m0\n\ts_mov_b32 m0, %2\n\ts_nop 0\n\tglobal_load_lds_dwordx4 %1, off\n\ts_mov_b32 m0, %0":"=&s"(keep):"v"(gsrc),"s"(lds_dst):"memory");}
__device__ __forceinline__ float max3f(float a,float b,float c){float r;asm("v_max3_f32 %0, %1, %2, %3":"=v"(r):"v"(a),"v"(b),"v"(c));return r;}
__device__ __forceinline__ float max2f(float a,float b){float r;asm("v_max_f32_e32 %0, %1, %2":"=v"(r):"v"(a),"v"(b));return r;}
__device__ __forceinline__ float fadd_s(float a,float b){float r;asm("v_add_f32_e32 %0, %1, %2":"=v"(r):"v"(a),"v"(b));return r;}
__device__ __forceinline__ float fsub_s(float a,float b){float r;asm("v_sub_f32_e32 %0, %1, %2":"=v"(r):"v"(a),"v"(b));return r;}
typedef float f32x2_t __attribute__((ext_vector_type(2))); typedef __bf16 bf16x2_t __attribute__((ext_vector_type(2)));
__device__ __forceinline__ unsigned cvtpk_s(float lo,float hi){f32x2_t v={lo,hi};bf16x2_t b=__builtin_convertvector(v,bf16x2_t);return __builtin_bit_cast(unsigned,b);}
#define WAIT_BAR(N) asm volatile("s_waitcnt vmcnt(" #N ") lgkmcnt(0)\n\ts_barrier":::"memory")

__device__ __forceinline__ void qkt(f32x16&p0,f32x16&p1,const char*Kslot,const bf16x8*qr,const f32x16&negm,int r32,int hi){
  const char*kb=Kslot+hi*1024+r32*16;
  #pragma unroll
  for(int d0=0;d0<4;++d0){
    const bf16x8 b0=*reinterpret_cast<const bf16x8*>(kb+d0*2048);
    const bf16x8 b1=*reinterpret_cast<const bf16x8*>(kb+d0*2048+512);
    if(d0==0){p0=__builtin_amdgcn_mfma_f32_32x32x16_bf16(b0,qr[0],negm,0,0,0);p1=__builtin_amdgcn_mfma_f32_32x32x16_bf16(b1,qr[0],negm,0,0,0);}
    else{p0=__builtin_amdgcn_mfma_f32_32x32x16_bf16(b0,qr[d0],p0,0,0,0);p1=__builtin_amdgcn_mfma_f32_32x32x16_bf16(b1,qr[d0],p1,0,0,0);}}
}
typedef __attribute__((address_space(3))) const char* lds_cptr;
typedef short v4i16_t __attribute__((ext_vector_type(4)));
__device__ __forceinline__ void kload8(bf16x8*kf,lds_cptr kp){
  kf[0]=*(const __attribute__((address_space(3))) bf16x8*)(kp);      kf[1]=*(const __attribute__((address_space(3))) bf16x8*)(kp+512);
  kf[2]=*(const __attribute__((address_space(3))) bf16x8*)(kp+2048); kf[3]=*(const __attribute__((address_space(3))) bf16x8*)(kp+2560);
  kf[4]=*(const __attribute__((address_space(3))) bf16x8*)(kp+4096); kf[5]=*(const __attribute__((address_space(3))) bf16x8*)(kp+4608);
  kf[6]=*(const __attribute__((address_space(3))) bf16x8*)(kp+6144); kf[7]=*(const __attribute__((address_space(3))) bf16x8*)(kp+6656);
}
__device__ __forceinline__ void kload2(bf16x8*kf,lds_cptr kp,int j){ kf[2*j]=*(const __attribute__((address_space(3))) bf16x8*)(kp+j*2048); kf[2*j+1]=*(const __attribute__((address_space(3))) bf16x8*)(kp+j*2048+512); }
__device__ __forceinline__ s16x4 vtr(lds_cptr p){ return __builtin_bit_cast(s16x4,__builtin_amdgcn_ds_read_tr16_b64_v4i16((__attribute__((address_space(3))) v4i16_t*)p)); }
__device__ __forceinline__ float rowmax(const f32x16&p0,const f32x16&p1){
  float a=max3f(p0[0],p0[1],p1[0]),b=max3f(p0[2],p0[3],p1[1]);a=max3f(a,p1[2],p1[3]);
  #pragma unroll
  for(int r=4;r<16;r+=4){a=max3f(a,p0[r],p0[r+1]);b=max3f(b,p0[r+2],p0[r+3]);a=max3f(a,p1[r],p1[r+1]);b=max3f(b,p1[r+2],p1[r+3]);}
  const float m=max2f(a,b);
  auto rr=__builtin_amdgcn_permlane32_swap(__float_as_uint(m),__float_as_uint(m),false,false);
  return max2f(__uint_as_float(rr[0]),__uint_as_float(rr[1]));
}
__device__ __forceinline__ void pv(f32x16*o,int vb,bf16x8 pa0,bf16x8 pa1,bf16x8 pa2,bf16x8 pa3){
  #pragma unroll
  for(int d0=0;d0<2;++d0){s16x4 lo[4],hi[4];
    #pragma unroll
    for(int ks=0;ks<4;++ks){
      asm volatile("ds_read_b64_tr_b16 %0,%1 offset:%c2":"=&v"(lo[ks]):"v"(vb),"i"(d0*4096+ks*1024):"memory");
      asm volatile("ds_read_b64_tr_b16 %0,%1 offset:%c2":"=&v"(hi[ks]):"v"(vb),"i"(d0*4096+ks*1024+512):"memory");}
    asm volatile("s_waitcnt lgkmcnt(0)":::"memory");SBAR();
    #define PK(k) (bf16x8){lo[k][0],lo[k][1],lo[k][2],lo[k][3],hi[k][0],hi[k][1],hi[k][2],hi[k][3]}
    o[d0]=__builtin_amdgcn_mfma_f32_32x32x16_bf16(pa0,PK(0),o[d0],0,0,0);
    o[d0]=__builtin_amdgcn_mfma_f32_32x32x16_bf16(pa1,PK(1),o[d0],0,0,0);
    o[d0]=__builtin_amdgcn_mfma_f32_32x32x16_bf16(pa2,PK(2),o[d0],0,0,0);
    o[d0]=__builtin_amdgcn_mfma_f32_32x32x16_bf16(pa3,PK(3),o[d0],0,0,0);
    #undef PK
  }
}

#ifndef ATTN_STORE16
#define ATTN_STORE16(p,v) (*(u32x4*)(p)=(v))
#endif
template<int THRL> __device__ __forceinline__ void attn_unit(int b,int qb,int t0,const bf16*Q,const bf16*K,const bf16*V,bf16*O,float slope2,char*shm){
  const int tid=otid(),lane=tid&63,r32=lane&31,hi=lane>>5; const int wid=__builtin_amdgcn_readfirstlane(tid>>6);
  const long rowbase=(long)b*SEQ; const int q0=qb*QB;
  const bf16*Qw=Q+(rowbase+q0+wid*QBLK)*PQ;
  const bf16*Kh=K+(rowbase+(long)t0*KVBLK)*PQ,*Vh=V+(rowbase+(long)t0*KVBLK)*PQ;
  const unsigned lds0=(unsigned)(uintptr_t)shm;
  float*wsf=(float*)(shm+LDS_WS)+wid*64;
  const bf16*ksrc=Kh+(long)lane*PQ+wid*8;
  const bf16*vsrc=Vh+(long)(16*(wid&3)+(lane>>2))*PQ+(wid>>2)*32+(lane&3)*8;
  const unsigned kdst=lds0+LDS_K+wid*1024, vdst=lds0+LDS_V+wid*1024;
  #define DMA_K(t,slot) glds16(ksrc+(long)(t)*KVBLK*PQ,(unsigned)__builtin_amdgcn_readfirstlane(kdst+(slot)))
  #define DMA_V(t,slot) glds16(vsrc+(long)(t)*KVBLK*PQ,(unsigned)__builtin_amdgcn_readfirstlane(vdst+(slot)))
  const int vb0=(int)(lds0+LDS_V)+((lane>>4)&1)*32+(lane&3)*8+(4*hi+((lane&15)>>2))*64;
  const char*Kbase=shm+LDS_K; bf16x8 kf[8];
  const lds_cptr shm3=(lds_cptr)shm; const lds_cptr kp0=shm3+LDS_K+hi*1024+r32*16; const lds_cptr vp0=shm3+LDS_V+((lane>>4)&1)*32+(lane&3)*8+(4*hi+((lane&15)>>2))*64;
  const int NT=(q0+QB)/KVBLK-t0;
  DMA_K(0,0);DMA_V(0,0);DMA_K(1,SLOTB);
  bf16x8 qr[4];
  #pragma unroll
  for(int d0=0;d0<4;++d0)qr[d0]=*reinterpret_cast<const bf16x8*>(&Qw[(long)r32*PQ+d0*16+hi*8]);
  float l_reg=0.f;f32x16 o[2];o[0]=f32x16{};o[1]=f32x16{};f32x16 negm;
  _Pragma("unroll") for(int r=0;r<16;++r)negm[r]=slope2*(float)crow(r,hi);
  asm volatile("":"+v"(negm)); const float b32=32.f*slope2, step64=64.f*slope2;
  const int qrel=wid*QBLK+r32;
  #define CMASK(P0,P1,t) do{int jb_=(t)-(NT-4); if(jb_>=0)cmask(P0,P1,jb_,qrel,hi);}while(0)
  bool resc=false;
  #define START(P0,P1) do{ const float rm=rowmax(P0,P1); resc=false; \
    { const float dl=rm; \
      _Pragma("unroll") for(int r=0;r<16;++r){P0[r]=fsub_s(P0[r],dl);P1[r]=fsub_s(P1[r],dl);} \
      const float adj_=step64-dl; _Pragma("unroll") for(int r=0;r<16;++r)negm[r]+=adj_; asm volatile("":"+v"(negm)); } \
    _Pragma("unroll") for(int r=0;r<16;++r)P0[r]=__builtin_amdgcn_exp2f(P0[r]); }while(0)
  #define RESC() do{ if(resc){ asm volatile("s_waitcnt lgkmcnt(0)":::"memory"); \
      _Pragma("unroll") for(int d_=0;d_<2;++d_) _Pragma("unroll") for(int r=0;r<16;++r)o[d_][r]*=wsf[crow(r,hi)]; } }while(0)
  f32x16 pA0,pA1,pB0,pB1;
  int sl_prev=0,sl_cur=0,sl_next=SLOTB;
  #define ROT() do{sl_prev=sl_cur;sl_cur=sl_next;sl_next=(sl_next==(NSLOT-1)*SLOTB)?0:sl_next+SLOTB;}while(0)
  DMA_K(2,2*SLOTB);
  WAIT_BAR(3);
  qkt(pA0,pA1,Kbase,qr,negm,r32,hi);asm volatile("s_nop 15\n\ts_nop 7":"+v"(pA0),"+v"(pA1));
  _Pragma("unroll") for(int r=0;r<16;++r)pA1[r]+=b32;
  CMASK(pA0,pA1,0);
  START(pA0,pA1);
  _Pragma("unroll") for(int r=0;r<16;++r)pA1[r]=__builtin_amdgcn_exp2f(pA1[r]);
  WAIT_BAR(0);
  DMA_K(3,0);DMA_V(1,SLOTB);
  ROT();
  kload8(kf,kp0+sl_cur);
  WAIT_BAR(2);
  s16x4 vlo[8],vhi[8]; u32x4 pw0,pw1,pw2,pw3;
  #define PKW(P,B) cvtpk_s(P[B],P[B+1])
  #define PAF(k) __builtin_bit_cast(bf16x8,pw##k)
  #define VFR(i) (bf16x8){vlo[i][0],vlo[i][1],vlo[i][2],vlo[i][3],vhi[i][0],vhi[i][1],vhi[i][2],vhi[i][3]}
  #define PIN(x) asm volatile("":"+v"(x))
  #define MX3(a,b,c) __builtin_fmaxf(__builtin_fmaxf((a),(b)),(c))
  #define GAPA(MF,A0,A1,A2,A3,W0,W1,PW) do{ MF; sacc+=A0; sacc+=A1; sacc+=A2; sacc+=A3; PIN(sacc); W0; W1; PIN(PW); SBAR(); }while(0)
  #define EX(v) __builtin_amdgcn_exp2f(v)
  #define GAPB(MF,X,B) do{ MF; X[B]=EX(X[B]); X[B+1]=EX(X[B+1]); X[B+2]=EX(X[B+2]); X[B+3]=EX(X[B+3]); PIN(X); SBAR(); }while(0)
  #define VRD(i) do{ vlo[i]=vtr(vp_+(((i)>>2)*4096+((i)&3)*1024)); vhi[i]=vtr(vp_+(((i)>>2)*4096+((i)&3)*1024+512)); }while(0)
  #define KRD(G,j) do{ if(G){ kload2(kf,kp0+sl_next,j); SBAR(); } }while(0)
  #define STEP(C0,C1,P0,P1,t,GK,GV,GL) do{ SBAR(); \
    const lds_cptr vp_=vp0+sl_prev; \
    VRD(0); SBAR(); float sacc=(P0[0]+P0[1]); \
    GAPA(C0=__builtin_amdgcn_mfma_f32_32x32x16_bf16(kf[0],qr[0],negm,0,0,0), P0[2],P0[3],P0[4],P0[5],     pw0[0]=PKW(P0,0), pw0[1]=PKW(P0,2), pw0); \
    VRD(4); SBAR(); GAPA(C1=__builtin_amdgcn_mfma_f32_32x32x16_bf16(kf[1],qr[0],negm,0,0,0), P0[6],P0[7],P0[8],P0[9],     pw0[2]=PKW(P0,4), pw0[3]=PKW(P0,6), pw0); \
    VRD(1); SBAR(); GAPA(C0=__builtin_amdgcn_mfma_f32_32x32x16_bf16(kf[2],qr[1],C0,0,0,0),   P0[10],P0[11],P0[12],P0[13], pw1[0]=PKW(P0,8), pw1[1]=PKW(P0,10), pw1); \
    VRD(5); SBAR(); GAPA(C1=__builtin_amdgcn_mfma_f32_32x32x16_bf16(kf[3],qr[1],C1,0,0,0),   P0[14],P0[15],P1[0],P1[1],   pw1[2]=PKW(P0,12),pw1[3]=PKW(P0,14), pw1); \
    VRD(2); SBAR(); GAPA(C0=__builtin_amdgcn_mfma_f32_32x32x16_bf16(kf[4],qr[2],C0,0,0,0),   P1[2],P1[3],P1[4],P1[5],     pw2[0]=PKW(P1,0), pw2[1]=PKW(P1,2), pw2); \
    VRD(6); SBAR(); GAPA(C1=__builtin_amdgcn_mfma_f32_32x32x16_bf16(kf[5],qr[2],C1,0,0,0),   P1[6],P1[7],P1[8],P1[9],     pw2[2]=PKW(P1,4), pw2[3]=PKW(P1,6), pw2); \
    VRD(3); SBAR(); GAPA(C0=__builtin_amdgcn_mfma_f32_32x32x16_bf16(kf[6],qr[3],C0,0,0,0),   P1[10],P1[11],P1[12],P1[13], pw3[0]=PKW(P1,8), pw3[1]=PKW(P1,10), pw3); \
    VRD(7); SBAR(); GAPA(C1=__builtin_amdgcn_mfma_f32_32x32x16_bf16(kf[7],qr[3],C1,0,0,0),   P1[14],P1[15],0.f,0.f,       pw3[2]=PKW(P1,12),pw3[3]=PKW(P1,14), pw3); \
    l_reg+=sacc; \
    if(GK){DMA_K((t)+3,sl_cur);} if(GV){DMA_V((t)+1,sl_next);} \
    _Pragma("unroll") for(int r=0;r<16;++r)C1[r]+=b32; \
    CMASK(C0,C1,t); \
    { float a=MX3(C0[0],C0[1],C1[0]),b=MX3(C0[2],C0[3],C1[1]); a=MX3(a,C1[2],C1[3]); \
      _Pragma("unroll") for(int r=4;r<16;r+=4){a=MX3(a,C0[r],C0[r+1]);b=MX3(b,C0[r+2],C0[r+3]);a=MX3(a,C1[r],C1[r+1]);b=MX3(b,C1[r+2],C1[r+3]);} \
      float rm=__builtin_fmaxf(a,b); { auto rr=__builtin_amdgcn_permlane32_swap(__float_as_uint(rm),__float_as_uint(rm),false,false); rm=__builtin_fmaxf(__uint_as_float(rr[0]),__uint_as_float(rr[1])); } \
      resc=false; float adj_=step64; \
      if(__any(rm>(float)THRL)){ const float dl=__builtin_fmaxf(rm,0.f); adj_-=dl; \
        _Pragma("unroll") for(int r=0;r<16;++r){C0[r]-=dl;C1[r]-=dl;} \
        const float f=__builtin_amdgcn_exp2f(-dl); l_reg*=f; if(hi==0)wsf[r32]=f; resc=true; } \
      _Pragma("unroll") for(int r=0;r<16;++r)negm[r]+=adj_; asm volatile("":"+v"(negm)); } \
    SBAR(); \
    GAPB(o[0]=__builtin_amdgcn_mfma_f32_32x32x16_bf16(PAF(0),VFR(0),o[0],0,0,0), C0,0); \
    GAPB(o[1]=__builtin_amdgcn_mfma_f32_32x32x16_bf16(PAF(0),VFR(4),o[1],0,0,0), C0,4); \
    KRD(GL,0); GAPB(o[0]=__builtin_amdgcn_mfma_f32_32x32x16_bf16(PAF(1),VFR(1),o[0],0,0,0), C0,8); \
    KRD(GL,1); GAPB(o[1]=__builtin_amdgcn_mfma_f32_32x32x16_bf16(PAF(1),VFR(5),o[1],0,0,0), C0,12); \
    KRD(GL,2); GAPB(o[0]=__builtin_amdgcn_mfma_f32_32x32x16_bf16(PAF(2),VFR(2),o[0],0,0,0), C1,0); \
    KRD(GL,3); GAPB(o[1]=__builtin_amdgcn_mfma_f32_32x32x16_bf16(PAF(2),VFR(6),o[1],0,0,0), C1,4); \
    GAPB(o[0]=__builtin_amdgcn_mfma_f32_32x32x16_bf16(PAF(3),VFR(3),o[0],0,0,0), C1,8); \
    GAPB(o[1]=__builtin_amdgcn_mfma_f32_32x32x16_bf16(PAF(3),VFR(7),o[1],0,0,0), C1,12); \
    }while(0)
  int t=1;
  #undef CMASK
  #define CMASK(P0,P1,t) do{}while(0)
  for(;t+5<NT;t+=2){
    STEP(pB0,pB1,pA0,pA1,t,true,true,true);     WAIT_BAR(2); RESC(); ROT();
    STEP(pA0,pA1,pB0,pB1,t+1,true,true,true);   WAIT_BAR(2); RESC(); ROT();
  }
  #undef CMASK
  #define CMASK(P0,P1,t) do{int jb_=(t)-(NT-4); if(jb_>=0)cmask(P0,P1,jb_,qrel,hi);}while(0)
  #define ENDW(tt) do{ if((tt)+3<NT){WAIT_BAR(2);} else if((tt)+2<NT){WAIT_BAR(1);} else {WAIT_BAR(0);} }while(0)
  for(;t+1<NT;t+=2){
    STEP(pB0,pB1,pA0,pA1,t,(t+3<NT),(t+1<NT),(t+1<NT));       ENDW(t);   RESC(); ROT();
    STEP(pA0,pA1,pB0,pB1,t+1,(t+4<NT),(t+2<NT),(t+2<NT));     ENDW(t+1); RESC(); ROT();
  }
  STEP(pB0,pB1,pA0,pA1,NT-1,false,false,false); RESC();
  { float sacc=pB0[0]+pB0[1]; _Pragma("unroll") for(int r=2;r<16;++r)sacc+=pB0[r]; _Pragma("unroll") for(int r=0;r<16;++r)sacc+=pB1[r]; l_reg+=sacc;
    pw0=(u32x4){PKW(pB0,0),PKW(pB0,2),PKW(pB0,4),PKW(pB0,6)};pw1=(u32x4){PKW(pB0,8),PKW(pB0,10),PKW(pB0,12),PKW(pB0,14)};pw2=(u32x4){PKW(pB1,0),PKW(pB1,2),PKW(pB1,4),PKW(pB1,6)};pw3=(u32x4){PKW(pB1,8),PKW(pB1,10),PKW(pB1,12),PKW(pB1,14)};
    SBAR(); pv(o,vb0+sl_cur,PAF(0),PAF(1),PAF(2),PAF(3)); }
  #undef PKW
  #undef PAF
  #undef VFR
  #undef PIN
  #undef MX3
  #undef GAPA
  #undef GAPB
  #undef EX
  #undef VRD
  #undef KRD
  #undef STEP
  #undef ENDW
  {auto rr=__builtin_amdgcn_permlane32_swap(__float_as_uint(l_reg),__float_as_uint(l_reg),false,false);l_reg=__uint_as_float(rr[0])+__uint_as_float(rr[1]);}
  if(hi==0)wsf[32+r32]=l_reg;asm volatile("s_waitcnt lgkmcnt(0)":::"memory");
  float rli[16];
  #pragma unroll
  for(int r=0;r<16;++r)rli[r]=__builtin_amdgcn_rcpf(wsf[32+crow(r,hi)]);
  bf16*Ow=O+(rowbase+q0+wid*QBLK)*PO;
  { bf16*stg=(bf16*)(shm+LDS_OST)+wid*2048;
    #pragma unroll
    for(int r=0;r<16;++r){const int orow=crow(r,hi);
      #pragma unroll
      for(int d0=0;d0<2;++d0)stg[orow*64+d0*32+r32]=__float2bfloat16(o[d0][r]*rli[r]);}
    asm volatile("s_waitcnt lgkmcnt(0)":::"memory");
    #pragma unroll
    for(int i=0;i<4;++i){const int row=i*8+(lane>>3),ch=lane&7; const u32x4 v=*(const u32x4*)(stg+row*64+ch*8); ATTN_STORE16(Ow+(long)row*PO+ch*8,v);} }
  asm volatile("s_waitcnt lgkmcnt(0)\n\ts_barrier":::"memory");
  #undef DMA_K
  #undef DMA_V
  #undef CMASK
  #undef START
  #undef RESC
  #undef ROT
}
constexpr int ATTN_LDS_BYTES=LDS_BYTES;
#undef SBAR
#undef WAIT_BAR
}

#ifndef USE_MFMA_ATTN
#define USE_MFMA_ATTN 1
#endif
__device__ __forceinline__ void phase_diff_mfma(char* shm, LAS unsigned char* lds, const Ctx& a, int vcu, int G) {
    bf16* proj = (bf16*)(a.ws + WS_H); bf16* o12 = (bf16*)(a.ws + WS_STATE);
    unsigned* ctl = (unsigned*)(a.ws + WS_CTL);
    volatile LAS unsigned* qslot = (volatile LAS unsigned*)(lds + MISC_OFF) + 16;
    for (;;) {
        const int tid = otid();
        if (tid == 0) *qslot = atomicAdd(ctl + CW_QUEUE, 1u);
        __syncthreads();
        const unsigned idx = (unsigned)__builtin_amdgcn_readfirstlane((int)*qslot);
        __syncthreads();
        if (idx >= (unsigned)(NB * DIFF_H * 2 * 32)) break;
        const int qb = 31 - (int)(idx >> 5), rem = idx & 31, b = rem >> 4, h = (rem >> 1) & 7, r = rem & 1;
        const float slope2 = exp2f(-(float)(h + 1)) * LOG2E;
        int t0 = 0;
        { const unsigned* qm = ctl + CW_QKMAX + b * 64; const int g0 = (h * 128 + r * 64) >> 5;
          const float pq = __uint_as_float(qm[g0]) + __uint_as_float(qm[g0 + 1]), pk = __uint_as_float(qm[32 + g0]) + __uint_as_float(qm[32 + g0 + 1]);
          const float smax = sqrtf(pq * pk);
          const float d = (float)(qb * 256) - (152.0f + 2.1f * smax) / slope2;
          if (d > 0.f) t0 = ((int)d >> 6) & ~1;
          if (t0 > 4 * qb) t0 = 4 * qb; }
#pragma nounroll
        for (int vh = 0; vh < 2; ++vh)
            attn_body::attn_unit<8>(b, qb, t0, (const attn_body::bf16*)(proj + h * 128 + r * 64), (const attn_body::bf16*)(proj + 1024 + h * 128 + r * 64),
                                    (const attn_body::bf16*)(proj + 2048 + h * 128 + vh * 64), (attn_body::bf16*)(o12 + r * 1024 + h * 128 + vh * 64), slope2, shm);
    }
}
__device__ __forceinline__ void phase_diff_combine(const Ctx& a, const LayerP& P, int vcu, int G) {
    const int tid = otid(), lane = tid & 63, wave = tid >> 6;
    bf16* proj = (bf16*)(a.ws + WS_H); const bf16* o12 = (const bf16*)(a.ws + WS_STATE);
    float lam;
    { float s1 = 0.f, s2 = 0.f;
      for (int i = 0; i < 64; ++i) { s1 += P.e0[i] * P.e1[i]; s2 += P.e2[i] * P.e3[i]; }
      lam = __expf(s1) - __expf(s2) + LAMBDA_INIT; }
    const int h = lane >> 3, sub = lane & 7;
    float hn[16];
#pragma unroll
    for (int j = 0; j < 16; ++j) hn[j] = P.e4[sub * 16 + j] * (1.0f - LAMBDA_INIT);
    const int gw = vcu * NWAVES + wave, NGW = G * NWAVES;
    for (int row = gw; row < NTOK; row += NGW) {
        const bf16* p1 = o12 + (size_t)row * 2048 + h * 128 + sub * 16;
        const v4u a0 = *(const v4u*)p1, a1 = *(const v4u*)(p1 + 8), b0 = *(const v4u*)(p1 + 1024), b1 = *(const v4u*)(p1 + 1032);
        const unsigned aw[8] = {a0.x, a0.y, a0.z, a0.w, a1.x, a1.y, a1.z, a1.w}, bw[8] = {b0.x, b0.y, b0.z, b0.w, b1.x, b1.y, b1.z, b1.w};
        float o[16]; float ss = 0.f;
#pragma unroll
        for (int j = 0; j < 8; ++j) { o[2 * j] = bflo(aw[j]) - lam * bflo(bw[j]); o[2 * j + 1] = bfhi(aw[j]) - lam * bfhi(bw[j]); ss += o[2 * j] * o[2 * j] + o[2 * j + 1] * o[2 * j + 1]; }
        ss += __shfl_xor(ss, 1); ss += __shfl_xor(ss, 2); ss += __shfl_xor(ss, 4);
        const float rs = 1.0f / sqrtf(ss * (1.0f / 128.0f) + EPS);
        v4u w0, w1;
        w0.x = pk2(o[0] * rs * hn[0], o[1] * rs * hn[1]); w0.y = pk2(o[2] * rs * hn[2], o[3] * rs * hn[3]); w0.z = pk2(o[4] * rs * hn[4], o[5] * rs * hn[5]); w0.w = pk2(o[6] * rs * hn[6], o[7] * rs * hn[7]);
        w1.x = pk2(o[8] * rs * hn[8], o[9] * rs * hn[9]); w1.y = pk2(o[10] * rs * hn[10], o[11] * rs * hn[11]); w1.z = pk2(o[12] * rs * hn[12], o[13] * rs * hn[13]); w1.w = pk2(o[14] * rs * hn[14], o[15] * rs * hn[15]);
        bf16* op = proj + (size_t)row * DIFF_PITCH + h * 128 + sub * 16;
        *(v4u*)op = w0; *(v4u*)(op + 8) = w1;
    }
}

typedef short mbf16x8 __attribute__((ext_vector_type(8)));
typedef short ms16x4 __attribute__((ext_vector_type(4)));
typedef float mf32x16 __attribute__((ext_vector_type(16)));
#define MFMA32(a, b, c) __builtin_amdgcn_mfma_f32_32x32x16_bf16(a, b, c, 0, 0, 0)
__device__ __forceinline__ int crow32(int r, int hi) { return (r & 3) + 8 * (r >> 2) + 4 * hi; }
__device__ __forceinline__ mbf16x8 frag_rk(const LAS unsigned char* base, int stride, int row0, int k0, int lane) {
    return *(const LAS mbf16x8*)(base + (row0 + (lane & 31)) * stride + (k0 + 8 * (lane >> 5)) * 2);
}
__device__ __forceinline__ mbf16x8 frag_kn(const LAS unsigned char* base, int stride, int k0, int n0, int lane) {
    const int i = lane & 15, g = lane >> 4;
    const LAS unsigned char* p = base + (k0 + 8 * (g >> 1) + (i >> 2)) * stride + (n0 + 16 * (g & 1) + 4 * (i & 3)) * 2;
    const ms16x4 lo = __builtin_bit_cast(ms16x4, __builtin_amdgcn_ds_read_tr16_b64_v4i16((LAS ms16x4*)p));
    const ms16x4 hi = __builtin_bit_cast(ms16x4, __builtin_amdgcn_ds_read_tr16_b64_v4i16((LAS ms16x4*)(p + 4 * stride)));
    return (mbf16x8){lo[0], lo[1], lo[2], lo[3], hi[0], hi[1], hi[2], hi[3]};
}
__device__ __forceinline__ mf32x16 zero16() { mf32x16 z;
#pragma unroll
    for (int r = 0; r < 16; ++r) z[r] = 0.f; return z; }

__device__ __forceinline__ void phase_sgu_mfma(LAS unsigned char* lds, const Ctx& a, const LayerP& P, int vcu, int G) {
    const int tid = otid(), lane = tid & 63, wave = __builtin_amdgcn_readfirstlane(tid >> 6);
    bf16* proj = (bf16*)(a.ws + WS_H); const float* vssq = (const float*)(a.ws + WS_VSSQ);
    const float* v_norm = P.e1; const float* w_s = P.e2; const float* b_s = P.e3;
    constexpr int SA = 272, SV = 320, SO = 132;
    LAS unsigned char* WA = lds;
    LAS unsigned char* VV = lds + 128 * SA;
    LAS float* RS = (LAS float*)(lds + 128 * SA + 128 * SV);
    LAS float* OS = (LAS float*)lds;
    const int tm = wave & 3, nh = wave >> 2, hi = lane >> 5;
    for (int u = vcu; u < NB * (T / SGU_C) * SGU_G; u += G) {
        const int g = u % SGU_G, bc = u / SGU_G;
        const int row0 = bc * SGU_C;
        if (tid < 128) RS[tid] = row_rstd(vssq, row0 + tid);
#pragma unroll
        for (int i = 0; i < 4; ++i) { const int ch = tid + NTHR * i, r = ch >> 4, c16 = ch & 15;
            const v4u w = *(const v4u*)(proj + (size_t)(row0 + r) * SGU_PITCH + 1024 + g * 128 + c16 * 8);
            *(LAS v4u*)(VV + r * SV + c16 * 16) = w; }
        __syncthreads();
#pragma unroll
        for (int i = 0; i < 8; ++i) { const int idx = tid + NTHR * i, t = idx >> 5, s4 = (idx & 31) * 4;
            const f32x4 w = *(const f32x4*)(w_s + (size_t)g * 16384 + t * 128 + s4);
            const float x0 = (s4 + 0 <= t) ? w.x * RS[s4 + 0] : 0.f, x1 = (s4 + 1 <= t) ? w.y * RS[s4 + 1] : 0.f, x2 = (s4 + 2 <= t) ? w.z * RS[s4 + 2] : 0.f, x3 = (s4 + 3 <= t) ? w.w * RS[s4 + 3] : 0.f;
            v2u o; o.x = pk2(x0, x1); o.y = pk2(x2, x3); *(LAS v2u*)(WA + t * SA + s4 * 2) = o; }
        __syncthreads();
        mf32x16 acc0 = zero16(), acc1 = zero16();
        for (int ks = 0; ks < 2 * (tm + 1); ++ks) {
            const mbf16x8 af = frag_rk(WA, SA, 32 * tm, 16 * ks, lane);
            const mbf16x8 b0 = frag_kn(VV, SV, 16 * ks, 64 * nh, lane), b1 = frag_kn(VV, SV, 16 * ks, 64 * nh + 32, lane);
            acc0 = MFMA32(af, b0, acc0); acc1 = MFMA32(af, b1, acc1);
        }
        __syncthreads();
#pragma unroll
        for (int r = 0; r < 16; ++r) { const int row = 32 * tm + crow32(r, hi);
            OS[row * SO + 64 * nh + (lane & 31)] = acc0[r]; OS[row * SO + 64 * nh + 32 + (lane & 31)] = acc1[r]; }
        __syncthreads();
#pragma unroll
        for (int i = 0; i < 4; ++i) { const int ch = tid + NTHR * i, t = ch >> 4, c8 = (ch & 15) * 8;
            const f32x4 s0 = *(const LAS f32x4*)(OS + t * SO + c8), s1 = *(const LAS f32x4*)(OS + t * SO + c8 + 4);
            const f32x4 n0 = *(const f32x4*)(v_norm + g * 128 + c8), n1 = *(const f32x4*)(v_norm + g * 128 + c8 + 4);
            const float bs = b_s[g * 128 + t];
            bf16* up = proj + (size_t)(row0 + t) * SGU_PITCH + g * 128 + c8;
            const v4u uw = *(const v4u*)up;
            v4u o;
            o.x = pk2(bflo(uw.x) * (n0.x * s0.x + bs), bfhi(uw.x) * (n0.y * s0.y + bs)); o.y = pk2(bflo(uw.y) * (n0.z * s0.z + bs), bfhi(uw.y) * (n0.w * s0.w + bs));
            o.z = pk2(bflo(uw.z) * (n1.x * s1.x + bs), bfhi(uw.z) * (n1.y * s1.y + bs)); o.w = pk2(bflo(uw.w) * (n1.z * s1.z + bs), bfhi(uw.w) * (n1.w * s1.w + bs));
            *(v4u*)up = o; }
        __syncthreads();
    }
}

__device__ __forceinline__ void phase_gla_kv_mfma(LAS unsigned char* lds, const Ctx& a, int vcu, int G) {
    const int tid = otid(), lane = tid & 63, wave = __builtin_amdgcn_readfirstlane(tid >> 6), hi = lane >> 5;
    const bf16* proj = (const bf16*)(a.ws + WS_H); bf16* state = (bf16*)(a.ws + WS_STATE); float* dec = (float*)(a.ws + WS_DEC);
    constexpr int SV = 576, SK = 320, SS = 272;
    LAS unsigned char* VV = lds;
    LAS unsigned char* KE = lds + 64 * SV;
    LAS unsigned char* ST = lds;
    LAS float* TOT = (LAS float*)(lds + 256 * SS);
    for (int u = vcu; u < NB * GLA_H * GLA_NC; u += G) {
        const int n = u % GLA_NC, bh = u / GLA_NC, h = bh % GLA_H, b = bh / GLA_H;
        const int row0 = b * T + n * GLA_C;
        GlaCum c; gla_cumsum(c, proj, row0, h, TOT, tid);
        const int cp = tid & 63, part = tid >> 6;
#pragma unroll
        for (int i = 0; i < 8; ++i) { const int t = 8 * part + i; const unsigned w = *(const unsigned*)(proj + (size_t)(row0 + t) * GLA_PITCH + 512 + h * 128 + 2 * cp);
            *(LAS unsigned*)(KE + t * SK + 4 * cp) = pk2(bflo(w) * __expf(c.tot0 - c.b0[i]), bfhi(w) * __expf(c.tot1 - c.b1[i])); }
        if (part == 0) { dec[(size_t)u * 128 + 2 * cp] = __expf(c.tot0); dec[(size_t)u * 128 + 2 * cp + 1] = __expf(c.tot1); }
#pragma unroll
        for (int i = 0; i < 4; ++i) { const int ch = tid + NTHR * i, r = ch >> 5, c16 = ch & 31;
            *(LAS v4u*)(VV + r * SV + c16 * 16) = *(const v4u*)(proj + (size_t)(row0 + r) * GLA_PITCH + 1024 + h * 256 + c16 * 8); }
        __syncthreads();
        mf32x16 acc[4];
#pragma unroll
        for (int nt = 0; nt < 4; ++nt) acc[nt] = zero16();
#pragma unroll
        for (int ks = 0; ks < 4; ++ks) { const mbf16x8 af = frag_kn(VV, SV, 16 * ks, 32 * wave, lane);
#pragma unroll
            for (int nt = 0; nt < 4; ++nt) { const mbf16x8 bfr = frag_kn(KE, SK, 16 * ks, 32 * nt, lane); acc[nt] = MFMA32(af, bfr, acc[nt]); } }
        __syncthreads();
#pragma unroll
        for (int nt = 0; nt < 4; ++nt)
#pragma unroll
            for (int r = 0; r < 16; ++r) *(LAS bf16*)(ST + (32 * wave + crow32(r, hi)) * SS + (32 * nt + (lane & 31)) * 2) = (bf16)f2bf(acc[nt][r]);
        __syncthreads();
#pragma unroll
        for (int i = 0; i < 8; ++i) { const int ch = tid + NTHR * i, vd = ch >> 4, c16 = ch & 15;
            *(v4u*)(state + ((size_t)u * 256 + vd) * 128 + c16 * 8) = *(const LAS v4u*)(ST + vd * SS + c16 * 16); }
        __syncthreads();
    }
}
__device__ __forceinline__ void phase_gla_out_mfma(LAS unsigned char* lds, const Ctx& a, const LayerP& P, int vcu, int G) {
    const int tid = otid(), lane = tid & 63, wave = __builtin_amdgcn_readfirstlane(tid >> 6), hi = lane >> 5;
    bf16* proj = (bf16*)(a.ws + WS_H); const bf16* state = (const bf16*)(a.ws + WS_STATE);
    const float* head_norm = P.e3;
    constexpr int SQ = 272, SA = 144, SV = 576, SO = 260;
    LAS unsigned char* QD = lds;
    LAS unsigned char* KI = lds + 64 * SQ;
    LAS unsigned char* AT = lds + 2 * 64 * SQ;
    LAS unsigned char* VV = lds + 2 * 64 * SQ + 64 * SA;
    LAS float* TOT = (LAS float*)(lds + 80896);
    LAS float* OS = (LAS float*)lds;
    for (int u = vcu; u < NB * GLA_H * GLA_NC; u += G) {
        const int n = u % GLA_NC, bh = u / GLA_NC, h = bh % GLA_H, b = bh / GLA_H;
        const int row0 = b * T + n * GLA_C;
        mbf16x8 sfr[8];
        { const bf16* sp = state + ((size_t)u * 256 + 32 * wave + (lane & 31)) * 128 + 8 * hi;
#pragma unroll
          for (int ks = 0; ks < 8; ++ks) sfr[ks] = *(const mbf16x8*)(sp + 16 * ks); }
        GlaCum c; gla_cumsum(c, proj, row0, h, TOT, tid);
        const int cp = tid & 63, part = tid >> 6;
#pragma unroll
        for (int i = 0; i < 8; ++i) { const int t = 8 * part + i;
            const unsigned wq = *(const unsigned*)(proj + (size_t)(row0 + t) * GLA_PITCH + h * 128 + 2 * cp);
            const unsigned wk = *(const unsigned*)(proj + (size_t)(row0 + t) * GLA_PITCH + 512 + h * 128 + 2 * cp);
            const float e0 = __expf(c.b0[i]), e1 = __expf(c.b1[i]);
            *(LAS unsigned*)(QD + t * SQ + 4 * cp) = pk2(bflo(wq) * 0.08838834764831845f * e0, bfhi(wq) * 0.08838834764831845f * e1);
            *(LAS unsigned*)(KI + t * SQ + 4 * cp) = pk2(bflo(wk) / e0, bfhi(wk) / e1); }
#pragma unroll
        for (int i = 0; i < 4; ++i) { const int ch = tid + NTHR * i, r = ch >> 5, c16 = ch & 31;
            *(LAS v4u*)(VV + r * SV + c16 * 16) = *(const v4u*)(proj + (size_t)(row0 + r) * GLA_PITCH + 1024 + h * 256 + c16 * 8); }
        __syncthreads();
        if (wave < 4) {
            const int mi = wave >> 1, ni = wave & 1;
            mf32x16 at = zero16();
            if (!(mi == 0 && ni == 1)) {
#pragma unroll
                for (int ks = 0; ks < 8; ++ks) at = MFMA32(frag_rk(QD, SQ, 32 * mi, 16 * ks, lane), frag_rk(KI, SQ, 32 * ni, 16 * ks, lane), at);
            }
#pragma unroll
            for (int r = 0; r < 16; ++r) { const int cc = 32 * mi + crow32(r, hi), ss = 32 * ni + (lane & 31);
                *(LAS bf16*)(AT + cc * SA + ss * 2) = (bf16)f2bf((ss <= cc) ? at[r] : 0.f); }
        }
        __syncthreads();
        mf32x16 acc[2]; acc[0] = zero16(); acc[1] = zero16();
#pragma unroll
        for (int ks = 0; ks < 4; ++ks) { const mbf16x8 bfr = frag_kn(VV, SV, 16 * ks, 32 * wave, lane);
            if (ks < 2) acc[0] = MFMA32(frag_rk(AT, SA, 0, 16 * ks, lane), bfr, acc[0]);
            acc[1] = MFMA32(frag_rk(AT, SA, 32, 16 * ks, lane), bfr, acc[1]); }
#pragma unroll
        for (int ks = 0; ks < 8; ++ks) { acc[0] = MFMA32(frag_rk(QD, SQ, 0, 16 * ks, lane), sfr[ks], acc[0]); acc[1] = MFMA32(frag_rk(QD, SQ, 32, 16 * ks, lane), sfr[ks], acc[1]); }
        __syncthreads();
#pragma unroll
        for (int mi = 0; mi < 2; ++mi)
#pragma unroll
            for (int r = 0; r < 16; ++r) OS[(32 * mi + crow32(r, hi)) * SO + 32 * wave + (lane & 31)] = acc[mi][r];
        __syncthreads();
#pragma unroll
        for (int p = 0; p < 4; ++p) { const int cc = p * 16 + wave * 2 + hi, c8 = (lane & 31) * 8;
            const f32x4 s0 = *(const LAS f32x4*)(OS + cc * SO + c8), s1 = *(const LAS f32x4*)(OS + cc * SO + c8 + 4);
            float ss = (s0.x * s0.x + s0.y * s0.y) + (s0.z * s0.z + s0.w * s0.w) + (s1.x * s1.x + s1.y * s1.y) + (s1.z * s1.z + s1.w * s1.w);
            ss += __shfl_xor(ss, 1); ss += __shfl_xor(ss, 2); ss += __shfl_xor(ss, 4); ss += __shfl_xor(ss, 8); ss += __shfl_xor(ss, 16);
            const float rs = 1.0f / sqrtf(ss * (1.0f / 256.0f) + EPS);
            const f32x4 n0 = *(const f32x4*)(head_norm + c8), n1 = *(const f32x4*)(head_norm + c8 + 4);
            const v4u gw = *(const v4u*)(proj + (size_t)(row0 + cc) * GLA_PITCH + 2048 + h * 256 + c8);
            const float gg[8] = {bflo(gw.x), bfhi(gw.x), bflo(gw.y), bfhi(gw.y), bflo(gw.z), bfhi(gw.z), bflo(gw.w), bfhi(gw.w)};
            const float ov[8] = {s0.x * n0.x, s0.y * n0.y, s0.z * n0.z, s0.w * n0.w, s1.x * n1.x, s1.y * n1.y, s1.z * n1.z, s1.w * n1.w};
            float o[8];
#pragma unroll
            for (int j = 0; j < 8; ++j) o[j] = ov[j] * rs * (gg[j] / (1.f + __expf(-gg[j])));
            v4u w; w.x = pk2(o[0], o[1]); w.y = pk2(o[2], o[3]); w.z = pk2(o[4], o[5]); w.w = pk2(o[6], o[7]);
            *(v4u*)(proj + (size_t)(row0 + cc) * GLA_PITCH + 1024 + h * 256 + c8) = w; }
        __syncthreads();
    }
}
#ifndef USE_MFMA_SGU
#define USE_MFMA_SGU 1
#endif
#ifndef USE_MFMA_GLA
#define USE_MFMA_GLA 1
#endif

constexpr int PH_PER_LAYER = 8, NPHASE = 4 * PH_PER_LAYER + 1;
__host__ __device__ inline bool phase_is_noop(int ph) {
    if (ph >= 4 * PH_PER_LAYER) return false;
    const int L = ph / PH_PER_LAYER, s = ph % PH_PER_LAYER;
    const bool gla = (L == 0 || L == 3), diff = (L == 1);
    return (s == 3 && !gla && !diff) || (s == 4 && !gla);
}

#ifndef PROBE_KIND
#define PROBE_KIND 0
#endif
#ifndef PROBE_REP
#define PROBE_REP 2
#endif
template <int L> __device__ __forceinline__ LayerP layer_params_ct(const CAS cfptr* in) {
    constexpr int base = (L == 0) ? 1 : (L == 1) ? 11 : (L == 2) ? 22 : 32;
    constexpr int kind = (L == 1) ? K_DIFF : (L == 2) ? K_SGU : K_GLA;
    constexpr int sh = (kind == K_DIFF) ? 1 : 0;
    LayerP p; p.kind = kind;
    p.norm1 = in[base]; p.w_in = in[base + 1];
    p.e0 = in[base + 2]; p.e1 = in[base + 3]; p.e2 = in[base + 4]; p.e3 = in[base + 5]; p.e4 = in[base + 6];
    p.w_out = in[base + 6 + sh]; p.norm2 = in[base + 7 + sh]; p.w1 = in[base + 8 + sh]; p.w2 = in[base + 9 + sh];
    p.nin = (kind == K_GLA) ? GLA_PITCH : (kind == K_DIFF) ? DIFF_PITCH : SGU_PITCH;
    p.mixoff = (kind == K_GLA) ? 1024 : 0;
    return p;
}
__device__ __forceinline__ void seam_xcd(const CAS Args* ap, LAS unsigned char* lds_k) {
#if PROBE_KIND == 1
    for (int br = 0; br < PROBE_REP; ++br)
#endif
    { XcdBarrier bb; bb.bar = (unsigned*)(ap->ws + WS_CTL) + 4096; bb.x = xb_xcc_id(); bb.st = (volatile LAS unsigned*)(lds_k + MISC_OFF) + 8; xcd_barrier(bb); }
}
#define PH_BEGIN(PK) { const int nrep_ = (PROBE_KIND == (PK) && (PK) != 0) ? PROBE_REP : 1; \
    for (int rep_ = 0; rep_ < nrep_; ++rep_) { \
    int vcu = vcu0, G = G0; asm volatile("" : "+s"(vcu), "+s"(G)); \
    LAS unsigned char* lds = lds_k; asm volatile("" : "+s"(lds)); \
    const CAS Args* ap = (const CAS Args*)__builtin_amdgcn_kernarg_segment_ptr(); asm volatile("" : "+s"(ap)); \
    Ctx args; args.in0 = ap->in[0]; args.in42 = ap->in[42]; args.out = ap->out; args.ws = ap->ws; \
    bf16* Wb = (bf16*)(args.ws + WS_W); bf16* XB = (bf16*)(args.ws + WS_XB); bf16* HB = (bf16*)(args.ws + WS_H); \
    float* SSQ = (float*)(args.ws + WS_SSQ); float* VSSQ = (float*)(args.ws + WS_VSSQ); \
    const LayerP P = layer_params_ct<L>((const CAS cfptr*)ap); \
    (void)Wb; (void)XB; (void)HB; (void)SSQ; (void)VSSQ; (void)P; (void)vcu; (void)G; (void)lds;
#define PH_END_SEAM   seam_xcd(ap, lds_k); } }
#define PH_END_NOSEAM } }

template <int L> __device__ __forceinline__ void run_layer(LAS unsigned char* lds_k, int vcu0, int G0) {
    constexpr int kind = (L == 1) ? K_DIFF : (L == 2) ? K_SGU : K_GLA;
    PH_BEGIN(5) phase_conv(lds, args, P, L, vcu, G);
    if (L == 0) { if (rep_ + 1 == nrep_) cg::this_grid().sync(); else seam_xcd(ap, lds_k); } else seam_xcd(ap, lds_k);
    PH_END_NOSEAM
    PH_BEGIN(3) { EpiIn E{kind, HB, SSQ, (kind == K_GLA) ? P.e2 : P.e0, VSSQ, (unsigned*)(args.ws + WS_CTL) + CW_QKMAX}; run_gemm(lds, XB, D, Wb + WOFF_IN, NTOK, P.nin, D, E, vcu, G); } PH_END_SEAM
    if constexpr (kind == K_GLA) {
        PH_BEGIN(4) phase_gla_kv_mfma(lds, args, vcu, G); PH_END_SEAM
        PH_BEGIN(0) phase_gla_scan(args, vcu, G); PH_END_SEAM
        PH_BEGIN(0) phase_gla_out_mfma(lds, args, P, vcu, G); PH_END_SEAM
    } else if constexpr (kind == K_DIFF) {
        PH_BEGIN(7)
            if (rep_ > 0) { if (blockIdx.x == 0 && otid() == 0) __hip_atomic_store((unsigned*)(ap->ws + WS_CTL) + CW_QUEUE, 0u, RLX_AGENT); seam_xcd(ap, lds_k); }
            phase_diff_mfma((char*)lds_raw, lds, args, vcu, G);
        PH_END_SEAM
        PH_BEGIN(6) phase_diff_combine(args, P, vcu, G); PH_END_SEAM
    } else {
        PH_BEGIN(0) phase_sgu_mfma(lds, args, P, vcu, G); PH_END_SEAM
    }
    PH_BEGIN(L == 0 ? 8 : 0) { EpiRes E{(L == 0) ? args.in0 : args.out, args.out, XB, SSQ}; run_gemm(lds, HB + P.mixoff, P.nin, Wb + WOFF_OUT, NTOK, D, D, E, vcu, G); } PH_END_SEAM
    PH_BEGIN(2) { EpiHid E{HB, SSQ}; run_gemm(lds, XB, D, Wb + WOFF_1, NTOK, FF, D, E, vcu, G); } PH_END_SEAM
    PH_BEGIN(0) { EpiRes E{args.out, args.out, XB, SSQ}; run_gemm(lds, HB, FF, Wb + WOFF_2, NTOK, D, FF, E, vcu, G); } PH_END_SEAM
}

__global__ void __launch_bounds__(NTHR, 2) trunk_fwd(Args kargs) {
    LAS unsigned char* const lds_k = (LAS unsigned char*)lds_raw;
    const int G0 = gridDim.x; const int bx = blockIdx.x;
    const int vcu0 = (G0 % 8 == 0) ? (bx % 8) * (G0 / 8) + bx / 8 : bx;
    { const int tid = threadIdx.x;
      for (int u = tid; u < (LDS_BYTES - LDSCTL_OFF) / 4; u += NTHR) ((LAS unsigned*)(lds_k + LDSCTL_OFF))[u] = 0u;
      __syncthreads();
      if ((tid & 63) == 0) ((LAS unsigned*)(lds_k + TIDTAB_OFF))[hw_slot()] = (unsigned)(tid >> 6);
      __syncthreads(); }
    (void)xcd_barrier_post((unsigned*)(kargs.ws + WS_CTL) + 4096, (volatile LAS unsigned*)(lds_k + MISC_OFF) + 8);
    run_layer<0>(lds_k, vcu0, G0);
    run_layer<1>(lds_k, vcu0, G0);
    run_layer<2>(lds_k, vcu0, G0);
    run_layer<3>(lds_k, vcu0, G0);
    { int vcu = vcu0, G = G0; asm volatile("" : "+s"(vcu), "+s"(G));
      const CAS Args* ap = (const CAS Args*)__builtin_amdgcn_kernarg_segment_ptr(); asm volatile("" : "+s"(ap));
      Ctx args; args.in0 = ap->in[0]; args.in42 = ap->in[42]; args.out = ap->out; args.ws = ap->ws;
      phase_final(args, vcu, G); }
}

extern "C" void kernel_launch(void* const* d_in, const int* in_sizes, int n_in, void* d_out, int out_size, void* d_ws, size_t ws_size, hipStream_t stream) {
    static int grid = 0;
    if (grid == 0) {
        if (n_in != 43 || in_sizes[0] != NTOK * D || out_size != NTOK * D || ws_size < WS_END) {
            fprintf(stderr, "kernel_launch: unexpected problem (n_in %d, in0 %d, out %d, ws %zu); nothing launched\n", n_in, n_in > 0 ? in_sizes[0] : -1, out_size, ws_size); grid = -1; return; }
        int dev = 0, cus = 0, per_cu = 0;
        if (hipGetDevice(&dev) != hipSuccess || hipDeviceGetAttribute(&cus, hipDeviceAttributeMultiprocessorCount, dev) != hipSuccess) { grid = -1; return; }
        if (hipFuncSetAttribute((const void*)trunk_fwd, hipFuncAttributeMaxDynamicSharedMemorySize, LDS_BYTES) != hipSuccess) { fprintf(stderr, "kernel_launch: hipFuncSetAttribute failed\n"); grid = -1; return; }
        if (hipOccupancyMaxActiveBlocksPerMultiprocessor(&per_cu, (const void*)trunk_fwd, NTHR, LDS_BYTES) != hipSuccess || per_cu < 1) { fprintf(stderr, "kernel_launch: occupancy query says %d blocks/CU\n", per_cu); per_cu = 1; }
        (void)hipGetLastError();
        grid = cus;
    }
    if (grid < 0) return;
    (void)hipMemsetAsync((char*)d_ws + WS_CTL, 0, CTL_ZERO_BYTES, stream);
    Args a{};
    for (int i = 0; i < 43; ++i) a.in[i] = (const float*)d_in[i];
    a.out = (float*)d_out; a.ws = (unsigned char*)d_ws;
    a.ph_lo = 0; a.ph_hi = 0;
    void* kargs[] = {&a};
    hipError_t e = hipLaunchCooperativeKernel((const void*)trunk_fwd, dim3(grid), dim3(NTHR), kargs, LDS_BYTES, stream);
    if (e != hipSuccess) fprintf(stderr, "kernel_launch: cooperative launch failed: %s (grid %d)\n", hipGetErrorString(e), grid);
}
```

```cpp
#include <hip/hip_runtime.h>
#include <hip/hip_cooperative_groups.h>
#include <cstdio>
#include <cstdint>
namespace cg = cooperative_groups;

#ifndef MK_ONE_LAUNCH
#define MK_ONE_LAUNCH 1
#endif

#define GAS __attribute__((address_space(1)))
#define LAS __attribute__((address_space(3)))
typedef unsigned short bf16;
typedef unsigned v4u __attribute__((ext_vector_type(4)));
typedef unsigned v2u __attribute__((ext_vector_type(2)));
typedef float f32x4 __attribute__((ext_vector_type(4)));

constexpr int NB = 2, T = 8192, D = 1024, NTOK = NB * T, FF = 4096;
constexpr float EPS = 1e-6f;
constexpr float LOG2E = 1.4426950408889634f;
constexpr int NWAVES = 8, NTHR = 512;
constexpr int K_GLA = 0, K_DIFF = 1, K_SGU = 2;
constexpr int GLA_H = 4, GLA_HK = 128, GLA_HV = 256, GLA_C = 64, GLA_NC = T / GLA_C;
constexpr int GLA_PITCH = 3584;
constexpr int DIFF_H = 8, DIFF_PITCH = 3072;
constexpr float LAMBDA_INIT = 0.35551069f;
constexpr int SGU_PITCH = 2048, SGU_C = 128, SGU_G = 8;

constexpr size_t MiB = 1u << 20;
constexpr size_t WS_CTL = 0, CTL_ZERO_BYTES = 1 * MiB;
constexpr size_t WS_SSQ = 1 * MiB;
constexpr size_t WS_VSSQ = 2 * MiB;
constexpr size_t WS_DEC = 3 * MiB;
constexpr size_t WS_W = 4 * MiB;
constexpr size_t WS_XB = 29 * MiB;
constexpr size_t WS_STATE = 61 * MiB;
constexpr size_t WS_H = 125 * MiB;
constexpr size_t WS_END = 253 * MiB;
constexpr int CW_QKMAX = 8192;
constexpr int CW_QUEUE = 8448;
constexpr size_t WOFF_IN = 0, WOFF_OUT = (size_t)3584 * 1024, WOFF_1 = WOFF_OUT + (size_t)1024 * 1024, WOFF_2 = WOFF_1 + (size_t)4096 * 1024;

constexpr int RING_BYTES = 131072, LDSCTL_OFF = RING_BYTES, MISC_OFF = LDSCTL_OFF + 320, LDS_BYTES = 147456;

#define RLX_AGENT __ATOMIC_RELAXED, __HIP_MEMORY_SCOPE_AGENT
#define LDS_WAIT() asm volatile("s_waitcnt lgkmcnt(0)" ::: "memory")
__device__ __forceinline__ unsigned f2bf(float f) { unsigned u = __builtin_bit_cast(unsigned, f); return (u + 0x7fffu + ((u >> 16) & 1u)) >> 16; }
typedef float pk_f32x2 __attribute__((ext_vector_type(2))); typedef __bf16 pk_bf16x2 __attribute__((ext_vector_type(2)));
__device__ __forceinline__ unsigned pk2(float lo, float hi) { pk_f32x2 v = {lo, hi}; pk_bf16x2 b = __builtin_convertvector(v, pk_bf16x2); return __builtin_bit_cast(unsigned, b); }
__device__ __forceinline__ float bf2f(unsigned b) { return __builtin_bit_cast(float, b << 16); }
__device__ __forceinline__ float bflo(unsigned w) { return __builtin_bit_cast(float, w << 16); }
__device__ __forceinline__ float bfhi(unsigned w) { return __builtin_bit_cast(float, w & 0xffff0000u); }
extern __shared__ __attribute__((aligned(16))) unsigned char lds_raw[];
constexpr int TIDTAB_OFF = 131072;
__device__ __forceinline__ unsigned hw_slot() { return (unsigned)__builtin_amdgcn_s_getreg((5 << 11) | 4) & 63u; }
__device__ __forceinline__ int otid() {
    const int wv = (int)((volatile __attribute__((address_space(3))) unsigned*)((__attribute__((address_space(3))) unsigned char*)lds_raw + TIDTAB_OFF))[hw_slot()];
    int ln; asm volatile("v_mbcnt_lo_u32_b32 %0, -1, 0\n\tv_mbcnt_hi_u32_b32 %0, -1, %0" : "=v"(ln));
    int t = wv * 64 + ln;
    asm volatile("" : "+v"(t)); return t; }
__device__ __forceinline__ float wave_sum(float v) {
#pragma unroll
    for (int o = 1; o < 64; o <<= 1) v += __shfl_xor(v, o);
    return v;
}
__device__ __forceinline__ float wave_max(float v) {
#pragma unroll
    for (int o = 1; o < 64; o <<= 1) v = fmaxf(v, __shfl_xor(v, o));
    return v;
}
__device__ __forceinline__ float gelu_tanh(float x) {
    const float u = 0.7978845608028654f * (x + 0.044715f * x * x * x);
    const float e = __builtin_amdgcn_exp2f(u * (2.f * LOG2E));
    return x - x * __builtin_amdgcn_rcpf(e + 1.f);
}
__device__ __forceinline__ float log_sigmoid(float z) { return fminf(z, 0.f) - 0.6931471805599453f * __builtin_amdgcn_logf(1.0f + __builtin_amdgcn_exp2f(-fabsf(z) * LOG2E)); }

#define XB_TMO      128
#define XB_XCNT(j)  (256  + 64 * (j))
#define XB_XSUB(j)  (1280 + 64 * (j))
#define XB_XGEN(j)  (2304 + 64 * (j))
#define XB_TOP      3328
#define XB_TOPGEN   3392
#define XCD_BAR_WORDS 3456
#define XB_SPIN_CAP (1u << 22)
__device__ __forceinline__ unsigned xb_ld(unsigned* p)              { return __hip_atomic_load(p, __ATOMIC_RELAXED, __HIP_MEMORY_SCOPE_AGENT); }
__device__ __forceinline__ unsigned xb_add(unsigned* p, unsigned v) { return __hip_atomic_fetch_add(p, v, __ATOMIC_RELAXED, __HIP_MEMORY_SCOPE_AGENT); }
__device__ __forceinline__ unsigned xb_xcc_id() { return (unsigned)__builtin_amdgcn_s_getreg((3 << 11) | 20) & 0xFu; }
#define XB_SPIN(cond, bar) do { unsigned _sp = 0; while (cond) { __builtin_amdgcn_s_sleep(1); \
    if ((++_sp & 255u) == 0u) { if (xb_ld(&(bar)[XB_TMO])) break; if (_sp > XB_SPIN_CAP) { atomicAdd(&(bar)[XB_TMO], 1u); break; } } } } while (0)
struct XcdBarrier { unsigned* bar; unsigned x; volatile LAS unsigned* st; };
__device__ __forceinline__ XcdBarrier xcd_barrier_post(unsigned* bar, volatile LAS unsigned* st) {
    XcdBarrier b; b.bar = bar; b.x = xb_xcc_id(); b.st = st;
    if (threadIdx.x == 0) (void)xb_add(&bar[XB_XCNT(b.x)], 1u);
    return b;
}
__device__ __forceinline__ void xcd_barrier_complete(unsigned* bar, unsigned x, unsigned& nloc, unsigned& nx) {
    const unsigned G = gridDim.x * gridDim.y * gridDim.z;
    unsigned sum, cnt, mine, sp = 0u;
    for (;;) {
        sum = 0u; cnt = 0u; mine = 0u;
#pragma unroll
        for (unsigned j = 0; j < 16; ++j) { const unsigned c = xb_ld(&bar[XB_XCNT(j)]); sum += c; cnt += (c > 0u) ? 1u : 0u; mine = (j == x) ? c : mine; }
        if (sum == G) break;
        __builtin_amdgcn_s_sleep(1);
        if ((++sp & 255u) == 0u) { if (xb_ld(&bar[XB_TMO])) break; if (sp > XB_SPIN_CAP) { atomicAdd(&bar[XB_TMO], 1u); break; } }
    }
    nloc = mine > 0u ? mine : 1u; nx = cnt > 0u ? cnt : 1u;
}
__device__ __forceinline__ void xcd_barrier(const XcdBarrier& b) {
    asm volatile("s_waitcnt vmcnt(0)" ::: "memory");
    __syncthreads();
    if (otid() == 0) {
        unsigned* bar = b.bar;
        __builtin_amdgcn_s_waitcnt(0);
        unsigned nloc = b.st[0], nx = b.st[1];
        if (nloc == 0u) { xcd_barrier_complete(bar, b.x, nloc, nx); b.st[0] = nloc; b.st[1] = nx; }
        const unsigned old = xb_add(&bar[XB_XSUB(b.x)], 1u);
        const unsigned gen = old / nloc;
        if (old + 1u == (gen + 1u) * nloc) {
            __builtin_amdgcn_fence(__ATOMIC_RELEASE, "agent");
            asm volatile("s_waitcnt vmcnt(0)" ::: "memory");
            const unsigned og = xb_add(&bar[XB_TOP], 1u);
            const unsigned tg = og / nx;
            if (og + 1u == (tg + 1u) * nx) xb_add(&bar[XB_TOPGEN], 1u);
            else XB_SPIN(xb_ld(&bar[XB_TOPGEN]) == tg, bar);
            __builtin_amdgcn_fence(__ATOMIC_ACQUIRE, "agent");
            xb_add(&bar[XB_XGEN(b.x)], 1u);
            asm volatile("s_waitcnt vmcnt(0)" ::: "memory");
        } else {
            XB_SPIN(xb_ld(&bar[XB_XGEN(b.x)]) == gen, bar);
            __builtin_amdgcn_fence(__ATOMIC_ACQUIRE, "agent");
            asm volatile("s_waitcnt vmcnt(0)" ::: "memory");
        }
    }
    __syncthreads();
}

struct Args { const float* in[43]; float* out; unsigned char* ws; int ph_lo, ph_hi; };
struct Ctx { const float* in0; const float* in42; float* out; unsigned char* ws; };
struct LayerP {
    int kind;
    const float *norm1, *w_in, *w_out, *norm2, *w1, *w2;
    const float *e0, *e1, *e2, *e3, *e4;
    int nin;
    int mixoff;
};
typedef const float* cfptr;
#define CAS __attribute__((address_space(4)))
__device__ __forceinline__ LayerP layer_params(const CAS cfptr* in, int L) {
    LayerP p;
    const int base = (L == 0) ? 1 : (L == 1) ? 11 : (L == 2) ? 22 : 32;
    p.kind = (L == 1) ? K_DIFF : (L == 2) ? K_SGU : K_GLA;
    const int sh = (p.kind == K_DIFF) ? 1 : 0;
    p.norm1 = in[base]; p.w_in = in[base + 1];
    p.e0 = in[base + 2]; p.e1 = in[base + 3]; p.e2 = in[base + 4]; p.e3 = in[base + 5]; p.e4 = in[base + 6];
    p.w_out = in[base + 6 + sh]; p.norm2 = in[base + 7 + sh]; p.w1 = in[base + 8 + sh]; p.w2 = in[base + 9 + sh];
    p.nin = (p.kind == K_GLA) ? GLA_PITCH : (p.kind == K_DIFF) ? DIFF_PITCH : SGU_PITCH;
    p.mixoff = (p.kind == K_GLA) ? 1024 : 0;
    return p;
}

__device__ __forceinline__ float row_rstd(const float* ssq, int row) {
    const f32x4* p = (const f32x4*)(ssq + (size_t)row * 16);
    const f32x4 a = p[0], b = p[1], c = p[2], d = p[3];
    const float s = ((a.x + a.y) + (a.z + a.w)) + ((b.x + b.y) + (b.z + b.w)) + ((c.x + c.y) + (c.z + c.w)) + ((d.x + d.y) + (d.z + d.w));
    return __builtin_amdgcn_rsqf(s * (1.0f / D) + EPS);
}

struct EpiIn {
    int kind; bf16* proj; const float* ssq; const float* bias;
    float* vssq;
    __device__ __forceinline__ float rowscale(int row) const { return row_rstd(ssq, row); }
    __device__ __forceinline__ float apply8(int row, int col0, const float (&v)[8], float rs) const {
        float o[8]; float part = 0.f; int pitch;
        if (kind == K_GLA) { pitch = GLA_PITCH;
            if (col0 < 3072) {
#pragma unroll
                for (int j = 0; j < 8; ++j) o[j] = v[j] * rs;
            } else {
#pragma unroll
                for (int j = 0; j < 8; ++j) o[j] = log_sigmoid(v[j] * rs + bias[col0 - 3072 + j]) * (1.0f / 16.0f);
            }
        } else if (kind == K_DIFF) { pitch = DIFF_PITCH;
            const float sc = (col0 < 1024) ? rs * (0.125f * LOG2E) : rs;
#pragma unroll
            for (int j = 0; j < 8; ++j) o[j] = v[j] * sc;
            if (col0 < 2048) {
#pragma unroll
                for (int j = 0; j < 8; ++j) part += o[j] * o[j];
            }
        } else { pitch = SGU_PITCH;
#pragma unroll
            for (int j = 0; j < 8; ++j) { o[j] = gelu_tanh(v[j] * rs + bias[col0 + j]); }
            if (col0 >= 1024) {
#pragma unroll
                for (int j = 0; j < 8; ++j) part += o[j] * o[j];
            }
        }
        v4u w; w.x = pk2(o[0], o[1]); w.y = pk2(o[2], o[3]); w.z = pk2(o[4], o[5]); w.w = pk2(o[6], o[7]);
        *(v4u*)(proj + (size_t)row * pitch + col0) = w;
        return part;
    }
    __device__ __forceinline__ void store_part(int row, int col0, int idx, float part) const {
        if (kind == K_SGU && col0 >= 1024) vssq[(size_t)row * 16 + idx] = part;
    }
    static constexpr bool GROUPMAX = true;
    unsigned* qkmax;
    __device__ __forceinline__ bool want_groupmax(int col0) const { return kind == K_DIFF && col0 < 2048; }
    __device__ __forceinline__ void store_groupmax(int row, int col0, float m) const {
        atomicMax(qkmax + (row >> 13) * 64 + (col0 >> 5), __float_as_uint(m * 1.01f));
    }
};
struct EpiHid {
    bf16* h; const float* ssq;
    __device__ __forceinline__ float rowscale(int row) const { return row_rstd(ssq, row); }
    __device__ __forceinline__ float apply8(int row, int col0, const float (&v)[8], float rs) const {
        float o[8];
#pragma unroll
        for (int j = 0; j < 8; ++j) { const float a = fmaxf(v[j] * rs, 0.f); o[j] = a * a; }
        v4u w; w.x = pk2(o[0], o[1]); w.y = pk2(o[2], o[3]); w.z = pk2(o[4], o[5]); w.w = pk2(o[6], o[7]);
        *(v4u*)(h + (size_t)row * FF + col0) = w;
        return 0.f;
    }
    __device__ __forceinline__ void store_part(int, int, int, float) const {}
    static constexpr bool GROUPMAX = false;
    __device__ __forceinline__ bool want_groupmax(int) const { return false; }
    __device__ __forceinline__ void store_groupmax(int, int, float) const {}
};
struct EpiRes {
    const float* base; float* x; bf16* xb; float* ssq;
    __device__ __forceinline__ float rowscale(int) const { return 1.f; }
    __device__ __forceinline__ float apply8(int row, int col0, const float (&v)[8], float) const {
        const size_t off = (size_t)row * D + col0;
        const f32x4 b0 = *(const f32x4*)(base + off), b1 = *(const f32x4*)(base + off + 4);
        float o[8] = {b0.x + v[0], b0.y + v[1], b0.z + v[2], b0.w + v[3], b1.x + v[4], b1.y + v[5], b1.z + v[6], b1.w + v[7]};
        *(f32x4*)(x + off) = (f32x4){o[0], o[1], o[2], o[3]}; *(f32x4*)(x + off + 4) = (f32x4){o[4], o[5], o[6], o[7]};
        v4u w; w.x = pk2(o[0], o[1]); w.y = pk2(o[2], o[3]); w.z = pk2(o[4], o[5]); w.w = pk2(o[6], o[7]);
        *(v4u*)(xb + off) = w;
        float part = 0.f;
#pragma unroll
        for (int j = 0; j < 8; ++j) part += o[j] * o[j];
        return part;
    }
    __device__ __forceinline__ void store_part(int row, int, int idx, float part) const { ssq[(size_t)row * 16 + idx] = part; }
    static constexpr bool GROUPMAX = false;
    __device__ __forceinline__ bool want_groupmax(int) const { return false; }
    __device__ __forceinline__ void store_groupmax(int, int, float) const {}
};

template <class Epi>
__device__ __forceinline__ void gemm_naive(LAS unsigned char* lds, const bf16* A, int lda, const bf16* Bt, int M, int N, int K, const Epi& E, int vcu, int G) {
    LAS float* As = (LAS float*)lds;
    LAS float* Bs = As + 64 * 33;
    const int tid = otid();
    const int nM = M / 64, nN = N / 64;
    const int r = tid >> 3, cgp = tid & 7;
    for (int u = vcu; u < nM * nN; u += G) {
        const int pm = u / nN, pn = u % nN;
        float acc[8];
#pragma unroll
        for (int j = 0; j < 8; ++j) acc[j] = 0.f;
        for (int k0 = 0; k0 < K; k0 += 32) {
            { const int lr = tid >> 3, lc = (tid & 7) * 4;
              const v2u av = *(const v2u*)(A + (size_t)(pm * 64 + lr) * lda + k0 + lc);
              const v2u bv = *(const v2u*)(Bt + (size_t)(pn * 64 + lr) * K + k0 + lc);
              As[lr * 33 + lc + 0] = bflo(av.x); As[lr * 33 + lc + 1] = bfhi(av.x); As[lr * 33 + lc + 2] = bflo(av.y); As[lr * 33 + lc + 3] = bfhi(av.y);
              Bs[lr * 33 + lc + 0] = bflo(bv.x); Bs[lr * 33 + lc + 1] = bfhi(bv.x); Bs[lr * 33 + lc + 2] = bflo(bv.y); Bs[lr * 33 + lc + 3] = bfhi(bv.y); }
            __syncthreads();
#pragma unroll 8
            for (int kk = 0; kk < 32; ++kk) { const float a = As[r * 33 + kk];
#pragma unroll
                for (int j = 0; j < 8; ++j) acc[j] += a * Bs[(cgp * 8 + j) * 33 + kk]; }
            __syncthreads();
        }
        const int row = pm * 64 + r, col0 = pn * 64 + cgp * 8;
        const float rs = E.rowscale(row);
        float part = E.apply8(row, col0, acc, rs);
        part += __shfl_xor(part, 1); part += __shfl_xor(part, 2); part += __shfl_xor(part, 4);
        if (cgp == 0) E.store_part(row, col0, pn & 15, part);
    }
}

__device__ __forceinline__ void conv_tile(const float* W, const float* gain, int K, int N, bf16* WT, int tile, LAS unsigned char* img, int tid) {
    const int nblk = N >> 7, kb = tile / nblk, nb = tile - kb * nblk, k0 = kb << 7, n0 = nb << 7;
    const int n4 = tid & 31, kk = tid >> 5;
    f32x4 w[8];
    const float* src = W + (size_t)(k0 + 8 * kk) * N + n0 + 4 * n4;
#pragma unroll
    for (int p = 0; p < 8; ++p) w[p] = *(const f32x4*)(src + (size_t)p * N);
    float g[8];
    if (gain) { const f32x4 g0 = *(const f32x4*)(gain + k0 + 8 * kk), g1 = *(const f32x4*)(gain + k0 + 8 * kk + 4);
        g[0] = g0.x; g[1] = g0.y; g[2] = g0.z; g[3] = g0.w; g[4] = g1.x; g[5] = g1.y; g[6] = g1.z; g[7] = g1.w; }
    else {
#pragma unroll
        for (int p = 0; p < 8; ++p) g[p] = 1.f; }
#pragma unroll
    for (int jn = 0; jn < 4; ++jn) {
        v4u o; o.x = pk2(g[0] * w[0][jn], g[1] * w[1][jn]); o.y = pk2(g[2] * w[2][jn], g[3] * w[3][jn]); o.z = pk2(g[4] * w[4][jn], g[5] * w[5][jn]); o.w = pk2(g[6] * w[6][jn], g[7] * w[7][jn]);
        *(LAS v4u*)(img + (4 * n4 + jn) * 256 + ((kk ^ (n4 & 15)) << 4)) = o; }
    __syncthreads();
#pragma unroll
    for (int i = 0; i < 4; ++i) { const int c = tid + NTHR * i, n = c >> 4, kc = c & 15;
        const v4u o = *(const LAS v4u*)(img + n * 256 + ((kc ^ ((n >> 2) & 15)) << 4));
        *(v4u*)(WT + (size_t)(n0 + n) * K + k0 + 8 * kc) = o; }
    __syncthreads();
}

__device__ __forceinline__ void phase_conv(LAS unsigned char* lds, const Ctx& a, const LayerP& P, int L, int vcu, int G) {
    const int tid = otid(), lane = tid & 63, wave = __builtin_amdgcn_readfirstlane(tid >> 6);
    bf16* Wb = (bf16*)(a.ws + WS_W);
    const int gw = vcu * NWAVES + wave, NGW = G * NWAVES;
    const int nin_w = (P.kind == K_SGU) ? 2048 : 3072;
    const int I_IN = (D / 128) * (nin_w / 128), I_OUT = (D / 128) * (D / 128), I_1 = (D / 128) * (FF / 128), I_2 = (FF / 128) * (D / 128);
    const int NITEMS = I_IN + I_OUT + I_1 + I_2;
    for (int it = vcu; it < NITEMS; it += G) {
        int r = it;
        if (r < I_IN) { conv_tile(P.w_in, P.norm1, D, nin_w, Wb + WOFF_IN, r, lds, tid); continue; } r -= I_IN;
        if (r < I_OUT) { conv_tile(P.w_out, nullptr, D, D, Wb + WOFF_OUT, r, lds, tid); continue; } r -= I_OUT;
        if (r < I_1) { conv_tile(P.w1, P.norm2, D, FF, Wb + WOFF_1, r, lds, tid); continue; } r -= I_1;
        conv_tile(P.w2, nullptr, FF, D, Wb + WOFF_2, r, lds, tid);
    }
    if (P.kind == K_GLA) {
        const float* W1 = P.e0; const float* W2 = P.e1;
        for (int e = vcu * NTHR + tid; e < 512 * 1024; e += G * NTHR) {
            const int n = e >> 10, k = e & 1023;
            float s = 0.f;
#pragma unroll
            for (int r = 0; r < 16; ++r) s += W1[k * 16 + r] * W2[r * 512 + n];
            Wb[WOFF_IN + (size_t)(3072 + n) * 1024 + k] = (bf16)f2bf(s * P.norm1[k]);
        }
    }
    if (L == 0) {
        const float* x = a.in0; bf16* xb = (bf16*)(a.ws + WS_XB); float* ssq = (float*)(a.ws + WS_SSQ);
        for (int m = gw; m < NTOK; m += NGW) {
            const f32x4* xr = (const f32x4*)(x + (size_t)m * D) + lane;
            f32x4 v[4]; float s = 0.f;
#pragma unroll
            for (int j = 0; j < 4; ++j) { v[j] = xr[64 * j]; s += (v[j].x * v[j].x + v[j].y * v[j].y) + (v[j].z * v[j].z + v[j].w * v[j].w); }
            s = wave_sum(s);
            v2u* o8 = (v2u*)(xb + (size_t)m * D) + lane;
#pragma unroll
            for (int j = 0; j < 4; ++j) { v2u w; w.x = pk2(v[j].x, v[j].y); w.y = pk2(v[j].z, v[j].w); o8[64 * j] = w; }
            if (lane < 16) ssq[(size_t)m * 16 + lane] = (lane == 0) ? s : 0.f;
        }
    }
}

__device__ __forceinline__ void phase_final(const Ctx& a, int vcu, int G) {
    const int tid = otid(), lane = tid & 63, wave = tid >> 6;
    const int gw = vcu * NWAVES + wave, NGW = G * NWAVES;
    const float* ssq = (const float*)(a.ws + WS_SSQ); const float* g = a.in42;
    for (int m = gw; m < NTOK; m += NGW) {
        const float rs = row_rstd(ssq, m);
        f32x4* xr = (f32x4*)(a.out + (size_t)m * D) + lane; const f32x4* gr = (const f32x4*)g + lane;
#pragma unroll
        for (int j = 0; j < 4; ++j) { f32x4 v = xr[64 * j]; const f32x4 gg = gr[64 * j]; v.x *= rs * gg.x; v.y *= rs * gg.y; v.z *= rs * gg.z; v.w *= rs * gg.w; xr[64 * j] = v; }
    }
}

struct GlaCum { float b0[8], b1[8], tot0, tot1; };
__device__ __forceinline__ void gla_cumsum(GlaCum& c, const bf16* proj, int row0, int h, LAS float* TOT, int tid) {
    const int cp = tid & 63, part = tid >> 6;
#pragma unroll
    for (int i = 0; i < 8; ++i) { const unsigned w = *(const unsigned*)(proj + (size_t)(row0 + 8 * part + i) * GLA_PITCH + 3072 + h * 128 + 2 * cp); c.b0[i] = bflo(w); c.b1[i] = bfhi(w); }
#pragma unroll
    for (int i = 1; i < 8; ++i) { c.b0[i] += c.b0[i - 1]; c.b1[i] += c.b1[i - 1]; }
    TOT[part * 128 + 2 * cp] = c.b0[7]; TOT[part * 128 + 2 * cp + 1] = c.b1[7];
    __syncthreads();
    float o0 = 0.f, o1 = 0.f, t0 = 0.f, t1 = 0.f;
#pragma unroll
    for (int p = 0; p < 8; ++p) { const float x0 = TOT[p * 128 + 2 * cp], x1 = TOT[p * 128 + 2 * cp + 1]; if (p < part) { o0 += x0; o1 += x1; } t0 += x0; t1 += x1; }
#pragma unroll
    for (int i = 0; i < 8; ++i) { c.b0[i] += o0; c.b1[i] += o1; }
    c.tot0 = t0; c.tot1 = t1;
}
__device__ __forceinline__ void phase_gla_kv(LAS unsigned char* lds, const Ctx& a, int vcu, int G) {
    const int tid = otid();
    const bf16* proj = (const bf16*)(a.ws + WS_H); bf16* state = (bf16*)(a.ws + WS_STATE); float* dec = (float*)(a.ws + WS_DEC);
    LAS float* KE = (LAS float*)lds;
    LAS float* V = KE + 64 * 128;
    LAS float* TOT = V + 64 * 256;
    for (int u = vcu; u < NB * GLA_H * GLA_NC; u += G) {
        const int n = u % GLA_NC, bh = u / GLA_NC, h = bh % GLA_H, b = bh / GLA_H;
        const int row0 = b * T + n * GLA_C;
        GlaCum c; gla_cumsum(c, proj, row0, h, TOT, tid);
        const int cp = tid & 63, part = tid >> 6;
#pragma unroll
        for (int i = 0; i < 8; ++i) { const int t = 8 * part + i; const unsigned w = *(const unsigned*)(proj + (size_t)(row0 + t) * GLA_PITCH + 512 + h * 128 + 2 * cp);
            KE[t * 128 + 2 * cp] = bflo(w) * __expf(c.tot0 - c.b0[i]); KE[t * 128 + 2 * cp + 1] = bfhi(w) * __expf(c.tot1 - c.b1[i]); }
        if (part == 0) { dec[(size_t)u * 128 + 2 * cp] = __expf(c.tot0); dec[(size_t)u * 128 + 2 * cp + 1] = __expf(c.tot1); }
        { const int vp = tid & 127, rp = tid >> 7;
#pragma unroll
          for (int i = 0; i < 16; ++i) { const int t = 16 * rp + i; const unsigned w = *(const unsigned*)(proj + (size_t)(row0 + t) * GLA_PITCH + 1024 + h * 256 + 2 * vp);
              V[t * 256 + 2 * vp] = bflo(w); V[t * 256 + 2 * vp + 1] = bfhi(w); } }
        __syncthreads();
        const int vd = tid & 255, kh = tid >> 8;
        float acc[64];
#pragma unroll
        for (int j = 0; j < 64; ++j) acc[j] = 0.f;
        for (int t = 0; t < 64; ++t) { const float v = V[t * 256 + vd];
#pragma unroll
            for (int j = 0; j < 64; ++j) acc[j] += KE[t * 128 + kh * 64 + j] * v; }
        bf16* sp = state + ((size_t)u * 256 + vd) * 128 + kh * 64;
#pragma unroll
        for (int j = 0; j < 64; j += 8) { v4u w; w.x = pk2(acc[j], acc[j + 1]); w.y = pk2(acc[j + 2], acc[j + 3]); w.z = pk2(acc[j + 4], acc[j + 5]); w.w = pk2(acc[j + 6], acc[j + 7]); *(v4u*)(sp + j) = w; }
        __syncthreads();
    }
}
__device__ __forceinline__ void phase_gla_scan(const Ctx& a, int vcu, int G) {
    unsigned* state = (unsigned*)(a.ws + WS_STATE); const float* dec = (const float*)(a.ws + WS_DEC);
    for (int gid = vcu * NTHR + otid(); gid < NB * GLA_H * 16384; gid += G * NTHR) {
        const int bh = gid >> 14, e = gid & 16383, kp = e & 63;
        unsigned* sp = state + (size_t)bh * GLA_NC * 16384 + e;
        const float* dp = dec + (size_t)bh * GLA_NC * 128 + 2 * kp;
        float s0 = 0.f, s1 = 0.f;
        for (int n0 = 0; n0 < GLA_NC; n0 += 8) {
            unsigned w[8]; float d0[8], d1[8];
#pragma unroll
            for (int i = 0; i < 8; ++i) { w[i] = sp[(size_t)(n0 + i) * 16384]; d0[i] = dp[(n0 + i) * 128]; d1[i] = dp[(n0 + i) * 128 + 1]; }
#pragma unroll
            for (int i = 0; i < 8; ++i) { sp[(size_t)(n0 + i) * 16384] = pk2(s0, s1); s0 = d0[i] * s0 + bflo(w[i]); s1 = d1[i] * s1 + bfhi(w[i]); }
        }
    }
}
__device__ __forceinline__ void phase_gla_out(LAS unsigned char* lds, const Ctx& a, const LayerP& P, int vcu, int G) {
    const int tid = otid(), lane = tid & 63, wave = tid >> 6;
    bf16* proj = (bf16*)(a.ws + WS_H); const bf16* state = (const bf16*)(a.ws + WS_STATE);
    LAS float* QD = (LAS float*)lds;
    LAS float* KI = QD + 64 * 128;
    LAS float* ATT = KI + 64 * 128;
    LAS unsigned* Vb = (LAS unsigned*)(ATT + 64 * 64);
    LAS float* TOT = (LAS float*)(Vb + 64 * 128);
    LAS float* RSS = TOT + 8 * 128;
    for (int u = vcu; u < NB * GLA_H * GLA_NC; u += G) {
        const int n = u % GLA_NC, bh = u / GLA_NC, h = bh % GLA_H, b = bh / GLA_H;
        const int row0 = b * T + n * GLA_C;
        GlaCum c; gla_cumsum(c, proj, row0, h, TOT, tid);
        const int cp = tid & 63, part = tid >> 6;
#pragma unroll
        for (int i = 0; i < 8; ++i) { const int t = 8 * part + i;
            const unsigned wq = *(const unsigned*)(proj + (size_t)(row0 + t) * GLA_PITCH + h * 128 + 2 * cp);
            const unsigned wk = *(const unsigned*)(proj + (size_t)(row0 + t) * GLA_PITCH + 512 + h * 128 + 2 * cp);
            const float e0 = __expf(c.b0[i]), e1 = __expf(c.b1[i]);
            QD[t * 128 + 2 * cp] = bflo(wq) * 0.08838834764831845f * e0; QD[t * 128 + 2 * cp + 1] = bfhi(wq) * 0.08838834764831845f * e1;
            KI[t * 128 + 2 * cp] = bflo(wk) / e0; KI[t * 128 + 2 * cp + 1] = bfhi(wk) / e1; }
        { const int vp = tid & 127, rp = tid >> 7;
#pragma unroll
          for (int i = 0; i < 16; ++i) { const int t = 16 * rp + i; Vb[t * 128 + vp] = *(const unsigned*)(proj + (size_t)(row0 + t) * GLA_PITCH + 1024 + h * 256 + 2 * vp); } }
        __syncthreads();
        { const int cc = tid >> 3, s0 = (tid & 7) * 8; float acc[8];
#pragma unroll
          for (int j = 0; j < 8; ++j) acc[j] = 0.f;
          for (int d = 0; d < 128; ++d) { const float q = QD[cc * 128 + d];
#pragma unroll
              for (int j = 0; j < 8; ++j) acc[j] += q * KI[(s0 + j) * 128 + d]; }
#pragma unroll
          for (int j = 0; j < 8; ++j) ATT[cc * 64 + s0 + j] = (s0 + j <= cc) ? acc[j] : 0.f; }
        __syncthreads();
        const int vd = tid & 255, ch = tid >> 8;
        float acc[32];
#pragma unroll
        for (int j = 0; j < 32; ++j) acc[j] = 0.f;
        for (int s = 0; s < 64; ++s) { const unsigned w = Vb[s * 128 + (vd >> 1)]; const float v = (vd & 1) ? bfhi(w) : bflo(w);
#pragma unroll
            for (int j = 0; j < 32; ++j) acc[j] += ATT[(ch * 32 + j) * 64 + s] * v; }
        { const bf16* sp = state + ((size_t)u * 256 + vd) * 128;
          for (int d0 = 0; d0 < 128; d0 += 8) { const v4u w = *(const v4u*)(sp + d0);
              const float st[8] = {bflo(w.x), bfhi(w.x), bflo(w.y), bfhi(w.y), bflo(w.z), bfhi(w.z), bflo(w.w), bfhi(w.w)};
#pragma unroll
              for (int dd = 0; dd < 8; ++dd) {
#pragma unroll
                  for (int j = 0; j < 32; ++j) acc[j] += QD[(ch * 32 + j) * 128 + d0 + dd] * st[dd]; } } }
#pragma unroll
        for (int j = 0; j < 32; ++j) { const float s = wave_sum(acc[j] * acc[j]); if (lane == 0) RSS[wave * 32 + j] = s; }
        __syncthreads();
        const float hn = P.e3[vd];
#pragma unroll
        for (int j = 0; j < 32; ++j) { const int cc = ch * 32 + j;
            const float ss = (RSS[(ch * 4 + 0) * 32 + j] + RSS[(ch * 4 + 1) * 32 + j]) + (RSS[(ch * 4 + 2) * 32 + j] + RSS[(ch * 4 + 3) * 32 + j]);
            const float rs = 1.0f / sqrtf(ss * (1.0f / 256.0f) + EPS);
            const float g = bf2f(proj[(size_t)(row0 + cc) * GLA_PITCH + 2048 + h * 256 + vd]);
            const float o = acc[j] * rs * hn * (g / (1.f + __expf(-g)));
            proj[(size_t)(row0 + cc) * GLA_PITCH + 1024 + h * 256 + vd] = (bf16)f2bf(o); }
        __syncthreads();
    }
}

__device__ __forceinline__ void phase_sgu(LAS unsigned char* lds, const Ctx& a, const LayerP& P, int vcu, int G) {
    const int tid = otid();
    bf16* proj = (bf16*)(a.ws + WS_H); const float* vssq = (const float*)(a.ws + WS_VSSQ);
    const float* v_norm = P.e1; const float* w_s = P.e2; const float* b_s = P.e3;
    LAS float* W = (LAS float*)lds;
    LAS float* V = W + 128 * 128;
    for (int u = vcu; u < NB * (T / SGU_C) * SGU_G; u += G) {
        const int g = u % SGU_G, bc = u / SGU_G;
        const int row0 = bc * SGU_C;
        for (int e = tid; e < 128 * 128; e += NTHR) { const int t = e >> 7, s = e & 127;
            const float rs = row_rstd(vssq, row0 + s);
            W[e] = (s <= t) ? w_s[(size_t)g * 16384 + e] * rs : 0.f;
            V[e] = bf2f(proj[(size_t)(row0 + t) * SGU_PITCH + 1024 + g * 128 + s]); }
        __syncthreads();
        const int d = tid & 127, tq = tid >> 7;
        float acc[32];
#pragma unroll
        for (int j = 0; j < 32; ++j) acc[j] = 0.f;
        for (int s = 0; s < 128; ++s) { const float v = V[s * 128 + d];
#pragma unroll
            for (int j = 0; j < 32; ++j) acc[j] += W[(tq + 4 * j) * 128 + s] * v; }
        const float vn = v_norm[g * 128 + d];
#pragma unroll
        for (int j = 0; j < 32; ++j) { const int t = tq + 4 * j;
            const float sv = vn * acc[j] + b_s[g * 128 + t];
            bf16* up = proj + (size_t)(row0 + t) * SGU_PITCH + g * 128 + d;
            *up = (bf16)f2bf(bf2f(*up) * sv); }
        __syncthreads();
    }
}

__device__ __forceinline__ void phase_diff(LAS unsigned char* lds, const Ctx& a, const LayerP& P, int vcu, int G) {
    const int tid = otid(), lane = tid & 63, wave = tid >> 6;
    bf16* proj = (bf16*)(a.ws + WS_H);
    LAS float* Ks = (LAS float*)lds;
    LAS float* Vs = Ks + 64 * 132;
    LAS float* Qs = Vs + 64 * 128;
    LAS float* Ps = Qs + 32 * 128;
    float lam;
    { float s1 = 0.f, s2 = 0.f;
      for (int i = 0; i < 64; ++i) { s1 += P.e0[i] * P.e1[i]; s2 += P.e2[i] * P.e3[i]; }
      lam = __expf(s1) - __expf(s2) + LAMBDA_INIT; }
    const float* head_norm = P.e4;
    const int NU = NB * DIFF_H * (T / 32);
    for (int u = vcu; u < NU; u += G) {
        const int qb = (T / 32 - 1) - (u / (NB * DIFF_H)), bh = u % (NB * DIFF_H), h = bh % DIFF_H, b = bh / DIFF_H;
        const int q0 = qb * 32; const size_t rowbase = (size_t)b * T;
        const float slope2 = exp2f(-(float)(h + 1)) * LOG2E;
        __syncthreads();
        for (int e = tid; e < 32 * 64; e += NTHR) { const int r = e >> 6, c2 = e & 63;
            const unsigned w = *(const unsigned*)(proj + (rowbase + q0 + r) * DIFF_PITCH + h * 128 + 2 * c2);
            Qs[r * 128 + 2 * c2] = bflo(w); Qs[r * 128 + 2 * c2 + 1] = bfhi(w); }
        float m1[4], l1[4], m2[4], l2[4], oa1[4], ob1[4], oa2[4], ob2[4];
#pragma unroll
        for (int i = 0; i < 4; ++i) { m1[i] = -1e30f; m2[i] = -1e30f; l1[i] = 0.f; l2[i] = 0.f; oa1[i] = 0.f; ob1[i] = 0.f; oa2[i] = 0.f; ob2[i] = 0.f; }
        const int ntile = (q0 + 31) / 64 + 1;
        for (int kt = 0; kt < ntile; ++kt) {
            __syncthreads();
            for (int e = tid; e < 64 * 64; e += NTHR) { const int r = e >> 6, c2 = e & 63;
                const unsigned wk = *(const unsigned*)(proj + (rowbase + kt * 64 + r) * DIFF_PITCH + 1024 + h * 128 + 2 * c2);
                const unsigned wv = *(const unsigned*)(proj + (rowbase + kt * 64 + r) * DIFF_PITCH + 2048 + h * 128 + 2 * c2);
                Ks[r * 132 + 2 * c2] = bflo(wk); Ks[r * 132 + 2 * c2 + 1] = bfhi(wk);
                Vs[r * 128 + 2 * c2] = bflo(wv); Vs[r * 128 + 2 * c2 + 1] = bfhi(wv); }
            __syncthreads();
            const int kpos = kt * 64 + lane;
#pragma unroll
            for (int i = 0; i < 4; ++i) {
                const int r = wave + 8 * i, qpos = q0 + r;
                if (kt * 64 > qpos) continue;
                float s1 = 0.f, s2 = 0.f;
                const LAS f32x4* qp = (const LAS f32x4*)(Qs + r * 128); const LAS f32x4* kp = (const LAS f32x4*)(Ks + lane * 132);
#pragma unroll
                for (int d = 0; d < 16; ++d) { const f32x4 q = qp[d], k = kp[d]; s1 += (q.x * k.x + q.y * k.y) + (q.z * k.z + q.w * k.w); }
#pragma unroll
                for (int d = 16; d < 32; ++d) { const f32x4 q = qp[d], k = kp[d]; s2 += (q.x * k.x + q.y * k.y) + (q.z * k.z + q.w * k.w); }
                const float bias = slope2 * (float)(qpos - kpos);
                const bool ok = kpos <= qpos;
                s1 = ok ? s1 - bias : -1e30f; s2 = ok ? s2 - bias : -1e30f;
                const float mn1 = fmaxf(m1[i], wave_max(s1)), mn2 = fmaxf(m2[i], wave_max(s2));
                const float p1 = ok ? exp2f(s1 - mn1) : 0.f, p2 = ok ? exp2f(s2 - mn2) : 0.f;
                const float a1 = exp2f(m1[i] - mn1), a2 = exp2f(m2[i] - mn2);
                l1[i] = l1[i] * a1 + wave_sum(p1); l2[i] = l2[i] * a2 + wave_sum(p2); m1[i] = mn1; m2[i] = mn2;
                Ps[wave * 128 + lane] = p1; Ps[wave * 128 + 64 + lane] = p2;
                LDS_WAIT();
                float x1 = 0.f, y1 = 0.f, x2 = 0.f, y2 = 0.f;
                for (int j = 0; j < 64; ++j) { const float pa = Ps[wave * 128 + j], pb = Ps[wave * 128 + 64 + j]; const float va = Vs[j * 128 + lane], vb = Vs[j * 128 + 64 + lane];
                    x1 += pa * va; y1 += pa * vb; x2 += pb * va; y2 += pb * vb; }
                oa1[i] = oa1[i] * a1 + x1; ob1[i] = ob1[i] * a1 + y1; oa2[i] = oa2[i] * a2 + x2; ob2[i] = ob2[i] * a2 + y2;
                LDS_WAIT();
            }
        }
#pragma unroll
        for (int i = 0; i < 4; ++i) {
            const int r = wave + 8 * i;
            const float oa = oa1[i] / l1[i] - lam * (oa2[i] / l2[i]), ob = ob1[i] / l1[i] - lam * (ob2[i] / l2[i]);
            const float ss = wave_sum(oa * oa + ob * ob);
            const float rs = (1.0f / sqrtf(ss * (1.0f / 128.0f) + EPS)) * (1.0f - LAMBDA_INIT);
            bf16* op = proj + (rowbase + q0 + r) * DIFF_PITCH + h * 128;
            op[lane] = (bf16)f2bf(oa * rs * head_norm[lane]); op[64 + lane] = (bf16)f2bf(ob * rs * head_norm[64 + lane]);
        }
    }
}

namespace pg8 {
#define PG8_LAS __attribute__((address_space(3)))
typedef unsigned short bf16_t;
typedef short bf16x8 __attribute__((ext_vector_type(8)));
typedef float f32x4 __attribute__((ext_vector_type(4)));
typedef unsigned u32x4 __attribute__((ext_vector_type(4)));
constexpr int BM = 256, BK = 64, HALF = 128, HTB = HALF * BK * 2  , STAGE_BYTES = 8 * HTB, NXCD = 8, WGM = 8;

__host__ __device__ __forceinline__ int lds_byte(int r, int c) { const int st = (r >> 4) * 2 + (c >> 5), rr = r & 15, cc = c & 31, ob = rr * 64 + cc * 2; return st * 1024 + (ob ^ (((ob >> 9) & 1) << 5)); }
__host__ __device__ __forceinline__ void stage_rc(int b, int& R, int& C) { const int st = b / 1024, sb = b % 1024, swz = sb ^ (((sb >> 9) & 1) << 5); R = (st >> 1) * 16 + swz / 64; C = (st & 1) * 32 + (swz % 64) / 2; }
__host__ __device__ __forceinline__ int perm32(int rho) { const int n = rho >> 4, i = rho & 15; return 8 * (i >> 2) + 4 * n + (i & 3); }

struct Unit { int pm, pn; };
struct Gemm { const bf16_t* A; int lda; const bf16_t* Bt; int M, N, K; };

struct StaticOrder {
    int nM, nN, nwg, G, c;
    __host__ __device__ void init(int M, int N, int G_, int c_) { nM = M / BM; nN = N / BM; nwg = nM * nN; G = G_; c = c_; }
    __host__ __device__ bool next(int i, Unit& u) const {
        const long L = (long)i * G + c; if (L >= nwg) return false;
        int wgid = (int)L; { const int q = nwg / NXCD, r = nwg % NXCD, xcd = wgid % NXCD, off = wgid / NXCD; wgid = (xcd < r ? xcd * (q + 1) : r * (q + 1) + (xcd - r) * q) + off; }
        const int nig = WGM * nN, gid = wgid / nig, fm = gid * WGM, gsz = (nM - fm) < WGM ? (nM - fm) : WGM;
        u.pm = fm + ((wgid % nig) % gsz); u.pn = (wgid % nig) / gsz; return true;
    }
    __device__ __forceinline__ void a_ready(const Unit&) const {}
    __device__ __forceinline__ void done(const Unit&) const {}
};

template <class Epi, class Sched, bool ALIGN_EPI = false, bool SP2 = false>
__device__ __forceinline__ void gemm_phase(PG8_LAS unsigned char* lds, const Gemm g, const Sched& S, const Epi& E) {
    const int tid = otid(), wid = __builtin_amdgcn_readfirstlane(tid >> 6), lane = tid & 63, wr = wid >> 2, wc = wid & 3, fr = lane & 15, fq = lane >> 4;
    const int K = g.K, nt = K / BK, lda = g.lda;
    unsigned voffA[2], voffB[2];
#pragma unroll
    for (int i = 0; i < 2; ++i) { int R, C; stage_rc(tid * 16 + i * 8192, R, C); const int Rb = Epi::PERM ? ((R & ~31) + perm32(R & 31)) : R;
        voffA[i] = (unsigned)(R * lda + C) * 2u; voffB[i] = (unsigned)(Rb * K + C) * 2u; }
    const size_t kstep = (size_t)(BK * 2);
    const size_t hstepA = (size_t)HALF * lda * 2, hstepB = (size_t)HALF * K * 2;
    const size_t tstepA = 2 * hstepA, tstepB = 2 * hstepB;
    const unsigned ldsw = (unsigned)wid * 1024u;
    const int aoff = lds_byte(wr * 64 + fr, fq * 8), boff = lds_byte(wc * 32 + fr, fq * 8);
#define PG8_SA(b, h) (((b) * 2 + (h)) * HTB)
#define PG8_SB(b, h) ((4 + (b) * 2 + (h)) * HTB)
#define PG8_STAGE(bufoff, gbase, voff) do { _Pragma("unroll") for (int _i = 0; _i < 2; ++_i) \
        __builtin_amdgcn_global_load_lds((const unsigned*)((const char*)(gbase) + (voff)[_i]), (PG8_LAS unsigned*)(lds + (bufoff) + ldsw + _i * 8192), 16, 0, 0); } while (0)
#define PG8_LDA(dst, b, h) do { _Pragma("unroll") for (int m = 0; m < 4; ++m) _Pragma("unroll") for (int k = 0; k < 2; ++k) dst[m][k] = *(const PG8_LAS bf16x8*)(lds + PG8_SA(b, h) + aoff + m * 2048 + k * 1024); } while (0)
#define PG8_LDB(dst, b, h) do { _Pragma("unroll") for (int n = 0; n < 2; ++n) _Pragma("unroll") for (int k = 0; k < 2; ++k) dst[n][k] = *(const PG8_LAS bf16x8*)(lds + PG8_SB(b, h) + boff + n * 2048 + k * 1024); } while (0)
#define PG8_MMA(ai, bj, At, Bt) do { __builtin_amdgcn_s_setprio(1); _Pragma("unroll") for (int m = 0; m < 4; ++m) _Pragma("unroll") for (int n = 0; n < 2; ++n) _Pragma("unroll") for (int k = 0; k < 2; ++k) \
        acc[ai][bj][m][n] = __builtin_amdgcn_mfma_f32_16x16x32_bf16(Bt[n][k], At[m][k], acc[ai][bj][m][n], 0, 0, 0); __builtin_amdgcn_s_setprio(0); } while (0)
#define PG8_WAIT_V(n) asm volatile("s_waitcnt vmcnt(" #n ")" ::: "memory")
#define PG8_WAIT_L(n) asm volatile("s_waitcnt lgkmcnt(" #n ")" ::: "memory")
#define PG8_BAR __builtin_amdgcn_s_barrier()
#define PG8_SCHED __builtin_amdgcn_sched_barrier(0)
    Unit cur, nxt; int ui = 0;
    if (!S.next(0, cur)) return;
    f32x4 acc[2][2][4][2];
#pragma unroll
    for (int a = 0; a < 2; ++a)
#pragma unroll
        for (int b = 0; b < 2; ++b)
#pragma unroll
            for (int m = 0; m < 4; ++m)
#pragma unroll
                for (int n = 0; n < 2; ++n) acc[a][b][m][n] = (f32x4){0.f, 0.f, 0.f, 0.f};
    bf16x8 At[4][2], B0[2][2], B1[2][2];
    const char* cA = (const char*)g.A + (size_t)cur.pm * tstepA; const char* cB = (const char*)g.Bt + (size_t)cur.pn * tstepB;
    S.a_ready(cur);
    if constexpr (SP2) {
        PG8_STAGE(PG8_SB(0, 0), cB, voffB); PG8_STAGE(PG8_SB(0, 1), cB + hstepB, voffB); PG8_STAGE(PG8_SA(0, 0), cA, voffA); PG8_STAGE(PG8_SA(0, 1), cA + hstepA, voffA);
        if (wr == 1) PG8_BAR;
        PG8_WAIT_V(2); PG8_BAR;
        PG8_STAGE(PG8_SB(1, 0), cB + kstep, voffB); PG8_STAGE(PG8_SA(1, 0), cA + kstep, voffA); PG8_STAGE(PG8_SB(1, 1), cB + hstepB + kstep, voffB);
        PG8_WAIT_V(6); PG8_BAR;
    } else {
        PG8_STAGE(PG8_SB(0, 0), cB, voffB); PG8_STAGE(PG8_SA(0, 0), cA, voffA); PG8_STAGE(PG8_SB(0, 1), cB + hstepB, voffB); PG8_STAGE(PG8_SA(0, 1), cA + hstepA, voffA);
        if (wr == 1) PG8_BAR;
        PG8_WAIT_V(4); PG8_BAR;
        PG8_STAGE(PG8_SB(1, 0), cB + kstep, voffB); PG8_STAGE(PG8_SA(1, 0), cA + kstep, voffA); PG8_STAGE(PG8_SB(1, 1), cB + hstepB + kstep, voffB);
        PG8_WAIT_V(6); PG8_BAR;
    }
    for (;;) {
        const bool has_next = S.next(ui + 1, nxt);
        const char* nA = has_next ? (const char*)g.A + (size_t)nxt.pm * tstepA : cA; const char* nB = has_next ? (const char*)g.Bt + (size_t)nxt.pn * tstepB : cB;
        for (int t = 0; t < nt; t += 2) {
            const bool last = (t == nt - 2);
            const char* a1 = cA + (size_t)(t + 1) * kstep;
            const char* a2 = last ? nA : cA + (size_t)(t + 2) * kstep; const char* b2 = last ? nB : cB + (size_t)(t + 2) * kstep;
            const char* a3 = a2 + kstep; const char* b3 = b2 + kstep;
            if (last && has_next) S.a_ready(nxt);
            if constexpr (SP2) {
            PG8_LDB(B0, 0, 0); PG8_LDB(B1, 0, 1); PG8_SCHED; PG8_LDA(At, 0, 0); PG8_STAGE(PG8_SA(1, 1), a1 + hstepA, voffA);
            PG8_WAIT_V(8); PG8_WAIT_L(0); PG8_BAR; PG8_MMA(0, 0, At, B0); PG8_MMA(0, 1, At, B1); PG8_BAR; PG8_SCHED;
            PG8_LDA(At, 0, 1); PG8_STAGE(PG8_SB(0, 0), b2, voffB); PG8_STAGE(PG8_SB(0, 1), b2 + hstepB, voffB); PG8_STAGE(PG8_SA(0, 0), a2, voffA);
            PG8_WAIT_V(8); PG8_WAIT_L(0); PG8_BAR; PG8_MMA(1, 0, At, B0); PG8_MMA(1, 1, At, B1); PG8_BAR; PG8_SCHED;
            PG8_LDB(B0, 1, 0); PG8_LDB(B1, 1, 1); PG8_SCHED; PG8_LDA(At, 1, 0); PG8_STAGE(PG8_SA(0, 1), a2 + hstepA, voffA);
            PG8_WAIT_V(8); PG8_WAIT_L(0); PG8_BAR; PG8_MMA(0, 0, At, B0); PG8_MMA(0, 1, At, B1); PG8_BAR; PG8_SCHED;
            PG8_LDA(At, 1, 1); PG8_STAGE(PG8_SB(1, 0), b3, voffB); PG8_STAGE(PG8_SB(1, 1), b3 + hstepB, voffB); PG8_STAGE(PG8_SA(1, 0), a3, voffA);
            PG8_WAIT_V(8); PG8_WAIT_L(0); PG8_BAR; PG8_MMA(1, 0, At, B0); PG8_MMA(1, 1, At, B1); PG8_BAR; PG8_SCHED;
            } else {
            PG8_LDB(B0, 0, 0); PG8_SCHED; PG8_LDA(At, 0, 0); PG8_STAGE(PG8_SA(1, 1), a1 + hstepA, voffA);
            PG8_WAIT_L(8); PG8_BAR; PG8_WAIT_L(0); PG8_MMA(0, 0, At, B0); PG8_BAR; PG8_SCHED;
            PG8_LDB(B1, 0, 1); PG8_STAGE(PG8_SB(0, 0), b2, voffB);
            PG8_BAR; PG8_WAIT_L(0); PG8_MMA(0, 1, At, B1); PG8_BAR;
            PG8_LDA(At, 0, 1); PG8_STAGE(PG8_SA(0, 0), a2, voffA);
            PG8_BAR; PG8_WAIT_L(0); PG8_MMA(1, 0, At, B0); PG8_BAR; PG8_SCHED;
            PG8_STAGE(PG8_SB(0, 1), b2 + hstepB, voffB);
            PG8_WAIT_V(6); PG8_BAR; PG8_MMA(1, 1, At, B1); PG8_BAR;
            PG8_LDB(B0, 1, 0); PG8_SCHED; PG8_LDA(At, 1, 0); PG8_STAGE(PG8_SA(0, 1), a2 + hstepA, voffA);
            PG8_WAIT_L(8); PG8_BAR; PG8_WAIT_L(0); PG8_MMA(0, 0, At, B0); PG8_BAR; PG8_SCHED;
            PG8_LDB(B1, 1, 1); PG8_STAGE(PG8_SB(1, 0), b3, voffB);
            PG8_BAR; PG8_WAIT_L(0); PG8_MMA(0, 1, At, B1); PG8_BAR;
            PG8_LDA(At, 1, 1); PG8_STAGE(PG8_SA(1, 0), a3, voffA);
            PG8_BAR; PG8_WAIT_L(0); PG8_MMA(1, 0, At, B0); PG8_BAR; PG8_SCHED;
            PG8_STAGE(PG8_SB(1, 1), b3 + hstepB, voffB);
            PG8_WAIT_V(6); PG8_BAR; PG8_MMA(1, 1, At, B1); PG8_BAR;
            }
        }
        if constexpr (ALIGN_EPI) { if (wr == 0) PG8_BAR; }
        if constexpr (!Epi::AFTER_DRAIN) { E(acc, cur, wr, wc, fr, fq); S.done(cur); }
        if (!has_next) break;
#pragma unroll
        for (int a = 0; a < 2; ++a)
#pragma unroll
            for (int b = 0; b < 2; ++b)
#pragma unroll
                for (int m = 0; m < 4; ++m)
#pragma unroll
                    for (int n = 0; n < 2; ++n) acc[a][b][m][n] = (f32x4){0.f, 0.f, 0.f, 0.f};
        cur = nxt; cA = nA; cB = nB; ++ui;
        if constexpr (ALIGN_EPI) { if (wr == 1) PG8_BAR; }
    }
    PG8_WAIT_V(0);
    if constexpr (!ALIGN_EPI) { if (wr == 0) PG8_BAR; }
    PG8_BAR;
    if constexpr (Epi::AFTER_DRAIN) { E.fused(acc, cur, wr, wc, fr, fq, lds, wid, lane); S.done(cur); }
#undef PG8_SA
#undef PG8_SB
#undef PG8_STAGE
#undef PG8_LDA
#undef PG8_LDB
#undef PG8_MMA
#undef PG8_WAIT_V
#undef PG8_WAIT_L
#undef PG8_BAR
#undef PG8_SCHED
}
}

template <class Core> struct EpiMfma {
    static constexpr bool PERM = true, AFTER_DRAIN = false;
    Core c;
    __device__ __forceinline__ void operator()(const pg8::f32x4 (&acc)[2][2][4][2], const pg8::Unit& u, int wr, int wc, int fr, int fq) const {
        float gmax[2] = {0.f, 0.f};
#pragma unroll
        for (int ai = 0; ai < 2; ++ai)
#pragma unroll
            for (int m = 0; m < 4; ++m) {
                const int row = u.pm * 256 + ai * 128 + wr * 64 + m * 16 + fr;
                const float rs = c.rowscale(row);
                float part = 0.f;
#pragma unroll
                for (int bj = 0; bj < 2; ++bj) {
                    const int col0 = u.pn * 256 + bj * 128 + wc * 32 + 8 * fq;
                    const float v[8] = {acc[ai][bj][m][0][0], acc[ai][bj][m][0][1], acc[ai][bj][m][0][2], acc[ai][bj][m][0][3],
                                        acc[ai][bj][m][1][0], acc[ai][bj][m][1][1], acc[ai][bj][m][1][2], acc[ai][bj][m][1][3]};
                    const float p = c.apply8(row, col0, v, rs);
                    part += p;
                    if (Core::GROUPMAX) { float q = p; q += __shfl_xor(q, 16); q += __shfl_xor(q, 32); gmax[bj] = fmaxf(gmax[bj], q); }
                }
                part += __shfl_xor(part, 16); part += __shfl_xor(part, 32);
                if (fq == 0) c.store_part(row, u.pn * 256, (u.pn & 3) * 4 + wc, part);
            }
        if (Core::GROUPMAX) {
#pragma unroll
            for (int bj = 0; bj < 2; ++bj) { const int colg = u.pn * 256 + bj * 128 + wc * 32;
                if (c.want_groupmax(colg)) { const float m = wave_max(gmax[bj]); if (fr == 0 && fq == 0) c.store_groupmax(u.pm * 256, colg, m); } }
        }
    }
};
#ifndef USE_MFMA_GEMM
#define USE_MFMA_GEMM 1
#endif
template <class Core>
__device__ __forceinline__ void run_gemm(LAS unsigned char* lds, const bf16* A, int lda, const bf16* Bt, int M, int N, int K, const Core& c, int vcu, int G) {
#if USE_MFMA_GEMM
    int bxo = (int)blockIdx.x; asm volatile("" : "+s"(bxo));
    pg8::Gemm g{A, lda, Bt, M, N, K}; pg8::StaticOrder S; S.init(M, N, G, bxo);
    EpiMfma<Core> E{c};
    pg8::gemm_phase<EpiMfma<Core>, pg8::StaticOrder, true, true>(lds, g, S, E);
#else
    gemm_naive(lds, A, lda, Bt, M, N, K, c, vcu, G);
#endif
}

#include <hip/hip_bf16.h>
#include <cmath>
namespace attn_body {
using bf16=__hip_bfloat16;
using bf16x8=__attribute__((ext_vector_type(8)))short;
using s16x4=__attribute__((ext_vector_type(4)))short;
using f32x16=__attribute__((ext_vector_type(16)))float;
using u32x4=__attribute__((ext_vector_type(4)))unsigned;
constexpr int SEQ=8192,D=64,PQ=3072,PO=2048;
constexpr int NW=8,QBLK=32,QB=QBLK*NW,KVBLK=64,NQB=SEQ/QB;
__device__ __forceinline__ int crow(int r,int hi){return (r&3)+8*(r>>2)+4*hi;}
#define SBAR() __builtin_amdgcn_sched_barrier(0)
__device__ __forceinline__ void cmask(f32x16&p0,f32x16&p1,int jb,int qrel,int hi){
  const float NEG=-INFINITY; int kb=64*jb+4*hi;
  #pragma unroll
  for(int r=0;r<16;++r){int kv=kb+(r&3)+8*(r>>2); if(kv>qrel)p0[r]=NEG; if(kv+32>qrel)p1[r]=NEG;}
}

constexpr int NSLOT=3, SLOTB=8192;
constexpr int LDS_K=0, LDS_V=NSLOT*SLOTB, LDS_WS=2*NSLOT*SLOTB, LDS_OST=LDS_WS+NW*64*4, LDS_BYTES=LDS_OST+NW*4096;
constexpr float C2=0.125f*1.4426950408889634f;
__device__ __forceinline__ void glds16(const void*gsrc,unsigned lds_dst){unsigned keep;
  asm volatile("s_mov_b32 %0, m0\n\ts_mov_b32 m0, %2\n\ts_nop 0\n\tglobal_load_lds_dwordx4 %1, off\n\ts_mov_b32 m0, %0":"=&s"(keep):"v"(gsrc),"s"(lds_dst):"memory");}
__device__ __forceinline__ float max3f(float a,float b,float c){float r;asm("v_max3_f32 %0, %1, %2, %3":"=v"(r):"v"(a),"v"(b),"v"(c));return r;}
__device__ __forceinline__ float max2f(float a,float b){float r;asm("v_max_f32_e32 %0, %1, %2":"=v"(r):"v"(a),"v"(b));return r;}
__device__ __forceinline__ float fadd_s(float a,float b){float r;asm("v_add_f32_e32 %0, %1, %2":"=v"(r):"v"(a),"v"(b));return r;}
__device__ __forceinline__ float fsub_s(float a,float b){float r;asm("v_sub_f32_e32 %0, %1, %2":"=v"(r):"v"(a),"v"(b));return r;}
typedef float f32x2_t __attribute__((ext_vector_type(2))); typedef __bf16 bf16x2_t __attribute__((ext_vector_type(2)));
__device__ __forceinline__ unsigned cvtpk_s(float lo,float hi){f32x2_t v={lo,hi};bf16x2_t b=__builtin_convertvector(v,bf16x2_t);return __builtin_bit_cast(unsigned,b);}
#define WAIT_BAR(N) asm volatile("s_waitcnt vmcnt(" #N ") lgkmcnt(0)\n\ts_barrier":::"memory")

__device__ __forceinline__ void qkt(f32x16&p0,f32x16&p1,const char*Kslot,const bf16x8*qr,const f32x16&negm,int r32,int hi){
  const char*kb=Kslot+hi*1024+r32*16;
  #pragma unroll
  for(int d0=0;d0<4;++d0){
    const bf16x8 b0=*reinterpret_cast<const bf16x8*>(kb+d0*2048);
    const bf16x8 b1=*reinterpret_cast<const bf16x8*>(kb+d0*2048+512);
    if(d0==0){p0=__builtin_amdgcn_mfma_f32_32x32x16_bf16(b0,qr[0],negm,0,0,0);p1=__builtin_amdgcn_mfma_f32_32x32x16_bf16(b1,qr[0],negm,0,0,0);}
    else{p0=__builtin_amdgcn_mfma_f32_32x32x16_bf16(b0,qr[d0],p0,0,0,0);p1=__builtin_amdgcn_mfma_f32_32x32x16_bf16(b1,qr[d0],p1,0,0,0);}}
}
typedef __attribute__((address_space(3))) const char* lds_cptr;
typedef short v4i16_t __attribute__((ext_vector_type(4)));
__device__ __forceinline__ void kload8(bf16x8*kf,lds_cptr kp){
  kf[0]=*(const __attribute__((address_space(3))) bf16x8*)(kp);      kf[1]=*(const __attribute__((address_space(3))) bf16x8*)(kp+512);
  kf[2]=*(const __attribute__((address_space(3))) bf16x8*)(kp+2048); kf[3]=*(const __attribute__((address_space(3))) bf16x8*)(kp+2560);
  kf[4]=*(const __attribute__((address_space(3))) bf16x8*)(kp+4096); kf[5]=*(const __attribute__((address_space(3))) bf16x8*)(kp+4608);
  kf[6]=*(const __attribute__((address_space(3))) bf16x8*)(kp+6144); kf[7]=*(const __attribute__((address_space(3))) bf16x8*)(kp+6656);
}
__device__ __forceinline__ void kload2(bf16x8*kf,lds_cptr kp,int j){ kf[2*j]=*(const __attribute__((address_space(3))) bf16x8*)(kp+j*2048); kf[2*j+1]=*(const __attribute__((address_space(3))) bf16x8*)(kp+j*2048+512); }
__device__ __forceinline__ s16x4 vtr(lds_cptr p){ return __builtin_bit_cast(s16x4,__builtin_amdgcn_ds_read_tr16_b64_v4i16((__attribute__((address_space(3))) v4i16_t*)p)); }
__device__ __forceinline__ float rowmax(const f32x16&p0,const f32x16&p1){
  float a=max3f(p0[0],p0[1],p1[0]),b=max3f(p0[2],p0[3],p1[1]);a=max3f(a,p1[2],p1[3]);
  #pragma unroll
  for(int r=4;r<16;r+=4){a=max3f(a,p0[r],p0[r+1]);b=max3f(b,p0[r+2],p0[r+3]);a=max3f(a,p1[r],p1[r+1]);b=max3f(b,p1[r+2],p1[r+3]);}
  const float m=max2f(a,b);
  auto rr=__builtin_amdgcn_permlane32_swap(__float_as_uint(m),__float_as_uint(m),false,false);
  return max2f(__uint_as_float(rr[0]),__uint_as_float(rr[1]));
}
__device__ __forceinline__ void pv(f32x16*o,int vb,bf16x8 pa0,bf16x8 pa1,bf16x8 pa2,bf16x8 pa3){
  #pragma unroll
  for(int d0=0;d0<2;++d0){s16x4 lo[4],hi[4];
    #pragma unroll
    for(int ks=0;ks<4;++ks){
      asm volatile("ds_read_b64_tr_b16 %0,%1 offset:%c2":"=&v"(lo[ks]):"v"(vb),"i"(d0*4096+ks*1024):"memory");
      asm volatile("ds_read_b64_tr_b16 %0,%1 offset:%c2":"=&v"(hi[ks]):"v"(vb),"i"(d0*4096+ks*1024+512):"memory");}
    asm volatile("s_waitcnt lgkmcnt(0)":::"memory");SBAR();
    #define PK(k) (bf16x8){lo[k][0],lo[k][1],lo[k][2],lo[k][3],hi[k][0],hi[k][1],hi[k][2],hi[k][3]}
    o[d0]=__builtin_amdgcn_mfma_f32_32x32x16_bf16(pa0,PK(0),o[d0],0,0,0);
    o[d0]=__builtin_amdgcn_mfma_f32_32x32x16_bf16(pa1,PK(1),o[d0],0,0,0);
    o[d0]=__builtin_amdgcn_mfma_f32_32x32x16_bf16(pa2,PK(2),o[d0],0,0,0);
    o[d0]=__builtin_amdgcn_mfma_f32_32x32x16_bf16(pa3,PK(3),o[d0],0,0,0);
    #undef PK
  }
}

#ifndef ATTN_STORE16
#define ATTN_STORE16(p,v) (*(u32x4*)(p)=(v))
#endif
template<int THRL> __device__ __forceinline__ void attn_unit(int b,int qb,int t0,const bf16*Q,const bf16*K,const bf16*V,bf16*O,float slope2,char*shm){
  const int tid=otid(),lane=tid&63,r32=lane&31,hi=lane>>5; const int wid=__builtin_amdgcn_readfirstlane(tid>>6);
  const long rowbase=(long)b*SEQ; const int q0=qb*QB;
  const bf16*Qw=Q+(rowbase+q0+wid*QBLK)*PQ;
  const bf16*Kh=K+(rowbase+(long)t0*KVBLK)*PQ,*Vh=V+(rowbase+(long)t0*KVBLK)*PQ;
  const unsigned lds0=(unsigned)(uintptr_t)shm;
  float*wsf=(float*)(shm+LDS_WS)+wid*64;
  const bf16*ksrc=Kh+(long)lane*PQ+wid*8;
  const bf16*vsrc=Vh+(long)(16*(wid&3)+(lane>>2))*PQ+(wid>>2)*32+(lane&3)*8;
  const unsigned kdst=lds0+LDS_K+wid*1024, vdst=lds0+LDS_V+wid*1024;
  #define DMA_K(t,slot) glds16(ksrc+(long)(t)*KVBLK*PQ,(unsigned)__builtin_amdgcn_readfirstlane(kdst+(slot)))
  #define DMA_V(t,slot) glds16(vsrc+(long)(t)*KVBLK*PQ,(unsigned)__builtin_amdgcn_readfirstlane(vdst+(slot)))
  const int vb0=(int)(lds0+LDS_V)+((lane>>4)&1)*32+(lane&3)*8+(4*hi+((lane&15)>>2))*64;
  const char*Kbase=shm+LDS_K; bf16x8 kf[8];
  const lds_cptr shm3=(lds_cptr)shm; const lds_cptr kp0=shm3+LDS_K+hi*1024+r32*16; const lds_cptr vp0=shm3+LDS_V+((lane>>4)&1)*32+(lane&3)*8+(4*hi+((lane&15)>>2))*64;
  const int NT=(q0+QB)/KVBLK-t0;
  DMA_K(0,0);DMA_V(0,0);DMA_K(1,SLOTB);
  bf16x8 qr[4];
  #pragma unroll
  for(int d0=0;d0<4;++d0)qr[d0]=*reinterpret_cast<const bf16x8*>(&Qw[(long)r32*PQ+d0*16+hi*8]);
  float l_reg=0.f;f32x16 o[2];o[0]=f32x16{};o[1]=f32x16{};f32x16 negm;
  _Pragma("unroll") for(int r=0;r<16;++r)negm[r]=slope2*(float)crow(r,hi);
  asm volatile("":"+v"(negm)); const float b32=32.f*slope2, step64=64.f*slope2;
  const int qrel=wid*QBLK+r32;
  #define CMASK(P0,P1,t) do{int jb_=(t)-(NT-4); if(jb_>=0)cmask(P0,P1,jb_,qrel,hi);}while(0)
  bool resc=false;
  #define START(P0,P1) do{ const float rm=rowmax(P0,P1); resc=false; \
    { const float dl=rm; \
      _Pragma("unroll") for(int r=0;r<16;++r){P0[r]=fsub_s(P0[r],dl);P1[r]=fsub_s(P1[r],dl);} \
      const float adj_=step64-dl; _Pragma("unroll") for(int r=0;r<16;++r)negm[r]+=adj_; asm volatile("":"+v"(negm)); } \
    _Pragma("unroll") for(int r=0;r<16;++r)P0[r]=__builtin_amdgcn_exp2f(P0[r]); }while(0)
  #define RESC() do{ if(resc){ asm volatile("s_waitcnt lgkmcnt(0)":::"memory"); \
      _Pragma("unroll") for(int d_=0;d_<2;++d_) _Pragma("unroll") for(int r=0;r<16;++r)o[d_][r]*=wsf[crow(r,hi)]; } }while(0)
  f32x16 pA0,pA1,pB0,pB1;
  int sl_prev=0,sl_cur=0,sl_next=SLOTB;
  #define ROT() do{sl_prev=sl_cur;sl_cur=sl_next;sl_next=(sl_next==(NSLOT-1)*SLOTB)?0:sl_next+SLOTB;}while(0)
  DMA_K(2,2*SLOTB);
  WAIT_BAR(3);
  qkt(pA0,pA1,Kbase,qr,negm,r32,hi);asm volatile("s_nop 15\n\ts_nop 7":"+v"(pA0),"+v"(pA1));
  _Pragma("unroll") for(int r=0;r<16;++r)pA1[r]+=b32;
  CMASK(pA0,pA1,0);
  START(pA0,pA1);
  _Pragma("unroll") for(int r=0;r<16;++r)pA1[r]=__builtin_amdgcn_exp2f(pA1[r]);
  WAIT_BAR(0);
  DMA_K(3,0);DMA_V(1,SLOTB);
  ROT();
  kload8(kf,kp0+sl_cur);
  WAIT_BAR(2);
  s16x4 vlo[8],vhi[8]; u32x4 pw0,pw1,pw2,pw3;
  #define PKW(P,B) cvtpk_s(P[B],P[B+1])
  #define PAF(k) __builtin_bit_cast(bf16x8,pw##k)
  #define VFR(i) (bf16x8){vlo[i][0],vlo[i][1],vlo[i][2],vlo[i][3],vhi[i][0],vhi[i][1],vhi[i][2],vhi[i][3]}
  #define PIN(x) asm volatile("":"+v"(x))
  #define MX3(a,b,c) __builtin_fmaxf(__builtin_fmaxf((a),(b)),(c))
  #define GAPA(MF,A0,A1,A2,A3,W0,W1,PW) do{ MF; sacc+=A0; sacc+=A1; sacc+=A2; sacc+=A3; PIN(sacc); W0; W1; PIN(PW); SBAR(); }while(0)
  #define EX(v) __builtin_amdgcn_exp2f(v)
  #define GAPB(MF,X,B) do{ MF; X[B]=EX(X[B]); X[B+1]=EX(X[B+1]); X[B+2]=EX(X[B+2]); X[B+3]=EX(X[B+3]); PIN(X); SBAR(); }while(0)
  #define VRD(i) do{ vlo[i]=vtr(vp_+(((i)>>2)*4096+((i)&3)*1024)); vhi[i]=vtr(vp_+(((i)>>2)*4096+((i)&3)*1024+512)); }while(0)
  #define KRD(G,j) do{ if(G){ kload2(kf,kp0+sl_next,j); SBAR(); } }while(0)
  #define STEP(C0,C1,P0,P1,t,GK,GV,GL) do{ SBAR(); \
    const lds_cptr vp_=vp0+sl_prev; \
    VRD(0); SBAR(); float sacc=(P0[0]+P0[1]); \
    GAPA(C0=__builtin_amdgcn_mfma_f32_32x32x16_bf16(kf[0],qr[0],negm,0,0,0), P0[2],P0[3],P0[4],P0[5],     pw0[0]=PKW(P0,0), pw0[1]=PKW(P0,2), pw0); \
    VRD(4); SBAR(); GAPA(C1=__builtin_amdgcn_mfma_f32_32x32x16_bf16(kf[1],qr[0],negm,0,0,0), P0[6],P0[7],P0[8],P0[9],     pw0[2]=PKW(P0,4), pw0[3]=PKW(P0,6), pw0); \
    VRD(1); SBAR(); GAPA(C0=__builtin_amdgcn_mfma_f32_32x32x16_bf16(kf[2],qr[1],C0,0,0,0),   P0[10],P0[11],P0[12],P0[13], pw1[0]=PKW(P0,8), pw1[1]=PKW(P0,10), pw1); \
    VRD(5); SBAR(); GAPA(C1=__builtin_amdgcn_mfma_f32_32x32x16_bf16(kf[3],qr[1],C1,0,0,0),   P0[14],P0[15],P1[0],P1[1],   pw1[2]=PKW(P0,12),pw1[3]=PKW(P0,14), pw1); \
    VRD(2); SBAR(); GAPA(C0=__builtin_amdgcn_mfma_f32_32x32x16_bf16(kf[4],qr[2],C0,0,0,0),   P1[2],P1[3],P1[4],P1[5],     pw2[0]=PKW(P1,0), pw2[1]=PKW(P1,2), pw2); \
    VRD(6); SBAR(); GAPA(C1=__builtin_amdgcn_mfma_f32_32x32x16_bf16(kf[5],qr[2],C1,0,0,0),   P1[6],P1[7],P1[8],P1[9],     pw2[2]=PKW(P1,4), pw2[3]=PKW(P1,6), pw2); \
    VRD(3); SBAR(); GAPA(C0=__builtin_amdgcn_mfma_f32_32x32x16_bf16(kf[6],qr[3],C0,0,0,0),   P1[10],P1[11],P1[12],P1[13], pw3[0]=PKW(P1,8), pw3[1]=PKW(P1,10), pw3); \
    VRD(7); SBAR(); GAPA(C1=__builtin_amdgcn_mfma_f32_32x32x16_bf16(kf[7],qr[3],C1,0,0,0),   P1[14],P1[15],0.f,0.f,       pw3[2]=PKW(P1,12),pw3[3]=PKW(P1,14), pw3); \
    l_reg+=sacc; \
    if(GK){DMA_K((t)+3,sl_cur);} if(GV){DMA_V((t)+1,sl_next);} \
    _Pragma("unroll") for(int r=0;r<16;++r)C1[r]+=b32; \
    CMASK(C0,C1,t); \
    { float a=MX3(C0[0],C0[1],C1[0]),b=MX3(C0[2],C0[3],C1[1]); a=MX3(a,C1[2],C1[3]); \
      _Pragma("unroll") for(int r=4;r<16;r+=4){a=MX3(a,C0[r],C0[r+1]);b=MX3(b,C0[r+2],C0[r+3]);a=MX3(a,C1[r],C1[r+1]);b=MX3(b,C1[r+2],C1[r+3]);} \
      float rm=__builtin_fmaxf(a,b); { auto rr=__builtin_amdgcn_permlane32_swap(__float_as_uint(rm),__float_as_uint(rm),false,false); rm=__builtin_fmaxf(__uint_as_float(rr[0]),__uint_as_float(rr[1])); } \
      resc=false; float adj_=step64; \
      if(__any(rm>(float)THRL)){ const float dl=__builtin_fmaxf(rm,0.f); adj_-=dl; \
        _Pragma("unroll") for(int r=0;r<16;++r){C0[r]-=dl;C1[r]-=dl;} \
        const float f=__builtin_amdgcn_exp2f(-dl); l_reg*=f; if(hi==0)wsf[r32]=f; resc=true; } \
      _Pragma("unroll") for(int r=0;r<16;++r)negm[r]+=adj_; asm volatile("":"+v"(negm)); } \
    SBAR(); \
    GAPB(o[0]=__builtin_amdgcn_mfma_f32_32x32x16_bf16(PAF(0),VFR(0),o[0],0,0,0), C0,0); \
    GAPB(o[1]=__builtin_amdgcn_mfma_f32_32x32x16_bf16(PAF(0),VFR(4),o[1],0,0,0), C0,4); \
    KRD(GL,0); GAPB(o[0]=__builtin_amdgcn_mfma_f32_32x32x16_bf16(PAF(1),VFR(1),o[0],0,0,0), C0,8); \
    KRD(GL,1); GAPB(o[1]=__builtin_amdgcn_mfma_f32_32x32x16_bf16(PAF(1),VFR(5),o[1],0,0,0), C0,12); \
    KRD(GL,2); GAPB(o[0]=__builtin_amdgcn_mfma_f32_32x32x16_bf16(PAF(2),VFR(2),o[0],0,0,0), C1,0); \
    KRD(GL,3); GAPB(o[1]=__builtin_amdgcn_mfma_f32_32x32x16_bf16(PAF(2),VFR(6),o[1],0,0,0), C1,4); \
    GAPB(o[0]=__builtin_amdgcn_mfma_f32_32x32x16_bf16(PAF(3),VFR(3),o[0],0,0,0), C1,8); \
    GAPB(o[1]=__builtin_amdgcn_mfma_f32_32x32x16_bf16(PAF(3),VFR(7),o[1],0,0,0), C1,12); \
    }while(0)
  int t=1;
  #undef CMASK
  #define CMASK(P0,P1,t) do{}while(0)
  for(;t+5<NT;t+=2){
    STEP(pB0,pB1,pA0,pA1,t,true,true,true);     WAIT_BAR(2); RESC(); ROT();
    STEP(pA0,pA1,pB0,pB1,t+1,true,true,true);   WAIT_BAR(2); RESC(); ROT();
  }
  #undef CMASK
  #define CMASK(P0,P1,t) do{int jb_=(t)-(NT-4); if(jb_>=0)cmask(P0,P1,jb_,qrel,hi);}while(0)
  #define ENDW(tt) do{ if((tt)+3<NT){WAIT_BAR(2);} else if((tt)+2<NT){WAIT_BAR(1);} else {WAIT_BAR(0);} }while(0)
  for(;t+1<NT;t+=2){
    STEP(pB0,pB1,pA0,pA1,t,(t+3<NT),(t+1<NT),(t+1<NT));       ENDW(t);   RESC(); ROT();
    STEP(pA0,pA1,pB0,pB1,t+1,(t+4<NT),(t+2<NT),(t+2<NT));     ENDW(t+1); RESC(); ROT();
  }
  STEP(pB0,pB1,pA0,pA1,NT-1,false,false,false); RESC();
  { float sacc=pB0[0]+pB0[1]; _Pragma("unroll") for(int r=2;r<16;++r)sacc+=pB0[r]; _Pragma("unroll") for(int r=0;r<16;++r)sacc+=pB1[r]; l_reg+=sacc;
    pw0=(u32x4){PKW(pB0,0),PKW(pB0,2),PKW(pB0,4),PKW(pB0,6)};pw1=(u32x4){PKW(pB0,8),PKW(pB0,10),PKW(pB0,12),PKW(pB0,14)};pw2=(u32x4){PKW(pB1,0),PKW(pB1,2),PKW(pB1,4),PKW(pB1,6)};pw3=(u32x4){PKW(pB1,8),PKW(pB1,10),PKW(pB1,12),PKW(pB1,14)};
    SBAR(); pv(o,vb0+sl_cur,PAF(0),PAF(1),PAF(2),PAF(3)); }
  #undef PKW
  #undef PAF
  #undef VFR
  #undef PIN
  #undef MX3
  #undef GAPA
  #undef GAPB
  #undef EX
  #undef VRD
  #undef KRD
  #undef STEP
  #undef ENDW
  {auto rr=__builtin_amdgcn_permlane32_swap(__float_as_uint(l_reg),__float_as_uint(l_reg),false,false);l_reg=__uint_as_float(rr[0])+__uint_as_float(rr[1]);}
  if(hi==0)wsf[32+r32]=l_reg;asm volatile("s_waitcnt lgkmcnt(0)":::"memory");
  float rli[16];
  #pragma unroll
  for(int r=0;r<16;++r)rli[r]=__builtin_amdgcn_rcpf(wsf[32+crow(r,hi)]);
  bf16*Ow=O+(rowbase+q0+wid*QBLK)*PO;
  { bf16*stg=(bf16*)(shm+LDS_OST)+wid*2048;
    #pragma unroll
    for(int r=0;r<16;++r){const int orow=crow(r,hi);
      #pragma unroll
      for(int d0=0;d0<2;++d0)stg[orow*64+d0*32+r32]=__float2bfloat16(o[d0][r]*rli[r]);}
    asm volatile("s_waitcnt lgkmcnt(0)":::"memory");
    #pragma unroll
    for(int i=0;i<4;++i){const int row=i*8+(lane>>3),ch=lane&7; const u32x4 v=*(const u32x4*)(stg+row*64+ch*8); ATTN_STORE16(Ow+(long)row*PO+ch*8,v);} }
  asm volatile("s_waitcnt lgkmcnt(0)\n\ts_barrier":::"memory");
  #undef DMA_K
  #undef DMA_V
  #undef CMASK
  #undef START
  #undef RESC
  #undef ROT
}
constexpr int ATTN_LDS_BYTES=LDS_BYTES;
#undef SBAR
#undef WAIT_BAR
}

#ifndef USE_MFMA_ATTN
#define USE_MFMA_ATTN 1
#endif
__device__ __forceinline__ void phase_diff_mfma(char* shm, LAS unsigned char* lds, const Ctx& a, int vcu, int G) {
    bf16* proj = (bf16*)(a.ws + WS_H); bf16* o12 = (bf16*)(a.ws + WS_STATE);
    unsigned* ctl = (unsigned*)(a.ws + WS_CTL);
    volatile LAS unsigned* qslot = (volatile LAS unsigned*)(lds + MISC_OFF) + 16;
    for (;;) {
        const int tid = otid();
        if (tid == 0) *qslot = atomicAdd(ctl + CW_QUEUE, 1u);
        __syncthreads();
        const unsigned idx = (unsigned)__builtin_amdgcn_readfirstlane((int)*qslot);
        __syncthreads();
        if (idx >= (unsigned)(NB * DIFF_H * 2 * 32)) break;
        const int qb = 31 - (int)(idx >> 5), rem = idx & 31, b = rem >> 4, h = (rem >> 1) & 7, r = rem & 1;
        const float slope2 = exp2f(-(float)(h + 1)) * LOG2E;
        int t0 = 0;
        { const unsigned* qm = ctl + CW_QKMAX + b * 64; const int g0 = (h * 128 + r * 64) >> 5;
          const float pq = __uint_as_float(qm[g0]) + __uint_as_float(qm[g0 + 1]), pk = __uint_as_float(qm[32 + g0]) + __uint_as_float(qm[32 + g0 + 1]);
          const float smax = sqrtf(pq * pk);
          const float d = (float)(qb * 256) - (152.0f + 2.1f * smax) / slope2;
          if (d > 0.f) t0 = ((int)d >> 6) & ~1;
          if (t0 > 4 * qb) t0 = 4 * qb; }
#pragma nounroll
        for (int vh = 0; vh < 2; ++vh)
            attn_body::attn_unit<8>(b, qb, t0, (const attn_body::bf16*)(proj + h * 128 + r * 64), (const attn_body::bf16*)(proj + 1024 + h * 128 + r * 64),
                                    (const attn_body::bf16*)(proj + 2048 + h * 128 + vh * 64), (attn_body::bf16*)(o12 + r * 1024 + h * 128 + vh * 64), slope2, shm);
    }
}
__device__ __forceinline__ void phase_diff_combine(const Ctx& a, const LayerP& P, int vcu, int G) {
    const int tid = otid(), lane = tid & 63, wave = tid >> 6;
    bf16* proj = (bf16*)(a.ws + WS_H); const bf16* o12 = (const bf16*)(a.ws + WS_STATE);
    float lam;
    { float s1 = 0.f, s2 = 0.f;
      for (int i = 0; i < 64; ++i) { s1 += P.e0[i] * P.e1[i]; s2 += P.e2[i] * P.e3[i]; }
      lam = __expf(s1) - __expf(s2) + LAMBDA_INIT; }
    const int h = lane >> 3, sub = lane & 7;
    float hn[16];
#pragma unroll
    for (int j = 0; j < 16; ++j) hn[j] = P.e4[sub * 16 + j] * (1.0f - LAMBDA_INIT);
    const int gw = vcu * NWAVES + wave, NGW = G * NWAVES;
    for (int row = gw; row < NTOK; row += NGW) {
        const bf16* p1 = o12 + (size_t)row * 2048 + h * 128 + sub * 16;
        const v4u a0 = *(const v4u*)p1, a1 = *(const v4u*)(p1 + 8), b0 = *(const v4u*)(p1 + 1024), b1 = *(const v4u*)(p1 + 1032);
        const unsigned aw[8] = {a0.x, a0.y, a0.z, a0.w, a1.x, a1.y, a1.z, a1.w}, bw[8] = {b0.x, b0.y, b0.z, b0.w, b1.x, b1.y, b1.z, b1.w};
        float o[16]; float ss = 0.f;
#pragma unroll
        for (int j = 0; j < 8; ++j) { o[2 * j] = bflo(aw[j]) - lam * bflo(bw[j]); o[2 * j + 1] = bfhi(aw[j]) - lam * bfhi(bw[j]); ss += o[2 * j] * o[2 * j] + o[2 * j + 1] * o[2 * j + 1]; }
        ss += __shfl_xor(ss, 1); ss += __shfl_xor(ss, 2); ss += __shfl_xor(ss, 4);
        const float rs = 1.0f / sqrtf(ss * (1.0f / 128.0f) + EPS);
        v4u w0, w1;
        w0.x = pk2(o[0] * rs * hn[0], o[1] * rs * hn[1]); w0.y = pk2(o[2] * rs * hn[2], o[3] * rs * hn[3]); w0.z = pk2(o[4] * rs * hn[4], o[5] * rs * hn[5]); w0.w = pk2(o[6] * rs * hn[6], o[7] * rs * hn[7]);
        w1.x = pk2(o[8] * rs * hn[8], o[9] * rs * hn[9]); w1.y = pk2(o[10] * rs * hn[10], o[11] * rs * hn[11]); w1.z = pk2(o[12] * rs * hn[12], o[13] * rs * hn[13]); w1.w = pk2(o[14] * rs * hn[14], o[15] * rs * hn[15]);
        bf16* op = proj + (size_t)row * DIFF_PITCH + h * 128 + sub * 16;
        *(v4u*)op = w0; *(v4u*)(op + 8) = w1;
    }
}

typedef short mbf16x8 __attribute__((ext_vector_type(8)));
typedef short ms16x4 __attribute__((ext_vector_type(4)));
typedef float mf32x16 __attribute__((ext_vector_type(16)));
#define MFMA32(a, b, c) __builtin_amdgcn_mfma_f32_32x32x16_bf16(a, b, c, 0, 0, 0)
__device__ __forceinline__ int crow32(int r, int hi) { return (r & 3) + 8 * (r >> 2) + 4 * hi; }
__device__ __forceinline__ mbf16x8 frag_rk(const LAS unsigned char* base, int stride, int row0, int k0, int lane) {
    return *(const LAS mbf16x8*)(base + (row0 + (lane & 31)) * stride + (k0 + 8 * (lane >> 5)) * 2);
}
__device__ __forceinline__ mbf16x8 frag_kn(const LAS unsigned char* base, int stride, int k0, int n0, int lane) {
    const int i = lane & 15, g = lane >> 4;
    const LAS unsigned char* p = base + (k0 + 8 * (g >> 1) + (i >> 2)) * stride + (n0 + 16 * (g & 1) + 4 * (i & 3)) * 2;
    const ms16x4 lo = __builtin_bit_cast(ms16x4, __builtin_amdgcn_ds_read_tr16_b64_v4i16((LAS ms16x4*)p));
    const ms16x4 hi = __builtin_bit_cast(ms16x4, __builtin_amdgcn_ds_read_tr16_b64_v4i16((LAS ms16x4*)(p + 4 * stride)));
    return (mbf16x8){lo[0], lo[1], lo[2], lo[3], hi[0], hi[1], hi[2], hi[3]};
}
__device__ __forceinline__ mf32x16 zero16() { mf32x16 z;
#pragma unroll
    for (int r = 0; r < 16; ++r) z[r] = 0.f; return z; }

__device__ __forceinline__ void phase_sgu_mfma(LAS unsigned char* lds, const Ctx& a, const LayerP& P, int vcu, int G) {
    const int tid = otid(), lane = tid & 63, wave = __builtin_amdgcn_readfirstlane(tid >> 6);
    bf16* proj = (bf16*)(a.ws + WS_H); const float* vssq = (const float*)(a.ws + WS_VSSQ);
    const float* v_norm = P.e1; const float* w_s = P.e2; const float* b_s = P.e3;
    constexpr int SA = 272, SV = 320, SO = 132;
    LAS unsigned char* WA = lds;
    LAS unsigned char* VV = lds + 128 * SA;
    LAS float* RS = (LAS float*)(lds + 128 * SA + 128 * SV);
    LAS float* OS = (LAS float*)lds;
    const int tm = wave & 3, nh = wave >> 2, hi = lane >> 5;
    for (int u = vcu; u < NB * (T / SGU_C) * SGU_G; u += G) {
        const int g = u % SGU_G, bc = u / SGU_G;
        const int row0 = bc * SGU_C;
        if (tid < 128) RS[tid] = row_rstd(vssq, row0 + tid);
#pragma unroll
        for (int i = 0; i < 4; ++i) { const int ch = tid + NTHR * i, r = ch >> 4, c16 = ch & 15;
            const v4u w = *(const v4u*)(proj + (size_t)(row0 + r) * SGU_PITCH + 1024 + g * 128 + c16 * 8);
            *(LAS v4u*)(VV + r * SV + c16 * 16) = w; }
        __syncthreads();
#pragma unroll
        for (int i = 0; i < 8; ++i) { const int idx = tid + NTHR * i, t = idx >> 5, s4 = (idx & 31) * 4;
            const f32x4 w = *(const f32x4*)(w_s + (size_t)g * 16384 + t * 128 + s4);
            const float x0 = (s4 + 0 <= t) ? w.x * RS[s4 + 0] : 0.f, x1 = (s4 + 1 <= t) ? w.y * RS[s4 + 1] : 0.f, x2 = (s4 + 2 <= t) ? w.z * RS[s4 + 2] : 0.f, x3 = (s4 + 3 <= t) ? w.w * RS[s4 + 3] : 0.f;
            v2u o; o.x = pk2(x0, x1); o.y = pk2(x2, x3); *(LAS v2u*)(WA + t * SA + s4 * 2) = o; }
        __syncthreads();
        mf32x16 acc0 = zero16(), acc1 = zero16();
        for (int ks = 0; ks < 2 * (tm + 1); ++ks) {
            const mbf16x8 af = frag_rk(WA, SA, 32 * tm, 16 * ks, lane);
            const mbf16x8 b0 = frag_kn(VV, SV, 16 * ks, 64 * nh, lane), b1 = frag_kn(VV, SV, 16 * ks, 64 * nh + 32, lane);
            acc0 = MFMA32(af, b0, acc0); acc1 = MFMA32(af, b1, acc1);
        }
        __syncthreads();
#pragma unroll
        for (int r = 0; r < 16; ++r) { const int row = 32 * tm + crow32(r, hi);
            OS[row * SO + 64 * nh + (lane & 31)] = acc0[r]; OS[row * SO + 64 * nh + 32 + (lane & 31)] = acc1[r]; }
        __syncthreads();
#pragma unroll
        for (int i = 0; i < 4; ++i) { const int ch = tid + NTHR * i, t = ch >> 4, c8 = (ch & 15) * 8;
            const f32x4 s0 = *(const LAS f32x4*)(OS + t * SO + c8), s1 = *(const LAS f32x4*)(OS + t * SO + c8 + 4);
            const f32x4 n0 = *(const f32x4*)(v_norm + g * 128 + c8), n1 = *(const f32x4*)(v_norm + g * 128 + c8 + 4);
            const float bs = b_s[g * 128 + t];
            bf16* up = proj + (size_t)(row0 + t) * SGU_PITCH + g * 128 + c8;
            const v4u uw = *(const v4u*)up;
            v4u o;
            o.x = pk2(bflo(uw.x) * (n0.x * s0.x + bs), bfhi(uw.x) * (n0.y * s0.y + bs)); o.y = pk2(bflo(uw.y) * (n0.z * s0.z + bs), bfhi(uw.y) * (n0.w * s0.w + bs));
            o.z = pk2(bflo(uw.z) * (n1.x * s1.x + bs), bfhi(uw.z) * (n1.y * s1.y + bs)); o.w = pk2(bflo(uw.w) * (n1.z * s1.z + bs), bfhi(uw.w) * (n1.w * s1.w + bs));
            *(v4u*)up = o; }
        __syncthreads();
    }
}

__device__ __forceinline__ void phase_gla_kv_mfma(LAS unsigned char* lds, const Ctx& a, int vcu, int G) {
    const int tid = otid(), lane = tid & 63, wave = __builtin_amdgcn_readfirstlane(tid >> 6), hi = lane >> 5;
    const bf16* proj = (const bf16*)(a.ws + WS_H); bf16* state = (bf16*)(a.ws + WS_STATE); float* dec = (float*)(a.ws + WS_DEC);
    constexpr int SV = 576, SK = 320, SS = 272;
    LAS unsigned char* VV = lds;
    LAS unsigned char* KE = lds + 64 * SV;
    LAS unsigned char* ST = lds;
    LAS float* TOT = (LAS float*)(lds + 256 * SS);
    for (int u = vcu; u < NB * GLA_H * GLA_NC; u += G) {
        const int n = u % GLA_NC, bh = u / GLA_NC, h = bh % GLA_H, b = bh / GLA_H;
        const int row0 = b * T + n * GLA_C;
        GlaCum c; gla_cumsum(c, proj, row0, h, TOT, tid);
        const int cp = tid & 63, part = tid >> 6;
#pragma unroll
        for (int i = 0; i < 8; ++i) { const int t = 8 * part + i; const unsigned w = *(const unsigned*)(proj + (size_t)(row0 + t) * GLA_PITCH + 512 + h * 128 + 2 * cp);
            *(LAS unsigned*)(KE + t * SK + 4 * cp) = pk2(bflo(w) * __expf(c.tot0 - c.b0[i]), bfhi(w) * __expf(c.tot1 - c.b1[i])); }
        if (part == 0) { dec[(size_t)u * 128 + 2 * cp] = __expf(c.tot0); dec[(size_t)u * 128 + 2 * cp + 1] = __expf(c.tot1); }
#pragma unroll
        for (int i = 0; i < 4; ++i) { const int ch = tid + NTHR * i, r = ch >> 5, c16 = ch & 31;
            *(LAS v4u*)(VV + r * SV + c16 * 16) = *(const v4u*)(proj + (size_t)(row0 + r) * GLA_PITCH + 1024 + h * 256 + c16 * 8); }
        __syncthreads();
        mf32x16 acc[4];
#pragma unroll
        for (int nt = 0; nt < 4; ++nt) acc[nt] = zero16();
#pragma unroll
        for (int ks = 0; ks < 4; ++ks) { const mbf16x8 af = frag_kn(VV, SV, 16 * ks, 32 * wave, lane);
#pragma unroll
            for (int nt = 0; nt < 4; ++nt) { const mbf16x8 bfr = frag_kn(KE, SK, 16 * ks, 32 * nt, lane); acc[nt] = MFMA32(af, bfr, acc[nt]); } }
        __syncthreads();
#pragma unroll
        for (int nt = 0; nt < 4; ++nt)
#pragma unroll
            for (int r = 0; r < 16; ++r) *(LAS bf16*)(ST + (32 * wave + crow32(r, hi)) * SS + (32 * nt + (lane & 31)) * 2) = (bf16)f2bf(acc[nt][r]);
        __syncthreads();
#pragma unroll
        for (int i = 0; i < 8; ++i) { const int ch = tid + NTHR * i, vd = ch >> 4, c16 = ch & 15;
            *(v4u*)(state + ((size_t)u * 256 + vd) * 128 + c16 * 8) = *(const LAS v4u*)(ST + vd * SS + c16 * 16); }
        __syncthreads();
    }
}
__device__ __forceinline__ void phase_gla_out_mfma(LAS unsigned char* lds, const Ctx& a, const LayerP& P, int vcu, int G) {
    const int tid = otid(), lane = tid & 63, wave = __builtin_amdgcn_readfirstlane(tid >> 6), hi = lane >> 5;
    bf16* proj = (bf16*)(a.ws + WS_H); const bf16* state = (const bf16*)(a.ws + WS_STATE);
    const float* head_norm = P.e3;
    constexpr int SQ = 272, SA = 144, SV = 576, SO = 260;
    LAS unsigned char* QD = lds;
    LAS unsigned char* KI = lds + 64 * SQ;
    LAS unsigned char* AT = lds + 2 * 64 * SQ;
    LAS unsigned char* VV = lds + 2 * 64 * SQ + 64 * SA;
    LAS float* TOT = (LAS float*)(lds + 80896);
    LAS float* OS = (LAS float*)lds;
    for (int u = vcu; u < NB * GLA_H * GLA_NC; u += G) {
        const int n = u % GLA_NC, bh = u / GLA_NC, h = bh % GLA_H, b = bh / GLA_H;
        const int row0 = b * T + n * GLA_C;
        mbf16x8 sfr[8];
        { const bf16* sp = state + ((size_t)u * 256 + 32 * wave + (lane & 31)) * 128 + 8 * hi;
#pragma unroll
          for (int ks = 0; ks < 8; ++ks) sfr[ks] = *(const mbf16x8*)(sp + 16 * ks); }
        GlaCum c; gla_cumsum(c, proj, row0, h, TOT, tid);
        const int cp = tid & 63, part = tid >> 6;
#pragma unroll
        for (int i = 0; i < 8; ++i) { const int t = 8 * part + i;
            const unsigned wq = *(const unsigned*)(proj + (size_t)(row0 + t) * GLA_PITCH + h * 128 + 2 * cp);
            const unsigned wk = *(const unsigned*)(proj + (size_t)(row0 + t) * GLA_PITCH + 512 + h * 128 + 2 * cp);
            const float e0 = __expf(c.b0[i]), e1 = __expf(c.b1[i]);
            *(LAS unsigned*)(QD + t * SQ + 4 * cp) = pk2(bflo(wq) * 0.08838834764831845f * e0, bfhi(wq) * 0.08838834764831845f * e1);
            *(LAS unsigned*)(KI + t * SQ + 4 * cp) = pk2(bflo(wk) / e0, bfhi(wk) / e1); }
#pragma unroll
        for (int i = 0; i < 4; ++i) { const int ch = tid + NTHR * i, r = ch >> 5, c16 = ch & 31;
            *(LAS v4u*)(VV + r * SV + c16 * 16) = *(const v4u*)(proj + (size_t)(row0 + r) * GLA_PITCH + 1024 + h * 256 + c16 * 8); }
        __syncthreads();
        if (wave < 4) {
            const int mi = wave >> 1, ni = wave & 1;
            mf32x16 at = zero16();
            if (!(mi == 0 && ni == 1)) {
#pragma unroll
                for (int ks = 0; ks < 8; ++ks) at = MFMA32(frag_rk(QD, SQ, 32 * mi, 16 * ks, lane), frag_rk(KI, SQ, 32 * ni, 16 * ks, lane), at);
            }
#pragma unroll
            for (int r = 0; r < 16; ++r) { const int cc = 32 * mi + crow32(r, hi), ss = 32 * ni + (lane & 31);
                *(LAS bf16*)(AT + cc * SA + ss * 2) = (bf16)f2bf((ss <= cc) ? at[r] : 0.f); }
        }
        __syncthreads();
        mf32x16 acc[2]; acc[0] = zero16(); acc[1] = zero16();
#pragma unroll
        for (int ks = 0; ks < 4; ++ks) { const mbf16x8 bfr = frag_kn(VV, SV, 16 * ks, 32 * wave, lane);
            if (ks < 2) acc[0] = MFMA32(frag_rk(AT, SA, 0, 16 * ks, lane), bfr, acc[0]);
            acc[1] = MFMA32(frag_rk(AT, SA, 32, 16 * ks, lane), bfr, acc[1]); }
#pragma unroll
        for (int ks = 0; ks < 8; ++ks) { acc[0] = MFMA32(frag_rk(QD, SQ, 0, 16 * ks, lane), sfr[ks], acc[0]); acc[1] = MFMA32(frag_rk(QD, SQ, 32, 16 * ks, lane), sfr[ks], acc[1]); }
        __syncthreads();
#pragma unroll
        for (int mi = 0; mi < 2; ++mi)
#pragma unroll
            for (int r = 0; r < 16; ++r) OS[(32 * mi + crow32(r, hi)) * SO + 32 * wave + (lane & 31)] = acc[mi][r];
        __syncthreads();
#pragma unroll
        for (int p = 0; p < 4; ++p) { const int cc = p * 16 + wave * 2 + hi, c8 = (lane & 31) * 8;
            const f32x4 s0 = *(const LAS f32x4*)(OS + cc * SO + c8), s1 = *(const LAS f32x4*)(OS + cc * SO + c8 + 4);
            float ss = (s0.x * s0.x + s0.y * s0.y) + (s0.z * s0.z + s0.w * s0.w) + (s1.x * s1.x + s1.y * s1.y) + (s1.z * s1.z + s1.w * s1.w);
            ss += __shfl_xor(ss, 1); ss += __shfl_xor(ss, 2); ss += __shfl_xor(ss, 4); ss += __shfl_xor(ss, 8); ss += __shfl_xor(ss, 16);
            const float rs = __builtin_amdgcn_rsqf(ss * (1.0f / 256.0f) + EPS);
            const f32x4 n0 = *(const f32x4*)(head_norm + c8), n1 = *(const f32x4*)(head_norm + c8 + 4);
            const v4u gw = *(const v4u*)(proj + (size_t)(row0 + cc) * GLA_PITCH + 2048 + h * 256 + c8);
            const float gg[8] = {bflo(gw.x), bfhi(gw.x), bflo(gw.y), bfhi(gw.y), bflo(gw.z), bfhi(gw.z), bflo(gw.w), bfhi(gw.w)};
            const float ov[8] = {s0.x * n0.x, s0.y * n0.y, s0.z * n0.z, s0.w * n0.w, s1.x * n1.x, s1.y * n1.y, s1.z * n1.z, s1.w * n1.w};
            float o[8];
#pragma unroll
            for (int j = 0; j < 8; ++j) o[j] = ov[j] * rs * (gg[j] * __builtin_amdgcn_rcpf(1.f + __builtin_amdgcn_exp2f(-gg[j] * LOG2E)));
            v4u w; w.x = pk2(o[0], o[1]); w.y = pk2(o[2], o[3]); w.z = pk2(o[4], o[5]); w.w = pk2(o[6], o[7]);
            *(v4u*)(proj + (size_t)(row0 + cc) * GLA_PITCH + 1024 + h * 256 + c8) = w; }
        __syncthreads();
    }
}
#ifndef USE_MFMA_SGU
#define USE_MFMA_SGU 1
#endif
#ifndef USE_MFMA_GLA
#define USE_MFMA_GLA 1
#endif

constexpr int PH_PER_LAYER = 8, NPHASE = 4 * PH_PER_LAYER + 1;
__host__ __device__ inline bool phase_is_noop(int ph) {
    if (ph >= 4 * PH_PER_LAYER) return false;
    const int L = ph / PH_PER_LAYER, s = ph % PH_PER_LAYER;
    const bool gla = (L == 0 || L == 3), diff = (L == 1);
    return (s == 3 && !gla && !diff) || (s == 4 && !gla);
}

#ifndef PROBE_KIND
#define PROBE_KIND 0
#endif
#ifndef PROBE_REP
#define PROBE_REP 2
#endif
template <int L> __device__ __forceinline__ LayerP layer_params_ct(const CAS cfptr* in) {
    constexpr int base = (L == 0) ? 1 : (L == 1) ? 11 : (L == 2) ? 22 : 32;
    constexpr int kind = (L == 1) ? K_DIFF : (L == 2) ? K_SGU : K_GLA;
    constexpr int sh = (kind == K_DIFF) ? 1 : 0;
    LayerP p; p.kind = kind;
    p.norm1 = in[base]; p.w_in = in[base + 1];
    p.e0 = in[base + 2]; p.e1 = in[base + 3]; p.e2 = in[base + 4]; p.e3 = in[base + 5]; p.e4 = in[base + 6];
    p.w_out = in[base + 6 + sh]; p.norm2 = in[base + 7 + sh]; p.w1 = in[base + 8 + sh]; p.w2 = in[base + 9 + sh];
    p.nin = (kind == K_GLA) ? GLA_PITCH : (kind == K_DIFF) ? DIFF_PITCH : SGU_PITCH;
    p.mixoff = (kind == K_GLA) ? 1024 : 0;
    return p;
}
__device__ __forceinline__ void seam_xcd(const CAS Args* ap, LAS unsigned char* lds_k) {
#if PROBE_KIND == 1
    for (int br = 0; br < PROBE_REP; ++br)
#endif
    { XcdBarrier bb; bb.bar = (unsigned*)(ap->ws + WS_CTL) + 4096; bb.x = xb_xcc_id(); bb.st = (volatile LAS unsigned*)(lds_k + MISC_OFF) + 8; xcd_barrier(bb); }
}
#define PH_BEGIN(PK) { const int nrep_ = (PROBE_KIND == (PK) && (PK) != 0) ? PROBE_REP : 1; \
    for (int rep_ = 0; rep_ < nrep_; ++rep_) { \
    int vcu = vcu0, G = G0; asm volatile("" : "+s"(vcu), "+s"(G)); \
    LAS unsigned char* lds = lds_k; asm volatile("" : "+s"(lds)); \
    const CAS Args* ap = (const CAS Args*)__builtin_amdgcn_kernarg_segment_ptr(); asm volatile("" : "+s"(ap)); \
    Ctx args; args.in0 = ap->in[0]; args.in42 = ap->in[42]; args.out = ap->out; args.ws = ap->ws; \
    bf16* Wb = (bf16*)(args.ws + WS_W); bf16* XB = (bf16*)(args.ws + WS_XB); bf16* HB = (bf16*)(args.ws + WS_H); \
    float* SSQ = (float*)(args.ws + WS_SSQ); float* VSSQ = (float*)(args.ws + WS_VSSQ); \
    const LayerP P = layer_params_ct<L>((const CAS cfptr*)ap); \
    (void)Wb; (void)XB; (void)HB; (void)SSQ; (void)VSSQ; (void)P; (void)vcu; (void)G; (void)lds;
#define PH_END_SEAM   seam_xcd(ap, lds_k); } }
#define PH_END_NOSEAM } }

template <int L> __device__ __forceinline__ void run_layer(LAS unsigned char* lds_k, int vcu0, int G0) {
    constexpr int kind = (L == 1) ? K_DIFF : (L == 2) ? K_SGU : K_GLA;
    PH_BEGIN(5) phase_conv(lds, args, P, L, vcu, G);
    if (L == 0) { if (rep_ + 1 == nrep_) cg::this_grid().sync(); else seam_xcd(ap, lds_k); } else seam_xcd(ap, lds_k);
    PH_END_NOSEAM
    PH_BEGIN(3) { EpiIn E{kind, HB, SSQ, (kind == K_GLA) ? P.e2 : P.e0, VSSQ, (unsigned*)(args.ws + WS_CTL) + CW_QKMAX}; run_gemm(lds, XB, D, Wb + WOFF_IN, NTOK, P.nin, D, E, vcu, G); } PH_END_SEAM
    if constexpr (kind == K_GLA) {
        PH_BEGIN(4) phase_gla_kv_mfma(lds, args, vcu, G); PH_END_SEAM
        PH_BEGIN(0) phase_gla_scan(args, vcu, G); PH_END_SEAM
        PH_BEGIN(0) phase_gla_out_mfma(lds, args, P, vcu, G); PH_END_SEAM
    } else if constexpr (kind == K_DIFF) {
        PH_BEGIN(7)
            if (rep_ > 0) { if (blockIdx.x == 0 && otid() == 0) __hip_atomic_store((unsigned*)(ap->ws + WS_CTL) + CW_QUEUE, 0u, RLX_AGENT); seam_xcd(ap, lds_k); }
            phase_diff_mfma((char*)lds_raw, lds, args, vcu, G);
        PH_END_SEAM
        PH_BEGIN(6) phase_diff_combine(args, P, vcu, G); PH_END_SEAM
    } else {
        PH_BEGIN(0) phase_sgu_mfma(lds, args, P, vcu, G); PH_END_SEAM
    }
    PH_BEGIN(L == 0 ? 8 : 0) { EpiRes E{(L == 0) ? args.in0 : args.out, args.out, XB, SSQ}; run_gemm(lds, HB + P.mixoff, P.nin, Wb + WOFF_OUT, NTOK, D, D, E, vcu, G); } PH_END_SEAM
    PH_BEGIN(2) { EpiHid E{HB, SSQ}; run_gemm(lds, XB, D, Wb + WOFF_1, NTOK, FF, D, E, vcu, G); } PH_END_SEAM
    PH_BEGIN(0) { EpiRes E{args.out, args.out, XB, SSQ}; run_gemm(lds, HB, FF, Wb + WOFF_2, NTOK, D, FF, E, vcu, G); } PH_END_SEAM
}

__global__ void __launch_bounds__(NTHR, 2) trunk_fwd(Args kargs) {
    LAS unsigned char* const lds_k = (LAS unsigned char*)lds_raw;
    const int G0 = gridDim.x; const int bx = blockIdx.x;
    const int vcu0 = (G0 % 8 == 0) ? (bx % 8) * (G0 / 8) + bx / 8 : bx;
    { const int tid = threadIdx.x;
      for (int u = tid; u < (LDS_BYTES - LDSCTL_OFF) / 4; u += NTHR) ((LAS unsigned*)(lds_k + LDSCTL_OFF))[u] = 0u;
      __syncthreads();
      if ((tid & 63) == 0) ((LAS unsigned*)(lds_k + TIDTAB_OFF))[hw_slot()] = (unsigned)(tid >> 6);
      __syncthreads(); }
    (void)xcd_barrier_post((unsigned*)(kargs.ws + WS_CTL) + 4096, (volatile LAS unsigned*)(lds_k + MISC_OFF) + 8);
    run_layer<0>(lds_k, vcu0, G0);
    run_layer<1>(lds_k, vcu0, G0);
    run_layer<2>(lds_k, vcu0, G0);
    run_layer<3>(lds_k, vcu0, G0);
    { int vcu = vcu0, G = G0; asm volatile("" : "+s"(vcu), "+s"(G));
      const CAS Args* ap = (const CAS Args*)__builtin_amdgcn_kernarg_segment_ptr(); asm volatile("" : "+s"(ap));
      Ctx args; args.in0 = ap->in[0]; args.in42 = ap->in[42]; args.out = ap->out; args.ws = ap->ws;
      phase_final(args, vcu, G); }
}

extern "C" void kernel_launch(void* const* d_in, const int* in_sizes, int n_in, void* d_out, int out_size, void* d_ws, size_t ws_size, hipStream_t stream) {
    static int grid = 0;
    if (grid == 0) {
        if (n_in != 43 || in_sizes[0] != NTOK * D || out_size != NTOK * D || ws_size < WS_END) {
            fprintf(stderr, "kernel_launch: unexpected problem (n_in %d, in0 %d, out %d, ws %zu); nothing launched\n", n_in, n_in > 0 ? in_sizes[0] : -1, out_size, ws_size); grid = -1; return; }
        int dev = 0, cus = 0, per_cu = 0;
        if (hipGetDevice(&dev) != hipSuccess || hipDeviceGetAttribute(&cus, hipDeviceAttributeMultiprocessorCount, dev) != hipSuccess) { grid = -1; return; }
        if (hipFuncSetAttribute((const void*)trunk_fwd, hipFuncAttributeMaxDynamicSharedMemorySize, LDS_BYTES) != hipSuccess) { fprintf(stderr, "kernel_launch: hipFuncSetAttribute failed\n"); grid = -1; return; }
        if (hipOccupancyMaxActiveBlocksPerMultiprocessor(&per_cu, (const void*)trunk_fwd, NTHR, LDS_BYTES) != hipSuccess || per_cu < 1) { fprintf(stderr, "kernel_launch: occupancy query says %d blocks/CU\n", per_cu); per_cu = 1; }
        (void)hipGetLastError();
        grid = cus;
    }
    if (grid < 0) return;
    (void)hipMemsetAsync((char*)d_ws + WS_CTL, 0, CTL_ZERO_BYTES, stream);
    Args a{};
    for (int i = 0; i < 43; ++i) a.in[i] = (const float*)d_in[i];
    a.out = (float*)d_out; a.ws = (unsigned char*)d_ws;
    a.ph_lo = 0; a.ph_hi = 0;
    void* kargs[] = {&a};
    hipError_t e = hipLaunchCooperativeKernel((const void*)trunk_fwd, dim3(grid), dim3(NTHR), kargs, LDS_BYTES, stream);
    if (e != hipSuccess) fprintf(stderr, "kernel_launch: cooperative launch failed: %s (grid %d)\n", hipGetErrorString(e), grid);
}
```

```cpp
#include <hip/hip_runtime.h>
#include <hip/hip_cooperative_groups.h>
#include <cstdio>
#include <cstdint>
namespace cg = cooperative_groups;

#ifndef MK_ONE_LAUNCH
#define MK_ONE_LAUNCH 1
#endif

#define GAS __attribute__((address_space(1)))
#define LAS __attribute__((address_space(3)))
typedef unsigned short bf16;
typedef unsigned v4u __attribute__((ext_vector_type(4)));
typedef unsigned v2u __attribute__((ext_vector_type(2)));
typedef float f32x4 __attribute__((ext_vector_type(4)));

constexpr int NB = 2, T = 8192, D = 1024, NTOK = NB * T, FF = 4096;
constexpr float EPS = 1e-6f;
constexpr float LOG2E = 1.4426950408889634f;
constexpr int NWAVES = 8, NTHR = 512;
constexpr int K_GLA = 0, K_DIFF = 1, K_SGU = 2;
constexpr int GLA_H = 4, GLA_HK = 128, GLA_HV = 256, GLA_C = 64, GLA_NC = T / GLA_C;
constexpr int GLA_PITCH = 3584;
constexpr int DIFF_H = 8, DIFF_PITCH = 3072;
constexpr float LAMBDA_INIT = 0.35551069f;
constexpr int SGU_PITCH = 2048, SGU_C = 128, SGU_G = 8;

constexpr size_t MiB = 1u << 20;
constexpr size_t WS_CTL = 0, CTL_ZERO_BYTES = 1 * MiB;
constexpr size_t WS_SSQ = 1 * MiB;
constexpr size_t WS_VSSQ = 2 * MiB;
constexpr size_t WS_DEC = 3 * MiB;
constexpr size_t WS_W = 4 * MiB;
constexpr size_t WS_XB = 29 * MiB;
constexpr size_t WS_STATE = 61 * MiB;
constexpr size_t WS_H = 125 * MiB;
constexpr size_t WS_END = 253 * MiB;
constexpr int CW_QKMAX = 8192;
constexpr int CW_QUEUE = 8448;
constexpr size_t WOFF_IN = 0, WOFF_OUT = (size_t)3584 * 1024, WOFF_1 = WOFF_OUT + (size_t)1024 * 1024, WOFF_2 = WOFF_1 + (size_t)4096 * 1024;

constexpr int RING_BYTES = 131072, LDSCTL_OFF = RING_BYTES, MISC_OFF = LDSCTL_OFF + 320, LDS_BYTES = 147456;

#define RLX_AGENT __ATOMIC_RELAXED, __HIP_MEMORY_SCOPE_AGENT
#define LDS_WAIT() asm volatile("s_waitcnt lgkmcnt(0)" ::: "memory")
__device__ __forceinline__ unsigned f2bf(float f) { unsigned u = __builtin_bit_cast(unsigned, f); return (u + 0x7fffu + ((u >> 16) & 1u)) >> 16; }
typedef float pk_f32x2 __attribute__((ext_vector_type(2))); typedef __bf16 pk_bf16x2 __attribute__((ext_vector_type(2)));
__device__ __forceinline__ unsigned pk2(float lo, float hi) { pk_f32x2 v = {lo, hi}; pk_bf16x2 b = __builtin_convertvector(v, pk_bf16x2); return __builtin_bit_cast(unsigned, b); }
__device__ __forceinline__ float bf2f(unsigned b) { return __builtin_bit_cast(float, b << 16); }
__device__ __forceinline__ float bflo(unsigned w) { return __builtin_bit_cast(float, w << 16); }
__device__ __forceinline__ float bfhi(unsigned w) { return __builtin_bit_cast(float, w & 0xffff0000u); }
extern __shared__ __attribute__((aligned(16))) unsigned char lds_raw[];
constexpr int TIDTAB_OFF = 131072;
__device__ __forceinline__ unsigned hw_slot() { return (unsigned)__builtin_amdgcn_s_getreg((5 << 11) | 4) & 63u; }
__device__ __forceinline__ int otid() {
    const int wv = (int)((volatile __attribute__((address_space(3))) unsigned*)((__attribute__((address_space(3))) unsigned char*)lds_raw + TIDTAB_OFF))[hw_slot()];
    int ln; asm volatile("v_mbcnt_lo_u32_b32 %0, -1, 0\n\tv_mbcnt_hi_u32_b32 %0, -1, %0" : "=v"(ln));
    int t = wv * 64 + ln;
    asm volatile("" : "+v"(t)); return t; }
__device__ __forceinline__ float wave_sum(float v) {
#pragma unroll
    for (int o = 1; o < 64; o <<= 1) v += __shfl_xor(v, o);
    return v;
}
__device__ __forceinline__ float wave_max(float v) {
#pragma unroll
    for (int o = 1; o < 64; o <<= 1) v = fmaxf(v, __shfl_xor(v, o));
    return v;
}
__device__ __forceinline__ float gelu_tanh(float x) {
    const float u = 0.7978845608028654f * (x + 0.044715f * x * x * x);
    const float e = __builtin_amdgcn_exp2f(u * (2.f * LOG2E));
    return x - x * __builtin_amdgcn_rcpf(e + 1.f);
}
__device__ __forceinline__ float log_sigmoid(float z) { return fminf(z, 0.f) - 0.6931471805599453f * __builtin_amdgcn_logf(1.0f + __builtin_amdgcn_exp2f(-fabsf(z) * LOG2E)); }

#define XB_TMO      128
#define XB_XCNT(j)  (256  + 64 * (j))
#define XB_XSUB(j)  (1280 + 64 * (j))
#define XB_XGEN(j)  (2304 + 64 * (j))
#define XB_TOP      3328
#define XB_TOPGEN   3392
#define XCD_BAR_WORDS 3456
#define XB_SPIN_CAP (1u << 22)
__device__ __forceinline__ unsigned xb_ld(unsigned* p)              { return __hip_atomic_load(p, __ATOMIC_RELAXED, __HIP_MEMORY_SCOPE_AGENT); }
__device__ __forceinline__ unsigned xb_add(unsigned* p, unsigned v) { return __hip_atomic_fetch_add(p, v, __ATOMIC_RELAXED, __HIP_MEMORY_SCOPE_AGENT); }
__device__ __forceinline__ unsigned xb_xcc_id() { return (unsigned)__builtin_amdgcn_s_getreg((3 << 11) | 20) & 0xFu; }
#define XB_SPIN(cond, bar) do { unsigned _sp = 0; while (cond) { __builtin_amdgcn_s_sleep(1); \
    if ((++_sp & 255u) == 0u) { if (xb_ld(&(bar)[XB_TMO])) break; if (_sp > XB_SPIN_CAP) { atomicAdd(&(bar)[XB_TMO], 1u); break; } } } } while (0)
struct XcdBarrier { unsigned* bar; unsigned x; volatile LAS unsigned* st; };
__device__ __forceinline__ XcdBarrier xcd_barrier_post(unsigned* bar, volatile LAS unsigned* st) {
    XcdBarrier b; b.bar = bar; b.x = xb_xcc_id(); b.st = st;
    if (threadIdx.x == 0) (void)xb_add(&bar[XB_XCNT(b.x)], 1u);
    return b;
}
__device__ __forceinline__ void xcd_barrier_complete(unsigned* bar, unsigned x, unsigned& nloc, unsigned& nx) {
    const unsigned G = gridDim.x * gridDim.y * gridDim.z;
    unsigned sum, cnt, mine, sp = 0u;
    for (;;) {
        sum = 0u; cnt = 0u; mine = 0u;
#pragma unroll
        for (unsigned j = 0; j < 16; ++j) { const unsigned c = xb_ld(&bar[XB_XCNT(j)]); sum += c; cnt += (c > 0u) ? 1u : 0u; mine = (j == x) ? c : mine; }
        if (sum == G) break;
        __builtin_amdgcn_s_sleep(1);
        if ((++sp & 255u) == 0u) { if (xb_ld(&bar[XB_TMO])) break; if (sp > XB_SPIN_CAP) { atomicAdd(&bar[XB_TMO], 1u); break; } }
    }
    nloc = mine > 0u ? mine : 1u; nx = cnt > 0u ? cnt : 1u;
}
__device__ __forceinline__ void xcd_barrier(const XcdBarrier& b) {
    asm volatile("s_waitcnt vmcnt(0)" ::: "memory");
    __syncthreads();
    if (otid() == 0) {
        unsigned* bar = b.bar;
        __builtin_amdgcn_s_waitcnt(0);
        unsigned nloc = b.st[0], nx = b.st[1];
        if (nloc == 0u) { xcd_barrier_complete(bar, b.x, nloc, nx); b.st[0] = nloc; b.st[1] = nx; }
        const unsigned old = xb_add(&bar[XB_XSUB(b.x)], 1u);
        const unsigned gen = old / nloc;
        if (old + 1u == (gen + 1u) * nloc) {
            __builtin_amdgcn_fence(__ATOMIC_RELEASE, "agent");
            asm volatile("s_waitcnt vmcnt(0)" ::: "memory");
            const unsigned og = xb_add(&bar[XB_TOP], 1u);
            const unsigned tg = og / nx;
            if (og + 1u == (tg + 1u) * nx) xb_add(&bar[XB_TOPGEN], 1u);
            else XB_SPIN(xb_ld(&bar[XB_TOPGEN]) == tg, bar);
            __builtin_amdgcn_fence(__ATOMIC_ACQUIRE, "agent");
            xb_add(&bar[XB_XGEN(b.x)], 1u);
            asm volatile("s_waitcnt vmcnt(0)" ::: "memory");
        } else {
            XB_SPIN(xb_ld(&bar[XB_XGEN(b.x)]) == gen, bar);
            __builtin_amdgcn_fence(__ATOMIC_ACQUIRE, "agent");
            asm volatile("s_waitcnt vmcnt(0)" ::: "memory");
        }
    }
    __syncthreads();
}

struct Args { const float* in[43]; float* out; unsigned char* ws; int ph_lo, ph_hi; };
struct Ctx { const float* in0; const float* in42; float* out; unsigned char* ws; };
struct LayerP {
    int kind;
    const float *norm1, *w_in, *w_out, *norm2, *w1, *w2;
    const float *e0, *e1, *e2, *e3, *e4;
    int nin;
    int mixoff;
};
typedef const float* cfptr;
#define CAS __attribute__((address_space(4)))
__device__ __forceinline__ LayerP layer_params(const CAS cfptr* in, int L) {
    LayerP p;
    const int base = (L == 0) ? 1 : (L == 1) ? 11 : (L == 2) ? 22 : 32;
    p.kind = (L == 1) ? K_DIFF : (L == 2) ? K_SGU : K_GLA;
    const int sh = (p.kind == K_DIFF) ? 1 : 0;
    p.norm1 = in[base]; p.w_in = in[base + 1];
    p.e0 = in[base + 2]; p.e1 = in[base + 3]; p.e2 = in[base + 4]; p.e3 = in[base + 5]; p.e4 = in[base + 6];
    p.w_out = in[base + 6 + sh]; p.norm2 = in[base + 7 + sh]; p.w1 = in[base + 8 + sh]; p.w2 = in[base + 9 + sh];
    p.nin = (p.kind == K_GLA) ? GLA_PITCH : (p.kind == K_DIFF) ? DIFF_PITCH : SGU_PITCH;
    p.mixoff = (p.kind == K_GLA) ? 1024 : 0;
    return p;
}

__device__ __forceinline__ float row_rstd(const float* ssq, int row) {
    const f32x4* p = (const f32x4*)(ssq + (size_t)row * 16);
    const f32x4 a = p[0], b = p[1], c = p[2], d = p[3];
    const float s = ((a.x + a.y) + (a.z + a.w)) + ((b.x + b.y) + (b.z + b.w)) + ((c.x + c.y) + (c.z + c.w)) + ((d.x + d.y) + (d.z + d.w));
    return __builtin_amdgcn_rsqf(s * (1.0f / D) + EPS);
}

struct EpiIn {
    int kind; bf16* proj; const float* ssq; const float* bias;
    float* vssq;
    __device__ __forceinline__ float rowscale(int row) const { return row_rstd(ssq, row); }
    __device__ __forceinline__ float apply8(int row, int col0, const float (&v)[8], float rs) const {
        float o[8]; float part = 0.f; int pitch;
        if (kind == K_GLA) { pitch = GLA_PITCH;
            if (col0 < 3072) {
#pragma unroll
                for (int j = 0; j < 8; ++j) o[j] = v[j] * rs;
            } else {
#pragma unroll
                for (int j = 0; j < 8; ++j) o[j] = log_sigmoid(v[j] * rs + bias[col0 - 3072 + j]) * (1.0f / 16.0f);
            }
        } else if (kind == K_DIFF) { pitch = DIFF_PITCH;
            const float sc = (col0 < 1024) ? rs * (0.125f * LOG2E) : rs;
#pragma unroll
            for (int j = 0; j < 8; ++j) o[j] = v[j] * sc;
            if (col0 < 2048) {
#pragma unroll
                for (int j = 0; j < 8; ++j) part += o[j] * o[j];
            }
        } else { pitch = SGU_PITCH;
#pragma unroll
            for (int j = 0; j < 8; ++j) { o[j] = gelu_tanh(v[j] * rs + bias[col0 + j]); }
            if (col0 >= 1024) {
#pragma unroll
                for (int j = 0; j < 8; ++j) part += o[j] * o[j];
            }
        }
        v4u w; w.x = pk2(o[0], o[1]); w.y = pk2(o[2], o[3]); w.z = pk2(o[4], o[5]); w.w = pk2(o[6], o[7]);
        *(v4u*)(proj + (size_t)row * pitch + col0) = w;
        return part;
    }
    __device__ __forceinline__ void store_part(int row, int col0, int idx, float part) const {
        if (kind == K_SGU && col0 >= 1024) vssq[(size_t)row * 16 + idx] = part;
    }
    static constexpr bool GROUPMAX = true;
    unsigned* qkmax;
    __device__ __forceinline__ bool want_groupmax(int col0) const { return kind == K_DIFF && col0 < 2048; }
    __device__ __forceinline__ void store_groupmax(int row, int col0, float m) const {
        atomicMax(qkmax + (row >> 13) * 64 + (col0 >> 5), __float_as_uint(m * 1.01f));
    }
};
struct EpiHid {
    bf16* h; const float* ssq;
    __device__ __forceinline__ float rowscale(int row) const { return row_rstd(ssq, row); }
    __device__ __forceinline__ float apply8(int row, int col0, const float (&v)[8], float rs) const {
        float o[8];
#pragma unroll
        for (int j = 0; j < 8; ++j) { const float a = fmaxf(v[j] * rs, 0.f); o[j] = a * a; }
        v4u w; w.x = pk2(o[0], o[1]); w.y = pk2(o[2], o[3]); w.z = pk2(o[4], o[5]); w.w = pk2(o[6], o[7]);
        *(v4u*)(h + (size_t)row * FF + col0) = w;
        return 0.f;
    }
    __device__ __forceinline__ void store_part(int, int, int, float) const {}
    static constexpr bool GROUPMAX = false;
    __device__ __forceinline__ bool want_groupmax(int) const { return false; }
    __device__ __forceinline__ void store_groupmax(int, int, float) const {}
};
struct EpiRes {
    const float* base; float* x; bf16* xb; float* ssq;
    __device__ __forceinline__ float rowscale(int) const { return 1.f; }
    __device__ __forceinline__ float apply8(int row, int col0, const float (&v)[8], float) const {
        const size_t off = (size_t)row * D + col0;
        const f32x4 b0 = *(const f32x4*)(base + off), b1 = *(const f32x4*)(base + off + 4);
        float o[8] = {b0.x + v[0], b0.y + v[1], b0.z + v[2], b0.w + v[3], b1.x + v[4], b1.y + v[5], b1.z + v[6], b1.w + v[7]};
        *(f32x4*)(x + off) = (f32x4){o[0], o[1], o[2], o[3]}; *(f32x4*)(x + off + 4) = (f32x4){o[4], o[5], o[6], o[7]};
        v4u w; w.x = pk2(o[0], o[1]); w.y = pk2(o[2], o[3]); w.z = pk2(o[4], o[5]); w.w = pk2(o[6], o[7]);
        *(v4u*)(xb + off) = w;
        float part = 0.f;
#pragma unroll
        for (int j = 0; j < 8; ++j) part += o[j] * o[j];
        return part;
    }
    __device__ __forceinline__ void store_part(int row, int, int idx, float part) const { ssq[(size_t)row * 16 + idx] = part; }
    static constexpr bool GROUPMAX = false;
    __device__ __forceinline__ bool want_groupmax(int) const { return false; }
    __device__ __forceinline__ void store_groupmax(int, int, float) const {}
};

template <class Epi>
__device__ __forceinline__ void gemm_naive(LAS unsigned char* lds, const bf16* A, int lda, const bf16* Bt, int M, int N, int K, const Epi& E, int vcu, int G) {
    LAS float* As = (LAS float*)lds;
    LAS float* Bs = As + 64 * 33;
    const int tid = otid();
    const int nM = M / 64, nN = N / 64;
    const int r = tid >> 3, cgp = tid & 7;
    for (int u = vcu; u < nM * nN; u += G) {
        const int pm = u / nN, pn = u % nN;
        float acc[8];
#pragma unroll
        for (int j = 0; j < 8; ++j) acc[j] = 0.f;
        for (int k0 = 0; k0 < K; k0 += 32) {
            { const int lr = tid >> 3, lc = (tid & 7) * 4;
              const v2u av = *(const v2u*)(A + (size_t)(pm * 64 + lr) * lda + k0 + lc);
              const v2u bv = *(const v2u*)(Bt + (size_t)(pn * 64 + lr) * K + k0 + lc);
              As[lr * 33 + lc + 0] = bflo(av.x); As[lr * 33 + lc + 1] = bfhi(av.x); As[lr * 33 + lc + 2] = bflo(av.y); As[lr * 33 + lc + 3] = bfhi(av.y);
              Bs[lr * 33 + lc + 0] = bflo(bv.x); Bs[lr * 33 + lc + 1] = bfhi(bv.x); Bs[lr * 33 + lc + 2] = bflo(bv.y); Bs[lr * 33 + lc + 3] = bfhi(bv.y); }
            __syncthreads();
#pragma unroll 8
            for (int kk = 0; kk < 32; ++kk) { const float a = As[r * 33 + kk];
#pragma unroll
                for (int j = 0; j < 8; ++j) acc[j] += a * Bs[(cgp * 8 + j) * 33 + kk]; }
            __syncthreads();
        }
        const int row = pm * 64 + r, col0 = pn * 64 + cgp * 8;
        const float rs = E.rowscale(row);
        float part = E.apply8(row, col0, acc, rs);
        part += __shfl_xor(part, 1); part += __shfl_xor(part, 2); part += __shfl_xor(part, 4);
        if (cgp == 0) E.store_part(row, col0, pn & 15, part);
    }
}

__device__ __forceinline__ void conv_tile(const float* W, const float* gain, int K, int N, bf16* WT, int tile, LAS unsigned char* img, int tid) {
    const int nblk = N >> 7, kb = tile / nblk, nb = tile - kb * nblk, k0 = kb << 7, n0 = nb << 7;
    const int n4 = tid & 31, kk = tid >> 5;
    f32x4 w[8];
    const float* src = W + (size_t)(k0 + 8 * kk) * N + n0 + 4 * n4;
#pragma unroll
    for (int p = 0; p < 8; ++p) w[p] = *(const f32x4*)(src + (size_t)p * N);
    float g[8];
    if (gain) { const f32x4 g0 = *(const f32x4*)(gain + k0 + 8 * kk), g1 = *(const f32x4*)(gain + k0 + 8 * kk + 4);
        g[0] = g0.x; g[1] = g0.y; g[2] = g0.z; g[3] = g0.w; g[4] = g1.x; g[5] = g1.y; g[6] = g1.z; g[7] = g1.w; }
    else {
#pragma unroll
        for (int p = 0; p < 8; ++p) g[p] = 1.f; }
#pragma unroll
    for (int jn = 0; jn < 4; ++jn) {
        v4u o; o.x = pk2(g[0] * w[0][jn], g[1] * w[1][jn]); o.y = pk2(g[2] * w[2][jn], g[3] * w[3][jn]); o.z = pk2(g[4] * w[4][jn], g[5] * w[5][jn]); o.w = pk2(g[6] * w[6][jn], g[7] * w[7][jn]);
        *(LAS v4u*)(img + (4 * n4 + jn) * 256 + ((kk ^ (n4 & 15)) << 4)) = o; }
    __syncthreads();
#pragma unroll
    for (int i = 0; i < 4; ++i) { const int c = tid + NTHR * i, n = c >> 4, kc = c & 15;
        const v4u o = *(const LAS v4u*)(img + n * 256 + ((kc ^ ((n >> 2) & 15)) << 4));
        *(v4u*)(WT + (size_t)(n0 + n) * K + k0 + 8 * kc) = o; }
    __syncthreads();
}

__device__ __forceinline__ void phase_conv(LAS unsigned char* lds, const Ctx& a, const LayerP& P, int L, int vcu, int G) {
    const int tid = otid(), lane = tid & 63, wave = __builtin_amdgcn_readfirstlane(tid >> 6);
    bf16* Wb = (bf16*)(a.ws + WS_W);
    const int gw = vcu * NWAVES + wave, NGW = G * NWAVES;
    const int nin_w = (P.kind == K_SGU) ? 2048 : 3072;
    const int I_IN = (D / 128) * (nin_w / 128), I_OUT = (D / 128) * (D / 128), I_1 = (D / 128) * (FF / 128), I_2 = (FF / 128) * (D / 128);
    const int NITEMS = I_IN + I_OUT + I_1 + I_2;
    for (int it = vcu; it < NITEMS; it += G) {
        int r = it;
        if (r < I_IN) { conv_tile(P.w_in, P.norm1, D, nin_w, Wb + WOFF_IN, r, lds, tid); continue; } r -= I_IN;
        if (r < I_OUT) { conv_tile(P.w_out, nullptr, D, D, Wb + WOFF_OUT, r, lds, tid); continue; } r -= I_OUT;
        if (r < I_1) { conv_tile(P.w1, P.norm2, D, FF, Wb + WOFF_1, r, lds, tid); continue; } r -= I_1;
        conv_tile(P.w2, nullptr, FF, D, Wb + WOFF_2, r, lds, tid);
    }
    if (P.kind == K_GLA) {
        const float* W1 = P.e0; const float* W2 = P.e1;
        for (int e = vcu * NTHR + tid; e < 512 * 1024; e += G * NTHR) {
            const int n = e >> 10, k = e & 1023;
            float s = 0.f;
#pragma unroll
            for (int r = 0; r < 16; ++r) s += W1[k * 16 + r] * W2[r * 512 + n];
            Wb[WOFF_IN + (size_t)(3072 + n) * 1024 + k] = (bf16)f2bf(s * P.norm1[k]);
        }
    }
    if (L == 0) {
        const float* x = a.in0; bf16* xb = (bf16*)(a.ws + WS_XB); float* ssq = (float*)(a.ws + WS_SSQ);
        for (int m = gw; m < NTOK; m += NGW) {
            const f32x4* xr = (const f32x4*)(x + (size_t)m * D) + lane;
            f32x4 v[4]; float s = 0.f;
#pragma unroll
            for (int j = 0; j < 4; ++j) { v[j] = xr[64 * j]; s += (v[j].x * v[j].x + v[j].y * v[j].y) + (v[j].z * v[j].z + v[j].w * v[j].w); }
            s = wave_sum(s);
            v2u* o8 = (v2u*)(xb + (size_t)m * D) + lane;
#pragma unroll
            for (int j = 0; j < 4; ++j) { v2u w; w.x = pk2(v[j].x, v[j].y); w.y = pk2(v[j].z, v[j].w); o8[64 * j] = w; }
            if (lane < 16) ssq[(size_t)m * 16 + lane] = (lane == 0) ? s : 0.f;
        }
    }
}

__device__ __forceinline__ void phase_final(const Ctx& a, int vcu, int G) {
    const int tid = otid(), lane = tid & 63, wave = tid >> 6;
    const int gw = vcu * NWAVES + wave, NGW = G * NWAVES;
    const float* ssq = (const float*)(a.ws + WS_SSQ); const float* g = a.in42;
    for (int m = gw; m < NTOK; m += NGW) {
        const float rs = row_rstd(ssq, m);
        f32x4* xr = (f32x4*)(a.out + (size_t)m * D) + lane; const f32x4* gr = (const f32x4*)g + lane;
#pragma unroll
        for (int j = 0; j < 4; ++j) { f32x4 v = xr[64 * j]; const f32x4 gg = gr[64 * j]; v.x *= rs * gg.x; v.y *= rs * gg.y; v.z *= rs * gg.z; v.w *= rs * gg.w; xr[64 * j] = v; }
    }
}

struct GlaCum { float b0[8], b1[8], tot0, tot1; };
__device__ __forceinline__ void gla_cumsum(GlaCum& c, const bf16* proj, int row0, int h, LAS float* TOT, int tid) {
    const int cp = tid & 63, part = tid >> 6;
#pragma unroll
    for (int i = 0; i < 8; ++i) { const unsigned w = *(const unsigned*)(proj + (size_t)(row0 + 8 * part + i) * GLA_PITCH + 3072 + h * 128 + 2 * cp); c.b0[i] = bflo(w); c.b1[i] = bfhi(w); }
#pragma unroll
    for (int i = 1; i < 8; ++i) { c.b0[i] += c.b0[i - 1]; c.b1[i] += c.b1[i - 1]; }
    TOT[part * 128 + 2 * cp] = c.b0[7]; TOT[part * 128 + 2 * cp + 1] = c.b1[7];
    __syncthreads();
    float o0 = 0.f, o1 = 0.f, t0 = 0.f, t1 = 0.f;
#pragma unroll
    for (int p = 0; p < 8; ++p) { const float x0 = TOT[p * 128 + 2 * cp], x1 = TOT[p * 128 + 2 * cp + 1]; if (p < part) { o0 += x0; o1 += x1; } t0 += x0; t1 += x1; }
#pragma unroll
    for (int i = 0; i < 8; ++i) { c.b0[i] += o0; c.b1[i] += o1; }
    c.tot0 = t0; c.tot1 = t1;
}
__device__ __forceinline__ void phase_gla_kv(LAS unsigned char* lds, const Ctx& a, int vcu, int G) {
    const int tid = otid();
    const bf16* proj = (const bf16*)(a.ws + WS_H); bf16* state = (bf16*)(a.ws + WS_STATE); float* dec = (float*)(a.ws + WS_DEC);
    LAS float* KE = (LAS float*)lds;
    LAS float* V = KE + 64 * 128;
    LAS float* TOT = V + 64 * 256;
    for (int u = vcu; u < NB * GLA_H * GLA_NC; u += G) {
        const int n = u % GLA_NC, bh = u / GLA_NC, h = bh % GLA_H, b = bh / GLA_H;
        const int row0 = b * T + n * GLA_C;
        GlaCum c; gla_cumsum(c, proj, row0, h, TOT, tid);
        const int cp = tid & 63, part = tid >> 6;
#pragma unroll
        for (int i = 0; i < 8; ++i) { const int t = 8 * part + i; const unsigned w = *(const unsigned*)(proj + (size_t)(row0 + t) * GLA_PITCH + 512 + h * 128 + 2 * cp);
            KE[t * 128 + 2 * cp] = bflo(w) * __expf(c.tot0 - c.b0[i]); KE[t * 128 + 2 * cp + 1] = bfhi(w) * __expf(c.tot1 - c.b1[i]); }
        if (part == 0) { dec[(size_t)u * 128 + 2 * cp] = __expf(c.tot0); dec[(size_t)u * 128 + 2 * cp + 1] = __expf(c.tot1); }
        { const int vp = tid & 127, rp = tid >> 7;
#pragma unroll
          for (int i = 0; i < 16; ++i) { const int t = 16 * rp + i; const unsigned w = *(const unsigned*)(proj + (size_t)(row0 + t) * GLA_PITCH + 1024 + h * 256 + 2 * vp);
              V[t * 256 + 2 * vp] = bflo(w); V[t * 256 + 2 * vp + 1] = bfhi(w); } }
        __syncthreads();
        const int vd = tid & 255, kh = tid >> 8;
        float acc[64];
#pragma unroll
        for (int j = 0; j < 64; ++j) acc[j] = 0.f;
        for (int t = 0; t < 64; ++t) { const float v = V[t * 256 + vd];
#pragma unroll
            for (int j = 0; j < 64; ++j) acc[j] += KE[t * 128 + kh * 64 + j] * v; }
        bf16* sp = state + ((size_t)u * 256 + vd) * 128 + kh * 64;
#pragma unroll
        for (int j = 0; j < 64; j += 8) { v4u w; w.x = pk2(acc[j], acc[j + 1]); w.y = pk2(acc[j + 2], acc[j + 3]); w.z = pk2(acc[j + 4], acc[j + 5]); w.w = pk2(acc[j + 6], acc[j + 7]); *(v4u*)(sp + j) = w; }
        __syncthreads();
    }
}
__device__ __forceinline__ void phase_gla_scan(const Ctx& a, int vcu, int G) {
    unsigned* state = (unsigned*)(a.ws + WS_STATE); const float* dec = (const float*)(a.ws + WS_DEC);
    for (int gid = vcu * NTHR + otid(); gid < NB * GLA_H * 16384; gid += G * NTHR) {
        const int bh = gid >> 14, e = gid & 16383, kp = e & 63;
        unsigned* sp = state + (size_t)bh * GLA_NC * 16384 + e;
        const float* dp = dec + (size_t)bh * GLA_NC * 128 + 2 * kp;
        float s0 = 0.f, s1 = 0.f;
        for (int n0 = 0; n0 < GLA_NC; n0 += 8) {
            unsigned w[8]; float d0[8], d1[8];
#pragma unroll
            for (int i = 0; i < 8; ++i) { w[i] = sp[(size_t)(n0 + i) * 16384]; d0[i] = dp[(n0 + i) * 128]; d1[i] = dp[(n0 + i) * 128 + 1]; }
#pragma unroll
            for (int i = 0; i < 8; ++i) { sp[(size_t)(n0 + i) * 16384] = pk2(s0, s1); s0 = d0[i] * s0 + bflo(w[i]); s1 = d1[i] * s1 + bfhi(w[i]); }
        }
    }
}
__device__ __forceinline__ void phase_gla_out(LAS unsigned char* lds, const Ctx& a, const LayerP& P, int vcu, int G) {
    const int tid = otid(), lane = tid & 63, wave = tid >> 6;
    bf16* proj = (bf16*)(a.ws + WS_H); const bf16* state = (const bf16*)(a.ws + WS_STATE);
    LAS float* QD = (LAS float*)lds;
    LAS float* KI = QD + 64 * 128;
    LAS float* ATT = KI + 64 * 128;
    LAS unsigned* Vb = (LAS unsigned*)(ATT + 64 * 64);
    LAS float* TOT = (LAS float*)(Vb + 64 * 128);
    LAS float* RSS = TOT + 8 * 128;
    for (int u = vcu; u < NB * GLA_H * GLA_NC; u += G) {
        const int n = u % GLA_NC, bh = u / GLA_NC, h = bh % GLA_H, b = bh / GLA_H;
        const int row0 = b * T + n * GLA_C;
        GlaCum c; gla_cumsum(c, proj, row0, h, TOT, tid);
        const int cp = tid & 63, part = tid >> 6;
#pragma unroll
        for (int i = 0; i < 8; ++i) { const int t = 8 * part + i;
            const unsigned wq = *(const unsigned*)(proj + (size_t)(row0 + t) * GLA_PITCH + h * 128 + 2 * cp);
            const unsigned wk = *(const unsigned*)(proj + (size_t)(row0 + t) * GLA_PITCH + 512 + h * 128 + 2 * cp);
            const float e0 = __expf(c.b0[i]), e1 = __expf(c.b1[i]);
            QD[t * 128 + 2 * cp] = bflo(wq) * 0.08838834764831845f * e0; QD[t * 128 + 2 * cp + 1] = bfhi(wq) * 0.08838834764831845f * e1;
            KI[t * 128 + 2 * cp] = bflo(wk) / e0; KI[t * 128 + 2 * cp + 1] = bfhi(wk) / e1; }
        { const int vp = tid & 127, rp = tid >> 7;
#pragma unroll
          for (int i = 0; i < 16; ++i) { const int t = 16 * rp + i; Vb[t * 128 + vp] = *(const unsigned*)(proj + (size_t)(row0 + t) * GLA_PITCH + 1024 + h * 256 + 2 * vp); } }
        __syncthreads();
        { const int cc = tid >> 3, s0 = (tid & 7) * 8; float acc[8];
#pragma unroll
          for (int j = 0; j < 8; ++j) acc[j] = 0.f;
          for (int d = 0; d < 128; ++d) { const float q = QD[cc * 128 + d];
#pragma unroll
              for (int j = 0; j < 8; ++j) acc[j] += q * KI[(s0 + j) * 128 + d]; }
#pragma unroll
          for (int j = 0; j < 8; ++j) ATT[cc * 64 + s0 + j] = (s0 + j <= cc) ? acc[j] : 0.f; }
        __syncthreads();
        const int vd = tid & 255, ch = tid >> 8;
        float acc[32];
#pragma unroll
        for (int j = 0; j < 32; ++j) acc[j] = 0.f;
        for (int s = 0; s < 64; ++s) { const unsigned w = Vb[s * 128 + (vd >> 1)]; const float v = (vd & 1) ? bfhi(w) : bflo(w);
#pragma unroll
            for (int j = 0; j < 32; ++j) acc[j] += ATT[(ch * 32 + j) * 64 + s] * v; }
        { const bf16* sp = state + ((size_t)u * 256 + vd) * 128;
          for (int d0 = 0; d0 < 128; d0 += 8) { const v4u w = *(const v4u*)(sp + d0);
              const float st[8] = {bflo(w.x), bfhi(w.x), bflo(w.y), bfhi(w.y), bflo(w.z), bfhi(w.z), bflo(w.w), bfhi(w.w)};
#pragma unroll
              for (int dd = 0; dd < 8; ++dd) {
#pragma unroll
                  for (int j = 0; j < 32; ++j) acc[j] += QD[(ch * 32 + j) * 128 + d0 + dd] * st[dd]; } } }
#pragma unroll
        for (int j = 0; j < 32; ++j) { const float s = wave_sum(acc[j] * acc[j]); if (lane == 0) RSS[wave * 32 + j] = s; }
        __syncthreads();
        const float hn = P.e3[vd];
#pragma unroll
        for (int j = 0; j < 32; ++j) { const int cc = ch * 32 + j;
            const float ss = (RSS[(ch * 4 + 0) * 32 + j] + RSS[(ch * 4 + 1) * 32 + j]) + (RSS[(ch * 4 + 2) * 32 + j] + RSS[(ch * 4 + 3) * 32 + j]);
            const float rs = 1.0f / sqrtf(ss * (1.0f / 256.0f) + EPS);
            const float g = bf2f(proj[(size_t)(row0 + cc) * GLA_PITCH + 2048 + h * 256 + vd]);
            const float o = acc[j] * rs * hn * (g / (1.f + __expf(-g)));
            proj[(size_t)(row0 + cc) * GLA_PITCH + 1024 + h * 256 + vd] = (bf16)f2bf(o); }
        __syncthreads();
    }
}

__device__ __forceinline__ void phase_sgu(LAS unsigned char* lds, const Ctx& a, const LayerP& P, int vcu, int G) {
    const int tid = otid();
    bf16* proj = (bf16*)(a.ws + WS_H); const float* vssq = (const float*)(a.ws + WS_VSSQ);
    const float* v_norm = P.e1; const float* w_s = P.e2; const float* b_s = P.e3;
    LAS float* W = (LAS float*)lds;
    LAS float* V = W + 128 * 128;
    for (int u = vcu; u < NB * (T / SGU_C) * SGU_G; u += G) {
        const int g = u % SGU_G, bc = u / SGU_G;
        const int row0 = bc * SGU_C;
        for (int e = tid; e < 128 * 128; e += NTHR) { const int t = e >> 7, s = e & 127;
            const float rs = row_rstd(vssq, row0 + s);
            W[e] = (s <= t) ? w_s[(size_t)g * 16384 + e] * rs : 0.f;
            V[e] = bf2f(proj[(size_t)(row0 + t) * SGU_PITCH + 1024 + g * 128 + s]); }
        __syncthreads();
        const int d = tid & 127, tq = tid >> 7;
        float acc[32];
#pragma unroll
        for (int j = 0; j < 32; ++j) acc[j] = 0.f;
        for (int s = 0; s < 128; ++s) { const float v = V[s * 128 + d];
#pragma unroll
            for (int j = 0; j < 32; ++j) acc[j] += W[(tq + 4 * j) * 128 + s] * v; }
        const float vn = v_norm[g * 128 + d];
#pragma unroll
        for (int j = 0; j < 32; ++j) { const int t = tq + 4 * j;
            const float sv = vn * acc[j] + b_s[g * 128 + t];
            bf16* up = proj + (size_t)(row0 + t) * SGU_PITCH + g * 128 + d;
            *up = (bf16)f2bf(bf2f(*up) * sv); }
        __syncthreads();
    }
}

__device__ __forceinline__ void phase_diff(LAS unsigned char* lds, const Ctx& a, const LayerP& P, int vcu, int G) {
    const int tid = otid(), lane = tid & 63, wave = tid >> 6;
    bf16* proj = (bf16*)(a.ws + WS_H);
    LAS float* Ks = (LAS float*)lds;
    LAS float* Vs = Ks + 64 * 132;
    LAS float* Qs = Vs + 64 * 128;
    LAS float* Ps = Qs + 32 * 128;
    float lam;
    { float s1 = 0.f, s2 = 0.f;
      for (int i = 0; i < 64; ++i) { s1 += P.e0[i] * P.e1[i]; s2 += P.e2[i] * P.e3[i]; }
      lam = __expf(s1) - __expf(s2) + LAMBDA_INIT; }
    const float* head_norm = P.e4;
    const int NU = NB * DIFF_H * (T / 32);
    for (int u = vcu; u < NU; u += G) {
        const int qb = (T / 32 - 1) - (u / (NB * DIFF_H)), bh = u % (NB * DIFF_H), h = bh % DIFF_H, b = bh / DIFF_H;
        const int q0 = qb * 32; const size_t rowbase = (size_t)b * T;
        const float slope2 = exp2f(-(float)(h + 1)) * LOG2E;
        __syncthreads();
        for (int e = tid; e < 32 * 64; e += NTHR) { const int r = e >> 6, c2 = e & 63;
            const unsigned w = *(const unsigned*)(proj + (rowbase + q0 + r) * DIFF_PITCH + h * 128 + 2 * c2);
            Qs[r * 128 + 2 * c2] = bflo(w); Qs[r * 128 + 2 * c2 + 1] = bfhi(w); }
        float m1[4], l1[4], m2[4], l2[4], oa1[4], ob1[4], oa2[4], ob2[4];
#pragma unroll
        for (int i = 0; i < 4; ++i) { m1[i] = -1e30f; m2[i] = -1e30f; l1[i] = 0.f; l2[i] = 0.f; oa1[i] = 0.f; ob1[i] = 0.f; oa2[i] = 0.f; ob2[i] = 0.f; }
        const int ntile = (q0 + 31) / 64 + 1;
        for (int kt = 0; kt < ntile; ++kt) {
            __syncthreads();
            for (int e = tid; e < 64 * 64; e += NTHR) { const int r = e >> 6, c2 = e & 63;
                const unsigned wk = *(const unsigned*)(proj + (rowbase + kt * 64 + r) * DIFF_PITCH + 1024 + h * 128 + 2 * c2);
                const unsigned wv = *(const unsigned*)(proj + (rowbase + kt * 64 + r) * DIFF_PITCH + 2048 + h * 128 + 2 * c2);
                Ks[r * 132 + 2 * c2] = bflo(wk); Ks[r * 132 + 2 * c2 + 1] = bfhi(wk);
                Vs[r * 128 + 2 * c2] = bflo(wv); Vs[r * 128 + 2 * c2 + 1] = bfhi(wv); }
            __syncthreads();
            const int kpos = kt * 64 + lane;
#pragma unroll
            for (int i = 0; i < 4; ++i) {
                const int r = wave + 8 * i, qpos = q0 + r;
                if (kt * 64 > qpos) continue;
                float s1 = 0.f, s2 = 0.f;
                const LAS f32x4* qp = (const LAS f32x4*)(Qs + r * 128); const LAS f32x4* kp = (const LAS f32x4*)(Ks + lane * 132);
#pragma unroll
                for (int d = 0; d < 16; ++d) { const f32x4 q = qp[d], k = kp[d]; s1 += (q.x * k.x + q.y * k.y) + (q.z * k.z + q.w * k.w); }
#pragma unroll
                for (int d = 16; d < 32; ++d) { const f32x4 q = qp[d], k = kp[d]; s2 += (q.x * k.x + q.y * k.y) + (q.z * k.z + q.w * k.w); }
                const float bias = slope2 * (float)(qpos - kpos);
                const bool ok = kpos <= qpos;
                s1 = ok ? s1 - bias : -1e30f; s2 = ok ? s2 - bias : -1e30f;
                const float mn1 = fmaxf(m1[i], wave_max(s1)), mn2 = fmaxf(m2[i], wave_max(s2));
                const float p1 = ok ? exp2f(s1 - mn1) : 0.f, p2 = ok ? exp2f(s2 - mn2) : 0.f;
                const float a1 = exp2f(m1[i] - mn1), a2 = exp2f(m2[i] - mn2);
                l1[i] = l1[i] * a1 + wave_sum(p1); l2[i] = l2[i] * a2 + wave_sum(p2); m1[i] = mn1; m2[i] = mn2;
                Ps[wave * 128 + lane] = p1; Ps[wave * 128 + 64 + lane] = p2;
                LDS_WAIT();
                float x1 = 0.f, y1 = 0.f, x2 = 0.f, y2 = 0.f;
                for (int j = 0; j < 64; ++j) { const float pa = Ps[wave * 128 + j], pb = Ps[wave * 128 + 64 + j]; const float va = Vs[j * 128 + lane], vb = Vs[j * 128 + 64 + lane];
                    x1 += pa * va; y1 += pa * vb; x2 += pb * va; y2 += pb * vb; }
                oa1[i] = oa1[i] * a1 + x1; ob1[i] = ob1[i] * a1 + y1; oa2[i] = oa2[i] * a2 + x2; ob2[i] = ob2[i] * a2 + y2;
                LDS_WAIT();
            }
        }
#pragma unroll
        for (int i = 0; i < 4; ++i) {
            const int r = wave + 8 * i;
            const float oa = oa1[i] / l1[i] - lam * (oa2[i] / l2[i]), ob = ob1[i] / l1[i] - lam * (ob2[i] / l2[i]);
            const float ss = wave_sum(oa * oa + ob * ob);
            const float rs = (1.0f / sqrtf(ss * (1.0f / 128.0f) + EPS)) * (1.0f - LAMBDA_INIT);
            bf16* op = proj + (rowbase + q0 + r) * DIFF_PITCH + h * 128;
            op[lane] = (bf16)f2bf(oa * rs * head_norm[lane]); op[64 + lane] = (bf16)f2bf(ob * rs * head_norm[64 + lane]);
        }
    }
}

namespace pg8 {
#define PG8_LAS __attribute__((address_space(3)))
typedef unsigned short bf16_t;
typedef short bf16x8 __attribute__((ext_vector_type(8)));
typedef float f32x4 __attribute__((ext_vector_type(4)));
typedef unsigned u32x4 __attribute__((ext_vector_type(4)));
constexpr int BM = 256, BK = 64, HALF = 128, HTB = HALF * BK * 2  , STAGE_BYTES = 8 * HTB, NXCD = 8, WGM = 8;

__host__ __device__ __forceinline__ int lds_byte(int r, int c) { const int st = (r >> 4) * 2 + (c >> 5), rr = r & 15, cc = c & 31, ob = rr * 64 + cc * 2; return st * 1024 + (ob ^ (((ob >> 9) & 1) << 5)); }
__host__ __device__ __forceinline__ void stage_rc(int b, int& R, int& C) { const int st = b / 1024, sb = b % 1024, swz = sb ^ (((sb >> 9) & 1) << 5); R = (st >> 1) * 16 + swz / 64; C = (st & 1) * 32 + (swz % 64) / 2; }
__host__ __device__ __forceinline__ int perm32(int rho) { const int n = rho >> 4, i = rho & 15; return 8 * (i >> 2) + 4 * n + (i & 3); }

struct Unit { int pm, pn; };
struct Gemm { const bf16_t* A; int lda; const bf16_t* Bt; int M, N, K; };

struct StaticOrder {
    int nM, nN, nwg, G, c;
    __host__ __device__ void init(int M, int N, int G_, int c_) { nM = M / BM; nN = N / BM; nwg = nM * nN; G = G_; c = c_; }
    __host__ __device__ bool next(int i, Unit& u) const {
        const long L = (long)i * G + c; if (L >= nwg) return false;
        int wgid = (int)L; { const int q = nwg / NXCD, r = nwg % NXCD, xcd = wgid % NXCD, off = wgid / NXCD; wgid = (xcd < r ? xcd * (q + 1) : r * (q + 1) + (xcd - r) * q) + off; }
        const int nig = WGM * nN, gid = wgid / nig, fm = gid * WGM, gsz = (nM - fm) < WGM ? (nM - fm) : WGM;
        u.pm = fm + ((wgid % nig) % gsz); u.pn = (wgid % nig) / gsz; return true;
    }
    __device__ __forceinline__ void a_ready(const Unit&) const {}
    __device__ __forceinline__ void done(const Unit&) const {}
};

template <class Epi, class Sched, bool ALIGN_EPI = false, bool SP2 = false>
__device__ __forceinline__ void gemm_phase(PG8_LAS unsigned char* lds, const Gemm g, const Sched& S, const Epi& E) {
    const int tid = otid(), wid = __builtin_amdgcn_readfirstlane(tid >> 6), lane = tid & 63, wr = wid >> 2, wc = wid & 3, fr = lane & 15, fq = lane >> 4;
    const int K = g.K, nt = K / BK, lda = g.lda;
    unsigned voffA[2], voffB[2];
#pragma unroll
    for (int i = 0; i < 2; ++i) { int R, C; stage_rc(tid * 16 + i * 8192, R, C); const int Rb = Epi::PERM ? ((R & ~31) + perm32(R & 31)) : R;
        voffA[i] = (unsigned)(R * lda + C) * 2u; voffB[i] = (unsigned)(Rb * K + C) * 2u; }
    const size_t kstep = (size_t)(BK * 2);
    const size_t hstepA = (size_t)HALF * lda * 2, hstepB = (size_t)HALF * K * 2;
    const size_t tstepA = 2 * hstepA, tstepB = 2 * hstepB;
    const unsigned ldsw = (unsigned)wid * 1024u;
    const int aoff = lds_byte(wr * 64 + fr, fq * 8), boff = lds_byte(wc * 32 + fr, fq * 8);
#define PG8_SA(b, h) (((b) * 2 + (h)) * HTB)
#define PG8_SB(b, h) ((4 + (b) * 2 + (h)) * HTB)
#define PG8_STAGE(bufoff, gbase, voff) do { _Pragma("unroll") for (int _i = 0; _i < 2; ++_i) \
        __builtin_amdgcn_global_load_lds((const unsigned*)((const char*)(gbase) + (voff)[_i]), (PG8_LAS unsigned*)(lds + (bufoff) + ldsw + _i * 8192), 16, 0, 0); } while (0)
#define PG8_LDA(dst, b, h) do { _Pragma("unroll") for (int m = 0; m < 4; ++m) _Pragma("unroll") for (int k = 0; k < 2; ++k) dst[m][k] = *(const PG8_LAS bf16x8*)(lds + PG8_SA(b, h) + aoff + m * 2048 + k * 1024); } while (0)
#define PG8_LDB(dst, b, h) do { _Pragma("unroll") for (int n = 0; n < 2; ++n) _Pragma("unroll") for (int k = 0; k < 2; ++k) dst[n][k] = *(const PG8_LAS bf16x8*)(lds + PG8_SB(b, h) + boff + n * 2048 + k * 1024); } while (0)
#define PG8_MMA(ai, bj, At, Bt) do { __builtin_amdgcn_s_setprio(1); _Pragma("unroll") for (int m = 0; m < 4; ++m) _Pragma("unroll") for (int n = 0; n < 2; ++n) _Pragma("unroll") for (int k = 0; k < 2; ++k) \
        acc[ai][bj][m][n] = __builtin_amdgcn_mfma_f32_16x16x32_bf16(Bt[n][k], At[m][k], acc[ai][bj][m][n], 0, 0, 0); __builtin_amdgcn_s_setprio(0); } while (0)
#define PG8_WAIT_V(n) asm volatile("s_waitcnt vmcnt(" #n ")" ::: "memory")
#define PG8_WAIT_L(n) asm volatile("s_waitcnt lgkmcnt(" #n ")" ::: "memory")
#define PG8_BAR __builtin_amdgcn_s_barrier()
#define PG8_SCHED __builtin_amdgcn_sched_barrier(0)
    Unit cur, nxt; int ui = 0;
    if (!S.next(0, cur)) return;
    f32x4 acc[2][2][4][2];
#pragma unroll
    for (int a = 0; a < 2; ++a)
#pragma unroll
        for (int b = 0; b < 2; ++b)
#pragma unroll
            for (int m = 0; m < 4; ++m)
#pragma unroll
                for (int n = 0; n < 2; ++n) acc[a][b][m][n] = (f32x4){0.f, 0.f, 0.f, 0.f};
    bf16x8 At[4][2], B0[2][2], B1[2][2];
    const char* cA = (const char*)g.A + (size_t)cur.pm * tstepA; const char* cB = (const char*)g.Bt + (size_t)cur.pn * tstepB;
    S.a_ready(cur);
    if constexpr (SP2) {
        PG8_STAGE(PG8_SB(0, 0), cB, voffB); PG8_STAGE(PG8_SB(0, 1), cB + hstepB, voffB); PG8_STAGE(PG8_SA(0, 0), cA, voffA); PG8_STAGE(PG8_SA(0, 1), cA + hstepA, voffA);
        if (wr == 1) PG8_BAR;
        PG8_WAIT_V(2); PG8_BAR;
        PG8_STAGE(PG8_SB(1, 0), cB + kstep, voffB); PG8_STAGE(PG8_SA(1, 0), cA + kstep, voffA); PG8_STAGE(PG8_SB(1, 1), cB + hstepB + kstep, voffB);
        PG8_WAIT_V(6); PG8_BAR;
    } else {
        PG8_STAGE(PG8_SB(0, 0), cB, voffB); PG8_STAGE(PG8_SA(0, 0), cA, voffA); PG8_STAGE(PG8_SB(0, 1), cB + hstepB, voffB); PG8_STAGE(PG8_SA(0, 1), cA + hstepA, voffA);
        if (wr == 1) PG8_BAR;
        PG8_WAIT_V(4); PG8_BAR;
        PG8_STAGE(PG8_SB(1, 0), cB + kstep, voffB); PG8_STAGE(PG8_SA(1, 0), cA + kstep, voffA); PG8_STAGE(PG8_SB(1, 1), cB + hstepB + kstep, voffB);
        PG8_WAIT_V(6); PG8_BAR;
    }
    for (;;) {
        const bool has_next = S.next(ui + 1, nxt);
        const char* nA = has_next ? (const char*)g.A + (size_t)nxt.pm * tstepA : cA; const char* nB = has_next ? (const char*)g.Bt + (size_t)nxt.pn * tstepB : cB;
        for (int t = 0; t < nt; t += 2) {
            const bool last = (t == nt - 2);
            const char* a1 = cA + (size_t)(t + 1) * kstep;
            const char* a2 = last ? nA : cA + (size_t)(t + 2) * kstep; const char* b2 = last ? nB : cB + (size_t)(t + 2) * kstep;
            const char* a3 = a2 + kstep; const char* b3 = b2 + kstep;
            if (last && has_next) S.a_ready(nxt);
            if constexpr (SP2) {
            PG8_LDB(B0, 0, 0); PG8_LDB(B1, 0, 1); PG8_SCHED; PG8_LDA(At, 0, 0); PG8_STAGE(PG8_SA(1, 1), a1 + hstepA, voffA);
            PG8_WAIT_V(8); PG8_WAIT_L(0); PG8_BAR; PG8_MMA(0, 0, At, B0); PG8_MMA(0, 1, At, B1); PG8_BAR; PG8_SCHED;
            PG8_LDA(At, 0, 1); PG8_STAGE(PG8_SB(0, 0), b2, voffB); PG8_STAGE(PG8_SB(0, 1), b2 + hstepB, voffB); PG8_STAGE(PG8_SA(0, 0), a2, voffA);
            PG8_WAIT_V(8); PG8_WAIT_L(0); PG8_BAR; PG8_MMA(1, 0, At, B0); PG8_MMA(1, 1, At, B1); PG8_BAR; PG8_SCHED;
            PG8_LDB(B0, 1, 0); PG8_LDB(B1, 1, 1); PG8_SCHED; PG8_LDA(At, 1, 0); PG8_STAGE(PG8_SA(0, 1), a2 + hstepA, voffA);
            PG8_WAIT_V(8); PG8_WAIT_L(0); PG8_BAR; PG8_MMA(0, 0, At, B0); PG8_MMA(0, 1, At, B1); PG8_BAR; PG8_SCHED;
            PG8_LDA(At, 1, 1); PG8_STAGE(PG8_SB(1, 0), b3, voffB); PG8_STAGE(PG8_SB(1, 1), b3 + hstepB, voffB); PG8_STAGE(PG8_SA(1, 0), a3, voffA);
            PG8_WAIT_V(8); PG8_WAIT_L(0); PG8_BAR; PG8_MMA(1, 0, At, B0); PG8_MMA(1, 1, At, B1); PG8_BAR; PG8_SCHED;
            } else {
            PG8_LDB(B0, 0, 0); PG8_SCHED; PG8_LDA(At, 0, 0); PG8_STAGE(PG8_SA(1, 1), a1 + hstepA, voffA);
            PG8_WAIT_L(8); PG8_BAR; PG8_WAIT_L(0); PG8_MMA(0, 0, At, B0); PG8_BAR; PG8_SCHED;
            PG8_LDB(B1, 0, 1); PG8_STAGE(PG8_SB(0, 0), b2, voffB);
            PG8_BAR; PG8_WAIT_L(0); PG8_MMA(0, 1, At, B1); PG8_BAR;
            PG8_LDA(At, 0, 1); PG8_STAGE(PG8_SA(0, 0), a2, voffA);
            PG8_BAR; PG8_WAIT_L(0); PG8_MMA(1, 0, At, B0); PG8_BAR; PG8_SCHED;
            PG8_STAGE(PG8_SB(0, 1), b2 + hstepB, voffB);
            PG8_WAIT_V(6); PG8_BAR; PG8_MMA(1, 1, At, B1); PG8_BAR;
            PG8_LDB(B0, 1, 0); PG8_SCHED; PG8_LDA(At, 1, 0); PG8_STAGE(PG8_SA(0, 1), a2 + hstepA, voffA);
            PG8_WAIT_L(8); PG8_BAR; PG8_WAIT_L(0); PG8_MMA(0, 0, At, B0); PG8_BAR; PG8_SCHED;
            PG8_LDB(B1, 1, 1); PG8_STAGE(PG8_SB(1, 0), b3, voffB);
            PG8_BAR; PG8_WAIT_L(0); PG8_MMA(0, 1, At, B1); PG8_BAR;
            PG8_LDA(At, 1, 1); PG8_STAGE(PG8_SA(1, 0), a3, voffA);
            PG8_BAR; PG8_WAIT_L(0); PG8_MMA(1, 0, At, B0); PG8_BAR; PG8_SCHED;
            PG8_STAGE(PG8_SB(1, 1), b3 + hstepB, voffB);
            PG8_WAIT_V(6); PG8_BAR; PG8_MMA(1, 1, At, B1); PG8_BAR;
            }
        }
        if constexpr (ALIGN_EPI) { if (wr == 0) PG8_BAR; }
        if constexpr (!Epi::AFTER_DRAIN) { E(acc, cur, wr, wc, fr, fq); S.done(cur); }
        if (!has_next) break;
#pragma unroll
        for (int a = 0; a < 2; ++a)
#pragma unroll
            for (int b = 0; b < 2; ++b)
#pragma unroll
                for (int m = 0; m < 4; ++m)
#pragma unroll
                    for (int n = 0; n < 2; ++n) acc[a][b][m][n] = (f32x4){0.f, 0.f, 0.f, 0.f};
        cur = nxt; cA = nA; cB = nB; ++ui;
        if constexpr (ALIGN_EPI) { if (wr == 1) PG8_BAR; }
    }
    PG8_WAIT_V(0);
    if constexpr (!ALIGN_EPI) { if (wr == 0) PG8_BAR; }
    PG8_BAR;
    if constexpr (Epi::AFTER_DRAIN) { E.fused(acc, cur, wr, wc, fr, fq, lds, wid, lane); S.done(cur); }
#undef PG8_SA
#undef PG8_SB
#undef PG8_STAGE
#undef PG8_LDA
#undef PG8_LDB
#undef PG8_MMA
#undef PG8_WAIT_V
#undef PG8_WAIT_L
#undef PG8_BAR
#undef PG8_SCHED
}
}

template <class Core> struct EpiMfma {
    static constexpr bool PERM = true, AFTER_DRAIN = false;
    Core c;
    __device__ __forceinline__ void operator()(const pg8::f32x4 (&acc)[2][2][4][2], const pg8::Unit& u, int wr, int wc, int fr, int fq) const {
        float gmax[2] = {0.f, 0.f};
#pragma unroll
        for (int ai = 0; ai < 2; ++ai)
#pragma unroll
            for (int m = 0; m < 4; ++m) {
                const int row = u.pm * 256 + ai * 128 + wr * 64 + m * 16 + fr;
                const float rs = c.rowscale(row);
                float part = 0.f;
#pragma unroll
                for (int bj = 0; bj < 2; ++bj) {
                    const int col0 = u.pn * 256 + bj * 128 + wc * 32 + 8 * fq;
                    const float v[8] = {acc[ai][bj][m][0][0], acc[ai][bj][m][0][1], acc[ai][bj][m][0][2], acc[ai][bj][m][0][3],
                                        acc[ai][bj][m][1][0], acc[ai][bj][m][1][1], acc[ai][bj][m][1][2], acc[ai][bj][m][1][3]};
                    const float p = c.apply8(row, col0, v, rs);
                    part += p;
                    if (Core::GROUPMAX) { float q = p; q += __shfl_xor(q, 16); q += __shfl_xor(q, 32); gmax[bj] = fmaxf(gmax[bj], q); }
                }
                part += __shfl_xor(part, 16); part += __shfl_xor(part, 32);
                if (fq == 0) c.store_part(row, u.pn * 256, (u.pn & 3) * 4 + wc, part);
            }
        if (Core::GROUPMAX) {
#pragma unroll
            for (int bj = 0; bj < 2; ++bj) { const int colg = u.pn * 256 + bj * 128 + wc * 32;
                if (c.want_groupmax(colg)) { const float m = wave_max(gmax[bj]); if (fr == 0 && fq == 0) c.store_groupmax(u.pm * 256, colg, m); } }
        }
    }
};
#ifndef USE_MFMA_GEMM
#define USE_MFMA_GEMM 1
#endif
template <class Core>
__device__ __forceinline__ void run_gemm(LAS unsigned char* lds, const bf16* A, int lda, const bf16* Bt, int M, int N, int K, const Core& c, int vcu, int G) {
#if USE_MFMA_GEMM
    int bxo = (int)blockIdx.x; asm volatile("" : "+s"(bxo));
    pg8::Gemm g{A, lda, Bt, M, N, K}; pg8::StaticOrder S; S.init(M, N, G, bxo);
    EpiMfma<Core> E{c};
    pg8::gemm_phase<EpiMfma<Core>, pg8::StaticOrder, true, true>(lds, g, S, E);
#else
    gemm_naive(lds, A, lda, Bt, M, N, K, c, vcu, G);
#endif
}

#include <hip/hip_bf16.h>
#include <cmath>
namespace attn_body {
using bf16=__hip_bfloat16;
using bf16x8=__attribute__((ext_vector_type(8)))short;
using s16x4=__attribute__((ext_vector_type(4)))short;
using f32x16=__attribute__((ext_vector_type(16)))float;
using u32x4=__attribute__((ext_vector_type(4)))unsigned;
constexpr int SEQ=8192,D=64,PQ=3072,PO=2048;
constexpr int NW=8,QBLK=32,QB=QBLK*NW,KVBLK=64,NQB=SEQ/QB;
__device__ __forceinline__ int crow(int r,int hi){return (r&3)+8*(r>>2)+4*hi;}
#define SBAR() __builtin_amdgcn_sched_barrier(0)
__device__ __forceinline__ void cmask(f32x16&p0,f32x16&p1,int jb,int qrel,int hi){
  const float NEG=-INFINITY; int kb=64*jb+4*hi;
  #pragma unroll
  for(int r=0;r<16;++r){int kv=kb+(r&3)+8*(r>>2); if(kv>qrel)p0[r]=NEG; if(kv+32>qrel)p1[r]=NEG;}
}

constexpr int NSLOT=3, SLOTB=8192;
constexpr int LDS_K=0, LDS_V=NSLOT*SLOTB, LDS_WS=2*NSLOT*SLOTB, LDS_OST=LDS_WS+NW*64*4, LDS_BYTES=LDS_OST+NW*4096;
constexpr float C2=0.125f*1.4426950408889634f;
__device__ __forceinline__ void glds16(const void*gsrc,unsigned lds_dst){unsigned keep;
  asm volatile("s_mov_b32 %0, m0\n\ts_mov_b32 m0, %2\n\ts_nop 0\n\tglobal_load_lds_dwordx4 %1, off\n\ts_mov_b32 m0, %0":"=&s"(keep):"v"(gsrc),"s"(lds_dst):"memory");}
__device__ __forceinline__ float max3f(float a,float b,float c){float r;asm("v_max3_f32 %0, %1, %2, %3":"=v"(r):"v"(a),"v"(b),"v"(c));return r;}
__device__ __forceinline__ float max2f(float a,float b){float r;asm("v_max_f32_e32 %0, %1, %2":"=v"(r):"v"(a),"v"(b));return r;}
__device__ __forceinline__ float fadd_s(float a,float b){float r;asm("v_add_f32_e32 %0, %1, %2":"=v"(r):"v"(a),"v"(b));return r;}
__device__ __forceinline__ float fsub_s(float a,float b){float r;asm("v_sub_f32_e32 %0, %1, %2":"=v"(r):"v"(a),"v"(b));return r;}
typedef float f32x2_t __attribute__((ext_vector_type(2))); typedef __bf16 bf16x2_t __attribute__((ext_vector_type(2)));
__device__ __forceinline__ unsigned cvtpk_s(float lo,float hi){f32x2_t v={lo,hi};bf16x2_t b=__builtin_convertvector(v,bf16x2_t);return __builtin_bit_cast(unsigned,b);}
#define WAIT_BAR(N) asm volatile("s_waitcnt vmcnt(" #N ") lgkmcnt(0)\n\ts_barrier":::"memory")

__device__ __forceinline__ void qkt(f32x16&p0,f32x16&p1,const char*Kslot,const bf16x8*qr,const f32x16&negm,int r32,int hi){
  const char*kb=Kslot+hi*1024+r32*16;
  #pragma unroll
  for(int d0=0;d0<4;++d0){
    const bf16x8 b0=*reinterpret_cast<const bf16x8*>(kb+d0*2048);
    const bf16x8 b1=*reinterpret_cast<const bf16x8*>(kb+d0*2048+512);
    if(d0==0){p0=__builtin_amdgcn_mfma_f32_32x32x16_bf16(b0,qr[0],negm,0,0,0);p1=__builtin_amdgcn_mfma_f32_32x32x16_bf16(b1,qr[0],negm,0,0,0);}
    else{p0=__builtin_amdgcn_mfma_f32_32x32x16_bf16(b0,qr[d0],p0,0,0,0);p1=__builtin_amdgcn_mfma_f32_32x32x16_bf16(b1,qr[d0],p1,0,0,0);}}
}
typedef __attribute__((address_space(3))) const char* lds_cptr;
typedef short v4i16_t __attribute__((ext_vector_type(4)));
__device__ __forceinline__ void kload8(bf16x8*kf,lds_cptr kp){
  kf[0]=*(const __attribute__((address_space(3))) bf16x8*)(kp);      kf[1]=*(const __attribute__((address_space(3))) bf16x8*)(kp+512);
  kf[2]=*(const __attribute__((address_space(3))) bf16x8*)(kp+2048); kf[3]=*(const __attribute__((address_space(3))) bf16x8*)(kp+2560);
  kf[4]=*(const __attribute__((address_space(3))) bf16x8*)(kp+4096); kf[5]=*(const __attribute__((address_space(3))) bf16x8*)(kp+4608);
  kf[6]=*(const __attribute__((address_space(3))) bf16x8*)(kp+6144); kf[7]=*(const __attribute__((address_space(3))) bf16x8*)(kp+6656);
}
__device__ __forceinline__ void kload2(bf16x8*kf,lds_cptr kp,int j){ kf[2*j]=*(const __attribute__((address_space(3))) bf16x8*)(kp+j*2048); kf[2*j+1]=*(const __attribute__((address_space(3))) bf16x8*)(kp+j*2048+512); }
__device__ __forceinline__ s16x4 vtr(lds_cptr p){ return __builtin_bit_cast(s16x4,__builtin_amdgcn_ds_read_tr16_b64_v4i16((__attribute__((address_space(3))) v4i16_t*)p)); }
__device__ __forceinline__ float rowmax(const f32x16&p0,const f32x16&p1){
  float a=max3f(p0[0],p0[1],p1[0]),b=max3f(p0[2],p0[3],p1[1]);a=max3f(a,p1[2],p1[3]);
  #pragma unroll
  for(int r=4;r<16;r+=4){a=max3f(a,p0[r],p0[r+1]);b=max3f(b,p0[r+2],p0[r+3]);a=max3f(a,p1[r],p1[r+1]);b=max3f(b,p1[r+2],p1[r+3]);}
  const float m=max2f(a,b);
  auto rr=__builtin_amdgcn_permlane32_swap(__float_as_uint(m),__float_as_uint(m),false,false);
  return max2f(__uint_as_float(rr[0]),__uint_as_float(rr[1]));
}
__device__ __forceinline__ void pv(f32x16*o,int vb,bf16x8 pa0,bf16x8 pa1,bf16x8 pa2,bf16x8 pa3){
  #pragma unroll
  for(int d0=0;d0<2;++d0){s16x4 lo[4],hi[4];
    #pragma unroll
    for(int ks=0;ks<4;++ks){
      asm volatile("ds_read_b64_tr_b16 %0,%1 offset:%c2":"=&v"(lo[ks]):"v"(vb),"i"(d0*4096+ks*1024):"memory");
      asm volatile("ds_read_b64_tr_b16 %0,%1 offset:%c2":"=&v"(hi[ks]):"v"(vb),"i"(d0*4096+ks*1024+512):"memory");}
    asm volatile("s_waitcnt lgkmcnt(0)":::"memory");SBAR();
    #define PK(k) (bf16x8){lo[k][0],lo[k][1],lo[k][2],lo[k][3],hi[k][0],hi[k][1],hi[k][2],hi[k][3]}
    o[d0]=__builtin_amdgcn_mfma_f32_32x32x16_bf16(pa0,PK(0),o[d0],0,0,0);
    o[d0]=__builtin_amdgcn_mfma_f32_32x32x16_bf16(pa1,PK(1),o[d0],0,0,0);
    o[d0]=__builtin_amdgcn_mfma_f32_32x32x16_bf16(pa2,PK(2),o[d0],0,0,0);
    o[d0]=__builtin_amdgcn_mfma_f32_32x32x16_bf16(pa3,PK(3),o[d0],0,0,0);
    #undef PK
  }
}

#ifndef ATTN_STORE16
#define ATTN_STORE16(p,v) (*(u32x4*)(p)=(v))
#endif
template<int THRL> __device__ __forceinline__ void attn_unit(int b,int qb,int t0,const bf16*Q,const bf16*K,const bf16*V,bf16*O,float slope2,char*shm){
  const int tid=otid(),lane=tid&63,r32=lane&31,hi=lane>>5; const int wid=__builtin_amdgcn_readfirstlane(tid>>6);
  const long rowbase=(long)b*SEQ; const int q0=qb*QB;
  const bf16*Qw=Q+(rowbase+q0+wid*QBLK)*PQ;
  const bf16*Kh=K+(rowbase+(long)t0*KVBLK)*PQ,*Vh=V+(rowbase+(long)t0*KVBLK)*PQ;
  const unsigned lds0=(unsigned)(uintptr_t)shm;
  float*wsf=(float*)(shm+LDS_WS)+wid*64;
  const bf16*ksrc=Kh+(long)lane*PQ+wid*8;
  const bf16*vsrc=Vh+(long)(16*(wid&3)+(lane>>2))*PQ+(wid>>2)*32+(lane&3)*8;
  const unsigned kdst=lds0+LDS_K+wid*1024, vdst=lds0+LDS_V+wid*1024;
  #define DMA_K(t,slot) glds16(ksrc+(long)(t)*KVBLK*PQ,(unsigned)__builtin_amdgcn_readfirstlane(kdst+(slot)))
  #define DMA_V(t,slot) glds16(vsrc+(long)(t)*KVBLK*PQ,(unsigned)__builtin_amdgcn_readfirstlane(vdst+(slot)))
  const int vb0=(int)(lds0+LDS_V)+((lane>>4)&1)*32+(lane&3)*8+(4*hi+((lane&15)>>2))*64;
  const char*Kbase=shm+LDS_K; bf16x8 kf[8];
  const lds_cptr shm3=(lds_cptr)shm; const lds_cptr kp0=shm3+LDS_K+hi*1024+r32*16; const lds_cptr vp0=shm3+LDS_V+((lane>>4)&1)*32+(lane&3)*8+(4*hi+((lane&15)>>2))*64;
  const int NT=(q0+QB)/KVBLK-t0;
  DMA_K(0,0);DMA_V(0,0);DMA_K(1,SLOTB);
  bf16x8 qr[4];
  #pragma unroll
  for(int d0=0;d0<4;++d0)qr[d0]=*reinterpret_cast<const bf16x8*>(&Qw[(long)r32*PQ+d0*16+hi*8]);
  float l_reg=0.f;f32x16 o[2];o[0]=f32x16{};o[1]=f32x16{};f32x16 negm;
  _Pragma("unroll") for(int r=0;r<16;++r)negm[r]=slope2*(float)crow(r,hi);
  asm volatile("":"+v"(negm)); const float b32=32.f*slope2, step64=64.f*slope2;
  const int qrel=wid*QBLK+r32;
  #define CMASK(P0,P1,t) do{int jb_=(t)-(NT-4); if(jb_>=0)cmask(P0,P1,jb_,qrel,hi);}while(0)
  bool resc=false;
  #define START(P0,P1) do{ const float rm=rowmax(P0,P1); resc=false; \
    { const float dl=rm; \
      _Pragma("unroll") for(int r=0;r<16;++r){P0[r]=fsub_s(P0[r],dl);P1[r]=fsub_s(P1[r],dl);} \
      const float adj_=step64-dl; _Pragma("unroll") for(int r=0;r<16;++r)negm[r]+=adj_; asm volatile("":"+v"(negm)); } \
    _Pragma("unroll") for(int r=0;r<16;++r)P0[r]=__builtin_amdgcn_exp2f(P0[r]); }while(0)
  #define RESC() do{ if(resc){ asm volatile("s_waitcnt lgkmcnt(0)":::"memory"); \
      _Pragma("unroll") for(int d_=0;d_<2;++d_) _Pragma("unroll") for(int r=0;r<16;++r)o[d_][r]*=wsf[crow(r,hi)]; } }while(0)
  f32x16 pA0,pA1,pB0,pB1;
  int sl_prev=0,sl_cur=0,sl_next=SLOTB;
  #define ROT() do{sl_prev=sl_cur;sl_cur=sl_next;sl_next=(sl_next==(NSLOT-1)*SLOTB)?0:sl_next+SLOTB;}while(0)
  DMA_K(2,2*SLOTB);
  WAIT_BAR(3);
  qkt(pA0,pA1,Kbase,qr,negm,r32,hi);asm volatile("s_nop 15\n\ts_nop 7":"+v"(pA0),"+v"(pA1));
  _Pragma("unroll") for(int r=0;r<16;++r)pA1[r]+=b32;
  CMASK(pA0,pA1,0);
  START(pA0,pA1);
  _Pragma("unroll") for(int r=0;r<16;++r)pA1[r]=__builtin_amdgcn_exp2f(pA1[r]);
  WAIT_BAR(0);
  DMA_K(3,0);DMA_V(1,SLOTB);
  ROT();
  kload8(kf,kp0+sl_cur);
  WAIT_BAR(2);
  s16x4 vlo[8],vhi[8]; u32x4 pw0,pw1,pw2,pw3;
  #define PKW(P,B) cvtpk_s(P[B],P[B+1])
  #define PAF(k) __builtin_bit_cast(bf16x8,pw##k)
  #define VFR(i) (bf16x8){vlo[i][0],vlo[i][1],vlo[i][2],vlo[i][3],vhi[i][0],vhi[i][1],vhi[i][2],vhi[i][3]}
  #define PIN(x) asm volatile("":"+v"(x))
  #define MX3(a,b,c) __builtin_fmaxf(__builtin_fmaxf((a),(b)),(c))
  #define GAPA(MF,A0,A1,A2,A3,W0,W1,PW) do{ MF; sacc+=A0; sacc+=A1; sacc+=A2; sacc+=A3; PIN(sacc); W0; W1; PIN(PW); SBAR(); }while(0)
  #define EX(v) __builtin_amdgcn_exp2f(v)
  #define GAPB(MF,X,B) do{ MF; X[B]=EX(X[B]); X[B+1]=EX(X[B+1]); X[B+2]=EX(X[B+2]); X[B+3]=EX(X[B+3]); PIN(X); SBAR(); }while(0)
  #define VRD(i) do{ vlo[i]=vtr(vp_+(((i)>>2)*4096+((i)&3)*1024)); vhi[i]=vtr(vp_+(((i)>>2)*4096+((i)&3)*1024+512)); }while(0)
  #define KRD(G,j) do{ if(G){ kload2(kf,kp0+sl_next,j); SBAR(); } }while(0)
  #define STEP(C0,C1,P0,P1,t,GK,GV,GL) do{ SBAR(); \
    const lds_cptr vp_=vp0+sl_prev; \
    VRD(0); SBAR(); float sacc=(P0[0]+P0[1]); \
    GAPA(C0=__builtin_amdgcn_mfma_f32_32x32x16_bf16(kf[0],qr[0],negm,0,0,0), P0[2],P0[3],P0[4],P0[5],     pw0[0]=PKW(P0,0), pw0[1]=PKW(P0,2), pw0); \
    VRD(4); SBAR(); GAPA(C1=__builtin_amdgcn_mfma_f32_32x32x16_bf16(kf[1],qr[0],negm,0,0,0), P0[6],P0[7],P0[8],P0[9],     pw0[2]=PKW(P0,4), pw0[3]=PKW(P0,6), pw0); \
    VRD(1); SBAR(); GAPA(C0=__builtin_amdgcn_mfma_f32_32x32x16_bf16(kf[2],qr[1],C0,0,0,0),   P0[10],P0[11],P0[12],P0[13], pw1[0]=PKW(P0,8), pw1[1]=PKW(P0,10), pw1); \
    VRD(5); SBAR(); GAPA(C1=__builtin_amdgcn_mfma_f32_32x32x16_bf16(kf[3],qr[1],C1,0,0,0),   P0[14],P0[15],P1[0],P1[1],   pw1[2]=PKW(P0,12),pw1[3]=PKW(P0,14), pw1); \
    VRD(2); SBAR(); GAPA(C0=__builtin_amdgcn_mfma_f32_32x32x16_bf16(kf[4],qr[2],C0,0,0,0),   P1[2],P1[3],P1[4],P1[5],     pw2[0]=PKW(P1,0), pw2[1]=PKW(P1,2), pw2); \
    VRD(6); SBAR(); GAPA(C1=__builtin_amdgcn_mfma_f32_32x32x16_bf16(kf[5],qr[2],C1,0,0,0),   P1[6],P1[7],P1[8],P1[9],     pw2[2]=PKW(P1,4), pw2[3]=PKW(P1,6), pw2); \
    VRD(3); SBAR(); GAPA(C0=__builtin_amdgcn_mfma_f32_32x32x16_bf16(kf[6],qr[3],C0,0,0,0),   P1[10],P1[11],P1[12],P1[13], pw3[0]=PKW(P1,8), pw3[1]=PKW(P1,10), pw3); \
    VRD(7); SBAR(); GAPA(C1=__builtin_amdgcn_mfma_f32_32x32x16_bf16(kf[7],qr[3],C1,0,0,0),   P1[14],P1[15],0.f,0.f,       pw3[2]=PKW(P1,12),pw3[3]=PKW(P1,14), pw3); \
    l_reg+=sacc; \
    if(GK){DMA_K((t)+3,sl_cur);} if(GV){DMA_V((t)+1,sl_next);} \
    _Pragma("unroll") for(int r=0;r<16;++r)C1[r]+=b32; \
    CMASK(C0,C1,t); \
    { float a=MX3(C0[0],C0[1],C1[0]),b=MX3(C0[2],C0[3],C1[1]); a=MX3(a,C1[2],C1[3]); \
      _Pragma("unroll") for(int r=4;r<16;r+=4){a=MX3(a,C0[r],C0[r+1]);b=MX3(b,C0[r+2],C0[r+3]);a=MX3(a,C1[r],C1[r+1]);b=MX3(b,C1[r+2],C1[r+3]);} \
      float rm=__builtin_fmaxf(a,b); { auto rr=__builtin_amdgcn_permlane32_swap(__float_as_uint(rm),__float_as_uint(rm),false,false); rm=__builtin_fmaxf(__uint_as_float(rr[0]),__uint_as_float(rr[1])); } \
      resc=false; float adj_=step64; \
      if(__any(rm>(float)THRL)){ const float dl=__builtin_fmaxf(rm,0.f); adj_-=dl; \
        _Pragma("unroll") for(int r=0;r<16;++r){C0[r]-=dl;C1[r]-=dl;} \
        const float f=__builtin_amdgcn_exp2f(-dl); l_reg*=f; if(hi==0)wsf[r32]=f; resc=true; } \
      _Pragma("unroll") for(int r=0;r<16;++r)negm[r]+=adj_; asm volatile("":"+v"(negm)); } \
    SBAR(); \
    GAPB(o[0]=__builtin_amdgcn_mfma_f32_32x32x16_bf16(PAF(0),VFR(0),o[0],0,0,0), C0,0); \
    GAPB(o[1]=__builtin_amdgcn_mfma_f32_32x32x16_bf16(PAF(0),VFR(4),o[1],0,0,0), C0,4); \
    KRD(GL,0); GAPB(o[0]=__builtin_amdgcn_mfma_f32_32x32x16_bf16(PAF(1),VFR(1),o[0],0,0,0), C0,8); \
    KRD(GL,1); GAPB(o[1]=__builtin_amdgcn_mfma_f32_32x32x16_bf16(PAF(1),VFR(5),o[1],0,0,0), C0,12); \
    KRD(GL,2); GAPB(o[0]=__builtin_amdgcn_mfma_f32_32x32x16_bf16(PAF(2),VFR(2),o[0],0,0,0), C1,0); \
    KRD(GL,3); GAPB(o[1]=__builtin_amdgcn_mfma_f32_32x32x16_bf16(PAF(2),VFR(6),o[1],0,0,0), C1,4); \
    GAPB(o[0]=__builtin_amdgcn_mfma_f32_32x32x16_bf16(PAF(3),VFR(3),o[0],0,0,0), C1,8); \
    GAPB(o[1]=__builtin_amdgcn_mfma_f32_32x32x16_bf16(PAF(3),VFR(7),o[1],0,0,0), C1,12); \
    }while(0)
  int t=1;
  #undef CMASK
  #define CMASK(P0,P1,t) do{}while(0)
  for(;t+5<NT;t+=2){
    STEP(pB0,pB1,pA0,pA1,t,true,true,true);     WAIT_BAR(2); RESC(); ROT();
    STEP(pA0,pA1,pB0,pB1,t+1,true,true,true);   WAIT_BAR(2); RESC(); ROT();
  }
  #undef CMASK
  #define CMASK(P0,P1,t) do{int jb_=(t)-(NT-4); if(jb_>=0)cmask(P0,P1,jb_,qrel,hi);}while(0)
  #define ENDW(tt) do{ if((tt)+3<NT){WAIT_BAR(2);} else if((tt)+2<NT){WAIT_BAR(1);} else {WAIT_BAR(0);} }while(0)
  for(;t+1<NT;t+=2){
    STEP(pB0,pB1,pA0,pA1,t,(t+3<NT),(t+1<NT),(t+1<NT));       ENDW(t);   RESC(); ROT();
    STEP(pA0,pA1,pB0,pB1,t+1,(t+4<NT),(t+2<NT),(t+2<NT));     ENDW(t+1); RESC(); ROT();
  }
  STEP(pB0,pB1,pA0,pA1,NT-1,false,false,false); RESC();
  { float sacc=pB0[0]+pB0[1]; _Pragma("unroll") for(int r=2;r<16;++r)sacc+=pB0[r]; _Pragma("unroll") for(int r=0;r<16;++r)sacc+=pB1[r]; l_reg+=sacc;
    pw0=(u32x4){PKW(pB0,0),PKW(pB0,2),PKW(pB0,4),PKW(pB0,6)};pw1=(u32x4){PKW(pB0,8),PKW(pB0,10),PKW(pB0,12),PKW(pB0,14)};pw2=(u32x4){PKW(pB1,0),PKW(pB1,2),PKW(pB1,4),PKW(pB1,6)};pw3=(u32x4){PKW(pB1,8),PKW(pB1,10),PKW(pB1,12),PKW(pB1,14)};
    SBAR(); pv(o,vb0+sl_cur,PAF(0),PAF(1),PAF(2),PAF(3)); }
  #undef PKW
  #undef PAF
  #undef VFR
  #undef PIN
  #undef MX3
  #undef GAPA
  #undef GAPB
  #undef EX
  #undef VRD
  #undef KRD
  #undef STEP
  #undef ENDW
  {auto rr=__builtin_amdgcn_permlane32_swap(__float_as_uint(l_reg),__float_as_uint(l_reg),false,false);l_reg=__uint_as_float(rr[0])+__uint_as_float(rr[1]);}
  if(hi==0)wsf[32+r32]=l_reg;asm volatile("s_waitcnt lgkmcnt(0)":::"memory");
  float rli[16];
  #pragma unroll
  for(int r=0;r<16;++r)rli[r]=__builtin_amdgcn_rcpf(wsf[32+crow(r,hi)]);
  bf16*Ow=O+(rowbase+q0+wid*QBLK)*PO;
  { bf16*stg=(bf16*)(shm+LDS_OST)+wid*2048;
    #pragma unroll
    for(int r=0;r<16;++r){const int orow=crow(r,hi);
      #pragma unroll
      for(int d0=0;d0<2;++d0)stg[orow*64+d0*32+r32]=__float2bfloat16(o[d0][r]*rli[r]);}
    asm volatile("s_waitcnt lgkmcnt(0)":::"memory");
    #pragma unroll
    for(int i=0;i<4;++i){const int row=i*8+(lane>>3),ch=lane&7; const u32x4 v=*(const u32x4*)(stg+row*64+ch*8); ATTN_STORE16(Ow+(long)row*PO+ch*8,v);} }
  asm volatile("s_waitcnt lgkmcnt(0)\n\ts_barrier":::"memory");
  #undef DMA_K
  #undef DMA_V
  #undef CMASK
  #undef START
  #undef RESC
  #undef ROT
}

namespace v2 {
constexpr int NSL=4, KSLOT=8192, VSLOT=16384, LDS_K2=0, LDS_V2=NSL*KSLOT, LDS_WS2=LDS_V2+NSL*VSLOT, LDS_BYTES2=LDS_WS2+NW*64*4;
#define V2_WAIT_BAR(N) asm volatile("s_waitcnt vmcnt(" #N ") lgkmcnt(0)\n\ts_barrier":::"memory")
#define V2_MX3(a,b,c) __builtin_fmaxf(__builtin_fmaxf((a),(b)),(c))
}
template<int THRL> __device__ __forceinline__ void attn_unit_v2(int b,int qb,int t0,const bf16*Q,const bf16*K,const bf16*V,bf16*O,float slope2,char*shm){
  using namespace v2;
  const int tid=otid(),lane=tid&63,r32=lane&31,hi=lane>>5; const int wid=__builtin_amdgcn_readfirstlane(tid>>6);
  const long rowbase=(long)b*SEQ; const int q0=qb*QB;
  const bf16*Qw=Q+(rowbase+q0+wid*QBLK)*PQ;
  const bf16*Kh=K+(rowbase+(long)t0*KVBLK)*PQ,*Vh=V+(rowbase+(long)t0*KVBLK)*PQ;
  const unsigned lds0=(unsigned)(uintptr_t)shm;
  float*wsf=(float*)(shm+LDS_WS2)+wid*64;
  const bf16*ksrc=Kh+(long)lane*PQ+wid*8;
  const int pi0=2*wid, pi1=2*wid+1;
  const bf16*vsrc0=Vh+(long)(16*(pi0&3)+(lane>>2))*PQ+(pi0>>2)*32+(lane&3)*8;
  const bf16*vsrc1=Vh+(long)(16*(pi1&3)+(lane>>2))*PQ+(pi1>>2)*32+(lane&3)*8;
  const unsigned kdst=lds0+LDS_K2+wid*1024, vdst0=lds0+LDS_V2+pi0*1024, vdst1=lds0+LDS_V2+pi1*1024;
  #define V2_DMA(t,sl) do{ glds16(ksrc+(long)(t)*KVBLK*PQ,(unsigned)__builtin_amdgcn_readfirstlane(kdst+(sl)*KSLOT)); \
      glds16(vsrc0+(long)(t)*KVBLK*PQ,(unsigned)__builtin_amdgcn_readfirstlane(vdst0+(sl)*VSLOT)); \
      glds16(vsrc1+(long)(t)*KVBLK*PQ,(unsigned)__builtin_amdgcn_readfirstlane(vdst1+(sl)*VSLOT)); }while(0)
  const int NT=(q0+QB)/KVBLK-t0;
  V2_DMA(0,0); V2_DMA(1,1);
  bf16x8 qr[4];
  #pragma unroll
  for(int d0=0;d0<4;++d0)qr[d0]=*reinterpret_cast<const bf16x8*>(&Qw[(long)r32*PQ+d0*16+hi*8]);
  float l_reg=0.f; f32x16 o[4];
  #pragma unroll
  for(int d0=0;d0<4;++d0)o[d0]=f32x16{};
  f32x16 negm;
  #pragma unroll
  for(int r=0;r<16;++r)negm[r]=slope2*(float)crow(r,hi);
  const float b32=32.f*slope2, step64=64.f*slope2;
  const int qrel=wid*QBLK+r32;
  const lds_cptr shm3=(lds_cptr)shm; const lds_cptr kp0=shm3+LDS_K2+hi*1024+r32*16; const lds_cptr vp0=shm3+LDS_V2+((lane>>4)&1)*32+(lane&3)*8+(4*hi+((lane&15)>>2))*64;
  f32x16 p0,p1; u32x4 pw0,pw1,pw2,pw3, qw0,qw1,qw2,qw3;
  #define V2_PIN(x) asm volatile("":"+v"(x))
  #define V2_VRD(dst,d0) do{ _Pragma("unroll") for(int ks=0;ks<4;++ks){ dst[2*ks]=vtr(vp+(d0)*4096+ks*1024); dst[2*ks+1]=vtr(vp+(d0)*4096+ks*1024+512);} }while(0)
  #define V2_VF(src,ks) (bf16x8){src[2*(ks)][0],src[2*(ks)][1],src[2*(ks)][2],src[2*(ks)][3],src[2*(ks)+1][0],src[2*(ks)+1][1],src[2*(ks)+1][2],src[2*(ks)+1][3]}
  #define V2_QK(t) do{ const lds_cptr kp=kp0+((t)&3)*KSLOT; bf16x8 kf[8]; \
      _Pragma("unroll") for(int d0=0;d0<4;++d0){ kf[2*d0]=*(const __attribute__((address_space(3))) bf16x8*)(kp+d0*2048); kf[2*d0+1]=*(const __attribute__((address_space(3))) bf16x8*)(kp+d0*2048+512); } \
      SBAR(); \
      p0=__builtin_amdgcn_mfma_f32_32x32x16_bf16(kf[0],qr[0],negm,0,0,0); p1=__builtin_amdgcn_mfma_f32_32x32x16_bf16(kf[1],qr[0],negm,0,0,0); \
      _Pragma("unroll") for(int d0=1;d0<4;++d0){ p0=__builtin_amdgcn_mfma_f32_32x32x16_bf16(kf[2*d0],qr[d0],p0,0,0,0); p1=__builtin_amdgcn_mfma_f32_32x32x16_bf16(kf[2*d0+1],qr[d0],p1,0,0,0); } \
      SBAR(); }while(0)
  bool resc=false;
  #define V2_DECIDE(t,FIRST) do{ \
      _Pragma("unroll") for(int r=0;r<16;++r)p1[r]+=b32; \
      { const int jb=(t)-(NT-4); if(jb>=0)cmask(p0,p1,jb,qrel,hi); } \
      float rm; \
      { float a=V2_MX3(p0[0],p0[1],p1[0]),c=V2_MX3(p0[2],p0[3],p1[1]); a=V2_MX3(a,p1[2],p1[3]); \
        _Pragma("unroll") for(int r=4;r<16;r+=4){a=V2_MX3(a,p0[r],p0[r+1]);c=V2_MX3(c,p0[r+2],p0[r+3]);a=V2_MX3(a,p1[r],p1[r+1]);c=V2_MX3(c,p1[r+2],p1[r+3]);} \
        rm=__builtin_fmaxf(a,c); auto rr=__builtin_amdgcn_permlane32_swap(__float_as_uint(rm),__float_as_uint(rm),false,false); rm=__builtin_fmaxf(__uint_as_float(rr[0]),__uint_as_float(rr[1])); } \
      float adj=step64; resc=false; \
      if(FIRST){ _Pragma("unroll") for(int r=0;r<16;++r){p0[r]-=rm;p1[r]-=rm;} adj-=rm; } \
      else if(__any(rm>(float)THRL)){ const float dl=__builtin_fmaxf(rm,0.f); \
        _Pragma("unroll") for(int r=0;r<16;++r){p0[r]-=dl;p1[r]-=dl;} \
        adj-=dl; const float f=__builtin_amdgcn_exp2f(-dl); l_reg*=f; if(hi==0)wsf[r32]=f; resc=true; } \
      _Pragma("unroll") for(int r=0;r<16;++r)negm[r]+=adj; \
      SBAR(); }while(0)
  float sacc;
  #define V2_GRP(d0,ks,src,P,B,QW,WI) do{ o[d0]=__builtin_amdgcn_mfma_f32_32x32x16_bf16(__builtin_bit_cast(bf16x8,pw##ks),V2_VF(src,ks),o[d0],0,0,0); \
      P[B]=__builtin_amdgcn_exp2f(P[B]); P[B+1]=__builtin_amdgcn_exp2f(P[B+1]); sacc+=P[B]; sacc+=P[B+1]; QW[WI]=cvtpk_s(P[B],P[B+1]); V2_PIN(sacc); V2_PIN(QW); SBAR(); }while(0)
  #define V2_SYNC(t) do{ if((t)+1<NT){ V2_WAIT_BAR(3); } else { V2_WAIT_BAR(0); } if((t)+2<NT){ V2_DMA((t)+2,((t)+2)&3); } }while(0)
  V2_SYNC(0); V2_QK(0); V2_DECIDE(0,true);
  sacc=0.f;
  #pragma unroll
  for(int r=0;r<16;++r){p0[r]=__builtin_amdgcn_exp2f(p0[r]);p1[r]=__builtin_amdgcn_exp2f(p1[r]);sacc+=p0[r]+p1[r];}
  l_reg+=sacc;
  pw0=(u32x4){cvtpk_s(p0[0],p0[1]),cvtpk_s(p0[2],p0[3]),cvtpk_s(p0[4],p0[5]),cvtpk_s(p0[6],p0[7])};
  pw1=(u32x4){cvtpk_s(p0[8],p0[9]),cvtpk_s(p0[10],p0[11]),cvtpk_s(p0[12],p0[13]),cvtpk_s(p0[14],p0[15])};
  pw2=(u32x4){cvtpk_s(p1[0],p1[1]),cvtpk_s(p1[2],p1[3]),cvtpk_s(p1[4],p1[5]),cvtpk_s(p1[6],p1[7])};
  pw3=(u32x4){cvtpk_s(p1[8],p1[9]),cvtpk_s(p1[10],p1[11]),cvtpk_s(p1[12],p1[13]),cvtpk_s(p1[14],p1[15])};
  for(int t=1;t<NT;++t){
    V2_SYNC(t);
    const lds_cptr vp=vp0+((t-1)&3)*VSLOT; s16x4 va[8],vb[8];
    V2_VRD(va,0);
    V2_QK(t); V2_DECIDE(t,false);
    sacc=0.f;
    V2_VRD(vb,1);
    V2_GRP(0,0,va,p0,0,qw0,0); V2_GRP(0,1,va,p0,2,qw0,1); V2_GRP(0,2,va,p0,4,qw0,2); V2_GRP(0,3,va,p0,6,qw0,3);
    V2_VRD(va,2);
    V2_GRP(1,0,vb,p0,8,qw1,0); V2_GRP(1,1,vb,p0,10,qw1,1); V2_GRP(1,2,vb,p0,12,qw1,2); V2_GRP(1,3,vb,p0,14,qw1,3);
    V2_VRD(vb,3);
    V2_GRP(2,0,va,p1,0,qw2,0); V2_GRP(2,1,va,p1,2,qw2,1); V2_GRP(2,2,va,p1,4,qw2,2); V2_GRP(2,3,va,p1,6,qw2,3);
    V2_GRP(3,0,vb,p1,8,qw3,0); V2_GRP(3,1,vb,p1,10,qw3,1); V2_GRP(3,2,vb,p1,12,qw3,2); V2_GRP(3,3,vb,p1,14,qw3,3);
    l_reg+=sacc;
    if(resc){ asm volatile("s_waitcnt lgkmcnt(0)":::"memory");
      #pragma unroll
      for(int r=0;r<16;++r){ const float fr_=wsf[crow(r,hi)];
        #pragma unroll
        for(int d0=0;d0<4;++d0)o[d0][r]*=fr_; }
      asm volatile("s_waitcnt lgkmcnt(0)":::"memory"); }
    pw0=qw0; pw1=qw1; pw2=qw2; pw3=qw3;
  }
  { const lds_cptr vp=vp0+((NT-1)&3)*VSLOT; s16x4 va[8],vb[8];
    #define V2_PV(d0,src) do{ o[d0]=__builtin_amdgcn_mfma_f32_32x32x16_bf16(__builtin_bit_cast(bf16x8,pw0),V2_VF(src,0),o[d0],0,0,0); \
        o[d0]=__builtin_amdgcn_mfma_f32_32x32x16_bf16(__builtin_bit_cast(bf16x8,pw1),V2_VF(src,1),o[d0],0,0,0); \
        o[d0]=__builtin_amdgcn_mfma_f32_32x32x16_bf16(__builtin_bit_cast(bf16x8,pw2),V2_VF(src,2),o[d0],0,0,0); \
        o[d0]=__builtin_amdgcn_mfma_f32_32x32x16_bf16(__builtin_bit_cast(bf16x8,pw3),V2_VF(src,3),o[d0],0,0,0); }while(0)
    V2_VRD(va,0); V2_VRD(vb,1); V2_PV(0,va); V2_VRD(va,2); V2_PV(1,vb); V2_VRD(vb,3); V2_PV(2,va); V2_PV(3,vb);
    #undef V2_PV
  }
  #undef V2_PIN
  #undef V2_VRD
  #undef V2_VF
  #undef V2_QK
  #undef V2_DECIDE
  #undef V2_GRP
  #undef V2_SYNC
  {auto rr=__builtin_amdgcn_permlane32_swap(__float_as_uint(l_reg),__float_as_uint(l_reg),false,false);l_reg=__uint_as_float(rr[0])+__uint_as_float(rr[1]);}
  if(hi==0)wsf[32+r32]=l_reg;asm volatile("s_waitcnt lgkmcnt(0)":::"memory");
  float rli[16];
  #pragma unroll
  for(int r=0;r<16;++r)rli[r]=__builtin_amdgcn_rcpf(wsf[32+crow(r,hi)]);
  asm volatile("s_waitcnt lgkmcnt(0)\n\ts_barrier":::"memory");
  bf16*Ow=O+(rowbase+q0+wid*QBLK)*PO;
  { bf16*stg=(bf16*)shm+wid*4096;
    #pragma unroll
    for(int r=0;r<16;++r){const int orow=crow(r,hi);
      #pragma unroll
      for(int d0=0;d0<4;++d0)stg[orow*128+d0*32+r32]=__float2bfloat16(o[d0][r]*rli[r]);}
    asm volatile("s_waitcnt lgkmcnt(0)":::"memory");
    #pragma unroll
    for(int i=0;i<8;++i){const int row=i*4+(lane>>4),ch=lane&15; const u32x4 v=*(const u32x4*)(stg+row*128+ch*8); *(u32x4*)(Ow+(long)row*PO+ch*8)=v;} }
  asm volatile("s_waitcnt lgkmcnt(0)\n\ts_barrier":::"memory");
  #undef V2_DMA
}
constexpr int ATTN_LDS_BYTES=LDS_BYTES;
#undef SBAR
#undef WAIT_BAR
}

#ifndef USE_MFMA_ATTN
#define USE_MFMA_ATTN 1
#endif
#ifndef ATTN_V2
#define ATTN_V2 1
#endif
__device__ __forceinline__ void phase_diff_mfma(char* shm, LAS unsigned char* lds, const Ctx& a, int vcu, int G) {
    bf16* proj = (bf16*)(a.ws + WS_H); bf16* o12 = (bf16*)(a.ws + WS_STATE);
    unsigned* ctl = (unsigned*)(a.ws + WS_CTL);
    volatile LAS unsigned* qslot = (volatile LAS unsigned*)(lds + MISC_OFF) + 16;
    for (;;) {
        const int tid = otid();
        if (tid == 0) *qslot = atomicAdd(ctl + CW_QUEUE, 1u);
        __syncthreads();
        const unsigned idx = (unsigned)__builtin_amdgcn_readfirstlane((int)*qslot);
        __syncthreads();
        if (idx >= (unsigned)(NB * DIFF_H * 2 * 32)) break;
        const int qb = 31 - (int)(idx >> 5), rem = idx & 31, b = rem >> 4, h = (rem >> 1) & 7, r = rem & 1;
        const float slope2 = exp2f(-(float)(h + 1)) * LOG2E;
        int t0 = 0;
        { const unsigned* qm = ctl + CW_QKMAX + b * 64; const int g0 = (h * 128 + r * 64) >> 5;
          const float pq = __uint_as_float(qm[g0]) + __uint_as_float(qm[g0 + 1]), pk = __uint_as_float(qm[32 + g0]) + __uint_as_float(qm[32 + g0 + 1]);
          const float smax = sqrtf(pq * pk);
          const float d = (float)(qb * 256) - (152.0f + 2.1f * smax) / slope2;
          if (d > 0.f) t0 = ((int)d >> 6) & ~1;
          if (t0 > 4 * qb) t0 = 4 * qb; }
#if ATTN_V2
        attn_body::attn_unit_v2<8>(b, qb, t0, (const attn_body::bf16*)(proj + h * 128 + r * 64), (const attn_body::bf16*)(proj + 1024 + h * 128 + r * 64),
                                   (const attn_body::bf16*)(proj + 2048 + h * 128), (attn_body::bf16*)(o12 + r * 1024 + h * 128), slope2, shm);
#else
#pragma nounroll
        for (int vh = 0; vh < 2; ++vh)
            attn_body::attn_unit<8>(b, qb, t0, (const attn_body::bf16*)(proj + h * 128 + r * 64), (const attn_body::bf16*)(proj + 1024 + h * 128 + r * 64),
                                    (const attn_body::bf16*)(proj + 2048 + h * 128 + vh * 64), (attn_body::bf16*)(o12 + r * 1024 + h * 128 + vh * 64), slope2, shm);
#endif
    }
}
__device__ __forceinline__ void phase_diff_combine(const Ctx& a, const LayerP& P, int vcu, int G) {
    const int tid = otid(), lane = tid & 63, wave = tid >> 6;
    bf16* proj = (bf16*)(a.ws + WS_H); const bf16* o12 = (const bf16*)(a.ws + WS_STATE);
    float lam;
    { float s1 = 0.f, s2 = 0.f;
      for (int i = 0; i < 64; ++i) { s1 += P.e0[i] * P.e1[i]; s2 += P.e2[i] * P.e3[i]; }
      lam = __expf(s1) - __expf(s2) + LAMBDA_INIT; }
    const int h = lane >> 3, sub = lane & 7;
    float hn[16];
#pragma unroll
    for (int j = 0; j < 16; ++j) hn[j] = P.e4[sub * 16 + j] * (1.0f - LAMBDA_INIT);
    const int gw = vcu * NWAVES + wave, NGW = G * NWAVES;
    for (int row = gw; row < NTOK; row += NGW) {
        const bf16* p1 = o12 + (size_t)row * 2048 + h * 128 + sub * 16;
        const v4u a0 = *(const v4u*)p1, a1 = *(const v4u*)(p1 + 8), b0 = *(const v4u*)(p1 + 1024), b1 = *(const v4u*)(p1 + 1032);
        const unsigned aw[8] = {a0.x, a0.y, a0.z, a0.w, a1.x, a1.y, a1.z, a1.w}, bw[8] = {b0.x, b0.y, b0.z, b0.w, b1.x, b1.y, b1.z, b1.w};
        float o[16]; float ss = 0.f;
#pragma unroll
        for (int j = 0; j < 8; ++j) { o[2 * j] = bflo(aw[j]) - lam * bflo(bw[j]); o[2 * j + 1] = bfhi(aw[j]) - lam * bfhi(bw[j]); ss += o[2 * j] * o[2 * j] + o[2 * j + 1] * o[2 * j + 1]; }
        ss += __shfl_xor(ss, 1); ss += __shfl_xor(ss, 2); ss += __shfl_xor(ss, 4);
        const float rs = 1.0f / sqrtf(ss * (1.0f / 128.0f) + EPS);
        v4u w0, w1;
        w0.x = pk2(o[0] * rs * hn[0], o[1] * rs * hn[1]); w0.y = pk2(o[2] * rs * hn[2], o[3] * rs * hn[3]); w0.z = pk2(o[4] * rs * hn[4], o[5] * rs * hn[5]); w0.w = pk2(o[6] * rs * hn[6], o[7] * rs * hn[7]);
        w1.x = pk2(o[8] * rs * hn[8], o[9] * rs * hn[9]); w1.y = pk2(o[10] * rs * hn[10], o[11] * rs * hn[11]); w1.z = pk2(o[12] * rs * hn[12], o[13] * rs * hn[13]); w1.w = pk2(o[14] * rs * hn[14], o[15] * rs * hn[15]);
        bf16* op = proj + (size_t)row * DIFF_PITCH + h * 128 + sub * 16;
        *(v4u*)op = w0; *(v4u*)(op + 8) = w1;
    }
}

typedef short mbf16x8 __attribute__((ext_vector_type(8)));
typedef short ms16x4 __attribute__((ext_vector_type(4)));
typedef float mf32x16 __attribute__((ext_vector_type(16)));
#define MFMA32(a, b, c) __builtin_amdgcn_mfma_f32_32x32x16_bf16(a, b, c, 0, 0, 0)
__device__ __forceinline__ int crow32(int r, int hi) { return (r & 3) + 8 * (r >> 2) + 4 * hi; }
__device__ __forceinline__ mbf16x8 frag_rk(const LAS unsigned char* base, int stride, int row0, int k0, int lane) {
    return *(const LAS mbf16x8*)(base + (row0 + (lane & 31)) * stride + (k0 + 8 * (lane >> 5)) * 2);
}
__device__ __forceinline__ mbf16x8 frag_kn(const LAS unsigned char* base, int stride, int k0, int n0, int lane) {
    const int i = lane & 15, g = lane >> 4;
    const LAS unsigned char* p = base + (k0 + 8 * (g >> 1) + (i >> 2)) * stride + (n0 + 16 * (g & 1) + 4 * (i & 3)) * 2;
    const ms16x4 lo = __builtin_bit_cast(ms16x4, __builtin_amdgcn_ds_read_tr16_b64_v4i16((LAS ms16x4*)p));
    const ms16x4 hi = __builtin_bit_cast(ms16x4, __builtin_amdgcn_ds_read_tr16_b64_v4i16((LAS ms16x4*)(p + 4 * stride)));
    return (mbf16x8){lo[0], lo[1], lo[2], lo[3], hi[0], hi[1], hi[2], hi[3]};
}
__device__ __forceinline__ mf32x16 zero16() { mf32x16 z;
#pragma unroll
    for (int r = 0; r < 16; ++r) z[r] = 0.f; return z; }

__device__ __forceinline__ void phase_sgu_mfma(LAS unsigned char* lds, const Ctx& a, const LayerP& P, int vcu, int G, bool dummy = false) {
    const int tid = otid(), lane = tid & 63, wave = __builtin_amdgcn_readfirstlane(tid >> 6);
    bf16* proj = (bf16*)(a.ws + WS_H); const float* vssq = (const float*)(a.ws + WS_VSSQ);
    const float* v_norm = P.e1; const float* w_s = P.e2; const float* b_s = P.e3;
    constexpr int SA = 272, SV = 320, SO = 132;
    LAS unsigned char* WA = lds;
    LAS unsigned char* VV = lds + 128 * SA;
    LAS float* RS = (LAS float*)(lds + 128 * SA + 128 * SV);
    LAS float* OS = (LAS float*)lds;
    const int tm = wave & 3, nh = wave >> 2, hi = lane >> 5;
    for (int u = vcu; u < NB * (T / SGU_C) * SGU_G; u += G) {
        const int g = u % SGU_G, bc = u / SGU_G;
        const int row0 = bc * SGU_C;
        if (tid < 128) RS[tid] = row_rstd(vssq, row0 + tid);
#pragma unroll
        for (int i = 0; i < 4; ++i) { const int ch = tid + NTHR * i, r = ch >> 4, c16 = ch & 15;
            const v4u w = *(const v4u*)(proj + (size_t)(row0 + r) * SGU_PITCH + 1024 + g * 128 + c16 * 8);
            *(LAS v4u*)(VV + r * SV + c16 * 16) = w; }
        __syncthreads();
#pragma unroll
        for (int i = 0; i < 8; ++i) { const int idx = tid + NTHR * i, t = idx >> 5, s4 = (idx & 31) * 4;
            const f32x4 w = *(const f32x4*)(w_s + (size_t)g * 16384 + t * 128 + s4);
            const float x0 = (s4 + 0 <= t) ? w.x * RS[s4 + 0] : 0.f, x1 = (s4 + 1 <= t) ? w.y * RS[s4 + 1] : 0.f, x2 = (s4 + 2 <= t) ? w.z * RS[s4 + 2] : 0.f, x3 = (s4 + 3 <= t) ? w.w * RS[s4 + 3] : 0.f;
            v2u o; o.x = pk2(x0, x1); o.y = pk2(x2, x3); *(LAS v2u*)(WA + t * SA + s4 * 2) = o; }
        __syncthreads();
        mf32x16 acc0 = zero16(), acc1 = zero16();
        for (int ks = 0; ks < 2 * (tm + 1); ++ks) {
            const mbf16x8 af = frag_rk(WA, SA, 32 * tm, 16 * ks, lane);
            const mbf16x8 b0 = frag_kn(VV, SV, 16 * ks, 64 * nh, lane), b1 = frag_kn(VV, SV, 16 * ks, 64 * nh + 32, lane);
            acc0 = MFMA32(af, b0, acc0); acc1 = MFMA32(af, b1, acc1);
        }
        __syncthreads();
#pragma unroll
        for (int r = 0; r < 16; ++r) { const int row = 32 * tm + crow32(r, hi);
            OS[row * SO + 64 * nh + (lane & 31)] = acc0[r]; OS[row * SO + 64 * nh + 32 + (lane & 31)] = acc1[r]; }
        __syncthreads();
#pragma unroll
        for (int i = 0; i < 4; ++i) { const int ch = tid + NTHR * i, t = ch >> 4, c8 = (ch & 15) * 8;
            const f32x4 s0 = *(const LAS f32x4*)(OS + t * SO + c8), s1 = *(const LAS f32x4*)(OS + t * SO + c8 + 4);
            const f32x4 n0 = *(const f32x4*)(v_norm + g * 128 + c8), n1 = *(const f32x4*)(v_norm + g * 128 + c8 + 4);
            const float bs = b_s[g * 128 + t];
            bf16* up = proj + (size_t)(row0 + t) * SGU_PITCH + g * 128 + c8;
            const v4u uw = *(const v4u*)up;
            v4u o;
            o.x = pk2(bflo(uw.x) * (n0.x * s0.x + bs), bfhi(uw.x) * (n0.y * s0.y + bs)); o.y = pk2(bflo(uw.y) * (n0.z * s0.z + bs), bfhi(uw.y) * (n0.w * s0.w + bs));
            o.z = pk2(bflo(uw.z) * (n1.x * s1.x + bs), bfhi(uw.z) * (n1.y * s1.y + bs)); o.w = pk2(bflo(uw.w) * (n1.z * s1.z + bs), bfhi(uw.w) * (n1.w * s1.w + bs));
            if (dummy) *(v4u*)((bf16*)(a.ws + WS_XB) + (size_t)(row0 + t) * 1024 + g * 128 + c8) = o; else *(v4u*)up = o; }
        __syncthreads();
    }
}

__device__ __forceinline__ void phase_gla_kv_mfma(LAS unsigned char* lds, const Ctx& a, int vcu, int G) {
    const int tid = otid(), lane = tid & 63, wave = __builtin_amdgcn_readfirstlane(tid >> 6), hi = lane >> 5;
    const bf16* proj = (const bf16*)(a.ws + WS_H); bf16* state = (bf16*)(a.ws + WS_STATE); float* dec = (float*)(a.ws + WS_DEC);
    constexpr int SV = 576, SK = 320, SS = 272;
    LAS unsigned char* VV = lds;
    LAS unsigned char* KE = lds + 64 * SV;
    LAS unsigned char* ST = lds;
    LAS float* TOT = (LAS float*)(lds + 256 * SS);
    for (int u = vcu; u < NB * GLA_H * GLA_NC; u += G) {
        const int n = u % GLA_NC, bh = u / GLA_NC, h = bh % GLA_H, b = bh / GLA_H;
        const int row0 = b * T + n * GLA_C;
        GlaCum c; gla_cumsum(c, proj, row0, h, TOT, tid);
        const int cp = tid & 63, part = tid >> 6;
#pragma unroll
        for (int i = 0; i < 8; ++i) { const int t = 8 * part + i; const unsigned w = *(const unsigned*)(proj + (size_t)(row0 + t) * GLA_PITCH + 512 + h * 128 + 2 * cp);
            *(LAS unsigned*)(KE + t * SK + 4 * cp) = pk2(bflo(w) * __expf(c.tot0 - c.b0[i]), bfhi(w) * __expf(c.tot1 - c.b1[i])); }
        if (part == 0) { dec[(size_t)u * 128 + 2 * cp] = __expf(c.tot0); dec[(size_t)u * 128 + 2 * cp + 1] = __expf(c.tot1); }
#pragma unroll
        for (int i = 0; i < 4; ++i) { const int ch = tid + NTHR * i, r = ch >> 5, c16 = ch & 31;
            *(LAS v4u*)(VV + r * SV + c16 * 16) = *(const v4u*)(proj + (size_t)(row0 + r) * GLA_PITCH + 1024 + h * 256 + c16 * 8); }
        __syncthreads();
        mf32x16 acc[4];
#pragma unroll
        for (int nt = 0; nt < 4; ++nt) acc[nt] = zero16();
#pragma unroll
        for (int ks = 0; ks < 4; ++ks) { const mbf16x8 af = frag_kn(VV, SV, 16 * ks, 32 * wave, lane);
#pragma unroll
            for (int nt = 0; nt < 4; ++nt) { const mbf16x8 bfr = frag_kn(KE, SK, 16 * ks, 32 * nt, lane); acc[nt] = MFMA32(af, bfr, acc[nt]); } }
        __syncthreads();
#pragma unroll
        for (int nt = 0; nt < 4; ++nt)
#pragma unroll
            for (int r = 0; r < 16; ++r) *(LAS bf16*)(ST + (32 * wave + crow32(r, hi)) * SS + (32 * nt + (lane & 31)) * 2) = (bf16)f2bf(acc[nt][r]);
        __syncthreads();
#pragma unroll
        for (int i = 0; i < 8; ++i) { const int ch = tid + NTHR * i, vd = ch >> 4, c16 = ch & 15;
            *(v4u*)(state + ((size_t)u * 256 + vd) * 128 + c16 * 8) = *(const LAS v4u*)(ST + vd * SS + c16 * 16); }
        __syncthreads();
    }
}
__device__ __forceinline__ void phase_gla_out_mfma(LAS unsigned char* lds, const Ctx& a, const LayerP& P, int vcu, int G, bool dummy = false) {
    const int tid = otid(), lane = tid & 63, wave = __builtin_amdgcn_readfirstlane(tid >> 6), hi = lane >> 5;
    bf16* proj = (bf16*)(a.ws + WS_H); const bf16* state = (const bf16*)(a.ws + WS_STATE);
    const float* head_norm = P.e3;
    constexpr int SQ = 272, SA = 144, SV = 576, SO = 260;
    LAS unsigned char* QD = lds;
    LAS unsigned char* KI = lds + 64 * SQ;
    LAS unsigned char* AT = lds + 2 * 64 * SQ;
    LAS unsigned char* VV = lds + 2 * 64 * SQ + 64 * SA;
    LAS float* TOT = (LAS float*)(lds + 80896);
    LAS float* OS = (LAS float*)lds;
    for (int u = vcu; u < NB * GLA_H * GLA_NC; u += G) {
        const int n = u % GLA_NC, bh = u / GLA_NC, h = bh % GLA_H, b = bh / GLA_H;
        const int row0 = b * T + n * GLA_C;
        mbf16x8 sfr[8];
        { const bf16* sp = state + ((size_t)u * 256 + 32 * wave + (lane & 31)) * 128 + 8 * hi;
#pragma unroll
          for (int ks = 0; ks < 8; ++ks) sfr[ks] = *(const mbf16x8*)(sp + 16 * ks); }
        GlaCum c; gla_cumsum(c, proj, row0, h, TOT, tid);
        const int cp = tid & 63, part = tid >> 6;
#pragma unroll
        for (int i = 0; i < 8; ++i) { const int t = 8 * part + i;
            const unsigned wq = *(const unsigned*)(proj + (size_t)(row0 + t) * GLA_PITCH + h * 128 + 2 * cp);
            const unsigned wk = *(const unsigned*)(proj + (size_t)(row0 + t) * GLA_PITCH + 512 + h * 128 + 2 * cp);
            const float e0 = __expf(c.b0[i]), e1 = __expf(c.b1[i]);
            *(LAS unsigned*)(QD + t * SQ + 4 * cp) = pk2(bflo(wq) * 0.08838834764831845f * e0, bfhi(wq) * 0.08838834764831845f * e1);
            *(LAS unsigned*)(KI + t * SQ + 4 * cp) = pk2(bflo(wk) / e0, bfhi(wk) / e1); }
#pragma unroll
        for (int i = 0; i < 4; ++i) { const int ch = tid + NTHR * i, r = ch >> 5, c16 = ch & 31;
            *(LAS v4u*)(VV + r * SV + c16 * 16) = *(const v4u*)(proj + (size_t)(row0 + r) * GLA_PITCH + 1024 + h * 256 + c16 * 8); }
        __syncthreads();
        if (wave < 4) {
            const int mi = wave >> 1, ni = wave & 1;
            mf32x16 at = zero16();
            if (!(mi == 0 && ni == 1)) {
#pragma unroll
                for (int ks = 0; ks < 8; ++ks) at = MFMA32(frag_rk(QD, SQ, 32 * mi, 16 * ks, lane), frag_rk(KI, SQ, 32 * ni, 16 * ks, lane), at);
            }
#pragma unroll
            for (int r = 0; r < 16; ++r) { const int cc = 32 * mi + crow32(r, hi), ss = 32 * ni + (lane & 31);
                *(LAS bf16*)(AT + cc * SA + ss * 2) = (bf16)f2bf((ss <= cc) ? at[r] : 0.f); }
        }
        __syncthreads();
        mf32x16 acc[2]; acc[0] = zero16(); acc[1] = zero16();
#pragma unroll
        for (int ks = 0; ks < 4; ++ks) { const mbf16x8 bfr = frag_kn(VV, SV, 16 * ks, 32 * wave, lane);
            if (ks < 2) acc[0] = MFMA32(frag_rk(AT, SA, 0, 16 * ks, lane), bfr, acc[0]);
            acc[1] = MFMA32(frag_rk(AT, SA, 32, 16 * ks, lane), bfr, acc[1]); }
#pragma unroll
        for (int ks = 0; ks < 8; ++ks) { acc[0] = MFMA32(frag_rk(QD, SQ, 0, 16 * ks, lane), sfr[ks], acc[0]); acc[1] = MFMA32(frag_rk(QD, SQ, 32, 16 * ks, lane), sfr[ks], acc[1]); }
        __syncthreads();
#pragma unroll
        for (int mi = 0; mi < 2; ++mi)
#pragma unroll
            for (int r = 0; r < 16; ++r) OS[(32 * mi + crow32(r, hi)) * SO + 32 * wave + (lane & 31)] = acc[mi][r];
        __syncthreads();
#pragma unroll
        for (int p = 0; p < 4; ++p) { const int cc = p * 16 + wave * 2 + hi, c8 = (lane & 31) * 8;
            const f32x4 s0 = *(const LAS f32x4*)(OS + cc * SO + c8), s1 = *(const LAS f32x4*)(OS + cc * SO + c8 + 4);
            float ss = (s0.x * s0.x + s0.y * s0.y) + (s0.z * s0.z + s0.w * s0.w) + (s1.x * s1.x + s1.y * s1.y) + (s1.z * s1.z + s1.w * s1.w);
            ss += __shfl_xor(ss, 1); ss += __shfl_xor(ss, 2); ss += __shfl_xor(ss, 4); ss += __shfl_xor(ss, 8); ss += __shfl_xor(ss, 16);
            const float rs = __builtin_amdgcn_rsqf(ss * (1.0f / 256.0f) + EPS);
            const f32x4 n0 = *(const f32x4*)(head_norm + c8), n1 = *(const f32x4*)(head_norm + c8 + 4);
            const v4u gw = *(const v4u*)(proj + (size_t)(row0 + cc) * GLA_PITCH + 2048 + h * 256 + c8);
            const float gg[8] = {bflo(gw.x), bfhi(gw.x), bflo(gw.y), bfhi(gw.y), bflo(gw.z), bfhi(gw.z), bflo(gw.w), bfhi(gw.w)};
            const float ov[8] = {s0.x * n0.x, s0.y * n0.y, s0.z * n0.z, s0.w * n0.w, s1.x * n1.x, s1.y * n1.y, s1.z * n1.z, s1.w * n1.w};
            float o[8];
#pragma unroll
            for (int j = 0; j < 8; ++j) o[j] = ov[j] * rs * (gg[j] * __builtin_amdgcn_rcpf(1.f + __builtin_amdgcn_exp2f(-gg[j] * LOG2E)));
            v4u w; w.x = pk2(o[0], o[1]); w.y = pk2(o[2], o[3]); w.z = pk2(o[4], o[5]); w.w = pk2(o[6], o[7]);
            if (dummy) *(v4u*)((bf16*)(a.ws + WS_XB) + (size_t)(row0 + cc) * 1024 + h * 256 + c8) = w;
            else *(v4u*)(proj + (size_t)(row0 + cc) * GLA_PITCH + 1024 + h * 256 + c8) = w; }
        __syncthreads();
    }
}
#ifndef USE_MFMA_SGU
#define USE_MFMA_SGU 1
#endif
#ifndef USE_MFMA_GLA
#define USE_MFMA_GLA 1
#endif

constexpr int PH_PER_LAYER = 8, NPHASE = 4 * PH_PER_LAYER + 1;
__host__ __device__ inline bool phase_is_noop(int ph) {
    if (ph >= 4 * PH_PER_LAYER) return false;
    const int L = ph / PH_PER_LAYER, s = ph % PH_PER_LAYER;
    const bool gla = (L == 0 || L == 3), diff = (L == 1);
    return (s == 3 && !gla && !diff) || (s == 4 && !gla);
}

#ifndef PROBE_KIND
#define PROBE_KIND 0
#endif
#ifndef PROBE_REP
#define PROBE_REP 2
#endif
template <int L> __device__ __forceinline__ LayerP layer_params_ct(const CAS cfptr* in) {
    constexpr int base = (L == 0) ? 1 : (L == 1) ? 11 : (L == 2) ? 22 : 32;
    constexpr int kind = (L == 1) ? K_DIFF : (L == 2) ? K_SGU : K_GLA;
    constexpr int sh = (kind == K_DIFF) ? 1 : 0;
    LayerP p; p.kind = kind;
    p.norm1 = in[base]; p.w_in = in[base + 1];
    p.e0 = in[base + 2]; p.e1 = in[base + 3]; p.e2 = in[base + 4]; p.e3 = in[base + 5]; p.e4 = in[base + 6];
    p.w_out = in[base + 6 + sh]; p.norm2 = in[base + 7 + sh]; p.w1 = in[base + 8 + sh]; p.w2 = in[base + 9 + sh];
    p.nin = (kind == K_GLA) ? GLA_PITCH : (kind == K_DIFF) ? DIFF_PITCH : SGU_PITCH;
    p.mixoff = (kind == K_GLA) ? 1024 : 0;
    return p;
}
__device__ __forceinline__ void seam_xcd(const CAS Args* ap, LAS unsigned char* lds_k) {
#if PROBE_KIND == 1
    for (int br = 0; br < PROBE_REP; ++br)
#endif
    { XcdBarrier bb; bb.bar = (unsigned*)(ap->ws + WS_CTL) + 4096; bb.x = xb_xcc_id(); bb.st = (volatile LAS unsigned*)(lds_k + MISC_OFF) + 8; xcd_barrier(bb); }
}
#define PH_BEGIN(PK) { const int nrep_ = (PROBE_KIND == (PK) && (PK) != 0) ? PROBE_REP : 1; \
    for (int rep_ = 0; rep_ < nrep_; ++rep_) { \
    int vcu = vcu0, G = G0; asm volatile("" : "+s"(vcu), "+s"(G)); \
    LAS unsigned char* lds = lds_k; asm volatile("" : "+s"(lds)); \
    const CAS Args* ap = (const CAS Args*)__builtin_amdgcn_kernarg_segment_ptr(); asm volatile("" : "+s"(ap)); \
    Ctx args; args.in0 = ap->in[0]; args.in42 = ap->in[42]; args.out = ap->out; args.ws = ap->ws; \
    bf16* Wb = (bf16*)(args.ws + WS_W); bf16* XB = (bf16*)(args.ws + WS_XB); bf16* HB = (bf16*)(args.ws + WS_H); \
    float* SSQ = (float*)(args.ws + WS_SSQ); float* VSSQ = (float*)(args.ws + WS_VSSQ); \
    const LayerP P = layer_params_ct<L>((const CAS cfptr*)ap); \
    (void)Wb; (void)XB; (void)HB; (void)SSQ; (void)VSSQ; (void)P; (void)vcu; (void)G; (void)lds;
#define PH_END_SEAM   seam_xcd(ap, lds_k); } }
#define PH_END_NOSEAM } }

template <int L> __device__ __forceinline__ void run_layer(LAS unsigned char* lds_k, int vcu0, int G0) {
    constexpr int kind = (L == 1) ? K_DIFF : (L == 2) ? K_SGU : K_GLA;
    PH_BEGIN(5) phase_conv(lds, args, P, L, vcu, G);
    if (L == 0) { if (rep_ + 1 == nrep_) cg::this_grid().sync(); else seam_xcd(ap, lds_k); } else seam_xcd(ap, lds_k);
    PH_END_NOSEAM
    PH_BEGIN(3) { EpiIn E{kind, HB, SSQ, (kind == K_GLA) ? P.e2 : P.e0, VSSQ, (unsigned*)(args.ws + WS_CTL) + CW_QKMAX}; run_gemm(lds, XB, D, Wb + WOFF_IN, NTOK, P.nin, D, E, vcu, G); } PH_END_SEAM
    if constexpr (kind == K_GLA) {
        PH_BEGIN(4) phase_gla_kv_mfma(lds, args, vcu, G); PH_END_SEAM
        PH_BEGIN(0) phase_gla_scan(args, vcu, G); PH_END_SEAM
        PH_BEGIN(9) phase_gla_out_mfma(lds, args, P, vcu, G, rep_ + 1 < nrep_); PH_END_SEAM
    } else if constexpr (kind == K_DIFF) {
        PH_BEGIN(7)
            if (rep_ > 0) { if (blockIdx.x == 0 && otid() == 0) __hip_atomic_store((unsigned*)(ap->ws + WS_CTL) + CW_QUEUE, 0u, RLX_AGENT); seam_xcd(ap, lds_k); }
            phase_diff_mfma((char*)lds_raw, lds, args, vcu, G);
        PH_END_SEAM
        PH_BEGIN(6) phase_diff_combine(args, P, vcu, G); PH_END_SEAM
    } else {
        PH_BEGIN(10) phase_sgu_mfma(lds, args, P, vcu, G, rep_ + 1 < nrep_); PH_END_SEAM
    }
    PH_BEGIN(L == 0 ? 8 : 0) { EpiRes E{(L == 0) ? args.in0 : args.out, args.out, XB, SSQ}; run_gemm(lds, HB + P.mixoff, P.nin, Wb + WOFF_OUT, NTOK, D, D, E, vcu, G); } PH_END_SEAM
    PH_BEGIN(2) { EpiHid E{HB, SSQ}; run_gemm(lds, XB, D, Wb + WOFF_1, NTOK, FF, D, E, vcu, G); } PH_END_SEAM
    PH_BEGIN(0) { EpiRes E{args.out, args.out, XB, SSQ}; run_gemm(lds, HB, FF, Wb + WOFF_2, NTOK, D, FF, E, vcu, G); } PH_END_SEAM
}

__global__ void __launch_bounds__(NTHR, 2) trunk_fwd(Args kargs) {
    LAS unsigned char* const lds_k = (LAS unsigned char*)lds_raw;
    const int G0 = gridDim.x; const int bx = blockIdx.x;
    const int vcu0 = (G0 % 8 == 0) ? (bx % 8) * (G0 / 8) + bx / 8 : bx;
    { const int tid = threadIdx.x;
      for (int u = tid; u < (LDS_BYTES - LDSCTL_OFF) / 4; u += NTHR) ((LAS unsigned*)(lds_k + LDSCTL_OFF))[u] = 0u;
      __syncthreads();
      if ((tid & 63) == 0) ((LAS unsigned*)(lds_k + TIDTAB_OFF))[hw_slot()] = (unsigned)(tid >> 6);
      __syncthreads(); }
    (void)xcd_barrier_post((unsigned*)(kargs.ws + WS_CTL) + 4096, (volatile LAS unsigned*)(lds_k + MISC_OFF) + 8);
    run_layer<0>(lds_k, vcu0, G0);
    run_layer<1>(lds_k, vcu0, G0);
    run_layer<2>(lds_k, vcu0, G0);
    run_layer<3>(lds_k, vcu0, G0);
    { int vcu = vcu0, G = G0; asm volatile("" : "+s"(vcu), "+s"(G));
      const CAS Args* ap = (const CAS Args*)__builtin_amdgcn_kernarg_segment_ptr(); asm volatile("" : "+s"(ap));
      Ctx args; args.in0 = ap->in[0]; args.in42 = ap->in[42]; args.out = ap->out; args.ws = ap->ws;
      phase_final(args, vcu, G); }
}

extern "C" void kernel_launch(void* const* d_in, const int* in_sizes, int n_in, void* d_out, int out_size, void* d_ws, size_t ws_size, hipStream_t stream) {
    static int grid = 0;
    if (grid == 0) {
        if (n_in != 43 || in_sizes[0] != NTOK * D || out_size != NTOK * D || ws_size < WS_END) {
            fprintf(stderr, "kernel_launch: unexpected problem (n_in %d, in0 %d, out %d, ws %zu); nothing launched\n", n_in, n_in > 0 ? in_sizes[0] : -1, out_size, ws_size); grid = -1; return; }
        int dev = 0, cus = 0, per_cu = 0;
        if (hipGetDevice(&dev) != hipSuccess || hipDeviceGetAttribute(&cus, hipDeviceAttributeMultiprocessorCount, dev) != hipSuccess) { grid = -1; return; }
        if (hipFuncSetAttribute((const void*)trunk_fwd, hipFuncAttributeMaxDynamicSharedMemorySize, LDS_BYTES) != hipSuccess) { fprintf(stderr, "kernel_launch: hipFuncSetAttribute failed\n"); grid = -1; return; }
        if (hipOccupancyMaxActiveBlocksPerMultiprocessor(&per_cu, (const void*)trunk_fwd, NTHR, LDS_BYTES) != hipSuccess || per_cu < 1) { fprintf(stderr, "kernel_launch: occupancy query says %d blocks/CU\n", per_cu); per_cu = 1; }
        (void)hipGetLastError();
        grid = cus;
    }
    if (grid < 0) return;
    (void)hipMemsetAsync((char*)d_ws + WS_CTL, 0, CTL_ZERO_BYTES, stream);
    Args a{};
    for (int i = 0; i < 43; ++i) a.in[i] = (const float*)d_in[i];
    a.out = (float*)d_out; a.ws = (unsigned char*)d_ws;
    a.ph_lo = 0; a.ph_hi = 0;
    void* kargs[] = {&a};
    hipError_t e = hipLaunchCooperativeKernel((const void*)trunk_fwd, dim3(grid), dim3(NTHR), kargs, LDS_BYTES, stream);
    if (e != hipSuccess) fprintf(stderr, "kernel_launch: cooperative launch failed: %s (grid %d)\n", hipGetErrorString(e), grid);
}
```

```cpp
#include <hip/hip_runtime.h>
#include <hip/hip_cooperative_groups.h>
#include <cstdio>
#include <cstdint>
namespace cg = cooperative_groups;

#ifndef MK_ONE_LAUNCH
#define MK_ONE_LAUNCH 1
#endif

#define GAS __attribute__((address_space(1)))
#define LAS __attribute__((address_space(3)))
typedef unsigned short bf16;
typedef unsigned v4u __attribute__((ext_vector_type(4)));
typedef unsigned v2u __attribute__((ext_vector_type(2)));
typedef float f32x4 __attribute__((ext_vector_type(4)));

constexpr int NB = 2, T = 8192, D = 1024, NTOK = NB * T, FF = 4096;
constexpr float EPS = 1e-6f;
constexpr float LOG2E = 1.4426950408889634f;
constexpr int NWAVES = 8, NTHR = 512;
constexpr int K_GLA = 0, K_DIFF = 1, K_SGU = 2;
constexpr int GLA_H = 4, GLA_HK = 128, GLA_HV = 256, GLA_C = 64, GLA_NC = T / GLA_C;
constexpr int GLA_PITCH = 3584;
constexpr int DIFF_H = 8, DIFF_PITCH = 3072;
constexpr float LAMBDA_INIT = 0.35551069f;
constexpr int SGU_PITCH = 2048, SGU_C = 128, SGU_G = 8;

constexpr size_t MiB = 1u << 20;
constexpr size_t WS_CTL = 0, CTL_ZERO_BYTES = 1 * MiB;
constexpr size_t WS_SSQ = 1 * MiB;
constexpr size_t WS_VSSQ = 2 * MiB;
constexpr size_t WS_DEC = 3 * MiB;
constexpr size_t WS_W = 4 * MiB;
constexpr size_t WS_XB = 29 * MiB;
constexpr size_t WS_STATE = 61 * MiB;
constexpr size_t WS_H = 125 * MiB;
constexpr size_t WS_END = 253 * MiB;
constexpr int CW_QKMAX = 8192;
constexpr int CW_QUEUE = 8448;
constexpr size_t WOFF_IN = 0, WOFF_OUT = (size_t)3584 * 1024, WOFF_1 = WOFF_OUT + (size_t)1024 * 1024, WOFF_2 = WOFF_1 + (size_t)4096 * 1024;

constexpr int RING_BYTES = 131072, LDSCTL_OFF = RING_BYTES, MISC_OFF = LDSCTL_OFF + 320, LDS_BYTES = 147456;

#define RLX_AGENT __ATOMIC_RELAXED, __HIP_MEMORY_SCOPE_AGENT
#define LDS_WAIT() asm volatile("s_waitcnt lgkmcnt(0)" ::: "memory")
__device__ __forceinline__ unsigned f2bf(float f) { unsigned u = __builtin_bit_cast(unsigned, f); return (u + 0x7fffu + ((u >> 16) & 1u)) >> 16; }
typedef float pk_f32x2 __attribute__((ext_vector_type(2))); typedef __bf16 pk_bf16x2 __attribute__((ext_vector_type(2)));
__device__ __forceinline__ unsigned pk2(float lo, float hi) { pk_f32x2 v = {lo, hi}; pk_bf16x2 b = __builtin_convertvector(v, pk_bf16x2); return __builtin_bit_cast(unsigned, b); }
__device__ __forceinline__ float bf2f(unsigned b) { return __builtin_bit_cast(float, b << 16); }
__device__ __forceinline__ float bflo(unsigned w) { return __builtin_bit_cast(float, w << 16); }
__device__ __forceinline__ float bfhi(unsigned w) { return __builtin_bit_cast(float, w & 0xffff0000u); }
extern __shared__ __attribute__((aligned(16))) unsigned char lds_raw[];
constexpr int TIDTAB_OFF = 131072;
__device__ __forceinline__ unsigned hw_slot() { return (unsigned)__builtin_amdgcn_s_getreg((5 << 11) | 4) & 63u; }
__device__ __forceinline__ int otid() {
    const int wv = (int)((volatile __attribute__((address_space(3))) unsigned*)((__attribute__((address_space(3))) unsigned char*)lds_raw + TIDTAB_OFF))[hw_slot()];
    int ln; asm volatile("v_mbcnt_lo_u32_b32 %0, -1, 0\n\tv_mbcnt_hi_u32_b32 %0, -1, %0" : "=v"(ln));
    int t = wv * 64 + ln;
    asm volatile("" : "+v"(t)); return t; }
__device__ __forceinline__ float wave_sum(float v) {
#pragma unroll
    for (int o = 1; o < 64; o <<= 1) v += __shfl_xor(v, o);
    return v;
}
__device__ __forceinline__ float wave_max(float v) {
#pragma unroll
    for (int o = 1; o < 64; o <<= 1) v = fmaxf(v, __shfl_xor(v, o));
    return v;
}
__device__ __forceinline__ float gelu_tanh(float x) {
    const float u = 0.7978845608028654f * (x + 0.044715f * x * x * x);
    const float e = __builtin_amdgcn_exp2f(u * (2.f * LOG2E));
    return x - x * __builtin_amdgcn_rcpf(e + 1.f);
}
__device__ __forceinline__ float log_sigmoid(float z) { return fminf(z, 0.f) - 0.6931471805599453f * __builtin_amdgcn_logf(1.0f + __builtin_amdgcn_exp2f(-fabsf(z) * LOG2E)); }

#define XB_TMO      128
#define XB_XCNT(j)  (256  + 64 * (j))
#define XB_XSUB(j)  (1280 + 64 * (j))
#define XB_XGEN(j)  (2304 + 64 * (j))
#define XB_TOP      3328
#define XB_TOPGEN   3392
#define XCD_BAR_WORDS 3456
#define XB_SPIN_CAP (1u << 22)
__device__ __forceinline__ unsigned xb_ld(unsigned* p)              { return __hip_atomic_load(p, __ATOMIC_RELAXED, __HIP_MEMORY_SCOPE_AGENT); }
__device__ __forceinline__ unsigned xb_add(unsigned* p, unsigned v) { return __hip_atomic_fetch_add(p, v, __ATOMIC_RELAXED, __HIP_MEMORY_SCOPE_AGENT); }
__device__ __forceinline__ unsigned xb_xcc_id() { return (unsigned)__builtin_amdgcn_s_getreg((3 << 11) | 20) & 0xFu; }
#define XB_SPIN(cond, bar) do { unsigned _sp = 0; while (cond) { __builtin_amdgcn_s_sleep(1); \
    if ((++_sp & 255u) == 0u) { if (xb_ld(&(bar)[XB_TMO])) break; if (_sp > XB_SPIN_CAP) { atomicAdd(&(bar)[XB_TMO], 1u); break; } } } } while (0)
struct XcdBarrier { unsigned* bar; unsigned x; volatile LAS unsigned* st; };
__device__ __forceinline__ XcdBarrier xcd_barrier_post(unsigned* bar, volatile LAS unsigned* st) {
    XcdBarrier b; b.bar = bar; b.x = xb_xcc_id(); b.st = st;
    if (threadIdx.x == 0) (void)xb_add(&bar[XB_XCNT(b.x)], 1u);
    return b;
}
__device__ __forceinline__ void xcd_barrier_complete(unsigned* bar, unsigned x, unsigned& nloc, unsigned& nx) {
    const unsigned G = gridDim.x * gridDim.y * gridDim.z;
    unsigned sum, cnt, mine, sp = 0u;
    for (;;) {
        sum = 0u; cnt = 0u; mine = 0u;
#pragma unroll
        for (unsigned j = 0; j < 16; ++j) { const unsigned c = xb_ld(&bar[XB_XCNT(j)]); sum += c; cnt += (c > 0u) ? 1u : 0u; mine = (j == x) ? c : mine; }
        if (sum == G) break;
        __builtin_amdgcn_s_sleep(1);
        if ((++sp & 255u) == 0u) { if (xb_ld(&bar[XB_TMO])) break; if (sp > XB_SPIN_CAP) { atomicAdd(&bar[XB_TMO], 1u); break; } }
    }
    nloc = mine > 0u ? mine : 1u; nx = cnt > 0u ? cnt : 1u;
}
__device__ __forceinline__ void xcd_barrier(const XcdBarrier& b) {
    asm volatile("s_waitcnt vmcnt(0)" ::: "memory");
    __syncthreads();
    if (otid() == 0) {
        unsigned* bar = b.bar;
        __builtin_amdgcn_s_waitcnt(0);
        unsigned nloc = b.st[0], nx = b.st[1];
        if (nloc == 0u) { xcd_barrier_complete(bar, b.x, nloc, nx); b.st[0] = nloc; b.st[1] = nx; }
        const unsigned old = xb_add(&bar[XB_XSUB(b.x)], 1u);
        const unsigned gen = old / nloc;
        if (old + 1u == (gen + 1u) * nloc) {
            __builtin_amdgcn_fence(__ATOMIC_RELEASE, "agent");
            asm volatile("s_waitcnt vmcnt(0)" ::: "memory");
            const unsigned og = xb_add(&bar[XB_TOP], 1u);
            const unsigned tg = og / nx;
            if (og + 1u == (tg + 1u) * nx) xb_add(&bar[XB_TOPGEN], 1u);
            else XB_SPIN(xb_ld(&bar[XB_TOPGEN]) == tg, bar);
            __builtin_amdgcn_fence(__ATOMIC_ACQUIRE, "agent");
            xb_add(&bar[XB_XGEN(b.x)], 1u);
            asm volatile("s_waitcnt vmcnt(0)" ::: "memory");
        } else {
            XB_SPIN(xb_ld(&bar[XB_XGEN(b.x)]) == gen, bar);
            __builtin_amdgcn_fence(__ATOMIC_ACQUIRE, "agent");
            asm volatile("s_waitcnt vmcnt(0)" ::: "memory");
        }
    }
    __syncthreads();
}

struct Args { const float* in[43]; float* out; unsigned char* ws; int ph_lo, ph_hi; };
struct Ctx { const float* in0; const float* in42; float* out; unsigned char* ws; };
struct LayerP {
    int kind;
    const float *norm1, *w_in, *w_out, *norm2, *w1, *w2;
    const float *e0, *e1, *e2, *e3, *e4;
    int nin;
    int mixoff;
};
typedef const float* cfptr;
#define CAS __attribute__((address_space(4)))
__device__ __forceinline__ LayerP layer_params(const CAS cfptr* in, int L) {
    LayerP p;
    const int base = (L == 0) ? 1 : (L == 1) ? 11 : (L == 2) ? 22 : 32;
    p.kind = (L == 1) ? K_DIFF : (L == 2) ? K_SGU : K_GLA;
    const int sh = (p.kind == K_DIFF) ? 1 : 0;
    p.norm1 = in[base]; p.w_in = in[base + 1];
    p.e0 = in[base + 2]; p.e1 = in[base + 3]; p.e2 = in[base + 4]; p.e3 = in[base + 5]; p.e4 = in[base + 6];
    p.w_out = in[base + 6 + sh]; p.norm2 = in[base + 7 + sh]; p.w1 = in[base + 8 + sh]; p.w2 = in[base + 9 + sh];
    p.nin = (p.kind == K_GLA) ? GLA_PITCH : (p.kind == K_DIFF) ? DIFF_PITCH : SGU_PITCH;
    p.mixoff = (p.kind == K_GLA) ? 1024 : 0;
    return p;
}

__device__ __forceinline__ float row_rstd(const float* ssq, int row) {
    const f32x4* p = (const f32x4*)(ssq + (size_t)row * 16);
    const f32x4 a = p[0], b = p[1], c = p[2], d = p[3];
    const float s = ((a.x + a.y) + (a.z + a.w)) + ((b.x + b.y) + (b.z + b.w)) + ((c.x + c.y) + (c.z + c.w)) + ((d.x + d.y) + (d.z + d.w));
    return __builtin_amdgcn_rsqf(s * (1.0f / D) + EPS);
}

struct EpiIn {
    int kind; bf16* proj; const float* ssq; const float* bias;
    float* vssq;
    static constexpr bool NEEDS_RS = true;
    __device__ __forceinline__ float rowscale(int row) const { const unsigned d = (unsigned)(row - rs_row0); return (d < 256u) ? rs_tab[d] : row_rstd(ssq, row); }
    __device__ __forceinline__ float apply8(int row, int col0, const float (&v)[8], float rs) const {
        float o[8]; float part = 0.f; int pitch;
        if (kind == K_GLA) { pitch = GLA_PITCH;
            if (col0 < 3072) {
#pragma unroll
                for (int j = 0; j < 8; ++j) o[j] = v[j] * rs;
            } else {
#pragma unroll
                for (int j = 0; j < 8; ++j) o[j] = log_sigmoid(v[j] * rs + bias[col0 - 3072 + j]) * (1.0f / 16.0f);
            }
        } else if (kind == K_DIFF) { pitch = DIFF_PITCH;
            const float sc = (col0 < 1024) ? rs * (0.125f * LOG2E) : rs;
#pragma unroll
            for (int j = 0; j < 8; ++j) o[j] = v[j] * sc;
            if (col0 < 2048) {
#pragma unroll
                for (int j = 0; j < 8; ++j) part += o[j] * o[j];
            }
        } else { pitch = SGU_PITCH;
#pragma unroll
            for (int j = 0; j < 8; ++j) { o[j] = gelu_tanh(v[j] * rs + bias[col0 + j]); }
            if (col0 >= 1024) {
#pragma unroll
                for (int j = 0; j < 8; ++j) part += o[j] * o[j];
            }
        }
        v4u w; w.x = pk2(o[0], o[1]); w.y = pk2(o[2], o[3]); w.z = pk2(o[4], o[5]); w.w = pk2(o[6], o[7]);
        *(v4u*)(proj + (size_t)row * pitch + col0) = w;
        return part;
    }
    __device__ __forceinline__ void store_part(int row, int col0, int idx, float part) const {
        if (kind == K_SGU && col0 >= 1024) vssq[(size_t)row * 16 + idx] = part;
    }
    static constexpr bool GROUPMAX = true;
    unsigned* qkmax;
    const LAS float* rs_tab = nullptr; int rs_row0 = -1;
    __device__ __forceinline__ bool want_groupmax(int col0) const { return kind == K_DIFF && col0 < 2048; }
    __device__ __forceinline__ void store_groupmax(int row, int col0, float m) const {
        atomicMax(qkmax + (row >> 13) * 64 + (col0 >> 5), __float_as_uint(m * 1.01f));
    }
};
struct EpiHid {
    bf16* h; const float* ssq;
    const LAS float* rs_tab = nullptr; int rs_row0 = -1;
    static constexpr bool NEEDS_RS = true;
    __device__ __forceinline__ float rowscale(int row) const { const unsigned d = (unsigned)(row - rs_row0); return (d < 256u) ? rs_tab[d] : row_rstd(ssq, row); }
    __device__ __forceinline__ float apply8(int row, int col0, const float (&v)[8], float rs) const {
        float o[8];
#pragma unroll
        for (int j = 0; j < 8; ++j) { const float a = fmaxf(v[j] * rs, 0.f); o[j] = a * a; }
        v4u w; w.x = pk2(o[0], o[1]); w.y = pk2(o[2], o[3]); w.z = pk2(o[4], o[5]); w.w = pk2(o[6], o[7]);
        *(v4u*)(h + (size_t)row * FF + col0) = w;
        return 0.f;
    }
    __device__ __forceinline__ void store_part(int, int, int, float) const {}
    static constexpr bool GROUPMAX = false;
    __device__ __forceinline__ bool want_groupmax(int) const { return false; }
    __device__ __forceinline__ void store_groupmax(int, int, float) const {}
};
struct EpiRes {
    const float* base; float* x; bf16* xb; float* ssq;
    static constexpr bool NEEDS_RS = false;
    __device__ __forceinline__ float rowscale(int) const { return 1.f; }
    __device__ __forceinline__ float apply8(int row, int col0, const float (&v)[8], float) const {
        const size_t off = (size_t)row * D + col0;
        const f32x4 b0 = *(const f32x4*)(base + off), b1 = *(const f32x4*)(base + off + 4);
        float o[8] = {b0.x + v[0], b0.y + v[1], b0.z + v[2], b0.w + v[3], b1.x + v[4], b1.y + v[5], b1.z + v[6], b1.w + v[7]};
        *(f32x4*)(x + off) = (f32x4){o[0], o[1], o[2], o[3]}; *(f32x4*)(x + off + 4) = (f32x4){o[4], o[5], o[6], o[7]};
        v4u w; w.x = pk2(o[0], o[1]); w.y = pk2(o[2], o[3]); w.z = pk2(o[4], o[5]); w.w = pk2(o[6], o[7]);
        *(v4u*)(xb + off) = w;
        float part = 0.f;
#pragma unroll
        for (int j = 0; j < 8; ++j) part += o[j] * o[j];
        return part;
    }
    __device__ __forceinline__ void store_part(int row, int, int idx, float part) const { ssq[(size_t)row * 16 + idx] = part; }
    static constexpr bool GROUPMAX = false;
    __device__ __forceinline__ bool want_groupmax(int) const { return false; }
    __device__ __forceinline__ void store_groupmax(int, int, float) const {}
};

template <class Epi>
__device__ __forceinline__ void gemm_naive(LAS unsigned char* lds, const bf16* A, int lda, const bf16* Bt, int M, int N, int K, const Epi& E, int vcu, int G) {
    LAS float* As = (LAS float*)lds;
    LAS float* Bs = As + 64 * 33;
    const int tid = otid();
    const int nM = M / 64, nN = N / 64;
    const int r = tid >> 3, cgp = tid & 7;
    for (int u = vcu; u < nM * nN; u += G) {
        const int pm = u / nN, pn = u % nN;
        float acc[8];
#pragma unroll
        for (int j = 0; j < 8; ++j) acc[j] = 0.f;
        for (int k0 = 0; k0 < K; k0 += 32) {
            { const int lr = tid >> 3, lc = (tid & 7) * 4;
              const v2u av = *(const v2u*)(A + (size_t)(pm * 64 + lr) * lda + k0 + lc);
              const v2u bv = *(const v2u*)(Bt + (size_t)(pn * 64 + lr) * K + k0 + lc);
              As[lr * 33 + lc + 0] = bflo(av.x); As[lr * 33 + lc + 1] = bfhi(av.x); As[lr * 33 + lc + 2] = bflo(av.y); As[lr * 33 + lc + 3] = bfhi(av.y);
              Bs[lr * 33 + lc + 0] = bflo(bv.x); Bs[lr * 33 + lc + 1] = bfhi(bv.x); Bs[lr * 33 + lc + 2] = bflo(bv.y); Bs[lr * 33 + lc + 3] = bfhi(bv.y); }
            __syncthreads();
#pragma unroll 8
            for (int kk = 0; kk < 32; ++kk) { const float a = As[r * 33 + kk];
#pragma unroll
                for (int j = 0; j < 8; ++j) acc[j] += a * Bs[(cgp * 8 + j) * 33 + kk]; }
            __syncthreads();
        }
        const int row = pm * 64 + r, col0 = pn * 64 + cgp * 8;
        const float rs = E.rowscale(row);
        float part = E.apply8(row, col0, acc, rs);
        part += __shfl_xor(part, 1); part += __shfl_xor(part, 2); part += __shfl_xor(part, 4);
        if (cgp == 0) E.store_part(row, col0, pn & 15, part);
    }
}

__device__ __forceinline__ void conv_tile(const float* W, const float* gain, int K, int N, bf16* WT, int tile, LAS unsigned char* img, int tid) {
    const int nblk = N >> 7, kb = tile / nblk, nb = tile - kb * nblk, k0 = kb << 7, n0 = nb << 7;
    const int n4 = tid & 31, kk = tid >> 5;
    f32x4 w[8];
    const float* src = W + (size_t)(k0 + 8 * kk) * N + n0 + 4 * n4;
#pragma unroll
    for (int p = 0; p < 8; ++p) w[p] = *(const f32x4*)(src + (size_t)p * N);
    float g[8];
    if (gain) { const f32x4 g0 = *(const f32x4*)(gain + k0 + 8 * kk), g1 = *(const f32x4*)(gain + k0 + 8 * kk + 4);
        g[0] = g0.x; g[1] = g0.y; g[2] = g0.z; g[3] = g0.w; g[4] = g1.x; g[5] = g1.y; g[6] = g1.z; g[7] = g1.w; }
    else {
#pragma unroll
        for (int p = 0; p < 8; ++p) g[p] = 1.f; }
#pragma unroll
    for (int jn = 0; jn < 4; ++jn) {
        v4u o; o.x = pk2(g[0] * w[0][jn], g[1] * w[1][jn]); o.y = pk2(g[2] * w[2][jn], g[3] * w[3][jn]); o.z = pk2(g[4] * w[4][jn], g[5] * w[5][jn]); o.w = pk2(g[6] * w[6][jn], g[7] * w[7][jn]);
        *(LAS v4u*)(img + (4 * n4 + jn) * 256 + ((kk ^ (n4 & 15)) << 4)) = o; }
    __syncthreads();
#pragma unroll
    for (int i = 0; i < 4; ++i) { const int c = tid + NTHR * i, n = c >> 4, kc = c & 15;
        const v4u o = *(const LAS v4u*)(img + n * 256 + ((kc ^ ((n >> 2) & 15)) << 4));
        *(v4u*)(WT + (size_t)(n0 + n) * K + k0 + 8 * kc) = o; }
    __syncthreads();
}

__device__ __forceinline__ void phase_conv(LAS unsigned char* lds, const Ctx& a, const LayerP& P, int L, int vcu, int G) {
    const int tid = otid(), lane = tid & 63, wave = __builtin_amdgcn_readfirstlane(tid >> 6);
    bf16* Wb = (bf16*)(a.ws + WS_W);
    const int gw = vcu * NWAVES + wave, NGW = G * NWAVES;
    const int nin_w = (P.kind == K_SGU) ? 2048 : 3072;
    const int I_IN = (D / 128) * (nin_w / 128), I_OUT = (D / 128) * (D / 128), I_1 = (D / 128) * (FF / 128), I_2 = (FF / 128) * (D / 128);
    const int NITEMS = I_IN + I_OUT + I_1 + I_2;
    for (int it = vcu; it < NITEMS; it += G) {
        int r = it;
        if (r < I_IN) { conv_tile(P.w_in, P.norm1, D, nin_w, Wb + WOFF_IN, r, lds, tid); continue; } r -= I_IN;
        if (r < I_OUT) { conv_tile(P.w_out, nullptr, D, D, Wb + WOFF_OUT, r, lds, tid); continue; } r -= I_OUT;
        if (r < I_1) { conv_tile(P.w1, P.norm2, D, FF, Wb + WOFF_1, r, lds, tid); continue; } r -= I_1;
        conv_tile(P.w2, nullptr, FF, D, Wb + WOFF_2, r, lds, tid);
    }
    if (P.kind == K_GLA) {
        const float* W1 = P.e0; const float* W2 = P.e1;
        for (int e = vcu * NTHR + tid; e < 512 * 1024; e += G * NTHR) {
            const int n = e >> 10, k = e & 1023;
            float s = 0.f;
#pragma unroll
            for (int r = 0; r < 16; ++r) s += W1[k * 16 + r] * W2[r * 512 + n];
            Wb[WOFF_IN + (size_t)(3072 + n) * 1024 + k] = (bf16)f2bf(s * P.norm1[k]);
        }
    }
    if (L == 0) {
        const float* x = a.in0; bf16* xb = (bf16*)(a.ws + WS_XB); float* ssq = (float*)(a.ws + WS_SSQ);
        for (int m = gw; m < NTOK; m += NGW) {
            const f32x4* xr = (const f32x4*)(x + (size_t)m * D) + lane;
            f32x4 v[4]; float s = 0.f;
#pragma unroll
            for (int j = 0; j < 4; ++j) { v[j] = xr[64 * j]; s += (v[j].x * v[j].x + v[j].y * v[j].y) + (v[j].z * v[j].z + v[j].w * v[j].w); }
            s = wave_sum(s);
            v2u* o8 = (v2u*)(xb + (size_t)m * D) + lane;
#pragma unroll
            for (int j = 0; j < 4; ++j) { v2u w; w.x = pk2(v[j].x, v[j].y); w.y = pk2(v[j].z, v[j].w); o8[64 * j] = w; }
            if (lane < 16) ssq[(size_t)m * 16 + lane] = (lane == 0) ? s : 0.f;
        }
    }
}

__device__ __forceinline__ void phase_final(const Ctx& a, int vcu, int G) {
    const int tid = otid(), lane = tid & 63, wave = tid >> 6;
    const int gw = vcu * NWAVES + wave, NGW = G * NWAVES;
    const float* ssq = (const float*)(a.ws + WS_SSQ); const float* g = a.in42;
    for (int m = gw; m < NTOK; m += NGW) {
        const float rs = row_rstd(ssq, m);
        f32x4* xr = (f32x4*)(a.out + (size_t)m * D) + lane; const f32x4* gr = (const f32x4*)g + lane;
#pragma unroll
        for (int j = 0; j < 4; ++j) { f32x4 v = xr[64 * j]; const f32x4 gg = gr[64 * j]; v.x *= rs * gg.x; v.y *= rs * gg.y; v.z *= rs * gg.z; v.w *= rs * gg.w; xr[64 * j] = v; }
    }
}

struct GlaCum { float b0[8], b1[8], tot0, tot1; };
__device__ __forceinline__ void gla_cumsum(GlaCum& c, const bf16* proj, int row0, int h, LAS float* TOT, int tid) {
    const int cp = tid & 63, part = tid >> 6;
#pragma unroll
    for (int i = 0; i < 8; ++i) { const unsigned w = *(const unsigned*)(proj + (size_t)(row0 + 8 * part + i) * GLA_PITCH + 3072 + h * 128 + 2 * cp); c.b0[i] = bflo(w); c.b1[i] = bfhi(w); }
#pragma unroll
    for (int i = 1; i < 8; ++i) { c.b0[i] += c.b0[i - 1]; c.b1[i] += c.b1[i - 1]; }
    TOT[part * 128 + 2 * cp] = c.b0[7]; TOT[part * 128 + 2 * cp + 1] = c.b1[7];
    __syncthreads();
    float o0 = 0.f, o1 = 0.f, t0 = 0.f, t1 = 0.f;
#pragma unroll
    for (int p = 0; p < 8; ++p) { const float x0 = TOT[p * 128 + 2 * cp], x1 = TOT[p * 128 + 2 * cp + 1]; if (p < part) { o0 += x0; o1 += x1; } t0 += x0; t1 += x1; }
#pragma unroll
    for (int i = 0; i < 8; ++i) { c.b0[i] += o0; c.b1[i] += o1; }
    c.tot0 = t0; c.tot1 = t1;
}
__device__ __forceinline__ void phase_gla_kv(LAS unsigned char* lds, const Ctx& a, int vcu, int G) {
    const int tid = otid();
    const bf16* proj = (const bf16*)(a.ws + WS_H); bf16* state = (bf16*)(a.ws + WS_STATE); float* dec = (float*)(a.ws + WS_DEC);
    LAS float* KE = (LAS float*)lds;
    LAS float* V = KE + 64 * 128;
    LAS float* TOT = V + 64 * 256;
    for (int u = vcu; u < NB * GLA_H * GLA_NC; u += G) {
        const int n = u % GLA_NC, bh = u / GLA_NC, h = bh % GLA_H, b = bh / GLA_H;
        const int row0 = b * T + n * GLA_C;
        GlaCum c; gla_cumsum(c, proj, row0, h, TOT, tid);
        const int cp = tid & 63, part = tid >> 6;
#pragma unroll
        for (int i = 0; i < 8; ++i) { const int t = 8 * part + i; const unsigned w = *(const unsigned*)(proj + (size_t)(row0 + t) * GLA_PITCH + 512 + h * 128 + 2 * cp);
            KE[t * 128 + 2 * cp] = bflo(w) * __expf(c.tot0 - c.b0[i]); KE[t * 128 + 2 * cp + 1] = bfhi(w) * __expf(c.tot1 - c.b1[i]); }
        if (part == 0) { dec[(size_t)u * 128 + 2 * cp] = __expf(c.tot0); dec[(size_t)u * 128 + 2 * cp + 1] = __expf(c.tot1); }
        { const int vp = tid & 127, rp = tid >> 7;
#pragma unroll
          for (int i = 0; i < 16; ++i) { const int t = 16 * rp + i; const unsigned w = *(const unsigned*)(proj + (size_t)(row0 + t) * GLA_PITCH + 1024 + h * 256 + 2 * vp);
              V[t * 256 + 2 * vp] = bflo(w); V[t * 256 + 2 * vp + 1] = bfhi(w); } }
        __syncthreads();
        const int vd = tid & 255, kh = tid >> 8;
        float acc[64];
#pragma unroll
        for (int j = 0; j < 64; ++j) acc[j] = 0.f;
        for (int t = 0; t < 64; ++t) { const float v = V[t * 256 + vd];
#pragma unroll
            for (int j = 0; j < 64; ++j) acc[j] += KE[t * 128 + kh * 64 + j] * v; }
        bf16* sp = state + ((size_t)u * 256 + vd) * 128 + kh * 64;
#pragma unroll
        for (int j = 0; j < 64; j += 8) { v4u w; w.x = pk2(acc[j], acc[j + 1]); w.y = pk2(acc[j + 2], acc[j + 3]); w.z = pk2(acc[j + 4], acc[j + 5]); w.w = pk2(acc[j + 6], acc[j + 7]); *(v4u*)(sp + j) = w; }
        __syncthreads();
    }
}
__device__ __forceinline__ void phase_gla_scan(const Ctx& a, int vcu, int G) {
    unsigned* state = (unsigned*)(a.ws + WS_STATE); const float* dec = (const float*)(a.ws + WS_DEC);
    for (int gid = vcu * NTHR + otid(); gid < NB * GLA_H * 16384; gid += G * NTHR) {
        const int bh = gid >> 14, e = gid & 16383, kp = e & 63;
        unsigned* sp = state + (size_t)bh * GLA_NC * 16384 + e;
        const float* dp = dec + (size_t)bh * GLA_NC * 128 + 2 * kp;
        float s0 = 0.f, s1 = 0.f;
        for (int n0 = 0; n0 < GLA_NC; n0 += 8) {
            unsigned w[8]; float d0[8], d1[8];
#pragma unroll
            for (int i = 0; i < 8; ++i) { w[i] = sp[(size_t)(n0 + i) * 16384]; d0[i] = dp[(n0 + i) * 128]; d1[i] = dp[(n0 + i) * 128 + 1]; }
#pragma unroll
            for (int i = 0; i < 8; ++i) { sp[(size_t)(n0 + i) * 16384] = pk2(s0, s1); s0 = d0[i] * s0 + bflo(w[i]); s1 = d1[i] * s1 + bfhi(w[i]); }
        }
    }
}
__device__ __forceinline__ void phase_gla_out(LAS unsigned char* lds, const Ctx& a, const LayerP& P, int vcu, int G) {
    const int tid = otid(), lane = tid & 63, wave = tid >> 6;
    bf16* proj = (bf16*)(a.ws + WS_H); const bf16* state = (const bf16*)(a.ws + WS_STATE);
    LAS float* QD = (LAS float*)lds;
    LAS float* KI = QD + 64 * 128;
    LAS float* ATT = KI + 64 * 128;
    LAS unsigned* Vb = (LAS unsigned*)(ATT + 64 * 64);
    LAS float* TOT = (LAS float*)(Vb + 64 * 128);
    LAS float* RSS = TOT + 8 * 128;
    for (int u = vcu; u < NB * GLA_H * GLA_NC; u += G) {
        const int n = u % GLA_NC, bh = u / GLA_NC, h = bh % GLA_H, b = bh / GLA_H;
        const int row0 = b * T + n * GLA_C;
        GlaCum c; gla_cumsum(c, proj, row0, h, TOT, tid);
        const int cp = tid & 63, part = tid >> 6;
#pragma unroll
        for (int i = 0; i < 8; ++i) { const int t = 8 * part + i;
            const unsigned wq = *(const unsigned*)(proj + (size_t)(row0 + t) * GLA_PITCH + h * 128 + 2 * cp);
            const unsigned wk = *(const unsigned*)(proj + (size_t)(row0 + t) * GLA_PITCH + 512 + h * 128 + 2 * cp);
            const float e0 = __expf(c.b0[i]), e1 = __expf(c.b1[i]);
            QD[t * 128 + 2 * cp] = bflo(wq) * 0.08838834764831845f * e0; QD[t * 128 + 2 * cp + 1] = bfhi(wq) * 0.08838834764831845f * e1;
            KI[t * 128 + 2 * cp] = bflo(wk) / e0; KI[t * 128 + 2 * cp + 1] = bfhi(wk) / e1; }
        { const int vp = tid & 127, rp = tid >> 7;
#pragma unroll
          for (int i = 0; i < 16; ++i) { const int t = 16 * rp + i; Vb[t * 128 + vp] = *(const unsigned*)(proj + (size_t)(row0 + t) * GLA_PITCH + 1024 + h * 256 + 2 * vp); } }
        __syncthreads();
        { const int cc = tid >> 3, s0 = (tid & 7) * 8; float acc[8];
#pragma unroll
          for (int j = 0; j < 8; ++j) acc[j] = 0.f;
          for (int d = 0; d < 128; ++d) { const float q = QD[cc * 128 + d];
#pragma unroll
              for (int j = 0; j < 8; ++j) acc[j] += q * KI[(s0 + j) * 128 + d]; }
#pragma unroll
          for (int j = 0; j < 8; ++j) ATT[cc * 64 + s0 + j] = (s0 + j <= cc) ? acc[j] : 0.f; }
        __syncthreads();
        const int vd = tid & 255, ch = tid >> 8;
        float acc[32];
#pragma unroll
        for (int j = 0; j < 32; ++j) acc[j] = 0.f;
        for (int s = 0; s < 64; ++s) { const unsigned w = Vb[s * 128 + (vd >> 1)]; const float v = (vd & 1) ? bfhi(w) : bflo(w);
#pragma unroll
            for (int j = 0; j < 32; ++j) acc[j] += ATT[(ch * 32 + j) * 64 + s] * v; }
        { const bf16* sp = state + ((size_t)u * 256 + vd) * 128;
          for (int d0 = 0; d0 < 128; d0 += 8) { const v4u w = *(const v4u*)(sp + d0);
              const float st[8] = {bflo(w.x), bfhi(w.x), bflo(w.y), bfhi(w.y), bflo(w.z), bfhi(w.z), bflo(w.w), bfhi(w.w)};
#pragma unroll
              for (int dd = 0; dd < 8; ++dd) {
#pragma unroll
                  for (int j = 0; j < 32; ++j) acc[j] += QD[(ch * 32 + j) * 128 + d0 + dd] * st[dd]; } } }
#pragma unroll
        for (int j = 0; j < 32; ++j) { const float s = wave_sum(acc[j] * acc[j]); if (lane == 0) RSS[wave * 32 + j] = s; }
        __syncthreads();
        const float hn = P.e3[vd];
#pragma unroll
        for (int j = 0; j < 32; ++j) { const int cc = ch * 32 + j;
            const float ss = (RSS[(ch * 4 + 0) * 32 + j] + RSS[(ch * 4 + 1) * 32 + j]) + (RSS[(ch * 4 + 2) * 32 + j] + RSS[(ch * 4 + 3) * 32 + j]);
            const float rs = 1.0f / sqrtf(ss * (1.0f / 256.0f) + EPS);
            const float g = bf2f(proj[(size_t)(row0 + cc) * GLA_PITCH + 2048 + h * 256 + vd]);
            const float o = acc[j] * rs * hn * (g / (1.f + __expf(-g)));
            proj[(size_t)(row0 + cc) * GLA_PITCH + 1024 + h * 256 + vd] = (bf16)f2bf(o); }
        __syncthreads();
    }
}

__device__ __forceinline__ void phase_sgu(LAS unsigned char* lds, const Ctx& a, const LayerP& P, int vcu, int G) {
    const int tid = otid();
    bf16* proj = (bf16*)(a.ws + WS_H); const float* vssq = (const float*)(a.ws + WS_VSSQ);
    const float* v_norm = P.e1; const float* w_s = P.e2; const float* b_s = P.e3;
    LAS float* W = (LAS float*)lds;
    LAS float* V = W + 128 * 128;
    for (int u = vcu; u < NB * (T / SGU_C) * SGU_G; u += G) {
        const int g = u % SGU_G, bc = u / SGU_G;
        const int row0 = bc * SGU_C;
        for (int e = tid; e < 128 * 128; e += NTHR) { const int t = e >> 7, s = e & 127;
            const float rs = row_rstd(vssq, row0 + s);
            W[e] = (s <= t) ? w_s[(size_t)g * 16384 + e] * rs : 0.f;
            V[e] = bf2f(proj[(size_t)(row0 + t) * SGU_PITCH + 1024 + g * 128 + s]); }
        __syncthreads();
        const int d = tid & 127, tq = tid >> 7;
        float acc[32];
#pragma unroll
        for (int j = 0; j < 32; ++j) acc[j] = 0.f;
        for (int s = 0; s < 128; ++s) { const float v = V[s * 128 + d];
#pragma unroll
            for (int j = 0; j < 32; ++j) acc[j] += W[(tq + 4 * j) * 128 + s] * v; }
        const float vn = v_norm[g * 128 + d];
#pragma unroll
        for (int j = 0; j < 32; ++j) { const int t = tq + 4 * j;
            const float sv = vn * acc[j] + b_s[g * 128 + t];
            bf16* up = proj + (size_t)(row0 + t) * SGU_PITCH + g * 128 + d;
            *up = (bf16)f2bf(bf2f(*up) * sv); }
        __syncthreads();
    }
}

__device__ __forceinline__ void phase_diff(LAS unsigned char* lds, const Ctx& a, const LayerP& P, int vcu, int G) {
    const int tid = otid(), lane = tid & 63, wave = tid >> 6;
    bf16* proj = (bf16*)(a.ws + WS_H);
    LAS float* Ks = (LAS float*)lds;
    LAS float* Vs = Ks + 64 * 132;
    LAS float* Qs = Vs + 64 * 128;
    LAS float* Ps = Qs + 32 * 128;
    float lam;
    { float s1 = 0.f, s2 = 0.f;
      for (int i = 0; i < 64; ++i) { s1 += P.e0[i] * P.e1[i]; s2 += P.e2[i] * P.e3[i]; }
      lam = __expf(s1) - __expf(s2) + LAMBDA_INIT; }
    const float* head_norm = P.e4;
    const int NU = NB * DIFF_H * (T / 32);
    for (int u = vcu; u < NU; u += G) {
        const int qb = (T / 32 - 1) - (u / (NB * DIFF_H)), bh = u % (NB * DIFF_H), h = bh % DIFF_H, b = bh / DIFF_H;
        const int q0 = qb * 32; const size_t rowbase = (size_t)b * T;
        const float slope2 = exp2f(-(float)(h + 1)) * LOG2E;
        __syncthreads();
        for (int e = tid; e < 32 * 64; e += NTHR) { const int r = e >> 6, c2 = e & 63;
            const unsigned w = *(const unsigned*)(proj + (rowbase + q0 + r) * DIFF_PITCH + h * 128 + 2 * c2);
            Qs[r * 128 + 2 * c2] = bflo(w); Qs[r * 128 + 2 * c2 + 1] = bfhi(w); }
        float m1[4], l1[4], m2[4], l2[4], oa1[4], ob1[4], oa2[4], ob2[4];
#pragma unroll
        for (int i = 0; i < 4; ++i) { m1[i] = -1e30f; m2[i] = -1e30f; l1[i] = 0.f; l2[i] = 0.f; oa1[i] = 0.f; ob1[i] = 0.f; oa2[i] = 0.f; ob2[i] = 0.f; }
        const int ntile = (q0 + 31) / 64 + 1;
        for (int kt = 0; kt < ntile; ++kt) {
            __syncthreads();
            for (int e = tid; e < 64 * 64; e += NTHR) { const int r = e >> 6, c2 = e & 63;
                const unsigned wk = *(const unsigned*)(proj + (rowbase + kt * 64 + r) * DIFF_PITCH + 1024 + h * 128 + 2 * c2);
                const unsigned wv = *(const unsigned*)(proj + (rowbase + kt * 64 + r) * DIFF_PITCH + 2048 + h * 128 + 2 * c2);
                Ks[r * 132 + 2 * c2] = bflo(wk); Ks[r * 132 + 2 * c2 + 1] = bfhi(wk);
                Vs[r * 128 + 2 * c2] = bflo(wv); Vs[r * 128 + 2 * c2 + 1] = bfhi(wv); }
            __syncthreads();
            const int kpos = kt * 64 + lane;
#pragma unroll
            for (int i = 0; i < 4; ++i) {
                const int r = wave + 8 * i, qpos = q0 + r;
                if (kt * 64 > qpos) continue;
                float s1 = 0.f, s2 = 0.f;
                const LAS f32x4* qp = (const LAS f32x4*)(Qs + r * 128); const LAS f32x4* kp = (const LAS f32x4*)(Ks + lane * 132);
#pragma unroll
                for (int d = 0; d < 16; ++d) { const f32x4 q = qp[d], k = kp[d]; s1 += (q.x * k.x + q.y * k.y) + (q.z * k.z + q.w * k.w); }
#pragma unroll
                for (int d = 16; d < 32; ++d) { const f32x4 q = qp[d], k = kp[d]; s2 += (q.x * k.x + q.y * k.y) + (q.z * k.z + q.w * k.w); }
                const float bias = slope2 * (float)(qpos - kpos);
                const bool ok = kpos <= qpos;
                s1 = ok ? s1 - bias : -1e30f; s2 = ok ? s2 - bias : -1e30f;
                const float mn1 = fmaxf(m1[i], wave_max(s1)), mn2 = fmaxf(m2[i], wave_max(s2));
                const float p1 = ok ? exp2f(s1 - mn1) : 0.f, p2 = ok ? exp2f(s2 - mn2) : 0.f;
                const float a1 = exp2f(m1[i] - mn1), a2 = exp2f(m2[i] - mn2);
                l1[i] = l1[i] * a1 + wave_sum(p1); l2[i] = l2[i] * a2 + wave_sum(p2); m1[i] = mn1; m2[i] = mn2;
                Ps[wave * 128 + lane] = p1; Ps[wave * 128 + 64 + lane] = p2;
                LDS_WAIT();
                float x1 = 0.f, y1 = 0.f, x2 = 0.f, y2 = 0.f;
                for (int j = 0; j < 64; ++j) { const float pa = Ps[wave * 128 + j], pb = Ps[wave * 128 + 64 + j]; const float va = Vs[j * 128 + lane], vb = Vs[j * 128 + 64 + lane];
                    x1 += pa * va; y1 += pa * vb; x2 += pb * va; y2 += pb * vb; }
                oa1[i] = oa1[i] * a1 + x1; ob1[i] = ob1[i] * a1 + y1; oa2[i] = oa2[i] * a2 + x2; ob2[i] = ob2[i] * a2 + y2;
                LDS_WAIT();
            }
        }
#pragma unroll
        for (int i = 0; i < 4; ++i) {
            const int r = wave + 8 * i;
            const float oa = oa1[i] / l1[i] - lam * (oa2[i] / l2[i]), ob = ob1[i] / l1[i] - lam * (ob2[i] / l2[i]);
            const float ss = wave_sum(oa * oa + ob * ob);
            const float rs = (1.0f / sqrtf(ss * (1.0f / 128.0f) + EPS)) * (1.0f - LAMBDA_INIT);
            bf16* op = proj + (rowbase + q0 + r) * DIFF_PITCH + h * 128;
            op[lane] = (bf16)f2bf(oa * rs * head_norm[lane]); op[64 + lane] = (bf16)f2bf(ob * rs * head_norm[64 + lane]);
        }
    }
}

namespace pg8 {
#define PG8_LAS __attribute__((address_space(3)))
typedef unsigned short bf16_t;
typedef short bf16x8 __attribute__((ext_vector_type(8)));
typedef float f32x4 __attribute__((ext_vector_type(4)));
typedef unsigned u32x4 __attribute__((ext_vector_type(4)));
constexpr int BM = 256, BK = 64, HALF = 128, HTB = HALF * BK * 2  , STAGE_BYTES = 8 * HTB, NXCD = 8, WGM = 8;

__host__ __device__ __forceinline__ int lds_byte(int r, int c) { const int st = (r >> 4) * 2 + (c >> 5), rr = r & 15, cc = c & 31, ob = rr * 64 + cc * 2; return st * 1024 + (ob ^ (((ob >> 9) & 1) << 5)); }
__host__ __device__ __forceinline__ void stage_rc(int b, int& R, int& C) { const int st = b / 1024, sb = b % 1024, swz = sb ^ (((sb >> 9) & 1) << 5); R = (st >> 1) * 16 + swz / 64; C = (st & 1) * 32 + (swz % 64) / 2; }
__host__ __device__ __forceinline__ int perm32(int rho) { const int n = rho >> 4, i = rho & 15; return 8 * (i >> 2) + 4 * n + (i & 3); }

struct Unit { int pm, pn; };
struct Gemm { const bf16_t* A; int lda; const bf16_t* Bt; int M, N, K; };

struct StaticOrder {
    int nM, nN, nwg, G, c;
    __host__ __device__ void init(int M, int N, int G_, int c_) { nM = M / BM; nN = N / BM; nwg = nM * nN; G = G_; c = c_; }
    __host__ __device__ bool next(int i, Unit& u) const {
        const long L = (long)i * G + c; if (L >= nwg) return false;
        int wgid = (int)L; { const int q = nwg / NXCD, r = nwg % NXCD, xcd = wgid % NXCD, off = wgid / NXCD; wgid = (xcd < r ? xcd * (q + 1) : r * (q + 1) + (xcd - r) * q) + off; }
        const int nig = WGM * nN, gid = wgid / nig, fm = gid * WGM, gsz = (nM - fm) < WGM ? (nM - fm) : WGM;
        u.pm = fm + ((wgid % nig) % gsz); u.pn = (wgid % nig) / gsz; return true;
    }
    __device__ __forceinline__ void a_ready(const Unit&) const {}
    __device__ __forceinline__ void done(const Unit&) const {}
};

template <class Epi, class Sched, bool ALIGN_EPI = false, bool SP2 = false>
__device__ __forceinline__ void gemm_phase(PG8_LAS unsigned char* lds, const Gemm g, const Sched& S, const Epi& E) {
    const int tid = otid(), wid = __builtin_amdgcn_readfirstlane(tid >> 6), lane = tid & 63, wr = wid >> 2, wc = wid & 3, fr = lane & 15, fq = lane >> 4;
    const int K = g.K, nt = K / BK, lda = g.lda;
    unsigned voffA[2], voffB[2];
#pragma unroll
    for (int i = 0; i < 2; ++i) { int R, C; stage_rc(tid * 16 + i * 8192, R, C); const int Rb = Epi::PERM ? ((R & ~31) + perm32(R & 31)) : R;
        voffA[i] = (unsigned)(R * lda + C) * 2u; voffB[i] = (unsigned)(Rb * K + C) * 2u; }
    const size_t kstep = (size_t)(BK * 2);
    const size_t hstepA = (size_t)HALF * lda * 2, hstepB = (size_t)HALF * K * 2;
    const size_t tstepA = 2 * hstepA, tstepB = 2 * hstepB;
    const unsigned ldsw = (unsigned)wid * 1024u;
    const int aoff = lds_byte(wr * 64 + fr, fq * 8), boff = lds_byte(wc * 32 + fr, fq * 8);
#define PG8_SA(b, h) (((b) * 2 + (h)) * HTB)
#define PG8_SB(b, h) ((4 + (b) * 2 + (h)) * HTB)
#define PG8_STAGE(bufoff, gbase, voff) do { _Pragma("unroll") for (int _i = 0; _i < 2; ++_i) \
        __builtin_amdgcn_global_load_lds((const unsigned*)((const char*)(gbase) + (voff)[_i]), (PG8_LAS unsigned*)(lds + (bufoff) + ldsw + _i * 8192), 16, 0, 0); } while (0)
#define PG8_LDA(dst, b, h) do { _Pragma("unroll") for (int m = 0; m < 4; ++m) _Pragma("unroll") for (int k = 0; k < 2; ++k) dst[m][k] = *(const PG8_LAS bf16x8*)(lds + PG8_SA(b, h) + aoff + m * 2048 + k * 1024); } while (0)
#define PG8_LDB(dst, b, h) do { _Pragma("unroll") for (int n = 0; n < 2; ++n) _Pragma("unroll") for (int k = 0; k < 2; ++k) dst[n][k] = *(const PG8_LAS bf16x8*)(lds + PG8_SB(b, h) + boff + n * 2048 + k * 1024); } while (0)
#define PG8_MMA(ai, bj, At, Bt) do { __builtin_amdgcn_s_setprio(1); _Pragma("unroll") for (int m = 0; m < 4; ++m) _Pragma("unroll") for (int n = 0; n < 2; ++n) _Pragma("unroll") for (int k = 0; k < 2; ++k) \
        acc[ai][bj][m][n] = __builtin_amdgcn_mfma_f32_16x16x32_bf16(Bt[n][k], At[m][k], acc[ai][bj][m][n], 0, 0, 0); __builtin_amdgcn_s_setprio(0); } while (0)
#define PG8_WAIT_V(n) asm volatile("s_waitcnt vmcnt(" #n ")" ::: "memory")
#define PG8_WAIT_L(n) asm volatile("s_waitcnt lgkmcnt(" #n ")" ::: "memory")
#define PG8_BAR __builtin_amdgcn_s_barrier()
#define PG8_SCHED __builtin_amdgcn_sched_barrier(0)
    Unit cur, nxt; int ui = 0;
    if (!S.next(0, cur)) return;
    f32x4 acc[2][2][4][2];
#pragma unroll
    for (int a = 0; a < 2; ++a)
#pragma unroll
        for (int b = 0; b < 2; ++b)
#pragma unroll
            for (int m = 0; m < 4; ++m)
#pragma unroll
                for (int n = 0; n < 2; ++n) acc[a][b][m][n] = (f32x4){0.f, 0.f, 0.f, 0.f};
    bf16x8 At[4][2], B0[2][2], B1[2][2];
    const char* cA = (const char*)g.A + (size_t)cur.pm * tstepA; const char* cB = (const char*)g.Bt + (size_t)cur.pn * tstepB;
    S.a_ready(cur);
    if constexpr (SP2) {
        PG8_STAGE(PG8_SB(0, 0), cB, voffB); PG8_STAGE(PG8_SB(0, 1), cB + hstepB, voffB); PG8_STAGE(PG8_SA(0, 0), cA, voffA); PG8_STAGE(PG8_SA(0, 1), cA + hstepA, voffA);
        if (wr == 1) PG8_BAR;
        PG8_WAIT_V(2); PG8_BAR;
        PG8_STAGE(PG8_SB(1, 0), cB + kstep, voffB); PG8_STAGE(PG8_SA(1, 0), cA + kstep, voffA); PG8_STAGE(PG8_SB(1, 1), cB + hstepB + kstep, voffB);
        PG8_WAIT_V(6); PG8_BAR;
    } else {
        PG8_STAGE(PG8_SB(0, 0), cB, voffB); PG8_STAGE(PG8_SA(0, 0), cA, voffA); PG8_STAGE(PG8_SB(0, 1), cB + hstepB, voffB); PG8_STAGE(PG8_SA(0, 1), cA + hstepA, voffA);
        if (wr == 1) PG8_BAR;
        PG8_WAIT_V(4); PG8_BAR;
        PG8_STAGE(PG8_SB(1, 0), cB + kstep, voffB); PG8_STAGE(PG8_SA(1, 0), cA + kstep, voffA); PG8_STAGE(PG8_SB(1, 1), cB + hstepB + kstep, voffB);
        PG8_WAIT_V(6); PG8_BAR;
    }
    for (;;) {
        const bool has_next = S.next(ui + 1, nxt);
        const char* nA = has_next ? (const char*)g.A + (size_t)nxt.pm * tstepA : cA; const char* nB = has_next ? (const char*)g.Bt + (size_t)nxt.pn * tstepB : cB;
        for (int t = 0; t < nt; t += 2) {
            const bool last = (t == nt - 2);
            const char* a1 = cA + (size_t)(t + 1) * kstep;
            const char* a2 = last ? nA : cA + (size_t)(t + 2) * kstep; const char* b2 = last ? nB : cB + (size_t)(t + 2) * kstep;
            const char* a3 = a2 + kstep; const char* b3 = b2 + kstep;
            if (last && has_next) S.a_ready(nxt);
            if constexpr (SP2) {
            PG8_LDB(B0, 0, 0); PG8_LDB(B1, 0, 1); PG8_SCHED; PG8_LDA(At, 0, 0); PG8_STAGE(PG8_SA(1, 1), a1 + hstepA, voffA);
            PG8_WAIT_V(8); PG8_WAIT_L(0); PG8_BAR; PG8_MMA(0, 0, At, B0); PG8_MMA(0, 1, At, B1); PG8_BAR; PG8_SCHED;
            PG8_LDA(At, 0, 1); PG8_STAGE(PG8_SB(0, 0), b2, voffB); PG8_STAGE(PG8_SB(0, 1), b2 + hstepB, voffB); PG8_STAGE(PG8_SA(0, 0), a2, voffA);
            PG8_WAIT_V(8); PG8_WAIT_L(0); PG8_BAR; PG8_MMA(1, 0, At, B0); PG8_MMA(1, 1, At, B1); PG8_BAR; PG8_SCHED;
            PG8_LDB(B0, 1, 0); PG8_LDB(B1, 1, 1); PG8_SCHED; PG8_LDA(At, 1, 0); PG8_STAGE(PG8_SA(0, 1), a2 + hstepA, voffA);
            PG8_WAIT_V(8); PG8_WAIT_L(0); PG8_BAR; PG8_MMA(0, 0, At, B0); PG8_MMA(0, 1, At, B1); PG8_BAR; PG8_SCHED;
            PG8_LDA(At, 1, 1); PG8_STAGE(PG8_SB(1, 0), b3, voffB); PG8_STAGE(PG8_SB(1, 1), b3 + hstepB, voffB); PG8_STAGE(PG8_SA(1, 0), a3, voffA);
            PG8_WAIT_V(8); PG8_WAIT_L(0); PG8_BAR; PG8_MMA(1, 0, At, B0); PG8_MMA(1, 1, At, B1); PG8_BAR; PG8_SCHED;
            } else {
            PG8_LDB(B0, 0, 0); PG8_SCHED; PG8_LDA(At, 0, 0); PG8_STAGE(PG8_SA(1, 1), a1 + hstepA, voffA);
            PG8_WAIT_L(8); PG8_BAR; PG8_WAIT_L(0); PG8_MMA(0, 0, At, B0); PG8_BAR; PG8_SCHED;
            PG8_LDB(B1, 0, 1); PG8_STAGE(PG8_SB(0, 0), b2, voffB);
            PG8_BAR; PG8_WAIT_L(0); PG8_MMA(0, 1, At, B1); PG8_BAR;
            PG8_LDA(At, 0, 1); PG8_STAGE(PG8_SA(0, 0), a2, voffA);
            PG8_BAR; PG8_WAIT_L(0); PG8_MMA(1, 0, At, B0); PG8_BAR; PG8_SCHED;
            PG8_STAGE(PG8_SB(0, 1), b2 + hstepB, voffB);
            PG8_WAIT_V(6); PG8_BAR; PG8_MMA(1, 1, At, B1); PG8_BAR;
            PG8_LDB(B0, 1, 0); PG8_SCHED; PG8_LDA(At, 1, 0); PG8_STAGE(PG8_SA(0, 1), a2 + hstepA, voffA);
            PG8_WAIT_L(8); PG8_BAR; PG8_WAIT_L(0); PG8_MMA(0, 0, At, B0); PG8_BAR; PG8_SCHED;
            PG8_LDB(B1, 1, 1); PG8_STAGE(PG8_SB(1, 0), b3, voffB);
            PG8_BAR; PG8_WAIT_L(0); PG8_MMA(0, 1, At, B1); PG8_BAR;
            PG8_LDA(At, 1, 1); PG8_STAGE(PG8_SA(1, 0), a3, voffA);
            PG8_BAR; PG8_WAIT_L(0); PG8_MMA(1, 0, At, B0); PG8_BAR; PG8_SCHED;
            PG8_STAGE(PG8_SB(1, 1), b3 + hstepB, voffB);
            PG8_WAIT_V(6); PG8_BAR; PG8_MMA(1, 1, At, B1); PG8_BAR;
            }
        }
        if constexpr (ALIGN_EPI) { if (wr == 0) PG8_BAR; }
        if constexpr (!Epi::AFTER_DRAIN) { E(acc, cur, wr, wc, fr, fq); S.done(cur); }
        if (!has_next) break;
#pragma unroll
        for (int a = 0; a < 2; ++a)
#pragma unroll
            for (int b = 0; b < 2; ++b)
#pragma unroll
                for (int m = 0; m < 4; ++m)
#pragma unroll
                    for (int n = 0; n < 2; ++n) acc[a][b][m][n] = (f32x4){0.f, 0.f, 0.f, 0.f};
        cur = nxt; cA = nA; cB = nB; ++ui;
        if constexpr (ALIGN_EPI) { if (wr == 1) PG8_BAR; }
    }
    PG8_WAIT_V(0);
    if constexpr (!ALIGN_EPI) { if (wr == 0) PG8_BAR; }
    PG8_BAR;
    if constexpr (Epi::AFTER_DRAIN) { E.fused(acc, cur, wr, wc, fr, fq, lds, wid, lane); S.done(cur); }
#undef PG8_SA
#undef PG8_SB
#undef PG8_STAGE
#undef PG8_LDA
#undef PG8_LDB
#undef PG8_MMA
#undef PG8_WAIT_V
#undef PG8_WAIT_L
#undef PG8_BAR
#undef PG8_SCHED
}
}

template <class Core> struct EpiMfma {
    static constexpr bool PERM = true, AFTER_DRAIN = false;
    Core c;
    __device__ __forceinline__ void operator()(const pg8::f32x4 (&acc)[2][2][4][2], const pg8::Unit& u, int wr, int wc, int fr, int fq) const {
        float gmax[2] = {0.f, 0.f};
#pragma unroll
        for (int ai = 0; ai < 2; ++ai)
#pragma unroll
            for (int m = 0; m < 4; ++m) {
                const int row = u.pm * 256 + ai * 128 + wr * 64 + m * 16 + fr;
                const float rs = c.rowscale(row);
                float part = 0.f;
#pragma unroll
                for (int bj = 0; bj < 2; ++bj) {
                    const int col0 = u.pn * 256 + bj * 128 + wc * 32 + 8 * fq;
                    const float v[8] = {acc[ai][bj][m][0][0], acc[ai][bj][m][0][1], acc[ai][bj][m][0][2], acc[ai][bj][m][0][3],
                                        acc[ai][bj][m][1][0], acc[ai][bj][m][1][1], acc[ai][bj][m][1][2], acc[ai][bj][m][1][3]};
                    const float p = c.apply8(row, col0, v, rs);
                    part += p;
                    if (Core::GROUPMAX) { float q = p; q += __shfl_xor(q, 16); q += __shfl_xor(q, 32); gmax[bj] = fmaxf(gmax[bj], q); }
                }
                part += __shfl_xor(part, 16); part += __shfl_xor(part, 32);
                if (fq == 0) c.store_part(row, u.pn * 256, (u.pn & 3) * 4 + wc, part);
            }
        if (Core::GROUPMAX) {
#pragma unroll
            for (int bj = 0; bj < 2; ++bj) { const int colg = u.pn * 256 + bj * 128 + wc * 32;
                if (c.want_groupmax(colg)) { const float m = wave_max(gmax[bj]); if (fr == 0 && fq == 0) c.store_groupmax(u.pm * 256, colg, m); } }
        }
    }
};
#ifndef USE_MFMA_GEMM
#define USE_MFMA_GEMM 1
#endif
template <class Core>
__device__ __forceinline__ void run_gemm(LAS unsigned char* lds, const bf16* A, int lda, const bf16* Bt, int M, int N, int K, const Core& c, int vcu, int G) {
#if USE_MFMA_GEMM
    int bxo = (int)blockIdx.x; asm volatile("" : "+s"(bxo));
    pg8::Gemm g{A, lda, Bt, M, N, K}; pg8::StaticOrder S; S.init(M, N, G, bxo);
    EpiMfma<Core> E{c};
    if constexpr (Core::NEEDS_RS) {
        pg8::Unit u0;
        if (S.next(0, u0)) { LAS float* tab = (LAS float*)(lds + LDSCTL_OFF + 1024); const int t_ = otid();
            if (t_ < 256) tab[t_] = row_rstd(c.ssq, u0.pm * 256 + t_);
            E.c.rs_tab = tab; E.c.rs_row0 = u0.pm * 256; }
        __syncthreads();
    }
    pg8::gemm_phase<EpiMfma<Core>, pg8::StaticOrder, true, true>(lds, g, S, E);
#else
    gemm_naive(lds, A, lda, Bt, M, N, K, c, vcu, G);
#endif
}

#include <hip/hip_bf16.h>
#include <cmath>
namespace attn_body {
using bf16=__hip_bfloat16;
using bf16x8=__attribute__((ext_vector_type(8)))short;
using s16x4=__attribute__((ext_vector_type(4)))short;
using f32x16=__attribute__((ext_vector_type(16)))float;
using u32x4=__attribute__((ext_vector_type(4)))unsigned;
constexpr int SEQ=8192,D=64,PQ=3072,PO=2048;
constexpr int NW=8,QBLK=32,QB=QBLK*NW,KVBLK=64,NQB=SEQ/QB;
__device__ __forceinline__ int crow(int r,int hi){return (r&3)+8*(r>>2)+4*hi;}
#define SBAR() __builtin_amdgcn_sched_barrier(0)
__device__ __forceinline__ void cmask(f32x16&p0,f32x16&p1,int jb,int qrel,int hi){
  const float NEG=-INFINITY; int kb=64*jb+4*hi;
  #pragma unroll
  for(int r=0;r<16;++r){int kv=kb+(r&3)+8*(r>>2); if(kv>qrel)p0[r]=NEG; if(kv+32>qrel)p1[r]=NEG;}
}

constexpr int NSLOT=3, SLOTB=8192;
constexpr int LDS_K=0, LDS_V=NSLOT*SLOTB, LDS_WS=2*NSLOT*SLOTB, LDS_OST=LDS_WS+NW*64*4, LDS_BYTES=LDS_OST+NW*4096;
constexpr float C2=0.125f*1.4426950408889634f;
__device__ __forceinline__ void glds16(const void*gsrc,unsigned lds_dst){unsigned keep;
  asm volatile("s_mov_b32 %0, m0\n\ts_mov_b32 m0, %2\n\ts_nop 0\n\tglobal_load_lds_dwordx4 %1, off\n\ts_mov_b32 m0, %0":"=&s"(keep):"v"(gsrc),"s"(lds_dst):"memory");}
__device__ __forceinline__ float max3f(float a,float b,float c){float r;asm("v_max3_f32 %0, %1, %2, %3":"=v"(r):"v"(a),"v"(b),"v"(c));return r;}
__device__ __forceinline__ float max2f(float a,float b){float r;asm("v_max_f32_e32 %0, %1, %2":"=v"(r):"v"(a),"v"(b));return r;}
__device__ __forceinline__ float fadd_s(float a,float b){float r;asm("v_add_f32_e32 %0, %1, %2":"=v"(r):"v"(a),"v"(b));return r;}
__device__ __forceinline__ float fsub_s(float a,float b){float r;asm("v_sub_f32_e32 %0, %1, %2":"=v"(r):"v"(a),"v"(b));return r;}
typedef float f32x2_t __attribute__((ext_vector_type(2))); typedef __bf16 bf16x2_t __attribute__((ext_vector_type(2)));
__device__ __forceinline__ unsigned cvtpk_s(float lo,float hi){f32x2_t v={lo,hi};bf16x2_t b=__builtin_convertvector(v,bf16x2_t);return __builtin_bit_cast(unsigned,b);}
#define WAIT_BAR(N) asm volatile("s_waitcnt vmcnt(" #N ") lgkmcnt(0)\n\ts_barrier":::"memory")

__device__ __forceinline__ void qkt(f32x16&p0,f32x16&p1,const char*Kslot,const bf16x8*qr,const f32x16&negm,int r32,int hi){
  const char*kb=Kslot+hi*1024+r32*16;
  #pragma unroll
  for(int d0=0;d0<4;++d0){
    const bf16x8 b0=*reinterpret_cast<const bf16x8*>(kb+d0*2048);
    const bf16x8 b1=*reinterpret_cast<const bf16x8*>(kb+d0*2048+512);
    if(d0==0){p0=__builtin_amdgcn_mfma_f32_32x32x16_bf16(b0,qr[0],negm,0,0,0);p1=__builtin_amdgcn_mfma_f32_32x32x16_bf16(b1,qr[0],negm,0,0,0);}
    else{p0=__builtin_amdgcn_mfma_f32_32x32x16_bf16(b0,qr[d0],p0,0,0,0);p1=__builtin_amdgcn_mfma_f32_32x32x16_bf16(b1,qr[d0],p1,0,0,0);}}
}
typedef __attribute__((address_space(3))) const char* lds_cptr;
typedef short v4i16_t __attribute__((ext_vector_type(4)));
__device__ __forceinline__ void kload8(bf16x8*kf,lds_cptr kp){
  kf[0]=*(const __attribute__((address_space(3))) bf16x8*)(kp);      kf[1]=*(const __attribute__((address_space(3))) bf16x8*)(kp+512);
  kf[2]=*(const __attribute__((address_space(3))) bf16x8*)(kp+2048); kf[3]=*(const __attribute__((address_space(3))) bf16x8*)(kp+2560);
  kf[4]=*(const __attribute__((address_space(3))) bf16x8*)(kp+4096); kf[5]=*(const __attribute__((address_space(3))) bf16x8*)(kp+4608);
  kf[6]=*(const __attribute__((address_space(3))) bf16x8*)(kp+6144); kf[7]=*(const __attribute__((address_space(3))) bf16x8*)(kp+6656);
}
__device__ __forceinline__ void kload2(bf16x8*kf,lds_cptr kp,int j){ kf[2*j]=*(const __attribute__((address_space(3))) bf16x8*)(kp+j*2048); kf[2*j+1]=*(const __attribute__((address_space(3))) bf16x8*)(kp+j*2048+512); }
__device__ __forceinline__ s16x4 vtr(lds_cptr p){ return __builtin_bit_cast(s16x4,__builtin_amdgcn_ds_read_tr16_b64_v4i16((__attribute__((address_space(3))) v4i16_t*)p)); }
__device__ __forceinline__ float rowmax(const f32x16&p0,const f32x16&p1){
  float a=max3f(p0[0],p0[1],p1[0]),b=max3f(p0[2],p0[3],p1[1]);a=max3f(a,p1[2],p1[3]);
  #pragma unroll
  for(int r=4;r<16;r+=4){a=max3f(a,p0[r],p0[r+1]);b=max3f(b,p0[r+2],p0[r+3]);a=max3f(a,p1[r],p1[r+1]);b=max3f(b,p1[r+2],p1[r+3]);}
  const float m=max2f(a,b);
  auto rr=__builtin_amdgcn_permlane32_swap(__float_as_uint(m),__float_as_uint(m),false,false);
  return max2f(__uint_as_float(rr[0]),__uint_as_float(rr[1]));
}
__device__ __forceinline__ void pv(f32x16*o,int vb,bf16x8 pa0,bf16x8 pa1,bf16x8 pa2,bf16x8 pa3){
  #pragma unroll
  for(int d0=0;d0<2;++d0){s16x4 lo[4],hi[4];
    #pragma unroll
    for(int ks=0;ks<4;++ks){
      asm volatile("ds_read_b64_tr_b16 %0,%1 offset:%c2":"=&v"(lo[ks]):"v"(vb),"i"(d0*4096+ks*1024):"memory");
      asm volatile("ds_read_b64_tr_b16 %0,%1 offset:%c2":"=&v"(hi[ks]):"v"(vb),"i"(d0*4096+ks*1024+512):"memory");}
    asm volatile("s_waitcnt lgkmcnt(0)":::"memory");SBAR();
    #define PK(k) (bf16x8){lo[k][0],lo[k][1],lo[k][2],lo[k][3],hi[k][0],hi[k][1],hi[k][2],hi[k][3]}
    o[d0]=__builtin_amdgcn_mfma_f32_32x32x16_bf16(pa0,PK(0),o[d0],0,0,0);
    o[d0]=__builtin_amdgcn_mfma_f32_32x32x16_bf16(pa1,PK(1),o[d0],0,0,0);
    o[d0]=__builtin_amdgcn_mfma_f32_32x32x16_bf16(pa2,PK(2),o[d0],0,0,0);
    o[d0]=__builtin_amdgcn_mfma_f32_32x32x16_bf16(pa3,PK(3),o[d0],0,0,0);
    #undef PK
  }
}

#ifndef ATTN_STORE16
#define ATTN_STORE16(p,v) (*(u32x4*)(p)=(v))
#endif
template<int THRL> __device__ __forceinline__ void attn_unit(int b,int qb,int t0,const bf16*Q,const bf16*K,const bf16*V,bf16*O,float slope2,char*shm){
  const int tid=otid(),lane=tid&63,r32=lane&31,hi=lane>>5; const int wid=__builtin_amdgcn_readfirstlane(tid>>6);
  const long rowbase=(long)b*SEQ; const int q0=qb*QB;
  const bf16*Qw=Q+(rowbase+q0+wid*QBLK)*PQ;
  const bf16*Kh=K+(rowbase+(long)t0*KVBLK)*PQ,*Vh=V+(rowbase+(long)t0*KVBLK)*PQ;
  const unsigned lds0=(unsigned)(uintptr_t)shm;
  float*wsf=(float*)(shm+LDS_WS)+wid*64;
  const bf16*ksrc=Kh+(long)lane*PQ+wid*8;
  const bf16*vsrc=Vh+(long)(16*(wid&3)+(lane>>2))*PQ+(wid>>2)*32+(lane&3)*8;
  const unsigned kdst=lds0+LDS_K+wid*1024, vdst=lds0+LDS_V+wid*1024;
  #define DMA_K(t,slot) glds16(ksrc+(long)(t)*KVBLK*PQ,(unsigned)__builtin_amdgcn_readfirstlane(kdst+(slot)))
  #define DMA_V(t,slot) glds16(vsrc+(long)(t)*KVBLK*PQ,(unsigned)__builtin_amdgcn_readfirstlane(vdst+(slot)))
  const int vb0=(int)(lds0+LDS_V)+((lane>>4)&1)*32+(lane&3)*8+(4*hi+((lane&15)>>2))*64;
  const char*Kbase=shm+LDS_K; bf16x8 kf[8];
  const lds_cptr shm3=(lds_cptr)shm; const lds_cptr kp0=shm3+LDS_K+hi*1024+r32*16; const lds_cptr vp0=shm3+LDS_V+((lane>>4)&1)*32+(lane&3)*8+(4*hi+((lane&15)>>2))*64;
  const int NT=(q0+QB)/KVBLK-t0;
  DMA_K(0,0);DMA_V(0,0);DMA_K(1,SLOTB);
  bf16x8 qr[4];
  #pragma unroll
  for(int d0=0;d0<4;++d0)qr[d0]=*reinterpret_cast<const bf16x8*>(&Qw[(long)r32*PQ+d0*16+hi*8]);
  float l_reg=0.f;f32x16 o[2];o[0]=f32x16{};o[1]=f32x16{};f32x16 negm;
  _Pragma("unroll") for(int r=0;r<16;++r)negm[r]=slope2*(float)crow(r,hi);
  asm volatile("":"+v"(negm)); const float b32=32.f*slope2, step64=64.f*slope2;
  const int qrel=wid*QBLK+r32;
  #define CMASK(P0,P1,t) do{int jb_=(t)-(NT-4); if(jb_>=0)cmask(P0,P1,jb_,qrel,hi);}while(0)
  bool resc=false;
  #define START(P0,P1) do{ const float rm=rowmax(P0,P1); resc=false; \
    { const float dl=rm; \
      _Pragma("unroll") for(int r=0;r<16;++r){P0[r]=fsub_s(P0[r],dl);P1[r]=fsub_s(P1[r],dl);} \
      const float adj_=step64-dl; _Pragma("unroll") for(int r=0;r<16;++r)negm[r]+=adj_; asm volatile("":"+v"(negm)); } \
    _Pragma("unroll") for(int r=0;r<16;++r)P0[r]=__builtin_amdgcn_exp2f(P0[r]); }while(0)
  #define RESC() do{ if(resc){ asm volatile("s_waitcnt lgkmcnt(0)":::"memory"); \
      _Pragma("unroll") for(int d_=0;d_<2;++d_) _Pragma("unroll") for(int r=0;r<16;++r)o[d_][r]*=wsf[crow(r,hi)]; } }while(0)
  f32x16 pA0,pA1,pB0,pB1;
  int sl_prev=0,sl_cur=0,sl_next=SLOTB;
  #define ROT() do{sl_prev=sl_cur;sl_cur=sl_next;sl_next=(sl_next==(NSLOT-1)*SLOTB)?0:sl_next+SLOTB;}while(0)
  DMA_K(2,2*SLOTB);
  WAIT_BAR(3);
  qkt(pA0,pA1,Kbase,qr,negm,r32,hi);asm volatile("s_nop 15\n\ts_nop 7":"+v"(pA0),"+v"(pA1));
  _Pragma("unroll") for(int r=0;r<16;++r)pA1[r]+=b32;
  CMASK(pA0,pA1,0);
  START(pA0,pA1);
  _Pragma("unroll") for(int r=0;r<16;++r)pA1[r]=__builtin_amdgcn_exp2f(pA1[r]);
  WAIT_BAR(0);
  DMA_K(3,0);DMA_V(1,SLOTB);
  ROT();
  kload8(kf,kp0+sl_cur);
  WAIT_BAR(2);
  s16x4 vlo[8],vhi[8]; u32x4 pw0,pw1,pw2,pw3;
  #define PKW(P,B) cvtpk_s(P[B],P[B+1])
  #define PAF(k) __builtin_bit_cast(bf16x8,pw##k)
  #define VFR(i) (bf16x8){vlo[i][0],vlo[i][1],vlo[i][2],vlo[i][3],vhi[i][0],vhi[i][1],vhi[i][2],vhi[i][3]}
  #define PIN(x) asm volatile("":"+v"(x))
  #define MX3(a,b,c) __builtin_fmaxf(__builtin_fmaxf((a),(b)),(c))
  #define GAPA(MF,A0,A1,A2,A3,W0,W1,PW) do{ MF; sacc+=A0; sacc+=A1; sacc+=A2; sacc+=A3; PIN(sacc); W0; W1; PIN(PW); SBAR(); }while(0)
  #define EX(v) __builtin_amdgcn_exp2f(v)
  #define GAPB(MF,X,B) do{ MF; X[B]=EX(X[B]); X[B+1]=EX(X[B+1]); X[B+2]=EX(X[B+2]); X[B+3]=EX(X[B+3]); PIN(X); SBAR(); }while(0)
  #define VRD(i) do{ vlo[i]=vtr(vp_+(((i)>>2)*4096+((i)&3)*1024)); vhi[i]=vtr(vp_+(((i)>>2)*4096+((i)&3)*1024+512)); }while(0)
  #define KRD(G,j) do{ if(G){ kload2(kf,kp0+sl_next,j); SBAR(); } }while(0)
  #define STEP(C0,C1,P0,P1,t,GK,GV,GL) do{ SBAR(); \
    const lds_cptr vp_=vp0+sl_prev; \
    VRD(0); SBAR(); float sacc=(P0[0]+P0[1]); \
    GAPA(C0=__builtin_amdgcn_mfma_f32_32x32x16_bf16(kf[0],qr[0],negm,0,0,0), P0[2],P0[3],P0[4],P0[5],     pw0[0]=PKW(P0,0), pw0[1]=PKW(P0,2), pw0); \
    VRD(4); SBAR(); GAPA(C1=__builtin_amdgcn_mfma_f32_32x32x16_bf16(kf[1],qr[0],negm,0,0,0), P0[6],P0[7],P0[8],P0[9],     pw0[2]=PKW(P0,4), pw0[3]=PKW(P0,6), pw0); \
    VRD(1); SBAR(); GAPA(C0=__builtin_amdgcn_mfma_f32_32x32x16_bf16(kf[2],qr[1],C0,0,0,0),   P0[10],P0[11],P0[12],P0[13], pw1[0]=PKW(P0,8), pw1[1]=PKW(P0,10), pw1); \
    VRD(5); SBAR(); GAPA(C1=__builtin_amdgcn_mfma_f32_32x32x16_bf16(kf[3],qr[1],C1,0,0,0),   P0[14],P0[15],P1[0],P1[1],   pw1[2]=PKW(P0,12),pw1[3]=PKW(P0,14), pw1); \
    VRD(2); SBAR(); GAPA(C0=__builtin_amdgcn_mfma_f32_32x32x16_bf16(kf[4],qr[2],C0,0,0,0),   P1[2],P1[3],P1[4],P1[5],     pw2[0]=PKW(P1,0), pw2[1]=PKW(P1,2), pw2); \
    VRD(6); SBAR(); GAPA(C1=__builtin_amdgcn_mfma_f32_32x32x16_bf16(kf[5],qr[2],C1,0,0,0),   P1[6],P1[7],P1[8],P1[9],     pw2[2]=PKW(P1,4), pw2[3]=PKW(P1,6), pw2); \
    VRD(3); SBAR(); GAPA(C0=__builtin_amdgcn_mfma_f32_32x32x16_bf16(kf[6],qr[3],C0,0,0,0),   P1[10],P1[11],P1[12],P1[13], pw3[0]=PKW(P1,8), pw3[1]=PKW(P1,10), pw3); \
    VRD(7); SBAR(); GAPA(C1=__builtin_amdgcn_mfma_f32_32x32x16_bf16(kf[7],qr[3],C1,0,0,0),   P1[14],P1[15],0.f,0.f,       pw3[2]=PKW(P1,12),pw3[3]=PKW(P1,14), pw3); \
    l_reg+=sacc; \
    if(GK){DMA_K((t)+3,sl_cur);} if(GV){DMA_V((t)+1,sl_next);} \
    _Pragma("unroll") for(int r=0;r<16;++r)C1[r]+=b32; \
    CMASK(C0,C1,t); \
    { float a=MX3(C0[0],C0[1],C1[0]),b=MX3(C0[2],C0[3],C1[1]); a=MX3(a,C1[2],C1[3]); \
      _Pragma("unroll") for(int r=4;r<16;r+=4){a=MX3(a,C0[r],C0[r+1]);b=MX3(b,C0[r+2],C0[r+3]);a=MX3(a,C1[r],C1[r+1]);b=MX3(b,C1[r+2],C1[r+3]);} \
      float rm=__builtin_fmaxf(a,b); { auto rr=__builtin_amdgcn_permlane32_swap(__float_as_uint(rm),__float_as_uint(rm),false,false); rm=__builtin_fmaxf(__uint_as_float(rr[0]),__uint_as_float(rr[1])); } \
      resc=false; float adj_=step64; \
      if(__any(rm>(float)THRL)){ const float dl=__builtin_fmaxf(rm,0.f); adj_-=dl; \
        _Pragma("unroll") for(int r=0;r<16;++r){C0[r]-=dl;C1[r]-=dl;} \
        const float f=__builtin_amdgcn_exp2f(-dl); l_reg*=f; if(hi==0)wsf[r32]=f; resc=true; } \
      _Pragma("unroll") for(int r=0;r<16;++r)negm[r]+=adj_; asm volatile("":"+v"(negm)); } \
    SBAR(); \
    GAPB(o[0]=__builtin_amdgcn_mfma_f32_32x32x16_bf16(PAF(0),VFR(0),o[0],0,0,0), C0,0); \
    GAPB(o[1]=__builtin_amdgcn_mfma_f32_32x32x16_bf16(PAF(0),VFR(4),o[1],0,0,0), C0,4); \
    KRD(GL,0); GAPB(o[0]=__builtin_amdgcn_mfma_f32_32x32x16_bf16(PAF(1),VFR(1),o[0],0,0,0), C0,8); \
    KRD(GL,1); GAPB(o[1]=__builtin_amdgcn_mfma_f32_32x32x16_bf16(PAF(1),VFR(5),o[1],0,0,0), C0,12); \
    KRD(GL,2); GAPB(o[0]=__builtin_amdgcn_mfma_f32_32x32x16_bf16(PAF(2),VFR(2),o[0],0,0,0), C1,0); \
    KRD(GL,3); GAPB(o[1]=__builtin_amdgcn_mfma_f32_32x32x16_bf16(PAF(2),VFR(6),o[1],0,0,0), C1,4); \
    GAPB(o[0]=__builtin_amdgcn_mfma_f32_32x32x16_bf16(PAF(3),VFR(3),o[0],0,0,0), C1,8); \
    GAPB(o[1]=__builtin_amdgcn_mfma_f32_32x32x16_bf16(PAF(3),VFR(7),o[1],0,0,0), C1,12); \
    }while(0)
  int t=1;
  #undef CMASK
  #define CMASK(P0,P1,t) do{}while(0)
  for(;t+5<NT;t+=2){
    STEP(pB0,pB1,pA0,pA1,t,true,true,true);     WAIT_BAR(2); RESC(); ROT();
    STEP(pA0,pA1,pB0,pB1,t+1,true,true,true);   WAIT_BAR(2); RESC(); ROT();
  }
  #undef CMASK
  #define CMASK(P0,P1,t) do{int jb_=(t)-(NT-4); if(jb_>=0)cmask(P0,P1,jb_,qrel,hi);}while(0)
  #define ENDW(tt) do{ if((tt)+3<NT){WAIT_BAR(2);} else if((tt)+2<NT){WAIT_BAR(1);} else {WAIT_BAR(0);} }while(0)
  for(;t+1<NT;t+=2){
    STEP(pB0,pB1,pA0,pA1,t,(t+3<NT),(t+1<NT),(t+1<NT));       ENDW(t);   RESC(); ROT();
    STEP(pA0,pA1,pB0,pB1,t+1,(t+4<NT),(t+2<NT),(t+2<NT));     ENDW(t+1); RESC(); ROT();
  }
  STEP(pB0,pB1,pA0,pA1,NT-1,false,false,false); RESC();
  { float sacc=pB0[0]+pB0[1]; _Pragma("unroll") for(int r=2;r<16;++r)sacc+=pB0[r]; _Pragma("unroll") for(int r=0;r<16;++r)sacc+=pB1[r]; l_reg+=sacc;
    pw0=(u32x4){PKW(pB0,0),PKW(pB0,2),PKW(pB0,4),PKW(pB0,6)};pw1=(u32x4){PKW(pB0,8),PKW(pB0,10),PKW(pB0,12),PKW(pB0,14)};pw2=(u32x4){PKW(pB1,0),PKW(pB1,2),PKW(pB1,4),PKW(pB1,6)};pw3=(u32x4){PKW(pB1,8),PKW(pB1,10),PKW(pB1,12),PKW(pB1,14)};
    SBAR(); pv(o,vb0+sl_cur,PAF(0),PAF(1),PAF(2),PAF(3)); }
  #undef PKW
  #undef PAF
  #undef VFR
  #undef PIN
  #undef MX3
  #undef GAPA
  #undef GAPB
  #undef EX
  #undef VRD
  #undef KRD
  #undef STEP
  #undef ENDW
  {auto rr=__builtin_amdgcn_permlane32_swap(__float_as_uint(l_reg),__float_as_uint(l_reg),false,false);l_reg=__uint_as_float(rr[0])+__uint_as_float(rr[1]);}
  if(hi==0)wsf[32+r32]=l_reg;asm volatile("s_waitcnt lgkmcnt(0)":::"memory");
  float rli[16];
  #pragma unroll
  for(int r=0;r<16;++r)rli[r]=__builtin_amdgcn_rcpf(wsf[32+crow(r,hi)]);
  bf16*Ow=O+(rowbase+q0+wid*QBLK)*PO;
  { bf16*stg=(bf16*)(shm+LDS_OST)+wid*2048;
    #pragma unroll
    for(int r=0;r<16;++r){const int orow=crow(r,hi);
      #pragma unroll
      for(int d0=0;d0<2;++d0)stg[orow*64+d0*32+r32]=__float2bfloat16(o[d0][r]*rli[r]);}
    asm volatile("s_waitcnt lgkmcnt(0)":::"memory");
    #pragma unroll
    for(int i=0;i<4;++i){const int row=i*8+(lane>>3),ch=lane&7; const u32x4 v=*(const u32x4*)(stg+row*64+ch*8); ATTN_STORE16(Ow+(long)row*PO+ch*8,v);} }
  asm volatile("s_waitcnt lgkmcnt(0)\n\ts_barrier":::"memory");
  #undef DMA_K
  #undef DMA_V
  #undef CMASK
  #undef START
  #undef RESC
  #undef ROT
}

namespace v2 {
constexpr int NSL=4, KSLOT=8192, VSLOT=16384, LDS_K2=0, LDS_V2=NSL*KSLOT, LDS_WS2=LDS_V2+NSL*VSLOT, LDS_BYTES2=LDS_WS2+NW*64*4;
#define V2_WAIT_BAR(N) asm volatile("s_waitcnt vmcnt(" #N ") lgkmcnt(0)\n\ts_barrier":::"memory")
#define V2_MX3(a,b,c) __builtin_fmaxf(__builtin_fmaxf((a),(b)),(c))
}
template<int THRL> __device__ __forceinline__ void attn_unit_v2(int b,int qb,int t0,const bf16*Q,const bf16*K,const bf16*V,bf16*O,float slope2,char*shm){
  using namespace v2;
  const int tid=otid(),lane=tid&63,r32=lane&31,hi=lane>>5; const int wid=__builtin_amdgcn_readfirstlane(tid>>6);
  const long rowbase=(long)b*SEQ; const int q0=qb*QB;
  const bf16*Qw=Q+(rowbase+q0+wid*QBLK)*PQ;
  const bf16*Kh=K+(rowbase+(long)t0*KVBLK)*PQ,*Vh=V+(rowbase+(long)t0*KVBLK)*PQ;
  const unsigned lds0=(unsigned)(uintptr_t)shm;
  float*wsf=(float*)(shm+LDS_WS2)+wid*64;
  const bf16*ksrc=Kh+(long)lane*PQ+wid*8;
  const int pi0=2*wid, pi1=2*wid+1;
  const bf16*vsrc0=Vh+(long)(16*(pi0&3)+(lane>>2))*PQ+(pi0>>2)*32+(lane&3)*8;
  const bf16*vsrc1=Vh+(long)(16*(pi1&3)+(lane>>2))*PQ+(pi1>>2)*32+(lane&3)*8;
  const unsigned kdst=lds0+LDS_K2+wid*1024, vdst0=lds0+LDS_V2+pi0*1024, vdst1=lds0+LDS_V2+pi1*1024;
  #define V2_DMA(t,sl) do{ glds16(ksrc+(long)(t)*KVBLK*PQ,(unsigned)__builtin_amdgcn_readfirstlane(kdst+(sl)*KSLOT)); \
      glds16(vsrc0+(long)(t)*KVBLK*PQ,(unsigned)__builtin_amdgcn_readfirstlane(vdst0+(sl)*VSLOT)); \
      glds16(vsrc1+(long)(t)*KVBLK*PQ,(unsigned)__builtin_amdgcn_readfirstlane(vdst1+(sl)*VSLOT)); }while(0)
  const int NT=(q0+QB)/KVBLK-t0;
  V2_DMA(0,0); V2_DMA(1,1);
  bf16x8 qr[4];
  #pragma unroll
  for(int d0=0;d0<4;++d0)qr[d0]=*reinterpret_cast<const bf16x8*>(&Qw[(long)r32*PQ+d0*16+hi*8]);
  float l_reg=0.f; f32x16 o[4];
  #pragma unroll
  for(int d0=0;d0<4;++d0)o[d0]=f32x16{};
  f32x16 negm;
  #pragma unroll
  for(int r=0;r<16;++r)negm[r]=slope2*(float)crow(r,hi);
  const float b32=32.f*slope2, step64=64.f*slope2;
  const int qrel=wid*QBLK+r32;
  const lds_cptr shm3=(lds_cptr)shm; const lds_cptr kp0=shm3+LDS_K2+hi*1024+r32*16; const lds_cptr vp0=shm3+LDS_V2+((lane>>4)&1)*32+(lane&3)*8+(4*hi+((lane&15)>>2))*64;
  f32x16 p0,p1; u32x4 pw0,pw1,pw2,pw3, qw0,qw1,qw2,qw3;
  #define V2_PIN(x) asm volatile("":"+v"(x))
  #define V2_VRD(dst,d0) do{ _Pragma("unroll") for(int ks=0;ks<4;++ks){ dst[2*ks]=vtr(vp+(d0)*4096+ks*1024); dst[2*ks+1]=vtr(vp+(d0)*4096+ks*1024+512);} }while(0)
  #define V2_VF(src,ks) (bf16x8){src[2*(ks)][0],src[2*(ks)][1],src[2*(ks)][2],src[2*(ks)][3],src[2*(ks)+1][0],src[2*(ks)+1][1],src[2*(ks)+1][2],src[2*(ks)+1][3]}
  #define V2_QK(t) do{ const lds_cptr kp=kp0+((t)&3)*KSLOT; bf16x8 kf[8]; \
      _Pragma("unroll") for(int d0=0;d0<4;++d0){ kf[2*d0]=*(const __attribute__((address_space(3))) bf16x8*)(kp+d0*2048); kf[2*d0+1]=*(const __attribute__((address_space(3))) bf16x8*)(kp+d0*2048+512); } \
      SBAR(); \
      p0=__builtin_amdgcn_mfma_f32_32x32x16_bf16(kf[0],qr[0],negm,0,0,0); p1=__builtin_amdgcn_mfma_f32_32x32x16_bf16(kf[1],qr[0],negm,0,0,0); \
      _Pragma("unroll") for(int d0=1;d0<4;++d0){ p0=__builtin_amdgcn_mfma_f32_32x32x16_bf16(kf[2*d0],qr[d0],p0,0,0,0); p1=__builtin_amdgcn_mfma_f32_32x32x16_bf16(kf[2*d0+1],qr[d0],p1,0,0,0); } \
      SBAR(); }while(0)
  bool resc=false;
  #define V2_DECIDE(t,FIRST) do{ \
      _Pragma("unroll") for(int r=0;r<16;++r)p1[r]+=b32; \
      { const int jb=(t)-(NT-4); if(jb>=0)cmask(p0,p1,jb,qrel,hi); } \
      float rm; \
      { float a=V2_MX3(p0[0],p0[1],p1[0]),c=V2_MX3(p0[2],p0[3],p1[1]); a=V2_MX3(a,p1[2],p1[3]); \
        _Pragma("unroll") for(int r=4;r<16;r+=4){a=V2_MX3(a,p0[r],p0[r+1]);c=V2_MX3(c,p0[r+2],p0[r+3]);a=V2_MX3(a,p1[r],p1[r+1]);c=V2_MX3(c,p1[r+2],p1[r+3]);} \
        rm=__builtin_fmaxf(a,c); auto rr=__builtin_amdgcn_permlane32_swap(__float_as_uint(rm),__float_as_uint(rm),false,false); rm=__builtin_fmaxf(__uint_as_float(rr[0]),__uint_as_float(rr[1])); } \
      float adj=step64; resc=false; \
      if(FIRST){ _Pragma("unroll") for(int r=0;r<16;++r){p0[r]-=rm;p1[r]-=rm;} adj-=rm; } \
      else if(__any(rm>(float)THRL)){ const float dl=__builtin_fmaxf(rm,0.f); \
        _Pragma("unroll") for(int r=0;r<16;++r){p0[r]-=dl;p1[r]-=dl;} \
        adj-=dl; const float f=__builtin_amdgcn_exp2f(-dl); l_reg*=f; if(hi==0)wsf[r32]=f; resc=true; } \
      _Pragma("unroll") for(int r=0;r<16;++r)negm[r]+=adj; \
      SBAR(); }while(0)
  float sacc;
  #define V2_GRP(d0,ks,src,P,B,QW,WI) do{ o[d0]=__builtin_amdgcn_mfma_f32_32x32x16_bf16(__builtin_bit_cast(bf16x8,pw##ks),V2_VF(src,ks),o[d0],0,0,0); \
      P[B]=__builtin_amdgcn_exp2f(P[B]); P[B+1]=__builtin_amdgcn_exp2f(P[B+1]); sacc+=P[B]; sacc+=P[B+1]; QW[WI]=cvtpk_s(P[B],P[B+1]); V2_PIN(sacc); V2_PIN(QW); SBAR(); }while(0)
  #define V2_SYNC(t) do{ if((t)+1<NT){ V2_WAIT_BAR(3); } else { V2_WAIT_BAR(0); } if((t)+2<NT){ V2_DMA((t)+2,((t)+2)&3); } }while(0)
  V2_SYNC(0); V2_QK(0); V2_DECIDE(0,true);
  sacc=0.f;
  #pragma unroll
  for(int r=0;r<16;++r){p0[r]=__builtin_amdgcn_exp2f(p0[r]);p1[r]=__builtin_amdgcn_exp2f(p1[r]);sacc+=p0[r]+p1[r];}
  l_reg+=sacc;
  pw0=(u32x4){cvtpk_s(p0[0],p0[1]),cvtpk_s(p0[2],p0[3]),cvtpk_s(p0[4],p0[5]),cvtpk_s(p0[6],p0[7])};
  pw1=(u32x4){cvtpk_s(p0[8],p0[9]),cvtpk_s(p0[10],p0[11]),cvtpk_s(p0[12],p0[13]),cvtpk_s(p0[14],p0[15])};
  pw2=(u32x4){cvtpk_s(p1[0],p1[1]),cvtpk_s(p1[2],p1[3]),cvtpk_s(p1[4],p1[5]),cvtpk_s(p1[6],p1[7])};
  pw3=(u32x4){cvtpk_s(p1[8],p1[9]),cvtpk_s(p1[10],p1[11]),cvtpk_s(p1[12],p1[13]),cvtpk_s(p1[14],p1[15])};
  for(int t=1;t<NT;++t){
    V2_SYNC(t);
    const lds_cptr vp=vp0+((t-1)&3)*VSLOT; s16x4 va[8],vb[8];
    V2_VRD(va,0);
    V2_QK(t); V2_DECIDE(t,false);
    sacc=0.f;
    V2_VRD(vb,1);
    V2_GRP(0,0,va,p0,0,qw0,0); V2_GRP(0,1,va,p0,2,qw0,1); V2_GRP(0,2,va,p0,4,qw0,2); V2_GRP(0,3,va,p0,6,qw0,3);
    V2_VRD(va,2);
    V2_GRP(1,0,vb,p0,8,qw1,0); V2_GRP(1,1,vb,p0,10,qw1,1); V2_GRP(1,2,vb,p0,12,qw1,2); V2_GRP(1,3,vb,p0,14,qw1,3);
    V2_VRD(vb,3);
    V2_GRP(2,0,va,p1,0,qw2,0); V2_GRP(2,1,va,p1,2,qw2,1); V2_GRP(2,2,va,p1,4,qw2,2); V2_GRP(2,3,va,p1,6,qw2,3);
    V2_GRP(3,0,vb,p1,8,qw3,0); V2_GRP(3,1,vb,p1,10,qw3,1); V2_GRP(3,2,vb,p1,12,qw3,2); V2_GRP(3,3,vb,p1,14,qw3,3);
    l_reg+=sacc;
    if(resc){ asm volatile("s_waitcnt lgkmcnt(0)":::"memory");
      #pragma unroll
      for(int r=0;r<16;++r){ const float fr_=wsf[crow(r,hi)];
        #pragma unroll
        for(int d0=0;d0<4;++d0)o[d0][r]*=fr_; }
      asm volatile("s_waitcnt lgkmcnt(0)":::"memory"); }
    pw0=qw0; pw1=qw1; pw2=qw2; pw3=qw3;
  }
  { const lds_cptr vp=vp0+((NT-1)&3)*VSLOT; s16x4 va[8],vb[8];
    #define V2_PV(d0,src) do{ o[d0]=__builtin_amdgcn_mfma_f32_32x32x16_bf16(__builtin_bit_cast(bf16x8,pw0),V2_VF(src,0),o[d0],0,0,0); \
        o[d0]=__builtin_amdgcn_mfma_f32_32x32x16_bf16(__builtin_bit_cast(bf16x8,pw1),V2_VF(src,1),o[d0],0,0,0); \
        o[d0]=__builtin_amdgcn_mfma_f32_32x32x16_bf16(__builtin_bit_cast(bf16x8,pw2),V2_VF(src,2),o[d0],0,0,0); \
        o[d0]=__builtin_amdgcn_mfma_f32_32x32x16_bf16(__builtin_bit_cast(bf16x8,pw3),V2_VF(src,3),o[d0],0,0,0); }while(0)
    V2_VRD(va,0); V2_VRD(vb,1); V2_PV(0,va); V2_VRD(va,2); V2_PV(1,vb); V2_VRD(vb,3); V2_PV(2,va); V2_PV(3,vb);
    #undef V2_PV
  }
  #undef V2_PIN
  #undef V2_VRD
  #undef V2_VF
  #undef V2_QK
  #undef V2_DECIDE
  #undef V2_GRP
  #undef V2_SYNC
  {auto rr=__builtin_amdgcn_permlane32_swap(__float_as_uint(l_reg),__float_as_uint(l_reg),false,false);l_reg=__uint_as_float(rr[0])+__uint_as_float(rr[1]);}
  if(hi==0)wsf[32+r32]=l_reg;asm volatile("s_waitcnt lgkmcnt(0)":::"memory");
  float rli[16];
  #pragma unroll
  for(int r=0;r<16;++r)rli[r]=__builtin_amdgcn_rcpf(wsf[32+crow(r,hi)]);
  asm volatile("s_waitcnt lgkmcnt(0)\n\ts_barrier":::"memory");
  bf16*Ow=O+(rowbase+q0+wid*QBLK)*PO;
  { bf16*stg=(bf16*)shm+wid*4096;
    #pragma unroll
    for(int r=0;r<16;++r){const int orow=crow(r,hi);
      #pragma unroll
      for(int d0=0;d0<4;++d0)stg[orow*128+d0*32+r32]=__float2bfloat16(o[d0][r]*rli[r]);}
    asm volatile("s_waitcnt lgkmcnt(0)":::"memory");
    #pragma unroll
    for(int i=0;i<8;++i){const int row=i*4+(lane>>4),ch=lane&15; const u32x4 v=*(const u32x4*)(stg+row*128+ch*8); *(u32x4*)(Ow+(long)row*PO+ch*8)=v;} }
  asm volatile("s_waitcnt lgkmcnt(0)\n\ts_barrier":::"memory");
  #undef V2_DMA
}
constexpr int ATTN_LDS_BYTES=LDS_BYTES;
#undef SBAR
#undef WAIT_BAR
}

#ifndef USE_MFMA_ATTN
#define USE_MFMA_ATTN 1
#endif
#ifndef ATTN_V2
#define ATTN_V2 1
#endif
__device__ __forceinline__ void phase_diff_mfma(char* shm, LAS unsigned char* lds, const Ctx& a, int vcu, int G) {
    bf16* proj = (bf16*)(a.ws + WS_H); bf16* o12 = (bf16*)(a.ws + WS_STATE);
    unsigned* ctl = (unsigned*)(a.ws + WS_CTL);
    volatile LAS unsigned* qslot = (volatile LAS unsigned*)(lds + MISC_OFF) + 16;
    for (;;) {
        const int tid = otid();
        if (tid == 0) *qslot = atomicAdd(ctl + CW_QUEUE, 1u);
        __syncthreads();
        const unsigned idx = (unsigned)__builtin_amdgcn_readfirstlane((int)*qslot);
        __syncthreads();
        if (idx >= (unsigned)(NB * DIFF_H * 2 * 32)) break;
        const int qb = 31 - (int)(idx >> 5), rem = idx & 31, b = rem >> 4, h = (rem >> 1) & 7, r = rem & 1;
        const float slope2 = exp2f(-(float)(h + 1)) * LOG2E;
        int t0 = 0;
        { const unsigned* qm = ctl + CW_QKMAX + b * 64; const int g0 = (h * 128 + r * 64) >> 5;
          const float pq = __uint_as_float(qm[g0]) + __uint_as_float(qm[g0 + 1]), pk = __uint_as_float(qm[32 + g0]) + __uint_as_float(qm[32 + g0 + 1]);
          const float smax = sqrtf(pq * pk);
          const float d = (float)(qb * 256) - (152.0f + 2.1f * smax) / slope2;
          if (d > 0.f) t0 = ((int)d >> 6) & ~1;
          if (t0 > 4 * qb) t0 = 4 * qb; }
#if ATTN_V2
        attn_body::attn_unit_v2<8>(b, qb, t0, (const attn_body::bf16*)(proj + h * 128 + r * 64), (const attn_body::bf16*)(proj + 1024 + h * 128 + r * 64),
                                   (const attn_body::bf16*)(proj + 2048 + h * 128), (attn_body::bf16*)(o12 + r * 1024 + h * 128), slope2, shm);
#else
#pragma nounroll
        for (int vh = 0; vh < 2; ++vh)
            attn_body::attn_unit<8>(b, qb, t0, (const attn_body::bf16*)(proj + h * 128 + r * 64), (const attn_body::bf16*)(proj + 1024 + h * 128 + r * 64),
                                    (const attn_body::bf16*)(proj + 2048 + h * 128 + vh * 64), (attn_body::bf16*)(o12 + r * 1024 + h * 128 + vh * 64), slope2, shm);
#endif
    }
}
__device__ __forceinline__ void phase_diff_combine(const Ctx& a, const LayerP& P, int vcu, int G) {
    const int tid = otid(), lane = tid & 63, wave = tid >> 6;
    bf16* proj = (bf16*)(a.ws + WS_H); const bf16* o12 = (const bf16*)(a.ws + WS_STATE);
    float lam;
    { float s1 = 0.f, s2 = 0.f;
      for (int i = 0; i < 64; ++i) { s1 += P.e0[i] * P.e1[i]; s2 += P.e2[i] * P.e3[i]; }
      lam = __expf(s1) - __expf(s2) + LAMBDA_INIT; }
    const int h = lane >> 3, sub = lane & 7;
    float hn[16];
#pragma unroll
    for (int j = 0; j < 16; ++j) hn[j] = P.e4[sub * 16 + j] * (1.0f - LAMBDA_INIT);
    const int gw = vcu * NWAVES + wave, NGW = G * NWAVES;
    for (int row = gw; row < NTOK; row += NGW) {
        const bf16* p1 = o12 + (size_t)row * 2048 + h * 128 + sub * 16;
        const v4u a0 = *(const v4u*)p1, a1 = *(const v4u*)(p1 + 8), b0 = *(const v4u*)(p1 + 1024), b1 = *(const v4u*)(p1 + 1032);
        const unsigned aw[8] = {a0.x, a0.y, a0.z, a0.w, a1.x, a1.y, a1.z, a1.w}, bw[8] = {b0.x, b0.y, b0.z, b0.w, b1.x, b1.y, b1.z, b1.w};
        float o[16]; float ss = 0.f;
#pragma unroll
        for (int j = 0; j < 8; ++j) { o[2 * j] = bflo(aw[j]) - lam * bflo(bw[j]); o[2 * j + 1] = bfhi(aw[j]) - lam * bfhi(bw[j]); ss += o[2 * j] * o[2 * j] + o[2 * j + 1] * o[2 * j + 1]; }
        ss += __shfl_xor(ss, 1); ss += __shfl_xor(ss, 2); ss += __shfl_xor(ss, 4);
        const float rs = 1.0f / sqrtf(ss * (1.0f / 128.0f) + EPS);
        v4u w0, w1;
        w0.x = pk2(o[0] * rs * hn[0], o[1] * rs * hn[1]); w0.y = pk2(o[2] * rs * hn[2], o[3] * rs * hn[3]); w0.z = pk2(o[4] * rs * hn[4], o[5] * rs * hn[5]); w0.w = pk2(o[6] * rs * hn[6], o[7] * rs * hn[7]);
        w1.x = pk2(o[8] * rs * hn[8], o[9] * rs * hn[9]); w1.y = pk2(o[10] * rs * hn[10], o[11] * rs * hn[11]); w1.z = pk2(o[12] * rs * hn[12], o[13] * rs * hn[13]); w1.w = pk2(o[14] * rs * hn[14], o[15] * rs * hn[15]);
        bf16* op = proj + (size_t)row * DIFF_PITCH + h * 128 + sub * 16;
        *(v4u*)op = w0; *(v4u*)(op + 8) = w1;
    }
}

typedef short mbf16x8 __attribute__((ext_vector_type(8)));
typedef short ms16x4 __attribute__((ext_vector_type(4)));
typedef float mf32x16 __attribute__((ext_vector_type(16)));
#define MFMA32(a, b, c) __builtin_amdgcn_mfma_f32_32x32x16_bf16(a, b, c, 0, 0, 0)
__device__ __forceinline__ int crow32(int r, int hi) { return (r & 3) + 8 * (r >> 2) + 4 * hi; }
__device__ __forceinline__ mbf16x8 frag_rk(const LAS unsigned char* base, int stride, int row0, int k0, int lane) {
    return *(const LAS mbf16x8*)(base + (row0 + (lane & 31)) * stride + (k0 + 8 * (lane >> 5)) * 2);
}
__device__ __forceinline__ mbf16x8 frag_kn(const LAS unsigned char* base, int stride, int k0, int n0, int lane) {
    const int i = lane & 15, g = lane >> 4;
    const LAS unsigned char* p = base + (k0 + 8 * (g >> 1) + (i >> 2)) * stride + (n0 + 16 * (g & 1) + 4 * (i & 3)) * 2;
    const ms16x4 lo = __builtin_bit_cast(ms16x4, __builtin_amdgcn_ds_read_tr16_b64_v4i16((LAS ms16x4*)p));
    const ms16x4 hi = __builtin_bit_cast(ms16x4, __builtin_amdgcn_ds_read_tr16_b64_v4i16((LAS ms16x4*)(p + 4 * stride)));
    return (mbf16x8){lo[0], lo[1], lo[2], lo[3], hi[0], hi[1], hi[2], hi[3]};
}
__device__ __forceinline__ mf32x16 zero16() { mf32x16 z;
#pragma unroll
    for (int r = 0; r < 16; ++r) z[r] = 0.f; return z; }

__device__ __forceinline__ void phase_sgu_mfma(LAS unsigned char* lds, const Ctx& a, const LayerP& P, int vcu, int G, bool dummy = false) {
    const int tid = otid(), lane = tid & 63, wave = __builtin_amdgcn_readfirstlane(tid >> 6);
    bf16* proj = (bf16*)(a.ws + WS_H); const float* vssq = (const float*)(a.ws + WS_VSSQ);
    const float* v_norm = P.e1; const float* w_s = P.e2; const float* b_s = P.e3;
    constexpr int SA = 272, SV = 320, SO = 132;
    LAS unsigned char* WA = lds;
    LAS unsigned char* VV = lds + 128 * SA;
    LAS float* RS = (LAS float*)(lds + 128 * SA + 128 * SV);
    LAS float* OS = (LAS float*)lds;
    const int tm = wave & 3, nh = wave >> 2, hi = lane >> 5;
    for (int u = vcu; u < NB * (T / SGU_C) * SGU_G; u += G) {
        const int g = u % SGU_G, bc = u / SGU_G;
        const int row0 = bc * SGU_C;
        if (tid < 128) RS[tid] = row_rstd(vssq, row0 + tid);
#pragma unroll
        for (int i = 0; i < 4; ++i) { const int ch = tid + NTHR * i, r = ch >> 4, c16 = ch & 15;
            const v4u w = *(const v4u*)(proj + (size_t)(row0 + r) * SGU_PITCH + 1024 + g * 128 + c16 * 8);
            *(LAS v4u*)(VV + r * SV + c16 * 16) = w; }
        __syncthreads();
#pragma unroll
        for (int i = 0; i < 8; ++i) { const int idx = tid + NTHR * i, t = idx >> 5, s4 = (idx & 31) * 4;
            const f32x4 w = *(const f32x4*)(w_s + (size_t)g * 16384 + t * 128 + s4);
            const float x0 = (s4 + 0 <= t) ? w.x * RS[s4 + 0] : 0.f, x1 = (s4 + 1 <= t) ? w.y * RS[s4 + 1] : 0.f, x2 = (s4 + 2 <= t) ? w.z * RS[s4 + 2] : 0.f, x3 = (s4 + 3 <= t) ? w.w * RS[s4 + 3] : 0.f;
            v2u o; o.x = pk2(x0, x1); o.y = pk2(x2, x3); *(LAS v2u*)(WA + t * SA + s4 * 2) = o; }
        __syncthreads();
        mf32x16 acc0 = zero16(), acc1 = zero16();
        for (int ks = 0; ks < 2 * (tm + 1); ++ks) {
            const mbf16x8 af = frag_rk(WA, SA, 32 * tm, 16 * ks, lane);
            const mbf16x8 b0 = frag_kn(VV, SV, 16 * ks, 64 * nh, lane), b1 = frag_kn(VV, SV, 16 * ks, 64 * nh + 32, lane);
            acc0 = MFMA32(af, b0, acc0); acc1 = MFMA32(af, b1, acc1);
        }
        __syncthreads();
#pragma unroll
        for (int r = 0; r < 16; ++r) { const int row = 32 * tm + crow32(r, hi);
            OS[row * SO + 64 * nh + (lane & 31)] = acc0[r]; OS[row * SO + 64 * nh + 32 + (lane & 31)] = acc1[r]; }
        __syncthreads();
#pragma unroll
        for (int i = 0; i < 4; ++i) { const int ch = tid + NTHR * i, t = ch >> 4, c8 = (ch & 15) * 8;
            const f32x4 s0 = *(const LAS f32x4*)(OS + t * SO + c8), s1 = *(const LAS f32x4*)(OS + t * SO + c8 + 4);
            const f32x4 n0 = *(const f32x4*)(v_norm + g * 128 + c8), n1 = *(const f32x4*)(v_norm + g * 128 + c8 + 4);
            const float bs = b_s[g * 128 + t];
            bf16* up = proj + (size_t)(row0 + t) * SGU_PITCH + g * 128 + c8;
            const v4u uw = *(const v4u*)up;
            v4u o;
            o.x = pk2(bflo(uw.x) * (n0.x * s0.x + bs), bfhi(uw.x) * (n0.y * s0.y + bs)); o.y = pk2(bflo(uw.y) * (n0.z * s0.z + bs), bfhi(uw.y) * (n0.w * s0.w + bs));
            o.z = pk2(bflo(uw.z) * (n1.x * s1.x + bs), bfhi(uw.z) * (n1.y * s1.y + bs)); o.w = pk2(bflo(uw.w) * (n1.z * s1.z + bs), bfhi(uw.w) * (n1.w * s1.w + bs));
            if (dummy) *(v4u*)((bf16*)(a.ws + WS_XB) + (size_t)(row0 + t) * 1024 + g * 128 + c8) = o; else *(v4u*)up = o; }
        __syncthreads();
    }
}

__device__ __forceinline__ void phase_gla_kv_mfma(LAS unsigned char* lds, const Ctx& a, int vcu, int G) {
    const int tid = otid(), lane = tid & 63, wave = __builtin_amdgcn_readfirstlane(tid >> 6), hi = lane >> 5;
    const bf16* proj = (const bf16*)(a.ws + WS_H); bf16* state = (bf16*)(a.ws + WS_STATE); float* dec = (float*)(a.ws + WS_DEC);
    constexpr int SV = 576, SK = 320, SS = 272;
    LAS unsigned char* VV = lds;
    LAS unsigned char* KE = lds + 64 * SV;
    LAS unsigned char* ST = lds;
    LAS float* TOT = (LAS float*)(lds + 256 * SS);
    for (int u = vcu; u < NB * GLA_H * GLA_NC; u += G) {
        const int n = u % GLA_NC, bh = u / GLA_NC, h = bh % GLA_H, b = bh / GLA_H;
        const int row0 = b * T + n * GLA_C;
        GlaCum c; gla_cumsum(c, proj, row0, h, TOT, tid);
        const int cp = tid & 63, part = tid >> 6;
#pragma unroll
        for (int i = 0; i < 8; ++i) { const int t = 8 * part + i; const unsigned w = *(const unsigned*)(proj + (size_t)(row0 + t) * GLA_PITCH + 512 + h * 128 + 2 * cp);
            *(LAS unsigned*)(KE + t * SK + 4 * cp) = pk2(bflo(w) * __expf(c.tot0 - c.b0[i]), bfhi(w) * __expf(c.tot1 - c.b1[i])); }
        if (part == 0) { dec[(size_t)u * 128 + 2 * cp] = __expf(c.tot0); dec[(size_t)u * 128 + 2 * cp + 1] = __expf(c.tot1); }
#pragma unroll
        for (int i = 0; i < 4; ++i) { const int ch = tid + NTHR * i, r = ch >> 5, c16 = ch & 31;
            *(LAS v4u*)(VV + r * SV + c16 * 16) = *(const v4u*)(proj + (size_t)(row0 + r) * GLA_PITCH + 1024 + h * 256 + c16 * 8); }
        __syncthreads();
        mf32x16 acc[4];
#pragma unroll
        for (int nt = 0; nt < 4; ++nt) acc[nt] = zero16();
#pragma unroll
        for (int ks = 0; ks < 4; ++ks) { const mbf16x8 af = frag_kn(VV, SV, 16 * ks, 32 * wave, lane);
#pragma unroll
            for (int nt = 0; nt < 4; ++nt) { const mbf16x8 bfr = frag_kn(KE, SK, 16 * ks, 32 * nt, lane); acc[nt] = MFMA32(af, bfr, acc[nt]); } }
        __syncthreads();
#pragma unroll
        for (int nt = 0; nt < 4; ++nt)
#pragma unroll
            for (int r = 0; r < 16; ++r) *(LAS bf16*)(ST + (32 * wave + crow32(r, hi)) * SS + (32 * nt + (lane & 31)) * 2) = (bf16)f2bf(acc[nt][r]);
        __syncthreads();
#pragma unroll
        for (int i = 0; i < 8; ++i) { const int ch = tid + NTHR * i, vd = ch >> 4, c16 = ch & 15;
            *(v4u*)(state + ((size_t)u * 256 + vd) * 128 + c16 * 8) = *(const LAS v4u*)(ST + vd * SS + c16 * 16); }
        __syncthreads();
    }
}
__device__ __forceinline__ void phase_gla_out_mfma(LAS unsigned char* lds, const Ctx& a, const LayerP& P, int vcu, int G, bool dummy = false) {
    const int tid = otid(), lane = tid & 63, wave = __builtin_amdgcn_readfirstlane(tid >> 6), hi = lane >> 5;
    bf16* proj = (bf16*)(a.ws + WS_H); const bf16* state = (const bf16*)(a.ws + WS_STATE);
    const float* head_norm = P.e3;
    constexpr int SQ = 272, SA = 144, SV = 576, SO = 260;
    LAS unsigned char* QD = lds;
    LAS unsigned char* KI = lds + 64 * SQ;
    LAS unsigned char* AT = lds + 2 * 64 * SQ;
    LAS unsigned char* VV = lds + 2 * 64 * SQ + 64 * SA;
    LAS float* TOT = (LAS float*)(lds + 80896);
    LAS float* OS = (LAS float*)lds;
    for (int u = vcu; u < NB * GLA_H * GLA_NC; u += G) {
        const int n = u % GLA_NC, bh = u / GLA_NC, h = bh % GLA_H, b = bh / GLA_H;
        const int row0 = b * T + n * GLA_C;
        mbf16x8 sfr[8];
        { const bf16* sp = state + ((size_t)u * 256 + 32 * wave + (lane & 31)) * 128 + 8 * hi;
#pragma unroll
          for (int ks = 0; ks < 8; ++ks) sfr[ks] = *(const mbf16x8*)(sp + 16 * ks); }
        GlaCum c; gla_cumsum(c, proj, row0, h, TOT, tid);
        const int cp = tid & 63, part = tid >> 6;
#pragma unroll
        for (int i = 0; i < 8; ++i) { const int t = 8 * part + i;
            const unsigned wq = *(const unsigned*)(proj + (size_t)(row0 + t) * GLA_PITCH + h * 128 + 2 * cp);
            const unsigned wk = *(const unsigned*)(proj + (size_t)(row0 + t) * GLA_PITCH + 512 + h * 128 + 2 * cp);
            const float e0 = __expf(c.b0[i]), e1 = __expf(c.b1[i]);
            *(LAS unsigned*)(QD + t * SQ + 4 * cp) = pk2(bflo(wq) * 0.08838834764831845f * e0, bfhi(wq) * 0.08838834764831845f * e1);
            *(LAS unsigned*)(KI + t * SQ + 4 * cp) = pk2(bflo(wk) / e0, bfhi(wk) / e1); }
#pragma unroll
        for (int i = 0; i < 4; ++i) { const int ch = tid + NTHR * i, r = ch >> 5, c16 = ch & 31;
            *(LAS v4u*)(VV + r * SV + c16 * 16) = *(const v4u*)(proj + (size_t)(row0 + r) * GLA_PITCH + 1024 + h * 256 + c16 * 8); }
        __syncthreads();
        if (wave < 4) {
            const int mi = wave >> 1, ni = wave & 1;
            mf32x16 at = zero16();
            if (!(mi == 0 && ni == 1)) {
#pragma unroll
                for (int ks = 0; ks < 8; ++ks) at = MFMA32(frag_rk(QD, SQ, 32 * mi, 16 * ks, lane), frag_rk(KI, SQ, 32 * ni, 16 * ks, lane), at);
            }
#pragma unroll
            for (int r = 0; r < 16; ++r) { const int cc = 32 * mi + crow32(r, hi), ss = 32 * ni + (lane & 31);
                *(LAS bf16*)(AT + cc * SA + ss * 2) = (bf16)f2bf((ss <= cc) ? at[r] : 0.f); }
        }
        __syncthreads();
        mf32x16 acc[2]; acc[0] = zero16(); acc[1] = zero16();
#pragma unroll
        for (int ks = 0; ks < 4; ++ks) { const mbf16x8 bfr = frag_kn(VV, SV, 16 * ks, 32 * wave, lane);
            if (ks < 2) acc[0] = MFMA32(frag_rk(AT, SA, 0, 16 * ks, lane), bfr, acc[0]);
            acc[1] = MFMA32(frag_rk(AT, SA, 32, 16 * ks, lane), bfr, acc[1]); }
#pragma unroll
        for (int ks = 0; ks < 8; ++ks) { acc[0] = MFMA32(frag_rk(QD, SQ, 0, 16 * ks, lane), sfr[ks], acc[0]); acc[1] = MFMA32(frag_rk(QD, SQ, 32, 16 * ks, lane), sfr[ks], acc[1]); }
        __syncthreads();
#pragma unroll
        for (int mi = 0; mi < 2; ++mi)
#pragma unroll
            for (int r = 0; r < 16; ++r) OS[(32 * mi + crow32(r, hi)) * SO + 32 * wave + (lane & 31)] = acc[mi][r];
        __syncthreads();
#pragma unroll
        for (int p = 0; p < 4; ++p) { const int cc = p * 16 + wave * 2 + hi, c8 = (lane & 31) * 8;
            const f32x4 s0 = *(const LAS f32x4*)(OS + cc * SO + c8), s1 = *(const LAS f32x4*)(OS + cc * SO + c8 + 4);
            float ss = (s0.x * s0.x + s0.y * s0.y) + (s0.z * s0.z + s0.w * s0.w) + (s1.x * s1.x + s1.y * s1.y) + (s1.z * s1.z + s1.w * s1.w);
            ss += __shfl_xor(ss, 1); ss += __shfl_xor(ss, 2); ss += __shfl_xor(ss, 4); ss += __shfl_xor(ss, 8); ss += __shfl_xor(ss, 16);
            const float rs = __builtin_amdgcn_rsqf(ss * (1.0f / 256.0f) + EPS);
            const f32x4 n0 = *(const f32x4*)(head_norm + c8), n1 = *(const f32x4*)(head_norm + c8 + 4);
            const v4u gw = *(const v4u*)(proj + (size_t)(row0 + cc) * GLA_PITCH + 2048 + h * 256 + c8);
            const float gg[8] = {bflo(gw.x), bfhi(gw.x), bflo(gw.y), bfhi(gw.y), bflo(gw.z), bfhi(gw.z), bflo(gw.w), bfhi(gw.w)};
            const float ov[8] = {s0.x * n0.x, s0.y * n0.y, s0.z * n0.z, s0.w * n0.w, s1.x * n1.x, s1.y * n1.y, s1.z * n1.z, s1.w * n1.w};
            float o[8];
#pragma unroll
            for (int j = 0; j < 8; ++j) o[j] = ov[j] * rs * (gg[j] * __builtin_amdgcn_rcpf(1.f + __builtin_amdgcn_exp2f(-gg[j] * LOG2E)));
            v4u w; w.x = pk2(o[0], o[1]); w.y = pk2(o[2], o[3]); w.z = pk2(o[4], o[5]); w.w = pk2(o[6], o[7]);
            if (dummy) *(v4u*)((bf16*)(a.ws + WS_XB) + (size_t)(row0 + cc) * 1024 + h * 256 + c8) = w;
            else *(v4u*)(proj + (size_t)(row0 + cc) * GLA_PITCH + 1024 + h * 256 + c8) = w; }
        __syncthreads();
    }
}
#ifndef USE_MFMA_SGU
#define USE_MFMA_SGU 1
#endif
#ifndef USE_MFMA_GLA
#define USE_MFMA_GLA 1
#endif

constexpr int PH_PER_LAYER = 8, NPHASE = 4 * PH_PER_LAYER + 1;
__host__ __device__ inline bool phase_is_noop(int ph) {
    if (ph >= 4 * PH_PER_LAYER) return false;
    const int L = ph / PH_PER_LAYER, s = ph % PH_PER_LAYER;
    const bool gla = (L == 0 || L == 3), diff = (L == 1);
    return (s == 3 && !gla && !diff) || (s == 4 && !gla);
}

#ifndef PROBE_KIND
#define PROBE_KIND 0
#endif
#ifndef PROBE_REP
#define PROBE_REP 2
#endif
template <int L> __device__ __forceinline__ LayerP layer_params_ct(const CAS cfptr* in) {
    constexpr int base = (L == 0) ? 1 : (L == 1) ? 11 : (L == 2) ? 22 : 32;
    constexpr int kind = (L == 1) ? K_DIFF : (L == 2) ? K_SGU : K_GLA;
    constexpr int sh = (kind == K_DIFF) ? 1 : 0;
    LayerP p; p.kind = kind;
    p.norm1 = in[base]; p.w_in = in[base + 1];
    p.e0 = in[base + 2]; p.e1 = in[base + 3]; p.e2 = in[base + 4]; p.e3 = in[base + 5]; p.e4 = in[base + 6];
    p.w_out = in[base + 6 + sh]; p.norm2 = in[base + 7 + sh]; p.w1 = in[base + 8 + sh]; p.w2 = in[base + 9 + sh];
    p.nin = (kind == K_GLA) ? GLA_PITCH : (kind == K_DIFF) ? DIFF_PITCH : SGU_PITCH;
    p.mixoff = (kind == K_GLA) ? 1024 : 0;
    return p;
}
__device__ __forceinline__ void seam_xcd(const CAS Args* ap, LAS unsigned char* lds_k) {
#if PROBE_KIND == 1
    for (int br = 0; br < PROBE_REP; ++br)
#endif
    { XcdBarrier bb; bb.bar = (unsigned*)(ap->ws + WS_CTL) + 4096; bb.x = xb_xcc_id(); bb.st = (volatile LAS unsigned*)(lds_k + MISC_OFF) + 8; xcd_barrier(bb); }
}
#define PH_BEGIN(PK) { const int nrep_ = (PROBE_KIND == (PK) && (PK) != 0) ? PROBE_REP : 1; \
    for (int rep_ = 0; rep_ < nrep_; ++rep_) { \
    int vcu = vcu0, G = G0; asm volatile("" : "+s"(vcu), "+s"(G)); \
    LAS unsigned char* lds = lds_k; asm volatile("" : "+s"(lds)); \
    const CAS Args* ap = (const CAS Args*)__builtin_amdgcn_kernarg_segment_ptr(); asm volatile("" : "+s"(ap)); \
    Ctx args; args.in0 = ap->in[0]; args.in42 = ap->in[42]; args.out = ap->out; args.ws = ap->ws; \
    bf16* Wb = (bf16*)(args.ws + WS_W); bf16* XB = (bf16*)(args.ws + WS_XB); bf16* HB = (bf16*)(args.ws + WS_H); \
    float* SSQ = (float*)(args.ws + WS_SSQ); float* VSSQ = (float*)(args.ws + WS_VSSQ); \
    const LayerP P = layer_params_ct<L>((const CAS cfptr*)ap); \
    (void)Wb; (void)XB; (void)HB; (void)SSQ; (void)VSSQ; (void)P; (void)vcu; (void)G; (void)lds;
#define PH_END_SEAM   seam_xcd(ap, lds_k); } }
#define PH_END_NOSEAM } }

template <int L> __device__ __forceinline__ void run_layer(LAS unsigned char* lds_k, int vcu0, int G0) {
    constexpr int kind = (L == 1) ? K_DIFF : (L == 2) ? K_SGU : K_GLA;
    PH_BEGIN(5) phase_conv(lds, args, P, L, vcu, G);
    if (L == 0) { if (rep_ + 1 == nrep_) cg::this_grid().sync(); else seam_xcd(ap, lds_k); } else seam_xcd(ap, lds_k);
    PH_END_NOSEAM
    PH_BEGIN(3) { EpiIn E{kind, HB, SSQ, (kind == K_GLA) ? P.e2 : P.e0, VSSQ, (unsigned*)(args.ws + WS_CTL) + CW_QKMAX}; run_gemm(lds, XB, D, Wb + WOFF_IN, NTOK, P.nin, D, E, vcu, G); } PH_END_SEAM
    if constexpr (kind == K_GLA) {
        PH_BEGIN(4) phase_gla_kv_mfma(lds, args, vcu, G); PH_END_SEAM
        PH_BEGIN(0) phase_gla_scan(args, vcu, G); PH_END_SEAM
        PH_BEGIN(9) phase_gla_out_mfma(lds, args, P, vcu, G, rep_ + 1 < nrep_); PH_END_SEAM
    } else if constexpr (kind == K_DIFF) {
        PH_BEGIN(7)
            if (rep_ > 0) { if (blockIdx.x == 0 && otid() == 0) __hip_atomic_store((unsigned*)(ap->ws + WS_CTL) + CW_QUEUE, 0u, RLX_AGENT); seam_xcd(ap, lds_k); }
            phase_diff_mfma((char*)lds_raw, lds, args, vcu, G);
        PH_END_SEAM
        PH_BEGIN(6) phase_diff_combine(args, P, vcu, G); PH_END_SEAM
    } else {
        PH_BEGIN(10) phase_sgu_mfma(lds, args, P, vcu, G, rep_ + 1 < nrep_); PH_END_SEAM
    }
    PH_BEGIN(L == 0 ? 8 : 0) { EpiRes E{(L == 0) ? args.in0 : args.out, args.out, XB, SSQ}; run_gemm(lds, HB + P.mixoff, P.nin, Wb + WOFF_OUT, NTOK, D, D, E, vcu, G); } PH_END_SEAM
    PH_BEGIN(2) { EpiHid E{HB, SSQ}; run_gemm(lds, XB, D, Wb + WOFF_1, NTOK, FF, D, E, vcu, G); } PH_END_SEAM
    PH_BEGIN(0) { EpiRes E{args.out, args.out, XB, SSQ}; run_gemm(lds, HB, FF, Wb + WOFF_2, NTOK, D, FF, E, vcu, G); } PH_END_SEAM
}

__global__ void __launch_bounds__(NTHR, 2) trunk_fwd(Args kargs) {
    LAS unsigned char* const lds_k = (LAS unsigned char*)lds_raw;
    const int G0 = gridDim.x; const int bx = blockIdx.x;
    const int vcu0 = (G0 % 8 == 0) ? (bx % 8) * (G0 / 8) + bx / 8 : bx;
    { const int tid = threadIdx.x;
      for (int u = tid; u < (LDS_BYTES - LDSCTL_OFF) / 4; u += NTHR) ((LAS unsigned*)(lds_k + LDSCTL_OFF))[u] = 0u;
      __syncthreads();
      if ((tid & 63) == 0) ((LAS unsigned*)(lds_k + TIDTAB_OFF))[hw_slot()] = (unsigned)(tid >> 6);
      __syncthreads(); }
    (void)xcd_barrier_post((unsigned*)(kargs.ws + WS_CTL) + 4096, (volatile LAS unsigned*)(lds_k + MISC_OFF) + 8);
    run_layer<0>(lds_k, vcu0, G0);
    run_layer<1>(lds_k, vcu0, G0);
    run_layer<2>(lds_k, vcu0, G0);
    run_layer<3>(lds_k, vcu0, G0);
    { int vcu = vcu0, G = G0; asm volatile("" : "+s"(vcu), "+s"(G));
      const CAS Args* ap = (const CAS Args*)__builtin_amdgcn_kernarg_segment_ptr(); asm volatile("" : "+s"(ap));
      Ctx args; args.in0 = ap->in[0]; args.in42 = ap->in[42]; args.out = ap->out; args.ws = ap->ws;
      phase_final(args, vcu, G); }
}

extern "C" void kernel_launch(void* const* d_in, const int* in_sizes, int n_in, void* d_out, int out_size, void* d_ws, size_t ws_size, hipStream_t stream) {
    static int grid = 0;
    if (grid == 0) {
        if (n_in != 43 || in_sizes[0] != NTOK * D || out_size != NTOK * D || ws_size < WS_END) {
            fprintf(stderr, "kernel_launch: unexpected problem (n_in %d, in0 %d, out %d, ws %zu); nothing launched\n", n_in, n_in > 0 ? in_sizes[0] : -1, out_size, ws_size); grid = -1; return; }
        int dev = 0, cus = 0, per_cu = 0;
        if (hipGetDevice(&dev) != hipSuccess || hipDeviceGetAttribute(&cus, hipDeviceAttributeMultiprocessorCount, dev) != hipSuccess) { grid = -1; return; }
        if (hipFuncSetAttribute((const void*)trunk_fwd, hipFuncAttributeMaxDynamicSharedMemorySize, LDS_BYTES) != hipSuccess) { fprintf(stderr, "kernel_launch: hipFuncSetAttribute failed\n"); grid = -1; return; }
        if (hipOccupancyMaxActiveBlocksPerMultiprocessor(&per_cu, (const void*)trunk_fwd, NTHR, LDS_BYTES) != hipSuccess || per_cu < 1) { fprintf(stderr, "kernel_launch: occupancy query says %d blocks/CU\n", per_cu); per_cu = 1; }
        (void)hipGetLastError();
        grid = cus;
    }
    if (grid < 0) return;
    (void)hipMemsetAsync((char*)d_ws + WS_CTL, 0, CTL_ZERO_BYTES, stream);
    Args a{};
    for (int i = 0; i < 43; ++i) a.in[i] = (const float*)d_in[i];
    a.out = (float*)d_out; a.ws = (unsigned char*)d_ws;
    a.ph_lo = 0; a.ph_hi = 0;
    void* kargs[] = {&a};
    hipError_t e = hipLaunchCooperativeKernel((const void*)trunk_fwd, dim3(grid), dim3(NTHR), kargs, LDS_BYTES, stream);
    if (e != hipSuccess) fprintf(stderr, "kernel_launch: cooperative launch failed: %s (grid %d)\n", hipGetErrorString(e), grid);
}
```

```cpp
#include <hip/hip_runtime.h>
#include <hip/hip_cooperative_groups.h>
#include <cstdio>
#include <cstdint>
namespace cg = cooperative_groups;

#ifndef MK_ONE_LAUNCH
#define MK_ONE_LAUNCH 1
#endif

#define GAS __attribute__((address_space(1)))
#define LAS __attribute__((address_space(3)))
typedef unsigned short bf16;
typedef unsigned v4u __attribute__((ext_vector_type(4)));
typedef unsigned v2u __attribute__((ext_vector_type(2)));
typedef float f32x4 __attribute__((ext_vector_type(4)));

constexpr int NB = 2, T = 8192, D = 1024, NTOK = NB * T, FF = 4096;
constexpr float EPS = 1e-6f;
constexpr float LOG2E = 1.4426950408889634f;
constexpr int NWAVES = 8, NTHR = 512;
constexpr int K_GLA = 0, K_DIFF = 1, K_SGU = 2;
constexpr int GLA_H = 4, GLA_HK = 128, GLA_HV = 256, GLA_C = 64, GLA_NC = T / GLA_C;
constexpr int GLA_PITCH = 3584;
constexpr int DIFF_H = 8, DIFF_PITCH = 3072;
constexpr float LAMBDA_INIT = 0.35551069f;
constexpr int SGU_PITCH = 2048, SGU_C = 128, SGU_G = 8;

constexpr size_t MiB = 1u << 20;
constexpr size_t WS_CTL = 0, CTL_ZERO_BYTES = 1 * MiB;
constexpr size_t WS_SSQ = 1 * MiB;
constexpr size_t WS_VSSQ = 2 * MiB;
constexpr size_t WS_DEC = 3 * MiB;
constexpr size_t WS_W = 4 * MiB;
constexpr size_t WS_XB = 29 * MiB;
constexpr size_t WS_STATE = 61 * MiB;
constexpr size_t WS_H = 125 * MiB;
constexpr size_t WS_END = 253 * MiB;
constexpr int CW_QKMAX = 8192;
constexpr int CW_QUEUE = 8448;
constexpr size_t WOFF_IN = 0, WOFF_OUT = (size_t)3584 * 1024, WOFF_1 = WOFF_OUT + (size_t)1024 * 1024, WOFF_2 = WOFF_1 + (size_t)4096 * 1024;

constexpr int RING_BYTES = 131072, LDSCTL_OFF = RING_BYTES, MISC_OFF = LDSCTL_OFF + 320, LDS_BYTES = 147456;

#define RLX_AGENT __ATOMIC_RELAXED, __HIP_MEMORY_SCOPE_AGENT
#define LDS_WAIT() asm volatile("s_waitcnt lgkmcnt(0)" ::: "memory")
__device__ __forceinline__ unsigned f2bf(float f) { unsigned u = __builtin_bit_cast(unsigned, f); return (u + 0x7fffu + ((u >> 16) & 1u)) >> 16; }
typedef float pk_f32x2 __attribute__((ext_vector_type(2))); typedef __bf16 pk_bf16x2 __attribute__((ext_vector_type(2)));
__device__ __forceinline__ unsigned pk2(float lo, float hi) { pk_f32x2 v = {lo, hi}; pk_bf16x2 b = __builtin_convertvector(v, pk_bf16x2); return __builtin_bit_cast(unsigned, b); }
__device__ __forceinline__ float bf2f(unsigned b) { return __builtin_bit_cast(float, b << 16); }
__device__ __forceinline__ float bflo(unsigned w) { return __builtin_bit_cast(float, w << 16); }
__device__ __forceinline__ float bfhi(unsigned w) { return __builtin_bit_cast(float, w & 0xffff0000u); }
extern __shared__ __attribute__((aligned(16))) unsigned char lds_raw[];
constexpr int TIDTAB_OFF = 131072;
__device__ __forceinline__ unsigned hw_slot() { return (unsigned)__builtin_amdgcn_s_getreg((5 << 11) | 4) & 63u; }
__device__ __forceinline__ int otid() {
    const int wv = (int)((volatile __attribute__((address_space(3))) unsigned*)((__attribute__((address_space(3))) unsigned char*)lds_raw + TIDTAB_OFF))[hw_slot()];
    int ln; asm volatile("v_mbcnt_lo_u32_b32 %0, -1, 0\n\tv_mbcnt_hi_u32_b32 %0, -1, %0" : "=v"(ln));
    int t = wv * 64 + ln;
    asm volatile("" : "+v"(t)); return t; }
__device__ __forceinline__ float wave_sum(float v) {
#pragma unroll
    for (int o = 1; o < 64; o <<= 1) v += __shfl_xor(v, o);
    return v;
}
__device__ __forceinline__ float wave_max(float v) {
#pragma unroll
    for (int o = 1; o < 64; o <<= 1) v = fmaxf(v, __shfl_xor(v, o));
    return v;
}
__device__ __forceinline__ float gelu_tanh(float x) {
    const float u = 0.7978845608028654f * (x + 0.044715f * x * x * x);
    const float e = __builtin_amdgcn_exp2f(u * (2.f * LOG2E));
    return x - x * __builtin_amdgcn_rcpf(e + 1.f);
}
__device__ __forceinline__ float log_sigmoid(float z) { return fminf(z, 0.f) - 0.6931471805599453f * __builtin_amdgcn_logf(1.0f + __builtin_amdgcn_exp2f(-fabsf(z) * LOG2E)); }

#define XB_TMO      128
#define XB_XCNT(j)  (256  + 64 * (j))
#define XB_XSUB(j)  (1280 + 64 * (j))
#define XB_XGEN(j)  (2304 + 64 * (j))
#define XB_TOP      3328
#define XB_TOPGEN   3392
#define XCD_BAR_WORDS 3456
#define XB_SPIN_CAP (1u << 22)
__device__ __forceinline__ unsigned xb_ld(unsigned* p)              { return __hip_atomic_load(p, __ATOMIC_RELAXED, __HIP_MEMORY_SCOPE_AGENT); }
__device__ __forceinline__ unsigned xb_add(unsigned* p, unsigned v) { return __hip_atomic_fetch_add(p, v, __ATOMIC_RELAXED, __HIP_MEMORY_SCOPE_AGENT); }
__device__ __forceinline__ unsigned xb_xcc_id() { return (unsigned)__builtin_amdgcn_s_getreg((3 << 11) | 20) & 0xFu; }
#define XB_SPIN(cond, bar) do { unsigned _sp = 0; while (cond) { __builtin_amdgcn_s_sleep(1); \
    if ((++_sp & 255u) == 0u) { if (xb_ld(&(bar)[XB_TMO])) break; if (_sp > XB_SPIN_CAP) { atomicAdd(&(bar)[XB_TMO], 1u); break; } } } } while (0)
struct XcdBarrier { unsigned* bar; unsigned x; volatile LAS unsigned* st; };
__device__ __forceinline__ XcdBarrier xcd_barrier_post(unsigned* bar, volatile LAS unsigned* st) {
    XcdBarrier b; b.bar = bar; b.x = xb_xcc_id(); b.st = st;
    if (threadIdx.x == 0) (void)xb_add(&bar[XB_XCNT(b.x)], 1u);
    return b;
}
__device__ __forceinline__ void xcd_barrier_complete(unsigned* bar, unsigned x, unsigned& nloc, unsigned& nx) {
    const unsigned G = gridDim.x * gridDim.y * gridDim.z;
    unsigned sum, cnt, mine, sp = 0u;
    for (;;) {
        sum = 0u; cnt = 0u; mine = 0u;
#pragma unroll
        for (unsigned j = 0; j < 16; ++j) { const unsigned c = xb_ld(&bar[XB_XCNT(j)]); sum += c; cnt += (c > 0u) ? 1u : 0u; mine = (j == x) ? c : mine; }
        if (sum == G) break;
        __builtin_amdgcn_s_sleep(1);
        if ((++sp & 255u) == 0u) { if (xb_ld(&bar[XB_TMO])) break; if (sp > XB_SPIN_CAP) { atomicAdd(&bar[XB_TMO], 1u); break; } }
    }
    nloc = mine > 0u ? mine : 1u; nx = cnt > 0u ? cnt : 1u;
}
__device__ __forceinline__ void xcd_barrier(const XcdBarrier& b) {
    asm volatile("s_waitcnt vmcnt(0)" ::: "memory");
    __syncthreads();
    if (otid() == 0) {
        unsigned* bar = b.bar;
        __builtin_amdgcn_s_waitcnt(0);
        unsigned nloc = b.st[0], nx = b.st[1];
        if (nloc == 0u) { xcd_barrier_complete(bar, b.x, nloc, nx); b.st[0] = nloc; b.st[1] = nx; }
        const unsigned old = xb_add(&bar[XB_XSUB(b.x)], 1u);
        const unsigned gen = old / nloc;
        if (old + 1u == (gen + 1u) * nloc) {
            __builtin_amdgcn_fence(__ATOMIC_RELEASE, "agent");
            asm volatile("s_waitcnt vmcnt(0)" ::: "memory");
            const unsigned og = xb_add(&bar[XB_TOP], 1u);
            const unsigned tg = og / nx;
            if (og + 1u == (tg + 1u) * nx) xb_add(&bar[XB_TOPGEN], 1u);
            else XB_SPIN(xb_ld(&bar[XB_TOPGEN]) == tg, bar);
            __builtin_amdgcn_fence(__ATOMIC_ACQUIRE, "agent");
            xb_add(&bar[XB_XGEN(b.x)], 1u);
            asm volatile("s_waitcnt vmcnt(0)" ::: "memory");
        } else {
            XB_SPIN(xb_ld(&bar[XB_XGEN(b.x)]) == gen, bar);
            __builtin_amdgcn_fence(__ATOMIC_ACQUIRE, "agent");
            asm volatile("s_waitcnt vmcnt(0)" ::: "memory");
        }
    }
    __syncthreads();
}

struct Args { const float* in[43]; float* out; unsigned char* ws; int ph_lo, ph_hi; };
struct Ctx { const float* in0; const float* in42; float* out; unsigned char* ws; };
struct LayerP {
    int kind;
    const float *norm1, *w_in, *w_out, *norm2, *w1, *w2;
    const float *e0, *e1, *e2, *e3, *e4;
    int nin;
    int mixoff;
};
typedef const float* cfptr;
#define CAS __attribute__((address_space(4)))
__device__ __forceinline__ LayerP layer_params(const CAS cfptr* in, int L) {
    LayerP p;
    const int base = (L == 0) ? 1 : (L == 1) ? 11 : (L == 2) ? 22 : 32;
    p.kind = (L == 1) ? K_DIFF : (L == 2) ? K_SGU : K_GLA;
    const int sh = (p.kind == K_DIFF) ? 1 : 0;
    p.norm1 = in[base]; p.w_in = in[base + 1];
    p.e0 = in[base + 2]; p.e1 = in[base + 3]; p.e2 = in[base + 4]; p.e3 = in[base + 5]; p.e4 = in[base + 6];
    p.w_out = in[base + 6 + sh]; p.norm2 = in[base + 7 + sh]; p.w1 = in[base + 8 + sh]; p.w2 = in[base + 9 + sh];
    p.nin = (p.kind == K_GLA) ? GLA_PITCH : (p.kind == K_DIFF) ? DIFF_PITCH : SGU_PITCH;
    p.mixoff = (p.kind == K_GLA) ? 1024 : 0;
    return p;
}

__device__ __forceinline__ float row_rstd(const float* ssq, int row) {
    const f32x4* p = (const f32x4*)(ssq + (size_t)row * 16);
    const f32x4 a = p[0], b = p[1], c = p[2], d = p[3];
    const float s = ((a.x + a.y) + (a.z + a.w)) + ((b.x + b.y) + (b.z + b.w)) + ((c.x + c.y) + (c.z + c.w)) + ((d.x + d.y) + (d.z + d.w));
    return __builtin_amdgcn_rsqf(s * (1.0f / D) + EPS);
}

struct EpiIn {
    int kind; bf16* proj; const float* ssq; const float* bias;
    float* vssq;
    static constexpr bool NEEDS_RS = true;
    __device__ __forceinline__ float rowscale(int row) const { const unsigned d = (unsigned)(row - rs_row0); return (d < 256u) ? rs_tab[d] : row_rstd(ssq, row); }
    __device__ __forceinline__ float apply8(int row, int col0, const float (&v)[8], float rs) const {
        float o[8]; float part = 0.f; int pitch;
        if (kind == K_GLA) { pitch = GLA_PITCH;
            if (col0 < 3072) {
#pragma unroll
                for (int j = 0; j < 8; ++j) o[j] = v[j] * rs;
            } else {
#pragma unroll
                for (int j = 0; j < 8; ++j) o[j] = log_sigmoid(v[j] * rs + bias[col0 - 3072 + j]) * (1.0f / 16.0f);
            }
        } else if (kind == K_DIFF) { pitch = DIFF_PITCH;
            const float sc = (col0 < 1024) ? rs * (0.125f * LOG2E) : rs;
#pragma unroll
            for (int j = 0; j < 8; ++j) o[j] = v[j] * sc;
            if (col0 < 2048) {
#pragma unroll
                for (int j = 0; j < 8; ++j) part += o[j] * o[j];
            }
        } else { pitch = SGU_PITCH;
#pragma unroll
            for (int j = 0; j < 8; ++j) { o[j] = gelu_tanh(v[j] * rs + bias[col0 + j]); }
            if (col0 >= 1024) {
#pragma unroll
                for (int j = 0; j < 8; ++j) part += o[j] * o[j];
            }
        }
        v4u w; w.x = pk2(o[0], o[1]); w.y = pk2(o[2], o[3]); w.z = pk2(o[4], o[5]); w.w = pk2(o[6], o[7]);
        *(v4u*)(proj + (size_t)row * pitch + col0) = w;
        return part;
    }
    __device__ __forceinline__ void store_part(int row, int col0, int idx, float part) const {
        if (kind == K_SGU && col0 >= 1024) vssq[(size_t)row * 16 + idx] = part;
    }
    static constexpr bool GROUPMAX = true;
    unsigned* qkmax;
    const LAS float* rs_tab = nullptr; int rs_row0 = -1;
    __device__ __forceinline__ bool want_groupmax(int col0) const { return kind == K_DIFF && col0 < 2048; }
    __device__ __forceinline__ void store_groupmax(int row, int col0, float m) const {
        atomicMax(qkmax + (row >> 13) * 64 + (col0 >> 5), __float_as_uint(m * 1.01f));
    }
};
struct EpiHid {
    bf16* h; const float* ssq;
    const LAS float* rs_tab = nullptr; int rs_row0 = -1;
    static constexpr bool NEEDS_RS = true;
    __device__ __forceinline__ float rowscale(int row) const { const unsigned d = (unsigned)(row - rs_row0); return (d < 256u) ? rs_tab[d] : row_rstd(ssq, row); }
    __device__ __forceinline__ float apply8(int row, int col0, const float (&v)[8], float rs) const {
        float o[8];
#pragma unroll
        for (int j = 0; j < 8; ++j) { const float a = fmaxf(v[j] * rs, 0.f); o[j] = a * a; }
        v4u w; w.x = pk2(o[0], o[1]); w.y = pk2(o[2], o[3]); w.z = pk2(o[4], o[5]); w.w = pk2(o[6], o[7]);
        *(v4u*)(h + (size_t)row * FF + col0) = w;
        return 0.f;
    }
    __device__ __forceinline__ void store_part(int, int, int, float) const {}
    static constexpr bool GROUPMAX = false;
    __device__ __forceinline__ bool want_groupmax(int) const { return false; }
    __device__ __forceinline__ void store_groupmax(int, int, float) const {}
};
struct EpiRes {
    const float* base; float* x; bf16* xb; float* ssq;
    static constexpr bool NEEDS_RS = false;
    __device__ __forceinline__ float rowscale(int) const { return 1.f; }
    __device__ __forceinline__ float apply8(int row, int col0, const float (&v)[8], float) const {
        const size_t off = (size_t)row * D + col0;
        const f32x4 b0 = *(const f32x4*)(base + off), b1 = *(const f32x4*)(base + off + 4);
        float o[8] = {b0.x + v[0], b0.y + v[1], b0.z + v[2], b0.w + v[3], b1.x + v[4], b1.y + v[5], b1.z + v[6], b1.w + v[7]};
        *(f32x4*)(x + off) = (f32x4){o[0], o[1], o[2], o[3]}; *(f32x4*)(x + off + 4) = (f32x4){o[4], o[5], o[6], o[7]};
        v4u w; w.x = pk2(o[0], o[1]); w.y = pk2(o[2], o[3]); w.z = pk2(o[4], o[5]); w.w = pk2(o[6], o[7]);
        *(v4u*)(xb + off) = w;
        float part = 0.f;
#pragma unroll
        for (int j = 0; j < 8; ++j) part += o[j] * o[j];
        return part;
    }
    __device__ __forceinline__ void store_part(int row, int, int idx, float part) const { ssq[(size_t)row * 16 + idx] = part; }
    static constexpr bool GROUPMAX = false;
    __device__ __forceinline__ bool want_groupmax(int) const { return false; }
    __device__ __forceinline__ void store_groupmax(int, int, float) const {}
};

template <class Epi>
__device__ __forceinline__ void gemm_naive(LAS unsigned char* lds, const bf16* A, int lda, const bf16* Bt, int M, int N, int K, const Epi& E, int vcu, int G) {
    LAS float* As = (LAS float*)lds;
    LAS float* Bs = As + 64 * 33;
    const int tid = otid();
    const int nM = M / 64, nN = N / 64;
    const int r = tid >> 3, cgp = tid & 7;
    for (int u = vcu; u < nM * nN; u += G) {
        const int pm = u / nN, pn = u % nN;
        float acc[8];
#pragma unroll
        for (int j = 0; j < 8; ++j) acc[j] = 0.f;
        for (int k0 = 0; k0 < K; k0 += 32) {
            { const int lr = tid >> 3, lc = (tid & 7) * 4;
              const v2u av = *(const v2u*)(A + (size_t)(pm * 64 + lr) * lda + k0 + lc);
              const v2u bv = *(const v2u*)(Bt + (size_t)(pn * 64 + lr) * K + k0 + lc);
              As[lr * 33 + lc + 0] = bflo(av.x); As[lr * 33 + lc + 1] = bfhi(av.x); As[lr * 33 + lc + 2] = bflo(av.y); As[lr * 33 + lc + 3] = bfhi(av.y);
              Bs[lr * 33 + lc + 0] = bflo(bv.x); Bs[lr * 33 + lc + 1] = bfhi(bv.x); Bs[lr * 33 + lc + 2] = bflo(bv.y); Bs[lr * 33 + lc + 3] = bfhi(bv.y); }
            __syncthreads();
#pragma unroll 8
            for (int kk = 0; kk < 32; ++kk) { const float a = As[r * 33 + kk];
#pragma unroll
                for (int j = 0; j < 8; ++j) acc[j] += a * Bs[(cgp * 8 + j) * 33 + kk]; }
            __syncthreads();
        }
        const int row = pm * 64 + r, col0 = pn * 64 + cgp * 8;
        const float rs = E.rowscale(row);
        float part = E.apply8(row, col0, acc, rs);
        part += __shfl_xor(part, 1); part += __shfl_xor(part, 2); part += __shfl_xor(part, 4);
        if (cgp == 0) E.store_part(row, col0, pn & 15, part);
    }
}

__device__ __forceinline__ void conv_tile(const float* W, const float* gain, int K, int N, bf16* WT, int tile, LAS unsigned char* img, int tid) {
    const int nblk = N >> 7, kb = tile / nblk, nb = tile - kb * nblk, k0 = kb << 7, n0 = nb << 7;
    const int n4 = tid & 31, kk = tid >> 5;
    f32x4 w[8];
    const float* src = W + (size_t)(k0 + 8 * kk) * N + n0 + 4 * n4;
#pragma unroll
    for (int p = 0; p < 8; ++p) w[p] = *(const f32x4*)(src + (size_t)p * N);
    float g[8];
    if (gain) { const f32x4 g0 = *(const f32x4*)(gain + k0 + 8 * kk), g1 = *(const f32x4*)(gain + k0 + 8 * kk + 4);
        g[0] = g0.x; g[1] = g0.y; g[2] = g0.z; g[3] = g0.w; g[4] = g1.x; g[5] = g1.y; g[6] = g1.z; g[7] = g1.w; }
    else {
#pragma unroll
        for (int p = 0; p < 8; ++p) g[p] = 1.f; }
#pragma unroll
    for (int jn = 0; jn < 4; ++jn) {
        v4u o; o.x = pk2(g[0] * w[0][jn], g[1] * w[1][jn]); o.y = pk2(g[2] * w[2][jn], g[3] * w[3][jn]); o.z = pk2(g[4] * w[4][jn], g[5] * w[5][jn]); o.w = pk2(g[6] * w[6][jn], g[7] * w[7][jn]);
        *(LAS v4u*)(img + (4 * n4 + jn) * 256 + ((kk ^ (n4 & 15)) << 4)) = o; }
    __syncthreads();
#pragma unroll
    for (int i = 0; i < 4; ++i) { const int c = tid + NTHR * i, n = c >> 4, kc = c & 15;
        const v4u o = *(const LAS v4u*)(img + n * 256 + ((kc ^ ((n >> 2) & 15)) << 4));
        *(v4u*)(WT + (size_t)(n0 + n) * K + k0 + 8 * kc) = o; }
    __syncthreads();
}

__device__ __forceinline__ void phase_conv(LAS unsigned char* lds, const Ctx& a, const LayerP& P, int L, int vcu, int G) {
    const int tid = otid(), lane = tid & 63, wave = __builtin_amdgcn_readfirstlane(tid >> 6);
    bf16* Wb = (bf16*)(a.ws + WS_W);
    const int gw = vcu * NWAVES + wave, NGW = G * NWAVES;
    const int nin_w = (P.kind == K_SGU) ? 2048 : 3072;
    const int I_IN = (D / 128) * (nin_w / 128), I_OUT = (D / 128) * (D / 128), I_1 = (D / 128) * (FF / 128), I_2 = (FF / 128) * (D / 128);
    const int NITEMS = I_IN + I_OUT + I_1 + I_2;
    for (int it = vcu; it < NITEMS; it += G) {
        int r = it;
        if (r < I_IN) { conv_tile(P.w_in, P.norm1, D, nin_w, Wb + WOFF_IN, r, lds, tid); continue; } r -= I_IN;
        if (r < I_OUT) { conv_tile(P.w_out, nullptr, D, D, Wb + WOFF_OUT, r, lds, tid); continue; } r -= I_OUT;
        if (r < I_1) { conv_tile(P.w1, P.norm2, D, FF, Wb + WOFF_1, r, lds, tid); continue; } r -= I_1;
        conv_tile(P.w2, nullptr, FF, D, Wb + WOFF_2, r, lds, tid);
    }
    if (P.kind == K_GLA) {
        const float* W1 = P.e0; const float* W2 = P.e1;
        for (int e = vcu * NTHR + tid; e < 512 * 1024; e += G * NTHR) {
            const int n = e >> 10, k = e & 1023;
            float s = 0.f;
#pragma unroll
            for (int r = 0; r < 16; ++r) s += W1[k * 16 + r] * W2[r * 512 + n];
            Wb[WOFF_IN + (size_t)(3072 + n) * 1024 + k] = (bf16)f2bf(s * P.norm1[k]);
        }
    }
    if (L == 0) {
        const float* x = a.in0; bf16* xb = (bf16*)(a.ws + WS_XB); float* ssq = (float*)(a.ws + WS_SSQ);
        for (int m = gw; m < NTOK; m += NGW) {
            const f32x4* xr = (const f32x4*)(x + (size_t)m * D) + lane;
            f32x4 v[4]; float s = 0.f;
#pragma unroll
            for (int j = 0; j < 4; ++j) { v[j] = xr[64 * j]; s += (v[j].x * v[j].x + v[j].y * v[j].y) + (v[j].z * v[j].z + v[j].w * v[j].w); }
            s = wave_sum(s);
            v2u* o8 = (v2u*)(xb + (size_t)m * D) + lane;
#pragma unroll
            for (int j = 0; j < 4; ++j) { v2u w; w.x = pk2(v[j].x, v[j].y); w.y = pk2(v[j].z, v[j].w); o8[64 * j] = w; }
            if (lane < 16) ssq[(size_t)m * 16 + lane] = (lane == 0) ? s : 0.f;
        }
    }
}

__device__ __forceinline__ void phase_final(const Ctx& a, int vcu, int G) {
    const int tid = otid(), lane = tid & 63, wave = tid >> 6;
    const int gw = vcu * NWAVES + wave, NGW = G * NWAVES;
    const float* ssq = (const float*)(a.ws + WS_SSQ); const float* g = a.in42;
    for (int m = gw; m < NTOK; m += NGW) {
        const float rs = row_rstd(ssq, m);
        f32x4* xr = (f32x4*)(a.out + (size_t)m * D) + lane; const f32x4* gr = (const f32x4*)g + lane;
#pragma unroll
        for (int j = 0; j < 4; ++j) { f32x4 v = xr[64 * j]; const f32x4 gg = gr[64 * j]; v.x *= rs * gg.x; v.y *= rs * gg.y; v.z *= rs * gg.z; v.w *= rs * gg.w; xr[64 * j] = v; }
    }
}

struct GlaCum { float b0[8], b1[8], tot0, tot1; };
__device__ __forceinline__ void gla_cumsum(GlaCum& c, const bf16* proj, int row0, int h, LAS float* TOT, int tid) {
    const int cp = tid & 63, part = tid >> 6;
#pragma unroll
    for (int i = 0; i < 8; ++i) { const unsigned w = *(const unsigned*)(proj + (size_t)(row0 + 8 * part + i) * GLA_PITCH + 3072 + h * 128 + 2 * cp); c.b0[i] = bflo(w); c.b1[i] = bfhi(w); }
#pragma unroll
    for (int i = 1; i < 8; ++i) { c.b0[i] += c.b0[i - 1]; c.b1[i] += c.b1[i - 1]; }
    TOT[part * 128 + 2 * cp] = c.b0[7]; TOT[part * 128 + 2 * cp + 1] = c.b1[7];
    __syncthreads();
    float o0 = 0.f, o1 = 0.f, t0 = 0.f, t1 = 0.f;
#pragma unroll
    for (int p = 0; p < 8; ++p) { const float x0 = TOT[p * 128 + 2 * cp], x1 = TOT[p * 128 + 2 * cp + 1]; if (p < part) { o0 += x0; o1 += x1; } t0 += x0; t1 += x1; }
#pragma unroll
    for (int i = 0; i < 8; ++i) { c.b0[i] += o0; c.b1[i] += o1; }
    c.tot0 = t0; c.tot1 = t1;
}
__device__ __forceinline__ void phase_gla_kv(LAS unsigned char* lds, const Ctx& a, int vcu, int G) {
    const int tid = otid();
    const bf16* proj = (const bf16*)(a.ws + WS_H); bf16* state = (bf16*)(a.ws + WS_STATE); float* dec = (float*)(a.ws + WS_DEC);
    LAS float* KE = (LAS float*)lds;
    LAS float* V = KE + 64 * 128;
    LAS float* TOT = V + 64 * 256;
    for (int u = vcu; u < NB * GLA_H * GLA_NC; u += G) {
        const int n = u % GLA_NC, bh = u / GLA_NC, h = bh % GLA_H, b = bh / GLA_H;
        const int row0 = b * T + n * GLA_C;
        GlaCum c; gla_cumsum(c, proj, row0, h, TOT, tid);
        const int cp = tid & 63, part = tid >> 6;
#pragma unroll
        for (int i = 0; i < 8; ++i) { const int t = 8 * part + i; const unsigned w = *(const unsigned*)(proj + (size_t)(row0 + t) * GLA_PITCH + 512 + h * 128 + 2 * cp);
            KE[t * 128 + 2 * cp] = bflo(w) * __expf(c.tot0 - c.b0[i]); KE[t * 128 + 2 * cp + 1] = bfhi(w) * __expf(c.tot1 - c.b1[i]); }
        if (part == 0) { dec[(size_t)u * 128 + 2 * cp] = __expf(c.tot0); dec[(size_t)u * 128 + 2 * cp + 1] = __expf(c.tot1); }
        { const int vp = tid & 127, rp = tid >> 7;
#pragma unroll
          for (int i = 0; i < 16; ++i) { const int t = 16 * rp + i; const unsigned w = *(const unsigned*)(proj + (size_t)(row0 + t) * GLA_PITCH + 1024 + h * 256 + 2 * vp);
              V[t * 256 + 2 * vp] = bflo(w); V[t * 256 + 2 * vp + 1] = bfhi(w); } }
        __syncthreads();
        const int vd = tid & 255, kh = tid >> 8;
        float acc[64];
#pragma unroll
        for (int j = 0; j < 64; ++j) acc[j] = 0.f;
        for (int t = 0; t < 64; ++t) { const float v = V[t * 256 + vd];
#pragma unroll
            for (int j = 0; j < 64; ++j) acc[j] += KE[t * 128 + kh * 64 + j] * v; }
        bf16* sp = state + ((size_t)u * 256 + vd) * 128 + kh * 64;
#pragma unroll
        for (int j = 0; j < 64; j += 8) { v4u w; w.x = pk2(acc[j], acc[j + 1]); w.y = pk2(acc[j + 2], acc[j + 3]); w.z = pk2(acc[j + 4], acc[j + 5]); w.w = pk2(acc[j + 6], acc[j + 7]); *(v4u*)(sp + j) = w; }
        __syncthreads();
    }
}
__device__ __forceinline__ void phase_gla_scan(const Ctx& a, int vcu, int G) {
    unsigned* state = (unsigned*)(a.ws + WS_STATE); const float* dec = (const float*)(a.ws + WS_DEC);
    for (int gid = vcu * NTHR + otid(); gid < NB * GLA_H * 16384; gid += G * NTHR) {
        const int bh = gid >> 14, e = gid & 16383, kp = e & 63;
        unsigned* sp = state + (size_t)bh * GLA_NC * 16384 + e;
        const float* dp = dec + (size_t)bh * GLA_NC * 128 + 2 * kp;
        float s0 = 0.f, s1 = 0.f;
        for (int n0 = 0; n0 < GLA_NC; n0 += 8) {
            unsigned w[8]; float d0[8], d1[8];
#pragma unroll
            for (int i = 0; i < 8; ++i) { w[i] = sp[(size_t)(n0 + i) * 16384]; d0[i] = dp[(n0 + i) * 128]; d1[i] = dp[(n0 + i) * 128 + 1]; }
#pragma unroll
            for (int i = 0; i < 8; ++i) { sp[(size_t)(n0 + i) * 16384] = pk2(s0, s1); s0 = d0[i] * s0 + bflo(w[i]); s1 = d1[i] * s1 + bfhi(w[i]); }
        }
    }
}
__device__ __forceinline__ void phase_gla_out(LAS unsigned char* lds, const Ctx& a, const LayerP& P, int vcu, int G) {
    const int tid = otid(), lane = tid & 63, wave = tid >> 6;
    bf16* proj = (bf16*)(a.ws + WS_H); const bf16* state = (const bf16*)(a.ws + WS_STATE);
    LAS float* QD = (LAS float*)lds;
    LAS float* KI = QD + 64 * 128;
    LAS float* ATT = KI + 64 * 128;
    LAS unsigned* Vb = (LAS unsigned*)(ATT + 64 * 64);
    LAS float* TOT = (LAS float*)(Vb + 64 * 128);
    LAS float* RSS = TOT + 8 * 128;
    for (int u = vcu; u < NB * GLA_H * GLA_NC; u += G) {
        const int n = u % GLA_NC, bh = u / GLA_NC, h = bh % GLA_H, b = bh / GLA_H;
        const int row0 = b * T + n * GLA_C;
        GlaCum c; gla_cumsum(c, proj, row0, h, TOT, tid);
        const int cp = tid & 63, part = tid >> 6;
#pragma unroll
        for (int i = 0; i < 8; ++i) { const int t = 8 * part + i;
            const unsigned wq = *(const unsigned*)(proj + (size_t)(row0 + t) * GLA_PITCH + h * 128 + 2 * cp);
            const unsigned wk = *(const unsigned*)(proj + (size_t)(row0 + t) * GLA_PITCH + 512 + h * 128 + 2 * cp);
            const float e0 = __expf(c.b0[i]), e1 = __expf(c.b1[i]);
            QD[t * 128 + 2 * cp] = bflo(wq) * 0.08838834764831845f * e0; QD[t * 128 + 2 * cp + 1] = bfhi(wq) * 0.08838834764831845f * e1;
            KI[t * 128 + 2 * cp] = bflo(wk) / e0; KI[t * 128 + 2 * cp + 1] = bfhi(wk) / e1; }
        { const int vp = tid & 127, rp = tid >> 7;
#pragma unroll
          for (int i = 0; i < 16; ++i) { const int t = 16 * rp + i; Vb[t * 128 + vp] = *(const unsigned*)(proj + (size_t)(row0 + t) * GLA_PITCH + 1024 + h * 256 + 2 * vp); } }
        __syncthreads();
        { const int cc = tid >> 3, s0 = (tid & 7) * 8; float acc[8];
#pragma unroll
          for (int j = 0; j < 8; ++j) acc[j] = 0.f;
          for (int d = 0; d < 128; ++d) { const float q = QD[cc * 128 + d];
#pragma unroll
              for (int j = 0; j < 8; ++j) acc[j] += q * KI[(s0 + j) * 128 + d]; }
#pragma unroll
          for (int j = 0; j < 8; ++j) ATT[cc * 64 + s0 + j] = (s0 + j <= cc) ? acc[j] : 0.f; }
        __syncthreads();
        const int vd = tid & 255, ch = tid >> 8;
        float acc[32];
#pragma unroll
        for (int j = 0; j < 32; ++j) acc[j] = 0.f;
        for (int s = 0; s < 64; ++s) { const unsigned w = Vb[s * 128 + (vd >> 1)]; const float v = (vd & 1) ? bfhi(w) : bflo(w);
#pragma unroll
            for (int j = 0; j < 32; ++j) acc[j] += ATT[(ch * 32 + j) * 64 + s] * v; }
        { const bf16* sp = state + ((size_t)u * 256 + vd) * 128;
          for (int d0 = 0; d0 < 128; d0 += 8) { const v4u w = *(const v4u*)(sp + d0);
              const float st[8] = {bflo(w.x), bfhi(w.x), bflo(w.y), bfhi(w.y), bflo(w.z), bfhi(w.z), bflo(w.w), bfhi(w.w)};
#pragma unroll
              for (int dd = 0; dd < 8; ++dd) {
#pragma unroll
                  for (int j = 0; j < 32; ++j) acc[j] += QD[(ch * 32 + j) * 128 + d0 + dd] * st[dd]; } } }
#pragma unroll
        for (int j = 0; j < 32; ++j) { const float s = wave_sum(acc[j] * acc[j]); if (lane == 0) RSS[wave * 32 + j] = s; }
        __syncthreads();
        const float hn = P.e3[vd];
#pragma unroll
        for (int j = 0; j < 32; ++j) { const int cc = ch * 32 + j;
            const float ss = (RSS[(ch * 4 + 0) * 32 + j] + RSS[(ch * 4 + 1) * 32 + j]) + (RSS[(ch * 4 + 2) * 32 + j] + RSS[(ch * 4 + 3) * 32 + j]);
            const float rs = 1.0f / sqrtf(ss * (1.0f / 256.0f) + EPS);
            const float g = bf2f(proj[(size_t)(row0 + cc) * GLA_PITCH + 2048 + h * 256 + vd]);
            const float o = acc[j] * rs * hn * (g / (1.f + __expf(-g)));
            proj[(size_t)(row0 + cc) * GLA_PITCH + 1024 + h * 256 + vd] = (bf16)f2bf(o); }
        __syncthreads();
    }
}

__device__ __forceinline__ void phase_sgu(LAS unsigned char* lds, const Ctx& a, const LayerP& P, int vcu, int G) {
    const int tid = otid();
    bf16* proj = (bf16*)(a.ws + WS_H); const float* vssq = (const float*)(a.ws + WS_VSSQ);
    const float* v_norm = P.e1; const float* w_s = P.e2; const float* b_s = P.e3;
    LAS float* W = (LAS float*)lds;
    LAS float* V = W + 128 * 128;
    for (int u = vcu; u < NB * (T / SGU_C) * SGU_G; u += G) {
        const int g = u % SGU_G, bc = u / SGU_G;
        const int row0 = bc * SGU_C;
        for (int e = tid; e < 128 * 128; e += NTHR) { const int t = e >> 7, s = e & 127;
            const float rs = row_rstd(vssq, row0 + s);
            W[e] = (s <= t) ? w_s[(size_t)g * 16384 + e] * rs : 0.f;
            V[e] = bf2f(proj[(size_t)(row0 + t) * SGU_PITCH + 1024 + g * 128 + s]); }
        __syncthreads();
        const int d = tid & 127, tq = tid >> 7;
        float acc[32];
#pragma unroll
        for (int j = 0; j < 32; ++j) acc[j] = 0.f;
        for (int s = 0; s < 128; ++s) { const float v = V[s * 128 + d];
#pragma unroll
            for (int j = 0; j < 32; ++j) acc[j] += W[(tq + 4 * j) * 128 + s] * v; }
        const float vn = v_norm[g * 128 + d];
#pragma unroll
        for (int j = 0; j < 32; ++j) { const int t = tq + 4 * j;
            const float sv = vn * acc[j] + b_s[g * 128 + t];
            bf16* up = proj + (size_t)(row0 + t) * SGU_PITCH + g * 128 + d;
            *up = (bf16)f2bf(bf2f(*up) * sv); }
        __syncthreads();
    }
}

__device__ __forceinline__ void phase_diff(LAS unsigned char* lds, const Ctx& a, const LayerP& P, int vcu, int G) {
    const int tid = otid(), lane = tid & 63, wave = tid >> 6;
    bf16* proj = (bf16*)(a.ws + WS_H);
    LAS float* Ks = (LAS float*)lds;
    LAS float* Vs = Ks + 64 * 132;
    LAS float* Qs = Vs + 64 * 128;
    LAS float* Ps = Qs + 32 * 128;
    float lam;
    { float s1 = 0.f, s2 = 0.f;
      for (int i = 0; i < 64; ++i) { s1 += P.e0[i] * P.e1[i]; s2 += P.e2[i] * P.e3[i]; }
      lam = __expf(s1) - __expf(s2) + LAMBDA_INIT; }
    const float* head_norm = P.e4;
    const int NU = NB * DIFF_H * (T / 32);
    for (int u = vcu; u < NU; u += G) {
        const int qb = (T / 32 - 1) - (u / (NB * DIFF_H)), bh = u % (NB * DIFF_H), h = bh % DIFF_H, b = bh / DIFF_H;
        const int q0 = qb * 32; const size_t rowbase = (size_t)b * T;
        const float slope2 = exp2f(-(float)(h + 1)) * LOG2E;
        __syncthreads();
        for (int e = tid; e < 32 * 64; e += NTHR) { const int r = e >> 6, c2 = e & 63;
            const unsigned w = *(const unsigned*)(proj + (rowbase + q0 + r) * DIFF_PITCH + h * 128 + 2 * c2);
            Qs[r * 128 + 2 * c2] = bflo(w); Qs[r * 128 + 2 * c2 + 1] = bfhi(w); }
        float m1[4], l1[4], m2[4], l2[4], oa1[4], ob1[4], oa2[4], ob2[4];
#pragma unroll
        for (int i = 0; i < 4; ++i) { m1[i] = -1e30f; m2[i] = -1e30f; l1[i] = 0.f; l2[i] = 0.f; oa1[i] = 0.f; ob1[i] = 0.f; oa2[i] = 0.f; ob2[i] = 0.f; }
        const int ntile = (q0 + 31) / 64 + 1;
        for (int kt = 0; kt < ntile; ++kt) {
            __syncthreads();
            for (int e = tid; e < 64 * 64; e += NTHR) { const int r = e >> 6, c2 = e & 63;
                const unsigned wk = *(const unsigned*)(proj + (rowbase + kt * 64 + r) * DIFF_PITCH + 1024 + h * 128 + 2 * c2);
                const unsigned wv = *(const unsigned*)(proj + (rowbase + kt * 64 + r) * DIFF_PITCH + 2048 + h * 128 + 2 * c2);
                Ks[r * 132 + 2 * c2] = bflo(wk); Ks[r * 132 + 2 * c2 + 1] = bfhi(wk);
                Vs[r * 128 + 2 * c2] = bflo(wv); Vs[r * 128 + 2 * c2 + 1] = bfhi(wv); }
            __syncthreads();
            const int kpos = kt * 64 + lane;
#pragma unroll
            for (int i = 0; i < 4; ++i) {
                const int r = wave + 8 * i, qpos = q0 + r;
                if (kt * 64 > qpos) continue;
                float s1 = 0.f, s2 = 0.f;
                const LAS f32x4* qp = (const LAS f32x4*)(Qs + r * 128); const LAS f32x4* kp = (const LAS f32x4*)(Ks + lane * 132);
#pragma unroll
                for (int d = 0; d < 16; ++d) { const f32x4 q = qp[d], k = kp[d]; s1 += (q.x * k.x + q.y * k.y) + (q.z * k.z + q.w * k.w); }
#pragma unroll
                for (int d = 16; d < 32; ++d) { const f32x4 q = qp[d], k = kp[d]; s2 += (q.x * k.x + q.y * k.y) + (q.z * k.z + q.w * k.w); }
                const float bias = slope2 * (float)(qpos - kpos);
                const bool ok = kpos <= qpos;
                s1 = ok ? s1 - bias : -1e30f; s2 = ok ? s2 - bias : -1e30f;
                const float mn1 = fmaxf(m1[i], wave_max(s1)), mn2 = fmaxf(m2[i], wave_max(s2));
                const float p1 = ok ? exp2f(s1 - mn1) : 0.f, p2 = ok ? exp2f(s2 - mn2) : 0.f;
                const float a1 = exp2f(m1[i] - mn1), a2 = exp2f(m2[i] - mn2);
                l1[i] = l1[i] * a1 + wave_sum(p1); l2[i] = l2[i] * a2 + wave_sum(p2); m1[i] = mn1; m2[i] = mn2;
                Ps[wave * 128 + lane] = p1; Ps[wave * 128 + 64 + lane] = p2;
                LDS_WAIT();
                float x1 = 0.f, y1 = 0.f, x2 = 0.f, y2 = 0.f;
                for (int j = 0; j < 64; ++j) { const float pa = Ps[wave * 128 + j], pb = Ps[wave * 128 + 64 + j]; const float va = Vs[j * 128 + lane], vb = Vs[j * 128 + 64 + lane];
                    x1 += pa * va; y1 += pa * vb; x2 += pb * va; y2 += pb * vb; }
                oa1[i] = oa1[i] * a1 + x1; ob1[i] = ob1[i] * a1 + y1; oa2[i] = oa2[i] * a2 + x2; ob2[i] = ob2[i] * a2 + y2;
                LDS_WAIT();
            }
        }
#pragma unroll
        for (int i = 0; i < 4; ++i) {
            const int r = wave + 8 * i;
            const float oa = oa1[i] / l1[i] - lam * (oa2[i] / l2[i]), ob = ob1[i] / l1[i] - lam * (ob2[i] / l2[i]);
            const float ss = wave_sum(oa * oa + ob * ob);
            const float rs = (1.0f / sqrtf(ss * (1.0f / 128.0f) + EPS)) * (1.0f - LAMBDA_INIT);
            bf16* op = proj + (rowbase + q0 + r) * DIFF_PITCH + h * 128;
            op[lane] = (bf16)f2bf(oa * rs * head_norm[lane]); op[64 + lane] = (bf16)f2bf(ob * rs * head_norm[64 + lane]);
        }
    }
}

namespace pg8 {
#define PG8_LAS __attribute__((address_space(3)))
typedef unsigned short bf16_t;
typedef short bf16x8 __attribute__((ext_vector_type(8)));
typedef float f32x4 __attribute__((ext_vector_type(4)));
typedef unsigned u32x4 __attribute__((ext_vector_type(4)));
constexpr int BM = 256, BK = 64, HALF = 128, HTB = HALF * BK * 2  , STAGE_BYTES = 8 * HTB, NXCD = 8, WGM = 8;

__host__ __device__ __forceinline__ int lds_byte(int r, int c) { const int st = (r >> 4) * 2 + (c >> 5), rr = r & 15, cc = c & 31, ob = rr * 64 + cc * 2; return st * 1024 + (ob ^ (((ob >> 9) & 1) << 5)); }
__host__ __device__ __forceinline__ void stage_rc(int b, int& R, int& C) { const int st = b / 1024, sb = b % 1024, swz = sb ^ (((sb >> 9) & 1) << 5); R = (st >> 1) * 16 + swz / 64; C = (st & 1) * 32 + (swz % 64) / 2; }
__host__ __device__ __forceinline__ int perm32(int rho) { const int n = rho >> 4, i = rho & 15; return 8 * (i >> 2) + 4 * n + (i & 3); }

struct Unit { int pm, pn; };
struct Gemm { const bf16_t* A; int lda; const bf16_t* Bt; int M, N, K; };

struct StaticOrder {
    int nM, nN, nwg, G, c;
    __host__ __device__ void init(int M, int N, int G_, int c_) { nM = M / BM; nN = N / BM; nwg = nM * nN; G = G_; c = c_; }
    __host__ __device__ bool next(int i, Unit& u) const {
        const long L = (long)i * G + c; if (L >= nwg) return false;
        int wgid = (int)L; { const int q = nwg / NXCD, r = nwg % NXCD, xcd = wgid % NXCD, off = wgid / NXCD; wgid = (xcd < r ? xcd * (q + 1) : r * (q + 1) + (xcd - r) * q) + off; }
        const int nig = WGM * nN, gid = wgid / nig, fm = gid * WGM, gsz = (nM - fm) < WGM ? (nM - fm) : WGM;
        u.pm = fm + ((wgid % nig) % gsz); u.pn = (wgid % nig) / gsz; return true;
    }
    __device__ __forceinline__ void a_ready(const Unit&) const {}
    __device__ __forceinline__ void done(const Unit&) const {}
};

template <class Epi, class Sched, bool ALIGN_EPI = false, bool SP2 = false>
__device__ __forceinline__ void gemm_phase(PG8_LAS unsigned char* lds, const Gemm g, const Sched& S, const Epi& E) {
    const int tid = otid(), wid = __builtin_amdgcn_readfirstlane(tid >> 6), lane = tid & 63, wr = wid >> 2, wc = wid & 3, fr = lane & 15, fq = lane >> 4;
    const int K = g.K, nt = K / BK, lda = g.lda;
    unsigned voffA[2], voffB[2];
#pragma unroll
    for (int i = 0; i < 2; ++i) { int R, C; stage_rc(tid * 16 + i * 8192, R, C); const int Rb = Epi::PERM ? ((R & ~31) + perm32(R & 31)) : R;
        voffA[i] = (unsigned)(R * lda + C) * 2u; voffB[i] = (unsigned)(Rb * K + C) * 2u; }
    const size_t kstep = (size_t)(BK * 2);
    const size_t hstepA = (size_t)HALF * lda * 2, hstepB = (size_t)HALF * K * 2;
    const size_t tstepA = 2 * hstepA, tstepB = 2 * hstepB;
    const unsigned ldsw = (unsigned)wid * 1024u;
    const int aoff = lds_byte(wr * 64 + fr, fq * 8), boff = lds_byte(wc * 32 + fr, fq * 8);
#define PG8_SA(b, h) (((b) * 2 + (h)) * HTB)
#define PG8_SB(b, h) ((4 + (b) * 2 + (h)) * HTB)
#define PG8_STAGE(bufoff, gbase, voff) do { _Pragma("unroll") for (int _i = 0; _i < 2; ++_i) \
        __builtin_amdgcn_global_load_lds((const unsigned*)((const char*)(gbase) + (voff)[_i]), (PG8_LAS unsigned*)(lds + (bufoff) + ldsw + _i * 8192), 16, 0, 0); } while (0)
#define PG8_LDA(dst, b, h) do { _Pragma("unroll") for (int m = 0; m < 4; ++m) _Pragma("unroll") for (int k = 0; k < 2; ++k) dst[m][k] = *(const PG8_LAS bf16x8*)(lds + PG8_SA(b, h) + aoff + m * 2048 + k * 1024); } while (0)
#define PG8_LDB(dst, b, h) do { _Pragma("unroll") for (int n = 0; n < 2; ++n) _Pragma("unroll") for (int k = 0; k < 2; ++k) dst[n][k] = *(const PG8_LAS bf16x8*)(lds + PG8_SB(b, h) + boff + n * 2048 + k * 1024); } while (0)
#define PG8_MMA(ai, bj, At, Bt) do { __builtin_amdgcn_s_setprio(1); _Pragma("unroll") for (int m = 0; m < 4; ++m) _Pragma("unroll") for (int n = 0; n < 2; ++n) _Pragma("unroll") for (int k = 0; k < 2; ++k) \
        acc[ai][bj][m][n] = __builtin_amdgcn_mfma_f32_16x16x32_bf16(Bt[n][k], At[m][k], acc[ai][bj][m][n], 0, 0, 0); __builtin_amdgcn_s_setprio(0); } while (0)
#define PG8_WAIT_V(n) asm volatile("s_waitcnt vmcnt(" #n ")" ::: "memory")
#define PG8_WAIT_L(n) asm volatile("s_waitcnt lgkmcnt(" #n ")" ::: "memory")
#define PG8_BAR __builtin_amdgcn_s_barrier()
#define PG8_SCHED __builtin_amdgcn_sched_barrier(0)
    Unit cur, nxt; int ui = 0;
    if (!S.next(0, cur)) return;
    f32x4 acc[2][2][4][2];
#pragma unroll
    for (int a = 0; a < 2; ++a)
#pragma unroll
        for (int b = 0; b < 2; ++b)
#pragma unroll
            for (int m = 0; m < 4; ++m)
#pragma unroll
                for (int n = 0; n < 2; ++n) acc[a][b][m][n] = (f32x4){0.f, 0.f, 0.f, 0.f};
    bf16x8 At[4][2], B0[2][2], B1[2][2];
    const char* cA = (const char*)g.A + (size_t)cur.pm * tstepA; const char* cB = (const char*)g.Bt + (size_t)cur.pn * tstepB;
    S.a_ready(cur);
    if constexpr (SP2) {
        PG8_STAGE(PG8_SB(0, 0), cB, voffB); PG8_STAGE(PG8_SB(0, 1), cB + hstepB, voffB); PG8_STAGE(PG8_SA(0, 0), cA, voffA); PG8_STAGE(PG8_SA(0, 1), cA + hstepA, voffA);
        if (wr == 1) PG8_BAR;
        PG8_WAIT_V(2); PG8_BAR;
        PG8_STAGE(PG8_SB(1, 0), cB + kstep, voffB); PG8_STAGE(PG8_SA(1, 0), cA + kstep, voffA); PG8_STAGE(PG8_SB(1, 1), cB + hstepB + kstep, voffB);
        PG8_WAIT_V(6); PG8_BAR;
    } else {
        PG8_STAGE(PG8_SB(0, 0), cB, voffB); PG8_STAGE(PG8_SA(0, 0), cA, voffA); PG8_STAGE(PG8_SB(0, 1), cB + hstepB, voffB); PG8_STAGE(PG8_SA(0, 1), cA + hstepA, voffA);
        if (wr == 1) PG8_BAR;
        PG8_WAIT_V(4); PG8_BAR;
        PG8_STAGE(PG8_SB(1, 0), cB + kstep, voffB); PG8_STAGE(PG8_SA(1, 0), cA + kstep, voffA); PG8_STAGE(PG8_SB(1, 1), cB + hstepB + kstep, voffB);
        PG8_WAIT_V(6); PG8_BAR;
    }
    for (;;) {
        const bool has_next = S.next(ui + 1, nxt);
        const char* nA = has_next ? (const char*)g.A + (size_t)nxt.pm * tstepA : cA; const char* nB = has_next ? (const char*)g.Bt + (size_t)nxt.pn * tstepB : cB;
        for (int t = 0; t < nt; t += 2) {
            const bool last = (t == nt - 2);
            const char* a1 = cA + (size_t)(t + 1) * kstep;
            const char* a2 = last ? nA : cA + (size_t)(t + 2) * kstep; const char* b2 = last ? nB : cB + (size_t)(t + 2) * kstep;
            const char* a3 = a2 + kstep; const char* b3 = b2 + kstep;
            if (last && has_next) S.a_ready(nxt);
            if constexpr (SP2) {
            PG8_LDB(B0, 0, 0); PG8_LDB(B1, 0, 1); PG8_SCHED; PG8_LDA(At, 0, 0); PG8_STAGE(PG8_SA(1, 1), a1 + hstepA, voffA);
            PG8_WAIT_V(8); PG8_WAIT_L(0); PG8_BAR; PG8_MMA(0, 0, At, B0); PG8_MMA(0, 1, At, B1); PG8_BAR; PG8_SCHED;
            PG8_LDA(At, 0, 1); PG8_STAGE(PG8_SB(0, 0), b2, voffB); PG8_STAGE(PG8_SB(0, 1), b2 + hstepB, voffB); PG8_STAGE(PG8_SA(0, 0), a2, voffA);
            PG8_WAIT_V(8); PG8_WAIT_L(0); PG8_BAR; PG8_MMA(1, 0, At, B0); PG8_MMA(1, 1, At, B1); PG8_BAR; PG8_SCHED;
            PG8_LDB(B0, 1, 0); PG8_LDB(B1, 1, 1); PG8_SCHED; PG8_LDA(At, 1, 0); PG8_STAGE(PG8_SA(0, 1), a2 + hstepA, voffA);
            PG8_WAIT_V(8); PG8_WAIT_L(0); PG8_BAR; PG8_MMA(0, 0, At, B0); PG8_MMA(0, 1, At, B1); PG8_BAR; PG8_SCHED;
            PG8_LDA(At, 1, 1); PG8_STAGE(PG8_SB(1, 0), b3, voffB); PG8_STAGE(PG8_SB(1, 1), b3 + hstepB, voffB); PG8_STAGE(PG8_SA(1, 0), a3, voffA);
            PG8_WAIT_V(8); PG8_WAIT_L(0); PG8_BAR; PG8_MMA(1, 0, At, B0); PG8_MMA(1, 1, At, B1); PG8_BAR; PG8_SCHED;
            } else {
            PG8_LDB(B0, 0, 0); PG8_SCHED; PG8_LDA(At, 0, 0); PG8_STAGE(PG8_SA(1, 1), a1 + hstepA, voffA);
            PG8_WAIT_L(8); PG8_BAR; PG8_WAIT_L(0); PG8_MMA(0, 0, At, B0); PG8_BAR; PG8_SCHED;
            PG8_LDB(B1, 0, 1); PG8_STAGE(PG8_SB(0, 0), b2, voffB);
            PG8_BAR; PG8_WAIT_L(0); PG8_MMA(0, 1, At, B1); PG8_BAR;
            PG8_LDA(At, 0, 1); PG8_STAGE(PG8_SA(0, 0), a2, voffA);
            PG8_BAR; PG8_WAIT_L(0); PG8_MMA(1, 0, At, B0); PG8_BAR; PG8_SCHED;
            PG8_STAGE(PG8_SB(0, 1), b2 + hstepB, voffB);
            PG8_WAIT_V(6); PG8_BAR; PG8_MMA(1, 1, At, B1); PG8_BAR;
            PG8_LDB(B0, 1, 0); PG8_SCHED; PG8_LDA(At, 1, 0); PG8_STAGE(PG8_SA(0, 1), a2 + hstepA, voffA);
            PG8_WAIT_L(8); PG8_BAR; PG8_WAIT_L(0); PG8_MMA(0, 0, At, B0); PG8_BAR; PG8_SCHED;
            PG8_LDB(B1, 1, 1); PG8_STAGE(PG8_SB(1, 0), b3, voffB);
            PG8_BAR; PG8_WAIT_L(0); PG8_MMA(0, 1, At, B1); PG8_BAR;
            PG8_LDA(At, 1, 1); PG8_STAGE(PG8_SA(1, 0), a3, voffA);
            PG8_BAR; PG8_WAIT_L(0); PG8_MMA(1, 0, At, B0); PG8_BAR; PG8_SCHED;
            PG8_STAGE(PG8_SB(1, 1), b3 + hstepB, voffB);
            PG8_WAIT_V(6); PG8_BAR; PG8_MMA(1, 1, At, B1); PG8_BAR;
            }
        }
        if constexpr (ALIGN_EPI) { if (wr == 0) PG8_BAR; }
        if constexpr (!Epi::AFTER_DRAIN) { E(acc, cur, wr, wc, fr, fq); S.done(cur); }
        if (!has_next) break;
#pragma unroll
        for (int a = 0; a < 2; ++a)
#pragma unroll
            for (int b = 0; b < 2; ++b)
#pragma unroll
                for (int m = 0; m < 4; ++m)
#pragma unroll
                    for (int n = 0; n < 2; ++n) acc[a][b][m][n] = (f32x4){0.f, 0.f, 0.f, 0.f};
        cur = nxt; cA = nA; cB = nB; ++ui;
        if constexpr (ALIGN_EPI) { if (wr == 1) PG8_BAR; }
    }
    PG8_WAIT_V(0);
    if constexpr (!ALIGN_EPI) { if (wr == 0) PG8_BAR; }
    PG8_BAR;
    if constexpr (Epi::AFTER_DRAIN) { E.fused(acc, cur, wr, wc, fr, fq, lds, wid, lane); S.done(cur); }
#undef PG8_SA
#undef PG8_SB
#undef PG8_STAGE
#undef PG8_LDA
#undef PG8_LDB
#undef PG8_MMA
#undef PG8_WAIT_V
#undef PG8_WAIT_L
#undef PG8_BAR
#undef PG8_SCHED
}
}

template <class Core> struct EpiMfma {
    static constexpr bool PERM = true, AFTER_DRAIN = false;
    Core c;
    __device__ __forceinline__ void operator()(const pg8::f32x4 (&acc)[2][2][4][2], const pg8::Unit& u, int wr, int wc, int fr, int fq) const {
        float gmax[2] = {0.f, 0.f};
#pragma unroll
        for (int ai = 0; ai < 2; ++ai)
#pragma unroll
            for (int m = 0; m < 4; ++m) {
                const int row = u.pm * 256 + ai * 128 + wr * 64 + m * 16 + fr;
                const float rs = c.rowscale(row);
                float part = 0.f;
#pragma unroll
                for (int bj = 0; bj < 2; ++bj) {
                    const int col0 = u.pn * 256 + bj * 128 + wc * 32 + 8 * fq;
                    const float v[8] = {acc[ai][bj][m][0][0], acc[ai][bj][m][0][1], acc[ai][bj][m][0][2], acc[ai][bj][m][0][3],
                                        acc[ai][bj][m][1][0], acc[ai][bj][m][1][1], acc[ai][bj][m][1][2], acc[ai][bj][m][1][3]};
                    const float p = c.apply8(row, col0, v, rs);
                    part += p;
                    if (Core::GROUPMAX) { float q = p; q += __shfl_xor(q, 16); q += __shfl_xor(q, 32); gmax[bj] = fmaxf(gmax[bj], q); }
                }
                part += __shfl_xor(part, 16); part += __shfl_xor(part, 32);
                if (fq == 0) c.store_part(row, u.pn * 256, (u.pn & 3) * 4 + wc, part);
            }
        if (Core::GROUPMAX) {
#pragma unroll
            for (int bj = 0; bj < 2; ++bj) { const int colg = u.pn * 256 + bj * 128 + wc * 32;
                if (c.want_groupmax(colg)) { const float m = wave_max(gmax[bj]); if (fr == 0 && fq == 0) c.store_groupmax(u.pm * 256, colg, m); } }
        }
    }
};
#ifndef USE_MFMA_GEMM
#define USE_MFMA_GEMM 1
#endif
template <class Core>
__device__ __forceinline__ void run_gemm(LAS unsigned char* lds, const bf16* A, int lda, const bf16* Bt, int M, int N, int K, const Core& c, int vcu, int G) {
#if USE_MFMA_GEMM
    int bxo = (int)blockIdx.x; asm volatile("" : "+s"(bxo));
    pg8::Gemm g{A, lda, Bt, M, N, K}; pg8::StaticOrder S; S.init(M, N, G, bxo);
    EpiMfma<Core> E{c};
    if constexpr (Core::NEEDS_RS) {
        pg8::Unit u0;
        if (S.next(0, u0)) { LAS float* tab = (LAS float*)(lds + LDSCTL_OFF + 1024); const int t_ = otid();
            if (t_ < 256) tab[t_] = row_rstd(c.ssq, u0.pm * 256 + t_);
            E.c.rs_tab = tab; E.c.rs_row0 = u0.pm * 256; }
        __syncthreads();
    }
    pg8::gemm_phase<EpiMfma<Core>, pg8::StaticOrder, true, true>(lds, g, S, E);
#else
    gemm_naive(lds, A, lda, Bt, M, N, K, c, vcu, G);
#endif
}

#include <hip/hip_bf16.h>
#include <cmath>
namespace attn_body {
using bf16=__hip_bfloat16;
using bf16x8=__attribute__((ext_vector_type(8)))short;
using s16x4=__attribute__((ext_vector_type(4)))short;
using f32x16=__attribute__((ext_vector_type(16)))float;
using u32x4=__attribute__((ext_vector_type(4)))unsigned;
constexpr int SEQ=8192,D=64,PQ=3072,PO=2048;
constexpr int NW=8,QBLK=32,QB=QBLK*NW,KVBLK=64,NQB=SEQ/QB;
__device__ __forceinline__ int crow(int r,int hi){return (r&3)+8*(r>>2)+4*hi;}
#define SBAR() __builtin_amdgcn_sched_barrier(0)
__device__ __forceinline__ void cmask(f32x16&p0,f32x16&p1,int jb,int qrel,int hi){
  const float NEG=-INFINITY; int kb=64*jb+4*hi;
  #pragma unroll
  for(int r=0;r<16;++r){int kv=kb+(r&3)+8*(r>>2); if(kv>qrel)p0[r]=NEG; if(kv+32>qrel)p1[r]=NEG;}
}

constexpr int NSLOT=3, SLOTB=8192;
constexpr int LDS_K=0, LDS_V=NSLOT*SLOTB, LDS_WS=2*NSLOT*SLOTB, LDS_OST=LDS_WS+NW*64*4, LDS_BYTES=LDS_OST+NW*4096;
constexpr float C2=0.125f*1.4426950408889634f;
__device__ __forceinline__ void glds16(const void*gsrc,unsigned lds_dst){unsigned keep;
  asm volatile("s_mov_b32 %0, m0\n\ts_mov_b32 m0, %2\n\ts_nop 0\n\tglobal_load_lds_dwordx4 %1, off\n\ts_mov_b32 m0, %0":"=&s"(keep):"v"(gsrc),"s"(lds_dst):"memory");}
__device__ __forceinline__ float max3f(float a,float b,float c){float r;asm("v_max3_f32 %0, %1, %2, %3":"=v"(r):"v"(a),"v"(b),"v"(c));return r;}
__device__ __forceinline__ float max2f(float a,float b){float r;asm("v_max_f32_e32 %0, %1, %2":"=v"(r):"v"(a),"v"(b));return r;}
__device__ __forceinline__ float fadd_s(float a,float b){float r;asm("v_add_f32_e32 %0, %1, %2":"=v"(r):"v"(a),"v"(b));return r;}
__device__ __forceinline__ float fsub_s(float a,float b){float r;asm("v_sub_f32_e32 %0, %1, %2":"=v"(r):"v"(a),"v"(b));return r;}
typedef float f32x2_t __attribute__((ext_vector_type(2))); typedef __bf16 bf16x2_t __attribute__((ext_vector_type(2)));
__device__ __forceinline__ unsigned cvtpk_s(float lo,float hi){f32x2_t v={lo,hi};bf16x2_t b=__builtin_convertvector(v,bf16x2_t);return __builtin_bit_cast(unsigned,b);}
#define WAIT_BAR(N) asm volatile("s_waitcnt vmcnt(" #N ") lgkmcnt(0)\n\ts_barrier":::"memory")

__device__ __forceinline__ void qkt(f32x16&p0,f32x16&p1,const char*Kslot,const bf16x8*qr,const f32x16&negm,int r32,int hi){
  const char*kb=Kslot+hi*1024+r32*16;
  #pragma unroll
  for(int d0=0;d0<4;++d0){
    const bf16x8 b0=*reinterpret_cast<const bf16x8*>(kb+d0*2048);
    const bf16x8 b1=*reinterpret_cast<const bf16x8*>(kb+d0*2048+512);
    if(d0==0){p0=__builtin_amdgcn_mfma_f32_32x32x16_bf16(b0,qr[0],negm,0,0,0);p1=__builtin_amdgcn_mfma_f32_32x32x16_bf16(b1,qr[0],negm,0,0,0);}
    else{p0=__builtin_amdgcn_mfma_f32_32x32x16_bf16(b0,qr[d0],p0,0,0,0);p1=__builtin_amdgcn_mfma_f32_32x32x16_bf16(b1,qr[d0],p1,0,0,0);}}
}
typedef __attribute__((address_space(3))) const char* lds_cptr;
typedef short v4i16_t __attribute__((ext_vector_type(4)));
__device__ __forceinline__ void kload8(bf16x8*kf,lds_cptr kp){
  kf[0]=*(const __attribute__((address_space(3))) bf16x8*)(kp);      kf[1]=*(const __attribute__((address_space(3))) bf16x8*)(kp+512);
  kf[2]=*(const __attribute__((address_space(3))) bf16x8*)(kp+2048); kf[3]=*(const __attribute__((address_space(3))) bf16x8*)(kp+2560);
  kf[4]=*(const __attribute__((address_space(3))) bf16x8*)(kp+4096); kf[5]=*(const __attribute__((address_space(3))) bf16x8*)(kp+4608);
  kf[6]=*(const __attribute__((address_space(3))) bf16x8*)(kp+6144); kf[7]=*(const __attribute__((address_space(3))) bf16x8*)(kp+6656);
}
__device__ __forceinline__ void kload2(bf16x8*kf,lds_cptr kp,int j){ kf[2*j]=*(const __attribute__((address_space(3))) bf16x8*)(kp+j*2048); kf[2*j+1]=*(const __attribute__((address_space(3))) bf16x8*)(kp+j*2048+512); }
__device__ __forceinline__ s16x4 vtr(lds_cptr p){ return __builtin_bit_cast(s16x4,__builtin_amdgcn_ds_read_tr16_b64_v4i16((__attribute__((address_space(3))) v4i16_t*)p)); }
__device__ __forceinline__ float rowmax(const f32x16&p0,const f32x16&p1){
  float a=max3f(p0[0],p0[1],p1[0]),b=max3f(p0[2],p0[3],p1[1]);a=max3f(a,p1[2],p1[3]);
  #pragma unroll
  for(int r=4;r<16;r+=4){a=max3f(a,p0[r],p0[r+1]);b=max3f(b,p0[r+2],p0[r+3]);a=max3f(a,p1[r],p1[r+1]);b=max3f(b,p1[r+2],p1[r+3]);}
  const float m=max2f(a,b);
  auto rr=__builtin_amdgcn_permlane32_swap(__float_as_uint(m),__float_as_uint(m),false,false);
  return max2f(__uint_as_float(rr[0]),__uint_as_float(rr[1]));
}
__device__ __forceinline__ void pv(f32x16*o,int vb,bf16x8 pa0,bf16x8 pa1,bf16x8 pa2,bf16x8 pa3){
  #pragma unroll
  for(int d0=0;d0<2;++d0){s16x4 lo[4],hi[4];
    #pragma unroll
    for(int ks=0;ks<4;++ks){
      asm volatile("ds_read_b64_tr_b16 %0,%1 offset:%c2":"=&v"(lo[ks]):"v"(vb),"i"(d0*4096+ks*1024):"memory");
      asm volatile("ds_read_b64_tr_b16 %0,%1 offset:%c2":"=&v"(hi[ks]):"v"(vb),"i"(d0*4096+ks*1024+512):"memory");}
    asm volatile("s_waitcnt lgkmcnt(0)":::"memory");SBAR();
    #define PK(k) (bf16x8){lo[k][0],lo[k][1],lo[k][2],lo[k][3],hi[k][0],hi[k][1],hi[k][2],hi[k][3]}
    o[d0]=__builtin_amdgcn_mfma_f32_32x32x16_bf16(pa0,PK(0),o[d0],0,0,0);
    o[d0]=__builtin_amdgcn_mfma_f32_32x32x16_bf16(pa1,PK(1),o[d0],0,0,0);
    o[d0]=__builtin_amdgcn_mfma_f32_32x32x16_bf16(pa2,PK(2),o[d0],0,0,0);
    o[d0]=__builtin_amdgcn_mfma_f32_32x32x16_bf16(pa3,PK(3),o[d0],0,0,0);
    #undef PK
  }
}

#ifndef ATTN_STORE16
#define ATTN_STORE16(p,v) (*(u32x4*)(p)=(v))
#endif
template<int THRL> __device__ __forceinline__ void attn_unit(int b,int qb,int t0,const bf16*Q,const bf16*K,const bf16*V,bf16*O,float slope2,char*shm){
  const int tid=otid(),lane=tid&63,r32=lane&31,hi=lane>>5; const int wid=__builtin_amdgcn_readfirstlane(tid>>6);
  const long rowbase=(long)b*SEQ; const int q0=qb*QB;
  const bf16*Qw=Q+(rowbase+q0+wid*QBLK)*PQ;
  const bf16*Kh=K+(rowbase+(long)t0*KVBLK)*PQ,*Vh=V+(rowbase+(long)t0*KVBLK)*PQ;
  const unsigned lds0=(unsigned)(uintptr_t)shm;
  float*wsf=(float*)(shm+LDS_WS)+wid*64;
  const bf16*ksrc=Kh+(long)lane*PQ+wid*8;
  const bf16*vsrc=Vh+(long)(16*(wid&3)+(lane>>2))*PQ+(wid>>2)*32+(lane&3)*8;
  const unsigned kdst=lds0+LDS_K+wid*1024, vdst=lds0+LDS_V+wid*1024;
  #define DMA_K(t,slot) glds16(ksrc+(long)(t)*KVBLK*PQ,(unsigned)__builtin_amdgcn_readfirstlane(kdst+(slot)))
  #define DMA_V(t,slot) glds16(vsrc+(long)(t)*KVBLK*PQ,(unsigned)__builtin_amdgcn_readfirstlane(vdst+(slot)))
  const int vb0=(int)(lds0+LDS_V)+((lane>>4)&1)*32+(lane&3)*8+(4*hi+((lane&15)>>2))*64;
  const char*Kbase=shm+LDS_K; bf16x8 kf[8];
  const lds_cptr shm3=(lds_cptr)shm; const lds_cptr kp0=shm3+LDS_K+hi*1024+r32*16; const lds_cptr vp0=shm3+LDS_V+((lane>>4)&1)*32+(lane&3)*8+(4*hi+((lane&15)>>2))*64;
  const int NT=(q0+QB)/KVBLK-t0;
  DMA_K(0,0);DMA_V(0,0);DMA_K(1,SLOTB);
  bf16x8 qr[4];
  #pragma unroll
  for(int d0=0;d0<4;++d0)qr[d0]=*reinterpret_cast<const bf16x8*>(&Qw[(long)r32*PQ+d0*16+hi*8]);
  float l_reg=0.f;f32x16 o[2];o[0]=f32x16{};o[1]=f32x16{};f32x16 negm;
  _Pragma("unroll") for(int r=0;r<16;++r)negm[r]=slope2*(float)crow(r,hi);
  asm volatile("":"+v"(negm)); const float b32=32.f*slope2, step64=64.f*slope2;
  const int qrel=wid*QBLK+r32;
  #define CMASK(P0,P1,t) do{int jb_=(t)-(NT-4); if(jb_>=0)cmask(P0,P1,jb_,qrel,hi);}while(0)
  bool resc=false;
  #define START(P0,P1) do{ const float rm=rowmax(P0,P1); resc=false; \
    { const float dl=rm; \
      _Pragma("unroll") for(int r=0;r<16;++r){P0[r]=fsub_s(P0[r],dl);P1[r]=fsub_s(P1[r],dl);} \
      const float adj_=step64-dl; _Pragma("unroll") for(int r=0;r<16;++r)negm[r]+=adj_; asm volatile("":"+v"(negm)); } \
    _Pragma("unroll") for(int r=0;r<16;++r)P0[r]=__builtin_amdgcn_exp2f(P0[r]); }while(0)
  #define RESC() do{ if(resc){ asm volatile("s_waitcnt lgkmcnt(0)":::"memory"); \
      _Pragma("unroll") for(int d_=0;d_<2;++d_) _Pragma("unroll") for(int r=0;r<16;++r)o[d_][r]*=wsf[crow(r,hi)]; } }while(0)
  f32x16 pA0,pA1,pB0,pB1;
  int sl_prev=0,sl_cur=0,sl_next=SLOTB;
  #define ROT() do{sl_prev=sl_cur;sl_cur=sl_next;sl_next=(sl_next==(NSLOT-1)*SLOTB)?0:sl_next+SLOTB;}while(0)
  DMA_K(2,2*SLOTB);
  WAIT_BAR(3);
  qkt(pA0,pA1,Kbase,qr,negm,r32,hi);asm volatile("s_nop 15\n\ts_nop 7":"+v"(pA0),"+v"(pA1));
  _Pragma("unroll") for(int r=0;r<16;++r)pA1[r]+=b32;
  CMASK(pA0,pA1,0);
  START(pA0,pA1);
  _Pragma("unroll") for(int r=0;r<16;++r)pA1[r]=__builtin_amdgcn_exp2f(pA1[r]);
  WAIT_BAR(0);
  DMA_K(3,0);DMA_V(1,SLOTB);
  ROT();
  kload8(kf,kp0+sl_cur);
  WAIT_BAR(2);
  s16x4 vlo[8],vhi[8]; u32x4 pw0,pw1,pw2,pw3;
  #define PKW(P,B) cvtpk_s(P[B],P[B+1])
  #define PAF(k) __builtin_bit_cast(bf16x8,pw##k)
  #define VFR(i) (bf16x8){vlo[i][0],vlo[i][1],vlo[i][2],vlo[i][3],vhi[i][0],vhi[i][1],vhi[i][2],vhi[i][3]}
  #define PIN(x) asm volatile("":"+v"(x))
  #define MX3(a,b,c) __builtin_fmaxf(__builtin_fmaxf((a),(b)),(c))
  #define GAPA(MF,A0,A1,A2,A3,W0,W1,PW) do{ MF; sacc+=A0; sacc+=A1; sacc+=A2; sacc+=A3; PIN(sacc); W0; W1; PIN(PW); SBAR(); }while(0)
  #define EX(v) __builtin_amdgcn_exp2f(v)
  #define GAPB(MF,X,B) do{ MF; X[B]=EX(X[B]); X[B+1]=EX(X[B+1]); X[B+2]=EX(X[B+2]); X[B+3]=EX(X[B+3]); PIN(X); SBAR(); }while(0)
  #define VRD(i) do{ vlo[i]=vtr(vp_+(((i)>>2)*4096+((i)&3)*1024)); vhi[i]=vtr(vp_+(((i)>>2)*4096+((i)&3)*1024+512)); }while(0)
  #define KRD(G,j) do{ if(G){ kload2(kf,kp0+sl_next,j); SBAR(); } }while(0)
  #define STEP(C0,C1,P0,P1,t,GK,GV,GL) do{ SBAR(); \
    const lds_cptr vp_=vp0+sl_prev; \
    VRD(0); SBAR(); float sacc=(P0[0]+P0[1]); \
    GAPA(C0=__builtin_amdgcn_mfma_f32_32x32x16_bf16(kf[0],qr[0],negm,0,0,0), P0[2],P0[3],P0[4],P0[5],     pw0[0]=PKW(P0,0), pw0[1]=PKW(P0,2), pw0); \
    VRD(4); SBAR(); GAPA(C1=__builtin_amdgcn_mfma_f32_32x32x16_bf16(kf[1],qr[0],negm,0,0,0), P0[6],P0[7],P0[8],P0[9],     pw0[2]=PKW(P0,4), pw0[3]=PKW(P0,6), pw0); \
    VRD(1); SBAR(); GAPA(C0=__builtin_amdgcn_mfma_f32_32x32x16_bf16(kf[2],qr[1],C0,0,0,0),   P0[10],P0[11],P0[12],P0[13], pw1[0]=PKW(P0,8), pw1[1]=PKW(P0,10), pw1); \
    VRD(5); SBAR(); GAPA(C1=__builtin_amdgcn_mfma_f32_32x32x16_bf16(kf[3],qr[1],C1,0,0,0),   P0[14],P0[15],P1[0],P1[1],   pw1[2]=PKW(P0,12),pw1[3]=PKW(P0,14), pw1); \
    VRD(2); SBAR(); GAPA(C0=__builtin_amdgcn_mfma_f32_32x32x16_bf16(kf[4],qr[2],C0,0,0,0),   P1[2],P1[3],P1[4],P1[5],     pw2[0]=PKW(P1,0), pw2[1]=PKW(P1,2), pw2); \
    VRD(6); SBAR(); GAPA(C1=__builtin_amdgcn_mfma_f32_32x32x16_bf16(kf[5],qr[2],C1,0,0,0),   P1[6],P1[7],P1[8],P1[9],     pw2[2]=PKW(P1,4), pw2[3]=PKW(P1,6), pw2); \
    VRD(3); SBAR(); GAPA(C0=__builtin_amdgcn_mfma_f32_32x32x16_bf16(kf[6],qr[3],C0,0,0,0),   P1[10],P1[11],P1[12],P1[13], pw3[0]=PKW(P1,8), pw3[1]=PKW(P1,10), pw3); \
    VRD(7); SBAR(); GAPA(C1=__builtin_amdgcn_mfma_f32_32x32x16_bf16(kf[7],qr[3],C1,0,0,0),   P1[14],P1[15],0.f,0.f,       pw3[2]=PKW(P1,12),pw3[3]=PKW(P1,14), pw3); \
    l_reg+=sacc; \
    if(GK){DMA_K((t)+3,sl_cur);} if(GV){DMA_V((t)+1,sl_next);} \
    _Pragma("unroll") for(int r=0;r<16;++r)C1[r]+=b32; \
    CMASK(C0,C1,t); \
    { float a=MX3(C0[0],C0[1],C1[0]),b=MX3(C0[2],C0[3],C1[1]); a=MX3(a,C1[2],C1[3]); \
      _Pragma("unroll") for(int r=4;r<16;r+=4){a=MX3(a,C0[r],C0[r+1]);b=MX3(b,C0[r+2],C0[r+3]);a=MX3(a,C1[r],C1[r+1]);b=MX3(b,C1[r+2],C1[r+3]);} \
      float rm=__builtin_fmaxf(a,b); { auto rr=__builtin_amdgcn_permlane32_swap(__float_as_uint(rm),__float_as_uint(rm),false,false); rm=__builtin_fmaxf(__uint_as_float(rr[0]),__uint_as_float(rr[1])); } \
      resc=false; float adj_=step64; \
      if(__any(rm>(float)THRL)){ const float dl=__builtin_fmaxf(rm,0.f); adj_-=dl; \
        _Pragma("unroll") for(int r=0;r<16;++r){C0[r]-=dl;C1[r]-=dl;} \
        const float f=__builtin_amdgcn_exp2f(-dl); l_reg*=f; if(hi==0)wsf[r32]=f; resc=true; } \
      _Pragma("unroll") for(int r=0;r<16;++r)negm[r]+=adj_; asm volatile("":"+v"(negm)); } \
    SBAR(); \
    GAPB(o[0]=__builtin_amdgcn_mfma_f32_32x32x16_bf16(PAF(0),VFR(0),o[0],0,0,0), C0,0); \
    GAPB(o[1]=__builtin_amdgcn_mfma_f32_32x32x16_bf16(PAF(0),VFR(4),o[1],0,0,0), C0,4); \
    KRD(GL,0); GAPB(o[0]=__builtin_amdgcn_mfma_f32_32x32x16_bf16(PAF(1),VFR(1),o[0],0,0,0), C0,8); \
    KRD(GL,1); GAPB(o[1]=__builtin_amdgcn_mfma_f32_32x32x16_bf16(PAF(1),VFR(5),o[1],0,0,0), C0,12); \
    KRD(GL,2); GAPB(o[0]=__builtin_amdgcn_mfma_f32_32x32x16_bf16(PAF(2),VFR(2),o[0],0,0,0), C1,0); \
    KRD(GL,3); GAPB(o[1]=__builtin_amdgcn_mfma_f32_32x32x16_bf16(PAF(2),VFR(6),o[1],0,0,0), C1,4); \
    GAPB(o[0]=__builtin_amdgcn_mfma_f32_32x32x16_bf16(PAF(3),VFR(3),o[0],0,0,0), C1,8); \
    GAPB(o[1]=__builtin_amdgcn_mfma_f32_32x32x16_bf16(PAF(3),VFR(7),o[1],0,0,0), C1,12); \
    }while(0)
  int t=1;
  #undef CMASK
  #define CMASK(P0,P1,t) do{}while(0)
  for(;t+5<NT;t+=2){
    STEP(pB0,pB1,pA0,pA1,t,true,true,true);     WAIT_BAR(2); RESC(); ROT();
    STEP(pA0,pA1,pB0,pB1,t+1,true,true,true);   WAIT_BAR(2); RESC(); ROT();
  }
  #undef CMASK
  #define CMASK(P0,P1,t) do{int jb_=(t)-(NT-4); if(jb_>=0)cmask(P0,P1,jb_,qrel,hi);}while(0)
  #define ENDW(tt) do{ if((tt)+3<NT){WAIT_BAR(2);} else if((tt)+2<NT){WAIT_BAR(1);} else {WAIT_BAR(0);} }while(0)
  for(;t+1<NT;t+=2){
    STEP(pB0,pB1,pA0,pA1,t,(t+3<NT),(t+1<NT),(t+1<NT));       ENDW(t);   RESC(); ROT();
    STEP(pA0,pA1,pB0,pB1,t+1,(t+4<NT),(t+2<NT),(t+2<NT));     ENDW(t+1); RESC(); ROT();
  }
  STEP(pB0,pB1,pA0,pA1,NT-1,false,false,false); RESC();
  { float sacc=pB0[0]+pB0[1]; _Pragma("unroll") for(int r=2;r<16;++r)sacc+=pB0[r]; _Pragma("unroll") for(int r=0;r<16;++r)sacc+=pB1[r]; l_reg+=sacc;
    pw0=(u32x4){PKW(pB0,0),PKW(pB0,2),PKW(pB0,4),PKW(pB0,6)};pw1=(u32x4){PKW(pB0,8),PKW(pB0,10),PKW(pB0,12),PKW(pB0,14)};pw2=(u32x4){PKW(pB1,0),PKW(pB1,2),PKW(pB1,4),PKW(pB1,6)};pw3=(u32x4){PKW(pB1,8),PKW(pB1,10),PKW(pB1,12),PKW(pB1,14)};
    SBAR(); pv(o,vb0+sl_cur,PAF(0),PAF(1),PAF(2),PAF(3)); }
  #undef PKW
  #undef PAF
  #undef VFR
  #undef PIN
  #undef MX3
  #undef GAPA
  #undef GAPB
  #undef EX
  #undef VRD
  #undef KRD
  #undef STEP
  #undef ENDW
  {auto rr=__builtin_amdgcn_permlane32_swap(__float_as_uint(l_reg),__float_as_uint(l_reg),false,false);l_reg=__uint_as_float(rr[0])+__uint_as_float(rr[1]);}
  if(hi==0)wsf[32+r32]=l_reg;asm volatile("s_waitcnt lgkmcnt(0)":::"memory");
  float rli[16];
  #pragma unroll
  for(int r=0;r<16;++r)rli[r]=__builtin_amdgcn_rcpf(wsf[32+crow(r,hi)]);
  bf16*Ow=O+(rowbase+q0+wid*QBLK)*PO;
  { bf16*stg=(bf16*)(shm+LDS_OST)+wid*2048;
    #pragma unroll
    for(int r=0;r<16;++r){const int orow=crow(r,hi);
      #pragma unroll
      for(int d0=0;d0<2;++d0)stg[orow*64+d0*32+r32]=__float2bfloat16(o[d0][r]*rli[r]);}
    asm volatile("s_waitcnt lgkmcnt(0)":::"memory");
    #pragma unroll
    for(int i=0;i<4;++i){const int row=i*8+(lane>>3),ch=lane&7; const u32x4 v=*(const u32x4*)(stg+row*64+ch*8); ATTN_STORE16(Ow+(long)row*PO+ch*8,v);} }
  asm volatile("s_waitcnt lgkmcnt(0)\n\ts_barrier":::"memory");
  #undef DMA_K
  #undef DMA_V
  #undef CMASK
  #undef START
  #undef RESC
  #undef ROT
}

namespace v2 {
constexpr int NSL=4, KSLOT=8192, VSLOT=16384, LDS_K2=0, LDS_V2=NSL*KSLOT, LDS_WS2=LDS_V2+NSL*VSLOT, LDS_BYTES2=LDS_WS2+NW*64*4;
#define V2_WAIT_BAR(N) asm volatile("s_waitcnt vmcnt(" #N ") lgkmcnt(0)\n\ts_barrier":::"memory")
#define V2_MX3(a,b,c) __builtin_fmaxf(__builtin_fmaxf((a),(b)),(c))
}
template<int THRL> __device__ __forceinline__ void attn_unit_v2(int b,int qb,int t0,const bf16*Q,const bf16*K,const bf16*V,bf16*O,float slope2,char*shm){
  using namespace v2;
  const int tid=otid(),lane=tid&63,r32=lane&31,hi=lane>>5; const int wid=__builtin_amdgcn_readfirstlane(tid>>6);
  const long rowbase=(long)b*SEQ; const int q0=qb*QB;
  const bf16*Qw=Q+(rowbase+q0+wid*QBLK)*PQ;
  const bf16*Kh=K+(rowbase+(long)t0*KVBLK)*PQ,*Vh=V+(rowbase+(long)t0*KVBLK)*PQ;
  const unsigned lds0=(unsigned)(uintptr_t)shm;
  float*wsf=(float*)(shm+LDS_WS2)+wid*64;
  const bf16*ksrc=Kh+(long)lane*PQ+wid*8;
  const int pi0=2*wid, pi1=2*wid+1;
  const bf16*vsrc0=Vh+(long)(16*(pi0&3)+(lane>>2))*PQ+(pi0>>2)*32+(lane&3)*8;
  const bf16*vsrc1=Vh+(long)(16*(pi1&3)+(lane>>2))*PQ+(pi1>>2)*32+(lane&3)*8;
  const unsigned kdst=lds0+LDS_K2+wid*1024, vdst0=lds0+LDS_V2+pi0*1024, vdst1=lds0+LDS_V2+pi1*1024;
  #define V2_DMA(t,sl) do{ glds16(ksrc+(long)(t)*KVBLK*PQ,(unsigned)__builtin_amdgcn_readfirstlane(kdst+(sl)*KSLOT)); \
      glds16(vsrc0+(long)(t)*KVBLK*PQ,(unsigned)__builtin_amdgcn_readfirstlane(vdst0+(sl)*VSLOT)); \
      glds16(vsrc1+(long)(t)*KVBLK*PQ,(unsigned)__builtin_amdgcn_readfirstlane(vdst1+(sl)*VSLOT)); }while(0)
  const int NT=(q0+QB)/KVBLK-t0;
  V2_DMA(0,0); V2_DMA(1,1);
  bf16x8 qr[4];
  #pragma unroll
  for(int d0=0;d0<4;++d0)qr[d0]=*reinterpret_cast<const bf16x8*>(&Qw[(long)r32*PQ+d0*16+hi*8]);
  float l_reg=0.f; f32x16 o[4];
  #pragma unroll
  for(int d0=0;d0<4;++d0)o[d0]=f32x16{};
  f32x16 negm;
  #pragma unroll
  for(int r=0;r<16;++r)negm[r]=slope2*(float)crow(r,hi);
  const float b32=32.f*slope2, step64=64.f*slope2;
  const int qrel=wid*QBLK+r32;
  const lds_cptr shm3=(lds_cptr)shm; const lds_cptr kp0=shm3+LDS_K2+hi*1024+r32*16; const lds_cptr vp0=shm3+LDS_V2+((lane>>4)&1)*32+(lane&3)*8+(4*hi+((lane&15)>>2))*64;
  f32x16 p0,p1; u32x4 pw0,pw1,pw2,pw3, qw0,qw1,qw2,qw3;
  #define V2_PIN(x) asm volatile("":"+v"(x))
  #define V2_VRD(dst,d0) do{ _Pragma("unroll") for(int ks=0;ks<4;++ks){ dst[2*ks]=vtr(vp+(d0)*4096+ks*1024); dst[2*ks+1]=vtr(vp+(d0)*4096+ks*1024+512);} }while(0)
  #define V2_VF(src,ks) (bf16x8){src[2*(ks)][0],src[2*(ks)][1],src[2*(ks)][2],src[2*(ks)][3],src[2*(ks)+1][0],src[2*(ks)+1][1],src[2*(ks)+1][2],src[2*(ks)+1][3]}
  #define V2_QK(t) do{ const lds_cptr kp=kp0+((t)&3)*KSLOT; bf16x8 kf[8]; \
      _Pragma("unroll") for(int d0=0;d0<4;++d0){ kf[2*d0]=*(const __attribute__((address_space(3))) bf16x8*)(kp+d0*2048); kf[2*d0+1]=*(const __attribute__((address_space(3))) bf16x8*)(kp+d0*2048+512); } \
      SBAR(); \
      p0=__builtin_amdgcn_mfma_f32_32x32x16_bf16(kf[0],qr[0],negm,0,0,0); p1=__builtin_amdgcn_mfma_f32_32x32x16_bf16(kf[1],qr[0],negm,0,0,0); \
      _Pragma("unroll") for(int d0=1;d0<4;++d0){ p0=__builtin_amdgcn_mfma_f32_32x32x16_bf16(kf[2*d0],qr[d0],p0,0,0,0); p1=__builtin_amdgcn_mfma_f32_32x32x16_bf16(kf[2*d0+1],qr[d0],p1,0,0,0); } \
      SBAR(); }while(0)
  bool resc=false;
  #define V2_DECIDE(t,FIRST) do{ \
      _Pragma("unroll") for(int r=0;r<16;++r)p1[r]+=b32; \
      { const int jb=(t)-(NT-4); if(jb>=0)cmask(p0,p1,jb,qrel,hi); } \
      float rm; \
      { float a=V2_MX3(p0[0],p0[1],p1[0]),c=V2_MX3(p0[2],p0[3],p1[1]); a=V2_MX3(a,p1[2],p1[3]); \
        _Pragma("unroll") for(int r=4;r<16;r+=4){a=V2_MX3(a,p0[r],p0[r+1]);c=V2_MX3(c,p0[r+2],p0[r+3]);a=V2_MX3(a,p1[r],p1[r+1]);c=V2_MX3(c,p1[r+2],p1[r+3]);} \
        rm=__builtin_fmaxf(a,c); auto rr=__builtin_amdgcn_permlane32_swap(__float_as_uint(rm),__float_as_uint(rm),false,false); rm=__builtin_fmaxf(__uint_as_float(rr[0]),__uint_as_float(rr[1])); } \
      float adj=step64; resc=false; \
      if(FIRST){ _Pragma("unroll") for(int r=0;r<16;++r){p0[r]-=rm;p1[r]-=rm;} adj-=rm; } \
      else if(__any(rm>(float)THRL)){ const float dl=__builtin_fmaxf(rm,0.f); \
        _Pragma("unroll") for(int r=0;r<16;++r){p0[r]-=dl;p1[r]-=dl;} \
        adj-=dl; const float f=__builtin_amdgcn_exp2f(-dl); l_reg*=f; if(hi==0)wsf[r32]=f; resc=true; } \
      _Pragma("unroll") for(int r=0;r<16;++r)negm[r]+=adj; \
      SBAR(); }while(0)
  float sacc;
  #define V2_GRP(d0,ks,src,P,B,QW,WI) do{ o[d0]=__builtin_amdgcn_mfma_f32_32x32x16_bf16(__builtin_bit_cast(bf16x8,pw##ks),V2_VF(src,ks),o[d0],0,0,0); \
      P[B]=__builtin_amdgcn_exp2f(P[B]); P[B+1]=__builtin_amdgcn_exp2f(P[B+1]); sacc+=P[B]; sacc+=P[B+1]; QW[WI]=cvtpk_s(P[B],P[B+1]); V2_PIN(sacc); V2_PIN(QW); SBAR(); }while(0)
  #define V2_SYNC(t) do{ if((t)+1<NT){ V2_WAIT_BAR(3); } else { V2_WAIT_BAR(0); } if((t)+2<NT){ V2_DMA((t)+2,((t)+2)&3); } }while(0)
  V2_SYNC(0); V2_QK(0); V2_DECIDE(0,true);
  sacc=0.f;
  #pragma unroll
  for(int r=0;r<16;++r){p0[r]=__builtin_amdgcn_exp2f(p0[r]);p1[r]=__builtin_amdgcn_exp2f(p1[r]);sacc+=p0[r]+p1[r];}
  l_reg+=sacc;
  pw0=(u32x4){cvtpk_s(p0[0],p0[1]),cvtpk_s(p0[2],p0[3]),cvtpk_s(p0[4],p0[5]),cvtpk_s(p0[6],p0[7])};
  pw1=(u32x4){cvtpk_s(p0[8],p0[9]),cvtpk_s(p0[10],p0[11]),cvtpk_s(p0[12],p0[13]),cvtpk_s(p0[14],p0[15])};
  pw2=(u32x4){cvtpk_s(p1[0],p1[1]),cvtpk_s(p1[2],p1[3]),cvtpk_s(p1[4],p1[5]),cvtpk_s(p1[6],p1[7])};
  pw3=(u32x4){cvtpk_s(p1[8],p1[9]),cvtpk_s(p1[10],p1[11]),cvtpk_s(p1[12],p1[13]),cvtpk_s(p1[14],p1[15])};
  for(int t=1;t<NT;++t){
    V2_SYNC(t);
    const lds_cptr vp=vp0+((t-1)&3)*VSLOT; s16x4 va[8],vb[8];
    V2_VRD(va,0);
    V2_QK(t); V2_DECIDE(t,false);
    sacc=0.f;
    V2_VRD(vb,1);
    V2_GRP(0,0,va,p0,0,qw0,0); V2_GRP(0,1,va,p0,2,qw0,1); V2_GRP(0,2,va,p0,4,qw0,2); V2_GRP(0,3,va,p0,6,qw0,3);
    V2_VRD(va,2);
    V2_GRP(1,0,vb,p0,8,qw1,0); V2_GRP(1,1,vb,p0,10,qw1,1); V2_GRP(1,2,vb,p0,12,qw1,2); V2_GRP(1,3,vb,p0,14,qw1,3);
    V2_VRD(vb,3);
    V2_GRP(2,0,va,p1,0,qw2,0); V2_GRP(2,1,va,p1,2,qw2,1); V2_GRP(2,2,va,p1,4,qw2,2); V2_GRP(2,3,va,p1,6,qw2,3);
    V2_GRP(3,0,vb,p1,8,qw3,0); V2_GRP(3,1,vb,p1,10,qw3,1); V2_GRP(3,2,vb,p1,12,qw3,2); V2_GRP(3,3,vb,p1,14,qw3,3);
    l_reg+=sacc;
    if(resc){ asm volatile("s_waitcnt lgkmcnt(0)":::"memory");
      #pragma unroll
      for(int r=0;r<16;++r){ const float fr_=wsf[crow(r,hi)];
        #pragma unroll
        for(int d0=0;d0<4;++d0)o[d0][r]*=fr_; }
      asm volatile("s_waitcnt lgkmcnt(0)":::"memory"); }
    pw0=qw0; pw1=qw1; pw2=qw2; pw3=qw3;
  }
  { const lds_cptr vp=vp0+((NT-1)&3)*VSLOT; s16x4 va[8],vb[8];
    #define V2_PV(d0,src) do{ o[d0]=__builtin_amdgcn_mfma_f32_32x32x16_bf16(__builtin_bit_cast(bf16x8,pw0),V2_VF(src,0),o[d0],0,0,0); \
        o[d0]=__builtin_amdgcn_mfma_f32_32x32x16_bf16(__builtin_bit_cast(bf16x8,pw1),V2_VF(src,1),o[d0],0,0,0); \
        o[d0]=__builtin_amdgcn_mfma_f32_32x32x16_bf16(__builtin_bit_cast(bf16x8,pw2),V2_VF(src,2),o[d0],0,0,0); \
        o[d0]=__builtin_amdgcn_mfma_f32_32x32x16_bf16(__builtin_bit_cast(bf16x8,pw3),V2_VF(src,3),o[d0],0,0,0); }while(0)
    V2_VRD(va,0); V2_VRD(vb,1); V2_PV(0,va); V2_VRD(va,2); V2_PV(1,vb); V2_VRD(vb,3); V2_PV(2,va); V2_PV(3,vb);
    #undef V2_PV
  }
  #undef V2_PIN
  #undef V2_VRD
  #undef V2_VF
  #undef V2_QK
  #undef V2_DECIDE
  #undef V2_GRP
  #undef V2_SYNC
  {auto rr=__builtin_amdgcn_permlane32_swap(__float_as_uint(l_reg),__float_as_uint(l_reg),false,false);l_reg=__uint_as_float(rr[0])+__uint_as_float(rr[1]);}
  if(hi==0)wsf[32+r32]=l_reg;asm volatile("s_waitcnt lgkmcnt(0)":::"memory");
  float rli[16];
  #pragma unroll
  for(int r=0;r<16;++r)rli[r]=__builtin_amdgcn_rcpf(wsf[32+crow(r,hi)]);
  asm volatile("s_waitcnt lgkmcnt(0)\n\ts_barrier":::"memory");
  bf16*Ow=O+(rowbase+q0+wid*QBLK)*PO;
  { bf16*stg=(bf16*)shm+wid*4096;
    #pragma unroll
    for(int r=0;r<16;++r){const int orow=crow(r,hi);
      #pragma unroll
      for(int d0=0;d0<4;++d0)stg[orow*128+d0*32+r32]=__float2bfloat16(o[d0][r]*rli[r]);}
    asm volatile("s_waitcnt lgkmcnt(0)":::"memory");
    #pragma unroll
    for(int i=0;i<8;++i){const int row=i*4+(lane>>4),ch=lane&15; const u32x4 v=*(const u32x4*)(stg+row*128+ch*8); *(u32x4*)(Ow+(long)row*PO+ch*8)=v;} }
  asm volatile("s_waitcnt lgkmcnt(0)\n\ts_barrier":::"memory");
  #undef V2_DMA
}
constexpr int ATTN_LDS_BYTES=LDS_BYTES;
#undef SBAR
#undef WAIT_BAR
}

#ifndef USE_MFMA_ATTN
#define USE_MFMA_ATTN 1
#endif
#ifndef ATTN_V2
#define ATTN_V2 1
#endif
__device__ __forceinline__ void phase_diff_mfma(char* shm, LAS unsigned char* lds, const Ctx& a, int vcu, int G) {
    bf16* proj = (bf16*)(a.ws + WS_H); bf16* o12 = (bf16*)(a.ws + WS_STATE);
    unsigned* ctl = (unsigned*)(a.ws + WS_CTL);
    volatile LAS unsigned* qslot = (volatile LAS unsigned*)(lds + MISC_OFF) + 16;
    for (;;) {
        const int tid = otid();
        if (tid == 0) *qslot = atomicAdd(ctl + CW_QUEUE, 1u);
        __syncthreads();
        const unsigned idx = (unsigned)__builtin_amdgcn_readfirstlane((int)*qslot);
        __syncthreads();
        if (idx >= (unsigned)(NB * DIFF_H * 2 * 32)) break;
        const int qb = 31 - (int)(idx >> 5), rem = idx & 31, b = rem >> 4, h = (rem >> 1) & 7, r = rem & 1;
        const float slope2 = exp2f(-(float)(h + 1)) * LOG2E;
        int t0 = 0;
        { const unsigned* qm = ctl + CW_QKMAX + b * 64; const int g0 = (h * 128 + r * 64) >> 5;
          const float pq = __uint_as_float(qm[g0]) + __uint_as_float(qm[g0 + 1]), pk = __uint_as_float(qm[32 + g0]) + __uint_as_float(qm[32 + g0 + 1]);
          const float smax = sqrtf(pq * pk);
          const float d = (float)(qb * 256) - (152.0f + 2.1f * smax) / slope2;
          if (d > 0.f) t0 = ((int)d >> 6) & ~1;
          if (t0 > 4 * qb) t0 = 4 * qb; }
#if ATTN_V2
        attn_body::attn_unit_v2<8>(b, qb, t0, (const attn_body::bf16*)(proj + h * 128 + r * 64), (const attn_body::bf16*)(proj + 1024 + h * 128 + r * 64),
                                   (const attn_body::bf16*)(proj + 2048 + h * 128), (attn_body::bf16*)(o12 + r * 1024 + h * 128), slope2, shm);
#else
#pragma nounroll
        for (int vh = 0; vh < 2; ++vh)
            attn_body::attn_unit<8>(b, qb, t0, (const attn_body::bf16*)(proj + h * 128 + r * 64), (const attn_body::bf16*)(proj + 1024 + h * 128 + r * 64),
                                    (const attn_body::bf16*)(proj + 2048 + h * 128 + vh * 64), (attn_body::bf16*)(o12 + r * 1024 + h * 128 + vh * 64), slope2, shm);
#endif
    }
}
__device__ __forceinline__ void phase_diff_combine(const Ctx& a, const LayerP& P, int vcu, int G) {
    const int tid = otid(), lane = tid & 63, wave = tid >> 6;
    bf16* proj = (bf16*)(a.ws + WS_H); const bf16* o12 = (const bf16*)(a.ws + WS_STATE);
    float lam;
    { float s1 = 0.f, s2 = 0.f;
      for (int i = 0; i < 64; ++i) { s1 += P.e0[i] * P.e1[i]; s2 += P.e2[i] * P.e3[i]; }
      lam = __expf(s1) - __expf(s2) + LAMBDA_INIT; }
    const int h = lane >> 3, sub = lane & 7;
    float hn[16];
#pragma unroll
    for (int j = 0; j < 16; ++j) hn[j] = P.e4[sub * 16 + j] * (1.0f - LAMBDA_INIT);
    const int gw = vcu * NWAVES + wave, NGW = G * NWAVES;
    for (int row = gw; row < NTOK; row += NGW) {
        const bf16* p1 = o12 + (size_t)row * 2048 + h * 128 + sub * 16;
        const v4u a0 = *(const v4u*)p1, a1 = *(const v4u*)(p1 + 8), b0 = *(const v4u*)(p1 + 1024), b1 = *(const v4u*)(p1 + 1032);
        const unsigned aw[8] = {a0.x, a0.y, a0.z, a0.w, a1.x, a1.y, a1.z, a1.w}, bw[8] = {b0.x, b0.y, b0.z, b0.w, b1.x, b1.y, b1.z, b1.w};
        float o[16]; float ss = 0.f;
#pragma unroll
        for (int j = 0; j < 8; ++j) { o[2 * j] = bflo(aw[j]) - lam * bflo(bw[j]); o[2 * j + 1] = bfhi(aw[j]) - lam * bfhi(bw[j]); ss += o[2 * j] * o[2 * j] + o[2 * j + 1] * o[2 * j + 1]; }
        ss += __shfl_xor(ss, 1); ss += __shfl_xor(ss, 2); ss += __shfl_xor(ss, 4);
        const float rs = 1.0f / sqrtf(ss * (1.0f / 128.0f) + EPS);
        v4u w0, w1;
        w0.x = pk2(o[0] * rs * hn[0], o[1] * rs * hn[1]); w0.y = pk2(o[2] * rs * hn[2], o[3] * rs * hn[3]); w0.z = pk2(o[4] * rs * hn[4], o[5] * rs * hn[5]); w0.w = pk2(o[6] * rs * hn[6], o[7] * rs * hn[7]);
        w1.x = pk2(o[8] * rs * hn[8], o[9] * rs * hn[9]); w1.y = pk2(o[10] * rs * hn[10], o[11] * rs * hn[11]); w1.z = pk2(o[12] * rs * hn[12], o[13] * rs * hn[13]); w1.w = pk2(o[14] * rs * hn[14], o[15] * rs * hn[15]);
        bf16* op = proj + (size_t)row * DIFF_PITCH + h * 128 + sub * 16;
        *(v4u*)op = w0; *(v4u*)(op + 8) = w1;
    }
}

typedef short mbf16x8 __attribute__((ext_vector_type(8)));
typedef short ms16x4 __attribute__((ext_vector_type(4)));
typedef float mf32x16 __attribute__((ext_vector_type(16)));
#define MFMA32(a, b, c) __builtin_amdgcn_mfma_f32_32x32x16_bf16(a, b, c, 0, 0, 0)
__device__ __forceinline__ int crow32(int r, int hi) { return (r & 3) + 8 * (r >> 2) + 4 * hi; }
__device__ __forceinline__ mbf16x8 frag_rk(const LAS unsigned char* base, int stride, int row0, int k0, int lane) {
    return *(const LAS mbf16x8*)(base + (row0 + (lane & 31)) * stride + (k0 + 8 * (lane >> 5)) * 2);
}
__device__ __forceinline__ mbf16x8 frag_kn(const LAS unsigned char* base, int stride, int k0, int n0, int lane) {
    const int i = lane & 15, g = lane >> 4;
    const LAS unsigned char* p = base + (k0 + 8 * (g >> 1) + (i >> 2)) * stride + (n0 + 16 * (g & 1) + 4 * (i & 3)) * 2;
    const ms16x4 lo = __builtin_bit_cast(ms16x4, __builtin_amdgcn_ds_read_tr16_b64_v4i16((LAS ms16x4*)p));
    const ms16x4 hi = __builtin_bit_cast(ms16x4, __builtin_amdgcn_ds_read_tr16_b64_v4i16((LAS ms16x4*)(p + 4 * stride)));
    return (mbf16x8){lo[0], lo[1], lo[2], lo[3], hi[0], hi[1], hi[2], hi[3]};
}
__device__ __forceinline__ mf32x16 zero16() { mf32x16 z;
#pragma unroll
    for (int r = 0; r < 16; ++r) z[r] = 0.f; return z; }

__device__ __forceinline__ void phase_sgu_mfma(LAS unsigned char* lds, const Ctx& a, const LayerP& P, int vcu, int G, bool dummy = false) {
    const int tid = otid(), lane = tid & 63, wave = __builtin_amdgcn_readfirstlane(tid >> 6);
    bf16* proj = (bf16*)(a.ws + WS_H); const float* vssq = (const float*)(a.ws + WS_VSSQ);
    const float* v_norm = P.e1; const float* w_s = P.e2; const float* b_s = P.e3;
    constexpr int SA = 272, SV = 320, SO = 132;
    LAS unsigned char* WA = lds;
    LAS unsigned char* VV = lds + 128 * SA;
    LAS float* OS = (LAS float*)(lds + 128 * SA);
    LAS float* RS = (LAS float*)(lds + 128 * SA + 128 * SO * 4);
    const int tm = wave & 3, nh = wave >> 2, hi = lane >> 5;
    constexpr int NU = NB * (T / SGU_C) * SGU_G;
    int g_res = -1;
    v4u vraw[4]; float rsraw = 0.f;
    #define SGU_LOAD_RAW(uu) do{ const int g_ = (uu) % SGU_G, row0_ = ((uu) / SGU_G) * SGU_C; \
        _Pragma("unroll") for (int i = 0; i < 4; ++i) { const int ch = tid + NTHR * i, r = ch >> 4, c16 = ch & 15; \
            vraw[i] = *(const v4u*)(proj + (size_t)(row0_ + r) * SGU_PITCH + 1024 + g_ * 128 + c16 * 8); } \
        if (tid < 128) rsraw = row_rstd(vssq, row0_ + tid); }while(0)
    if (vcu < NU) SGU_LOAD_RAW(vcu);
    for (int u = vcu; u < NU; u += G) {
        const int g = u % SGU_G, bc = u / SGU_G;
        const int row0 = bc * SGU_C;
        if (tid < 128) RS[tid] = rsraw;
        v4u vcur[4];
#pragma unroll
        for (int i = 0; i < 4; ++i) vcur[i] = vraw[i];
        v4u uw[4];
#pragma unroll
        for (int i = 0; i < 4; ++i) { const int ch = tid + NTHR * i, t = ch >> 4, c8 = (ch & 15) * 8; uw[i] = *(const v4u*)(proj + (size_t)(row0 + t) * SGU_PITCH + g * 128 + c8); }
        if (g != g_res) {
#pragma unroll
            for (int i = 0; i < 8; ++i) { const int idx = tid + NTHR * i, t = idx >> 5, s4 = (idx & 31) * 4;
                const f32x4 w = *(const f32x4*)(w_s + (size_t)g * 16384 + t * 128 + s4);
                v2u o; o.x = pk2((s4 + 0 <= t) ? w.x : 0.f, (s4 + 1 <= t) ? w.y : 0.f); o.y = pk2((s4 + 2 <= t) ? w.z : 0.f, (s4 + 3 <= t) ? w.w : 0.f);
                *(LAS v2u*)(WA + t * SA + s4 * 2) = o; }
            g_res = g;
        }
        if (u + G < NU) SGU_LOAD_RAW(u + G);
        __syncthreads();
#pragma unroll
        for (int i = 0; i < 4; ++i) { const int ch = tid + NTHR * i, r = ch >> 4, c16 = ch & 15; const float rs = RS[r];
            v4u o; o.x = pk2(bflo(vcur[i].x) * rs, bfhi(vcur[i].x) * rs); o.y = pk2(bflo(vcur[i].y) * rs, bfhi(vcur[i].y) * rs);
            o.z = pk2(bflo(vcur[i].z) * rs, bfhi(vcur[i].z) * rs); o.w = pk2(bflo(vcur[i].w) * rs, bfhi(vcur[i].w) * rs);
            *(LAS v4u*)(VV + r * SV + c16 * 16) = o; }
        __syncthreads();
        mf32x16 acc0 = zero16(), acc1 = zero16();
        for (int ks = 0; ks < 2 * (tm + 1); ++ks) {
            const mbf16x8 af = frag_rk(WA, SA, 32 * tm, 16 * ks, lane);
            const mbf16x8 b0 = frag_kn(VV, SV, 16 * ks, 64 * nh, lane), b1 = frag_kn(VV, SV, 16 * ks, 64 * nh + 32, lane);
            acc0 = MFMA32(af, b0, acc0); acc1 = MFMA32(af, b1, acc1);
        }
        __syncthreads();
#pragma unroll
        for (int r = 0; r < 16; ++r) { const int row = 32 * tm + crow32(r, hi);
            OS[row * SO + 64 * nh + (lane & 31)] = acc0[r]; OS[row * SO + 64 * nh + 32 + (lane & 31)] = acc1[r]; }
        __syncthreads();
#pragma unroll
        for (int i = 0; i < 4; ++i) { const int ch = tid + NTHR * i, t = ch >> 4, c8 = (ch & 15) * 8;
            const f32x4 s0 = *(const LAS f32x4*)(OS + t * SO + c8), s1 = *(const LAS f32x4*)(OS + t * SO + c8 + 4);
            const f32x4 n0 = *(const f32x4*)(v_norm + g * 128 + c8), n1 = *(const f32x4*)(v_norm + g * 128 + c8 + 4);
            const float bs = b_s[g * 128 + t];
            bf16* up = proj + (size_t)(row0 + t) * SGU_PITCH + g * 128 + c8;
            const v4u uwv = uw[i];
            v4u o;
            o.x = pk2(bflo(uwv.x) * (n0.x * s0.x + bs), bfhi(uwv.x) * (n0.y * s0.y + bs)); o.y = pk2(bflo(uwv.y) * (n0.z * s0.z + bs), bfhi(uwv.y) * (n0.w * s0.w + bs));
            o.z = pk2(bflo(uwv.z) * (n1.x * s1.x + bs), bfhi(uwv.z) * (n1.y * s1.y + bs)); o.w = pk2(bflo(uwv.w) * (n1.z * s1.z + bs), bfhi(uwv.w) * (n1.w * s1.w + bs));
            if (dummy) *(v4u*)((bf16*)(a.ws + WS_XB) + (size_t)(row0 + t) * 1024 + g * 128 + c8) = o; else *(v4u*)up = o; }
        __syncthreads();
    }
    #undef SGU_LOAD_RAW
}

struct GlaRaw { unsigned la[8], q[8], k[8]; v4u v[4]; };
__device__ __forceinline__ void gla_load_raw(GlaRaw& r, const bf16* proj, int u, int tid, bool want_q) {
    const int n = u % GLA_NC, bh = u / GLA_NC, h = bh % GLA_H, b = bh / GLA_H, row0 = b * T + n * GLA_C;
    const int cp = tid & 63, part = tid >> 6;
#pragma unroll
    for (int i = 0; i < 8; ++i) { const bf16* base = proj + (size_t)(row0 + 8 * part + i) * GLA_PITCH + h * 128 + 2 * cp;
        r.la[i] = *(const unsigned*)(base + 3072); r.k[i] = *(const unsigned*)(base + 512); r.q[i] = want_q ? *(const unsigned*)base : 0u; }
#pragma unroll
    for (int i = 0; i < 4; ++i) { const int ch = tid + NTHR * i, rr = ch >> 5, c16 = ch & 31;
        r.v[i] = *(const v4u*)(proj + (size_t)(row0 + rr) * GLA_PITCH + 1024 + h * 256 + c16 * 8); }
}
__device__ __forceinline__ void gla_cumsum_raw(GlaCum& c, const GlaRaw& r, LAS float* TOT, int tid) {
    const int cp = tid & 63, part = tid >> 6;
#pragma unroll
    for (int i = 0; i < 8; ++i) { c.b0[i] = bflo(r.la[i]); c.b1[i] = bfhi(r.la[i]); }
#pragma unroll
    for (int i = 1; i < 8; ++i) { c.b0[i] += c.b0[i - 1]; c.b1[i] += c.b1[i - 1]; }
    TOT[part * 128 + 2 * cp] = c.b0[7]; TOT[part * 128 + 2 * cp + 1] = c.b1[7];
    __syncthreads();
    float o0 = 0.f, o1 = 0.f, t0 = 0.f, t1 = 0.f;
#pragma unroll
    for (int p = 0; p < 8; ++p) { const float x0 = TOT[p * 128 + 2 * cp], x1 = TOT[p * 128 + 2 * cp + 1]; if (p < part) { o0 += x0; o1 += x1; } t0 += x0; t1 += x1; }
#pragma unroll
    for (int i = 0; i < 8; ++i) { c.b0[i] += o0; c.b1[i] += o1; }
    c.tot0 = t0; c.tot1 = t1;
}
__device__ __forceinline__ void phase_gla_kv_mfma(LAS unsigned char* lds, const Ctx& a, int vcu, int G) {
    const int tid = otid(), lane = tid & 63, wave = __builtin_amdgcn_readfirstlane(tid >> 6), hi = lane >> 5;
    const bf16* proj = (const bf16*)(a.ws + WS_H); bf16* state = (bf16*)(a.ws + WS_STATE); float* dec = (float*)(a.ws + WS_DEC);
    constexpr int SV = 576, SK = 320, SS = 272;
    LAS unsigned char* VV = lds;
    LAS unsigned char* KE = lds + 64 * SV;
    LAS unsigned char* ST = lds;
    LAS float* TOT = (LAS float*)(lds + 256 * SS);
    constexpr int NU = NB * GLA_H * GLA_NC;
    GlaRaw nxt; if (vcu < NU) gla_load_raw(nxt, proj, vcu, tid, false);
    for (int u = vcu; u < NU; u += G) {
        const GlaRaw cur = nxt;
        if (u + G < NU) gla_load_raw(nxt, proj, u + G, tid, false);
        GlaCum c; gla_cumsum_raw(c, cur, TOT, tid);
        const int cp = tid & 63, part = tid >> 6;
#pragma unroll
        for (int i = 0; i < 8; ++i) { const int t = 8 * part + i; const unsigned w = cur.k[i];
            *(LAS unsigned*)(KE + t * SK + 4 * cp) = pk2(bflo(w) * __expf(c.tot0 - c.b0[i]), bfhi(w) * __expf(c.tot1 - c.b1[i])); }
        if (part == 0) { dec[(size_t)u * 128 + 2 * cp] = __expf(c.tot0); dec[(size_t)u * 128 + 2 * cp + 1] = __expf(c.tot1); }
#pragma unroll
        for (int i = 0; i < 4; ++i) { const int ch = tid + NTHR * i, r = ch >> 5, c16 = ch & 31;
            *(LAS v4u*)(VV + r * SV + c16 * 16) = cur.v[i]; }
        __syncthreads();
        mf32x16 acc[4];
#pragma unroll
        for (int nt = 0; nt < 4; ++nt) acc[nt] = zero16();
#pragma unroll
        for (int ks = 0; ks < 4; ++ks) { const mbf16x8 af = frag_kn(VV, SV, 16 * ks, 32 * wave, lane);
#pragma unroll
            for (int nt = 0; nt < 4; ++nt) { const mbf16x8 bfr = frag_kn(KE, SK, 16 * ks, 32 * nt, lane); acc[nt] = MFMA32(af, bfr, acc[nt]); } }
        __syncthreads();
#pragma unroll
        for (int nt = 0; nt < 4; ++nt)
#pragma unroll
            for (int r = 0; r < 16; ++r) *(LAS bf16*)(ST + (32 * wave + crow32(r, hi)) * SS + (32 * nt + (lane & 31)) * 2) = (bf16)f2bf(acc[nt][r]);
        __syncthreads();
#pragma unroll
        for (int i = 0; i < 8; ++i) { const int ch = tid + NTHR * i, vd = ch >> 4, c16 = ch & 15;
            *(v4u*)(state + ((size_t)u * 256 + vd) * 128 + c16 * 8) = *(const LAS v4u*)(ST + vd * SS + c16 * 16); }
        __syncthreads();
    }
}
__device__ __forceinline__ void phase_gla_out_mfma(LAS unsigned char* lds, const Ctx& a, const LayerP& P, int vcu, int G, bool dummy = false) {
    const int tid = otid(), lane = tid & 63, wave = __builtin_amdgcn_readfirstlane(tid >> 6), hi = lane >> 5;
    bf16* proj = (bf16*)(a.ws + WS_H); const bf16* state = (const bf16*)(a.ws + WS_STATE);
    const float* head_norm = P.e3;
    constexpr int SQ = 272, SA = 144, SV = 576, SO = 260;
    LAS unsigned char* QD = lds;
    LAS unsigned char* KI = lds + 64 * SQ;
    LAS unsigned char* AT = lds + 2 * 64 * SQ;
    LAS unsigned char* VV = lds + 2 * 64 * SQ + 64 * SA;
    LAS float* TOT = (LAS float*)(lds + 80896);
    LAS float* OS = (LAS float*)lds;
    constexpr int NU = NB * GLA_H * GLA_NC;
    GlaRaw nxt; if (vcu < NU) gla_load_raw(nxt, proj, vcu, tid, true);
    for (int u = vcu; u < NU; u += G) {
        const int n = u % GLA_NC, bh = u / GLA_NC, h = bh % GLA_H, b = bh / GLA_H;
        const int row0 = b * T + n * GLA_C;
        const GlaRaw cur = nxt;
        mbf16x8 sfr[8];
        { const bf16* sp = state + ((size_t)u * 256 + 32 * wave + (lane & 31)) * 128 + 8 * hi;
#pragma unroll
          for (int ks = 0; ks < 8; ++ks) sfr[ks] = *(const mbf16x8*)(sp + 16 * ks); }
        v4u gwv[4];
#pragma unroll
        for (int p = 0; p < 4; ++p) gwv[p] = *(const v4u*)(proj + (size_t)(row0 + p * 16 + wave * 2 + hi) * GLA_PITCH + 2048 + h * 256 + (lane & 31) * 8);
        if (u + G < NU) gla_load_raw(nxt, proj, u + G, tid, true);
        GlaCum c; gla_cumsum_raw(c, cur, TOT, tid);
        const int cp = tid & 63, part = tid >> 6;
#pragma unroll
        for (int i = 0; i < 8; ++i) { const int t = 8 * part + i;
            const unsigned wq = cur.q[i];
            const unsigned wk = cur.k[i];
            const float e0 = __expf(c.b0[i]), e1 = __expf(c.b1[i]);
            *(LAS unsigned*)(QD + t * SQ + 4 * cp) = pk2(bflo(wq) * 0.08838834764831845f * e0, bfhi(wq) * 0.08838834764831845f * e1);
            *(LAS unsigned*)(KI + t * SQ + 4 * cp) = pk2(bflo(wk) / e0, bfhi(wk) / e1); }
#pragma unroll
        for (int i = 0; i < 4; ++i) { const int ch = tid + NTHR * i, r = ch >> 5, c16 = ch & 31;
            *(LAS v4u*)(VV + r * SV + c16 * 16) = cur.v[i]; }
        __syncthreads();
        if (wave < 4) {
            const int mi = wave >> 1, ni = wave & 1;
            mf32x16 at = zero16();
            if (!(mi == 0 && ni == 1)) {
#pragma unroll
                for (int ks = 0; ks < 8; ++ks) at = MFMA32(frag_rk(QD, SQ, 32 * mi, 16 * ks, lane), frag_rk(KI, SQ, 32 * ni, 16 * ks, lane), at);
            }
#pragma unroll
            for (int r = 0; r < 16; ++r) { const int cc = 32 * mi + crow32(r, hi), ss = 32 * ni + (lane & 31);
                *(LAS bf16*)(AT + cc * SA + ss * 2) = (bf16)f2bf((ss <= cc) ? at[r] : 0.f); }
        }
        __syncthreads();
        mf32x16 acc[2]; acc[0] = zero16(); acc[1] = zero16();
#pragma unroll
        for (int ks = 0; ks < 4; ++ks) { const mbf16x8 bfr = frag_kn(VV, SV, 16 * ks, 32 * wave, lane);
            if (ks < 2) acc[0] = MFMA32(frag_rk(AT, SA, 0, 16 * ks, lane), bfr, acc[0]);
            acc[1] = MFMA32(frag_rk(AT, SA, 32, 16 * ks, lane), bfr, acc[1]); }
#pragma unroll
        for (int ks = 0; ks < 8; ++ks) { acc[0] = MFMA32(frag_rk(QD, SQ, 0, 16 * ks, lane), sfr[ks], acc[0]); acc[1] = MFMA32(frag_rk(QD, SQ, 32, 16 * ks, lane), sfr[ks], acc[1]); }
        __syncthreads();
#pragma unroll
        for (int mi = 0; mi < 2; ++mi)
#pragma unroll
            for (int r = 0; r < 16; ++r) OS[(32 * mi + crow32(r, hi)) * SO + 32 * wave + (lane & 31)] = acc[mi][r];
        __syncthreads();
#pragma unroll
        for (int p = 0; p < 4; ++p) { const int cc = p * 16 + wave * 2 + hi, c8 = (lane & 31) * 8;
            const f32x4 s0 = *(const LAS f32x4*)(OS + cc * SO + c8), s1 = *(const LAS f32x4*)(OS + cc * SO + c8 + 4);
            float ss = (s0.x * s0.x + s0.y * s0.y) + (s0.z * s0.z + s0.w * s0.w) + (s1.x * s1.x + s1.y * s1.y) + (s1.z * s1.z + s1.w * s1.w);
            ss += __shfl_xor(ss, 1); ss += __shfl_xor(ss, 2); ss += __shfl_xor(ss, 4); ss += __shfl_xor(ss, 8); ss += __shfl_xor(ss, 16);
            const float rs = __builtin_amdgcn_rsqf(ss * (1.0f / 256.0f) + EPS);
            const f32x4 n0 = *(const f32x4*)(head_norm + c8), n1 = *(const f32x4*)(head_norm + c8 + 4);
            const v4u gw = gwv[p];
            const float gg[8] = {bflo(gw.x), bfhi(gw.x), bflo(gw.y), bfhi(gw.y), bflo(gw.z), bfhi(gw.z), bflo(gw.w), bfhi(gw.w)};
            const float ov[8] = {s0.x * n0.x, s0.y * n0.y, s0.z * n0.z, s0.w * n0.w, s1.x * n1.x, s1.y * n1.y, s1.z * n1.z, s1.w * n1.w};
            float o[8];
#pragma unroll
            for (int j = 0; j < 8; ++j) o[j] = ov[j] * rs * (gg[j] * __builtin_amdgcn_rcpf(1.f + __builtin_amdgcn_exp2f(-gg[j] * LOG2E)));
            v4u w; w.x = pk2(o[0], o[1]); w.y = pk2(o[2], o[3]); w.z = pk2(o[4], o[5]); w.w = pk2(o[6], o[7]);
            if (dummy) *(v4u*)((bf16*)(a.ws + WS_XB) + (size_t)(row0 + cc) * 1024 + h * 256 + c8) = w;
            else *(v4u*)(proj + (size_t)(row0 + cc) * GLA_PITCH + 1024 + h * 256 + c8) = w; }
        __syncthreads();
    }
}

constexpr int GLA_GRP = 4, GLA_NG = GLA_NC / GLA_GRP;
constexpr int GLA_NU2 = NB * GLA_H * GLA_NG;
struct GlaRaw2 { unsigned la[8], q[8], k[8]; v4u v[4]; };
__device__ __forceinline__ void gla2_load_raw(GlaRaw2& r, const bf16* proj, int row0, int h, int tid, bool want_q) {
    const int cp = tid & 63, part = tid >> 6;
#pragma unroll
    for (int i = 0; i < 8; ++i) { const bf16* base = proj + (size_t)(row0 + 8 * part + i) * GLA_PITCH + h * 128 + 2 * cp;
        r.la[i] = *(const unsigned*)(base + 3072); r.k[i] = *(const unsigned*)(base + 512); r.q[i] = want_q ? *(const unsigned*)base : 0u; }
#pragma unroll
    for (int i = 0; i < 4; ++i) { const int ch = tid + NTHR * i, rr = ch >> 5, c16 = ch & 31;
        r.v[i] = *(const v4u*)(proj + (size_t)(row0 + rr) * GLA_PITCH + 1024 + h * 256 + c16 * 8); }
}
__device__ __forceinline__ void gla2_cumsum(GlaCum& c, const GlaRaw2& r, LAS float* TOT, int tid) {
    const int cp = tid & 63, part = tid >> 6;
#pragma unroll
    for (int i = 0; i < 8; ++i) { c.b0[i] = bflo(r.la[i]); c.b1[i] = bfhi(r.la[i]); }
#pragma unroll
    for (int i = 1; i < 8; ++i) { c.b0[i] += c.b0[i - 1]; c.b1[i] += c.b1[i - 1]; }
    TOT[part * 128 + 2 * cp] = c.b0[7]; TOT[part * 128 + 2 * cp + 1] = c.b1[7];
    __syncthreads();
    float o0 = 0.f, o1 = 0.f, t0 = 0.f, t1 = 0.f;
#pragma unroll
    for (int p = 0; p < 8; ++p) { const float x0 = TOT[p * 128 + 2 * cp], x1 = TOT[p * 128 + 2 * cp + 1]; if (p < part) { o0 += x0; o1 += x1; } t0 += x0; t1 += x1; }
#pragma unroll
    for (int i = 0; i < 8; ++i) { c.b0[i] += o0; c.b1[i] += o1; }
    c.tot0 = t0; c.tot1 = t1;
}
__device__ __forceinline__ void gla2_state_update(mf32x16 (&S)[4], const LAS unsigned char* KE, const LAS unsigned char* VV, const LAS float* DEC, int wave, int lane, bool scale) {
    const int hi = lane >> 5;
    if (scale) {
#pragma unroll
        for (int kt = 0; kt < 4; ++kt)
#pragma unroll
            for (int rq = 0; rq < 4; ++rq) { const f32x4 d = *(const LAS f32x4*)(DEC + 32 * kt + 8 * rq + 4 * hi);
                S[kt][4 * rq + 0] *= d.x; S[kt][4 * rq + 1] *= d.y; S[kt][4 * rq + 2] *= d.z; S[kt][4 * rq + 3] *= d.w; }
    }
#pragma unroll
    for (int ks = 0; ks < 4; ++ks) { const mbf16x8 bfr = frag_kn(VV, 576, 16 * ks, 32 * wave, lane);
#pragma unroll
        for (int kt = 0; kt < 4; ++kt) S[kt] = MFMA32(frag_kn(KE, 320, 16 * ks, 32 * kt, lane), bfr, S[kt]); }
}
__device__ __forceinline__ void phase_gla2_kv(LAS unsigned char* lds, const Ctx& a, int vcu, int G) {
    const int tid = otid(), lane = tid & 63, wave = __builtin_amdgcn_readfirstlane(tid >> 6), hi = lane >> 5;
    const bf16* proj = (const bf16*)(a.ws + WS_H); bf16* state = (bf16*)(a.ws + WS_STATE); float* dec = (float*)(a.ws + WS_DEC);
    LAS unsigned char* VV = lds;
    LAS unsigned char* KE = lds + 36864;
    LAS float* TOT = (LAS float*)(lds + 57344);
    LAS float* DEC = (LAS float*)(lds + 61440);
    const int cp = tid & 63, part = tid >> 6;
    for (int u = vcu; u < GLA_NU2; u += G) {
        const int grp = u % GLA_NG, bh = u / GLA_NG, h = bh % GLA_H, b = bh / GLA_H;
        const int row0 = b * T + grp * (GLA_GRP * GLA_C);
        mf32x16 S[4];
#pragma unroll
        for (int kt = 0; kt < 4; ++kt) S[kt] = zero16();
        float sum0 = 0.f, sum1 = 0.f;
#pragma unroll 1
        for (int j = 0; j < GLA_GRP; ++j) {
            GlaRaw2 cur; gla2_load_raw(cur, proj, row0 + j * GLA_C, h, tid, false);
            GlaCum c; gla2_cumsum(c, cur, TOT, tid);
#pragma unroll
            for (int i = 0; i < 8; ++i) { const int t = 8 * part + i; const unsigned w = cur.k[i];
                *(LAS unsigned*)(KE + t * 320 + 4 * cp) = pk2(bflo(w) * __expf(c.tot0 - c.b0[i]), bfhi(w) * __expf(c.tot1 - c.b1[i])); }
            if (part == 0) { DEC[2 * cp] = __expf(c.tot0); DEC[2 * cp + 1] = __expf(c.tot1); sum0 += c.tot0; sum1 += c.tot1; }
#pragma unroll
            for (int i = 0; i < 4; ++i) { const int ch = tid + NTHR * i, r = ch >> 5, c16 = ch & 31; *(LAS v4u*)(VV + r * 576 + c16 * 16) = cur.v[i]; }
            __syncthreads();
            gla2_state_update(S, KE, VV, DEC, wave, lane, j > 0);
            __syncthreads();
        }
        if (part == 0) { dec[(size_t)u * 128 + 2 * cp] = __expf(sum0); dec[(size_t)u * 128 + 2 * cp + 1] = __expf(sum1); }
        bf16* sp = state + (size_t)u * 32768 + 32 * wave + (lane & 31);
#pragma unroll
        for (int kt = 0; kt < 4; ++kt)
#pragma unroll
            for (int r = 0; r < 16; ++r) sp[(size_t)(32 * kt + crow32(r, hi)) * 256] = (bf16)f2bf(S[kt][r]);
    }
}
__device__ __forceinline__ void phase_gla2_scan(const Ctx& a, int vcu, int G) {
    unsigned* state = (unsigned*)(a.ws + WS_STATE); const float* dec = (const float*)(a.ws + WS_DEC);
    for (int gid = vcu * NTHR + otid(); gid < NB * GLA_H * 16384; gid += G * NTHR) {
        const int bh = gid >> 14, e = gid & 16383, kd = e >> 7;
        unsigned* sp = state + (size_t)bh * GLA_NG * 16384 + e;
        const float* dp = dec + (size_t)bh * GLA_NG * 128 + kd;
        float s0 = 0.f, s1 = 0.f;
        for (int n0 = 0; n0 < GLA_NG; n0 += 8) {
            unsigned w[8]; float d[8];
#pragma unroll
            for (int i = 0; i < 8; ++i) { w[i] = sp[(size_t)(n0 + i) * 16384]; d[i] = dp[(n0 + i) * 128]; }
#pragma unroll
            for (int i = 0; i < 8; ++i) { sp[(size_t)(n0 + i) * 16384] = pk2(s0, s1); s0 = d[i] * s0 + bflo(w[i]); s1 = d[i] * s1 + bfhi(w[i]); }
        }
    }
}
__device__ __forceinline__ void phase_gla2_out(LAS unsigned char* lds, const Ctx& a, const LayerP& P, int vcu, int G, bool dummy = false) {
    const int tid = otid(), lane = tid & 63, wave = __builtin_amdgcn_readfirstlane(tid >> 6), hi = lane >> 5;
    bf16* proj = (bf16*)(a.ws + WS_H); const bf16* state = (const bf16*)(a.ws + WS_STATE);
    const float* head_norm = P.e3;
    constexpr int SQ = 272, SA = 144, SV = 576, SO = 260;
    LAS unsigned char* QD = lds;
    LAS unsigned char* KI = lds + 17408;
    LAS unsigned char* AT = lds + 34816;
    LAS unsigned char* VV = lds + 44032;
    LAS unsigned char* KE = lds + 80896;
    LAS float* TOT = (LAS float*)(lds + 101376);
    LAS float* DEC = (LAS float*)(lds + 105472);
    LAS float* OS = (LAS float*)lds;
    const int cp = tid & 63, part = tid >> 6;
    for (int u = vcu; u < GLA_NU2; u += G) {
        const int grp = u % GLA_NG, bh = u / GLA_NG, h = bh % GLA_H, b = bh / GLA_H;
        const int rowg = b * T + grp * (GLA_GRP * GLA_C);
        mf32x16 S[4];
        { const bf16* sp = state + (size_t)u * 32768 + 32 * wave + (lane & 31);
#pragma unroll
          for (int kt = 0; kt < 4; ++kt)
#pragma unroll
              for (int r = 0; r < 16; ++r) S[kt][r] = bf2f(sp[(size_t)(32 * kt + crow32(r, hi)) * 256]); }
#pragma unroll 1
        for (int j = 0; j < GLA_GRP; ++j) {
            const int row0 = rowg + j * GLA_C;
            GlaRaw2 cur; gla2_load_raw(cur, proj, row0, h, tid, true);
            v4u gwv[4];
#pragma unroll
            for (int p = 0; p < 4; ++p) gwv[p] = *(const v4u*)(proj + (size_t)(row0 + p * 16 + wave * 2 + hi) * GLA_PITCH + 2048 + h * 256 + (lane & 31) * 8);
            GlaCum c; gla2_cumsum(c, cur, TOT, tid);
#pragma unroll
            for (int i = 0; i < 8; ++i) { const int t = 8 * part + i;
                const unsigned wq = cur.q[i], wk = cur.k[i];
                const float e0 = __expf(c.b0[i]), e1 = __expf(c.b1[i]);
                *(LAS unsigned*)(QD + t * SQ + 4 * cp) = pk2(bflo(wq) * 0.08838834764831845f * e0, bfhi(wq) * 0.08838834764831845f * e1);
                *(LAS unsigned*)(KI + t * SQ + 4 * cp) = pk2(bflo(wk) * __builtin_amdgcn_rcpf(e0), bfhi(wk) * __builtin_amdgcn_rcpf(e1));
                *(LAS unsigned*)(KE + t * 320 + 4 * cp) = pk2(bflo(wk) * __expf(c.tot0 - c.b0[i]), bfhi(wk) * __expf(c.tot1 - c.b1[i])); }
            if (part == 0) { DEC[2 * cp] = __expf(c.tot0); DEC[2 * cp + 1] = __expf(c.tot1); }
#pragma unroll
            for (int i = 0; i < 4; ++i) { const int ch = tid + NTHR * i, r = ch >> 5, c16 = ch & 31; *(LAS v4u*)(VV + r * SV + c16 * 16) = cur.v[i]; }
            __syncthreads();
            if (wave < 4) {
                const int mi = wave >> 1, ni = wave & 1;
                mf32x16 at = zero16();
                if (!(mi == 0 && ni == 1)) {
#pragma unroll
                    for (int ks = 0; ks < 8; ++ks) at = MFMA32(frag_rk(QD, SQ, 32 * mi, 16 * ks, lane), frag_rk(KI, SQ, 32 * ni, 16 * ks, lane), at);
                }
#pragma unroll
                for (int r = 0; r < 16; ++r) { const int cc = 32 * mi + crow32(r, hi), ss = 32 * ni + (lane & 31);
                    *(LAS bf16*)(AT + cc * SA + ss * 2) = (bf16)f2bf((ss <= cc) ? at[r] : 0.f); }
            }
            __syncthreads();
            mf32x16 acc[2]; acc[0] = zero16(); acc[1] = zero16();
#pragma unroll
            for (int ks = 0; ks < 4; ++ks) { const mbf16x8 bfr = frag_kn(VV, SV, 16 * ks, 32 * wave, lane);
                if (ks < 2) acc[0] = MFMA32(frag_rk(AT, SA, 0, 16 * ks, lane), bfr, acc[0]);
                acc[1] = MFMA32(frag_rk(AT, SA, 32, 16 * ks, lane), bfr, acc[1]); }
#pragma unroll
            for (int kt = 0; kt < 4; ++kt)
#pragma unroll
                for (int sx = 0; sx < 2; ++sx) {
                    v4u bw; bw.x = pk2(S[kt][8 * sx + 0], S[kt][8 * sx + 1]); bw.y = pk2(S[kt][8 * sx + 2], S[kt][8 * sx + 3]); bw.z = pk2(S[kt][8 * sx + 4], S[kt][8 * sx + 5]); bw.w = pk2(S[kt][8 * sx + 6], S[kt][8 * sx + 7]);
                    const mbf16x8 bfr = __builtin_bit_cast(mbf16x8, bw);
#pragma unroll
                    for (int mi = 0; mi < 2; ++mi) { const LAS unsigned char* qp = QD + (32 * mi + (lane & 31)) * SQ + (32 * kt + 16 * sx + 4 * hi) * 2;
                        const v2u a0 = *(const LAS v2u*)qp, a1 = *(const LAS v2u*)(qp + 16);
                        v4u aw; aw.x = a0.x; aw.y = a0.y; aw.z = a1.x; aw.w = a1.y;
                        acc[mi] = MFMA32(__builtin_bit_cast(mbf16x8, aw), bfr, acc[mi]); } }
            if (j + 1 < GLA_GRP) gla2_state_update(S, KE, VV, DEC, wave, lane, true);
            __syncthreads();
#pragma unroll
            for (int mi = 0; mi < 2; ++mi)
#pragma unroll
                for (int r = 0; r < 16; ++r) OS[(32 * mi + crow32(r, hi)) * SO + 32 * wave + (lane & 31)] = acc[mi][r];
            __syncthreads();
#pragma unroll
            for (int p = 0; p < 4; ++p) { const int cc = p * 16 + wave * 2 + hi, c8 = (lane & 31) * 8;
                const f32x4 s0 = *(const LAS f32x4*)(OS + cc * SO + c8), s1 = *(const LAS f32x4*)(OS + cc * SO + c8 + 4);
                float ss = (s0.x * s0.x + s0.y * s0.y) + (s0.z * s0.z + s0.w * s0.w) + (s1.x * s1.x + s1.y * s1.y) + (s1.z * s1.z + s1.w * s1.w);
                ss += __shfl_xor(ss, 1); ss += __shfl_xor(ss, 2); ss += __shfl_xor(ss, 4); ss += __shfl_xor(ss, 8); ss += __shfl_xor(ss, 16);
                const float rs = __builtin_amdgcn_rsqf(ss * (1.0f / 256.0f) + EPS);
                const f32x4 n0 = *(const f32x4*)(head_norm + c8), n1 = *(const f32x4*)(head_norm + c8 + 4);
                const v4u gw = gwv[p];
                const float gg[8] = {bflo(gw.x), bfhi(gw.x), bflo(gw.y), bfhi(gw.y), bflo(gw.z), bfhi(gw.z), bflo(gw.w), bfhi(gw.w)};
                const float ov[8] = {s0.x * n0.x, s0.y * n0.y, s0.z * n0.z, s0.w * n0.w, s1.x * n1.x, s1.y * n1.y, s1.z * n1.z, s1.w * n1.w};
                float o[8];
#pragma unroll
                for (int jj = 0; jj < 8; ++jj) o[jj] = ov[jj] * rs * (gg[jj] * __builtin_amdgcn_rcpf(1.f + __builtin_amdgcn_exp2f(-gg[jj] * LOG2E)));
                v4u w; w.x = pk2(o[0], o[1]); w.y = pk2(o[2], o[3]); w.z = pk2(o[4], o[5]); w.w = pk2(o[6], o[7]);
                if (dummy) *(v4u*)((bf16*)(a.ws + WS_XB) + (size_t)(row0 + cc) * 1024 + h * 256 + c8) = w;
                else *(v4u*)(proj + (size_t)(row0 + cc) * GLA_PITCH + 1024 + h * 256 + c8) = w; }
            __syncthreads();
        }
    }
}
#ifndef GLA_TWO_LEVEL
#define GLA_TWO_LEVEL 1
#endif
#ifndef USE_MFMA_SGU
#define USE_MFMA_SGU 1
#endif
#ifndef USE_MFMA_GLA
#define USE_MFMA_GLA 1
#endif

constexpr int PH_PER_LAYER = 8, NPHASE = 4 * PH_PER_LAYER + 1;
__host__ __device__ inline bool phase_is_noop(int ph) {
    if (ph >= 4 * PH_PER_LAYER) return false;
    const int L = ph / PH_PER_LAYER, s = ph % PH_PER_LAYER;
    const bool gla = (L == 0 || L == 3), diff = (L == 1);
    return (s == 3 && !gla && !diff) || (s == 4 && !gla);
}

#ifndef PROBE_KIND
#define PROBE_KIND 0
#endif
#ifndef PROBE_REP
#define PROBE_REP 2
#endif
template <int L> __device__ __forceinline__ LayerP layer_params_ct(const CAS cfptr* in) {
    constexpr int base = (L == 0) ? 1 : (L == 1) ? 11 : (L == 2) ? 22 : 32;
    constexpr int kind = (L == 1) ? K_DIFF : (L == 2) ? K_SGU : K_GLA;
    constexpr int sh = (kind == K_DIFF) ? 1 : 0;
    LayerP p; p.kind = kind;
    p.norm1 = in[base]; p.w_in = in[base + 1];
    p.e0 = in[base + 2]; p.e1 = in[base + 3]; p.e2 = in[base + 4]; p.e3 = in[base + 5]; p.e4 = in[base + 6];
    p.w_out = in[base + 6 + sh]; p.norm2 = in[base + 7 + sh]; p.w1 = in[base + 8 + sh]; p.w2 = in[base + 9 + sh];
    p.nin = (kind == K_GLA) ? GLA_PITCH : (kind == K_DIFF) ? DIFF_PITCH : SGU_PITCH;
    p.mixoff = (kind == K_GLA) ? 1024 : 0;
    return p;
}
__device__ __forceinline__ void seam_xcd(const CAS Args* ap, LAS unsigned char* lds_k) {
#if PROBE_KIND == 1
    for (int br = 0; br < PROBE_REP; ++br)
#endif
    { XcdBarrier bb; bb.bar = (unsigned*)(ap->ws + WS_CTL) + 4096; bb.x = xb_xcc_id(); bb.st = (volatile LAS unsigned*)(lds_k + MISC_OFF) + 8; xcd_barrier(bb); }
}
#define PH_BEGIN(PK) { const int nrep_ = (PROBE_KIND == (PK) && (PK) != 0) ? PROBE_REP : 1; \
    for (int rep_ = 0; rep_ < nrep_; ++rep_) { \
    int vcu = vcu0, G = G0; asm volatile("" : "+s"(vcu), "+s"(G)); \
    LAS unsigned char* lds = lds_k; asm volatile("" : "+s"(lds)); \
    const CAS Args* ap = (const CAS Args*)__builtin_amdgcn_kernarg_segment_ptr(); asm volatile("" : "+s"(ap)); \
    Ctx args; args.in0 = ap->in[0]; args.in42 = ap->in[42]; args.out = ap->out; args.ws = ap->ws; \
    bf16* Wb = (bf16*)(args.ws + WS_W); bf16* XB = (bf16*)(args.ws + WS_XB); bf16* HB = (bf16*)(args.ws + WS_H); \
    float* SSQ = (float*)(args.ws + WS_SSQ); float* VSSQ = (float*)(args.ws + WS_VSSQ); \
    const LayerP P = layer_params_ct<L>((const CAS cfptr*)ap); \
    (void)Wb; (void)XB; (void)HB; (void)SSQ; (void)VSSQ; (void)P; (void)vcu; (void)G; (void)lds;
#define PH_END_SEAM   seam_xcd(ap, lds_k); } }
#define PH_END_NOSEAM } }

template <int L> __device__ __forceinline__ void run_layer(LAS unsigned char* lds_k, int vcu0, int G0) {
    constexpr int kind = (L == 1) ? K_DIFF : (L == 2) ? K_SGU : K_GLA;
    PH_BEGIN(5) phase_conv(lds, args, P, L, vcu, G);
    if (L == 0) { if (rep_ + 1 == nrep_) cg::this_grid().sync(); else seam_xcd(ap, lds_k); } else seam_xcd(ap, lds_k);
    PH_END_NOSEAM
    PH_BEGIN(3) { EpiIn E{kind, HB, SSQ, (kind == K_GLA) ? P.e2 : P.e0, VSSQ, (unsigned*)(args.ws + WS_CTL) + CW_QKMAX}; run_gemm(lds, XB, D, Wb + WOFF_IN, NTOK, P.nin, D, E, vcu, G); } PH_END_SEAM
    if constexpr (kind == K_GLA) {
#if GLA_TWO_LEVEL
        PH_BEGIN(4) phase_gla2_kv(lds, args, vcu, G); PH_END_SEAM
        PH_BEGIN(0) phase_gla2_scan(args, vcu, G); PH_END_SEAM
        PH_BEGIN(9) phase_gla2_out(lds, args, P, vcu, G, rep_ + 1 < nrep_); PH_END_SEAM
#else
        PH_BEGIN(4) phase_gla_kv_mfma(lds, args, vcu, G); PH_END_SEAM
        PH_BEGIN(0) phase_gla_scan(args, vcu, G); PH_END_SEAM
        PH_BEGIN(9) phase_gla_out_mfma(lds, args, P, vcu, G, rep_ + 1 < nrep_); PH_END_SEAM
#endif
    } else if constexpr (kind == K_DIFF) {
        PH_BEGIN(7)
            if (rep_ > 0) { if (blockIdx.x == 0 && otid() == 0) __hip_atomic_store((unsigned*)(ap->ws + WS_CTL) + CW_QUEUE, 0u, RLX_AGENT); seam_xcd(ap, lds_k); }
            phase_diff_mfma((char*)lds_raw, lds, args, vcu, G);
        PH_END_SEAM
        PH_BEGIN(6) phase_diff_combine(args, P, vcu, G); PH_END_SEAM
    } else {
        PH_BEGIN(10) phase_sgu_mfma(lds, args, P, vcu, G, rep_ + 1 < nrep_); PH_END_SEAM
    }
    PH_BEGIN(L == 0 ? 8 : 0) { EpiRes E{(L == 0) ? args.in0 : args.out, args.out, XB, SSQ}; run_gemm(lds, HB + P.mixoff, P.nin, Wb + WOFF_OUT, NTOK, D, D, E, vcu, G); } PH_END_SEAM
    PH_BEGIN(2) { EpiHid E{HB, SSQ}; run_gemm(lds, XB, D, Wb + WOFF_1, NTOK, FF, D, E, vcu, G); } PH_END_SEAM
    PH_BEGIN(0) { EpiRes E{args.out, args.out, XB, SSQ}; run_gemm(lds, HB, FF, Wb + WOFF_2, NTOK, D, FF, E, vcu, G); } PH_END_SEAM
}

__global__ void __launch_bounds__(NTHR, 2) trunk_fwd(Args kargs) {
    LAS unsigned char* const lds_k = (LAS unsigned char*)lds_raw;
    const int G0 = gridDim.x; const int bx = blockIdx.x;
    const int vcu0 = (G0 % 8 == 0) ? (bx % 8) * (G0 / 8) + bx / 8 : bx;
    { const int tid = threadIdx.x;
      for (int u = tid; u < (LDS_BYTES - LDSCTL_OFF) / 4; u += NTHR) ((LAS unsigned*)(lds_k + LDSCTL_OFF))[u] = 0u;
      __syncthreads();
      if ((tid & 63) == 0) ((LAS unsigned*)(lds_k + TIDTAB_OFF))[hw_slot()] = (unsigned)(tid >> 6);
      __syncthreads(); }
    (void)xcd_barrier_post((unsigned*)(kargs.ws + WS_CTL) + 4096, (volatile LAS unsigned*)(lds_k + MISC_OFF) + 8);
    run_layer<0>(lds_k, vcu0, G0);
    run_layer<1>(lds_k, vcu0, G0);
    run_layer<2>(lds_k, vcu0, G0);
    run_layer<3>(lds_k, vcu0, G0);
    { int vcu = vcu0, G = G0; asm volatile("" : "+s"(vcu), "+s"(G));
      const CAS Args* ap = (const CAS Args*)__builtin_amdgcn_kernarg_segment_ptr(); asm volatile("" : "+s"(ap));
      Ctx args; args.in0 = ap->in[0]; args.in42 = ap->in[42]; args.out = ap->out; args.ws = ap->ws;
      phase_final(args, vcu, G); }
}

extern "C" void kernel_launch(void* const* d_in, const int* in_sizes, int n_in, void* d_out, int out_size, void* d_ws, size_t ws_size, hipStream_t stream) {
    static int grid = 0;
    if (grid == 0) {
        if (n_in != 43 || in_sizes[0] != NTOK * D || out_size != NTOK * D || ws_size < WS_END) {
            fprintf(stderr, "kernel_launch: unexpected problem (n_in %d, in0 %d, out %d, ws %zu); nothing launched\n", n_in, n_in > 0 ? in_sizes[0] : -1, out_size, ws_size); grid = -1; return; }
        int dev = 0, cus = 0, per_cu = 0;
        if (hipGetDevice(&dev) != hipSuccess || hipDeviceGetAttribute(&cus, hipDeviceAttributeMultiprocessorCount, dev) != hipSuccess) { grid = -1; return; }
        if (hipFuncSetAttribute((const void*)trunk_fwd, hipFuncAttributeMaxDynamicSharedMemorySize, LDS_BYTES) != hipSuccess) { fprintf(stderr, "kernel_launch: hipFuncSetAttribute failed\n"); grid = -1; return; }
        if (hipOccupancyMaxActiveBlocksPerMultiprocessor(&per_cu, (const void*)trunk_fwd, NTHR, LDS_BYTES) != hipSuccess || per_cu < 1) { fprintf(stderr, "kernel_launch: occupancy query says %d blocks/CU\n", per_cu); per_cu = 1; }
        (void)hipGetLastError();
        grid = cus;
    }
    if (grid < 0) return;
    (void)hipMemsetAsync((char*)d_ws + WS_CTL, 0, CTL_ZERO_BYTES, stream);
    Args a{};
    for (int i = 0; i < 43; ++i) a.in[i] = (const float*)d_in[i];
    a.out = (float*)d_out; a.ws = (unsigned char*)d_ws;
    a.ph_lo = 0; a.ph_hi = 0;
    void* kargs[] = {&a};
    hipError_t e = hipLaunchCooperativeKernel((const void*)trunk_fwd, dim3(grid), dim3(NTHR), kargs, LDS_BYTES, stream);
    if (e != hipSuccess) fprintf(stderr, "kernel_launch: cooperative launch failed: %s (grid %d)\n", hipGetErrorString(e), grid);
}
```

```cpp
#include <hip/hip_runtime.h>
#include <hip/hip_cooperative_groups.h>
#include <cstdio>
#include <cstdint>
namespace cg = cooperative_groups;

#ifndef MK_ONE_LAUNCH
#define MK_ONE_LAUNCH 1
#endif

#define GAS __attribute__((address_space(1)))
#define LAS __attribute__((address_space(3)))
typedef unsigned short bf16;
typedef unsigned v4u __attribute__((ext_vector_type(4)));
typedef unsigned v2u __attribute__((ext_vector_type(2)));
typedef float f32x4 __attribute__((ext_vector_type(4)));

constexpr int NB = 2, T = 8192, D = 1024, NTOK = NB * T, FF = 4096;
constexpr float EPS = 1e-6f;
constexpr float LOG2E = 1.4426950408889634f;
constexpr int NWAVES = 8, NTHR = 512;
constexpr int K_GLA = 0, K_DIFF = 1, K_SGU = 2;
constexpr int GLA_H = 4, GLA_HK = 128, GLA_HV = 256, GLA_C = 64, GLA_NC = T / GLA_C;
constexpr int GLA_PITCH = 3584;
constexpr int DIFF_H = 8, DIFF_PITCH = 3072;
constexpr float LAMBDA_INIT = 0.35551069f;
constexpr int SGU_PITCH = 2048, SGU_C = 128, SGU_G = 8;

constexpr size_t MiB = 1u << 20;
constexpr size_t WS_CTL = 0, CTL_ZERO_BYTES = 1 * MiB;
constexpr size_t WS_SSQ = 1 * MiB;
constexpr size_t WS_VSSQ = 2 * MiB;
constexpr size_t WS_DEC = 3 * MiB;
constexpr size_t WS_W = 4 * MiB;
constexpr size_t WS_XB = 29 * MiB;
constexpr size_t WS_STATE = 61 * MiB;
constexpr size_t WS_H = 125 * MiB;
constexpr size_t WS_END = 253 * MiB;
constexpr int CW_QKMAX = 8192;
constexpr int CW_QUEUE = 8448;
constexpr size_t WOFF_IN = 0, WOFF_OUT = (size_t)3584 * 1024, WOFF_1 = WOFF_OUT + (size_t)1024 * 1024, WOFF_2 = WOFF_1 + (size_t)4096 * 1024;

constexpr int RING_BYTES = 131072, LDSCTL_OFF = RING_BYTES, MISC_OFF = LDSCTL_OFF + 320, LDS_BYTES = 147456;

#define RLX_AGENT __ATOMIC_RELAXED, __HIP_MEMORY_SCOPE_AGENT
#define LDS_WAIT() asm volatile("s_waitcnt lgkmcnt(0)" ::: "memory")
__device__ __forceinline__ unsigned f2bf(float f) { unsigned u = __builtin_bit_cast(unsigned, f); return (u + 0x7fffu + ((u >> 16) & 1u)) >> 16; }
typedef float pk_f32x2 __attribute__((ext_vector_type(2))); typedef __bf16 pk_bf16x2 __attribute__((ext_vector_type(2)));
__device__ __forceinline__ unsigned pk2(float lo, float hi) { pk_f32x2 v = {lo, hi}; pk_bf16x2 b = __builtin_convertvector(v, pk_bf16x2); return __builtin_bit_cast(unsigned, b); }
__device__ __forceinline__ float bf2f(unsigned b) { return __builtin_bit_cast(float, b << 16); }
__device__ __forceinline__ float bflo(unsigned w) { return __builtin_bit_cast(float, w << 16); }
__device__ __forceinline__ float bfhi(unsigned w) { return __builtin_bit_cast(float, w & 0xffff0000u); }
extern __shared__ __attribute__((aligned(16))) unsigned char lds_raw[];
constexpr int TIDTAB_OFF = 131072;
__device__ __forceinline__ unsigned hw_slot() { return (unsigned)__builtin_amdgcn_s_getreg((5 << 11) | 4) & 63u; }
__device__ __forceinline__ int otid() {
    const int wv = (int)((volatile __attribute__((address_space(3))) unsigned*)((__attribute__((address_space(3))) unsigned char*)lds_raw + TIDTAB_OFF))[hw_slot()];
    int ln; asm volatile("v_mbcnt_lo_u32_b32 %0, -1, 0\n\tv_mbcnt_hi_u32_b32 %0, -1, %0" : "=v"(ln));
    int t = wv * 64 + ln;
    asm volatile("" : "+v"(t)); return t; }
__device__ __forceinline__ float wave_sum(float v) {
#pragma unroll
    for (int o = 1; o < 64; o <<= 1) v += __shfl_xor(v, o);
    return v;
}
__device__ __forceinline__ float wave_max(float v) {
#pragma unroll
    for (int o = 1; o < 64; o <<= 1) v = fmaxf(v, __shfl_xor(v, o));
    return v;
}
__device__ __forceinline__ float gelu_tanh(float x) {
    const float u = 0.7978845608028654f * (x + 0.044715f * x * x * x);
    const float e = __builtin_amdgcn_exp2f(u * (2.f * LOG2E));
    return x - x * __builtin_amdgcn_rcpf(e + 1.f);
}
__device__ __forceinline__ float log_sigmoid(float z) { return fminf(z, 0.f) - 0.6931471805599453f * __builtin_amdgcn_logf(1.0f + __builtin_amdgcn_exp2f(-fabsf(z) * LOG2E)); }

#define XB_TMO      128
#define XB_XCNT(j)  (256  + 64 * (j))
#define XB_XSUB(j)  (1280 + 64 * (j))
#define XB_XGEN(j)  (2304 + 64 * (j))
#define XB_TOP      3328
#define XB_TOPGEN   3392
#define XCD_BAR_WORDS 3456
#define XB_SPIN_CAP (1u << 22)
__device__ __forceinline__ unsigned xb_ld(unsigned* p)              { return __hip_atomic_load(p, __ATOMIC_RELAXED, __HIP_MEMORY_SCOPE_AGENT); }
__device__ __forceinline__ unsigned xb_add(unsigned* p, unsigned v) { return __hip_atomic_fetch_add(p, v, __ATOMIC_RELAXED, __HIP_MEMORY_SCOPE_AGENT); }
__device__ __forceinline__ unsigned xb_xcc_id() { return (unsigned)__builtin_amdgcn_s_getreg((3 << 11) | 20) & 0xFu; }
#define XB_SPIN(cond, bar) do { unsigned _sp = 0; while (cond) { __builtin_amdgcn_s_sleep(1); \
    if ((++_sp & 255u) == 0u) { if (xb_ld(&(bar)[XB_TMO])) break; if (_sp > XB_SPIN_CAP) { atomicAdd(&(bar)[XB_TMO], 1u); break; } } } } while (0)
struct XcdBarrier { unsigned* bar; unsigned x; volatile LAS unsigned* st; };
__device__ __forceinline__ XcdBarrier xcd_barrier_post(unsigned* bar, volatile LAS unsigned* st) {
    XcdBarrier b; b.bar = bar; b.x = xb_xcc_id(); b.st = st;
    if (threadIdx.x == 0) (void)xb_add(&bar[XB_XCNT(b.x)], 1u);
    return b;
}
__device__ __forceinline__ void xcd_barrier_complete(unsigned* bar, unsigned x, unsigned& nloc, unsigned& nx) {
    const unsigned G = gridDim.x * gridDim.y * gridDim.z;
    unsigned sum, cnt, mine, sp = 0u;
    for (;;) {
        sum = 0u; cnt = 0u; mine = 0u;
#pragma unroll
        for (unsigned j = 0; j < 16; ++j) { const unsigned c = xb_ld(&bar[XB_XCNT(j)]); sum += c; cnt += (c > 0u) ? 1u : 0u; mine = (j == x) ? c : mine; }
        if (sum == G) break;
        __builtin_amdgcn_s_sleep(1);
        if ((++sp & 255u) == 0u) { if (xb_ld(&bar[XB_TMO])) break; if (sp > XB_SPIN_CAP) { atomicAdd(&bar[XB_TMO], 1u); break; } }
    }
    nloc = mine > 0u ? mine : 1u; nx = cnt > 0u ? cnt : 1u;
}
__device__ __forceinline__ void xcd_barrier(const XcdBarrier& b) {
    asm volatile("s_waitcnt vmcnt(0)" ::: "memory");
    __syncthreads();
    if (otid() == 0) {
        unsigned* bar = b.bar;
        __builtin_amdgcn_s_waitcnt(0);
        unsigned nloc = b.st[0], nx = b.st[1];
        if (nloc == 0u) { xcd_barrier_complete(bar, b.x, nloc, nx); b.st[0] = nloc; b.st[1] = nx; }
        const unsigned old = xb_add(&bar[XB_XSUB(b.x)], 1u);
        const unsigned gen = old / nloc;
        if (old + 1u == (gen + 1u) * nloc) {
            __builtin_amdgcn_fence(__ATOMIC_RELEASE, "agent");
            asm volatile("s_waitcnt vmcnt(0)" ::: "memory");
            const unsigned og = xb_add(&bar[XB_TOP], 1u);
            const unsigned tg = og / nx;
            if (og + 1u == (tg + 1u) * nx) xb_add(&bar[XB_TOPGEN], 1u);
            else XB_SPIN(xb_ld(&bar[XB_TOPGEN]) == tg, bar);
            __builtin_amdgcn_fence(__ATOMIC_ACQUIRE, "agent");
            xb_add(&bar[XB_XGEN(b.x)], 1u);
            asm volatile("s_waitcnt vmcnt(0)" ::: "memory");
        } else {
            XB_SPIN(xb_ld(&bar[XB_XGEN(b.x)]) == gen, bar);
            __builtin_amdgcn_fence(__ATOMIC_ACQUIRE, "agent");
            asm volatile("s_waitcnt vmcnt(0)" ::: "memory");
        }
    }
    __syncthreads();
}

struct Args { const float* in[43]; float* out; unsigned char* ws; int ph_lo, ph_hi; };
struct Ctx { const float* in0; const float* in42; float* out; unsigned char* ws; };
struct LayerP {
    int kind;
    const float *norm1, *w_in, *w_out, *norm2, *w1, *w2;
    const float *e0, *e1, *e2, *e3, *e4;
    int nin;
    int mixoff;
};
typedef const float* cfptr;
#define CAS __attribute__((address_space(4)))
__device__ __forceinline__ LayerP layer_params(const CAS cfptr* in, int L) {
    LayerP p;
    const int base = (L == 0) ? 1 : (L == 1) ? 11 : (L == 2) ? 22 : 32;
    p.kind = (L == 1) ? K_DIFF : (L == 2) ? K_SGU : K_GLA;
    const int sh = (p.kind == K_DIFF) ? 1 : 0;
    p.norm1 = in[base]; p.w_in = in[base + 1];
    p.e0 = in[base + 2]; p.e1 = in[base + 3]; p.e2 = in[base + 4]; p.e3 = in[base + 5]; p.e4 = in[base + 6];
    p.w_out = in[base + 6 + sh]; p.norm2 = in[base + 7 + sh]; p.w1 = in[base + 8 + sh]; p.w2 = in[base + 9 + sh];
    p.nin = (p.kind == K_GLA) ? GLA_PITCH : (p.kind == K_DIFF) ? DIFF_PITCH : SGU_PITCH;
    p.mixoff = (p.kind == K_GLA) ? 1024 : 0;
    return p;
}

__device__ __forceinline__ float row_rstd(const float* ssq, int row) {
    const f32x4* p = (const f32x4*)(ssq + (size_t)row * 16);
    const f32x4 a = p[0], b = p[1], c = p[2], d = p[3];
    const float s = ((a.x + a.y) + (a.z + a.w)) + ((b.x + b.y) + (b.z + b.w)) + ((c.x + c.y) + (c.z + c.w)) + ((d.x + d.y) + (d.z + d.w));
    return __builtin_amdgcn_rsqf(s * (1.0f / D) + EPS);
}

struct EpiIn {
    int kind; bf16* proj; const float* ssq; const float* bias;
    float* vssq;
    static constexpr bool NEEDS_RS = true;
    __device__ __forceinline__ float rowscale(int row) const { const unsigned d = (unsigned)(row - rs_row0); return (d < 256u) ? rs_tab[d] : row_rstd(ssq, row); }
    __device__ __forceinline__ float apply8(int row, int col0, const float (&v)[8], float rs) const {
        float o[8]; float part = 0.f; int pitch;
        if (kind == K_GLA) { pitch = GLA_PITCH;
            if (col0 < 3072) {
#pragma unroll
                for (int j = 0; j < 8; ++j) o[j] = v[j] * rs;
            } else {
#pragma unroll
                for (int j = 0; j < 8; ++j) o[j] = log_sigmoid(v[j] * rs + bias[col0 - 3072 + j]) * (1.0f / 16.0f);
            }
        } else if (kind == K_DIFF) { pitch = DIFF_PITCH;
            const float sc = (col0 < 1024) ? rs * (0.125f * LOG2E) : rs;
#pragma unroll
            for (int j = 0; j < 8; ++j) o[j] = v[j] * sc;
            if (col0 < 2048) {
#pragma unroll
                for (int j = 0; j < 8; ++j) part += o[j] * o[j];
            }
        } else { pitch = SGU_PITCH;
#pragma unroll
            for (int j = 0; j < 8; ++j) { o[j] = gelu_tanh(v[j] * rs + bias[col0 + j]); }
            if (col0 >= 1024) {
#pragma unroll
                for (int j = 0; j < 8; ++j) part += o[j] * o[j];
            }
        }
        v4u w; w.x = pk2(o[0], o[1]); w.y = pk2(o[2], o[3]); w.z = pk2(o[4], o[5]); w.w = pk2(o[6], o[7]);
        *(v4u*)(proj + (size_t)row * pitch + col0) = w;
        return part;
    }
    __device__ __forceinline__ void store_part(int row, int col0, int idx, float part) const {
        if (kind == K_SGU && col0 >= 1024) vssq[(size_t)row * 16 + idx] = part;
    }
    static constexpr bool GROUPMAX = true;
    unsigned* qkmax;
    const LAS float* rs_tab = nullptr; int rs_row0 = -1;
    __device__ __forceinline__ bool want_groupmax(int col0) const { return kind == K_DIFF && col0 < 2048; }
    __device__ __forceinline__ void store_groupmax(int row, int col0, float m) const {
        atomicMax(qkmax + (row >> 13) * 64 + (col0 >> 5), __float_as_uint(m * 1.01f));
    }
};
struct EpiHid {
    bf16* h; const float* ssq;
    const LAS float* rs_tab = nullptr; int rs_row0 = -1;
    static constexpr bool NEEDS_RS = true;
    __device__ __forceinline__ float rowscale(int row) const { const unsigned d = (unsigned)(row - rs_row0); return (d < 256u) ? rs_tab[d] : row_rstd(ssq, row); }
    __device__ __forceinline__ float apply8(int row, int col0, const float (&v)[8], float rs) const {
        float o[8];
#pragma unroll
        for (int j = 0; j < 8; ++j) { const float a = fmaxf(v[j] * rs, 0.f); o[j] = a * a; }
        v4u w; w.x = pk2(o[0], o[1]); w.y = pk2(o[2], o[3]); w.z = pk2(o[4], o[5]); w.w = pk2(o[6], o[7]);
        *(v4u*)(h + (size_t)row * FF + col0) = w;
        return 0.f;
    }
    __device__ __forceinline__ void store_part(int, int, int, float) const {}
    static constexpr bool GROUPMAX = false;
    __device__ __forceinline__ bool want_groupmax(int) const { return false; }
    __device__ __forceinline__ void store_groupmax(int, int, float) const {}
};
struct EpiRes {
    bf16* xb; float* ssq;
    static constexpr bool NEEDS_RS = false;
    __device__ __forceinline__ float rowscale(int) const { return 1.f; }
    __device__ __forceinline__ float apply8(int row, int col0, const float (&v)[8], float) const {
        const size_t off = (size_t)row * D + col0;
        const v4u bw = *(const v4u*)(xb + off);
        float o[8] = {bflo(bw.x) + v[0], bfhi(bw.x) + v[1], bflo(bw.y) + v[2], bfhi(bw.y) + v[3], bflo(bw.z) + v[4], bfhi(bw.z) + v[5], bflo(bw.w) + v[6], bfhi(bw.w) + v[7]};
        v4u w; w.x = pk2(o[0], o[1]); w.y = pk2(o[2], o[3]); w.z = pk2(o[4], o[5]); w.w = pk2(o[6], o[7]);
        *(v4u*)(xb + off) = w;
        float part = 0.f;
#pragma unroll
        for (int j = 0; j < 8; ++j) part += o[j] * o[j];
        return part;
    }
    __device__ __forceinline__ void store_part(int row, int, int idx, float part) const { ssq[(size_t)row * 16 + idx] = part; }
    static constexpr bool GROUPMAX = false;
    __device__ __forceinline__ bool want_groupmax(int) const { return false; }
    __device__ __forceinline__ void store_groupmax(int, int, float) const {}
};

template <class Epi>
__device__ __forceinline__ void gemm_naive(LAS unsigned char* lds, const bf16* A, int lda, const bf16* Bt, int M, int N, int K, const Epi& E, int vcu, int G) {
    LAS float* As = (LAS float*)lds;
    LAS float* Bs = As + 64 * 33;
    const int tid = otid();
    const int nM = M / 64, nN = N / 64;
    const int r = tid >> 3, cgp = tid & 7;
    for (int u = vcu; u < nM * nN; u += G) {
        const int pm = u / nN, pn = u % nN;
        float acc[8];
#pragma unroll
        for (int j = 0; j < 8; ++j) acc[j] = 0.f;
        for (int k0 = 0; k0 < K; k0 += 32) {
            { const int lr = tid >> 3, lc = (tid & 7) * 4;
              const v2u av = *(const v2u*)(A + (size_t)(pm * 64 + lr) * lda + k0 + lc);
              const v2u bv = *(const v2u*)(Bt + (size_t)(pn * 64 + lr) * K + k0 + lc);
              As[lr * 33 + lc + 0] = bflo(av.x); As[lr * 33 + lc + 1] = bfhi(av.x); As[lr * 33 + lc + 2] = bflo(av.y); As[lr * 33 + lc + 3] = bfhi(av.y);
              Bs[lr * 33 + lc + 0] = bflo(bv.x); Bs[lr * 33 + lc + 1] = bfhi(bv.x); Bs[lr * 33 + lc + 2] = bflo(bv.y); Bs[lr * 33 + lc + 3] = bfhi(bv.y); }
            __syncthreads();
#pragma unroll 8
            for (int kk = 0; kk < 32; ++kk) { const float a = As[r * 33 + kk];
#pragma unroll
                for (int j = 0; j < 8; ++j) acc[j] += a * Bs[(cgp * 8 + j) * 33 + kk]; }
            __syncthreads();
        }
        const int row = pm * 64 + r, col0 = pn * 64 + cgp * 8;
        const float rs = E.rowscale(row);
        float part = E.apply8(row, col0, acc, rs);
        part += __shfl_xor(part, 1); part += __shfl_xor(part, 2); part += __shfl_xor(part, 4);
        if (cgp == 0) E.store_part(row, col0, pn & 15, part);
    }
}

__device__ __forceinline__ void conv_tile(const float* W, const float* gain, int K, int N, bf16* WT, int tile, LAS unsigned char* img, int tid) {
    const int nblk = N >> 7, kb = tile / nblk, nb = tile - kb * nblk, k0 = kb << 7, n0 = nb << 7;
    const int n4 = tid & 31, kk = tid >> 5;
    f32x4 w[8];
    const float* src = W + (size_t)(k0 + 8 * kk) * N + n0 + 4 * n4;
#pragma unroll
    for (int p = 0; p < 8; ++p) w[p] = *(const f32x4*)(src + (size_t)p * N);
    float g[8];
    if (gain) { const f32x4 g0 = *(const f32x4*)(gain + k0 + 8 * kk), g1 = *(const f32x4*)(gain + k0 + 8 * kk + 4);
        g[0] = g0.x; g[1] = g0.y; g[2] = g0.z; g[3] = g0.w; g[4] = g1.x; g[5] = g1.y; g[6] = g1.z; g[7] = g1.w; }
    else {
#pragma unroll
        for (int p = 0; p < 8; ++p) g[p] = 1.f; }
#pragma unroll
    for (int jn = 0; jn < 4; ++jn) {
        v4u o; o.x = pk2(g[0] * w[0][jn], g[1] * w[1][jn]); o.y = pk2(g[2] * w[2][jn], g[3] * w[3][jn]); o.z = pk2(g[4] * w[4][jn], g[5] * w[5][jn]); o.w = pk2(g[6] * w[6][jn], g[7] * w[7][jn]);
        *(LAS v4u*)(img + (4 * n4 + jn) * 256 + ((kk ^ (n4 & 15)) << 4)) = o; }
    __syncthreads();
#pragma unroll
    for (int i = 0; i < 4; ++i) { const int c = tid + NTHR * i, n = c >> 4, kc = c & 15;
        const v4u o = *(const LAS v4u*)(img + n * 256 + ((kc ^ ((n >> 2) & 15)) << 4));
        *(v4u*)(WT + (size_t)(n0 + n) * K + k0 + 8 * kc) = o; }
    __syncthreads();
}

__device__ __forceinline__ void phase_conv(LAS unsigned char* lds, const Ctx& a, const LayerP& P, int L, int vcu, int G) {
    const int tid = otid(), lane = tid & 63, wave = __builtin_amdgcn_readfirstlane(tid >> 6);
    bf16* Wb = (bf16*)(a.ws + WS_W);
    const int gw = vcu * NWAVES + wave, NGW = G * NWAVES;
    const int nin_w = (P.kind == K_SGU) ? 2048 : 3072;
    const int I_IN = (D / 128) * (nin_w / 128), I_OUT = (D / 128) * (D / 128), I_1 = (D / 128) * (FF / 128), I_2 = (FF / 128) * (D / 128);
    const int NITEMS = I_IN + I_OUT + I_1 + I_2;
    for (int it = vcu; it < NITEMS; it += G) {
        int r = it;
        if (r < I_IN) { conv_tile(P.w_in, P.norm1, D, nin_w, Wb + WOFF_IN, r, lds, tid); continue; } r -= I_IN;
        if (r < I_OUT) { conv_tile(P.w_out, nullptr, D, D, Wb + WOFF_OUT, r, lds, tid); continue; } r -= I_OUT;
        if (r < I_1) { conv_tile(P.w1, P.norm2, D, FF, Wb + WOFF_1, r, lds, tid); continue; } r -= I_1;
        conv_tile(P.w2, nullptr, FF, D, Wb + WOFF_2, r, lds, tid);
    }
    if (P.kind == K_GLA) {
        const float* W1 = P.e0; const float* W2 = P.e1;
        for (int e = vcu * NTHR + tid; e < 512 * 1024; e += G * NTHR) {
            const int n = e >> 10, k = e & 1023;
            float s = 0.f;
#pragma unroll
            for (int r = 0; r < 16; ++r) s += W1[k * 16 + r] * W2[r * 512 + n];
            Wb[WOFF_IN + (size_t)(3072 + n) * 1024 + k] = (bf16)f2bf(s * P.norm1[k]);
        }
    }
    if (L == 0) {
        const float* x = a.in0; bf16* xb = (bf16*)(a.ws + WS_XB); float* ssq = (float*)(a.ws + WS_SSQ);
        for (int m = gw; m < NTOK; m += NGW) {
            const f32x4* xr = (const f32x4*)(x + (size_t)m * D) + lane;
            f32x4 v[4]; float s = 0.f;
#pragma unroll
            for (int j = 0; j < 4; ++j) { v[j] = xr[64 * j]; s += (v[j].x * v[j].x + v[j].y * v[j].y) + (v[j].z * v[j].z + v[j].w * v[j].w); }
            s = wave_sum(s);
            v2u* o8 = (v2u*)(xb + (size_t)m * D) + lane;
#pragma unroll
            for (int j = 0; j < 4; ++j) { v2u w; w.x = pk2(v[j].x, v[j].y); w.y = pk2(v[j].z, v[j].w); o8[64 * j] = w; }
            if (lane < 16) ssq[(size_t)m * 16 + lane] = (lane == 0) ? s : 0.f;
        }
    }
}

__device__ __forceinline__ void phase_final(const Ctx& a, int vcu, int G) {
    const int tid = otid(), lane = tid & 63, wave = tid >> 6;
    const int gw = vcu * NWAVES + wave, NGW = G * NWAVES;
    const float* ssq = (const float*)(a.ws + WS_SSQ); const float* g = a.in42; const bf16* xb = (const bf16*)(a.ws + WS_XB);
    for (int m = gw; m < NTOK; m += NGW) {
        const float rs = row_rstd(ssq, m);
        const v4u* xr = (const v4u*)(xb + (size_t)m * D) + lane;
        f32x4* orow = (f32x4*)(a.out + (size_t)m * D); const f32x4* gr = (const f32x4*)g;
#pragma unroll
        for (int jj = 0; jj < 2; ++jj) { const v4u w = xr[64 * jj]; const int c4 = (64 * jj + lane) * 2;
            const f32x4 g0 = gr[c4], g1 = gr[c4 + 1];
            orow[c4] = (f32x4){bflo(w.x) * rs * g0.x, bfhi(w.x) * rs * g0.y, bflo(w.y) * rs * g0.z, bfhi(w.y) * rs * g0.w};
            orow[c4 + 1] = (f32x4){bflo(w.z) * rs * g1.x, bfhi(w.z) * rs * g1.y, bflo(w.w) * rs * g1.z, bfhi(w.w) * rs * g1.w}; }
    }
}

struct GlaCum { float b0[8], b1[8], tot0, tot1; };
__device__ __forceinline__ void gla_cumsum(GlaCum& c, const bf16* proj, int row0, int h, LAS float* TOT, int tid) {
    const int cp = tid & 63, part = tid >> 6;
#pragma unroll
    for (int i = 0; i < 8; ++i) { const unsigned w = *(const unsigned*)(proj + (size_t)(row0 + 8 * part + i) * GLA_PITCH + 3072 + h * 128 + 2 * cp); c.b0[i] = bflo(w); c.b1[i] = bfhi(w); }
#pragma unroll
    for (int i = 1; i < 8; ++i) { c.b0[i] += c.b0[i - 1]; c.b1[i] += c.b1[i - 1]; }
    TOT[part * 128 + 2 * cp] = c.b0[7]; TOT[part * 128 + 2 * cp + 1] = c.b1[7];
    __syncthreads();
    float o0 = 0.f, o1 = 0.f, t0 = 0.f, t1 = 0.f;
#pragma unroll
    for (int p = 0; p < 8; ++p) { const float x0 = TOT[p * 128 + 2 * cp], x1 = TOT[p * 128 + 2 * cp + 1]; if (p < part) { o0 += x0; o1 += x1; } t0 += x0; t1 += x1; }
#pragma unroll
    for (int i = 0; i < 8; ++i) { c.b0[i] += o0; c.b1[i] += o1; }
    c.tot0 = t0; c.tot1 = t1;
}
__device__ __forceinline__ void phase_gla_kv(LAS unsigned char* lds, const Ctx& a, int vcu, int G) {
    const int tid = otid();
    const bf16* proj = (const bf16*)(a.ws + WS_H); bf16* state = (bf16*)(a.ws + WS_STATE); float* dec = (float*)(a.ws + WS_DEC);
    LAS float* KE = (LAS float*)lds;
    LAS float* V = KE + 64 * 128;
    LAS float* TOT = V + 64 * 256;
    for (int u = vcu; u < NB * GLA_H * GLA_NC; u += G) {
        const int n = u % GLA_NC, bh = u / GLA_NC, h = bh % GLA_H, b = bh / GLA_H;
        const int row0 = b * T + n * GLA_C;
        GlaCum c; gla_cumsum(c, proj, row0, h, TOT, tid);
        const int cp = tid & 63, part = tid >> 6;
#pragma unroll
        for (int i = 0; i < 8; ++i) { const int t = 8 * part + i; const unsigned w = *(const unsigned*)(proj + (size_t)(row0 + t) * GLA_PITCH + 512 + h * 128 + 2 * cp);
            KE[t * 128 + 2 * cp] = bflo(w) * __expf(c.tot0 - c.b0[i]); KE[t * 128 + 2 * cp + 1] = bfhi(w) * __expf(c.tot1 - c.b1[i]); }
        if (part == 0) { dec[(size_t)u * 128 + 2 * cp] = __expf(c.tot0); dec[(size_t)u * 128 + 2 * cp + 1] = __expf(c.tot1); }
        { const int vp = tid & 127, rp = tid >> 7;
#pragma unroll
          for (int i = 0; i < 16; ++i) { const int t = 16 * rp + i; const unsigned w = *(const unsigned*)(proj + (size_t)(row0 + t) * GLA_PITCH + 1024 + h * 256 + 2 * vp);
              V[t * 256 + 2 * vp] = bflo(w); V[t * 256 + 2 * vp + 1] = bfhi(w); } }
        __syncthreads();
        const int vd = tid & 255, kh = tid >> 8;
        float acc[64];
#pragma unroll
        for (int j = 0; j < 64; ++j) acc[j] = 0.f;
        for (int t = 0; t < 64; ++t) { const float v = V[t * 256 + vd];
#pragma unroll
            for (int j = 0; j < 64; ++j) acc[j] += KE[t * 128 + kh * 64 + j] * v; }
        bf16* sp = state + ((size_t)u * 256 + vd) * 128 + kh * 64;
#pragma unroll
        for (int j = 0; j < 64; j += 8) { v4u w; w.x = pk2(acc[j], acc[j + 1]); w.y = pk2(acc[j + 2], acc[j + 3]); w.z = pk2(acc[j + 4], acc[j + 5]); w.w = pk2(acc[j + 6], acc[j + 7]); *(v4u*)(sp + j) = w; }
        __syncthreads();
    }
}
__device__ __forceinline__ void phase_gla_scan(const Ctx& a, int vcu, int G) {
    unsigned* state = (unsigned*)(a.ws + WS_STATE); const float* dec = (const float*)(a.ws + WS_DEC);
    for (int gid = vcu * NTHR + otid(); gid < NB * GLA_H * 16384; gid += G * NTHR) {
        const int bh = gid >> 14, e = gid & 16383, kp = e & 63;
        unsigned* sp = state + (size_t)bh * GLA_NC * 16384 + e;
        const float* dp = dec + (size_t)bh * GLA_NC * 128 + 2 * kp;
        float s0 = 0.f, s1 = 0.f;
        for (int n0 = 0; n0 < GLA_NC; n0 += 8) {
            unsigned w[8]; float d0[8], d1[8];
#pragma unroll
            for (int i = 0; i < 8; ++i) { w[i] = sp[(size_t)(n0 + i) * 16384]; d0[i] = dp[(n0 + i) * 128]; d1[i] = dp[(n0 + i) * 128 + 1]; }
#pragma unroll
            for (int i = 0; i < 8; ++i) { sp[(size_t)(n0 + i) * 16384] = pk2(s0, s1); s0 = d0[i] * s0 + bflo(w[i]); s1 = d1[i] * s1 + bfhi(w[i]); }
        }
    }
}
__device__ __forceinline__ void phase_gla_out(LAS unsigned char* lds, const Ctx& a, const LayerP& P, int vcu, int G) {
    const int tid = otid(), lane = tid & 63, wave = tid >> 6;
    bf16* proj = (bf16*)(a.ws + WS_H); const bf16* state = (const bf16*)(a.ws + WS_STATE);
    LAS float* QD = (LAS float*)lds;
    LAS float* KI = QD + 64 * 128;
    LAS float* ATT = KI + 64 * 128;
    LAS unsigned* Vb = (LAS unsigned*)(ATT + 64 * 64);
    LAS float* TOT = (LAS float*)(Vb + 64 * 128);
    LAS float* RSS = TOT + 8 * 128;
    for (int u = vcu; u < NB * GLA_H * GLA_NC; u += G) {
        const int n = u % GLA_NC, bh = u / GLA_NC, h = bh % GLA_H, b = bh / GLA_H;
        const int row0 = b * T + n * GLA_C;
        GlaCum c; gla_cumsum(c, proj, row0, h, TOT, tid);
        const int cp = tid & 63, part = tid >> 6;
#pragma unroll
        for (int i = 0; i < 8; ++i) { const int t = 8 * part + i;
            const unsigned wq = *(const unsigned*)(proj + (size_t)(row0 + t) * GLA_PITCH + h * 128 + 2 * cp);
            const unsigned wk = *(const unsigned*)(proj + (size_t)(row0 + t) * GLA_PITCH + 512 + h * 128 + 2 * cp);
            const float e0 = __expf(c.b0[i]), e1 = __expf(c.b1[i]);
            QD[t * 128 + 2 * cp] = bflo(wq) * 0.08838834764831845f * e0; QD[t * 128 + 2 * cp + 1] = bfhi(wq) * 0.08838834764831845f * e1;
            KI[t * 128 + 2 * cp] = bflo(wk) / e0; KI[t * 128 + 2 * cp + 1] = bfhi(wk) / e1; }
        { const int vp = tid & 127, rp = tid >> 7;
#pragma unroll
          for (int i = 0; i < 16; ++i) { const int t = 16 * rp + i; Vb[t * 128 + vp] = *(const unsigned*)(proj + (size_t)(row0 + t) * GLA_PITCH + 1024 + h * 256 + 2 * vp); } }
        __syncthreads();
        { const int cc = tid >> 3, s0 = (tid & 7) * 8; float acc[8];
#pragma unroll
          for (int j = 0; j < 8; ++j) acc[j] = 0.f;
          for (int d = 0; d < 128; ++d) { const float q = QD[cc * 128 + d];
#pragma unroll
              for (int j = 0; j < 8; ++j) acc[j] += q * KI[(s0 + j) * 128 + d]; }
#pragma unroll
          for (int j = 0; j < 8; ++j) ATT[cc * 64 + s0 + j] = (s0 + j <= cc) ? acc[j] : 0.f; }
        __syncthreads();
        const int vd = tid & 255, ch = tid >> 8;
        float acc[32];
#pragma unroll
        for (int j = 0; j < 32; ++j) acc[j] = 0.f;
        for (int s = 0; s < 64; ++s) { const unsigned w = Vb[s * 128 + (vd >> 1)]; const float v = (vd & 1) ? bfhi(w) : bflo(w);
#pragma unroll
            for (int j = 0; j < 32; ++j) acc[j] += ATT[(ch * 32 + j) * 64 + s] * v; }
        { const bf16* sp = state + ((size_t)u * 256 + vd) * 128;
          for (int d0 = 0; d0 < 128; d0 += 8) { const v4u w = *(const v4u*)(sp + d0);
              const float st[8] = {bflo(w.x), bfhi(w.x), bflo(w.y), bfhi(w.y), bflo(w.z), bfhi(w.z), bflo(w.w), bfhi(w.w)};
#pragma unroll
              for (int dd = 0; dd < 8; ++dd) {
#pragma unroll
                  for (int j = 0; j < 32; ++j) acc[j] += QD[(ch * 32 + j) * 128 + d0 + dd] * st[dd]; } } }
#pragma unroll
        for (int j = 0; j < 32; ++j) { const float s = wave_sum(acc[j] * acc[j]); if (lane == 0) RSS[wave * 32 + j] = s; }
        __syncthreads();
        const float hn = P.e3[vd];
#pragma unroll
        for (int j = 0; j < 32; ++j) { const int cc = ch * 32 + j;
            const float ss = (RSS[(ch * 4 + 0) * 32 + j] + RSS[(ch * 4 + 1) * 32 + j]) + (RSS[(ch * 4 + 2) * 32 + j] + RSS[(ch * 4 + 3) * 32 + j]);
            const float rs = 1.0f / sqrtf(ss * (1.0f / 256.0f) + EPS);
            const float g = bf2f(proj[(size_t)(row0 + cc) * GLA_PITCH + 2048 + h * 256 + vd]);
            const float o = acc[j] * rs * hn * (g / (1.f + __expf(-g)));
            proj[(size_t)(row0 + cc) * GLA_PITCH + 1024 + h * 256 + vd] = (bf16)f2bf(o); }
        __syncthreads();
    }
}

__device__ __forceinline__ void phase_sgu(LAS unsigned char* lds, const Ctx& a, const LayerP& P, int vcu, int G) {
    const int tid = otid();
    bf16* proj = (bf16*)(a.ws + WS_H); const float* vssq = (const float*)(a.ws + WS_VSSQ);
    const float* v_norm = P.e1; const float* w_s = P.e2; const float* b_s = P.e3;
    LAS float* W = (LAS float*)lds;
    LAS float* V = W + 128 * 128;
    for (int u = vcu; u < NB * (T / SGU_C) * SGU_G; u += G) {
        const int g = u % SGU_G, bc = u / SGU_G;
        const int row0 = bc * SGU_C;
        for (int e = tid; e < 128 * 128; e += NTHR) { const int t = e >> 7, s = e & 127;
            const float rs = row_rstd(vssq, row0 + s);
            W[e] = (s <= t) ? w_s[(size_t)g * 16384 + e] * rs : 0.f;
            V[e] = bf2f(proj[(size_t)(row0 + t) * SGU_PITCH + 1024 + g * 128 + s]); }
        __syncthreads();
        const int d = tid & 127, tq = tid >> 7;
        float acc[32];
#pragma unroll
        for (int j = 0; j < 32; ++j) acc[j] = 0.f;
        for (int s = 0; s < 128; ++s) { const float v = V[s * 128 + d];
#pragma unroll
            for (int j = 0; j < 32; ++j) acc[j] += W[(tq + 4 * j) * 128 + s] * v; }
        const float vn = v_norm[g * 128 + d];
#pragma unroll
        for (int j = 0; j < 32; ++j) { const int t = tq + 4 * j;
            const float sv = vn * acc[j] + b_s[g * 128 + t];
            bf16* up = proj + (size_t)(row0 + t) * SGU_PITCH + g * 128 + d;
            *up = (bf16)f2bf(bf2f(*up) * sv); }
        __syncthreads();
    }
}

__device__ __forceinline__ void phase_diff(LAS unsigned char* lds, const Ctx& a, const LayerP& P, int vcu, int G) {
    const int tid = otid(), lane = tid & 63, wave = tid >> 6;
    bf16* proj = (bf16*)(a.ws + WS_H);
    LAS float* Ks = (LAS float*)lds;
    LAS float* Vs = Ks + 64 * 132;
    LAS float* Qs = Vs + 64 * 128;
    LAS float* Ps = Qs + 32 * 128;
    float lam;
    { float s1 = 0.f, s2 = 0.f;
      for (int i = 0; i < 64; ++i) { s1 += P.e0[i] * P.e1[i]; s2 += P.e2[i] * P.e3[i]; }
      lam = __expf(s1) - __expf(s2) + LAMBDA_INIT; }
    const float* head_norm = P.e4;
    const int NU = NB * DIFF_H * (T / 32);
    for (int u = vcu; u < NU; u += G) {
        const int qb = (T / 32 - 1) - (u / (NB * DIFF_H)), bh = u % (NB * DIFF_H), h = bh % DIFF_H, b = bh / DIFF_H;
        const int q0 = qb * 32; const size_t rowbase = (size_t)b * T;
        const float slope2 = exp2f(-(float)(h + 1)) * LOG2E;
        __syncthreads();
        for (int e = tid; e < 32 * 64; e += NTHR) { const int r = e >> 6, c2 = e & 63;
            const unsigned w = *(const unsigned*)(proj + (rowbase + q0 + r) * DIFF_PITCH + h * 128 + 2 * c2);
            Qs[r * 128 + 2 * c2] = bflo(w); Qs[r * 128 + 2 * c2 + 1] = bfhi(w); }
        float m1[4], l1[4], m2[4], l2[4], oa1[4], ob1[4], oa2[4], ob2[4];
#pragma unroll
        for (int i = 0; i < 4; ++i) { m1[i] = -1e30f; m2[i] = -1e30f; l1[i] = 0.f; l2[i] = 0.f; oa1[i] = 0.f; ob1[i] = 0.f; oa2[i] = 0.f; ob2[i] = 0.f; }
        const int ntile = (q0 + 31) / 64 + 1;
        for (int kt = 0; kt < ntile; ++kt) {
            __syncthreads();
            for (int e = tid; e < 64 * 64; e += NTHR) { const int r = e >> 6, c2 = e & 63;
                const unsigned wk = *(const unsigned*)(proj + (rowbase + kt * 64 + r) * DIFF_PITCH + 1024 + h * 128 + 2 * c2);
                const unsigned wv = *(const unsigned*)(proj + (rowbase + kt * 64 + r) * DIFF_PITCH + 2048 + h * 128 + 2 * c2);
                Ks[r * 132 + 2 * c2] = bflo(wk); Ks[r * 132 + 2 * c2 + 1] = bfhi(wk);
                Vs[r * 128 + 2 * c2] = bflo(wv); Vs[r * 128 + 2 * c2 + 1] = bfhi(wv); }
            __syncthreads();
            const int kpos = kt * 64 + lane;
#pragma unroll
            for (int i = 0; i < 4; ++i) {
                const int r = wave + 8 * i, qpos = q0 + r;
                if (kt * 64 > qpos) continue;
                float s1 = 0.f, s2 = 0.f;
                const LAS f32x4* qp = (const LAS f32x4*)(Qs + r * 128); const LAS f32x4* kp = (const LAS f32x4*)(Ks + lane * 132);
#pragma unroll
                for (int d = 0; d < 16; ++d) { const f32x4 q = qp[d], k = kp[d]; s1 += (q.x * k.x + q.y * k.y) + (q.z * k.z + q.w * k.w); }
#pragma unroll
                for (int d = 16; d < 32; ++d) { const f32x4 q = qp[d], k = kp[d]; s2 += (q.x * k.x + q.y * k.y) + (q.z * k.z + q.w * k.w); }
                const float bias = slope2 * (float)(qpos - kpos);
                const bool ok = kpos <= qpos;
                s1 = ok ? s1 - bias : -1e30f; s2 = ok ? s2 - bias : -1e30f;
                const float mn1 = fmaxf(m1[i], wave_max(s1)), mn2 = fmaxf(m2[i], wave_max(s2));
                const float p1 = ok ? exp2f(s1 - mn1) : 0.f, p2 = ok ? exp2f(s2 - mn2) : 0.f;
                const float a1 = exp2f(m1[i] - mn1), a2 = exp2f(m2[i] - mn2);
                l1[i] = l1[i] * a1 + wave_sum(p1); l2[i] = l2[i] * a2 + wave_sum(p2); m1[i] = mn1; m2[i] = mn2;
                Ps[wave * 128 + lane] = p1; Ps[wave * 128 + 64 + lane] = p2;
                LDS_WAIT();
                float x1 = 0.f, y1 = 0.f, x2 = 0.f, y2 = 0.f;
                for (int j = 0; j < 64; ++j) { const float pa = Ps[wave * 128 + j], pb = Ps[wave * 128 + 64 + j]; const float va = Vs[j * 128 + lane], vb = Vs[j * 128 + 64 + lane];
                    x1 += pa * va; y1 += pa * vb; x2 += pb * va; y2 += pb * vb; }
                oa1[i] = oa1[i] * a1 + x1; ob1[i] = ob1[i] * a1 + y1; oa2[i] = oa2[i] * a2 + x2; ob2[i] = ob2[i] * a2 + y2;
                LDS_WAIT();
            }
        }
#pragma unroll
        for (int i = 0; i < 4; ++i) {
            const int r = wave + 8 * i;
            const float oa = oa1[i] / l1[i] - lam * (oa2[i] / l2[i]), ob = ob1[i] / l1[i] - lam * (ob2[i] / l2[i]);
            const float ss = wave_sum(oa * oa + ob * ob);
            const float rs = (1.0f / sqrtf(ss * (1.0f / 128.0f) + EPS)) * (1.0f - LAMBDA_INIT);
            bf16* op = proj + (rowbase + q0 + r) * DIFF_PITCH + h * 128;
            op[lane] = (bf16)f2bf(oa * rs * head_norm[lane]); op[64 + lane] = (bf16)f2bf(ob * rs * head_norm[64 + lane]);
        }
    }
}

namespace pg8 {
#define PG8_LAS __attribute__((address_space(3)))
typedef unsigned short bf16_t;
typedef short bf16x8 __attribute__((ext_vector_type(8)));
typedef float f32x4 __attribute__((ext_vector_type(4)));
typedef unsigned u32x4 __attribute__((ext_vector_type(4)));
constexpr int BM = 256, BK = 64, HALF = 128, HTB = HALF * BK * 2  , STAGE_BYTES = 8 * HTB, NXCD = 8, WGM = 8;

__host__ __device__ __forceinline__ int lds_byte(int r, int c) { const int st = (r >> 4) * 2 + (c >> 5), rr = r & 15, cc = c & 31, ob = rr * 64 + cc * 2; return st * 1024 + (ob ^ (((ob >> 9) & 1) << 5)); }
__host__ __device__ __forceinline__ void stage_rc(int b, int& R, int& C) { const int st = b / 1024, sb = b % 1024, swz = sb ^ (((sb >> 9) & 1) << 5); R = (st >> 1) * 16 + swz / 64; C = (st & 1) * 32 + (swz % 64) / 2; }
__host__ __device__ __forceinline__ int perm32(int rho) { const int n = rho >> 4, i = rho & 15; return 8 * (i >> 2) + 4 * n + (i & 3); }

struct Unit { int pm, pn; };
struct Gemm { const bf16_t* A; int lda; const bf16_t* Bt; int M, N, K; };

struct StaticOrder {
    int nM, nN, nwg, G, c;
    __host__ __device__ void init(int M, int N, int G_, int c_) { nM = M / BM; nN = N / BM; nwg = nM * nN; G = G_; c = c_; }
    __host__ __device__ bool next(int i, Unit& u) const {
        const long L = (long)i * G + c; if (L >= nwg) return false;
        int wgid = (int)L; { const int q = nwg / NXCD, r = nwg % NXCD, xcd = wgid % NXCD, off = wgid / NXCD; wgid = (xcd < r ? xcd * (q + 1) : r * (q + 1) + (xcd - r) * q) + off; }
        const int nig = WGM * nN, gid = wgid / nig, fm = gid * WGM, gsz = (nM - fm) < WGM ? (nM - fm) : WGM;
        u.pm = fm + ((wgid % nig) % gsz); u.pn = (wgid % nig) / gsz; return true;
    }
    __device__ __forceinline__ void a_ready(const Unit&) const {}
    __device__ __forceinline__ void done(const Unit&) const {}
};

template <class Epi, class Sched, bool ALIGN_EPI = false, bool SP2 = false>
__device__ __forceinline__ void gemm_phase(PG8_LAS unsigned char* lds, const Gemm g, const Sched& S, const Epi& E) {
    const int tid = otid(), wid = __builtin_amdgcn_readfirstlane(tid >> 6), lane = tid & 63, wr = wid >> 2, wc = wid & 3, fr = lane & 15, fq = lane >> 4;
    const int K = g.K, nt = K / BK, lda = g.lda;
    unsigned voffA[2], voffB[2];
#pragma unroll
    for (int i = 0; i < 2; ++i) { int R, C; stage_rc(tid * 16 + i * 8192, R, C); const int Rb = Epi::PERM ? ((R & ~31) + perm32(R & 31)) : R;
        voffA[i] = (unsigned)(R * lda + C) * 2u; voffB[i] = (unsigned)(Rb * K + C) * 2u; }
    const size_t kstep = (size_t)(BK * 2);
    const size_t hstepA = (size_t)HALF * lda * 2, hstepB = (size_t)HALF * K * 2;
    const size_t tstepA = 2 * hstepA, tstepB = 2 * hstepB;
    const unsigned ldsw = (unsigned)wid * 1024u;
    const int aoff = lds_byte(wr * 64 + fr, fq * 8), boff = lds_byte(wc * 32 + fr, fq * 8);
#define PG8_SA(b, h) (((b) * 2 + (h)) * HTB)
#define PG8_SB(b, h) ((4 + (b) * 2 + (h)) * HTB)
#define PG8_STAGE(bufoff, gbase, voff) do { _Pragma("unroll") for (int _i = 0; _i < 2; ++_i) \
        __builtin_amdgcn_global_load_lds((const unsigned*)((const char*)(gbase) + (voff)[_i]), (PG8_LAS unsigned*)(lds + (bufoff) + ldsw + _i * 8192), 16, 0, 0); } while (0)
#define PG8_LDA(dst, b, h) do { _Pragma("unroll") for (int m = 0; m < 4; ++m) _Pragma("unroll") for (int k = 0; k < 2; ++k) dst[m][k] = *(const PG8_LAS bf16x8*)(lds + PG8_SA(b, h) + aoff + m * 2048 + k * 1024); } while (0)
#define PG8_LDB(dst, b, h) do { _Pragma("unroll") for (int n = 0; n < 2; ++n) _Pragma("unroll") for (int k = 0; k < 2; ++k) dst[n][k] = *(const PG8_LAS bf16x8*)(lds + PG8_SB(b, h) + boff + n * 2048 + k * 1024); } while (0)
#define PG8_MMA(ai, bj, At, Bt) do { __builtin_amdgcn_s_setprio(1); _Pragma("unroll") for (int m = 0; m < 4; ++m) _Pragma("unroll") for (int n = 0; n < 2; ++n) _Pragma("unroll") for (int k = 0; k < 2; ++k) \
        acc[ai][bj][m][n] = __builtin_amdgcn_mfma_f32_16x16x32_bf16(Bt[n][k], At[m][k], acc[ai][bj][m][n], 0, 0, 0); __builtin_amdgcn_s_setprio(0); } while (0)
#define PG8_WAIT_V(n) asm volatile("s_waitcnt vmcnt(" #n ")" ::: "memory")
#define PG8_WAIT_L(n) asm volatile("s_waitcnt lgkmcnt(" #n ")" ::: "memory")
#define PG8_BAR __builtin_amdgcn_s_barrier()
#define PG8_SCHED __builtin_amdgcn_sched_barrier(0)
    Unit cur, nxt; int ui = 0;
    if (!S.next(0, cur)) return;
    f32x4 acc[2][2][4][2];
#pragma unroll
    for (int a = 0; a < 2; ++a)
#pragma unroll
        for (int b = 0; b < 2; ++b)
#pragma unroll
            for (int m = 0; m < 4; ++m)
#pragma unroll
                for (int n = 0; n < 2; ++n) acc[a][b][m][n] = (f32x4){0.f, 0.f, 0.f, 0.f};
    bf16x8 At[4][2], B0[2][2], B1[2][2];
    const char* cA = (const char*)g.A + (size_t)cur.pm * tstepA; const char* cB = (const char*)g.Bt + (size_t)cur.pn * tstepB;
    S.a_ready(cur);
    if constexpr (SP2) {
        PG8_STAGE(PG8_SB(0, 0), cB, voffB); PG8_STAGE(PG8_SB(0, 1), cB + hstepB, voffB); PG8_STAGE(PG8_SA(0, 0), cA, voffA); PG8_STAGE(PG8_SA(0, 1), cA + hstepA, voffA);
        if (wr == 1) PG8_BAR;
        PG8_WAIT_V(2); PG8_BAR;
        PG8_STAGE(PG8_SB(1, 0), cB + kstep, voffB); PG8_STAGE(PG8_SA(1, 0), cA + kstep, voffA); PG8_STAGE(PG8_SB(1, 1), cB + hstepB + kstep, voffB);
        PG8_WAIT_V(6); PG8_BAR;
    } else {
        PG8_STAGE(PG8_SB(0, 0), cB, voffB); PG8_STAGE(PG8_SA(0, 0), cA, voffA); PG8_STAGE(PG8_SB(0, 1), cB + hstepB, voffB); PG8_STAGE(PG8_SA(0, 1), cA + hstepA, voffA);
        if (wr == 1) PG8_BAR;
        PG8_WAIT_V(4); PG8_BAR;
        PG8_STAGE(PG8_SB(1, 0), cB + kstep, voffB); PG8_STAGE(PG8_SA(1, 0), cA + kstep, voffA); PG8_STAGE(PG8_SB(1, 1), cB + hstepB + kstep, voffB);
        PG8_WAIT_V(6); PG8_BAR;
    }
    for (;;) {
        const bool has_next = S.next(ui + 1, nxt);
        const char* nA = has_next ? (const char*)g.A + (size_t)nxt.pm * tstepA : cA; const char* nB = has_next ? (const char*)g.Bt + (size_t)nxt.pn * tstepB : cB;
        for (int t = 0; t < nt; t += 2) {
            const bool last = (t == nt - 2);
            const char* a1 = cA + (size_t)(t + 1) * kstep;
            const char* a2 = last ? nA : cA + (size_t)(t + 2) * kstep; const char* b2 = last ? nB : cB + (size_t)(t + 2) * kstep;
            const char* a3 = a2 + kstep; const char* b3 = b2 + kstep;
            if (last && has_next) S.a_ready(nxt);
            if constexpr (SP2) {
            PG8_LDB(B0, 0, 0); PG8_LDB(B1, 0, 1); PG8_SCHED; PG8_LDA(At, 0, 0); PG8_STAGE(PG8_SA(1, 1), a1 + hstepA, voffA);
            PG8_WAIT_V(8); PG8_WAIT_L(0); PG8_BAR; PG8_MMA(0, 0, At, B0); PG8_MMA(0, 1, At, B1); PG8_BAR; PG8_SCHED;
            PG8_LDA(At, 0, 1); PG8_STAGE(PG8_SB(0, 0), b2, voffB); PG8_STAGE(PG8_SB(0, 1), b2 + hstepB, voffB); PG8_STAGE(PG8_SA(0, 0), a2, voffA);
            PG8_WAIT_V(8); PG8_WAIT_L(0); PG8_BAR; PG8_MMA(1, 0, At, B0); PG8_MMA(1, 1, At, B1); PG8_BAR; PG8_SCHED;
            PG8_LDB(B0, 1, 0); PG8_LDB(B1, 1, 1); PG8_SCHED; PG8_LDA(At, 1, 0); PG8_STAGE(PG8_SA(0, 1), a2 + hstepA, voffA);
            PG8_WAIT_V(8); PG8_WAIT_L(0); PG8_BAR; PG8_MMA(0, 0, At, B0); PG8_MMA(0, 1, At, B1); PG8_BAR; PG8_SCHED;
            PG8_LDA(At, 1, 1); PG8_STAGE(PG8_SB(1, 0), b3, voffB); PG8_STAGE(PG8_SB(1, 1), b3 + hstepB, voffB); PG8_STAGE(PG8_SA(1, 0), a3, voffA);
            PG8_WAIT_V(8); PG8_WAIT_L(0); PG8_BAR; PG8_MMA(1, 0, At, B0); PG8_MMA(1, 1, At, B1); PG8_BAR; PG8_SCHED;
            } else {
            PG8_LDB(B0, 0, 0); PG8_SCHED; PG8_LDA(At, 0, 0); PG8_STAGE(PG8_SA(1, 1), a1 + hstepA, voffA);
            PG8_WAIT_L(8); PG8_BAR; PG8_WAIT_L(0); PG8_MMA(0, 0, At, B0); PG8_BAR; PG8_SCHED;
            PG8_LDB(B1, 0, 1); PG8_STAGE(PG8_SB(0, 0), b2, voffB);
            PG8_BAR; PG8_WAIT_L(0); PG8_MMA(0, 1, At, B1); PG8_BAR;
            PG8_LDA(At, 0, 1); PG8_STAGE(PG8_SA(0, 0), a2, voffA);
            PG8_BAR; PG8_WAIT_L(0); PG8_MMA(1, 0, At, B0); PG8_BAR; PG8_SCHED;
            PG8_STAGE(PG8_SB(0, 1), b2 + hstepB, voffB);
            PG8_WAIT_V(6); PG8_BAR; PG8_MMA(1, 1, At, B1); PG8_BAR;
            PG8_LDB(B0, 1, 0); PG8_SCHED; PG8_LDA(At, 1, 0); PG8_STAGE(PG8_SA(0, 1), a2 + hstepA, voffA);
            PG8_WAIT_L(8); PG8_BAR; PG8_WAIT_L(0); PG8_MMA(0, 0, At, B0); PG8_BAR; PG8_SCHED;
            PG8_LDB(B1, 1, 1); PG8_STAGE(PG8_SB(1, 0), b3, voffB);
            PG8_BAR; PG8_WAIT_L(0); PG8_MMA(0, 1, At, B1); PG8_BAR;
            PG8_LDA(At, 1, 1); PG8_STAGE(PG8_SA(1, 0), a3, voffA);
            PG8_BAR; PG8_WAIT_L(0); PG8_MMA(1, 0, At, B0); PG8_BAR; PG8_SCHED;
            PG8_STAGE(PG8_SB(1, 1), b3 + hstepB, voffB);
            PG8_WAIT_V(6); PG8_BAR; PG8_MMA(1, 1, At, B1); PG8_BAR;
            }
        }
        if constexpr (ALIGN_EPI) { if (wr == 0) PG8_BAR; }
        if constexpr (!Epi::AFTER_DRAIN) { E(acc, cur, wr, wc, fr, fq); S.done(cur); }
        if (!has_next) break;
#pragma unroll
        for (int a = 0; a < 2; ++a)
#pragma unroll
            for (int b = 0; b < 2; ++b)
#pragma unroll
                for (int m = 0; m < 4; ++m)
#pragma unroll
                    for (int n = 0; n < 2; ++n) acc[a][b][m][n] = (f32x4){0.f, 0.f, 0.f, 0.f};
        cur = nxt; cA = nA; cB = nB; ++ui;
        if constexpr (ALIGN_EPI) { if (wr == 1) PG8_BAR; }
    }
    PG8_WAIT_V(0);
    if constexpr (!ALIGN_EPI) { if (wr == 0) PG8_BAR; }
    PG8_BAR;
    if constexpr (Epi::AFTER_DRAIN) { E.fused(acc, cur, wr, wc, fr, fq, lds, wid, lane); S.done(cur); }
#undef PG8_SA
#undef PG8_SB
#undef PG8_STAGE
#undef PG8_LDA
#undef PG8_LDB
#undef PG8_MMA
#undef PG8_WAIT_V
#undef PG8_WAIT_L
#undef PG8_BAR
#undef PG8_SCHED
}
}

template <class Core> struct EpiMfma {
    static constexpr bool PERM = true, AFTER_DRAIN = false;
    Core c;
    __device__ __forceinline__ void operator()(const pg8::f32x4 (&acc)[2][2][4][2], const pg8::Unit& u, int wr, int wc, int fr, int fq) const {
        float gmax[2] = {0.f, 0.f};
#pragma unroll
        for (int ai = 0; ai < 2; ++ai)
#pragma unroll
            for (int m = 0; m < 4; ++m) {
                const int row = u.pm * 256 + ai * 128 + wr * 64 + m * 16 + fr;
                const float rs = c.rowscale(row);
                float part = 0.f;
#pragma unroll
                for (int bj = 0; bj < 2; ++bj) {
                    const int col0 = u.pn * 256 + bj * 128 + wc * 32 + 8 * fq;
                    const float v[8] = {acc[ai][bj][m][0][0], acc[ai][bj][m][0][1], acc[ai][bj][m][0][2], acc[ai][bj][m][0][3],
                                        acc[ai][bj][m][1][0], acc[ai][bj][m][1][1], acc[ai][bj][m][1][2], acc[ai][bj][m][1][3]};
                    const float p = c.apply8(row, col0, v, rs);
                    part += p;
                    if (Core::GROUPMAX) { float q = p; q += __shfl_xor(q, 16); q += __shfl_xor(q, 32); gmax[bj] = fmaxf(gmax[bj], q); }
                }
                part += __shfl_xor(part, 16); part += __shfl_xor(part, 32);
                if (fq == 0) c.store_part(row, u.pn * 256, (u.pn & 3) * 4 + wc, part);
            }
        if (Core::GROUPMAX) {
#pragma unroll
            for (int bj = 0; bj < 2; ++bj) { const int colg = u.pn * 256 + bj * 128 + wc * 32;
                if (c.want_groupmax(colg)) { const float m = wave_max(gmax[bj]); if (fr == 0 && fq == 0) c.store_groupmax(u.pm * 256, colg, m); } }
        }
    }
};
#ifndef USE_MFMA_GEMM
#define USE_MFMA_GEMM 1
#endif
template <class Core>
__device__ __forceinline__ void run_gemm(LAS unsigned char* lds, const bf16* A, int lda, const bf16* Bt, int M, int N, int K, const Core& c, int vcu, int G) {
#if USE_MFMA_GEMM
    int bxo = (int)blockIdx.x; asm volatile("" : "+s"(bxo));
    pg8::Gemm g{A, lda, Bt, M, N, K}; pg8::StaticOrder S; S.init(M, N, G, bxo);
    EpiMfma<Core> E{c};
    if constexpr (Core::NEEDS_RS) {
        pg8::Unit u0;
        if (S.next(0, u0)) { LAS float* tab = (LAS float*)(lds + LDSCTL_OFF + 1024); const int t_ = otid();
            if (t_ < 256) tab[t_] = row_rstd(c.ssq, u0.pm * 256 + t_);
            E.c.rs_tab = tab; E.c.rs_row0 = u0.pm * 256; }
        __syncthreads();
    }
    pg8::gemm_phase<EpiMfma<Core>, pg8::StaticOrder, true, true>(lds, g, S, E);
#else
    gemm_naive(lds, A, lda, Bt, M, N, K, c, vcu, G);
#endif
}

#include <hip/hip_bf16.h>
#include <cmath>
namespace attn_body {
using bf16=__hip_bfloat16;
using bf16x8=__attribute__((ext_vector_type(8)))short;
using s16x4=__attribute__((ext_vector_type(4)))short;
using f32x16=__attribute__((ext_vector_type(16)))float;
using u32x4=__attribute__((ext_vector_type(4)))unsigned;
constexpr int SEQ=8192,D=64,PQ=3072,PO=2048;
constexpr int NW=8,QBLK=32,QB=QBLK*NW,KVBLK=64,NQB=SEQ/QB;
__device__ __forceinline__ int crow(int r,int hi){return (r&3)+8*(r>>2)+4*hi;}
#define SBAR() __builtin_amdgcn_sched_barrier(0)
__device__ __forceinline__ void cmask(f32x16&p0,f32x16&p1,int jb,int qrel,int hi){
  const float NEG=-INFINITY; int kb=64*jb+4*hi;
  #pragma unroll
  for(int r=0;r<16;++r){int kv=kb+(r&3)+8*(r>>2); if(kv>qrel)p0[r]=NEG; if(kv+32>qrel)p1[r]=NEG;}
}

constexpr int NSLOT=3, SLOTB=8192;
constexpr int LDS_K=0, LDS_V=NSLOT*SLOTB, LDS_WS=2*NSLOT*SLOTB, LDS_OST=LDS_WS+NW*64*4, LDS_BYTES=LDS_OST+NW*4096;
constexpr float C2=0.125f*1.4426950408889634f;
__device__ __forceinline__ void glds16(const void*gsrc,unsigned lds_dst){unsigned keep;
  asm volatile("s_mov_b32 %0, m0\n\ts_mov_b32 m0, %2\n\ts_nop 0\n\tglobal_load_lds_dwordx4 %1, off\n\ts_mov_b32 m0, %0":"=&s"(keep):"v"(gsrc),"s"(lds_dst):"memory");}
__device__ __forceinline__ float max3f(float a,float b,float c){float r;asm("v_max3_f32 %0, %1, %2, %3":"=v"(r):"v"(a),"v"(b),"v"(c));return r;}
__device__ __forceinline__ float max2f(float a,float b){float r;asm("v_max_f32_e32 %0, %1, %2":"=v"(r):"v"(a),"v"(b));return r;}
__device__ __forceinline__ float fadd_s(float a,float b){float r;asm("v_add_f32_e32 %0, %1, %2":"=v"(r):"v"(a),"v"(b));return r;}
__device__ __forceinline__ float fsub_s(float a,float b){float r;asm("v_sub_f32_e32 %0, %1, %2":"=v"(r):"v"(a),"v"(b));return r;}
typedef float f32x2_t __attribute__((ext_vector_type(2))); typedef __bf16 bf16x2_t __attribute__((ext_vector_type(2)));
__device__ __forceinline__ unsigned cvtpk_s(float lo,float hi){f32x2_t v={lo,hi};bf16x2_t b=__builtin_convertvector(v,bf16x2_t);return __builtin_bit_cast(unsigned,b);}
#define WAIT_BAR(N) asm volatile("s_waitcnt vmcnt(" #N ") lgkmcnt(0)\n\ts_barrier":::"memory")

__device__ __forceinline__ void qkt(f32x16&p0,f32x16&p1,const char*Kslot,const bf16x8*qr,const f32x16&negm,int r32,int hi){
  const char*kb=Kslot+hi*1024+r32*16;
  #pragma unroll
  for(int d0=0;d0<4;++d0){
    const bf16x8 b0=*reinterpret_cast<const bf16x8*>(kb+d0*2048);
    const bf16x8 b1=*reinterpret_cast<const bf16x8*>(kb+d0*2048+512);
    if(d0==0){p0=__builtin_amdgcn_mfma_f32_32x32x16_bf16(b0,qr[0],negm,0,0,0);p1=__builtin_amdgcn_mfma_f32_32x32x16_bf16(b1,qr[0],negm,0,0,0);}
    else{p0=__builtin_amdgcn_mfma_f32_32x32x16_bf16(b0,qr[d0],p0,0,0,0);p1=__builtin_amdgcn_mfma_f32_32x32x16_bf16(b1,qr[d0],p1,0,0,0);}}
}
typedef __attribute__((address_space(3))) const char* lds_cptr;
typedef short v4i16_t __attribute__((ext_vector_type(4)));
__device__ __forceinline__ void kload8(bf16x8*kf,lds_cptr kp){
  kf[0]=*(const __attribute__((address_space(3))) bf16x8*)(kp);      kf[1]=*(const __attribute__((address_space(3))) bf16x8*)(kp+512);
  kf[2]=*(const __attribute__((address_space(3))) bf16x8*)(kp+2048); kf[3]=*(const __attribute__((address_space(3))) bf16x8*)(kp+2560);
  kf[4]=*(const __attribute__((address_space(3))) bf16x8*)(kp+4096); kf[5]=*(const __attribute__((address_space(3))) bf16x8*)(kp+4608);
  kf[6]=*(const __attribute__((address_space(3))) bf16x8*)(kp+6144); kf[7]=*(const __attribute__((address_space(3))) bf16x8*)(kp+6656);
}
__device__ __forceinline__ void kload2(bf16x8*kf,lds_cptr kp,int j){ kf[2*j]=*(const __attribute__((address_space(3))) bf16x8*)(kp+j*2048); kf[2*j+1]=*(const __attribute__((address_space(3))) bf16x8*)(kp+j*2048+512); }
__device__ __forceinline__ s16x4 vtr(lds_cptr p){ return __builtin_bit_cast(s16x4,__builtin_amdgcn_ds_read_tr16_b64_v4i16((__attribute__((address_space(3))) v4i16_t*)p)); }
__device__ __forceinline__ float rowmax(const f32x16&p0,const f32x16&p1){
  float a=max3f(p0[0],p0[1],p1[0]),b=max3f(p0[2],p0[3],p1[1]);a=max3f(a,p1[2],p1[3]);
  #pragma unroll
  for(int r=4;r<16;r+=4){a=max3f(a,p0[r],p0[r+1]);b=max3f(b,p0[r+2],p0[r+3]);a=max3f(a,p1[r],p1[r+1]);b=max3f(b,p1[r+2],p1[r+3]);}
  const float m=max2f(a,b);
  auto rr=__builtin_amdgcn_permlane32_swap(__float_as_uint(m),__float_as_uint(m),false,false);
  return max2f(__uint_as_float(rr[0]),__uint_as_float(rr[1]));
}
__device__ __forceinline__ void pv(f32x16*o,int vb,bf16x8 pa0,bf16x8 pa1,bf16x8 pa2,bf16x8 pa3){
  #pragma unroll
  for(int d0=0;d0<2;++d0){s16x4 lo[4],hi[4];
    #pragma unroll
    for(int ks=0;ks<4;++ks){
      asm volatile("ds_read_b64_tr_b16 %0,%1 offset:%c2":"=&v"(lo[ks]):"v"(vb),"i"(d0*4096+ks*1024):"memory");
      asm volatile("ds_read_b64_tr_b16 %0,%1 offset:%c2":"=&v"(hi[ks]):"v"(vb),"i"(d0*4096+ks*1024+512):"memory");}
    asm volatile("s_waitcnt lgkmcnt(0)":::"memory");SBAR();
    #define PK(k) (bf16x8){lo[k][0],lo[k][1],lo[k][2],lo[k][3],hi[k][0],hi[k][1],hi[k][2],hi[k][3]}
    o[d0]=__builtin_amdgcn_mfma_f32_32x32x16_bf16(pa0,PK(0),o[d0],0,0,0);
    o[d0]=__builtin_amdgcn_mfma_f32_32x32x16_bf16(pa1,PK(1),o[d0],0,0,0);
    o[d0]=__builtin_amdgcn_mfma_f32_32x32x16_bf16(pa2,PK(2),o[d0],0,0,0);
    o[d0]=__builtin_amdgcn_mfma_f32_32x32x16_bf16(pa3,PK(3),o[d0],0,0,0);
    #undef PK
  }
}

#ifndef ATTN_STORE16
#define ATTN_STORE16(p,v) (*(u32x4*)(p)=(v))
#endif
template<int THRL> __device__ __forceinline__ void attn_unit(int b,int qb,int t0,const bf16*Q,const bf16*K,const bf16*V,bf16*O,float slope2,char*shm){
  const int tid=otid(),lane=tid&63,r32=lane&31,hi=lane>>5; const int wid=__builtin_amdgcn_readfirstlane(tid>>6);
  const long rowbase=(long)b*SEQ; const int q0=qb*QB;
  const bf16*Qw=Q+(rowbase+q0+wid*QBLK)*PQ;
  const bf16*Kh=K+(rowbase+(long)t0*KVBLK)*PQ,*Vh=V+(rowbase+(long)t0*KVBLK)*PQ;
  const unsigned lds0=(unsigned)(uintptr_t)shm;
  float*wsf=(float*)(shm+LDS_WS)+wid*64;
  const bf16*ksrc=Kh+(long)lane*PQ+wid*8;
  const bf16*vsrc=Vh+(long)(16*(wid&3)+(lane>>2))*PQ+(wid>>2)*32+(lane&3)*8;
  const unsigned kdst=lds0+LDS_K+wid*1024, vdst=lds0+LDS_V+wid*1024;
  #define DMA_K(t,slot) glds16(ksrc+(long)(t)*KVBLK*PQ,(unsigned)__builtin_amdgcn_readfirstlane(kdst+(slot)))
  #define DMA_V(t,slot) glds16(vsrc+(long)(t)*KVBLK*PQ,(unsigned)__builtin_amdgcn_readfirstlane(vdst+(slot)))
  const int vb0=(int)(lds0+LDS_V)+((lane>>4)&1)*32+(lane&3)*8+(4*hi+((lane&15)>>2))*64;
  const char*Kbase=shm+LDS_K; bf16x8 kf[8];
  const lds_cptr shm3=(lds_cptr)shm; const lds_cptr kp0=shm3+LDS_K+hi*1024+r32*16; const lds_cptr vp0=shm3+LDS_V+((lane>>4)&1)*32+(lane&3)*8+(4*hi+((lane&15)>>2))*64;
  const int NT=(q0+QB)/KVBLK-t0;
  DMA_K(0,0);DMA_V(0,0);DMA_K(1,SLOTB);
  bf16x8 qr[4];
  #pragma unroll
  for(int d0=0;d0<4;++d0)qr[d0]=*reinterpret_cast<const bf16x8*>(&Qw[(long)r32*PQ+d0*16+hi*8]);
  float l_reg=0.f;f32x16 o[2];o[0]=f32x16{};o[1]=f32x16{};f32x16 negm;
  _Pragma("unroll") for(int r=0;r<16;++r)negm[r]=slope2*(float)crow(r,hi);
  asm volatile("":"+v"(negm)); const float b32=32.f*slope2, step64=64.f*slope2;
  const int qrel=wid*QBLK+r32;
  #define CMASK(P0,P1,t) do{int jb_=(t)-(NT-4); if(jb_>=0)cmask(P0,P1,jb_,qrel,hi);}while(0)
  bool resc=false;
  #define START(P0,P1) do{ const float rm=rowmax(P0,P1); resc=false; \
    { const float dl=rm; \
      _Pragma("unroll") for(int r=0;r<16;++r){P0[r]=fsub_s(P0[r],dl);P1[r]=fsub_s(P1[r],dl);} \
      const float adj_=step64-dl; _Pragma("unroll") for(int r=0;r<16;++r)negm[r]+=adj_; asm volatile("":"+v"(negm)); } \
    _Pragma("unroll") for(int r=0;r<16;++r)P0[r]=__builtin_amdgcn_exp2f(P0[r]); }while(0)
  #define RESC() do{ if(resc){ asm volatile("s_waitcnt lgkmcnt(0)":::"memory"); \
      _Pragma("unroll") for(int d_=0;d_<2;++d_) _Pragma("unroll") for(int r=0;r<16;++r)o[d_][r]*=wsf[crow(r,hi)]; } }while(0)
  f32x16 pA0,pA1,pB0,pB1;
  int sl_prev=0,sl_cur=0,sl_next=SLOTB;
  #define ROT() do{sl_prev=sl_cur;sl_cur=sl_next;sl_next=(sl_next==(NSLOT-1)*SLOTB)?0:sl_next+SLOTB;}while(0)
  DMA_K(2,2*SLOTB);
  WAIT_BAR(3);
  qkt(pA0,pA1,Kbase,qr,negm,r32,hi);asm volatile("s_nop 15\n\ts_nop 7":"+v"(pA0),"+v"(pA1));
  _Pragma("unroll") for(int r=0;r<16;++r)pA1[r]+=b32;
  CMASK(pA0,pA1,0);
  START(pA0,pA1);
  _Pragma("unroll") for(int r=0;r<16;++r)pA1[r]=__builtin_amdgcn_exp2f(pA1[r]);
  WAIT_BAR(0);
  DMA_K(3,0);DMA_V(1,SLOTB);
  ROT();
  kload8(kf,kp0+sl_cur);
  WAIT_BAR(2);
  s16x4 vlo[8],vhi[8]; u32x4 pw0,pw1,pw2,pw3;
  #define PKW(P,B) cvtpk_s(P[B],P[B+1])
  #define PAF(k) __builtin_bit_cast(bf16x8,pw##k)
  #define VFR(i) (bf16x8){vlo[i][0],vlo[i][1],vlo[i][2],vlo[i][3],vhi[i][0],vhi[i][1],vhi[i][2],vhi[i][3]}
  #define PIN(x) asm volatile("":"+v"(x))
  #define MX3(a,b,c) __builtin_fmaxf(__builtin_fmaxf((a),(b)),(c))
  #define GAPA(MF,A0,A1,A2,A3,W0,W1,PW) do{ MF; sacc+=A0; sacc+=A1; sacc+=A2; sacc+=A3; PIN(sacc); W0; W1; PIN(PW); SBAR(); }while(0)
  #define EX(v) __builtin_amdgcn_exp2f(v)
  #define GAPB(MF,X,B) do{ MF; X[B]=EX(X[B]); X[B+1]=EX(X[B+1]); X[B+2]=EX(X[B+2]); X[B+3]=EX(X[B+3]); PIN(X); SBAR(); }while(0)
  #define VRD(i) do{ vlo[i]=vtr(vp_+(((i)>>2)*4096+((i)&3)*1024)); vhi[i]=vtr(vp_+(((i)>>2)*4096+((i)&3)*1024+512)); }while(0)
  #define KRD(G,j) do{ if(G){ kload2(kf,kp0+sl_next,j); SBAR(); } }while(0)
  #define STEP(C0,C1,P0,P1,t,GK,GV,GL) do{ SBAR(); \
    const lds_cptr vp_=vp0+sl_prev; \
    VRD(0); SBAR(); float sacc=(P0[0]+P0[1]); \
    GAPA(C0=__builtin_amdgcn_mfma_f32_32x32x16_bf16(kf[0],qr[0],negm,0,0,0), P0[2],P0[3],P0[4],P0[5],     pw0[0]=PKW(P0,0), pw0[1]=PKW(P0,2), pw0); \
    VRD(4); SBAR(); GAPA(C1=__builtin_amdgcn_mfma_f32_32x32x16_bf16(kf[1],qr[0],negm,0,0,0), P0[6],P0[7],P0[8],P0[9],     pw0[2]=PKW(P0,4), pw0[3]=PKW(P0,6), pw0); \
    VRD(1); SBAR(); GAPA(C0=__builtin_amdgcn_mfma_f32_32x32x16_bf16(kf[2],qr[1],C0,0,0,0),   P0[10],P0[11],P0[12],P0[13], pw1[0]=PKW(P0,8), pw1[1]=PKW(P0,10), pw1); \
    VRD(5); SBAR(); GAPA(C1=__builtin_amdgcn_mfma_f32_32x32x16_bf16(kf[3],qr[1],C1,0,0,0),   P0[14],P0[15],P1[0],P1[1],   pw1[2]=PKW(P0,12),pw1[3]=PKW(P0,14), pw1); \
    VRD(2); SBAR(); GAPA(C0=__builtin_amdgcn_mfma_f32_32x32x16_bf16(kf[4],qr[2],C0,0,0,0),   P1[2],P1[3],P1[4],P1[5],     pw2[0]=PKW(P1,0), pw2[1]=PKW(P1,2), pw2); \
    VRD(6); SBAR(); GAPA(C1=__builtin_amdgcn_mfma_f32_32x32x16_bf16(kf[5],qr[2],C1,0,0,0),   P1[6],P1[7],P1[8],P1[9],     pw2[2]=PKW(P1,4), pw2[3]=PKW(P1,6), pw2); \
    VRD(3); SBAR(); GAPA(C0=__builtin_amdgcn_mfma_f32_32x32x16_bf16(kf[6],qr[3],C0,0,0,0),   P1[10],P1[11],P1[12],P1[13], pw3[0]=PKW(P1,8), pw3[1]=PKW(P1,10), pw3); \
    VRD(7); SBAR(); GAPA(C1=__builtin_amdgcn_mfma_f32_32x32x16_bf16(kf[7],qr[3],C1,0,0,0),   P1[14],P1[15],0.f,0.f,       pw3[2]=PKW(P1,12),pw3[3]=PKW(P1,14), pw3); \
    l_reg+=sacc; \
    if(GK){DMA_K((t)+3,sl_cur);} if(GV){DMA_V((t)+1,sl_next);} \
    _Pragma("unroll") for(int r=0;r<16;++r)C1[r]+=b32; \
    CMASK(C0,C1,t); \
    { float a=MX3(C0[0],C0[1],C1[0]),b=MX3(C0[2],C0[3],C1[1]); a=MX3(a,C1[2],C1[3]); \
      _Pragma("unroll") for(int r=4;r<16;r+=4){a=MX3(a,C0[r],C0[r+1]);b=MX3(b,C0[r+2],C0[r+3]);a=MX3(a,C1[r],C1[r+1]);b=MX3(b,C1[r+2],C1[r+3]);} \
      float rm=__builtin_fmaxf(a,b); { auto rr=__builtin_amdgcn_permlane32_swap(__float_as_uint(rm),__float_as_uint(rm),false,false); rm=__builtin_fmaxf(__uint_as_float(rr[0]),__uint_as_float(rr[1])); } \
      resc=false; float adj_=step64; \
      if(__any(rm>(float)THRL)){ const float dl=__builtin_fmaxf(rm,0.f); adj_-=dl; \
        _Pragma("unroll") for(int r=0;r<16;++r){C0[r]-=dl;C1[r]-=dl;} \
        const float f=__builtin_amdgcn_exp2f(-dl); l_reg*=f; if(hi==0)wsf[r32]=f; resc=true; } \
      _Pragma("unroll") for(int r=0;r<16;++r)negm[r]+=adj_; asm volatile("":"+v"(negm)); } \
    SBAR(); \
    GAPB(o[0]=__builtin_amdgcn_mfma_f32_32x32x16_bf16(PAF(0),VFR(0),o[0],0,0,0), C0,0); \
    GAPB(o[1]=__builtin_amdgcn_mfma_f32_32x32x16_bf16(PAF(0),VFR(4),o[1],0,0,0), C0,4); \
    KRD(GL,0); GAPB(o[0]=__builtin_amdgcn_mfma_f32_32x32x16_bf16(PAF(1),VFR(1),o[0],0,0,0), C0,8); \
    KRD(GL,1); GAPB(o[1]=__builtin_amdgcn_mfma_f32_32x32x16_bf16(PAF(1),VFR(5),o[1],0,0,0), C0,12); \
    KRD(GL,2); GAPB(o[0]=__builtin_amdgcn_mfma_f32_32x32x16_bf16(PAF(2),VFR(2),o[0],0,0,0), C1,0); \
    KRD(GL,3); GAPB(o[1]=__builtin_amdgcn_mfma_f32_32x32x16_bf16(PAF(2),VFR(6),o[1],0,0,0), C1,4); \
    GAPB(o[0]=__builtin_amdgcn_mfma_f32_32x32x16_bf16(PAF(3),VFR(3),o[0],0,0,0), C1,8); \
    GAPB(o[1]=__builtin_amdgcn_mfma_f32_32x32x16_bf16(PAF(3),VFR(7),o[1],0,0,0), C1,12); \
    }while(0)
  int t=1;
  #undef CMASK
  #define CMASK(P0,P1,t) do{}while(0)
  for(;t+5<NT;t+=2){
    STEP(pB0,pB1,pA0,pA1,t,true,true,true);     WAIT_BAR(2); RESC(); ROT();
    STEP(pA0,pA1,pB0,pB1,t+1,true,true,true);   WAIT_BAR(2); RESC(); ROT();
  }
  #undef CMASK
  #define CMASK(P0,P1,t) do{int jb_=(t)-(NT-4); if(jb_>=0)cmask(P0,P1,jb_,qrel,hi);}while(0)
  #define ENDW(tt) do{ if((tt)+3<NT){WAIT_BAR(2);} else if((tt)+2<NT){WAIT_BAR(1);} else {WAIT_BAR(0);} }while(0)
  for(;t+1<NT;t+=2){
    STEP(pB0,pB1,pA0,pA1,t,(t+3<NT),(t+1<NT),(t+1<NT));       ENDW(t);   RESC(); ROT();
    STEP(pA0,pA1,pB0,pB1,t+1,(t+4<NT),(t+2<NT),(t+2<NT));     ENDW(t+1); RESC(); ROT();
  }
  STEP(pB0,pB1,pA0,pA1,NT-1,false,false,false); RESC();
  { float sacc=pB0[0]+pB0[1]; _Pragma("unroll") for(int r=2;r<16;++r)sacc+=pB0[r]; _Pragma("unroll") for(int r=0;r<16;++r)sacc+=pB1[r]; l_reg+=sacc;
    pw0=(u32x4){PKW(pB0,0),PKW(pB0,2),PKW(pB0,4),PKW(pB0,6)};pw1=(u32x4){PKW(pB0,8),PKW(pB0,10),PKW(pB0,12),PKW(pB0,14)};pw2=(u32x4){PKW(pB1,0),PKW(pB1,2),PKW(pB1,4),PKW(pB1,6)};pw3=(u32x4){PKW(pB1,8),PKW(pB1,10),PKW(pB1,12),PKW(pB1,14)};
    SBAR(); pv(o,vb0+sl_cur,PAF(0),PAF(1),PAF(2),PAF(3)); }
  #undef PKW
  #undef PAF
  #undef VFR
  #undef PIN
  #undef MX3
  #undef GAPA
  #undef GAPB
  #undef EX
  #undef VRD
  #undef KRD
  #undef STEP
  #undef ENDW
  {auto rr=__builtin_amdgcn_permlane32_swap(__float_as_uint(l_reg),__float_as_uint(l_reg),false,false);l_reg=__uint_as_float(rr[0])+__uint_as_float(rr[1]);}
  if(hi==0)wsf[32+r32]=l_reg;asm volatile("s_waitcnt lgkmcnt(0)":::"memory");
  float rli[16];
  #pragma unroll
  for(int r=0;r<16;++r)rli[r]=__builtin_amdgcn_rcpf(wsf[32+crow(r,hi)]);
  bf16*Ow=O+(rowbase+q0+wid*QBLK)*PO;
  { bf16*stg=(bf16*)(shm+LDS_OST)+wid*2048;
    #pragma unroll
    for(int r=0;r<16;++r){const int orow=crow(r,hi);
      #pragma unroll
      for(int d0=0;d0<2;++d0)stg[orow*64+d0*32+r32]=__float2bfloat16(o[d0][r]*rli[r]);}
    asm volatile("s_waitcnt lgkmcnt(0)":::"memory");
    #pragma unroll
    for(int i=0;i<4;++i){const int row=i*8+(lane>>3),ch=lane&7; const u32x4 v=*(const u32x4*)(stg+row*64+ch*8); ATTN_STORE16(Ow+(long)row*PO+ch*8,v);} }
  asm volatile("s_waitcnt lgkmcnt(0)\n\ts_barrier":::"memory");
  #undef DMA_K
  #undef DMA_V
  #undef CMASK
  #undef START
  #undef RESC
  #undef ROT
}

namespace v2 {
constexpr int NSL=4, KSLOT=8192, VSLOT=16384, LDS_K2=0, LDS_V2=NSL*KSLOT, LDS_WS2=LDS_V2+NSL*VSLOT, LDS_BYTES2=LDS_WS2+NW*64*4;
#define V2_WAIT_BAR(N) asm volatile("s_waitcnt vmcnt(" #N ") lgkmcnt(0)\n\ts_barrier":::"memory")
#define V2_MX3(a,b,c) __builtin_fmaxf(__builtin_fmaxf((a),(b)),(c))
}
template<int THRL> __device__ __forceinline__ void attn_unit_v2(int b,int qb,int t0,const bf16*Q,const bf16*K,const bf16*V,bf16*O,float slope2,char*shm){
  using namespace v2;
  const int tid=otid(),lane=tid&63,r32=lane&31,hi=lane>>5; const int wid=__builtin_amdgcn_readfirstlane(tid>>6);
  const long rowbase=(long)b*SEQ; const int q0=qb*QB;
  const bf16*Qw=Q+(rowbase+q0+wid*QBLK)*PQ;
  const bf16*Kh=K+(rowbase+(long)t0*KVBLK)*PQ,*Vh=V+(rowbase+(long)t0*KVBLK)*PQ;
  const unsigned lds0=(unsigned)(uintptr_t)shm;
  float*wsf=(float*)(shm+LDS_WS2)+wid*64;
  const bf16*ksrc=Kh+(long)lane*PQ+wid*8;
  const int pi0=2*wid, pi1=2*wid+1;
  const bf16*vsrc0=Vh+(long)(16*(pi0&3)+(lane>>2))*PQ+(pi0>>2)*32+(lane&3)*8;
  const bf16*vsrc1=Vh+(long)(16*(pi1&3)+(lane>>2))*PQ+(pi1>>2)*32+(lane&3)*8;
  const unsigned kdst=lds0+LDS_K2+wid*1024, vdst0=lds0+LDS_V2+pi0*1024, vdst1=lds0+LDS_V2+pi1*1024;
  #define V2_DMA(t,sl) do{ glds16(ksrc+(long)(t)*KVBLK*PQ,(unsigned)__builtin_amdgcn_readfirstlane(kdst+(sl)*KSLOT)); \
      glds16(vsrc0+(long)(t)*KVBLK*PQ,(unsigned)__builtin_amdgcn_readfirstlane(vdst0+(sl)*VSLOT)); \
      glds16(vsrc1+(long)(t)*KVBLK*PQ,(unsigned)__builtin_amdgcn_readfirstlane(vdst1+(sl)*VSLOT)); }while(0)
  const int NT=(q0+QB)/KVBLK-t0;
  V2_DMA(0,0); V2_DMA(1,1);
  bf16x8 qr[4];
  #pragma unroll
  for(int d0=0;d0<4;++d0)qr[d0]=*reinterpret_cast<const bf16x8*>(&Qw[(long)r32*PQ+d0*16+hi*8]);
  float l_reg=0.f; f32x16 o[4];
  #pragma unroll
  for(int d0=0;d0<4;++d0)o[d0]=f32x16{};
  f32x16 negm;
  #pragma unroll
  for(int r=0;r<16;++r)negm[r]=slope2*(float)crow(r,hi);
  const float b32=32.f*slope2, step64=64.f*slope2;
  const int qrel=wid*QBLK+r32;
  const lds_cptr shm3=(lds_cptr)shm; const lds_cptr kp0=shm3+LDS_K2+hi*1024+r32*16; const lds_cptr vp0=shm3+LDS_V2+((lane>>4)&1)*32+(lane&3)*8+(4*hi+((lane&15)>>2))*64;
  f32x16 p0,p1; u32x4 pw0,pw1,pw2,pw3, qw0,qw1,qw2,qw3;
  #define V2_PIN(x) asm volatile("":"+v"(x))
  #define V2_VRD(dst,d0) do{ _Pragma("unroll") for(int ks=0;ks<4;++ks){ dst[2*ks]=vtr(vp+(d0)*4096+ks*1024); dst[2*ks+1]=vtr(vp+(d0)*4096+ks*1024+512);} }while(0)
  #define V2_VF(src,ks) (bf16x8){src[2*(ks)][0],src[2*(ks)][1],src[2*(ks)][2],src[2*(ks)][3],src[2*(ks)+1][0],src[2*(ks)+1][1],src[2*(ks)+1][2],src[2*(ks)+1][3]}
  #define V2_QK(t) do{ const lds_cptr kp=kp0+((t)&3)*KSLOT; bf16x8 kf[8]; \
      _Pragma("unroll") for(int d0=0;d0<4;++d0){ kf[2*d0]=*(const __attribute__((address_space(3))) bf16x8*)(kp+d0*2048); kf[2*d0+1]=*(const __attribute__((address_space(3))) bf16x8*)(kp+d0*2048+512); } \
      SBAR(); \
      p0=__builtin_amdgcn_mfma_f32_32x32x16_bf16(kf[0],qr[0],negm,0,0,0); p1=__builtin_amdgcn_mfma_f32_32x32x16_bf16(kf[1],qr[0],negm,0,0,0); \
      _Pragma("unroll") for(int d0=1;d0<4;++d0){ p0=__builtin_amdgcn_mfma_f32_32x32x16_bf16(kf[2*d0],qr[d0],p0,0,0,0); p1=__builtin_amdgcn_mfma_f32_32x32x16_bf16(kf[2*d0+1],qr[d0],p1,0,0,0); } \
      SBAR(); }while(0)
  bool resc=false;
  #define V2_DECIDE(t,FIRST) do{ \
      _Pragma("unroll") for(int r=0;r<16;++r)p1[r]+=b32; \
      { const int jb=(t)-(NT-4); if(jb>=0)cmask(p0,p1,jb,qrel,hi); } \
      float rm; \
      { float a=V2_MX3(p0[0],p0[1],p1[0]),c=V2_MX3(p0[2],p0[3],p1[1]); a=V2_MX3(a,p1[2],p1[3]); \
        _Pragma("unroll") for(int r=4;r<16;r+=4){a=V2_MX3(a,p0[r],p0[r+1]);c=V2_MX3(c,p0[r+2],p0[r+3]);a=V2_MX3(a,p1[r],p1[r+1]);c=V2_MX3(c,p1[r+2],p1[r+3]);} \
        rm=__builtin_fmaxf(a,c); auto rr=__builtin_amdgcn_permlane32_swap(__float_as_uint(rm),__float_as_uint(rm),false,false); rm=__builtin_fmaxf(__uint_as_float(rr[0]),__uint_as_float(rr[1])); } \
      float adj=step64; resc=false; \
      if(FIRST){ _Pragma("unroll") for(int r=0;r<16;++r){p0[r]-=rm;p1[r]-=rm;} adj-=rm; } \
      else if(__any(rm>(float)THRL)){ const float dl=__builtin_fmaxf(rm,0.f); \
        _Pragma("unroll") for(int r=0;r<16;++r){p0[r]-=dl;p1[r]-=dl;} \
        adj-=dl; const float f=__builtin_amdgcn_exp2f(-dl); l_reg*=f; if(hi==0)wsf[r32]=f; resc=true; } \
      _Pragma("unroll") for(int r=0;r<16;++r)negm[r]+=adj; \
      SBAR(); }while(0)
  float sacc;
  #define V2_GRP(d0,ks,src,P,B,QW,WI) do{ o[d0]=__builtin_amdgcn_mfma_f32_32x32x16_bf16(__builtin_bit_cast(bf16x8,pw##ks),V2_VF(src,ks),o[d0],0,0,0); \
      P[B]=__builtin_amdgcn_exp2f(P[B]); P[B+1]=__builtin_amdgcn_exp2f(P[B+1]); sacc+=P[B]; sacc+=P[B+1]; QW[WI]=cvtpk_s(P[B],P[B+1]); V2_PIN(sacc); V2_PIN(QW); SBAR(); }while(0)
  #define V2_SYNC(t) do{ if((t)+1<NT){ V2_WAIT_BAR(3); } else { V2_WAIT_BAR(0); } if((t)+2<NT){ V2_DMA((t)+2,((t)+2)&3); } }while(0)
  V2_SYNC(0); V2_QK(0); V2_DECIDE(0,true);
  sacc=0.f;
  #pragma unroll
  for(int r=0;r<16;++r){p0[r]=__builtin_amdgcn_exp2f(p0[r]);p1[r]=__builtin_amdgcn_exp2f(p1[r]);sacc+=p0[r]+p1[r];}
  l_reg+=sacc;
  pw0=(u32x4){cvtpk_s(p0[0],p0[1]),cvtpk_s(p0[2],p0[3]),cvtpk_s(p0[4],p0[5]),cvtpk_s(p0[6],p0[7])};
  pw1=(u32x4){cvtpk_s(p0[8],p0[9]),cvtpk_s(p0[10],p0[11]),cvtpk_s(p0[12],p0[13]),cvtpk_s(p0[14],p0[15])};
  pw2=(u32x4){cvtpk_s(p1[0],p1[1]),cvtpk_s(p1[2],p1[3]),cvtpk_s(p1[4],p1[5]),cvtpk_s(p1[6],p1[7])};
  pw3=(u32x4){cvtpk_s(p1[8],p1[9]),cvtpk_s(p1[10],p1[11]),cvtpk_s(p1[12],p1[13]),cvtpk_s(p1[14],p1[15])};
  for(int t=1;t<NT;++t){
    V2_SYNC(t);
    const lds_cptr vp=vp0+((t-1)&3)*VSLOT; s16x4 va[8],vb[8];
    V2_VRD(va,0);
    V2_QK(t); V2_DECIDE(t,false);
    sacc=0.f;
    V2_VRD(vb,1);
    V2_GRP(0,0,va,p0,0,qw0,0); V2_GRP(0,1,va,p0,2,qw0,1); V2_GRP(0,2,va,p0,4,qw0,2); V2_GRP(0,3,va,p0,6,qw0,3);
    V2_VRD(va,2);
    V2_GRP(1,0,vb,p0,8,qw1,0); V2_GRP(1,1,vb,p0,10,qw1,1); V2_GRP(1,2,vb,p0,12,qw1,2); V2_GRP(1,3,vb,p0,14,qw1,3);
    V2_VRD(vb,3);
    V2_GRP(2,0,va,p1,0,qw2,0); V2_GRP(2,1,va,p1,2,qw2,1); V2_GRP(2,2,va,p1,4,qw2,2); V2_GRP(2,3,va,p1,6,qw2,3);
    V2_GRP(3,0,vb,p1,8,qw3,0); V2_GRP(3,1,vb,p1,10,qw3,1); V2_GRP(3,2,vb,p1,12,qw3,2); V2_GRP(3,3,vb,p1,14,qw3,3);
    l_reg+=sacc;
    if(resc){ asm volatile("s_waitcnt lgkmcnt(0)":::"memory");
      #pragma unroll
      for(int r=0;r<16;++r){ const float fr_=wsf[crow(r,hi)];
        #pragma unroll
        for(int d0=0;d0<4;++d0)o[d0][r]*=fr_; }
      asm volatile("s_waitcnt lgkmcnt(0)":::"memory"); }
    pw0=qw0; pw1=qw1; pw2=qw2; pw3=qw3;
  }
  { const lds_cptr vp=vp0+((NT-1)&3)*VSLOT; s16x4 va[8],vb[8];
    #define V2_PV(d0,src) do{ o[d0]=__builtin_amdgcn_mfma_f32_32x32x16_bf16(__builtin_bit_cast(bf16x8,pw0),V2_VF(src,0),o[d0],0,0,0); \
        o[d0]=__builtin_amdgcn_mfma_f32_32x32x16_bf16(__builtin_bit_cast(bf16x8,pw1),V2_VF(src,1),o[d0],0,0,0); \
        o[d0]=__builtin_amdgcn_mfma_f32_32x32x16_bf16(__builtin_bit_cast(bf16x8,pw2),V2_VF(src,2),o[d0],0,0,0); \
        o[d0]=__builtin_amdgcn_mfma_f32_32x32x16_bf16(__builtin_bit_cast(bf16x8,pw3),V2_VF(src,3),o[d0],0,0,0); }while(0)
    V2_VRD(va,0); V2_VRD(vb,1); V2_PV(0,va); V2_VRD(va,2); V2_PV(1,vb); V2_VRD(vb,3); V2_PV(2,va); V2_PV(3,vb);
    #undef V2_PV
  }
  #undef V2_PIN
  #undef V2_VRD
  #undef V2_VF
  #undef V2_QK
  #undef V2_DECIDE
  #undef V2_GRP
  #undef V2_SYNC
  {auto rr=__builtin_amdgcn_permlane32_swap(__float_as_uint(l_reg),__float_as_uint(l_reg),false,false);l_reg=__uint_as_float(rr[0])+__uint_as_float(rr[1]);}
  if(hi==0)wsf[32+r32]=l_reg;asm volatile("s_waitcnt lgkmcnt(0)":::"memory");
  float rli[16];
  #pragma unroll
  for(int r=0;r<16;++r)rli[r]=__builtin_amdgcn_rcpf(wsf[32+crow(r,hi)]);
  asm volatile("s_waitcnt lgkmcnt(0)\n\ts_barrier":::"memory");
  bf16*Ow=O+(rowbase+q0+wid*QBLK)*PO;
  { bf16*stg=(bf16*)shm+wid*4096;
    #pragma unroll
    for(int r=0;r<16;++r){const int orow=crow(r,hi);
      #pragma unroll
      for(int d0=0;d0<4;++d0)stg[orow*128+d0*32+r32]=__float2bfloat16(o[d0][r]*rli[r]);}
    asm volatile("s_waitcnt lgkmcnt(0)":::"memory");
    #pragma unroll
    for(int i=0;i<8;++i){const int row=i*4+(lane>>4),ch=lane&15; const u32x4 v=*(const u32x4*)(stg+row*128+ch*8); *(u32x4*)(Ow+(long)row*PO+ch*8)=v;} }
  asm volatile("s_waitcnt lgkmcnt(0)\n\ts_barrier":::"memory");
  #undef V2_DMA
}
constexpr int ATTN_LDS_BYTES=LDS_BYTES;
#undef SBAR
#undef WAIT_BAR
}

#ifndef USE_MFMA_ATTN
#define USE_MFMA_ATTN 1
#endif
#ifndef ATTN_V2
#define ATTN_V2 1
#endif
__device__ __forceinline__ void phase_diff_mfma(char* shm, LAS unsigned char* lds, const Ctx& a, int vcu, int G) {
    bf16* proj = (bf16*)(a.ws + WS_H); bf16* o12 = (bf16*)(a.ws + WS_STATE);
    unsigned* ctl = (unsigned*)(a.ws + WS_CTL);
    volatile LAS unsigned* qslot = (volatile LAS unsigned*)(lds + MISC_OFF) + 16;
    for (;;) {
        const int tid = otid();
        if (tid == 0) *qslot = atomicAdd(ctl + CW_QUEUE, 1u);
        __syncthreads();
        const unsigned idx = (unsigned)__builtin_amdgcn_readfirstlane((int)*qslot);
        __syncthreads();
        if (idx >= (unsigned)(NB * DIFF_H * 2 * 32)) break;
        const int qb = 31 - (int)(idx >> 5), rem = idx & 31, b = rem >> 4, h = (rem >> 1) & 7, r = rem & 1;
        const float slope2 = exp2f(-(float)(h + 1)) * LOG2E;
        int t0 = 0;
        { const unsigned* qm = ctl + CW_QKMAX + b * 64; const int g0 = (h * 128 + r * 64) >> 5;
          const float pq = __uint_as_float(qm[g0]) + __uint_as_float(qm[g0 + 1]), pk = __uint_as_float(qm[32 + g0]) + __uint_as_float(qm[32 + g0 + 1]);
          const float smax = sqrtf(pq * pk);
          const float d = (float)(qb * 256) - (152.0f + 2.1f * smax) / slope2;
          if (d > 0.f) t0 = ((int)d >> 6) & ~1;
          if (t0 > 4 * qb) t0 = 4 * qb; }
#if ATTN_V2
        attn_body::attn_unit_v2<8>(b, qb, t0, (const attn_body::bf16*)(proj + h * 128 + r * 64), (const attn_body::bf16*)(proj + 1024 + h * 128 + r * 64),
                                   (const attn_body::bf16*)(proj + 2048 + h * 128), (attn_body::bf16*)(o12 + r * 1024 + h * 128), slope2, shm);
#else
#pragma nounroll
        for (int vh = 0; vh < 2; ++vh)
            attn_body::attn_unit<8>(b, qb, t0, (const attn_body::bf16*)(proj + h * 128 + r * 64), (const attn_body::bf16*)(proj + 1024 + h * 128 + r * 64),
                                    (const attn_body::bf16*)(proj + 2048 + h * 128 + vh * 64), (attn_body::bf16*)(o12 + r * 1024 + h * 128 + vh * 64), slope2, shm);
#endif
    }
}
__device__ __forceinline__ void phase_diff_combine(const Ctx& a, const LayerP& P, int vcu, int G) {
    const int tid = otid(), lane = tid & 63, wave = tid >> 6;
    bf16* proj = (bf16*)(a.ws + WS_H); const bf16* o12 = (const bf16*)(a.ws + WS_STATE);
    float lam;
    { float s1 = 0.f, s2 = 0.f;
      for (int i = 0; i < 64; ++i) { s1 += P.e0[i] * P.e1[i]; s2 += P.e2[i] * P.e3[i]; }
      lam = __expf(s1) - __expf(s2) + LAMBDA_INIT; }
    const int h = lane >> 3, sub = lane & 7;
    float hn[16];
#pragma unroll
    for (int j = 0; j < 16; ++j) hn[j] = P.e4[sub * 16 + j] * (1.0f - LAMBDA_INIT);
    const int gw = vcu * NWAVES + wave, NGW = G * NWAVES;
    for (int row = gw; row < NTOK; row += NGW) {
        const bf16* p1 = o12 + (size_t)row * 2048 + h * 128 + sub * 16;
        const v4u a0 = *(const v4u*)p1, a1 = *(const v4u*)(p1 + 8), b0 = *(const v4u*)(p1 + 1024), b1 = *(const v4u*)(p1 + 1032);
        const unsigned aw[8] = {a0.x, a0.y, a0.z, a0.w, a1.x, a1.y, a1.z, a1.w}, bw[8] = {b0.x, b0.y, b0.z, b0.w, b1.x, b1.y, b1.z, b1.w};
        float o[16]; float ss = 0.f;
#pragma unroll
        for (int j = 0; j < 8; ++j) { o[2 * j] = bflo(aw[j]) - lam * bflo(bw[j]); o[2 * j + 1] = bfhi(aw[j]) - lam * bfhi(bw[j]); ss += o[2 * j] * o[2 * j] + o[2 * j + 1] * o[2 * j + 1]; }
        ss += __shfl_xor(ss, 1); ss += __shfl_xor(ss, 2); ss += __shfl_xor(ss, 4);
        const float rs = 1.0f / sqrtf(ss * (1.0f / 128.0f) + EPS);
        v4u w0, w1;
        w0.x = pk2(o[0] * rs * hn[0], o[1] * rs * hn[1]); w0.y = pk2(o[2] * rs * hn[2], o[3] * rs * hn[3]); w0.z = pk2(o[4] * rs * hn[4], o[5] * rs * hn[5]); w0.w = pk2(o[6] * rs * hn[6], o[7] * rs * hn[7]);
        w1.x = pk2(o[8] * rs * hn[8], o[9] * rs * hn[9]); w1.y = pk2(o[10] * rs * hn[10], o[11] * rs * hn[11]); w1.z = pk2(o[12] * rs * hn[12], o[13] * rs * hn[13]); w1.w = pk2(o[14] * rs * hn[14], o[15] * rs * hn[15]);
        bf16* op = proj + (size_t)row * DIFF_PITCH + h * 128 + sub * 16;
        *(v4u*)op = w0; *(v4u*)(op + 8) = w1;
    }
}

typedef short mbf16x8 __attribute__((ext_vector_type(8)));
typedef short ms16x4 __attribute__((ext_vector_type(4)));
typedef float mf32x16 __attribute__((ext_vector_type(16)));
#define MFMA32(a, b, c) __builtin_amdgcn_mfma_f32_32x32x16_bf16(a, b, c, 0, 0, 0)
__device__ __forceinline__ int crow32(int r, int hi) { return (r & 3) + 8 * (r >> 2) + 4 * hi; }
__device__ __forceinline__ mbf16x8 frag_rk(const LAS unsigned char* base, int stride, int row0, int k0, int lane) {
    return *(const LAS mbf16x8*)(base + (row0 + (lane & 31)) * stride + (k0 + 8 * (lane >> 5)) * 2);
}
__device__ __forceinline__ mbf16x8 frag_kn(const LAS unsigned char* base, int stride, int k0, int n0, int lane) {
    const int i = lane & 15, g = lane >> 4;
    const LAS unsigned char* p = base + (k0 + 8 * (g >> 1) + (i >> 2)) * stride + (n0 + 16 * (g & 1) + 4 * (i & 3)) * 2;
    const ms16x4 lo = __builtin_bit_cast(ms16x4, __builtin_amdgcn_ds_read_tr16_b64_v4i16((LAS ms16x4*)p));
    const ms16x4 hi = __builtin_bit_cast(ms16x4, __builtin_amdgcn_ds_read_tr16_b64_v4i16((LAS ms16x4*)(p + 4 * stride)));
    return (mbf16x8){lo[0], lo[1], lo[2], lo[3], hi[0], hi[1], hi[2], hi[3]};
}
__device__ __forceinline__ mf32x16 zero16() { mf32x16 z;
#pragma unroll
    for (int r = 0; r < 16; ++r) z[r] = 0.f; return z; }

__device__ __forceinline__ void phase_sgu_mfma(LAS unsigned char* lds, const Ctx& a, const LayerP& P, int vcu, int G, bool dummy = false) {
    const int tid = otid(), lane = tid & 63, wave = __builtin_amdgcn_readfirstlane(tid >> 6);
    bf16* proj = (bf16*)(a.ws + WS_H); const float* vssq = (const float*)(a.ws + WS_VSSQ);
    const float* v_norm = P.e1; const float* w_s = P.e2; const float* b_s = P.e3;
    constexpr int SA = 272, SV = 320, SO = 132;
    LAS unsigned char* WA = lds;
    LAS unsigned char* VV = lds + 128 * SA;
    LAS float* OS = (LAS float*)(lds + 128 * SA);
    LAS float* RS = (LAS float*)(lds + 128 * SA + 128 * SO * 4);
    const int tm = wave & 3, nh = wave >> 2, hi = lane >> 5;
    constexpr int NU = NB * (T / SGU_C) * SGU_G;
    int g_res = -1;
    v4u vraw[4]; float rsraw = 0.f;
    #define SGU_LOAD_RAW(uu) do{ const int g_ = (uu) % SGU_G, row0_ = ((uu) / SGU_G) * SGU_C; \
        _Pragma("unroll") for (int i = 0; i < 4; ++i) { const int ch = tid + NTHR * i, r = ch >> 4, c16 = ch & 15; \
            vraw[i] = *(const v4u*)(proj + (size_t)(row0_ + r) * SGU_PITCH + 1024 + g_ * 128 + c16 * 8); } \
        if (tid < 128) rsraw = row_rstd(vssq, row0_ + tid); }while(0)
    if (vcu < NU) SGU_LOAD_RAW(vcu);
    for (int u = vcu; u < NU; u += G) {
        const int g = u % SGU_G, bc = u / SGU_G;
        const int row0 = bc * SGU_C;
        if (tid < 128) RS[tid] = rsraw;
        v4u vcur[4];
#pragma unroll
        for (int i = 0; i < 4; ++i) vcur[i] = vraw[i];
        v4u uw[4];
#pragma unroll
        for (int i = 0; i < 4; ++i) { const int ch = tid + NTHR * i, t = ch >> 4, c8 = (ch & 15) * 8; uw[i] = *(const v4u*)(proj + (size_t)(row0 + t) * SGU_PITCH + g * 128 + c8); }
        if (g != g_res) {
#pragma unroll
            for (int i = 0; i < 8; ++i) { const int idx = tid + NTHR * i, t = idx >> 5, s4 = (idx & 31) * 4;
                const f32x4 w = *(const f32x4*)(w_s + (size_t)g * 16384 + t * 128 + s4);
                v2u o; o.x = pk2((s4 + 0 <= t) ? w.x : 0.f, (s4 + 1 <= t) ? w.y : 0.f); o.y = pk2((s4 + 2 <= t) ? w.z : 0.f, (s4 + 3 <= t) ? w.w : 0.f);
                *(LAS v2u*)(WA + t * SA + s4 * 2) = o; }
            g_res = g;
        }
        if (u + G < NU) SGU_LOAD_RAW(u + G);
        __syncthreads();
#pragma unroll
        for (int i = 0; i < 4; ++i) { const int ch = tid + NTHR * i, r = ch >> 4, c16 = ch & 15; const float rs = RS[r];
            v4u o; o.x = pk2(bflo(vcur[i].x) * rs, bfhi(vcur[i].x) * rs); o.y = pk2(bflo(vcur[i].y) * rs, bfhi(vcur[i].y) * rs);
            o.z = pk2(bflo(vcur[i].z) * rs, bfhi(vcur[i].z) * rs); o.w = pk2(bflo(vcur[i].w) * rs, bfhi(vcur[i].w) * rs);
            *(LAS v4u*)(VV + r * SV + c16 * 16) = o; }
        __syncthreads();
        mf32x16 acc0 = zero16(), acc1 = zero16();
        for (int ks = 0; ks < 2 * (tm + 1); ++ks) {
            const mbf16x8 af = frag_rk(WA, SA, 32 * tm, 16 * ks, lane);
            const mbf16x8 b0 = frag_kn(VV, SV, 16 * ks, 64 * nh, lane), b1 = frag_kn(VV, SV, 16 * ks, 64 * nh + 32, lane);
            acc0 = MFMA32(af, b0, acc0); acc1 = MFMA32(af, b1, acc1);
        }
        __syncthreads();
#pragma unroll
        for (int r = 0; r < 16; ++r) { const int row = 32 * tm + crow32(r, hi);
            OS[row * SO + 64 * nh + (lane & 31)] = acc0[r]; OS[row * SO + 64 * nh + 32 + (lane & 31)] = acc1[r]; }
        __syncthreads();
#pragma unroll
        for (int i = 0; i < 4; ++i) { const int ch = tid + NTHR * i, t = ch >> 4, c8 = (ch & 15) * 8;
            const f32x4 s0 = *(const LAS f32x4*)(OS + t * SO + c8), s1 = *(const LAS f32x4*)(OS + t * SO + c8 + 4);
            const f32x4 n0 = *(const f32x4*)(v_norm + g * 128 + c8), n1 = *(const f32x4*)(v_norm + g * 128 + c8 + 4);
            const float bs = b_s[g * 128 + t];
            bf16* up = proj + (size_t)(row0 + t) * SGU_PITCH + g * 128 + c8;
            const v4u uwv = uw[i];
            v4u o;
            o.x = pk2(bflo(uwv.x) * (n0.x * s0.x + bs), bfhi(uwv.x) * (n0.y * s0.y + bs)); o.y = pk2(bflo(uwv.y) * (n0.z * s0.z + bs), bfhi(uwv.y) * (n0.w * s0.w + bs));
            o.z = pk2(bflo(uwv.z) * (n1.x * s1.x + bs), bfhi(uwv.z) * (n1.y * s1.y + bs)); o.w = pk2(bflo(uwv.w) * (n1.z * s1.z + bs), bfhi(uwv.w) * (n1.w * s1.w + bs));
            if (dummy) *(v4u*)((bf16*)(a.ws + WS_XB) + (size_t)(row0 + t) * 1024 + g * 128 + c8) = o; else *(v4u*)up = o; }
        __syncthreads();
    }
    #undef SGU_LOAD_RAW
}

struct GlaRaw { unsigned la[8], q[8], k[8]; v4u v[4]; };
__device__ __forceinline__ void gla_load_raw(GlaRaw& r, const bf16* proj, int u, int tid, bool want_q) {
    const int n = u % GLA_NC, bh = u / GLA_NC, h = bh % GLA_H, b = bh / GLA_H, row0 = b * T + n * GLA_C;
    const int cp = tid & 63, part = tid >> 6;
#pragma unroll
    for (int i = 0; i < 8; ++i) { const bf16* base = proj + (size_t)(row0 + 8 * part + i) * GLA_PITCH + h * 128 + 2 * cp;
        r.la[i] = *(const unsigned*)(base + 3072); r.k[i] = *(const unsigned*)(base + 512); r.q[i] = want_q ? *(const unsigned*)base : 0u; }
#pragma unroll
    for (int i = 0; i < 4; ++i) { const int ch = tid + NTHR * i, rr = ch >> 5, c16 = ch & 31;
        r.v[i] = *(const v4u*)(proj + (size_t)(row0 + rr) * GLA_PITCH + 1024 + h * 256 + c16 * 8); }
}
__device__ __forceinline__ void gla_cumsum_raw(GlaCum& c, const GlaRaw& r, LAS float* TOT, int tid) {
    const int cp = tid & 63, part = tid >> 6;
#pragma unroll
    for (int i = 0; i < 8; ++i) { c.b0[i] = bflo(r.la[i]); c.b1[i] = bfhi(r.la[i]); }
#pragma unroll
    for (int i = 1; i < 8; ++i) { c.b0[i] += c.b0[i - 1]; c.b1[i] += c.b1[i - 1]; }
    TOT[part * 128 + 2 * cp] = c.b0[7]; TOT[part * 128 + 2 * cp + 1] = c.b1[7];
    __syncthreads();
    float o0 = 0.f, o1 = 0.f, t0 = 0.f, t1 = 0.f;
#pragma unroll
    for (int p = 0; p < 8; ++p) { const float x0 = TOT[p * 128 + 2 * cp], x1 = TOT[p * 128 + 2 * cp + 1]; if (p < part) { o0 += x0; o1 += x1; } t0 += x0; t1 += x1; }
#pragma unroll
    for (int i = 0; i < 8; ++i) { c.b0[i] += o0; c.b1[i] += o1; }
    c.tot0 = t0; c.tot1 = t1;
}
__device__ __forceinline__ void phase_gla_kv_mfma(LAS unsigned char* lds, const Ctx& a, int vcu, int G) {
    const int tid = otid(), lane = tid & 63, wave = __builtin_amdgcn_readfirstlane(tid >> 6), hi = lane >> 5;
    const bf16* proj = (const bf16*)(a.ws + WS_H); bf16* state = (bf16*)(a.ws + WS_STATE); float* dec = (float*)(a.ws + WS_DEC);
    constexpr int SV = 576, SK = 320, SS = 272;
    LAS unsigned char* VV = lds;
    LAS unsigned char* KE = lds + 64 * SV;
    LAS unsigned char* ST = lds;
    LAS float* TOT = (LAS float*)(lds + 256 * SS);
    constexpr int NU = NB * GLA_H * GLA_NC;
    GlaRaw nxt; if (vcu < NU) gla_load_raw(nxt, proj, vcu, tid, false);
    for (int u = vcu; u < NU; u += G) {
        const GlaRaw cur = nxt;
        if (u + G < NU) gla_load_raw(nxt, proj, u + G, tid, false);
        GlaCum c; gla_cumsum_raw(c, cur, TOT, tid);
        const int cp = tid & 63, part = tid >> 6;
#pragma unroll
        for (int i = 0; i < 8; ++i) { const int t = 8 * part + i; const unsigned w = cur.k[i];
            *(LAS unsigned*)(KE + t * SK + 4 * cp) = pk2(bflo(w) * __expf(c.tot0 - c.b0[i]), bfhi(w) * __expf(c.tot1 - c.b1[i])); }
        if (part == 0) { dec[(size_t)u * 128 + 2 * cp] = __expf(c.tot0); dec[(size_t)u * 128 + 2 * cp + 1] = __expf(c.tot1); }
#pragma unroll
        for (int i = 0; i < 4; ++i) { const int ch = tid + NTHR * i, r = ch >> 5, c16 = ch & 31;
            *(LAS v4u*)(VV + r * SV + c16 * 16) = cur.v[i]; }
        __syncthreads();
        mf32x16 acc[4];
#pragma unroll
        for (int nt = 0; nt < 4; ++nt) acc[nt] = zero16();
#pragma unroll
        for (int ks = 0; ks < 4; ++ks) { const mbf16x8 af = frag_kn(VV, SV, 16 * ks, 32 * wave, lane);
#pragma unroll
            for (int nt = 0; nt < 4; ++nt) { const mbf16x8 bfr = frag_kn(KE, SK, 16 * ks, 32 * nt, lane); acc[nt] = MFMA32(af, bfr, acc[nt]); } }
        __syncthreads();
#pragma unroll
        for (int nt = 0; nt < 4; ++nt)
#pragma unroll
            for (int r = 0; r < 16; ++r) *(LAS bf16*)(ST + (32 * wave + crow32(r, hi)) * SS + (32 * nt + (lane & 31)) * 2) = (bf16)f2bf(acc[nt][r]);
        __syncthreads();
#pragma unroll
        for (int i = 0; i < 8; ++i) { const int ch = tid + NTHR * i, vd = ch >> 4, c16 = ch & 15;
            *(v4u*)(state + ((size_t)u * 256 + vd) * 128 + c16 * 8) = *(const LAS v4u*)(ST + vd * SS + c16 * 16); }
        __syncthreads();
    }
}
__device__ __forceinline__ void phase_gla_out_mfma(LAS unsigned char* lds, const Ctx& a, const LayerP& P, int vcu, int G, bool dummy = false) {
    const int tid = otid(), lane = tid & 63, wave = __builtin_amdgcn_readfirstlane(tid >> 6), hi = lane >> 5;
    bf16* proj = (bf16*)(a.ws + WS_H); const bf16* state = (const bf16*)(a.ws + WS_STATE);
    const float* head_norm = P.e3;
    constexpr int SQ = 272, SA = 144, SV = 576, SO = 260;
    LAS unsigned char* QD = lds;
    LAS unsigned char* KI = lds + 64 * SQ;
    LAS unsigned char* AT = lds + 2 * 64 * SQ;
    LAS unsigned char* VV = lds + 2 * 64 * SQ + 64 * SA;
    LAS float* TOT = (LAS float*)(lds + 80896);
    LAS float* OS = (LAS float*)lds;
    constexpr int NU = NB * GLA_H * GLA_NC;
    GlaRaw nxt; if (vcu < NU) gla_load_raw(nxt, proj, vcu, tid, true);
    for (int u = vcu; u < NU; u += G) {
        const int n = u % GLA_NC, bh = u / GLA_NC, h = bh % GLA_H, b = bh / GLA_H;
        const int row0 = b * T + n * GLA_C;
        const GlaRaw cur = nxt;
        mbf16x8 sfr[8];
        { const bf16* sp = state + ((size_t)u * 256 + 32 * wave + (lane & 31)) * 128 + 8 * hi;
#pragma unroll
          for (int ks = 0; ks < 8; ++ks) sfr[ks] = *(const mbf16x8*)(sp + 16 * ks); }
        v4u gwv[4];
#pragma unroll
        for (int p = 0; p < 4; ++p) gwv[p] = *(const v4u*)(proj + (size_t)(row0 + p * 16 + wave * 2 + hi) * GLA_PITCH + 2048 + h * 256 + (lane & 31) * 8);
        if (u + G < NU) gla_load_raw(nxt, proj, u + G, tid, true);
        GlaCum c; gla_cumsum_raw(c, cur, TOT, tid);
        const int cp = tid & 63, part = tid >> 6;
#pragma unroll
        for (int i = 0; i < 8; ++i) { const int t = 8 * part + i;
            const unsigned wq = cur.q[i];
            const unsigned wk = cur.k[i];
            const float e0 = __expf(c.b0[i]), e1 = __expf(c.b1[i]);
            *(LAS unsigned*)(QD + t * SQ + 4 * cp) = pk2(bflo(wq) * 0.08838834764831845f * e0, bfhi(wq) * 0.08838834764831845f * e1);
            *(LAS unsigned*)(KI + t * SQ + 4 * cp) = pk2(bflo(wk) / e0, bfhi(wk) / e1); }
#pragma unroll
        for (int i = 0; i < 4; ++i) { const int ch = tid + NTHR * i, r = ch >> 5, c16 = ch & 31;
            *(LAS v4u*)(VV + r * SV + c16 * 16) = cur.v[i]; }
        __syncthreads();
        if (wave < 4) {
            const int mi = wave >> 1, ni = wave & 1;
            mf32x16 at = zero16();
            if (!(mi == 0 && ni == 1)) {
#pragma unroll
                for (int ks = 0; ks < 8; ++ks) at = MFMA32(frag_rk(QD, SQ, 32 * mi, 16 * ks, lane), frag_rk(KI, SQ, 32 * ni, 16 * ks, lane), at);
            }
#pragma unroll
            for (int r = 0; r < 16; ++r) { const int cc = 32 * mi + crow32(r, hi), ss = 32 * ni + (lane & 31);
                *(LAS bf16*)(AT + cc * SA + ss * 2) = (bf16)f2bf((ss <= cc) ? at[r] : 0.f); }
        }
        __syncthreads();
        mf32x16 acc[2]; acc[0] = zero16(); acc[1] = zero16();
#pragma unroll
        for (int ks = 0; ks < 4; ++ks) { const mbf16x8 bfr = frag_kn(VV, SV, 16 * ks, 32 * wave, lane);
            if (ks < 2) acc[0] = MFMA32(frag_rk(AT, SA, 0, 16 * ks, lane), bfr, acc[0]);
            acc[1] = MFMA32(frag_rk(AT, SA, 32, 16 * ks, lane), bfr, acc[1]); }
#pragma unroll
        for (int ks = 0; ks < 8; ++ks) { acc[0] = MFMA32(frag_rk(QD, SQ, 0, 16 * ks, lane), sfr[ks], acc[0]); acc[1] = MFMA32(frag_rk(QD, SQ, 32, 16 * ks, lane), sfr[ks], acc[1]); }
        __syncthreads();
#pragma unroll
        for (int mi = 0; mi < 2; ++mi)
#pragma unroll
            for (int r = 0; r < 16; ++r) OS[(32 * mi + crow32(r, hi)) * SO + 32 * wave + (lane & 31)] = acc[mi][r];
        __syncthreads();
#pragma unroll
        for (int p = 0; p < 4; ++p) { const int cc = p * 16 + wave * 2 + hi, c8 = (lane & 31) * 8;
            const f32x4 s0 = *(const LAS f32x4*)(OS + cc * SO + c8), s1 = *(const LAS f32x4*)(OS + cc * SO + c8 + 4);
            float ss = (s0.x * s0.x + s0.y * s0.y) + (s0.z * s0.z + s0.w * s0.w) + (s1.x * s1.x + s1.y * s1.y) + (s1.z * s1.z + s1.w * s1.w);
            ss += __shfl_xor(ss, 1); ss += __shfl_xor(ss, 2); ss += __shfl_xor(ss, 4); ss += __shfl_xor(ss, 8); ss += __shfl_xor(ss, 16);
            const float rs = __builtin_amdgcn_rsqf(ss * (1.0f / 256.0f) + EPS);
            const f32x4 n0 = *(const f32x4*)(head_norm + c8), n1 = *(const f32x4*)(head_norm + c8 + 4);
            const v4u gw = gwv[p];
            const float gg[8] = {bflo(gw.x), bfhi(gw.x), bflo(gw.y), bfhi(gw.y), bflo(gw.z), bfhi(gw.z), bflo(gw.w), bfhi(gw.w)};
            const float ov[8] = {s0.x * n0.x, s0.y * n0.y, s0.z * n0.z, s0.w * n0.w, s1.x * n1.x, s1.y * n1.y, s1.z * n1.z, s1.w * n1.w};
            float o[8];
#pragma unroll
            for (int j = 0; j < 8; ++j) o[j] = ov[j] * rs * (gg[j] * __builtin_amdgcn_rcpf(1.f + __builtin_amdgcn_exp2f(-gg[j] * LOG2E)));
            v4u w; w.x = pk2(o[0], o[1]); w.y = pk2(o[2], o[3]); w.z = pk2(o[4], o[5]); w.w = pk2(o[6], o[7]);
            if (dummy) *(v4u*)((bf16*)(a.ws + WS_XB) + (size_t)(row0 + cc) * 1024 + h * 256 + c8) = w;
            else *(v4u*)(proj + (size_t)(row0 + cc) * GLA_PITCH + 1024 + h * 256 + c8) = w; }
        __syncthreads();
    }
}

constexpr int GLA_GRP = 4, GLA_NG = GLA_NC / GLA_GRP;
constexpr int GLA_NU2 = NB * GLA_H * GLA_NG;
struct GlaRaw2 { unsigned la[8], q[8], k[8]; v4u v[4]; };
__device__ __forceinline__ void gla2_load_raw(GlaRaw2& r, const bf16* proj, int row0, int h, int tid, bool want_q) {
    const int cp = tid & 63, part = tid >> 6;
#pragma unroll
    for (int i = 0; i < 8; ++i) { const bf16* base = proj + (size_t)(row0 + 8 * part + i) * GLA_PITCH + h * 128 + 2 * cp;
        r.la[i] = *(const unsigned*)(base + 3072); r.k[i] = *(const unsigned*)(base + 512); r.q[i] = want_q ? *(const unsigned*)base : 0u; }
#pragma unroll
    for (int i = 0; i < 4; ++i) { const int ch = tid + NTHR * i, rr = ch >> 5, c16 = ch & 31;
        r.v[i] = *(const v4u*)(proj + (size_t)(row0 + rr) * GLA_PITCH + 1024 + h * 256 + c16 * 8); }
}
__device__ __forceinline__ void gla2_cumsum(GlaCum& c, const GlaRaw2& r, LAS float* TOT, int tid) {
    const int cp = tid & 63, part = tid >> 6;
#pragma unroll
    for (int i = 0; i < 8; ++i) { c.b0[i] = bflo(r.la[i]); c.b1[i] = bfhi(r.la[i]); }
#pragma unroll
    for (int i = 1; i < 8; ++i) { c.b0[i] += c.b0[i - 1]; c.b1[i] += c.b1[i - 1]; }
    TOT[part * 128 + 2 * cp] = c.b0[7]; TOT[part * 128 + 2 * cp + 1] = c.b1[7];
    __syncthreads();
    float o0 = 0.f, o1 = 0.f, t0 = 0.f, t1 = 0.f;
#pragma unroll
    for (int p = 0; p < 8; ++p) { const float x0 = TOT[p * 128 + 2 * cp], x1 = TOT[p * 128 + 2 * cp + 1]; if (p < part) { o0 += x0; o1 += x1; } t0 += x0; t1 += x1; }
#pragma unroll
    for (int i = 0; i < 8; ++i) { c.b0[i] += o0; c.b1[i] += o1; }
    c.tot0 = t0; c.tot1 = t1;
}
__device__ __forceinline__ void gla2_state_update(mf32x16 (&S)[4], const LAS unsigned char* KE, const LAS unsigned char* VV, const LAS float* DEC, int wave, int lane, bool scale) {
    const int hi = lane >> 5;
    if (scale) {
#pragma unroll
        for (int kt = 0; kt < 4; ++kt)
#pragma unroll
            for (int rq = 0; rq < 4; ++rq) { const f32x4 d = *(const LAS f32x4*)(DEC + 32 * kt + 8 * rq + 4 * hi);
                S[kt][4 * rq + 0] *= d.x; S[kt][4 * rq + 1] *= d.y; S[kt][4 * rq + 2] *= d.z; S[kt][4 * rq + 3] *= d.w; }
    }
#pragma unroll
    for (int ks = 0; ks < 4; ++ks) { const mbf16x8 bfr = frag_kn(VV, 576, 16 * ks, 32 * wave, lane);
#pragma unroll
        for (int kt = 0; kt < 4; ++kt) S[kt] = MFMA32(frag_kn(KE, 320, 16 * ks, 32 * kt, lane), bfr, S[kt]); }
}
__device__ __forceinline__ void phase_gla2_kv(LAS unsigned char* lds, const Ctx& a, int vcu, int G) {
    const int tid = otid(), lane = tid & 63, wave = __builtin_amdgcn_readfirstlane(tid >> 6), hi = lane >> 5;
    const bf16* proj = (const bf16*)(a.ws + WS_H); bf16* state = (bf16*)(a.ws + WS_STATE); float* dec = (float*)(a.ws + WS_DEC);
    LAS unsigned char* VV = lds;
    LAS unsigned char* KE = lds + 36864;
    LAS float* TOT = (LAS float*)(lds + 57344);
    LAS float* DEC = (LAS float*)(lds + 61440);
    const int cp = tid & 63, part = tid >> 6;
    for (int u = vcu; u < GLA_NU2; u += G) {
        const int grp = u % GLA_NG, bh = u / GLA_NG, h = bh % GLA_H, b = bh / GLA_H;
        const int row0 = b * T + grp * (GLA_GRP * GLA_C);
        mf32x16 S[4];
#pragma unroll
        for (int kt = 0; kt < 4; ++kt) S[kt] = zero16();
        float sum0 = 0.f, sum1 = 0.f;
#pragma unroll 1
        for (int j = 0; j < GLA_GRP; ++j) {
            GlaRaw2 cur; gla2_load_raw(cur, proj, row0 + j * GLA_C, h, tid, false);
            GlaCum c; gla2_cumsum(c, cur, TOT, tid);
#pragma unroll
            for (int i = 0; i < 8; ++i) { const int t = 8 * part + i; const unsigned w = cur.k[i];
                *(LAS unsigned*)(KE + t * 320 + 4 * cp) = pk2(bflo(w) * __expf(c.tot0 - c.b0[i]), bfhi(w) * __expf(c.tot1 - c.b1[i])); }
            if (part == 0) { DEC[2 * cp] = __expf(c.tot0); DEC[2 * cp + 1] = __expf(c.tot1); sum0 += c.tot0; sum1 += c.tot1; }
#pragma unroll
            for (int i = 0; i < 4; ++i) { const int ch = tid + NTHR * i, r = ch >> 5, c16 = ch & 31; *(LAS v4u*)(VV + r * 576 + c16 * 16) = cur.v[i]; }
            __syncthreads();
            gla2_state_update(S, KE, VV, DEC, wave, lane, j > 0);
            __syncthreads();
        }
        if (part == 0) { dec[(size_t)u * 128 + 2 * cp] = __expf(sum0); dec[(size_t)u * 128 + 2 * cp + 1] = __expf(sum1); }
        bf16* sp = state + (size_t)u * 32768 + 32 * wave + (lane & 31);
#pragma unroll
        for (int kt = 0; kt < 4; ++kt)
#pragma unroll
            for (int r = 0; r < 16; ++r) sp[(size_t)(32 * kt + crow32(r, hi)) * 256] = (bf16)f2bf(S[kt][r]);
    }
}
__device__ __forceinline__ void phase_gla2_scan(const Ctx& a, int vcu, int G) {
    unsigned* state = (unsigned*)(a.ws + WS_STATE); const float* dec = (const float*)(a.ws + WS_DEC);
    for (int gid = vcu * NTHR + otid(); gid < NB * GLA_H * 16384; gid += G * NTHR) {
        const int bh = gid >> 14, e = gid & 16383, kd = e >> 7;
        unsigned* sp = state + (size_t)bh * GLA_NG * 16384 + e;
        const float* dp = dec + (size_t)bh * GLA_NG * 128 + kd;
        float s0 = 0.f, s1 = 0.f;
        for (int n0 = 0; n0 < GLA_NG; n0 += 8) {
            unsigned w[8]; float d[8];
#pragma unroll
            for (int i = 0; i < 8; ++i) { w[i] = sp[(size_t)(n0 + i) * 16384]; d[i] = dp[(n0 + i) * 128]; }
#pragma unroll
            for (int i = 0; i < 8; ++i) { sp[(size_t)(n0 + i) * 16384] = pk2(s0, s1); s0 = d[i] * s0 + bflo(w[i]); s1 = d[i] * s1 + bfhi(w[i]); }
        }
    }
}
__device__ __forceinline__ void phase_gla2_out(LAS unsigned char* lds, const Ctx& a, const LayerP& P, int vcu, int G, bool dummy = false) {
    const int tid = otid(), lane = tid & 63, wave = __builtin_amdgcn_readfirstlane(tid >> 6), hi = lane >> 5;
    bf16* proj = (bf16*)(a.ws + WS_H); const bf16* state = (const bf16*)(a.ws + WS_STATE);
    const float* head_norm = P.e3;
    constexpr int SQ = 272, SA = 144, SV = 576, SO = 260;
    LAS unsigned char* QD = lds;
    LAS unsigned char* KI = lds + 17408;
    LAS unsigned char* AT = lds + 34816;
    LAS unsigned char* VV = lds + 44032;
    LAS unsigned char* KE = lds + 80896;
    LAS float* TOT = (LAS float*)(lds + 101376);
    LAS float* DEC = (LAS float*)(lds + 105472);
    LAS float* OS = (LAS float*)lds;
    const int cp = tid & 63, part = tid >> 6;
    for (int u = vcu; u < GLA_NU2; u += G) {
        const int grp = u % GLA_NG, bh = u / GLA_NG, h = bh % GLA_H, b = bh / GLA_H;
        const int rowg = b * T + grp * (GLA_GRP * GLA_C);
        mf32x16 S[4];
        { const bf16* sp = state + (size_t)u * 32768 + 32 * wave + (lane & 31);
#pragma unroll
          for (int kt = 0; kt < 4; ++kt)
#pragma unroll
              for (int r = 0; r < 16; ++r) S[kt][r] = bf2f(sp[(size_t)(32 * kt + crow32(r, hi)) * 256]); }
#pragma unroll 1
        for (int j = 0; j < GLA_GRP; ++j) {
            const int row0 = rowg + j * GLA_C;
            GlaRaw2 cur; gla2_load_raw(cur, proj, row0, h, tid, true);
            v4u gwv[4];
#pragma unroll
            for (int p = 0; p < 4; ++p) gwv[p] = *(const v4u*)(proj + (size_t)(row0 + p * 16 + wave * 2 + hi) * GLA_PITCH + 2048 + h * 256 + (lane & 31) * 8);
            GlaCum c; gla2_cumsum(c, cur, TOT, tid);
#pragma unroll
            for (int i = 0; i < 8; ++i) { const int t = 8 * part + i;
                const unsigned wq = cur.q[i], wk = cur.k[i];
                const float e0 = __expf(c.b0[i]), e1 = __expf(c.b1[i]);
                *(LAS unsigned*)(QD + t * SQ + 4 * cp) = pk2(bflo(wq) * 0.08838834764831845f * e0, bfhi(wq) * 0.08838834764831845f * e1);
                *(LAS unsigned*)(KI + t * SQ + 4 * cp) = pk2(bflo(wk) * __builtin_amdgcn_rcpf(e0), bfhi(wk) * __builtin_amdgcn_rcpf(e1));
                *(LAS unsigned*)(KE + t * 320 + 4 * cp) = pk2(bflo(wk) * __expf(c.tot0 - c.b0[i]), bfhi(wk) * __expf(c.tot1 - c.b1[i])); }
            if (part == 0) { DEC[2 * cp] = __expf(c.tot0); DEC[2 * cp + 1] = __expf(c.tot1); }
#pragma unroll
            for (int i = 0; i < 4; ++i) { const int ch = tid + NTHR * i, r = ch >> 5, c16 = ch & 31; *(LAS v4u*)(VV + r * SV + c16 * 16) = cur.v[i]; }
            __syncthreads();
            if (wave < 4) {
                const int mi = wave >> 1, ni = wave & 1;
                mf32x16 at = zero16();
                if (!(mi == 0 && ni == 1)) {
#pragma unroll
                    for (int ks = 0; ks < 8; ++ks) at = MFMA32(frag_rk(QD, SQ, 32 * mi, 16 * ks, lane), frag_rk(KI, SQ, 32 * ni, 16 * ks, lane), at);
                }
#pragma unroll
                for (int r = 0; r < 16; ++r) { const int cc = 32 * mi + crow32(r, hi), ss = 32 * ni + (lane & 31);
                    *(LAS bf16*)(AT + cc * SA + ss * 2) = (bf16)f2bf((ss <= cc) ? at[r] : 0.f); }
            }
            __syncthreads();
            mf32x16 acc[2]; acc[0] = zero16(); acc[1] = zero16();
#pragma unroll
            for (int ks = 0; ks < 4; ++ks) { const mbf16x8 bfr = frag_kn(VV, SV, 16 * ks, 32 * wave, lane);
                if (ks < 2) acc[0] = MFMA32(frag_rk(AT, SA, 0, 16 * ks, lane), bfr, acc[0]);
                acc[1] = MFMA32(frag_rk(AT, SA, 32, 16 * ks, lane), bfr, acc[1]); }
#pragma unroll
            for (int kt = 0; kt < 4; ++kt)
#pragma unroll
                for (int sx = 0; sx < 2; ++sx) {
                    v4u bw; bw.x = pk2(S[kt][8 * sx + 0], S[kt][8 * sx + 1]); bw.y = pk2(S[kt][8 * sx + 2], S[kt][8 * sx + 3]); bw.z = pk2(S[kt][8 * sx + 4], S[kt][8 * sx + 5]); bw.w = pk2(S[kt][8 * sx + 6], S[kt][8 * sx + 7]);
                    const mbf16x8 bfr = __builtin_bit_cast(mbf16x8, bw);
#pragma unroll
                    for (int mi = 0; mi < 2; ++mi) { const LAS unsigned char* qp = QD + (32 * mi + (lane & 31)) * SQ + (32 * kt + 16 * sx + 4 * hi) * 2;
                        const v2u a0 = *(const LAS v2u*)qp, a1 = *(const LAS v2u*)(qp + 16);
                        v4u aw; aw.x = a0.x; aw.y = a0.y; aw.z = a1.x; aw.w = a1.y;
                        acc[mi] = MFMA32(__builtin_bit_cast(mbf16x8, aw), bfr, acc[mi]); } }
            if (j + 1 < GLA_GRP) gla2_state_update(S, KE, VV, DEC, wave, lane, true);
            __syncthreads();
#pragma unroll
            for (int mi = 0; mi < 2; ++mi)
#pragma unroll
                for (int r = 0; r < 16; ++r) OS[(32 * mi + crow32(r, hi)) * SO + 32 * wave + (lane & 31)] = acc[mi][r];
            __syncthreads();
#pragma unroll
            for (int p = 0; p < 4; ++p) { const int cc = p * 16 + wave * 2 + hi, c8 = (lane & 31) * 8;
                const f32x4 s0 = *(const LAS f32x4*)(OS + cc * SO + c8), s1 = *(const LAS f32x4*)(OS + cc * SO + c8 + 4);
                float ss = (s0.x * s0.x + s0.y * s0.y) + (s0.z * s0.z + s0.w * s0.w) + (s1.x * s1.x + s1.y * s1.y) + (s1.z * s1.z + s1.w * s1.w);
                ss += __shfl_xor(ss, 1); ss += __shfl_xor(ss, 2); ss += __shfl_xor(ss, 4); ss += __shfl_xor(ss, 8); ss += __shfl_xor(ss, 16);
                const float rs = __builtin_amdgcn_rsqf(ss * (1.0f / 256.0f) + EPS);
                const f32x4 n0 = *(const f32x4*)(head_norm + c8), n1 = *(const f32x4*)(head_norm + c8 + 4);
                const v4u gw = gwv[p];
                const float gg[8] = {bflo(gw.x), bfhi(gw.x), bflo(gw.y), bfhi(gw.y), bflo(gw.z), bfhi(gw.z), bflo(gw.w), bfhi(gw.w)};
                const float ov[8] = {s0.x * n0.x, s0.y * n0.y, s0.z * n0.z, s0.w * n0.w, s1.x * n1.x, s1.y * n1.y, s1.z * n1.z, s1.w * n1.w};
                float o[8];
#pragma unroll
                for (int jj = 0; jj < 8; ++jj) o[jj] = ov[jj] * rs * (gg[jj] * __builtin_amdgcn_rcpf(1.f + __builtin_amdgcn_exp2f(-gg[jj] * LOG2E)));
                v4u w; w.x = pk2(o[0], o[1]); w.y = pk2(o[2], o[3]); w.z = pk2(o[4], o[5]); w.w = pk2(o[6], o[7]);
                if (dummy) *(v4u*)((bf16*)(a.ws + WS_XB) + (size_t)(row0 + cc) * 1024 + h * 256 + c8) = w;
                else *(v4u*)(proj + (size_t)(row0 + cc) * GLA_PITCH + 1024 + h * 256 + c8) = w; }
            __syncthreads();
        }
    }
}
#ifndef GLA_TWO_LEVEL
#define GLA_TWO_LEVEL 1
#endif
#ifndef USE_MFMA_SGU
#define USE_MFMA_SGU 1
#endif
#ifndef USE_MFMA_GLA
#define USE_MFMA_GLA 1
#endif

constexpr int PH_PER_LAYER = 8, NPHASE = 4 * PH_PER_LAYER + 1;
__host__ __device__ inline bool phase_is_noop(int ph) {
    if (ph >= 4 * PH_PER_LAYER) return false;
    const int L = ph / PH_PER_LAYER, s = ph % PH_PER_LAYER;
    const bool gla = (L == 0 || L == 3), diff = (L == 1);
    return (s == 3 && !gla && !diff) || (s == 4 && !gla);
}

#ifndef PROBE_KIND
#define PROBE_KIND 0
#endif
#ifndef PROBE_REP
#define PROBE_REP 2
#endif
template <int L> __device__ __forceinline__ LayerP layer_params_ct(const CAS cfptr* in) {
    constexpr int base = (L == 0) ? 1 : (L == 1) ? 11 : (L == 2) ? 22 : 32;
    constexpr int kind = (L == 1) ? K_DIFF : (L == 2) ? K_SGU : K_GLA;
    constexpr int sh = (kind == K_DIFF) ? 1 : 0;
    LayerP p; p.kind = kind;
    p.norm1 = in[base]; p.w_in = in[base + 1];
    p.e0 = in[base + 2]; p.e1 = in[base + 3]; p.e2 = in[base + 4]; p.e3 = in[base + 5]; p.e4 = in[base + 6];
    p.w_out = in[base + 6 + sh]; p.norm2 = in[base + 7 + sh]; p.w1 = in[base + 8 + sh]; p.w2 = in[base + 9 + sh];
    p.nin = (kind == K_GLA) ? GLA_PITCH : (kind == K_DIFF) ? DIFF_PITCH : SGU_PITCH;
    p.mixoff = (kind == K_GLA) ? 1024 : 0;
    return p;
}
__device__ __forceinline__ void seam_xcd(const CAS Args* ap, LAS unsigned char* lds_k) {
#if PROBE_KIND == 1
    for (int br = 0; br < PROBE_REP; ++br)
#endif
    { XcdBarrier bb; bb.bar = (unsigned*)(ap->ws + WS_CTL) + 4096; bb.x = xb_xcc_id(); bb.st = (volatile LAS unsigned*)(lds_k + MISC_OFF) + 8; xcd_barrier(bb); }
}
#define PH_BEGIN(PK) { const int nrep_ = (PROBE_KIND == (PK) && (PK) != 0) ? PROBE_REP : 1; \
    for (int rep_ = 0; rep_ < nrep_; ++rep_) { \
    int vcu = vcu0, G = G0; asm volatile("" : "+s"(vcu), "+s"(G)); \
    LAS unsigned char* lds = lds_k; asm volatile("" : "+s"(lds)); \
    const CAS Args* ap = (const CAS Args*)__builtin_amdgcn_kernarg_segment_ptr(); asm volatile("" : "+s"(ap)); \
    Ctx args; args.in0 = ap->in[0]; args.in42 = ap->in[42]; args.out = ap->out; args.ws = ap->ws; \
    bf16* Wb = (bf16*)(args.ws + WS_W); bf16* XB = (bf16*)(args.ws + WS_XB); bf16* HB = (bf16*)(args.ws + WS_H); \
    float* SSQ = (float*)(args.ws + WS_SSQ); float* VSSQ = (float*)(args.ws + WS_VSSQ); \
    const LayerP P = layer_params_ct<L>((const CAS cfptr*)ap); \
    (void)Wb; (void)XB; (void)HB; (void)SSQ; (void)VSSQ; (void)P; (void)vcu; (void)G; (void)lds;
#define PH_END_SEAM   seam_xcd(ap, lds_k); } }
#define PH_END_NOSEAM } }

template <int L> __device__ __forceinline__ void run_layer(LAS unsigned char* lds_k, int vcu0, int G0) {
    constexpr int kind = (L == 1) ? K_DIFF : (L == 2) ? K_SGU : K_GLA;
    PH_BEGIN(5) phase_conv(lds, args, P, L, vcu, G);
    if (L == 0) { if (rep_ + 1 == nrep_) cg::this_grid().sync(); else seam_xcd(ap, lds_k); } else seam_xcd(ap, lds_k);
    PH_END_NOSEAM
    PH_BEGIN(3) { EpiIn E{kind, HB, SSQ, (kind == K_GLA) ? P.e2 : P.e0, VSSQ, (unsigned*)(args.ws + WS_CTL) + CW_QKMAX}; run_gemm(lds, XB, D, Wb + WOFF_IN, NTOK, P.nin, D, E, vcu, G); } PH_END_SEAM
    if constexpr (kind == K_GLA) {
#if GLA_TWO_LEVEL
        PH_BEGIN(4) phase_gla2_kv(lds, args, vcu, G); PH_END_SEAM
        PH_BEGIN(0) phase_gla2_scan(args, vcu, G); PH_END_SEAM
        PH_BEGIN(9) phase_gla2_out(lds, args, P, vcu, G, rep_ + 1 < nrep_); PH_END_SEAM
#else
        PH_BEGIN(4) phase_gla_kv_mfma(lds, args, vcu, G); PH_END_SEAM
        PH_BEGIN(0) phase_gla_scan(args, vcu, G); PH_END_SEAM
        PH_BEGIN(9) phase_gla_out_mfma(lds, args, P, vcu, G, rep_ + 1 < nrep_); PH_END_SEAM
#endif
    } else if constexpr (kind == K_DIFF) {
        PH_BEGIN(7)
            if (rep_ > 0) { if (blockIdx.x == 0 && otid() == 0) __hip_atomic_store((unsigned*)(ap->ws + WS_CTL) + CW_QUEUE, 0u, RLX_AGENT); seam_xcd(ap, lds_k); }
            phase_diff_mfma((char*)lds_raw, lds, args, vcu, G);
        PH_END_SEAM
        PH_BEGIN(6) phase_diff_combine(args, P, vcu, G); PH_END_SEAM
    } else {
        PH_BEGIN(10) phase_sgu_mfma(lds, args, P, vcu, G, rep_ + 1 < nrep_); PH_END_SEAM
    }
    PH_BEGIN(L == 0 ? 8 : 0) { EpiRes E{XB, SSQ}; run_gemm(lds, HB + P.mixoff, P.nin, Wb + WOFF_OUT, NTOK, D, D, E, vcu, G); } PH_END_SEAM
    PH_BEGIN(2) { EpiHid E{HB, SSQ}; run_gemm(lds, XB, D, Wb + WOFF_1, NTOK, FF, D, E, vcu, G); } PH_END_SEAM
    PH_BEGIN(0) { EpiRes E{XB, SSQ}; run_gemm(lds, HB, FF, Wb + WOFF_2, NTOK, D, FF, E, vcu, G); } PH_END_SEAM
}

__global__ void __launch_bounds__(NTHR, 2) trunk_fwd(Args kargs) {
    LAS unsigned char* const lds_k = (LAS unsigned char*)lds_raw;
    const int G0 = gridDim.x; const int bx = blockIdx.x;
    const int vcu0 = (G0 % 8 == 0) ? (bx % 8) * (G0 / 8) + bx / 8 : bx;
    { const int tid = threadIdx.x;
      for (int u = tid; u < (LDS_BYTES - LDSCTL_OFF) / 4; u += NTHR) ((LAS unsigned*)(lds_k + LDSCTL_OFF))[u] = 0u;
      __syncthreads();
      if ((tid & 63) == 0) ((LAS unsigned*)(lds_k + TIDTAB_OFF))[hw_slot()] = (unsigned)(tid >> 6);
      __syncthreads(); }
    (void)xcd_barrier_post((unsigned*)(kargs.ws + WS_CTL) + 4096, (volatile LAS unsigned*)(lds_k + MISC_OFF) + 8);
    run_layer<0>(lds_k, vcu0, G0);
    run_layer<1>(lds_k, vcu0, G0);
    run_layer<2>(lds_k, vcu0, G0);
    run_layer<3>(lds_k, vcu0, G0);
    { int vcu = vcu0, G = G0; asm volatile("" : "+s"(vcu), "+s"(G));
      const CAS Args* ap = (const CAS Args*)__builtin_amdgcn_kernarg_segment_ptr(); asm volatile("" : "+s"(ap));
      Ctx args; args.in0 = ap->in[0]; args.in42 = ap->in[42]; args.out = ap->out; args.ws = ap->ws;
      phase_final(args, vcu, G); }
}

extern "C" void kernel_launch(void* const* d_in, const int* in_sizes, int n_in, void* d_out, int out_size, void* d_ws, size_t ws_size, hipStream_t stream) {
    static int grid = 0;
    if (grid == 0) {
        if (n_in != 43 || in_sizes[0] != NTOK * D || out_size != NTOK * D || ws_size < WS_END) {
            fprintf(stderr, "kernel_launch: unexpected problem (n_in %d, in0 %d, out %d, ws %zu); nothing launched\n", n_in, n_in > 0 ? in_sizes[0] : -1, out_size, ws_size); grid = -1; return; }
        int dev = 0, cus = 0, per_cu = 0;
        if (hipGetDevice(&dev) != hipSuccess || hipDeviceGetAttribute(&cus, hipDeviceAttributeMultiprocessorCount, dev) != hipSuccess) { grid = -1; return; }
        if (hipFuncSetAttribute((const void*)trunk_fwd, hipFuncAttributeMaxDynamicSharedMemorySize, LDS_BYTES) != hipSuccess) { fprintf(stderr, "kernel_launch: hipFuncSetAttribute failed\n"); grid = -1; return; }
        if (hipOccupancyMaxActiveBlocksPerMultiprocessor(&per_cu, (const void*)trunk_fwd, NTHR, LDS_BYTES) != hipSuccess || per_cu < 1) { fprintf(stderr, "kernel_launch: occupancy query says %d blocks/CU\n", per_cu); per_cu = 1; }
        (void)hipGetLastError();
        grid = cus;
    }
    if (grid < 0) return;
    (void)hipMemsetAsync((char*)d_ws + WS_CTL, 0, CTL_ZERO_BYTES, stream);
    Args a{};
    for (int i = 0; i < 43; ++i) a.in[i] = (const float*)d_in[i];
    a.out = (float*)d_out; a.ws = (unsigned char*)d_ws;
    a.ph_lo = 0; a.ph_hi = 0;
    void* kargs[] = {&a};
    hipError_t e = hipLaunchCooperativeKernel((const void*)trunk_fwd, dim3(grid), dim3(NTHR), kargs, LDS_BYTES, stream);
    if (e != hipSuccess) fprintf(stderr, "kernel_launch: cooperative launch failed: %s (grid %d)\n", hipGetErrorString(e), grid);
}
```

```cpp
#include <hip/hip_runtime.h>
#include <hip/hip_cooperative_groups.h>
#include <cstdio>
#include <cstdint>
namespace cg = cooperative_groups;


#define GAS __attribute__((address_space(1)))
#define LAS __attribute__((address_space(3)))
typedef unsigned short bf16;
typedef unsigned v4u __attribute__((ext_vector_type(4)));
typedef unsigned v2u __attribute__((ext_vector_type(2)));
typedef float f32x4 __attribute__((ext_vector_type(4)));
typedef float f32x2v __attribute__((ext_vector_type(2)));

constexpr int NB = 2, T = 8192, D = 1024, NTOK = NB * T, FF = 4096;
constexpr float EPS = 1e-6f;
constexpr float LOG2E = 1.4426950408889634f;
constexpr int NWAVES = 8, NTHR = 512;
constexpr int K_GLA = 0, K_DIFF = 1, K_SGU = 2;
constexpr int GLA_H = 4, GLA_HK = 128, GLA_HV = 256, GLA_C = 64, GLA_NC = T / GLA_C;
#ifndef GLA_RANK16
#define GLA_RANK16 0
#endif
constexpr int GLA_PITCH = GLA_RANK16 ? 3072 : 3584;
constexpr int DIFF_H = 8, DIFF_PITCH = 3072;
constexpr float LAMBDA_INIT = 0.35551069f;
constexpr int SGU_PITCH = 2048, SGU_C = 128, SGU_G = 8;

constexpr size_t MiB = 1u << 20;
constexpr size_t WS_CTL = 0, CTL_ZERO_BYTES = 1 * MiB;
constexpr size_t WS_SSQ = 1 * MiB;
constexpr size_t WS_VSSQ = 2 * MiB;
constexpr size_t WS_R = 2 * MiB;
constexpr size_t WS_DEC = 3 * MiB;
constexpr size_t WS_W = 4 * MiB;
constexpr size_t WS_XB = 29 * MiB;
constexpr size_t WS_STATE = 61 * MiB;
constexpr size_t WS_H = 125 * MiB;
constexpr size_t WS_SSQ2 = 253 * MiB;
constexpr size_t WS_END = 254 * MiB;
constexpr int CW_QKMAX = 8192;
constexpr int CW_QUEUE = 8448;
constexpr size_t WOFF_IN = 0, WOFF_OUT = (size_t)3584 * 1024, WOFF_1 = WOFF_OUT + (size_t)1024 * 1024, WOFF_2 = WOFF_1 + (size_t)4096 * 1024;

#ifndef ATTN_BAR2
#define ATTN_BAR2 1
#endif
#ifndef ATTN_SREF
#define ATTN_SREF 1
#endif
#ifndef CONV_SPLIT
#define CONV_SPLIT 1
#endif
#ifndef PROBE_KIND
#define PROBE_KIND 0
#endif
#ifndef PROBE_REP
#define PROBE_REP 2
#endif
constexpr int RING_BYTES = 131072, LDSCTL_OFF = RING_BYTES, MISC_OFF = LDSCTL_OFF + 320, LDS_BYTES = 147456;

#define RLX_AGENT __ATOMIC_RELAXED, __HIP_MEMORY_SCOPE_AGENT
#define LDS_WAIT() asm volatile("s_waitcnt lgkmcnt(0)" ::: "memory")
__device__ __forceinline__ unsigned f2bf(float f) { unsigned u = __builtin_bit_cast(unsigned, f); return (u + 0x7fffu + ((u >> 16) & 1u)) >> 16; }
typedef float pk_f32x2 __attribute__((ext_vector_type(2))); typedef __bf16 pk_bf16x2 __attribute__((ext_vector_type(2)));
__device__ __forceinline__ unsigned pk2(float lo, float hi) { pk_f32x2 v = {lo, hi}; pk_bf16x2 b = __builtin_convertvector(v, pk_bf16x2); return __builtin_bit_cast(unsigned, b); }
__device__ __forceinline__ float bf2f(unsigned b) { return __builtin_bit_cast(float, b << 16); }
__device__ __forceinline__ float bflo(unsigned w) { return __builtin_bit_cast(float, w << 16); }
__device__ __forceinline__ float bfhi(unsigned w) { return __builtin_bit_cast(float, w & 0xffff0000u); }
extern __shared__ __attribute__((aligned(16))) unsigned char lds_raw[];
constexpr int TIDTAB_OFF = 131072;
__device__ __forceinline__ unsigned hw_slot() { return (unsigned)__builtin_amdgcn_s_getreg((5 << 11) | 4) & 63u; }
__device__ __forceinline__ int otid() {
    const int wv = (int)((volatile __attribute__((address_space(3))) unsigned*)((__attribute__((address_space(3))) unsigned char*)lds_raw + TIDTAB_OFF))[hw_slot()];
    int ln; asm volatile("v_mbcnt_lo_u32_b32 %0, -1, 0\n\tv_mbcnt_hi_u32_b32 %0, -1, %0" : "=v"(ln));
    int t = wv * 64 + ln;
    asm volatile("" : "+v"(t)); return t; }
#ifndef EPI_SC1
#define EPI_SC1 0
#endif
__device__ __forceinline__ void store16(void* p, v4u v) {
#if EPI_SC1
    asm volatile("global_store_dwordx4 %0, %1, off sc1\n\ts_nop 1" :: "v"(p), "v"(v) : "memory");
#else
    *(v4u*)p = v;
#endif
}
__device__ __forceinline__ float xl_1(float v)  { return __int_as_float(__builtin_amdgcn_mov_dpp(__float_as_int(v), 0xB1, 0xF, 0xF, true)); }
__device__ __forceinline__ float xl_2(float v)  { return __int_as_float(__builtin_amdgcn_mov_dpp(__float_as_int(v), 0x4E, 0xF, 0xF, true)); }
__device__ __forceinline__ float xl_4(float v)  { return __int_as_float(__builtin_amdgcn_mov_dpp(__float_as_int(v), 0x141, 0xF, 0xF, true)); }
__device__ __forceinline__ float xl_8(float v)  { return __int_as_float(__builtin_amdgcn_mov_dpp(__float_as_int(v), 0x140, 0xF, 0xF, true)); }
__device__ __forceinline__ float sum_x16(float v) { auto r = __builtin_amdgcn_permlane16_swap(__float_as_uint(v), __float_as_uint(v), false, false); return __uint_as_float(r[0]) + __uint_as_float(r[1]); }
__device__ __forceinline__ float sum_x32(float v) { auto r = __builtin_amdgcn_permlane32_swap(__float_as_uint(v), __float_as_uint(v), false, false); return __uint_as_float(r[0]) + __uint_as_float(r[1]); }
__device__ __forceinline__ float max_x16(float v) { auto r = __builtin_amdgcn_permlane16_swap(__float_as_uint(v), __float_as_uint(v), false, false); return fmaxf(__uint_as_float(r[0]), __uint_as_float(r[1])); }
__device__ __forceinline__ float max_x32(float v) { auto r = __builtin_amdgcn_permlane32_swap(__float_as_uint(v), __float_as_uint(v), false, false); return fmaxf(__uint_as_float(r[0]), __uint_as_float(r[1])); }
__device__ __forceinline__ float sum_lanes8(float v)  { v += xl_1(v); v += xl_2(v); v += xl_4(v); return v; }
__device__ __forceinline__ float sum_lanes32(float v) { v = sum_lanes8(v); v += xl_8(v); return sum_x16(v); }
__device__ __forceinline__ float wave_sum(float v) { return sum_x32(sum_lanes32(v)); }
__device__ __forceinline__ float wave_max(float v) { v = fmaxf(v, xl_1(v)); v = fmaxf(v, xl_2(v)); v = fmaxf(v, xl_4(v)); v = fmaxf(v, xl_8(v)); return max_x32(max_x16(v)); }
__device__ __forceinline__ float gelu_tanh(float x) {
    const float u = 0.7978845608028654f * (x + 0.044715f * x * x * x);
    const float e = __builtin_amdgcn_exp2f(u * (2.f * LOG2E));
    return x - x * __builtin_amdgcn_rcpf(e + 1.f);
}
__device__ __forceinline__ float log_sigmoid(float z) { return fminf(z, 0.f) - 0.6931471805599453f * __builtin_amdgcn_logf(1.0f + __builtin_amdgcn_exp2f(-fabsf(z) * LOG2E)); }

#define XB_TMO      128
#define XB_XCNT(j)  (256  + 64 * (j))
#define XB_XSUB(j)  (1280 + 64 * (j))
#define XB_XGEN(j)  (2304 + 64 * (j))
#define XB_TOP      3328
#define XB_TOPGEN   3392
#define XCD_BAR_WORDS 3456
#define XB_SPIN_CAP (1u << 22)
__device__ __forceinline__ unsigned xb_ld(unsigned* p)              { return __hip_atomic_load(p, __ATOMIC_RELAXED, __HIP_MEMORY_SCOPE_AGENT); }
__device__ __forceinline__ unsigned xb_add(unsigned* p, unsigned v) { return __hip_atomic_fetch_add(p, v, __ATOMIC_RELAXED, __HIP_MEMORY_SCOPE_AGENT); }
__device__ __forceinline__ unsigned xb_xcc_id() { return (unsigned)__builtin_amdgcn_s_getreg((3 << 11) | 20) & 0xFu; }
#define XB_SPIN(cond, bar) do { unsigned _sp = 0; while (cond) { __builtin_amdgcn_s_sleep(1); \
    if ((++_sp & 255u) == 0u) { if (xb_ld(&(bar)[XB_TMO])) break; if (_sp > XB_SPIN_CAP) { atomicAdd(&(bar)[XB_TMO], 1u); break; } } } } while (0)
struct XcdBarrier { unsigned* bar; unsigned x; volatile LAS unsigned* st; };
__device__ __forceinline__ XcdBarrier xcd_barrier_post(unsigned* bar, volatile LAS unsigned* st) {
    XcdBarrier b; b.bar = bar; b.x = xb_xcc_id(); b.st = st;
    if (threadIdx.x == 0) (void)xb_add(&bar[XB_XCNT(b.x)], 1u);
    return b;
}
__device__ __forceinline__ void xcd_barrier_complete(unsigned* bar, unsigned x, unsigned& nloc, unsigned& nx) {
    const unsigned G = gridDim.x * gridDim.y * gridDim.z;
    unsigned sum, cnt, mine, sp = 0u;
    for (;;) {
        sum = 0u; cnt = 0u; mine = 0u;
#pragma unroll
        for (unsigned j = 0; j < 16; ++j) { const unsigned c = xb_ld(&bar[XB_XCNT(j)]); sum += c; cnt += (c > 0u) ? 1u : 0u; mine = (j == x) ? c : mine; }
        if (sum == G) break;
        __builtin_amdgcn_s_sleep(1);
        if ((++sp & 255u) == 0u) { if (xb_ld(&bar[XB_TMO])) break; if (sp > XB_SPIN_CAP) { atomicAdd(&bar[XB_TMO], 1u); break; } }
    }
    nloc = mine > 0u ? mine : 1u; nx = cnt > 0u ? cnt : 1u;
}
__device__ __forceinline__ void xcd_barrier(const XcdBarrier& b) {
    asm volatile("s_waitcnt vmcnt(0)" ::: "memory");
    __syncthreads();
    if (otid() == 0) {
        unsigned* bar = b.bar;
        __builtin_amdgcn_s_waitcnt(0);
        unsigned nloc = b.st[0], nx = b.st[1];
        if (nloc == 0u) { xcd_barrier_complete(bar, b.x, nloc, nx); b.st[0] = nloc; b.st[1] = nx; }
        const unsigned old = xb_add(&bar[XB_XSUB(b.x)], 1u);
        const unsigned gen = old / nloc;
        if (old + 1u == (gen + 1u) * nloc) {
            __builtin_amdgcn_fence(__ATOMIC_RELEASE, "agent");
            asm volatile("s_waitcnt vmcnt(0)" ::: "memory");
            const unsigned og = xb_add(&bar[XB_TOP], 1u);
            const unsigned tg = og / nx;
            if (og + 1u == (tg + 1u) * nx) xb_add(&bar[XB_TOPGEN], 1u);
            else XB_SPIN(xb_ld(&bar[XB_TOPGEN]) == tg, bar);
            __builtin_amdgcn_fence(__ATOMIC_ACQUIRE, "agent");
            xb_add(&bar[XB_XGEN(b.x)], 1u);
            asm volatile("s_waitcnt vmcnt(0)" ::: "memory");
        } else {
            XB_SPIN(xb_ld(&bar[XB_XGEN(b.x)]) == gen, bar);
            __builtin_amdgcn_fence(__ATOMIC_ACQUIRE, "agent");
            asm volatile("s_waitcnt vmcnt(0)" ::: "memory");
        }
    }
    __syncthreads();
}

struct Args { const float* in[43]; float* out; unsigned char* ws; int ph_lo, ph_hi; };
struct Ctx { const float* in0; const float* in42; float* out; unsigned char* ws; };
struct LayerP {
    int kind;
    const float *norm1, *w_in, *w_out, *norm2, *w1, *w2;
    const float *e0, *e1, *e2, *e3, *e4;
    int nin;
    int mixoff;
};
typedef const float* cfptr;
#define CAS __attribute__((address_space(4)))
__device__ __forceinline__ float row_rstd(const float* ssq, int row) {
    const f32x4* p = (const f32x4*)(ssq + (size_t)row * 16);
    const f32x4 a = p[0], b = p[1], c = p[2], d = p[3];
    const float s = ((a.x + a.y) + (a.z + a.w)) + ((b.x + b.y) + (b.z + b.w)) + ((c.x + c.y) + (c.z + c.w)) + ((d.x + d.y) + (d.z + d.w));
    return __builtin_amdgcn_rsqf(s * (1.0f / D) + EPS);
}

typedef float f2 __attribute__((ext_vector_type(2)));
__device__ __forceinline__ unsigned pk2v(f2 t) { pk_bf16x2 b = __builtin_convertvector(t, pk_bf16x2); return __builtin_bit_cast(unsigned, b); }
__device__ __forceinline__ f2 f2s(float x) { return (f2){x, x}; }
__device__ __forceinline__ void store16o(const void* base, size_t off_bytes, v4u v) {
    __builtin_amdgcn_raw_buffer_store_b128(v, __builtin_amdgcn_make_buffer_rsrc((void*)base, 0, 0x7fffffff, 0x00020000), (int)off_bytes, 0, 0);
}
__device__ __forceinline__ f2 gelu_tanh2(f2 x) {
    const f2 x2 = x * x;
    const f2 p = x2 * f2s(0.044715f * 0.7978845608028654f * 2.f * LOG2E) + f2s(0.7978845608028654f * 2.f * LOG2E);
    const f2 arg = x * p;
    const f2 e = (f2){__builtin_amdgcn_exp2f(arg.x), __builtin_amdgcn_exp2f(arg.y)} + f2s(1.f);
    const f2 r = (f2){__builtin_amdgcn_rcpf(e.x), __builtin_amdgcn_rcpf(e.y)};
    return x - x * r;
}
struct EpiIn {
    int kind; bf16* proj; const float* ssq; const float* bias;
    float* vssq;
    static constexpr bool NEEDS_RS = true;
    __device__ __forceinline__ float apply8(int row, int col0, const float (&v)[8], float rs) const {
        f2 t[4] = {(f2){v[0], v[1]}, (f2){v[2], v[3]}, (f2){v[4], v[5]}, (f2){v[6], v[7]}};
        f2 part2 = f2s(0.f); int pitch;
        if (kind == K_GLA) { pitch = GLA_PITCH;
            if (col0 < 3072) {
#pragma unroll
                for (int j = 0; j < 4; ++j) t[j] = t[j] * f2s(rs);
            } else {
#pragma unroll
                for (int j = 0; j < 4; ++j) { const f2 bb = *(const LAS f2*)(bias_lds + col0 - 3072 + 2 * j); const f2 z = t[j] * f2s(rs) + bb;
                    t[j] = (f2){log_sigmoid(z.x), log_sigmoid(z.y)} * f2s(1.0f / 16.0f); }
            }
        } else if (kind == K_DIFF) { pitch = DIFF_PITCH;
            const float sc = (col0 < 1024) ? rs * (0.125f * LOG2E) : rs;
#pragma unroll
            for (int j = 0; j < 4; ++j) t[j] = t[j] * f2s(sc);
            if (col0 < 2048) {
#pragma unroll
                for (int j = 0; j < 4; ++j) part2 += t[j] * t[j];
            }
        } else { pitch = SGU_PITCH;
#pragma unroll
            for (int j = 0; j < 4; ++j) { const f2 bb = *(const LAS f2*)(bias_lds + col0 + 2 * j); t[j] = gelu_tanh2(t[j] * f2s(rs) + bb); }
            if (col0 >= 1024) {
#pragma unroll
                for (int j = 0; j < 4; ++j) part2 += t[j] * t[j];
            }
        }
        v4u w; w.x = pk2v(t[0]); w.y = pk2v(t[1]); w.z = pk2v(t[2]); w.w = pk2v(t[3]);
        store16o(proj, ((size_t)row * pitch + col0) * 2, w);
        return part2.x + part2.y;
    }
    __device__ __forceinline__ void store_part(int row, int col0, int idx, float part) const {
        if (kind == K_SGU && col0 >= 1024) vssq[(size_t)row * 16 + idx] = part;
    }
    static constexpr bool GROUPMAX = true;
    unsigned* qkmax;
    const LAS float* rs_tab = nullptr; int rs_row0 = -1;
    const LAS float* bias_lds = nullptr;
    static constexpr bool HAS_BIAS = true;
    __device__ __forceinline__ int bias_count() const { return kind == K_GLA ? 512 : (kind == K_SGU ? 2048 : 0); }
    __device__ __forceinline__ bool want_groupmax(int col0) const { return kind == K_DIFF && col0 < 2048; }
    __device__ __forceinline__ void store_groupmax(int row, int col0, float m) const {
        atomicMax(qkmax + (row >> 13) * 64 + (col0 >> 5), __float_as_uint(m * 1.01f));
    }
};
struct EpiHid {
    bf16* h;
    int nostore = 0;
    static constexpr bool NEEDS_RS = false; static constexpr bool HAS_BIAS = false;
    __device__ __forceinline__ float apply8(int row, int col0, const float (&v)[8], float) const {
        f2 t[4];
#pragma unroll
        for (int j = 0; j < 4; ++j) { const f2 a = {__int_as_float(max(__float_as_int(v[2 * j]), 0)), __int_as_float(max(__float_as_int(v[2 * j + 1]), 0))}; t[j] = a * a; }
        v4u w; w.x = pk2v(t[0]); w.y = pk2v(t[1]); w.z = pk2v(t[2]); w.w = pk2v(t[3]);
#if PROBE_KIND == 11
        if (nostore) { asm volatile("" :: "v"(w.x), "v"(w.y), "v"(w.z), "v"(w.w)); return 0.f; }
#endif
        store16o(h, ((size_t)row * FF + col0) * 2, w);
        return 0.f;
    }
    __device__ __forceinline__ void store_part(int, int, int, float) const {}
    static constexpr bool GROUPMAX = false;
    __device__ __forceinline__ bool want_groupmax(int) const { return false; }
    __device__ __forceinline__ void store_groupmax(int, int, float) const {}
};
template <bool RS2> struct EpiResT {
    bf16* xb; float* ssq_out; const float* ssq;
    const LAS float* rs_tab = nullptr; int rs_row0 = -1;
    static constexpr bool NEEDS_RS = RS2; static constexpr bool HAS_BIAS = false;
    __device__ __forceinline__ float apply8(int row, int col0, const float (&v)[8], float rs) const {
        const size_t off = (size_t)row * D + col0;
        const v4u bw = *(const v4u*)(xb + off);
        const f2 s2 = f2s(RS2 ? rs * rs : 1.f);
        const unsigned bwv[4] = {bw.x, bw.y, bw.z, bw.w};
        f2 o[4]; f2 part2 = f2s(0.f);
#pragma unroll
        for (int j = 0; j < 4; ++j) { const f2 x = {bflo(bwv[j]), bfhi(bwv[j])}; const f2 a = {v[2 * j], v[2 * j + 1]};
            o[j] = RS2 ? (a * s2 + x) : (a + x); part2 += o[j] * o[j]; }
        v4u w; w.x = pk2v(o[0]); w.y = pk2v(o[1]); w.z = pk2v(o[2]); w.w = pk2v(o[3]);
        store16o(xb, off * 2, w);
        return part2.x + part2.y;
    }
    __device__ __forceinline__ void store_part(int row, int, int idx, float part) const { ssq_out[(size_t)row * 16 + idx] = part; }
    static constexpr bool GROUPMAX = false;
    __device__ __forceinline__ bool want_groupmax(int) const { return false; }
    __device__ __forceinline__ void store_groupmax(int, int, float) const {}
};

struct ConvItem { const float* W; const float* gain; bf16* WT; int K, N, tile; };
struct ConvRegs { f32x4 w[8]; float g[8]; };
__device__ __forceinline__ void conv_load(ConvRegs& R, const ConvItem& it, int tid) {
    const int nblk = it.N >> 7, kb = it.tile / nblk, nb = it.tile - kb * nblk, k0 = kb << 7, n0 = nb << 7;
    const int n4 = tid & 31, kk = tid >> 5;
    const float* src = it.W + (size_t)(k0 + 8 * kk) * it.N + n0 + 4 * n4;
#pragma unroll
    for (int p = 0; p < 8; ++p) R.w[p] = __builtin_nontemporal_load((const f32x4*)(src + (size_t)p * it.N));
    if (it.gain) { const f32x4 g0 = *(const f32x4*)(it.gain + k0 + 8 * kk), g1 = *(const f32x4*)(it.gain + k0 + 8 * kk + 4);
        R.g[0] = g0.x; R.g[1] = g0.y; R.g[2] = g0.z; R.g[3] = g0.w; R.g[4] = g1.x; R.g[5] = g1.y; R.g[6] = g1.z; R.g[7] = g1.w; }
    else {
#pragma unroll
        for (int p = 0; p < 8; ++p) R.g[p] = 1.f; }
}
__device__ __forceinline__ void conv_store(const ConvRegs& R, const ConvItem& it, LAS unsigned char* img, int tid) {
    const int nblk = it.N >> 7, kb = it.tile / nblk, nb = it.tile - kb * nblk, k0 = kb << 7, n0 = nb << 7;
    const int n4 = tid & 31, kk = tid >> 5;
#pragma unroll
    for (int jn = 0; jn < 4; ++jn) {
        v4u o; o.x = pk2(R.g[0] * R.w[0][jn], R.g[1] * R.w[1][jn]); o.y = pk2(R.g[2] * R.w[2][jn], R.g[3] * R.w[3][jn]); o.z = pk2(R.g[4] * R.w[4][jn], R.g[5] * R.w[5][jn]); o.w = pk2(R.g[6] * R.w[6][jn], R.g[7] * R.w[7][jn]);
        *(LAS v4u*)(img + (4 * n4 + jn) * 256 + ((kk ^ (n4 & 15)) << 4)) = o; }
    __syncthreads();
#pragma unroll
    for (int i = 0; i < 4; ++i) { const int c = tid + NTHR * i, n = c >> 4, kc = c & 15;
        const v4u o = *(const LAS v4u*)(img + n * 256 + ((kc ^ ((n >> 2) & 15)) << 4));
        *(v4u*)(it.WT + (size_t)(n0 + n) * it.K + k0 + 8 * kc) = o; }
    __syncthreads();
}

__device__ __forceinline__ void phase_conv(LAS unsigned char* lds, const Ctx& a, const LayerP& P, int L, int vcu, int G, int part = 0) {
    const int tid = otid(), lane = tid & 63, wave = __builtin_amdgcn_readfirstlane(tid >> 6);
    bf16* Wb = (bf16*)(a.ws + WS_W);
    const int gw = vcu * NWAVES + wave, NGW = G * NWAVES;
    const int nin_w = (P.kind == K_SGU) ? 2048 : 3072;
    const int I_IN = (D / 128) * (nin_w / 128), I_OUT = (D / 128) * (D / 128), I_1 = (D / 128) * (FF / 128), I_2 = (FF / 128) * (D / 128);
    const int NITEMS = I_IN + I_OUT + I_1 + I_2;
    auto item_of = [&](int it) { ConvItem c; int r = it;
        if (r < I_IN) { c.W = P.w_in; c.gain = P.norm1; c.WT = Wb + WOFF_IN; c.K = D; c.N = nin_w; c.tile = r; return c; } r -= I_IN;
        if (r < I_OUT) { c.W = P.w_out; c.gain = nullptr; c.WT = Wb + WOFF_OUT; c.K = D; c.N = D; c.tile = r; return c; } r -= I_OUT;
        if (r < I_1) { c.W = P.w1; c.gain = P.norm2; c.WT = Wb + WOFF_1; c.K = D; c.N = FF; c.tile = r; return c; } r -= I_1;
        c.W = P.w2; c.gain = nullptr; c.WT = Wb + WOFF_2; c.K = FF; c.N = D; c.tile = r; return c; };
    const int it_lo = (part == 2) ? I_IN : 0, it_hi = (part == 1) ? I_IN : NITEMS;
    if (it_lo + vcu < it_hi) {
        int it = it_lo + vcu;
        ConvItem c0 = item_of(it), c1 = c0, c2 = c0; ConvRegs r0, r1, r2;
        conv_load(r0, c0, tid);
        if (it + G < it_hi) { c1 = item_of(it + G); conv_load(r1, c1, tid); } else r1 = r0;
        if (it + 2 * G < it_hi) { c2 = item_of(it + 2 * G); conv_load(r2, c2, tid); } else r2 = r0;
        for (; it < it_hi; it += G) {
            conv_store(r0, c0, lds, tid);
            r0 = r1; c0 = c1; r1 = r2; c1 = c2;
            if (it + 3 * G < it_hi) { c2 = item_of(it + 3 * G); conv_load(r2, c2, tid); }
        }
    }
    if (part == 2) return;
#if GLA_RANK16
    if (P.kind == K_GLA) {
        typedef short cbf16x8 __attribute__((ext_vector_type(8)));
        LAS unsigned char* WgT = lds + 32768;
        { const float* W1 = P.e0;
          for (int k = tid; k < 1024; k += NTHR) { const float gk = P.norm1[k];
              const f32x4 w0 = *(const f32x4*)(W1 + k * 16), w1 = *(const f32x4*)(W1 + k * 16 + 4), w2 = *(const f32x4*)(W1 + k * 16 + 8), w3 = *(const f32x4*)(W1 + k * 16 + 12);
              const float wv[16] = {w0.x, w0.y, w0.z, w0.w, w1.x, w1.y, w1.z, w1.w, w2.x, w2.y, w2.z, w2.w, w3.x, w3.y, w3.z, w3.w};
#pragma unroll
              for (int r = 0; r < 16; ++r) *(LAS bf16*)(WgT + r * 2064 + k * 2) = (bf16)f2bf(gk * wv[r]); } }
        __syncthreads();
        float* R = (float*)(a.ws + WS_R); const bf16* xbr = (const bf16*)(a.ws + WS_XB);
        const int n16 = lane & 15, kq = lane >> 4;
        for (int tile = gw; tile < NTOK / 16; tile += NGW) {
            const int row = tile * 16 + n16;
            f32x4 acc = {0.f, 0.f, 0.f, 0.f}; float sq = 0.f;
#pragma unroll 4
            for (int ks = 0; ks < 32; ++ks) {
                v4u aw;
                if (L == 0) { const f32x4 x0 = *(const f32x4*)(a.in0 + (size_t)row * D + 32 * ks + 8 * kq), x1 = *(const f32x4*)(a.in0 + (size_t)row * D + 32 * ks + 8 * kq + 4);
                    sq += (x0.x * x0.x + x0.y * x0.y) + (x0.z * x0.z + x0.w * x0.w) + (x1.x * x1.x + x1.y * x1.y) + (x1.z * x1.z + x1.w * x1.w);
                    aw.x = pk2(x0.x, x0.y); aw.y = pk2(x0.z, x0.w); aw.z = pk2(x1.x, x1.y); aw.w = pk2(x1.z, x1.w); }
                else { aw = *(const v4u*)(xbr + (size_t)row * D + 32 * ks + 8 * kq);
                    const float e[8] = {bflo(aw.x), bfhi(aw.x), bflo(aw.y), bfhi(aw.y), bflo(aw.z), bfhi(aw.z), bflo(aw.w), bfhi(aw.w)};
#pragma unroll
                    for (int j = 0; j < 8; ++j) sq += e[j] * e[j]; }
                const cbf16x8 bfr = *(const LAS cbf16x8*)(WgT + n16 * 2064 + (32 * ks + 8 * kq) * 2);
                acc = __builtin_amdgcn_mfma_f32_16x16x32_bf16(__builtin_bit_cast(cbf16x8, aw), bfr, acc, 0, 0, 0);
            }
            sq += __shfl_xor(sq, 16); sq += __shfl_xor(sq, 32);
            const float rstd = __builtin_amdgcn_rsqf(sq * (1.0f / D) + EPS);
#pragma unroll
            for (int rg = 0; rg < 4; ++rg) { const float rr = __shfl(rstd, 4 * kq + rg);
                R[(size_t)(tile * 16 + 4 * kq + rg) * 16 + n16] = acc[rg] * rr; }
        }
    }
#else
    if (P.kind == K_GLA) {
        const float* W1 = P.e0; const float* W2 = P.e1;
        for (int e = vcu * NTHR + tid; e < 512 * 1024; e += G * NTHR) {
            const int n = e >> 10, k = e & 1023;
            float s = 0.f;
#pragma unroll
            for (int r = 0; r < 16; ++r) s += W1[k * 16 + r] * W2[r * 512 + n];
            Wb[WOFF_IN + (size_t)(3072 + n) * 1024 + k] = (bf16)f2bf(s * P.norm1[k]);
        }
    }
#endif
    if (L == 0) {
        const float* x = a.in0; bf16* xb = (bf16*)(a.ws + WS_XB); float* ssq = (float*)(a.ws + WS_SSQ);
        for (int m0 = gw; m0 < NTOK; m0 += 2 * NGW) {
            const int m1 = (m0 + NGW < NTOK) ? m0 + NGW : m0;
            f32x4 v[2][4];
#pragma unroll
            for (int j = 0; j < 4; ++j) v[0][j] = __builtin_nontemporal_load((const f32x4*)(x + (size_t)m0 * D) + lane + 64 * j);
#pragma unroll
            for (int j = 0; j < 4; ++j) v[1][j] = __builtin_nontemporal_load((const f32x4*)(x + (size_t)m1 * D) + lane + 64 * j);
#pragma unroll
            for (int q = 0; q < 2; ++q) { const int m = q ? m1 : m0; if (q && m1 == m0) break;
                float s = 0.f;
#pragma unroll
                for (int j = 0; j < 4; ++j) s += (v[q][j].x * v[q][j].x + v[q][j].y * v[q][j].y) + (v[q][j].z * v[q][j].z + v[q][j].w * v[q][j].w);
                s = wave_sum(s);
                v2u* o8 = (v2u*)(xb + (size_t)m * D) + lane;
#pragma unroll
                for (int j = 0; j < 4; ++j) { v2u w; w.x = pk2(v[q][j].x, v[q][j].y); w.y = pk2(v[q][j].z, v[q][j].w); o8[64 * j] = w; }
                if (lane < 16) ssq[(size_t)m * 16 + lane] = (lane == 0) ? s : 0.f; }
        }
    }
}

__device__ __forceinline__ void phase_final(const Ctx& a, int vcu, int G) {
    const int tid = otid(), lane = tid & 63, wave = tid >> 6;
    const int gw = vcu * NWAVES + wave, NGW = G * NWAVES;
    const float* ssq = (const float*)(a.ws + WS_SSQ); const float* g = a.in42; const bf16* xb = (const bf16*)(a.ws + WS_XB);
    const f32x4* gr = (const f32x4*)g;
    for (int m0 = gw; m0 < NTOK; m0 += 2 * NGW) {
        const int m1 = (m0 + NGW < NTOK) ? m0 + NGW : m0;
        v4u w[2][2]; f32x4 sq[2][4];
#pragma unroll
        for (int q = 0; q < 2; ++q) { const int m = q ? m1 : m0;
            const v4u* xr = (const v4u*)(xb + (size_t)m * D) + lane;
            w[q][0] = xr[0]; w[q][1] = xr[64];
            const f32x4* sp = (const f32x4*)(ssq + (size_t)m * 16); sq[q][0] = sp[0]; sq[q][1] = sp[1]; sq[q][2] = sp[2]; sq[q][3] = sp[3]; }
#pragma unroll
        for (int q = 0; q < 2; ++q) { const int m = q ? m1 : m0; if (q && m1 == m0) break;
            const f32x4 a_ = sq[q][0], b_ = sq[q][1], c_ = sq[q][2], d_ = sq[q][3];
            const float ssum = ((a_.x + a_.y) + (a_.z + a_.w)) + ((b_.x + b_.y) + (b_.z + b_.w)) + ((c_.x + c_.y) + (c_.z + c_.w)) + ((d_.x + d_.y) + (d_.z + d_.w));
            const float rs = __builtin_amdgcn_rsqf(ssum * (1.0f / D) + EPS);
            f32x4* orow = (f32x4*)(a.out + (size_t)m * D);
#pragma unroll
            for (int jj = 0; jj < 2; ++jj) { const v4u ww = w[q][jj]; const int c4 = (64 * jj + lane) * 2;
                const f32x4 g0 = gr[c4], g1 = gr[c4 + 1];
                __builtin_nontemporal_store((f32x4){bflo(ww.x) * rs * g0.x, bfhi(ww.x) * rs * g0.y, bflo(ww.y) * rs * g0.z, bfhi(ww.y) * rs * g0.w}, orow + c4);
                __builtin_nontemporal_store((f32x4){bflo(ww.z) * rs * g1.x, bfhi(ww.z) * rs * g1.y, bflo(ww.w) * rs * g1.z, bfhi(ww.w) * rs * g1.w}, orow + c4 + 1); } }
    }
}

struct GlaCum { float b0[8], b1[8], tot0, tot1; };

#ifndef GEMM_RELAX_SEAM
#define GEMM_RELAX_SEAM 1
#endif
namespace pg8 {
#define PG8_LAS __attribute__((address_space(3)))
typedef unsigned short bf16_t;
typedef short bf16x8 __attribute__((ext_vector_type(8)));
typedef float f32x4 __attribute__((ext_vector_type(4)));
typedef unsigned u32x4 __attribute__((ext_vector_type(4)));
constexpr int BM = 256, BK = 64, HALF = 128, HTB = HALF * BK * 2  , STAGE_BYTES = 8 * HTB, NXCD = 8, WGM = 8;

__host__ __device__ __forceinline__ int lds_byte(int r, int c) { const int st = (r >> 4) * 2 + (c >> 5), rr = r & 15, cc = c & 31, ob = rr * 64 + cc * 2; return st * 1024 + (ob ^ (((ob >> 9) & 1) << 5)); }
__host__ __device__ __forceinline__ void stage_rc(int b, int& R, int& C) { const int st = b / 1024, sb = b % 1024, swz = sb ^ (((sb >> 9) & 1) << 5); R = (st >> 1) * 16 + swz / 64; C = (st & 1) * 32 + (swz % 64) / 2; }
__host__ __device__ __forceinline__ int perm32(int rho) { const int n = rho >> 4, i = rho & 15; return 8 * (i >> 2) + 4 * n + (i & 3); }

struct Unit { int pm, pn; };
struct Gemm { const bf16_t* A; int lda; const bf16_t* Bt; int M, N, K; };

struct StaticOrder {
    int nM, nN, nwg, G, c;
    __host__ __device__ void init(int M, int N, int G_, int c_) { nM = M / BM; nN = N / BM; nwg = nM * nN; G = G_; c = c_; }
    __host__ __device__ bool next(int i, Unit& u) const {
        const long L = (long)i * G + c; if (L >= nwg) return false;
        int wgid = (int)L; { const int q = nwg / NXCD, r = nwg % NXCD, xcd = wgid % NXCD, off = wgid / NXCD; wgid = (xcd < r ? xcd * (q + 1) : r * (q + 1) + (xcd - r) * q) + off; }
        const int nig = WGM * nN, gid = wgid / nig, fm = gid * WGM, gsz = (nM - fm) < WGM ? (nM - fm) : WGM;
        u.pm = fm + ((wgid % nig) % gsz); u.pn = (wgid % nig) / gsz; return true;
    }
    __device__ __forceinline__ void a_ready(const Unit&) const {}
    __device__ __forceinline__ void done(const Unit&) const {}
};

struct NoPre { __device__ __forceinline__ void operator()() const {} };
template <class Epi, class Sched, bool ALIGN_EPI = false, bool SP2 = false, class Pre = NoPre>
__device__ __forceinline__ void gemm_phase(PG8_LAS unsigned char* lds, const Gemm g, const Sched& S, const Epi& E, const Pre& pre = Pre()) {
    const int tid = otid(), wid = __builtin_amdgcn_readfirstlane(tid >> 6), lane = tid & 63, wr = wid >> 2, wc = wid & 3, fr = lane & 15, fq = lane >> 4;
    const int K = g.K, nt = K / BK, lda = g.lda;
    unsigned voffA[2], voffB[2];
#pragma unroll
    for (int i = 0; i < 2; ++i) { int R, C; stage_rc(tid * 16 + i * 8192, R, C); const int Rb = Epi::PERM ? ((R & ~31) + perm32(R & 31)) : R;
        voffA[i] = (unsigned)(R * lda + C) * 2u; voffB[i] = (unsigned)(Rb * K + C) * 2u; }
    const unsigned kstep = (unsigned)(BK * 2);
    const unsigned hstepA = (unsigned)HALF * lda * 2, hstepB = (unsigned)HALF * K * 2;
    const unsigned tstepA = 2 * hstepA, tstepB = 2 * hstepB;
    const __amdgpu_buffer_rsrc_t rsA = __builtin_amdgcn_make_buffer_rsrc((void*)g.A, 0, 0x7fffffff, 0x00020000), rsB = __builtin_amdgcn_make_buffer_rsrc((void*)g.Bt, 0, 0x7fffffff, 0x00020000);
    const unsigned ldsw = (unsigned)wid * 1024u;
    const int aoff = lds_byte(wr * 64 + fr, fq * 8), boff = lds_byte(wc * 32 + fr, fq * 8);
#define PG8_SA(b, h) (((b) * 2 + (h)) * HTB)
#define PG8_SB(b, h) ((4 + (b) * 2 + (h)) * HTB)
#define PG8_STAGE(bufoff, goff, voff) do { _Pragma("unroll") for (int _i = 0; _i < 2; ++_i) \
        __builtin_amdgcn_raw_ptr_buffer_load_lds(((bufoff) >= 4 * HTB) ? rsB : rsA, (PG8_LAS unsigned*)(lds + (bufoff) + ldsw + _i * 8192), 16, (int)(voff)[_i], (int)(goff), 0, 0); } while (0)
#define PG8_LDA(dst, b, h) do { _Pragma("unroll") for (int m = 0; m < 4; ++m) _Pragma("unroll") for (int k = 0; k < 2; ++k) dst[m][k] = *(const PG8_LAS bf16x8*)(lds + PG8_SA(b, h) + aoff + m * 2048 + k * 1024); } while (0)
#define PG8_LDB(dst, b, h) do { _Pragma("unroll") for (int n = 0; n < 2; ++n) _Pragma("unroll") for (int k = 0; k < 2; ++k) dst[n][k] = *(const PG8_LAS bf16x8*)(lds + PG8_SB(b, h) + boff + n * 2048 + k * 1024); } while (0)
#define PG8_MMA(ai, bj, At, Bt) do { __builtin_amdgcn_s_setprio(1); _Pragma("unroll") for (int m = 0; m < 4; ++m) _Pragma("unroll") for (int n = 0; n < 2; ++n) _Pragma("unroll") for (int k = 0; k < 2; ++k) \
        acc[ai][bj][m][n] = __builtin_amdgcn_mfma_f32_16x16x32_bf16(Bt[n][k], At[m][k], acc[ai][bj][m][n], 0, 0, 0); __builtin_amdgcn_s_setprio(0); } while (0)
#define PG8_WAIT_V(n) asm volatile("s_waitcnt vmcnt(" #n ")" ::: "memory")
#define PG8_WAIT_VR asm volatile("s_waitcnt vmcnt(%0)" :: "n"(8 + Epi::MIN_VM) : "memory")
#define PG8_WAIT_L(n) asm volatile("s_waitcnt lgkmcnt(" #n ")" ::: "memory")
#define PG8_BAR __builtin_amdgcn_s_barrier()
#define PG8_SCHED __builtin_amdgcn_sched_barrier(0)
    Unit cur, nxt; int ui = 0;
    if (!S.next(0, cur)) return;
    f32x4 acc[2][2][4][2];
#pragma unroll
    for (int a = 0; a < 2; ++a)
#pragma unroll
        for (int b = 0; b < 2; ++b)
#pragma unroll
            for (int m = 0; m < 4; ++m)
#pragma unroll
                for (int n = 0; n < 2; ++n) acc[a][b][m][n] = (f32x4){0.f, 0.f, 0.f, 0.f};
    bf16x8 At[4][2], B0[2][2], B1[2][2];
    unsigned cA = (unsigned)cur.pm * tstepA; unsigned cB = (unsigned)cur.pn * tstepB;
    S.a_ready(cur);
    if constexpr (SP2) {
        PG8_STAGE(PG8_SB(0, 0), cB, voffB); PG8_STAGE(PG8_SB(0, 1), cB + hstepB, voffB); PG8_STAGE(PG8_SA(0, 0), cA, voffA); PG8_STAGE(PG8_SA(0, 1), cA + hstepA, voffA);
        pre();
        if (wr == 1) PG8_BAR;
        PG8_WAIT_V(2); PG8_BAR;
        PG8_STAGE(PG8_SB(1, 0), cB + kstep, voffB); PG8_STAGE(PG8_SA(1, 0), cA + kstep, voffA); PG8_STAGE(PG8_SB(1, 1), cB + hstepB + kstep, voffB);
        PG8_WAIT_V(6); PG8_BAR;
    } else {
        PG8_STAGE(PG8_SB(0, 0), cB, voffB); PG8_STAGE(PG8_SA(0, 0), cA, voffA); PG8_STAGE(PG8_SB(0, 1), cB + hstepB, voffB); PG8_STAGE(PG8_SA(0, 1), cA + hstepA, voffA);
        if (wr == 1) PG8_BAR;
        PG8_WAIT_V(4); PG8_BAR;
        PG8_STAGE(PG8_SB(1, 0), cB + kstep, voffB); PG8_STAGE(PG8_SA(1, 0), cA + kstep, voffA); PG8_STAGE(PG8_SB(1, 1), cB + hstepB + kstep, voffB);
        PG8_WAIT_V(6); PG8_BAR;
    }
    for (;;) {
        const bool has_next = S.next(ui + 1, nxt);
        const unsigned nA = has_next ? (unsigned)nxt.pm * tstepA : cA; const unsigned nB = has_next ? (unsigned)nxt.pn * tstepB : cB;
#define PG8_KT2(FA) do { \
            const bool last = (t == nt - 2); \
            unsigned a1 = cA + (unsigned)(t + 1) * kstep; \
            unsigned a2 = last ? nA : cA + (unsigned)(t + 2) * kstep; unsigned b2 = last ? nB : cB + (unsigned)(t + 2) * kstep; \
            unsigned a3 = a2 + kstep; unsigned b3 = b2 + kstep; \
            asm volatile("" : "+s"(a1), "+s"(a2), "+s"(b2), "+s"(a3), "+s"(b3));     \
            if (last && has_next) S.a_ready(nxt); \
            PG8_LDB(B0, 0, 0); PG8_LDB(B1, 0, 1); PG8_SCHED; PG8_LDA(At, 0, 0); if constexpr (!(FA)) PG8_STAGE(PG8_SA(1, 1), a1 + hstepA, voffA); \
            if constexpr (FA) PG8_WAIT_VR; else PG8_WAIT_V(8); PG8_WAIT_L(0); PG8_BAR; PG8_MMA(0, 0, At, B0); PG8_MMA(0, 1, At, B1); PG8_BAR; PG8_SCHED; \
            PG8_LDA(At, 0, 1); PG8_STAGE(PG8_SB(0, 0), b2, voffB); PG8_STAGE(PG8_SB(0, 1), b2 + hstepB, voffB); PG8_STAGE(PG8_SA(0, 0), a2, voffA); \
            if constexpr (FA) PG8_WAIT_VR; else PG8_WAIT_V(8); PG8_WAIT_L(0); PG8_BAR; PG8_MMA(1, 0, At, B0); PG8_MMA(1, 1, At, B1); PG8_BAR; PG8_SCHED; \
            PG8_LDB(B0, 1, 0); PG8_LDB(B1, 1, 1); PG8_SCHED; PG8_LDA(At, 1, 0); PG8_STAGE(PG8_SA(0, 1), a2 + hstepA, voffA); \
            if constexpr (FA) PG8_WAIT_VR; else PG8_WAIT_V(8); PG8_WAIT_L(0); PG8_BAR; PG8_MMA(0, 0, At, B0); PG8_MMA(0, 1, At, B1); PG8_BAR; PG8_SCHED; \
            PG8_LDA(At, 1, 1); PG8_STAGE(PG8_SB(1, 0), b3, voffB); PG8_STAGE(PG8_SB(1, 1), b3 + hstepB, voffB); PG8_STAGE(PG8_SA(1, 0), a3, voffA); \
            PG8_WAIT_V(8); PG8_WAIT_L(0); PG8_BAR; PG8_MMA(1, 0, At, B0); PG8_MMA(1, 1, At, B1); PG8_BAR; PG8_SCHED; } while (0)
        int t = 0;
        if constexpr (SP2 && GEMM_RELAX_SEAM) { if (ui > 0) { PG8_KT2(true); t = 2; } }
        for (; t < nt; t += 2) {
            if constexpr (SP2) {
            PG8_KT2(false);
            } else {
            const bool last = (t == nt - 2);
            unsigned a1 = cA + (unsigned)(t + 1) * kstep;
            unsigned a2 = last ? nA : cA + (unsigned)(t + 2) * kstep; unsigned b2 = last ? nB : cB + (unsigned)(t + 2) * kstep;
            unsigned a3 = a2 + kstep; unsigned b3 = b2 + kstep;
            if (last && has_next) S.a_ready(nxt);
            PG8_LDB(B0, 0, 0); PG8_SCHED; PG8_LDA(At, 0, 0); PG8_STAGE(PG8_SA(1, 1), a1 + hstepA, voffA);
            PG8_WAIT_L(8); PG8_BAR; PG8_WAIT_L(0); PG8_MMA(0, 0, At, B0); PG8_BAR; PG8_SCHED;
            PG8_LDB(B1, 0, 1); PG8_STAGE(PG8_SB(0, 0), b2, voffB);
            PG8_BAR; PG8_WAIT_L(0); PG8_MMA(0, 1, At, B1); PG8_BAR;
            PG8_LDA(At, 0, 1); PG8_STAGE(PG8_SA(0, 0), a2, voffA);
            PG8_BAR; PG8_WAIT_L(0); PG8_MMA(1, 0, At, B0); PG8_BAR; PG8_SCHED;
            PG8_STAGE(PG8_SB(0, 1), b2 + hstepB, voffB);
            PG8_WAIT_V(6); PG8_BAR; PG8_MMA(1, 1, At, B1); PG8_BAR;
            PG8_LDB(B0, 1, 0); PG8_SCHED; PG8_LDA(At, 1, 0); PG8_STAGE(PG8_SA(0, 1), a2 + hstepA, voffA);
            PG8_WAIT_L(8); PG8_BAR; PG8_WAIT_L(0); PG8_MMA(0, 0, At, B0); PG8_BAR; PG8_SCHED;
            PG8_LDB(B1, 1, 1); PG8_STAGE(PG8_SB(1, 0), b3, voffB);
            PG8_BAR; PG8_WAIT_L(0); PG8_MMA(0, 1, At, B1); PG8_BAR;
            PG8_LDA(At, 1, 1); PG8_STAGE(PG8_SA(1, 0), a3, voffA);
            PG8_BAR; PG8_WAIT_L(0); PG8_MMA(1, 0, At, B0); PG8_BAR; PG8_SCHED;
            PG8_STAGE(PG8_SB(1, 1), b3 + hstepB, voffB);
            PG8_WAIT_V(6); PG8_BAR; PG8_MMA(1, 1, At, B1); PG8_BAR;
            }
        }
        if constexpr (ALIGN_EPI) { if (wr == 0) PG8_BAR; }
        if constexpr (GEMM_RELAX_SEAM && SP2) { if (has_next) { unsigned eb = nA + kstep + hstepA; asm volatile("" : "+s"(eb)); PG8_STAGE(PG8_SA(1, 1), eb, voffA); } }
        if constexpr (!Epi::AFTER_DRAIN) { E(acc, cur, wr, wc, fr, fq); S.done(cur); }
        if (!has_next) break;
#pragma unroll
        for (int a = 0; a < 2; ++a)
#pragma unroll
            for (int b = 0; b < 2; ++b)
#pragma unroll
                for (int m = 0; m < 4; ++m)
#pragma unroll
                    for (int n = 0; n < 2; ++n) acc[a][b][m][n] = (f32x4){0.f, 0.f, 0.f, 0.f};
        cur = nxt; cA = nA; cB = nB; ++ui;
        if constexpr (ALIGN_EPI) { if (wr == 1) PG8_BAR; }
    }
    PG8_WAIT_V(0);
    if constexpr (!ALIGN_EPI) { if (wr == 0) PG8_BAR; }
    PG8_BAR;
    if constexpr (Epi::AFTER_DRAIN) { E.fused(acc, cur, wr, wc, fr, fq, lds, wid, lane); S.done(cur); }
#undef PG8_SA
#undef PG8_SB
#undef PG8_STAGE
#undef PG8_LDA
#undef PG8_LDB
#undef PG8_MMA
#undef PG8_WAIT_V
#undef PG8_WAIT_VR
#undef PG8_KT2
#undef PG8_WAIT_L
#undef PG8_BAR
#undef PG8_SCHED
}
}

template <class Core> struct EpiMfma {
    static constexpr bool PERM = true, AFTER_DRAIN = false;
    static constexpr int MIN_VM = 16;
    Core c;
    __device__ __forceinline__ void operator()(const pg8::f32x4 (&acc)[2][2][4][2], const pg8::Unit& u, int wr, int wc, int fr, int fq) const {
        asm volatile("" : "+v"(fr), "+v"(fq));
        float gmax[2] = {0.f, 0.f};
        float rsv[2][4];
#pragma unroll
        for (int ai = 0; ai < 2; ++ai)
#pragma unroll
            for (int m = 0; m < 4; ++m) { if constexpr (Core::NEEDS_RS) rsv[ai][m] = c.rs_tab[ai * 128 + wr * 64 + m * 16 + fr]; else rsv[ai][m] = 1.f; }
#pragma unroll
        for (int ai = 0; ai < 2; ++ai)
#pragma unroll
            for (int m = 0; m < 4; ++m) {
                const int row = u.pm * 256 + ai * 128 + wr * 64 + m * 16 + fr;
                const float rs = rsv[ai][m];
                float part = 0.f;
#pragma unroll
                for (int bj = 0; bj < 2; ++bj) {
                    const int col0 = u.pn * 256 + bj * 128 + wc * 32 + 8 * fq;
                    const float v[8] = {acc[ai][bj][m][0][0], acc[ai][bj][m][0][1], acc[ai][bj][m][0][2], acc[ai][bj][m][0][3],
                                        acc[ai][bj][m][1][0], acc[ai][bj][m][1][1], acc[ai][bj][m][1][2], acc[ai][bj][m][1][3]};
                    const float p = c.apply8(row, col0, v, rs);
                    part += p;
                    if (Core::GROUPMAX) { const float q = sum_x32(sum_x16(p)); gmax[bj] = fmaxf(gmax[bj], q); }
                }
                part = sum_x32(sum_x16(part));
                if (fq == 0) c.store_part(row, u.pn * 256, (u.pn & 3) * 4 + wc, part);
            }
        if (Core::GROUPMAX) {
#pragma unroll
            for (int bj = 0; bj < 2; ++bj) { const int colg = u.pn * 256 + bj * 128 + wc * 32;
                if (c.want_groupmax(colg)) { const float m = wave_max(gmax[bj]); if (fr == 0 && fq == 0) c.store_groupmax(u.pm * 256, colg, m); } }
        }
    }
};
#ifndef GEMM_STAGGER_TICKS
#define GEMM_STAGGER_TICKS 0
#endif
template <class Core>
__device__ __forceinline__ void run_gemm(LAS unsigned char* lds, const bf16* A, int lda, const bf16* Bt, int M, int N, int K, const Core& c, int vcu, int G) {
    int bxo = (int)blockIdx.x; asm volatile("" : "+s"(bxo));
    pg8::Gemm g{A, lda, Bt, M, N, K}; pg8::StaticOrder S; S.init(M, N, G, bxo);
    EpiMfma<Core> E{c};
#if GEMM_STAGGER_TICKS
    if (N > 1024) {
        const unsigned long long t0_ = __builtin_amdgcn_s_memrealtime(); const unsigned long long dl_ = (unsigned long long)((bxo >> 3) & 3) * GEMM_STAGGER_TICKS;
        while (__builtin_amdgcn_s_memrealtime() - t0_ < dl_) __builtin_amdgcn_s_sleep(4);
    }
#endif
    if constexpr (Core::NEEDS_RS) {
        pg8::Unit u0; const bool have = S.next(0, u0);
        LAS float* tab = (LAS float*)(lds + LDSCTL_OFF + 1024); LAS float* bt = (LAS float*)(lds + LDSCTL_OFF + 2048); const int t_ = otid();
        f32x4 q0 = {0.f, 0.f, 0.f, 0.f}, q1 = q0, q2 = q0, q3 = q0; float bv[4] = {0.f, 0.f, 0.f, 0.f}; int nb = 0;
        if (have) { if (t_ < 256) { const f32x4* pq = (const f32x4*)(c.ssq + (size_t)(u0.pm * 256 + t_) * 16); q0 = pq[0]; q1 = pq[1]; q2 = pq[2]; q3 = pq[3]; }
            E.c.rs_tab = tab; E.c.rs_row0 = u0.pm * 256;
            if constexpr (Core::HAS_BIAS) { nb = c.bias_count();
#pragma unroll
                for (int i = 0; i < 4; ++i) if (t_ + NTHR * i < nb) bv[i] = c.bias[t_ + NTHR * i];
                E.c.bias_lds = bt; } }
        auto pre = [&]() { if (have) { if (t_ < 256) { const float sm = ((q0.x + q0.y) + (q0.z + q0.w)) + ((q1.x + q1.y) + (q1.z + q1.w)) + ((q2.x + q2.y) + (q2.z + q2.w)) + ((q3.x + q3.y) + (q3.z + q3.w));
                                                     tab[t_] = __builtin_amdgcn_rsqf(sm * (1.0f / D) + EPS); }
                                       if constexpr (Core::HAS_BIAS) {
#pragma unroll
                                           for (int i = 0; i < 4; ++i) if (t_ + NTHR * i < nb) bt[t_ + NTHR * i] = bv[i]; } } };
        pg8::gemm_phase<EpiMfma<Core>, pg8::StaticOrder, true, true, decltype(pre)>(lds, g, S, E, pre);
    } else
    pg8::gemm_phase<EpiMfma<Core>, pg8::StaticOrder, true, true>(lds, g, S, E);

}

#include <hip/hip_bf16.h>
#include <cmath>
namespace attn_body {
using bf16=__hip_bfloat16;
using bf16x8=__attribute__((ext_vector_type(8)))short;
using s16x4=__attribute__((ext_vector_type(4)))short;
using f32x16=__attribute__((ext_vector_type(16)))float;
using u32x4=__attribute__((ext_vector_type(4)))unsigned;
constexpr int SEQ=8192,D=64,PQ=3072,PO=2048;
constexpr int NW=8,QBLK=32,QB=QBLK*NW,KVBLK=64,NQB=SEQ/QB;
__device__ __forceinline__ int crow(int r,int hi){return (r&3)+8*(r>>2)+4*hi;}
#define SBAR() __builtin_amdgcn_sched_barrier(0)
__device__ __forceinline__ void cmask(f32x16&p0,f32x16&p1,int jb,int qrel,int hi){
  const float NEG=-INFINITY; int kb=64*jb+4*hi;
  #pragma unroll
  for(int r=0;r<16;++r){int kv=kb+(r&3)+8*(r>>2); if(kv>qrel)p0[r]=NEG; if(kv+32>qrel)p1[r]=NEG;}
}

constexpr int NSLOT=3, SLOTB=8192;
constexpr int LDS_K=0, LDS_V=NSLOT*SLOTB, LDS_WS=2*NSLOT*SLOTB, LDS_OST=LDS_WS+NW*64*4, LDS_BYTES=LDS_OST+NW*4096;
constexpr float C2=0.125f*1.4426950408889634f;
__device__ __forceinline__ void glds16(const void*gsrc,unsigned lds_dst){unsigned keep;
  asm volatile("s_mov_b32 %0, m0\n\ts_mov_b32 m0, %2\n\ts_nop 0\n\tglobal_load_lds_dwordx4 %1, off\n\ts_mov_b32 m0, %0":"=&s"(keep):"v"(gsrc),"s"(lds_dst):"memory");}
__device__ __forceinline__ float max3f(float a,float b,float c){float r;asm("v_max3_f32 %0, %1, %2, %3":"=v"(r):"v"(a),"v"(b),"v"(c));return r;}
__device__ __forceinline__ float max2f(float a,float b){float r;asm("v_max_f32_e32 %0, %1, %2":"=v"(r):"v"(a),"v"(b));return r;}
__device__ __forceinline__ float fadd_s(float a,float b){float r;asm("v_add_f32_e32 %0, %1, %2":"=v"(r):"v"(a),"v"(b));return r;}
__device__ __forceinline__ float fsub_s(float a,float b){float r;asm("v_sub_f32_e32 %0, %1, %2":"=v"(r):"v"(a),"v"(b));return r;}
typedef float f32x2_t __attribute__((ext_vector_type(2))); typedef __bf16 bf16x2_t __attribute__((ext_vector_type(2)));
__device__ __forceinline__ unsigned cvtpk_s(float lo,float hi){f32x2_t v={lo,hi};bf16x2_t b=__builtin_convertvector(v,bf16x2_t);return __builtin_bit_cast(unsigned,b);}
#define WAIT_BAR(N) asm volatile("s_waitcnt vmcnt(" #N ") lgkmcnt(0)\n\ts_barrier":::"memory")

__device__ __forceinline__ void qkt(f32x16&p0,f32x16&p1,const char*Kslot,const bf16x8*qr,const f32x16&negm,int r32,int hi){
  const char*kb=Kslot+hi*1024+r32*16;
  #pragma unroll
  for(int d0=0;d0<4;++d0){
    const bf16x8 b0=*reinterpret_cast<const bf16x8*>(kb+d0*2048);
    const bf16x8 b1=*reinterpret_cast<const bf16x8*>(kb+d0*2048+512);
    if(d0==0){p0=__builtin_amdgcn_mfma_f32_32x32x16_bf16(b0,qr[0],negm,0,0,0);p1=__builtin_amdgcn_mfma_f32_32x32x16_bf16(b1,qr[0],negm,0,0,0);}
    else{p0=__builtin_amdgcn_mfma_f32_32x32x16_bf16(b0,qr[d0],p0,0,0,0);p1=__builtin_amdgcn_mfma_f32_32x32x16_bf16(b1,qr[d0],p1,0,0,0);}}
}
typedef __attribute__((address_space(3))) const char* lds_cptr;
typedef short v4i16_t __attribute__((ext_vector_type(4)));
__device__ __forceinline__ void kload8(bf16x8*kf,lds_cptr kp){
  kf[0]=*(const __attribute__((address_space(3))) bf16x8*)(kp);      kf[1]=*(const __attribute__((address_space(3))) bf16x8*)(kp+512);
  kf[2]=*(const __attribute__((address_space(3))) bf16x8*)(kp+2048); kf[3]=*(const __attribute__((address_space(3))) bf16x8*)(kp+2560);
  kf[4]=*(const __attribute__((address_space(3))) bf16x8*)(kp+4096); kf[5]=*(const __attribute__((address_space(3))) bf16x8*)(kp+4608);
  kf[6]=*(const __attribute__((address_space(3))) bf16x8*)(kp+6144); kf[7]=*(const __attribute__((address_space(3))) bf16x8*)(kp+6656);
}
__device__ __forceinline__ void kload2(bf16x8*kf,lds_cptr kp,int j){ kf[2*j]=*(const __attribute__((address_space(3))) bf16x8*)(kp+j*2048); kf[2*j+1]=*(const __attribute__((address_space(3))) bf16x8*)(kp+j*2048+512); }
__device__ __forceinline__ s16x4 vtr(lds_cptr p){ return __builtin_bit_cast(s16x4,__builtin_amdgcn_ds_read_tr16_b64_v4i16((__attribute__((address_space(3))) v4i16_t*)p)); }
__device__ __forceinline__ float rowmax(const f32x16&p0,const f32x16&p1){
  float a=max3f(p0[0],p0[1],p1[0]),b=max3f(p0[2],p0[3],p1[1]);a=max3f(a,p1[2],p1[3]);
  #pragma unroll
  for(int r=4;r<16;r+=4){a=max3f(a,p0[r],p0[r+1]);b=max3f(b,p0[r+2],p0[r+3]);a=max3f(a,p1[r],p1[r+1]);b=max3f(b,p1[r+2],p1[r+3]);}
  const float m=max2f(a,b);
  auto rr=__builtin_amdgcn_permlane32_swap(__float_as_uint(m),__float_as_uint(m),false,false);
  return max2f(__uint_as_float(rr[0]),__uint_as_float(rr[1]));
}
__device__ __forceinline__ void pv(f32x16*o,int vb,bf16x8 pa0,bf16x8 pa1,bf16x8 pa2,bf16x8 pa3){
  #pragma unroll
  for(int d0=0;d0<2;++d0){s16x4 lo[4],hi[4];
    #pragma unroll
    for(int ks=0;ks<4;++ks){
      asm volatile("ds_read_b64_tr_b16 %0,%1 offset:%c2":"=&v"(lo[ks]):"v"(vb),"i"(d0*4096+ks*1024):"memory");
      asm volatile("ds_read_b64_tr_b16 %0,%1 offset:%c2":"=&v"(hi[ks]):"v"(vb),"i"(d0*4096+ks*1024+512):"memory");}
    asm volatile("s_waitcnt lgkmcnt(0)":::"memory");SBAR();
    #define PK(k) (bf16x8){lo[k][0],lo[k][1],lo[k][2],lo[k][3],hi[k][0],hi[k][1],hi[k][2],hi[k][3]}
    o[d0]=__builtin_amdgcn_mfma_f32_32x32x16_bf16(pa0,PK(0),o[d0],0,0,0);
    o[d0]=__builtin_amdgcn_mfma_f32_32x32x16_bf16(pa1,PK(1),o[d0],0,0,0);
    o[d0]=__builtin_amdgcn_mfma_f32_32x32x16_bf16(pa2,PK(2),o[d0],0,0,0);
    o[d0]=__builtin_amdgcn_mfma_f32_32x32x16_bf16(pa3,PK(3),o[d0],0,0,0);
    #undef PK
  }
}

namespace v2 {
constexpr int NSL=4, KSLOT=8192, VSLOT=16384, LDS_K2=0, LDS_V2=NSL*KSLOT, LDS_WS2=LDS_V2+NSL*VSLOT, LDS_BYTES2=LDS_WS2+NW*64*4;
#define V2_WAIT_BAR(N) asm volatile("s_waitcnt vmcnt(" #N ") lgkmcnt(0)\n\ts_barrier":::"memory")
#define V2_MX3(a,b,c) __builtin_fmaxf(__builtin_fmaxf((a),(b)),(c))
}
template<int THRL,bool SREF> __device__ __forceinline__ void attn_unit_v2(int b,int qb,int t0,const bf16*Q,const bf16*K,const bf16*V,bf16*O,float slope2,float bref,char*shm){
  using namespace v2;
  const int tid=otid(),lane=tid&63,r32=lane&31,hi=lane>>5; const int wid=__builtin_amdgcn_readfirstlane(tid>>6);
  const long rowbase=(long)b*SEQ; const int q0=qb*QB;
  const bf16*Qw=Q+(rowbase+q0+wid*QBLK)*PQ;
  const bf16*Kh=K+(rowbase+(long)t0*KVBLK)*PQ,*Vh=V+(rowbase+(long)t0*KVBLK)*PQ;
  const unsigned lds0=(unsigned)(uintptr_t)shm;
  float*wsf=(float*)(shm+LDS_WS2)+wid*64;
  const bf16*ksrc=Kh+(long)lane*PQ+wid*8;
  const int pi0=2*wid, pi1=2*wid+1;
  const bf16*vsrc0=Vh+(long)(16*(pi0&3)+(lane>>2))*PQ+(pi0>>2)*32+(lane&3)*8;
  const bf16*vsrc1=Vh+(long)(16*(pi1&3)+(lane>>2))*PQ+(pi1>>2)*32+(lane&3)*8;
  const unsigned kdst=lds0+LDS_K2+wid*1024, vdst0=lds0+LDS_V2+pi0*1024, vdst1=lds0+LDS_V2+pi1*1024;
  #define V2_DMA(t,sl) do{ glds16(ksrc+(long)(t)*KVBLK*PQ,(unsigned)__builtin_amdgcn_readfirstlane(kdst+(sl)*KSLOT)); \
      glds16(vsrc0+(long)(t)*KVBLK*PQ,(unsigned)__builtin_amdgcn_readfirstlane(vdst0+(sl)*VSLOT)); \
      glds16(vsrc1+(long)(t)*KVBLK*PQ,(unsigned)__builtin_amdgcn_readfirstlane(vdst1+(sl)*VSLOT)); }while(0)
  #define V2_DMAK(t,sl) glds16(ksrc+(long)(t)*KVBLK*PQ,(unsigned)__builtin_amdgcn_readfirstlane(kdst+(sl)*KSLOT))
  #define V2_DMAV(t,sl) do{ glds16(vsrc0+(long)(t)*KVBLK*PQ,(unsigned)__builtin_amdgcn_readfirstlane(vdst0+(sl)*VSLOT)); \
      glds16(vsrc1+(long)(t)*KVBLK*PQ,(unsigned)__builtin_amdgcn_readfirstlane(vdst1+(sl)*VSLOT)); }while(0)
  const int NT=(q0+QB)/KVBLK-t0;
#if ATTN_BAR2
  V2_DMAK(0,0); V2_DMAK(1,1); V2_DMAK(2,2); V2_DMAV(0,0);
#else
  V2_DMAK(0,0); V2_DMAK(1,1); V2_DMAV(0,0); V2_DMAK(2,2); V2_DMAV(1,1);
#endif
  bf16x8 kf[8];
  bf16x8 qr[4];
  #pragma unroll
  for(int d0=0;d0<4;++d0)qr[d0]=*reinterpret_cast<const bf16x8*>(&Qw[(long)r32*PQ+d0*16+hi*8]);
  float l_reg=0.f; f32x16 o[4];
  #pragma unroll
  for(int d0=0;d0<4;++d0)o[d0]=f32x16{};
  f32x16 negm;
  const float b32=32.f*slope2, step64=64.f*slope2;
  const int qrel=wid*QBLK+r32;
  #pragma unroll
  for(int r=0;r<16;++r)negm[r]=SREF?(slope2*(float)(crow(r,hi)+KVBLK*t0-(q0+qrel))-bref):slope2*(float)crow(r,hi);
  const lds_cptr shm3=(lds_cptr)shm; const lds_cptr kp0=shm3+LDS_K2+hi*1024+r32*16; const lds_cptr vp0=shm3+LDS_V2+((lane>>4)&1)*32+(lane&3)*8+(4*hi+((lane&15)>>2))*64;
  f32x16 pA0,pA1,pB0,pB1; u32x4 pw0,pw1,pw2,pw3;
  #define V2_PIN(x) asm volatile("":"+v"(x))
  #define V2_VRD(dst,d0) do{ _Pragma("unroll") for(int ks=0;ks<4;++ks){ dst[2*ks]=vtr(vp+(d0)*4096+ks*1024); dst[2*ks+1]=vtr(vp+(d0)*4096+ks*1024+512);} }while(0)
  #define V2_VF(src,ks) (bf16x8){src[2*(ks)][0],src[2*(ks)][1],src[2*(ks)][2],src[2*(ks)][3],src[2*(ks)+1][0],src[2*(ks)+1][1],src[2*(ks)+1][2],src[2*(ks)+1][3]}
  #define V2_KLD2(t,d0) do{ const lds_cptr kp_=kp0+((t)&3)*KSLOT; kf[2*(d0)]=*(const __attribute__((address_space(3))) bf16x8*)(kp_+(d0)*2048); kf[2*(d0)+1]=*(const __attribute__((address_space(3))) bf16x8*)(kp_+(d0)*2048+512); SBAR(); }while(0)
  #define V2_KRD(t)
  #define V2_QK(t,C0,C1) do{ V2_KRD(t) \
      C0=__builtin_amdgcn_mfma_f32_32x32x16_bf16(kf[0],qr[0],negm,0,0,0); C1=__builtin_amdgcn_mfma_f32_32x32x16_bf16(kf[1],qr[0],negm,0,0,0); \
      _Pragma("unroll") for(int d0=1;d0<4;++d0){ C0=__builtin_amdgcn_mfma_f32_32x32x16_bf16(kf[2*d0],qr[d0],C0,0,0,0); C1=__builtin_amdgcn_mfma_f32_32x32x16_bf16(kf[2*d0+1],qr[d0],C1,0,0,0); } \
      SBAR(); }while(0)
  #define V2_FILL(P,B,PW,W) do{ sacc+=P[B]; sacc+=P[B+1]; sacc+=P[B+2]; sacc+=P[B+3]; PW[W]=cvtpk_s(P[B],P[B+1]); PW[W+1]=cvtpk_s(P[B+2],P[B+3]); V2_PIN(sacc); V2_PIN(PW); SBAR(); }while(0)
  #define V2_QKF(t,C0,C1,P0,P1) do{ V2_KRD(t) float sacc=0.f; \
      C0=__builtin_amdgcn_mfma_f32_32x32x16_bf16(kf[0],qr[0],negm,0,0,0); V2_FILL(P0,0,pw0,0); \
      C1=__builtin_amdgcn_mfma_f32_32x32x16_bf16(kf[1],qr[0],negm,0,0,0); V2_FILL(P0,4,pw0,2); \
      C0=__builtin_amdgcn_mfma_f32_32x32x16_bf16(kf[2],qr[1],C0,0,0,0);   V2_FILL(P0,8,pw1,0); \
      C1=__builtin_amdgcn_mfma_f32_32x32x16_bf16(kf[3],qr[1],C1,0,0,0);   V2_FILL(P0,12,pw1,2); \
      C0=__builtin_amdgcn_mfma_f32_32x32x16_bf16(kf[4],qr[2],C0,0,0,0);   V2_FILL(P1,0,pw2,0); \
      C1=__builtin_amdgcn_mfma_f32_32x32x16_bf16(kf[5],qr[2],C1,0,0,0);   V2_FILL(P1,4,pw2,2); \
      C0=__builtin_amdgcn_mfma_f32_32x32x16_bf16(kf[6],qr[3],C0,0,0,0);   V2_FILL(P1,8,pw3,0); \
      C1=__builtin_amdgcn_mfma_f32_32x32x16_bf16(kf[7],qr[3],C1,0,0,0);   V2_FILL(P1,12,pw3,2); \
      l_reg+=sacc; }while(0)
  bool resc=false;
  #define V2_DECIDE(t,FIRST,C0,C1) do{ \
      _Pragma("unroll") for(int r=0;r<16;++r)C1[r]+=b32; \
      { const int jb=(t)-(NT-4); if(jb>=0)cmask(C0,C1,jb,qrel,hi); } \
      if constexpr(SREF){ _Pragma("unroll") for(int r=0;r<16;++r)negm[r]+=step64; SBAR(); break; } \
      float rm; \
      { float a=V2_MX3(C0[0],C0[1],C1[0]),c=V2_MX3(C0[2],C0[3],C1[1]); a=V2_MX3(a,C1[2],C1[3]); \
        _Pragma("unroll") for(int r=4;r<16;r+=4){a=V2_MX3(a,C0[r],C0[r+1]);c=V2_MX3(c,C0[r+2],C0[r+3]);a=V2_MX3(a,C1[r],C1[r+1]);c=V2_MX3(c,C1[r+2],C1[r+3]);} \
        rm=__builtin_fmaxf(a,c); auto rr=__builtin_amdgcn_permlane32_swap(__float_as_uint(rm),__float_as_uint(rm),false,false); rm=__builtin_fmaxf(__uint_as_float(rr[0]),__uint_as_float(rr[1])); } \
      float adj=step64; resc=false; \
      if(FIRST){ _Pragma("unroll") for(int r=0;r<16;++r){C0[r]-=rm;C1[r]-=rm;} adj-=rm; } \
      else if(__any(rm>(float)THRL)){ const float dl=__builtin_fmaxf(rm,0.f); \
        _Pragma("unroll") for(int r=0;r<16;++r){C0[r]-=dl;C1[r]-=dl;} \
        adj-=dl; const float f=__builtin_amdgcn_exp2f(-dl); l_reg*=f; if(hi==0)wsf[r32]=f; resc=true; } \
      _Pragma("unroll") for(int r=0;r<16;++r)negm[r]+=adj; \
      SBAR(); }while(0)
  #define V2_GRP(d0,ks,src,C,B) do{ o[d0]=__builtin_amdgcn_mfma_f32_32x32x16_bf16(__builtin_bit_cast(bf16x8,pw##ks),V2_VF(src,ks),o[d0],0,0,0); \
      C[B]=__builtin_amdgcn_exp2f(C[B]); C[B+1]=__builtin_amdgcn_exp2f(C[B+1]); V2_PIN(C); SBAR(); }while(0)
#if ATTN_BAR2
  #define V2_SYNC(t) do{ V2_WAIT_BAR(0); \
      if((t)+3<NT){ V2_DMAK((t)+3,((t)+3)&3); } if((t)+4<NT){ V2_DMAK((t)+4,((t)+4)&3); } if((t)+1<NT){ V2_DMAV((t)+1,((t)+1)&3); } if((t)+2<NT){ V2_DMAV((t)+2,((t)+2)&3); } }while(0)
#else
  #define V2_SYNC(t) do{ if((t)+2<NT){ V2_WAIT_BAR(3); } else if((t)+1<NT){ V2_WAIT_BAR(2); } else { V2_WAIT_BAR(0); } \
      if((t)+3<NT){ V2_DMAK((t)+3,((t)+3)&3); } if((t)+2<NT){ V2_DMAV((t)+2,((t)+2)&3); } }while(0)
#endif
  #define V2_KPF(PF,t,d0) do{ if(PF){ V2_KLD2((t)+1,d0); } }while(0)
  #define V2_STEP(t,C0,C1,P0,P1,PF,BAR) do{ if(!(ATTN_BAR2)||(BAR)){ V2_SYNC(t); } \
      const lds_cptr vp=vp0+(((t)-1)&3)*VSLOT; s16x4 va[8],vb[8]; \
      V2_VRD(va,0); \
      V2_QKF(t,C0,C1,P0,P1); V2_DECIDE(t,false,C0,C1); \
      V2_VRD(vb,1); \
      V2_GRP(0,0,va,C0,0); V2_GRP(0,1,va,C0,2); V2_GRP(0,2,va,C0,4); V2_GRP(0,3,va,C0,6); \
      V2_VRD(va,2); \
      V2_GRP(1,0,vb,C0,8); V2_KPF(PF,t,0); V2_GRP(1,1,vb,C0,10); V2_KPF(PF,t,1); V2_GRP(1,2,vb,C0,12); V2_GRP(1,3,vb,C0,14); \
      V2_VRD(vb,3); \
      V2_GRP(2,0,va,C1,0); V2_KPF(PF,t,2); V2_GRP(2,1,va,C1,2); V2_KPF(PF,t,3); V2_GRP(2,2,va,C1,4); V2_GRP(2,3,va,C1,6); \
      V2_GRP(3,0,vb,C1,8); V2_GRP(3,1,vb,C1,10); V2_GRP(3,2,vb,C1,12); V2_GRP(3,3,vb,C1,14); \
      if(resc){ asm volatile("s_waitcnt lgkmcnt(0)":::"memory");         \
        _Pragma("unroll") for(int r=0;r<16;++r){ const float fr_=wsf[crow(r,hi)]; \
          _Pragma("unroll") for(int d0=0;d0<4;++d0)o[d0][r]*=fr_; } \
        asm volatile("s_waitcnt lgkmcnt(0)":::"memory"); } }while(0)
#if ATTN_BAR2
  V2_WAIT_BAR(0);
  V2_KLD2(0,0); V2_KLD2(0,1); V2_KLD2(0,2); V2_KLD2(0,3);
  V2_SYNC(0); V2_QK(0,pA0,pA1);
#else
  V2_SYNC(0); V2_KLD2(0,0); V2_KLD2(0,1); V2_KLD2(0,2); V2_KLD2(0,3); V2_QK(0,pA0,pA1);
#endif
  V2_KLD2(1,0); V2_KLD2(1,1); V2_KLD2(1,2); V2_KLD2(1,3);
  V2_DECIDE(0,true,pA0,pA1);
  #pragma unroll
  for(int r=0;r<16;++r){pA0[r]=__builtin_amdgcn_exp2f(pA0[r]);pA1[r]=__builtin_amdgcn_exp2f(pA1[r]);}
  for(int t=1;t+1<NT;t+=2){ V2_STEP(t,pB0,pB1,pA0,pA1,true,false); V2_STEP(t+1,pA0,pA1,pB0,pB1,true,true); }
  V2_STEP(NT-1,pB0,pB1,pA0,pA1,false,false);
#if ATTN_BAR2
  V2_WAIT_BAR(0);
#endif
  { float sacc=0.f;
    #pragma unroll
    for(int r=0;r<16;++r)sacc+=pB0[r]+pB1[r];
    l_reg+=sacc;
    pw0=(u32x4){cvtpk_s(pB0[0],pB0[1]),cvtpk_s(pB0[2],pB0[3]),cvtpk_s(pB0[4],pB0[5]),cvtpk_s(pB0[6],pB0[7])};
    pw1=(u32x4){cvtpk_s(pB0[8],pB0[9]),cvtpk_s(pB0[10],pB0[11]),cvtpk_s(pB0[12],pB0[13]),cvtpk_s(pB0[14],pB0[15])};
    pw2=(u32x4){cvtpk_s(pB1[0],pB1[1]),cvtpk_s(pB1[2],pB1[3]),cvtpk_s(pB1[4],pB1[5]),cvtpk_s(pB1[6],pB1[7])};
    pw3=(u32x4){cvtpk_s(pB1[8],pB1[9]),cvtpk_s(pB1[10],pB1[11]),cvtpk_s(pB1[12],pB1[13]),cvtpk_s(pB1[14],pB1[15])};
    const lds_cptr vp=vp0+((NT-1)&3)*VSLOT; s16x4 va[8],vb[8];
    #define V2_PV(d0,src) do{ o[d0]=__builtin_amdgcn_mfma_f32_32x32x16_bf16(__builtin_bit_cast(bf16x8,pw0),V2_VF(src,0),o[d0],0,0,0); \
        o[d0]=__builtin_amdgcn_mfma_f32_32x32x16_bf16(__builtin_bit_cast(bf16x8,pw1),V2_VF(src,1),o[d0],0,0,0); \
        o[d0]=__builtin_amdgcn_mfma_f32_32x32x16_bf16(__builtin_bit_cast(bf16x8,pw2),V2_VF(src,2),o[d0],0,0,0); \
        o[d0]=__builtin_amdgcn_mfma_f32_32x32x16_bf16(__builtin_bit_cast(bf16x8,pw3),V2_VF(src,3),o[d0],0,0,0); }while(0)
    V2_VRD(va,0); V2_VRD(vb,1); V2_PV(0,va); V2_VRD(va,2); V2_PV(1,vb); V2_VRD(vb,3); V2_PV(2,va); V2_PV(3,vb);
    #undef V2_PV
  }
  #undef V2_PIN
  #undef V2_VRD
  #undef V2_VF
  #undef V2_KRD
  #undef V2_QK
  #undef V2_QKF
  #undef V2_FILL
  #undef V2_DECIDE
  #undef V2_GRP
  #undef V2_STEP
  #undef V2_SYNC
  {auto rr=__builtin_amdgcn_permlane32_swap(__float_as_uint(l_reg),__float_as_uint(l_reg),false,false);l_reg=__uint_as_float(rr[0])+__uint_as_float(rr[1]);}
  if(hi==0)wsf[32+r32]=l_reg;asm volatile("s_waitcnt lgkmcnt(0)":::"memory");
  float rli[16];
  #pragma unroll
  for(int r=0;r<16;++r)rli[r]=__builtin_amdgcn_rcpf(wsf[32+crow(r,hi)]);
  asm volatile("s_waitcnt lgkmcnt(0)\n\ts_barrier":::"memory");
  bf16*Ow=O+(rowbase+q0+wid*QBLK)*PO;
  { bf16*stg=(bf16*)shm+wid*4096;
    #pragma unroll
    for(int r=0;r<16;++r){const int orow=crow(r,hi);
      #pragma unroll
      for(int d0=0;d0<4;++d0)stg[orow*128+d0*32+r32]=__float2bfloat16(o[d0][r]*rli[r]);}
    asm volatile("s_waitcnt lgkmcnt(0)":::"memory");
    #pragma unroll
    for(int i=0;i<8;++i){const int row=i*4+(lane>>4),ch=lane&15; const u32x4 v=*(const u32x4*)(stg+row*128+ch*8); *(u32x4*)(Ow+(long)row*PO+ch*8)=v;} }
  asm volatile("s_waitcnt lgkmcnt(0)\n\ts_barrier":::"memory");
  #undef V2_DMA
  #undef V2_DMAK
  #undef V2_DMAV
  #undef V2_KLD2
  #undef V2_KPF
}
constexpr int ATTN_LDS_BYTES=LDS_BYTES;
#undef SBAR
#undef WAIT_BAR
}

__device__ __forceinline__ void phase_diff_mfma(char* shm, LAS unsigned char* lds, const Ctx& a, int vcu, int G) {
    bf16* proj = (bf16*)(a.ws + WS_H); bf16* o12 = (bf16*)(a.ws + WS_STATE);
    unsigned* ctl = (unsigned*)(a.ws + WS_CTL);
    volatile LAS unsigned* qslot = (volatile LAS unsigned*)(lds + MISC_OFF) + 16;
    for (;;) {
        const int tid = otid();
        if (tid == 0) *qslot = atomicAdd(ctl + CW_QUEUE, 1u);
        __syncthreads();
        const unsigned idx = (unsigned)__builtin_amdgcn_readfirstlane((int)*qslot);
        __syncthreads();
        if (idx >= (unsigned)(NB * DIFF_H * 2 * 32)) break;
        const int qb = 31 - (int)(idx >> 5), rem = idx & 31, b = rem >> 4, h = (rem >> 1) & 7, r = rem & 1;
        const float slope2 = exp2f(-(float)(h + 1)) * LOG2E;
        int t0 = 0; float smax_u;
        { const unsigned* qm = ctl + CW_QKMAX + b * 64; const int g0 = (h * 128 + r * 64) >> 5;
          const float pq = __uint_as_float(qm[g0]) + __uint_as_float(qm[g0 + 1]), pk = __uint_as_float(qm[32 + g0]) + __uint_as_float(qm[32 + g0 + 1]);
          const float smax = sqrtf(pq * pk); smax_u = smax;
          const float d = (float)(qb * 256) - (152.0f + 2.1f * smax) / slope2;
          if (d > 0.f) t0 = ((int)d >> 6) & ~1;
          if (t0 > 4 * qb) t0 = 4 * qb; }
#if ATTN_SREF
        if (smax_u <= 48.f)
            attn_body::attn_unit_v2<8, true>(b, qb, t0, (const attn_body::bf16*)(proj + h * 128 + r * 64), (const attn_body::bf16*)(proj + 1024 + h * 128 + r * 64),
                                   (const attn_body::bf16*)(proj + 2048 + h * 128), (attn_body::bf16*)(o12 + r * 1024 + h * 128), slope2, smax_u, shm);
        else
#endif
        attn_body::attn_unit_v2<8, false>(b, qb, t0, (const attn_body::bf16*)(proj + h * 128 + r * 64), (const attn_body::bf16*)(proj + 1024 + h * 128 + r * 64),
                                   (const attn_body::bf16*)(proj + 2048 + h * 128), (attn_body::bf16*)(o12 + r * 1024 + h * 128), slope2, 0.f, shm);
    }
}
__device__ __forceinline__ void phase_diff_combine(const Ctx& a, const LayerP& P, int vcu, int G) {
    const int tid = otid(), lane = tid & 63, wave = tid >> 6;
    bf16* proj = (bf16*)(a.ws + WS_H); const bf16* o12 = (const bf16*)(a.ws + WS_STATE);
    float lam;
    { float s1 = 0.f, s2 = 0.f;
      for (int i = 0; i < 64; ++i) { s1 += P.e0[i] * P.e1[i]; s2 += P.e2[i] * P.e3[i]; }
      lam = __expf(s1) - __expf(s2) + LAMBDA_INIT; }
    const int h = lane >> 3, sub = lane & 7;
    float hn[16];
#pragma unroll
    for (int j = 0; j < 16; ++j) hn[j] = P.e4[sub * 16 + j] * (1.0f - LAMBDA_INIT);
    const int gw = vcu * NWAVES + wave, NGW = G * NWAVES;
    for (int r0 = gw; r0 < NTOK; r0 += 2 * NGW) {
      const int r1 = (r0 + NGW < NTOK) ? r0 + NGW : r0;
      v4u ld[2][4];
#pragma unroll
      for (int q = 0; q < 2; ++q) { const bf16* p1 = o12 + (size_t)(q ? r1 : r0) * 2048 + h * 128 + sub * 16;
          ld[q][0] = *(const v4u*)p1; ld[q][1] = *(const v4u*)(p1 + 8); ld[q][2] = *(const v4u*)(p1 + 1024); ld[q][3] = *(const v4u*)(p1 + 1032); }
#pragma unroll
      for (int q = 0; q < 2; ++q) { const int row = q ? r1 : r0; if (q && r1 == r0) break;
        const v4u a0 = ld[q][0], a1 = ld[q][1], b0 = ld[q][2], b1 = ld[q][3];
        const unsigned aw[8] = {a0.x, a0.y, a0.z, a0.w, a1.x, a1.y, a1.z, a1.w}, bw[8] = {b0.x, b0.y, b0.z, b0.w, b1.x, b1.y, b1.z, b1.w};
        float o[16]; float ss = 0.f;
#pragma unroll
        for (int j = 0; j < 8; ++j) { o[2 * j] = bflo(aw[j]) - lam * bflo(bw[j]); o[2 * j + 1] = bfhi(aw[j]) - lam * bfhi(bw[j]); ss += o[2 * j] * o[2 * j] + o[2 * j + 1] * o[2 * j + 1]; }
        ss = sum_lanes8(ss);
        const float rs = 1.0f / sqrtf(ss * (1.0f / 128.0f) + EPS);
        v4u w0, w1;
        w0.x = pk2(o[0] * rs * hn[0], o[1] * rs * hn[1]); w0.y = pk2(o[2] * rs * hn[2], o[3] * rs * hn[3]); w0.z = pk2(o[4] * rs * hn[4], o[5] * rs * hn[5]); w0.w = pk2(o[6] * rs * hn[6], o[7] * rs * hn[7]);
        w1.x = pk2(o[8] * rs * hn[8], o[9] * rs * hn[9]); w1.y = pk2(o[10] * rs * hn[10], o[11] * rs * hn[11]); w1.z = pk2(o[12] * rs * hn[12], o[13] * rs * hn[13]); w1.w = pk2(o[14] * rs * hn[14], o[15] * rs * hn[15]);
        bf16* op = proj + (size_t)row * DIFF_PITCH + h * 128 + sub * 16;
        *(v4u*)op = w0; *(v4u*)(op + 8) = w1;
      }
    }
}

typedef short mbf16x8 __attribute__((ext_vector_type(8)));
typedef short ms16x4 __attribute__((ext_vector_type(4)));
typedef float mf32x16 __attribute__((ext_vector_type(16)));
#define MFMA32(a, b, c) __builtin_amdgcn_mfma_f32_32x32x16_bf16(a, b, c, 0, 0, 0)
__device__ __forceinline__ int crow32(int r, int hi) { return (r & 3) + 8 * (r >> 2) + 4 * hi; }
__device__ __forceinline__ mbf16x8 frag_rk(const LAS unsigned char* base, int stride, int row0, int k0, int lane) {
    return *(const LAS mbf16x8*)(base + (row0 + (lane & 31)) * stride + (k0 + 8 * (lane >> 5)) * 2);
}
__device__ __forceinline__ mbf16x8 frag_kn(const LAS unsigned char* base, int stride, int k0, int n0, int lane) {
    const int i = lane & 15, g = lane >> 4;
    const LAS unsigned char* p = base + (k0 + 8 * (g >> 1) + (i >> 2)) * stride + (n0 + 16 * (g & 1) + 4 * (i & 3)) * 2;
    const ms16x4 lo = __builtin_bit_cast(ms16x4, __builtin_amdgcn_ds_read_tr16_b64_v4i16((LAS ms16x4*)p));
    const ms16x4 hi = __builtin_bit_cast(ms16x4, __builtin_amdgcn_ds_read_tr16_b64_v4i16((LAS ms16x4*)(p + 4 * stride)));
    return (mbf16x8){lo[0], lo[1], lo[2], lo[3], hi[0], hi[1], hi[2], hi[3]};
}
__device__ __forceinline__ mf32x16 zero16() { mf32x16 z;
#pragma unroll
    for (int r = 0; r < 16; ++r) z[r] = 0.f; return z; }

__device__ __forceinline__ void phase_sgu_mfma(LAS unsigned char* lds, const Ctx& a, const LayerP& P, int vcu, int G, bool dummy = false) {
    const int tid = otid(), lane = tid & 63, wave = __builtin_amdgcn_readfirstlane(tid >> 6);
    bf16* proj = (bf16*)(a.ws + WS_H); const float* vssq = (const float*)(a.ws + WS_VSSQ);
    const float* v_norm = P.e1; const float* w_s = P.e2; const float* b_s = P.e3;
    constexpr int SA = 272, SV = 320, SO = 132;
    LAS unsigned char* WA = lds;
    LAS unsigned char* VV = lds + 128 * SA;
    LAS float* OS = (LAS float*)(lds + 128 * SA);
    LAS float* RS = (LAS float*)(lds + 128 * SA + 128 * SO * 4);
    const int tm = wave & 3, nh = wave >> 2, hi = lane >> 5;
    constexpr int NU = NB * (T / SGU_C) * SGU_G;
    int g_res = -1;
    v4u vraw[4]; float rsraw = 0.f;
    #define SGU_LOAD_RAW(uu) do{ const int g_ = (uu) % SGU_G, row0_ = ((uu) / SGU_G) * SGU_C; \
        _Pragma("unroll") for (int i = 0; i < 4; ++i) { const int ch = tid + NTHR * i, r = ch >> 4, c16 = ch & 15; \
            vraw[i] = *(const v4u*)(proj + (size_t)(row0_ + r) * SGU_PITCH + 1024 + g_ * 128 + c16 * 8); } \
        if (tid < 128) rsraw = row_rstd(vssq, row0_ + tid); }while(0)
    if (vcu < NU) SGU_LOAD_RAW(vcu);
    for (int u = vcu; u < NU; u += G) {
        const int g = u % SGU_G, bc = u / SGU_G;
        const int row0 = bc * SGU_C;
        if (tid < 128) RS[tid] = rsraw;
        v4u vcur[4];
#pragma unroll
        for (int i = 0; i < 4; ++i) vcur[i] = vraw[i];
        v4u uw[4];
#pragma unroll
        for (int i = 0; i < 4; ++i) { const int ch = tid + NTHR * i, t = ch >> 4, c8 = (ch & 15) * 8; uw[i] = *(const v4u*)(proj + (size_t)(row0 + t) * SGU_PITCH + g * 128 + c8); }
        if (g != g_res) {
#pragma unroll
            for (int i = 0; i < 8; ++i) { const int idx = tid + NTHR * i, t = idx >> 5, s4 = (idx & 31) * 4;
                const f32x4 w = *(const f32x4*)(w_s + (size_t)g * 16384 + t * 128 + s4);
                v2u o; o.x = pk2((s4 + 0 <= t) ? w.x : 0.f, (s4 + 1 <= t) ? w.y : 0.f); o.y = pk2((s4 + 2 <= t) ? w.z : 0.f, (s4 + 3 <= t) ? w.w : 0.f);
                *(LAS v2u*)(WA + t * SA + s4 * 2) = o; }
            g_res = g;
        }
        if (u + G < NU) SGU_LOAD_RAW(u + G);
        __syncthreads();
#pragma unroll
        for (int i = 0; i < 4; ++i) { const int ch = tid + NTHR * i, r = ch >> 4, c16 = ch & 15; const float rs = RS[r];
            v4u o; o.x = pk2(bflo(vcur[i].x) * rs, bfhi(vcur[i].x) * rs); o.y = pk2(bflo(vcur[i].y) * rs, bfhi(vcur[i].y) * rs);
            o.z = pk2(bflo(vcur[i].z) * rs, bfhi(vcur[i].z) * rs); o.w = pk2(bflo(vcur[i].w) * rs, bfhi(vcur[i].w) * rs);
            *(LAS v4u*)(VV + r * SV + c16 * 16) = o; }
        __syncthreads();
        mf32x16 acc0 = zero16(), acc1 = zero16();
        for (int ks = 0; ks < 2 * (tm + 1); ++ks) {
            const mbf16x8 af = frag_rk(WA, SA, 32 * tm, 16 * ks, lane);
            const mbf16x8 b0 = frag_kn(VV, SV, 16 * ks, 64 * nh, lane), b1 = frag_kn(VV, SV, 16 * ks, 64 * nh + 32, lane);
            acc0 = MFMA32(af, b0, acc0); acc1 = MFMA32(af, b1, acc1);
        }
        __syncthreads();
#pragma unroll
        for (int r = 0; r < 16; ++r) { const int row = 32 * tm + crow32(r, hi);
            OS[row * SO + 64 * nh + (lane & 31)] = acc0[r]; OS[row * SO + 64 * nh + 32 + (lane & 31)] = acc1[r]; }
        __syncthreads();
#pragma unroll
        for (int i = 0; i < 4; ++i) { const int ch = tid + NTHR * i, t = ch >> 4, c8 = (ch & 15) * 8;
            const f32x4 s0 = *(const LAS f32x4*)(OS + t * SO + c8), s1 = *(const LAS f32x4*)(OS + t * SO + c8 + 4);
            const f32x4 n0 = *(const f32x4*)(v_norm + g * 128 + c8), n1 = *(const f32x4*)(v_norm + g * 128 + c8 + 4);
            const float bs = b_s[g * 128 + t];
            bf16* up = proj + (size_t)(row0 + t) * SGU_PITCH + g * 128 + c8;
            const v4u uwv = uw[i];
            v4u o;
            o.x = pk2(bflo(uwv.x) * (n0.x * s0.x + bs), bfhi(uwv.x) * (n0.y * s0.y + bs)); o.y = pk2(bflo(uwv.y) * (n0.z * s0.z + bs), bfhi(uwv.y) * (n0.w * s0.w + bs));
            o.z = pk2(bflo(uwv.z) * (n1.x * s1.x + bs), bfhi(uwv.z) * (n1.y * s1.y + bs)); o.w = pk2(bflo(uwv.w) * (n1.z * s1.z + bs), bfhi(uwv.w) * (n1.w * s1.w + bs));
            if (dummy) *(v4u*)((bf16*)(a.ws + WS_STATE + 32 * MiB) + (size_t)(row0 + t) * 1024 + g * 128 + c8) = o; else *(v4u*)up = o; }
        __syncthreads();
    }
    #undef SGU_LOAD_RAW
}

constexpr int GLA_GRP = 4, GLA_NG = GLA_NC / GLA_GRP;
constexpr int GLA_NU2 = NB * GLA_H * GLA_NG;
struct GlaGate { const float* R; const float* w2; const float* gb; };
struct GlaRaw2 { float la0[8], la1[8]; unsigned q[8], k[8]; v4u v[4]; };
__device__ __forceinline__ void gla2_load_raw(GlaRaw2& r, const bf16* proj, const GlaGate& gt, int row0, int h, int tid, bool want_q) {
    const int cp = tid & 63, part = tid >> 6;
#pragma unroll
    for (int i = 0; i < 8; ++i) { const bf16* base = proj + (size_t)(row0 + 8 * part + i) * GLA_PITCH + h * 128 + 2 * cp;
        r.k[i] = *(const unsigned*)(base + 512); r.q[i] = want_q ? *(const unsigned*)base : 0u; }
#if GLA_RANK16
    { const f32x2v gbv = *(const f32x2v*)(gt.gb + h * 128 + 2 * cp);
#pragma unroll
      for (int i = 0; i < 8; ++i) { r.la0[i] = gbv.x; r.la1[i] = gbv.y; }
#pragma unroll 1
      for (int j4 = 0; j4 < 4; ++j4) {
          f32x2v w[4];
#pragma unroll
          for (int jj = 0; jj < 4; ++jj) w[jj] = *(const f32x2v*)(gt.w2 + (4 * j4 + jj) * 512 + h * 128 + 2 * cp);
#pragma unroll
          for (int i = 0; i < 8; ++i) { const f32x4 rv = *(const f32x4*)(gt.R + (size_t)(row0 + 8 * part + i) * 16 + 4 * j4);
              r.la0[i] += rv.x * w[0].x + rv.y * w[1].x + rv.z * w[2].x + rv.w * w[3].x;
              r.la1[i] += rv.x * w[0].y + rv.y * w[1].y + rv.z * w[2].y + rv.w * w[3].y; }
      }
#pragma unroll
      for (int i = 0; i < 8; ++i) { r.la0[i] = log_sigmoid(r.la0[i]) * (1.0f / 16.0f); r.la1[i] = log_sigmoid(r.la1[i]) * (1.0f / 16.0f); } }
#else
#pragma unroll
    for (int i = 0; i < 8; ++i) { const unsigned w = *(const unsigned*)(proj + (size_t)(row0 + 8 * part + i) * GLA_PITCH + 3072 + h * 128 + 2 * cp); r.la0[i] = bflo(w); r.la1[i] = bfhi(w); }
#endif
#pragma unroll
    for (int i = 0; i < 4; ++i) { const int ch = tid + NTHR * i, rr = ch >> 5, c16 = ch & 31;
        r.v[i] = *(const v4u*)(proj + (size_t)(row0 + rr) * GLA_PITCH + 1024 + h * 256 + c16 * 8); }
}
__device__ __forceinline__ void gla2_cumsum(GlaCum& c, const GlaRaw2& r, LAS float* TOT, int tid) {
    const int cp = tid & 63, part = tid >> 6;
#pragma unroll
    for (int i = 0; i < 8; ++i) { c.b0[i] = r.la0[i]; c.b1[i] = r.la1[i]; }
#pragma unroll
    for (int i = 1; i < 8; ++i) { c.b0[i] += c.b0[i - 1]; c.b1[i] += c.b1[i - 1]; }
    TOT[part * 128 + 2 * cp] = c.b0[7]; TOT[part * 128 + 2 * cp + 1] = c.b1[7];
    __syncthreads();
    float o0 = 0.f, o1 = 0.f, t0 = 0.f, t1 = 0.f;
#pragma unroll
    for (int p = 0; p < 8; ++p) { const float x0 = TOT[p * 128 + 2 * cp], x1 = TOT[p * 128 + 2 * cp + 1]; if (p < part) { o0 += x0; o1 += x1; } t0 += x0; t1 += x1; }
#pragma unroll
    for (int i = 0; i < 8; ++i) { c.b0[i] += o0; c.b1[i] += o1; }
    c.tot0 = t0; c.tot1 = t1;
}
__device__ __forceinline__ void gla2_state_update(mf32x16 (&S)[4], const LAS unsigned char* KE, const LAS unsigned char* VV, const LAS float* DEC, int wave, int lane, bool scale) {
    const int hi = lane >> 5;
    if (scale) {
#pragma unroll
        for (int kt = 0; kt < 4; ++kt)
#pragma unroll
            for (int rq = 0; rq < 4; ++rq) { const f32x4 d = *(const LAS f32x4*)(DEC + 32 * kt + 8 * rq + 4 * hi);
                S[kt][4 * rq + 0] *= d.x; S[kt][4 * rq + 1] *= d.y; S[kt][4 * rq + 2] *= d.z; S[kt][4 * rq + 3] *= d.w; }
    }
#pragma unroll
    for (int ks = 0; ks < 4; ++ks) { const mbf16x8 bfr = frag_kn(VV, 576, 16 * ks, 32 * wave, lane);
#pragma unroll
        for (int kt = 0; kt < 4; ++kt) S[kt] = MFMA32(frag_kn(KE, 320, 16 * ks, 32 * kt, lane), bfr, S[kt]); }
}
__device__ __forceinline__ void phase_gla2_kv(LAS unsigned char* lds, const Ctx& a, const LayerP& P, int vcu, int G) {
    const GlaGate gt{(const float*)(a.ws + WS_R), P.e1, P.e2};
    const int tid = otid(), lane = tid & 63, wave = __builtin_amdgcn_readfirstlane(tid >> 6), hi = lane >> 5;
    const bf16* proj = (const bf16*)(a.ws + WS_H); bf16* state = (bf16*)(a.ws + WS_STATE); float* dec = (float*)(a.ws + WS_DEC);
    LAS unsigned char* VV = lds;
    LAS unsigned char* KE = lds + 36864;
    LAS float* TOT = (LAS float*)(lds + 57344);
    LAS float* DEC = (LAS float*)(lds + 61440);
    const int cp = tid & 63, part = tid >> 6;
    for (int u = vcu; u < GLA_NU2; u += G) {
        const int grp = u % GLA_NG, bh = u / GLA_NG, h = bh % GLA_H, b = bh / GLA_H;
        const int row0 = b * T + grp * (GLA_GRP * GLA_C);
        mf32x16 S[4];
#pragma unroll
        for (int kt = 0; kt < 4; ++kt) S[kt] = zero16();
        float sum0 = 0.f, sum1 = 0.f;
        GlaRaw2 cur; gla2_load_raw(cur, proj, gt, row0, h, tid, false);
#pragma unroll 1
        for (int j = 0; j < GLA_GRP; ++j) {
            GlaCum c; gla2_cumsum(c, cur, TOT, tid);
#pragma unroll
            for (int i = 0; i < 8; ++i) { const int t = 8 * part + i; const unsigned w = cur.k[i];
                *(LAS unsigned*)(KE + t * 320 + 4 * cp) = pk2(bflo(w) * __expf(c.tot0 - c.b0[i]), bfhi(w) * __expf(c.tot1 - c.b1[i])); }
            if (part == 0) { DEC[2 * cp] = __expf(c.tot0); DEC[2 * cp + 1] = __expf(c.tot1); sum0 += c.tot0; sum1 += c.tot1; }
#pragma unroll
            for (int i = 0; i < 4; ++i) { const int ch = tid + NTHR * i, r = ch >> 5, c16 = ch & 31; *(LAS v4u*)(VV + r * 576 + c16 * 16) = cur.v[i]; }
            if (j + 1 < GLA_GRP) gla2_load_raw(cur, proj, gt, row0 + (j + 1) * GLA_C, h, tid, false);
            __syncthreads();
            gla2_state_update(S, KE, VV, DEC, wave, lane, j > 0);
            __syncthreads();
        }
        if (part == 0) { dec[(size_t)u * 128 + 2 * cp] = __expf(sum0); dec[(size_t)u * 128 + 2 * cp + 1] = __expf(sum1); }
        bf16* sp = state + (size_t)u * 32768 + 32 * wave + (lane & 31);
#pragma unroll
        for (int kt = 0; kt < 4; ++kt)
#pragma unroll
            for (int r = 0; r < 16; ++r) sp[(size_t)(32 * kt + crow32(r, hi)) * 256] = (bf16)f2bf(S[kt][r]);
    }
}
__device__ __forceinline__ void phase_gla2_scan(const Ctx& a, int vcu, int G) {
    unsigned* state = (unsigned*)(a.ws + WS_STATE); const float* dec = (const float*)(a.ws + WS_DEC);
    for (int gid = vcu * NTHR + otid(); gid < NB * GLA_H * 16384; gid += G * NTHR) {
        const int bh = gid >> 14, e = gid & 16383, kd = e >> 7;
        unsigned* sp = state + (size_t)bh * GLA_NG * 16384 + e;
        const float* dp = dec + (size_t)bh * GLA_NG * 128 + kd;
        float s0 = 0.f, s1 = 0.f;
        for (int n0 = 0; n0 < GLA_NG; n0 += 32) {
            unsigned w[32]; float d[32];
#pragma unroll
            for (int i = 0; i < 32; ++i) { w[i] = sp[(size_t)(n0 + i) * 16384]; d[i] = dp[(n0 + i) * 128]; }
#pragma unroll
            for (int i = 0; i < 32; ++i) { sp[(size_t)(n0 + i) * 16384] = pk2(s0, s1); s0 = d[i] * s0 + bflo(w[i]); s1 = d[i] * s1 + bfhi(w[i]); }
        }
    }
}
__device__ __forceinline__ void phase_gla2_out(LAS unsigned char* lds, const Ctx& a, const LayerP& P, int vcu, int G, bool dummy = false) {
    const int tid = otid(), lane = tid & 63, wave = __builtin_amdgcn_readfirstlane(tid >> 6), hi = lane >> 5;
    bf16* proj = (bf16*)(a.ws + WS_H); const bf16* state = (const bf16*)(a.ws + WS_STATE);
    const float* head_norm = P.e3;
    const GlaGate gt{(const float*)(a.ws + WS_R), P.e1, P.e2};
    constexpr int SQ = 272, SA = 144, SV = 576, SO = 260;
    LAS unsigned char* QD = lds;
    LAS unsigned char* KI = lds + 17408;
    LAS unsigned char* AT = lds + 34816;
    LAS unsigned char* VV = lds + 44032;
    LAS unsigned char* KE = lds + 80896;
    LAS float* TOT = (LAS float*)(lds + 101376);
    LAS float* DEC = (LAS float*)(lds + 105472);
    LAS float* OS = (LAS float*)lds;
    const int cp = tid & 63, part = tid >> 6;
    for (int u = vcu; u < GLA_NU2; u += G) {
        const int grp = u % GLA_NG, bh = u / GLA_NG, h = bh % GLA_H, b = bh / GLA_H;
        const int rowg = b * T + grp * (GLA_GRP * GLA_C);
        mf32x16 S[4];
        { const bf16* sp = state + (size_t)u * 32768 + 32 * wave + (lane & 31);
#pragma unroll
          for (int kt = 0; kt < 4; ++kt)
#pragma unroll
              for (int r = 0; r < 16; ++r) S[kt][r] = bf2f(sp[(size_t)(32 * kt + crow32(r, hi)) * 256]); }
        GlaRaw2 cur; gla2_load_raw(cur, proj, gt, rowg, h, tid, true);
#pragma unroll 1
        for (int j = 0; j < GLA_GRP; ++j) {
            const int row0 = rowg + j * GLA_C;
            v4u gwv[4];
#pragma unroll
            for (int p = 0; p < 4; ++p) gwv[p] = *(const v4u*)(proj + (size_t)(row0 + p * 16 + wave * 2 + hi) * GLA_PITCH + 2048 + h * 256 + (lane & 31) * 8);
            GlaCum c; gla2_cumsum(c, cur, TOT, tid);
#pragma unroll
            for (int i = 0; i < 8; ++i) { const int t = 8 * part + i;
                const unsigned wq = cur.q[i], wk = cur.k[i];
                const float e0 = __expf(c.b0[i]), e1 = __expf(c.b1[i]);
                *(LAS unsigned*)(QD + t * SQ + 4 * cp) = pk2(bflo(wq) * 0.08838834764831845f * e0, bfhi(wq) * 0.08838834764831845f * e1);
                *(LAS unsigned*)(KI + t * SQ + 4 * cp) = pk2(bflo(wk) * __builtin_amdgcn_rcpf(e0), bfhi(wk) * __builtin_amdgcn_rcpf(e1));
                *(LAS unsigned*)(KE + t * 320 + 4 * cp) = pk2(bflo(wk) * __expf(c.tot0 - c.b0[i]), bfhi(wk) * __expf(c.tot1 - c.b1[i])); }
            if (part == 0) { DEC[2 * cp] = __expf(c.tot0); DEC[2 * cp + 1] = __expf(c.tot1); }
#pragma unroll
            for (int i = 0; i < 4; ++i) { const int ch = tid + NTHR * i, r = ch >> 5, c16 = ch & 31; *(LAS v4u*)(VV + r * SV + c16 * 16) = cur.v[i]; }
            if (j + 1 < GLA_GRP) gla2_load_raw(cur, proj, gt, row0 + GLA_C, h, tid, true);
            __syncthreads();
            if (wave < 4) {
                const int mi = wave >> 1, ni = wave & 1;
                mf32x16 at = zero16();
                if (!(mi == 0 && ni == 1)) {
#pragma unroll
                    for (int ks = 0; ks < 8; ++ks) at = MFMA32(frag_rk(QD, SQ, 32 * mi, 16 * ks, lane), frag_rk(KI, SQ, 32 * ni, 16 * ks, lane), at);
                }
#pragma unroll
                for (int r = 0; r < 16; ++r) { const int cc = 32 * mi + crow32(r, hi), ss = 32 * ni + (lane & 31);
                    *(LAS bf16*)(AT + cc * SA + ss * 2) = (bf16)f2bf((ss <= cc) ? at[r] : 0.f); }
            }
            __syncthreads();
            mf32x16 acc[2]; acc[0] = zero16(); acc[1] = zero16();
#pragma unroll
            for (int ks = 0; ks < 4; ++ks) { const mbf16x8 bfr = frag_kn(VV, SV, 16 * ks, 32 * wave, lane);
                if (ks < 2) acc[0] = MFMA32(frag_rk(AT, SA, 0, 16 * ks, lane), bfr, acc[0]);
                acc[1] = MFMA32(frag_rk(AT, SA, 32, 16 * ks, lane), bfr, acc[1]); }
#pragma unroll
            for (int kt = 0; kt < 4; ++kt)
#pragma unroll
                for (int sx = 0; sx < 2; ++sx) {
                    v4u bw; bw.x = pk2(S[kt][8 * sx + 0], S[kt][8 * sx + 1]); bw.y = pk2(S[kt][8 * sx + 2], S[kt][8 * sx + 3]); bw.z = pk2(S[kt][8 * sx + 4], S[kt][8 * sx + 5]); bw.w = pk2(S[kt][8 * sx + 6], S[kt][8 * sx + 7]);
                    const mbf16x8 bfr = __builtin_bit_cast(mbf16x8, bw);
#pragma unroll
                    for (int mi = 0; mi < 2; ++mi) { const LAS unsigned char* qp = QD + (32 * mi + (lane & 31)) * SQ + (32 * kt + 16 * sx + 4 * hi) * 2;
                        const v2u a0 = *(const LAS v2u*)qp, a1 = *(const LAS v2u*)(qp + 16);
                        v4u aw; aw.x = a0.x; aw.y = a0.y; aw.z = a1.x; aw.w = a1.y;
                        acc[mi] = MFMA32(__builtin_bit_cast(mbf16x8, aw), bfr, acc[mi]); } }
            if (j + 1 < GLA_GRP) gla2_state_update(S, KE, VV, DEC, wave, lane, true);
            __syncthreads();
#pragma unroll
            for (int mi = 0; mi < 2; ++mi)
#pragma unroll
                for (int r = 0; r < 16; ++r) OS[(32 * mi + crow32(r, hi)) * SO + 32 * wave + (lane & 31)] = acc[mi][r];
            __syncthreads();
#pragma unroll
            for (int p = 0; p < 4; ++p) { const int cc = p * 16 + wave * 2 + hi, c8 = (lane & 31) * 8;
                const f32x4 s0 = *(const LAS f32x4*)(OS + cc * SO + c8), s1 = *(const LAS f32x4*)(OS + cc * SO + c8 + 4);
                float ss = (s0.x * s0.x + s0.y * s0.y) + (s0.z * s0.z + s0.w * s0.w) + (s1.x * s1.x + s1.y * s1.y) + (s1.z * s1.z + s1.w * s1.w);
                ss = sum_lanes32(ss);
                const float rs = __builtin_amdgcn_rsqf(ss * (1.0f / 256.0f) + EPS);
                const f32x4 n0 = *(const f32x4*)(head_norm + c8), n1 = *(const f32x4*)(head_norm + c8 + 4);
                const v4u gw = gwv[p];
                const float gg[8] = {bflo(gw.x), bfhi(gw.x), bflo(gw.y), bfhi(gw.y), bflo(gw.z), bfhi(gw.z), bflo(gw.w), bfhi(gw.w)};
                const float ov[8] = {s0.x * n0.x, s0.y * n0.y, s0.z * n0.z, s0.w * n0.w, s1.x * n1.x, s1.y * n1.y, s1.z * n1.z, s1.w * n1.w};
                float o[8];
#pragma unroll
                for (int jj = 0; jj < 8; ++jj) o[jj] = ov[jj] * rs * (gg[jj] * __builtin_amdgcn_rcpf(1.f + __builtin_amdgcn_exp2f(-gg[jj] * LOG2E)));
                v4u w; w.x = pk2(o[0], o[1]); w.y = pk2(o[2], o[3]); w.z = pk2(o[4], o[5]); w.w = pk2(o[6], o[7]);
                if (dummy) *(v4u*)((bf16*)(a.ws + WS_STATE + 32 * MiB) + (size_t)(row0 + cc) * 1024 + h * 256 + c8) = w;
                else *(v4u*)(proj + (size_t)(row0 + cc) * GLA_PITCH + 1024 + h * 256 + c8) = w; }
            __syncthreads();
        }
    }
}

template <int L> __device__ __forceinline__ LayerP layer_params_ct(const CAS cfptr* in) {
    constexpr int base = (L == 0) ? 1 : (L == 1) ? 11 : (L == 2) ? 22 : 32;
    constexpr int kind = (L == 1) ? K_DIFF : (L == 2) ? K_SGU : K_GLA;
    constexpr int sh = (kind == K_DIFF) ? 1 : 0;
    LayerP p; p.kind = kind;
    p.norm1 = in[base]; p.w_in = in[base + 1];
    p.e0 = in[base + 2]; p.e1 = in[base + 3]; p.e2 = in[base + 4]; p.e3 = in[base + 5]; p.e4 = in[base + 6];
    p.w_out = in[base + 6 + sh]; p.norm2 = in[base + 7 + sh]; p.w1 = in[base + 8 + sh]; p.w2 = in[base + 9 + sh];
    p.nin = (kind == K_GLA) ? GLA_PITCH : (kind == K_DIFF) ? DIFF_PITCH : SGU_PITCH;
    p.mixoff = (kind == K_GLA) ? 1024 : 0;
    return p;
}
__device__ __forceinline__ void seam_xcd(const CAS Args* ap, LAS unsigned char* lds_k) {
#if PROBE_KIND == 1
    for (int br = 0; br < PROBE_REP; ++br)
#endif
    { XcdBarrier bb; bb.bar = (unsigned*)(ap->ws + WS_CTL) + 4096; bb.x = xb_xcc_id(); bb.st = (volatile LAS unsigned*)(lds_k + MISC_OFF) + 8; xcd_barrier(bb); }
}
#define PH_BEGIN(PK) { const int nrep_ = (PROBE_KIND == (PK) && (PK) != 0) ? PROBE_REP : 1; \
    for (int rep_ = 0; rep_ < nrep_; ++rep_) { \
    int vcu = vcu0, G = G0; asm volatile("" : "+s"(vcu), "+s"(G)); \
    LAS unsigned char* lds = lds_k; asm volatile("" : "+s"(lds)); \
    const CAS Args* ap = (const CAS Args*)__builtin_amdgcn_kernarg_segment_ptr(); asm volatile("" : "+s"(ap)); \
    Ctx args; args.in0 = ap->in[0]; args.in42 = ap->in[42]; args.out = ap->out; args.ws = ap->ws; \
    bf16* Wb = (bf16*)(args.ws + WS_W); bf16* XB = (bf16*)(args.ws + WS_XB); bf16* HB = (bf16*)(args.ws + WS_H); \
    float* SSQ = (float*)(args.ws + WS_SSQ); float* SSQ2 = (float*)(args.ws + WS_SSQ2); float* VSSQ = (float*)(args.ws + WS_VSSQ); \
    const LayerP P = layer_params_ct<L>((const CAS cfptr*)ap); \
    (void)Wb; (void)XB; (void)HB; (void)SSQ; (void)SSQ2; (void)VSSQ; (void)P; (void)vcu; (void)G; (void)lds;
#define PH_END_SEAM   seam_xcd(ap, lds_k); } }
#define PH_END_NOSEAM } }

template <int L> __device__ __forceinline__ void run_layer(LAS unsigned char* lds_k, int vcu0, int G0) {
    constexpr int kind = (L == 1) ? K_DIFF : (L == 2) ? K_SGU : K_GLA;
    PH_BEGIN(5) phase_conv(lds, args, P, L, vcu, G, (CONV_SPLIT && kind == K_GLA && G == 256) ? 1 : 0);
    if (L == 0) { if (rep_ + 1 == nrep_) cg::this_grid().sync(); else seam_xcd(ap, lds_k); } else seam_xcd(ap, lds_k);
    PH_END_NOSEAM
    PH_BEGIN(3) { EpiIn E{kind, HB, SSQ, (kind == K_GLA) ? P.e2 : P.e0, VSSQ, (unsigned*)(args.ws + WS_CTL) + CW_QKMAX}; run_gemm(lds, XB, D, Wb + WOFF_IN, NTOK, P.nin, D, E, vcu, G);
        if constexpr (CONV_SPLIT && kind == K_GLA) { int bxo = (int)blockIdx.x; asm volatile("" : "+s"(bxo));
            if (G == 256 && bxo >= 128) { LAS unsigned char* lds2 = lds_k; asm volatile("" : "+s"(lds2)); phase_conv(lds2, args, P, L, bxo - 128, 128, 2); } } } PH_END_SEAM
    if constexpr (kind == K_GLA) {
        PH_BEGIN(4) phase_gla2_kv(lds, args, P, vcu, G); PH_END_SEAM
        PH_BEGIN(0) phase_gla2_scan(args, vcu, G); PH_END_SEAM
        PH_BEGIN(9) phase_gla2_out(lds, args, P, vcu, G, rep_ + 1 < nrep_); PH_END_SEAM
    } else if constexpr (kind == K_DIFF) {
        PH_BEGIN(7)
            if (rep_ > 0) { if (blockIdx.x == 0 && otid() == 0) __hip_atomic_store((unsigned*)(ap->ws + WS_CTL) + CW_QUEUE, 0u, RLX_AGENT); seam_xcd(ap, lds_k); }
            phase_diff_mfma((char*)lds_raw, lds, args, vcu, G);
        PH_END_SEAM
        PH_BEGIN(6) phase_diff_combine(args, P, vcu, G); PH_END_SEAM
    } else {
        PH_BEGIN(10) phase_sgu_mfma(lds, args, P, vcu, G, rep_ + 1 < nrep_); PH_END_SEAM
    }
    PH_BEGIN(L == 0 ? 8 : 0) { EpiResT<false> E{XB, SSQ2, nullptr}; run_gemm(lds, HB + P.mixoff, P.nin, Wb + WOFF_OUT, NTOK, D, D, E, vcu, G); } PH_END_SEAM
#if PROBE_KIND == 11
    PH_BEGIN(11) { EpiHid E{HB}; E.nostore = (rep_ + 1 < nrep_) ? 1 : 0; run_gemm(lds, XB, D, Wb + WOFF_1, NTOK, FF, D, E, vcu, G); } PH_END_SEAM
#else
    PH_BEGIN(2) { EpiHid E{HB}; run_gemm(lds, XB, D, Wb + WOFF_1, NTOK, FF, D, E, vcu, G); } PH_END_SEAM
#endif
    PH_BEGIN(0) { EpiResT<true> E{XB, SSQ, SSQ2}; run_gemm(lds, HB, FF, Wb + WOFF_2, NTOK, D, FF, E, vcu, G); } PH_END_SEAM
}

__global__ void __launch_bounds__(NTHR, 2) trunk_fwd(Args kargs) {
    LAS unsigned char* const lds_k = (LAS unsigned char*)lds_raw;
    const int G0 = gridDim.x; const int bx = blockIdx.x;
    const int vcu0 = (G0 % 8 == 0) ? (bx % 8) * (G0 / 8) + bx / 8 : bx;
    { const int tid = threadIdx.x;
      for (int u = tid; u < (LDS_BYTES - LDSCTL_OFF) / 4; u += NTHR) ((LAS unsigned*)(lds_k + LDSCTL_OFF))[u] = 0u;
      __syncthreads();
      if ((tid & 63) == 0) ((LAS unsigned*)(lds_k + TIDTAB_OFF))[hw_slot()] = (unsigned)(tid >> 6);
      __syncthreads(); }
    (void)xcd_barrier_post((unsigned*)(kargs.ws + WS_CTL) + 4096, (volatile LAS unsigned*)(lds_k + MISC_OFF) + 8);
    run_layer<0>(lds_k, vcu0, G0);
    run_layer<1>(lds_k, vcu0, G0);
    run_layer<2>(lds_k, vcu0, G0);
    run_layer<3>(lds_k, vcu0, G0);
    { int vcu = vcu0, G = G0; asm volatile("" : "+s"(vcu), "+s"(G));
      const CAS Args* ap = (const CAS Args*)__builtin_amdgcn_kernarg_segment_ptr(); asm volatile("" : "+s"(ap));
      Ctx args; args.in0 = ap->in[0]; args.in42 = ap->in[42]; args.out = ap->out; args.ws = ap->ws;
      phase_final(args, vcu, G); }
}

extern "C" void kernel_launch(void* const* d_in, const int* in_sizes, int n_in, void* d_out, int out_size, void* d_ws, size_t ws_size, hipStream_t stream) {
    static int grid = 0;
    if (grid == 0) {
        if (n_in != 43 || in_sizes[0] != NTOK * D || out_size != NTOK * D || ws_size < WS_END) {
            fprintf(stderr, "kernel_launch: unexpected problem (n_in %d, in0 %d, out %d, ws %zu); nothing launched\n", n_in, n_in > 0 ? in_sizes[0] : -1, out_size, ws_size); grid = -1; return; }
        int dev = 0, cus = 0, per_cu = 0;
        if (hipGetDevice(&dev) != hipSuccess || hipDeviceGetAttribute(&cus, hipDeviceAttributeMultiprocessorCount, dev) != hipSuccess) { grid = -1; return; }
        if (hipFuncSetAttribute((const void*)trunk_fwd, hipFuncAttributeMaxDynamicSharedMemorySize, LDS_BYTES) != hipSuccess) { fprintf(stderr, "kernel_launch: hipFuncSetAttribute failed\n"); grid = -1; return; }
        if (hipOccupancyMaxActiveBlocksPerMultiprocessor(&per_cu, (const void*)trunk_fwd, NTHR, LDS_BYTES) != hipSuccess || per_cu < 1) { fprintf(stderr, "kernel_launch: occupancy query says %d blocks/CU\n", per_cu); per_cu = 1; }
        (void)hipGetLastError();
        grid = cus;
    }
    if (grid < 0) return;
    (void)hipMemsetAsync((char*)d_ws + WS_CTL, 0, CTL_ZERO_BYTES, stream);
    Args a{};
    for (int i = 0; i < 43; ++i) a.in[i] = (const float*)d_in[i];
    a.out = (float*)d_out; a.ws = (unsigned char*)d_ws;
    a.ph_lo = 0; a.ph_hi = 0;
    void* kargs[] = {&a};
    hipError_t e = hipLaunchCooperativeKernel((const void*)trunk_fwd, dim3(grid), dim3(NTHR), kargs, LDS_BYTES, stream);
    if (e != hipSuccess) fprintf(stderr, "kernel_launch: cooperative launch failed: %s (grid %d)\n", hipGetErrorString(e), grid);
}
```

```cpp
#include <hip/hip_runtime.h>
#include <hip/hip_cooperative_groups.h>
#include <cstdio>
#include <cstdint>
namespace cg = cooperative_groups;


#define GAS __attribute__((address_space(1)))
#define LAS __attribute__((address_space(3)))
typedef unsigned short bf16;
typedef unsigned v4u __attribute__((ext_vector_type(4)));
typedef unsigned v2u __attribute__((ext_vector_type(2)));
typedef float f32x4 __attribute__((ext_vector_type(4)));
typedef float f32x2v __attribute__((ext_vector_type(2)));

constexpr int NB = 2, T = 8192, D = 1024, NTOK = NB * T, FF = 4096;
constexpr float EPS = 1e-6f;
constexpr float LOG2E = 1.4426950408889634f;
constexpr int NWAVES = 8, NTHR = 512;
constexpr int K_GLA = 0, K_DIFF = 1, K_SGU = 2;
constexpr int GLA_H = 4, GLA_HK = 128, GLA_HV = 256, GLA_C = 64, GLA_NC = T / GLA_C;
#ifndef GLA_RANK16
#define GLA_RANK16 0
#endif
constexpr int GLA_PITCH = GLA_RANK16 ? 3072 : 3584;
constexpr int DIFF_H = 8, DIFF_PITCH = 3072;
constexpr float LAMBDA_INIT = 0.35551069f;
constexpr int SGU_PITCH = 2048, SGU_C = 128, SGU_G = 8;

constexpr size_t MiB = 1u << 20;
constexpr size_t WS_CTL = 0, CTL_ZERO_BYTES = 1 * MiB;
constexpr size_t WS_SSQ = 1 * MiB;
constexpr size_t WS_VSSQ = 2 * MiB;
constexpr size_t WS_R = 2 * MiB;
constexpr size_t WS_DEC = 3 * MiB;
constexpr size_t WS_W = 4 * MiB;
constexpr size_t WS_XB = 29 * MiB;
constexpr size_t WS_STATE = 61 * MiB;
constexpr size_t WS_H = 125 * MiB;
constexpr size_t WS_SSQ2 = 253 * MiB;
constexpr size_t WS_END = 254 * MiB;
constexpr int CW_QKMAX = 8192;
constexpr int CW_QUEUE = 8448;
constexpr size_t WOFF_IN = 0, WOFF_OUT = (size_t)3584 * 1024, WOFF_1 = WOFF_OUT + (size_t)1024 * 1024, WOFF_2 = WOFF_1 + (size_t)4096 * 1024;

#ifndef CG_SYNC_AT_START
#define CG_SYNC_AT_START 1
#endif
#ifndef ATTN_SREF
#define ATTN_SREF 1
#endif
#ifndef CONV_SPLIT
#define CONV_SPLIT 1
#endif
#ifndef PROBE_KIND
#define PROBE_KIND 0
#endif
#ifndef PROBE_REP
#define PROBE_REP 2
#endif
constexpr int RING_BYTES = 131072, LDSCTL_OFF = RING_BYTES, MISC_OFF = LDSCTL_OFF + 320, LDS_BYTES = 147456;

#define RLX_AGENT __ATOMIC_RELAXED, __HIP_MEMORY_SCOPE_AGENT
#define LDS_WAIT() asm volatile("s_waitcnt lgkmcnt(0)" ::: "memory")
__device__ __forceinline__ unsigned f2bf(float f) { unsigned u = __builtin_bit_cast(unsigned, f); return (u + 0x7fffu + ((u >> 16) & 1u)) >> 16; }
typedef float pk_f32x2 __attribute__((ext_vector_type(2))); typedef __bf16 pk_bf16x2 __attribute__((ext_vector_type(2)));
__device__ __forceinline__ unsigned pk2(float lo, float hi) { pk_f32x2 v = {lo, hi}; pk_bf16x2 b = __builtin_convertvector(v, pk_bf16x2); return __builtin_bit_cast(unsigned, b); }
__device__ __forceinline__ float bf2f(unsigned b) { return __builtin_bit_cast(float, b << 16); }
__device__ __forceinline__ float bflo(unsigned w) { return __builtin_bit_cast(float, w << 16); }
__device__ __forceinline__ float bfhi(unsigned w) { return __builtin_bit_cast(float, w & 0xffff0000u); }
extern __shared__ __attribute__((aligned(16))) unsigned char lds_raw[];
constexpr int TIDTAB_OFF = 131072;
__device__ __forceinline__ unsigned hw_slot() { return (unsigned)__builtin_amdgcn_s_getreg((5 << 11) | 4) & 63u; }
__device__ __forceinline__ int otid() {
    const int wv = (int)((volatile __attribute__((address_space(3))) unsigned*)((__attribute__((address_space(3))) unsigned char*)lds_raw + TIDTAB_OFF))[hw_slot()];
    int ln; asm volatile("v_mbcnt_lo_u32_b32 %0, -1, 0\n\tv_mbcnt_hi_u32_b32 %0, -1, %0" : "=v"(ln));
    int t = wv * 64 + ln;
    asm volatile("" : "+v"(t)); return t; }
#ifndef EPI_SC1
#define EPI_SC1 0
#endif
__device__ __forceinline__ void store16(void* p, v4u v) {
#if EPI_SC1
    asm volatile("global_store_dwordx4 %0, %1, off sc1\n\ts_nop 1" :: "v"(p), "v"(v) : "memory");
#else
    *(v4u*)p = v;
#endif
}
__device__ __forceinline__ float xl_1(float v)  { return __int_as_float(__builtin_amdgcn_mov_dpp(__float_as_int(v), 0xB1, 0xF, 0xF, true)); }
__device__ __forceinline__ float xl_2(float v)  { return __int_as_float(__builtin_amdgcn_mov_dpp(__float_as_int(v), 0x4E, 0xF, 0xF, true)); }
__device__ __forceinline__ float xl_4(float v)  { return __int_as_float(__builtin_amdgcn_mov_dpp(__float_as_int(v), 0x141, 0xF, 0xF, true)); }
__device__ __forceinline__ float xl_8(float v)  { return __int_as_float(__builtin_amdgcn_mov_dpp(__float_as_int(v), 0x140, 0xF, 0xF, true)); }
__device__ __forceinline__ float sum_x16(float v) { auto r = __builtin_amdgcn_permlane16_swap(__float_as_uint(v), __float_as_uint(v), false, false); return __uint_as_float(r[0]) + __uint_as_float(r[1]); }
__device__ __forceinline__ float sum_x32(float v) { auto r = __builtin_amdgcn_permlane32_swap(__float_as_uint(v), __float_as_uint(v), false, false); return __uint_as_float(r[0]) + __uint_as_float(r[1]); }
__device__ __forceinline__ float max_x16(float v) { auto r = __builtin_amdgcn_permlane16_swap(__float_as_uint(v), __float_as_uint(v), false, false); return fmaxf(__uint_as_float(r[0]), __uint_as_float(r[1])); }
__device__ __forceinline__ float max_x32(float v) { auto r = __builtin_amdgcn_permlane32_swap(__float_as_uint(v), __float_as_uint(v), false, false); return fmaxf(__uint_as_float(r[0]), __uint_as_float(r[1])); }
__device__ __forceinline__ float sum_lanes8(float v)  { v += xl_1(v); v += xl_2(v); v += xl_4(v); return v; }
__device__ __forceinline__ float sum_lanes32(float v) { v = sum_lanes8(v); v += xl_8(v); return sum_x16(v); }
__device__ __forceinline__ float wave_sum(float v) { return sum_x32(sum_lanes32(v)); }
__device__ __forceinline__ float wave_max(float v) { v = fmaxf(v, xl_1(v)); v = fmaxf(v, xl_2(v)); v = fmaxf(v, xl_4(v)); v = fmaxf(v, xl_8(v)); return max_x32(max_x16(v)); }
__device__ __forceinline__ float gelu_tanh(float x) {
    const float u = 0.7978845608028654f * (x + 0.044715f * x * x * x);
    const float e = __builtin_amdgcn_exp2f(u * (2.f * LOG2E));
    return x - x * __builtin_amdgcn_rcpf(e + 1.f);
}
__device__ __forceinline__ float log_sigmoid(float z) { return fminf(z, 0.f) - 0.6931471805599453f * __builtin_amdgcn_logf(1.0f + __builtin_amdgcn_exp2f(-fabsf(z) * LOG2E)); }

#define XB_TMO      128
#define XB_XCNT(j)  (256  + 64 * (j))
#define XB_XSUB(j)  (1280 + 64 * (j))
#define XB_XGEN(j)  (2304 + 64 * (j))
#define XB_TOP      3328
#define XB_TOPGEN   3392
#define XCD_BAR_WORDS 3456
#define XB_SPIN_CAP (1u << 22)
__device__ __forceinline__ unsigned xb_ld(unsigned* p)              { return __hip_atomic_load(p, __ATOMIC_RELAXED, __HIP_MEMORY_SCOPE_AGENT); }
__device__ __forceinline__ unsigned xb_add(unsigned* p, unsigned v) { return __hip_atomic_fetch_add(p, v, __ATOMIC_RELAXED, __HIP_MEMORY_SCOPE_AGENT); }
__device__ __forceinline__ unsigned xb_xcc_id() { return (unsigned)__builtin_amdgcn_s_getreg((3 << 11) | 20) & 0xFu; }
#define XB_SPIN(cond, bar) do { unsigned _sp = 0; while (cond) { __builtin_amdgcn_s_sleep(1); \
    if ((++_sp & 255u) == 0u) { if (xb_ld(&(bar)[XB_TMO])) break; if (_sp > XB_SPIN_CAP) { atomicAdd(&(bar)[XB_TMO], 1u); break; } } } } while (0)
struct XcdBarrier { unsigned* bar; unsigned x; volatile LAS unsigned* st; };
__device__ __forceinline__ XcdBarrier xcd_barrier_post(unsigned* bar, volatile LAS unsigned* st) {
    XcdBarrier b; b.bar = bar; b.x = xb_xcc_id(); b.st = st;
    if (threadIdx.x == 0) (void)xb_add(&bar[XB_XCNT(b.x)], 1u);
    return b;
}
__device__ __forceinline__ void xcd_barrier_complete(unsigned* bar, unsigned x, unsigned& nloc, unsigned& nx) {
    const unsigned G = gridDim.x * gridDim.y * gridDim.z;
    unsigned sum, cnt, mine, sp = 0u;
    for (;;) {
        sum = 0u; cnt = 0u; mine = 0u;
#pragma unroll
        for (unsigned j = 0; j < 16; ++j) { const unsigned c = xb_ld(&bar[XB_XCNT(j)]); sum += c; cnt += (c > 0u) ? 1u : 0u; mine = (j == x) ? c : mine; }
        if (sum == G) break;
        __builtin_amdgcn_s_sleep(1);
        if ((++sp & 255u) == 0u) { if (xb_ld(&bar[XB_TMO])) break; if (sp > XB_SPIN_CAP) { atomicAdd(&bar[XB_TMO], 1u); break; } }
    }
    nloc = mine > 0u ? mine : 1u; nx = cnt > 0u ? cnt : 1u;
}
__device__ __forceinline__ void xcd_barrier(const XcdBarrier& b) {
    asm volatile("s_waitcnt vmcnt(0)" ::: "memory");
    __syncthreads();
    if (otid() == 0) {
        unsigned* bar = b.bar;
        __builtin_amdgcn_s_waitcnt(0);
        unsigned nloc = b.st[0], nx = b.st[1];
        if (nloc == 0u) { xcd_barrier_complete(bar, b.x, nloc, nx); b.st[0] = nloc; b.st[1] = nx; }
        const unsigned old = xb_add(&bar[XB_XSUB(b.x)], 1u);
        const unsigned gen = old / nloc;
        if (old + 1u == (gen + 1u) * nloc) {
            __builtin_amdgcn_fence(__ATOMIC_RELEASE, "agent");
            asm volatile("s_waitcnt vmcnt(0)" ::: "memory");
            const unsigned og = xb_add(&bar[XB_TOP], 1u);
            const unsigned tg = og / nx;
            if (og + 1u == (tg + 1u) * nx) xb_add(&bar[XB_TOPGEN], 1u);
            else XB_SPIN(xb_ld(&bar[XB_TOPGEN]) == tg, bar);
            __builtin_amdgcn_fence(__ATOMIC_ACQUIRE, "agent");
            xb_add(&bar[XB_XGEN(b.x)], 1u);
            asm volatile("s_waitcnt vmcnt(0)" ::: "memory");
        } else {
            XB_SPIN(xb_ld(&bar[XB_XGEN(b.x)]) == gen, bar);
            __builtin_amdgcn_fence(__ATOMIC_ACQUIRE, "agent");
            asm volatile("s_waitcnt vmcnt(0)" ::: "memory");
        }
    }
    __syncthreads();
}

struct Args { const float* in[43]; float* out; unsigned char* ws; int ph_lo, ph_hi; };
struct Ctx { const float* in0; const float* in42; float* out; unsigned char* ws; };
struct LayerP {
    int kind;
    const float *norm1, *w_in, *w_out, *norm2, *w1, *w2;
    const float *e0, *e1, *e2, *e3, *e4;
    int nin;
    int mixoff;
};
typedef const float* cfptr;
#define CAS __attribute__((address_space(4)))
__device__ __forceinline__ float row_rstd(const float* ssq, int row) {
    const f32x4* p = (const f32x4*)(ssq + (size_t)row * 16);
    const f32x4 a = p[0], b = p[1], c = p[2], d = p[3];
    const float s = ((a.x + a.y) + (a.z + a.w)) + ((b.x + b.y) + (b.z + b.w)) + ((c.x + c.y) + (c.z + c.w)) + ((d.x + d.y) + (d.z + d.w));
    return __builtin_amdgcn_rsqf(s * (1.0f / D) + EPS);
}

typedef float f2 __attribute__((ext_vector_type(2)));
__device__ __forceinline__ unsigned pk2v(f2 t) { pk_bf16x2 b = __builtin_convertvector(t, pk_bf16x2); return __builtin_bit_cast(unsigned, b); }
__device__ __forceinline__ f2 f2s(float x) { return (f2){x, x}; }
__device__ __forceinline__ void store16o(const void* base, size_t off_bytes, v4u v) {
    __builtin_amdgcn_raw_buffer_store_b128(v, __builtin_amdgcn_make_buffer_rsrc((void*)base, 0, 0x7fffffff, 0x00020000), (int)off_bytes, 0, 0);
}
__device__ __forceinline__ f2 gelu_tanh2(f2 x) {
    const f2 x2 = x * x;
    const f2 p = x2 * f2s(0.044715f * 0.7978845608028654f * 2.f * LOG2E) + f2s(0.7978845608028654f * 2.f * LOG2E);
    const f2 arg = x * p;
    const f2 e = (f2){__builtin_amdgcn_exp2f(arg.x), __builtin_amdgcn_exp2f(arg.y)} + f2s(1.f);
    const f2 r = (f2){__builtin_amdgcn_rcpf(e.x), __builtin_amdgcn_rcpf(e.y)};
    return x - x * r;
}
struct EpiIn {
    int kind; bf16* proj; const float* ssq; const float* bias;
    float* vssq;
    static constexpr bool NEEDS_RS = true;
    __device__ __forceinline__ float apply8(int row, int col0, const float (&v)[8], float rs) const {
        f2 t[4] = {(f2){v[0], v[1]}, (f2){v[2], v[3]}, (f2){v[4], v[5]}, (f2){v[6], v[7]}};
        f2 part2 = f2s(0.f); int pitch;
        if (kind == K_GLA) { pitch = GLA_PITCH;
            if (col0 < 3072) {
#pragma unroll
                for (int j = 0; j < 4; ++j) t[j] = t[j] * f2s(rs);
            } else {
#pragma unroll
                for (int j = 0; j < 4; ++j) { const f2 bb = *(const LAS f2*)(bias_lds + col0 - 3072 + 2 * j); const f2 z = t[j] * f2s(rs) + bb;
                    t[j] = (f2){log_sigmoid(z.x), log_sigmoid(z.y)} * f2s(1.0f / 16.0f); }
            }
        } else if (kind == K_DIFF) { pitch = DIFF_PITCH;
            const float sc = (col0 < 1024) ? rs * (0.125f * LOG2E) : rs;
#pragma unroll
            for (int j = 0; j < 4; ++j) t[j] = t[j] * f2s(sc);
            if (col0 < 2048) {
#pragma unroll
                for (int j = 0; j < 4; ++j) part2 += t[j] * t[j];
            }
        } else { pitch = SGU_PITCH;
#pragma unroll
            for (int j = 0; j < 4; ++j) { const f2 bb = *(const LAS f2*)(bias_lds + col0 + 2 * j); t[j] = gelu_tanh2(t[j] * f2s(rs) + bb); }
            if (col0 >= 1024) {
#pragma unroll
                for (int j = 0; j < 4; ++j) part2 += t[j] * t[j];
            }
        }
        v4u w; w.x = pk2v(t[0]); w.y = pk2v(t[1]); w.z = pk2v(t[2]); w.w = pk2v(t[3]);
        store16o(proj, ((size_t)row * pitch + col0) * 2, w);
        return part2.x + part2.y;
    }
    __device__ __forceinline__ void store_part(int row, int col0, int idx, float part) const {
        if (kind == K_SGU && col0 >= 1024) vssq[(size_t)row * 16 + idx] = part;
    }
    static constexpr bool GROUPMAX = true;
    unsigned* qkmax;
    const LAS float* rs_tab = nullptr; int rs_row0 = -1;
    const LAS float* bias_lds = nullptr;
    static constexpr bool HAS_BIAS = true;
    __device__ __forceinline__ int bias_count() const { return kind == K_GLA ? 512 : (kind == K_SGU ? 2048 : 0); }
    __device__ __forceinline__ bool want_groupmax(int col0) const { return kind == K_DIFF && col0 < 2048; }
    __device__ __forceinline__ void store_groupmax(int row, int col0, float m) const {
        atomicMax(qkmax + (row >> 13) * 64 + (col0 >> 5), __float_as_uint(m * 1.01f));
    }
};
struct EpiHid {
    bf16* h;
    int nostore = 0;
    static constexpr bool NEEDS_RS = false; static constexpr bool HAS_BIAS = false;
    __device__ __forceinline__ float apply8(int row, int col0, const float (&v)[8], float) const {
        f2 t[4];
#pragma unroll
        for (int j = 0; j < 4; ++j) { const f2 a = {__int_as_float(max(__float_as_int(v[2 * j]), 0)), __int_as_float(max(__float_as_int(v[2 * j + 1]), 0))}; t[j] = a * a; }
        v4u w; w.x = pk2v(t[0]); w.y = pk2v(t[1]); w.z = pk2v(t[2]); w.w = pk2v(t[3]);
#if PROBE_KIND == 11
        if (nostore) { asm volatile("" :: "v"(w.x), "v"(w.y), "v"(w.z), "v"(w.w)); return 0.f; }
#endif
        store16o(h, ((size_t)row * FF + col0) * 2, w);
        return 0.f;
    }
    __device__ __forceinline__ void store_part(int, int, int, float) const {}
    static constexpr bool GROUPMAX = false;
    __device__ __forceinline__ bool want_groupmax(int) const { return false; }
    __device__ __forceinline__ void store_groupmax(int, int, float) const {}
};
template <bool RS2> struct EpiResT {
    bf16* xb; float* ssq_out; const float* ssq;
    const LAS float* rs_tab = nullptr; int rs_row0 = -1;
    static constexpr bool NEEDS_RS = RS2; static constexpr bool HAS_BIAS = false;
    __device__ __forceinline__ float apply8(int row, int col0, const float (&v)[8], float rs) const {
        const size_t off = (size_t)row * D + col0;
        const v4u bw = *(const v4u*)(xb + off);
        const f2 s2 = f2s(RS2 ? rs * rs : 1.f);
        const unsigned bwv[4] = {bw.x, bw.y, bw.z, bw.w};
        f2 o[4]; f2 part2 = f2s(0.f);
#pragma unroll
        for (int j = 0; j < 4; ++j) { const f2 x = {bflo(bwv[j]), bfhi(bwv[j])}; const f2 a = {v[2 * j], v[2 * j + 1]};
            o[j] = RS2 ? (a * s2 + x) : (a + x); part2 += o[j] * o[j]; }
        v4u w; w.x = pk2v(o[0]); w.y = pk2v(o[1]); w.z = pk2v(o[2]); w.w = pk2v(o[3]);
        store16o(xb, off * 2, w);
        return part2.x + part2.y;
    }
    __device__ __forceinline__ void store_part(int row, int, int idx, float part) const { ssq_out[(size_t)row * 16 + idx] = part; }
    static constexpr bool GROUPMAX = false;
    __device__ __forceinline__ bool want_groupmax(int) const { return false; }
    __device__ __forceinline__ void store_groupmax(int, int, float) const {}
};

struct ConvItem { const float* W; const float* gain; bf16* WT; int K, N, tile; };
struct ConvRegs { f32x4 w[8]; float g[8]; };
__device__ __forceinline__ void conv_load(ConvRegs& R, const ConvItem& it, int tid) {
    const int nblk = it.N >> 7, kb = it.tile / nblk, nb = it.tile - kb * nblk, k0 = kb << 7, n0 = nb << 7;
    const int n4 = tid & 31, kk = tid >> 5;
    const float* src = it.W + (size_t)(k0 + 8 * kk) * it.N + n0 + 4 * n4;
#pragma unroll
    for (int p = 0; p < 8; ++p) R.w[p] = __builtin_nontemporal_load((const f32x4*)(src + (size_t)p * it.N));
    if (it.gain) { const f32x4 g0 = *(const f32x4*)(it.gain + k0 + 8 * kk), g1 = *(const f32x4*)(it.gain + k0 + 8 * kk + 4);
        R.g[0] = g0.x; R.g[1] = g0.y; R.g[2] = g0.z; R.g[3] = g0.w; R.g[4] = g1.x; R.g[5] = g1.y; R.g[6] = g1.z; R.g[7] = g1.w; }
    else {
#pragma unroll
        for (int p = 0; p < 8; ++p) R.g[p] = 1.f; }
}
__device__ __forceinline__ void conv_store(const ConvRegs& R, const ConvItem& it, LAS unsigned char* img, int tid) {
    const int nblk = it.N >> 7, kb = it.tile / nblk, nb = it.tile - kb * nblk, k0 = kb << 7, n0 = nb << 7;
    const int n4 = tid & 31, kk = tid >> 5;
#pragma unroll
    for (int jn = 0; jn < 4; ++jn) {
        v4u o; o.x = pk2(R.g[0] * R.w[0][jn], R.g[1] * R.w[1][jn]); o.y = pk2(R.g[2] * R.w[2][jn], R.g[3] * R.w[3][jn]); o.z = pk2(R.g[4] * R.w[4][jn], R.g[5] * R.w[5][jn]); o.w = pk2(R.g[6] * R.w[6][jn], R.g[7] * R.w[7][jn]);
        *(LAS v4u*)(img + (4 * n4 + jn) * 256 + ((kk ^ (n4 & 15)) << 4)) = o; }
    __syncthreads();
#pragma unroll
    for (int i = 0; i < 4; ++i) { const int c = tid + NTHR * i, n = c >> 4, kc = c & 15;
        const v4u o = *(const LAS v4u*)(img + n * 256 + ((kc ^ ((n >> 2) & 15)) << 4));
        *(v4u*)(it.WT + (size_t)(n0 + n) * it.K + k0 + 8 * kc) = o; }
    __syncthreads();
}

__device__ __forceinline__ void phase_conv(LAS unsigned char* lds, const Ctx& a, const LayerP& P, int L, int vcu, int G, int part = 0) {
    const int tid = otid(), lane = tid & 63, wave = __builtin_amdgcn_readfirstlane(tid >> 6);
    bf16* Wb = (bf16*)(a.ws + WS_W);
    const int gw = vcu * NWAVES + wave, NGW = G * NWAVES;
    const int nin_w = (P.kind == K_SGU) ? 2048 : 3072;
    const int I_IN = (D / 128) * (nin_w / 128), I_OUT = (D / 128) * (D / 128), I_1 = (D / 128) * (FF / 128), I_2 = (FF / 128) * (D / 128);
    const int NITEMS = I_IN + I_OUT + I_1 + I_2;
    auto item_of = [&](int it) { ConvItem c; int r = it;
        if (r < I_IN) { c.W = P.w_in; c.gain = P.norm1; c.WT = Wb + WOFF_IN; c.K = D; c.N = nin_w; c.tile = r; return c; } r -= I_IN;
        if (r < I_OUT) { c.W = P.w_out; c.gain = nullptr; c.WT = Wb + WOFF_OUT; c.K = D; c.N = D; c.tile = r; return c; } r -= I_OUT;
        if (r < I_1) { c.W = P.w1; c.gain = P.norm2; c.WT = Wb + WOFF_1; c.K = D; c.N = FF; c.tile = r; return c; } r -= I_1;
        c.W = P.w2; c.gain = nullptr; c.WT = Wb + WOFF_2; c.K = FF; c.N = D; c.tile = r; return c; };
    const int it_lo = (part == 2) ? I_IN : 0, it_hi = (part == 1) ? I_IN : NITEMS;
    if (it_lo + vcu < it_hi) {
        int it = it_lo + vcu;
        ConvItem c0 = item_of(it), c1 = c0, c2 = c0; ConvRegs r0, r1, r2;
        conv_load(r0, c0, tid);
        if (it + G < it_hi) { c1 = item_of(it + G); conv_load(r1, c1, tid); } else r1 = r0;
        if (it + 2 * G < it_hi) { c2 = item_of(it + 2 * G); conv_load(r2, c2, tid); } else r2 = r0;
        for (; it < it_hi; it += G) {
            conv_store(r0, c0, lds, tid);
            r0 = r1; c0 = c1; r1 = r2; c1 = c2;
            if (it + 3 * G < it_hi) { c2 = item_of(it + 3 * G); conv_load(r2, c2, tid); }
        }
    }
    if (part == 2) return;
#if GLA_RANK16
    if (P.kind == K_GLA) {
        typedef short cbf16x8 __attribute__((ext_vector_type(8)));
        LAS unsigned char* WgT = lds + 32768;
        { const float* W1 = P.e0;
          for (int k = tid; k < 1024; k += NTHR) { const float gk = P.norm1[k];
              const f32x4 w0 = *(const f32x4*)(W1 + k * 16), w1 = *(const f32x4*)(W1 + k * 16 + 4), w2 = *(const f32x4*)(W1 + k * 16 + 8), w3 = *(const f32x4*)(W1 + k * 16 + 12);
              const float wv[16] = {w0.x, w0.y, w0.z, w0.w, w1.x, w1.y, w1.z, w1.w, w2.x, w2.y, w2.z, w2.w, w3.x, w3.y, w3.z, w3.w};
#pragma unroll
              for (int r = 0; r < 16; ++r) *(LAS bf16*)(WgT + r * 2064 + k * 2) = (bf16)f2bf(gk * wv[r]); } }
        __syncthreads();
        float* R = (float*)(a.ws + WS_R); const bf16* xbr = (const bf16*)(a.ws + WS_XB);
        const int n16 = lane & 15, kq = lane >> 4;
        for (int tile = gw; tile < NTOK / 16; tile += NGW) {
            const int row = tile * 16 + n16;
            f32x4 acc = {0.f, 0.f, 0.f, 0.f}; float sq = 0.f;
#pragma unroll 4
            for (int ks = 0; ks < 32; ++ks) {
                v4u aw;
                if (L == 0) { const f32x4 x0 = *(const f32x4*)(a.in0 + (size_t)row * D + 32 * ks + 8 * kq), x1 = *(const f32x4*)(a.in0 + (size_t)row * D + 32 * ks + 8 * kq + 4);
                    sq += (x0.x * x0.x + x0.y * x0.y) + (x0.z * x0.z + x0.w * x0.w) + (x1.x * x1.x + x1.y * x1.y) + (x1.z * x1.z + x1.w * x1.w);
                    aw.x = pk2(x0.x, x0.y); aw.y = pk2(x0.z, x0.w); aw.z = pk2(x1.x, x1.y); aw.w = pk2(x1.z, x1.w); }
                else { aw = *(const v4u*)(xbr + (size_t)row * D + 32 * ks + 8 * kq);
                    const float e[8] = {bflo(aw.x), bfhi(aw.x), bflo(aw.y), bfhi(aw.y), bflo(aw.z), bfhi(aw.z), bflo(aw.w), bfhi(aw.w)};
#pragma unroll
                    for (int j = 0; j < 8; ++j) sq += e[j] * e[j]; }
                const cbf16x8 bfr = *(const LAS cbf16x8*)(WgT + n16 * 2064 + (32 * ks + 8 * kq) * 2);
                acc = __builtin_amdgcn_mfma_f32_16x16x32_bf16(__builtin_bit_cast(cbf16x8, aw), bfr, acc, 0, 0, 0);
            }
            sq += __shfl_xor(sq, 16); sq += __shfl_xor(sq, 32);
            const float rstd = __builtin_amdgcn_rsqf(sq * (1.0f / D) + EPS);
#pragma unroll
            for (int rg = 0; rg < 4; ++rg) { const float rr = __shfl(rstd, 4 * kq + rg);
                R[(size_t)(tile * 16 + 4 * kq + rg) * 16 + n16] = acc[rg] * rr; }
        }
    }
#else
    if (P.kind == K_GLA) {
        const float* W1 = P.e0; const float* W2 = P.e1;
        for (int e = vcu * NTHR + tid; e < 512 * 1024; e += G * NTHR) {
            const int n = e >> 10, k = e & 1023;
            float s = 0.f;
#pragma unroll
            for (int r = 0; r < 16; ++r) s += W1[k * 16 + r] * W2[r * 512 + n];
            Wb[WOFF_IN + (size_t)(3072 + n) * 1024 + k] = (bf16)f2bf(s * P.norm1[k]);
        }
    }
#endif
    if (L == 0) {
        const float* x = a.in0; bf16* xb = (bf16*)(a.ws + WS_XB); float* ssq = (float*)(a.ws + WS_SSQ);
        for (int m0 = gw; m0 < NTOK; m0 += 2 * NGW) {
            const int m1 = (m0 + NGW < NTOK) ? m0 + NGW : m0;
            f32x4 v[2][4];
#pragma unroll
            for (int j = 0; j < 4; ++j) v[0][j] = __builtin_nontemporal_load((const f32x4*)(x + (size_t)m0 * D) + lane + 64 * j);
#pragma unroll
            for (int j = 0; j < 4; ++j) v[1][j] = __builtin_nontemporal_load((const f32x4*)(x + (size_t)m1 * D) + lane + 64 * j);
#pragma unroll
            for (int q = 0; q < 2; ++q) { const int m = q ? m1 : m0; if (q && m1 == m0) break;
                float s = 0.f;
#pragma unroll
                for (int j = 0; j < 4; ++j) s += (v[q][j].x * v[q][j].x + v[q][j].y * v[q][j].y) + (v[q][j].z * v[q][j].z + v[q][j].w * v[q][j].w);
                s = wave_sum(s);
                v2u* o8 = (v2u*)(xb + (size_t)m * D) + lane;
#pragma unroll
                for (int j = 0; j < 4; ++j) { v2u w; w.x = pk2(v[q][j].x, v[q][j].y); w.y = pk2(v[q][j].z, v[q][j].w); o8[64 * j] = w; }
                if (lane < 16) ssq[(size_t)m * 16 + lane] = (lane == 0) ? s : 0.f; }
        }
    }
}

__device__ __forceinline__ void phase_final(const Ctx& a, int vcu, int G) {
    const int tid = otid(), lane = tid & 63, wave = tid >> 6;
    const int gw = vcu * NWAVES + wave, NGW = G * NWAVES;
    const float* ssq = (const float*)(a.ws + WS_SSQ); const float* g = a.in42; const bf16* xb = (const bf16*)(a.ws + WS_XB);
    const f32x4* gr = (const f32x4*)g;
    for (int m0 = gw; m0 < NTOK; m0 += 2 * NGW) {
        const int m1 = (m0 + NGW < NTOK) ? m0 + NGW : m0;
        v4u w[2][2]; f32x4 sq[2][4];
#pragma unroll
        for (int q = 0; q < 2; ++q) { const int m = q ? m1 : m0;
            const v4u* xr = (const v4u*)(xb + (size_t)m * D) + lane;
            w[q][0] = xr[0]; w[q][1] = xr[64];
            const f32x4* sp = (const f32x4*)(ssq + (size_t)m * 16); sq[q][0] = sp[0]; sq[q][1] = sp[1]; sq[q][2] = sp[2]; sq[q][3] = sp[3]; }
#pragma unroll
        for (int q = 0; q < 2; ++q) { const int m = q ? m1 : m0; if (q && m1 == m0) break;
            const f32x4 a_ = sq[q][0], b_ = sq[q][1], c_ = sq[q][2], d_ = sq[q][3];
            const float ssum = ((a_.x + a_.y) + (a_.z + a_.w)) + ((b_.x + b_.y) + (b_.z + b_.w)) + ((c_.x + c_.y) + (c_.z + c_.w)) + ((d_.x + d_.y) + (d_.z + d_.w));
            const float rs = __builtin_amdgcn_rsqf(ssum * (1.0f / D) + EPS);
            f32x4* orow = (f32x4*)(a.out + (size_t)m * D);
#pragma unroll
            for (int jj = 0; jj < 2; ++jj) { const v4u ww = w[q][jj]; const int c4 = (64 * jj + lane) * 2;
                const f32x4 g0 = gr[c4], g1 = gr[c4 + 1];
                __builtin_nontemporal_store((f32x4){bflo(ww.x) * rs * g0.x, bfhi(ww.x) * rs * g0.y, bflo(ww.y) * rs * g0.z, bfhi(ww.y) * rs * g0.w}, orow + c4);
                __builtin_nontemporal_store((f32x4){bflo(ww.z) * rs * g1.x, bfhi(ww.z) * rs * g1.y, bflo(ww.w) * rs * g1.z, bfhi(ww.w) * rs * g1.w}, orow + c4 + 1); } }
    }
}

struct GlaCum { float b0[8], b1[8], tot0, tot1; };

#ifndef GEMM_RELAX_SEAM
#define GEMM_RELAX_SEAM 1
#endif
namespace pg8 {
#define PG8_LAS __attribute__((address_space(3)))
typedef unsigned short bf16_t;
typedef short bf16x8 __attribute__((ext_vector_type(8)));
typedef float f32x4 __attribute__((ext_vector_type(4)));
typedef unsigned u32x4 __attribute__((ext_vector_type(4)));
constexpr int BM = 256, BK = 64, HALF = 128, HTB = HALF * BK * 2  , STAGE_BYTES = 8 * HTB, NXCD = 8, WGM = 8;

__host__ __device__ __forceinline__ int lds_byte(int r, int c) { const int st = (r >> 4) * 2 + (c >> 5), rr = r & 15, cc = c & 31, ob = rr * 64 + cc * 2; return st * 1024 + (ob ^ (((ob >> 9) & 1) << 5)); }
__host__ __device__ __forceinline__ void stage_rc(int b, int& R, int& C) { const int st = b / 1024, sb = b % 1024, swz = sb ^ (((sb >> 9) & 1) << 5); R = (st >> 1) * 16 + swz / 64; C = (st & 1) * 32 + (swz % 64) / 2; }
__host__ __device__ __forceinline__ int perm32(int rho) { const int n = rho >> 4, i = rho & 15; return 8 * (i >> 2) + 4 * n + (i & 3); }

struct Unit { int pm, pn; };
struct Gemm { const bf16_t* A; int lda; const bf16_t* Bt; int M, N, K; };

struct StaticOrder {
    int nM, nN, nwg, G, c;
    __host__ __device__ void init(int M, int N, int G_, int c_) { nM = M / BM; nN = N / BM; nwg = nM * nN; G = G_; c = c_; }
    __host__ __device__ bool next(int i, Unit& u) const {
        const long L = (long)i * G + c; if (L >= nwg) return false;
        int wgid = (int)L; { const int q = nwg / NXCD, r = nwg % NXCD, xcd = wgid % NXCD, off = wgid / NXCD; wgid = (xcd < r ? xcd * (q + 1) : r * (q + 1) + (xcd - r) * q) + off; }
        const int nig = WGM * nN, gid = wgid / nig, fm = gid * WGM, gsz = (nM - fm) < WGM ? (nM - fm) : WGM;
        u.pm = fm + ((wgid % nig) % gsz); u.pn = (wgid % nig) / gsz; return true;
    }
    __device__ __forceinline__ void a_ready(const Unit&) const {}
    __device__ __forceinline__ void done(const Unit&) const {}
};

struct NoPre { __device__ __forceinline__ void operator()() const {} };
template <class Epi, class Sched, bool ALIGN_EPI = false, bool SP2 = false, class Pre = NoPre>
__device__ __forceinline__ void gemm_phase(PG8_LAS unsigned char* lds, const Gemm g, const Sched& S, const Epi& E, const Pre& pre = Pre()) {
    const int tid = otid(), wid = __builtin_amdgcn_readfirstlane(tid >> 6), lane = tid & 63, wr = wid >> 2, wc = wid & 3, fr = lane & 15, fq = lane >> 4;
    const int K = g.K, nt = K / BK, lda = g.lda;
    unsigned voffA[2], voffB[2];
#pragma unroll
    for (int i = 0; i < 2; ++i) { int R, C; stage_rc(tid * 16 + i * 8192, R, C); const int Rb = Epi::PERM ? ((R & ~31) + perm32(R & 31)) : R;
        voffA[i] = (unsigned)(R * lda + C) * 2u; voffB[i] = (unsigned)(Rb * K + C) * 2u; }
    const unsigned kstep = (unsigned)(BK * 2);
    const unsigned hstepA = (unsigned)HALF * lda * 2, hstepB = (unsigned)HALF * K * 2;
    const unsigned tstepA = 2 * hstepA, tstepB = 2 * hstepB;
    const __amdgpu_buffer_rsrc_t rsA = __builtin_amdgcn_make_buffer_rsrc((void*)g.A, 0, 0x7fffffff, 0x00020000), rsB = __builtin_amdgcn_make_buffer_rsrc((void*)g.Bt, 0, 0x7fffffff, 0x00020000);
    const unsigned ldsw = (unsigned)wid * 1024u;
    const int aoff = lds_byte(wr * 64 + fr, fq * 8), boff = lds_byte(wc * 32 + fr, fq * 8);
#define PG8_SA(b, h) (((b) * 2 + (h)) * HTB)
#define PG8_SB(b, h) ((4 + (b) * 2 + (h)) * HTB)
#define PG8_STAGE(bufoff, goff, voff) do { _Pragma("unroll") for (int _i = 0; _i < 2; ++_i) \
        __builtin_amdgcn_raw_ptr_buffer_load_lds(((bufoff) >= 4 * HTB) ? rsB : rsA, (PG8_LAS unsigned*)(lds + (bufoff) + ldsw + _i * 8192), 16, (int)(voff)[_i], (int)(goff), 0, 0); } while (0)
#define PG8_LDA(dst, b, h) do { _Pragma("unroll") for (int m = 0; m < 4; ++m) _Pragma("unroll") for (int k = 0; k < 2; ++k) dst[m][k] = *(const PG8_LAS bf16x8*)(lds + PG8_SA(b, h) + aoff + m * 2048 + k * 1024); } while (0)
#define PG8_LDB(dst, b, h) do { _Pragma("unroll") for (int n = 0; n < 2; ++n) _Pragma("unroll") for (int k = 0; k < 2; ++k) dst[n][k] = *(const PG8_LAS bf16x8*)(lds + PG8_SB(b, h) + boff + n * 2048 + k * 1024); } while (0)
#define PG8_MMA(ai, bj, At, Bt) do { __builtin_amdgcn_s_setprio(1); _Pragma("unroll") for (int m = 0; m < 4; ++m) _Pragma("unroll") for (int n = 0; n < 2; ++n) _Pragma("unroll") for (int k = 0; k < 2; ++k) \
        acc[ai][bj][m][n] = __builtin_amdgcn_mfma_f32_16x16x32_bf16(Bt[n][k], At[m][k], acc[ai][bj][m][n], 0, 0, 0); __builtin_amdgcn_s_setprio(0); } while (0)
#define PG8_WAIT_V(n) asm volatile("s_waitcnt vmcnt(" #n ")" ::: "memory")
#define PG8_WAIT_VR asm volatile("s_waitcnt vmcnt(%0)" :: "n"(8 + Epi::MIN_VM) : "memory")
#define PG8_WAIT_L(n) asm volatile("s_waitcnt lgkmcnt(" #n ")" ::: "memory")
#define PG8_BAR __builtin_amdgcn_s_barrier()
#define PG8_SCHED __builtin_amdgcn_sched_barrier(0)
    Unit cur, nxt; int ui = 0;
    if (!S.next(0, cur)) return;
    f32x4 acc[2][2][4][2];
#pragma unroll
    for (int a = 0; a < 2; ++a)
#pragma unroll
        for (int b = 0; b < 2; ++b)
#pragma unroll
            for (int m = 0; m < 4; ++m)
#pragma unroll
                for (int n = 0; n < 2; ++n) acc[a][b][m][n] = (f32x4){0.f, 0.f, 0.f, 0.f};
    bf16x8 At[4][2], B0[2][2], B1[2][2];
    unsigned cA = (unsigned)cur.pm * tstepA; unsigned cB = (unsigned)cur.pn * tstepB;
    S.a_ready(cur);
    if constexpr (SP2) {
        PG8_STAGE(PG8_SB(0, 0), cB, voffB); PG8_STAGE(PG8_SB(0, 1), cB + hstepB, voffB); PG8_STAGE(PG8_SA(0, 0), cA, voffA); PG8_STAGE(PG8_SA(0, 1), cA + hstepA, voffA);
        pre();
        if (wr == 1) PG8_BAR;
        PG8_WAIT_V(2); PG8_BAR;
        PG8_STAGE(PG8_SB(1, 0), cB + kstep, voffB); PG8_STAGE(PG8_SA(1, 0), cA + kstep, voffA); PG8_STAGE(PG8_SB(1, 1), cB + hstepB + kstep, voffB);
        PG8_WAIT_V(6); PG8_BAR;
    } else {
        PG8_STAGE(PG8_SB(0, 0), cB, voffB); PG8_STAGE(PG8_SA(0, 0), cA, voffA); PG8_STAGE(PG8_SB(0, 1), cB + hstepB, voffB); PG8_STAGE(PG8_SA(0, 1), cA + hstepA, voffA);
        if (wr == 1) PG8_BAR;
        PG8_WAIT_V(4); PG8_BAR;
        PG8_STAGE(PG8_SB(1, 0), cB + kstep, voffB); PG8_STAGE(PG8_SA(1, 0), cA + kstep, voffA); PG8_STAGE(PG8_SB(1, 1), cB + hstepB + kstep, voffB);
        PG8_WAIT_V(6); PG8_BAR;
    }
    for (;;) {
        const bool has_next = S.next(ui + 1, nxt);
        const unsigned nA = has_next ? (unsigned)nxt.pm * tstepA : cA; const unsigned nB = has_next ? (unsigned)nxt.pn * tstepB : cB;
#define PG8_KT2(FA) do { \
            const bool last = (t == nt - 2); \
            unsigned a1 = cA + (unsigned)(t + 1) * kstep; \
            unsigned a2 = last ? nA : cA + (unsigned)(t + 2) * kstep; unsigned b2 = last ? nB : cB + (unsigned)(t + 2) * kstep; \
            unsigned a3 = a2 + kstep; unsigned b3 = b2 + kstep; \
            asm volatile("" : "+s"(a1), "+s"(a2), "+s"(b2), "+s"(a3), "+s"(b3));     \
            if (last && has_next) S.a_ready(nxt); \
            PG8_LDB(B0, 0, 0); PG8_LDB(B1, 0, 1); PG8_SCHED; PG8_LDA(At, 0, 0); if constexpr (!(FA)) PG8_STAGE(PG8_SA(1, 1), a1 + hstepA, voffA); \
            if constexpr (FA) PG8_WAIT_VR; else PG8_WAIT_V(8); PG8_WAIT_L(0); PG8_BAR; PG8_MMA(0, 0, At, B0); PG8_MMA(0, 1, At, B1); PG8_BAR; PG8_SCHED; \
            PG8_LDA(At, 0, 1); PG8_STAGE(PG8_SB(0, 0), b2, voffB); PG8_STAGE(PG8_SB(0, 1), b2 + hstepB, voffB); PG8_STAGE(PG8_SA(0, 0), a2, voffA); \
            if constexpr (FA) PG8_WAIT_VR; else PG8_WAIT_V(8); PG8_WAIT_L(0); PG8_BAR; PG8_MMA(1, 0, At, B0); PG8_MMA(1, 1, At, B1); PG8_BAR; PG8_SCHED; \
            PG8_LDB(B0, 1, 0); PG8_LDB(B1, 1, 1); PG8_SCHED; PG8_LDA(At, 1, 0); PG8_STAGE(PG8_SA(0, 1), a2 + hstepA, voffA); \
            if constexpr (FA) PG8_WAIT_VR; else PG8_WAIT_V(8); PG8_WAIT_L(0); PG8_BAR; PG8_MMA(0, 0, At, B0); PG8_MMA(0, 1, At, B1); PG8_BAR; PG8_SCHED; \
            PG8_LDA(At, 1, 1); PG8_STAGE(PG8_SB(1, 0), b3, voffB); PG8_STAGE(PG8_SB(1, 1), b3 + hstepB, voffB); PG8_STAGE(PG8_SA(1, 0), a3, voffA); \
            PG8_WAIT_V(8); PG8_WAIT_L(0); PG8_BAR; PG8_MMA(1, 0, At, B0); PG8_MMA(1, 1, At, B1); PG8_BAR; PG8_SCHED; } while (0)
        int t = 0;
        if constexpr (SP2 && GEMM_RELAX_SEAM) { if (ui > 0) { PG8_KT2(true); t = 2; } }
        for (; t < nt; t += 2) {
            if constexpr (SP2) {
            PG8_KT2(false);
            } else {
            const bool last = (t == nt - 2);
            unsigned a1 = cA + (unsigned)(t + 1) * kstep;
            unsigned a2 = last ? nA : cA + (unsigned)(t + 2) * kstep; unsigned b2 = last ? nB : cB + (unsigned)(t + 2) * kstep;
            unsigned a3 = a2 + kstep; unsigned b3 = b2 + kstep;
            if (last && has_next) S.a_ready(nxt);
            PG8_LDB(B0, 0, 0); PG8_SCHED; PG8_LDA(At, 0, 0); PG8_STAGE(PG8_SA(1, 1), a1 + hstepA, voffA);
            PG8_WAIT_L(8); PG8_BAR; PG8_WAIT_L(0); PG8_MMA(0, 0, At, B0); PG8_BAR; PG8_SCHED;
            PG8_LDB(B1, 0, 1); PG8_STAGE(PG8_SB(0, 0), b2, voffB);
            PG8_BAR; PG8_WAIT_L(0); PG8_MMA(0, 1, At, B1); PG8_BAR;
            PG8_LDA(At, 0, 1); PG8_STAGE(PG8_SA(0, 0), a2, voffA);
            PG8_BAR; PG8_WAIT_L(0); PG8_MMA(1, 0, At, B0); PG8_BAR; PG8_SCHED;
            PG8_STAGE(PG8_SB(0, 1), b2 + hstepB, voffB);
            PG8_WAIT_V(6); PG8_BAR; PG8_MMA(1, 1, At, B1); PG8_BAR;
            PG8_LDB(B0, 1, 0); PG8_SCHED; PG8_LDA(At, 1, 0); PG8_STAGE(PG8_SA(0, 1), a2 + hstepA, voffA);
            PG8_WAIT_L(8); PG8_BAR; PG8_WAIT_L(0); PG8_MMA(0, 0, At, B0); PG8_BAR; PG8_SCHED;
            PG8_LDB(B1, 1, 1); PG8_STAGE(PG8_SB(1, 0), b3, voffB);
            PG8_BAR; PG8_WAIT_L(0); PG8_MMA(0, 1, At, B1); PG8_BAR;
            PG8_LDA(At, 1, 1); PG8_STAGE(PG8_SA(1, 0), a3, voffA);
            PG8_BAR; PG8_WAIT_L(0); PG8_MMA(1, 0, At, B0); PG8_BAR; PG8_SCHED;
            PG8_STAGE(PG8_SB(1, 1), b3 + hstepB, voffB);
            PG8_WAIT_V(6); PG8_BAR; PG8_MMA(1, 1, At, B1); PG8_BAR;
            }
        }
        if constexpr (ALIGN_EPI) { if (wr == 0) PG8_BAR; }
        if constexpr (GEMM_RELAX_SEAM && SP2) { if (has_next) { unsigned eb = nA + kstep + hstepA; asm volatile("" : "+s"(eb)); PG8_STAGE(PG8_SA(1, 1), eb, voffA); } }
        if constexpr (!Epi::AFTER_DRAIN) { E(acc, cur, wr, wc, fr, fq); S.done(cur); }
        if (!has_next) break;
#pragma unroll
        for (int a = 0; a < 2; ++a)
#pragma unroll
            for (int b = 0; b < 2; ++b)
#pragma unroll
                for (int m = 0; m < 4; ++m)
#pragma unroll
                    for (int n = 0; n < 2; ++n) acc[a][b][m][n] = (f32x4){0.f, 0.f, 0.f, 0.f};
        cur = nxt; cA = nA; cB = nB; ++ui;
        if constexpr (ALIGN_EPI) { if (wr == 1) PG8_BAR; }
    }
    PG8_WAIT_V(0);
    if constexpr (!ALIGN_EPI) { if (wr == 0) PG8_BAR; }
    PG8_BAR;
    if constexpr (Epi::AFTER_DRAIN) { E.fused(acc, cur, wr, wc, fr, fq, lds, wid, lane); S.done(cur); }
#undef PG8_SA
#undef PG8_SB
#undef PG8_STAGE
#undef PG8_LDA
#undef PG8_LDB
#undef PG8_MMA
#undef PG8_WAIT_V
#undef PG8_WAIT_VR
#undef PG8_KT2
#undef PG8_WAIT_L
#undef PG8_BAR
#undef PG8_SCHED
}
}

template <class Core> struct EpiMfma {
    static constexpr bool PERM = true, AFTER_DRAIN = false;
    static constexpr int MIN_VM = 16;
    Core c;
    __device__ __forceinline__ void operator()(const pg8::f32x4 (&acc)[2][2][4][2], const pg8::Unit& u, int wr, int wc, int fr, int fq) const {
        asm volatile("" : "+v"(fr), "+v"(fq));
        float gmax[2] = {0.f, 0.f};
        float rsv[2][4];
#pragma unroll
        for (int ai = 0; ai < 2; ++ai)
#pragma unroll
            for (int m = 0; m < 4; ++m) { if constexpr (Core::NEEDS_RS) rsv[ai][m] = c.rs_tab[ai * 128 + wr * 64 + m * 16 + fr]; else rsv[ai][m] = 1.f; }
#pragma unroll
        for (int ai = 0; ai < 2; ++ai)
#pragma unroll
            for (int m = 0; m < 4; ++m) {
                const int row = u.pm * 256 + ai * 128 + wr * 64 + m * 16 + fr;
                const float rs = rsv[ai][m];
                float part = 0.f;
#pragma unroll
                for (int bj = 0; bj < 2; ++bj) {
                    const int col0 = u.pn * 256 + bj * 128 + wc * 32 + 8 * fq;
                    const float v[8] = {acc[ai][bj][m][0][0], acc[ai][bj][m][0][1], acc[ai][bj][m][0][2], acc[ai][bj][m][0][3],
                                        acc[ai][bj][m][1][0], acc[ai][bj][m][1][1], acc[ai][bj][m][1][2], acc[ai][bj][m][1][3]};
                    const float p = c.apply8(row, col0, v, rs);
                    part += p;
                    if (Core::GROUPMAX) { const float q = sum_x32(sum_x16(p)); gmax[bj] = fmaxf(gmax[bj], q); }
                }
                part = sum_x32(sum_x16(part));
                if (fq == 0) c.store_part(row, u.pn * 256, (u.pn & 3) * 4 + wc, part);
            }
        if (Core::GROUPMAX) {
#pragma unroll
            for (int bj = 0; bj < 2; ++bj) { const int colg = u.pn * 256 + bj * 128 + wc * 32;
                if (c.want_groupmax(colg)) { const float m = wave_max(gmax[bj]); if (fr == 0 && fq == 0) c.store_groupmax(u.pm * 256, colg, m); } }
        }
    }
};
#ifndef GEMM_STAGGER_TICKS
#define GEMM_STAGGER_TICKS 0
#endif
template <class Core>
__device__ __forceinline__ void run_gemm(LAS unsigned char* lds, const bf16* A, int lda, const bf16* Bt, int M, int N, int K, const Core& c, int vcu, int G) {
    int bxo = (int)blockIdx.x; asm volatile("" : "+s"(bxo));
    pg8::Gemm g{A, lda, Bt, M, N, K}; pg8::StaticOrder S; S.init(M, N, G, bxo);
    EpiMfma<Core> E{c};
#if GEMM_STAGGER_TICKS
    if (N > 1024) {
        const unsigned long long t0_ = __builtin_amdgcn_s_memrealtime(); const unsigned long long dl_ = (unsigned long long)((bxo >> 3) & 3) * GEMM_STAGGER_TICKS;
        while (__builtin_amdgcn_s_memrealtime() - t0_ < dl_) __builtin_amdgcn_s_sleep(4);
    }
#endif
    if constexpr (Core::NEEDS_RS) {
        pg8::Unit u0; const bool have = S.next(0, u0);
        LAS float* tab = (LAS float*)(lds + LDSCTL_OFF + 1024); LAS float* bt = (LAS float*)(lds + LDSCTL_OFF + 2048); const int t_ = otid();
        f32x4 q0 = {0.f, 0.f, 0.f, 0.f}, q1 = q0, q2 = q0, q3 = q0; float bv[4] = {0.f, 0.f, 0.f, 0.f}; int nb = 0;
        if (have) { if (t_ < 256) { const f32x4* pq = (const f32x4*)(c.ssq + (size_t)(u0.pm * 256 + t_) * 16); q0 = pq[0]; q1 = pq[1]; q2 = pq[2]; q3 = pq[3]; }
            E.c.rs_tab = tab; E.c.rs_row0 = u0.pm * 256;
            if constexpr (Core::HAS_BIAS) { nb = c.bias_count();
#pragma unroll
                for (int i = 0; i < 4; ++i) if (t_ + NTHR * i < nb) bv[i] = c.bias[t_ + NTHR * i];
                E.c.bias_lds = bt; } }
        auto pre = [&]() { if (have) { if (t_ < 256) { const float sm = ((q0.x + q0.y) + (q0.z + q0.w)) + ((q1.x + q1.y) + (q1.z + q1.w)) + ((q2.x + q2.y) + (q2.z + q2.w)) + ((q3.x + q3.y) + (q3.z + q3.w));
                                                     tab[t_] = __builtin_amdgcn_rsqf(sm * (1.0f / D) + EPS); }
                                       if constexpr (Core::HAS_BIAS) {
#pragma unroll
                                           for (int i = 0; i < 4; ++i) if (t_ + NTHR * i < nb) bt[t_ + NTHR * i] = bv[i]; } } };
        pg8::gemm_phase<EpiMfma<Core>, pg8::StaticOrder, true, true, decltype(pre)>(lds, g, S, E, pre);
    } else
    pg8::gemm_phase<EpiMfma<Core>, pg8::StaticOrder, true, true>(lds, g, S, E);

}

#include <hip/hip_bf16.h>
#include <cmath>
namespace attn_body {
using bf16=__hip_bfloat16;
using bf16x8=__attribute__((ext_vector_type(8)))short;
using s16x4=__attribute__((ext_vector_type(4)))short;
using f32x16=__attribute__((ext_vector_type(16)))float;
using u32x4=__attribute__((ext_vector_type(4)))unsigned;
constexpr int SEQ=8192,D=64,PQ=3072,PO=2048;
constexpr int NW=8,QBLK=32,QB=QBLK*NW,KVBLK=64,NQB=SEQ/QB;
__device__ __forceinline__ int crow(int r,int hi){return (r&3)+8*(r>>2)+4*hi;}
#define SBAR() __builtin_amdgcn_sched_barrier(0)
__device__ __forceinline__ void cmask(f32x16&p0,f32x16&p1,int jb,int qrel,int hi){
  const float NEG=-INFINITY; int kb=64*jb+4*hi;
  #pragma unroll
  for(int r=0;r<16;++r){int kv=kb+(r&3)+8*(r>>2); if(kv>qrel)p0[r]=NEG; if(kv+32>qrel)p1[r]=NEG;}
}

constexpr int NSLOT=3, SLOTB=8192;
constexpr int LDS_K=0, LDS_V=NSLOT*SLOTB, LDS_WS=2*NSLOT*SLOTB, LDS_OST=LDS_WS+NW*64*4, LDS_BYTES=LDS_OST+NW*4096;
constexpr float C2=0.125f*1.4426950408889634f;
__device__ __forceinline__ void glds16(const void*gsrc,unsigned lds_dst){unsigned keep;
  asm volatile("s_mov_b32 %0, m0\n\ts_mov_b32 m0, %2\n\ts_nop 0\n\tglobal_load_lds_dwordx4 %1, off\n\ts_mov_b32 m0, %0":"=&s"(keep):"v"(gsrc),"s"(lds_dst):"memory");}
__device__ __forceinline__ float max3f(float a,float b,float c){float r;asm("v_max3_f32 %0, %1, %2, %3":"=v"(r):"v"(a),"v"(b),"v"(c));return r;}
__device__ __forceinline__ float max2f(float a,float b){float r;asm("v_max_f32_e32 %0, %1, %2":"=v"(r):"v"(a),"v"(b));return r;}
__device__ __forceinline__ float fadd_s(float a,float b){float r;asm("v_add_f32_e32 %0, %1, %2":"=v"(r):"v"(a),"v"(b));return r;}
__device__ __forceinline__ float fsub_s(float a,float b){float r;asm("v_sub_f32_e32 %0, %1, %2":"=v"(r):"v"(a),"v"(b));return r;}
typedef float f32x2_t __attribute__((ext_vector_type(2))); typedef __bf16 bf16x2_t __attribute__((ext_vector_type(2)));
__device__ __forceinline__ unsigned cvtpk_s(float lo,float hi){f32x2_t v={lo,hi};bf16x2_t b=__builtin_convertvector(v,bf16x2_t);return __builtin_bit_cast(unsigned,b);}
#define WAIT_BAR(N) asm volatile("s_waitcnt vmcnt(" #N ") lgkmcnt(0)\n\ts_barrier":::"memory")

__device__ __forceinline__ void qkt(f32x16&p0,f32x16&p1,const char*Kslot,const bf16x8*qr,const f32x16&negm,int r32,int hi){
  const char*kb=Kslot+hi*1024+r32*16;
  #pragma unroll
  for(int d0=0;d0<4;++d0){
    const bf16x8 b0=*reinterpret_cast<const bf16x8*>(kb+d0*2048);
    const bf16x8 b1=*reinterpret_cast<const bf16x8*>(kb+d0*2048+512);
    if(d0==0){p0=__builtin_amdgcn_mfma_f32_32x32x16_bf16(b0,qr[0],negm,0,0,0);p1=__builtin_amdgcn_mfma_f32_32x32x16_bf16(b1,qr[0],negm,0,0,0);}
    else{p0=__builtin_amdgcn_mfma_f32_32x32x16_bf16(b0,qr[d0],p0,0,0,0);p1=__builtin_amdgcn_mfma_f32_32x32x16_bf16(b1,qr[d0],p1,0,0,0);}}
}
typedef __attribute__((address_space(3))) const char* lds_cptr;
typedef short v4i16_t __attribute__((ext_vector_type(4)));
__device__ __forceinline__ void kload8(bf16x8*kf,lds_cptr kp){
  kf[0]=*(const __attribute__((address_space(3))) bf16x8*)(kp);      kf[1]=*(const __attribute__((address_space(3))) bf16x8*)(kp+512);
  kf[2]=*(const __attribute__((address_space(3))) bf16x8*)(kp+2048); kf[3]=*(const __attribute__((address_space(3))) bf16x8*)(kp+2560);
  kf[4]=*(const __attribute__((address_space(3))) bf16x8*)(kp+4096); kf[5]=*(const __attribute__((address_space(3))) bf16x8*)(kp+4608);
  kf[6]=*(const __attribute__((address_space(3))) bf16x8*)(kp+6144); kf[7]=*(const __attribute__((address_space(3))) bf16x8*)(kp+6656);
}
__device__ __forceinline__ void kload2(bf16x8*kf,lds_cptr kp,int j){ kf[2*j]=*(const __attribute__((address_space(3))) bf16x8*)(kp+j*2048); kf[2*j+1]=*(const __attribute__((address_space(3))) bf16x8*)(kp+j*2048+512); }
__device__ __forceinline__ s16x4 vtr(lds_cptr p){ return __builtin_bit_cast(s16x4,__builtin_amdgcn_ds_read_tr16_b64_v4i16((__attribute__((address_space(3))) v4i16_t*)p)); }
__device__ __forceinline__ float rowmax(const f32x16&p0,const f32x16&p1){
  float a=max3f(p0[0],p0[1],p1[0]),b=max3f(p0[2],p0[3],p1[1]);a=max3f(a,p1[2],p1[3]);
  #pragma unroll
  for(int r=4;r<16;r+=4){a=max3f(a,p0[r],p0[r+1]);b=max3f(b,p0[r+2],p0[r+3]);a=max3f(a,p1[r],p1[r+1]);b=max3f(b,p1[r+2],p1[r+3]);}
  const float m=max2f(a,b);
  auto rr=__builtin_amdgcn_permlane32_swap(__float_as_uint(m),__float_as_uint(m),false,false);
  return max2f(__uint_as_float(rr[0]),__uint_as_float(rr[1]));
}
__device__ __forceinline__ void pv(f32x16*o,int vb,bf16x8 pa0,bf16x8 pa1,bf16x8 pa2,bf16x8 pa3){
  #pragma unroll
  for(int d0=0;d0<2;++d0){s16x4 lo[4],hi[4];
    #pragma unroll
    for(int ks=0;ks<4;++ks){
      asm volatile("ds_read_b64_tr_b16 %0,%1 offset:%c2":"=&v"(lo[ks]):"v"(vb),"i"(d0*4096+ks*1024):"memory");
      asm volatile("ds_read_b64_tr_b16 %0,%1 offset:%c2":"=&v"(hi[ks]):"v"(vb),"i"(d0*4096+ks*1024+512):"memory");}
    asm volatile("s_waitcnt lgkmcnt(0)":::"memory");SBAR();
    #define PK(k) (bf16x8){lo[k][0],lo[k][1],lo[k][2],lo[k][3],hi[k][0],hi[k][1],hi[k][2],hi[k][3]}
    o[d0]=__builtin_amdgcn_mfma_f32_32x32x16_bf16(pa0,PK(0),o[d0],0,0,0);
    o[d0]=__builtin_amdgcn_mfma_f32_32x32x16_bf16(pa1,PK(1),o[d0],0,0,0);
    o[d0]=__builtin_amdgcn_mfma_f32_32x32x16_bf16(pa2,PK(2),o[d0],0,0,0);
    o[d0]=__builtin_amdgcn_mfma_f32_32x32x16_bf16(pa3,PK(3),o[d0],0,0,0);
    #undef PK
  }
}

namespace v2 {
constexpr int NSL=4, KSLOT=8192, VSLOT=16384, LDS_K2=0, LDS_V2=NSL*KSLOT, LDS_WS2=LDS_V2+NSL*VSLOT, LDS_BYTES2=LDS_WS2+NW*64*4;
#define V2_WAIT_BAR(N) asm volatile("s_waitcnt vmcnt(" #N ") lgkmcnt(0)\n\ts_barrier":::"memory")
#define V2_MX3(a,b,c) __builtin_fmaxf(__builtin_fmaxf((a),(b)),(c))
}
template<int THRL,bool SREF> __device__ __forceinline__ void attn_unit_v2(int b,int qb,int t0,const bf16*Q,const bf16*K,const bf16*V,bf16*O,float slope2,float bref,char*shm){
  using namespace v2;
  const int tid=otid(),lane=tid&63,r32=lane&31,hi=lane>>5; const int wid=__builtin_amdgcn_readfirstlane(tid>>6);
  const long rowbase=(long)b*SEQ; const int q0=qb*QB;
  const bf16*Qw=Q+(rowbase+q0+wid*QBLK)*PQ;
  const bf16*Kh=K+(rowbase+(long)t0*KVBLK)*PQ,*Vh=V+(rowbase+(long)t0*KVBLK)*PQ;
  const unsigned lds0=(unsigned)(uintptr_t)shm;
  float*wsf=(float*)(shm+LDS_WS2)+wid*64;
  const bf16*ksrc=Kh+(long)lane*PQ+wid*8;
  const int pi0=2*wid, pi1=2*wid+1;
  const bf16*vsrc0=Vh+(long)(16*(pi0&3)+(lane>>2))*PQ+(pi0>>2)*32+(lane&3)*8;
  const bf16*vsrc1=Vh+(long)(16*(pi1&3)+(lane>>2))*PQ+(pi1>>2)*32+(lane&3)*8;
  const unsigned kdst=lds0+LDS_K2+wid*1024, vdst0=lds0+LDS_V2+pi0*1024, vdst1=lds0+LDS_V2+pi1*1024;
  #define V2_DMA(t,sl) do{ glds16(ksrc+(long)(t)*KVBLK*PQ,(unsigned)__builtin_amdgcn_readfirstlane(kdst+(sl)*KSLOT)); \
      glds16(vsrc0+(long)(t)*KVBLK*PQ,(unsigned)__builtin_amdgcn_readfirstlane(vdst0+(sl)*VSLOT)); \
      glds16(vsrc1+(long)(t)*KVBLK*PQ,(unsigned)__builtin_amdgcn_readfirstlane(vdst1+(sl)*VSLOT)); }while(0)
  #define V2_DMAK(t,sl) glds16(ksrc+(long)(t)*KVBLK*PQ,(unsigned)__builtin_amdgcn_readfirstlane(kdst+(sl)*KSLOT))
  #define V2_DMAV(t,sl) do{ glds16(vsrc0+(long)(t)*KVBLK*PQ,(unsigned)__builtin_amdgcn_readfirstlane(vdst0+(sl)*VSLOT)); \
      glds16(vsrc1+(long)(t)*KVBLK*PQ,(unsigned)__builtin_amdgcn_readfirstlane(vdst1+(sl)*VSLOT)); }while(0)
  const int NT=(q0+QB)/KVBLK-t0;
  V2_DMAK(0,0); V2_DMAK(1,1); V2_DMAV(0,0); V2_DMAK(2,2); V2_DMAV(1,1);
  bf16x8 kf[8];
  bf16x8 qr[4];
  #pragma unroll
  for(int d0=0;d0<4;++d0)qr[d0]=*reinterpret_cast<const bf16x8*>(&Qw[(long)r32*PQ+d0*16+hi*8]);
  float l_reg=0.f; f32x16 o[4];
  #pragma unroll
  for(int d0=0;d0<4;++d0)o[d0]=f32x16{};
  f32x16 negm;
  const float b32=32.f*slope2, step64=64.f*slope2;
  const int qrel=wid*QBLK+r32;
  #pragma unroll
  for(int r=0;r<16;++r)negm[r]=SREF?(slope2*(float)(crow(r,hi)+KVBLK*t0-(q0+qrel))-bref):slope2*(float)crow(r,hi);
  const lds_cptr shm3=(lds_cptr)shm; const lds_cptr kp0=shm3+LDS_K2+hi*1024+r32*16; const lds_cptr vp0=shm3+LDS_V2+((lane>>4)&1)*32+(lane&3)*8+(4*hi+((lane&15)>>2))*64;
  f32x16 pA0,pA1,pB0,pB1; u32x4 pw0,pw1,pw2,pw3;
  #define V2_PIN(x) asm volatile("":"+v"(x))
  #define V2_VRD(dst,d0) do{ _Pragma("unroll") for(int ks=0;ks<4;++ks){ dst[2*ks]=vtr(vp+(d0)*4096+ks*1024); dst[2*ks+1]=vtr(vp+(d0)*4096+ks*1024+512);} }while(0)
  #define V2_VF(src,ks) (bf16x8){src[2*(ks)][0],src[2*(ks)][1],src[2*(ks)][2],src[2*(ks)][3],src[2*(ks)+1][0],src[2*(ks)+1][1],src[2*(ks)+1][2],src[2*(ks)+1][3]}
  #define V2_KLD2(t,d0) do{ const lds_cptr kp_=kp0+((t)&3)*KSLOT; kf[2*(d0)]=*(const __attribute__((address_space(3))) bf16x8*)(kp_+(d0)*2048); kf[2*(d0)+1]=*(const __attribute__((address_space(3))) bf16x8*)(kp_+(d0)*2048+512); SBAR(); }while(0)
  #define V2_KRD(t)
  #define V2_QK(t,C0,C1) do{ V2_KRD(t) \
      C0=__builtin_amdgcn_mfma_f32_32x32x16_bf16(kf[0],qr[0],negm,0,0,0); C1=__builtin_amdgcn_mfma_f32_32x32x16_bf16(kf[1],qr[0],negm,0,0,0); \
      _Pragma("unroll") for(int d0=1;d0<4;++d0){ C0=__builtin_amdgcn_mfma_f32_32x32x16_bf16(kf[2*d0],qr[d0],C0,0,0,0); C1=__builtin_amdgcn_mfma_f32_32x32x16_bf16(kf[2*d0+1],qr[d0],C1,0,0,0); } \
      SBAR(); }while(0)
  #define V2_FILL(P,B,PW,W) do{ sacc+=P[B]; sacc+=P[B+1]; sacc+=P[B+2]; sacc+=P[B+3]; PW[W]=cvtpk_s(P[B],P[B+1]); PW[W+1]=cvtpk_s(P[B+2],P[B+3]); V2_PIN(sacc); V2_PIN(PW); SBAR(); }while(0)
  #define V2_QKF(t,C0,C1,P0,P1) do{ V2_KRD(t) float sacc=0.f; \
      C0=__builtin_amdgcn_mfma_f32_32x32x16_bf16(kf[0],qr[0],negm,0,0,0); V2_FILL(P0,0,pw0,0); \
      C1=__builtin_amdgcn_mfma_f32_32x32x16_bf16(kf[1],qr[0],negm,0,0,0); V2_FILL(P0,4,pw0,2); \
      C0=__builtin_amdgcn_mfma_f32_32x32x16_bf16(kf[2],qr[1],C0,0,0,0);   V2_FILL(P0,8,pw1,0); \
      C1=__builtin_amdgcn_mfma_f32_32x32x16_bf16(kf[3],qr[1],C1,0,0,0);   V2_FILL(P0,12,pw1,2); \
      C0=__builtin_amdgcn_mfma_f32_32x32x16_bf16(kf[4],qr[2],C0,0,0,0);   V2_FILL(P1,0,pw2,0); \
      C1=__builtin_amdgcn_mfma_f32_32x32x16_bf16(kf[5],qr[2],C1,0,0,0);   V2_FILL(P1,4,pw2,2); \
      C0=__builtin_amdgcn_mfma_f32_32x32x16_bf16(kf[6],qr[3],C0,0,0,0);   V2_FILL(P1,8,pw3,0); \
      C1=__builtin_amdgcn_mfma_f32_32x32x16_bf16(kf[7],qr[3],C1,0,0,0);   V2_FILL(P1,12,pw3,2); \
      l_reg+=sacc; }while(0)
  bool resc=false;
  #define V2_DECIDE(t,FIRST,C0,C1) do{ \
      _Pragma("unroll") for(int r=0;r<16;++r)C1[r]+=b32; \
      { const int jb=(t)-(NT-4); if(jb>=0)cmask(C0,C1,jb,qrel,hi); } \
      if constexpr(SREF){ _Pragma("unroll") for(int r=0;r<16;++r)negm[r]+=step64; SBAR(); break; } \
      float rm; \
      { float a=V2_MX3(C0[0],C0[1],C1[0]),c=V2_MX3(C0[2],C0[3],C1[1]); a=V2_MX3(a,C1[2],C1[3]); \
        _Pragma("unroll") for(int r=4;r<16;r+=4){a=V2_MX3(a,C0[r],C0[r+1]);c=V2_MX3(c,C0[r+2],C0[r+3]);a=V2_MX3(a,C1[r],C1[r+1]);c=V2_MX3(c,C1[r+2],C1[r+3]);} \
        rm=__builtin_fmaxf(a,c); auto rr=__builtin_amdgcn_permlane32_swap(__float_as_uint(rm),__float_as_uint(rm),false,false); rm=__builtin_fmaxf(__uint_as_float(rr[0]),__uint_as_float(rr[1])); } \
      float adj=step64; resc=false; \
      if(FIRST){ _Pragma("unroll") for(int r=0;r<16;++r){C0[r]-=rm;C1[r]-=rm;} adj-=rm; } \
      else if(__any(rm>(float)THRL)){ const float dl=__builtin_fmaxf(rm,0.f); \
        _Pragma("unroll") for(int r=0;r<16;++r){C0[r]-=dl;C1[r]-=dl;} \
        adj-=dl; const float f=__builtin_amdgcn_exp2f(-dl); l_reg*=f; if(hi==0)wsf[r32]=f; resc=true; } \
      _Pragma("unroll") for(int r=0;r<16;++r)negm[r]+=adj; \
      SBAR(); }while(0)
  #define V2_GRP(d0,ks,src,C,B) do{ o[d0]=__builtin_amdgcn_mfma_f32_32x32x16_bf16(__builtin_bit_cast(bf16x8,pw##ks),V2_VF(src,ks),o[d0],0,0,0); \
      C[B]=__builtin_amdgcn_exp2f(C[B]); C[B+1]=__builtin_amdgcn_exp2f(C[B+1]); V2_PIN(C); SBAR(); }while(0)
  #define V2_SYNC(t) do{ if((t)+2<NT){ V2_WAIT_BAR(3); } else if((t)+1<NT){ V2_WAIT_BAR(2); } else { V2_WAIT_BAR(0); } \
      if((t)+3<NT){ V2_DMAK((t)+3,((t)+3)&3); } if((t)+2<NT){ V2_DMAV((t)+2,((t)+2)&3); } }while(0)
  #define V2_KPF(PF,t,d0) do{ if(PF){ V2_KLD2((t)+1,d0); } }while(0)
  #define V2_STEP(t,C0,C1,P0,P1,PF) do{ V2_SYNC(t); \
      const lds_cptr vp=vp0+(((t)-1)&3)*VSLOT; s16x4 va[8],vb[8]; \
      V2_VRD(va,0); \
      V2_QKF(t,C0,C1,P0,P1); V2_DECIDE(t,false,C0,C1); \
      V2_VRD(vb,1); \
      V2_GRP(0,0,va,C0,0); V2_GRP(0,1,va,C0,2); V2_GRP(0,2,va,C0,4); V2_GRP(0,3,va,C0,6); \
      V2_VRD(va,2); \
      V2_GRP(1,0,vb,C0,8); V2_KPF(PF,t,0); V2_GRP(1,1,vb,C0,10); V2_KPF(PF,t,1); V2_GRP(1,2,vb,C0,12); V2_GRP(1,3,vb,C0,14); \
      V2_VRD(vb,3); \
      V2_GRP(2,0,va,C1,0); V2_KPF(PF,t,2); V2_GRP(2,1,va,C1,2); V2_KPF(PF,t,3); V2_GRP(2,2,va,C1,4); V2_GRP(2,3,va,C1,6); \
      V2_GRP(3,0,vb,C1,8); V2_GRP(3,1,vb,C1,10); V2_GRP(3,2,vb,C1,12); V2_GRP(3,3,vb,C1,14); \
      if(resc){ asm volatile("s_waitcnt lgkmcnt(0)":::"memory");         \
        _Pragma("unroll") for(int r=0;r<16;++r){ const float fr_=wsf[crow(r,hi)]; \
          _Pragma("unroll") for(int d0=0;d0<4;++d0)o[d0][r]*=fr_; } \
        asm volatile("s_waitcnt lgkmcnt(0)":::"memory"); } }while(0)
  V2_SYNC(0); V2_KLD2(0,0); V2_KLD2(0,1); V2_KLD2(0,2); V2_KLD2(0,3); V2_QK(0,pA0,pA1);
  V2_KLD2(1,0); V2_KLD2(1,1); V2_KLD2(1,2); V2_KLD2(1,3);
  V2_DECIDE(0,true,pA0,pA1);
  #pragma unroll
  for(int r=0;r<16;++r){pA0[r]=__builtin_amdgcn_exp2f(pA0[r]);pA1[r]=__builtin_amdgcn_exp2f(pA1[r]);}
  for(int t=1;t+1<NT;t+=2){ V2_STEP(t,pB0,pB1,pA0,pA1,true); V2_STEP(t+1,pA0,pA1,pB0,pB1,true); }
  V2_STEP(NT-1,pB0,pB1,pA0,pA1,false);
  { float sacc=0.f;
    #pragma unroll
    for(int r=0;r<16;++r)sacc+=pB0[r]+pB1[r];
    l_reg+=sacc;
    pw0=(u32x4){cvtpk_s(pB0[0],pB0[1]),cvtpk_s(pB0[2],pB0[3]),cvtpk_s(pB0[4],pB0[5]),cvtpk_s(pB0[6],pB0[7])};
    pw1=(u32x4){cvtpk_s(pB0[8],pB0[9]),cvtpk_s(pB0[10],pB0[11]),cvtpk_s(pB0[12],pB0[13]),cvtpk_s(pB0[14],pB0[15])};
    pw2=(u32x4){cvtpk_s(pB1[0],pB1[1]),cvtpk_s(pB1[2],pB1[3]),cvtpk_s(pB1[4],pB1[5]),cvtpk_s(pB1[6],pB1[7])};
    pw3=(u32x4){cvtpk_s(pB1[8],pB1[9]),cvtpk_s(pB1[10],pB1[11]),cvtpk_s(pB1[12],pB1[13]),cvtpk_s(pB1[14],pB1[15])};
    const lds_cptr vp=vp0+((NT-1)&3)*VSLOT; s16x4 va[8],vb[8];
    #define V2_PV(d0,src) do{ o[d0]=__builtin_amdgcn_mfma_f32_32x32x16_bf16(__builtin_bit_cast(bf16x8,pw0),V2_VF(src,0),o[d0],0,0,0); \
        o[d0]=__builtin_amdgcn_mfma_f32_32x32x16_bf16(__builtin_bit_cast(bf16x8,pw1),V2_VF(src,1),o[d0],0,0,0); \
        o[d0]=__builtin_amdgcn_mfma_f32_32x32x16_bf16(__builtin_bit_cast(bf16x8,pw2),V2_VF(src,2),o[d0],0,0,0); \
        o[d0]=__builtin_amdgcn_mfma_f32_32x32x16_bf16(__builtin_bit_cast(bf16x8,pw3),V2_VF(src,3),o[d0],0,0,0); }while(0)
    V2_VRD(va,0); V2_VRD(vb,1); V2_PV(0,va); V2_VRD(va,2); V2_PV(1,vb); V2_VRD(vb,3); V2_PV(2,va); V2_PV(3,vb);
    #undef V2_PV
  }
  #undef V2_PIN
  #undef V2_VRD
  #undef V2_VF
  #undef V2_KRD
  #undef V2_QK
  #undef V2_QKF
  #undef V2_FILL
  #undef V2_DECIDE
  #undef V2_GRP
  #undef V2_STEP
  #undef V2_SYNC
  {auto rr=__builtin_amdgcn_permlane32_swap(__float_as_uint(l_reg),__float_as_uint(l_reg),false,false);l_reg=__uint_as_float(rr[0])+__uint_as_float(rr[1]);}
  if(hi==0)wsf[32+r32]=l_reg;asm volatile("s_waitcnt lgkmcnt(0)":::"memory");
  float rli[16];
  #pragma unroll
  for(int r=0;r<16;++r)rli[r]=__builtin_amdgcn_rcpf(wsf[32+crow(r,hi)]);
  asm volatile("s_waitcnt lgkmcnt(0)\n\ts_barrier":::"memory");
  bf16*Ow=O+(rowbase+q0+wid*QBLK)*PO;
  { bf16*stg=(bf16*)shm+wid*4096;
    #pragma unroll
    for(int r=0;r<16;++r){const int orow=crow(r,hi);
      #pragma unroll
      for(int d0=0;d0<4;++d0)stg[orow*128+d0*32+r32]=__float2bfloat16(o[d0][r]*rli[r]);}
    asm volatile("s_waitcnt lgkmcnt(0)":::"memory");
    #pragma unroll
    for(int i=0;i<8;++i){const int row=i*4+(lane>>4),ch=lane&15; const u32x4 v=*(const u32x4*)(stg+row*128+ch*8); *(u32x4*)(Ow+(long)row*PO+ch*8)=v;} }
  asm volatile("s_waitcnt lgkmcnt(0)\n\ts_barrier":::"memory");
  #undef V2_DMA
  #undef V2_DMAK
  #undef V2_DMAV
  #undef V2_KLD2
  #undef V2_KPF
}
constexpr int ATTN_LDS_BYTES=LDS_BYTES;
#undef SBAR
#undef WAIT_BAR
}

__device__ __forceinline__ void phase_diff_mfma(char* shm, LAS unsigned char* lds, const Ctx& a, int vcu, int G) {
    bf16* proj = (bf16*)(a.ws + WS_H); bf16* o12 = (bf16*)(a.ws + WS_STATE);
    unsigned* ctl = (unsigned*)(a.ws + WS_CTL);
    volatile LAS unsigned* qslot = (volatile LAS unsigned*)(lds + MISC_OFF) + 16;
    for (;;) {
        const int tid = otid();
        if (tid == 0) *qslot = atomicAdd(ctl + CW_QUEUE, 1u);
        __syncthreads();
        const unsigned idx = (unsigned)__builtin_amdgcn_readfirstlane((int)*qslot);
        __syncthreads();
        if (idx >= (unsigned)(NB * DIFF_H * 2 * 32)) break;
        const int qb = 31 - (int)(idx >> 5), rem = idx & 31, b = rem >> 4, h = (rem >> 1) & 7, r = rem & 1;
        const float slope2 = exp2f(-(float)(h + 1)) * LOG2E;
        int t0 = 0; float smax_u;
        { const unsigned* qm = ctl + CW_QKMAX + b * 64; const int g0 = (h * 128 + r * 64) >> 5;
          const float pq = __uint_as_float(qm[g0]) + __uint_as_float(qm[g0 + 1]), pk = __uint_as_float(qm[32 + g0]) + __uint_as_float(qm[32 + g0 + 1]);
          const float smax = sqrtf(pq * pk); smax_u = smax;
          const float d = (float)(qb * 256) - (152.0f + 2.1f * smax) / slope2;
          if (d > 0.f) t0 = ((int)d >> 6) & ~1;
          if (t0 > 4 * qb) t0 = 4 * qb; }
#if ATTN_SREF
        if (smax_u <= 48.f)
            attn_body::attn_unit_v2<8, true>(b, qb, t0, (const attn_body::bf16*)(proj + h * 128 + r * 64), (const attn_body::bf16*)(proj + 1024 + h * 128 + r * 64),
                                   (const attn_body::bf16*)(proj + 2048 + h * 128), (attn_body::bf16*)(o12 + r * 1024 + h * 128), slope2, smax_u, shm);
        else
#endif
        attn_body::attn_unit_v2<8, false>(b, qb, t0, (const attn_body::bf16*)(proj + h * 128 + r * 64), (const attn_body::bf16*)(proj + 1024 + h * 128 + r * 64),
                                   (const attn_body::bf16*)(proj + 2048 + h * 128), (attn_body::bf16*)(o12 + r * 1024 + h * 128), slope2, 0.f, shm);
    }
}
__device__ __forceinline__ void phase_diff_combine(const Ctx& a, const LayerP& P, int vcu, int G) {
    const int tid = otid(), lane = tid & 63, wave = tid >> 6;
    bf16* proj = (bf16*)(a.ws + WS_H); const bf16* o12 = (const bf16*)(a.ws + WS_STATE);
    float lam;
    { float s1 = 0.f, s2 = 0.f;
      for (int i = 0; i < 64; ++i) { s1 += P.e0[i] * P.e1[i]; s2 += P.e2[i] * P.e3[i]; }
      lam = __expf(s1) - __expf(s2) + LAMBDA_INIT; }
    const int h = lane >> 3, sub = lane & 7;
    float hn[16];
#pragma unroll
    for (int j = 0; j < 16; ++j) hn[j] = P.e4[sub * 16 + j] * (1.0f - LAMBDA_INIT);
    const int gw = vcu * NWAVES + wave, NGW = G * NWAVES;
    for (int r0 = gw; r0 < NTOK; r0 += 2 * NGW) {
      const int r1 = (r0 + NGW < NTOK) ? r0 + NGW : r0;
      v4u ld[2][4];
#pragma unroll
      for (int q = 0; q < 2; ++q) { const bf16* p1 = o12 + (size_t)(q ? r1 : r0) * 2048 + h * 128 + sub * 16;
          ld[q][0] = *(const v4u*)p1; ld[q][1] = *(const v4u*)(p1 + 8); ld[q][2] = *(const v4u*)(p1 + 1024); ld[q][3] = *(const v4u*)(p1 + 1032); }
#pragma unroll
      for (int q = 0; q < 2; ++q) { const int row = q ? r1 : r0; if (q && r1 == r0) break;
        const v4u a0 = ld[q][0], a1 = ld[q][1], b0 = ld[q][2], b1 = ld[q][3];
        const unsigned aw[8] = {a0.x, a0.y, a0.z, a0.w, a1.x, a1.y, a1.z, a1.w}, bw[8] = {b0.x, b0.y, b0.z, b0.w, b1.x, b1.y, b1.z, b1.w};
        float o[16]; float ss = 0.f;
#pragma unroll
        for (int j = 0; j < 8; ++j) { o[2 * j] = bflo(aw[j]) - lam * bflo(bw[j]); o[2 * j + 1] = bfhi(aw[j]) - lam * bfhi(bw[j]); ss += o[2 * j] * o[2 * j] + o[2 * j + 1] * o[2 * j + 1]; }
        ss = sum_lanes8(ss);
        const float rs = 1.0f / sqrtf(ss * (1.0f / 128.0f) + EPS);
        v4u w0, w1;
        w0.x = pk2(o[0] * rs * hn[0], o[1] * rs * hn[1]); w0.y = pk2(o[2] * rs * hn[2], o[3] * rs * hn[3]); w0.z = pk2(o[4] * rs * hn[4], o[5] * rs * hn[5]); w0.w = pk2(o[6] * rs * hn[6], o[7] * rs * hn[7]);
        w1.x = pk2(o[8] * rs * hn[8], o[9] * rs * hn[9]); w1.y = pk2(o[10] * rs * hn[10], o[11] * rs * hn[11]); w1.z = pk2(o[12] * rs * hn[12], o[13] * rs * hn[13]); w1.w = pk2(o[14] * rs * hn[14], o[15] * rs * hn[15]);
        bf16* op = proj + (size_t)row * DIFF_PITCH + h * 128 + sub * 16;
        *(v4u*)op = w0; *(v4u*)(op + 8) = w1;
      }
    }
}

typedef short mbf16x8 __attribute__((ext_vector_type(8)));
typedef short ms16x4 __attribute__((ext_vector_type(4)));
typedef float mf32x16 __attribute__((ext_vector_type(16)));
#define MFMA32(a, b, c) __builtin_amdgcn_mfma_f32_32x32x16_bf16(a, b, c, 0, 0, 0)
__device__ __forceinline__ int crow32(int r, int hi) { return (r & 3) + 8 * (r >> 2) + 4 * hi; }
__device__ __forceinline__ mbf16x8 frag_rk(const LAS unsigned char* base, int stride, int row0, int k0, int lane) {
    return *(const LAS mbf16x8*)(base + (row0 + (lane & 31)) * stride + (k0 + 8 * (lane >> 5)) * 2);
}
__device__ __forceinline__ mbf16x8 frag_kn(const LAS unsigned char* base, int stride, int k0, int n0, int lane) {
    const int i = lane & 15, g = lane >> 4;
    const LAS unsigned char* p = base + (k0 + 8 * (g >> 1) + (i >> 2)) * stride + (n0 + 16 * (g & 1) + 4 * (i & 3)) * 2;
    const ms16x4 lo = __builtin_bit_cast(ms16x4, __builtin_amdgcn_ds_read_tr16_b64_v4i16((LAS ms16x4*)p));
    const ms16x4 hi = __builtin_bit_cast(ms16x4, __builtin_amdgcn_ds_read_tr16_b64_v4i16((LAS ms16x4*)(p + 4 * stride)));
    return (mbf16x8){lo[0], lo[1], lo[2], lo[3], hi[0], hi[1], hi[2], hi[3]};
}
__device__ __forceinline__ mf32x16 zero16() { mf32x16 z;
#pragma unroll
    for (int r = 0; r < 16; ++r) z[r] = 0.f; return z; }

__device__ __forceinline__ void phase_sgu_mfma(LAS unsigned char* lds, const Ctx& a, const LayerP& P, int vcu, int G, bool dummy = false) {
    const int tid = otid(), lane = tid & 63, wave = __builtin_amdgcn_readfirstlane(tid >> 6);
    bf16* proj = (bf16*)(a.ws + WS_H); const float* vssq = (const float*)(a.ws + WS_VSSQ);
    const float* v_norm = P.e1; const float* w_s = P.e2; const float* b_s = P.e3;
    constexpr int SA = 272, SV = 320, SO = 132;
    LAS unsigned char* WA = lds;
    LAS unsigned char* VV = lds + 128 * SA;
    LAS float* OS = (LAS float*)(lds + 128 * SA);
    LAS float* RS = (LAS float*)(lds + 128 * SA + 128 * SO * 4);
    const int tm = wave & 3, nh = wave >> 2, hi = lane >> 5;
    constexpr int NU = NB * (T / SGU_C) * SGU_G;
    int g_res = -1;
    v4u vraw[4]; float rsraw = 0.f;
    #define SGU_LOAD_RAW(uu) do{ const int g_ = (uu) % SGU_G, row0_ = ((uu) / SGU_G) * SGU_C; \
        _Pragma("unroll") for (int i = 0; i < 4; ++i) { const int ch = tid + NTHR * i, r = ch >> 4, c16 = ch & 15; \
            vraw[i] = *(const v4u*)(proj + (size_t)(row0_ + r) * SGU_PITCH + 1024 + g_ * 128 + c16 * 8); } \
        if (tid < 128) rsraw = row_rstd(vssq, row0_ + tid); }while(0)
    if (vcu < NU) SGU_LOAD_RAW(vcu);
    for (int u = vcu; u < NU; u += G) {
        const int g = u % SGU_G, bc = u / SGU_G;
        const int row0 = bc * SGU_C;
        if (tid < 128) RS[tid] = rsraw;
        v4u vcur[4];
#pragma unroll
        for (int i = 0; i < 4; ++i) vcur[i] = vraw[i];
        v4u uw[4];
#pragma unroll
        for (int i = 0; i < 4; ++i) { const int ch = tid + NTHR * i, t = ch >> 4, c8 = (ch & 15) * 8; uw[i] = *(const v4u*)(proj + (size_t)(row0 + t) * SGU_PITCH + g * 128 + c8); }
        if (g != g_res) {
#pragma unroll
            for (int i = 0; i < 8; ++i) { const int idx = tid + NTHR * i, t = idx >> 5, s4 = (idx & 31) * 4;
                const f32x4 w = *(const f32x4*)(w_s + (size_t)g * 16384 + t * 128 + s4);
                v2u o; o.x = pk2((s4 + 0 <= t) ? w.x : 0.f, (s4 + 1 <= t) ? w.y : 0.f); o.y = pk2((s4 + 2 <= t) ? w.z : 0.f, (s4 + 3 <= t) ? w.w : 0.f);
                *(LAS v2u*)(WA + t * SA + s4 * 2) = o; }
            g_res = g;
        }
        if (u + G < NU) SGU_LOAD_RAW(u + G);
        __syncthreads();
#pragma unroll
        for (int i = 0; i < 4; ++i) { const int ch = tid + NTHR * i, r = ch >> 4, c16 = ch & 15; const float rs = RS[r];
            v4u o; o.x = pk2(bflo(vcur[i].x) * rs, bfhi(vcur[i].x) * rs); o.y = pk2(bflo(vcur[i].y) * rs, bfhi(vcur[i].y) * rs);
            o.z = pk2(bflo(vcur[i].z) * rs, bfhi(vcur[i].z) * rs); o.w = pk2(bflo(vcur[i].w) * rs, bfhi(vcur[i].w) * rs);
            *(LAS v4u*)(VV + r * SV + c16 * 16) = o; }
        __syncthreads();
        mf32x16 acc0 = zero16(), acc1 = zero16();
        for (int ks = 0; ks < 2 * (tm + 1); ++ks) {
            const mbf16x8 af = frag_rk(WA, SA, 32 * tm, 16 * ks, lane);
            const mbf16x8 b0 = frag_kn(VV, SV, 16 * ks, 64 * nh, lane), b1 = frag_kn(VV, SV, 16 * ks, 64 * nh + 32, lane);
            acc0 = MFMA32(af, b0, acc0); acc1 = MFMA32(af, b1, acc1);
        }
        __syncthreads();
#pragma unroll
        for (int r = 0; r < 16; ++r) { const int row = 32 * tm + crow32(r, hi);
            OS[row * SO + 64 * nh + (lane & 31)] = acc0[r]; OS[row * SO + 64 * nh + 32 + (lane & 31)] = acc1[r]; }
        __syncthreads();
#pragma unroll
        for (int i = 0; i < 4; ++i) { const int ch = tid + NTHR * i, t = ch >> 4, c8 = (ch & 15) * 8;
            const f32x4 s0 = *(const LAS f32x4*)(OS + t * SO + c8), s1 = *(const LAS f32x4*)(OS + t * SO + c8 + 4);
            const f32x4 n0 = *(const f32x4*)(v_norm + g * 128 + c8), n1 = *(const f32x4*)(v_norm + g * 128 + c8 + 4);
            const float bs = b_s[g * 128 + t];
            bf16* up = proj + (size_t)(row0 + t) * SGU_PITCH + g * 128 + c8;
            const v4u uwv = uw[i];
            v4u o;
            o.x = pk2(bflo(uwv.x) * (n0.x * s0.x + bs), bfhi(uwv.x) * (n0.y * s0.y + bs)); o.y = pk2(bflo(uwv.y) * (n0.z * s0.z + bs), bfhi(uwv.y) * (n0.w * s0.w + bs));
            o.z = pk2(bflo(uwv.z) * (n1.x * s1.x + bs), bfhi(uwv.z) * (n1.y * s1.y + bs)); o.w = pk2(bflo(uwv.w) * (n1.z * s1.z + bs), bfhi(uwv.w) * (n1.w * s1.w + bs));
            if (dummy) *(v4u*)((bf16*)(a.ws + WS_STATE + 32 * MiB) + (size_t)(row0 + t) * 1024 + g * 128 + c8) = o; else *(v4u*)up = o; }
        __syncthreads();
    }
    #undef SGU_LOAD_RAW
}

constexpr int GLA_GRP = 4, GLA_NG = GLA_NC / GLA_GRP;
constexpr int GLA_NU2 = NB * GLA_H * GLA_NG;
struct GlaGate { const float* R; const float* w2; const float* gb; };
struct GlaRaw2 { float la0[8], la1[8]; unsigned q[8], k[8]; v4u v[4]; };
__device__ __forceinline__ void gla2_load_raw(GlaRaw2& r, const bf16* proj, const GlaGate& gt, int row0, int h, int tid, bool want_q) {
    const int cp = tid & 63, part = tid >> 6;
#pragma unroll
    for (int i = 0; i < 8; ++i) { const bf16* base = proj + (size_t)(row0 + 8 * part + i) * GLA_PITCH + h * 128 + 2 * cp;
        r.k[i] = *(const unsigned*)(base + 512); r.q[i] = want_q ? *(const unsigned*)base : 0u; }
#if GLA_RANK16
    { const f32x2v gbv = *(const f32x2v*)(gt.gb + h * 128 + 2 * cp);
#pragma unroll
      for (int i = 0; i < 8; ++i) { r.la0[i] = gbv.x; r.la1[i] = gbv.y; }
#pragma unroll 1
      for (int j4 = 0; j4 < 4; ++j4) {
          f32x2v w[4];
#pragma unroll
          for (int jj = 0; jj < 4; ++jj) w[jj] = *(const f32x2v*)(gt.w2 + (4 * j4 + jj) * 512 + h * 128 + 2 * cp);
#pragma unroll
          for (int i = 0; i < 8; ++i) { const f32x4 rv = *(const f32x4*)(gt.R + (size_t)(row0 + 8 * part + i) * 16 + 4 * j4);
              r.la0[i] += rv.x * w[0].x + rv.y * w[1].x + rv.z * w[2].x + rv.w * w[3].x;
              r.la1[i] += rv.x * w[0].y + rv.y * w[1].y + rv.z * w[2].y + rv.w * w[3].y; }
      }
#pragma unroll
      for (int i = 0; i < 8; ++i) { r.la0[i] = log_sigmoid(r.la0[i]) * (1.0f / 16.0f); r.la1[i] = log_sigmoid(r.la1[i]) * (1.0f / 16.0f); } }
#else
#pragma unroll
    for (int i = 0; i < 8; ++i) { const unsigned w = *(const unsigned*)(proj + (size_t)(row0 + 8 * part + i) * GLA_PITCH + 3072 + h * 128 + 2 * cp); r.la0[i] = bflo(w); r.la1[i] = bfhi(w); }
#endif
#pragma unroll
    for (int i = 0; i < 4; ++i) { const int ch = tid + NTHR * i, rr = ch >> 5, c16 = ch & 31;
        r.v[i] = *(const v4u*)(proj + (size_t)(row0 + rr) * GLA_PITCH + 1024 + h * 256 + c16 * 8); }
}
__device__ __forceinline__ void gla2_cumsum(GlaCum& c, const GlaRaw2& r, LAS float* TOT, int tid) {
    const int cp = tid & 63, part = tid >> 6;
#pragma unroll
    for (int i = 0; i < 8; ++i) { c.b0[i] = r.la0[i]; c.b1[i] = r.la1[i]; }
#pragma unroll
    for (int i = 1; i < 8; ++i) { c.b0[i] += c.b0[i - 1]; c.b1[i] += c.b1[i - 1]; }
    TOT[part * 128 + 2 * cp] = c.b0[7]; TOT[part * 128 + 2 * cp + 1] = c.b1[7];
    __syncthreads();
    float o0 = 0.f, o1 = 0.f, t0 = 0.f, t1 = 0.f;
#pragma unroll
    for (int p = 0; p < 8; ++p) { const float x0 = TOT[p * 128 + 2 * cp], x1 = TOT[p * 128 + 2 * cp + 1]; if (p < part) { o0 += x0; o1 += x1; } t0 += x0; t1 += x1; }
#pragma unroll
    for (int i = 0; i < 8; ++i) { c.b0[i] += o0; c.b1[i] += o1; }
    c.tot0 = t0; c.tot1 = t1;
}
__device__ __forceinline__ void gla2_state_update(mf32x16 (&S)[4], const LAS unsigned char* KE, const LAS unsigned char* VV, const LAS float* DEC, int wave, int lane, bool scale) {
    const int hi = lane >> 5;
    if (scale) {
#pragma unroll
        for (int kt = 0; kt < 4; ++kt)
#pragma unroll
            for (int rq = 0; rq < 4; ++rq) { const f32x4 d = *(const LAS f32x4*)(DEC + 32 * kt + 8 * rq + 4 * hi);
                S[kt][4 * rq + 0] *= d.x; S[kt][4 * rq + 1] *= d.y; S[kt][4 * rq + 2] *= d.z; S[kt][4 * rq + 3] *= d.w; }
    }
#pragma unroll
    for (int ks = 0; ks < 4; ++ks) { const mbf16x8 bfr = frag_kn(VV, 576, 16 * ks, 32 * wave, lane);
#pragma unroll
        for (int kt = 0; kt < 4; ++kt) S[kt] = MFMA32(frag_kn(KE, 320, 16 * ks, 32 * kt, lane), bfr, S[kt]); }
}
__device__ __forceinline__ void phase_gla2_kv(LAS unsigned char* lds, const Ctx& a, const LayerP& P, int vcu, int G) {
    const GlaGate gt{(const float*)(a.ws + WS_R), P.e1, P.e2};
    const int tid = otid(), lane = tid & 63, wave = __builtin_amdgcn_readfirstlane(tid >> 6), hi = lane >> 5;
    const bf16* proj = (const bf16*)(a.ws + WS_H); bf16* state = (bf16*)(a.ws + WS_STATE); float* dec = (float*)(a.ws + WS_DEC);
    LAS unsigned char* VV = lds;
    LAS unsigned char* KE = lds + 36864;
    LAS float* TOT = (LAS float*)(lds + 57344);
    LAS float* DEC = (LAS float*)(lds + 61440);
    const int cp = tid & 63, part = tid >> 6;
    for (int u = vcu; u < GLA_NU2; u += G) {
        const int grp = u % GLA_NG, bh = u / GLA_NG, h = bh % GLA_H, b = bh / GLA_H;
        const int row0 = b * T + grp * (GLA_GRP * GLA_C);
        mf32x16 S[4];
#pragma unroll
        for (int kt = 0; kt < 4; ++kt) S[kt] = zero16();
        float sum0 = 0.f, sum1 = 0.f;
        GlaRaw2 cur; gla2_load_raw(cur, proj, gt, row0, h, tid, false);
#pragma unroll 1
        for (int j = 0; j < GLA_GRP; ++j) {
            GlaCum c; gla2_cumsum(c, cur, TOT, tid);
#pragma unroll
            for (int i = 0; i < 8; ++i) { const int t = 8 * part + i; const unsigned w = cur.k[i];
                *(LAS unsigned*)(KE + t * 320 + 4 * cp) = pk2(bflo(w) * __expf(c.tot0 - c.b0[i]), bfhi(w) * __expf(c.tot1 - c.b1[i])); }
            if (part == 0) { DEC[2 * cp] = __expf(c.tot0); DEC[2 * cp + 1] = __expf(c.tot1); sum0 += c.tot0; sum1 += c.tot1; }
#pragma unroll
            for (int i = 0; i < 4; ++i) { const int ch = tid + NTHR * i, r = ch >> 5, c16 = ch & 31; *(LAS v4u*)(VV + r * 576 + c16 * 16) = cur.v[i]; }
            if (j + 1 < GLA_GRP) gla2_load_raw(cur, proj, gt, row0 + (j + 1) * GLA_C, h, tid, false);
            __syncthreads();
            gla2_state_update(S, KE, VV, DEC, wave, lane, j > 0);
            __syncthreads();
        }
        if (part == 0) { dec[(size_t)u * 128 + 2 * cp] = __expf(sum0); dec[(size_t)u * 128 + 2 * cp + 1] = __expf(sum1); }
        bf16* sp = state + (size_t)u * 32768 + 32 * wave + (lane & 31);
#pragma unroll
        for (int kt = 0; kt < 4; ++kt)
#pragma unroll
            for (int r = 0; r < 16; ++r) sp[(size_t)(32 * kt + crow32(r, hi)) * 256] = (bf16)f2bf(S[kt][r]);
    }
}
__device__ __forceinline__ void phase_gla2_scan(const Ctx& a, int vcu, int G) {
    unsigned* state = (unsigned*)(a.ws + WS_STATE); const float* dec = (const float*)(a.ws + WS_DEC);
    for (int gid = vcu * NTHR + otid(); gid < NB * GLA_H * 16384; gid += G * NTHR) {
        const int bh = gid >> 14, e = gid & 16383, kd = e >> 7;
        unsigned* sp = state + (size_t)bh * GLA_NG * 16384 + e;
        const float* dp = dec + (size_t)bh * GLA_NG * 128 + kd;
        float s0 = 0.f, s1 = 0.f;
        for (int n0 = 0; n0 < GLA_NG; n0 += 32) {
            unsigned w[32]; float d[32];
#pragma unroll
            for (int i = 0; i < 32; ++i) { w[i] = sp[(size_t)(n0 + i) * 16384]; d[i] = dp[(n0 + i) * 128]; }
#pragma unroll
            for (int i = 0; i < 32; ++i) { sp[(size_t)(n0 + i) * 16384] = pk2(s0, s1); s0 = d[i] * s0 + bflo(w[i]); s1 = d[i] * s1 + bfhi(w[i]); }
        }
    }
}
__device__ __forceinline__ void phase_gla2_out(LAS unsigned char* lds, const Ctx& a, const LayerP& P, int vcu, int G, bool dummy = false) {
    const int tid = otid(), lane = tid & 63, wave = __builtin_amdgcn_readfirstlane(tid >> 6), hi = lane >> 5;
    bf16* proj = (bf16*)(a.ws + WS_H); const bf16* state = (const bf16*)(a.ws + WS_STATE);
    const float* head_norm = P.e3;
    const GlaGate gt{(const float*)(a.ws + WS_R), P.e1, P.e2};
    constexpr int SQ = 272, SA = 144, SV = 576, SO = 260;
    LAS unsigned char* QD = lds;
    LAS unsigned char* KI = lds + 17408;
    LAS unsigned char* AT = lds + 34816;
    LAS unsigned char* VV = lds + 44032;
    LAS unsigned char* KE = lds + 80896;
    LAS float* TOT = (LAS float*)(lds + 101376);
    LAS float* DEC = (LAS float*)(lds + 105472);
    LAS float* OS = (LAS float*)lds;
    const int cp = tid & 63, part = tid >> 6;
    for (int u = vcu; u < GLA_NU2; u += G) {
        const int grp = u % GLA_NG, bh = u / GLA_NG, h = bh % GLA_H, b = bh / GLA_H;
        const int rowg = b * T + grp * (GLA_GRP * GLA_C);
        mf32x16 S[4];
        { const bf16* sp = state + (size_t)u * 32768 + 32 * wave + (lane & 31);
#pragma unroll
          for (int kt = 0; kt < 4; ++kt)
#pragma unroll
              for (int r = 0; r < 16; ++r) S[kt][r] = bf2f(sp[(size_t)(32 * kt + crow32(r, hi)) * 256]); }
        GlaRaw2 cur; gla2_load_raw(cur, proj, gt, rowg, h, tid, true);
#pragma unroll 1
        for (int j = 0; j < GLA_GRP; ++j) {
            const int row0 = rowg + j * GLA_C;
            v4u gwv[4];
#pragma unroll
            for (int p = 0; p < 4; ++p) gwv[p] = *(const v4u*)(proj + (size_t)(row0 + p * 16 + wave * 2 + hi) * GLA_PITCH + 2048 + h * 256 + (lane & 31) * 8);
            GlaCum c; gla2_cumsum(c, cur, TOT, tid);
#pragma unroll
            for (int i = 0; i < 8; ++i) { const int t = 8 * part + i;
                const unsigned wq = cur.q[i], wk = cur.k[i];
                const float e0 = __expf(c.b0[i]), e1 = __expf(c.b1[i]);
                *(LAS unsigned*)(QD + t * SQ + 4 * cp) = pk2(bflo(wq) * 0.08838834764831845f * e0, bfhi(wq) * 0.08838834764831845f * e1);
                *(LAS unsigned*)(KI + t * SQ + 4 * cp) = pk2(bflo(wk) * __builtin_amdgcn_rcpf(e0), bfhi(wk) * __builtin_amdgcn_rcpf(e1));
                *(LAS unsigned*)(KE + t * 320 + 4 * cp) = pk2(bflo(wk) * __expf(c.tot0 - c.b0[i]), bfhi(wk) * __expf(c.tot1 - c.b1[i])); }
            if (part == 0) { DEC[2 * cp] = __expf(c.tot0); DEC[2 * cp + 1] = __expf(c.tot1); }
#pragma unroll
            for (int i = 0; i < 4; ++i) { const int ch = tid + NTHR * i, r = ch >> 5, c16 = ch & 31; *(LAS v4u*)(VV + r * SV + c16 * 16) = cur.v[i]; }
            if (j + 1 < GLA_GRP) gla2_load_raw(cur, proj, gt, row0 + GLA_C, h, tid, true);
            __syncthreads();
            if (wave < 4) {
                const int mi = wave >> 1, ni = wave & 1;
                mf32x16 at = zero16();
                if (!(mi == 0 && ni == 1)) {
#pragma unroll
                    for (int ks = 0; ks < 8; ++ks) at = MFMA32(frag_rk(QD, SQ, 32 * mi, 16 * ks, lane), frag_rk(KI, SQ, 32 * ni, 16 * ks, lane), at);
                }
#pragma unroll
                for (int r = 0; r < 16; ++r) { const int cc = 32 * mi + crow32(r, hi), ss = 32 * ni + (lane & 31);
                    *(LAS bf16*)(AT + cc * SA + ss * 2) = (bf16)f2bf((ss <= cc) ? at[r] : 0.f); }
            }
            __syncthreads();
            mf32x16 acc[2]; acc[0] = zero16(); acc[1] = zero16();
#pragma unroll
            for (int ks = 0; ks < 4; ++ks) { const mbf16x8 bfr = frag_kn(VV, SV, 16 * ks, 32 * wave, lane);
                if (ks < 2) acc[0] = MFMA32(frag_rk(AT, SA, 0, 16 * ks, lane), bfr, acc[0]);
                acc[1] = MFMA32(frag_rk(AT, SA, 32, 16 * ks, lane), bfr, acc[1]); }
#pragma unroll
            for (int kt = 0; kt < 4; ++kt)
#pragma unroll
                for (int sx = 0; sx < 2; ++sx) {
                    v4u bw; bw.x = pk2(S[kt][8 * sx + 0], S[kt][8 * sx + 1]); bw.y = pk2(S[kt][8 * sx + 2], S[kt][8 * sx + 3]); bw.z = pk2(S[kt][8 * sx + 4], S[kt][8 * sx + 5]); bw.w = pk2(S[kt][8 * sx + 6], S[kt][8 * sx + 7]);
                    const mbf16x8 bfr = __builtin_bit_cast(mbf16x8, bw);
#pragma unroll
                    for (int mi = 0; mi < 2; ++mi) { const LAS unsigned char* qp = QD + (32 * mi + (lane & 31)) * SQ + (32 * kt + 16 * sx + 4 * hi) * 2;
                        const v2u a0 = *(const LAS v2u*)qp, a1 = *(const LAS v2u*)(qp + 16);
                        v4u aw; aw.x = a0.x; aw.y = a0.y; aw.z = a1.x; aw.w = a1.y;
                        acc[mi] = MFMA32(__builtin_bit_cast(mbf16x8, aw), bfr, acc[mi]); } }
            if (j + 1 < GLA_GRP) gla2_state_update(S, KE, VV, DEC, wave, lane, true);
            __syncthreads();
#pragma unroll
            for (int mi = 0; mi < 2; ++mi)
#pragma unroll
                for (int r = 0; r < 16; ++r) OS[(32 * mi + crow32(r, hi)) * SO + 32 * wave + (lane & 31)] = acc[mi][r];
            __syncthreads();
#pragma unroll
            for (int p = 0; p < 4; ++p) { const int cc = p * 16 + wave * 2 + hi, c8 = (lane & 31) * 8;
                const f32x4 s0 = *(const LAS f32x4*)(OS + cc * SO + c8), s1 = *(const LAS f32x4*)(OS + cc * SO + c8 + 4);
                float ss = (s0.x * s0.x + s0.y * s0.y) + (s0.z * s0.z + s0.w * s0.w) + (s1.x * s1.x + s1.y * s1.y) + (s1.z * s1.z + s1.w * s1.w);
                ss = sum_lanes32(ss);
                const float rs = __builtin_amdgcn_rsqf(ss * (1.0f / 256.0f) + EPS);
                const f32x4 n0 = *(const f32x4*)(head_norm + c8), n1 = *(const f32x4*)(head_norm + c8 + 4);
                const v4u gw = gwv[p];
                const float gg[8] = {bflo(gw.x), bfhi(gw.x), bflo(gw.y), bfhi(gw.y), bflo(gw.z), bfhi(gw.z), bflo(gw.w), bfhi(gw.w)};
                const float ov[8] = {s0.x * n0.x, s0.y * n0.y, s0.z * n0.z, s0.w * n0.w, s1.x * n1.x, s1.y * n1.y, s1.z * n1.z, s1.w * n1.w};
                float o[8];
#pragma unroll
                for (int jj = 0; jj < 8; ++jj) o[jj] = ov[jj] * rs * (gg[jj] * __builtin_amdgcn_rcpf(1.f + __builtin_amdgcn_exp2f(-gg[jj] * LOG2E)));
                v4u w; w.x = pk2(o[0], o[1]); w.y = pk2(o[2], o[3]); w.z = pk2(o[4], o[5]); w.w = pk2(o[6], o[7]);
                if (dummy) *(v4u*)((bf16*)(a.ws + WS_STATE + 32 * MiB) + (size_t)(row0 + cc) * 1024 + h * 256 + c8) = w;
                else *(v4u*)(proj + (size_t)(row0 + cc) * GLA_PITCH + 1024 + h * 256 + c8) = w; }
            __syncthreads();
        }
    }
}

template <int L> __device__ __forceinline__ LayerP layer_params_ct(const CAS cfptr* in) {
    constexpr int base = (L == 0) ? 1 : (L == 1) ? 11 : (L == 2) ? 22 : 32;
    constexpr int kind = (L == 1) ? K_DIFF : (L == 2) ? K_SGU : K_GLA;
    constexpr int sh = (kind == K_DIFF) ? 1 : 0;
    LayerP p; p.kind = kind;
    p.norm1 = in[base]; p.w_in = in[base + 1];
    p.e0 = in[base + 2]; p.e1 = in[base + 3]; p.e2 = in[base + 4]; p.e3 = in[base + 5]; p.e4 = in[base + 6];
    p.w_out = in[base + 6 + sh]; p.norm2 = in[base + 7 + sh]; p.w1 = in[base + 8 + sh]; p.w2 = in[base + 9 + sh];
    p.nin = (kind == K_GLA) ? GLA_PITCH : (kind == K_DIFF) ? DIFF_PITCH : SGU_PITCH;
    p.mixoff = (kind == K_GLA) ? 1024 : 0;
    return p;
}
__device__ __forceinline__ void seam_xcd(const CAS Args* ap, LAS unsigned char* lds_k) {
#if PROBE_KIND == 1
    for (int br = 0; br < PROBE_REP; ++br)
#endif
    { XcdBarrier bb; bb.bar = (unsigned*)(ap->ws + WS_CTL) + 4096; bb.x = xb_xcc_id(); bb.st = (volatile LAS unsigned*)(lds_k + MISC_OFF) + 8; xcd_barrier(bb); }
}
#define PH_BEGIN(PK) { const int nrep_ = (PROBE_KIND == (PK) && (PK) != 0) ? PROBE_REP : 1; \
    for (int rep_ = 0; rep_ < nrep_; ++rep_) { \
    int vcu = vcu0, G = G0; asm volatile("" : "+s"(vcu), "+s"(G)); \
    LAS unsigned char* lds = lds_k; asm volatile("" : "+s"(lds)); \
    const CAS Args* ap = (const CAS Args*)__builtin_amdgcn_kernarg_segment_ptr(); asm volatile("" : "+s"(ap)); \
    Ctx args; args.in0 = ap->in[0]; args.in42 = ap->in[42]; args.out = ap->out; args.ws = ap->ws; \
    bf16* Wb = (bf16*)(args.ws + WS_W); bf16* XB = (bf16*)(args.ws + WS_XB); bf16* HB = (bf16*)(args.ws + WS_H); \
    float* SSQ = (float*)(args.ws + WS_SSQ); float* SSQ2 = (float*)(args.ws + WS_SSQ2); float* VSSQ = (float*)(args.ws + WS_VSSQ); \
    const LayerP P = layer_params_ct<L>((const CAS cfptr*)ap); \
    (void)Wb; (void)XB; (void)HB; (void)SSQ; (void)SSQ2; (void)VSSQ; (void)P; (void)vcu; (void)G; (void)lds;
#define PH_END_SEAM   seam_xcd(ap, lds_k); } }
#define PH_END_NOSEAM } }

template <int L> __device__ __forceinline__ void run_layer(LAS unsigned char* lds_k, int vcu0, int G0) {
    constexpr int kind = (L == 1) ? K_DIFF : (L == 2) ? K_SGU : K_GLA;
    PH_BEGIN(5) phase_conv(lds, args, P, L, vcu, G, (CONV_SPLIT && kind == K_GLA && G == 256) ? 1 : 0);
#if CG_SYNC_AT_START
    seam_xcd(ap, lds_k);
#else
    if (L == 0) { if (rep_ + 1 == nrep_) cg::this_grid().sync(); else seam_xcd(ap, lds_k); } else seam_xcd(ap, lds_k);
#endif
    PH_END_NOSEAM
    PH_BEGIN(3) { EpiIn E{kind, HB, SSQ, (kind == K_GLA) ? P.e2 : P.e0, VSSQ, (unsigned*)(args.ws + WS_CTL) + CW_QKMAX}; run_gemm(lds, XB, D, Wb + WOFF_IN, NTOK, P.nin, D, E, vcu, G);
        if constexpr (CONV_SPLIT && kind == K_GLA) { int bxo = (int)blockIdx.x; asm volatile("" : "+s"(bxo));
            if (G == 256 && bxo >= 128) { LAS unsigned char* lds2 = lds_k; asm volatile("" : "+s"(lds2)); phase_conv(lds2, args, P, L, bxo - 128, 128, 2); } } } PH_END_SEAM
    if constexpr (kind == K_GLA) {
        PH_BEGIN(4) phase_gla2_kv(lds, args, P, vcu, G); PH_END_SEAM
        PH_BEGIN(0) phase_gla2_scan(args, vcu, G); PH_END_SEAM
        PH_BEGIN(9) phase_gla2_out(lds, args, P, vcu, G, rep_ + 1 < nrep_); PH_END_SEAM
    } else if constexpr (kind == K_DIFF) {
        PH_BEGIN(7)
            if (rep_ > 0) { if (blockIdx.x == 0 && otid() == 0) __hip_atomic_store((unsigned*)(ap->ws + WS_CTL) + CW_QUEUE, 0u, RLX_AGENT); seam_xcd(ap, lds_k); }
            phase_diff_mfma((char*)lds_raw, lds, args, vcu, G);
        PH_END_SEAM
        PH_BEGIN(6) phase_diff_combine(args, P, vcu, G); PH_END_SEAM
    } else {
        PH_BEGIN(10) phase_sgu_mfma(lds, args, P, vcu, G, rep_ + 1 < nrep_); PH_END_SEAM
    }
    PH_BEGIN(L == 0 ? 8 : 0) { EpiResT<false> E{XB, SSQ2, nullptr}; run_gemm(lds, HB + P.mixoff, P.nin, Wb + WOFF_OUT, NTOK, D, D, E, vcu, G); } PH_END_SEAM
#if PROBE_KIND == 11
    PH_BEGIN(11) { EpiHid E{HB}; E.nostore = (rep_ + 1 < nrep_) ? 1 : 0; run_gemm(lds, XB, D, Wb + WOFF_1, NTOK, FF, D, E, vcu, G); } PH_END_SEAM
#else
    PH_BEGIN(2) { EpiHid E{HB}; run_gemm(lds, XB, D, Wb + WOFF_1, NTOK, FF, D, E, vcu, G); } PH_END_SEAM
#endif
    PH_BEGIN(0) { EpiResT<true> E{XB, SSQ, SSQ2}; run_gemm(lds, HB, FF, Wb + WOFF_2, NTOK, D, FF, E, vcu, G); } PH_END_SEAM
}

__global__ void __launch_bounds__(NTHR, 2) trunk_fwd(Args kargs) {
    LAS unsigned char* const lds_k = (LAS unsigned char*)lds_raw;
    const int G0 = gridDim.x; const int bx = blockIdx.x;
    const int vcu0 = (G0 % 8 == 0) ? (bx % 8) * (G0 / 8) + bx / 8 : bx;
    { const int tid = threadIdx.x;
      for (int u = tid; u < (LDS_BYTES - LDSCTL_OFF) / 4; u += NTHR) ((LAS unsigned*)(lds_k + LDSCTL_OFF))[u] = 0u;
      __syncthreads();
      if ((tid & 63) == 0) ((LAS unsigned*)(lds_k + TIDTAB_OFF))[hw_slot()] = (unsigned)(tid >> 6);
      __syncthreads(); }
    (void)xcd_barrier_post((unsigned*)(kargs.ws + WS_CTL) + 4096, (volatile LAS unsigned*)(lds_k + MISC_OFF) + 8);
#if CG_SYNC_AT_START
    cg::this_grid().sync();
#endif
    run_layer<0>(lds_k, vcu0, G0);
    run_layer<1>(lds_k, vcu0, G0);
    run_layer<2>(lds_k, vcu0, G0);
    run_layer<3>(lds_k, vcu0, G0);
    { int vcu = vcu0, G = G0; asm volatile("" : "+s"(vcu), "+s"(G));
      const CAS Args* ap = (const CAS Args*)__builtin_amdgcn_kernarg_segment_ptr(); asm volatile("" : "+s"(ap));
      Ctx args; args.in0 = ap->in[0]; args.in42 = ap->in[42]; args.out = ap->out; args.ws = ap->ws;
      phase_final(args, vcu, G); }
}

extern "C" void kernel_launch(void* const* d_in, const int* in_sizes, int n_in, void* d_out, int out_size, void* d_ws, size_t ws_size, hipStream_t stream) {
    static int grid = 0;
    if (grid == 0) {
        if (n_in != 43 || in_sizes[0] != NTOK * D || out_size != NTOK * D || ws_size < WS_END) {
            fprintf(stderr, "kernel_launch: unexpected problem (n_in %d, in0 %d, out %d, ws %zu); nothing launched\n", n_in, n_in > 0 ? in_sizes[0] : -1, out_size, ws_size); grid = -1; return; }
        int dev = 0, cus = 0, per_cu = 0;
        if (hipGetDevice(&dev) != hipSuccess || hipDeviceGetAttribute(&cus, hipDeviceAttributeMultiprocessorCount, dev) != hipSuccess) { grid = -1; return; }
        if (hipFuncSetAttribute((const void*)trunk_fwd, hipFuncAttributeMaxDynamicSharedMemorySize, LDS_BYTES) != hipSuccess) { fprintf(stderr, "kernel_launch: hipFuncSetAttribute failed\n"); grid = -1; return; }
        if (hipOccupancyMaxActiveBlocksPerMultiprocessor(&per_cu, (const void*)trunk_fwd, NTHR, LDS_BYTES) != hipSuccess || per_cu < 1) { fprintf(stderr, "kernel_launch: occupancy query says %d blocks/CU\n", per_cu); per_cu = 1; }
        (void)hipGetLastError();
        grid = cus;
    }
    if (grid < 0) return;
    (void)hipMemsetAsync((char*)d_ws + WS_CTL, 0, CTL_ZERO_BYTES, stream);
    Args a{};
    for (int i = 0; i < 43; ++i) a.in[i] = (const float*)d_in[i];
    a.out = (float*)d_out; a.ws = (unsigned char*)d_ws;
    a.ph_lo = 0; a.ph_hi = 0;
    void* kargs[] = {&a};
    hipError_t e = hipLaunchCooperativeKernel((const void*)trunk_fwd, dim3(grid), dim3(NTHR), kargs, LDS_BYTES, stream);
    if (e != hipSuccess) fprintf(stderr, "kernel_launch: cooperative launch failed: %s (grid %d)\n", hipGetErrorString(e), grid);
}
```

```cpp
#include <hip/hip_runtime.h>
#include <hip/hip_cooperative_groups.h>
#include <cstdio>
#include <cstdint>
namespace cg = cooperative_groups;


#define GAS __attribute__((address_space(1)))
#define LAS __attribute__((address_space(3)))
typedef unsigned short bf16;
typedef unsigned v4u __attribute__((ext_vector_type(4)));
typedef unsigned v2u __attribute__((ext_vector_type(2)));
typedef float f32x4 __attribute__((ext_vector_type(4)));
typedef float f32x2v __attribute__((ext_vector_type(2)));

constexpr int NB = 2, T = 8192, D = 1024, NTOK = NB * T, FF = 4096;
constexpr float EPS = 1e-6f;
constexpr float LOG2E = 1.4426950408889634f;
constexpr int NWAVES = 8, NTHR = 512;
constexpr int K_GLA = 0, K_DIFF = 1, K_SGU = 2;
constexpr int GLA_H = 4, GLA_HK = 128, GLA_HV = 256, GLA_C = 64, GLA_NC = T / GLA_C;
#ifndef GLA_RANK16
#define GLA_RANK16 0
#endif
constexpr int GLA_PITCH = GLA_RANK16 ? 3072 : 3584;
constexpr int DIFF_H = 8, DIFF_PITCH = 3072;
constexpr float LAMBDA_INIT = 0.35551069f;
constexpr int SGU_PITCH = 2048, SGU_C = 128, SGU_G = 8;

constexpr size_t MiB = 1u << 20;
constexpr size_t WS_CTL = 0, CTL_ZERO_BYTES = 64 * 1024;
constexpr size_t WS_SSQ = 1 * MiB;
constexpr size_t WS_VSSQ = 2 * MiB;
constexpr size_t WS_R = 2 * MiB;
constexpr size_t WS_DEC = 3 * MiB;
constexpr size_t WS_W = 4 * MiB;
constexpr size_t WS_XB = 29 * MiB;
constexpr size_t WS_STATE = 61 * MiB;
constexpr size_t WS_H = 125 * MiB;
constexpr size_t WS_SSQ2 = 253 * MiB;
constexpr size_t WS_END = 254 * MiB;
constexpr int CW_QKMAX = 8192;
constexpr int CW_QUEUE = 8448;
constexpr size_t WOFF_IN = 0, WOFF_OUT = (size_t)3584 * 1024, WOFF_1 = WOFF_OUT + (size_t)1024 * 1024, WOFF_2 = WOFF_1 + (size_t)4096 * 1024;

#ifndef CG_SYNC_AT_START
#define CG_SYNC_AT_START 1
#endif
#ifndef ATTN_SREF
#define ATTN_SREF 1
#endif
#ifndef CONV_SPLIT
#define CONV_SPLIT 1
#endif
#ifndef PROBE_KIND
#define PROBE_KIND 0
#endif
#ifndef PROBE_REP
#define PROBE_REP 2
#endif
constexpr int RING_BYTES = 131072, LDSCTL_OFF = RING_BYTES, MISC_OFF = LDSCTL_OFF + 320, LDS_BYTES = 147456;

#define RLX_AGENT __ATOMIC_RELAXED, __HIP_MEMORY_SCOPE_AGENT
#define LDS_WAIT() asm volatile("s_waitcnt lgkmcnt(0)" ::: "memory")
__device__ __forceinline__ unsigned f2bf(float f) { unsigned u = __builtin_bit_cast(unsigned, f); return (u + 0x7fffu + ((u >> 16) & 1u)) >> 16; }
typedef float pk_f32x2 __attribute__((ext_vector_type(2))); typedef __bf16 pk_bf16x2 __attribute__((ext_vector_type(2)));
__device__ __forceinline__ unsigned pk2(float lo, float hi) { pk_f32x2 v = {lo, hi}; pk_bf16x2 b = __builtin_convertvector(v, pk_bf16x2); return __builtin_bit_cast(unsigned, b); }
__device__ __forceinline__ float bf2f(unsigned b) { return __builtin_bit_cast(float, b << 16); }
__device__ __forceinline__ float bflo(unsigned w) { return __builtin_bit_cast(float, w << 16); }
__device__ __forceinline__ float bfhi(unsigned w) { return __builtin_bit_cast(float, w & 0xffff0000u); }
extern __shared__ __attribute__((aligned(16))) unsigned char lds_raw[];
constexpr int TIDTAB_OFF = 131072;
__device__ __forceinline__ unsigned hw_slot() { return (unsigned)__builtin_amdgcn_s_getreg((5 << 11) | 4) & 63u; }
__device__ __forceinline__ int otid() {
    const int wv = (int)((volatile __attribute__((address_space(3))) unsigned*)((__attribute__((address_space(3))) unsigned char*)lds_raw + TIDTAB_OFF))[hw_slot()];
    int ln; asm volatile("v_mbcnt_lo_u32_b32 %0, -1, 0\n\tv_mbcnt_hi_u32_b32 %0, -1, %0" : "=v"(ln));
    int t = wv * 64 + ln;
    asm volatile("" : "+v"(t)); return t; }
#ifndef EPI_SC1
#define EPI_SC1 0
#endif
__device__ __forceinline__ void store16(void* p, v4u v) {
#if EPI_SC1
    asm volatile("global_store_dwordx4 %0, %1, off sc1\n\ts_nop 1" :: "v"(p), "v"(v) : "memory");
#else
    *(v4u*)p = v;
#endif
}
__device__ __forceinline__ float xl_1(float v)  { return __int_as_float(__builtin_amdgcn_mov_dpp(__float_as_int(v), 0xB1, 0xF, 0xF, true)); }
__device__ __forceinline__ float xl_2(float v)  { return __int_as_float(__builtin_amdgcn_mov_dpp(__float_as_int(v), 0x4E, 0xF, 0xF, true)); }
__device__ __forceinline__ float xl_4(float v)  { return __int_as_float(__builtin_amdgcn_mov_dpp(__float_as_int(v), 0x141, 0xF, 0xF, true)); }
__device__ __forceinline__ float xl_8(float v)  { return __int_as_float(__builtin_amdgcn_mov_dpp(__float_as_int(v), 0x140, 0xF, 0xF, true)); }
__device__ __forceinline__ float sum_x16(float v) { auto r = __builtin_amdgcn_permlane16_swap(__float_as_uint(v), __float_as_uint(v), false, false); return __uint_as_float(r[0]) + __uint_as_float(r[1]); }
__device__ __forceinline__ float sum_x32(float v) { auto r = __builtin_amdgcn_permlane32_swap(__float_as_uint(v), __float_as_uint(v), false, false); return __uint_as_float(r[0]) + __uint_as_float(r[1]); }
__device__ __forceinline__ float max_x16(float v) { auto r = __builtin_amdgcn_permlane16_swap(__float_as_uint(v), __float_as_uint(v), false, false); return fmaxf(__uint_as_float(r[0]), __uint_as_float(r[1])); }
__device__ __forceinline__ float max_x32(float v) { auto r = __builtin_amdgcn_permlane32_swap(__float_as_uint(v), __float_as_uint(v), false, false); return fmaxf(__uint_as_float(r[0]), __uint_as_float(r[1])); }
__device__ __forceinline__ float sum_lanes8(float v)  { v += xl_1(v); v += xl_2(v); v += xl_4(v); return v; }
__device__ __forceinline__ float sum_lanes32(float v) { v = sum_lanes8(v); v += xl_8(v); return sum_x16(v); }
__device__ __forceinline__ float wave_sum(float v) { return sum_x32(sum_lanes32(v)); }
__device__ __forceinline__ float wave_max(float v) { v = fmaxf(v, xl_1(v)); v = fmaxf(v, xl_2(v)); v = fmaxf(v, xl_4(v)); v = fmaxf(v, xl_8(v)); return max_x32(max_x16(v)); }
__device__ __forceinline__ float gelu_tanh(float x) {
    const float u = 0.7978845608028654f * (x + 0.044715f * x * x * x);
    const float e = __builtin_amdgcn_exp2f(u * (2.f * LOG2E));
    return x - x * __builtin_amdgcn_rcpf(e + 1.f);
}
__device__ __forceinline__ float log_sigmoid(float z) { return fminf(z, 0.f) - 0.6931471805599453f * __builtin_amdgcn_logf(1.0f + __builtin_amdgcn_exp2f(-fabsf(z) * LOG2E)); }

#define XB_TMO      128
#define XB_XCNT(j)  (256  + 64 * (j))
#define XB_XSUB(j)  (1280 + 64 * (j))
#define XB_XGEN(j)  (2304 + 64 * (j))
#define XB_TOP      3328
#define XB_TOPGEN   3392
#define XCD_BAR_WORDS 3456
#define XB_SPIN_CAP (1u << 22)
__device__ __forceinline__ unsigned xb_ld(unsigned* p)              { return __hip_atomic_load(p, __ATOMIC_RELAXED, __HIP_MEMORY_SCOPE_AGENT); }
__device__ __forceinline__ unsigned xb_add(unsigned* p, unsigned v) { return __hip_atomic_fetch_add(p, v, __ATOMIC_RELAXED, __HIP_MEMORY_SCOPE_AGENT); }
__device__ __forceinline__ unsigned xb_xcc_id() { return (unsigned)__builtin_amdgcn_s_getreg((3 << 11) | 20) & 0xFu; }
#define XB_SPIN(cond, bar) do { unsigned _sp = 0; while (cond) { __builtin_amdgcn_s_sleep(1); \
    if ((++_sp & 255u) == 0u) { if (xb_ld(&(bar)[XB_TMO])) break; if (_sp > XB_SPIN_CAP) { atomicAdd(&(bar)[XB_TMO], 1u); break; } } } } while (0)
struct XcdBarrier { unsigned* bar; unsigned x; volatile LAS unsigned* st; };
__device__ __forceinline__ XcdBarrier xcd_barrier_post(unsigned* bar, volatile LAS unsigned* st) {
    XcdBarrier b; b.bar = bar; b.x = xb_xcc_id(); b.st = st;
    if (threadIdx.x == 0) (void)xb_add(&bar[XB_XCNT(b.x)], 1u);
    return b;
}
__device__ __forceinline__ void xcd_barrier_complete(unsigned* bar, unsigned x, unsigned& nloc, unsigned& nx) {
    const unsigned G = gridDim.x * gridDim.y * gridDim.z;
    unsigned sum, cnt, mine, sp = 0u;
    for (;;) {
        sum = 0u; cnt = 0u; mine = 0u;
#pragma unroll
        for (unsigned j = 0; j < 16; ++j) { const unsigned c = xb_ld(&bar[XB_XCNT(j)]); sum += c; cnt += (c > 0u) ? 1u : 0u; mine = (j == x) ? c : mine; }
        if (sum == G) break;
        __builtin_amdgcn_s_sleep(1);
        if ((++sp & 255u) == 0u) { if (xb_ld(&bar[XB_TMO])) break; if (sp > XB_SPIN_CAP) { atomicAdd(&bar[XB_TMO], 1u); break; } }
    }
    nloc = mine > 0u ? mine : 1u; nx = cnt > 0u ? cnt : 1u;
}
__device__ __forceinline__ void xcd_barrier(const XcdBarrier& b) {
    asm volatile("s_waitcnt vmcnt(0)" ::: "memory");
    __syncthreads();
    if (otid() == 0) {
        unsigned* bar = b.bar;
        __builtin_amdgcn_s_waitcnt(0);
        unsigned nloc = b.st[0], nx = b.st[1];
        if (nloc == 0u) { xcd_barrier_complete(bar, b.x, nloc, nx); b.st[0] = nloc; b.st[1] = nx; }
        const unsigned old = xb_add(&bar[XB_XSUB(b.x)], 1u);
        const unsigned gen = old / nloc;
        if (old + 1u == (gen + 1u) * nloc) {
            __builtin_amdgcn_fence(__ATOMIC_RELEASE, "agent");
            asm volatile("s_waitcnt vmcnt(0)" ::: "memory");
            const unsigned og = xb_add(&bar[XB_TOP], 1u);
            const unsigned tg = og / nx;
            if (og + 1u == (tg + 1u) * nx) xb_add(&bar[XB_TOPGEN], 1u);
            else XB_SPIN(xb_ld(&bar[XB_TOPGEN]) == tg, bar);
            __builtin_amdgcn_fence(__ATOMIC_ACQUIRE, "agent");
            xb_add(&bar[XB_XGEN(b.x)], 1u);
            asm volatile("s_waitcnt vmcnt(0)" ::: "memory");
        } else {
            XB_SPIN(xb_ld(&bar[XB_XGEN(b.x)]) == gen, bar);
            __builtin_amdgcn_fence(__ATOMIC_ACQUIRE, "agent");
            asm volatile("s_waitcnt vmcnt(0)" ::: "memory");
        }
    }
    __syncthreads();
}

struct Args { const float* in[43]; float* out; unsigned char* ws; int ph_lo, ph_hi; };
struct Ctx { const float* in0; const float* in42; float* out; unsigned char* ws; };
struct LayerP {
    int kind;
    const float *norm1, *w_in, *w_out, *norm2, *w1, *w2;
    const float *e0, *e1, *e2, *e3, *e4;
    int nin;
    int mixoff;
};
typedef const float* cfptr;
#define CAS __attribute__((address_space(4)))
__device__ __forceinline__ float row_rstd(const float* ssq, int row) {
    const f32x4* p = (const f32x4*)(ssq + (size_t)row * 16);
    const f32x4 a = p[0], b = p[1], c = p[2], d = p[3];
    const float s = ((a.x + a.y) + (a.z + a.w)) + ((b.x + b.y) + (b.z + b.w)) + ((c.x + c.y) + (c.z + c.w)) + ((d.x + d.y) + (d.z + d.w));
    return __builtin_amdgcn_rsqf(s * (1.0f / D) + EPS);
}

typedef float f2 __attribute__((ext_vector_type(2)));
__device__ __forceinline__ unsigned pk2v(f2 t) { pk_bf16x2 b = __builtin_convertvector(t, pk_bf16x2); return __builtin_bit_cast(unsigned, b); }
__device__ __forceinline__ f2 f2s(float x) { return (f2){x, x}; }
__device__ __forceinline__ void store16o(const void* base, size_t off_bytes, v4u v) {
    __builtin_amdgcn_raw_buffer_store_b128(v, __builtin_amdgcn_make_buffer_rsrc((void*)base, 0, 0x7fffffff, 0x00020000), (int)off_bytes, 0, 0);
}
__device__ __forceinline__ f2 gelu_tanh2(f2 x) {
    const f2 x2 = x * x;
    const f2 p = x2 * f2s(0.044715f * 0.7978845608028654f * 2.f * LOG2E) + f2s(0.7978845608028654f * 2.f * LOG2E);
    const f2 arg = x * p;
    const f2 e = (f2){__builtin_amdgcn_exp2f(arg.x), __builtin_amdgcn_exp2f(arg.y)} + f2s(1.f);
    const f2 r = (f2){__builtin_amdgcn_rcpf(e.x), __builtin_amdgcn_rcpf(e.y)};
    return x - x * r;
}
struct EpiIn {
    int kind; bf16* proj; const float* ssq; const float* bias;
    float* vssq;
    static constexpr bool NEEDS_RS = true;
    __device__ __forceinline__ float apply8(int row, int col0, const float (&v)[8], float rs) const {
        f2 t[4] = {(f2){v[0], v[1]}, (f2){v[2], v[3]}, (f2){v[4], v[5]}, (f2){v[6], v[7]}};
        f2 part2 = f2s(0.f); int pitch;
        if (kind == K_GLA) { pitch = GLA_PITCH;
            if (col0 < 3072) {
#pragma unroll
                for (int j = 0; j < 4; ++j) t[j] = t[j] * f2s(rs);
            } else {
#pragma unroll
                for (int j = 0; j < 4; ++j) { const f2 bb = *(const LAS f2*)(bias_lds + col0 - 3072 + 2 * j); const f2 z = t[j] * f2s(rs) + bb;
                    t[j] = (f2){log_sigmoid(z.x), log_sigmoid(z.y)} * f2s(1.0f / 16.0f); }
            }
        } else if (kind == K_DIFF) { pitch = DIFF_PITCH;
            const float sc = (col0 < 1024) ? rs * (0.125f * LOG2E) : rs;
#pragma unroll
            for (int j = 0; j < 4; ++j) t[j] = t[j] * f2s(sc);
            if (col0 < 2048) {
#pragma unroll
                for (int j = 0; j < 4; ++j) part2 += t[j] * t[j];
            }
        } else { pitch = SGU_PITCH;
#pragma unroll
            for (int j = 0; j < 4; ++j) { const f2 bb = *(const LAS f2*)(bias_lds + col0 + 2 * j); t[j] = gelu_tanh2(t[j] * f2s(rs) + bb); }
            if (col0 >= 1024) {
#pragma unroll
                for (int j = 0; j < 4; ++j) part2 += t[j] * t[j];
            }
        }
        v4u w; w.x = pk2v(t[0]); w.y = pk2v(t[1]); w.z = pk2v(t[2]); w.w = pk2v(t[3]);
        store16o(proj, ((size_t)row * pitch + col0) * 2, w);
        return part2.x + part2.y;
    }
    __device__ __forceinline__ void store_part(int row, int col0, int idx, float part) const {
        if (kind == K_SGU && col0 >= 1024) vssq[(size_t)row * 16 + idx] = part;
    }
    static constexpr bool GROUPMAX = true;
    unsigned* qkmax;
    const LAS float* rs_tab = nullptr; int rs_row0 = -1;
    const LAS float* bias_lds = nullptr;
    static constexpr bool HAS_BIAS = true;
    __device__ __forceinline__ int bias_count() const { return kind == K_GLA ? 512 : (kind == K_SGU ? 2048 : 0); }
    __device__ __forceinline__ bool want_groupmax(int col0) const { return kind == K_DIFF && col0 < 2048; }
    __device__ __forceinline__ void store_groupmax(int row, int col0, float m) const {
        atomicMax(qkmax + (row >> 13) * 64 + (col0 >> 5), __float_as_uint(m * 1.01f));
    }
};
struct EpiHid {
    bf16* h;
    int nostore = 0;
    static constexpr bool NEEDS_RS = false; static constexpr bool HAS_BIAS = false;
    __device__ __forceinline__ float apply8(int row, int col0, const float (&v)[8], float) const {
        f2 t[4];
#pragma unroll
        for (int j = 0; j < 4; ++j) { const f2 a = {__int_as_float(max(__float_as_int(v[2 * j]), 0)), __int_as_float(max(__float_as_int(v[2 * j + 1]), 0))}; t[j] = a * a; }
        v4u w; w.x = pk2v(t[0]); w.y = pk2v(t[1]); w.z = pk2v(t[2]); w.w = pk2v(t[3]);
#if PROBE_KIND == 11
        if (nostore) { asm volatile("" :: "v"(w.x), "v"(w.y), "v"(w.z), "v"(w.w)); return 0.f; }
#endif
        store16o(h, ((size_t)row * FF + col0) * 2, w);
        return 0.f;
    }
    __device__ __forceinline__ void store_part(int, int, int, float) const {}
    static constexpr bool GROUPMAX = false;
    __device__ __forceinline__ bool want_groupmax(int) const { return false; }
    __device__ __forceinline__ void store_groupmax(int, int, float) const {}
};
template <bool RS2> struct EpiResT {
    bf16* xb; float* ssq_out; const float* ssq;
    const LAS float* rs_tab = nullptr; int rs_row0 = -1;
    static constexpr bool NEEDS_RS = RS2; static constexpr bool HAS_BIAS = false;
    __device__ __forceinline__ float apply8(int row, int col0, const float (&v)[8], float rs) const {
        const size_t off = (size_t)row * D + col0;
        const v4u bw = *(const v4u*)(xb + off);
        const f2 s2 = f2s(RS2 ? rs * rs : 1.f);
        const unsigned bwv[4] = {bw.x, bw.y, bw.z, bw.w};
        f2 o[4]; f2 part2 = f2s(0.f);
#pragma unroll
        for (int j = 0; j < 4; ++j) { const f2 x = {bflo(bwv[j]), bfhi(bwv[j])}; const f2 a = {v[2 * j], v[2 * j + 1]};
            o[j] = RS2 ? (a * s2 + x) : (a + x); part2 += o[j] * o[j]; }
        v4u w; w.x = pk2v(o[0]); w.y = pk2v(o[1]); w.z = pk2v(o[2]); w.w = pk2v(o[3]);
        store16o(xb, off * 2, w);
        return part2.x + part2.y;
    }
    __device__ __forceinline__ void store_part(int row, int, int idx, float part) const { ssq_out[(size_t)row * 16 + idx] = part; }
    static constexpr bool GROUPMAX = false;
    __device__ __forceinline__ bool want_groupmax(int) const { return false; }
    __device__ __forceinline__ void store_groupmax(int, int, float) const {}
};

struct ConvItem { const float* W; const float* gain; bf16* WT; int K, N, tile; };
struct ConvRegs { f32x4 w[8]; float g[8]; };
__device__ __forceinline__ void conv_load(ConvRegs& R, const ConvItem& it, int tid) {
    const int nblk = it.N >> 7, kb = it.tile / nblk, nb = it.tile - kb * nblk, k0 = kb << 7, n0 = nb << 7;
    const int n4 = tid & 31, kk = tid >> 5;
    const float* src = it.W + (size_t)(k0 + 8 * kk) * it.N + n0 + 4 * n4;
#pragma unroll
    for (int p = 0; p < 8; ++p) R.w[p] = __builtin_nontemporal_load((const f32x4*)(src + (size_t)p * it.N));
    if (it.gain) { const f32x4 g0 = *(const f32x4*)(it.gain + k0 + 8 * kk), g1 = *(const f32x4*)(it.gain + k0 + 8 * kk + 4);
        R.g[0] = g0.x; R.g[1] = g0.y; R.g[2] = g0.z; R.g[3] = g0.w; R.g[4] = g1.x; R.g[5] = g1.y; R.g[6] = g1.z; R.g[7] = g1.w; }
    else {
#pragma unroll
        for (int p = 0; p < 8; ++p) R.g[p] = 1.f; }
}
__device__ __forceinline__ void conv_store(const ConvRegs& R, const ConvItem& it, LAS unsigned char* img, int tid) {
    const int nblk = it.N >> 7, kb = it.tile / nblk, nb = it.tile - kb * nblk, k0 = kb << 7, n0 = nb << 7;
    const int n4 = tid & 31, kk = tid >> 5;
#pragma unroll
    for (int jn = 0; jn < 4; ++jn) {
        v4u o; o.x = pk2(R.g[0] * R.w[0][jn], R.g[1] * R.w[1][jn]); o.y = pk2(R.g[2] * R.w[2][jn], R.g[3] * R.w[3][jn]); o.z = pk2(R.g[4] * R.w[4][jn], R.g[5] * R.w[5][jn]); o.w = pk2(R.g[6] * R.w[6][jn], R.g[7] * R.w[7][jn]);
        *(LAS v4u*)(img + (4 * n4 + jn) * 256 + ((kk ^ (n4 & 15)) << 4)) = o; }
    __syncthreads();
#pragma unroll
    for (int i = 0; i < 4; ++i) { const int c = tid + NTHR * i, n = c >> 4, kc = c & 15;
        const v4u o = *(const LAS v4u*)(img + n * 256 + ((kc ^ ((n >> 2) & 15)) << 4));
        *(v4u*)(it.WT + (size_t)(n0 + n) * it.K + k0 + 8 * kc) = o; }
    __syncthreads();
}

__device__ __forceinline__ void phase_conv(LAS unsigned char* lds, const Ctx& a, const LayerP& P, int L, int vcu, int G, int part = 0) {
    const int tid = otid(), lane = tid & 63, wave = __builtin_amdgcn_readfirstlane(tid >> 6);
    bf16* Wb = (bf16*)(a.ws + WS_W);
    const int gw = vcu * NWAVES + wave, NGW = G * NWAVES;
    const int nin_w = (P.kind == K_SGU) ? 2048 : 3072;
    const int I_IN = (D / 128) * (nin_w / 128), I_OUT = (D / 128) * (D / 128), I_1 = (D / 128) * (FF / 128), I_2 = (FF / 128) * (D / 128);
    const int NITEMS = I_IN + I_OUT + I_1 + I_2;
    auto item_of = [&](int it) { ConvItem c; int r = it;
        if (r < I_IN) { c.W = P.w_in; c.gain = P.norm1; c.WT = Wb + WOFF_IN; c.K = D; c.N = nin_w; c.tile = r; return c; } r -= I_IN;
        if (r < I_OUT) { c.W = P.w_out; c.gain = nullptr; c.WT = Wb + WOFF_OUT; c.K = D; c.N = D; c.tile = r; return c; } r -= I_OUT;
        if (r < I_1) { c.W = P.w1; c.gain = P.norm2; c.WT = Wb + WOFF_1; c.K = D; c.N = FF; c.tile = r; return c; } r -= I_1;
        c.W = P.w2; c.gain = nullptr; c.WT = Wb + WOFF_2; c.K = FF; c.N = D; c.tile = r; return c; };
    const int it_lo = (part == 2) ? I_IN : 0, it_hi = (part == 1) ? I_IN : NITEMS;
    if (it_lo + vcu < it_hi) {
        int it = it_lo + vcu;
        ConvItem c0 = item_of(it), c1 = c0, c2 = c0; ConvRegs r0, r1, r2;
        conv_load(r0, c0, tid);
        if (it + G < it_hi) { c1 = item_of(it + G); conv_load(r1, c1, tid); } else r1 = r0;
        if (it + 2 * G < it_hi) { c2 = item_of(it + 2 * G); conv_load(r2, c2, tid); } else r2 = r0;
        for (; it < it_hi; it += G) {
            conv_store(r0, c0, lds, tid);
            r0 = r1; c0 = c1; r1 = r2; c1 = c2;
            if (it + 3 * G < it_hi) { c2 = item_of(it + 3 * G); conv_load(r2, c2, tid); }
        }
    }
    if (part == 2) return;
#if GLA_RANK16
    if (P.kind == K_GLA) {
        typedef short cbf16x8 __attribute__((ext_vector_type(8)));
        LAS unsigned char* WgT = lds + 32768;
        { const float* W1 = P.e0;
          for (int k = tid; k < 1024; k += NTHR) { const float gk = P.norm1[k];
              const f32x4 w0 = *(const f32x4*)(W1 + k * 16), w1 = *(const f32x4*)(W1 + k * 16 + 4), w2 = *(const f32x4*)(W1 + k * 16 + 8), w3 = *(const f32x4*)(W1 + k * 16 + 12);
              const float wv[16] = {w0.x, w0.y, w0.z, w0.w, w1.x, w1.y, w1.z, w1.w, w2.x, w2.y, w2.z, w2.w, w3.x, w3.y, w3.z, w3.w};
#pragma unroll
              for (int r = 0; r < 16; ++r) *(LAS bf16*)(WgT + r * 2064 + k * 2) = (bf16)f2bf(gk * wv[r]); } }
        __syncthreads();
        float* R = (float*)(a.ws + WS_R); const bf16* xbr = (const bf16*)(a.ws + WS_XB);
        const int n16 = lane & 15, kq = lane >> 4;
        for (int tile = gw; tile < NTOK / 16; tile += NGW) {
            const int row = tile * 16 + n16;
            f32x4 acc = {0.f, 0.f, 0.f, 0.f}; float sq = 0.f;
#pragma unroll 4
            for (int ks = 0; ks < 32; ++ks) {
                v4u aw;
                if (L == 0) { const f32x4 x0 = *(const f32x4*)(a.in0 + (size_t)row * D + 32 * ks + 8 * kq), x1 = *(const f32x4*)(a.in0 + (size_t)row * D + 32 * ks + 8 * kq + 4);
                    sq += (x0.x * x0.x + x0.y * x0.y) + (x0.z * x0.z + x0.w * x0.w) + (x1.x * x1.x + x1.y * x1.y) + (x1.z * x1.z + x1.w * x1.w);
                    aw.x = pk2(x0.x, x0.y); aw.y = pk2(x0.z, x0.w); aw.z = pk2(x1.x, x1.y); aw.w = pk2(x1.z, x1.w); }
                else { aw = *(const v4u*)(xbr + (size_t)row * D + 32 * ks + 8 * kq);
                    const float e[8] = {bflo(aw.x), bfhi(aw.x), bflo(aw.y), bfhi(aw.y), bflo(aw.z), bfhi(aw.z), bflo(aw.w), bfhi(aw.w)};
#pragma unroll
                    for (int j = 0; j < 8; ++j) sq += e[j] * e[j]; }
                const cbf16x8 bfr = *(const LAS cbf16x8*)(WgT + n16 * 2064 + (32 * ks + 8 * kq) * 2);
                acc = __builtin_amdgcn_mfma_f32_16x16x32_bf16(__builtin_bit_cast(cbf16x8, aw), bfr, acc, 0, 0, 0);
            }
            sq += __shfl_xor(sq, 16); sq += __shfl_xor(sq, 32);
            const float rstd = __builtin_amdgcn_rsqf(sq * (1.0f / D) + EPS);
#pragma unroll
            for (int rg = 0; rg < 4; ++rg) { const float rr = __shfl(rstd, 4 * kq + rg);
                R[(size_t)(tile * 16 + 4 * kq + rg) * 16 + n16] = acc[rg] * rr; }
        }
    }
#else
    if (P.kind == K_GLA) {
        const float* W1 = P.e0; const float* W2 = P.e1;
        for (int e = vcu * NTHR + tid; e < 512 * 1024; e += G * NTHR) {
            const int n = e >> 10, k = e & 1023;
            float s = 0.f;
#pragma unroll
            for (int r = 0; r < 16; ++r) s += W1[k * 16 + r] * W2[r * 512 + n];
            Wb[WOFF_IN + (size_t)(3072 + n) * 1024 + k] = (bf16)f2bf(s * P.norm1[k]);
        }
    }
#endif
    if (L == 0) {
        const float* x = a.in0; bf16* xb = (bf16*)(a.ws + WS_XB); float* ssq = (float*)(a.ws + WS_SSQ);
        for (int m0 = gw; m0 < NTOK; m0 += 2 * NGW) {
            const int m1 = (m0 + NGW < NTOK) ? m0 + NGW : m0;
            f32x4 v[2][4];
#pragma unroll
            for (int j = 0; j < 4; ++j) v[0][j] = __builtin_nontemporal_load((const f32x4*)(x + (size_t)m0 * D) + lane + 64 * j);
#pragma unroll
            for (int j = 0; j < 4; ++j) v[1][j] = __builtin_nontemporal_load((const f32x4*)(x + (size_t)m1 * D) + lane + 64 * j);
#pragma unroll
            for (int q = 0; q < 2; ++q) { const int m = q ? m1 : m0; if (q && m1 == m0) break;
                float s = 0.f;
#pragma unroll
                for (int j = 0; j < 4; ++j) s += (v[q][j].x * v[q][j].x + v[q][j].y * v[q][j].y) + (v[q][j].z * v[q][j].z + v[q][j].w * v[q][j].w);
                s = wave_sum(s);
                v2u* o8 = (v2u*)(xb + (size_t)m * D) + lane;
#pragma unroll
                for (int j = 0; j < 4; ++j) { v2u w; w.x = pk2(v[q][j].x, v[q][j].y); w.y = pk2(v[q][j].z, v[q][j].w); o8[64 * j] = w; }
                if (lane < 16) ssq[(size_t)m * 16 + lane] = (lane == 0) ? s : 0.f; }
        }
    }
}

__device__ __forceinline__ void phase_final(const Ctx& a, int vcu, int G) {
    const int tid = otid(), lane = tid & 63, wave = tid >> 6;
    const int gw = vcu * NWAVES + wave, NGW = G * NWAVES;
    const float* ssq = (const float*)(a.ws + WS_SSQ); const float* g = a.in42; const bf16* xb = (const bf16*)(a.ws + WS_XB);
    const f32x4* gr = (const f32x4*)g;
    for (int m0 = gw; m0 < NTOK; m0 += 2 * NGW) {
        const int m1 = (m0 + NGW < NTOK) ? m0 + NGW : m0;
        v4u w[2][2]; f32x4 sq[2][4];
#pragma unroll
        for (int q = 0; q < 2; ++q) { const int m = q ? m1 : m0;
            const v4u* xr = (const v4u*)(xb + (size_t)m * D) + lane;
            w[q][0] = xr[0]; w[q][1] = xr[64];
            const f32x4* sp = (const f32x4*)(ssq + (size_t)m * 16); sq[q][0] = sp[0]; sq[q][1] = sp[1]; sq[q][2] = sp[2]; sq[q][3] = sp[3]; }
#pragma unroll
        for (int q = 0; q < 2; ++q) { const int m = q ? m1 : m0; if (q && m1 == m0) break;
            const f32x4 a_ = sq[q][0], b_ = sq[q][1], c_ = sq[q][2], d_ = sq[q][3];
            const float ssum = ((a_.x + a_.y) + (a_.z + a_.w)) + ((b_.x + b_.y) + (b_.z + b_.w)) + ((c_.x + c_.y) + (c_.z + c_.w)) + ((d_.x + d_.y) + (d_.z + d_.w));
            const float rs = __builtin_amdgcn_rsqf(ssum * (1.0f / D) + EPS);
            f32x4* orow = (f32x4*)(a.out + (size_t)m * D);
#pragma unroll
            for (int jj = 0; jj < 2; ++jj) { const v4u ww = w[q][jj]; const int c4 = (64 * jj + lane) * 2;
                const f32x4 g0 = gr[c4], g1 = gr[c4 + 1];
                __builtin_nontemporal_store((f32x4){bflo(ww.x) * rs * g0.x, bfhi(ww.x) * rs * g0.y, bflo(ww.y) * rs * g0.z, bfhi(ww.y) * rs * g0.w}, orow + c4);
                __builtin_nontemporal_store((f32x4){bflo(ww.z) * rs * g1.x, bfhi(ww.z) * rs * g1.y, bflo(ww.w) * rs * g1.z, bfhi(ww.w) * rs * g1.w}, orow + c4 + 1); } }
    }
}

struct GlaCum { float b0[8], b1[8], tot0, tot1; };

#ifndef GEMM_RELAX_SEAM
#define GEMM_RELAX_SEAM 1
#endif
namespace pg8 {
#define PG8_LAS __attribute__((address_space(3)))
typedef unsigned short bf16_t;
typedef short bf16x8 __attribute__((ext_vector_type(8)));
typedef float f32x4 __attribute__((ext_vector_type(4)));
typedef unsigned u32x4 __attribute__((ext_vector_type(4)));
constexpr int BM = 256, BK = 64, HALF = 128, HTB = HALF * BK * 2  , STAGE_BYTES = 8 * HTB, NXCD = 8, WGM = 8;

__host__ __device__ __forceinline__ int lds_byte(int r, int c) { const int st = (r >> 4) * 2 + (c >> 5), rr = r & 15, cc = c & 31, ob = rr * 64 + cc * 2; return st * 1024 + (ob ^ (((ob >> 9) & 1) << 5)); }
__host__ __device__ __forceinline__ void stage_rc(int b, int& R, int& C) { const int st = b / 1024, sb = b % 1024, swz = sb ^ (((sb >> 9) & 1) << 5); R = (st >> 1) * 16 + swz / 64; C = (st & 1) * 32 + (swz % 64) / 2; }
__host__ __device__ __forceinline__ int perm32(int rho) { const int n = rho >> 4, i = rho & 15; return 8 * (i >> 2) + 4 * n + (i & 3); }

struct Unit { int pm, pn; };
struct Gemm { const bf16_t* A; int lda; const bf16_t* Bt; int M, N, K; };

struct StaticOrder {
    int nM, nN, nwg, G, c;
    __host__ __device__ void init(int M, int N, int G_, int c_) { nM = M / BM; nN = N / BM; nwg = nM * nN; G = G_; c = c_; }
    __host__ __device__ bool next(int i, Unit& u) const {
        const long L = (long)i * G + c; if (L >= nwg) return false;
        int wgid = (int)L; { const int q = nwg / NXCD, r = nwg % NXCD, xcd = wgid % NXCD, off = wgid / NXCD; wgid = (xcd < r ? xcd * (q + 1) : r * (q + 1) + (xcd - r) * q) + off; }
        const int nig = WGM * nN, gid = wgid / nig, fm = gid * WGM, gsz = (nM - fm) < WGM ? (nM - fm) : WGM;
        u.pm = fm + ((wgid % nig) % gsz); u.pn = (wgid % nig) / gsz; return true;
    }
    __device__ __forceinline__ void a_ready(const Unit&) const {}
    __device__ __forceinline__ void done(const Unit&) const {}
};

struct NoPre { __device__ __forceinline__ void operator()() const {} };
template <class Epi, class Sched, bool ALIGN_EPI = false, bool SP2 = false, class Pre = NoPre>
__device__ __forceinline__ void gemm_phase(PG8_LAS unsigned char* lds, const Gemm g, const Sched& S, const Epi& E, const Pre& pre = Pre()) {
    const int tid = otid(), wid = __builtin_amdgcn_readfirstlane(tid >> 6), lane = tid & 63, wr = wid >> 2, wc = wid & 3, fr = lane & 15, fq = lane >> 4;
    const int K = g.K, nt = K / BK, lda = g.lda;
    unsigned voffA[2], voffB[2];
#pragma unroll
    for (int i = 0; i < 2; ++i) { int R, C; stage_rc(tid * 16 + i * 8192, R, C); const int Rb = Epi::PERM ? ((R & ~31) + perm32(R & 31)) : R;
        voffA[i] = (unsigned)(R * lda + C) * 2u; voffB[i] = (unsigned)(Rb * K + C) * 2u; }
    const unsigned kstep = (unsigned)(BK * 2);
    const unsigned hstepA = (unsigned)HALF * lda * 2, hstepB = (unsigned)HALF * K * 2;
    const unsigned tstepA = 2 * hstepA, tstepB = 2 * hstepB;
    const __amdgpu_buffer_rsrc_t rsA = __builtin_amdgcn_make_buffer_rsrc((void*)g.A, 0, 0x7fffffff, 0x00020000), rsB = __builtin_amdgcn_make_buffer_rsrc((void*)g.Bt, 0, 0x7fffffff, 0x00020000);
    const unsigned ldsw = (unsigned)wid * 1024u;
    const int aoff = lds_byte(wr * 64 + fr, fq * 8), boff = lds_byte(wc * 32 + fr, fq * 8);
#define PG8_SA(b, h) (((b) * 2 + (h)) * HTB)
#define PG8_SB(b, h) ((4 + (b) * 2 + (h)) * HTB)
#define PG8_STAGE(bufoff, goff, voff) do { _Pragma("unroll") for (int _i = 0; _i < 2; ++_i) \
        __builtin_amdgcn_raw_ptr_buffer_load_lds(((bufoff) >= 4 * HTB) ? rsB : rsA, (PG8_LAS unsigned*)(lds + (bufoff) + ldsw + _i * 8192), 16, (int)(voff)[_i], (int)(goff), 0, 0); } while (0)
#define PG8_LDA(dst, b, h) do { _Pragma("unroll") for (int m = 0; m < 4; ++m) _Pragma("unroll") for (int k = 0; k < 2; ++k) dst[m][k] = *(const PG8_LAS bf16x8*)(lds + PG8_SA(b, h) + aoff + m * 2048 + k * 1024); } while (0)
#define PG8_LDB(dst, b, h) do { _Pragma("unroll") for (int n = 0; n < 2; ++n) _Pragma("unroll") for (int k = 0; k < 2; ++k) dst[n][k] = *(const PG8_LAS bf16x8*)(lds + PG8_SB(b, h) + boff + n * 2048 + k * 1024); } while (0)
#define PG8_MMA(ai, bj, At, Bt) do { __builtin_amdgcn_s_setprio(1); _Pragma("unroll") for (int m = 0; m < 4; ++m) _Pragma("unroll") for (int n = 0; n < 2; ++n) _Pragma("unroll") for (int k = 0; k < 2; ++k) \
        acc[ai][bj][m][n] = __builtin_amdgcn_mfma_f32_16x16x32_bf16(Bt[n][k], At[m][k], acc[ai][bj][m][n], 0, 0, 0); __builtin_amdgcn_s_setprio(0); } while (0)
#define PG8_WAIT_V(n) asm volatile("s_waitcnt vmcnt(" #n ")" ::: "memory")
#define PG8_WAIT_VR asm volatile("s_waitcnt vmcnt(%0)" :: "n"(8 + Epi::MIN_VM) : "memory")
#define PG8_WAIT_L(n) asm volatile("s_waitcnt lgkmcnt(" #n ")" ::: "memory")
#define PG8_BAR __builtin_amdgcn_s_barrier()
#define PG8_SCHED __builtin_amdgcn_sched_barrier(0)
    Unit cur, nxt; int ui = 0;
    if (!S.next(0, cur)) return;
    f32x4 acc[2][2][4][2];
#pragma unroll
    for (int a = 0; a < 2; ++a)
#pragma unroll
        for (int b = 0; b < 2; ++b)
#pragma unroll
            for (int m = 0; m < 4; ++m)
#pragma unroll
                for (int n = 0; n < 2; ++n) acc[a][b][m][n] = (f32x4){0.f, 0.f, 0.f, 0.f};
    bf16x8 At[4][2], B0[2][2], B1[2][2];
    unsigned cA = (unsigned)cur.pm * tstepA; unsigned cB = (unsigned)cur.pn * tstepB;
    S.a_ready(cur);
    if constexpr (SP2) {
        PG8_STAGE(PG8_SB(0, 0), cB, voffB); PG8_STAGE(PG8_SB(0, 1), cB + hstepB, voffB); PG8_STAGE(PG8_SA(0, 0), cA, voffA); PG8_STAGE(PG8_SA(0, 1), cA + hstepA, voffA);
        pre();
        if (wr == 1) PG8_BAR;
        PG8_WAIT_V(2); PG8_BAR;
        PG8_STAGE(PG8_SB(1, 0), cB + kstep, voffB); PG8_STAGE(PG8_SA(1, 0), cA + kstep, voffA); PG8_STAGE(PG8_SB(1, 1), cB + hstepB + kstep, voffB);
        PG8_WAIT_V(6); PG8_BAR;
    } else {
        PG8_STAGE(PG8_SB(0, 0), cB, voffB); PG8_STAGE(PG8_SA(0, 0), cA, voffA); PG8_STAGE(PG8_SB(0, 1), cB + hstepB, voffB); PG8_STAGE(PG8_SA(0, 1), cA + hstepA, voffA);
        if (wr == 1) PG8_BAR;
        PG8_WAIT_V(4); PG8_BAR;
        PG8_STAGE(PG8_SB(1, 0), cB + kstep, voffB); PG8_STAGE(PG8_SA(1, 0), cA + kstep, voffA); PG8_STAGE(PG8_SB(1, 1), cB + hstepB + kstep, voffB);
        PG8_WAIT_V(6); PG8_BAR;
    }
    for (;;) {
        const bool has_next = S.next(ui + 1, nxt);
        const unsigned nA = has_next ? (unsigned)nxt.pm * tstepA : cA; const unsigned nB = has_next ? (unsigned)nxt.pn * tstepB : cB;
#define PG8_KT2(FA) do { \
            const bool last = (t == nt - 2); \
            unsigned a1 = cA + (unsigned)(t + 1) * kstep; \
            unsigned a2 = last ? nA : cA + (unsigned)(t + 2) * kstep; unsigned b2 = last ? nB : cB + (unsigned)(t + 2) * kstep; \
            unsigned a3 = a2 + kstep; unsigned b3 = b2 + kstep; \
            asm volatile("" : "+s"(a1), "+s"(a2), "+s"(b2), "+s"(a3), "+s"(b3));     \
            if (last && has_next) S.a_ready(nxt); \
            PG8_LDB(B0, 0, 0); PG8_LDB(B1, 0, 1); PG8_SCHED; PG8_LDA(At, 0, 0); if constexpr (!(FA)) PG8_STAGE(PG8_SA(1, 1), a1 + hstepA, voffA); \
            if constexpr (FA) PG8_WAIT_VR; else PG8_WAIT_V(8); PG8_WAIT_L(0); PG8_BAR; PG8_MMA(0, 0, At, B0); PG8_MMA(0, 1, At, B1); PG8_BAR; PG8_SCHED; \
            PG8_LDA(At, 0, 1); PG8_STAGE(PG8_SB(0, 0), b2, voffB); PG8_STAGE(PG8_SB(0, 1), b2 + hstepB, voffB); PG8_STAGE(PG8_SA(0, 0), a2, voffA); \
            if constexpr (FA) PG8_WAIT_VR; else PG8_WAIT_V(8); PG8_WAIT_L(0); PG8_BAR; PG8_MMA(1, 0, At, B0); PG8_MMA(1, 1, At, B1); PG8_BAR; PG8_SCHED; \
            PG8_LDB(B0, 1, 0); PG8_LDB(B1, 1, 1); PG8_SCHED; PG8_LDA(At, 1, 0); PG8_STAGE(PG8_SA(0, 1), a2 + hstepA, voffA); \
            if constexpr (FA) PG8_WAIT_VR; else PG8_WAIT_V(8); PG8_WAIT_L(0); PG8_BAR; PG8_MMA(0, 0, At, B0); PG8_MMA(0, 1, At, B1); PG8_BAR; PG8_SCHED; \
            PG8_LDA(At, 1, 1); PG8_STAGE(PG8_SB(1, 0), b3, voffB); PG8_STAGE(PG8_SB(1, 1), b3 + hstepB, voffB); PG8_STAGE(PG8_SA(1, 0), a3, voffA); \
            PG8_WAIT_V(8); PG8_WAIT_L(0); PG8_BAR; PG8_MMA(1, 0, At, B0); PG8_MMA(1, 1, At, B1); PG8_BAR; PG8_SCHED; } while (0)
        int t = 0;
        if constexpr (SP2 && GEMM_RELAX_SEAM) { if (ui > 0) { PG8_KT2(true); t = 2; } }
        for (; t < nt; t += 2) {
            if constexpr (SP2) {
            PG8_KT2(false);
            } else {
            const bool last = (t == nt - 2);
            unsigned a1 = cA + (unsigned)(t + 1) * kstep;
            unsigned a2 = last ? nA : cA + (unsigned)(t + 2) * kstep; unsigned b2 = last ? nB : cB + (unsigned)(t + 2) * kstep;
            unsigned a3 = a2 + kstep; unsigned b3 = b2 + kstep;
            if (last && has_next) S.a_ready(nxt);
            PG8_LDB(B0, 0, 0); PG8_SCHED; PG8_LDA(At, 0, 0); PG8_STAGE(PG8_SA(1, 1), a1 + hstepA, voffA);
            PG8_WAIT_L(8); PG8_BAR; PG8_WAIT_L(0); PG8_MMA(0, 0, At, B0); PG8_BAR; PG8_SCHED;
            PG8_LDB(B1, 0, 1); PG8_STAGE(PG8_SB(0, 0), b2, voffB);
            PG8_BAR; PG8_WAIT_L(0); PG8_MMA(0, 1, At, B1); PG8_BAR;
            PG8_LDA(At, 0, 1); PG8_STAGE(PG8_SA(0, 0), a2, voffA);
            PG8_BAR; PG8_WAIT_L(0); PG8_MMA(1, 0, At, B0); PG8_BAR; PG8_SCHED;
            PG8_STAGE(PG8_SB(0, 1), b2 + hstepB, voffB);
            PG8_WAIT_V(6); PG8_BAR; PG8_MMA(1, 1, At, B1); PG8_BAR;
            PG8_LDB(B0, 1, 0); PG8_SCHED; PG8_LDA(At, 1, 0); PG8_STAGE(PG8_SA(0, 1), a2 + hstepA, voffA);
            PG8_WAIT_L(8); PG8_BAR; PG8_WAIT_L(0); PG8_MMA(0, 0, At, B0); PG8_BAR; PG8_SCHED;
            PG8_LDB(B1, 1, 1); PG8_STAGE(PG8_SB(1, 0), b3, voffB);
            PG8_BAR; PG8_WAIT_L(0); PG8_MMA(0, 1, At, B1); PG8_BAR;
            PG8_LDA(At, 1, 1); PG8_STAGE(PG8_SA(1, 0), a3, voffA);
            PG8_BAR; PG8_WAIT_L(0); PG8_MMA(1, 0, At, B0); PG8_BAR; PG8_SCHED;
            PG8_STAGE(PG8_SB(1, 1), b3 + hstepB, voffB);
            PG8_WAIT_V(6); PG8_BAR; PG8_MMA(1, 1, At, B1); PG8_BAR;
            }
        }
        if constexpr (ALIGN_EPI) { if (wr == 0) PG8_BAR; }
        if constexpr (GEMM_RELAX_SEAM && SP2) { if (has_next) { unsigned eb = nA + kstep + hstepA; asm volatile("" : "+s"(eb)); PG8_STAGE(PG8_SA(1, 1), eb, voffA); } }
        if constexpr (!Epi::AFTER_DRAIN) { E(acc, cur, wr, wc, fr, fq); S.done(cur); }
        if (!has_next) break;
#pragma unroll
        for (int a = 0; a < 2; ++a)
#pragma unroll
            for (int b = 0; b < 2; ++b)
#pragma unroll
                for (int m = 0; m < 4; ++m)
#pragma unroll
                    for (int n = 0; n < 2; ++n) acc[a][b][m][n] = (f32x4){0.f, 0.f, 0.f, 0.f};
        cur = nxt; cA = nA; cB = nB; ++ui;
        if constexpr (ALIGN_EPI) { if (wr == 1) PG8_BAR; }
    }
    PG8_WAIT_V(0);
    if constexpr (!ALIGN_EPI) { if (wr == 0) PG8_BAR; }
    PG8_BAR;
    if constexpr (Epi::AFTER_DRAIN) { E.fused(acc, cur, wr, wc, fr, fq, lds, wid, lane); S.done(cur); }
#undef PG8_SA
#undef PG8_SB
#undef PG8_STAGE
#undef PG8_LDA
#undef PG8_LDB
#undef PG8_MMA
#undef PG8_WAIT_V
#undef PG8_WAIT_VR
#undef PG8_KT2
#undef PG8_WAIT_L
#undef PG8_BAR
#undef PG8_SCHED
}
}

template <class Core> struct EpiMfma {
    static constexpr bool PERM = true, AFTER_DRAIN = false;
    static constexpr int MIN_VM = 16;
    Core c;
    __device__ __forceinline__ void operator()(const pg8::f32x4 (&acc)[2][2][4][2], const pg8::Unit& u, int wr, int wc, int fr, int fq) const {
        asm volatile("" : "+v"(fr), "+v"(fq));
        float gmax[2] = {0.f, 0.f};
        float rsv[2][4];
#pragma unroll
        for (int ai = 0; ai < 2; ++ai)
#pragma unroll
            for (int m = 0; m < 4; ++m) { if constexpr (Core::NEEDS_RS) rsv[ai][m] = c.rs_tab[ai * 128 + wr * 64 + m * 16 + fr]; else rsv[ai][m] = 1.f; }
#pragma unroll
        for (int ai = 0; ai < 2; ++ai)
#pragma unroll
            for (int m = 0; m < 4; ++m) {
                const int row = u.pm * 256 + ai * 128 + wr * 64 + m * 16 + fr;
                const float rs = rsv[ai][m];
                float part = 0.f;
#pragma unroll
                for (int bj = 0; bj < 2; ++bj) {
                    const int col0 = u.pn * 256 + bj * 128 + wc * 32 + 8 * fq;
                    const float v[8] = {acc[ai][bj][m][0][0], acc[ai][bj][m][0][1], acc[ai][bj][m][0][2], acc[ai][bj][m][0][3],
                                        acc[ai][bj][m][1][0], acc[ai][bj][m][1][1], acc[ai][bj][m][1][2], acc[ai][bj][m][1][3]};
                    const float p = c.apply8(row, col0, v, rs);
                    part += p;
                    if (Core::GROUPMAX) { const float q = sum_x32(sum_x16(p)); gmax[bj] = fmaxf(gmax[bj], q); }
                }
                part = sum_x32(sum_x16(part));
                if (fq == 0) c.store_part(row, u.pn * 256, (u.pn & 3) * 4 + wc, part);
            }
        if (Core::GROUPMAX) {
#pragma unroll
            for (int bj = 0; bj < 2; ++bj) { const int colg = u.pn * 256 + bj * 128 + wc * 32;
                if (c.want_groupmax(colg)) { const float m = wave_max(gmax[bj]); if (fr == 0 && fq == 0) c.store_groupmax(u.pm * 256, colg, m); } }
        }
    }
};
#ifndef GEMM_STAGGER_TICKS
#define GEMM_STAGGER_TICKS 0
#endif
template <class Core>
__device__ __forceinline__ void run_gemm(LAS unsigned char* lds, const bf16* A, int lda, const bf16* Bt, int M, int N, int K, const Core& c, int vcu, int G) {
    int bxo = (int)blockIdx.x; asm volatile("" : "+s"(bxo));
    pg8::Gemm g{A, lda, Bt, M, N, K}; pg8::StaticOrder S; S.init(M, N, G, bxo);
    EpiMfma<Core> E{c};
#if GEMM_STAGGER_TICKS
    if (N > 1024) {
        const unsigned long long t0_ = __builtin_amdgcn_s_memrealtime(); const unsigned long long dl_ = (unsigned long long)((bxo >> 3) & 3) * GEMM_STAGGER_TICKS;
        while (__builtin_amdgcn_s_memrealtime() - t0_ < dl_) __builtin_amdgcn_s_sleep(4);
    }
#endif
    if constexpr (Core::NEEDS_RS) {
        pg8::Unit u0; const bool have = S.next(0, u0);
        LAS float* tab = (LAS float*)(lds + LDSCTL_OFF + 1024); LAS float* bt = (LAS float*)(lds + LDSCTL_OFF + 2048); const int t_ = otid();
        f32x4 q0 = {0.f, 0.f, 0.f, 0.f}, q1 = q0, q2 = q0, q3 = q0; float bv[4] = {0.f, 0.f, 0.f, 0.f}; int nb = 0;
        if (have) { if (t_ < 256) { const f32x4* pq = (const f32x4*)(c.ssq + (size_t)(u0.pm * 256 + t_) * 16); q0 = pq[0]; q1 = pq[1]; q2 = pq[2]; q3 = pq[3]; }
            E.c.rs_tab = tab; E.c.rs_row0 = u0.pm * 256;
            if constexpr (Core::HAS_BIAS) { nb = c.bias_count();
#pragma unroll
                for (int i = 0; i < 4; ++i) if (t_ + NTHR * i < nb) bv[i] = c.bias[t_ + NTHR * i];
                E.c.bias_lds = bt; } }
        auto pre = [&]() { if (have) { if (t_ < 256) { const float sm = ((q0.x + q0.y) + (q0.z + q0.w)) + ((q1.x + q1.y) + (q1.z + q1.w)) + ((q2.x + q2.y) + (q2.z + q2.w)) + ((q3.x + q3.y) + (q3.z + q3.w));
                                                     tab[t_] = __builtin_amdgcn_rsqf(sm * (1.0f / D) + EPS); }
                                       if constexpr (Core::HAS_BIAS) {
#pragma unroll
                                           for (int i = 0; i < 4; ++i) if (t_ + NTHR * i < nb) bt[t_ + NTHR * i] = bv[i]; } } };
        pg8::gemm_phase<EpiMfma<Core>, pg8::StaticOrder, true, true, decltype(pre)>(lds, g, S, E, pre);
    } else
    pg8::gemm_phase<EpiMfma<Core>, pg8::StaticOrder, true, true>(lds, g, S, E);

}

#include <hip/hip_bf16.h>
#include <cmath>
namespace attn_body {
using bf16=__hip_bfloat16;
using bf16x8=__attribute__((ext_vector_type(8)))short;
using s16x4=__attribute__((ext_vector_type(4)))short;
using f32x16=__attribute__((ext_vector_type(16)))float;
using u32x4=__attribute__((ext_vector_type(4)))unsigned;
constexpr int SEQ=8192,D=64,PQ=3072,PO=2048;
constexpr int NW=8,QBLK=32,QB=QBLK*NW,KVBLK=64,NQB=SEQ/QB;
__device__ __forceinline__ int crow(int r,int hi){return (r&3)+8*(r>>2)+4*hi;}
#define SBAR() __builtin_amdgcn_sched_barrier(0)
__device__ __forceinline__ void cmask(f32x16&p0,f32x16&p1,int jb,int qrel,int hi){
  const float NEG=-INFINITY; int kb=64*jb+4*hi;
  #pragma unroll
  for(int r=0;r<16;++r){int kv=kb+(r&3)+8*(r>>2); if(kv>qrel)p0[r]=NEG; if(kv+32>qrel)p1[r]=NEG;}
}

constexpr int NSLOT=3, SLOTB=8192;
constexpr int LDS_K=0, LDS_V=NSLOT*SLOTB, LDS_WS=2*NSLOT*SLOTB, LDS_OST=LDS_WS+NW*64*4, LDS_BYTES=LDS_OST+NW*4096;
constexpr float C2=0.125f*1.4426950408889634f;
__device__ __forceinline__ void glds16(const void*gsrc,unsigned lds_dst){unsigned keep;
  asm volatile("s_mov_b32 %0, m0\n\ts_mov_b32 m0, %2\n\ts_nop 0\n\tglobal_load_lds_dwordx4 %1, off\n\ts_mov_b32 m0, %0":"=&s"(keep):"v"(gsrc),"s"(lds_dst):"memory");}
__device__ __forceinline__ float max3f(float a,float b,float c){float r;asm("v_max3_f32 %0, %1, %2, %3":"=v"(r):"v"(a),"v"(b),"v"(c));return r;}
__device__ __forceinline__ float max2f(float a,float b){float r;asm("v_max_f32_e32 %0, %1, %2":"=v"(r):"v"(a),"v"(b));return r;}
__device__ __forceinline__ float fadd_s(float a,float b){float r;asm("v_add_f32_e32 %0, %1, %2":"=v"(r):"v"(a),"v"(b));return r;}
__device__ __forceinline__ float fsub_s(float a,float b){float r;asm("v_sub_f32_e32 %0, %1, %2":"=v"(r):"v"(a),"v"(b));return r;}
typedef float f32x2_t __attribute__((ext_vector_type(2))); typedef __bf16 bf16x2_t __attribute__((ext_vector_type(2)));
__device__ __forceinline__ unsigned cvtpk_s(float lo,float hi){f32x2_t v={lo,hi};bf16x2_t b=__builtin_convertvector(v,bf16x2_t);return __builtin_bit_cast(unsigned,b);}
#define WAIT_BAR(N) asm volatile("s_waitcnt vmcnt(" #N ") lgkmcnt(0)\n\ts_barrier":::"memory")

__device__ __forceinline__ void qkt(f32x16&p0,f32x16&p1,const char*Kslot,const bf16x8*qr,const f32x16&negm,int r32,int hi){
  const char*kb=Kslot+hi*1024+r32*16;
  #pragma unroll
  for(int d0=0;d0<4;++d0){
    const bf16x8 b0=*reinterpret_cast<const bf16x8*>(kb+d0*2048);
    const bf16x8 b1=*reinterpret_cast<const bf16x8*>(kb+d0*2048+512);
    if(d0==0){p0=__builtin_amdgcn_mfma_f32_32x32x16_bf16(b0,qr[0],negm,0,0,0);p1=__builtin_amdgcn_mfma_f32_32x32x16_bf16(b1,qr[0],negm,0,0,0);}
    else{p0=__builtin_amdgcn_mfma_f32_32x32x16_bf16(b0,qr[d0],p0,0,0,0);p1=__builtin_amdgcn_mfma_f32_32x32x16_bf16(b1,qr[d0],p1,0,0,0);}}
}
typedef __attribute__((address_space(3))) const char* lds_cptr;
typedef short v4i16_t __attribute__((ext_vector_type(4)));
__device__ __forceinline__ void kload8(bf16x8*kf,lds_cptr kp){
  kf[0]=*(const __attribute__((address_space(3))) bf16x8*)(kp);      kf[1]=*(const __attribute__((address_space(3))) bf16x8*)(kp+512);
  kf[2]=*(const __attribute__((address_space(3))) bf16x8*)(kp+2048); kf[3]=*(const __attribute__((address_space(3))) bf16x8*)(kp+2560);
  kf[4]=*(const __attribute__((address_space(3))) bf16x8*)(kp+4096); kf[5]=*(const __attribute__((address_space(3))) bf16x8*)(kp+4608);
  kf[6]=*(const __attribute__((address_space(3))) bf16x8*)(kp+6144); kf[7]=*(const __attribute__((address_space(3))) bf16x8*)(kp+6656);
}
__device__ __forceinline__ void kload2(bf16x8*kf,lds_cptr kp,int j){ kf[2*j]=*(const __attribute__((address_space(3))) bf16x8*)(kp+j*2048); kf[2*j+1]=*(const __attribute__((address_space(3))) bf16x8*)(kp+j*2048+512); }
__device__ __forceinline__ s16x4 vtr(lds_cptr p){ return __builtin_bit_cast(s16x4,__builtin_amdgcn_ds_read_tr16_b64_v4i16((__attribute__((address_space(3))) v4i16_t*)p)); }
__device__ __forceinline__ float rowmax(const f32x16&p0,const f32x16&p1){
  float a=max3f(p0[0],p0[1],p1[0]),b=max3f(p0[2],p0[3],p1[1]);a=max3f(a,p1[2],p1[3]);
  #pragma unroll
  for(int r=4;r<16;r+=4){a=max3f(a,p0[r],p0[r+1]);b=max3f(b,p0[r+2],p0[r+3]);a=max3f(a,p1[r],p1[r+1]);b=max3f(b,p1[r+2],p1[r+3]);}
  const float m=max2f(a,b);
  auto rr=__builtin_amdgcn_permlane32_swap(__float_as_uint(m),__float_as_uint(m),false,false);
  return max2f(__uint_as_float(rr[0]),__uint_as_float(rr[1]));
}
__device__ __forceinline__ void pv(f32x16*o,int vb,bf16x8 pa0,bf16x8 pa1,bf16x8 pa2,bf16x8 pa3){
  #pragma unroll
  for(int d0=0;d0<2;++d0){s16x4 lo[4],hi[4];
    #pragma unroll
    for(int ks=0;ks<4;++ks){
      asm volatile("ds_read_b64_tr_b16 %0,%1 offset:%c2":"=&v"(lo[ks]):"v"(vb),"i"(d0*4096+ks*1024):"memory");
      asm volatile("ds_read_b64_tr_b16 %0,%1 offset:%c2":"=&v"(hi[ks]):"v"(vb),"i"(d0*4096+ks*1024+512):"memory");}
    asm volatile("s_waitcnt lgkmcnt(0)":::"memory");SBAR();
    #define PK(k) (bf16x8){lo[k][0],lo[k][1],lo[k][2],lo[k][3],hi[k][0],hi[k][1],hi[k][2],hi[k][3]}
    o[d0]=__builtin_amdgcn_mfma_f32_32x32x16_bf16(pa0,PK(0),o[d0],0,0,0);
    o[d0]=__builtin_amdgcn_mfma_f32_32x32x16_bf16(pa1,PK(1),o[d0],0,0,0);
    o[d0]=__builtin_amdgcn_mfma_f32_32x32x16_bf16(pa2,PK(2),o[d0],0,0,0);
    o[d0]=__builtin_amdgcn_mfma_f32_32x32x16_bf16(pa3,PK(3),o[d0],0,0,0);
    #undef PK
  }
}

namespace v2 {
constexpr int NSL=4, KSLOT=8192, VSLOT=16384, LDS_K2=0, LDS_V2=NSL*KSLOT, LDS_WS2=LDS_V2+NSL*VSLOT, LDS_BYTES2=LDS_WS2+NW*64*4;
#define V2_WAIT_BAR(N) asm volatile("s_waitcnt vmcnt(" #N ") lgkmcnt(0)\n\ts_barrier":::"memory")
#define V2_MX3(a,b,c) __builtin_fmaxf(__builtin_fmaxf((a),(b)),(c))
}
template<int THRL,bool SREF> __device__ __forceinline__ void attn_unit_v2(int b,int qb,int t0,const bf16*Q,const bf16*K,const bf16*V,bf16*O,float slope2,float bref,char*shm){
  using namespace v2;
  const int tid=otid(),lane=tid&63,r32=lane&31,hi=lane>>5; const int wid=__builtin_amdgcn_readfirstlane(tid>>6);
  const long rowbase=(long)b*SEQ; const int q0=qb*QB;
  const bf16*Qw=Q+(rowbase+q0+wid*QBLK)*PQ;
  const bf16*Kh=K+(rowbase+(long)t0*KVBLK)*PQ,*Vh=V+(rowbase+(long)t0*KVBLK)*PQ;
  const unsigned lds0=(unsigned)(uintptr_t)shm;
  float*wsf=(float*)(shm+LDS_WS2)+wid*64;
  const bf16*ksrc=Kh+(long)lane*PQ+wid*8;
  const int pi0=2*wid, pi1=2*wid+1;
  const bf16*vsrc0=Vh+(long)(16*(pi0&3)+(lane>>2))*PQ+(pi0>>2)*32+(lane&3)*8;
  const bf16*vsrc1=Vh+(long)(16*(pi1&3)+(lane>>2))*PQ+(pi1>>2)*32+(lane&3)*8;
  const unsigned kdst=lds0+LDS_K2+wid*1024, vdst0=lds0+LDS_V2+pi0*1024, vdst1=lds0+LDS_V2+pi1*1024;
  #define V2_DMA(t,sl) do{ glds16(ksrc+(long)(t)*KVBLK*PQ,(unsigned)__builtin_amdgcn_readfirstlane(kdst+(sl)*KSLOT)); \
      glds16(vsrc0+(long)(t)*KVBLK*PQ,(unsigned)__builtin_amdgcn_readfirstlane(vdst0+(sl)*VSLOT)); \
      glds16(vsrc1+(long)(t)*KVBLK*PQ,(unsigned)__builtin_amdgcn_readfirstlane(vdst1+(sl)*VSLOT)); }while(0)
  #define V2_DMAK(t,sl) glds16(ksrc+(long)(t)*KVBLK*PQ,(unsigned)__builtin_amdgcn_readfirstlane(kdst+(sl)*KSLOT))
  #define V2_DMAV(t,sl) do{ glds16(vsrc0+(long)(t)*KVBLK*PQ,(unsigned)__builtin_amdgcn_readfirstlane(vdst0+(sl)*VSLOT)); \
      glds16(vsrc1+(long)(t)*KVBLK*PQ,(unsigned)__builtin_amdgcn_readfirstlane(vdst1+(sl)*VSLOT)); }while(0)
  const int NT=(q0+QB)/KVBLK-t0;
  V2_DMAK(0,0); V2_DMAK(1,1); V2_DMAV(0,0); V2_DMAK(2,2); V2_DMAV(1,1);
  bf16x8 kf[8];
  bf16x8 qr[4];
  #pragma unroll
  for(int d0=0;d0<4;++d0)qr[d0]=*reinterpret_cast<const bf16x8*>(&Qw[(long)r32*PQ+d0*16+hi*8]);
  float l_reg=0.f; f32x16 o[4];
  #pragma unroll
  for(int d0=0;d0<4;++d0)o[d0]=f32x16{};
  f32x16 negm;
  const float b32=32.f*slope2, step64=64.f*slope2;
  const int qrel=wid*QBLK+r32;
  #pragma unroll
  for(int r=0;r<16;++r)negm[r]=SREF?(slope2*(float)(crow(r,hi)+KVBLK*t0-(q0+qrel))-bref):slope2*(float)crow(r,hi);
  const lds_cptr shm3=(lds_cptr)shm; const lds_cptr kp0=shm3+LDS_K2+hi*1024+r32*16; const lds_cptr vp0=shm3+LDS_V2+((lane>>4)&1)*32+(lane&3)*8+(4*hi+((lane&15)>>2))*64;
  f32x16 pA0,pA1,pB0,pB1; u32x4 pw0,pw1,pw2,pw3;
  #define V2_PIN(x) asm volatile("":"+v"(x))
  #define V2_VRD(dst,d0) do{ _Pragma("unroll") for(int ks=0;ks<4;++ks){ dst[2*ks]=vtr(vp+(d0)*4096+ks*1024); dst[2*ks+1]=vtr(vp+(d0)*4096+ks*1024+512);} }while(0)
  #define V2_VF(src,ks) (bf16x8){src[2*(ks)][0],src[2*(ks)][1],src[2*(ks)][2],src[2*(ks)][3],src[2*(ks)+1][0],src[2*(ks)+1][1],src[2*(ks)+1][2],src[2*(ks)+1][3]}
  #define V2_KLD2(t,d0) do{ const lds_cptr kp_=kp0+((t)&3)*KSLOT; kf[2*(d0)]=*(const __attribute__((address_space(3))) bf16x8*)(kp_+(d0)*2048); kf[2*(d0)+1]=*(const __attribute__((address_space(3))) bf16x8*)(kp_+(d0)*2048+512); SBAR(); }while(0)
  #define V2_KRD(t)
  #define V2_QK(t,C0,C1) do{ V2_KRD(t) \
      C0=__builtin_amdgcn_mfma_f32_32x32x16_bf16(kf[0],qr[0],negm,0,0,0); C1=__builtin_amdgcn_mfma_f32_32x32x16_bf16(kf[1],qr[0],negm,0,0,0); \
      _Pragma("unroll") for(int d0=1;d0<4;++d0){ C0=__builtin_amdgcn_mfma_f32_32x32x16_bf16(kf[2*d0],qr[d0],C0,0,0,0); C1=__builtin_amdgcn_mfma_f32_32x32x16_bf16(kf[2*d0+1],qr[d0],C1,0,0,0); } \
      SBAR(); }while(0)
  #define V2_FILL(P,B,PW,W) do{ sacc+=P[B]; sacc+=P[B+1]; sacc+=P[B+2]; sacc+=P[B+3]; PW[W]=cvtpk_s(P[B],P[B+1]); PW[W+1]=cvtpk_s(P[B+2],P[B+3]); V2_PIN(sacc); V2_PIN(PW); SBAR(); }while(0)
  #define V2_QKF(t,C0,C1,P0,P1) do{ V2_KRD(t) float sacc=0.f; \
      C0=__builtin_amdgcn_mfma_f32_32x32x16_bf16(kf[0],qr[0],negm,0,0,0); V2_FILL(P0,0,pw0,0); \
      C1=__builtin_amdgcn_mfma_f32_32x32x16_bf16(kf[1],qr[0],negm,0,0,0); V2_FILL(P0,4,pw0,2); \
      C0=__builtin_amdgcn_mfma_f32_32x32x16_bf16(kf[2],qr[1],C0,0,0,0);   V2_FILL(P0,8,pw1,0); \
      C1=__builtin_amdgcn_mfma_f32_32x32x16_bf16(kf[3],qr[1],C1,0,0,0);   V2_FILL(P0,12,pw1,2); \
      C0=__builtin_amdgcn_mfma_f32_32x32x16_bf16(kf[4],qr[2],C0,0,0,0);   V2_FILL(P1,0,pw2,0); \
      C1=__builtin_amdgcn_mfma_f32_32x32x16_bf16(kf[5],qr[2],C1,0,0,0);   V2_FILL(P1,4,pw2,2); \
      C0=__builtin_amdgcn_mfma_f32_32x32x16_bf16(kf[6],qr[3],C0,0,0,0);   V2_FILL(P1,8,pw3,0); \
      C1=__builtin_amdgcn_mfma_f32_32x32x16_bf16(kf[7],qr[3],C1,0,0,0);   V2_FILL(P1,12,pw3,2); \
      l_reg+=sacc; }while(0)
  bool resc=false;
  #define V2_DECIDE(t,FIRST,C0,C1) do{ \
      _Pragma("unroll") for(int r=0;r<16;++r)C1[r]+=b32; \
      { const int jb=(t)-(NT-4); if(jb>=0)cmask(C0,C1,jb,qrel,hi); } \
      if constexpr(SREF){ _Pragma("unroll") for(int r=0;r<16;++r)negm[r]+=step64; SBAR(); break; } \
      float rm; \
      { float a=V2_MX3(C0[0],C0[1],C1[0]),c=V2_MX3(C0[2],C0[3],C1[1]); a=V2_MX3(a,C1[2],C1[3]); \
        _Pragma("unroll") for(int r=4;r<16;r+=4){a=V2_MX3(a,C0[r],C0[r+1]);c=V2_MX3(c,C0[r+2],C0[r+3]);a=V2_MX3(a,C1[r],C1[r+1]);c=V2_MX3(c,C1[r+2],C1[r+3]);} \
        rm=__builtin_fmaxf(a,c); auto rr=__builtin_amdgcn_permlane32_swap(__float_as_uint(rm),__float_as_uint(rm),false,false); rm=__builtin_fmaxf(__uint_as_float(rr[0]),__uint_as_float(rr[1])); } \
      float adj=step64; resc=false; \
      if(FIRST){ _Pragma("unroll") for(int r=0;r<16;++r){C0[r]-=rm;C1[r]-=rm;} adj-=rm; } \
      else if(__any(rm>(float)THRL)){ const float dl=__builtin_fmaxf(rm,0.f); \
        _Pragma("unroll") for(int r=0;r<16;++r){C0[r]-=dl;C1[r]-=dl;} \
        adj-=dl; const float f=__builtin_amdgcn_exp2f(-dl); l_reg*=f; if(hi==0)wsf[r32]=f; resc=true; } \
      _Pragma("unroll") for(int r=0;r<16;++r)negm[r]+=adj; \
      SBAR(); }while(0)
  #define V2_GRP(d0,ks,src,C,B) do{ o[d0]=__builtin_amdgcn_mfma_f32_32x32x16_bf16(__builtin_bit_cast(bf16x8,pw##ks),V2_VF(src,ks),o[d0],0,0,0); \
      C[B]=__builtin_amdgcn_exp2f(C[B]); C[B+1]=__builtin_amdgcn_exp2f(C[B+1]); V2_PIN(C); SBAR(); }while(0)
  #define V2_SYNC(t) do{ if((t)+2<NT){ V2_WAIT_BAR(3); } else if((t)+1<NT){ V2_WAIT_BAR(2); } else { V2_WAIT_BAR(0); } \
      if((t)+3<NT){ V2_DMAK((t)+3,((t)+3)&3); } if((t)+2<NT){ V2_DMAV((t)+2,((t)+2)&3); } }while(0)
  #define V2_KPF(PF,t,d0) do{ if(PF){ V2_KLD2((t)+1,d0); } }while(0)
  #define V2_STEP(t,C0,C1,P0,P1,PF) do{ V2_SYNC(t); \
      const lds_cptr vp=vp0+(((t)-1)&3)*VSLOT; s16x4 va[8],vb[8]; \
      V2_VRD(va,0); \
      V2_QKF(t,C0,C1,P0,P1); V2_DECIDE(t,false,C0,C1); \
      V2_VRD(vb,1); \
      V2_GRP(0,0,va,C0,0); V2_GRP(0,1,va,C0,2); V2_GRP(0,2,va,C0,4); V2_GRP(0,3,va,C0,6); \
      V2_VRD(va,2); \
      V2_GRP(1,0,vb,C0,8); V2_KPF(PF,t,0); V2_GRP(1,1,vb,C0,10); V2_KPF(PF,t,1); V2_GRP(1,2,vb,C0,12); V2_GRP(1,3,vb,C0,14); \
      V2_VRD(vb,3); \
      V2_GRP(2,0,va,C1,0); V2_KPF(PF,t,2); V2_GRP(2,1,va,C1,2); V2_KPF(PF,t,3); V2_GRP(2,2,va,C1,4); V2_GRP(2,3,va,C1,6); \
      V2_GRP(3,0,vb,C1,8); V2_GRP(3,1,vb,C1,10); V2_GRP(3,2,vb,C1,12); V2_GRP(3,3,vb,C1,14); \
      if(resc){ asm volatile("s_waitcnt lgkmcnt(0)":::"memory");         \
        _Pragma("unroll") for(int r=0;r<16;++r){ const float fr_=wsf[crow(r,hi)]; \
          _Pragma("unroll") for(int d0=0;d0<4;++d0)o[d0][r]*=fr_; } \
        asm volatile("s_waitcnt lgkmcnt(0)":::"memory"); } }while(0)
  V2_SYNC(0); V2_KLD2(0,0); V2_KLD2(0,1); V2_KLD2(0,2); V2_KLD2(0,3); V2_QK(0,pA0,pA1);
  V2_KLD2(1,0); V2_KLD2(1,1); V2_KLD2(1,2); V2_KLD2(1,3);
  V2_DECIDE(0,true,pA0,pA1);
  #pragma unroll
  for(int r=0;r<16;++r){pA0[r]=__builtin_amdgcn_exp2f(pA0[r]);pA1[r]=__builtin_amdgcn_exp2f(pA1[r]);}
  for(int t=1;t+1<NT;t+=2){ V2_STEP(t,pB0,pB1,pA0,pA1,true); V2_STEP(t+1,pA0,pA1,pB0,pB1,true); }
  V2_STEP(NT-1,pB0,pB1,pA0,pA1,false);
  { float sacc=0.f;
    #pragma unroll
    for(int r=0;r<16;++r)sacc+=pB0[r]+pB1[r];
    l_reg+=sacc;
    pw0=(u32x4){cvtpk_s(pB0[0],pB0[1]),cvtpk_s(pB0[2],pB0[3]),cvtpk_s(pB0[4],pB0[5]),cvtpk_s(pB0[6],pB0[7])};
    pw1=(u32x4){cvtpk_s(pB0[8],pB0[9]),cvtpk_s(pB0[10],pB0[11]),cvtpk_s(pB0[12],pB0[13]),cvtpk_s(pB0[14],pB0[15])};
    pw2=(u32x4){cvtpk_s(pB1[0],pB1[1]),cvtpk_s(pB1[2],pB1[3]),cvtpk_s(pB1[4],pB1[5]),cvtpk_s(pB1[6],pB1[7])};
    pw3=(u32x4){cvtpk_s(pB1[8],pB1[9]),cvtpk_s(pB1[10],pB1[11]),cvtpk_s(pB1[12],pB1[13]),cvtpk_s(pB1[14],pB1[15])};
    const lds_cptr vp=vp0+((NT-1)&3)*VSLOT; s16x4 va[8],vb[8];
    #define V2_PV(d0,src) do{ o[d0]=__builtin_amdgcn_mfma_f32_32x32x16_bf16(__builtin_bit_cast(bf16x8,pw0),V2_VF(src,0),o[d0],0,0,0); \
        o[d0]=__builtin_amdgcn_mfma_f32_32x32x16_bf16(__builtin_bit_cast(bf16x8,pw1),V2_VF(src,1),o[d0],0,0,0); \
        o[d0]=__builtin_amdgcn_mfma_f32_32x32x16_bf16(__builtin_bit_cast(bf16x8,pw2),V2_VF(src,2),o[d0],0,0,0); \
        o[d0]=__builtin_amdgcn_mfma_f32_32x32x16_bf16(__builtin_bit_cast(bf16x8,pw3),V2_VF(src,3),o[d0],0,0,0); }while(0)
    V2_VRD(va,0); V2_VRD(vb,1); V2_PV(0,va); V2_VRD(va,2); V2_PV(1,vb); V2_VRD(vb,3); V2_PV(2,va); V2_PV(3,vb);
    #undef V2_PV
  }
  #undef V2_PIN
  #undef V2_VRD
  #undef V2_VF
  #undef V2_KRD
  #undef V2_QK
  #undef V2_QKF
  #undef V2_FILL
  #undef V2_DECIDE
  #undef V2_GRP
  #undef V2_STEP
  #undef V2_SYNC
  {auto rr=__builtin_amdgcn_permlane32_swap(__float_as_uint(l_reg),__float_as_uint(l_reg),false,false);l_reg=__uint_as_float(rr[0])+__uint_as_float(rr[1]);}
  if(hi==0)wsf[32+r32]=l_reg;asm volatile("s_waitcnt lgkmcnt(0)":::"memory");
  float rli[16];
  #pragma unroll
  for(int r=0;r<16;++r)rli[r]=__builtin_amdgcn_rcpf(wsf[32+crow(r,hi)]);
  asm volatile("s_waitcnt lgkmcnt(0)\n\ts_barrier":::"memory");
  bf16*Ow=O+(rowbase+q0+wid*QBLK)*PO;
  { bf16*stg=(bf16*)shm+wid*4096;
    #pragma unroll
    for(int r=0;r<16;++r){const int orow=crow(r,hi);
      #pragma unroll
      for(int d0=0;d0<4;++d0)stg[orow*128+d0*32+r32]=__float2bfloat16(o[d0][r]*rli[r]);}
    asm volatile("s_waitcnt lgkmcnt(0)":::"memory");
    #pragma unroll
    for(int i=0;i<8;++i){const int row=i*4+(lane>>4),ch=lane&15; const u32x4 v=*(const u32x4*)(stg+row*128+ch*8); *(u32x4*)(Ow+(long)row*PO+ch*8)=v;} }
  asm volatile("s_waitcnt lgkmcnt(0)\n\ts_barrier":::"memory");
  #undef V2_DMA
  #undef V2_DMAK
  #undef V2_DMAV
  #undef V2_KLD2
  #undef V2_KPF
}
constexpr int ATTN_LDS_BYTES=LDS_BYTES;
#undef SBAR
#undef WAIT_BAR
}

__device__ __forceinline__ void phase_diff_mfma(char* shm, LAS unsigned char* lds, const Ctx& a, int vcu, int G) {
    bf16* proj = (bf16*)(a.ws + WS_H); bf16* o12 = (bf16*)(a.ws + WS_STATE);
    unsigned* ctl = (unsigned*)(a.ws + WS_CTL);
    volatile LAS unsigned* qslot = (volatile LAS unsigned*)(lds + MISC_OFF) + 16;
    for (;;) {
        const int tid = otid();
        if (tid == 0) *qslot = atomicAdd(ctl + CW_QUEUE, 1u);
        __syncthreads();
        const unsigned idx = (unsigned)__builtin_amdgcn_readfirstlane((int)*qslot);
        __syncthreads();
        if (idx >= (unsigned)(NB * DIFF_H * 2 * 32)) break;
        const int qb = 31 - (int)(idx >> 5), rem = idx & 31, b = rem >> 4, h = (rem >> 1) & 7, r = rem & 1;
        const float slope2 = exp2f(-(float)(h + 1)) * LOG2E;
        int t0 = 0; float smax_u;
        { const unsigned* qm = ctl + CW_QKMAX + b * 64; const int g0 = (h * 128 + r * 64) >> 5;
          const float pq = __uint_as_float(qm[g0]) + __uint_as_float(qm[g0 + 1]), pk = __uint_as_float(qm[32 + g0]) + __uint_as_float(qm[32 + g0 + 1]);
          const float smax = sqrtf(pq * pk); smax_u = smax;
          const float d = (float)(qb * 256) - (152.0f + 2.1f * smax) / slope2;
          if (d > 0.f) t0 = ((int)d >> 6) & ~1;
          if (t0 > 4 * qb) t0 = 4 * qb; }
#if ATTN_SREF
        if (smax_u <= 48.f)
            attn_body::attn_unit_v2<8, true>(b, qb, t0, (const attn_body::bf16*)(proj + h * 128 + r * 64), (const attn_body::bf16*)(proj + 1024 + h * 128 + r * 64),
                                   (const attn_body::bf16*)(proj + 2048 + h * 128), (attn_body::bf16*)(o12 + r * 1024 + h * 128), slope2, smax_u, shm);
        else
#endif
        attn_body::attn_unit_v2<8, false>(b, qb, t0, (const attn_body::bf16*)(proj + h * 128 + r * 64), (const attn_body::bf16*)(proj + 1024 + h * 128 + r * 64),
                                   (const attn_body::bf16*)(proj + 2048 + h * 128), (attn_body::bf16*)(o12 + r * 1024 + h * 128), slope2, 0.f, shm);
    }
}
__device__ __forceinline__ void phase_diff_combine(const Ctx& a, const LayerP& P, int vcu, int G) {
    const int tid = otid(), lane = tid & 63, wave = tid >> 6;
    bf16* proj = (bf16*)(a.ws + WS_H); const bf16* o12 = (const bf16*)(a.ws + WS_STATE);
    float lam;
    { float s1 = 0.f, s2 = 0.f;
      for (int i = 0; i < 64; ++i) { s1 += P.e0[i] * P.e1[i]; s2 += P.e2[i] * P.e3[i]; }
      lam = __expf(s1) - __expf(s2) + LAMBDA_INIT; }
    const int h = lane >> 3, sub = lane & 7;
    float hn[16];
#pragma unroll
    for (int j = 0; j < 16; ++j) hn[j] = P.e4[sub * 16 + j] * (1.0f - LAMBDA_INIT);
    const int gw = vcu * NWAVES + wave, NGW = G * NWAVES;
    for (int r0 = gw; r0 < NTOK; r0 += 2 * NGW) {
      const int r1 = (r0 + NGW < NTOK) ? r0 + NGW : r0;
      v4u ld[2][4];
#pragma unroll
      for (int q = 0; q < 2; ++q) { const bf16* p1 = o12 + (size_t)(q ? r1 : r0) * 2048 + h * 128 + sub * 16;
          ld[q][0] = *(const v4u*)p1; ld[q][1] = *(const v4u*)(p1 + 8); ld[q][2] = *(const v4u*)(p1 + 1024); ld[q][3] = *(const v4u*)(p1 + 1032); }
#pragma unroll
      for (int q = 0; q < 2; ++q) { const int row = q ? r1 : r0; if (q && r1 == r0) break;
        const v4u a0 = ld[q][0], a1 = ld[q][1], b0 = ld[q][2], b1 = ld[q][3];
        const unsigned aw[8] = {a0.x, a0.y, a0.z, a0.w, a1.x, a1.y, a1.z, a1.w}, bw[8] = {b0.x, b0.y, b0.z, b0.w, b1.x, b1.y, b1.z, b1.w};
        float o[16]; float ss = 0.f;
#pragma unroll
        for (int j = 0; j < 8; ++j) { o[2 * j] = bflo(aw[j]) - lam * bflo(bw[j]); o[2 * j + 1] = bfhi(aw[j]) - lam * bfhi(bw[j]); ss += o[2 * j] * o[2 * j] + o[2 * j + 1] * o[2 * j + 1]; }
        ss = sum_lanes8(ss);
        const float rs = 1.0f / sqrtf(ss * (1.0f / 128.0f) + EPS);
        v4u w0, w1;
        w0.x = pk2(o[0] * rs * hn[0], o[1] * rs * hn[1]); w0.y = pk2(o[2] * rs * hn[2], o[3] * rs * hn[3]); w0.z = pk2(o[4] * rs * hn[4], o[5] * rs * hn[5]); w0.w = pk2(o[6] * rs * hn[6], o[7] * rs * hn[7]);
        w1.x = pk2(o[8] * rs * hn[8], o[9] * rs * hn[9]); w1.y = pk2(o[10] * rs * hn[10], o[11] * rs * hn[11]); w1.z = pk2(o[12] * rs * hn[12], o[13] * rs * hn[13]); w1.w = pk2(o[14] * rs * hn[14], o[15] * rs * hn[15]);
        bf16* op = proj + (size_t)row * DIFF_PITCH + h * 128 + sub * 16;
        *(v4u*)op = w0; *(v4u*)(op + 8) = w1;
      }
    }
}

typedef short mbf16x8 __attribute__((ext_vector_type(8)));
typedef short ms16x4 __attribute__((ext_vector_type(4)));
typedef float mf32x16 __attribute__((ext_vector_type(16)));
#define MFMA32(a, b, c) __builtin_amdgcn_mfma_f32_32x32x16_bf16(a, b, c, 0, 0, 0)
__device__ __forceinline__ int crow32(int r, int hi) { return (r & 3) + 8 * (r >> 2) + 4 * hi; }
__device__ __forceinline__ mbf16x8 frag_rk(const LAS unsigned char* base, int stride, int row0, int k0, int lane) {
    return *(const LAS mbf16x8*)(base + (row0 + (lane & 31)) * stride + (k0 + 8 * (lane >> 5)) * 2);
}
__device__ __forceinline__ mbf16x8 frag_kn(const LAS unsigned char* base, int stride, int k0, int n0, int lane) {
    const int i = lane & 15, g = lane >> 4;
    const LAS unsigned char* p = base + (k0 + 8 * (g >> 1) + (i >> 2)) * stride + (n0 + 16 * (g & 1) + 4 * (i & 3)) * 2;
    const ms16x4 lo = __builtin_bit_cast(ms16x4, __builtin_amdgcn_ds_read_tr16_b64_v4i16((LAS ms16x4*)p));
    const ms16x4 hi = __builtin_bit_cast(ms16x4, __builtin_amdgcn_ds_read_tr16_b64_v4i16((LAS ms16x4*)(p + 4 * stride)));
    return (mbf16x8){lo[0], lo[1], lo[2], lo[3], hi[0], hi[1], hi[2], hi[3]};
}
__device__ __forceinline__ mf32x16 zero16() { mf32x16 z;
#pragma unroll
    for (int r = 0; r < 16; ++r) z[r] = 0.f; return z; }

__device__ __forceinline__ void phase_sgu_mfma(LAS unsigned char* lds, const Ctx& a, const LayerP& P, int vcu, int G, bool dummy = false) {
    const int tid = otid(), lane = tid & 63, wave = __builtin_amdgcn_readfirstlane(tid >> 6);
    bf16* proj = (bf16*)(a.ws + WS_H); const float* vssq = (const float*)(a.ws + WS_VSSQ);
    const float* v_norm = P.e1; const float* w_s = P.e2; const float* b_s = P.e3;
    constexpr int SA = 272, SV = 320, SO = 132;
    LAS unsigned char* WA = lds;
    LAS unsigned char* VV = lds + 128 * SA;
    LAS float* OS = (LAS float*)(lds + 128 * SA);
    LAS float* RS = (LAS float*)(lds + 128 * SA + 128 * SO * 4);
    const int tm = wave & 3, nh = wave >> 2, hi = lane >> 5;
    constexpr int NU = NB * (T / SGU_C) * SGU_G;
    int g_res = -1;
    v4u vraw[4]; float rsraw = 0.f;
    #define SGU_LOAD_RAW(uu) do{ const int g_ = (uu) % SGU_G, row0_ = ((uu) / SGU_G) * SGU_C; \
        _Pragma("unroll") for (int i = 0; i < 4; ++i) { const int ch = tid + NTHR * i, r = ch >> 4, c16 = ch & 15; \
            vraw[i] = *(const v4u*)(proj + (size_t)(row0_ + r) * SGU_PITCH + 1024 + g_ * 128 + c16 * 8); } \
        if (tid < 128) rsraw = row_rstd(vssq, row0_ + tid); }while(0)
    if (vcu < NU) SGU_LOAD_RAW(vcu);
    for (int u = vcu; u < NU; u += G) {
        const int g = u % SGU_G, bc = u / SGU_G;
        const int row0 = bc * SGU_C;
        if (tid < 128) RS[tid] = rsraw;
        v4u vcur[4];
#pragma unroll
        for (int i = 0; i < 4; ++i) vcur[i] = vraw[i];
        v4u uw[4];
#pragma unroll
        for (int i = 0; i < 4; ++i) { const int ch = tid + NTHR * i, t = ch >> 4, c8 = (ch & 15) * 8; uw[i] = *(const v4u*)(proj + (size_t)(row0 + t) * SGU_PITCH + g * 128 + c8); }
        if (g != g_res) {
#pragma unroll
            for (int i = 0; i < 8; ++i) { const int idx = tid + NTHR * i, t = idx >> 5, s4 = (idx & 31) * 4;
                const f32x4 w = *(const f32x4*)(w_s + (size_t)g * 16384 + t * 128 + s4);
                v2u o; o.x = pk2((s4 + 0 <= t) ? w.x : 0.f, (s4 + 1 <= t) ? w.y : 0.f); o.y = pk2((s4 + 2 <= t) ? w.z : 0.f, (s4 + 3 <= t) ? w.w : 0.f);
                *(LAS v2u*)(WA + t * SA + s4 * 2) = o; }
            g_res = g;
        }
        if (u + G < NU) SGU_LOAD_RAW(u + G);
        __syncthreads();
#pragma unroll
        for (int i = 0; i < 4; ++i) { const int ch = tid + NTHR * i, r = ch >> 4, c16 = ch & 15; const float rs = RS[r];
            v4u o; o.x = pk2(bflo(vcur[i].x) * rs, bfhi(vcur[i].x) * rs); o.y = pk2(bflo(vcur[i].y) * rs, bfhi(vcur[i].y) * rs);
            o.z = pk2(bflo(vcur[i].z) * rs, bfhi(vcur[i].z) * rs); o.w = pk2(bflo(vcur[i].w) * rs, bfhi(vcur[i].w) * rs);
            *(LAS v4u*)(VV + r * SV + c16 * 16) = o; }
        __syncthreads();
        mf32x16 acc0 = zero16(), acc1 = zero16();
        for (int ks = 0; ks < 2 * (tm + 1); ++ks) {
            const mbf16x8 af = frag_rk(WA, SA, 32 * tm, 16 * ks, lane);
            const mbf16x8 b0 = frag_kn(VV, SV, 16 * ks, 64 * nh, lane), b1 = frag_kn(VV, SV, 16 * ks, 64 * nh + 32, lane);
            acc0 = MFMA32(af, b0, acc0); acc1 = MFMA32(af, b1, acc1);
        }
        __syncthreads();
#pragma unroll
        for (int r = 0; r < 16; ++r) { const int row = 32 * tm + crow32(r, hi);
            OS[row * SO + 64 * nh + (lane & 31)] = acc0[r]; OS[row * SO + 64 * nh + 32 + (lane & 31)] = acc1[r]; }
        __syncthreads();
#pragma unroll
        for (int i = 0; i < 4; ++i) { const int ch = tid + NTHR * i, t = ch >> 4, c8 = (ch & 15) * 8;
            const f32x4 s0 = *(const LAS f32x4*)(OS + t * SO + c8), s1 = *(const LAS f32x4*)(OS + t * SO + c8 + 4);
            const f32x4 n0 = *(const f32x4*)(v_norm + g * 128 + c8), n1 = *(const f32x4*)(v_norm + g * 128 + c8 + 4);
            const float bs = b_s[g * 128 + t];
            bf16* up = proj + (size_t)(row0 + t) * SGU_PITCH + g * 128 + c8;
            const v4u uwv = uw[i];
            v4u o;
            o.x = pk2(bflo(uwv.x) * (n0.x * s0.x + bs), bfhi(uwv.x) * (n0.y * s0.y + bs)); o.y = pk2(bflo(uwv.y) * (n0.z * s0.z + bs), bfhi(uwv.y) * (n0.w * s0.w + bs));
            o.z = pk2(bflo(uwv.z) * (n1.x * s1.x + bs), bfhi(uwv.z) * (n1.y * s1.y + bs)); o.w = pk2(bflo(uwv.w) * (n1.z * s1.z + bs), bfhi(uwv.w) * (n1.w * s1.w + bs));
            if (dummy) *(v4u*)((bf16*)(a.ws + WS_STATE + 32 * MiB) + (size_t)(row0 + t) * 1024 + g * 128 + c8) = o; else *(v4u*)up = o; }
        __syncthreads();
    }
    #undef SGU_LOAD_RAW
}

constexpr int GLA_GRP = 4, GLA_NG = GLA_NC / GLA_GRP;
constexpr int GLA_NU2 = NB * GLA_H * GLA_NG;
struct GlaGate { const float* R; const float* w2; const float* gb; };
struct GlaRaw2 { float la0[8], la1[8]; unsigned q[8], k[8]; v4u v[4]; };
__device__ __forceinline__ void gla2_load_raw(GlaRaw2& r, const bf16* proj, const GlaGate& gt, int row0, int h, int tid, bool want_q) {
    const int cp = tid & 63, part = tid >> 6;
#pragma unroll
    for (int i = 0; i < 8; ++i) { const bf16* base = proj + (size_t)(row0 + 8 * part + i) * GLA_PITCH + h * 128 + 2 * cp;
        r.k[i] = *(const unsigned*)(base + 512); r.q[i] = want_q ? *(const unsigned*)base : 0u; }
#if GLA_RANK16
    { const f32x2v gbv = *(const f32x2v*)(gt.gb + h * 128 + 2 * cp);
#pragma unroll
      for (int i = 0; i < 8; ++i) { r.la0[i] = gbv.x; r.la1[i] = gbv.y; }
#pragma unroll 1
      for (int j4 = 0; j4 < 4; ++j4) {
          f32x2v w[4];
#pragma unroll
          for (int jj = 0; jj < 4; ++jj) w[jj] = *(const f32x2v*)(gt.w2 + (4 * j4 + jj) * 512 + h * 128 + 2 * cp);
#pragma unroll
          for (int i = 0; i < 8; ++i) { const f32x4 rv = *(const f32x4*)(gt.R + (size_t)(row0 + 8 * part + i) * 16 + 4 * j4);
              r.la0[i] += rv.x * w[0].x + rv.y * w[1].x + rv.z * w[2].x + rv.w * w[3].x;
              r.la1[i] += rv.x * w[0].y + rv.y * w[1].y + rv.z * w[2].y + rv.w * w[3].y; }
      }
#pragma unroll
      for (int i = 0; i < 8; ++i) { r.la0[i] = log_sigmoid(r.la0[i]) * (1.0f / 16.0f); r.la1[i] = log_sigmoid(r.la1[i]) * (1.0f / 16.0f); } }
#else
#pragma unroll
    for (int i = 0; i < 8; ++i) { const unsigned w = *(const unsigned*)(proj + (size_t)(row0 + 8 * part + i) * GLA_PITCH + 3072 + h * 128 + 2 * cp); r.la0[i] = bflo(w); r.la1[i] = bfhi(w); }
#endif
#pragma unroll
    for (int i = 0; i < 4; ++i) { const int ch = tid + NTHR * i, rr = ch >> 5, c16 = ch & 31;
        r.v[i] = *(const v4u*)(proj + (size_t)(row0 + rr) * GLA_PITCH + 1024 + h * 256 + c16 * 8); }
}
__device__ __forceinline__ void gla2_cumsum(GlaCum& c, const GlaRaw2& r, LAS float* TOT, int tid) {
    const int cp = tid & 63, part = tid >> 6;
#pragma unroll
    for (int i = 0; i < 8; ++i) { c.b0[i] = r.la0[i]; c.b1[i] = r.la1[i]; }
#pragma unroll
    for (int i = 1; i < 8; ++i) { c.b0[i] += c.b0[i - 1]; c.b1[i] += c.b1[i - 1]; }
    TOT[part * 128 + 2 * cp] = c.b0[7]; TOT[part * 128 + 2 * cp + 1] = c.b1[7];
    __syncthreads();
    float o0 = 0.f, o1 = 0.f, t0 = 0.f, t1 = 0.f;
#pragma unroll
    for (int p = 0; p < 8; ++p) { const float x0 = TOT[p * 128 + 2 * cp], x1 = TOT[p * 128 + 2 * cp + 1]; if (p < part) { o0 += x0; o1 += x1; } t0 += x0; t1 += x1; }
#pragma unroll
    for (int i = 0; i < 8; ++i) { c.b0[i] += o0; c.b1[i] += o1; }
    c.tot0 = t0; c.tot1 = t1;
}
__device__ __forceinline__ void gla2_state_update(mf32x16 (&S)[4], const LAS unsigned char* KE, const LAS unsigned char* VV, const LAS float* DEC, int wave, int lane, bool scale) {
    const int hi = lane >> 5;
    if (scale) {
#pragma unroll
        for (int kt = 0; kt < 4; ++kt)
#pragma unroll
            for (int rq = 0; rq < 4; ++rq) { const f32x4 d = *(const LAS f32x4*)(DEC + 32 * kt + 8 * rq + 4 * hi);
                S[kt][4 * rq + 0] *= d.x; S[kt][4 * rq + 1] *= d.y; S[kt][4 * rq + 2] *= d.z; S[kt][4 * rq + 3] *= d.w; }
    }
#pragma unroll
    for (int ks = 0; ks < 4; ++ks) { const mbf16x8 bfr = frag_kn(VV, 576, 16 * ks, 32 * wave, lane);
#pragma unroll
        for (int kt = 0; kt < 4; ++kt) S[kt] = MFMA32(frag_kn(KE, 320, 16 * ks, 32 * kt, lane), bfr, S[kt]); }
}
__device__ __forceinline__ void phase_gla2_kv(LAS unsigned char* lds, const Ctx& a, const LayerP& P, int vcu, int G) {
    const GlaGate gt{(const float*)(a.ws + WS_R), P.e1, P.e2};
    const int tid = otid(), lane = tid & 63, wave = __builtin_amdgcn_readfirstlane(tid >> 6), hi = lane >> 5;
    const bf16* proj = (const bf16*)(a.ws + WS_H); bf16* state = (bf16*)(a.ws + WS_STATE); float* dec = (float*)(a.ws + WS_DEC);
    LAS unsigned char* VV = lds;
    LAS unsigned char* KE = lds + 36864;
    LAS float* TOT = (LAS float*)(lds + 57344);
    LAS float* DEC = (LAS float*)(lds + 61440);
    const int cp = tid & 63, part = tid >> 6;
    for (int u = vcu; u < GLA_NU2; u += G) {
        const int grp = u % GLA_NG, bh = u / GLA_NG, h = bh % GLA_H, b = bh / GLA_H;
        const int row0 = b * T + grp * (GLA_GRP * GLA_C);
        mf32x16 S[4];
#pragma unroll
        for (int kt = 0; kt < 4; ++kt) S[kt] = zero16();
        float sum0 = 0.f, sum1 = 0.f;
        GlaRaw2 cur; gla2_load_raw(cur, proj, gt, row0, h, tid, false);
#pragma unroll 1
        for (int j = 0; j < GLA_GRP; ++j) {
            GlaCum c; gla2_cumsum(c, cur, TOT, tid);
#pragma unroll
            for (int i = 0; i < 8; ++i) { const int t = 8 * part + i; const unsigned w = cur.k[i];
                *(LAS unsigned*)(KE + t * 320 + 4 * cp) = pk2(bflo(w) * __expf(c.tot0 - c.b0[i]), bfhi(w) * __expf(c.tot1 - c.b1[i])); }
            if (part == 0) { DEC[2 * cp] = __expf(c.tot0); DEC[2 * cp + 1] = __expf(c.tot1); sum0 += c.tot0; sum1 += c.tot1; }
#pragma unroll
            for (int i = 0; i < 4; ++i) { const int ch = tid + NTHR * i, r = ch >> 5, c16 = ch & 31; *(LAS v4u*)(VV + r * 576 + c16 * 16) = cur.v[i]; }
            if (j + 1 < GLA_GRP) gla2_load_raw(cur, proj, gt, row0 + (j + 1) * GLA_C, h, tid, false);
            __syncthreads();
            gla2_state_update(S, KE, VV, DEC, wave, lane, j > 0);
            __syncthreads();
        }
        if (part == 0) { dec[(size_t)u * 128 + 2 * cp] = __expf(sum0); dec[(size_t)u * 128 + 2 * cp + 1] = __expf(sum1); }
        bf16* sp = state + (size_t)u * 32768 + 32 * wave + (lane & 31);
#pragma unroll
        for (int kt = 0; kt < 4; ++kt)
#pragma unroll
            for (int r = 0; r < 16; ++r) sp[(size_t)(32 * kt + crow32(r, hi)) * 256] = (bf16)f2bf(S[kt][r]);
    }
}
__device__ __forceinline__ void phase_gla2_scan(const Ctx& a, int vcu, int G) {
    unsigned* state = (unsigned*)(a.ws + WS_STATE); const float* dec = (const float*)(a.ws + WS_DEC);
    for (int gid = vcu * NTHR + otid(); gid < NB * GLA_H * 16384; gid += G * NTHR) {
        const int bh = gid >> 14, e = gid & 16383, kd = e >> 7;
        unsigned* sp = state + (size_t)bh * GLA_NG * 16384 + e;
        const float* dp = dec + (size_t)bh * GLA_NG * 128 + kd;
        float s0 = 0.f, s1 = 0.f;
        for (int n0 = 0; n0 < GLA_NG; n0 += 32) {
            unsigned w[32]; float d[32];
#pragma unroll
            for (int i = 0; i < 32; ++i) { w[i] = sp[(size_t)(n0 + i) * 16384]; d[i] = dp[(n0 + i) * 128]; }
#pragma unroll
            for (int i = 0; i < 32; ++i) { sp[(size_t)(n0 + i) * 16384] = pk2(s0, s1); s0 = d[i] * s0 + bflo(w[i]); s1 = d[i] * s1 + bfhi(w[i]); }
        }
    }
}
__device__ __forceinline__ void phase_gla2_out(LAS unsigned char* lds, const Ctx& a, const LayerP& P, int vcu, int G, bool dummy = false) {
    const int tid = otid(), lane = tid & 63, wave = __builtin_amdgcn_readfirstlane(tid >> 6), hi = lane >> 5;
    bf16* proj = (bf16*)(a.ws + WS_H); const bf16* state = (const bf16*)(a.ws + WS_STATE);
    const float* head_norm = P.e3;
    const GlaGate gt{(const float*)(a.ws + WS_R), P.e1, P.e2};
    constexpr int SQ = 272, SA = 144, SV = 576, SO = 260;
    LAS unsigned char* QD = lds;
    LAS unsigned char* KI = lds + 17408;
    LAS unsigned char* AT = lds + 34816;
    LAS unsigned char* VV = lds + 44032;
    LAS unsigned char* KE = lds + 80896;
    LAS float* TOT = (LAS float*)(lds + 101376);
    LAS float* DEC = (LAS float*)(lds + 105472);
    LAS float* OS = (LAS float*)lds;
    const int cp = tid & 63, part = tid >> 6;
    for (int u = vcu; u < GLA_NU2; u += G) {
        const int grp = u % GLA_NG, bh = u / GLA_NG, h = bh % GLA_H, b = bh / GLA_H;
        const int rowg = b * T + grp * (GLA_GRP * GLA_C);
        mf32x16 S[4];
        { const bf16* sp = state + (size_t)u * 32768 + 32 * wave + (lane & 31);
#pragma unroll
          for (int kt = 0; kt < 4; ++kt)
#pragma unroll
              for (int r = 0; r < 16; ++r) S[kt][r] = bf2f(sp[(size_t)(32 * kt + crow32(r, hi)) * 256]); }
        GlaRaw2 cur; gla2_load_raw(cur, proj, gt, rowg, h, tid, true);
#pragma unroll 1
        for (int j = 0; j < GLA_GRP; ++j) {
            const int row0 = rowg + j * GLA_C;
            v4u gwv[4];
#pragma unroll
            for (int p = 0; p < 4; ++p) gwv[p] = *(const v4u*)(proj + (size_t)(row0 + p * 16 + wave * 2 + hi) * GLA_PITCH + 2048 + h * 256 + (lane & 31) * 8);
            GlaCum c; gla2_cumsum(c, cur, TOT, tid);
#pragma unroll
            for (int i = 0; i < 8; ++i) { const int t = 8 * part + i;
                const unsigned wq = cur.q[i], wk = cur.k[i];
                const float e0 = __expf(c.b0[i]), e1 = __expf(c.b1[i]);
                *(LAS unsigned*)(QD + t * SQ + 4 * cp) = pk2(bflo(wq) * 0.08838834764831845f * e0, bfhi(wq) * 0.08838834764831845f * e1);
                *(LAS unsigned*)(KI + t * SQ + 4 * cp) = pk2(bflo(wk) * __builtin_amdgcn_rcpf(e0), bfhi(wk) * __builtin_amdgcn_rcpf(e1));
                *(LAS unsigned*)(KE + t * 320 + 4 * cp) = pk2(bflo(wk) * __expf(c.tot0 - c.b0[i]), bfhi(wk) * __expf(c.tot1 - c.b1[i])); }
            if (part == 0) { DEC[2 * cp] = __expf(c.tot0); DEC[2 * cp + 1] = __expf(c.tot1); }
#pragma unroll
            for (int i = 0; i < 4; ++i) { const int ch = tid + NTHR * i, r = ch >> 5, c16 = ch & 31; *(LAS v4u*)(VV + r * SV + c16 * 16) = cur.v[i]; }
            if (j + 1 < GLA_GRP) gla2_load_raw(cur, proj, gt, row0 + GLA_C, h, tid, true);
            __syncthreads();
            if (wave < 4) {
                const int mi = wave >> 1, ni = wave & 1;
                mf32x16 at = zero16();
                if (!(mi == 0 && ni == 1)) {
#pragma unroll
                    for (int ks = 0; ks < 8; ++ks) at = MFMA32(frag_rk(QD, SQ, 32 * mi, 16 * ks, lane), frag_rk(KI, SQ, 32 * ni, 16 * ks, lane), at);
                }
#pragma unroll
                for (int r = 0; r < 16; ++r) { const int cc = 32 * mi + crow32(r, hi), ss = 32 * ni + (lane & 31);
                    *(LAS bf16*)(AT + cc * SA + ss * 2) = (bf16)f2bf((ss <= cc) ? at[r] : 0.f); }
            }
            __syncthreads();
            mf32x16 acc[2]; acc[0] = zero16(); acc[1] = zero16();
#pragma unroll
            for (int ks = 0; ks < 4; ++ks) { const mbf16x8 bfr = frag_kn(VV, SV, 16 * ks, 32 * wave, lane);
                if (ks < 2) acc[0] = MFMA32(frag_rk(AT, SA, 0, 16 * ks, lane), bfr, acc[0]);
                acc[1] = MFMA32(frag_rk(AT, SA, 32, 16 * ks, lane), bfr, acc[1]); }
#pragma unroll
            for (int kt = 0; kt < 4; ++kt)
#pragma unroll
                for (int sx = 0; sx < 2; ++sx) {
                    v4u bw; bw.x = pk2(S[kt][8 * sx + 0], S[kt][8 * sx + 1]); bw.y = pk2(S[kt][8 * sx + 2], S[kt][8 * sx + 3]); bw.z = pk2(S[kt][8 * sx + 4], S[kt][8 * sx + 5]); bw.w = pk2(S[kt][8 * sx + 6], S[kt][8 * sx + 7]);
                    const mbf16x8 bfr = __builtin_bit_cast(mbf16x8, bw);
#pragma unroll
                    for (int mi = 0; mi < 2; ++mi) { const LAS unsigned char* qp = QD + (32 * mi + (lane & 31)) * SQ + (32 * kt + 16 * sx + 4 * hi) * 2;
                        const v2u a0 = *(const LAS v2u*)qp, a1 = *(const LAS v2u*)(qp + 16);
                        v4u aw; aw.x = a0.x; aw.y = a0.y; aw.z = a1.x; aw.w = a1.y;
                        acc[mi] = MFMA32(__builtin_bit_cast(mbf16x8, aw), bfr, acc[mi]); } }
            if (j + 1 < GLA_GRP) gla2_state_update(S, KE, VV, DEC, wave, lane, true);
            __syncthreads();
#pragma unroll
            for (int mi = 0; mi < 2; ++mi)
#pragma unroll
                for (int r = 0; r < 16; ++r) OS[(32 * mi + crow32(r, hi)) * SO + 32 * wave + (lane & 31)] = acc[mi][r];
            __syncthreads();
#pragma unroll
            for (int p = 0; p < 4; ++p) { const int cc = p * 16 + wave * 2 + hi, c8 = (lane & 31) * 8;
                const f32x4 s0 = *(const LAS f32x4*)(OS + cc * SO + c8), s1 = *(const LAS f32x4*)(OS + cc * SO + c8 + 4);
                float ss = (s0.x * s0.x + s0.y * s0.y) + (s0.z * s0.z + s0.w * s0.w) + (s1.x * s1.x + s1.y * s1.y) + (s1.z * s1.z + s1.w * s1.w);
                ss = sum_lanes32(ss);
                const float rs = __builtin_amdgcn_rsqf(ss * (1.0f / 256.0f) + EPS);
                const f32x4 n0 = *(const f32x4*)(head_norm + c8), n1 = *(const f32x4*)(head_norm + c8 + 4);
                const v4u gw = gwv[p];
                const float gg[8] = {bflo(gw.x), bfhi(gw.x), bflo(gw.y), bfhi(gw.y), bflo(gw.z), bfhi(gw.z), bflo(gw.w), bfhi(gw.w)};
                const float ov[8] = {s0.x * n0.x, s0.y * n0.y, s0.z * n0.z, s0.w * n0.w, s1.x * n1.x, s1.y * n1.y, s1.z * n1.z, s1.w * n1.w};
                float o[8];
#pragma unroll
                for (int jj = 0; jj < 8; ++jj) o[jj] = ov[jj] * rs * (gg[jj] * __builtin_amdgcn_rcpf(1.f + __builtin_amdgcn_exp2f(-gg[jj] * LOG2E)));
                v4u w; w.x = pk2(o[0], o[1]); w.y = pk2(o[2], o[3]); w.z = pk2(o[4], o[5]); w.w = pk2(o[6], o[7]);
                if (dummy) *(v4u*)((bf16*)(a.ws + WS_STATE + 32 * MiB) + (size_t)(row0 + cc) * 1024 + h * 256 + c8) = w;
                else *(v4u*)(proj + (size_t)(row0 + cc) * GLA_PITCH + 1024 + h * 256 + c8) = w; }
            __syncthreads();
        }
    }
}

template <int L> __device__ __forceinline__ LayerP layer_params_ct(const CAS cfptr* in) {
    constexpr int base = (L == 0) ? 1 : (L == 1) ? 11 : (L == 2) ? 22 : 32;
    constexpr int kind = (L == 1) ? K_DIFF : (L == 2) ? K_SGU : K_GLA;
    constexpr int sh = (kind == K_DIFF) ? 1 : 0;
    LayerP p; p.kind = kind;
    p.norm1 = in[base]; p.w_in = in[base + 1];
    p.e0 = in[base + 2]; p.e1 = in[base + 3]; p.e2 = in[base + 4]; p.e3 = in[base + 5]; p.e4 = in[base + 6];
    p.w_out = in[base + 6 + sh]; p.norm2 = in[base + 7 + sh]; p.w1 = in[base + 8 + sh]; p.w2 = in[base + 9 + sh];
    p.nin = (kind == K_GLA) ? GLA_PITCH : (kind == K_DIFF) ? DIFF_PITCH : SGU_PITCH;
    p.mixoff = (kind == K_GLA) ? 1024 : 0;
    return p;
}
__device__ __forceinline__ void seam_xcd(const CAS Args* ap, LAS unsigned char* lds_k) {
#if PROBE_KIND == 1
    for (int br = 0; br < PROBE_REP; ++br)
#endif
    { XcdBarrier bb; bb.bar = (unsigned*)(ap->ws + WS_CTL) + 4096; bb.x = xb_xcc_id(); bb.st = (volatile LAS unsigned*)(lds_k + MISC_OFF) + 8; xcd_barrier(bb); }
}
#define PH_BEGIN(PK) { const int nrep_ = (PROBE_KIND == (PK) && (PK) != 0) ? PROBE_REP : 1; \
    for (int rep_ = 0; rep_ < nrep_; ++rep_) { \
    int vcu = vcu0, G = G0; asm volatile("" : "+s"(vcu), "+s"(G)); \
    LAS unsigned char* lds = lds_k; asm volatile("" : "+s"(lds)); \
    const CAS Args* ap = (const CAS Args*)__builtin_amdgcn_kernarg_segment_ptr(); asm volatile("" : "+s"(ap)); \
    Ctx args; args.in0 = ap->in[0]; args.in42 = ap->in[42]; args.out = ap->out; args.ws = ap->ws; \
    bf16* Wb = (bf16*)(args.ws + WS_W); bf16* XB = (bf16*)(args.ws + WS_XB); bf16* HB = (bf16*)(args.ws + WS_H); \
    float* SSQ = (float*)(args.ws + WS_SSQ); float* SSQ2 = (float*)(args.ws + WS_SSQ2); float* VSSQ = (float*)(args.ws + WS_VSSQ); \
    const LayerP P = layer_params_ct<L>((const CAS cfptr*)ap); \
    (void)Wb; (void)XB; (void)HB; (void)SSQ; (void)SSQ2; (void)VSSQ; (void)P; (void)vcu; (void)G; (void)lds;
#define PH_END_SEAM   seam_xcd(ap, lds_k); } }
#define PH_END_NOSEAM } }

template <int L> __device__ __forceinline__ void run_layer(LAS unsigned char* lds_k, int vcu0, int G0) {
    constexpr int kind = (L == 1) ? K_DIFF : (L == 2) ? K_SGU : K_GLA;
    PH_BEGIN(5) phase_conv(lds, args, P, L, vcu, G, (CONV_SPLIT && kind == K_GLA && G == 256) ? 1 : 0);
#if CG_SYNC_AT_START
    seam_xcd(ap, lds_k);
#else
    if (L == 0) { if (rep_ + 1 == nrep_) cg::this_grid().sync(); else seam_xcd(ap, lds_k); } else seam_xcd(ap, lds_k);
#endif
    PH_END_NOSEAM
    PH_BEGIN(3) { EpiIn E{kind, HB, SSQ, (kind == K_GLA) ? P.e2 : P.e0, VSSQ, (unsigned*)(args.ws + WS_CTL) + CW_QKMAX}; run_gemm(lds, XB, D, Wb + WOFF_IN, NTOK, P.nin, D, E, vcu, G);
        if constexpr (CONV_SPLIT && kind == K_GLA) { int bxo = (int)blockIdx.x; asm volatile("" : "+s"(bxo));
            if (G == 256 && bxo >= 128) { LAS unsigned char* lds2 = lds_k; asm volatile("" : "+s"(lds2)); phase_conv(lds2, args, P, L, bxo - 128, 128, 2); } } } PH_END_SEAM
    if constexpr (kind == K_GLA) {
        PH_BEGIN(4) phase_gla2_kv(lds, args, P, vcu, G); PH_END_SEAM
        PH_BEGIN(0) phase_gla2_scan(args, vcu, G); PH_END_SEAM
        PH_BEGIN(9) phase_gla2_out(lds, args, P, vcu, G, rep_ + 1 < nrep_); PH_END_SEAM
    } else if constexpr (kind == K_DIFF) {
        PH_BEGIN(7)
            if (rep_ > 0) { if (blockIdx.x == 0 && otid() == 0) __hip_atomic_store((unsigned*)(ap->ws + WS_CTL) + CW_QUEUE, 0u, RLX_AGENT); seam_xcd(ap, lds_k); }
            phase_diff_mfma((char*)lds_raw, lds, args, vcu, G);
        PH_END_SEAM
        PH_BEGIN(6) phase_diff_combine(args, P, vcu, G); PH_END_SEAM
    } else {
        PH_BEGIN(10) phase_sgu_mfma(lds, args, P, vcu, G, rep_ + 1 < nrep_); PH_END_SEAM
    }
    PH_BEGIN(L == 0 ? 8 : 0) { EpiResT<false> E{XB, SSQ2, nullptr}; run_gemm(lds, HB + P.mixoff, P.nin, Wb + WOFF_OUT, NTOK, D, D, E, vcu, G); } PH_END_SEAM
#if PROBE_KIND == 11
    PH_BEGIN(11) { EpiHid E{HB}; E.nostore = (rep_ + 1 < nrep_) ? 1 : 0; run_gemm(lds, XB, D, Wb + WOFF_1, NTOK, FF, D, E, vcu, G); } PH_END_SEAM
#else
    PH_BEGIN(2) { EpiHid E{HB}; run_gemm(lds, XB, D, Wb + WOFF_1, NTOK, FF, D, E, vcu, G); } PH_END_SEAM
#endif
    PH_BEGIN(0) { EpiResT<true> E{XB, SSQ, SSQ2}; run_gemm(lds, HB, FF, Wb + WOFF_2, NTOK, D, FF, E, vcu, G); } PH_END_SEAM
}

__global__ void __launch_bounds__(NTHR, 2) trunk_fwd(Args kargs) {
    LAS unsigned char* const lds_k = (LAS unsigned char*)lds_raw;
    const int G0 = gridDim.x; const int bx = blockIdx.x;
    const int vcu0 = (G0 % 8 == 0) ? (bx % 8) * (G0 / 8) + bx / 8 : bx;
    { const int tid = threadIdx.x;
      for (int u = tid; u < (LDS_BYTES - LDSCTL_OFF) / 4; u += NTHR) ((LAS unsigned*)(lds_k + LDSCTL_OFF))[u] = 0u;
      __syncthreads();
      if ((tid & 63) == 0) ((LAS unsigned*)(lds_k + TIDTAB_OFF))[hw_slot()] = (unsigned)(tid >> 6);
      __syncthreads(); }
    (void)xcd_barrier_post((unsigned*)(kargs.ws + WS_CTL) + 4096, (volatile LAS unsigned*)(lds_k + MISC_OFF) + 8);
#if CG_SYNC_AT_START
    cg::this_grid().sync();
#endif
    run_layer<0>(lds_k, vcu0, G0);
    run_layer<1>(lds_k, vcu0, G0);
    run_layer<2>(lds_k, vcu0, G0);
    run_layer<3>(lds_k, vcu0, G0);
    { int vcu = vcu0, G = G0; asm volatile("" : "+s"(vcu), "+s"(G));
      const CAS Args* ap = (const CAS Args*)__builtin_amdgcn_kernarg_segment_ptr(); asm volatile("" : "+s"(ap));
      Ctx args; args.in0 = ap->in[0]; args.in42 = ap->in[42]; args.out = ap->out; args.ws = ap->ws;
      phase_final(args, vcu, G); }
}

extern "C" void kernel_launch(void* const* d_in, const int* in_sizes, int n_in, void* d_out, int out_size, void* d_ws, size_t ws_size, hipStream_t stream) {
    static int grid = 0;
    if (grid == 0) {
        if (n_in != 43 || in_sizes[0] != NTOK * D || out_size != NTOK * D || ws_size < WS_END) {
            fprintf(stderr, "kernel_launch: unexpected problem (n_in %d, in0 %d, out %d, ws %zu); nothing launched\n", n_in, n_in > 0 ? in_sizes[0] : -1, out_size, ws_size); grid = -1; return; }
        int dev = 0, cus = 0, per_cu = 0;
        if (hipGetDevice(&dev) != hipSuccess || hipDeviceGetAttribute(&cus, hipDeviceAttributeMultiprocessorCount, dev) != hipSuccess) { grid = -1; return; }
        if (hipFuncSetAttribute((const void*)trunk_fwd, hipFuncAttributeMaxDynamicSharedMemorySize, LDS_BYTES) != hipSuccess) { fprintf(stderr, "kernel_launch: hipFuncSetAttribute failed\n"); grid = -1; return; }
        if (hipOccupancyMaxActiveBlocksPerMultiprocessor(&per_cu, (const void*)trunk_fwd, NTHR, LDS_BYTES) != hipSuccess || per_cu < 1) { fprintf(stderr, "kernel_launch: occupancy query says %d blocks/CU\n", per_cu); per_cu = 1; }
        (void)hipGetLastError();
        grid = cus;
    }
    if (grid < 0) return;
    (void)hipMemsetAsync((char*)d_ws + WS_CTL, 0, CTL_ZERO_BYTES, stream);
    Args a{};
    for (int i = 0; i < 43; ++i) a.in[i] = (const float*)d_in[i];
    a.out = (float*)d_out; a.ws = (unsigned char*)d_ws;
    a.ph_lo = 0; a.ph_hi = 0;
    void* kargs[] = {&a};
    hipError_t e = hipLaunchCooperativeKernel((const void*)trunk_fwd, dim3(grid), dim3(NTHR), kargs, LDS_BYTES, stream);
    if (e != hipSuccess) fprintf(stderr, "kernel_launch: cooperative launch failed: %s (grid %d)\n", hipGetErrorString(e), grid);
}
```

```cpp
#include <hip/hip_runtime.h>
#include <hip/hip_cooperative_groups.h>
#include <cstdio>
#include <cstdint>
namespace cg = cooperative_groups;


#define GAS __attribute__((address_space(1)))
#define LAS __attribute__((address_space(3)))
typedef unsigned short bf16;
typedef unsigned v4u __attribute__((ext_vector_type(4)));
typedef unsigned v2u __attribute__((ext_vector_type(2)));
typedef float f32x4 __attribute__((ext_vector_type(4)));
typedef float f32x2v __attribute__((ext_vector_type(2)));

constexpr int NB = 2, T = 8192, D = 1024, NTOK = NB * T, FF = 4096;
constexpr float EPS = 1e-6f;
constexpr float LOG2E = 1.4426950408889634f;
constexpr int NWAVES = 8, NTHR = 512;
constexpr int K_GLA = 0, K_DIFF = 1, K_SGU = 2;
constexpr int GLA_H = 4, GLA_HK = 128, GLA_HV = 256, GLA_C = 64, GLA_NC = T / GLA_C;
#ifndef GLA_RANK16
#define GLA_RANK16 0
#endif
constexpr int GLA_PITCH = GLA_RANK16 ? 3072 : 3584;
constexpr int DIFF_H = 8, DIFF_PITCH = 3072;
constexpr float LAMBDA_INIT = 0.35551069f;
constexpr int SGU_PITCH = 2048, SGU_C = 128, SGU_G = 8;

constexpr size_t MiB = 1u << 20;
constexpr size_t WS_CTL = 0, CTL_ZERO_BYTES = 64 * 1024;
constexpr size_t WS_SSQ = 1 * MiB;
constexpr size_t WS_VSSQ = 2 * MiB;
constexpr size_t WS_R = 2 * MiB;
constexpr size_t WS_DEC = 3 * MiB;
constexpr size_t WS_W = 4 * MiB;
constexpr size_t WS_XB = 29 * MiB;
constexpr size_t WS_STATE = 61 * MiB;
constexpr size_t WS_H = 125 * MiB;
constexpr size_t WS_SSQ2 = 253 * MiB;
constexpr size_t WS_END = 254 * MiB;
constexpr int CW_QKMAX = 8192;
constexpr int CW_QUEUE = 8448;
constexpr size_t WOFF_IN = 0, WOFF_OUT = (size_t)3584 * 1024, WOFF_1 = WOFF_OUT + (size_t)1024 * 1024, WOFF_2 = WOFF_1 + (size_t)4096 * 1024;

#ifndef CG_SYNC_AT_START
#define CG_SYNC_AT_START 1
#endif
#ifndef ATTN_SREF
#define ATTN_SREF 1
#endif
#ifndef CONV_SPLIT
#define CONV_SPLIT 1
#endif
#ifndef PROBE_KIND
#define PROBE_KIND 0
#endif
#ifndef PROBE_REP
#define PROBE_REP 2
#endif
constexpr int RING_BYTES = 131072, LDSCTL_OFF = RING_BYTES, MISC_OFF = LDSCTL_OFF + 320, LDS_BYTES = 147456;

#define RLX_AGENT __ATOMIC_RELAXED, __HIP_MEMORY_SCOPE_AGENT
#define LDS_WAIT() asm volatile("s_waitcnt lgkmcnt(0)" ::: "memory")
__device__ __forceinline__ unsigned f2bf(float f) { unsigned u = __builtin_bit_cast(unsigned, f); return (u + 0x7fffu + ((u >> 16) & 1u)) >> 16; }
typedef float pk_f32x2 __attribute__((ext_vector_type(2))); typedef __bf16 pk_bf16x2 __attribute__((ext_vector_type(2)));
__device__ __forceinline__ unsigned pk2(float lo, float hi) { pk_f32x2 v = {lo, hi}; pk_bf16x2 b = __builtin_convertvector(v, pk_bf16x2); return __builtin_bit_cast(unsigned, b); }
__device__ __forceinline__ float bf2f(unsigned b) { return __builtin_bit_cast(float, b << 16); }
__device__ __forceinline__ float bflo(unsigned w) { return __builtin_bit_cast(float, w << 16); }
__device__ __forceinline__ float bfhi(unsigned w) { return __builtin_bit_cast(float, w & 0xffff0000u); }
extern __shared__ __attribute__((aligned(16))) unsigned char lds_raw[];
constexpr int TIDTAB_OFF = 131072;
__device__ __forceinline__ unsigned hw_slot() { return (unsigned)__builtin_amdgcn_s_getreg((5 << 11) | 4) & 63u; }
__device__ __forceinline__ int otid() {
    const int wv = (int)((volatile __attribute__((address_space(3))) unsigned*)((__attribute__((address_space(3))) unsigned char*)lds_raw + TIDTAB_OFF))[hw_slot()];
    int ln; asm volatile("v_mbcnt_lo_u32_b32 %0, -1, 0\n\tv_mbcnt_hi_u32_b32 %0, -1, %0" : "=v"(ln));
    int t = wv * 64 + ln;
    asm volatile("" : "+v"(t)); return t; }
#ifndef EPI_SC1
#define EPI_SC1 0
#endif
__device__ __forceinline__ void store16(void* p, v4u v) {
#if EPI_SC1
    asm volatile("global_store_dwordx4 %0, %1, off sc1\n\ts_nop 1" :: "v"(p), "v"(v) : "memory");
#else
    *(v4u*)p = v;
#endif
}
__device__ __forceinline__ float xl_1(float v)  { return __int_as_float(__builtin_amdgcn_mov_dpp(__float_as_int(v), 0xB1, 0xF, 0xF, true)); }
__device__ __forceinline__ float xl_2(float v)  { return __int_as_float(__builtin_amdgcn_mov_dpp(__float_as_int(v), 0x4E, 0xF, 0xF, true)); }
__device__ __forceinline__ float xl_4(float v)  { return __int_as_float(__builtin_amdgcn_mov_dpp(__float_as_int(v), 0x141, 0xF, 0xF, true)); }
__device__ __forceinline__ float xl_8(float v)  { return __int_as_float(__builtin_amdgcn_mov_dpp(__float_as_int(v), 0x140, 0xF, 0xF, true)); }
__device__ __forceinline__ float sum_x16(float v) { auto r = __builtin_amdgcn_permlane16_swap(__float_as_uint(v), __float_as_uint(v), false, false); return __uint_as_float(r[0]) + __uint_as_float(r[1]); }
__device__ __forceinline__ float sum_x32(float v) { auto r = __builtin_amdgcn_permlane32_swap(__float_as_uint(v), __float_as_uint(v), false, false); return __uint_as_float(r[0]) + __uint_as_float(r[1]); }
__device__ __forceinline__ float max_x16(float v) { auto r = __builtin_amdgcn_permlane16_swap(__float_as_uint(v), __float_as_uint(v), false, false); return fmaxf(__uint_as_float(r[0]), __uint_as_float(r[1])); }
__device__ __forceinline__ float max_x32(float v) { auto r = __builtin_amdgcn_permlane32_swap(__float_as_uint(v), __float_as_uint(v), false, false); return fmaxf(__uint_as_float(r[0]), __uint_as_float(r[1])); }
__device__ __forceinline__ float sum_lanes8(float v)  { v += xl_1(v); v += xl_2(v); v += xl_4(v); return v; }
__device__ __forceinline__ float sum_lanes32(float v) { v = sum_lanes8(v); v += xl_8(v); return sum_x16(v); }
__device__ __forceinline__ float wave_sum(float v) { return sum_x32(sum_lanes32(v)); }
__device__ __forceinline__ float wave_max(float v) { v = fmaxf(v, xl_1(v)); v = fmaxf(v, xl_2(v)); v = fmaxf(v, xl_4(v)); v = fmaxf(v, xl_8(v)); return max_x32(max_x16(v)); }
__device__ __forceinline__ float gelu_tanh(float x) {
    const float u = 0.7978845608028654f * (x + 0.044715f * x * x * x);
    const float e = __builtin_amdgcn_exp2f(u * (2.f * LOG2E));
    return x - x * __builtin_amdgcn_rcpf(e + 1.f);
}
__device__ __forceinline__ float log_sigmoid(float z) { return fminf(z, 0.f) - 0.6931471805599453f * __builtin_amdgcn_logf(1.0f + __builtin_amdgcn_exp2f(-fabsf(z) * LOG2E)); }

#define XB_TMO      128
#define XB_XCNT(j)  (256  + 64 * (j))
#define XB_XSUB(j)  (1280 + 64 * (j))
#define XB_XGEN(j)  (2304 + 64 * (j))
#define XB_TOP      3328
#define XB_TOPGEN   3392
#define XCD_BAR_WORDS 3456
#define XB_SPIN_CAP (1u << 22)
__device__ __forceinline__ unsigned xb_ld(unsigned* p)              { return __hip_atomic_load(p, __ATOMIC_RELAXED, __HIP_MEMORY_SCOPE_AGENT); }
__device__ __forceinline__ unsigned xb_add(unsigned* p, unsigned v) { return __hip_atomic_fetch_add(p, v, __ATOMIC_RELAXED, __HIP_MEMORY_SCOPE_AGENT); }
__device__ __forceinline__ unsigned xb_xcc_id() { return (unsigned)__builtin_amdgcn_s_getreg((3 << 11) | 20) & 0xFu; }
#define XB_SPIN(cond, bar) do { unsigned _sp = 0; while (cond) {   \
    if ((++_sp & 255u) == 0u) { if (xb_ld(&(bar)[XB_TMO])) break; if (_sp > XB_SPIN_CAP) { atomicAdd(&(bar)[XB_TMO], 1u); break; } } } } while (0)
__device__ __forceinline__ void xb_spin2(unsigned* p, unsigned gen, unsigned* bar) {
    unsigned v0, v1, sp = 0u;
    asm volatile("global_load_dword %0, %1, off sc1" : "=&v"(v0) : "v"(p) : "memory");
    for (;;) {
        asm volatile("global_load_dword %0, %1, off sc1" : "=&v"(v1) : "v"(p) : "memory");
        asm volatile("s_waitcnt vmcnt(1)" : "+v"(v0) :: "memory");
        if (v0 != gen) break;
        asm volatile("global_load_dword %0, %1, off sc1" : "=&v"(v0) : "v"(p) : "memory");
        asm volatile("s_waitcnt vmcnt(1)" : "+v"(v1) :: "memory");
        if (v1 != gen) break;
        if ((++sp & 127u) == 0u) { asm volatile("s_waitcnt vmcnt(0)" : "+v"(v0) :: "memory"); if (xb_ld(&bar[XB_TMO])) break; if (sp > (XB_SPIN_CAP >> 1)) { atomicAdd(&bar[XB_TMO], 1u); break; } }
    }
    asm volatile("s_waitcnt vmcnt(0)" : "+v"(v0), "+v"(v1) :: "memory");
}
struct XcdBarrier { unsigned* bar; unsigned x; volatile LAS unsigned* st; };
__device__ __forceinline__ XcdBarrier xcd_barrier_post(unsigned* bar, volatile LAS unsigned* st) {
    XcdBarrier b; b.bar = bar; b.x = xb_xcc_id(); b.st = st;
    if (threadIdx.x == 0) (void)xb_add(&bar[XB_XCNT(b.x)], 1u);
    return b;
}
__device__ __forceinline__ void xcd_barrier_complete(unsigned* bar, unsigned x, unsigned& nloc, unsigned& nx) {
    const unsigned G = gridDim.x * gridDim.y * gridDim.z;
    unsigned sum, cnt, mine, sp = 0u;
    for (;;) {
        sum = 0u; cnt = 0u; mine = 0u;
#pragma unroll
        for (unsigned j = 0; j < 16; ++j) { const unsigned c = xb_ld(&bar[XB_XCNT(j)]); sum += c; cnt += (c > 0u) ? 1u : 0u; mine = (j == x) ? c : mine; }
        if (sum == G) break;
        __builtin_amdgcn_s_sleep(1);
        if ((++sp & 255u) == 0u) { if (xb_ld(&bar[XB_TMO])) break; if (sp > XB_SPIN_CAP) { atomicAdd(&bar[XB_TMO], 1u); break; } }
    }
    nloc = mine > 0u ? mine : 1u; nx = cnt > 0u ? cnt : 1u;
}
__device__ __forceinline__ void xcd_barrier(const XcdBarrier& b, bool release = true) {
    asm volatile("s_waitcnt vmcnt(0)" ::: "memory");
    __syncthreads();
    if (otid() == 0) {
        unsigned* bar = b.bar;
        __builtin_amdgcn_s_waitcnt(0);
        unsigned nloc = b.st[0], nx = b.st[1];
        if (nloc == 0u) { xcd_barrier_complete(bar, b.x, nloc, nx); b.st[0] = nloc; b.st[1] = nx; }
        const unsigned old = xb_add(&bar[XB_XSUB(b.x)], 1u);
        const unsigned gen = old / nloc;
        if (old + 1u == (gen + 1u) * nloc) {
            if (release) __builtin_amdgcn_fence(__ATOMIC_RELEASE, "agent");
            asm volatile("s_waitcnt vmcnt(0)" ::: "memory");
            const unsigned og = xb_add(&bar[XB_TOP], 1u);
            const unsigned tg = og / nx;
            if (og + 1u != (tg + 1u) * nx) { const unsigned want = (tg + 1u) * nx; XB_SPIN(xb_ld(&bar[XB_TOP]) < want, bar); }
            __builtin_amdgcn_fence(__ATOMIC_ACQUIRE, "agent");
            xb_add(&bar[XB_XGEN(b.x)], 1u);
            asm volatile("s_waitcnt vmcnt(0)" ::: "memory");
        } else {
            xb_spin2(&bar[XB_XGEN(b.x)], gen, bar);
            __builtin_amdgcn_fence(__ATOMIC_ACQUIRE, "agent");
            asm volatile("s_waitcnt vmcnt(0)" ::: "memory");
        }
    }
    __syncthreads();
}

struct Args { const float* in[43]; float* out; unsigned char* ws; int ph_lo, ph_hi; };
struct Ctx { const float* in0; const float* in42; float* out; unsigned char* ws; };
struct LayerP {
    int kind;
    const float *norm1, *w_in, *w_out, *norm2, *w1, *w2;
    const float *e0, *e1, *e2, *e3, *e4;
    int nin;
    int mixoff;
};
typedef const float* cfptr;
#define CAS __attribute__((address_space(4)))
__device__ __forceinline__ float row_rstd(const float* ssq, int row) {
    const f32x4* p = (const f32x4*)(ssq + (size_t)row * 16);
    const f32x4 a = p[0], b = p[1], c = p[2], d = p[3];
    const float s = ((a.x + a.y) + (a.z + a.w)) + ((b.x + b.y) + (b.z + b.w)) + ((c.x + c.y) + (c.z + c.w)) + ((d.x + d.y) + (d.z + d.w));
    return __builtin_amdgcn_rsqf(s * (1.0f / D) + EPS);
}

typedef float f2 __attribute__((ext_vector_type(2)));
__device__ __forceinline__ unsigned pk2v(f2 t) { pk_bf16x2 b = __builtin_convertvector(t, pk_bf16x2); return __builtin_bit_cast(unsigned, b); }
__device__ __forceinline__ f2 f2s(float x) { return (f2){x, x}; }
template <int AUX = 0>
__device__ __forceinline__ void store16o(const void* base, size_t off_bytes, v4u v) {
    __builtin_amdgcn_raw_buffer_store_b128(v, __builtin_amdgcn_make_buffer_rsrc((void*)base, 0, 0x7fffffff, 0x00020000), (int)off_bytes, 0, AUX);
}
#ifndef RES_PRELOAD
#define RES_PRELOAD true
#endif
#ifndef LAST_WT
#define LAST_WT 1
#endif
#ifndef RES_PACK
#define RES_PACK true
#endif
#ifndef RES_WT
#define RES_WT 1
#endif
__device__ __forceinline__ f2 gelu_tanh2(f2 x) {
    const f2 x2 = x * x;
    const f2 p = x2 * f2s(0.044715f * 0.7978845608028654f * 2.f * LOG2E) + f2s(0.7978845608028654f * 2.f * LOG2E);
    const f2 arg = x * p;
    const f2 e = (f2){__builtin_amdgcn_exp2f(arg.x), __builtin_amdgcn_exp2f(arg.y)} + f2s(1.f);
    const f2 r = (f2){__builtin_amdgcn_rcpf(e.x), __builtin_amdgcn_rcpf(e.y)};
    return x - x * r;
}
struct EpiIn {
    int kind; bf16* proj; const float* ssq; const float* bias;
    float* vssq;
    static constexpr bool NEEDS_RS = true; static constexpr bool PRELOAD = false; static constexpr bool PACK_PART = false;
    __device__ __forceinline__ float apply8(int row, int col0, const float (&v)[8], float rs, bool last) const {
        f2 t[4] = {(f2){v[0], v[1]}, (f2){v[2], v[3]}, (f2){v[4], v[5]}, (f2){v[6], v[7]}};
        f2 part2 = f2s(0.f); int pitch;
        if (kind == K_GLA) { pitch = GLA_PITCH;
            if (col0 < 3072) {
#pragma unroll
                for (int j = 0; j < 4; ++j) t[j] = t[j] * f2s(rs);
            } else {
#pragma unroll
                for (int j = 0; j < 4; ++j) { const f2 bb = *(const LAS f2*)(bias_lds + col0 - 3072 + 2 * j); const f2 z = t[j] * f2s(rs) + bb;
                    t[j] = (f2){log_sigmoid(z.x), log_sigmoid(z.y)} * f2s(1.0f / 16.0f); }
            }
        } else if (kind == K_DIFF) { pitch = DIFF_PITCH;
            const float sc = (col0 < 1024) ? rs * (0.125f * LOG2E) : rs;
#pragma unroll
            for (int j = 0; j < 4; ++j) t[j] = t[j] * f2s(sc);
            if (col0 < 2048) {
#pragma unroll
                for (int j = 0; j < 4; ++j) part2 += t[j] * t[j];
            }
        } else { pitch = SGU_PITCH;
#pragma unroll
            for (int j = 0; j < 4; ++j) { const f2 bb = *(const LAS f2*)(bias_lds + col0 + 2 * j); t[j] = gelu_tanh2(t[j] * f2s(rs) + bb); }
            if (col0 >= 1024) {
#pragma unroll
                for (int j = 0; j < 4; ++j) part2 += t[j] * t[j];
            }
        }
        v4u w; w.x = pk2v(t[0]); w.y = pk2v(t[1]); w.z = pk2v(t[2]); w.w = pk2v(t[3]);
        if (LAST_WT && last) store16o<16>(proj, ((size_t)row * pitch + col0) * 2, w); else store16o(proj, ((size_t)row * pitch + col0) * 2, w);
        return part2.x + part2.y;
    }
    __device__ __forceinline__ void store_part(int row, int col0, int idx, float part) const {
        if (kind == K_SGU && col0 >= 1024) vssq[(size_t)row * 16 + idx] = part;
    }
    static constexpr bool GROUPMAX = true;
    unsigned* qkmax;
    const LAS float* rs_tab = nullptr; int rs_row0 = -1;
    const LAS float* bias_lds = nullptr;
    static constexpr bool HAS_BIAS = true;
    __device__ __forceinline__ int bias_count() const { return kind == K_GLA ? 512 : (kind == K_SGU ? 2048 : 0); }
    __device__ __forceinline__ bool want_groupmax(int col0) const { return kind == K_DIFF && col0 < 2048; }
    __device__ __forceinline__ void store_groupmax(int row, int col0, float m) const {
        atomicMax(qkmax + (row >> 13) * 64 + (col0 >> 5), __float_as_uint(m * 1.01f));
    }
};
struct EpiHid {
    bf16* h;
    int nostore = 0;
    static constexpr bool NEEDS_RS = false; static constexpr bool HAS_BIAS = false; static constexpr bool PRELOAD = false; static constexpr bool PACK_PART = false;
    __device__ __forceinline__ float apply8(int row, int col0, const float (&v)[8], float, bool last) const {
        f2 t[4];
#pragma unroll
        for (int j = 0; j < 4; ++j) { const f2 a = {__int_as_float(max(__float_as_int(v[2 * j]), 0)), __int_as_float(max(__float_as_int(v[2 * j + 1]), 0))}; t[j] = a * a; }
        v4u w; w.x = pk2v(t[0]); w.y = pk2v(t[1]); w.z = pk2v(t[2]); w.w = pk2v(t[3]);
#if PROBE_KIND == 11
        if (nostore) { asm volatile("" :: "v"(w.x), "v"(w.y), "v"(w.z), "v"(w.w)); return 0.f; }
#endif
        if (LAST_WT && last) store16o<16>(h, ((size_t)row * FF + col0) * 2, w); else store16o(h, ((size_t)row * FF + col0) * 2, w);
        return 0.f;
    }
    __device__ __forceinline__ void store_part(int, int, int, float) const {}
    static constexpr bool GROUPMAX = false;
    __device__ __forceinline__ bool want_groupmax(int) const { return false; }
    __device__ __forceinline__ void store_groupmax(int, int, float) const {}
};
template <bool RS2> struct EpiResT {
    bf16* xb; float* ssq_out; const float* ssq;
    const LAS float* rs_tab = nullptr; int rs_row0 = -1;
    static constexpr bool NEEDS_RS = RS2; static constexpr bool HAS_BIAS = false;
    static constexpr bool PRELOAD = RES_PRELOAD; static constexpr bool PACK_PART = RES_PACK;
    __device__ __forceinline__ void store_part4(int row, int idx0, v4u pv) const { store16o<16>(ssq_out, ((size_t)row * 16 + idx0) * 4, pv); }
    __device__ __forceinline__ v4u preload(int row, int col0) const { return *(const v4u*)(xb + (size_t)row * D + col0); }
    __device__ __forceinline__ float apply8(int row, int col0, const float (&v)[8], float rs) const { return apply8p(row, col0, v, rs, preload(row, col0)); }
    __device__ __forceinline__ float apply8p(int row, int col0, const float (&v)[8], float rs, const v4u bw) const {
        const size_t off = (size_t)row * D + col0;
        const f2 s2 = f2s(RS2 ? rs * rs : 1.f);
        const unsigned bwv[4] = {bw.x, bw.y, bw.z, bw.w};
        f2 o[4]; f2 part2 = f2s(0.f);
#pragma unroll
        for (int j = 0; j < 4; ++j) { const f2 x = {bflo(bwv[j]), bfhi(bwv[j])}; const f2 a = {v[2 * j], v[2 * j + 1]};
            o[j] = RS2 ? (a * s2 + x) : (a + x); part2 += o[j] * o[j]; }
        v4u w; w.x = pk2v(o[0]); w.y = pk2v(o[1]); w.z = pk2v(o[2]); w.w = pk2v(o[3]);
        store16o<RES_WT ? 16 : 0>(xb, off * 2, w);
        return part2.x + part2.y;
    }
    __device__ __forceinline__ void store_part(int row, int, int idx, float part) const { ssq_out[(size_t)row * 16 + idx] = part; }
    static constexpr bool GROUPMAX = false;
    __device__ __forceinline__ bool want_groupmax(int) const { return false; }
    __device__ __forceinline__ void store_groupmax(int, int, float) const {}
};

struct ConvItem { const float* W; const float* gain; bf16* WT; int K, N, tile; };
struct ConvRegs { f32x4 w[8]; float g[8]; };
__device__ __forceinline__ void conv_load(ConvRegs& R, const ConvItem& it, int tid) {
    const int nblk = it.N >> 7, kb = it.tile / nblk, nb = it.tile - kb * nblk, k0 = kb << 7, n0 = nb << 7;
    const int n4 = tid & 31, kk = tid >> 5;
    const float* src = it.W + (size_t)(k0 + 8 * kk) * it.N + n0 + 4 * n4;
#pragma unroll
    for (int p = 0; p < 8; ++p) R.w[p] = __builtin_nontemporal_load((const f32x4*)(src + (size_t)p * it.N));
    if (it.gain) { const f32x4 g0 = *(const f32x4*)(it.gain + k0 + 8 * kk), g1 = *(const f32x4*)(it.gain + k0 + 8 * kk + 4);
        R.g[0] = g0.x; R.g[1] = g0.y; R.g[2] = g0.z; R.g[3] = g0.w; R.g[4] = g1.x; R.g[5] = g1.y; R.g[6] = g1.z; R.g[7] = g1.w; }
    else {
#pragma unroll
        for (int p = 0; p < 8; ++p) R.g[p] = 1.f; }
}
__device__ __forceinline__ void conv_store(const ConvRegs& R, const ConvItem& it, LAS unsigned char* img, int tid) {
    const int nblk = it.N >> 7, kb = it.tile / nblk, nb = it.tile - kb * nblk, k0 = kb << 7, n0 = nb << 7;
    const int n4 = tid & 31, kk = tid >> 5;
#pragma unroll
    for (int jn = 0; jn < 4; ++jn) {
        v4u o; o.x = pk2(R.g[0] * R.w[0][jn], R.g[1] * R.w[1][jn]); o.y = pk2(R.g[2] * R.w[2][jn], R.g[3] * R.w[3][jn]); o.z = pk2(R.g[4] * R.w[4][jn], R.g[5] * R.w[5][jn]); o.w = pk2(R.g[6] * R.w[6][jn], R.g[7] * R.w[7][jn]);
        *(LAS v4u*)(img + (4 * n4 + jn) * 256 + ((kk ^ (n4 & 15)) << 4)) = o; }
    __syncthreads();
#pragma unroll
    for (int i = 0; i < 4; ++i) { const int c = tid + NTHR * i, n = c >> 4, kc = c & 15;
        const v4u o = *(const LAS v4u*)(img + n * 256 + ((kc ^ ((n >> 2) & 15)) << 4));
        *(v4u*)(it.WT + (size_t)(n0 + n) * it.K + k0 + 8 * kc) = o; }
    __syncthreads();
}

__device__ __forceinline__ void phase_conv(LAS unsigned char* lds, const Ctx& a, const LayerP& P, int L, int vcu, int G, int part = 0) {
    const int tid = otid(), lane = tid & 63, wave = __builtin_amdgcn_readfirstlane(tid >> 6);
    bf16* Wb = (bf16*)(a.ws + WS_W);
    const int gw = vcu * NWAVES + wave, NGW = G * NWAVES;
    const int nin_w = (P.kind == K_SGU) ? 2048 : 3072;
    const int I_IN = (D / 128) * (nin_w / 128), I_OUT = (D / 128) * (D / 128), I_1 = (D / 128) * (FF / 128), I_2 = (FF / 128) * (D / 128);
    const int NITEMS = I_IN + I_OUT + I_1 + I_2;
    auto item_of = [&](int it) { ConvItem c; int r = it;
        if (r < I_IN) { c.W = P.w_in; c.gain = P.norm1; c.WT = Wb + WOFF_IN; c.K = D; c.N = nin_w; c.tile = r; return c; } r -= I_IN;
        if (r < I_OUT) { c.W = P.w_out; c.gain = nullptr; c.WT = Wb + WOFF_OUT; c.K = D; c.N = D; c.tile = r; return c; } r -= I_OUT;
        if (r < I_1) { c.W = P.w1; c.gain = P.norm2; c.WT = Wb + WOFF_1; c.K = D; c.N = FF; c.tile = r; return c; } r -= I_1;
        c.W = P.w2; c.gain = nullptr; c.WT = Wb + WOFF_2; c.K = FF; c.N = D; c.tile = r; return c; };
    const int it_lo = (part == 2) ? I_IN : 0, it_hi = (part == 1) ? I_IN : NITEMS;
    if (it_lo + vcu < it_hi) {
        int it = it_lo + vcu;
        ConvItem c0 = item_of(it), c1 = c0, c2 = c0; ConvRegs r0, r1, r2;
        conv_load(r0, c0, tid);
        if (it + G < it_hi) { c1 = item_of(it + G); conv_load(r1, c1, tid); } else r1 = r0;
        if (it + 2 * G < it_hi) { c2 = item_of(it + 2 * G); conv_load(r2, c2, tid); } else r2 = r0;
        for (; it < it_hi; it += G) {
            conv_store(r0, c0, lds, tid);
            r0 = r1; c0 = c1; r1 = r2; c1 = c2;
            if (it + 3 * G < it_hi) { c2 = item_of(it + 3 * G); conv_load(r2, c2, tid); }
        }
    }
    if (part == 2) return;
#if GLA_RANK16
    if (P.kind == K_GLA) {
        typedef short cbf16x8 __attribute__((ext_vector_type(8)));
        LAS unsigned char* WgT = lds + 32768;
        { const float* W1 = P.e0;
          for (int k = tid; k < 1024; k += NTHR) { const float gk = P.norm1[k];
              const f32x4 w0 = *(const f32x4*)(W1 + k * 16), w1 = *(const f32x4*)(W1 + k * 16 + 4), w2 = *(const f32x4*)(W1 + k * 16 + 8), w3 = *(const f32x4*)(W1 + k * 16 + 12);
              const float wv[16] = {w0.x, w0.y, w0.z, w0.w, w1.x, w1.y, w1.z, w1.w, w2.x, w2.y, w2.z, w2.w, w3.x, w3.y, w3.z, w3.w};
#pragma unroll
              for (int r = 0; r < 16; ++r) *(LAS bf16*)(WgT + r * 2064 + k * 2) = (bf16)f2bf(gk * wv[r]); } }
        __syncthreads();
        float* R = (float*)(a.ws + WS_R); const bf16* xbr = (const bf16*)(a.ws + WS_XB);
        const int n16 = lane & 15, kq = lane >> 4;
        for (int tile = gw; tile < NTOK / 16; tile += NGW) {
            const int row = tile * 16 + n16;
            f32x4 acc = {0.f, 0.f, 0.f, 0.f}; float sq = 0.f;
#pragma unroll 4
            for (int ks = 0; ks < 32; ++ks) {
                v4u aw;
                if (L == 0) { const f32x4 x0 = *(const f32x4*)(a.in0 + (size_t)row * D + 32 * ks + 8 * kq), x1 = *(const f32x4*)(a.in0 + (size_t)row * D + 32 * ks + 8 * kq + 4);
                    sq += (x0.x * x0.x + x0.y * x0.y) + (x0.z * x0.z + x0.w * x0.w) + (x1.x * x1.x + x1.y * x1.y) + (x1.z * x1.z + x1.w * x1.w);
                    aw.x = pk2(x0.x, x0.y); aw.y = pk2(x0.z, x0.w); aw.z = pk2(x1.x, x1.y); aw.w = pk2(x1.z, x1.w); }
                else { aw = *(const v4u*)(xbr + (size_t)row * D + 32 * ks + 8 * kq);
                    const float e[8] = {bflo(aw.x), bfhi(aw.x), bflo(aw.y), bfhi(aw.y), bflo(aw.z), bfhi(aw.z), bflo(aw.w), bfhi(aw.w)};
#pragma unroll
                    for (int j = 0; j < 8; ++j) sq += e[j] * e[j]; }
                const cbf16x8 bfr = *(const LAS cbf16x8*)(WgT + n16 * 2064 + (32 * ks + 8 * kq) * 2);
                acc = __builtin_amdgcn_mfma_f32_16x16x32_bf16(__builtin_bit_cast(cbf16x8, aw), bfr, acc, 0, 0, 0);
            }
            sq += __shfl_xor(sq, 16); sq += __shfl_xor(sq, 32);
            const float rstd = __builtin_amdgcn_rsqf(sq * (1.0f / D) + EPS);
#pragma unroll
            for (int rg = 0; rg < 4; ++rg) { const float rr = __shfl(rstd, 4 * kq + rg);
                R[(size_t)(tile * 16 + 4 * kq + rg) * 16 + n16] = acc[rg] * rr; }
        }
    }
#else
    if (P.kind == K_GLA) {
        const float* W1 = P.e0; const float* W2 = P.e1;
        for (int e = vcu * NTHR + tid; e < 512 * 1024; e += G * NTHR) {
            const int n = e >> 10, k = e & 1023;
            float s = 0.f;
#pragma unroll
            for (int r = 0; r < 16; ++r) s += W1[k * 16 + r] * W2[r * 512 + n];
            Wb[WOFF_IN + (size_t)(3072 + n) * 1024 + k] = (bf16)f2bf(s * P.norm1[k]);
        }
    }
#endif
    if (L == 0) {
        const float* x = a.in0; bf16* xb = (bf16*)(a.ws + WS_XB); float* ssq = (float*)(a.ws + WS_SSQ);
        for (int m0 = gw; m0 < NTOK; m0 += 2 * NGW) {
            const int m1 = (m0 + NGW < NTOK) ? m0 + NGW : m0;
            f32x4 v[2][4];
#pragma unroll
            for (int j = 0; j < 4; ++j) v[0][j] = __builtin_nontemporal_load((const f32x4*)(x + (size_t)m0 * D) + lane + 64 * j);
#pragma unroll
            for (int j = 0; j < 4; ++j) v[1][j] = __builtin_nontemporal_load((const f32x4*)(x + (size_t)m1 * D) + lane + 64 * j);
#pragma unroll
            for (int q = 0; q < 2; ++q) { const int m = q ? m1 : m0; if (q && m1 == m0) break;
                float s = 0.f;
#pragma unroll
                for (int j = 0; j < 4; ++j) s += (v[q][j].x * v[q][j].x + v[q][j].y * v[q][j].y) + (v[q][j].z * v[q][j].z + v[q][j].w * v[q][j].w);
                s = wave_sum(s);
                v2u* o8 = (v2u*)(xb + (size_t)m * D) + lane;
#pragma unroll
                for (int j = 0; j < 4; ++j) { v2u w; w.x = pk2(v[q][j].x, v[q][j].y); w.y = pk2(v[q][j].z, v[q][j].w); o8[64 * j] = w; }
                if (lane < 16) ssq[(size_t)m * 16 + lane] = (lane == 0) ? s : 0.f; }
        }
    }
}

__device__ __forceinline__ void phase_final(const Ctx& a, int vcu, int G) {
    const int tid = otid(), lane = tid & 63, wave = tid >> 6;
    const int gw = vcu * NWAVES + wave, NGW = G * NWAVES;
    const float* ssq = (const float*)(a.ws + WS_SSQ); const float* g = a.in42; const bf16* xb = (const bf16*)(a.ws + WS_XB);
    const f32x4* gr = (const f32x4*)g;
    for (int m0 = gw; m0 < NTOK; m0 += 2 * NGW) {
        const int m1 = (m0 + NGW < NTOK) ? m0 + NGW : m0;
        v4u w[2][2]; f32x4 sq[2][4];
#pragma unroll
        for (int q = 0; q < 2; ++q) { const int m = q ? m1 : m0;
            const v4u* xr = (const v4u*)(xb + (size_t)m * D) + lane;
            w[q][0] = xr[0]; w[q][1] = xr[64];
            const f32x4* sp = (const f32x4*)(ssq + (size_t)m * 16); sq[q][0] = sp[0]; sq[q][1] = sp[1]; sq[q][2] = sp[2]; sq[q][3] = sp[3]; }
#pragma unroll
        for (int q = 0; q < 2; ++q) { const int m = q ? m1 : m0; if (q && m1 == m0) break;
            const f32x4 a_ = sq[q][0], b_ = sq[q][1], c_ = sq[q][2], d_ = sq[q][3];
            const float ssum = ((a_.x + a_.y) + (a_.z + a_.w)) + ((b_.x + b_.y) + (b_.z + b_.w)) + ((c_.x + c_.y) + (c_.z + c_.w)) + ((d_.x + d_.y) + (d_.z + d_.w));
            const float rs = __builtin_amdgcn_rsqf(ssum * (1.0f / D) + EPS);
            f32x4* orow = (f32x4*)(a.out + (size_t)m * D);
#pragma unroll
            for (int jj = 0; jj < 2; ++jj) { const v4u ww = w[q][jj]; const int c4 = (64 * jj + lane) * 2;
                const f32x4 g0 = gr[c4], g1 = gr[c4 + 1];
                __builtin_nontemporal_store((f32x4){bflo(ww.x) * rs * g0.x, bfhi(ww.x) * rs * g0.y, bflo(ww.y) * rs * g0.z, bfhi(ww.y) * rs * g0.w}, orow + c4);
                __builtin_nontemporal_store((f32x4){bflo(ww.z) * rs * g1.x, bfhi(ww.z) * rs * g1.y, bflo(ww.w) * rs * g1.z, bfhi(ww.w) * rs * g1.w}, orow + c4 + 1); } }
    }
}

struct GlaCum { float b0[8], b1[8], tot0, tot1; };

#ifndef GEMM_RELAX_SEAM
#define GEMM_RELAX_SEAM 1
#endif
namespace pg8 {
#define PG8_LAS __attribute__((address_space(3)))
typedef unsigned short bf16_t;
typedef short bf16x8 __attribute__((ext_vector_type(8)));
typedef float f32x4 __attribute__((ext_vector_type(4)));
typedef unsigned u32x4 __attribute__((ext_vector_type(4)));
constexpr int BM = 256, BK = 64, HALF = 128, HTB = HALF * BK * 2  , STAGE_BYTES = 8 * HTB, NXCD = 8, WGM = 8;

__host__ __device__ __forceinline__ int lds_byte(int r, int c) { const int st = (r >> 4) * 2 + (c >> 5), rr = r & 15, cc = c & 31, ob = rr * 64 + cc * 2; return st * 1024 + (ob ^ (((ob >> 9) & 1) << 5)); }
__host__ __device__ __forceinline__ void stage_rc(int b, int& R, int& C) { const int st = b / 1024, sb = b % 1024, swz = sb ^ (((sb >> 9) & 1) << 5); R = (st >> 1) * 16 + swz / 64; C = (st & 1) * 32 + (swz % 64) / 2; }
__host__ __device__ __forceinline__ int perm32(int rho) { const int n = rho >> 4, i = rho & 15; return 8 * (i >> 2) + 4 * n + (i & 3); }

struct Unit { int pm, pn; };
struct Gemm { const bf16_t* A; int lda; const bf16_t* Bt; int M, N, K; };

struct StaticOrder {
    int nM, nN, nwg, G, c;
    __host__ __device__ void init(int M, int N, int G_, int c_) { nM = M / BM; nN = N / BM; nwg = nM * nN; G = G_; c = c_; }
    __host__ __device__ bool next(int i, Unit& u) const {
        const long L = (long)i * G + c; if (L >= nwg) return false;
        int wgid = (int)L; { const int q = nwg / NXCD, r = nwg % NXCD, xcd = wgid % NXCD, off = wgid / NXCD; wgid = (xcd < r ? xcd * (q + 1) : r * (q + 1) + (xcd - r) * q) + off; }
        const int nig = WGM * nN, gid = wgid / nig, fm = gid * WGM, gsz = (nM - fm) < WGM ? (nM - fm) : WGM;
        u.pm = fm + ((wgid % nig) % gsz); u.pn = (wgid % nig) / gsz; return true;
    }
    __device__ __forceinline__ void a_ready(const Unit&) const {}
    __device__ __forceinline__ void done(const Unit&) const {}
};

struct NoPre { __device__ __forceinline__ void operator()() const {} };
template <class Epi, class Sched, bool ALIGN_EPI = false, bool SP2 = false, class Pre = NoPre>
__device__ __forceinline__ void gemm_phase(PG8_LAS unsigned char* lds, const Gemm g, const Sched& S, const Epi& E, const Pre& pre = Pre()) {
    const int tid = otid(), wid = __builtin_amdgcn_readfirstlane(tid >> 6), lane = tid & 63, wr = wid >> 2, wc = wid & 3, fr = lane & 15, fq = lane >> 4;
    const int K = g.K, nt = K / BK, lda = g.lda;
    unsigned voffA[2], voffB[2];
#pragma unroll
    for (int i = 0; i < 2; ++i) { int R, C; stage_rc(tid * 16 + i * 8192, R, C); const int Rb = Epi::PERM ? ((R & ~31) + perm32(R & 31)) : R;
        voffA[i] = (unsigned)(R * lda + C) * 2u; voffB[i] = (unsigned)(Rb * K + C) * 2u; }
    const unsigned kstep = (unsigned)(BK * 2);
    const unsigned hstepA = (unsigned)HALF * lda * 2, hstepB = (unsigned)HALF * K * 2;
    const unsigned tstepA = 2 * hstepA, tstepB = 2 * hstepB;
    const __amdgpu_buffer_rsrc_t rsA = __builtin_amdgcn_make_buffer_rsrc((void*)g.A, 0, 0x7fffffff, 0x00020000), rsB = __builtin_amdgcn_make_buffer_rsrc((void*)g.Bt, 0, 0x7fffffff, 0x00020000);
    const unsigned ldsw = (unsigned)wid * 1024u;
    const int aoff = lds_byte(wr * 64 + fr, fq * 8), boff = lds_byte(wc * 32 + fr, fq * 8);
#define PG8_SA(b, h) (((b) * 2 + (h)) * HTB)
#define PG8_SB(b, h) ((4 + (b) * 2 + (h)) * HTB)
#define PG8_STAGE(bufoff, goff, voff) do { _Pragma("unroll") for (int _i = 0; _i < 2; ++_i) \
        __builtin_amdgcn_raw_ptr_buffer_load_lds(((bufoff) >= 4 * HTB) ? rsB : rsA, (PG8_LAS unsigned*)(lds + (bufoff) + ldsw + _i * 8192), 16, (int)(voff)[_i], (int)(goff), 0, 0); } while (0)
#define PG8_LDA(dst, b, h) do { _Pragma("unroll") for (int m = 0; m < 4; ++m) _Pragma("unroll") for (int k = 0; k < 2; ++k) dst[m][k] = *(const PG8_LAS bf16x8*)(lds + PG8_SA(b, h) + aoff + m * 2048 + k * 1024); } while (0)
#define PG8_LDB(dst, b, h) do { _Pragma("unroll") for (int n = 0; n < 2; ++n) _Pragma("unroll") for (int k = 0; k < 2; ++k) dst[n][k] = *(const PG8_LAS bf16x8*)(lds + PG8_SB(b, h) + boff + n * 2048 + k * 1024); } while (0)
#define PG8_MMA(ai, bj, At, Bt) do { __builtin_amdgcn_s_setprio(1); _Pragma("unroll") for (int m = 0; m < 4; ++m) _Pragma("unroll") for (int n = 0; n < 2; ++n) _Pragma("unroll") for (int k = 0; k < 2; ++k) \
        acc[ai][bj][m][n] = __builtin_amdgcn_mfma_f32_16x16x32_bf16(Bt[n][k], At[m][k], acc[ai][bj][m][n], 0, 0, 0); __builtin_amdgcn_s_setprio(0); } while (0)
#define PG8_WAIT_V(n) asm volatile("s_waitcnt vmcnt(" #n ")" ::: "memory")
#define PG8_WAIT_VR asm volatile("s_waitcnt vmcnt(%0)" :: "n"(8 + Epi::MIN_VM) : "memory")
#define PG8_WAIT_L(n) asm volatile("s_waitcnt lgkmcnt(" #n ")" ::: "memory")
#define PG8_BAR __builtin_amdgcn_s_barrier()
#define PG8_SCHED __builtin_amdgcn_sched_barrier(0)
    Unit cur, nxt; int ui = 0;
    if (!S.next(0, cur)) return;
    f32x4 acc[2][2][4][2];
#pragma unroll
    for (int a = 0; a < 2; ++a)
#pragma unroll
        for (int b = 0; b < 2; ++b)
#pragma unroll
            for (int m = 0; m < 4; ++m)
#pragma unroll
                for (int n = 0; n < 2; ++n) acc[a][b][m][n] = (f32x4){0.f, 0.f, 0.f, 0.f};
    bf16x8 At[4][2], B0[2][2], B1[2][2];
    unsigned cA = (unsigned)cur.pm * tstepA; unsigned cB = (unsigned)cur.pn * tstepB;
    S.a_ready(cur);
    if constexpr (SP2) {
        PG8_STAGE(PG8_SB(0, 0), cB, voffB); PG8_STAGE(PG8_SB(0, 1), cB + hstepB, voffB); PG8_STAGE(PG8_SA(0, 0), cA, voffA); PG8_STAGE(PG8_SA(0, 1), cA + hstepA, voffA);
        pre();
        if (wr == 1) PG8_BAR;
        PG8_WAIT_V(2); PG8_BAR;
        PG8_STAGE(PG8_SB(1, 0), cB + kstep, voffB); PG8_STAGE(PG8_SA(1, 0), cA + kstep, voffA); PG8_STAGE(PG8_SB(1, 1), cB + hstepB + kstep, voffB);
        PG8_WAIT_V(6); PG8_BAR;
    } else {
        PG8_STAGE(PG8_SB(0, 0), cB, voffB); PG8_STAGE(PG8_SA(0, 0), cA, voffA); PG8_STAGE(PG8_SB(0, 1), cB + hstepB, voffB); PG8_STAGE(PG8_SA(0, 1), cA + hstepA, voffA);
        if (wr == 1) PG8_BAR;
        PG8_WAIT_V(4); PG8_BAR;
        PG8_STAGE(PG8_SB(1, 0), cB + kstep, voffB); PG8_STAGE(PG8_SA(1, 0), cA + kstep, voffA); PG8_STAGE(PG8_SB(1, 1), cB + hstepB + kstep, voffB);
        PG8_WAIT_V(6); PG8_BAR;
    }
    for (;;) {
        const bool has_next = S.next(ui + 1, nxt);
        const unsigned nA = has_next ? (unsigned)nxt.pm * tstepA : cA; const unsigned nB = has_next ? (unsigned)nxt.pn * tstepB : cB;
#define PG8_KT2(FA) do { \
            const bool last = (t == nt - 2); \
            unsigned a1 = cA + (unsigned)(t + 1) * kstep; \
            unsigned a2 = last ? nA : cA + (unsigned)(t + 2) * kstep; unsigned b2 = last ? nB : cB + (unsigned)(t + 2) * kstep; \
            unsigned a3 = a2 + kstep; unsigned b3 = b2 + kstep; \
            asm volatile("" : "+s"(a1), "+s"(a2), "+s"(b2), "+s"(a3), "+s"(b3));     \
            if (last && has_next) S.a_ready(nxt); \
            PG8_LDB(B0, 0, 0); PG8_LDB(B1, 0, 1); PG8_SCHED; PG8_LDA(At, 0, 0); if constexpr (!(FA)) PG8_STAGE(PG8_SA(1, 1), a1 + hstepA, voffA); \
            if constexpr (FA) PG8_WAIT_VR; else PG8_WAIT_V(8); PG8_WAIT_L(0); PG8_BAR; PG8_MMA(0, 0, At, B0); PG8_MMA(0, 1, At, B1); PG8_BAR; PG8_SCHED; \
            PG8_LDA(At, 0, 1); PG8_STAGE(PG8_SB(0, 0), b2, voffB); PG8_STAGE(PG8_SB(0, 1), b2 + hstepB, voffB); PG8_STAGE(PG8_SA(0, 0), a2, voffA); \
            if constexpr (FA) PG8_WAIT_VR; else PG8_WAIT_V(8); PG8_WAIT_L(0); PG8_BAR; PG8_MMA(1, 0, At, B0); PG8_MMA(1, 1, At, B1); PG8_BAR; PG8_SCHED; \
            PG8_LDB(B0, 1, 0); PG8_LDB(B1, 1, 1); PG8_SCHED; PG8_LDA(At, 1, 0); PG8_STAGE(PG8_SA(0, 1), a2 + hstepA, voffA); \
            if constexpr (FA) PG8_WAIT_VR; else PG8_WAIT_V(8); PG8_WAIT_L(0); PG8_BAR; PG8_MMA(0, 0, At, B0); PG8_MMA(0, 1, At, B1); PG8_BAR; PG8_SCHED; \
            PG8_LDA(At, 1, 1); PG8_STAGE(PG8_SB(1, 0), b3, voffB); PG8_STAGE(PG8_SB(1, 1), b3 + hstepB, voffB); PG8_STAGE(PG8_SA(1, 0), a3, voffA); \
            PG8_WAIT_V(8); PG8_WAIT_L(0); PG8_BAR; PG8_MMA(1, 0, At, B0); PG8_MMA(1, 1, At, B1); PG8_BAR; PG8_SCHED; } while (0)
        int t = 0;
        if constexpr (SP2 && GEMM_RELAX_SEAM) { if (ui > 0) { PG8_KT2(true); t = 2; } }
        for (; t < nt; t += 2) {
            if constexpr (SP2) {
            PG8_KT2(false);
            } else {
            const bool last = (t == nt - 2);
            unsigned a1 = cA + (unsigned)(t + 1) * kstep;
            unsigned a2 = last ? nA : cA + (unsigned)(t + 2) * kstep; unsigned b2 = last ? nB : cB + (unsigned)(t + 2) * kstep;
            unsigned a3 = a2 + kstep; unsigned b3 = b2 + kstep;
            if (last && has_next) S.a_ready(nxt);
            PG8_LDB(B0, 0, 0); PG8_SCHED; PG8_LDA(At, 0, 0); PG8_STAGE(PG8_SA(1, 1), a1 + hstepA, voffA);
            PG8_WAIT_L(8); PG8_BAR; PG8_WAIT_L(0); PG8_MMA(0, 0, At, B0); PG8_BAR; PG8_SCHED;
            PG8_LDB(B1, 0, 1); PG8_STAGE(PG8_SB(0, 0), b2, voffB);
            PG8_BAR; PG8_WAIT_L(0); PG8_MMA(0, 1, At, B1); PG8_BAR;
            PG8_LDA(At, 0, 1); PG8_STAGE(PG8_SA(0, 0), a2, voffA);
            PG8_BAR; PG8_WAIT_L(0); PG8_MMA(1, 0, At, B0); PG8_BAR; PG8_SCHED;
            PG8_STAGE(PG8_SB(0, 1), b2 + hstepB, voffB);
            PG8_WAIT_V(6); PG8_BAR; PG8_MMA(1, 1, At, B1); PG8_BAR;
            PG8_LDB(B0, 1, 0); PG8_SCHED; PG8_LDA(At, 1, 0); PG8_STAGE(PG8_SA(0, 1), a2 + hstepA, voffA);
            PG8_WAIT_L(8); PG8_BAR; PG8_WAIT_L(0); PG8_MMA(0, 0, At, B0); PG8_BAR; PG8_SCHED;
            PG8_LDB(B1, 1, 1); PG8_STAGE(PG8_SB(1, 0), b3, voffB);
            PG8_BAR; PG8_WAIT_L(0); PG8_MMA(0, 1, At, B1); PG8_BAR;
            PG8_LDA(At, 1, 1); PG8_STAGE(PG8_SA(1, 0), a3, voffA);
            PG8_BAR; PG8_WAIT_L(0); PG8_MMA(1, 0, At, B0); PG8_BAR; PG8_SCHED;
            PG8_STAGE(PG8_SB(1, 1), b3 + hstepB, voffB);
            PG8_WAIT_V(6); PG8_BAR; PG8_MMA(1, 1, At, B1); PG8_BAR;
            }
        }
        if constexpr (ALIGN_EPI) { if (wr == 0) PG8_BAR; }
        if constexpr (GEMM_RELAX_SEAM && SP2) { if (has_next) { unsigned eb = nA + kstep + hstepA; asm volatile("" : "+s"(eb)); PG8_STAGE(PG8_SA(1, 1), eb, voffA); } }
        if constexpr (!Epi::AFTER_DRAIN) { E(acc, cur, wr, wc, fr, fq, !has_next); S.done(cur); }
        if (!has_next) break;
#pragma unroll
        for (int a = 0; a < 2; ++a)
#pragma unroll
            for (int b = 0; b < 2; ++b)
#pragma unroll
                for (int m = 0; m < 4; ++m)
#pragma unroll
                    for (int n = 0; n < 2; ++n) acc[a][b][m][n] = (f32x4){0.f, 0.f, 0.f, 0.f};
        cur = nxt; cA = nA; cB = nB; ++ui;
        if constexpr (ALIGN_EPI) { if (wr == 1) PG8_BAR; }
    }
    PG8_WAIT_V(0);
    if constexpr (!ALIGN_EPI) { if (wr == 0) PG8_BAR; }
    PG8_BAR;
    if constexpr (Epi::AFTER_DRAIN) { E.fused(acc, cur, wr, wc, fr, fq, lds, wid, lane); S.done(cur); }
#undef PG8_SA
#undef PG8_SB
#undef PG8_STAGE
#undef PG8_LDA
#undef PG8_LDB
#undef PG8_MMA
#undef PG8_WAIT_V
#undef PG8_WAIT_VR
#undef PG8_KT2
#undef PG8_WAIT_L
#undef PG8_BAR
#undef PG8_SCHED
}
}

template <class Core> struct EpiMfma {
    static constexpr bool PERM = true, AFTER_DRAIN = false;
    static constexpr int MIN_VM = 16;
    Core c;
    LAS unsigned char* pk_lds = nullptr;
    __device__ __forceinline__ void operator()(const pg8::f32x4 (&acc)[2][2][4][2], const pg8::Unit& u, int wr, int wc, int fr, int fq, bool last) const {
        asm volatile("" : "+v"(fr), "+v"(fq));
        float gmax[2] = {0.f, 0.f};
        float rsv[2][4];
#pragma unroll
        for (int ai = 0; ai < 2; ++ai)
#pragma unroll
            for (int m = 0; m < 4; ++m) { if constexpr (Core::NEEDS_RS) rsv[ai][m] = c.rs_tab[ai * 128 + wr * 64 + m * 16 + fr]; else rsv[ai][m] = 1.f; }
        v4u pre[2][4][2];
        if constexpr (Core::PRELOAD) {
#pragma unroll
            for (int ai = 0; ai < 2; ++ai)
#pragma unroll
                for (int m = 0; m < 4; ++m)
#pragma unroll
                    for (int bj = 0; bj < 2; ++bj) pre[ai][m][bj] = c.preload(u.pm * 256 + ai * 128 + wr * 64 + m * 16 + fr, u.pn * 256 + bj * 128 + wc * 32 + 8 * fq);
        }
#pragma unroll
        for (int ai = 0; ai < 2; ++ai)
#pragma unroll
            for (int m = 0; m < 4; ++m) {
                const int row = u.pm * 256 + ai * 128 + wr * 64 + m * 16 + fr;
                const float rs = rsv[ai][m];
                float part = 0.f;
#pragma unroll
                for (int bj = 0; bj < 2; ++bj) {
                    const int col0 = u.pn * 256 + bj * 128 + wc * 32 + 8 * fq;
                    const float v[8] = {acc[ai][bj][m][0][0], acc[ai][bj][m][0][1], acc[ai][bj][m][0][2], acc[ai][bj][m][0][3],
                                        acc[ai][bj][m][1][0], acc[ai][bj][m][1][1], acc[ai][bj][m][1][2], acc[ai][bj][m][1][3]};
                    float p;
                    if constexpr (Core::PRELOAD) p = c.apply8p(row, col0, v, rs, pre[ai][m][bj]); else p = c.apply8(row, col0, v, rs, last);
                    part += p;
                    if (Core::GROUPMAX) { const float q = sum_x32(sum_x16(p)); gmax[bj] = fmaxf(gmax[bj], q); }
                }
                part = sum_x32(sum_x16(part));
                if constexpr (Core::PACK_PART) { if (fq == 0) ((LAS float*)(pk_lds))[(ai * 128 + wr * 64 + m * 16 + fr) * 4 + wc] = part; }
                else if (fq == 0) c.store_part(row, u.pn * 256, (u.pn & 3) * 4 + wc, part);
            }
        if constexpr (Core::PACK_PART) {
            asm volatile("s_waitcnt lgkmcnt(0)\n\ts_barrier" ::: "memory");
            const int t_ = (wr * 4 + wc) * 64 + fq * 16 + fr;
            if (t_ < 256) { const v4u pv = *(const LAS v4u*)(pk_lds + t_ * 16); c.store_part4(u.pm * 256 + t_, (u.pn & 3) * 4, pv); }
        }
        if (Core::GROUPMAX) {
#pragma unroll
            for (int bj = 0; bj < 2; ++bj) { const int colg = u.pn * 256 + bj * 128 + wc * 32;
                if (c.want_groupmax(colg)) { const float m = wave_max(gmax[bj]); if (fr == 0 && fq == 0) c.store_groupmax(u.pm * 256, colg, m); } }
        }
    }
};
#ifndef GEMM_STAGGER_TICKS
#define GEMM_STAGGER_TICKS 0
#endif
template <class Core>
__device__ __forceinline__ void run_gemm(LAS unsigned char* lds, const bf16* A, int lda, const bf16* Bt, int M, int N, int K, const Core& c, int vcu, int G) {
    int bxo = (int)blockIdx.x; asm volatile("" : "+s"(bxo));
    pg8::Gemm g{A, lda, Bt, M, N, K}; pg8::StaticOrder S; S.init(M, N, G, bxo);
    EpiMfma<Core> E{c}; E.pk_lds = lds + LDSCTL_OFF + 10240;
#if GEMM_STAGGER_TICKS
    if (N > 1024) {
        const unsigned long long t0_ = __builtin_amdgcn_s_memrealtime(); const unsigned long long dl_ = (unsigned long long)((bxo >> 3) & 3) * GEMM_STAGGER_TICKS;
        while (__builtin_amdgcn_s_memrealtime() - t0_ < dl_) __builtin_amdgcn_s_sleep(4);
    }
#endif
    if constexpr (Core::NEEDS_RS) {
        pg8::Unit u0; const bool have = S.next(0, u0);
        LAS float* tab = (LAS float*)(lds + LDSCTL_OFF + 1024); LAS float* bt = (LAS float*)(lds + LDSCTL_OFF + 2048); const int t_ = otid();
        f32x4 q0 = {0.f, 0.f, 0.f, 0.f}, q1 = q0, q2 = q0, q3 = q0; float bv[4] = {0.f, 0.f, 0.f, 0.f}; int nb = 0;
        if (have) { if (t_ < 256) { const f32x4* pq = (const f32x4*)(c.ssq + (size_t)(u0.pm * 256 + t_) * 16); q0 = pq[0]; q1 = pq[1]; q2 = pq[2]; q3 = pq[3]; }
            E.c.rs_tab = tab; E.c.rs_row0 = u0.pm * 256;
            if constexpr (Core::HAS_BIAS) { nb = c.bias_count();
#pragma unroll
                for (int i = 0; i < 4; ++i) if (t_ + NTHR * i < nb) bv[i] = c.bias[t_ + NTHR * i];
                E.c.bias_lds = bt; } }
        auto pre = [&]() { if (have) { if (t_ < 256) { const float sm = ((q0.x + q0.y) + (q0.z + q0.w)) + ((q1.x + q1.y) + (q1.z + q1.w)) + ((q2.x + q2.y) + (q2.z + q2.w)) + ((q3.x + q3.y) + (q3.z + q3.w));
                                                     tab[t_] = __builtin_amdgcn_rsqf(sm * (1.0f / D) + EPS); }
                                       if constexpr (Core::HAS_BIAS) {
#pragma unroll
                                           for (int i = 0; i < 4; ++i) if (t_ + NTHR * i < nb) bt[t_ + NTHR * i] = bv[i]; } } };
        pg8::gemm_phase<EpiMfma<Core>, pg8::StaticOrder, true, true, decltype(pre)>(lds, g, S, E, pre);
    } else
    pg8::gemm_phase<EpiMfma<Core>, pg8::StaticOrder, true, true>(lds, g, S, E);

}

#include <hip/hip_bf16.h>
#include <cmath>
namespace attn_body {
using bf16=__hip_bfloat16;
using bf16x8=__attribute__((ext_vector_type(8)))short;
using s16x4=__attribute__((ext_vector_type(4)))short;
using f32x16=__attribute__((ext_vector_type(16)))float;
using u32x4=__attribute__((ext_vector_type(4)))unsigned;
constexpr int SEQ=8192,D=64,PQ=3072,PO=2048;
constexpr int NW=8,QBLK=32,QB=QBLK*NW,KVBLK=64,NQB=SEQ/QB;
__device__ __forceinline__ int crow(int r,int hi){return (r&3)+8*(r>>2)+4*hi;}
#define SBAR() __builtin_amdgcn_sched_barrier(0)
__device__ __forceinline__ void cmask(f32x16&p0,f32x16&p1,int jb,int qrel,int hi){
  const float NEG=-INFINITY; int kb=64*jb+4*hi;
  #pragma unroll
  for(int r=0;r<16;++r){int kv=kb+(r&3)+8*(r>>2); if(kv>qrel)p0[r]=NEG; if(kv+32>qrel)p1[r]=NEG;}
}

constexpr int NSLOT=3, SLOTB=8192;
constexpr int LDS_K=0, LDS_V=NSLOT*SLOTB, LDS_WS=2*NSLOT*SLOTB, LDS_OST=LDS_WS+NW*64*4, LDS_BYTES=LDS_OST+NW*4096;
constexpr float C2=0.125f*1.4426950408889634f;
__device__ __forceinline__ void glds16(const void*gsrc,unsigned lds_dst){unsigned keep;
  asm volatile("s_mov_b32 %0, m0\n\ts_mov_b32 m0, %2\n\ts_nop 0\n\tglobal_load_lds_dwordx4 %1, off\n\ts_mov_b32 m0, %0":"=&s"(keep):"v"(gsrc),"s"(lds_dst):"memory");}
__device__ __forceinline__ float max3f(float a,float b,float c){float r;asm("v_max3_f32 %0, %1, %2, %3":"=v"(r):"v"(a),"v"(b),"v"(c));return r;}
__device__ __forceinline__ float max2f(float a,float b){float r;asm("v_max_f32_e32 %0, %1, %2":"=v"(r):"v"(a),"v"(b));return r;}
__device__ __forceinline__ float fadd_s(float a,float b){float r;asm("v_add_f32_e32 %0, %1, %2":"=v"(r):"v"(a),"v"(b));return r;}
__device__ __forceinline__ float fsub_s(float a,float b){float r;asm("v_sub_f32_e32 %0, %1, %2":"=v"(r):"v"(a),"v"(b));return r;}
typedef float f32x2_t __attribute__((ext_vector_type(2))); typedef __bf16 bf16x2_t __attribute__((ext_vector_type(2)));
__device__ __forceinline__ unsigned cvtpk_s(float lo,float hi){f32x2_t v={lo,hi};bf16x2_t b=__builtin_convertvector(v,bf16x2_t);return __builtin_bit_cast(unsigned,b);}
#define WAIT_BAR(N) asm volatile("s_waitcnt vmcnt(" #N ") lgkmcnt(0)\n\ts_barrier":::"memory")

__device__ __forceinline__ void qkt(f32x16&p0,f32x16&p1,const char*Kslot,const bf16x8*qr,const f32x16&negm,int r32,int hi){
  const char*kb=Kslot+hi*1024+r32*16;
  #pragma unroll
  for(int d0=0;d0<4;++d0){
    const bf16x8 b0=*reinterpret_cast<const bf16x8*>(kb+d0*2048);
    const bf16x8 b1=*reinterpret_cast<const bf16x8*>(kb+d0*2048+512);
    if(d0==0){p0=__builtin_amdgcn_mfma_f32_32x32x16_bf16(b0,qr[0],negm,0,0,0);p1=__builtin_amdgcn_mfma_f32_32x32x16_bf16(b1,qr[0],negm,0,0,0);}
    else{p0=__builtin_amdgcn_mfma_f32_32x32x16_bf16(b0,qr[d0],p0,0,0,0);p1=__builtin_amdgcn_mfma_f32_32x32x16_bf16(b1,qr[d0],p1,0,0,0);}}
}
typedef __attribute__((address_space(3))) const char* lds_cptr;
typedef short v4i16_t __attribute__((ext_vector_type(4)));
__device__ __forceinline__ void kload8(bf16x8*kf,lds_cptr kp){
  kf[0]=*(const __attribute__((address_space(3))) bf16x8*)(kp);      kf[1]=*(const __attribute__((address_space(3))) bf16x8*)(kp+512);
  kf[2]=*(const __attribute__((address_space(3))) bf16x8*)(kp+2048); kf[3]=*(const __attribute__((address_space(3))) bf16x8*)(kp+2560);
  kf[4]=*(const __attribute__((address_space(3))) bf16x8*)(kp+4096); kf[5]=*(const __attribute__((address_space(3))) bf16x8*)(kp+4608);
  kf[6]=*(const __attribute__((address_space(3))) bf16x8*)(kp+6144); kf[7]=*(const __attribute__((address_space(3))) bf16x8*)(kp+6656);
}
__device__ __forceinline__ void kload2(bf16x8*kf,lds_cptr kp,int j){ kf[2*j]=*(const __attribute__((address_space(3))) bf16x8*)(kp+j*2048); kf[2*j+1]=*(const __attribute__((address_space(3))) bf16x8*)(kp+j*2048+512); }
__device__ __forceinline__ s16x4 vtr(lds_cptr p){ return __builtin_bit_cast(s16x4,__builtin_amdgcn_ds_read_tr16_b64_v4i16((__attribute__((address_space(3))) v4i16_t*)p)); }
__device__ __forceinline__ float rowmax(const f32x16&p0,const f32x16&p1){
  float a=max3f(p0[0],p0[1],p1[0]),b=max3f(p0[2],p0[3],p1[1]);a=max3f(a,p1[2],p1[3]);
  #pragma unroll
  for(int r=4;r<16;r+=4){a=max3f(a,p0[r],p0[r+1]);b=max3f(b,p0[r+2],p0[r+3]);a=max3f(a,p1[r],p1[r+1]);b=max3f(b,p1[r+2],p1[r+3]);}
  const float m=max2f(a,b);
  auto rr=__builtin_amdgcn_permlane32_swap(__float_as_uint(m),__float_as_uint(m),false,false);
  return max2f(__uint_as_float(rr[0]),__uint_as_float(rr[1]));
}
__device__ __forceinline__ void pv(f32x16*o,int vb,bf16x8 pa0,bf16x8 pa1,bf16x8 pa2,bf16x8 pa3){
  #pragma unroll
  for(int d0=0;d0<2;++d0){s16x4 lo[4],hi[4];
    #pragma unroll
    for(int ks=0;ks<4;++ks){
      asm volatile("ds_read_b64_tr_b16 %0,%1 offset:%c2":"=&v"(lo[ks]):"v"(vb),"i"(d0*4096+ks*1024):"memory");
      asm volatile("ds_read_b64_tr_b16 %0,%1 offset:%c2":"=&v"(hi[ks]):"v"(vb),"i"(d0*4096+ks*1024+512):"memory");}
    asm volatile("s_waitcnt lgkmcnt(0)":::"memory");SBAR();
    #define PK(k) (bf16x8){lo[k][0],lo[k][1],lo[k][2],lo[k][3],hi[k][0],hi[k][1],hi[k][2],hi[k][3]}
    o[d0]=__builtin_amdgcn_mfma_f32_32x32x16_bf16(pa0,PK(0),o[d0],0,0,0);
    o[d0]=__builtin_amdgcn_mfma_f32_32x32x16_bf16(pa1,PK(1),o[d0],0,0,0);
    o[d0]=__builtin_amdgcn_mfma_f32_32x32x16_bf16(pa2,PK(2),o[d0],0,0,0);
    o[d0]=__builtin_amdgcn_mfma_f32_32x32x16_bf16(pa3,PK(3),o[d0],0,0,0);
    #undef PK
  }
}

namespace v2 {
constexpr int NSL=4, KSLOT=8192, VSLOT=16384, LDS_K2=0, LDS_V2=NSL*KSLOT, LDS_WS2=LDS_V2+NSL*VSLOT, LDS_BYTES2=LDS_WS2+NW*64*4;
#define V2_WAIT_BAR(N) asm volatile("s_waitcnt vmcnt(" #N ") lgkmcnt(0)\n\ts_barrier":::"memory")
#define V2_MX3(a,b,c) __builtin_fmaxf(__builtin_fmaxf((a),(b)),(c))
}
template<int THRL,bool SREF> __device__ __forceinline__ void attn_unit_v2(int b,int qb,int t0,const bf16*Q,const bf16*K,const bf16*V,bf16*O,float slope2,float bref,char*shm){
  using namespace v2;
  const int tid=otid(),lane=tid&63,r32=lane&31,hi=lane>>5; const int wid=__builtin_amdgcn_readfirstlane(tid>>6);
  const long rowbase=(long)b*SEQ; const int q0=qb*QB;
  const bf16*Qw=Q+(rowbase+q0+wid*QBLK)*PQ;
  const bf16*Kh=K+(rowbase+(long)t0*KVBLK)*PQ,*Vh=V+(rowbase+(long)t0*KVBLK)*PQ;
  const unsigned lds0=(unsigned)(uintptr_t)shm;
  float*wsf=(float*)(shm+LDS_WS2)+wid*64;
  const bf16*ksrc=Kh+(long)lane*PQ+wid*8;
  const int pi0=2*wid, pi1=2*wid+1;
  const bf16*vsrc0=Vh+(long)(16*(pi0&3)+(lane>>2))*PQ+(pi0>>2)*32+(lane&3)*8;
  const bf16*vsrc1=Vh+(long)(16*(pi1&3)+(lane>>2))*PQ+(pi1>>2)*32+(lane&3)*8;
  const unsigned kdst=lds0+LDS_K2+wid*1024, vdst0=lds0+LDS_V2+pi0*1024, vdst1=lds0+LDS_V2+pi1*1024;
  #define V2_DMA(t,sl) do{ glds16(ksrc+(long)(t)*KVBLK*PQ,(unsigned)__builtin_amdgcn_readfirstlane(kdst+(sl)*KSLOT)); \
      glds16(vsrc0+(long)(t)*KVBLK*PQ,(unsigned)__builtin_amdgcn_readfirstlane(vdst0+(sl)*VSLOT)); \
      glds16(vsrc1+(long)(t)*KVBLK*PQ,(unsigned)__builtin_amdgcn_readfirstlane(vdst1+(sl)*VSLOT)); }while(0)
  #define V2_DMAK(t,sl) glds16(ksrc+(long)(t)*KVBLK*PQ,(unsigned)__builtin_amdgcn_readfirstlane(kdst+(sl)*KSLOT))
  #define V2_DMAV(t,sl) do{ glds16(vsrc0+(long)(t)*KVBLK*PQ,(unsigned)__builtin_amdgcn_readfirstlane(vdst0+(sl)*VSLOT)); \
      glds16(vsrc1+(long)(t)*KVBLK*PQ,(unsigned)__builtin_amdgcn_readfirstlane(vdst1+(sl)*VSLOT)); }while(0)
  const int NT=(q0+QB)/KVBLK-t0;
  V2_DMAK(0,0); V2_DMAK(1,1); V2_DMAV(0,0); V2_DMAK(2,2); V2_DMAV(1,1);
  bf16x8 kf[8];
  bf16x8 qr[4];
  #pragma unroll
  for(int d0=0;d0<4;++d0)qr[d0]=*reinterpret_cast<const bf16x8*>(&Qw[(long)r32*PQ+d0*16+hi*8]);
  float l_reg=0.f; f32x16 o[4];
  #pragma unroll
  for(int d0=0;d0<4;++d0)o[d0]=f32x16{};
  f32x16 negm;
  const float b32=32.f*slope2, step64=64.f*slope2;
  const int qrel=wid*QBLK+r32;
  #pragma unroll
  for(int r=0;r<16;++r)negm[r]=SREF?(slope2*(float)(crow(r,hi)+KVBLK*t0-(q0+qrel))-bref):slope2*(float)crow(r,hi);
  const lds_cptr shm3=(lds_cptr)shm; const lds_cptr kp0=shm3+LDS_K2+hi*1024+r32*16; const lds_cptr vp0=shm3+LDS_V2+((lane>>4)&1)*32+(lane&3)*8+(4*hi+((lane&15)>>2))*64;
  f32x16 pA0,pA1,pB0,pB1; u32x4 pw0,pw1,pw2,pw3;
  #define V2_PIN(x) asm volatile("":"+v"(x))
  #define V2_VRD(dst,d0) do{ _Pragma("unroll") for(int ks=0;ks<4;++ks){ dst[2*ks]=vtr(vp+(d0)*4096+ks*1024); dst[2*ks+1]=vtr(vp+(d0)*4096+ks*1024+512);} }while(0)
  #define V2_VF(src,ks) (bf16x8){src[2*(ks)][0],src[2*(ks)][1],src[2*(ks)][2],src[2*(ks)][3],src[2*(ks)+1][0],src[2*(ks)+1][1],src[2*(ks)+1][2],src[2*(ks)+1][3]}
  #define V2_KLD2(t,d0) do{ const lds_cptr kp_=kp0+((t)&3)*KSLOT; kf[2*(d0)]=*(const __attribute__((address_space(3))) bf16x8*)(kp_+(d0)*2048); kf[2*(d0)+1]=*(const __attribute__((address_space(3))) bf16x8*)(kp_+(d0)*2048+512); SBAR(); }while(0)
  #define V2_KRD(t)
  #define V2_QK(t,C0,C1) do{ V2_KRD(t) \
      C0=__builtin_amdgcn_mfma_f32_32x32x16_bf16(kf[0],qr[0],negm,0,0,0); C1=__builtin_amdgcn_mfma_f32_32x32x16_bf16(kf[1],qr[0],negm,0,0,0); \
      _Pragma("unroll") for(int d0=1;d0<4;++d0){ C0=__builtin_amdgcn_mfma_f32_32x32x16_bf16(kf[2*d0],qr[d0],C0,0,0,0); C1=__builtin_amdgcn_mfma_f32_32x32x16_bf16(kf[2*d0+1],qr[d0],C1,0,0,0); } \
      SBAR(); }while(0)
  #define V2_FILL(P,B,PW,W) do{ sacc+=P[B]; sacc+=P[B+1]; sacc+=P[B+2]; sacc+=P[B+3]; PW[W]=cvtpk_s(P[B],P[B+1]); PW[W+1]=cvtpk_s(P[B+2],P[B+3]); V2_PIN(sacc); V2_PIN(PW); SBAR(); }while(0)
  #define V2_QKF(t,C0,C1,P0,P1) do{ V2_KRD(t) float sacc=0.f; \
      C0=__builtin_amdgcn_mfma_f32_32x32x16_bf16(kf[0],qr[0],negm,0,0,0); V2_FILL(P0,0,pw0,0); \
      C1=__builtin_amdgcn_mfma_f32_32x32x16_bf16(kf[1],qr[0],negm,0,0,0); V2_FILL(P0,4,pw0,2); \
      C0=__builtin_amdgcn_mfma_f32_32x32x16_bf16(kf[2],qr[1],C0,0,0,0);   V2_FILL(P0,8,pw1,0); \
      C1=__builtin_amdgcn_mfma_f32_32x32x16_bf16(kf[3],qr[1],C1,0,0,0);   V2_FILL(P0,12,pw1,2); \
      C0=__builtin_amdgcn_mfma_f32_32x32x16_bf16(kf[4],qr[2],C0,0,0,0);   V2_FILL(P1,0,pw2,0); \
      C1=__builtin_amdgcn_mfma_f32_32x32x16_bf16(kf[5],qr[2],C1,0,0,0);   V2_FILL(P1,4,pw2,2); \
      C0=__builtin_amdgcn_mfma_f32_32x32x16_bf16(kf[6],qr[3],C0,0,0,0);   V2_FILL(P1,8,pw3,0); \
      C1=__builtin_amdgcn_mfma_f32_32x32x16_bf16(kf[7],qr[3],C1,0,0,0);   V2_FILL(P1,12,pw3,2); \
      l_reg+=sacc; }while(0)
  bool resc=false;
  #define V2_DECIDE(t,FIRST,C0,C1) do{ \
      _Pragma("unroll") for(int r=0;r<16;++r)C1[r]+=b32; \
      { const int jb=(t)-(NT-4); if(jb>=0)cmask(C0,C1,jb,qrel,hi); } \
      if constexpr(SREF){ _Pragma("unroll") for(int r=0;r<16;++r)negm[r]+=step64; SBAR(); break; } \
      float rm; \
      { float a=V2_MX3(C0[0],C0[1],C1[0]),c=V2_MX3(C0[2],C0[3],C1[1]); a=V2_MX3(a,C1[2],C1[3]); \
        _Pragma("unroll") for(int r=4;r<16;r+=4){a=V2_MX3(a,C0[r],C0[r+1]);c=V2_MX3(c,C0[r+2],C0[r+3]);a=V2_MX3(a,C1[r],C1[r+1]);c=V2_MX3(c,C1[r+2],C1[r+3]);} \
        rm=__builtin_fmaxf(a,c); auto rr=__builtin_amdgcn_permlane32_swap(__float_as_uint(rm),__float_as_uint(rm),false,false); rm=__builtin_fmaxf(__uint_as_float(rr[0]),__uint_as_float(rr[1])); } \
      float adj=step64; resc=false; \
      if(FIRST){ _Pragma("unroll") for(int r=0;r<16;++r){C0[r]-=rm;C1[r]-=rm;} adj-=rm; } \
      else if(__any(rm>(float)THRL)){ const float dl=__builtin_fmaxf(rm,0.f); \
        _Pragma("unroll") for(int r=0;r<16;++r){C0[r]-=dl;C1[r]-=dl;} \
        adj-=dl; const float f=__builtin_amdgcn_exp2f(-dl); l_reg*=f; if(hi==0)wsf[r32]=f; resc=true; } \
      _Pragma("unroll") for(int r=0;r<16;++r)negm[r]+=adj; \
      SBAR(); }while(0)
  #define V2_GRP(d0,ks,src,C,B) do{ o[d0]=__builtin_amdgcn_mfma_f32_32x32x16_bf16(__builtin_bit_cast(bf16x8,pw##ks),V2_VF(src,ks),o[d0],0,0,0); \
      C[B]=__builtin_amdgcn_exp2f(C[B]); C[B+1]=__builtin_amdgcn_exp2f(C[B+1]); V2_PIN(C); SBAR(); }while(0)
  #define V2_SYNC(t) do{ if((t)+2<NT){ V2_WAIT_BAR(3); } else if((t)+1<NT){ V2_WAIT_BAR(2); } else { V2_WAIT_BAR(0); } \
      if((t)+3<NT){ V2_DMAK((t)+3,((t)+3)&3); } if((t)+2<NT){ V2_DMAV((t)+2,((t)+2)&3); } }while(0)
  #define V2_KPF(PF,t,d0) do{ if(PF){ V2_KLD2((t)+1,d0); } }while(0)
  #define V2_STEP(t,C0,C1,P0,P1,PF) do{ V2_SYNC(t); \
      const lds_cptr vp=vp0+(((t)-1)&3)*VSLOT; s16x4 va[8],vb[8]; \
      V2_VRD(va,0); \
      V2_QKF(t,C0,C1,P0,P1); V2_DECIDE(t,false,C0,C1); \
      V2_VRD(vb,1); \
      V2_GRP(0,0,va,C0,0); V2_GRP(0,1,va,C0,2); V2_GRP(0,2,va,C0,4); V2_GRP(0,3,va,C0,6); \
      V2_VRD(va,2); \
      V2_GRP(1,0,vb,C0,8); V2_KPF(PF,t,0); V2_GRP(1,1,vb,C0,10); V2_KPF(PF,t,1); V2_GRP(1,2,vb,C0,12); V2_GRP(1,3,vb,C0,14); \
      V2_VRD(vb,3); \
      V2_GRP(2,0,va,C1,0); V2_KPF(PF,t,2); V2_GRP(2,1,va,C1,2); V2_KPF(PF,t,3); V2_GRP(2,2,va,C1,4); V2_GRP(2,3,va,C1,6); \
      V2_GRP(3,0,vb,C1,8); V2_GRP(3,1,vb,C1,10); V2_GRP(3,2,vb,C1,12); V2_GRP(3,3,vb,C1,14); \
      if(resc){ asm volatile("s_waitcnt lgkmcnt(0)":::"memory");         \
        _Pragma("unroll") for(int r=0;r<16;++r){ const float fr_=wsf[crow(r,hi)]; \
          _Pragma("unroll") for(int d0=0;d0<4;++d0)o[d0][r]*=fr_; } \
        asm volatile("s_waitcnt lgkmcnt(0)":::"memory"); } }while(0)
  V2_SYNC(0); V2_KLD2(0,0); V2_KLD2(0,1); V2_KLD2(0,2); V2_KLD2(0,3); V2_QK(0,pA0,pA1);
  V2_KLD2(1,0); V2_KLD2(1,1); V2_KLD2(1,2); V2_KLD2(1,3);
  V2_DECIDE(0,true,pA0,pA1);
  #pragma unroll
  for(int r=0;r<16;++r){pA0[r]=__builtin_amdgcn_exp2f(pA0[r]);pA1[r]=__builtin_amdgcn_exp2f(pA1[r]);}
  for(int t=1;t+1<NT;t+=2){ V2_STEP(t,pB0,pB1,pA0,pA1,true); V2_STEP(t+1,pA0,pA1,pB0,pB1,true); }
  V2_STEP(NT-1,pB0,pB1,pA0,pA1,false);
  { float sacc=0.f;
    #pragma unroll
    for(int r=0;r<16;++r)sacc+=pB0[r]+pB1[r];
    l_reg+=sacc;
    pw0=(u32x4){cvtpk_s(pB0[0],pB0[1]),cvtpk_s(pB0[2],pB0[3]),cvtpk_s(pB0[4],pB0[5]),cvtpk_s(pB0[6],pB0[7])};
    pw1=(u32x4){cvtpk_s(pB0[8],pB0[9]),cvtpk_s(pB0[10],pB0[11]),cvtpk_s(pB0[12],pB0[13]),cvtpk_s(pB0[14],pB0[15])};
    pw2=(u32x4){cvtpk_s(pB1[0],pB1[1]),cvtpk_s(pB1[2],pB1[3]),cvtpk_s(pB1[4],pB1[5]),cvtpk_s(pB1[6],pB1[7])};
    pw3=(u32x4){cvtpk_s(pB1[8],pB1[9]),cvtpk_s(pB1[10],pB1[11]),cvtpk_s(pB1[12],pB1[13]),cvtpk_s(pB1[14],pB1[15])};
    const lds_cptr vp=vp0+((NT-1)&3)*VSLOT; s16x4 va[8],vb[8];
    #define V2_PV(d0,src) do{ o[d0]=__builtin_amdgcn_mfma_f32_32x32x16_bf16(__builtin_bit_cast(bf16x8,pw0),V2_VF(src,0),o[d0],0,0,0); \
        o[d0]=__builtin_amdgcn_mfma_f32_32x32x16_bf16(__builtin_bit_cast(bf16x8,pw1),V2_VF(src,1),o[d0],0,0,0); \
        o[d0]=__builtin_amdgcn_mfma_f32_32x32x16_bf16(__builtin_bit_cast(bf16x8,pw2),V2_VF(src,2),o[d0],0,0,0); \
        o[d0]=__builtin_amdgcn_mfma_f32_32x32x16_bf16(__builtin_bit_cast(bf16x8,pw3),V2_VF(src,3),o[d0],0,0,0); }while(0)
    V2_VRD(va,0); V2_VRD(vb,1); V2_PV(0,va); V2_VRD(va,2); V2_PV(1,vb); V2_VRD(vb,3); V2_PV(2,va); V2_PV(3,vb);
    #undef V2_PV
  }
  #undef V2_PIN
  #undef V2_VRD
  #undef V2_VF
  #undef V2_KRD
  #undef V2_QK
  #undef V2_QKF
  #undef V2_FILL
  #undef V2_DECIDE
  #undef V2_GRP
  #undef V2_STEP
  #undef V2_SYNC
  {auto rr=__builtin_amdgcn_permlane32_swap(__float_as_uint(l_reg),__float_as_uint(l_reg),false,false);l_reg=__uint_as_float(rr[0])+__uint_as_float(rr[1]);}
  if(hi==0)wsf[32+r32]=l_reg;asm volatile("s_waitcnt lgkmcnt(0)":::"memory");
  float rli[16];
  #pragma unroll
  for(int r=0;r<16;++r)rli[r]=__builtin_amdgcn_rcpf(wsf[32+crow(r,hi)]);
  asm volatile("s_waitcnt lgkmcnt(0)\n\ts_barrier":::"memory");
  bf16*Ow=O+(rowbase+q0+wid*QBLK)*PO;
  { bf16*stg=(bf16*)shm+wid*4096;
    #pragma unroll
    for(int r=0;r<16;++r){const int orow=crow(r,hi);
      #pragma unroll
      for(int d0=0;d0<4;++d0)stg[orow*128+d0*32+r32]=__float2bfloat16(o[d0][r]*rli[r]);}
    asm volatile("s_waitcnt lgkmcnt(0)":::"memory");
    #pragma unroll
    for(int i=0;i<8;++i){const int row=i*4+(lane>>4),ch=lane&15; const u32x4 v=*(const u32x4*)(stg+row*128+ch*8); *(u32x4*)(Ow+(long)row*PO+ch*8)=v;} }
  asm volatile("s_waitcnt lgkmcnt(0)\n\ts_barrier":::"memory");
  #undef V2_DMA
  #undef V2_DMAK
  #undef V2_DMAV
  #undef V2_KLD2
  #undef V2_KPF
}
constexpr int ATTN_LDS_BYTES=LDS_BYTES;
#undef SBAR
#undef WAIT_BAR
}

__device__ __forceinline__ void phase_diff_mfma(char* shm, LAS unsigned char* lds, const Ctx& a, int vcu, int G) {
    bf16* proj = (bf16*)(a.ws + WS_H); bf16* o12 = (bf16*)(a.ws + WS_STATE);
    unsigned* ctl = (unsigned*)(a.ws + WS_CTL);
    volatile LAS unsigned* qslot = (volatile LAS unsigned*)(lds + MISC_OFF) + 16;
    for (;;) {
        const int tid = otid();
        if (tid == 0) *qslot = atomicAdd(ctl + CW_QUEUE, 1u);
        __syncthreads();
        const unsigned idx = (unsigned)__builtin_amdgcn_readfirstlane((int)*qslot);
        __syncthreads();
        if (idx >= (unsigned)(NB * DIFF_H * 2 * 32)) break;
        const int qb = 31 - (int)(idx >> 5), rem = idx & 31, b = rem >> 4, h = (rem >> 1) & 7, r = rem & 1;
        const float slope2 = exp2f(-(float)(h + 1)) * LOG2E;
        int t0 = 0; float smax_u;
        { const unsigned* qm = ctl + CW_QKMAX + b * 64; const int g0 = (h * 128 + r * 64) >> 5;
          const float pq = __uint_as_float(qm[g0]) + __uint_as_float(qm[g0 + 1]), pk = __uint_as_float(qm[32 + g0]) + __uint_as_float(qm[32 + g0 + 1]);
          const float smax = sqrtf(pq * pk); smax_u = smax;
          const float d = (float)(qb * 256) - (152.0f + 2.1f * smax) / slope2;
          if (d > 0.f) t0 = ((int)d >> 6) & ~1;
          if (t0 > 4 * qb) t0 = 4 * qb; }
#if ATTN_SREF
        if (smax_u <= 48.f)
            attn_body::attn_unit_v2<8, true>(b, qb, t0, (const attn_body::bf16*)(proj + h * 128 + r * 64), (const attn_body::bf16*)(proj + 1024 + h * 128 + r * 64),
                                   (const attn_body::bf16*)(proj + 2048 + h * 128), (attn_body::bf16*)(o12 + r * 1024 + h * 128), slope2, smax_u, shm);
        else
#endif
        attn_body::attn_unit_v2<8, false>(b, qb, t0, (const attn_body::bf16*)(proj + h * 128 + r * 64), (const attn_body::bf16*)(proj + 1024 + h * 128 + r * 64),
                                   (const attn_body::bf16*)(proj + 2048 + h * 128), (attn_body::bf16*)(o12 + r * 1024 + h * 128), slope2, 0.f, shm);
    }
}
__device__ __forceinline__ void phase_diff_combine(const Ctx& a, const LayerP& P, int vcu, int G) {
    const int tid = otid(), lane = tid & 63, wave = tid >> 6;
    bf16* proj = (bf16*)(a.ws + WS_H); const bf16* o12 = (const bf16*)(a.ws + WS_STATE);
    float lam;
    { float s1 = 0.f, s2 = 0.f;
      for (int i = 0; i < 64; ++i) { s1 += P.e0[i] * P.e1[i]; s2 += P.e2[i] * P.e3[i]; }
      lam = __expf(s1) - __expf(s2) + LAMBDA_INIT; }
    const int h = lane >> 3, sub = lane & 7;
    float hn[16];
#pragma unroll
    for (int j = 0; j < 16; ++j) hn[j] = P.e4[sub * 16 + j] * (1.0f - LAMBDA_INIT);
    const int gw = vcu * NWAVES + wave, NGW = G * NWAVES;
    for (int r0 = gw; r0 < NTOK; r0 += 2 * NGW) {
      const int r1 = (r0 + NGW < NTOK) ? r0 + NGW : r0;
      v4u ld[2][4];
#pragma unroll
      for (int q = 0; q < 2; ++q) { const bf16* p1 = o12 + (size_t)(q ? r1 : r0) * 2048 + h * 128 + sub * 16;
          ld[q][0] = *(const v4u*)p1; ld[q][1] = *(const v4u*)(p1 + 8); ld[q][2] = *(const v4u*)(p1 + 1024); ld[q][3] = *(const v4u*)(p1 + 1032); }
#pragma unroll
      for (int q = 0; q < 2; ++q) { const int row = q ? r1 : r0; if (q && r1 == r0) break;
        const v4u a0 = ld[q][0], a1 = ld[q][1], b0 = ld[q][2], b1 = ld[q][3];
        const unsigned aw[8] = {a0.x, a0.y, a0.z, a0.w, a1.x, a1.y, a1.z, a1.w}, bw[8] = {b0.x, b0.y, b0.z, b0.w, b1.x, b1.y, b1.z, b1.w};
        float o[16]; float ss = 0.f;
#pragma unroll
        for (int j = 0; j < 8; ++j) { o[2 * j] = bflo(aw[j]) - lam * bflo(bw[j]); o[2 * j + 1] = bfhi(aw[j]) - lam * bfhi(bw[j]); ss += o[2 * j] * o[2 * j] + o[2 * j + 1] * o[2 * j + 1]; }
        ss = sum_lanes8(ss);
        const float rs = 1.0f / sqrtf(ss * (1.0f / 128.0f) + EPS);
        v4u w0, w1;
        w0.x = pk2(o[0] * rs * hn[0], o[1] * rs * hn[1]); w0.y = pk2(o[2] * rs * hn[2], o[3] * rs * hn[3]); w0.z = pk2(o[4] * rs * hn[4], o[5] * rs * hn[5]); w0.w = pk2(o[6] * rs * hn[6], o[7] * rs * hn[7]);
        w1.x = pk2(o[8] * rs * hn[8], o[9] * rs * hn[9]); w1.y = pk2(o[10] * rs * hn[10], o[11] * rs * hn[11]); w1.z = pk2(o[12] * rs * hn[12], o[13] * rs * hn[13]); w1.w = pk2(o[14] * rs * hn[14], o[15] * rs * hn[15]);
        bf16* op = proj + (size_t)row * DIFF_PITCH + h * 128 + sub * 16;
        *(v4u*)op = w0; *(v4u*)(op + 8) = w1;
      }
    }
}

typedef short mbf16x8 __attribute__((ext_vector_type(8)));
typedef short ms16x4 __attribute__((ext_vector_type(4)));
typedef float mf32x16 __attribute__((ext_vector_type(16)));
#define MFMA32(a, b, c) __builtin_amdgcn_mfma_f32_32x32x16_bf16(a, b, c, 0, 0, 0)
__device__ __forceinline__ int crow32(int r, int hi) { return (r & 3) + 8 * (r >> 2) + 4 * hi; }
__device__ __forceinline__ mbf16x8 frag_rk(const LAS unsigned char* base, int stride, int row0, int k0, int lane) {
    return *(const LAS mbf16x8*)(base + (row0 + (lane & 31)) * stride + (k0 + 8 * (lane >> 5)) * 2);
}
__device__ __forceinline__ mbf16x8 frag_kn(const LAS unsigned char* base, int stride, int k0, int n0, int lane) {
    const int i = lane & 15, g = lane >> 4;
    const LAS unsigned char* p = base + (k0 + 8 * (g >> 1) + (i >> 2)) * stride + (n0 + 16 * (g & 1) + 4 * (i & 3)) * 2;
    const ms16x4 lo = __builtin_bit_cast(ms16x4, __builtin_amdgcn_ds_read_tr16_b64_v4i16((LAS ms16x4*)p));
    const ms16x4 hi = __builtin_bit_cast(ms16x4, __builtin_amdgcn_ds_read_tr16_b64_v4i16((LAS ms16x4*)(p + 4 * stride)));
    return (mbf16x8){lo[0], lo[1], lo[2], lo[3], hi[0], hi[1], hi[2], hi[3]};
}
__device__ __forceinline__ mf32x16 zero16() { mf32x16 z;
#pragma unroll
    for (int r = 0; r < 16; ++r) z[r] = 0.f; return z; }

__device__ __forceinline__ void phase_sgu_mfma(LAS unsigned char* lds, const Ctx& a, const LayerP& P, int vcu, int G, bool dummy = false) {
    const int tid = otid(), lane = tid & 63, wave = __builtin_amdgcn_readfirstlane(tid >> 6);
    bf16* proj = (bf16*)(a.ws + WS_H); const float* vssq = (const float*)(a.ws + WS_VSSQ);
    const float* v_norm = P.e1; const float* w_s = P.e2; const float* b_s = P.e3;
    constexpr int SA = 272, SV = 320, SO = 132;
    LAS unsigned char* WA = lds;
    LAS unsigned char* VV = lds + 128 * SA;
    LAS float* OS = (LAS float*)(lds + 128 * SA);
    LAS float* RS = (LAS float*)(lds + 128 * SA + 128 * SO * 4);
    const int tm = wave & 3, nh = wave >> 2, hi = lane >> 5;
    constexpr int NU = NB * (T / SGU_C) * SGU_G;
    int g_res = -1;
    v4u vraw[4]; float rsraw = 0.f;
    #define SGU_LOAD_RAW(uu) do{ const int g_ = (uu) % SGU_G, row0_ = ((uu) / SGU_G) * SGU_C; \
        _Pragma("unroll") for (int i = 0; i < 4; ++i) { const int ch = tid + NTHR * i, r = ch >> 4, c16 = ch & 15; \
            vraw[i] = *(const v4u*)(proj + (size_t)(row0_ + r) * SGU_PITCH + 1024 + g_ * 128 + c16 * 8); } \
        if (tid < 128) rsraw = row_rstd(vssq, row0_ + tid); }while(0)
    if (vcu < NU) SGU_LOAD_RAW(vcu);
    for (int u = vcu; u < NU; u += G) {
        const int g = u % SGU_G, bc = u / SGU_G;
        const int row0 = bc * SGU_C;
        if (tid < 128) RS[tid] = rsraw;
        v4u vcur[4];
#pragma unroll
        for (int i = 0; i < 4; ++i) vcur[i] = vraw[i];
        v4u uw[4];
#pragma unroll
        for (int i = 0; i < 4; ++i) { const int ch = tid + NTHR * i, t = ch >> 4, c8 = (ch & 15) * 8; uw[i] = *(const v4u*)(proj + (size_t)(row0 + t) * SGU_PITCH + g * 128 + c8); }
        if (g != g_res) {
#pragma unroll
            for (int i = 0; i < 8; ++i) { const int idx = tid + NTHR * i, t = idx >> 5, s4 = (idx & 31) * 4;
                const f32x4 w = *(const f32x4*)(w_s + (size_t)g * 16384 + t * 128 + s4);
                v2u o; o.x = pk2((s4 + 0 <= t) ? w.x : 0.f, (s4 + 1 <= t) ? w.y : 0.f); o.y = pk2((s4 + 2 <= t) ? w.z : 0.f, (s4 + 3 <= t) ? w.w : 0.f);
                *(LAS v2u*)(WA + t * SA + s4 * 2) = o; }
            g_res = g;
        }
        if (u + G < NU) SGU_LOAD_RAW(u + G);
        __syncthreads();
#pragma unroll
        for (int i = 0; i < 4; ++i) { const int ch = tid + NTHR * i, r = ch >> 4, c16 = ch & 15; const float rs = RS[r];
            v4u o; o.x = pk2(bflo(vcur[i].x) * rs, bfhi(vcur[i].x) * rs); o.y = pk2(bflo(vcur[i].y) * rs, bfhi(vcur[i].y) * rs);
            o.z = pk2(bflo(vcur[i].z) * rs, bfhi(vcur[i].z) * rs); o.w = pk2(bflo(vcur[i].w) * rs, bfhi(vcur[i].w) * rs);
            *(LAS v4u*)(VV + r * SV + c16 * 16) = o; }
        __syncthreads();
        mf32x16 acc0 = zero16(), acc1 = zero16();
        for (int ks = 0; ks < 2 * (tm + 1); ++ks) {
            const mbf16x8 af = frag_rk(WA, SA, 32 * tm, 16 * ks, lane);
            const mbf16x8 b0 = frag_kn(VV, SV, 16 * ks, 64 * nh, lane), b1 = frag_kn(VV, SV, 16 * ks, 64 * nh + 32, lane);
            acc0 = MFMA32(af, b0, acc0); acc1 = MFMA32(af, b1, acc1);
        }
        __syncthreads();
#pragma unroll
        for (int r = 0; r < 16; ++r) { const int row = 32 * tm + crow32(r, hi);
            OS[row * SO + 64 * nh + (lane & 31)] = acc0[r]; OS[row * SO + 64 * nh + 32 + (lane & 31)] = acc1[r]; }
        __syncthreads();
#pragma unroll
        for (int i = 0; i < 4; ++i) { const int ch = tid + NTHR * i, t = ch >> 4, c8 = (ch & 15) * 8;
            const f32x4 s0 = *(const LAS f32x4*)(OS + t * SO + c8), s1 = *(const LAS f32x4*)(OS + t * SO + c8 + 4);
            const f32x4 n0 = *(const f32x4*)(v_norm + g * 128 + c8), n1 = *(const f32x4*)(v_norm + g * 128 + c8 + 4);
            const float bs = b_s[g * 128 + t];
            bf16* up = proj + (size_t)(row0 + t) * SGU_PITCH + g * 128 + c8;
            const v4u uwv = uw[i];
            v4u o;
            o.x = pk2(bflo(uwv.x) * (n0.x * s0.x + bs), bfhi(uwv.x) * (n0.y * s0.y + bs)); o.y = pk2(bflo(uwv.y) * (n0.z * s0.z + bs), bfhi(uwv.y) * (n0.w * s0.w + bs));
            o.z = pk2(bflo(uwv.z) * (n1.x * s1.x + bs), bfhi(uwv.z) * (n1.y * s1.y + bs)); o.w = pk2(bflo(uwv.w) * (n1.z * s1.z + bs), bfhi(uwv.w) * (n1.w * s1.w + bs));
            if (dummy) *(v4u*)((bf16*)(a.ws + WS_STATE + 32 * MiB) + (size_t)(row0 + t) * 1024 + g * 128 + c8) = o; else *(v4u*)up = o; }
        __syncthreads();
    }
    #undef SGU_LOAD_RAW
}

constexpr int GLA_GRP = 4, GLA_NG = GLA_NC / GLA_GRP;
constexpr int GLA_NU2 = NB * GLA_H * GLA_NG;
struct GlaGate { const float* R; const float* w2; const float* gb; };
struct GlaRaw2 { float la0[8], la1[8]; unsigned q[8], k[8]; v4u v[4]; };
__device__ __forceinline__ void gla2_load_raw(GlaRaw2& r, const bf16* proj, const GlaGate& gt, int row0, int h, int tid, bool want_q) {
    const int cp = tid & 63, part = tid >> 6;
#pragma unroll
    for (int i = 0; i < 8; ++i) { const bf16* base = proj + (size_t)(row0 + 8 * part + i) * GLA_PITCH + h * 128 + 2 * cp;
        r.k[i] = *(const unsigned*)(base + 512); r.q[i] = want_q ? *(const unsigned*)base : 0u; }
#if GLA_RANK16
    { const f32x2v gbv = *(const f32x2v*)(gt.gb + h * 128 + 2 * cp);
#pragma unroll
      for (int i = 0; i < 8; ++i) { r.la0[i] = gbv.x; r.la1[i] = gbv.y; }
#pragma unroll 1
      for (int j4 = 0; j4 < 4; ++j4) {
          f32x2v w[4];
#pragma unroll
          for (int jj = 0; jj < 4; ++jj) w[jj] = *(const f32x2v*)(gt.w2 + (4 * j4 + jj) * 512 + h * 128 + 2 * cp);
#pragma unroll
          for (int i = 0; i < 8; ++i) { const f32x4 rv = *(const f32x4*)(gt.R + (size_t)(row0 + 8 * part + i) * 16 + 4 * j4);
              r.la0[i] += rv.x * w[0].x + rv.y * w[1].x + rv.z * w[2].x + rv.w * w[3].x;
              r.la1[i] += rv.x * w[0].y + rv.y * w[1].y + rv.z * w[2].y + rv.w * w[3].y; }
      }
#pragma unroll
      for (int i = 0; i < 8; ++i) { r.la0[i] = log_sigmoid(r.la0[i]) * (1.0f / 16.0f); r.la1[i] = log_sigmoid(r.la1[i]) * (1.0f / 16.0f); } }
#else
#pragma unroll
    for (int i = 0; i < 8; ++i) { const unsigned w = *(const unsigned*)(proj + (size_t)(row0 + 8 * part + i) * GLA_PITCH + 3072 + h * 128 + 2 * cp); r.la0[i] = bflo(w); r.la1[i] = bfhi(w); }
#endif
#pragma unroll
    for (int i = 0; i < 4; ++i) { const int ch = tid + NTHR * i, rr = ch >> 5, c16 = ch & 31;
        r.v[i] = *(const v4u*)(proj + (size_t)(row0 + rr) * GLA_PITCH + 1024 + h * 256 + c16 * 8); }
}
__device__ __forceinline__ void gla2_cumsum(GlaCum& c, const GlaRaw2& r, LAS float* TOT, int tid) {
    const int cp = tid & 63, part = tid >> 6;
#pragma unroll
    for (int i = 0; i < 8; ++i) { c.b0[i] = r.la0[i]; c.b1[i] = r.la1[i]; }
#pragma unroll
    for (int i = 1; i < 8; ++i) { c.b0[i] += c.b0[i - 1]; c.b1[i] += c.b1[i - 1]; }
    TOT[part * 128 + 2 * cp] = c.b0[7]; TOT[part * 128 + 2 * cp + 1] = c.b1[7];
    __syncthreads();
    float o0 = 0.f, o1 = 0.f, t0 = 0.f, t1 = 0.f;
#pragma unroll
    for (int p = 0; p < 8; ++p) { const float x0 = TOT[p * 128 + 2 * cp], x1 = TOT[p * 128 + 2 * cp + 1]; if (p < part) { o0 += x0; o1 += x1; } t0 += x0; t1 += x1; }
#pragma unroll
    for (int i = 0; i < 8; ++i) { c.b0[i] += o0; c.b1[i] += o1; }
    c.tot0 = t0; c.tot1 = t1;
}
__device__ __forceinline__ void gla2_state_update(mf32x16 (&S)[4], const LAS unsigned char* KE, const LAS unsigned char* VV, const LAS float* DEC, int wave, int lane, bool scale) {
    const int hi = lane >> 5;
    if (scale) {
#pragma unroll
        for (int kt = 0; kt < 4; ++kt)
#pragma unroll
            for (int rq = 0; rq < 4; ++rq) { const f32x4 d = *(const LAS f32x4*)(DEC + 32 * kt + 8 * rq + 4 * hi);
                S[kt][4 * rq + 0] *= d.x; S[kt][4 * rq + 1] *= d.y; S[kt][4 * rq + 2] *= d.z; S[kt][4 * rq + 3] *= d.w; }
    }
#pragma unroll
    for (int ks = 0; ks < 4; ++ks) { const mbf16x8 bfr = frag_kn(VV, 576, 16 * ks, 32 * wave, lane);
#pragma unroll
        for (int kt = 0; kt < 4; ++kt) S[kt] = MFMA32(frag_kn(KE, 320, 16 * ks, 32 * kt, lane), bfr, S[kt]); }
}
__device__ __forceinline__ void phase_gla2_kv(LAS unsigned char* lds, const Ctx& a, const LayerP& P, int vcu, int G) {
    const GlaGate gt{(const float*)(a.ws + WS_R), P.e1, P.e2};
    const int tid = otid(), lane = tid & 63, wave = __builtin_amdgcn_readfirstlane(tid >> 6), hi = lane >> 5;
    const bf16* proj = (const bf16*)(a.ws + WS_H); bf16* state = (bf16*)(a.ws + WS_STATE); float* dec = (float*)(a.ws + WS_DEC);
    LAS unsigned char* VV = lds;
    LAS unsigned char* KE = lds + 36864;
    LAS float* TOT = (LAS float*)(lds + 57344);
    LAS float* DEC = (LAS float*)(lds + 61440);
    const int cp = tid & 63, part = tid >> 6;
    for (int u = vcu; u < GLA_NU2; u += G) {
        const int grp = u % GLA_NG, bh = u / GLA_NG, h = bh % GLA_H, b = bh / GLA_H;
        const int row0 = b * T + grp * (GLA_GRP * GLA_C);
        mf32x16 S[4];
#pragma unroll
        for (int kt = 0; kt < 4; ++kt) S[kt] = zero16();
        float sum0 = 0.f, sum1 = 0.f;
        GlaRaw2 cur; gla2_load_raw(cur, proj, gt, row0, h, tid, false);
#pragma unroll 1
        for (int j = 0; j < GLA_GRP; ++j) {
            GlaCum c; gla2_cumsum(c, cur, TOT, tid);
#pragma unroll
            for (int i = 0; i < 8; ++i) { const int t = 8 * part + i; const unsigned w = cur.k[i];
                *(LAS unsigned*)(KE + t * 320 + 4 * cp) = pk2(bflo(w) * __expf(c.tot0 - c.b0[i]), bfhi(w) * __expf(c.tot1 - c.b1[i])); }
            if (part == 0) { DEC[2 * cp] = __expf(c.tot0); DEC[2 * cp + 1] = __expf(c.tot1); sum0 += c.tot0; sum1 += c.tot1; }
#pragma unroll
            for (int i = 0; i < 4; ++i) { const int ch = tid + NTHR * i, r = ch >> 5, c16 = ch & 31; *(LAS v4u*)(VV + r * 576 + c16 * 16) = cur.v[i]; }
            if (j + 1 < GLA_GRP) gla2_load_raw(cur, proj, gt, row0 + (j + 1) * GLA_C, h, tid, false);
            __syncthreads();
            gla2_state_update(S, KE, VV, DEC, wave, lane, j > 0);
            __syncthreads();
        }
        if (part == 0) { dec[(size_t)u * 128 + 2 * cp] = __expf(sum0); dec[(size_t)u * 128 + 2 * cp + 1] = __expf(sum1); }
        bf16* sp = state + (size_t)u * 32768 + 32 * wave + (lane & 31);
#pragma unroll
        for (int kt = 0; kt < 4; ++kt)
#pragma unroll
            for (int r = 0; r < 16; ++r) sp[(size_t)(32 * kt + crow32(r, hi)) * 256] = (bf16)f2bf(S[kt][r]);
    }
}
__device__ __forceinline__ void phase_gla2_scan(const Ctx& a, int vcu, int G) {
    unsigned* state = (unsigned*)(a.ws + WS_STATE); const float* dec = (const float*)(a.ws + WS_DEC);
    for (int gid = vcu * NTHR + otid(); gid < NB * GLA_H * 16384; gid += G * NTHR) {
        const int bh = gid >> 14, e = gid & 16383, kd = e >> 7;
        unsigned* sp = state + (size_t)bh * GLA_NG * 16384 + e;
        const float* dp = dec + (size_t)bh * GLA_NG * 128 + kd;
        float s0 = 0.f, s1 = 0.f;
        for (int n0 = 0; n0 < GLA_NG; n0 += 32) {
            unsigned w[32]; float d[32];
#pragma unroll
            for (int i = 0; i < 32; ++i) { w[i] = sp[(size_t)(n0 + i) * 16384]; d[i] = dp[(n0 + i) * 128]; }
#pragma unroll
            for (int i = 0; i < 32; ++i) { sp[(size_t)(n0 + i) * 16384] = pk2(s0, s1); s0 = d[i] * s0 + bflo(w[i]); s1 = d[i] * s1 + bfhi(w[i]); }
        }
    }
}
__device__ __forceinline__ void phase_gla2_out(LAS unsigned char* lds, const Ctx& a, const LayerP& P, int vcu, int G, bool dummy = false) {
    const int tid = otid(), lane = tid & 63, wave = __builtin_amdgcn_readfirstlane(tid >> 6), hi = lane >> 5;
    bf16* proj = (bf16*)(a.ws + WS_H); const bf16* state = (const bf16*)(a.ws + WS_STATE);
    const float* head_norm = P.e3;
    const GlaGate gt{(const float*)(a.ws + WS_R), P.e1, P.e2};
    constexpr int SQ = 272, SA = 144, SV = 576, SO = 260;
    LAS unsigned char* QD = lds;
    LAS unsigned char* KI = lds + 17408;
    LAS unsigned char* AT = lds + 34816;
    LAS unsigned char* VV = lds + 44032;
    LAS unsigned char* KE = lds + 80896;
    LAS float* TOT = (LAS float*)(lds + 101376);
    LAS float* DEC = (LAS float*)(lds + 105472);
    LAS float* OS = (LAS float*)lds;
    const int cp = tid & 63, part = tid >> 6;
    for (int u = vcu; u < GLA_NU2; u += G) {
        const int grp = u % GLA_NG, bh = u / GLA_NG, h = bh % GLA_H, b = bh / GLA_H;
        const int rowg = b * T + grp * (GLA_GRP * GLA_C);
        mf32x16 S[4];
        { const bf16* sp = state + (size_t)u * 32768 + 32 * wave + (lane & 31);
#pragma unroll
          for (int kt = 0; kt < 4; ++kt)
#pragma unroll
              for (int r = 0; r < 16; ++r) S[kt][r] = bf2f(sp[(size_t)(32 * kt + crow32(r, hi)) * 256]); }
        GlaRaw2 cur; gla2_load_raw(cur, proj, gt, rowg, h, tid, true);
#pragma unroll 1
        for (int j = 0; j < GLA_GRP; ++j) {
            const int row0 = rowg + j * GLA_C;
            v4u gwv[4];
#pragma unroll
            for (int p = 0; p < 4; ++p) gwv[p] = *(const v4u*)(proj + (size_t)(row0 + p * 16 + wave * 2 + hi) * GLA_PITCH + 2048 + h * 256 + (lane & 31) * 8);
            GlaCum c; gla2_cumsum(c, cur, TOT, tid);
#pragma unroll
            for (int i = 0; i < 8; ++i) { const int t = 8 * part + i;
                const unsigned wq = cur.q[i], wk = cur.k[i];
                const float e0 = __expf(c.b0[i]), e1 = __expf(c.b1[i]);
                *(LAS unsigned*)(QD + t * SQ + 4 * cp) = pk2(bflo(wq) * 0.08838834764831845f * e0, bfhi(wq) * 0.08838834764831845f * e1);
                *(LAS unsigned*)(KI + t * SQ + 4 * cp) = pk2(bflo(wk) * __builtin_amdgcn_rcpf(e0), bfhi(wk) * __builtin_amdgcn_rcpf(e1));
                *(LAS unsigned*)(KE + t * 320 + 4 * cp) = pk2(bflo(wk) * __expf(c.tot0 - c.b0[i]), bfhi(wk) * __expf(c.tot1 - c.b1[i])); }
            if (part == 0) { DEC[2 * cp] = __expf(c.tot0); DEC[2 * cp + 1] = __expf(c.tot1); }
#pragma unroll
            for (int i = 0; i < 4; ++i) { const int ch = tid + NTHR * i, r = ch >> 5, c16 = ch & 31; *(LAS v4u*)(VV + r * SV + c16 * 16) = cur.v[i]; }
            if (j + 1 < GLA_GRP) gla2_load_raw(cur, proj, gt, row0 + GLA_C, h, tid, true);
            __syncthreads();
            if (wave < 4) {
                const int mi = wave >> 1, ni = wave & 1;
                mf32x16 at = zero16();
                if (!(mi == 0 && ni == 1)) {
#pragma unroll
                    for (int ks = 0; ks < 8; ++ks) at = MFMA32(frag_rk(QD, SQ, 32 * mi, 16 * ks, lane), frag_rk(KI, SQ, 32 * ni, 16 * ks, lane), at);
                }
#pragma unroll
                for (int r = 0; r < 16; ++r) { const int cc = 32 * mi + crow32(r, hi), ss = 32 * ni + (lane & 31);
                    *(LAS bf16*)(AT + cc * SA + ss * 2) = (bf16)f2bf((ss <= cc) ? at[r] : 0.f); }
            }
            __syncthreads();
            mf32x16 acc[2]; acc[0] = zero16(); acc[1] = zero16();
#pragma unroll
            for (int ks = 0; ks < 4; ++ks) { const mbf16x8 bfr = frag_kn(VV, SV, 16 * ks, 32 * wave, lane);
                if (ks < 2) acc[0] = MFMA32(frag_rk(AT, SA, 0, 16 * ks, lane), bfr, acc[0]);
                acc[1] = MFMA32(frag_rk(AT, SA, 32, 16 * ks, lane), bfr, acc[1]); }
#pragma unroll
            for (int kt = 0; kt < 4; ++kt)
#pragma unroll
                for (int sx = 0; sx < 2; ++sx) {
                    v4u bw; bw.x = pk2(S[kt][8 * sx + 0], S[kt][8 * sx + 1]); bw.y = pk2(S[kt][8 * sx + 2], S[kt][8 * sx + 3]); bw.z = pk2(S[kt][8 * sx + 4], S[kt][8 * sx + 5]); bw.w = pk2(S[kt][8 * sx + 6], S[kt][8 * sx + 7]);
                    const mbf16x8 bfr = __builtin_bit_cast(mbf16x8, bw);
#pragma unroll
                    for (int mi = 0; mi < 2; ++mi) { const LAS unsigned char* qp = QD + (32 * mi + (lane & 31)) * SQ + (32 * kt + 16 * sx + 4 * hi) * 2;
                        const v2u a0 = *(const LAS v2u*)qp, a1 = *(const LAS v2u*)(qp + 16);
                        v4u aw; aw.x = a0.x; aw.y = a0.y; aw.z = a1.x; aw.w = a1.y;
                        acc[mi] = MFMA32(__builtin_bit_cast(mbf16x8, aw), bfr, acc[mi]); } }
            if (j + 1 < GLA_GRP) gla2_state_update(S, KE, VV, DEC, wave, lane, true);
            __syncthreads();
#pragma unroll
            for (int mi = 0; mi < 2; ++mi)
#pragma unroll
                for (int r = 0; r < 16; ++r) OS[(32 * mi + crow32(r, hi)) * SO + 32 * wave + (lane & 31)] = acc[mi][r];
            __syncthreads();
#pragma unroll
            for (int p = 0; p < 4; ++p) { const int cc = p * 16 + wave * 2 + hi, c8 = (lane & 31) * 8;
                const f32x4 s0 = *(const LAS f32x4*)(OS + cc * SO + c8), s1 = *(const LAS f32x4*)(OS + cc * SO + c8 + 4);
                float ss = (s0.x * s0.x + s0.y * s0.y) + (s0.z * s0.z + s0.w * s0.w) + (s1.x * s1.x + s1.y * s1.y) + (s1.z * s1.z + s1.w * s1.w);
                ss = sum_lanes32(ss);
                const float rs = __builtin_amdgcn_rsqf(ss * (1.0f / 256.0f) + EPS);
                const f32x4 n0 = *(const f32x4*)(head_norm + c8), n1 = *(const f32x4*)(head_norm + c8 + 4);
                const v4u gw = gwv[p];
                const float gg[8] = {bflo(gw.x), bfhi(gw.x), bflo(gw.y), bfhi(gw.y), bflo(gw.z), bfhi(gw.z), bflo(gw.w), bfhi(gw.w)};
                const float ov[8] = {s0.x * n0.x, s0.y * n0.y, s0.z * n0.z, s0.w * n0.w, s1.x * n1.x, s1.y * n1.y, s1.z * n1.z, s1.w * n1.w};
                float o[8];
#pragma unroll
                for (int jj = 0; jj < 8; ++jj) o[jj] = ov[jj] * rs * (gg[jj] * __builtin_amdgcn_rcpf(1.f + __builtin_amdgcn_exp2f(-gg[jj] * LOG2E)));
                v4u w; w.x = pk2(o[0], o[1]); w.y = pk2(o[2], o[3]); w.z = pk2(o[4], o[5]); w.w = pk2(o[6], o[7]);
                if (dummy) *(v4u*)((bf16*)(a.ws + WS_STATE + 32 * MiB) + (size_t)(row0 + cc) * 1024 + h * 256 + c8) = w;
                else *(v4u*)(proj + (size_t)(row0 + cc) * GLA_PITCH + 1024 + h * 256 + c8) = w; }
            __syncthreads();
        }
    }
}

template <int L> __device__ __forceinline__ LayerP layer_params_ct(const CAS cfptr* in) {
    constexpr int base = (L == 0) ? 1 : (L == 1) ? 11 : (L == 2) ? 22 : 32;
    constexpr int kind = (L == 1) ? K_DIFF : (L == 2) ? K_SGU : K_GLA;
    constexpr int sh = (kind == K_DIFF) ? 1 : 0;
    LayerP p; p.kind = kind;
    p.norm1 = in[base]; p.w_in = in[base + 1];
    p.e0 = in[base + 2]; p.e1 = in[base + 3]; p.e2 = in[base + 4]; p.e3 = in[base + 5]; p.e4 = in[base + 6];
    p.w_out = in[base + 6 + sh]; p.norm2 = in[base + 7 + sh]; p.w1 = in[base + 8 + sh]; p.w2 = in[base + 9 + sh];
    p.nin = (kind == K_GLA) ? GLA_PITCH : (kind == K_DIFF) ? DIFF_PITCH : SGU_PITCH;
    p.mixoff = (kind == K_GLA) ? 1024 : 0;
    return p;
}
__device__ __forceinline__ void seam_xcd(const CAS Args* ap, LAS unsigned char* lds_k, bool release = true) {
#if PROBE_KIND == 1
    for (int br = 0; br < PROBE_REP; ++br)
#endif
    { XcdBarrier bb; bb.bar = (unsigned*)(ap->ws + WS_CTL) + 4096; bb.x = xb_xcc_id(); bb.st = (volatile LAS unsigned*)(lds_k + MISC_OFF) + 8; xcd_barrier(bb, release); }
}
#define PH_BEGIN(PK) { const int nrep_ = (PROBE_KIND == (PK) && (PK) != 0) ? PROBE_REP : 1; \
    for (int rep_ = 0; rep_ < nrep_; ++rep_) { \
    int vcu = vcu0, G = G0; asm volatile("" : "+s"(vcu), "+s"(G)); \
    LAS unsigned char* lds = lds_k; asm volatile("" : "+s"(lds)); \
    const CAS Args* ap = (const CAS Args*)__builtin_amdgcn_kernarg_segment_ptr(); asm volatile("" : "+s"(ap)); \
    Ctx args; args.in0 = ap->in[0]; args.in42 = ap->in[42]; args.out = ap->out; args.ws = ap->ws; \
    bf16* Wb = (bf16*)(args.ws + WS_W); bf16* XB = (bf16*)(args.ws + WS_XB); bf16* HB = (bf16*)(args.ws + WS_H); \
    float* SSQ = (float*)(args.ws + WS_SSQ); float* SSQ2 = (float*)(args.ws + WS_SSQ2); float* VSSQ = (float*)(args.ws + WS_VSSQ); \
    const LayerP P = layer_params_ct<L>((const CAS cfptr*)ap); \
    (void)Wb; (void)XB; (void)HB; (void)SSQ; (void)SSQ2; (void)VSSQ; (void)P; (void)vcu; (void)G; (void)lds;
#define PH_END_SEAM   seam_xcd(ap, lds_k); } }
#define PH_END_NOSEAM } }

template <int L> __device__ __forceinline__ void run_layer(LAS unsigned char* lds_k, int vcu0, int G0) {
    constexpr int kind = (L == 1) ? K_DIFF : (L == 2) ? K_SGU : K_GLA;
    PH_BEGIN(5) phase_conv(lds, args, P, L, vcu, G, (CONV_SPLIT && kind == K_GLA && G == 256) ? 1 : 0);
#if CG_SYNC_AT_START
    seam_xcd(ap, lds_k);
#else
    if (L == 0) { if (rep_ + 1 == nrep_) cg::this_grid().sync(); else seam_xcd(ap, lds_k); } else seam_xcd(ap, lds_k);
#endif
    PH_END_NOSEAM
    PH_BEGIN(3) { EpiIn E{kind, HB, SSQ, (kind == K_GLA) ? P.e2 : P.e0, VSSQ, (unsigned*)(args.ws + WS_CTL) + CW_QKMAX}; run_gemm(lds, XB, D, Wb + WOFF_IN, NTOK, P.nin, D, E, vcu, G);
        if constexpr (CONV_SPLIT && kind == K_GLA) { int bxo = (int)blockIdx.x; asm volatile("" : "+s"(bxo));
            if (G == 256 && bxo >= 128) { LAS unsigned char* lds2 = lds_k; asm volatile("" : "+s"(lds2)); phase_conv(lds2, args, P, L, bxo - 128, 128, 2); } } } PH_END_SEAM
    if constexpr (kind == K_GLA) {
        PH_BEGIN(4) phase_gla2_kv(lds, args, P, vcu, G); PH_END_SEAM
        PH_BEGIN(0) phase_gla2_scan(args, vcu, G); PH_END_SEAM
        PH_BEGIN(9) phase_gla2_out(lds, args, P, vcu, G, rep_ + 1 < nrep_); PH_END_SEAM
    } else if constexpr (kind == K_DIFF) {
        PH_BEGIN(7)
            if (rep_ > 0) { if (blockIdx.x == 0 && otid() == 0) __hip_atomic_store((unsigned*)(ap->ws + WS_CTL) + CW_QUEUE, 0u, RLX_AGENT); seam_xcd(ap, lds_k); }
            phase_diff_mfma((char*)lds_raw, lds, args, vcu, G);
        PH_END_SEAM
        PH_BEGIN(6) phase_diff_combine(args, P, vcu, G); PH_END_SEAM
    } else {
        PH_BEGIN(10) phase_sgu_mfma(lds, args, P, vcu, G, rep_ + 1 < nrep_); PH_END_SEAM
    }
    PH_BEGIN(L == 0 ? 8 : 0) { EpiResT<false> E{XB, SSQ2, nullptr}; run_gemm(lds, HB + P.mixoff, P.nin, Wb + WOFF_OUT, NTOK, D, D, E, vcu, G); } seam_xcd(ap, lds_k, !(RES_WT && RES_PACK)); PH_END_NOSEAM
#if PROBE_KIND == 11
    PH_BEGIN(11) { EpiHid E{HB}; E.nostore = (rep_ + 1 < nrep_) ? 1 : 0; run_gemm(lds, XB, D, Wb + WOFF_1, NTOK, FF, D, E, vcu, G); } PH_END_SEAM
#else
    PH_BEGIN(2) { EpiHid E{HB}; run_gemm(lds, XB, D, Wb + WOFF_1, NTOK, FF, D, E, vcu, G); } PH_END_SEAM
#endif
    PH_BEGIN(0) { EpiResT<true> E{XB, SSQ, SSQ2}; run_gemm(lds, HB, FF, Wb + WOFF_2, NTOK, D, FF, E, vcu, G); } seam_xcd(ap, lds_k, !(RES_WT && RES_PACK)); PH_END_NOSEAM
}

__global__ void __launch_bounds__(NTHR, 2) trunk_fwd(Args kargs) {
    LAS unsigned char* const lds_k = (LAS unsigned char*)lds_raw;
    const int G0 = gridDim.x; const int bx = blockIdx.x;
    const int vcu0 = (G0 % 8 == 0) ? (bx % 8) * (G0 / 8) + bx / 8 : bx;
    { const int tid = threadIdx.x;
      for (int u = tid; u < (LDS_BYTES - LDSCTL_OFF) / 4; u += NTHR) ((LAS unsigned*)(lds_k + LDSCTL_OFF))[u] = 0u;
      __syncthreads();
      if ((tid & 63) == 0) ((LAS unsigned*)(lds_k + TIDTAB_OFF))[hw_slot()] = (unsigned)(tid >> 6);
      __syncthreads(); }
    (void)xcd_barrier_post((unsigned*)(kargs.ws + WS_CTL) + 4096, (volatile LAS unsigned*)(lds_k + MISC_OFF) + 8);
#if CG_SYNC_AT_START
    cg::this_grid().sync();
#endif
    run_layer<0>(lds_k, vcu0, G0);
    run_layer<1>(lds_k, vcu0, G0);
    run_layer<2>(lds_k, vcu0, G0);
    run_layer<3>(lds_k, vcu0, G0);
    { int vcu = vcu0, G = G0; asm volatile("" : "+s"(vcu), "+s"(G));
      const CAS Args* ap = (const CAS Args*)__builtin_amdgcn_kernarg_segment_ptr(); asm volatile("" : "+s"(ap));
      Ctx args; args.in0 = ap->in[0]; args.in42 = ap->in[42]; args.out = ap->out; args.ws = ap->ws;
      phase_final(args, vcu, G); }
}

extern "C" void kernel_launch(void* const* d_in, const int* in_sizes, int n_in, void* d_out, int out_size, void* d_ws, size_t ws_size, hipStream_t stream) {
    static int grid = 0;
    if (grid == 0) {
        if (n_in != 43 || in_sizes[0] != NTOK * D || out_size != NTOK * D || ws_size < WS_END) {
            fprintf(stderr, "kernel_launch: unexpected problem (n_in %d, in0 %d, out %d, ws %zu); nothing launched\n", n_in, n_in > 0 ? in_sizes[0] : -1, out_size, ws_size); grid = -1; return; }
        int dev = 0, cus = 0, per_cu = 0;
        if (hipGetDevice(&dev) != hipSuccess || hipDeviceGetAttribute(&cus, hipDeviceAttributeMultiprocessorCount, dev) != hipSuccess) { grid = -1; return; }
        if (hipFuncSetAttribute((const void*)trunk_fwd, hipFuncAttributeMaxDynamicSharedMemorySize, LDS_BYTES) != hipSuccess) { fprintf(stderr, "kernel_launch: hipFuncSetAttribute failed\n"); grid = -1; return; }
        if (hipOccupancyMaxActiveBlocksPerMultiprocessor(&per_cu, (const void*)trunk_fwd, NTHR, LDS_BYTES) != hipSuccess || per_cu < 1) { fprintf(stderr, "kernel_launch: occupancy query says %d blocks/CU\n", per_cu); per_cu = 1; }
        (void)hipGetLastError();
        grid = cus;
    }
    if (grid < 0) return;
    (void)hipMemsetAsync((char*)d_ws + WS_CTL, 0, CTL_ZERO_BYTES, stream);
    Args a{};
    for (int i = 0; i < 43; ++i) a.in[i] = (const float*)d_in[i];
    a.out = (float*)d_out; a.ws = (unsigned char*)d_ws;
    a.ph_lo = 0; a.ph_hi = 0;
    void* kargs[] = {&a};
    hipError_t e = hipLaunchCooperativeKernel((const void*)trunk_fwd, dim3(grid), dim3(NTHR), kargs, LDS_BYTES, stream);
    if (e != hipSuccess) fprintf(stderr, "kernel_launch: cooperative launch failed: %s (grid %d)\n", hipGetErrorString(e), grid);
}
```
